# Optimizing an MI355X kernel written in HIP

```python
import jax, jax.numpy as jnp
from jax import lax
import numpy as np

D_MODEL = 2048
BATCH = 2
SEQ = 4096
DEPTH = 1

CHUNK = 64
EPS = 1e-6

GM_GROUPS = 8
GM_DIM = 1024
GM_GROUP_DIM = GM_DIM // GM_GROUPS
GM_BLOCK = 128

RET_HEADS = 8
RET_DK = 128
RET_DV = 256
RET_QK = RET_HEADS * RET_DK
RET_V = RET_HEADS * RET_DV
ROPE_BASE = 10000.0

IN_WIDTH = 2 * GM_DIM + 2 * RET_QK + 2 * RET_V
N_BRANCH = 2
N_MOD = 6

PEER_HEADS = 8
PEER_NKEYS = 128
PEER_NEXPERTS = PEER_NKEYS * PEER_NKEYS
PEER_DKEY = 256
PEER_DHALF = PEER_DKEY // 2
PEER_TOPK = 16
PEER_TOKEN_BLOCK = 128

kernel_name = "chunk_causal_gmlp_retention_peer_hybrid"


def rmsnorm(x, g):
    xf = x.astype(jnp.float32)
    y = xf * lax.rsqrt(jnp.mean(xf * xf, axis=-1, keepdims=True) + EPS)
    return (y * g.astype(jnp.float32)).astype(x.dtype)


def modulate(h, shift, scale):
    return h * (1.0 + scale[:, None, :]) + shift[:, None, :]


def rotary(t, positions):
    half = t.shape[-1] // 2
    freqs = ROPE_BASE ** (-jnp.arange(half, dtype=jnp.float32) / half)
    ang = positions.astype(jnp.float32)[:, :, None, None] * freqs
    cos, sin = jnp.cos(ang), jnp.sin(ang)
    t1, t2 = t[..., :half], t[..., half:]
    return jnp.concatenate([t1 * cos - t2 * sin, t1 * sin + t2 * cos], axis=-1)


def gmlp_mixer(za, v_gain, ws, bias):
    b_, s_ = za.shape[0], za.shape[1]
    za = jax.nn.gelu(za, approximate=False)
    u, v = jnp.split(za, 2, axis=-1)
    v = rmsnorm(v.reshape(b_, s_, GM_GROUPS, GM_GROUP_DIM),
                v_gain.reshape(GM_GROUPS, GM_GROUP_DIM))
    vb = v.reshape(b_, s_ // GM_BLOCK, GM_BLOCK, GM_GROUPS, GM_GROUP_DIM)
    cid = jnp.arange(GM_BLOCK) // CHUNK
    mask = cid[:, None] >= cid[None, :]
    wsm = jnp.where(mask[None], ws, jnp.zeros_like(ws))
    s = jnp.einsum('gij,bnjgd->bnigd', wsm, vb) + bias.T[None, None, :, :, None]
    return u * s.reshape(b_, s_, GM_DIM)


def retention(q, k, v, g, positions, gn_gain):
    b_, s_ = q.shape[0], q.shape[1]
    nc = s_ // CHUNK
    f32 = jnp.float32
    qf = rotary(q.reshape(b_, s_, RET_HEADS, RET_DK).astype(f32), positions)
    kf = rotary(k.reshape(b_, s_, RET_HEADS, RET_DK).astype(f32), positions) * (RET_DK ** -0.5)
    vf = v.reshape(b_, s_, RET_HEADS, RET_DV).astype(f32)

    def to_chunks(t):
        return t.reshape(b_, nc, CHUNK, RET_HEADS, t.shape[-1]).transpose(1, 0, 3, 2, 4)

    log_g = jnp.log1p(-jnp.exp2(-5.0 - jnp.arange(RET_HEADS, dtype=f32)))
    idx = jnp.arange(CHUNK, dtype=f32)
    d_intra = jnp.exp(log_g[:, None, None] * jnp.abs(idx[:, None] - idx[None, :]))
    q_dec = jnp.exp(log_g[:, None] * (idx + 1.0))
    k_dec = jnp.exp(log_g[:, None] * (CHUNK - 1.0 - idx))
    c_dec = jnp.exp(log_g * CHUNK)

    def step(state, inp):
        qc, kc, vc = inp
        att = jnp.einsum('bhid,bhjd->bhij', qc, kc) * d_intra
        o = jnp.einsum('bhij,bhjv->bhiv', att, vc) + jnp.einsum(
            'bhid,bhdv->bhiv', qc * q_dec[None, :, :, None], state)
        state = state * c_dec[None, :, None, None] + jnp.einsum(
            'bhjd,bhjv->bhdv', kc * k_dec[None, :, :, None], vc)
        return state, o

    s0 = jnp.zeros((b_, RET_HEADS, RET_DK, RET_DV), f32)
    _, o = lax.scan(step, s0, (to_chunks(qf), to_chunks(kf), to_chunks(vf)))
    o = o.transpose(1, 0, 3, 2, 4).reshape(b_, s_, RET_HEADS, RET_DV)
    mu = jnp.mean(o, axis=-1, keepdims=True)
    var = jnp.mean(jnp.square(o - mu), axis=-1, keepdims=True)
    on = (o - mu) * lax.rsqrt(var + EPS) * gn_gain.astype(f32).reshape(RET_HEADS, RET_DV)
    return jax.nn.silu(g) * on.reshape(b_, s_, RET_V).astype(g.dtype)


def peer(h, wq, subkeys, emb_u, emb_v):
    b_, s_, d_ = h.shape
    t_ = b_ * s_
    hf = h.reshape(t_, d_)
    q = (hf @ wq).reshape(t_, PEER_HEADS, 2, PEER_DHALF).astype(jnp.float32)
    sc = jnp.einsum('thpd,hpnd->thpn', q, subkeys.astype(jnp.float32))
    v1, i1 = lax.top_k(sc[:, :, 0], PEER_TOPK)
    v2, i2 = lax.top_k(sc[:, :, 1], PEER_TOPK)
    cand = (v1[..., :, None] + v2[..., None, :]).reshape(t_, PEER_HEADS, PEER_TOPK * PEER_TOPK)
    cidx = (i1[..., :, None] * PEER_NKEYS + i2[..., None, :]).reshape(t_, PEER_HEADS, PEER_TOPK * PEER_TOPK)
    top, sel = lax.top_k(cand, PEER_TOPK)
    eidx = jnp.take_along_axis(cidx, sel, axis=-1)
    gate = jax.nn.softmax(top, axis=-1).astype(h.dtype)

    nb = t_ // PEER_TOKEN_BLOCK
    xb = hf.reshape(nb, PEER_TOKEN_BLOCK, d_)
    ib = eidx.reshape(nb, PEER_TOKEN_BLOCK, PEER_HEADS, PEER_TOPK)
    gb = gate.reshape(nb, PEER_TOKEN_BLOCK, PEER_HEADS, PEER_TOPK)

    def block(args):
        xt, it, gt = args
        u = emb_u[it]
        a = jnp.einsum('td,thkd->thk', xt, u)
        w = jax.nn.gelu(a, approximate=False) * gt
        vv = emb_v[it]
        return jnp.einsum('thk,thkd->td', w, vv)

    y = lax.map(block, (xb, ib, gb))
    return y.reshape(b_, s_, d_)


def setup_inputs(seed: int = 0) -> dict:
    key = jax.random.key(seed)
    ks = jax.random.split(key, 24)
    n = jax.random.normal
    f32 = jnp.float32
    D = D_MODEL
    x = n(ks[0], (BATCH, SEQ, D), f32)
    c = n(ks[1], (BATCH, D), f32)
    offset = jax.random.randint(ks[2], (BATCH, 1), 0, 64, dtype=jnp.int32) * CHUNK
    positions = jnp.arange(SEQ, dtype=jnp.int32)[None, :] + offset
    return {
        "x": x,
        "c": c,
        "positions": positions,
        "w_ada": n(ks[3], (DEPTH, D, N_MOD * D), f32) * (0.5 * D ** -0.5),
        "b_ada": n(ks[4], (DEPTH, N_MOD * D), f32) * 0.02,
        "norm1_g": 1.0 + 0.02 * n(ks[5], (DEPTH, D), f32),
        "w_in": n(ks[6], (DEPTH, D, IN_WIDTH), f32) * D ** -0.5,
        "w_branch_gate": n(ks[7], (DEPTH, D, N_BRANCH * D), f32) * D ** -0.5,
        "b_branch_gate": n(ks[8], (DEPTH, N_BRANCH * D), f32) * 0.02,
        "gm_v_g": 1.0 + 0.02 * n(ks[9], (DEPTH, GM_DIM), f32),
        "gm_ws": n(ks[10], (DEPTH, GM_GROUPS, GM_BLOCK, GM_BLOCK), f32) * (0.5 * GM_BLOCK ** -0.5),
        "gm_b": 1.0 + 0.1 * n(ks[11], (DEPTH, GM_GROUPS, GM_BLOCK), f32),
        "ret_gn_g": 1.0 + 0.02 * n(ks[12], (DEPTH, RET_V), f32),
        "w_a_out": n(ks[13], (DEPTH, GM_DIM, D), f32) * GM_DIM ** -0.5,
        "w_b_out": n(ks[14], (DEPTH, RET_V, D), f32) * RET_V ** -0.5,
        "w_o": n(ks[15], (DEPTH, D, D), f32) * D ** -0.5,
        "norm2_g": 1.0 + 0.02 * n(ks[16], (DEPTH, D), f32),
        "peer_wq": n(ks[17], (DEPTH, D, PEER_HEADS * PEER_DKEY), f32) * D ** -0.5,
        "peer_subkeys": n(ks[18], (DEPTH, PEER_HEADS, 2, PEER_NKEYS, PEER_DHALF), f32) * PEER_DHALF ** -0.5,
        "peer_u": n(ks[19], (DEPTH, PEER_NEXPERTS, D), f32) * D ** -0.5,
        "peer_v": n(ks[20], (DEPTH, PEER_NEXPERTS, D), f32) * 0.5,
        "norm_f_g": 1.0 + 0.02 * n(ks[21], (D,), f32),
    }


def reference(x, c, positions, w_ada, b_ada, norm1_g, w_in, w_branch_gate, b_branch_gate,
              gm_v_g, gm_ws, gm_b, ret_gn_g, w_a_out, w_b_out, w_o, norm2_g,
              peer_wq, peer_subkeys, peer_u, peer_v, norm_f_g):
    for l in range(DEPTH):
        ada = jax.nn.silu(c) @ w_ada[l] + b_ada[l]
        sh1, sc1, ga1, sh2, sc2, ga2 = jnp.split(ada, N_MOD, axis=-1)

        h = modulate(rmsnorm(x, norm1_g[l]), sh1, sc1)
        z = h @ w_in[l]
        za, zq, zk, zv, zg = jnp.split(
            z, [2 * GM_DIM, 2 * GM_DIM + RET_QK, 2 * GM_DIM + 2 * RET_QK,
                2 * GM_DIM + 2 * RET_QK + RET_V], axis=-1)
        ya = gmlp_mixer(za, gm_v_g[l], gm_ws[l], gm_b[l]) @ w_a_out[l]
        yb = retention(zq, zk, zv, zg, positions, ret_gn_g[l]) @ w_b_out[l]
        gates = jax.nn.sigmoid(h @ w_branch_gate[l] + b_branch_gate[l])
        gate_a, gate_b = jnp.split(gates, N_BRANCH, axis=-1)
        mix = (gate_a * ya + gate_b * yb) @ w_o[l]
        x = x + ga1[:, None, :] * mix

        h2 = modulate(rmsnorm(x, norm2_g[l]), sh2, sc2)
        x = x + ga2[:, None, :] * peer(h2, peer_wq[l], peer_subkeys[l], peer_u[l], peer_v[l])
    return rmsnorm(x, norm_f_g)
```

```cpp
#include <hip/hip_runtime.h>
#include <hip/hip_cooperative_groups.h>
#include <stdint.h>
#include <math.h>
#include <cstdio>

namespace cg = cooperative_groups;

#ifndef ONE_LAUNCH
#define ONE_LAUNCH 0
#endif

constexpr int DM = 2048;
constexpr int SQ = 4096;
constexpr int NTOK = 8192;
constexpr int NTH = 512;
constexpr int INW = 8192;
constexpr int NMOD = 12288;
constexpr int LDS_BYTES = 132 * 1024;

struct Params {
    const float *x, *c; const int* pos;
    const float *w_ada, *b_ada, *norm1_g, *w_in, *w_bg, *b_bg, *gm_v_g, *gm_ws, *gm_b, *ret_gn_g, *w_a_out, *w_b_out, *w_o, *norm2_g,
                *peer_wq, *peer_sk, *peer_u, *peer_v, *norm_f_g;
    float* out;
    float *ada, *rope, *gatev; int* eidx;
    float *bufA, *bufZ, *bufG, *bufY;
};

__constant__ float c_freq[64] = {
1.000000000e+00f, 8.659643531e-01f, 7.498942018e-01f, 6.493816376e-01f, 5.623413324e-01f, 4.869675338e-01f, 4.216965139e-01f, 3.651741147e-01f, 3.162277639e-01f, 2.738419771e-01f, 2.371373773e-01f, 2.053525001e-01f, 1.778279394e-01f, 1.539926529e-01f, 1.333521456e-01f, 1.154781953e-01f, 1.000000015e-01f, 8.659642935e-02f, 7.498942316e-02f, 6.493816525e-02f, 5.623413250e-02f, 4.869675264e-02f, 4.216964915e-02f, 3.651741147e-02f, 3.162277490e-02f, 2.738419548e-02f, 2.371373773e-02f, 2.053525113e-02f, 1.778279431e-02f, 1.539926510e-02f, 1.333521400e-02f, 1.154781971e-02f, 9.999999776e-03f, 8.659643121e-03f, 7.498942316e-03f, 6.493816152e-03f, 5.623413250e-03f, 4.869675264e-03f, 4.216964822e-03f, 3.651741194e-03f, 3.162277630e-03f, 2.738419687e-03f, 2.371373819e-03f, 2.053525066e-03f, 1.778279431e-03f, 1.539926510e-03f, 1.333521446e-03f, 1.154782018e-03f, 1.000000047e-03f, 8.659643354e-04f, 7.498941850e-04f, 6.493816036e-04f, 5.623413017e-04f, 4.869675322e-04f, 4.216965172e-04f, 3.651741135e-04f, 3.162277571e-04f, 2.738419571e-04f, 2.371373703e-04f, 2.053525095e-04f, 1.778279402e-04f, 1.539926598e-04f, 1.333521504e-04f, 1.154782003e-04f };

__device__ __forceinline__ float wave_sum(float v) {
#pragma unroll
    for (int o = 1; o < 64; o <<= 1) v += __shfl_xor(v, o);
    return v;
}
__device__ __forceinline__ float wave_max(float v) {
#pragma unroll
    for (int o = 1; o < 64; o <<= 1) v = fmaxf(v, __shfl_xor(v, o));
    return v;
}
__device__ __forceinline__ float sigmoidf_(float x) { return 1.0f / (1.0f + expf(-x)); }
__device__ __forceinline__ float siluf_(float x) { return x * sigmoidf_(x); }
__device__ __forceinline__ float geluf_(float x) { return 0.5f * x * (1.0f + erff(x * 0.70710678118654752f)); }
__device__ __forceinline__ float dot4(float4 a, float4 b) { return a.x * b.x + a.y * b.y + a.z * b.z + a.w * b.w; }

__device__ __forceinline__ void sincos_acc(float ang, float& s, float& c) {
    const double x = (double)ang;
    const double k = rint(x * 0.63661977236758134308);
    double r = fma(-k, 1.57079632679489655800, x); r = fma(-k, 6.12323399573676603587e-17, r);
    const double r2 = r * r;
    const double sp = r * (1.0 + r2 * (-1.0 / 6.0 + r2 * (1.0 / 120.0 + r2 * (-1.0 / 5040.0 + r2 * (1.0 / 362880.0 + r2 * (-1.0 / 39916800.0 + r2 * (1.0 / 6227020800.0)))))));
    const double cp = 1.0 + r2 * (-0.5 + r2 * (1.0 / 24.0 + r2 * (-1.0 / 720.0 + r2 * (1.0 / 40320.0 + r2 * (-1.0 / 3628800.0 + r2 * (1.0 / 479001600.0 + r2 * (-1.0 / 87178291200.0)))))));
    const int q = ((int)k) & 3;
    const float fs = (float)sp, fc = (float)cp;
    s = (q == 0) ? fs : (q == 1) ? fc : (q == 2) ? -fs : -fc;
    c = (q == 0) ? fc : (q == 1) ? -fs : (q == 2) ? -fc : fs;
}

__device__ __forceinline__ void ph_prep(const Params& p, int bid, int nb, float* lds) {
    const int tid = threadIdx.x;
    for (int it = bid; it < 24; it += nb) {
        const int col = it * 512 + tid;
        float a0 = 0.f, a1 = 0.f;
        for (int k = 0; k < DM; ++k) {
            const float w = p.w_ada[(size_t)k * NMOD + col];
            a0 += siluf_(p.c[k]) * w; a1 += siluf_(p.c[DM + k]) * w;
        }
        p.ada[col] = a0 + p.b_ada[col]; p.ada[NMOD + col] = a1 + p.b_ada[col];
    }
    for (int e = bid * NTH + tid; e < NTOK * 64; e += nb * NTH) {
        const int tok = e >> 6, j = e & 63;
        const float ang = (float)p.pos[tok] * c_freq[j];
        float s, c; sincos_acc(ang, s, c);
        p.rope[(size_t)e * 2] = c; p.rope[(size_t)e * 2 + 1] = s;
    }
}

__device__ __forceinline__ void ph_modnorm(const Params& p, const float* xin, const float* g, int sh_off, int sc_off, float* hout, int bid, int nb, float* lds) {
    const int tid = threadIdx.x, wave = tid >> 6, lane = tid & 63;
    for (int row = bid * 8 + wave; row < NTOK; row += nb * 8) {
        const int b = row / SQ;
        const float4* xr = (const float4*)(xin + (size_t)row * DM);
        float4 v[8]; float ss = 0.f;
#pragma unroll
        for (int j = 0; j < 8; ++j) { v[j] = xr[lane + 64 * j]; ss += dot4(v[j], v[j]); }
        ss = wave_sum(ss);
        const float rs = 1.0f / sqrtf(ss * (1.0f / DM) + 1e-6f);
#pragma unroll
        for (int j = 0; j < 8; ++j) {
            const int col = (lane + 64 * j) * 4;
            const float4 g4 = *(const float4*)(g + col);
            const float4 sc = *(const float4*)(p.ada + b * NMOD + sc_off + col);
            const float4 sh = *(const float4*)(p.ada + b * NMOD + sh_off + col);
            float4 o;
            o.x = v[j].x * rs * g4.x * (1.0f + sc.x) + sh.x; o.y = v[j].y * rs * g4.y * (1.0f + sc.y) + sh.y;
            o.z = v[j].z * rs * g4.z * (1.0f + sc.z) + sh.z; o.w = v[j].w * rs * g4.w * (1.0f + sc.w) + sh.w;
            *(float4*)(hout + (size_t)row * DM + col) = o;
        }
    }
}

template <class Epi>
__device__ __forceinline__ void sgemm(const float* __restrict__ A, int lda, const float* __restrict__ W, int ldw, int M, int N, int K, int bid, int nb, float* lds, const Epi& epi) {
    float* As = lds;
    float* Bs = lds + 16 * 132;
    const int tid = threadIdx.x, tx = tid & 31, ty = tid >> 5;
    const int ntn = N / 128, ntiles = ntn * (M / 128);
    const int ar = tid >> 2, ak = (tid & 3) * 4, bk = tid >> 5, bc = (tid & 31) * 4;
    for (int tile = bid; tile < ntiles; tile += nb) {
        const int tm = tile / ntn, tn = tile % ntn;
        float acc[8][4];
#pragma unroll
        for (int i = 0; i < 8; ++i)
#pragma unroll
            for (int j = 0; j < 4; ++j) acc[i][j] = 0.f;
        const float* Ap = A + (size_t)(tm * 128 + ar) * lda + ak;
        const float* Wp = W + (size_t)bk * ldw + tn * 128 + bc;
        for (int k0 = 0; k0 < K; k0 += 16) {
            const float4 av = *(const float4*)(Ap + k0);
            const float4 bv = *(const float4*)(Wp + (size_t)k0 * ldw);
            __syncthreads();
            As[(ak + 0) * 132 + ar] = av.x; As[(ak + 1) * 132 + ar] = av.y; As[(ak + 2) * 132 + ar] = av.z; As[(ak + 3) * 132 + ar] = av.w;
            *(float4*)(Bs + bk * 128 + bc) = bv;
            __syncthreads();
#pragma unroll
            for (int k = 0; k < 16; ++k) {
                const float4 a0 = *(const float4*)(As + k * 132 + ty * 8), a1 = *(const float4*)(As + k * 132 + ty * 8 + 4);
                const float4 b4 = *(const float4*)(Bs + k * 128 + tx * 4);
                const float a[8] = {a0.x, a0.y, a0.z, a0.w, a1.x, a1.y, a1.z, a1.w};
                const float bb[4] = {b4.x, b4.y, b4.z, b4.w};
#pragma unroll
                for (int i = 0; i < 8; ++i)
#pragma unroll
                    for (int j = 0; j < 4; ++j) acc[i][j] += a[i] * bb[j];
            }
        }
#pragma unroll
        for (int i = 0; i < 8; ++i) epi(tm * 128 + ty * 8 + i, tn * 128 + tx * 4, make_float4(acc[i][0], acc[i][1], acc[i][2], acc[i][3]));
    }
    __syncthreads();
}

struct EpiZ {
    float* z;
    __device__ __forceinline__ void operator()(int r, int c, float4 v) const {
        if (c < 2048) { v.x = geluf_(v.x); v.y = geluf_(v.y); v.z = geluf_(v.z); v.w = geluf_(v.w); }
        *(float4*)(z + (size_t)r * INW + c) = v;
    }
};
struct EpiGate {
    float* g; const float* bias;
    __device__ __forceinline__ void operator()(int r, int c, float4 v) const {
        const float4 b = *(const float4*)(bias + c);
        v.x = sigmoidf_(v.x + b.x); v.y = sigmoidf_(v.y + b.y); v.z = sigmoidf_(v.z + b.z); v.w = sigmoidf_(v.w + b.w);
        *(float4*)(g + (size_t)r * 4096 + c) = v;
    }
};
struct EpiMix {
    float* m; const float* g; int goff; int accum;
    __device__ __forceinline__ void operator()(int r, int c, float4 v) const {
        const float4 gt = *(const float4*)(g + (size_t)r * 4096 + goff + c);
        float4 o = make_float4(gt.x * v.x, gt.y * v.y, gt.z * v.z, gt.w * v.w);
        float* mp = m + (size_t)r * DM + c;
        if (accum) { const float4 old = *(const float4*)mp; o.x += old.x; o.y += old.y; o.z += old.z; o.w += old.w; }
        *(float4*)mp = o;
    }
};
struct EpiRes {
    float* x1; const float* x; const float* ada; int ga_off;
    __device__ __forceinline__ void operator()(int r, int c, float4 v) const {
        const int b = r / SQ;
        const float4 ga = *(const float4*)(ada + b * NMOD + ga_off + c);
        const float4 xv = *(const float4*)(x + (size_t)r * DM + c);
        *(float4*)(x1 + (size_t)r * DM + c) = make_float4(xv.x + ga.x * v.x, xv.y + ga.y * v.y, xv.z + ga.z * v.z, xv.w + ga.w * v.w);
    }
};
struct EpiStore { float* o; int ldo;
    __device__ __forceinline__ void operator()(int r, int c, float4 v) const { *(float4*)(o + (size_t)r * ldo + c) = v; }
};

__device__ __forceinline__ void ph_gmlp(const Params& p, int bid, int nb, float* lds) {
    float* vt = lds;
    float* wm = lds + 16384;
    const float* z = p.bufZ;
    const int tid = threadIdx.x, wave = tid >> 6, lane = tid & 63;
    for (int it = bid; it < 512; it += nb) {
        const int g = it & 7, n = (it >> 3) & 31, b = it >> 8;
        const int tok0 = b * SQ + n * 128;
        __syncthreads();
        for (int i = tid; i < 16384; i += NTH) { const int ii = i >> 7, jj = i & 127; wm[i] = ((ii >> 6) >= (jj >> 6)) ? p.gm_ws[g * 16384 + i] : 0.f; }
        for (int j = wave; j < 128; j += 8) {
            const float* zr = z + (size_t)(tok0 + j) * INW + 1024 + g * 128;
            const float a = zr[lane], c2 = zr[lane + 64];
            const float ss = wave_sum(a * a + c2 * c2);
            const float rs = 1.0f / sqrtf(ss * (1.0f / 128.0f) + 1e-6f);
            vt[j * 128 + lane] = a * rs * p.gm_v_g[g * 128 + lane];
            vt[j * 128 + lane + 64] = c2 * rs * p.gm_v_g[g * 128 + lane + 64];
        }
        __syncthreads();
        const int d = tid & 127, ig = tid >> 7;
        float acc[32];
#pragma unroll
        for (int ii = 0; ii < 32; ++ii) acc[ii] = 0.f;
        for (int j = 0; j < 128; ++j) {
            const float vv = vt[j * 128 + d];
#pragma unroll
            for (int ii = 0; ii < 32; ++ii) acc[ii] += wm[(ig * 32 + ii) * 128 + j] * vv;
        }
#pragma unroll
        for (int ii = 0; ii < 32; ++ii) {
            const int i = ig * 32 + ii;
            const float s = acc[ii] + p.gm_b[g * 128 + i];
            const size_t tok = (size_t)(tok0 + i);
            const float u = z[tok * INW + g * 128 + d];
            p.bufY[tok * 1024 + g * 128 + d] = u * s;
        }
    }
    __syncthreads();
}

__device__ __forceinline__ void ph_ret(const Params& p, int bid, int nb, float* lds) {
    float* Qs = lds;
    float* Ks = Qs + 64 * 129;
    float* Vs = Ks + 64 * 129;
    float* Ss = Vs + 64 * 16;
    float* At = Ss + 128 * 16;
    float* kd = At + 64 * 65;
    const int tid = threadIdx.x;
    const float* z = p.bufZ;
    for (int it = bid; it < 256; it += nb) {
        const int vs = it & 15, h = (it >> 4) & 7, b = it >> 7;
        const float lg = log1pf(-exp2f(-5.0f - (float)h));
        const float cdec = expf(lg * 64.0f);
        __syncthreads();
        for (int i = tid; i < 2048; i += NTH) Ss[i] = 0.f;
        if (tid < 64) kd[tid] = expf(lg * (float)(63 - tid));
        for (int n = 0; n < 64; ++n) {
            const int tok0 = b * SQ + n * 64;
            __syncthreads();
            for (int e = tid; e < 4096; e += NTH) {
                const int i = e >> 6, dd = e & 63; const size_t tok = (size_t)(tok0 + i);
                const float cs = p.rope[(tok * 64 + dd) * 2], sn = p.rope[(tok * 64 + dd) * 2 + 1];
                const float* zr = z + tok * INW;
                const float q1 = zr[2048 + h * 128 + dd], q2 = zr[2048 + h * 128 + 64 + dd];
                const float k1 = zr[3072 + h * 128 + dd], k2 = zr[3072 + h * 128 + 64 + dd];
                Qs[i * 129 + dd] = q1 * cs - q2 * sn; Qs[i * 129 + 64 + dd] = q1 * sn + q2 * cs;
                const float sc = 0.08838834764831845f;
                Ks[i * 129 + dd] = (k1 * cs - k2 * sn) * sc; Ks[i * 129 + 64 + dd] = (k1 * sn + k2 * cs) * sc;
            }
            for (int e = tid; e < 1024; e += NTH) { const int j = e >> 4, v = e & 15; Vs[e] = z[(size_t)(tok0 + j) * INW + 4096 + h * 256 + vs * 16 + v]; }
            __syncthreads();
            {
                const int j = tid & 63, i0 = (tid >> 6) * 8;
                float acc[8];
#pragma unroll
                for (int ii = 0; ii < 8; ++ii) acc[ii] = 0.f;
                for (int d = 0; d < 128; ++d) {
                    const float kv = Ks[j * 129 + d];
#pragma unroll
                    for (int ii = 0; ii < 8; ++ii) acc[ii] += Qs[(i0 + ii) * 129 + d] * kv;
                }
#pragma unroll
                for (int ii = 0; ii < 8; ++ii) { const int i = i0 + ii; At[i * 65 + j] = acc[ii] * expf(lg * fabsf((float)(i - j))); }
            }
            __syncthreads();
            {
                const int v = tid & 15, i0 = tid >> 4;
#pragma unroll
                for (int rep = 0; rep < 2; ++rep) {
                    const int i = i0 + 32 * rep;
                    float a = 0.f; for (int j = 0; j < 64; ++j) a += At[i * 65 + j] * Vs[j * 16 + v];
                    float c2 = 0.f; for (int d = 0; d < 128; ++d) c2 += Qs[i * 129 + d] * Ss[d * 16 + v];
                    p.bufA[(size_t)(tok0 + i) * DM + h * 256 + vs * 16 + v] = a + c2 * expf(lg * (float)(i + 1));
                }
            }
            __syncthreads();
            {
                const int v = tid & 15, d0 = tid >> 4;
#pragma unroll
                for (int rep = 0; rep < 4; ++rep) {
                    const int d = d0 + 32 * rep;
                    float a = 0.f; for (int j = 0; j < 64; ++j) a += Ks[j * 129 + d] * kd[j] * Vs[j * 16 + v];
                    Ss[d * 16 + v] = Ss[d * 16 + v] * cdec + a;
                }
            }
        }
    }
    __syncthreads();
}

__device__ __forceinline__ void ph_gn(const Params& p, int bid, int nb, float* lds) {
    const int tid = threadIdx.x, wave = tid >> 6, lane = tid & 63;
    for (int tok = bid * 8 + wave; tok < NTOK; tok += nb * 8) {
#pragma unroll
        for (int h = 0; h < 8; ++h) {
            float* op = p.bufA + (size_t)tok * DM + h * 256 + lane * 4;
            const float4 o = *(const float4*)op;
            const float mu = wave_sum(o.x + o.y + o.z + o.w) * (1.0f / 256.0f);
            const float4 d = make_float4(o.x - mu, o.y - mu, o.z - mu, o.w - mu);
            const float var = wave_sum(dot4(d, d)) * (1.0f / 256.0f);
            const float rs = 1.0f / sqrtf(var + 1e-6f);
            const float4 gn = *(const float4*)(p.ret_gn_g + h * 256 + lane * 4);
            const float4 g = *(const float4*)(p.bufZ + (size_t)tok * INW + 6144 + h * 256 + lane * 4);
            *(float4*)op = make_float4(siluf_(g.x) * d.x * rs * gn.x, siluf_(g.y) * d.y * rs * gn.y, siluf_(g.z) * d.z * rs * gn.z, siluf_(g.w) * d.w * rs * gn.w);
        }
    }
}

template <int NL>
__device__ __forceinline__ void wave_top16(float (&v)[NL], const int (&idx)[NL], float& outv, int& outi, int lane) {
    outv = 0.f; outi = 0;
    for (int r = 0; r < 16; ++r) {
        float m = v[0];
#pragma unroll
        for (int u = 1; u < NL; ++u) m = fmaxf(m, v[u]);
        const float wm = wave_max(m);
        const unsigned long long bal = __ballot(m == wm);
        const int owner = __ffsll((long long)bal) - 1;
        int myi = -1;
        if (lane == owner) {
            bool done = false;
#pragma unroll
            for (int u = 0; u < NL; ++u) if (!done && v[u] == wm) { myi = idx[u]; v[u] = -INFINITY; done = true; }
        }
        const int wi = __shfl(myi, owner);
        if (lane == r) { outv = wm; outi = wi; }
    }
}
__device__ __forceinline__ void ph_topk(const Params& p, const float* qb, int bid, int nb, float* lds) {
    const int tid = threadIdx.x, wave = tid >> 6, lane = tid & 63;
    for (int t = bid; t < NTOK; t += nb) {
        const int h = wave;
        const float* q = qb + (size_t)t * DM + h * 256;
        float s[2][2];
#pragma unroll
        for (int pp = 0; pp < 2; ++pp)
#pragma unroll
            for (int r = 0; r < 2; ++r) {
                const int n = lane + 64 * r;
                const float4* kr = (const float4*)(p.peer_sk + ((size_t)(h * 2 + pp) * 128 + n) * 128);
                const float4* qr = (const float4*)(q + pp * 128);
                float a = 0.f;
#pragma unroll 4
                for (int d4 = 0; d4 < 32; ++d4) a += dot4(kr[d4], qr[d4]);
                s[pp][r] = a;
            }
        float v1, v2; int i1, i2;
        { float vv[2] = {s[0][0], s[0][1]}; const int ii[2] = {lane, lane + 64}; wave_top16<2>(vv, ii, v1, i1, lane); }
        { float vv[2] = {s[1][0], s[1][1]}; const int ii[2] = {lane, lane + 64}; wave_top16<2>(vv, ii, v2, i2, lane); }
        float cv[4]; int ci[4];
        const int a = lane >> 2, b0 = (lane & 3) * 4;
        const float va = __shfl(v1, a); const int ia = __shfl(i1, a);
#pragma unroll
        for (int u = 0; u < 4; ++u) { const float vb = __shfl(v2, b0 + u); const int ib = __shfl(i2, b0 + u); cv[u] = va + vb; ci[u] = ia * 128 + ib; }
        float tv; int te;
        wave_top16<4>(cv, ci, tv, te, lane);
        const float mx = __shfl(tv, 0);
        const float ex = (lane < 16) ? expf(tv - mx) : 0.f;
        const float sum = wave_sum(ex);
        if (lane < 16) { p.eidx[(size_t)t * 128 + h * 16 + lane] = te; p.gatev[(size_t)t * 128 + h * 16 + lane] = ex / sum; }
    }
}

__device__ __forceinline__ void ph_peer(const Params& p, const float* x1, const float* h2, int bid, int nb, float* lds) {
    float* ys = lds;
    float* red = lds + 8 * 2048;
    const int tid = threadIdx.x, wave = tid >> 6, lane = tid & 63;
    for (int t = bid; t < NTOK; t += nb) {
        const int b = t / SQ, h = wave;
        const float4* hr = (const float4*)(h2 + (size_t)t * DM);
        float4 hv[8], y[8];
#pragma unroll
        for (int j = 0; j < 8; ++j) { hv[j] = hr[lane + 64 * j]; y[j] = make_float4(0.f, 0.f, 0.f, 0.f); }
        for (int k = 0; k < 16; ++k) {
            const int e = p.eidx[(size_t)t * 128 + h * 16 + k]; const float gt = p.gatev[(size_t)t * 128 + h * 16 + k];
            const float4* ur = (const float4*)(p.peer_u + (size_t)e * DM);
            float a = 0.f;
#pragma unroll
            for (int j = 0; j < 8; ++j) a += dot4(ur[lane + 64 * j], hv[j]);
            a = wave_sum(a);
            const float w = geluf_(a) * gt;
            const float4* vr = (const float4*)(p.peer_v + (size_t)e * DM);
#pragma unroll
            for (int j = 0; j < 8; ++j) { const float4 v4 = vr[lane + 64 * j]; y[j].x += w * v4.x; y[j].y += w * v4.y; y[j].z += w * v4.z; y[j].w += w * v4.w; }
        }
        __syncthreads();
#pragma unroll
        for (int j = 0; j < 8; ++j) *(float4*)(ys + h * 2048 + (lane + 64 * j) * 4) = y[j];
        __syncthreads();
        const int c = tid * 4;
        float4 s = make_float4(0.f, 0.f, 0.f, 0.f);
#pragma unroll
        for (int hh = 0; hh < 8; ++hh) { const float4 a = *(const float4*)(ys + hh * 2048 + c); s.x += a.x; s.y += a.y; s.z += a.z; s.w += a.w; }
        const float4 xv = *(const float4*)(x1 + (size_t)t * DM + c);
        const float4 ga = *(const float4*)(p.ada + b * NMOD + 5 * DM + c);
        const float4 x2 = make_float4(xv.x + ga.x * s.x, xv.y + ga.y * s.y, xv.z + ga.z * s.z, xv.w + ga.w * s.w);
        const float ss = wave_sum(dot4(x2, x2));
        if (lane == 0) red[wave] = ss;
        __syncthreads();
        float tot = 0.f;
#pragma unroll
        for (int w = 0; w < 8; ++w) tot += red[w];
        const float rs = 1.0f / sqrtf(tot * (1.0f / DM) + 1e-6f);
        const float4 gf = *(const float4*)(p.norm_f_g + c);
        *(float4*)(p.out + (size_t)t * DM + c) = make_float4(x2.x * rs * gf.x, x2.y * rs * gf.y, x2.z * rs * gf.z, x2.w * rs * gf.w);
    }
    __syncthreads();
}

constexpr size_t SLOT = (size_t)NTOK * DM;
constexpr int NPHASE = 11;
template <int PH>
__device__ __forceinline__ void run_phase(const Params& p, int bid, int nb, float* lds) {
    float* m = p.bufZ; float* x1 = p.bufZ + SLOT; float* h2 = p.bufZ + 2 * SLOT; float* q = p.bufZ + 3 * SLOT;
    if constexpr (PH == 0) ph_prep(p, bid, nb, lds);
    if constexpr (PH == 1) ph_modnorm(p, p.x, p.norm1_g, 0 * DM, 1 * DM, p.bufA, bid, nb, lds);
    if constexpr (PH == 2) {
        sgemm(p.bufA, DM, p.w_in, INW, NTOK, INW, DM, bid, nb, lds, EpiZ{p.bufZ});
        sgemm(p.bufA, DM, p.w_bg, 4096, NTOK, 4096, DM, bid, nb, lds, EpiGate{p.bufG, p.b_bg});
    }
    if constexpr (PH == 3) { ph_ret(p, bid, nb, lds); ph_gmlp(p, bid, nb, lds); }
    if constexpr (PH == 4) ph_gn(p, bid, nb, lds);
    if constexpr (PH == 5) {
        sgemm(p.bufY, 1024, p.w_a_out, DM, NTOK, DM, 1024, bid, nb, lds, EpiMix{m, p.bufG, 0, 0});
        sgemm(p.bufA, DM, p.w_b_out, DM, NTOK, DM, DM, bid, nb, lds, EpiMix{m, p.bufG, 2048, 1});
    }
    if constexpr (PH == 6) sgemm(m, DM, p.w_o, DM, NTOK, DM, DM, bid, nb, lds, EpiRes{x1, p.x, p.ada, 2 * DM});
    if constexpr (PH == 7) ph_modnorm(p, x1, p.norm2_g, 3 * DM, 4 * DM, h2, bid, nb, lds);
    if constexpr (PH == 8) sgemm(h2, DM, p.peer_wq, DM, NTOK, DM, DM, bid, nb, lds, EpiStore{q, DM});
    if constexpr (PH == 9) ph_topk(p, q, bid, nb, lds);
    if constexpr (PH == 10) ph_peer(p, x1, h2, bid, nb, lds);
}

template <int PH>
__global__ void __launch_bounds__(NTH) k_phase(Params p) {
    extern __shared__ __attribute__((aligned(16))) float lds[];
    run_phase<PH>(p, blockIdx.x, gridDim.x, lds);
}

#if ONE_LAUNCH
__global__ void __launch_bounds__(NTH) k_mega(Params p) {
    extern __shared__ __attribute__((aligned(16))) float lds[];
    cg::grid_group grid = cg::this_grid();
    const int bid = blockIdx.x, nb = gridDim.x;
    run_phase<0>(p, bid, nb, lds); grid.sync();
    run_phase<1>(p, bid, nb, lds); grid.sync();
    run_phase<2>(p, bid, nb, lds); grid.sync();
    run_phase<3>(p, bid, nb, lds); grid.sync();
    run_phase<4>(p, bid, nb, lds); grid.sync();
    run_phase<5>(p, bid, nb, lds); grid.sync();
    run_phase<6>(p, bid, nb, lds); grid.sync();
    run_phase<7>(p, bid, nb, lds); grid.sync();
    run_phase<8>(p, bid, nb, lds); grid.sync();
    run_phase<9>(p, bid, nb, lds); grid.sync();
    run_phase<10>(p, bid, nb, lds);
}
#endif

template <int PH> static void launch_phase(const Params& p, int grid, hipStream_t stream) {
    static bool attr = false;
    if (!attr) { (void)hipFuncSetAttribute((const void*)k_phase<PH>, hipFuncAttributeMaxDynamicSharedMemorySize, LDS_BYTES); attr = true; }
    hipLaunchKernelGGL(k_phase<PH>, dim3(grid), dim3(NTH), LDS_BYTES, stream, p);
}

extern "C" void kernel_launch(void* const* d_in, const int* in_sizes, int n_in, void* d_out, int out_size, void* d_ws, size_t ws_size, hipStream_t stream) {
    Params p{};
    p.x = (const float*)d_in[0]; p.c = (const float*)d_in[1]; p.pos = (const int*)d_in[2];
    p.w_ada = (const float*)d_in[3]; p.b_ada = (const float*)d_in[4]; p.norm1_g = (const float*)d_in[5]; p.w_in = (const float*)d_in[6];
    p.w_bg = (const float*)d_in[7]; p.b_bg = (const float*)d_in[8]; p.gm_v_g = (const float*)d_in[9]; p.gm_ws = (const float*)d_in[10];
    p.gm_b = (const float*)d_in[11]; p.ret_gn_g = (const float*)d_in[12]; p.w_a_out = (const float*)d_in[13]; p.w_b_out = (const float*)d_in[14];
    p.w_o = (const float*)d_in[15]; p.norm2_g = (const float*)d_in[16]; p.peer_wq = (const float*)d_in[17]; p.peer_sk = (const float*)d_in[18];
    p.peer_u = (const float*)d_in[19]; p.peer_v = (const float*)d_in[20]; p.norm_f_g = (const float*)d_in[21];
    p.out = (float*)d_out;
    float* w = (float*)d_ws; size_t off = 0;
    p.ada = w + off; off += 32768;
    p.rope = w + off; off += (size_t)NTOK * 128;
    p.eidx = (int*)(w + off); off += (size_t)NTOK * 128;
    p.gatev = w + off; off += (size_t)NTOK * 128;
    p.bufA = w + off; off += SLOT;
    p.bufZ = w + off; off += 4 * SLOT;
    p.bufG = w + off; off += 2 * SLOT;
    p.bufY = w + off; off += SLOT / 2;
    if (off * sizeof(float) > ws_size) { fprintf(stderr, "kernel_launch: workspace too small: need %zu have %zu\n", off * sizeof(float), ws_size); return; }
#if ONE_LAUNCH
    static int grid = 0;
    if (!grid) {
        int dev = 0, cus = 0, per_cu = 0;
        hipGetDevice(&dev); hipDeviceGetAttribute(&cus, hipDeviceAttributeMultiprocessorCount, dev);
        (void)hipFuncSetAttribute((const void*)k_mega, hipFuncAttributeMaxDynamicSharedMemorySize, LDS_BYTES);
        hipOccupancyMaxActiveBlocksPerMultiprocessor(&per_cu, k_mega, NTH, LDS_BYTES);
        if (per_cu < 1) per_cu = 1;
        grid = cus * per_cu;
    }
    void* args[] = {&p};
    hipError_t e = hipLaunchCooperativeKernel((const void*)k_mega, dim3(grid), dim3(NTH), args, LDS_BYTES, stream);
    if (e != hipSuccess) fprintf(stderr, "cooperative launch failed: %s (grid %d)\n", hipGetErrorString(e), grid);
#else
    const int G = 256;
    launch_phase<0>(p, G, stream); launch_phase<1>(p, G, stream); launch_phase<2>(p, G, stream); launch_phase<3>(p, G, stream);
    launch_phase<4>(p, G, stream); launch_phase<5>(p, G, stream); launch_phase<6>(p, G, stream); launch_phase<7>(p, G, stream);
    launch_phase<8>(p, G, stream); launch_phase<9>(p, G, stream); launch_phase<10>(p, G, stream);
#endif
}
```

```cpp
#include <hip/hip_runtime.h>
#include <hip/hip_cooperative_groups.h>
#include <stdint.h>
#include <math.h>
#include <cstdio>

namespace cg = cooperative_groups;

#ifndef ONE_LAUNCH
#define ONE_LAUNCH 1
#endif

constexpr int DM = 2048;
constexpr int SQ = 4096;
constexpr int NTOK = 8192;
constexpr int NTH = 512;
constexpr int INW = 8192;
constexpr int NMOD = 12288;
constexpr int LDS_BYTES = 132 * 1024;

struct Params {
    const float *x, *c; const int* pos;
    const float *w_ada, *b_ada, *norm1_g, *w_in, *w_bg, *b_bg, *gm_v_g, *gm_ws, *gm_b, *ret_gn_g, *w_a_out, *w_b_out, *w_o, *norm2_g,
                *peer_wq, *peer_sk, *peer_u, *peer_v, *norm_f_g;
    float* out;
    float *ada, *rope, *gatev; int* eidx;
    float *bufA, *bufZ, *bufG, *bufY;
};

__constant__ float c_freq[64] = {
1.000000000e+00f, 8.659643531e-01f, 7.498942018e-01f, 6.493816376e-01f, 5.623413324e-01f, 4.869675338e-01f, 4.216965139e-01f, 3.651741147e-01f, 3.162277639e-01f, 2.738419771e-01f, 2.371373773e-01f, 2.053525001e-01f, 1.778279394e-01f, 1.539926529e-01f, 1.333521456e-01f, 1.154781953e-01f, 1.000000015e-01f, 8.659642935e-02f, 7.498942316e-02f, 6.493816525e-02f, 5.623413250e-02f, 4.869675264e-02f, 4.216964915e-02f, 3.651741147e-02f, 3.162277490e-02f, 2.738419548e-02f, 2.371373773e-02f, 2.053525113e-02f, 1.778279431e-02f, 1.539926510e-02f, 1.333521400e-02f, 1.154781971e-02f, 9.999999776e-03f, 8.659643121e-03f, 7.498942316e-03f, 6.493816152e-03f, 5.623413250e-03f, 4.869675264e-03f, 4.216964822e-03f, 3.651741194e-03f, 3.162277630e-03f, 2.738419687e-03f, 2.371373819e-03f, 2.053525066e-03f, 1.778279431e-03f, 1.539926510e-03f, 1.333521446e-03f, 1.154782018e-03f, 1.000000047e-03f, 8.659643354e-04f, 7.498941850e-04f, 6.493816036e-04f, 5.623413017e-04f, 4.869675322e-04f, 4.216965172e-04f, 3.651741135e-04f, 3.162277571e-04f, 2.738419571e-04f, 2.371373703e-04f, 2.053525095e-04f, 1.778279402e-04f, 1.539926598e-04f, 1.333521504e-04f, 1.154782003e-04f };

__device__ __forceinline__ int tid_() { int t = threadIdx.x; asm volatile("" : "+v"(t)); return t; }
__device__ __forceinline__ float wave_sum(float v) {
#pragma unroll
    for (int o = 1; o < 64; o <<= 1) v += __shfl_xor(v, o);
    return v;
}
__device__ __forceinline__ float wave_max(float v) {
#pragma unroll
    for (int o = 1; o < 64; o <<= 1) v = fmaxf(v, __shfl_xor(v, o));
    return v;
}
__device__ __forceinline__ float sigmoidf_(float x) { return 1.0f / (1.0f + expf(-x)); }
__device__ __forceinline__ float siluf_(float x) { return x * sigmoidf_(x); }
__device__ __forceinline__ float geluf_(float x) { return 0.5f * x * (1.0f + erff(x * 0.70710678118654752f)); }
__device__ __forceinline__ float dot4(float4 a, float4 b) { return a.x * b.x + a.y * b.y + a.z * b.z + a.w * b.w; }

__device__ __forceinline__ void sincos_acc(float ang, float& s, float& c) {
    const double x = (double)ang;
    const double k = rint(x * 0.63661977236758134308);
    double r = fma(-k, 1.57079632679489655800, x); r = fma(-k, 6.12323399573676603587e-17, r);
    const double r2 = r * r;
    const double sp = r * (1.0 + r2 * (-1.0 / 6.0 + r2 * (1.0 / 120.0 + r2 * (-1.0 / 5040.0 + r2 * (1.0 / 362880.0 + r2 * (-1.0 / 39916800.0 + r2 * (1.0 / 6227020800.0)))))));
    const double cp = 1.0 + r2 * (-0.5 + r2 * (1.0 / 24.0 + r2 * (-1.0 / 720.0 + r2 * (1.0 / 40320.0 + r2 * (-1.0 / 3628800.0 + r2 * (1.0 / 479001600.0 + r2 * (-1.0 / 87178291200.0)))))));
    const int q = ((int)k) & 3;
    const float fs = (float)sp, fc = (float)cp;
    s = (q == 0) ? fs : (q == 1) ? fc : (q == 2) ? -fs : -fc;
    c = (q == 0) ? fc : (q == 1) ? -fs : (q == 2) ? -fc : fs;
}

__device__ __forceinline__ void ph_prep(const Params& p, int bid, int nb, float* lds) {
    const int tid = tid_();
    for (int it = bid; it < 24; it += nb) {
        const int col = it * 512 + tid;
        float a0 = 0.f, a1 = 0.f;
        for (int k = 0; k < DM; ++k) {
            const float w = p.w_ada[(size_t)k * NMOD + col];
            a0 += siluf_(p.c[k]) * w; a1 += siluf_(p.c[DM + k]) * w;
        }
        p.ada[col] = a0 + p.b_ada[col]; p.ada[NMOD + col] = a1 + p.b_ada[col];
    }
    for (int e = bid * NTH + tid; e < NTOK * 64; e += nb * NTH) {
        const int tok = e >> 6, j = e & 63;
        const float ang = (float)p.pos[tok] * c_freq[j];
        float s, c; sincos_acc(ang, s, c);
        p.rope[(size_t)e * 2] = c; p.rope[(size_t)e * 2 + 1] = s;
    }
}

__device__ __forceinline__ void ph_modnorm(const Params& p, const float* xin, const float* g, int sh_off, int sc_off, float* hout, int bid, int nb, float* lds) {
    const int tid = tid_(), wave = tid >> 6, lane = tid & 63;
    for (int row = bid * 8 + wave; row < NTOK; row += nb * 8) {
        const int b = row / SQ;
        const float4* xr = (const float4*)(xin + (size_t)row * DM);
        float4 v[8]; float ss = 0.f;
#pragma unroll
        for (int j = 0; j < 8; ++j) { v[j] = xr[lane + 64 * j]; ss += dot4(v[j], v[j]); }
        ss = wave_sum(ss);
        const float rs = 1.0f / sqrtf(ss * (1.0f / DM) + 1e-6f);
#pragma unroll
        for (int j = 0; j < 8; ++j) {
            const int col = (lane + 64 * j) * 4;
            const float4 g4 = *(const float4*)(g + col);
            const float4 sc = *(const float4*)(p.ada + b * NMOD + sc_off + col);
            const float4 sh = *(const float4*)(p.ada + b * NMOD + sh_off + col);
            float4 o;
            o.x = v[j].x * rs * g4.x * (1.0f + sc.x) + sh.x; o.y = v[j].y * rs * g4.y * (1.0f + sc.y) + sh.y;
            o.z = v[j].z * rs * g4.z * (1.0f + sc.z) + sh.z; o.w = v[j].w * rs * g4.w * (1.0f + sc.w) + sh.w;
            *(float4*)(hout + (size_t)row * DM + col) = o;
        }
    }
}

template <class Epi>
__device__ __forceinline__ void sgemm(const float* __restrict__ A, int lda, const float* __restrict__ W, int ldw, int M, int N, int K, int bid, int nb, float* lds, const Epi& epi) {
    float* As = lds;
    float* Bs = lds + 16 * 132;
    const int tid = tid_(), tx = tid & 31, ty = tid >> 5;
    const int ntn = N / 128, ntiles = ntn * (M / 128);
    const int ar = tid >> 2, ak = (tid & 3) * 4, bk = tid >> 5, bc = (tid & 31) * 4;
    for (int tile = bid; tile < ntiles; tile += nb) {
        const int tm = tile / ntn, tn = tile % ntn;
        float acc[8][4];
#pragma unroll
        for (int i = 0; i < 8; ++i)
#pragma unroll
            for (int j = 0; j < 4; ++j) acc[i][j] = 0.f;
        const float* Ap = A + (size_t)(tm * 128 + ar) * lda + ak;
        const float* Wp = W + (size_t)bk * ldw + tn * 128 + bc;
        for (int k0 = 0; k0 < K; k0 += 16) {
            const float4 av = *(const float4*)(Ap + k0);
            const float4 bv = *(const float4*)(Wp + (size_t)k0 * ldw);
            __syncthreads();
            As[(ak + 0) * 132 + ar] = av.x; As[(ak + 1) * 132 + ar] = av.y; As[(ak + 2) * 132 + ar] = av.z; As[(ak + 3) * 132 + ar] = av.w;
            *(float4*)(Bs + bk * 128 + bc) = bv;
            __syncthreads();
#pragma unroll
            for (int k = 0; k < 16; ++k) {
                const float4 a0 = *(const float4*)(As + k * 132 + ty * 8), a1 = *(const float4*)(As + k * 132 + ty * 8 + 4);
                const float4 b4 = *(const float4*)(Bs + k * 128 + tx * 4);
                const float a[8] = {a0.x, a0.y, a0.z, a0.w, a1.x, a1.y, a1.z, a1.w};
                const float bb[4] = {b4.x, b4.y, b4.z, b4.w};
#pragma unroll
                for (int i = 0; i < 8; ++i)
#pragma unroll
                    for (int j = 0; j < 4; ++j) acc[i][j] += a[i] * bb[j];
            }
        }
#pragma unroll
        for (int i = 0; i < 8; ++i) epi(tm * 128 + ty * 8 + i, tn * 128 + tx * 4, make_float4(acc[i][0], acc[i][1], acc[i][2], acc[i][3]));
    }
    __syncthreads();
}

struct EpiZ {
    float* z;
    __device__ __forceinline__ void operator()(int r, int c, float4 v) const {
        if (c < 2048) { v.x = geluf_(v.x); v.y = geluf_(v.y); v.z = geluf_(v.z); v.w = geluf_(v.w); }
        *(float4*)(z + (size_t)r * INW + c) = v;
    }
};
struct EpiGate {
    float* g; const float* bias;
    __device__ __forceinline__ void operator()(int r, int c, float4 v) const {
        const float4 b = *(const float4*)(bias + c);
        v.x = sigmoidf_(v.x + b.x); v.y = sigmoidf_(v.y + b.y); v.z = sigmoidf_(v.z + b.z); v.w = sigmoidf_(v.w + b.w);
        *(float4*)(g + (size_t)r * 4096 + c) = v;
    }
};
struct EpiMix {
    float* m; const float* g; int goff; int accum;
    __device__ __forceinline__ void operator()(int r, int c, float4 v) const {
        const float4 gt = *(const float4*)(g + (size_t)r * 4096 + goff + c);
        float4 o = make_float4(gt.x * v.x, gt.y * v.y, gt.z * v.z, gt.w * v.w);
        float* mp = m + (size_t)r * DM + c;
        if (accum) { const float4 old = *(const float4*)mp; o.x += old.x; o.y += old.y; o.z += old.z; o.w += old.w; }
        *(float4*)mp = o;
    }
};
struct EpiRes {
    float* x1; const float* x; const float* ada; int ga_off;
    __device__ __forceinline__ void operator()(int r, int c, float4 v) const {
        const int b = r / SQ;
        const float4 ga = *(const float4*)(ada + b * NMOD + ga_off + c);
        const float4 xv = *(const float4*)(x + (size_t)r * DM + c);
        *(float4*)(x1 + (size_t)r * DM + c) = make_float4(xv.x + ga.x * v.x, xv.y + ga.y * v.y, xv.z + ga.z * v.z, xv.w + ga.w * v.w);
    }
};
struct EpiStore { float* o; int ldo;
    __device__ __forceinline__ void operator()(int r, int c, float4 v) const { *(float4*)(o + (size_t)r * ldo + c) = v; }
};

__device__ __forceinline__ void ph_gmlp(const Params& p, int bid, int nb, float* lds) {
    float* vt = lds;
    float* wm = lds + 16384;
    const float* z = p.bufZ;
    const int tid = tid_(), wave = tid >> 6, lane = tid & 63;
    for (int it = bid; it < 512; it += nb) {
        const int g = it & 7, n = (it >> 3) & 31, b = it >> 8;
        const int tok0 = b * SQ + n * 128;
        __syncthreads();
        for (int i = tid; i < 16384; i += NTH) { const int ii = i >> 7, jj = i & 127; wm[i] = ((ii >> 6) >= (jj >> 6)) ? p.gm_ws[g * 16384 + i] : 0.f; }
        for (int j = wave; j < 128; j += 8) {
            const float* zr = z + (size_t)(tok0 + j) * INW + 1024 + g * 128;
            const float a = zr[lane], c2 = zr[lane + 64];
            const float ss = wave_sum(a * a + c2 * c2);
            const float rs = 1.0f / sqrtf(ss * (1.0f / 128.0f) + 1e-6f);
            vt[j * 128 + lane] = a * rs * p.gm_v_g[g * 128 + lane];
            vt[j * 128 + lane + 64] = c2 * rs * p.gm_v_g[g * 128 + lane + 64];
        }
        __syncthreads();
        const int d = tid & 127, ig = tid >> 7;
        float acc[32];
#pragma unroll
        for (int ii = 0; ii < 32; ++ii) acc[ii] = 0.f;
        for (int j = 0; j < 128; ++j) {
            const float vv = vt[j * 128 + d];
#pragma unroll
            for (int ii = 0; ii < 32; ++ii) acc[ii] += wm[(ig * 32 + ii) * 128 + j] * vv;
        }
#pragma unroll
        for (int ii = 0; ii < 32; ++ii) {
            const int i = ig * 32 + ii;
            const float s = acc[ii] + p.gm_b[g * 128 + i];
            const size_t tok = (size_t)(tok0 + i);
            const float u = z[tok * INW + g * 128 + d];
            p.bufY[tok * 1024 + g * 128 + d] = u * s;
        }
    }
    __syncthreads();
}

__device__ __forceinline__ void ph_ret(const Params& p, int bid, int nb, float* lds) {
    float* Qs = lds;
    float* Ks = Qs + 64 * 129;
    float* Vs = Ks + 64 * 129;
    float* Ss = Vs + 64 * 16;
    float* At = Ss + 128 * 16;
    float* kd = At + 64 * 65;
    const int tid = tid_();
    const float* z = p.bufZ;
    for (int it = bid; it < 256; it += nb) {
        const int vs = it & 15, h = (it >> 4) & 7, b = it >> 7;
        const float lg = log1pf(-exp2f(-5.0f - (float)h));
        const float cdec = expf(lg * 64.0f);
        __syncthreads();
        for (int i = tid; i < 2048; i += NTH) Ss[i] = 0.f;
        if (tid < 64) kd[tid] = expf(lg * (float)(63 - tid));
        for (int n = 0; n < 64; ++n) {
            const int tok0 = b * SQ + n * 64;
            __syncthreads();
            for (int e = tid; e < 4096; e += NTH) {
                const int i = e >> 6, dd = e & 63; const size_t tok = (size_t)(tok0 + i);
                const float cs = p.rope[(tok * 64 + dd) * 2], sn = p.rope[(tok * 64 + dd) * 2 + 1];
                const float* zr = z + tok * INW;
                const float q1 = zr[2048 + h * 128 + dd], q2 = zr[2048 + h * 128 + 64 + dd];
                const float k1 = zr[3072 + h * 128 + dd], k2 = zr[3072 + h * 128 + 64 + dd];
                Qs[i * 129 + dd] = q1 * cs - q2 * sn; Qs[i * 129 + 64 + dd] = q1 * sn + q2 * cs;
                const float sc = 0.08838834764831845f;
                Ks[i * 129 + dd] = (k1 * cs - k2 * sn) * sc; Ks[i * 129 + 64 + dd] = (k1 * sn + k2 * cs) * sc;
            }
            for (int e = tid; e < 1024; e += NTH) { const int j = e >> 4, v = e & 15; Vs[e] = z[(size_t)(tok0 + j) * INW + 4096 + h * 256 + vs * 16 + v]; }
            __syncthreads();
            {
                const int j = tid & 63, i0 = (tid >> 6) * 8;
                float acc[8];
#pragma unroll
                for (int ii = 0; ii < 8; ++ii) acc[ii] = 0.f;
                for (int d = 0; d < 128; ++d) {
                    const float kv = Ks[j * 129 + d];
#pragma unroll
                    for (int ii = 0; ii < 8; ++ii) acc[ii] += Qs[(i0 + ii) * 129 + d] * kv;
                }
#pragma unroll
                for (int ii = 0; ii < 8; ++ii) { const int i = i0 + ii; At[i * 65 + j] = acc[ii] * expf(lg * fabsf((float)(i - j))); }
            }
            __syncthreads();
            {
                const int v = tid & 15, i0 = tid >> 4;
#pragma unroll
                for (int rep = 0; rep < 2; ++rep) {
                    const int i = i0 + 32 * rep;
                    float a = 0.f; for (int j = 0; j < 64; ++j) a += At[i * 65 + j] * Vs[j * 16 + v];
                    float c2 = 0.f; for (int d = 0; d < 128; ++d) c2 += Qs[i * 129 + d] * Ss[d * 16 + v];
                    p.bufA[(size_t)(tok0 + i) * DM + h * 256 + vs * 16 + v] = a + c2 * expf(lg * (float)(i + 1));
                }
            }
            __syncthreads();
            {
                const int v = tid & 15, d0 = tid >> 4;
#pragma unroll
                for (int rep = 0; rep < 4; ++rep) {
                    const int d = d0 + 32 * rep;
                    float a = 0.f; for (int j = 0; j < 64; ++j) a += Ks[j * 129 + d] * kd[j] * Vs[j * 16 + v];
                    Ss[d * 16 + v] = Ss[d * 16 + v] * cdec + a;
                }
            }
        }
    }
    __syncthreads();
}

__device__ __forceinline__ void ph_gn(const Params& p, int bid, int nb, float* lds) {
    const int tid = tid_(), wave = tid >> 6, lane = tid & 63;
    for (int tok = bid * 8 + wave; tok < NTOK; tok += nb * 8) {
#pragma unroll
        for (int h = 0; h < 8; ++h) {
            float* op = p.bufA + (size_t)tok * DM + h * 256 + lane * 4;
            const float4 o = *(const float4*)op;
            const float mu = wave_sum(o.x + o.y + o.z + o.w) * (1.0f / 256.0f);
            const float4 d = make_float4(o.x - mu, o.y - mu, o.z - mu, o.w - mu);
            const float var = wave_sum(dot4(d, d)) * (1.0f / 256.0f);
            const float rs = 1.0f / sqrtf(var + 1e-6f);
            const float4 gn = *(const float4*)(p.ret_gn_g + h * 256 + lane * 4);
            const float4 g = *(const float4*)(p.bufZ + (size_t)tok * INW + 6144 + h * 256 + lane * 4);
            *(float4*)op = make_float4(siluf_(g.x) * d.x * rs * gn.x, siluf_(g.y) * d.y * rs * gn.y, siluf_(g.z) * d.z * rs * gn.z, siluf_(g.w) * d.w * rs * gn.w);
        }
    }
}

template <int NL>
__device__ __forceinline__ void wave_top16(float (&v)[NL], const int (&idx)[NL], float& outv, int& outi, int lane) {
    outv = 0.f; outi = 0;
    for (int r = 0; r < 16; ++r) {
        float m = v[0];
#pragma unroll
        for (int u = 1; u < NL; ++u) m = fmaxf(m, v[u]);
        const float wm = wave_max(m);
        const unsigned long long bal = __ballot(m == wm);
        const int owner = __ffsll((long long)bal) - 1;
        int myi = -1;
        if (lane == owner) {
            bool done = false;
#pragma unroll
            for (int u = 0; u < NL; ++u) if (!done && v[u] == wm) { myi = idx[u]; v[u] = -INFINITY; done = true; }
        }
        const int wi = __shfl(myi, owner);
        if (lane == r) { outv = wm; outi = wi; }
    }
}
__device__ __forceinline__ void ph_topk(const Params& p, const float* qb, int bid, int nb, float* lds) {
    const int tid = tid_(), wave = tid >> 6, lane = tid & 63;
    for (int t = bid; t < NTOK; t += nb) {
        const int h = wave;
        const float* q = qb + (size_t)t * DM + h * 256;
        float s[2][2];
#pragma unroll
        for (int pp = 0; pp < 2; ++pp)
#pragma unroll
            for (int r = 0; r < 2; ++r) {
                const int n = lane + 64 * r;
                const float4* kr = (const float4*)(p.peer_sk + ((size_t)(h * 2 + pp) * 128 + n) * 128);
                const float4* qr = (const float4*)(q + pp * 128);
                float a = 0.f;
#pragma unroll 4
                for (int d4 = 0; d4 < 32; ++d4) a += dot4(kr[d4], qr[d4]);
                s[pp][r] = a;
            }
        float v1, v2; int i1, i2;
        { float vv[2] = {s[0][0], s[0][1]}; const int ii[2] = {lane, lane + 64}; wave_top16<2>(vv, ii, v1, i1, lane); }
        { float vv[2] = {s[1][0], s[1][1]}; const int ii[2] = {lane, lane + 64}; wave_top16<2>(vv, ii, v2, i2, lane); }
        float cv[4]; int ci[4];
        const int a = lane >> 2, b0 = (lane & 3) * 4;
        const float va = __shfl(v1, a); const int ia = __shfl(i1, a);
#pragma unroll
        for (int u = 0; u < 4; ++u) { const float vb = __shfl(v2, b0 + u); const int ib = __shfl(i2, b0 + u); cv[u] = va + vb; ci[u] = ia * 128 + ib; }
        float tv; int te;
        wave_top16<4>(cv, ci, tv, te, lane);
        const float mx = __shfl(tv, 0);
        const float ex = (lane < 16) ? expf(tv - mx) : 0.f;
        const float sum = wave_sum(ex);
        if (lane < 16) { p.eidx[(size_t)t * 128 + h * 16 + lane] = te; p.gatev[(size_t)t * 128 + h * 16 + lane] = ex / sum; }
    }
}

__device__ __forceinline__ void ph_peer(const Params& p, const float* x1, const float* h2, int bid, int nb, float* lds) {
    float* ys = lds;
    float* red = lds + 8 * 2048;
    const int tid = tid_(), wave = tid >> 6, lane = tid & 63;
    for (int t = bid; t < NTOK; t += nb) {
        const int b = t / SQ, h = wave;
        const float4* hr = (const float4*)(h2 + (size_t)t * DM);
        float4 hv[8], y[8];
#pragma unroll
        for (int j = 0; j < 8; ++j) { hv[j] = hr[lane + 64 * j]; y[j] = make_float4(0.f, 0.f, 0.f, 0.f); }
        for (int k = 0; k < 16; ++k) {
            const int e = p.eidx[(size_t)t * 128 + h * 16 + k]; const float gt = p.gatev[(size_t)t * 128 + h * 16 + k];
            const float4* ur = (const float4*)(p.peer_u + (size_t)e * DM);
            float a = 0.f;
#pragma unroll
            for (int j = 0; j < 8; ++j) a += dot4(ur[lane + 64 * j], hv[j]);
            a = wave_sum(a);
            const float w = geluf_(a) * gt;
            const float4* vr = (const float4*)(p.peer_v + (size_t)e * DM);
#pragma unroll
            for (int j = 0; j < 8; ++j) { const float4 v4 = vr[lane + 64 * j]; y[j].x += w * v4.x; y[j].y += w * v4.y; y[j].z += w * v4.z; y[j].w += w * v4.w; }
        }
        __syncthreads();
#pragma unroll
        for (int j = 0; j < 8; ++j) *(float4*)(ys + h * 2048 + (lane + 64 * j) * 4) = y[j];
        __syncthreads();
        const int c = tid * 4;
        float4 s = make_float4(0.f, 0.f, 0.f, 0.f);
#pragma unroll
        for (int hh = 0; hh < 8; ++hh) { const float4 a = *(const float4*)(ys + hh * 2048 + c); s.x += a.x; s.y += a.y; s.z += a.z; s.w += a.w; }
        const float4 xv = *(const float4*)(x1 + (size_t)t * DM + c);
        const float4 ga = *(const float4*)(p.ada + b * NMOD + 5 * DM + c);
        const float4 x2 = make_float4(xv.x + ga.x * s.x, xv.y + ga.y * s.y, xv.z + ga.z * s.z, xv.w + ga.w * s.w);
        const float ss = wave_sum(dot4(x2, x2));
        if (lane == 0) red[wave] = ss;
        __syncthreads();
        float tot = 0.f;
#pragma unroll
        for (int w = 0; w < 8; ++w) tot += red[w];
        const float rs = 1.0f / sqrtf(tot * (1.0f / DM) + 1e-6f);
        const float4 gf = *(const float4*)(p.norm_f_g + c);
        *(float4*)(p.out + (size_t)t * DM + c) = make_float4(x2.x * rs * gf.x, x2.y * rs * gf.y, x2.z * rs * gf.z, x2.w * rs * gf.w);
    }
    __syncthreads();
}

constexpr size_t SLOT = (size_t)NTOK * DM;
constexpr int NPHASE = 11;
template <int PH>
__device__ __forceinline__ void run_phase(const Params& p, int bid, int nb, float* lds) {
    asm volatile("" : "+s"(bid));
    float* m = p.bufZ; float* x1 = p.bufZ + SLOT; float* h2 = p.bufZ + 2 * SLOT; float* q = p.bufZ + 3 * SLOT;
    if constexpr (PH == 0) ph_prep(p, bid, nb, lds);
    if constexpr (PH == 1) ph_modnorm(p, p.x, p.norm1_g, 0 * DM, 1 * DM, p.bufA, bid, nb, lds);
    if constexpr (PH == 2) {
        sgemm(p.bufA, DM, p.w_in, INW, NTOK, INW, DM, bid, nb, lds, EpiZ{p.bufZ});
        sgemm(p.bufA, DM, p.w_bg, 4096, NTOK, 4096, DM, bid, nb, lds, EpiGate{p.bufG, p.b_bg});
    }
    if constexpr (PH == 3) { ph_ret(p, bid, nb, lds); ph_gmlp(p, bid, nb, lds); }
    if constexpr (PH == 4) ph_gn(p, bid, nb, lds);
    if constexpr (PH == 5) {
        sgemm(p.bufY, 1024, p.w_a_out, DM, NTOK, DM, 1024, bid, nb, lds, EpiMix{m, p.bufG, 0, 0});
        sgemm(p.bufA, DM, p.w_b_out, DM, NTOK, DM, DM, bid, nb, lds, EpiMix{m, p.bufG, 2048, 1});
    }
    if constexpr (PH == 6) sgemm(m, DM, p.w_o, DM, NTOK, DM, DM, bid, nb, lds, EpiRes{x1, p.x, p.ada, 2 * DM});
    if constexpr (PH == 7) ph_modnorm(p, x1, p.norm2_g, 3 * DM, 4 * DM, h2, bid, nb, lds);
    if constexpr (PH == 8) sgemm(h2, DM, p.peer_wq, DM, NTOK, DM, DM, bid, nb, lds, EpiStore{q, DM});
    if constexpr (PH == 9) ph_topk(p, q, bid, nb, lds);
    if constexpr (PH == 10) ph_peer(p, x1, h2, bid, nb, lds);
}

template <int PH>
__global__ void __launch_bounds__(NTH) k_phase(Params p) {
    extern __shared__ __attribute__((aligned(16))) float lds[];
    run_phase<PH>(p, blockIdx.x, gridDim.x, lds);
}

#if ONE_LAUNCH
__global__ void __launch_bounds__(NTH) k_mega(Params p) {
    extern __shared__ __attribute__((aligned(16))) float lds[];
    cg::grid_group grid = cg::this_grid();
    const int bid = blockIdx.x, nb = gridDim.x;
    run_phase<0>(p, bid, nb, lds); grid.sync();
    run_phase<1>(p, bid, nb, lds); grid.sync();
    run_phase<2>(p, bid, nb, lds); grid.sync();
    run_phase<3>(p, bid, nb, lds); grid.sync();
    run_phase<4>(p, bid, nb, lds); grid.sync();
    run_phase<5>(p, bid, nb, lds); grid.sync();
    run_phase<6>(p, bid, nb, lds); grid.sync();
    run_phase<7>(p, bid, nb, lds); grid.sync();
    run_phase<8>(p, bid, nb, lds); grid.sync();
    run_phase<9>(p, bid, nb, lds); grid.sync();
    run_phase<10>(p, bid, nb, lds);
}
#endif

template <int PH> static void launch_phase(const Params& p, int grid, hipStream_t stream) {
    static bool attr = false;
    if (!attr) { (void)hipFuncSetAttribute((const void*)k_phase<PH>, hipFuncAttributeMaxDynamicSharedMemorySize, LDS_BYTES); attr = true; }
    hipLaunchKernelGGL(k_phase<PH>, dim3(grid), dim3(NTH), LDS_BYTES, stream, p);
}

extern "C" void kernel_launch(void* const* d_in, const int* in_sizes, int n_in, void* d_out, int out_size, void* d_ws, size_t ws_size, hipStream_t stream) {
    Params p{};
    p.x = (const float*)d_in[0]; p.c = (const float*)d_in[1]; p.pos = (const int*)d_in[2];
    p.w_ada = (const float*)d_in[3]; p.b_ada = (const float*)d_in[4]; p.norm1_g = (const float*)d_in[5]; p.w_in = (const float*)d_in[6];
    p.w_bg = (const float*)d_in[7]; p.b_bg = (const float*)d_in[8]; p.gm_v_g = (const float*)d_in[9]; p.gm_ws = (const float*)d_in[10];
    p.gm_b = (const float*)d_in[11]; p.ret_gn_g = (const float*)d_in[12]; p.w_a_out = (const float*)d_in[13]; p.w_b_out = (const float*)d_in[14];
    p.w_o = (const float*)d_in[15]; p.norm2_g = (const float*)d_in[16]; p.peer_wq = (const float*)d_in[17]; p.peer_sk = (const float*)d_in[18];
    p.peer_u = (const float*)d_in[19]; p.peer_v = (const float*)d_in[20]; p.norm_f_g = (const float*)d_in[21];
    p.out = (float*)d_out;
    float* w = (float*)d_ws; size_t off = 0;
    p.ada = w + off; off += 32768;
    p.rope = w + off; off += (size_t)NTOK * 128;
    p.eidx = (int*)(w + off); off += (size_t)NTOK * 128;
    p.gatev = w + off; off += (size_t)NTOK * 128;
    p.bufA = w + off; off += SLOT;
    p.bufZ = w + off; off += 4 * SLOT;
    p.bufG = w + off; off += 2 * SLOT;
    p.bufY = w + off; off += SLOT / 2;
    if (off * sizeof(float) > ws_size) { fprintf(stderr, "kernel_launch: workspace too small: need %zu have %zu\n", off * sizeof(float), ws_size); return; }
#if ONE_LAUNCH
    static int grid = 0;
    if (!grid) {
        int dev = 0, cus = 0, per_cu = 0;
        hipGetDevice(&dev); hipDeviceGetAttribute(&cus, hipDeviceAttributeMultiprocessorCount, dev);
        (void)hipFuncSetAttribute((const void*)k_mega, hipFuncAttributeMaxDynamicSharedMemorySize, LDS_BYTES);
        hipOccupancyMaxActiveBlocksPerMultiprocessor(&per_cu, k_mega, NTH, LDS_BYTES);
        if (per_cu < 1) per_cu = 1;
        grid = cus * per_cu;
    }
    void* args[] = {&p};
    hipError_t e = hipLaunchCooperativeKernel((const void*)k_mega, dim3(grid), dim3(NTH), args, LDS_BYTES, stream);
    if (e != hipSuccess) fprintf(stderr, "cooperative launch failed: %s (grid %d)\n", hipGetErrorString(e), grid);
#else
    const int G = 256;
    launch_phase<0>(p, G, stream); launch_phase<1>(p, G, stream); launch_phase<2>(p, G, stream); launch_phase<3>(p, G, stream);
    launch_phase<4>(p, G, stream); launch_phase<5>(p, G, stream); launch_phase<6>(p, G, stream); launch_phase<7>(p, G, stream);
    launch_phase<8>(p, G, stream); launch_phase<9>(p, G, stream); launch_phase<10>(p, G, stream);
#endif
}
```

```cpp
#include <hip/hip_runtime.h>
#include <hip/hip_cooperative_groups.h>
#include <stdint.h>
#include <math.h>
#include <cstdio>

namespace cg = cooperative_groups;

constexpr int DM = 2048;
constexpr int SQ = 4096;
constexpr int NTOK = 8192;
constexpr int NTH = 512;
constexpr int ZW = 12288;
constexpr int NMOD = 12288;
constexpr int LDS_BYTES = 136 * 1024;

typedef unsigned short bf16_t;

struct Params {
    const float *x, *c; const int* pos;
    const float *w_ada, *b_ada, *norm1_g, *w_in, *w_bg, *b_bg, *gm_v_g, *gm_ws, *gm_b, *ret_gn_g, *w_a_out, *w_b_out, *w_o, *norm2_g,
                *peer_wq, *peer_sk, *peer_u, *peer_v, *norm_f_g;
    float* out;
    float *ada, *rope, *gatev; int* eidx;
    bf16_t *Wt1, *Wta, *Wtb, *Wto, *Wtq;
    bf16_t *hb;
    bf16_t *ZG;
    float *obuf;
    bf16_t *ybin, *yain;
    float *qbuf;
};

__constant__ float c_freq[64] = {
1.000000000e+00f, 8.659643531e-01f, 7.498942018e-01f, 6.493816376e-01f, 5.623413324e-01f, 4.869675338e-01f, 4.216965139e-01f, 3.651741147e-01f, 3.162277639e-01f, 2.738419771e-01f, 2.371373773e-01f, 2.053525001e-01f, 1.778279394e-01f, 1.539926529e-01f, 1.333521456e-01f, 1.154781953e-01f, 1.000000015e-01f, 8.659642935e-02f, 7.498942316e-02f, 6.493816525e-02f, 5.623413250e-02f, 4.869675264e-02f, 4.216964915e-02f, 3.651741147e-02f, 3.162277490e-02f, 2.738419548e-02f, 2.371373773e-02f, 2.053525113e-02f, 1.778279431e-02f, 1.539926510e-02f, 1.333521400e-02f, 1.154781971e-02f, 9.999999776e-03f, 8.659643121e-03f, 7.498942316e-03f, 6.493816152e-03f, 5.623413250e-03f, 4.869675264e-03f, 4.216964822e-03f, 3.651741194e-03f, 3.162277630e-03f, 2.738419687e-03f, 2.371373819e-03f, 2.053525066e-03f, 1.778279431e-03f, 1.539926510e-03f, 1.333521446e-03f, 1.154782018e-03f, 1.000000047e-03f, 8.659643354e-04f, 7.498941850e-04f, 6.493816036e-04f, 5.623413017e-04f, 4.869675322e-04f, 4.216965172e-04f, 3.651741135e-04f, 3.162277571e-04f, 2.738419571e-04f, 2.371373703e-04f, 2.053525095e-04f, 1.778279402e-04f, 1.539926598e-04f, 1.333521504e-04f, 1.154782003e-04f };

__device__ __forceinline__ int tid_() { int t = threadIdx.x; asm volatile("" : "+v"(t)); return t; }
__device__ __forceinline__ float wave_sum(float v) {
#pragma unroll
    for (int o = 1; o < 64; o <<= 1) v += __shfl_xor(v, o);
    return v;
}
__device__ __forceinline__ float wave_max(float v) {
#pragma unroll
    for (int o = 1; o < 64; o <<= 1) v = fmaxf(v, __shfl_xor(v, o));
    return v;
}
__device__ __forceinline__ float sigmoidf_(float x) { return 1.0f / (1.0f + expf(-x)); }
__device__ __forceinline__ float siluf_(float x) { return x * sigmoidf_(x); }
__device__ __forceinline__ float geluf_(float x) { return 0.5f * x * (1.0f + erff(x * 0.70710678118654752f)); }
__device__ __forceinline__ float dot4(float4 a, float4 b) { return a.x * b.x + a.y * b.y + a.z * b.z + a.w * b.w; }
__device__ __forceinline__ float bf2f(bf16_t v) { return __uint_as_float((unsigned)v << 16); }
__device__ __forceinline__ float bflo(unsigned w) { return __uint_as_float(w << 16); }
__device__ __forceinline__ float bfhi(unsigned w) { return __uint_as_float(w & 0xffff0000u); }
__device__ __forceinline__ unsigned f2bf(float f) { unsigned u = __float_as_uint(f); return (u + 0x7fffu + ((u >> 16) & 1u)) >> 16; }
__device__ __forceinline__ unsigned pk2(float lo, float hi) { return f2bf(lo) | (f2bf(hi) << 16); }

__device__ __forceinline__ void sincos_acc(float ang, float& s, float& c) {
    const double x = (double)ang;
    const double k = rint(x * 0.63661977236758134308);
    double r = fma(-k, 1.57079632679489655800, x); r = fma(-k, 6.12323399573676603587e-17, r);
    const double r2 = r * r;
    const double sp = r * (1.0 + r2 * (-1.0 / 6.0 + r2 * (1.0 / 120.0 + r2 * (-1.0 / 5040.0 + r2 * (1.0 / 362880.0 + r2 * (-1.0 / 39916800.0 + r2 * (1.0 / 6227020800.0)))))));
    const double cp = 1.0 + r2 * (-0.5 + r2 * (1.0 / 24.0 + r2 * (-1.0 / 720.0 + r2 * (1.0 / 40320.0 + r2 * (-1.0 / 3628800.0 + r2 * (1.0 / 479001600.0 + r2 * (-1.0 / 87178291200.0)))))));
    const int q = ((int)k) & 3;
    const float fs = (float)sp, fc = (float)cp;
    s = (q == 0) ? fs : (q == 1) ? fc : (q == 2) ? -fs : -fc;
    c = (q == 0) ? fc : (q == 1) ? -fs : (q == 2) ? -fc : fs;
}

namespace pg8 {
#define PG8_LAS __attribute__((address_space(3)))
typedef unsigned short bf16_t;
typedef short bf16x8 __attribute__((ext_vector_type(8)));
typedef float f32x4 __attribute__((ext_vector_type(4)));
typedef unsigned u32x4 __attribute__((ext_vector_type(4)));
constexpr int BM = 256, BK = 64, HALF = 128, HTB = HALF * BK * 2  , STAGE_BYTES = 8 * HTB, NXCD = 8, WGM = 8;

__host__ __device__ __forceinline__ int lds_byte(int r, int c) { const int st = (r >> 4) * 2 + (c >> 5), rr = r & 15, cc = c & 31, ob = rr * 64 + cc * 2; return st * 1024 + (ob ^ (((ob >> 9) & 1) << 5)); }
__host__ __device__ __forceinline__ void stage_rc(int b, int& R, int& C) { const int st = b / 1024, sb = b % 1024, swz = sb ^ (((sb >> 9) & 1) << 5); R = (st >> 1) * 16 + swz / 64; C = (st & 1) * 32 + (swz % 64) / 2; }
__host__ __device__ __forceinline__ int perm32(int rho) { const int n = rho >> 4, i = rho & 15; return 8 * (i >> 2) + 4 * n + (i & 3); }

struct Unit { int pm, pn; };
struct Gemm { const bf16_t* A; const bf16_t* Bt; int M, N, K; };

struct StaticOrder {
    int nM, nN, nwg, G, c;
    __host__ __device__ void init(int M, int N, int G_, int c_) { nM = M / BM; nN = N / BM; nwg = nM * nN; G = G_; c = c_; }
    __host__ __device__ bool next(int i, Unit& u) const {
        const long L = (long)i * G + c; if (L >= nwg) return false;
        int wgid = (int)L; { const int q = nwg / NXCD, r = nwg % NXCD, xcd = wgid % NXCD, off = wgid / NXCD; wgid = (xcd < r ? xcd * (q + 1) : r * (q + 1) + (xcd - r) * q) + off; }
        const int nig = WGM * nN, gid = wgid / nig, fm = gid * WGM, gsz = (nM - fm) < WGM ? (nM - fm) : WGM;
        u.pm = fm + ((wgid % nig) % gsz); u.pn = (wgid % nig) / gsz; return true;
    }
    __device__ __forceinline__ void a_ready(const Unit&) const {}
    __device__ __forceinline__ void done(const Unit&) const {}
};

__device__ __forceinline__ unsigned cvt_pk_bf16(float lo, float hi) { unsigned r; asm volatile("v_cvt_pk_bf16_f32 %0, %1, %2" : "=v"(r) : "v"(lo), "v"(hi)); return r; }
typedef float f32x2 __attribute__((ext_vector_type(2)));
__device__ __forceinline__ f32x2 gelu_pk(f32x2 v) {
    const f32x2 av = __builtin_elementwise_abs(v), d = av * 0.2316418882f + 1.0f;
    f32x2 t; t.x = __builtin_amdgcn_rcpf(d.x); t.y = __builtin_amdgcn_rcpf(d.y);
    f32x2 q = t * 0.5307027145f + (-0.7265760135f); q = q * t + 0.7107068705f; q = q * t + (-0.142248368f); q = q * t + 0.127414796f; q = q * t;
    const f32x2 s = (v * v) * (-0.72134752044f);
    f32x2 e; e.x = __builtin_amdgcn_exp2f(s.x); e.y = __builtin_amdgcn_exp2f(s.y);
    const f32x2 m = v * (q * e), r = v - m;
    f32x2 o; o.x = v.x < 0.f ? m.x : r.x; o.y = v.y < 0.f ? m.y : r.y; return o;
}

typedef unsigned u32x2v __attribute__((ext_vector_type(2)));
struct EpiZG {
    static constexpr bool PERM = true, AFTER_DRAIN = false;
    bf16_t* O; const float* bias;
    __device__ __forceinline__ void operator()(const f32x4 (&acc)[2][2][4][2], const Unit& u, int wr, int wc, int fr, int fq) const {
        const int row0 = u.pm * BM + wr * 64 + fr, col0 = u.pn * BM + wc * 32 + 8 * fq;
        const int mode = u.pn < 8 ? 1 : (u.pn < 32 ? 0 : 2);
        f32x4 bv[2][2];
#pragma unroll
        for (int bj = 0; bj < 2; ++bj)
#pragma unroll
            for (int n = 0; n < 2; ++n) bv[bj][n] = (mode == 2) ? *(const f32x4*)(bias + (col0 - 8192) + bj * HALF + 4 * n) : (f32x4){0.f, 0.f, 0.f, 0.f};
#pragma unroll
        for (int ai = 0; ai < 2; ++ai)
#pragma unroll
            for (int m = 0; m < 4; ++m) { bf16_t* rowp = O + (size_t)(row0 + ai * HALF + m * 16) * ZW + col0;
#pragma unroll
                for (int bj = 0; bj < 2; ++bj) { f32x4 v0 = acc[ai][bj][m][0], v1 = acc[ai][bj][m][1];
                    if (mode == 1) { f32x2 a = gelu_pk((f32x2){v0[0], v0[1]}), b = gelu_pk((f32x2){v0[2], v0[3]}), c = gelu_pk((f32x2){v1[0], v1[1]}), d = gelu_pk((f32x2){v1[2], v1[3]});
                        v0 = (f32x4){a.x, a.y, b.x, b.y}; v1 = (f32x4){c.x, c.y, d.x, d.y}; }
                    if (mode == 2) { v0 = v0 + bv[bj][0]; v1 = v1 + bv[bj][1];
#pragma unroll
                        for (int e = 0; e < 4; ++e) { v0[e] = __builtin_amdgcn_rcpf(1.0f + __expf(-v0[e])); v1[e] = __builtin_amdgcn_rcpf(1.0f + __expf(-v1[e])); } }
                    u32x4 w; w.x = cvt_pk_bf16(v0[0], v0[1]); w.y = cvt_pk_bf16(v0[2], v0[3]); w.z = cvt_pk_bf16(v1[0], v1[1]); w.w = cvt_pk_bf16(v1[2], v1[3]);
                    *(u32x4*)(rowp + bj * HALF) = w; } }
    }
};
template <int ACCUM> struct EpiMixB {
    static constexpr bool PERM = true, AFTER_DRAIN = false;
    bf16_t* Mo; const bf16_t* ZGp; int goff;
    __device__ __forceinline__ void operator()(const f32x4 (&acc)[2][2][4][2], const Unit& u, int wr, int wc, int fr, int fq) const {
        const int row0 = u.pm * BM + wr * 64 + fr, col0 = u.pn * BM + wc * 32 + 8 * fq;
#pragma unroll
        for (int ai = 0; ai < 2; ++ai)
#pragma unroll
            for (int m = 0; m < 4; ++m) { const size_t row = (size_t)(row0 + ai * HALF + m * 16);
#pragma unroll
                for (int bj = 0; bj < 2; ++bj) { const f32x4 v0 = acc[ai][bj][m][0], v1 = acc[ai][bj][m][1];
                    const u32x4 g = *(const u32x4*)(ZGp + row * ZW + 8192 + goff + col0 + bj * HALF);
                    float o[8];
                    o[0] = bflo(g.x) * v0[0]; o[1] = bfhi(g.x) * v0[1]; o[2] = bflo(g.y) * v0[2]; o[3] = bfhi(g.y) * v0[3];
                    o[4] = bflo(g.z) * v1[0]; o[5] = bfhi(g.z) * v1[1]; o[6] = bflo(g.w) * v1[2]; o[7] = bfhi(g.w) * v1[3];
                    bf16_t* mp = Mo + row * DM + col0 + bj * HALF;
                    if (ACCUM) { const u32x4 old = *(const u32x4*)mp;
                        o[0] += bflo(old.x); o[1] += bfhi(old.x); o[2] += bflo(old.y); o[3] += bfhi(old.y); o[4] += bflo(old.z); o[5] += bfhi(old.z); o[6] += bflo(old.w); o[7] += bfhi(old.w); }
                    u32x4 w; w.x = cvt_pk_bf16(o[0], o[1]); w.y = cvt_pk_bf16(o[2], o[3]); w.z = cvt_pk_bf16(o[4], o[5]); w.w = cvt_pk_bf16(o[6], o[7]);
                    *(u32x4*)mp = w; } }
    }
};
struct EpiResF {
    static constexpr bool PERM = false, AFTER_DRAIN = false;
    float* x1; const float* x; const float* ga;
    __device__ __forceinline__ void operator()(const f32x4 (&acc)[2][2][4][2], const Unit& u, int wr, int wc, int fr, int fq) const {
        const int row0 = u.pm * BM + wr * 64 + fr, col0 = u.pn * BM + wc * 32 + 4 * fq;
        const int b = (u.pm * BM) / SQ;
        f32x4 gv[2][2];
#pragma unroll
        for (int bj = 0; bj < 2; ++bj)
#pragma unroll
            for (int n = 0; n < 2; ++n) gv[bj][n] = *(const f32x4*)(ga + b * NMOD + col0 + bj * HALF + n * 16);
#pragma unroll
        for (int ai = 0; ai < 2; ++ai)
#pragma unroll
            for (int m = 0; m < 4; ++m) { const size_t off = (size_t)(row0 + ai * HALF + m * 16) * DM + col0;
#pragma unroll
                for (int bj = 0; bj < 2; ++bj)
#pragma unroll
                    for (int n = 0; n < 2; ++n) { const f32x4 xv = *(const f32x4*)(x + off + bj * HALF + n * 16);
                        *(f32x4*)(x1 + off + bj * HALF + n * 16) = xv + gv[bj][n] * acc[ai][bj][m][n]; } }
    }
};
struct EpiF32 {
    static constexpr bool PERM = false, AFTER_DRAIN = false;
    float* O; int ldc;
    __device__ __forceinline__ void operator()(const f32x4 (&acc)[2][2][4][2], const Unit& u, int wr, int wc, int fr, int fq) const {
        const int row0 = u.pm * BM + wr * 64 + fr, col0 = u.pn * BM + wc * 32 + 4 * fq;
#pragma unroll
        for (int ai = 0; ai < 2; ++ai)
#pragma unroll
            for (int m = 0; m < 4; ++m) { const size_t off = (size_t)(row0 + ai * HALF + m * 16) * ldc + col0;
#pragma unroll
                for (int bj = 0; bj < 2; ++bj)
#pragma unroll
                    for (int n = 0; n < 2; ++n) *(f32x4*)(O + off + bj * HALF + n * 16) = acc[ai][bj][m][n]; }
    }
};

template <class Epi, class Sched, bool ALIGN_EPI = false, bool SP2 = false>
__device__ __forceinline__ void gemm_phase(PG8_LAS unsigned char* lds, const Gemm g, const Sched& S, const Epi& E) {
    const int tid = threadIdx.x, wid = __builtin_amdgcn_readfirstlane(tid >> 6), lane = tid & 63, wr = wid >> 2, wc = wid & 3, fr = lane & 15, fq = lane >> 4;
    const int K = g.K, nt = K / BK;
    unsigned voffA[2], voffB[2];
#pragma unroll
    for (int i = 0; i < 2; ++i) { int R, C; stage_rc(tid * 16 + i * 8192, R, C); const int Rb = Epi::PERM ? ((R & ~31) + perm32(R & 31)) : R;
        voffA[i] = (unsigned)(R * K + C) * 2u; voffB[i] = (unsigned)(Rb * K + C) * 2u; }
    const size_t kstep = (size_t)(BK * 2);
    const size_t hstep = (size_t)HALF * K * 2;
    const size_t tstep = 2 * hstep;
    const unsigned ldsw = (unsigned)wid * 1024u;
    const int aoff = lds_byte(wr * 64 + fr, fq * 8), boff = lds_byte(wc * 32 + fr, fq * 8);
#define PG8_SA(b, h) (((b) * 2 + (h)) * HTB)
#define PG8_SB(b, h) ((4 + (b) * 2 + (h)) * HTB)
#define PG8_STAGE(bufoff, gbase, voff) do { _Pragma("unroll") for (int _i = 0; _i < 2; ++_i) \
        __builtin_amdgcn_global_load_lds((const unsigned*)((const char*)(gbase) + (voff)[_i]), (PG8_LAS unsigned*)(lds + (bufoff) + ldsw + _i * 8192), 16, 0, 0); } while (0)
#define PG8_LDA(dst, b, h) do { _Pragma("unroll") for (int m = 0; m < 4; ++m) _Pragma("unroll") for (int k = 0; k < 2; ++k) dst[m][k] = *(const PG8_LAS bf16x8*)(lds + PG8_SA(b, h) + aoff + m * 2048 + k * 1024); } while (0)
#define PG8_LDB(dst, b, h) do { _Pragma("unroll") for (int n = 0; n < 2; ++n) _Pragma("unroll") for (int k = 0; k < 2; ++k) dst[n][k] = *(const PG8_LAS bf16x8*)(lds + PG8_SB(b, h) + boff + n * 2048 + k * 1024); } while (0)
#define PG8_MMA(ai, bj, At, Bt) do { __builtin_amdgcn_s_setprio(1); _Pragma("unroll") for (int m = 0; m < 4; ++m) _Pragma("unroll") for (int n = 0; n < 2; ++n) _Pragma("unroll") for (int k = 0; k < 2; ++k) \
        acc[ai][bj][m][n] = __builtin_amdgcn_mfma_f32_16x16x32_bf16(Bt[n][k], At[m][k], acc[ai][bj][m][n], 0, 0, 0); __builtin_amdgcn_s_setprio(0); } while (0)
#define PG8_WAIT_V(n) asm volatile("s_waitcnt vmcnt(" #n ")" ::: "memory")
#define PG8_WAIT_L(n) asm volatile("s_waitcnt lgkmcnt(" #n ")" ::: "memory")
#define PG8_BAR __builtin_amdgcn_s_barrier()
#define PG8_SCHED __builtin_amdgcn_sched_barrier(0)
    Unit cur, nxt; int ui = 0;
    if (!S.next(0, cur)) return;
    f32x4 acc[2][2][4][2];
#pragma unroll
    for (int a = 0; a < 2; ++a)
#pragma unroll
        for (int b = 0; b < 2; ++b)
#pragma unroll
            for (int m = 0; m < 4; ++m)
#pragma unroll
                for (int n = 0; n < 2; ++n) acc[a][b][m][n] = (f32x4){0.f, 0.f, 0.f, 0.f};
    bf16x8 At[4][2], B0[2][2], B1[2][2];
    const char* cA = (const char*)g.A + (size_t)cur.pm * tstep; const char* cB = (const char*)g.Bt + (size_t)cur.pn * tstep;
    S.a_ready(cur);
    if constexpr (SP2) {
        PG8_STAGE(PG8_SB(0, 0), cB, voffB); PG8_STAGE(PG8_SB(0, 1), cB + hstep, voffB); PG8_STAGE(PG8_SA(0, 0), cA, voffA); PG8_STAGE(PG8_SA(0, 1), cA + hstep, voffA);
        if (wr == 1) PG8_BAR;
        PG8_WAIT_V(2); PG8_BAR;
        PG8_STAGE(PG8_SB(1, 0), cB + kstep, voffB); PG8_STAGE(PG8_SA(1, 0), cA + kstep, voffA); PG8_STAGE(PG8_SB(1, 1), cB + hstep + kstep, voffB);
        PG8_WAIT_V(6); PG8_BAR;
    } else {
        PG8_STAGE(PG8_SB(0, 0), cB, voffB); PG8_STAGE(PG8_SA(0, 0), cA, voffA); PG8_STAGE(PG8_SB(0, 1), cB + hstep, voffB); PG8_STAGE(PG8_SA(0, 1), cA + hstep, voffA);
        if (wr == 1) PG8_BAR;
        PG8_WAIT_V(4); PG8_BAR;
        PG8_STAGE(PG8_SB(1, 0), cB + kstep, voffB); PG8_STAGE(PG8_SA(1, 0), cA + kstep, voffA); PG8_STAGE(PG8_SB(1, 1), cB + hstep + kstep, voffB);
        PG8_WAIT_V(6); PG8_BAR;
    }
    for (;;) {
        const bool has_next = S.next(ui + 1, nxt);
        const char* nA = has_next ? (const char*)g.A + (size_t)nxt.pm * tstep : cA; const char* nB = has_next ? (const char*)g.Bt + (size_t)nxt.pn * tstep : cB;
        for (int t = 0; t < nt; t += 2) {
            const bool last = (t == nt - 2);
            const char* a1 = cA + (size_t)(t + 1) * kstep;
            const char* a2 = last ? nA : cA + (size_t)(t + 2) * kstep; const char* b2 = last ? nB : cB + (size_t)(t + 2) * kstep;
            const char* a3 = a2 + kstep; const char* b3 = b2 + kstep;
            if (last && has_next) S.a_ready(nxt);
            if constexpr (SP2) {
            PG8_LDB(B0, 0, 0); PG8_LDB(B1, 0, 1); PG8_SCHED; PG8_LDA(At, 0, 0); PG8_STAGE(PG8_SA(1, 1), a1 + hstep, voffA);
            PG8_WAIT_V(8); PG8_WAIT_L(0); PG8_BAR; PG8_MMA(0, 0, At, B0); PG8_MMA(0, 1, At, B1); PG8_BAR; PG8_SCHED;
            PG8_LDA(At, 0, 1); PG8_STAGE(PG8_SB(0, 0), b2, voffB); PG8_STAGE(PG8_SB(0, 1), b2 + hstep, voffB); PG8_STAGE(PG8_SA(0, 0), a2, voffA);
            PG8_WAIT_V(8); PG8_WAIT_L(0); PG8_BAR; PG8_MMA(1, 0, At, B0); PG8_MMA(1, 1, At, B1); PG8_BAR; PG8_SCHED;
            PG8_LDB(B0, 1, 0); PG8_LDB(B1, 1, 1); PG8_SCHED; PG8_LDA(At, 1, 0); PG8_STAGE(PG8_SA(0, 1), a2 + hstep, voffA);
            PG8_WAIT_V(8); PG8_WAIT_L(0); PG8_BAR; PG8_MMA(0, 0, At, B0); PG8_MMA(0, 1, At, B1); PG8_BAR; PG8_SCHED;
            PG8_LDA(At, 1, 1); PG8_STAGE(PG8_SB(1, 0), b3, voffB); PG8_STAGE(PG8_SB(1, 1), b3 + hstep, voffB); PG8_STAGE(PG8_SA(1, 0), a3, voffA);
            PG8_WAIT_V(8); PG8_WAIT_L(0); PG8_BAR; PG8_MMA(1, 0, At, B0); PG8_MMA(1, 1, At, B1); PG8_BAR; PG8_SCHED;
            } else {
            PG8_LDB(B0, 0, 0); PG8_SCHED; PG8_LDA(At, 0, 0); PG8_STAGE(PG8_SA(1, 1), a1 + hstep, voffA);
            PG8_WAIT_L(8); PG8_BAR; PG8_WAIT_L(0); PG8_MMA(0, 0, At, B0); PG8_BAR; PG8_SCHED;
            PG8_LDB(B1, 0, 1); PG8_STAGE(PG8_SB(0, 0), b2, voffB);
            PG8_BAR; PG8_WAIT_L(0); PG8_MMA(0, 1, At, B1); PG8_BAR;
            PG8_LDA(At, 0, 1); PG8_STAGE(PG8_SA(0, 0), a2, voffA);
            PG8_BAR; PG8_WAIT_L(0); PG8_MMA(1, 0, At, B0); PG8_BAR; PG8_SCHED;
            PG8_STAGE(PG8_SB(0, 1), b2 + hstep, voffB);
            PG8_WAIT_V(6); PG8_BAR; PG8_MMA(1, 1, At, B1); PG8_BAR;
            PG8_LDB(B0, 1, 0); PG8_SCHED; PG8_LDA(At, 1, 0); PG8_STAGE(PG8_SA(0, 1), a2 + hstep, voffA);
            PG8_WAIT_L(8); PG8_BAR; PG8_WAIT_L(0); PG8_MMA(0, 0, At, B0); PG8_BAR; PG8_SCHED;
            PG8_LDB(B1, 1, 1); PG8_STAGE(PG8_SB(1, 0), b3, voffB);
            PG8_BAR; PG8_WAIT_L(0); PG8_MMA(0, 1, At, B1); PG8_BAR;
            PG8_LDA(At, 1, 1); PG8_STAGE(PG8_SA(1, 0), a3, voffA);
            PG8_BAR; PG8_WAIT_L(0); PG8_MMA(1, 0, At, B0); PG8_BAR; PG8_SCHED;
            PG8_STAGE(PG8_SB(1, 1), b3 + hstep, voffB);
            PG8_WAIT_V(6); PG8_BAR; PG8_MMA(1, 1, At, B1); PG8_BAR;
            }
        }
        if constexpr (ALIGN_EPI) { if (wr == 0) PG8_BAR; }
        if constexpr (!Epi::AFTER_DRAIN) { E(acc, cur, wr, wc, fr, fq); S.done(cur); }
        if (!has_next) break;
#pragma unroll
        for (int a = 0; a < 2; ++a)
#pragma unroll
            for (int b = 0; b < 2; ++b)
#pragma unroll
                for (int m = 0; m < 4; ++m)
#pragma unroll
                    for (int n = 0; n < 2; ++n) acc[a][b][m][n] = (f32x4){0.f, 0.f, 0.f, 0.f};
        cur = nxt; cA = nA; cB = nB; ++ui;
        if constexpr (ALIGN_EPI) { if (wr == 1) PG8_BAR; }
    }
    PG8_WAIT_V(0);
    if constexpr (!ALIGN_EPI) { if (wr == 0) PG8_BAR; }
    PG8_BAR;
    if constexpr (Epi::AFTER_DRAIN) { E.fused(acc, cur, wr, wc, fr, fq, lds, wid, lane); S.done(cur); }
#undef PG8_SA
#undef PG8_SB
#undef PG8_STAGE
#undef PG8_LDA
#undef PG8_LDB
#undef PG8_MMA
#undef PG8_WAIT_V
#undef PG8_WAIT_L
#undef PG8_BAR
#undef PG8_SCHED
}
}
using pg8::f32x4; using pg8::u32x4;

__device__ __forceinline__ void transpose_item(const float* W, int K, int N, bf16_t* WT, int row_off, float* scr, int item, int lane) {
    const int nblk = N / 32, kb = item / nblk, nbk = item % nblk, k0 = 64 * kb, n0 = 32 * nbk;
#pragma unroll 8
    for (int i = 0; i < 32; ++i) { const int kk = 2 * i + (lane >> 5); scr[kk * 33 + (lane & 31)] = W[(size_t)(k0 + kk) * N + n0 + (lane & 31)]; }
    asm volatile("s_waitcnt lgkmcnt(0)" ::: "memory");
    const int c = lane & 7;
#pragma unroll
    for (int j = 0; j < 4; ++j) { const int n = (lane >> 3) + 8 * j; const float* s = scr + (8 * c) * 33 + n;
        uint4 o; o.x = pk2(s[0 * 33], s[1 * 33]); o.y = pk2(s[2 * 33], s[3 * 33]); o.z = pk2(s[4 * 33], s[5 * 33]); o.w = pk2(s[6 * 33], s[7 * 33]);
        *(uint4*)(WT + (size_t)(row_off + n0 + n) * K + k0 + 8 * c) = o; }
    asm volatile("s_waitcnt lgkmcnt(0)" ::: "memory");
}
__device__ __forceinline__ void ph_prep(const Params& p, int bid, int nb, float* lds) {
    const int tid = tid_(), wave = tid >> 6, lane = tid & 63;
    {
        float* sl = lds;
        float* red = lds + 4096;
        for (int i = tid; i < 4096; i += NTH) sl[i] = siluf_(p.c[i]);
        __syncthreads();
        for (int it = bid; it < 192; it += nb) {
            const int c4 = tid & 15, kg = tid >> 4;
            const float* wp = p.w_ada + (size_t)kg * NMOD + it * 64 + c4 * 4;
            float a0[4] = {0.f, 0.f, 0.f, 0.f}, a1[4] = {0.f, 0.f, 0.f, 0.f};
#pragma unroll 8
            for (int i = 0; i < 64; ++i) {
                const int k = kg + 32 * i;
                const float4 w = *(const float4*)(wp + (size_t)(32 * i) * NMOD);
                const float s0 = sl[k], s1 = sl[2048 + k];
                a0[0] += s0 * w.x; a0[1] += s0 * w.y; a0[2] += s0 * w.z; a0[3] += s0 * w.w;
                a1[0] += s1 * w.x; a1[1] += s1 * w.y; a1[2] += s1 * w.z; a1[3] += s1 * w.w;
            }
            __syncthreads();
#pragma unroll
            for (int e = 0; e < 4; ++e) { red[(kg * 16 + c4) * 8 + e] = a0[e]; red[(kg * 16 + c4) * 8 + 4 + e] = a1[e]; }
            __syncthreads();
            if (tid < 128) {
                const int b = tid >> 6, col = tid & 63;
                float s = 0.f;
                for (int g = 0; g < 32; ++g) s += red[(g * 16 + (col >> 2)) * 8 + b * 4 + (col & 3)];
                p.ada[b * NMOD + it * 64 + col] = s + p.b_ada[it * 64 + col];
            }
        }
        __syncthreads();
    }
    for (int e = bid * NTH + tid; e < NTOK * 64; e += nb * NTH) {
        const int tok = e >> 6, j = e & 63;
        const float ang = (float)p.pos[tok] * c_freq[j];
        float s, c; sincos_acc(ang, s, c);
        p.rope[(size_t)e * 2] = c; p.rope[(size_t)e * 2 + 1] = s;
    }
    {
        float* scr = lds + wave * (64 * 33);
        const int gw = bid * 8 + wave, ngw = nb * 8;
        constexpr int I1 = 32 * 256, I2 = 32 * 128, I3 = 16 * 64, I4 = 32 * 64;
        constexpr int NIT = I1 + I2 + I3 + 3 * I4;
        for (int it = gw; it < NIT; it += ngw) {
            int r = it;
            if (r < I1) { transpose_item(p.w_in, 2048, 8192, p.Wt1, 0, scr, r, lane); continue; } r -= I1;
            if (r < I2) { transpose_item(p.w_bg, 2048, 4096, p.Wt1, 8192, scr, r, lane); continue; } r -= I2;
            if (r < I3) { transpose_item(p.w_a_out, 1024, 2048, p.Wta, 0, scr, r, lane); continue; } r -= I3;
            if (r < I4) { transpose_item(p.w_b_out, 2048, 2048, p.Wtb, 0, scr, r, lane); continue; } r -= I4;
            if (r < I4) { transpose_item(p.w_o, 2048, 2048, p.Wto, 0, scr, r, lane); continue; } r -= I4;
            transpose_item(p.peer_wq, 2048, 2048, p.Wtq, 0, scr, r, lane);
        }
    }
    __syncthreads();
}

__device__ __forceinline__ void ph_modnorm(const Params& p, const float* xin, const float* g, int sh_off, int sc_off, bf16_t* hout, int bid, int nb, float* lds) {
    const int tid = tid_(), wave = tid >> 6, lane = tid & 63;
    for (int row = bid * 8 + wave; row < NTOK; row += nb * 8) {
        const int b = row / SQ;
        const float4* xr = (const float4*)(xin + (size_t)row * DM);
        float4 v[8]; float ss = 0.f;
#pragma unroll
        for (int j = 0; j < 8; ++j) { v[j] = xr[lane + 64 * j]; ss += dot4(v[j], v[j]); }
        ss = wave_sum(ss);
        const float rs = 1.0f / sqrtf(ss * (1.0f / DM) + 1e-6f);
#pragma unroll
        for (int j = 0; j < 8; ++j) {
            const int col = (lane + 64 * j) * 4;
            const float4 g4 = *(const float4*)(g + col);
            const float4 sc = *(const float4*)(p.ada + b * NMOD + sc_off + col);
            const float4 sh = *(const float4*)(p.ada + b * NMOD + sh_off + col);
            float4 o;
            o.x = v[j].x * rs * g4.x * (1.0f + sc.x) + sh.x; o.y = v[j].y * rs * g4.y * (1.0f + sc.y) + sh.y;
            o.z = v[j].z * rs * g4.z * (1.0f + sc.z) + sh.z; o.w = v[j].w * rs * g4.w * (1.0f + sc.w) + sh.w;
            *(uint2*)(hout + (size_t)row * DM + col) = make_uint2(pk2(o.x, o.y), pk2(o.z, o.w));
        }
    }
}

__device__ __forceinline__ void ph_gmlp(const Params& p, int bid, int nb, float* lds) {
    float* vt = lds;
    float* wm = lds + 16384;
    const bf16_t* z = p.ZG;
    const int tid = tid_(), wave = tid >> 6, lane = tid & 63;
    for (int it = bid; it < 512; it += nb) {
        const int g = it & 7, n = (it >> 3) & 31, b = it >> 8;
        const int tok0 = b * SQ + n * 128;
        __syncthreads();
        for (int i = tid; i < 16384; i += NTH) { const int ii = i >> 7, jj = i & 127; wm[i] = ((ii >> 6) >= (jj >> 6)) ? p.gm_ws[g * 16384 + i] : 0.f; }
        for (int j = wave; j < 128; j += 8) {
            const bf16_t* zr = z + (size_t)(tok0 + j) * ZW + 1024 + g * 128;
            const float a = bf2f(zr[lane]), c2 = bf2f(zr[lane + 64]);
            const float ss = wave_sum(a * a + c2 * c2);
            const float rs = 1.0f / sqrtf(ss * (1.0f / 128.0f) + 1e-6f);
            vt[j * 128 + lane] = a * rs * p.gm_v_g[g * 128 + lane];
            vt[j * 128 + lane + 64] = c2 * rs * p.gm_v_g[g * 128 + lane + 64];
        }
        __syncthreads();
        const int d = tid & 127, ig = tid >> 7;
        float acc[32];
#pragma unroll
        for (int ii = 0; ii < 32; ++ii) acc[ii] = 0.f;
        for (int j = 0; j < 128; ++j) {
            const float vv = vt[j * 128 + d];
#pragma unroll
            for (int ii = 0; ii < 32; ++ii) acc[ii] += wm[(ig * 32 + ii) * 128 + j] * vv;
        }
#pragma unroll
        for (int ii = 0; ii < 32; ++ii) {
            const int i = ig * 32 + ii;
            const float s = acc[ii] + p.gm_b[g * 128 + i];
            const size_t tok = (size_t)(tok0 + i);
            const float u = bf2f(z[tok * ZW + g * 128 + d]);
            p.yain[tok * 1024 + g * 128 + d] = (bf16_t)f2bf(u * s);
        }
    }
    __syncthreads();
}

__device__ __forceinline__ void ph_ret(const Params& p, int bid, int nb, float* lds) {
    float* Qs = lds;
    float* Ks = Qs + 64 * 129;
    float* Vs = Ks + 64 * 129;
    float* Ss = Vs + 64 * 16;
    float* At = Ss + 128 * 16;
    float* kd = At + 64 * 65;
    const int tid = tid_();
    const bf16_t* z = p.ZG;
    for (int it = bid; it < 256; it += nb) {
        const int vs = it & 15, h = (it >> 4) & 7, b = it >> 7;
        const float lg = log1pf(-exp2f(-5.0f - (float)h));
        const float cdec = expf(lg * 64.0f);
        __syncthreads();
        for (int i = tid; i < 2048; i += NTH) Ss[i] = 0.f;
        if (tid < 64) kd[tid] = expf(lg * (float)(63 - tid));
        for (int n = 0; n < 64; ++n) {
            const int tok0 = b * SQ + n * 64;
            __syncthreads();
            for (int e = tid; e < 4096; e += NTH) {
                const int i = e >> 6, dd = e & 63; const size_t tok = (size_t)(tok0 + i);
                const float cs = p.rope[(tok * 64 + dd) * 2], sn = p.rope[(tok * 64 + dd) * 2 + 1];
                const bf16_t* zr = z + tok * ZW;
                const float q1 = bf2f(zr[2048 + h * 128 + dd]), q2 = bf2f(zr[2048 + h * 128 + 64 + dd]);
                const float k1 = bf2f(zr[3072 + h * 128 + dd]), k2 = bf2f(zr[3072 + h * 128 + 64 + dd]);
                Qs[i * 129 + dd] = q1 * cs - q2 * sn; Qs[i * 129 + 64 + dd] = q1 * sn + q2 * cs;
                const float sc = 0.08838834764831845f;
                Ks[i * 129 + dd] = (k1 * cs - k2 * sn) * sc; Ks[i * 129 + 64 + dd] = (k1 * sn + k2 * cs) * sc;
            }
            for (int e = tid; e < 1024; e += NTH) { const int j = e >> 4, v = e & 15; Vs[e] = bf2f(z[(size_t)(tok0 + j) * ZW + 4096 + h * 256 + vs * 16 + v]); }
            __syncthreads();
            {
                const int j = tid & 63, i0 = (tid >> 6) * 8;
                float acc[8];
#pragma unroll
                for (int ii = 0; ii < 8; ++ii) acc[ii] = 0.f;
                for (int d = 0; d < 128; ++d) {
                    const float kv = Ks[j * 129 + d];
#pragma unroll
                    for (int ii = 0; ii < 8; ++ii) acc[ii] += Qs[(i0 + ii) * 129 + d] * kv;
                }
#pragma unroll
                for (int ii = 0; ii < 8; ++ii) { const int i = i0 + ii; At[i * 65 + j] = acc[ii] * expf(lg * fabsf((float)(i - j))); }
            }
            __syncthreads();
            {
                const int v = tid & 15, i0 = tid >> 4;
#pragma unroll
                for (int rep = 0; rep < 2; ++rep) {
                    const int i = i0 + 32 * rep;
                    float a = 0.f; for (int j = 0; j < 64; ++j) a += At[i * 65 + j] * Vs[j * 16 + v];
                    float c2 = 0.f; for (int d = 0; d < 128; ++d) c2 += Qs[i * 129 + d] * Ss[d * 16 + v];
                    p.obuf[(size_t)(tok0 + i) * DM + h * 256 + vs * 16 + v] = a + c2 * expf(lg * (float)(i + 1));
                }
            }
            __syncthreads();
            {
                const int v = tid & 15, d0 = tid >> 4;
#pragma unroll
                for (int rep = 0; rep < 4; ++rep) {
                    const int d = d0 + 32 * rep;
                    float a = 0.f; for (int j = 0; j < 64; ++j) a += Ks[j * 129 + d] * kd[j] * Vs[j * 16 + v];
                    Ss[d * 16 + v] = Ss[d * 16 + v] * cdec + a;
                }
            }
        }
    }
    __syncthreads();
}

__device__ __forceinline__ void ph_gn(const Params& p, int bid, int nb, float* lds) {
    const int tid = tid_(), wave = tid >> 6, lane = tid & 63;
    for (int tok = bid * 8 + wave; tok < NTOK; tok += nb * 8) {
#pragma unroll
        for (int h = 0; h < 8; ++h) {
            const float4 o = *(const float4*)(p.obuf + (size_t)tok * DM + h * 256 + lane * 4);
            const float mu = wave_sum(o.x + o.y + o.z + o.w) * (1.0f / 256.0f);
            const float4 d = make_float4(o.x - mu, o.y - mu, o.z - mu, o.w - mu);
            const float var = wave_sum(dot4(d, d)) * (1.0f / 256.0f);
            const float rs = 1.0f / sqrtf(var + 1e-6f);
            const float4 gn = *(const float4*)(p.ret_gn_g + h * 256 + lane * 4);
            const uint2 gw = *(const uint2*)(p.ZG + (size_t)tok * ZW + 6144 + h * 256 + lane * 4);
            const float g0 = bflo(gw.x), g1 = bfhi(gw.x), g2 = bflo(gw.y), g3 = bfhi(gw.y);
            *(uint2*)(p.ybin + (size_t)tok * DM + h * 256 + lane * 4) =
                make_uint2(pk2(siluf_(g0) * d.x * rs * gn.x, siluf_(g1) * d.y * rs * gn.y), pk2(siluf_(g2) * d.z * rs * gn.z, siluf_(g3) * d.w * rs * gn.w));
        }
    }
}

template <int NL>
__device__ __forceinline__ void wave_top16(float (&v)[NL], const int (&idx)[NL], float& outv, int& outi, int lane) {
    outv = 0.f; outi = 0;
    for (int r = 0; r < 16; ++r) {
        float m = v[0];
#pragma unroll
        for (int u = 1; u < NL; ++u) m = fmaxf(m, v[u]);
        const float wm = wave_max(m);
        const unsigned long long bal = __ballot(m == wm);
        const int owner = __ffsll((long long)bal) - 1;
        int myi = -1;
        if (lane == owner) {
            bool done = false;
#pragma unroll
            for (int u = 0; u < NL; ++u) if (!done && v[u] == wm) { myi = idx[u]; v[u] = -INFINITY; done = true; }
        }
        const int wi = __shfl(myi, owner);
        if (lane == r) { outv = wm; outi = wi; }
    }
}
__device__ __forceinline__ void ph_topk(const Params& p, const float* qb, int bid, int nb, float* lds) {
    const int tid = tid_(), wave = tid >> 6, lane = tid & 63;
    for (int t = bid; t < NTOK; t += nb) {
        const int h = wave;
        const float* q = qb + (size_t)t * DM + h * 256;
        float s[2][2];
#pragma unroll
        for (int pp = 0; pp < 2; ++pp)
#pragma unroll
            for (int r = 0; r < 2; ++r) {
                const int n = lane + 64 * r;
                const float4* kr = (const float4*)(p.peer_sk + ((size_t)(h * 2 + pp) * 128 + n) * 128);
                const float4* qr = (const float4*)(q + pp * 128);
                float a = 0.f;
#pragma unroll 4
                for (int d4 = 0; d4 < 32; ++d4) a += dot4(kr[d4], qr[d4]);
                s[pp][r] = a;
            }
        float v1, v2; int i1, i2;
        { float vv[2] = {s[0][0], s[0][1]}; const int ii[2] = {lane, lane + 64}; wave_top16<2>(vv, ii, v1, i1, lane); }
        { float vv[2] = {s[1][0], s[1][1]}; const int ii[2] = {lane, lane + 64}; wave_top16<2>(vv, ii, v2, i2, lane); }
        float cv[4]; int ci[4];
        const int a = lane >> 2, b0 = (lane & 3) * 4;
        const float va = __shfl(v1, a); const int ia = __shfl(i1, a);
#pragma unroll
        for (int u = 0; u < 4; ++u) { const float vb = __shfl(v2, b0 + u); const int ib = __shfl(i2, b0 + u); cv[u] = va + vb; ci[u] = ia * 128 + ib; }
        float tv; int te;
        wave_top16<4>(cv, ci, tv, te, lane);
        const float mx = __shfl(tv, 0);
        const float ex = (lane < 16) ? expf(tv - mx) : 0.f;
        const float sum = wave_sum(ex);
        if (lane < 16) { p.eidx[(size_t)t * 128 + h * 16 + lane] = te; p.gatev[(size_t)t * 128 + h * 16 + lane] = ex / sum; }
    }
}

__device__ __forceinline__ void ph_peer(const Params& p, const float* x1, const bf16_t* h2, int bid, int nb, float* lds) {
    float* ys = lds;
    float* red = lds + 8 * 2048;
    const int tid = tid_(), wave = tid >> 6, lane = tid & 63;
    for (int t = bid; t < NTOK; t += nb) {
        const int b = t / SQ, h = wave;
        const uint2* hr = (const uint2*)(h2 + (size_t)t * DM);
        float4 hv[8], y[8];
#pragma unroll
        for (int j = 0; j < 8; ++j) { const uint2 w = hr[lane + 64 * j]; hv[j] = make_float4(bflo(w.x), bfhi(w.x), bflo(w.y), bfhi(w.y)); y[j] = make_float4(0.f, 0.f, 0.f, 0.f); }
        for (int k = 0; k < 16; ++k) {
            const int e = p.eidx[(size_t)t * 128 + h * 16 + k]; const float gt = p.gatev[(size_t)t * 128 + h * 16 + k];
            const float4* ur = (const float4*)(p.peer_u + (size_t)e * DM);
            float a = 0.f;
#pragma unroll
            for (int j = 0; j < 8; ++j) a += dot4(ur[lane + 64 * j], hv[j]);
            a = wave_sum(a);
            const float w = geluf_(a) * gt;
            const float4* vr = (const float4*)(p.peer_v + (size_t)e * DM);
#pragma unroll
            for (int j = 0; j < 8; ++j) { const float4 v4 = vr[lane + 64 * j]; y[j].x += w * v4.x; y[j].y += w * v4.y; y[j].z += w * v4.z; y[j].w += w * v4.w; }
        }
        __syncthreads();
#pragma unroll
        for (int j = 0; j < 8; ++j) *(float4*)(ys + h * 2048 + (lane + 64 * j) * 4) = y[j];
        __syncthreads();
        const int c = tid * 4;
        float4 s = make_float4(0.f, 0.f, 0.f, 0.f);
#pragma unroll
        for (int hh = 0; hh < 8; ++hh) { const float4 a = *(const float4*)(ys + hh * 2048 + c); s.x += a.x; s.y += a.y; s.z += a.z; s.w += a.w; }
        const float4 xv = *(const float4*)(x1 + (size_t)t * DM + c);
        const float4 ga = *(const float4*)(p.ada + b * NMOD + 5 * DM + c);
        const float4 x2 = make_float4(xv.x + ga.x * s.x, xv.y + ga.y * s.y, xv.z + ga.z * s.z, xv.w + ga.w * s.w);
        const float ss = wave_sum(dot4(x2, x2));
        if (lane == 0) red[wave] = ss;
        __syncthreads();
        float tot = 0.f;
#pragma unroll
        for (int w = 0; w < 8; ++w) tot += red[w];
        const float rs = 1.0f / sqrtf(tot * (1.0f / DM) + 1e-6f);
        const float4 gf = *(const float4*)(p.norm_f_g + c);
        *(float4*)(p.out + (size_t)t * DM + c) = make_float4(x2.x * rs * gf.x, x2.y * rs * gf.y, x2.z * rs * gf.z, x2.w * rs * gf.w);
    }
    __syncthreads();
}

template <class Epi>
__device__ __forceinline__ void gemm_run(float* lds, const bf16_t* A, const bf16_t* Bt, int M, int N, int K, const Epi& E) {
    __syncthreads();
    pg8::Gemm g{A, Bt, M, N, K}; pg8::StaticOrder S; S.init(M, N, (int)gridDim.x, (int)blockIdx.x);
    pg8::gemm_phase<Epi, pg8::StaticOrder, true, true>((PG8_LAS unsigned char*)lds, g, S, E);
    __syncthreads();
}
constexpr int NPHASE = 11;
template <int PH>
__device__ __forceinline__ void run_phase(const Params& p, int bid, int nb, float* lds) {
    asm volatile("" : "+s"(bid));
    if constexpr (PH == 0) ph_prep(p, bid, nb, lds);
    if constexpr (PH == 1) ph_modnorm(p, p.x, p.norm1_g, 0 * DM, 1 * DM, p.hb, bid, nb, lds);
    if constexpr (PH == 2) gemm_run(lds, p.hb, p.Wt1, NTOK, ZW, DM, pg8::EpiZG{p.ZG, p.b_bg});
    if constexpr (PH == 3) { ph_ret(p, bid, nb, lds); ph_gmlp(p, bid, nb, lds); }
    if constexpr (PH == 4) ph_gn(p, bid, nb, lds);
    if constexpr (PH == 5) {
        gemm_run(lds, p.yain, p.Wta, NTOK, DM, 1024, pg8::EpiMixB<0>{p.hb, p.ZG, 0});
        gemm_run(lds, p.ybin, p.Wtb, NTOK, DM, DM, pg8::EpiMixB<1>{p.hb, p.ZG, 2048});
    }
    if constexpr (PH == 6) gemm_run(lds, p.hb, p.Wto, NTOK, DM, DM, pg8::EpiResF{p.obuf, p.x, p.ada + 2 * DM});
    if constexpr (PH == 7) ph_modnorm(p, p.obuf, p.norm2_g, 3 * DM, 4 * DM, p.hb, bid, nb, lds);
    if constexpr (PH == 8) gemm_run(lds, p.hb, p.Wtq, NTOK, DM, DM, pg8::EpiF32{p.qbuf, DM});
    if constexpr (PH == 9) ph_topk(p, p.qbuf, bid, nb, lds);
    if constexpr (PH == 10) ph_peer(p, p.obuf, p.hb, bid, nb, lds);
}

__global__ void __launch_bounds__(NTH) k_mega(Params p) {
    extern __shared__ __attribute__((aligned(16))) float lds[];
    cg::grid_group grid = cg::this_grid();
    const int bid = blockIdx.x, nb = gridDim.x;
    run_phase<0>(p, bid, nb, lds); grid.sync();
    run_phase<1>(p, bid, nb, lds); grid.sync();
    run_phase<2>(p, bid, nb, lds); grid.sync();
    run_phase<3>(p, bid, nb, lds); grid.sync();
    run_phase<4>(p, bid, nb, lds); grid.sync();
    run_phase<5>(p, bid, nb, lds); grid.sync();
    run_phase<6>(p, bid, nb, lds); grid.sync();
    run_phase<7>(p, bid, nb, lds); grid.sync();
    run_phase<8>(p, bid, nb, lds); grid.sync();
    run_phase<9>(p, bid, nb, lds); grid.sync();
    run_phase<10>(p, bid, nb, lds);
}

extern "C" void kernel_launch(void* const* d_in, const int* in_sizes, int n_in, void* d_out, int out_size, void* d_ws, size_t ws_size, hipStream_t stream) {
    Params p{};
    p.x = (const float*)d_in[0]; p.c = (const float*)d_in[1]; p.pos = (const int*)d_in[2];
    p.w_ada = (const float*)d_in[3]; p.b_ada = (const float*)d_in[4]; p.norm1_g = (const float*)d_in[5]; p.w_in = (const float*)d_in[6];
    p.w_bg = (const float*)d_in[7]; p.b_bg = (const float*)d_in[8]; p.gm_v_g = (const float*)d_in[9]; p.gm_ws = (const float*)d_in[10];
    p.gm_b = (const float*)d_in[11]; p.ret_gn_g = (const float*)d_in[12]; p.w_a_out = (const float*)d_in[13]; p.w_b_out = (const float*)d_in[14];
    p.w_o = (const float*)d_in[15]; p.norm2_g = (const float*)d_in[16]; p.peer_wq = (const float*)d_in[17]; p.peer_sk = (const float*)d_in[18];
    p.peer_u = (const float*)d_in[19]; p.peer_v = (const float*)d_in[20]; p.norm_f_g = (const float*)d_in[21];
    p.out = (float*)d_out;
    char* w = (char*)d_ws; size_t off = 0;
    auto take = [&](size_t bytes) { char* r = w + off; off += (bytes + 255) & ~(size_t)255; return r; };
    p.ada = (float*)take(2 * NMOD * 4);
    p.rope = (float*)take((size_t)NTOK * 128 * 4);
    p.eidx = (int*)take((size_t)NTOK * 128 * 4);
    p.gatev = (float*)take((size_t)NTOK * 128 * 4);
    p.Wt1 = (bf16_t*)take((size_t)ZW * DM * 2);
    p.Wta = (bf16_t*)take((size_t)DM * 1024 * 2);
    p.Wtb = (bf16_t*)take((size_t)DM * DM * 2);
    p.Wto = (bf16_t*)take((size_t)DM * DM * 2);
    p.Wtq = (bf16_t*)take((size_t)DM * DM * 2);
    p.hb = (bf16_t*)take((size_t)NTOK * DM * 2);
    p.ZG = (bf16_t*)take((size_t)NTOK * ZW * 2);
    p.qbuf = (float*)p.ZG;
    p.obuf = (float*)take((size_t)NTOK * DM * 4);
    p.ybin = (bf16_t*)take((size_t)NTOK * DM * 2);
    p.yain = (bf16_t*)take((size_t)NTOK * 1024 * 2);
    if (off > ws_size) { fprintf(stderr, "kernel_launch: workspace too small: need %zu have %zu\n", off, ws_size); return; }
    static int grid = 0;
    if (!grid) {
        int dev = 0, cus = 0, per_cu = 0;
        (void)hipGetDevice(&dev); (void)hipDeviceGetAttribute(&cus, hipDeviceAttributeMultiprocessorCount, dev);
        (void)hipFuncSetAttribute((const void*)k_mega, hipFuncAttributeMaxDynamicSharedMemorySize, LDS_BYTES);
        (void)hipOccupancyMaxActiveBlocksPerMultiprocessor(&per_cu, k_mega, NTH, LDS_BYTES);
        if (per_cu < 1) per_cu = 1;
        grid = cus * per_cu;
    }
    void* args[] = {&p};
    hipError_t e = hipLaunchCooperativeKernel((const void*)k_mega, dim3(grid), dim3(NTH), args, LDS_BYTES, stream);
    if (e != hipSuccess) fprintf(stderr, "cooperative launch failed: %s (grid %d)\n", hipGetErrorString(e), grid);
}
```

```cpp
#include <hip/hip_runtime.h>
#include <hip/hip_cooperative_groups.h>
#include <stdint.h>
#include <math.h>
#include <cstdio>

namespace cg = cooperative_groups;

constexpr int DM = 2048;
constexpr int SQ = 4096;
constexpr int NTOK = 8192;
constexpr int NTH = 512;
constexpr int ZW = 12288;
constexpr int NMOD = 12288;
constexpr int LDS_BYTES = 136 * 1024;

typedef unsigned short bf16_t;

struct Params {
    const float *x, *c; const int* pos;
    const float *w_ada, *b_ada, *norm1_g, *w_in, *w_bg, *b_bg, *gm_v_g, *gm_ws, *gm_b, *ret_gn_g, *w_a_out, *w_b_out, *w_o, *norm2_g,
                *peer_wq, *peer_sk, *peer_u, *peer_v, *norm_f_g;
    float* out;
    float *ada, *rope, *gatev; int* eidx;
    bf16_t *Wt1, *Wta, *Wtb, *Wto, *Wtq;
    bf16_t *hb;
    bf16_t *ZG;
    float *obuf;
    bf16_t *ybin, *yain;
    float *qbuf;
    bf16_t *Ub, *Vb;
};

__constant__ float c_freq[64] = {
1.000000000e+00f, 8.659643531e-01f, 7.498942018e-01f, 6.493816376e-01f, 5.623413324e-01f, 4.869675338e-01f, 4.216965139e-01f, 3.651741147e-01f, 3.162277639e-01f, 2.738419771e-01f, 2.371373773e-01f, 2.053525001e-01f, 1.778279394e-01f, 1.539926529e-01f, 1.333521456e-01f, 1.154781953e-01f, 1.000000015e-01f, 8.659642935e-02f, 7.498942316e-02f, 6.493816525e-02f, 5.623413250e-02f, 4.869675264e-02f, 4.216964915e-02f, 3.651741147e-02f, 3.162277490e-02f, 2.738419548e-02f, 2.371373773e-02f, 2.053525113e-02f, 1.778279431e-02f, 1.539926510e-02f, 1.333521400e-02f, 1.154781971e-02f, 9.999999776e-03f, 8.659643121e-03f, 7.498942316e-03f, 6.493816152e-03f, 5.623413250e-03f, 4.869675264e-03f, 4.216964822e-03f, 3.651741194e-03f, 3.162277630e-03f, 2.738419687e-03f, 2.371373819e-03f, 2.053525066e-03f, 1.778279431e-03f, 1.539926510e-03f, 1.333521446e-03f, 1.154782018e-03f, 1.000000047e-03f, 8.659643354e-04f, 7.498941850e-04f, 6.493816036e-04f, 5.623413017e-04f, 4.869675322e-04f, 4.216965172e-04f, 3.651741135e-04f, 3.162277571e-04f, 2.738419571e-04f, 2.371373703e-04f, 2.053525095e-04f, 1.778279402e-04f, 1.539926598e-04f, 1.333521504e-04f, 1.154782003e-04f };

__device__ __forceinline__ int tid_() { int t = threadIdx.x; asm volatile("" : "+v"(t)); return t; }
__device__ __forceinline__ float wave_sum(float v) {
#pragma unroll
    for (int o = 1; o < 64; o <<= 1) v += __shfl_xor(v, o);
    return v;
}
__device__ __forceinline__ float wave_max(float v) {
#pragma unroll
    for (int o = 1; o < 64; o <<= 1) v = fmaxf(v, __shfl_xor(v, o));
    return v;
}
__device__ __forceinline__ float sigmoidf_(float x) { return 1.0f / (1.0f + expf(-x)); }
__device__ __forceinline__ float siluf_(float x) { return x * sigmoidf_(x); }
__device__ __forceinline__ float geluf_(float x) { return 0.5f * x * (1.0f + erff(x * 0.70710678118654752f)); }
__device__ __forceinline__ float dot4(float4 a, float4 b) { return a.x * b.x + a.y * b.y + a.z * b.z + a.w * b.w; }
__device__ __forceinline__ float bf2f(bf16_t v) { return __uint_as_float((unsigned)v << 16); }
__device__ __forceinline__ float bflo(unsigned w) { return __uint_as_float(w << 16); }
__device__ __forceinline__ float bfhi(unsigned w) { return __uint_as_float(w & 0xffff0000u); }
__device__ __forceinline__ unsigned f2bf(float f) { unsigned u = __float_as_uint(f); return (u + 0x7fffu + ((u >> 16) & 1u)) >> 16; }
__device__ __forceinline__ unsigned pk2(float lo, float hi) { return f2bf(lo) | (f2bf(hi) << 16); }

__device__ __forceinline__ void sincos_acc(float ang, float& s, float& c) {
    const double x = (double)ang;
    const double k = rint(x * 0.63661977236758134308);
    double r = fma(-k, 1.57079632679489655800, x); r = fma(-k, 6.12323399573676603587e-17, r);
    const double r2 = r * r;
    const double sp = r * (1.0 + r2 * (-1.0 / 6.0 + r2 * (1.0 / 120.0 + r2 * (-1.0 / 5040.0 + r2 * (1.0 / 362880.0 + r2 * (-1.0 / 39916800.0 + r2 * (1.0 / 6227020800.0)))))));
    const double cp = 1.0 + r2 * (-0.5 + r2 * (1.0 / 24.0 + r2 * (-1.0 / 720.0 + r2 * (1.0 / 40320.0 + r2 * (-1.0 / 3628800.0 + r2 * (1.0 / 479001600.0 + r2 * (-1.0 / 87178291200.0)))))));
    const int q = ((int)k) & 3;
    const float fs = (float)sp, fc = (float)cp;
    s = (q == 0) ? fs : (q == 1) ? fc : (q == 2) ? -fs : -fc;
    c = (q == 0) ? fc : (q == 1) ? -fs : (q == 2) ? -fc : fs;
}

namespace pg8 {
#define PG8_LAS __attribute__((address_space(3)))
typedef unsigned short bf16_t;
typedef short bf16x8 __attribute__((ext_vector_type(8)));
typedef float f32x4 __attribute__((ext_vector_type(4)));
typedef unsigned u32x4 __attribute__((ext_vector_type(4)));
constexpr int BM = 256, BK = 64, HALF = 128, HTB = HALF * BK * 2  , STAGE_BYTES = 8 * HTB, NXCD = 8, WGM = 8;

__host__ __device__ __forceinline__ int lds_byte(int r, int c) { const int st = (r >> 4) * 2 + (c >> 5), rr = r & 15, cc = c & 31, ob = rr * 64 + cc * 2; return st * 1024 + (ob ^ (((ob >> 9) & 1) << 5)); }
__host__ __device__ __forceinline__ void stage_rc(int b, int& R, int& C) { const int st = b / 1024, sb = b % 1024, swz = sb ^ (((sb >> 9) & 1) << 5); R = (st >> 1) * 16 + swz / 64; C = (st & 1) * 32 + (swz % 64) / 2; }
__host__ __device__ __forceinline__ int perm32(int rho) { const int n = rho >> 4, i = rho & 15; return 8 * (i >> 2) + 4 * n + (i & 3); }

struct Unit { int pm, pn; };
struct Gemm { const bf16_t* A; const bf16_t* Bt; int M, N, K; };

struct StaticOrder {
    int nM, nN, nwg, G, c;
    __host__ __device__ void init(int M, int N, int G_, int c_) { nM = M / BM; nN = N / BM; nwg = nM * nN; G = G_; c = c_; }
    __host__ __device__ bool next(int i, Unit& u) const {
        const long L = (long)i * G + c; if (L >= nwg) return false;
        int wgid = (int)L; { const int q = nwg / NXCD, r = nwg % NXCD, xcd = wgid % NXCD, off = wgid / NXCD; wgid = (xcd < r ? xcd * (q + 1) : r * (q + 1) + (xcd - r) * q) + off; }
        const int nig = WGM * nN, gid = wgid / nig, fm = gid * WGM, gsz = (nM - fm) < WGM ? (nM - fm) : WGM;
        u.pm = fm + ((wgid % nig) % gsz); u.pn = (wgid % nig) / gsz; return true;
    }
    __device__ __forceinline__ void a_ready(const Unit&) const {}
    __device__ __forceinline__ void done(const Unit&) const {}
};

__device__ __forceinline__ unsigned cvt_pk_bf16(float lo, float hi) { unsigned r; asm volatile("v_cvt_pk_bf16_f32 %0, %1, %2" : "=v"(r) : "v"(lo), "v"(hi)); return r; }
typedef float f32x2 __attribute__((ext_vector_type(2)));
__device__ __forceinline__ f32x2 gelu_pk(f32x2 v) {
    const f32x2 av = __builtin_elementwise_abs(v), d = av * 0.2316418882f + 1.0f;
    f32x2 t; t.x = __builtin_amdgcn_rcpf(d.x); t.y = __builtin_amdgcn_rcpf(d.y);
    f32x2 q = t * 0.5307027145f + (-0.7265760135f); q = q * t + 0.7107068705f; q = q * t + (-0.142248368f); q = q * t + 0.127414796f; q = q * t;
    const f32x2 s = (v * v) * (-0.72134752044f);
    f32x2 e; e.x = __builtin_amdgcn_exp2f(s.x); e.y = __builtin_amdgcn_exp2f(s.y);
    const f32x2 m = v * (q * e), r = v - m;
    f32x2 o; o.x = v.x < 0.f ? m.x : r.x; o.y = v.y < 0.f ? m.y : r.y; return o;
}

typedef unsigned u32x2v __attribute__((ext_vector_type(2)));
struct EpiZG {
    static constexpr bool PERM = true, AFTER_DRAIN = false;
    bf16_t* O; const float* bias;
    __device__ __forceinline__ void operator()(const f32x4 (&acc)[2][2][4][2], const Unit& u, int wr, int wc, int fr, int fq) const {
        const int row0 = u.pm * BM + wr * 64 + fr, col0 = u.pn * BM + wc * 32 + 8 * fq;
        const int mode = u.pn < 8 ? 1 : (u.pn < 32 ? 0 : 2);
        f32x4 bv[2][2];
#pragma unroll
        for (int bj = 0; bj < 2; ++bj)
#pragma unroll
            for (int n = 0; n < 2; ++n) bv[bj][n] = (mode == 2) ? *(const f32x4*)(bias + (col0 - 8192) + bj * HALF + 4 * n) : (f32x4){0.f, 0.f, 0.f, 0.f};
#pragma unroll
        for (int ai = 0; ai < 2; ++ai)
#pragma unroll
            for (int m = 0; m < 4; ++m) { bf16_t* rowp = O + (size_t)(row0 + ai * HALF + m * 16) * ZW + col0;
#pragma unroll
                for (int bj = 0; bj < 2; ++bj) { f32x4 v0 = acc[ai][bj][m][0], v1 = acc[ai][bj][m][1];
                    if (mode == 1) { f32x2 a = gelu_pk((f32x2){v0[0], v0[1]}), b = gelu_pk((f32x2){v0[2], v0[3]}), c = gelu_pk((f32x2){v1[0], v1[1]}), d = gelu_pk((f32x2){v1[2], v1[3]});
                        v0 = (f32x4){a.x, a.y, b.x, b.y}; v1 = (f32x4){c.x, c.y, d.x, d.y}; }
                    if (mode == 2) { v0 = v0 + bv[bj][0]; v1 = v1 + bv[bj][1];
#pragma unroll
                        for (int e = 0; e < 4; ++e) { v0[e] = __builtin_amdgcn_rcpf(1.0f + __expf(-v0[e])); v1[e] = __builtin_amdgcn_rcpf(1.0f + __expf(-v1[e])); } }
                    u32x4 w; w.x = cvt_pk_bf16(v0[0], v0[1]); w.y = cvt_pk_bf16(v0[2], v0[3]); w.z = cvt_pk_bf16(v1[0], v1[1]); w.w = cvt_pk_bf16(v1[2], v1[3]);
                    *(u32x4*)(rowp + bj * HALF) = w; } }
    }
};
template <int ACCUM> struct EpiMixB {
    static constexpr bool PERM = true, AFTER_DRAIN = false;
    bf16_t* Mo; const bf16_t* ZGp; int goff;
    __device__ __forceinline__ void operator()(const f32x4 (&acc)[2][2][4][2], const Unit& u, int wr, int wc, int fr, int fq) const {
        const int row0 = u.pm * BM + wr * 64 + fr, col0 = u.pn * BM + wc * 32 + 8 * fq;
#pragma unroll
        for (int ai = 0; ai < 2; ++ai)
#pragma unroll
            for (int m = 0; m < 4; ++m) { const size_t row = (size_t)(row0 + ai * HALF + m * 16);
#pragma unroll
                for (int bj = 0; bj < 2; ++bj) { const f32x4 v0 = acc[ai][bj][m][0], v1 = acc[ai][bj][m][1];
                    const u32x4 g = *(const u32x4*)(ZGp + row * ZW + 8192 + goff + col0 + bj * HALF);
                    float o[8];
                    o[0] = bflo(g.x) * v0[0]; o[1] = bfhi(g.x) * v0[1]; o[2] = bflo(g.y) * v0[2]; o[3] = bfhi(g.y) * v0[3];
                    o[4] = bflo(g.z) * v1[0]; o[5] = bfhi(g.z) * v1[1]; o[6] = bflo(g.w) * v1[2]; o[7] = bfhi(g.w) * v1[3];
                    bf16_t* mp = Mo + row * DM + col0 + bj * HALF;
                    if (ACCUM) { const u32x4 old = *(const u32x4*)mp;
                        o[0] += bflo(old.x); o[1] += bfhi(old.x); o[2] += bflo(old.y); o[3] += bfhi(old.y); o[4] += bflo(old.z); o[5] += bfhi(old.z); o[6] += bflo(old.w); o[7] += bfhi(old.w); }
                    u32x4 w; w.x = cvt_pk_bf16(o[0], o[1]); w.y = cvt_pk_bf16(o[2], o[3]); w.z = cvt_pk_bf16(o[4], o[5]); w.w = cvt_pk_bf16(o[6], o[7]);
                    *(u32x4*)mp = w; } }
    }
};
struct EpiResF {
    static constexpr bool PERM = false, AFTER_DRAIN = false;
    float* x1; const float* x; const float* ga;
    __device__ __forceinline__ void operator()(const f32x4 (&acc)[2][2][4][2], const Unit& u, int wr, int wc, int fr, int fq) const {
        const int row0 = u.pm * BM + wr * 64 + fr, col0 = u.pn * BM + wc * 32 + 4 * fq;
        const int b = (u.pm * BM) / SQ;
        f32x4 gv[2][2];
#pragma unroll
        for (int bj = 0; bj < 2; ++bj)
#pragma unroll
            for (int n = 0; n < 2; ++n) gv[bj][n] = *(const f32x4*)(ga + b * NMOD + col0 + bj * HALF + n * 16);
#pragma unroll
        for (int ai = 0; ai < 2; ++ai)
#pragma unroll
            for (int m = 0; m < 4; ++m) { const size_t off = (size_t)(row0 + ai * HALF + m * 16) * DM + col0;
#pragma unroll
                for (int bj = 0; bj < 2; ++bj)
#pragma unroll
                    for (int n = 0; n < 2; ++n) { const f32x4 xv = *(const f32x4*)(x + off + bj * HALF + n * 16);
                        *(f32x4*)(x1 + off + bj * HALF + n * 16) = xv + gv[bj][n] * acc[ai][bj][m][n]; } }
    }
};
struct EpiF32 {
    static constexpr bool PERM = false, AFTER_DRAIN = false;
    float* O; int ldc;
    __device__ __forceinline__ void operator()(const f32x4 (&acc)[2][2][4][2], const Unit& u, int wr, int wc, int fr, int fq) const {
        const int row0 = u.pm * BM + wr * 64 + fr, col0 = u.pn * BM + wc * 32 + 4 * fq;
#pragma unroll
        for (int ai = 0; ai < 2; ++ai)
#pragma unroll
            for (int m = 0; m < 4; ++m) { const size_t off = (size_t)(row0 + ai * HALF + m * 16) * ldc + col0;
#pragma unroll
                for (int bj = 0; bj < 2; ++bj)
#pragma unroll
                    for (int n = 0; n < 2; ++n) *(f32x4*)(O + off + bj * HALF + n * 16) = acc[ai][bj][m][n]; }
    }
};

template <class Epi, class Sched, bool ALIGN_EPI = false, bool SP2 = false>
__device__ __forceinline__ void gemm_phase(PG8_LAS unsigned char* lds, const Gemm g, const Sched& S, const Epi& E) {
    const int tid = threadIdx.x, wid = __builtin_amdgcn_readfirstlane(tid >> 6), lane = tid & 63, wr = wid >> 2, wc = wid & 3, fr = lane & 15, fq = lane >> 4;
    const int K = g.K, nt = K / BK;
    unsigned voffA[2], voffB[2];
#pragma unroll
    for (int i = 0; i < 2; ++i) { int R, C; stage_rc(tid * 16 + i * 8192, R, C); const int Rb = Epi::PERM ? ((R & ~31) + perm32(R & 31)) : R;
        voffA[i] = (unsigned)(R * K + C) * 2u; voffB[i] = (unsigned)(Rb * K + C) * 2u; }
    const size_t kstep = (size_t)(BK * 2);
    const size_t hstep = (size_t)HALF * K * 2;
    const size_t tstep = 2 * hstep;
    const unsigned ldsw = (unsigned)wid * 1024u;
    const int aoff = lds_byte(wr * 64 + fr, fq * 8), boff = lds_byte(wc * 32 + fr, fq * 8);
#define PG8_SA(b, h) (((b) * 2 + (h)) * HTB)
#define PG8_SB(b, h) ((4 + (b) * 2 + (h)) * HTB)
#define PG8_STAGE(bufoff, gbase, voff) do { _Pragma("unroll") for (int _i = 0; _i < 2; ++_i) \
        __builtin_amdgcn_global_load_lds((const unsigned*)((const char*)(gbase) + (voff)[_i]), (PG8_LAS unsigned*)(lds + (bufoff) + ldsw + _i * 8192), 16, 0, 0); } while (0)
#define PG8_LDA(dst, b, h) do { _Pragma("unroll") for (int m = 0; m < 4; ++m) _Pragma("unroll") for (int k = 0; k < 2; ++k) dst[m][k] = *(const PG8_LAS bf16x8*)(lds + PG8_SA(b, h) + aoff + m * 2048 + k * 1024); } while (0)
#define PG8_LDB(dst, b, h) do { _Pragma("unroll") for (int n = 0; n < 2; ++n) _Pragma("unroll") for (int k = 0; k < 2; ++k) dst[n][k] = *(const PG8_LAS bf16x8*)(lds + PG8_SB(b, h) + boff + n * 2048 + k * 1024); } while (0)
#define PG8_MMA(ai, bj, At, Bt) do { __builtin_amdgcn_s_setprio(1); _Pragma("unroll") for (int m = 0; m < 4; ++m) _Pragma("unroll") for (int n = 0; n < 2; ++n) _Pragma("unroll") for (int k = 0; k < 2; ++k) \
        acc[ai][bj][m][n] = __builtin_amdgcn_mfma_f32_16x16x32_bf16(Bt[n][k], At[m][k], acc[ai][bj][m][n], 0, 0, 0); __builtin_amdgcn_s_setprio(0); } while (0)
#define PG8_WAIT_V(n) asm volatile("s_waitcnt vmcnt(" #n ")" ::: "memory")
#define PG8_WAIT_L(n) asm volatile("s_waitcnt lgkmcnt(" #n ")" ::: "memory")
#define PG8_BAR __builtin_amdgcn_s_barrier()
#define PG8_SCHED __builtin_amdgcn_sched_barrier(0)
    Unit cur, nxt; int ui = 0;
    if (!S.next(0, cur)) return;
    f32x4 acc[2][2][4][2];
#pragma unroll
    for (int a = 0; a < 2; ++a)
#pragma unroll
        for (int b = 0; b < 2; ++b)
#pragma unroll
            for (int m = 0; m < 4; ++m)
#pragma unroll
                for (int n = 0; n < 2; ++n) acc[a][b][m][n] = (f32x4){0.f, 0.f, 0.f, 0.f};
    bf16x8 At[4][2], B0[2][2], B1[2][2];
    const char* cA = (const char*)g.A + (size_t)cur.pm * tstep; const char* cB = (const char*)g.Bt + (size_t)cur.pn * tstep;
    S.a_ready(cur);
    if constexpr (SP2) {
        PG8_STAGE(PG8_SB(0, 0), cB, voffB); PG8_STAGE(PG8_SB(0, 1), cB + hstep, voffB); PG8_STAGE(PG8_SA(0, 0), cA, voffA); PG8_STAGE(PG8_SA(0, 1), cA + hstep, voffA);
        if (wr == 1) PG8_BAR;
        PG8_WAIT_V(2); PG8_BAR;
        PG8_STAGE(PG8_SB(1, 0), cB + kstep, voffB); PG8_STAGE(PG8_SA(1, 0), cA + kstep, voffA); PG8_STAGE(PG8_SB(1, 1), cB + hstep + kstep, voffB);
        PG8_WAIT_V(6); PG8_BAR;
    } else {
        PG8_STAGE(PG8_SB(0, 0), cB, voffB); PG8_STAGE(PG8_SA(0, 0), cA, voffA); PG8_STAGE(PG8_SB(0, 1), cB + hstep, voffB); PG8_STAGE(PG8_SA(0, 1), cA + hstep, voffA);
        if (wr == 1) PG8_BAR;
        PG8_WAIT_V(4); PG8_BAR;
        PG8_STAGE(PG8_SB(1, 0), cB + kstep, voffB); PG8_STAGE(PG8_SA(1, 0), cA + kstep, voffA); PG8_STAGE(PG8_SB(1, 1), cB + hstep + kstep, voffB);
        PG8_WAIT_V(6); PG8_BAR;
    }
    for (;;) {
        const bool has_next = S.next(ui + 1, nxt);
        const char* nA = has_next ? (const char*)g.A + (size_t)nxt.pm * tstep : cA; const char* nB = has_next ? (const char*)g.Bt + (size_t)nxt.pn * tstep : cB;
        for (int t = 0; t < nt; t += 2) {
            const bool last = (t == nt - 2);
            const char* a1 = cA + (size_t)(t + 1) * kstep;
            const char* a2 = last ? nA : cA + (size_t)(t + 2) * kstep; const char* b2 = last ? nB : cB + (size_t)(t + 2) * kstep;
            const char* a3 = a2 + kstep; const char* b3 = b2 + kstep;
            if (last && has_next) S.a_ready(nxt);
            if constexpr (SP2) {
            PG8_LDB(B0, 0, 0); PG8_LDB(B1, 0, 1); PG8_SCHED; PG8_LDA(At, 0, 0); PG8_STAGE(PG8_SA(1, 1), a1 + hstep, voffA);
            PG8_WAIT_V(8); PG8_WAIT_L(0); PG8_BAR; PG8_MMA(0, 0, At, B0); PG8_MMA(0, 1, At, B1); PG8_BAR; PG8_SCHED;
            PG8_LDA(At, 0, 1); PG8_STAGE(PG8_SB(0, 0), b2, voffB); PG8_STAGE(PG8_SB(0, 1), b2 + hstep, voffB); PG8_STAGE(PG8_SA(0, 0), a2, voffA);
            PG8_WAIT_V(8); PG8_WAIT_L(0); PG8_BAR; PG8_MMA(1, 0, At, B0); PG8_MMA(1, 1, At, B1); PG8_BAR; PG8_SCHED;
            PG8_LDB(B0, 1, 0); PG8_LDB(B1, 1, 1); PG8_SCHED; PG8_LDA(At, 1, 0); PG8_STAGE(PG8_SA(0, 1), a2 + hstep, voffA);
            PG8_WAIT_V(8); PG8_WAIT_L(0); PG8_BAR; PG8_MMA(0, 0, At, B0); PG8_MMA(0, 1, At, B1); PG8_BAR; PG8_SCHED;
            PG8_LDA(At, 1, 1); PG8_STAGE(PG8_SB(1, 0), b3, voffB); PG8_STAGE(PG8_SB(1, 1), b3 + hstep, voffB); PG8_STAGE(PG8_SA(1, 0), a3, voffA);
            PG8_WAIT_V(8); PG8_WAIT_L(0); PG8_BAR; PG8_MMA(1, 0, At, B0); PG8_MMA(1, 1, At, B1); PG8_BAR; PG8_SCHED;
            } else {
            PG8_LDB(B0, 0, 0); PG8_SCHED; PG8_LDA(At, 0, 0); PG8_STAGE(PG8_SA(1, 1), a1 + hstep, voffA);
            PG8_WAIT_L(8); PG8_BAR; PG8_WAIT_L(0); PG8_MMA(0, 0, At, B0); PG8_BAR; PG8_SCHED;
            PG8_LDB(B1, 0, 1); PG8_STAGE(PG8_SB(0, 0), b2, voffB);
            PG8_BAR; PG8_WAIT_L(0); PG8_MMA(0, 1, At, B1); PG8_BAR;
            PG8_LDA(At, 0, 1); PG8_STAGE(PG8_SA(0, 0), a2, voffA);
            PG8_BAR; PG8_WAIT_L(0); PG8_MMA(1, 0, At, B0); PG8_BAR; PG8_SCHED;
            PG8_STAGE(PG8_SB(0, 1), b2 + hstep, voffB);
            PG8_WAIT_V(6); PG8_BAR; PG8_MMA(1, 1, At, B1); PG8_BAR;
            PG8_LDB(B0, 1, 0); PG8_SCHED; PG8_LDA(At, 1, 0); PG8_STAGE(PG8_SA(0, 1), a2 + hstep, voffA);
            PG8_WAIT_L(8); PG8_BAR; PG8_WAIT_L(0); PG8_MMA(0, 0, At, B0); PG8_BAR; PG8_SCHED;
            PG8_LDB(B1, 1, 1); PG8_STAGE(PG8_SB(1, 0), b3, voffB);
            PG8_BAR; PG8_WAIT_L(0); PG8_MMA(0, 1, At, B1); PG8_BAR;
            PG8_LDA(At, 1, 1); PG8_STAGE(PG8_SA(1, 0), a3, voffA);
            PG8_BAR; PG8_WAIT_L(0); PG8_MMA(1, 0, At, B0); PG8_BAR; PG8_SCHED;
            PG8_STAGE(PG8_SB(1, 1), b3 + hstep, voffB);
            PG8_WAIT_V(6); PG8_BAR; PG8_MMA(1, 1, At, B1); PG8_BAR;
            }
        }
        if constexpr (ALIGN_EPI) { if (wr == 0) PG8_BAR; }
        if constexpr (!Epi::AFTER_DRAIN) { E(acc, cur, wr, wc, fr, fq); S.done(cur); }
        if (!has_next) break;
#pragma unroll
        for (int a = 0; a < 2; ++a)
#pragma unroll
            for (int b = 0; b < 2; ++b)
#pragma unroll
                for (int m = 0; m < 4; ++m)
#pragma unroll
                    for (int n = 0; n < 2; ++n) acc[a][b][m][n] = (f32x4){0.f, 0.f, 0.f, 0.f};
        cur = nxt; cA = nA; cB = nB; ++ui;
        if constexpr (ALIGN_EPI) { if (wr == 1) PG8_BAR; }
    }
    PG8_WAIT_V(0);
    if constexpr (!ALIGN_EPI) { if (wr == 0) PG8_BAR; }
    PG8_BAR;
    if constexpr (Epi::AFTER_DRAIN) { E.fused(acc, cur, wr, wc, fr, fq, lds, wid, lane); S.done(cur); }
#undef PG8_SA
#undef PG8_SB
#undef PG8_STAGE
#undef PG8_LDA
#undef PG8_LDB
#undef PG8_MMA
#undef PG8_WAIT_V
#undef PG8_WAIT_L
#undef PG8_BAR
#undef PG8_SCHED
}
}
using pg8::f32x4; using pg8::u32x4;

__device__ __forceinline__ void transpose_item(const float* W, int K, int N, bf16_t* WT, int row_off, float* scr, int item, int lane) {
    const int nblk = N / 32, kb = item / nblk, nbk = item % nblk, k0 = 64 * kb, n0 = 32 * nbk;
#pragma unroll 8
    for (int i = 0; i < 32; ++i) { const int kk = 2 * i + (lane >> 5); scr[kk * 33 + (lane & 31)] = W[(size_t)(k0 + kk) * N + n0 + (lane & 31)]; }
    asm volatile("s_waitcnt lgkmcnt(0)" ::: "memory");
    const int c = lane & 7;
#pragma unroll
    for (int j = 0; j < 4; ++j) { const int n = (lane >> 3) + 8 * j; const float* s = scr + (8 * c) * 33 + n;
        uint4 o; o.x = pk2(s[0 * 33], s[1 * 33]); o.y = pk2(s[2 * 33], s[3 * 33]); o.z = pk2(s[4 * 33], s[5 * 33]); o.w = pk2(s[6 * 33], s[7 * 33]);
        *(uint4*)(WT + (size_t)(row_off + n0 + n) * K + k0 + 8 * c) = o; }
    asm volatile("s_waitcnt lgkmcnt(0)" ::: "memory");
}
__device__ __forceinline__ void ph_prep(const Params& p, int bid, int nb, float* lds) {
    const int tid = tid_(), wave = tid >> 6, lane = tid & 63;
    {
        float* sl = lds;
        float* red = lds + 4096;
        for (int i = tid; i < 4096; i += NTH) sl[i] = siluf_(p.c[i]);
        __syncthreads();
        for (int it = bid; it < 192; it += nb) {
            const int c4 = tid & 15, kg = tid >> 4;
            const float* wp = p.w_ada + (size_t)kg * NMOD + it * 64 + c4 * 4;
            float a0[4] = {0.f, 0.f, 0.f, 0.f}, a1[4] = {0.f, 0.f, 0.f, 0.f};
#pragma unroll 8
            for (int i = 0; i < 64; ++i) {
                const int k = kg + 32 * i;
                const float4 w = *(const float4*)(wp + (size_t)(32 * i) * NMOD);
                const float s0 = sl[k], s1 = sl[2048 + k];
                a0[0] += s0 * w.x; a0[1] += s0 * w.y; a0[2] += s0 * w.z; a0[3] += s0 * w.w;
                a1[0] += s1 * w.x; a1[1] += s1 * w.y; a1[2] += s1 * w.z; a1[3] += s1 * w.w;
            }
            __syncthreads();
#pragma unroll
            for (int e = 0; e < 4; ++e) { red[(kg * 16 + c4) * 8 + e] = a0[e]; red[(kg * 16 + c4) * 8 + 4 + e] = a1[e]; }
            __syncthreads();
            if (tid < 128) {
                const int b = tid >> 6, col = tid & 63;
                float s = 0.f;
                for (int g = 0; g < 32; ++g) s += red[(g * 16 + (col >> 2)) * 8 + b * 4 + (col & 3)];
                p.ada[b * NMOD + it * 64 + col] = s + p.b_ada[it * 64 + col];
            }
        }
        __syncthreads();
    }
    for (int e = bid * NTH + tid; e < NTOK * 64; e += nb * NTH) {
        const int tok = e >> 6, j = e & 63;
        const float ang = (float)p.pos[tok] * c_freq[j];
        float s, c; sincos_acc(ang, s, c);
        p.rope[(size_t)e * 2] = c; p.rope[(size_t)e * 2 + 1] = s;
    }
    {
        float* scr = lds + wave * (64 * 33);
        const int gw = bid * 8 + wave, ngw = nb * 8;
        constexpr int I1 = 32 * 256, I2 = 32 * 128, I3 = 16 * 64, I4 = 32 * 64;
        constexpr int NIT = I1 + I2 + I3 + 3 * I4;
        for (int it = gw; it < NIT; it += ngw) {
            int r = it;
            if (r < I1) { transpose_item(p.w_in, 2048, 8192, p.Wt1, 0, scr, r, lane); continue; } r -= I1;
            if (r < I2) { transpose_item(p.w_bg, 2048, 4096, p.Wt1, 8192, scr, r, lane); continue; } r -= I2;
            if (r < I3) { transpose_item(p.w_a_out, 1024, 2048, p.Wta, 0, scr, r, lane); continue; } r -= I3;
            if (r < I4) { transpose_item(p.w_b_out, 2048, 2048, p.Wtb, 0, scr, r, lane); continue; } r -= I4;
            if (r < I4) { transpose_item(p.w_o, 2048, 2048, p.Wto, 0, scr, r, lane); continue; } r -= I4;
            transpose_item(p.peer_wq, 2048, 2048, p.Wtq, 0, scr, r, lane);
        }
    }
    {
        const size_t n8 = (size_t)16384 * 2048 / 8;
        for (size_t i = (size_t)bid * NTH + tid; i < 2 * n8; i += (size_t)nb * NTH) {
            const bool second = i >= n8; const size_t j = second ? i - n8 : i;
            const float4* src = (const float4*)((second ? p.peer_v : p.peer_u) + j * 8);
            const float4 a = src[0], b = src[1];
            *(uint4*)((second ? p.Vb : p.Ub) + j * 8) = make_uint4(pk2(a.x, a.y), pk2(a.z, a.w), pk2(b.x, b.y), pk2(b.z, b.w));
        }
    }
    __syncthreads();
}

__device__ __forceinline__ void ph_modnorm(const Params& p, const float* xin, const float* g, int sh_off, int sc_off, bf16_t* hout, int bid, int nb, float* lds) {
    const int tid = tid_(), wave = tid >> 6, lane = tid & 63;
    for (int row = bid * 8 + wave; row < NTOK; row += nb * 8) {
        const int b = row / SQ;
        const float4* xr = (const float4*)(xin + (size_t)row * DM);
        float4 v[8]; float ss = 0.f;
#pragma unroll
        for (int j = 0; j < 8; ++j) { v[j] = xr[lane + 64 * j]; ss += dot4(v[j], v[j]); }
        ss = wave_sum(ss);
        const float rs = 1.0f / sqrtf(ss * (1.0f / DM) + 1e-6f);
#pragma unroll
        for (int j = 0; j < 8; ++j) {
            const int col = (lane + 64 * j) * 4;
            const float4 g4 = *(const float4*)(g + col);
            const float4 sc = *(const float4*)(p.ada + b * NMOD + sc_off + col);
            const float4 sh = *(const float4*)(p.ada + b * NMOD + sh_off + col);
            float4 o;
            o.x = v[j].x * rs * g4.x * (1.0f + sc.x) + sh.x; o.y = v[j].y * rs * g4.y * (1.0f + sc.y) + sh.y;
            o.z = v[j].z * rs * g4.z * (1.0f + sc.z) + sh.z; o.w = v[j].w * rs * g4.w * (1.0f + sc.w) + sh.w;
            *(uint2*)(hout + (size_t)row * DM + col) = make_uint2(pk2(o.x, o.y), pk2(o.z, o.w));
        }
    }
}

__device__ __forceinline__ void ph_gmlp(const Params& p, int bid, int nb, float* lds) {
    float* vt = lds;
    float* wm = lds + 16384;
    const bf16_t* z = p.ZG;
    const int tid = tid_(), wave = tid >> 6, lane = tid & 63;
    for (int it = bid; it < 512; it += nb) {
        const int g = it & 7, n = (it >> 3) & 31, b = it >> 8;
        const int tok0 = b * SQ + n * 128;
        __syncthreads();
        for (int i = tid; i < 16384; i += NTH) { const int ii = i >> 7, jj = i & 127; wm[i] = ((ii >> 6) >= (jj >> 6)) ? p.gm_ws[g * 16384 + i] : 0.f; }
        for (int j = wave; j < 128; j += 8) {
            const bf16_t* zr = z + (size_t)(tok0 + j) * ZW + 1024 + g * 128;
            const float a = bf2f(zr[lane]), c2 = bf2f(zr[lane + 64]);
            const float ss = wave_sum(a * a + c2 * c2);
            const float rs = 1.0f / sqrtf(ss * (1.0f / 128.0f) + 1e-6f);
            vt[j * 128 + lane] = a * rs * p.gm_v_g[g * 128 + lane];
            vt[j * 128 + lane + 64] = c2 * rs * p.gm_v_g[g * 128 + lane + 64];
        }
        __syncthreads();
        const int d = tid & 127, ig = tid >> 7;
        float acc[32];
#pragma unroll
        for (int ii = 0; ii < 32; ++ii) acc[ii] = 0.f;
        for (int j = 0; j < 128; ++j) {
            const float vv = vt[j * 128 + d];
#pragma unroll
            for (int ii = 0; ii < 32; ++ii) acc[ii] += wm[(ig * 32 + ii) * 128 + j] * vv;
        }
#pragma unroll
        for (int ii = 0; ii < 32; ++ii) {
            const int i = ig * 32 + ii;
            const float s = acc[ii] + p.gm_b[g * 128 + i];
            const size_t tok = (size_t)(tok0 + i);
            const float u = bf2f(z[tok * ZW + g * 128 + d]);
            p.yain[tok * 1024 + g * 128 + d] = (bf16_t)f2bf(u * s);
        }
    }
    __syncthreads();
}

__device__ __forceinline__ void ph_ret(const Params& p, int bid, int nb, float* lds) {
    float* Qs = lds;
    float* Ks = Qs + 64 * 129;
    float* Vs = Ks + 64 * 129;
    float* Ss = Vs + 64 * 16;
    float* At = Ss + 128 * 16;
    float* kd = At + 64 * 65;
    const int tid = tid_();
    const bf16_t* z = p.ZG;
    for (int it = bid; it < 256; it += nb) {
        const int vs = it & 15, h = (it >> 4) & 7, b = it >> 7;
        const float lg = log1pf(-exp2f(-5.0f - (float)h));
        const float cdec = expf(lg * 64.0f);
        __syncthreads();
        for (int i = tid; i < 2048; i += NTH) Ss[i] = 0.f;
        if (tid < 64) kd[tid] = expf(lg * (float)(63 - tid));
        for (int n = 0; n < 64; ++n) {
            const int tok0 = b * SQ + n * 64;
            __syncthreads();
            for (int e = tid; e < 4096; e += NTH) {
                const int i = e >> 6, dd = e & 63; const size_t tok = (size_t)(tok0 + i);
                const float cs = p.rope[(tok * 64 + dd) * 2], sn = p.rope[(tok * 64 + dd) * 2 + 1];
                const bf16_t* zr = z + tok * ZW;
                const float q1 = bf2f(zr[2048 + h * 128 + dd]), q2 = bf2f(zr[2048 + h * 128 + 64 + dd]);
                const float k1 = bf2f(zr[3072 + h * 128 + dd]), k2 = bf2f(zr[3072 + h * 128 + 64 + dd]);
                Qs[i * 129 + dd] = q1 * cs - q2 * sn; Qs[i * 129 + 64 + dd] = q1 * sn + q2 * cs;
                const float sc = 0.08838834764831845f;
                Ks[i * 129 + dd] = (k1 * cs - k2 * sn) * sc; Ks[i * 129 + 64 + dd] = (k1 * sn + k2 * cs) * sc;
            }
            for (int e = tid; e < 1024; e += NTH) { const int j = e >> 4, v = e & 15; Vs[e] = bf2f(z[(size_t)(tok0 + j) * ZW + 4096 + h * 256 + vs * 16 + v]); }
            __syncthreads();
            {
                const int j = tid & 63, i0 = (tid >> 6) * 8;
                float acc[8];
#pragma unroll
                for (int ii = 0; ii < 8; ++ii) acc[ii] = 0.f;
                for (int d = 0; d < 128; ++d) {
                    const float kv = Ks[j * 129 + d];
#pragma unroll
                    for (int ii = 0; ii < 8; ++ii) acc[ii] += Qs[(i0 + ii) * 129 + d] * kv;
                }
#pragma unroll
                for (int ii = 0; ii < 8; ++ii) { const int i = i0 + ii; At[i * 65 + j] = acc[ii] * expf(lg * fabsf((float)(i - j))); }
            }
            __syncthreads();
            {
                const int v = tid & 15, i0 = tid >> 4;
#pragma unroll
                for (int rep = 0; rep < 2; ++rep) {
                    const int i = i0 + 32 * rep;
                    float a = 0.f; for (int j = 0; j < 64; ++j) a += At[i * 65 + j] * Vs[j * 16 + v];
                    float c2 = 0.f; for (int d = 0; d < 128; ++d) c2 += Qs[i * 129 + d] * Ss[d * 16 + v];
                    p.obuf[(size_t)(tok0 + i) * DM + h * 256 + vs * 16 + v] = a + c2 * expf(lg * (float)(i + 1));
                }
            }
            __syncthreads();
            {
                const int v = tid & 15, d0 = tid >> 4;
#pragma unroll
                for (int rep = 0; rep < 4; ++rep) {
                    const int d = d0 + 32 * rep;
                    float a = 0.f; for (int j = 0; j < 64; ++j) a += Ks[j * 129 + d] * kd[j] * Vs[j * 16 + v];
                    Ss[d * 16 + v] = Ss[d * 16 + v] * cdec + a;
                }
            }
        }
    }
    __syncthreads();
}

__device__ __forceinline__ void ph_gn(const Params& p, int bid, int nb, float* lds) {
    const int tid = tid_(), wave = tid >> 6, lane = tid & 63;
    for (int tok = bid * 8 + wave; tok < NTOK; tok += nb * 8) {
#pragma unroll
        for (int h = 0; h < 8; ++h) {
            const float4 o = *(const float4*)(p.obuf + (size_t)tok * DM + h * 256 + lane * 4);
            const float mu = wave_sum(o.x + o.y + o.z + o.w) * (1.0f / 256.0f);
            const float4 d = make_float4(o.x - mu, o.y - mu, o.z - mu, o.w - mu);
            const float var = wave_sum(dot4(d, d)) * (1.0f / 256.0f);
            const float rs = 1.0f / sqrtf(var + 1e-6f);
            const float4 gn = *(const float4*)(p.ret_gn_g + h * 256 + lane * 4);
            const uint2 gw = *(const uint2*)(p.ZG + (size_t)tok * ZW + 6144 + h * 256 + lane * 4);
            const float g0 = bflo(gw.x), g1 = bfhi(gw.x), g2 = bflo(gw.y), g3 = bfhi(gw.y);
            *(uint2*)(p.ybin + (size_t)tok * DM + h * 256 + lane * 4) =
                make_uint2(pk2(siluf_(g0) * d.x * rs * gn.x, siluf_(g1) * d.y * rs * gn.y), pk2(siluf_(g2) * d.z * rs * gn.z, siluf_(g3) * d.w * rs * gn.w));
        }
    }
}

template <int NL>
__device__ __forceinline__ void wave_top16(float (&v)[NL], const int (&idx)[NL], float& outv, int& outi, int lane) {
    outv = 0.f; outi = 0;
    for (int r = 0; r < 16; ++r) {
        float m = v[0];
#pragma unroll
        for (int u = 1; u < NL; ++u) m = fmaxf(m, v[u]);
        const float wm = wave_max(m);
        const unsigned long long bal = __ballot(m == wm);
        const int owner = __ffsll((long long)bal) - 1;
        int myi = -1;
        if (lane == owner) {
            bool done = false;
#pragma unroll
            for (int u = 0; u < NL; ++u) if (!done && v[u] == wm) { myi = idx[u]; v[u] = -INFINITY; done = true; }
        }
        const int wi = __shfl(myi, owner);
        if (lane == r) { outv = wm; outi = wi; }
    }
}
__device__ __forceinline__ void ph_topk(const Params& p, const float* qb, int bid, int nb, float* lds) {
    const int tid = tid_(), wave = tid >> 6, lane = tid & 63;
    for (int t = bid; t < NTOK; t += nb) {
        const int h = wave;
        const float* q = qb + (size_t)t * DM + h * 256;
        float s[2][2];
#pragma unroll
        for (int pp = 0; pp < 2; ++pp)
#pragma unroll
            for (int r = 0; r < 2; ++r) {
                const int n = lane + 64 * r;
                const float4* kr = (const float4*)(p.peer_sk + ((size_t)(h * 2 + pp) * 128 + n) * 128);
                const float4* qr = (const float4*)(q + pp * 128);
                float a = 0.f;
#pragma unroll 4
                for (int d4 = 0; d4 < 32; ++d4) a += dot4(kr[d4], qr[d4]);
                s[pp][r] = a;
            }
        float v1, v2; int i1, i2;
        { float vv[2] = {s[0][0], s[0][1]}; const int ii[2] = {lane, lane + 64}; wave_top16<2>(vv, ii, v1, i1, lane); }
        { float vv[2] = {s[1][0], s[1][1]}; const int ii[2] = {lane, lane + 64}; wave_top16<2>(vv, ii, v2, i2, lane); }
        float cv[4]; int ci[4];
        const int a = lane >> 2, b0 = (lane & 3) * 4;
        const float va = __shfl(v1, a); const int ia = __shfl(i1, a);
#pragma unroll
        for (int u = 0; u < 4; ++u) { const float vb = __shfl(v2, b0 + u); const int ib = __shfl(i2, b0 + u); cv[u] = va + vb; ci[u] = ia * 128 + ib; }
        float tv; int te;
        wave_top16<4>(cv, ci, tv, te, lane);
        const float mx = __shfl(tv, 0);
        const float ex = (lane < 16) ? expf(tv - mx) : 0.f;
        const float sum = wave_sum(ex);
        if (lane < 16) { p.eidx[(size_t)t * 128 + h * 16 + lane] = te; p.gatev[(size_t)t * 128 + h * 16 + lane] = ex / sum; }
    }
}

__device__ __forceinline__ void ph_peer(const Params& p, const float* x1, const bf16_t* h2, int bid, int nb, float* lds) {
    float* ys = lds;
    float* red = lds + 8 * 2048;
    const int tid = tid_(), wave = tid >> 6, lane = tid & 63;
    for (int t = bid; t < NTOK; t += nb) {
        const int b = t / SQ, h = wave;
        const uint2* hr = (const uint2*)(h2 + (size_t)t * DM);
        float4 hv[8], y[8];
#pragma unroll
        for (int j = 0; j < 8; ++j) { const uint2 w = hr[lane + 64 * j]; hv[j] = make_float4(bflo(w.x), bfhi(w.x), bflo(w.y), bfhi(w.y)); y[j] = make_float4(0.f, 0.f, 0.f, 0.f); }
        for (int k = 0; k < 16; ++k) {
            const int e = p.eidx[(size_t)t * 128 + h * 16 + k]; const float gt = p.gatev[(size_t)t * 128 + h * 16 + k];
            const float4* ur = (const float4*)(p.peer_u + (size_t)e * DM);
            float a = 0.f;
#pragma unroll
            for (int j = 0; j < 8; ++j) a += dot4(ur[lane + 64 * j], hv[j]);
            a = wave_sum(a);
            const float w = geluf_(a) * gt;
            const float4* vr = (const float4*)(p.peer_v + (size_t)e * DM);
#pragma unroll
            for (int j = 0; j < 8; ++j) { const float4 v4 = vr[lane + 64 * j]; y[j].x += w * v4.x; y[j].y += w * v4.y; y[j].z += w * v4.z; y[j].w += w * v4.w; }
        }
        __syncthreads();
#pragma unroll
        for (int j = 0; j < 8; ++j) *(float4*)(ys + h * 2048 + (lane + 64 * j) * 4) = y[j];
        __syncthreads();
        const int c = tid * 4;
        float4 s = make_float4(0.f, 0.f, 0.f, 0.f);
#pragma unroll
        for (int hh = 0; hh < 8; ++hh) { const float4 a = *(const float4*)(ys + hh * 2048 + c); s.x += a.x; s.y += a.y; s.z += a.z; s.w += a.w; }
        const float4 xv = *(const float4*)(x1 + (size_t)t * DM + c);
        const float4 ga = *(const float4*)(p.ada + b * NMOD + 5 * DM + c);
        const float4 x2 = make_float4(xv.x + ga.x * s.x, xv.y + ga.y * s.y, xv.z + ga.z * s.z, xv.w + ga.w * s.w);
        const float ss = wave_sum(dot4(x2, x2));
        if (lane == 0) red[wave] = ss;
        __syncthreads();
        float tot = 0.f;
#pragma unroll
        for (int w = 0; w < 8; ++w) tot += red[w];
        const float rs = 1.0f / sqrtf(tot * (1.0f / DM) + 1e-6f);
        const float4 gf = *(const float4*)(p.norm_f_g + c);
        *(float4*)(p.out + (size_t)t * DM + c) = make_float4(x2.x * rs * gf.x, x2.y * rs * gf.y, x2.z * rs * gf.z, x2.w * rs * gf.w);
    }
    __syncthreads();
}

typedef short bf16x8_t __attribute__((ext_vector_type(8)));
typedef float f32x4_t __attribute__((ext_vector_type(4)));
__device__ __forceinline__ void split8(const float4 a, const float4 b, uint4& hi, uint4& lo) {
    const float x[8] = {a.x, a.y, a.z, a.w, b.x, b.y, b.z, b.w}; unsigned h[8], l[8];
#pragma unroll
    for (int i = 0; i < 8; ++i) { h[i] = f2bf(x[i]); l[i] = f2bf(x[i] - __uint_as_float(h[i] << 16)); }
    hi = make_uint4(h[0] | (h[1] << 16), h[2] | (h[3] << 16), h[4] | (h[5] << 16), h[6] | (h[7] << 16));
    lo = make_uint4(l[0] | (l[1] << 16), l[2] | (l[3] << 16), l[4] | (l[5] << 16), l[6] | (l[7] << 16));
}
__device__ __forceinline__ bf16x8_t as_bf16x8(const uint4 v) { return __builtin_bit_cast(bf16x8_t, v); }
struct PairTab { int a[52], b[52]; };
__host__ __device__ constexpr PairTab make_pairs() {
    PairTab t{}; int n = 0;
    for (int a = 0; a < 16; ++a) for (int b = 0; b < 16; ++b) if ((a + 1) * (b + 1) <= 16) { t.a[n] = a; t.b[n] = b; ++n; }
    for (; n < 52; ++n) { t.a[n] = -1; t.b[n] = -1; }
    return t;
}
constexpr PairTab PAIRS = make_pairs();
static_assert(PAIRS.a[49] >= 0 && PAIRS.a[50] < 0, "50 candidate pairs");

__device__ __forceinline__ void ph_topk2(const Params& p, const float* qb, int bid, int nb, float* lds) {
    const int tid = tid_(), wave = tid >> 6, lane = tid & 63;
    uint4* SK = (uint4*)lds;
    const float NEG = -INFINITY;
    for (int it = bid; it < 256; it += nb) {
        const int h = it & 7, tg = it >> 3;
        __syncthreads();
        for (int gi = tid; gi < 4096; gi += NTH) {
            const int dq = gi & 15, n = (gi >> 4) & 127, pp = gi >> 11;
            const float4* src = (const float4*)(p.peer_sk + ((size_t)(h * 2 + pp) * 128 + n) * 128 + dq * 8);
            uint4 hi, lo; split8(src[0], src[1], hi, lo);
            const int base = (((pp * 8 + (n >> 4)) * 4 + (dq >> 2)) * 2) * 64 + (dq & 3) * 16 + (n & 15);
            SK[base] = hi; SK[base + 64] = lo;
        }
        __syncthreads();
#pragma unroll 1
        for (int tile = 0; tile < 2; ++tile) {
            const int tok = tg * 256 + wave * 32 + tile * 16 + (lane & 15);
            const int qd = lane >> 4;
            float v12[2][16];
#pragma unroll
            for (int pp = 0; pp < 2; ++pp) {
                bf16x8_t Bh[4], Bl[4];
                const float* qp = qb + (size_t)tok * DM + h * 256 + pp * 128 + 8 * qd;
#pragma unroll
                for (int ks = 0; ks < 4; ++ks) { uint4 hi, lo; split8(*(const float4*)(qp + ks * 32), *(const float4*)(qp + ks * 32 + 4), hi, lo); Bh[ks] = as_bf16x8(hi); Bl[ks] = as_bf16x8(lo); }
                float v[32];
#pragma unroll
                for (int kt = 0; kt < 8; ++kt) {
                    f32x4_t acc = {0.f, 0.f, 0.f, 0.f};
#pragma unroll
                    for (int ks = 0; ks < 4; ++ks) {
                        const bf16x8_t Ah = as_bf16x8(SK[(((pp * 8 + kt) * 4 + ks) * 2) * 64 + lane]), Al = as_bf16x8(SK[(((pp * 8 + kt) * 4 + ks) * 2 + 1) * 64 + lane]);
                        acc = __builtin_amdgcn_mfma_f32_16x16x32_bf16(Ah, Bh[ks], acc, 0, 0, 0);
                        acc = __builtin_amdgcn_mfma_f32_16x16x32_bf16(Ah, Bl[ks], acc, 0, 0, 0);
                        acc = __builtin_amdgcn_mfma_f32_16x16x32_bf16(Al, Bh[ks], acc, 0, 0, 0);
                    }
#pragma unroll
                    for (int r = 0; r < 4; ++r) v[kt * 4 + r] = __uint_as_float((__float_as_uint(acc[r]) & ~127u) | (unsigned)(kt * 16 + qd * 4 + r));
                    __builtin_amdgcn_sched_barrier(0);
                }
#pragma unroll
                for (int r = 0; r < 16; ++r) {
                    float m = v[0];
#pragma unroll
                    for (int u = 1; u < 32; ++u) m = fmaxf(m, v[u]);
                    m = fmaxf(m, __shfl_xor(m, 16)); m = fmaxf(m, __shfl_xor(m, 32));
                    v12[pp][r] = m;
#pragma unroll
                    for (int u = 0; u < 32; ++u) v[u] = (v[u] == m) ? NEG : v[u];
                }
            }
            float c[13]; unsigned pay[13];
#pragma unroll
            for (int s = 0; s < 13; ++s) {
                float cq[4]; unsigned pq[4];
#pragma unroll
                for (int q = 0; q < 4; ++q) {
                    const int pi = 4 * s + q; const int a = PAIRS.a[pi], b = PAIRS.b[pi];
                    if (a >= 0) {
                        const float sum = v12[0][a] + v12[1][b];
                        cq[q] = __uint_as_float((__float_as_uint(sum) & ~63u) | (unsigned)pi);
                        pq[q] = (__float_as_uint(v12[0][a]) & 127u) * 128u + (__float_as_uint(v12[1][b]) & 127u);
                    } else { cq[q] = NEG; pq[q] = 0u; }
                }
                c[s] = qd == 0 ? cq[0] : qd == 1 ? cq[1] : qd == 2 ? cq[2] : cq[3];
                pay[s] = qd == 0 ? pq[0] : qd == 1 ? pq[1] : qd == 2 ? pq[2] : pq[3];
            }
            float top[16]; unsigned eid[16];
#pragma unroll
            for (int r = 0; r < 16; ++r) {
                float m = c[0];
#pragma unroll
                for (int s = 1; s < 13; ++s) m = fmaxf(m, c[s]);
                m = fmaxf(m, __shfl_xor(m, 16)); m = fmaxf(m, __shfl_xor(m, 32));
                unsigned pw = 0u;
#pragma unroll
                for (int s = 0; s < 13; ++s) { const bool eq = (c[s] == m); pw |= eq ? pay[s] : 0u; c[s] = eq ? NEG : c[s]; }
                pw |= (unsigned)__shfl_xor((int)pw, 16); pw |= (unsigned)__shfl_xor((int)pw, 32);
                top[r] = m; eid[r] = pw;
            }
            float sum = 0.f; const float mx = top[0];
#pragma unroll
            for (int r = 0; r < 16; ++r) { top[r] = expf(top[r] - mx); sum += top[r]; }
            const float inv = 1.0f / sum;
            if (lane < 16) {
                int4* ep = (int4*)(p.eidx + (size_t)tok * 128 + h * 16); float4* gp = (float4*)(p.gatev + (size_t)tok * 128 + h * 16);
#pragma unroll
                for (int q = 0; q < 4; ++q) {
                    ep[q] = make_int4((int)eid[4 * q], (int)eid[4 * q + 1], (int)eid[4 * q + 2], (int)eid[4 * q + 3]);
                    gp[q] = make_float4(top[4 * q] * inv, top[4 * q + 1] * inv, top[4 * q + 2] * inv, top[4 * q + 3] * inv);
                }
            }
        }
    }
    __syncthreads();
}

__device__ __forceinline__ void peer_load2(const bf16_t* tab, int ea, int eb, int lane, uint4 (&R)[2][4]) {
    const uint4* ra = (const uint4*)(tab + (size_t)ea * DM) + lane; const uint4* rb = (const uint4*)(tab + (size_t)eb * DM) + lane;
#pragma unroll
    for (int j = 0; j < 4; ++j) { R[0][j] = ra[64 * j]; R[1][j] = rb[64 * j]; }
}
__device__ __forceinline__ void ph_peer2(const Params& p, const float* x1, const bf16_t* h2, int bid, int nb) {
    const int tid = tid_(), wave = tid >> 6, lane = tid & 63;
    for (int t = bid * 8 + wave; t < NTOK; t += nb * 8) {
        const int b = t / SQ;
        float hv[32], y[32];
        {
            const uint4* hr = (const uint4*)(h2 + (size_t)t * DM) + lane;
#pragma unroll
            for (int j = 0; j < 4; ++j) { const uint4 w = hr[64 * j];
                hv[8 * j + 0] = bflo(w.x); hv[8 * j + 1] = bfhi(w.x); hv[8 * j + 2] = bflo(w.y); hv[8 * j + 3] = bfhi(w.y);
                hv[8 * j + 4] = bflo(w.z); hv[8 * j + 5] = bfhi(w.z); hv[8 * j + 6] = bflo(w.w); hv[8 * j + 7] = bfhi(w.w); }
        }
#pragma unroll
        for (int i = 0; i < 32; ++i) y[i] = 0.f;
        const int e0 = p.eidx[(size_t)t * 128 + lane], e1 = p.eidx[(size_t)t * 128 + 64 + lane];
        const float g0 = p.gatev[(size_t)t * 128 + lane], g1 = p.gatev[(size_t)t * 128 + 64 + lane];
        uint4 Uc[2][4], Un[2][4], Vc[2][4];
        peer_load2(p.Ub, __builtin_amdgcn_readlane(e0, 0), __builtin_amdgcn_readlane(e0, 1), lane, Uc);
        for (int g = 0; g < 64; ++g) {
            const int ee = (g < 32) ? e0 : e1; const float gg = (g < 32) ? g0 : g1;
            const int k0 = (2 * g) & 63;
            const int ea = __builtin_amdgcn_readlane(ee, k0), eb = __builtin_amdgcn_readlane(ee, k0 + 1);
            const float ga = __uint_as_float(__builtin_amdgcn_readlane(__float_as_uint(gg), k0)), gb = __uint_as_float(__builtin_amdgcn_readlane(__float_as_uint(gg), k0 + 1));
            peer_load2(p.Vb, ea, eb, lane, Vc);
            {
                const int gn = (g < 63) ? g + 1 : g; const int en = (gn < 32) ? e0 : e1; const int kn = (2 * gn) & 63;
                peer_load2(p.Ub, __builtin_amdgcn_readlane(en, kn), __builtin_amdgcn_readlane(en, kn + 1), lane, Un);
            }
            float a0 = 0.f, a1 = 0.f;
#pragma unroll
            for (int j = 0; j < 4; ++j) {
                const unsigned ua[4] = {Uc[0][j].x, Uc[0][j].y, Uc[0][j].z, Uc[0][j].w}, ub[4] = {Uc[1][j].x, Uc[1][j].y, Uc[1][j].z, Uc[1][j].w};
#pragma unroll
                for (int q = 0; q < 4; ++q) {
                    a0 += bflo(ua[q]) * hv[8 * j + 2 * q] + bfhi(ua[q]) * hv[8 * j + 2 * q + 1];
                    a1 += bflo(ub[q]) * hv[8 * j + 2 * q] + bfhi(ub[q]) * hv[8 * j + 2 * q + 1];
                }
            }
#pragma unroll
            for (int o = 1; o < 64; o <<= 1) { a0 += __shfl_xor(a0, o); a1 += __shfl_xor(a1, o); }
            const float w0 = geluf_(a0) * ga, w1 = geluf_(a1) * gb;
#pragma unroll
            for (int j = 0; j < 4; ++j) {
                const unsigned va[4] = {Vc[0][j].x, Vc[0][j].y, Vc[0][j].z, Vc[0][j].w}, vb[4] = {Vc[1][j].x, Vc[1][j].y, Vc[1][j].z, Vc[1][j].w};
#pragma unroll
                for (int q = 0; q < 4; ++q) {
                    y[8 * j + 2 * q] += w0 * bflo(va[q]) + w1 * bflo(vb[q]);
                    y[8 * j + 2 * q + 1] += w0 * bfhi(va[q]) + w1 * bfhi(vb[q]);
                }
            }
#pragma unroll
            for (int i = 0; i < 2; ++i)
#pragma unroll
                for (int j = 0; j < 4; ++j) Uc[i][j] = Un[i][j];
        }
        float ss = 0.f;
#pragma unroll
        for (int j = 0; j < 4; ++j)
#pragma unroll
            for (int hq = 0; hq < 2; ++hq) {
                const int c = (lane + 64 * j) * 8 + 4 * hq;
                const float4 xv = *(const float4*)(x1 + (size_t)t * DM + c);
                const float4 ga = *(const float4*)(p.ada + b * NMOD + 5 * DM + c);
                float* yy = y + 8 * j + 4 * hq;
                yy[0] = xv.x + ga.x * yy[0]; yy[1] = xv.y + ga.y * yy[1]; yy[2] = xv.z + ga.z * yy[2]; yy[3] = xv.w + ga.w * yy[3];
                ss += yy[0] * yy[0] + yy[1] * yy[1] + yy[2] * yy[2] + yy[3] * yy[3];
            }
        ss = wave_sum(ss);
        const float rs = 1.0f / sqrtf(ss * (1.0f / DM) + 1e-6f);
#pragma unroll
        for (int j = 0; j < 4; ++j)
#pragma unroll
            for (int hq = 0; hq < 2; ++hq) {
                const int c = (lane + 64 * j) * 8 + 4 * hq;
                const float4 gf = *(const float4*)(p.norm_f_g + c);
                const float* yy = y + 8 * j + 4 * hq;
                *(float4*)(p.out + (size_t)t * DM + c) = make_float4(yy[0] * rs * gf.x, yy[1] * rs * gf.y, yy[2] * rs * gf.z, yy[3] * rs * gf.w);
            }
    }
}

template <class Epi>
__device__ __forceinline__ void gemm_run(float* lds, const bf16_t* A, const bf16_t* Bt, int M, int N, int K, const Epi& E) {
    __syncthreads();
    pg8::Gemm g{A, Bt, M, N, K}; pg8::StaticOrder S; S.init(M, N, (int)gridDim.x, (int)blockIdx.x);
    pg8::gemm_phase<Epi, pg8::StaticOrder, true, true>((PG8_LAS unsigned char*)lds, g, S, E);
    __syncthreads();
}
constexpr int NPHASE = 11;
template <int PH>
__device__ __forceinline__ void run_phase(const Params& p, int bid, int nb, float* lds) {
    asm volatile("" : "+s"(bid));
    if constexpr (PH == 0) ph_prep(p, bid, nb, lds);
    if constexpr (PH == 1) ph_modnorm(p, p.x, p.norm1_g, 0 * DM, 1 * DM, p.hb, bid, nb, lds);
    if constexpr (PH == 2) gemm_run(lds, p.hb, p.Wt1, NTOK, ZW, DM, pg8::EpiZG{p.ZG, p.b_bg});
    if constexpr (PH == 3) { ph_ret(p, bid, nb, lds); ph_gmlp(p, bid, nb, lds); }
    if constexpr (PH == 4) ph_gn(p, bid, nb, lds);
    if constexpr (PH == 5) {
        gemm_run(lds, p.yain, p.Wta, NTOK, DM, 1024, pg8::EpiMixB<0>{p.hb, p.ZG, 0});
        gemm_run(lds, p.ybin, p.Wtb, NTOK, DM, DM, pg8::EpiMixB<1>{p.hb, p.ZG, 2048});
    }
    if constexpr (PH == 6) gemm_run(lds, p.hb, p.Wto, NTOK, DM, DM, pg8::EpiResF{p.obuf, p.x, p.ada + 2 * DM});
    if constexpr (PH == 7) ph_modnorm(p, p.obuf, p.norm2_g, 3 * DM, 4 * DM, p.hb, bid, nb, lds);
    if constexpr (PH == 8) gemm_run(lds, p.hb, p.Wtq, NTOK, DM, DM, pg8::EpiF32{p.qbuf, DM});
    if constexpr (PH == 9) ph_topk2(p, p.qbuf, bid, nb, lds);
    if constexpr (PH == 10) ph_peer2(p, p.obuf, p.hb, bid, nb);
}

__global__ void __launch_bounds__(NTH) k_mega(Params p) {
    extern __shared__ __attribute__((aligned(16))) float lds[];
    cg::grid_group grid = cg::this_grid();
    const int bid = blockIdx.x, nb = gridDim.x;
    run_phase<0>(p, bid, nb, lds); grid.sync();
    run_phase<1>(p, bid, nb, lds); grid.sync();
    run_phase<2>(p, bid, nb, lds); grid.sync();
    run_phase<3>(p, bid, nb, lds); grid.sync();
    run_phase<4>(p, bid, nb, lds); grid.sync();
    run_phase<5>(p, bid, nb, lds); grid.sync();
    run_phase<6>(p, bid, nb, lds); grid.sync();
    run_phase<7>(p, bid, nb, lds); grid.sync();
    run_phase<8>(p, bid, nb, lds); grid.sync();
    run_phase<9>(p, bid, nb, lds); grid.sync();
    run_phase<10>(p, bid, nb, lds);
}

extern "C" void kernel_launch(void* const* d_in, const int* in_sizes, int n_in, void* d_out, int out_size, void* d_ws, size_t ws_size, hipStream_t stream) {
    Params p{};
    p.x = (const float*)d_in[0]; p.c = (const float*)d_in[1]; p.pos = (const int*)d_in[2];
    p.w_ada = (const float*)d_in[3]; p.b_ada = (const float*)d_in[4]; p.norm1_g = (const float*)d_in[5]; p.w_in = (const float*)d_in[6];
    p.w_bg = (const float*)d_in[7]; p.b_bg = (const float*)d_in[8]; p.gm_v_g = (const float*)d_in[9]; p.gm_ws = (const float*)d_in[10];
    p.gm_b = (const float*)d_in[11]; p.ret_gn_g = (const float*)d_in[12]; p.w_a_out = (const float*)d_in[13]; p.w_b_out = (const float*)d_in[14];
    p.w_o = (const float*)d_in[15]; p.norm2_g = (const float*)d_in[16]; p.peer_wq = (const float*)d_in[17]; p.peer_sk = (const float*)d_in[18];
    p.peer_u = (const float*)d_in[19]; p.peer_v = (const float*)d_in[20]; p.norm_f_g = (const float*)d_in[21];
    p.out = (float*)d_out;
    char* w = (char*)d_ws; size_t off = 0;
    auto take = [&](size_t bytes) { char* r = w + off; off += (bytes + 255) & ~(size_t)255; return r; };
    p.ada = (float*)take(2 * NMOD * 4);
    p.rope = (float*)take((size_t)NTOK * 128 * 4);
    p.eidx = (int*)take((size_t)NTOK * 128 * 4);
    p.gatev = (float*)take((size_t)NTOK * 128 * 4);
    p.Wt1 = (bf16_t*)take((size_t)ZW * DM * 2);
    p.Wta = (bf16_t*)take((size_t)DM * 1024 * 2);
    p.Wtb = (bf16_t*)take((size_t)DM * DM * 2);
    p.Wto = (bf16_t*)take((size_t)DM * DM * 2);
    p.Wtq = (bf16_t*)take((size_t)DM * DM * 2);
    p.hb = (bf16_t*)take((size_t)NTOK * DM * 2);
    p.ZG = (bf16_t*)take((size_t)NTOK * ZW * 2);
    p.qbuf = (float*)p.ZG;
    p.obuf = (float*)take((size_t)NTOK * DM * 4);
    p.ybin = (bf16_t*)take((size_t)NTOK * DM * 2);
    p.yain = (bf16_t*)take((size_t)NTOK * 1024 * 2);
    p.Ub = (bf16_t*)take((size_t)16384 * DM * 2);
    p.Vb = (bf16_t*)take((size_t)16384 * DM * 2);
    if (off > ws_size) { fprintf(stderr, "kernel_launch: workspace too small: need %zu have %zu\n", off, ws_size); return; }
    static int grid = 0;
    if (!grid) {
        int dev = 0, cus = 0, per_cu = 0;
        (void)hipGetDevice(&dev); (void)hipDeviceGetAttribute(&cus, hipDeviceAttributeMultiprocessorCount, dev);
        (void)hipFuncSetAttribute((const void*)k_mega, hipFuncAttributeMaxDynamicSharedMemorySize, LDS_BYTES);
        (void)hipOccupancyMaxActiveBlocksPerMultiprocessor(&per_cu, k_mega, NTH, LDS_BYTES);
        if (per_cu < 1) per_cu = 1;
        grid = cus * per_cu;
    }
    void* args[] = {&p};
    hipError_t e = hipLaunchCooperativeKernel((const void*)k_mega, dim3(grid), dim3(NTH), args, LDS_BYTES, stream);
    if (e != hipSuccess) fprintf(stderr, "cooperative launch failed: %s (grid %d)\n", hipGetErrorString(e), grid);
}
```

```cpp
#include <hip/hip_runtime.h>
#include <hip/hip_cooperative_groups.h>
#include <stdint.h>
#include <math.h>
#include <cstdio>

namespace cg = cooperative_groups;

constexpr int DM = 2048;
constexpr int SQ = 4096;
constexpr int NTOK = 8192;
constexpr int NTH = 512;
constexpr int ZW = 12288;
constexpr int NMOD = 12288;
constexpr int LDS_BYTES = 136 * 1024;

typedef unsigned short bf16_t;

struct Params {
    const float *x, *c; const int* pos;
    const float *w_ada, *b_ada, *norm1_g, *w_in, *w_bg, *b_bg, *gm_v_g, *gm_ws, *gm_b, *ret_gn_g, *w_a_out, *w_b_out, *w_o, *norm2_g,
                *peer_wq, *peer_sk, *peer_u, *peer_v, *norm_f_g;
    float* out;
    float *ada, *rope, *gatev; int* eidx;
    bf16_t *Wt1, *Wta, *Wtb, *Wto, *Wtq;
    bf16_t *hb;
    bf16_t *ZG;
    float *obuf;
    bf16_t *ybin, *yain;
    float *qbuf;
    bf16_t *Ub, *Vb;
    bf16_t *Qr, *Kr, *KTd, *Vt;
    bf16_t *ob16;
};

__constant__ float c_freq[64] = {
1.000000000e+00f, 8.659643531e-01f, 7.498942018e-01f, 6.493816376e-01f, 5.623413324e-01f, 4.869675338e-01f, 4.216965139e-01f, 3.651741147e-01f, 3.162277639e-01f, 2.738419771e-01f, 2.371373773e-01f, 2.053525001e-01f, 1.778279394e-01f, 1.539926529e-01f, 1.333521456e-01f, 1.154781953e-01f, 1.000000015e-01f, 8.659642935e-02f, 7.498942316e-02f, 6.493816525e-02f, 5.623413250e-02f, 4.869675264e-02f, 4.216964915e-02f, 3.651741147e-02f, 3.162277490e-02f, 2.738419548e-02f, 2.371373773e-02f, 2.053525113e-02f, 1.778279431e-02f, 1.539926510e-02f, 1.333521400e-02f, 1.154781971e-02f, 9.999999776e-03f, 8.659643121e-03f, 7.498942316e-03f, 6.493816152e-03f, 5.623413250e-03f, 4.869675264e-03f, 4.216964822e-03f, 3.651741194e-03f, 3.162277630e-03f, 2.738419687e-03f, 2.371373819e-03f, 2.053525066e-03f, 1.778279431e-03f, 1.539926510e-03f, 1.333521446e-03f, 1.154782018e-03f, 1.000000047e-03f, 8.659643354e-04f, 7.498941850e-04f, 6.493816036e-04f, 5.623413017e-04f, 4.869675322e-04f, 4.216965172e-04f, 3.651741135e-04f, 3.162277571e-04f, 2.738419571e-04f, 2.371373703e-04f, 2.053525095e-04f, 1.778279402e-04f, 1.539926598e-04f, 1.333521504e-04f, 1.154782003e-04f };

__device__ __forceinline__ int tid_() { int t = threadIdx.x; asm volatile("" : "+v"(t)); return t; }
__device__ __forceinline__ float wave_sum(float v) {
#pragma unroll
    for (int o = 1; o < 64; o <<= 1) v += __shfl_xor(v, o);
    return v;
}
__device__ __forceinline__ float wave_max(float v) {
#pragma unroll
    for (int o = 1; o < 64; o <<= 1) v = fmaxf(v, __shfl_xor(v, o));
    return v;
}
__device__ __forceinline__ float sigmoidf_(float x) { return 1.0f / (1.0f + expf(-x)); }
__device__ __forceinline__ float siluf_(float x) { return x * sigmoidf_(x); }
__device__ __forceinline__ float geluf_(float x) { return 0.5f * x * (1.0f + erff(x * 0.70710678118654752f)); }
__device__ __forceinline__ float dot4(float4 a, float4 b) { return a.x * b.x + a.y * b.y + a.z * b.z + a.w * b.w; }
__device__ __forceinline__ float bf2f(bf16_t v) { return __uint_as_float((unsigned)v << 16); }
__device__ __forceinline__ float bflo(unsigned w) { return __uint_as_float(w << 16); }
__device__ __forceinline__ float bfhi(unsigned w) { return __uint_as_float(w & 0xffff0000u); }
__device__ __forceinline__ unsigned f2bf(float f) { unsigned u = __float_as_uint(f); return (u + 0x7fffu + ((u >> 16) & 1u)) >> 16; }
__device__ __forceinline__ unsigned pk2(float lo, float hi) { return f2bf(lo) | (f2bf(hi) << 16); }

__device__ __forceinline__ void sincos_acc(float ang, float& s, float& c) {
    const double x = (double)ang;
    const double k = rint(x * 0.63661977236758134308);
    double r = fma(-k, 1.57079632679489655800, x); r = fma(-k, 6.12323399573676603587e-17, r);
    const double r2 = r * r;
    const double sp = r * (1.0 + r2 * (-1.0 / 6.0 + r2 * (1.0 / 120.0 + r2 * (-1.0 / 5040.0 + r2 * (1.0 / 362880.0 + r2 * (-1.0 / 39916800.0 + r2 * (1.0 / 6227020800.0)))))));
    const double cp = 1.0 + r2 * (-0.5 + r2 * (1.0 / 24.0 + r2 * (-1.0 / 720.0 + r2 * (1.0 / 40320.0 + r2 * (-1.0 / 3628800.0 + r2 * (1.0 / 479001600.0 + r2 * (-1.0 / 87178291200.0)))))));
    const int q = ((int)k) & 3;
    const float fs = (float)sp, fc = (float)cp;
    s = (q == 0) ? fs : (q == 1) ? fc : (q == 2) ? -fs : -fc;
    c = (q == 0) ? fc : (q == 1) ? -fs : (q == 2) ? -fc : fs;
}

namespace pg8 {
#define PG8_LAS __attribute__((address_space(3)))
typedef unsigned short bf16_t;
typedef short bf16x8 __attribute__((ext_vector_type(8)));
typedef float f32x4 __attribute__((ext_vector_type(4)));
typedef unsigned u32x4 __attribute__((ext_vector_type(4)));
constexpr int BM = 256, BK = 64, HALF = 128, HTB = HALF * BK * 2  , STAGE_BYTES = 8 * HTB, NXCD = 8, WGM = 8;

__host__ __device__ __forceinline__ int lds_byte(int r, int c) { const int st = (r >> 4) * 2 + (c >> 5), rr = r & 15, cc = c & 31, ob = rr * 64 + cc * 2; return st * 1024 + (ob ^ (((ob >> 9) & 1) << 5)); }
__host__ __device__ __forceinline__ void stage_rc(int b, int& R, int& C) { const int st = b / 1024, sb = b % 1024, swz = sb ^ (((sb >> 9) & 1) << 5); R = (st >> 1) * 16 + swz / 64; C = (st & 1) * 32 + (swz % 64) / 2; }
__host__ __device__ __forceinline__ int perm32(int rho) { const int n = rho >> 4, i = rho & 15; return 8 * (i >> 2) + 4 * n + (i & 3); }

struct Unit { int pm, pn; };
struct Gemm { const bf16_t* A; const bf16_t* Bt; int M, N, K; };

struct StaticOrder {
    int nM, nN, nwg, G, c;
    __host__ __device__ void init(int M, int N, int G_, int c_) { nM = M / BM; nN = N / BM; nwg = nM * nN; G = G_; c = c_; }
    __host__ __device__ bool next(int i, Unit& u) const {
        const long L = (long)i * G + c; if (L >= nwg) return false;
        int wgid = (int)L; { const int q = nwg / NXCD, r = nwg % NXCD, xcd = wgid % NXCD, off = wgid / NXCD; wgid = (xcd < r ? xcd * (q + 1) : r * (q + 1) + (xcd - r) * q) + off; }
        const int nig = WGM * nN, gid = wgid / nig, fm = gid * WGM, gsz = (nM - fm) < WGM ? (nM - fm) : WGM;
        u.pm = fm + ((wgid % nig) % gsz); u.pn = (wgid % nig) / gsz; return true;
    }
    __device__ __forceinline__ void a_ready(const Unit&) const {}
    __device__ __forceinline__ void done(const Unit&) const {}
};

__device__ __forceinline__ unsigned cvt_pk_bf16(float lo, float hi) { unsigned r; asm volatile("v_cvt_pk_bf16_f32 %0, %1, %2" : "=v"(r) : "v"(lo), "v"(hi)); return r; }
typedef float f32x2 __attribute__((ext_vector_type(2)));
__device__ __forceinline__ f32x2 gelu_pk(f32x2 v) {
    const f32x2 av = __builtin_elementwise_abs(v), d = av * 0.2316418882f + 1.0f;
    f32x2 t; t.x = __builtin_amdgcn_rcpf(d.x); t.y = __builtin_amdgcn_rcpf(d.y);
    f32x2 q = t * 0.5307027145f + (-0.7265760135f); q = q * t + 0.7107068705f; q = q * t + (-0.142248368f); q = q * t + 0.127414796f; q = q * t;
    const f32x2 s = (v * v) * (-0.72134752044f);
    f32x2 e; e.x = __builtin_amdgcn_exp2f(s.x); e.y = __builtin_amdgcn_exp2f(s.y);
    const f32x2 m = v * (q * e), r = v - m;
    f32x2 o; o.x = v.x < 0.f ? m.x : r.x; o.y = v.y < 0.f ? m.y : r.y; return o;
}

typedef unsigned u32x2v __attribute__((ext_vector_type(2)));
struct EpiZG {
    static constexpr bool PERM = true, AFTER_DRAIN = false;
    bf16_t* O; const float* bias;
    __device__ __forceinline__ void operator()(const f32x4 (&acc)[2][2][4][2], const Unit& u, int wr, int wc, int fr, int fq) const {
        const int row0 = u.pm * BM + wr * 64 + fr, col0 = u.pn * BM + wc * 32 + 8 * fq;
        const int mode = u.pn < 8 ? 1 : (u.pn < 32 ? 0 : 2);
        f32x4 bv[2][2];
#pragma unroll
        for (int bj = 0; bj < 2; ++bj)
#pragma unroll
            for (int n = 0; n < 2; ++n) bv[bj][n] = (mode == 2) ? *(const f32x4*)(bias + (col0 - 8192) + bj * HALF + 4 * n) : (f32x4){0.f, 0.f, 0.f, 0.f};
#pragma unroll
        for (int ai = 0; ai < 2; ++ai)
#pragma unroll
            for (int m = 0; m < 4; ++m) { bf16_t* rowp = O + (size_t)(row0 + ai * HALF + m * 16) * ZW + col0;
#pragma unroll
                for (int bj = 0; bj < 2; ++bj) { f32x4 v0 = acc[ai][bj][m][0], v1 = acc[ai][bj][m][1];
                    if (mode == 1) { f32x2 a = gelu_pk((f32x2){v0[0], v0[1]}), b = gelu_pk((f32x2){v0[2], v0[3]}), c = gelu_pk((f32x2){v1[0], v1[1]}), d = gelu_pk((f32x2){v1[2], v1[3]});
                        v0 = (f32x4){a.x, a.y, b.x, b.y}; v1 = (f32x4){c.x, c.y, d.x, d.y}; }
                    if (mode == 2) { v0 = v0 + bv[bj][0]; v1 = v1 + bv[bj][1];
#pragma unroll
                        for (int e = 0; e < 4; ++e) { v0[e] = __builtin_amdgcn_rcpf(1.0f + __expf(-v0[e])); v1[e] = __builtin_amdgcn_rcpf(1.0f + __expf(-v1[e])); } }
                    u32x4 w; w.x = cvt_pk_bf16(v0[0], v0[1]); w.y = cvt_pk_bf16(v0[2], v0[3]); w.z = cvt_pk_bf16(v1[0], v1[1]); w.w = cvt_pk_bf16(v1[2], v1[3]);
                    *(u32x4*)(rowp + bj * HALF) = w; } }
    }
};
template <int ACCUM> struct EpiMixB {
    static constexpr bool PERM = true, AFTER_DRAIN = false;
    bf16_t* Mo; const bf16_t* ZGp; int goff;
    __device__ __forceinline__ void operator()(const f32x4 (&acc)[2][2][4][2], const Unit& u, int wr, int wc, int fr, int fq) const {
        const int row0 = u.pm * BM + wr * 64 + fr, col0 = u.pn * BM + wc * 32 + 8 * fq;
#pragma unroll
        for (int ai = 0; ai < 2; ++ai)
#pragma unroll
            for (int m = 0; m < 4; ++m) { const size_t row = (size_t)(row0 + ai * HALF + m * 16);
#pragma unroll
                for (int bj = 0; bj < 2; ++bj) { const f32x4 v0 = acc[ai][bj][m][0], v1 = acc[ai][bj][m][1];
                    const u32x4 g = *(const u32x4*)(ZGp + row * ZW + 8192 + goff + col0 + bj * HALF);
                    float o[8];
                    o[0] = bflo(g.x) * v0[0]; o[1] = bfhi(g.x) * v0[1]; o[2] = bflo(g.y) * v0[2]; o[3] = bfhi(g.y) * v0[3];
                    o[4] = bflo(g.z) * v1[0]; o[5] = bfhi(g.z) * v1[1]; o[6] = bflo(g.w) * v1[2]; o[7] = bfhi(g.w) * v1[3];
                    bf16_t* mp = Mo + row * DM + col0 + bj * HALF;
                    if (ACCUM) { const u32x4 old = *(const u32x4*)mp;
                        o[0] += bflo(old.x); o[1] += bfhi(old.x); o[2] += bflo(old.y); o[3] += bfhi(old.y); o[4] += bflo(old.z); o[5] += bfhi(old.z); o[6] += bflo(old.w); o[7] += bfhi(old.w); }
                    u32x4 w; w.x = cvt_pk_bf16(o[0], o[1]); w.y = cvt_pk_bf16(o[2], o[3]); w.z = cvt_pk_bf16(o[4], o[5]); w.w = cvt_pk_bf16(o[6], o[7]);
                    *(u32x4*)mp = w; } }
    }
};
struct EpiResF {
    static constexpr bool PERM = false, AFTER_DRAIN = false;
    float* x1; const float* x; const float* ga;
    __device__ __forceinline__ void operator()(const f32x4 (&acc)[2][2][4][2], const Unit& u, int wr, int wc, int fr, int fq) const {
        const int row0 = u.pm * BM + wr * 64 + fr, col0 = u.pn * BM + wc * 32 + 4 * fq;
        const int b = (u.pm * BM) / SQ;
        f32x4 gv[2][2];
#pragma unroll
        for (int bj = 0; bj < 2; ++bj)
#pragma unroll
            for (int n = 0; n < 2; ++n) gv[bj][n] = *(const f32x4*)(ga + b * NMOD + col0 + bj * HALF + n * 16);
#pragma unroll
        for (int ai = 0; ai < 2; ++ai)
#pragma unroll
            for (int m = 0; m < 4; ++m) { const size_t off = (size_t)(row0 + ai * HALF + m * 16) * DM + col0;
#pragma unroll
                for (int bj = 0; bj < 2; ++bj)
#pragma unroll
                    for (int n = 0; n < 2; ++n) { const f32x4 xv = *(const f32x4*)(x + off + bj * HALF + n * 16);
                        *(f32x4*)(x1 + off + bj * HALF + n * 16) = xv + gv[bj][n] * acc[ai][bj][m][n]; } }
    }
};
struct EpiF32 {
    static constexpr bool PERM = false, AFTER_DRAIN = false;
    float* O; int ldc;
    __device__ __forceinline__ void operator()(const f32x4 (&acc)[2][2][4][2], const Unit& u, int wr, int wc, int fr, int fq) const {
        const int row0 = u.pm * BM + wr * 64 + fr, col0 = u.pn * BM + wc * 32 + 4 * fq;
#pragma unroll
        for (int ai = 0; ai < 2; ++ai)
#pragma unroll
            for (int m = 0; m < 4; ++m) { const size_t off = (size_t)(row0 + ai * HALF + m * 16) * ldc + col0;
#pragma unroll
                for (int bj = 0; bj < 2; ++bj)
#pragma unroll
                    for (int n = 0; n < 2; ++n) *(f32x4*)(O + off + bj * HALF + n * 16) = acc[ai][bj][m][n]; }
    }
};

template <class Epi, class Sched, bool ALIGN_EPI = false, bool SP2 = false>
__device__ __forceinline__ void gemm_phase(PG8_LAS unsigned char* lds, const Gemm g, const Sched& S, const Epi& E) {
    const int tid = threadIdx.x, wid = __builtin_amdgcn_readfirstlane(tid >> 6), lane = tid & 63, wr = wid >> 2, wc = wid & 3, fr = lane & 15, fq = lane >> 4;
    const int K = g.K, nt = K / BK;
    unsigned voffA[2], voffB[2];
#pragma unroll
    for (int i = 0; i < 2; ++i) { int R, C; stage_rc(tid * 16 + i * 8192, R, C); const int Rb = Epi::PERM ? ((R & ~31) + perm32(R & 31)) : R;
        voffA[i] = (unsigned)(R * K + C) * 2u; voffB[i] = (unsigned)(Rb * K + C) * 2u; }
    const size_t kstep = (size_t)(BK * 2);
    const size_t hstep = (size_t)HALF * K * 2;
    const size_t tstep = 2 * hstep;
    const unsigned ldsw = (unsigned)wid * 1024u;
    const int aoff = lds_byte(wr * 64 + fr, fq * 8), boff = lds_byte(wc * 32 + fr, fq * 8);
#define PG8_SA(b, h) (((b) * 2 + (h)) * HTB)
#define PG8_SB(b, h) ((4 + (b) * 2 + (h)) * HTB)
#define PG8_STAGE(bufoff, gbase, voff) do { _Pragma("unroll") for (int _i = 0; _i < 2; ++_i) \
        __builtin_amdgcn_global_load_lds((const unsigned*)((const char*)(gbase) + (voff)[_i]), (PG8_LAS unsigned*)(lds + (bufoff) + ldsw + _i * 8192), 16, 0, 0); } while (0)
#define PG8_LDA(dst, b, h) do { _Pragma("unroll") for (int m = 0; m < 4; ++m) _Pragma("unroll") for (int k = 0; k < 2; ++k) dst[m][k] = *(const PG8_LAS bf16x8*)(lds + PG8_SA(b, h) + aoff + m * 2048 + k * 1024); } while (0)
#define PG8_LDB(dst, b, h) do { _Pragma("unroll") for (int n = 0; n < 2; ++n) _Pragma("unroll") for (int k = 0; k < 2; ++k) dst[n][k] = *(const PG8_LAS bf16x8*)(lds + PG8_SB(b, h) + boff + n * 2048 + k * 1024); } while (0)
#define PG8_MMA(ai, bj, At, Bt) do { __builtin_amdgcn_s_setprio(1); _Pragma("unroll") for (int m = 0; m < 4; ++m) _Pragma("unroll") for (int n = 0; n < 2; ++n) _Pragma("unroll") for (int k = 0; k < 2; ++k) \
        acc[ai][bj][m][n] = __builtin_amdgcn_mfma_f32_16x16x32_bf16(Bt[n][k], At[m][k], acc[ai][bj][m][n], 0, 0, 0); __builtin_amdgcn_s_setprio(0); } while (0)
#define PG8_WAIT_V(n) asm volatile("s_waitcnt vmcnt(" #n ")" ::: "memory")
#define PG8_WAIT_L(n) asm volatile("s_waitcnt lgkmcnt(" #n ")" ::: "memory")
#define PG8_BAR __builtin_amdgcn_s_barrier()
#define PG8_SCHED __builtin_amdgcn_sched_barrier(0)
    Unit cur, nxt; int ui = 0;
    if (!S.next(0, cur)) return;
    f32x4 acc[2][2][4][2];
#pragma unroll
    for (int a = 0; a < 2; ++a)
#pragma unroll
        for (int b = 0; b < 2; ++b)
#pragma unroll
            for (int m = 0; m < 4; ++m)
#pragma unroll
                for (int n = 0; n < 2; ++n) acc[a][b][m][n] = (f32x4){0.f, 0.f, 0.f, 0.f};
    bf16x8 At[4][2], B0[2][2], B1[2][2];
    const char* cA = (const char*)g.A + (size_t)cur.pm * tstep; const char* cB = (const char*)g.Bt + (size_t)cur.pn * tstep;
    S.a_ready(cur);
    if constexpr (SP2) {
        PG8_STAGE(PG8_SB(0, 0), cB, voffB); PG8_STAGE(PG8_SB(0, 1), cB + hstep, voffB); PG8_STAGE(PG8_SA(0, 0), cA, voffA); PG8_STAGE(PG8_SA(0, 1), cA + hstep, voffA);
        if (wr == 1) PG8_BAR;
        PG8_WAIT_V(2); PG8_BAR;
        PG8_STAGE(PG8_SB(1, 0), cB + kstep, voffB); PG8_STAGE(PG8_SA(1, 0), cA + kstep, voffA); PG8_STAGE(PG8_SB(1, 1), cB + hstep + kstep, voffB);
        PG8_WAIT_V(6); PG8_BAR;
    } else {
        PG8_STAGE(PG8_SB(0, 0), cB, voffB); PG8_STAGE(PG8_SA(0, 0), cA, voffA); PG8_STAGE(PG8_SB(0, 1), cB + hstep, voffB); PG8_STAGE(PG8_SA(0, 1), cA + hstep, voffA);
        if (wr == 1) PG8_BAR;
        PG8_WAIT_V(4); PG8_BAR;
        PG8_STAGE(PG8_SB(1, 0), cB + kstep, voffB); PG8_STAGE(PG8_SA(1, 0), cA + kstep, voffA); PG8_STAGE(PG8_SB(1, 1), cB + hstep + kstep, voffB);
        PG8_WAIT_V(6); PG8_BAR;
    }
    for (;;) {
        const bool has_next = S.next(ui + 1, nxt);
        const char* nA = has_next ? (const char*)g.A + (size_t)nxt.pm * tstep : cA; const char* nB = has_next ? (const char*)g.Bt + (size_t)nxt.pn * tstep : cB;
        for (int t = 0; t < nt; t += 2) {
            const bool last = (t == nt - 2);
            const char* a1 = cA + (size_t)(t + 1) * kstep;
            const char* a2 = last ? nA : cA + (size_t)(t + 2) * kstep; const char* b2 = last ? nB : cB + (size_t)(t + 2) * kstep;
            const char* a3 = a2 + kstep; const char* b3 = b2 + kstep;
            if (last && has_next) S.a_ready(nxt);
            if constexpr (SP2) {
            PG8_LDB(B0, 0, 0); PG8_LDB(B1, 0, 1); PG8_SCHED; PG8_LDA(At, 0, 0); PG8_STAGE(PG8_SA(1, 1), a1 + hstep, voffA);
            PG8_WAIT_V(8); PG8_WAIT_L(0); PG8_BAR; PG8_MMA(0, 0, At, B0); PG8_MMA(0, 1, At, B1); PG8_BAR; PG8_SCHED;
            PG8_LDA(At, 0, 1); PG8_STAGE(PG8_SB(0, 0), b2, voffB); PG8_STAGE(PG8_SB(0, 1), b2 + hstep, voffB); PG8_STAGE(PG8_SA(0, 0), a2, voffA);
            PG8_WAIT_V(8); PG8_WAIT_L(0); PG8_BAR; PG8_MMA(1, 0, At, B0); PG8_MMA(1, 1, At, B1); PG8_BAR; PG8_SCHED;
            PG8_LDB(B0, 1, 0); PG8_LDB(B1, 1, 1); PG8_SCHED; PG8_LDA(At, 1, 0); PG8_STAGE(PG8_SA(0, 1), a2 + hstep, voffA);
            PG8_WAIT_V(8); PG8_WAIT_L(0); PG8_BAR; PG8_MMA(0, 0, At, B0); PG8_MMA(0, 1, At, B1); PG8_BAR; PG8_SCHED;
            PG8_LDA(At, 1, 1); PG8_STAGE(PG8_SB(1, 0), b3, voffB); PG8_STAGE(PG8_SB(1, 1), b3 + hstep, voffB); PG8_STAGE(PG8_SA(1, 0), a3, voffA);
            PG8_WAIT_V(8); PG8_WAIT_L(0); PG8_BAR; PG8_MMA(1, 0, At, B0); PG8_MMA(1, 1, At, B1); PG8_BAR; PG8_SCHED;
            } else {
            PG8_LDB(B0, 0, 0); PG8_SCHED; PG8_LDA(At, 0, 0); PG8_STAGE(PG8_SA(1, 1), a1 + hstep, voffA);
            PG8_WAIT_L(8); PG8_BAR; PG8_WAIT_L(0); PG8_MMA(0, 0, At, B0); PG8_BAR; PG8_SCHED;
            PG8_LDB(B1, 0, 1); PG8_STAGE(PG8_SB(0, 0), b2, voffB);
            PG8_BAR; PG8_WAIT_L(0); PG8_MMA(0, 1, At, B1); PG8_BAR;
            PG8_LDA(At, 0, 1); PG8_STAGE(PG8_SA(0, 0), a2, voffA);
            PG8_BAR; PG8_WAIT_L(0); PG8_MMA(1, 0, At, B0); PG8_BAR; PG8_SCHED;
            PG8_STAGE(PG8_SB(0, 1), b2 + hstep, voffB);
            PG8_WAIT_V(6); PG8_BAR; PG8_MMA(1, 1, At, B1); PG8_BAR;
            PG8_LDB(B0, 1, 0); PG8_SCHED; PG8_LDA(At, 1, 0); PG8_STAGE(PG8_SA(0, 1), a2 + hstep, voffA);
            PG8_WAIT_L(8); PG8_BAR; PG8_WAIT_L(0); PG8_MMA(0, 0, At, B0); PG8_BAR; PG8_SCHED;
            PG8_LDB(B1, 1, 1); PG8_STAGE(PG8_SB(1, 0), b3, voffB);
            PG8_BAR; PG8_WAIT_L(0); PG8_MMA(0, 1, At, B1); PG8_BAR;
            PG8_LDA(At, 1, 1); PG8_STAGE(PG8_SA(1, 0), a3, voffA);
            PG8_BAR; PG8_WAIT_L(0); PG8_MMA(1, 0, At, B0); PG8_BAR; PG8_SCHED;
            PG8_STAGE(PG8_SB(1, 1), b3 + hstep, voffB);
            PG8_WAIT_V(6); PG8_BAR; PG8_MMA(1, 1, At, B1); PG8_BAR;
            }
        }
        if constexpr (ALIGN_EPI) { if (wr == 0) PG8_BAR; }
        if constexpr (!Epi::AFTER_DRAIN) { E(acc, cur, wr, wc, fr, fq); S.done(cur); }
        if (!has_next) break;
#pragma unroll
        for (int a = 0; a < 2; ++a)
#pragma unroll
            for (int b = 0; b < 2; ++b)
#pragma unroll
                for (int m = 0; m < 4; ++m)
#pragma unroll
                    for (int n = 0; n < 2; ++n) acc[a][b][m][n] = (f32x4){0.f, 0.f, 0.f, 0.f};
        cur = nxt; cA = nA; cB = nB; ++ui;
        if constexpr (ALIGN_EPI) { if (wr == 1) PG8_BAR; }
    }
    PG8_WAIT_V(0);
    if constexpr (!ALIGN_EPI) { if (wr == 0) PG8_BAR; }
    PG8_BAR;
    if constexpr (Epi::AFTER_DRAIN) { E.fused(acc, cur, wr, wc, fr, fq, lds, wid, lane); S.done(cur); }
#undef PG8_SA
#undef PG8_SB
#undef PG8_STAGE
#undef PG8_LDA
#undef PG8_LDB
#undef PG8_MMA
#undef PG8_WAIT_V
#undef PG8_WAIT_L
#undef PG8_BAR
#undef PG8_SCHED
}
}
using pg8::f32x4; using pg8::u32x4;

__device__ __forceinline__ void transpose_item(const float* W, int K, int N, bf16_t* WT, int row_off, float* scr, int item, int lane) {
    const int nblk = N / 32, kb = item / nblk, nbk = item % nblk, k0 = 64 * kb, n0 = 32 * nbk;
#pragma unroll 8
    for (int i = 0; i < 32; ++i) { const int kk = 2 * i + (lane >> 5); scr[kk * 33 + (lane & 31)] = W[(size_t)(k0 + kk) * N + n0 + (lane & 31)]; }
    asm volatile("s_waitcnt lgkmcnt(0)" ::: "memory");
    const int c = lane & 7;
#pragma unroll
    for (int j = 0; j < 4; ++j) { const int n = (lane >> 3) + 8 * j; const float* s = scr + (8 * c) * 33 + n;
        uint4 o; o.x = pk2(s[0 * 33], s[1 * 33]); o.y = pk2(s[2 * 33], s[3 * 33]); o.z = pk2(s[4 * 33], s[5 * 33]); o.w = pk2(s[6 * 33], s[7 * 33]);
        *(uint4*)(WT + (size_t)(row_off + n0 + n) * K + k0 + 8 * c) = o; }
    asm volatile("s_waitcnt lgkmcnt(0)" ::: "memory");
}
__device__ __forceinline__ void ph_prep(const Params& p, int bid, int nb, float* lds) {
    const int tid = tid_(), wave = tid >> 6, lane = tid & 63;
    {
        float* sl = lds;
        float* red = lds + 4096;
        for (int i = tid; i < 4096; i += NTH) sl[i] = siluf_(p.c[i]);
        __syncthreads();
        for (int it = bid; it < 192; it += nb) {
            const int c4 = tid & 15, kg = tid >> 4;
            const float* wp = p.w_ada + (size_t)kg * NMOD + it * 64 + c4 * 4;
            float a0[4] = {0.f, 0.f, 0.f, 0.f}, a1[4] = {0.f, 0.f, 0.f, 0.f};
#pragma unroll 8
            for (int i = 0; i < 64; ++i) {
                const int k = kg + 32 * i;
                const float4 w = *(const float4*)(wp + (size_t)(32 * i) * NMOD);
                const float s0 = sl[k], s1 = sl[2048 + k];
                a0[0] += s0 * w.x; a0[1] += s0 * w.y; a0[2] += s0 * w.z; a0[3] += s0 * w.w;
                a1[0] += s1 * w.x; a1[1] += s1 * w.y; a1[2] += s1 * w.z; a1[3] += s1 * w.w;
            }
            __syncthreads();
#pragma unroll
            for (int e = 0; e < 4; ++e) { red[(kg * 16 + c4) * 8 + e] = a0[e]; red[(kg * 16 + c4) * 8 + 4 + e] = a1[e]; }
            __syncthreads();
            if (tid < 128) {
                const int b = tid >> 6, col = tid & 63;
                float s = 0.f;
                for (int g = 0; g < 32; ++g) s += red[(g * 16 + (col >> 2)) * 8 + b * 4 + (col & 3)];
                p.ada[b * NMOD + it * 64 + col] = s + p.b_ada[it * 64 + col];
            }
        }
        __syncthreads();
    }
    for (int e = bid * NTH + tid; e < NTOK * 64; e += nb * NTH) {
        const int tok = e >> 6, j = e & 63;
        const float ang = (float)p.pos[tok] * c_freq[j];
        float s, c; sincos_acc(ang, s, c);
        p.rope[(size_t)e * 2] = c; p.rope[(size_t)e * 2 + 1] = s;
    }
    {
        float* scr = lds + wave * (64 * 33);
        const int gw = bid * 8 + wave, ngw = nb * 8;
        constexpr int I1 = 32 * 256, I2 = 32 * 128, I3 = 16 * 64, I4 = 32 * 64;
        constexpr int NIT = I1 + I2 + I3 + 3 * I4;
        for (int it = gw; it < NIT; it += ngw) {
            int r = it;
            if (r < I1) { transpose_item(p.w_in, 2048, 8192, p.Wt1, 0, scr, r, lane); continue; } r -= I1;
            if (r < I2) { transpose_item(p.w_bg, 2048, 4096, p.Wt1, 8192, scr, r, lane); continue; } r -= I2;
            if (r < I3) { transpose_item(p.w_a_out, 1024, 2048, p.Wta, 0, scr, r, lane); continue; } r -= I3;
            if (r < I4) { transpose_item(p.w_b_out, 2048, 2048, p.Wtb, 0, scr, r, lane); continue; } r -= I4;
            if (r < I4) { transpose_item(p.w_o, 2048, 2048, p.Wto, 0, scr, r, lane); continue; } r -= I4;
            transpose_item(p.peer_wq, 2048, 2048, p.Wtq, 0, scr, r, lane);
        }
    }
    __syncthreads();
}
__device__ __forceinline__ void ph_tabconv(const Params& p, int bid, int nb) {
    const int tid = tid_();
    const size_t n8 = (size_t)16384 * 2048 / 8;
    for (size_t i = (size_t)bid * NTH + tid; i < 2 * n8; i += (size_t)nb * NTH) {
        const bool second = i >= n8; const size_t j = second ? i - n8 : i;
        const float4* src = (const float4*)((second ? p.peer_v : p.peer_u) + j * 8);
        const float4 a = src[0], b = src[1];
        *(uint4*)((second ? p.Vb : p.Ub) + j * 8) = make_uint4(pk2(a.x, a.y), pk2(a.z, a.w), pk2(b.x, b.y), pk2(b.z, b.w));
    }
}

__device__ __forceinline__ void ph_modnorm(const Params& p, const float* xin, const float* g, int sh_off, int sc_off, bf16_t* hout, int bid, int nb, float* lds) {
    const int tid = tid_(), wave = tid >> 6, lane = tid & 63;
    for (int row = bid * 8 + wave; row < NTOK; row += nb * 8) {
        const int b = row / SQ;
        const float4* xr = (const float4*)(xin + (size_t)row * DM);
        float4 v[8]; float ss = 0.f;
#pragma unroll
        for (int j = 0; j < 8; ++j) { v[j] = xr[lane + 64 * j]; ss += dot4(v[j], v[j]); }
        ss = wave_sum(ss);
        const float rs = 1.0f / sqrtf(ss * (1.0f / DM) + 1e-6f);
#pragma unroll
        for (int j = 0; j < 8; ++j) {
            const int col = (lane + 64 * j) * 4;
            const float4 g4 = *(const float4*)(g + col);
            const float4 sc = *(const float4*)(p.ada + b * NMOD + sc_off + col);
            const float4 sh = *(const float4*)(p.ada + b * NMOD + sh_off + col);
            float4 o;
            o.x = v[j].x * rs * g4.x * (1.0f + sc.x) + sh.x; o.y = v[j].y * rs * g4.y * (1.0f + sc.y) + sh.y;
            o.z = v[j].z * rs * g4.z * (1.0f + sc.z) + sh.z; o.w = v[j].w * rs * g4.w * (1.0f + sc.w) + sh.w;
            *(uint2*)(hout + (size_t)row * DM + col) = make_uint2(pk2(o.x, o.y), pk2(o.z, o.w));
        }
    }
}

__device__ __forceinline__ void ph_gmlp(const Params& p, int bid, int nb, float* lds) {
    float* vt = lds;
    float* wm = lds + 16384;
    const bf16_t* z = p.ZG;
    const int tid = tid_(), wave = tid >> 6, lane = tid & 63;
    for (int it = bid; it < 512; it += nb) {
        const int g = it & 7, n = (it >> 3) & 31, b = it >> 8;
        const int tok0 = b * SQ + n * 128;
        __syncthreads();
        for (int i = tid; i < 16384; i += NTH) { const int ii = i >> 7, jj = i & 127; wm[i] = ((ii >> 6) >= (jj >> 6)) ? p.gm_ws[g * 16384 + i] : 0.f; }
        for (int j = wave; j < 128; j += 8) {
            const bf16_t* zr = z + (size_t)(tok0 + j) * ZW + 1024 + g * 128;
            const float a = bf2f(zr[lane]), c2 = bf2f(zr[lane + 64]);
            const float ss = wave_sum(a * a + c2 * c2);
            const float rs = 1.0f / sqrtf(ss * (1.0f / 128.0f) + 1e-6f);
            vt[j * 128 + lane] = a * rs * p.gm_v_g[g * 128 + lane];
            vt[j * 128 + lane + 64] = c2 * rs * p.gm_v_g[g * 128 + lane + 64];
        }
        __syncthreads();
        const int d = tid & 127, ig = tid >> 7;
        float acc[32];
#pragma unroll
        for (int ii = 0; ii < 32; ++ii) acc[ii] = 0.f;
        for (int j = 0; j < 128; ++j) {
            const float vv = vt[j * 128 + d];
#pragma unroll
            for (int ii = 0; ii < 32; ++ii) acc[ii] += wm[(ig * 32 + ii) * 128 + j] * vv;
        }
#pragma unroll
        for (int ii = 0; ii < 32; ++ii) {
            const int i = ig * 32 + ii;
            const float s = acc[ii] + p.gm_b[g * 128 + i];
            const size_t tok = (size_t)(tok0 + i);
            const float u = bf2f(z[tok * ZW + g * 128 + d]);
            p.yain[tok * 1024 + g * 128 + d] = (bf16_t)f2bf(u * s);
        }
    }
    __syncthreads();
}

__device__ __forceinline__ void ph_ret(const Params& p, int bid, int nb, float* lds) {
    float* Qs = lds;
    float* Ks = Qs + 64 * 129;
    float* Vs = Ks + 64 * 129;
    float* Ss = Vs + 64 * 16;
    float* At = Ss + 128 * 16;
    float* kd = At + 64 * 65;
    const int tid = tid_();
    const bf16_t* z = p.ZG;
    for (int it = bid; it < 256; it += nb) {
        const int vs = it & 15, h = (it >> 4) & 7, b = it >> 7;
        const float lg = log1pf(-exp2f(-5.0f - (float)h));
        const float cdec = expf(lg * 64.0f);
        __syncthreads();
        for (int i = tid; i < 2048; i += NTH) Ss[i] = 0.f;
        if (tid < 64) kd[tid] = expf(lg * (float)(63 - tid));
        for (int n = 0; n < 64; ++n) {
            const int tok0 = b * SQ + n * 64;
            __syncthreads();
            for (int e = tid; e < 4096; e += NTH) {
                const int i = e >> 6, dd = e & 63; const size_t tok = (size_t)(tok0 + i);
                const float cs = p.rope[(tok * 64 + dd) * 2], sn = p.rope[(tok * 64 + dd) * 2 + 1];
                const bf16_t* zr = z + tok * ZW;
                const float q1 = bf2f(zr[2048 + h * 128 + dd]), q2 = bf2f(zr[2048 + h * 128 + 64 + dd]);
                const float k1 = bf2f(zr[3072 + h * 128 + dd]), k2 = bf2f(zr[3072 + h * 128 + 64 + dd]);
                Qs[i * 129 + dd] = q1 * cs - q2 * sn; Qs[i * 129 + 64 + dd] = q1 * sn + q2 * cs;
                const float sc = 0.08838834764831845f;
                Ks[i * 129 + dd] = (k1 * cs - k2 * sn) * sc; Ks[i * 129 + 64 + dd] = (k1 * sn + k2 * cs) * sc;
            }
            for (int e = tid; e < 1024; e += NTH) { const int j = e >> 4, v = e & 15; Vs[e] = bf2f(z[(size_t)(tok0 + j) * ZW + 4096 + h * 256 + vs * 16 + v]); }
            __syncthreads();
            {
                const int j = tid & 63, i0 = (tid >> 6) * 8;
                float acc[8];
#pragma unroll
                for (int ii = 0; ii < 8; ++ii) acc[ii] = 0.f;
                for (int d = 0; d < 128; ++d) {
                    const float kv = Ks[j * 129 + d];
#pragma unroll
                    for (int ii = 0; ii < 8; ++ii) acc[ii] += Qs[(i0 + ii) * 129 + d] * kv;
                }
#pragma unroll
                for (int ii = 0; ii < 8; ++ii) { const int i = i0 + ii; At[i * 65 + j] = acc[ii] * expf(lg * fabsf((float)(i - j))); }
            }
            __syncthreads();
            {
                const int v = tid & 15, i0 = tid >> 4;
#pragma unroll
                for (int rep = 0; rep < 2; ++rep) {
                    const int i = i0 + 32 * rep;
                    float a = 0.f; for (int j = 0; j < 64; ++j) a += At[i * 65 + j] * Vs[j * 16 + v];
                    float c2 = 0.f; for (int d = 0; d < 128; ++d) c2 += Qs[i * 129 + d] * Ss[d * 16 + v];
                    p.obuf[(size_t)(tok0 + i) * DM + h * 256 + vs * 16 + v] = a + c2 * expf(lg * (float)(i + 1));
                }
            }
            __syncthreads();
            {
                const int v = tid & 15, d0 = tid >> 4;
#pragma unroll
                for (int rep = 0; rep < 4; ++rep) {
                    const int d = d0 + 32 * rep;
                    float a = 0.f; for (int j = 0; j < 64; ++j) a += Ks[j * 129 + d] * kd[j] * Vs[j * 16 + v];
                    Ss[d * 16 + v] = Ss[d * 16 + v] * cdec + a;
                }
            }
        }
    }
    __syncthreads();
}

typedef short bf16x8_t __attribute__((ext_vector_type(8)));
typedef float f32x4_t __attribute__((ext_vector_type(4)));

__device__ __forceinline__ void ph_retprep(const Params& p, int bid, int nb, float* lds) {
    bf16_t* Kl = (bf16_t*)lds;
    bf16_t* Vl = Kl + 64 * 130;
    const int tid = tid_();
    for (int it = bid; it < 1024; it += nb) {
        const int n = it & 63, h = (it >> 6) & 7, b = it >> 9;
        const int tok0 = b * SQ + n * 64;
        const size_t rowbase = (size_t)(b * 8 + h) * SQ + n * 64;
        const float lg = log1pf(-exp2f(-5.0f - (float)h));
        __syncthreads();
        for (int e = tid; e < 4096; e += NTH) {
            const int i = e >> 6, dd = e & 63; const size_t tok = (size_t)(tok0 + i);
            const float2 cssn = *(const float2*)(p.rope + (tok * 64 + dd) * 2);
            const float cs = cssn.x, sn = cssn.y;
            const bf16_t* zr = p.ZG + tok * ZW;
            const float q1 = bf2f(zr[2048 + h * 128 + dd]), q2 = bf2f(zr[2048 + h * 128 + 64 + dd]);
            const float k1 = bf2f(zr[3072 + h * 128 + dd]), k2 = bf2f(zr[3072 + h * 128 + 64 + dd]);
            const float sc = 0.08838834764831845f;
            const float qa = q1 * cs - q2 * sn, qb = q1 * sn + q2 * cs, ka = (k1 * cs - k2 * sn) * sc, kb = (k1 * sn + k2 * cs) * sc;
            p.Qr[(rowbase + i) * 128 + dd] = (bf16_t)f2bf(qa); p.Qr[(rowbase + i) * 128 + 64 + dd] = (bf16_t)f2bf(qb);
            p.Kr[(rowbase + i) * 128 + dd] = (bf16_t)f2bf(ka); p.Kr[(rowbase + i) * 128 + 64 + dd] = (bf16_t)f2bf(kb);
            const float kd = expf(lg * (float)(63 - i));
            Kl[i * 130 + dd] = (bf16_t)f2bf(ka * kd); Kl[i * 130 + 64 + dd] = (bf16_t)f2bf(kb * kd);
        }
        for (int e = tid; e < 64 * 128; e += NTH) {
            const int j = e >> 7, vp = e & 127;
            *(unsigned*)(Vl + j * 258 + vp * 2) = *(const unsigned*)(p.ZG + (size_t)(tok0 + j) * ZW + 4096 + h * 256 + vp * 2);
        }
        __syncthreads();
        bf16_t* kt = p.KTd + (size_t)it * 8192;
        for (int e = tid; e < 8192; e += NTH) { const int d = e >> 6, j = e & 63; kt[e] = Kl[j * 130 + d]; }
        bf16_t* vt = p.Vt + (size_t)it * 16384;
        for (int e = tid; e < 16384; e += NTH) { const int v = e >> 6, j = e & 63; vt[e] = Vl[j * 258 + v]; }
    }
    __syncthreads();
}

__device__ __forceinline__ bf16x8_t ldfrag(const char* base, int row, int chunk, int rb, int sm) { return *(const bf16x8_t*)(base + row * rb + ((chunk ^ (row & sm)) << 4)); }
__device__ __forceinline__ void ph_ret2(const Params& p, int bid, int nb, float* lds) {
    char* L = (char*)lds;
    constexpr int OQ = 0, OKK = 16384, OKT = 32768, OVT = 49152, TILE = 51200, OP = 2 * TILE, OST = OP + 8192;
    const int tid = tid_(), wave = tid >> 6, lane = tid & 63, fr = lane & 15, fq = lane >> 4;
    for (int it = bid; it < 256; it += nb) {
        const int vs = it & 15, h = (it >> 4) & 7, b = it >> 7;
        const float lg = log1pf(-exp2f(-5.0f - (float)h));
        const float cdec = expf(lg * 64.0f);
        const size_t bh = (size_t)(b * 8 + h);
        const char* gQ = (const char*)(p.Qr + bh * SQ * 128);
        const char* gK = (const char*)(p.Kr + bh * SQ * 128);
        const char* gKT = (const char*)(p.KTd + bh * 64 * 8192);
        const char* gVt = (const char*)(p.Vt + bh * 64 * 16384) + vs * 16 * 128;
        int lq[2], lkt[2];
#pragma unroll
        for (int u = 0; u < 2; ++u) { const int ci = tid + 512 * u; const int r = ci >> 4, c = ci & 15; lq[u] = r * 256 + ((c ^ (r & 15)) << 4); const int d = ci >> 3, c8 = ci & 7; lkt[u] = d * 128 + ((c8 ^ (d & 7)) << 4); }
        const int lv = (tid >> 3) * 128 + (((tid & 7) ^ ((tid >> 3) & 7)) << 4);
        uint4 sq0, sq1, sk0, sk1, skt0, skt1, sv = make_uint4(0u, 0u, 0u, 0u);
#define RET_LOAD(n_) do { const size_t o0 = (size_t)(n_) * 16384 + (size_t)tid * 16, o1 = o0 + 8192; \
        sq0 = *(const uint4*)(gQ + o0); sq1 = *(const uint4*)(gQ + o1); sk0 = *(const uint4*)(gK + o0); sk1 = *(const uint4*)(gK + o1); skt0 = *(const uint4*)(gKT + o0); skt1 = *(const uint4*)(gKT + o1); \
        if (tid < 128) sv = *(const uint4*)(gVt + (size_t)(n_) * 32768 + tid * 16); } while (0)
#define RET_WRITE(buf_) do { char* B_ = L + (buf_) * TILE; \
        *(uint4*)(B_ + OQ + lq[0]) = sq0; *(uint4*)(B_ + OQ + lq[1]) = sq1; *(uint4*)(B_ + OKK + lq[0]) = sk0; *(uint4*)(B_ + OKK + lq[1]) = sk1; *(uint4*)(B_ + OKT + lkt[0]) = skt0; *(uint4*)(B_ + OKT + lkt[1]) = skt1; \
        if (tid < 128) *(uint4*)(B_ + OVT + lv) = sv; } while (0)
        __syncthreads();
        for (int i = tid; i < 1024; i += NTH) ((unsigned*)(L + OST))[i] = 0u;
        RET_LOAD(0); RET_WRITE(0);
        f32x4_t sacc[2] = {{0.f, 0.f, 0.f, 0.f}, {0.f, 0.f, 0.f, 0.f}};
        for (int n = 0; n < 64; ++n) {
            const int cur = n & 1;
            __syncthreads();
            if (n + 1 < 64) RET_LOAD(n + 1);
            const char* T = L + cur * TILE;
            {
                const int jt = wave >> 1, it0 = 2 * (wave & 1);
                f32x4_t s0 = {0.f, 0.f, 0.f, 0.f}, s1 = {0.f, 0.f, 0.f, 0.f};
#pragma unroll
                for (int ks = 0; ks < 4; ++ks) {
                    const bf16x8_t a = ldfrag(T + OKK, jt * 16 + fr, ks * 4 + fq, 256, 15);
                    const bf16x8_t b0 = ldfrag(T + OQ, it0 * 16 + fr, ks * 4 + fq, 256, 15), b1 = ldfrag(T + OQ, (it0 + 1) * 16 + fr, ks * 4 + fq, 256, 15);
                    s0 = __builtin_amdgcn_mfma_f32_16x16x32_bf16(a, b0, s0, 0, 0, 0);
                    s1 = __builtin_amdgcn_mfma_f32_16x16x32_bf16(a, b1, s1, 0, 0, 0);
                }
                const int j0 = jt * 16 + fq * 4;
#pragma unroll
                for (int tt = 0; tt < 2; ++tt) {
                    const int i = (it0 + tt) * 16 + fr; const f32x4_t sv4 = tt ? s1 : s0; float pv[4];
#pragma unroll
                    for (int r = 0; r < 4; ++r) pv[r] = sv4[r] * __expf(lg * fabsf((float)(i - (j0 + r))));
                    *(uint2*)(L + OP + i * 128 + ((((j0 >> 3)) ^ (i & 7)) << 4) + (j0 & 7) * 2) = make_uint2(pk2(pv[0], pv[1]), pk2(pv[2], pv[3]));
                }
            }
            __syncthreads();
            if (wave < 4) {
                const int itl = wave;
                f32x4_t o1 = {0.f, 0.f, 0.f, 0.f}, o2 = {0.f, 0.f, 0.f, 0.f};
#pragma unroll
                for (int ks = 0; ks < 2; ++ks) o1 = __builtin_amdgcn_mfma_f32_16x16x32_bf16(ldfrag(L + OP, itl * 16 + fr, ks * 4 + fq, 128, 7), ldfrag(T + OVT, fr, ks * 4 + fq, 128, 7), o1, 0, 0, 0);
#pragma unroll
                for (int ks = 0; ks < 4; ++ks) o2 = __builtin_amdgcn_mfma_f32_16x16x32_bf16(ldfrag(T + OQ, itl * 16 + fr, ks * 4 + fq, 256, 15), ldfrag(L + OST + cur * 4096, fr, ks * 4 + fq, 256, 15), o2, 0, 0, 0);
#pragma unroll
                for (int r = 0; r < 4; ++r) { const int i = itl * 16 + fq * 4 + r;
                    p.ob16[(size_t)(b * SQ + n * 64 + i) * DM + h * 256 + vs * 16 + fr] = (bf16_t)f2bf(o1[r] + __expf(lg * (float)(i + 1)) * o2[r]); }
            } else {
#pragma unroll
                for (int u = 0; u < 2; ++u) {
                    const int dt = 2 * (wave - 4) + u;
                    sacc[u] = sacc[u] * cdec;
#pragma unroll
                    for (int ks = 0; ks < 2; ++ks) sacc[u] = __builtin_amdgcn_mfma_f32_16x16x32_bf16(ldfrag(T + OKT, dt * 16 + fr, ks * 4 + fq, 128, 7), ldfrag(T + OVT, fr, ks * 4 + fq, 128, 7), sacc[u], 0, 0, 0);
                    *(uint2*)(L + OST + (cur ^ 1) * 4096 + fr * 256 + (((dt * 2 + (fq >> 1)) ^ fr) << 4) + (fq & 1) * 8) = make_uint2(pk2(sacc[u][0], sacc[u][1]), pk2(sacc[u][2], sacc[u][3]));
                }
            }
            if (n + 1 < 64) RET_WRITE(cur ^ 1);
        }
#undef RET_LOAD
#undef RET_WRITE
    }
    __syncthreads();
}

__device__ __forceinline__ void ph_gn(const Params& p, int bid, int nb, float* lds) {
    const int tid = tid_(), wave = tid >> 6, lane = tid & 63;
    for (int tok = bid * 8 + wave; tok < NTOK; tok += nb * 8) {
#pragma unroll
        for (int h = 0; h < 8; ++h) {
            const uint2 ow = *(const uint2*)(p.ob16 + (size_t)tok * DM + h * 256 + lane * 4);
            const float4 o = make_float4(bflo(ow.x), bfhi(ow.x), bflo(ow.y), bfhi(ow.y));
            const float mu = wave_sum(o.x + o.y + o.z + o.w) * (1.0f / 256.0f);
            const float4 d = make_float4(o.x - mu, o.y - mu, o.z - mu, o.w - mu);
            const float var = wave_sum(dot4(d, d)) * (1.0f / 256.0f);
            const float rs = 1.0f / sqrtf(var + 1e-6f);
            const float4 gn = *(const float4*)(p.ret_gn_g + h * 256 + lane * 4);
            const uint2 gw = *(const uint2*)(p.ZG + (size_t)tok * ZW + 6144 + h * 256 + lane * 4);
            const float g0 = bflo(gw.x), g1 = bfhi(gw.x), g2 = bflo(gw.y), g3 = bfhi(gw.y);
            *(uint2*)(p.ybin + (size_t)tok * DM + h * 256 + lane * 4) =
                make_uint2(pk2(siluf_(g0) * d.x * rs * gn.x, siluf_(g1) * d.y * rs * gn.y), pk2(siluf_(g2) * d.z * rs * gn.z, siluf_(g3) * d.w * rs * gn.w));
        }
    }
}

template <int NL>
__device__ __forceinline__ void wave_top16(float (&v)[NL], const int (&idx)[NL], float& outv, int& outi, int lane) {
    outv = 0.f; outi = 0;
    for (int r = 0; r < 16; ++r) {
        float m = v[0];
#pragma unroll
        for (int u = 1; u < NL; ++u) m = fmaxf(m, v[u]);
        const float wm = wave_max(m);
        const unsigned long long bal = __ballot(m == wm);
        const int owner = __ffsll((long long)bal) - 1;
        int myi = -1;
        if (lane == owner) {
            bool done = false;
#pragma unroll
            for (int u = 0; u < NL; ++u) if (!done && v[u] == wm) { myi = idx[u]; v[u] = -INFINITY; done = true; }
        }
        const int wi = __shfl(myi, owner);
        if (lane == r) { outv = wm; outi = wi; }
    }
}
__device__ __forceinline__ void ph_topk(const Params& p, const float* qb, int bid, int nb, float* lds) {
    const int tid = tid_(), wave = tid >> 6, lane = tid & 63;
    for (int t = bid; t < NTOK; t += nb) {
        const int h = wave;
        const float* q = qb + (size_t)t * DM + h * 256;
        float s[2][2];
#pragma unroll
        for (int pp = 0; pp < 2; ++pp)
#pragma unroll
            for (int r = 0; r < 2; ++r) {
                const int n = lane + 64 * r;
                const float4* kr = (const float4*)(p.peer_sk + ((size_t)(h * 2 + pp) * 128 + n) * 128);
                const float4* qr = (const float4*)(q + pp * 128);
                float a = 0.f;
#pragma unroll 4
                for (int d4 = 0; d4 < 32; ++d4) a += dot4(kr[d4], qr[d4]);
                s[pp][r] = a;
            }
        float v1, v2; int i1, i2;
        { float vv[2] = {s[0][0], s[0][1]}; const int ii[2] = {lane, lane + 64}; wave_top16<2>(vv, ii, v1, i1, lane); }
        { float vv[2] = {s[1][0], s[1][1]}; const int ii[2] = {lane, lane + 64}; wave_top16<2>(vv, ii, v2, i2, lane); }
        float cv[4]; int ci[4];
        const int a = lane >> 2, b0 = (lane & 3) * 4;
        const float va = __shfl(v1, a); const int ia = __shfl(i1, a);
#pragma unroll
        for (int u = 0; u < 4; ++u) { const float vb = __shfl(v2, b0 + u); const int ib = __shfl(i2, b0 + u); cv[u] = va + vb; ci[u] = ia * 128 + ib; }
        float tv; int te;
        wave_top16<4>(cv, ci, tv, te, lane);
        const float mx = __shfl(tv, 0);
        const float ex = (lane < 16) ? expf(tv - mx) : 0.f;
        const float sum = wave_sum(ex);
        if (lane < 16) { p.eidx[(size_t)t * 128 + h * 16 + lane] = te; p.gatev[(size_t)t * 128 + h * 16 + lane] = ex / sum; }
    }
}

__device__ __forceinline__ void ph_peer(const Params& p, const float* x1, const bf16_t* h2, int bid, int nb, float* lds) {
    float* ys = lds;
    float* red = lds + 8 * 2048;
    const int tid = tid_(), wave = tid >> 6, lane = tid & 63;
    for (int t = bid; t < NTOK; t += nb) {
        const int b = t / SQ, h = wave;
        const uint2* hr = (const uint2*)(h2 + (size_t)t * DM);
        float4 hv[8], y[8];
#pragma unroll
        for (int j = 0; j < 8; ++j) { const uint2 w = hr[lane + 64 * j]; hv[j] = make_float4(bflo(w.x), bfhi(w.x), bflo(w.y), bfhi(w.y)); y[j] = make_float4(0.f, 0.f, 0.f, 0.f); }
        for (int k = 0; k < 16; ++k) {
            const int e = p.eidx[(size_t)t * 128 + h * 16 + k]; const float gt = p.gatev[(size_t)t * 128 + h * 16 + k];
            const float4* ur = (const float4*)(p.peer_u + (size_t)e * DM);
            float a = 0.f;
#pragma unroll
            for (int j = 0; j < 8; ++j) a += dot4(ur[lane + 64 * j], hv[j]);
            a = wave_sum(a);
            const float w = geluf_(a) * gt;
            const float4* vr = (const float4*)(p.peer_v + (size_t)e * DM);
#pragma unroll
            for (int j = 0; j < 8; ++j) { const float4 v4 = vr[lane + 64 * j]; y[j].x += w * v4.x; y[j].y += w * v4.y; y[j].z += w * v4.z; y[j].w += w * v4.w; }
        }
        __syncthreads();
#pragma unroll
        for (int j = 0; j < 8; ++j) *(float4*)(ys + h * 2048 + (lane + 64 * j) * 4) = y[j];
        __syncthreads();
        const int c = tid * 4;
        float4 s = make_float4(0.f, 0.f, 0.f, 0.f);
#pragma unroll
        for (int hh = 0; hh < 8; ++hh) { const float4 a = *(const float4*)(ys + hh * 2048 + c); s.x += a.x; s.y += a.y; s.z += a.z; s.w += a.w; }
        const float4 xv = *(const float4*)(x1 + (size_t)t * DM + c);
        const float4 ga = *(const float4*)(p.ada + b * NMOD + 5 * DM + c);
        const float4 x2 = make_float4(xv.x + ga.x * s.x, xv.y + ga.y * s.y, xv.z + ga.z * s.z, xv.w + ga.w * s.w);
        const float ss = wave_sum(dot4(x2, x2));
        if (lane == 0) red[wave] = ss;
        __syncthreads();
        float tot = 0.f;
#pragma unroll
        for (int w = 0; w < 8; ++w) tot += red[w];
        const float rs = 1.0f / sqrtf(tot * (1.0f / DM) + 1e-6f);
        const float4 gf = *(const float4*)(p.norm_f_g + c);
        *(float4*)(p.out + (size_t)t * DM + c) = make_float4(x2.x * rs * gf.x, x2.y * rs * gf.y, x2.z * rs * gf.z, x2.w * rs * gf.w);
    }
    __syncthreads();
}

__device__ __forceinline__ void split8(const float4 a, const float4 b, uint4& hi, uint4& lo) {
    const float x[8] = {a.x, a.y, a.z, a.w, b.x, b.y, b.z, b.w}; unsigned h[8], l[8];
#pragma unroll
    for (int i = 0; i < 8; ++i) { h[i] = f2bf(x[i]); l[i] = f2bf(x[i] - __uint_as_float(h[i] << 16)); }
    hi = make_uint4(h[0] | (h[1] << 16), h[2] | (h[3] << 16), h[4] | (h[5] << 16), h[6] | (h[7] << 16));
    lo = make_uint4(l[0] | (l[1] << 16), l[2] | (l[3] << 16), l[4] | (l[5] << 16), l[6] | (l[7] << 16));
}
__device__ __forceinline__ bf16x8_t as_bf16x8(const uint4 v) { return __builtin_bit_cast(bf16x8_t, v); }
struct PairTab { int a[52], b[52]; };
__host__ __device__ constexpr PairTab make_pairs() {
    PairTab t{}; int n = 0;
    for (int a = 0; a < 16; ++a) for (int b = 0; b < 16; ++b) if ((a + 1) * (b + 1) <= 16) { t.a[n] = a; t.b[n] = b; ++n; }
    for (; n < 52; ++n) { t.a[n] = -1; t.b[n] = -1; }
    return t;
}
constexpr PairTab PAIRS = make_pairs();
static_assert(PAIRS.a[49] >= 0 && PAIRS.a[50] < 0, "50 candidate pairs");

__device__ __forceinline__ void ph_topk2(const Params& p, const float* qb, int bid, int nb, float* lds) {
    const int tid = tid_(), wave = tid >> 6, lane = tid & 63;
    uint4* SK = (uint4*)lds;
    const float NEG = -INFINITY;
    for (int it = bid; it < 256; it += nb) {
        const int h = it & 7, tg = it >> 3;
        __syncthreads();
        for (int gi = tid; gi < 4096; gi += NTH) {
            const int dq = gi & 15, n = (gi >> 4) & 127, pp = gi >> 11;
            const float4* src = (const float4*)(p.peer_sk + ((size_t)(h * 2 + pp) * 128 + n) * 128 + dq * 8);
            uint4 hi, lo; split8(src[0], src[1], hi, lo);
            const int base = (((pp * 8 + (n >> 4)) * 4 + (dq >> 2)) * 2) * 64 + (dq & 3) * 16 + (n & 15);
            SK[base] = hi; SK[base + 64] = lo;
        }
        __syncthreads();
#pragma unroll 1
        for (int tile = 0; tile < 2; ++tile) {
            const int tok = tg * 256 + wave * 32 + tile * 16 + (lane & 15);
            const int qd = lane >> 4;
            float v12[2][16];
#pragma unroll
            for (int pp = 0; pp < 2; ++pp) {
                bf16x8_t Bh[4], Bl[4];
                const float* qp = qb + (size_t)tok * DM + h * 256 + pp * 128 + 8 * qd;
#pragma unroll
                for (int ks = 0; ks < 4; ++ks) { uint4 hi, lo; split8(*(const float4*)(qp + ks * 32), *(const float4*)(qp + ks * 32 + 4), hi, lo); Bh[ks] = as_bf16x8(hi); Bl[ks] = as_bf16x8(lo); }
                float v[32];
#pragma unroll
                for (int kt = 0; kt < 8; ++kt) {
                    f32x4_t acc = {0.f, 0.f, 0.f, 0.f};
#pragma unroll
                    for (int ks = 0; ks < 4; ++ks) {
                        const bf16x8_t Ah = as_bf16x8(SK[(((pp * 8 + kt) * 4 + ks) * 2) * 64 + lane]), Al = as_bf16x8(SK[(((pp * 8 + kt) * 4 + ks) * 2 + 1) * 64 + lane]);
                        acc = __builtin_amdgcn_mfma_f32_16x16x32_bf16(Ah, Bh[ks], acc, 0, 0, 0);
                        acc = __builtin_amdgcn_mfma_f32_16x16x32_bf16(Ah, Bl[ks], acc, 0, 0, 0);
                        acc = __builtin_amdgcn_mfma_f32_16x16x32_bf16(Al, Bh[ks], acc, 0, 0, 0);
                    }
#pragma unroll
                    for (int r = 0; r < 4; ++r) v[kt * 4 + r] = __uint_as_float((__float_as_uint(acc[r]) & ~127u) | (unsigned)(kt * 16 + qd * 4 + r));
                    __builtin_amdgcn_sched_barrier(0);
                }
#pragma unroll
                for (int r = 0; r < 16; ++r) {
                    float m = v[0];
#pragma unroll
                    for (int u = 1; u < 32; ++u) m = fmaxf(m, v[u]);
                    m = fmaxf(m, __shfl_xor(m, 16)); m = fmaxf(m, __shfl_xor(m, 32));
                    v12[pp][r] = m;
#pragma unroll
                    for (int u = 0; u < 32; ++u) v[u] = (v[u] == m) ? NEG : v[u];
                }
            }
            float c[13]; unsigned pay[13];
#pragma unroll
            for (int s = 0; s < 13; ++s) {
                float cq[4]; unsigned pq[4];
#pragma unroll
                for (int q = 0; q < 4; ++q) {
                    const int pi = 4 * s + q; const int a = PAIRS.a[pi], b = PAIRS.b[pi];
                    if (a >= 0) {
                        const float sum = v12[0][a] + v12[1][b];
                        cq[q] = __uint_as_float((__float_as_uint(sum) & ~63u) | (unsigned)pi);
                        pq[q] = (__float_as_uint(v12[0][a]) & 127u) * 128u + (__float_as_uint(v12[1][b]) & 127u);
                    } else { cq[q] = NEG; pq[q] = 0u; }
                }
                c[s] = qd == 0 ? cq[0] : qd == 1 ? cq[1] : qd == 2 ? cq[2] : cq[3];
                pay[s] = qd == 0 ? pq[0] : qd == 1 ? pq[1] : qd == 2 ? pq[2] : pq[3];
            }
            float top[16]; unsigned eid[16];
#pragma unroll
            for (int r = 0; r < 16; ++r) {
                float m = c[0];
#pragma unroll
                for (int s = 1; s < 13; ++s) m = fmaxf(m, c[s]);
                m = fmaxf(m, __shfl_xor(m, 16)); m = fmaxf(m, __shfl_xor(m, 32));
                unsigned pw = 0u;
#pragma unroll
                for (int s = 0; s < 13; ++s) { const bool eq = (c[s] == m); pw |= eq ? pay[s] : 0u; c[s] = eq ? NEG : c[s]; }
                pw |= (unsigned)__shfl_xor((int)pw, 16); pw |= (unsigned)__shfl_xor((int)pw, 32);
                top[r] = m; eid[r] = pw;
            }
            float sum = 0.f; const float mx = top[0];
#pragma unroll
            for (int r = 0; r < 16; ++r) { top[r] = expf(top[r] - mx); sum += top[r]; }
            const float inv = 1.0f / sum;
            if (lane < 16) {
                int4* ep = (int4*)(p.eidx + (size_t)tok * 128 + h * 16); float4* gp = (float4*)(p.gatev + (size_t)tok * 128 + h * 16);
#pragma unroll
                for (int q = 0; q < 4; ++q) {
                    ep[q] = make_int4((int)eid[4 * q], (int)eid[4 * q + 1], (int)eid[4 * q + 2], (int)eid[4 * q + 3]);
                    gp[q] = make_float4(top[4 * q] * inv, top[4 * q + 1] * inv, top[4 * q + 2] * inv, top[4 * q + 3] * inv);
                }
            }
        }
    }
    __syncthreads();
}

__device__ __forceinline__ void peer_load2(const bf16_t* tab, int ea, int eb, int lane, uint4 (&R)[2][4]) {
    const uint4* ra = (const uint4*)(tab + (size_t)ea * DM) + lane; const uint4* rb = (const uint4*)(tab + (size_t)eb * DM) + lane;
#pragma unroll
    for (int j = 0; j < 4; ++j) { R[0][j] = ra[64 * j]; R[1][j] = rb[64 * j]; }
}
__device__ __forceinline__ void ph_peer2(const Params& p, const float* x1, const bf16_t* h2, int bid, int nb) {
    const int tid = tid_(), wave = tid >> 6, lane = tid & 63;
    for (int t = bid * 8 + wave; t < NTOK; t += nb * 8) {
        const int b = t / SQ;
        float hv[32], y[32];
        {
            const uint4* hr = (const uint4*)(h2 + (size_t)t * DM) + lane;
#pragma unroll
            for (int j = 0; j < 4; ++j) { const uint4 w = hr[64 * j];
                hv[8 * j + 0] = bflo(w.x); hv[8 * j + 1] = bfhi(w.x); hv[8 * j + 2] = bflo(w.y); hv[8 * j + 3] = bfhi(w.y);
                hv[8 * j + 4] = bflo(w.z); hv[8 * j + 5] = bfhi(w.z); hv[8 * j + 6] = bflo(w.w); hv[8 * j + 7] = bfhi(w.w); }
        }
#pragma unroll
        for (int i = 0; i < 32; ++i) y[i] = 0.f;
        const int e0 = p.eidx[(size_t)t * 128 + lane], e1 = p.eidx[(size_t)t * 128 + 64 + lane];
        const float g0 = p.gatev[(size_t)t * 128 + lane], g1 = p.gatev[(size_t)t * 128 + 64 + lane];
        uint4 Uc[2][4], Un[2][4], Vc[2][4];
        peer_load2(p.Ub, __builtin_amdgcn_readlane(e0, 0), __builtin_amdgcn_readlane(e0, 1), lane, Uc);
        for (int g = 0; g < 64; ++g) {
            const int ee = (g < 32) ? e0 : e1; const float gg = (g < 32) ? g0 : g1;
            const int k0 = (2 * g) & 63;
            const int ea = __builtin_amdgcn_readlane(ee, k0), eb = __builtin_amdgcn_readlane(ee, k0 + 1);
            const float ga = __uint_as_float(__builtin_amdgcn_readlane(__float_as_uint(gg), k0)), gb = __uint_as_float(__builtin_amdgcn_readlane(__float_as_uint(gg), k0 + 1));
            peer_load2(p.Vb, ea, eb, lane, Vc);
            {
                const int gn = (g < 63) ? g + 1 : g; const int en = (gn < 32) ? e0 : e1; const int kn = (2 * gn) & 63;
                peer_load2(p.Ub, __builtin_amdgcn_readlane(en, kn), __builtin_amdgcn_readlane(en, kn + 1), lane, Un);
            }
            float a0 = 0.f, a1 = 0.f;
#pragma unroll
            for (int j = 0; j < 4; ++j) {
                const unsigned ua[4] = {Uc[0][j].x, Uc[0][j].y, Uc[0][j].z, Uc[0][j].w}, ub[4] = {Uc[1][j].x, Uc[1][j].y, Uc[1][j].z, Uc[1][j].w};
#pragma unroll
                for (int q = 0; q < 4; ++q) {
                    a0 += bflo(ua[q]) * hv[8 * j + 2 * q] + bfhi(ua[q]) * hv[8 * j + 2 * q + 1];
                    a1 += bflo(ub[q]) * hv[8 * j + 2 * q] + bfhi(ub[q]) * hv[8 * j + 2 * q + 1];
                }
            }
#pragma unroll
            for (int o = 1; o < 64; o <<= 1) { a0 += __shfl_xor(a0, o); a1 += __shfl_xor(a1, o); }
            const float w0 = geluf_(a0) * ga, w1 = geluf_(a1) * gb;
#pragma unroll
            for (int j = 0; j < 4; ++j) {
                const unsigned va[4] = {Vc[0][j].x, Vc[0][j].y, Vc[0][j].z, Vc[0][j].w}, vb[4] = {Vc[1][j].x, Vc[1][j].y, Vc[1][j].z, Vc[1][j].w};
#pragma unroll
                for (int q = 0; q < 4; ++q) {
                    y[8 * j + 2 * q] += w0 * bflo(va[q]) + w1 * bflo(vb[q]);
                    y[8 * j + 2 * q + 1] += w0 * bfhi(va[q]) + w1 * bfhi(vb[q]);
                }
            }
#pragma unroll
            for (int i = 0; i < 2; ++i)
#pragma unroll
                for (int j = 0; j < 4; ++j) Uc[i][j] = Un[i][j];
        }
        float ss = 0.f;
#pragma unroll
        for (int j = 0; j < 4; ++j)
#pragma unroll
            for (int hq = 0; hq < 2; ++hq) {
                const int c = (lane + 64 * j) * 8 + 4 * hq;
                const float4 xv = *(const float4*)(x1 + (size_t)t * DM + c);
                const float4 ga = *(const float4*)(p.ada + b * NMOD + 5 * DM + c);
                float* yy = y + 8 * j + 4 * hq;
                yy[0] = xv.x + ga.x * yy[0]; yy[1] = xv.y + ga.y * yy[1]; yy[2] = xv.z + ga.z * yy[2]; yy[3] = xv.w + ga.w * yy[3];
                ss += yy[0] * yy[0] + yy[1] * yy[1] + yy[2] * yy[2] + yy[3] * yy[3];
            }
        ss = wave_sum(ss);
        const float rs = 1.0f / sqrtf(ss * (1.0f / DM) + 1e-6f);
#pragma unroll
        for (int j = 0; j < 4; ++j)
#pragma unroll
            for (int hq = 0; hq < 2; ++hq) {
                const int c = (lane + 64 * j) * 8 + 4 * hq;
                const float4 gf = *(const float4*)(p.norm_f_g + c);
                const float* yy = y + 8 * j + 4 * hq;
                *(float4*)(p.out + (size_t)t * DM + c) = make_float4(yy[0] * rs * gf.x, yy[1] * rs * gf.y, yy[2] * rs * gf.z, yy[3] * rs * gf.w);
            }
    }
}

template <class Epi>
__device__ __forceinline__ void gemm_run(float* lds, const bf16_t* A, const bf16_t* Bt, int M, int N, int K, const Epi& E) {
    __syncthreads();
    pg8::Gemm g{A, Bt, M, N, K}; pg8::StaticOrder S; S.init(M, N, (int)gridDim.x, (int)blockIdx.x);
    pg8::gemm_phase<Epi, pg8::StaticOrder, true, true>((PG8_LAS unsigned char*)lds, g, S, E);
    __syncthreads();
}
constexpr int NPHASE = 11;
template <int PH>
__device__ __forceinline__ void run_phase(const Params& p, int bid, int nb, float* lds) {
    asm volatile("" : "+s"(bid));
    if constexpr (PH == 0) ph_prep(p, bid, nb, lds);
    if constexpr (PH == 1) ph_modnorm(p, p.x, p.norm1_g, 0 * DM, 1 * DM, p.hb, bid, nb, lds);
    if constexpr (PH == 2) gemm_run(lds, p.hb, p.Wt1, NTOK, ZW, DM, pg8::EpiZG{p.ZG, p.b_bg});
    if constexpr (PH == 3) { ph_retprep(p, bid, nb, lds); ph_gmlp(p, bid, nb, lds); }
    if constexpr (PH == 11) ph_ret2(p, bid, nb, lds);
    if constexpr (PH == 4) ph_gn(p, bid, nb, lds);
    if constexpr (PH == 5) {
        gemm_run(lds, p.yain, p.Wta, NTOK, DM, 1024, pg8::EpiMixB<0>{p.hb, p.ZG, 0});
        gemm_run(lds, p.ybin, p.Wtb, NTOK, DM, DM, pg8::EpiMixB<1>{p.hb, p.ZG, 2048});
    }
    if constexpr (PH == 6) gemm_run(lds, p.hb, p.Wto, NTOK, DM, DM, pg8::EpiResF{p.obuf, p.x, p.ada + 2 * DM});
    if constexpr (PH == 7) { ph_modnorm(p, p.obuf, p.norm2_g, 3 * DM, 4 * DM, p.hb, bid, nb, lds); ph_tabconv(p, bid, nb); }
    if constexpr (PH == 8) gemm_run(lds, p.hb, p.Wtq, NTOK, DM, DM, pg8::EpiF32{p.qbuf, DM});
    if constexpr (PH == 9) ph_topk2(p, p.qbuf, bid, nb, lds);
    if constexpr (PH == 10) ph_peer2(p, p.obuf, p.hb, bid, nb);
}

__global__ void __launch_bounds__(NTH) k_mega(Params p) {
    extern __shared__ __attribute__((aligned(16))) float lds[];
    cg::grid_group grid = cg::this_grid();
    const int bid = blockIdx.x, nb = gridDim.x;
    run_phase<0>(p, bid, nb, lds); grid.sync();
    run_phase<1>(p, bid, nb, lds); grid.sync();
    run_phase<2>(p, bid, nb, lds); grid.sync();
    run_phase<3>(p, bid, nb, lds); grid.sync();
    run_phase<11>(p, bid, nb, lds); grid.sync();
    run_phase<4>(p, bid, nb, lds); grid.sync();
    run_phase<5>(p, bid, nb, lds); grid.sync();
    run_phase<6>(p, bid, nb, lds); grid.sync();
    run_phase<7>(p, bid, nb, lds); grid.sync();
    run_phase<8>(p, bid, nb, lds); grid.sync();
    run_phase<9>(p, bid, nb, lds); grid.sync();
    run_phase<10>(p, bid, nb, lds);
}

extern "C" void kernel_launch(void* const* d_in, const int* in_sizes, int n_in, void* d_out, int out_size, void* d_ws, size_t ws_size, hipStream_t stream) {
    Params p{};
    p.x = (const float*)d_in[0]; p.c = (const float*)d_in[1]; p.pos = (const int*)d_in[2];
    p.w_ada = (const float*)d_in[3]; p.b_ada = (const float*)d_in[4]; p.norm1_g = (const float*)d_in[5]; p.w_in = (const float*)d_in[6];
    p.w_bg = (const float*)d_in[7]; p.b_bg = (const float*)d_in[8]; p.gm_v_g = (const float*)d_in[9]; p.gm_ws = (const float*)d_in[10];
    p.gm_b = (const float*)d_in[11]; p.ret_gn_g = (const float*)d_in[12]; p.w_a_out = (const float*)d_in[13]; p.w_b_out = (const float*)d_in[14];
    p.w_o = (const float*)d_in[15]; p.norm2_g = (const float*)d_in[16]; p.peer_wq = (const float*)d_in[17]; p.peer_sk = (const float*)d_in[18];
    p.peer_u = (const float*)d_in[19]; p.peer_v = (const float*)d_in[20]; p.norm_f_g = (const float*)d_in[21];
    p.out = (float*)d_out;
    char* w = (char*)d_ws; size_t off = 0;
    auto take = [&](size_t bytes) { char* r = w + off; off += (bytes + 255) & ~(size_t)255; return r; };
    p.ada = (float*)take(2 * NMOD * 4);
    p.rope = (float*)take((size_t)NTOK * 128 * 4);
    p.eidx = (int*)take((size_t)NTOK * 128 * 4);
    p.gatev = (float*)take((size_t)NTOK * 128 * 4);
    p.Wt1 = (bf16_t*)take((size_t)ZW * DM * 2);
    p.Wta = (bf16_t*)take((size_t)DM * 1024 * 2);
    p.Wtb = (bf16_t*)take((size_t)DM * DM * 2);
    p.Wto = (bf16_t*)take((size_t)DM * DM * 2);
    p.Wtq = (bf16_t*)take((size_t)DM * DM * 2);
    p.hb = (bf16_t*)take((size_t)NTOK * DM * 2);
    p.ZG = (bf16_t*)take((size_t)NTOK * ZW * 2);
    p.qbuf = (float*)p.ZG;
    p.obuf = (float*)take((size_t)NTOK * DM * 4);
    p.ybin = (bf16_t*)take((size_t)NTOK * DM * 2);
    p.yain = (bf16_t*)take((size_t)NTOK * 1024 * 2);
    p.Ub = p.ZG + (size_t)NTOK * DM * 2;
    p.Vb = p.ZG + (size_t)NTOK * DM * 4;
    p.Qr = (bf16_t*)take((size_t)NTOK * 1024 * 2);
    p.Kr = (bf16_t*)take((size_t)NTOK * 1024 * 2);
    p.KTd = (bf16_t*)take((size_t)NTOK * 1024 * 2);
    p.Vt = (bf16_t*)take((size_t)NTOK * 2048 * 2);
    p.ob16 = (bf16_t*)take((size_t)NTOK * DM * 2);
    if (off > ws_size) { fprintf(stderr, "kernel_launch: workspace too small: need %zu have %zu\n", off, ws_size); return; }
    static int grid = 0;
    if (!grid) {
        int dev = 0, cus = 0, per_cu = 0;
        (void)hipGetDevice(&dev); (void)hipDeviceGetAttribute(&cus, hipDeviceAttributeMultiprocessorCount, dev);
        (void)hipFuncSetAttribute((const void*)k_mega, hipFuncAttributeMaxDynamicSharedMemorySize, LDS_BYTES);
        (void)hipOccupancyMaxActiveBlocksPerMultiprocessor(&per_cu, k_mega, NTH, LDS_BYTES);
        if (per_cu < 1) per_cu = 1;
        grid = cus * per_cu;
    }
    void* args[] = {&p};
    hipError_t e = hipLaunchCooperativeKernel((const void*)k_mega, dim3(grid), dim3(NTH), args, LDS_BYTES, stream);
    if (e != hipSuccess) fprintf(stderr, "cooperative launch failed: %s (grid %d)\n", hipGetErrorString(e), grid);
}
```

```cpp
#include <hip/hip_runtime.h>
#include <hip/hip_cooperative_groups.h>
#include <stdint.h>
#include <math.h>
#include <cstdio>

namespace cg = cooperative_groups;

constexpr int DM = 2048;
constexpr int SQ = 4096;
constexpr int NTOK = 8192;
constexpr int NTH = 512;
constexpr int ZW = 12288;
constexpr int NMOD = 12288;
constexpr int LDS_BYTES = 136 * 1024;

typedef unsigned short bf16_t;

struct Params {
    const float *x, *c; const int* pos;
    const float *w_ada, *b_ada, *norm1_g, *w_in, *w_bg, *b_bg, *gm_v_g, *gm_ws, *gm_b, *ret_gn_g, *w_a_out, *w_b_out, *w_o, *norm2_g,
                *peer_wq, *peer_sk, *peer_u, *peer_v, *norm_f_g;
    float* out;
    float *ada, *rope, *gatev; int* eidx;
    bf16_t *Wt1, *Wta, *Wtb, *Wto, *Wtq;
    bf16_t *hb;
    bf16_t *ZG;
    float *obuf;
    bf16_t *ybin, *yain;
    float *qbuf;
    unsigned char *U8, *V8;
    float *su, *sv;
    bf16_t *Qr, *Kr, *KTd, *Vt;
    bf16_t *ob16;
    unsigned *bar;
};

__constant__ float c_freq[64] = {
1.000000000e+00f, 8.659643531e-01f, 7.498942018e-01f, 6.493816376e-01f, 5.623413324e-01f, 4.869675338e-01f, 4.216965139e-01f, 3.651741147e-01f, 3.162277639e-01f, 2.738419771e-01f, 2.371373773e-01f, 2.053525001e-01f, 1.778279394e-01f, 1.539926529e-01f, 1.333521456e-01f, 1.154781953e-01f, 1.000000015e-01f, 8.659642935e-02f, 7.498942316e-02f, 6.493816525e-02f, 5.623413250e-02f, 4.869675264e-02f, 4.216964915e-02f, 3.651741147e-02f, 3.162277490e-02f, 2.738419548e-02f, 2.371373773e-02f, 2.053525113e-02f, 1.778279431e-02f, 1.539926510e-02f, 1.333521400e-02f, 1.154781971e-02f, 9.999999776e-03f, 8.659643121e-03f, 7.498942316e-03f, 6.493816152e-03f, 5.623413250e-03f, 4.869675264e-03f, 4.216964822e-03f, 3.651741194e-03f, 3.162277630e-03f, 2.738419687e-03f, 2.371373819e-03f, 2.053525066e-03f, 1.778279431e-03f, 1.539926510e-03f, 1.333521446e-03f, 1.154782018e-03f, 1.000000047e-03f, 8.659643354e-04f, 7.498941850e-04f, 6.493816036e-04f, 5.623413017e-04f, 4.869675322e-04f, 4.216965172e-04f, 3.651741135e-04f, 3.162277571e-04f, 2.738419571e-04f, 2.371373703e-04f, 2.053525095e-04f, 1.778279402e-04f, 1.539926598e-04f, 1.333521504e-04f, 1.154782003e-04f };

__device__ __forceinline__ int tid_() { int t = threadIdx.x; asm volatile("" : "+v"(t)); return t; }
__device__ __forceinline__ float wave_sum(float v) {
#pragma unroll
    for (int o = 1; o < 64; o <<= 1) v += __shfl_xor(v, o);
    return v;
}
__device__ __forceinline__ float wave_max(float v) {
#pragma unroll
    for (int o = 1; o < 64; o <<= 1) v = fmaxf(v, __shfl_xor(v, o));
    return v;
}
__device__ __forceinline__ float sigmoidf_(float x) { return 1.0f / (1.0f + expf(-x)); }
__device__ __forceinline__ float siluf_(float x) { return x * sigmoidf_(x); }
__device__ __forceinline__ float geluf_(float x) { return 0.5f * x * (1.0f + erff(x * 0.70710678118654752f)); }
__device__ __forceinline__ float dot4(float4 a, float4 b) { return a.x * b.x + a.y * b.y + a.z * b.z + a.w * b.w; }
__device__ __forceinline__ float bf2f(bf16_t v) { return __uint_as_float((unsigned)v << 16); }
__device__ __forceinline__ float bflo(unsigned w) { return __uint_as_float(w << 16); }
__device__ __forceinline__ float bfhi(unsigned w) { return __uint_as_float(w & 0xffff0000u); }
__device__ __forceinline__ unsigned f2bf(float f) { unsigned u = __float_as_uint(f); return (u + 0x7fffu + ((u >> 16) & 1u)) >> 16; }
__device__ __forceinline__ unsigned pk2(float lo, float hi) { return f2bf(lo) | (f2bf(hi) << 16); }

__device__ __forceinline__ void sincos_acc(float ang, float& s, float& c) {
    const double x = (double)ang;
    const double k = rint(x * 0.63661977236758134308);
    double r = fma(-k, 1.57079632679489655800, x); r = fma(-k, 6.12323399573676603587e-17, r);
    const double r2 = r * r;
    const double sp = r * (1.0 + r2 * (-1.0 / 6.0 + r2 * (1.0 / 120.0 + r2 * (-1.0 / 5040.0 + r2 * (1.0 / 362880.0 + r2 * (-1.0 / 39916800.0 + r2 * (1.0 / 6227020800.0)))))));
    const double cp = 1.0 + r2 * (-0.5 + r2 * (1.0 / 24.0 + r2 * (-1.0 / 720.0 + r2 * (1.0 / 40320.0 + r2 * (-1.0 / 3628800.0 + r2 * (1.0 / 479001600.0 + r2 * (-1.0 / 87178291200.0)))))));
    const int q = ((int)k) & 3;
    const float fs = (float)sp, fc = (float)cp;
    s = (q == 0) ? fs : (q == 1) ? fc : (q == 2) ? -fs : -fc;
    c = (q == 0) ? fc : (q == 1) ? -fs : (q == 2) ? -fc : fs;
}

namespace pg8 {
#define PG8_LAS __attribute__((address_space(3)))
typedef unsigned short bf16_t;
typedef short bf16x8 __attribute__((ext_vector_type(8)));
typedef float f32x4 __attribute__((ext_vector_type(4)));
typedef unsigned u32x4 __attribute__((ext_vector_type(4)));
constexpr int BM = 256, BK = 64, HALF = 128, HTB = HALF * BK * 2  , STAGE_BYTES = 8 * HTB, NXCD = 8, WGM = 8;

__host__ __device__ __forceinline__ int lds_byte(int r, int c) { const int st = (r >> 4) * 2 + (c >> 5), rr = r & 15, cc = c & 31, ob = rr * 64 + cc * 2; return st * 1024 + (ob ^ (((ob >> 9) & 1) << 5)); }
__host__ __device__ __forceinline__ void stage_rc(int b, int& R, int& C) { const int st = b / 1024, sb = b % 1024, swz = sb ^ (((sb >> 9) & 1) << 5); R = (st >> 1) * 16 + swz / 64; C = (st & 1) * 32 + (swz % 64) / 2; }
__host__ __device__ __forceinline__ int perm32(int rho) { const int n = rho >> 4, i = rho & 15; return 8 * (i >> 2) + 4 * n + (i & 3); }

struct Unit { int pm, pn; };
struct Gemm { const bf16_t* A; const bf16_t* Bt; int M, N, K; };

struct StaticOrder {
    int nM, nN, nwg, G, c;
    __host__ __device__ void init(int M, int N, int G_, int c_) { nM = M / BM; nN = N / BM; nwg = nM * nN; G = G_; c = c_; }
    __host__ __device__ bool next(int i, Unit& u) const {
        const long L = (long)i * G + c; if (L >= nwg) return false;
        int wgid = (int)L; { const int q = nwg / NXCD, r = nwg % NXCD, xcd = wgid % NXCD, off = wgid / NXCD; wgid = (xcd < r ? xcd * (q + 1) : r * (q + 1) + (xcd - r) * q) + off; }
        const int nig = WGM * nN, gid = wgid / nig, fm = gid * WGM, gsz = (nM - fm) < WGM ? (nM - fm) : WGM;
        u.pm = fm + ((wgid % nig) % gsz); u.pn = (wgid % nig) / gsz; return true;
    }
    __device__ __forceinline__ void a_ready(const Unit&) const {}
    __device__ __forceinline__ void done(const Unit&) const {}
};

__device__ __forceinline__ unsigned cvt_pk_bf16(float lo, float hi) { unsigned r; asm volatile("v_cvt_pk_bf16_f32 %0, %1, %2" : "=v"(r) : "v"(lo), "v"(hi)); return r; }
typedef float f32x2 __attribute__((ext_vector_type(2)));
__device__ __forceinline__ f32x2 gelu_pk(f32x2 v) {
    const f32x2 av = __builtin_elementwise_abs(v), d = av * 0.2316418882f + 1.0f;
    f32x2 t; t.x = __builtin_amdgcn_rcpf(d.x); t.y = __builtin_amdgcn_rcpf(d.y);
    f32x2 q = t * 0.5307027145f + (-0.7265760135f); q = q * t + 0.7107068705f; q = q * t + (-0.142248368f); q = q * t + 0.127414796f; q = q * t;
    const f32x2 s = (v * v) * (-0.72134752044f);
    f32x2 e; e.x = __builtin_amdgcn_exp2f(s.x); e.y = __builtin_amdgcn_exp2f(s.y);
    const f32x2 m = v * (q * e), r = v - m;
    f32x2 o; o.x = v.x < 0.f ? m.x : r.x; o.y = v.y < 0.f ? m.y : r.y; return o;
}

typedef unsigned u32x2v __attribute__((ext_vector_type(2)));
struct EpiZG {
    static constexpr bool PERM = true, AFTER_DRAIN = false;
    bf16_t* O; const float* bias;
    __device__ __forceinline__ void operator()(const f32x4 (&acc)[2][2][4][2], const Unit& u, int wr, int wc, int fr, int fq) const {
        const int row0 = u.pm * BM + wr * 64 + fr, col0 = u.pn * BM + wc * 32 + 8 * fq;
        const int mode = u.pn < 8 ? 1 : (u.pn < 32 ? 0 : 2);
        f32x4 bv[2][2];
#pragma unroll
        for (int bj = 0; bj < 2; ++bj)
#pragma unroll
            for (int n = 0; n < 2; ++n) bv[bj][n] = (mode == 2) ? *(const f32x4*)(bias + (col0 - 8192) + bj * HALF + 4 * n) : (f32x4){0.f, 0.f, 0.f, 0.f};
#pragma unroll
        for (int ai = 0; ai < 2; ++ai)
#pragma unroll
            for (int m = 0; m < 4; ++m) { bf16_t* rowp = O + (size_t)(row0 + ai * HALF + m * 16) * ZW + col0;
#pragma unroll
                for (int bj = 0; bj < 2; ++bj) { f32x4 v0 = acc[ai][bj][m][0], v1 = acc[ai][bj][m][1];
                    if (mode == 1) { f32x2 a = gelu_pk((f32x2){v0[0], v0[1]}), b = gelu_pk((f32x2){v0[2], v0[3]}), c = gelu_pk((f32x2){v1[0], v1[1]}), d = gelu_pk((f32x2){v1[2], v1[3]});
                        v0 = (f32x4){a.x, a.y, b.x, b.y}; v1 = (f32x4){c.x, c.y, d.x, d.y}; }
                    if (mode == 2) { v0 = v0 + bv[bj][0]; v1 = v1 + bv[bj][1];
#pragma unroll
                        for (int e = 0; e < 4; ++e) { v0[e] = __builtin_amdgcn_rcpf(1.0f + __expf(-v0[e])); v1[e] = __builtin_amdgcn_rcpf(1.0f + __expf(-v1[e])); } }
                    u32x4 w; w.x = cvt_pk_bf16(v0[0], v0[1]); w.y = cvt_pk_bf16(v0[2], v0[3]); w.z = cvt_pk_bf16(v1[0], v1[1]); w.w = cvt_pk_bf16(v1[2], v1[3]);
                    *(u32x4*)(rowp + bj * HALF) = w; } }
    }
};
template <int ACCUM> struct EpiMixB {
    static constexpr bool PERM = true, AFTER_DRAIN = false;
    bf16_t* Mo; const bf16_t* ZGp; int goff;
    __device__ __forceinline__ void operator()(const f32x4 (&acc)[2][2][4][2], const Unit& u, int wr, int wc, int fr, int fq) const {
        const int row0 = u.pm * BM + wr * 64 + fr, col0 = u.pn * BM + wc * 32 + 8 * fq;
#pragma unroll
        for (int ai = 0; ai < 2; ++ai)
#pragma unroll
            for (int m = 0; m < 4; ++m) { const size_t row = (size_t)(row0 + ai * HALF + m * 16);
#pragma unroll
                for (int bj = 0; bj < 2; ++bj) { const f32x4 v0 = acc[ai][bj][m][0], v1 = acc[ai][bj][m][1];
                    const u32x4 g = *(const u32x4*)(ZGp + row * ZW + 8192 + goff + col0 + bj * HALF);
                    float o[8];
                    o[0] = bflo(g.x) * v0[0]; o[1] = bfhi(g.x) * v0[1]; o[2] = bflo(g.y) * v0[2]; o[3] = bfhi(g.y) * v0[3];
                    o[4] = bflo(g.z) * v1[0]; o[5] = bfhi(g.z) * v1[1]; o[6] = bflo(g.w) * v1[2]; o[7] = bfhi(g.w) * v1[3];
                    bf16_t* mp = Mo + row * DM + col0 + bj * HALF;
                    if (ACCUM) { const u32x4 old = *(const u32x4*)mp;
                        o[0] += bflo(old.x); o[1] += bfhi(old.x); o[2] += bflo(old.y); o[3] += bfhi(old.y); o[4] += bflo(old.z); o[5] += bfhi(old.z); o[6] += bflo(old.w); o[7] += bfhi(old.w); }
                    u32x4 w; w.x = cvt_pk_bf16(o[0], o[1]); w.y = cvt_pk_bf16(o[2], o[3]); w.z = cvt_pk_bf16(o[4], o[5]); w.w = cvt_pk_bf16(o[6], o[7]);
                    *(u32x4*)mp = w; } }
    }
};
struct EpiResF {
    static constexpr bool PERM = false, AFTER_DRAIN = false;
    float* x1; const float* x; const float* ga;
    __device__ __forceinline__ void operator()(const f32x4 (&acc)[2][2][4][2], const Unit& u, int wr, int wc, int fr, int fq) const {
        const int row0 = u.pm * BM + wr * 64 + fr, col0 = u.pn * BM + wc * 32 + 4 * fq;
        const int b = (u.pm * BM) / SQ;
        f32x4 gv[2][2];
#pragma unroll
        for (int bj = 0; bj < 2; ++bj)
#pragma unroll
            for (int n = 0; n < 2; ++n) gv[bj][n] = *(const f32x4*)(ga + b * NMOD + col0 + bj * HALF + n * 16);
#pragma unroll
        for (int ai = 0; ai < 2; ++ai)
#pragma unroll
            for (int m = 0; m < 4; ++m) { const size_t off = (size_t)(row0 + ai * HALF + m * 16) * DM + col0;
#pragma unroll
                for (int bj = 0; bj < 2; ++bj)
#pragma unroll
                    for (int n = 0; n < 2; ++n) { const f32x4 xv = *(const f32x4*)(x + off + bj * HALF + n * 16);
                        *(f32x4*)(x1 + off + bj * HALF + n * 16) = xv + gv[bj][n] * acc[ai][bj][m][n]; } }
    }
};
struct EpiF32 {
    static constexpr bool PERM = false, AFTER_DRAIN = false;
    float* O; int ldc;
    __device__ __forceinline__ void operator()(const f32x4 (&acc)[2][2][4][2], const Unit& u, int wr, int wc, int fr, int fq) const {
        const int row0 = u.pm * BM + wr * 64 + fr, col0 = u.pn * BM + wc * 32 + 4 * fq;
#pragma unroll
        for (int ai = 0; ai < 2; ++ai)
#pragma unroll
            for (int m = 0; m < 4; ++m) { const size_t off = (size_t)(row0 + ai * HALF + m * 16) * ldc + col0;
#pragma unroll
                for (int bj = 0; bj < 2; ++bj)
#pragma unroll
                    for (int n = 0; n < 2; ++n) *(f32x4*)(O + off + bj * HALF + n * 16) = acc[ai][bj][m][n]; }
    }
};

template <class Epi, class Sched, bool ALIGN_EPI = false, bool SP2 = false>
__device__ __forceinline__ void gemm_phase(PG8_LAS unsigned char* lds, const Gemm g, const Sched& S, const Epi& E) {
    const int tid = threadIdx.x, wid = __builtin_amdgcn_readfirstlane(tid >> 6), lane = tid & 63, wr = wid >> 2, wc = wid & 3, fr = lane & 15, fq = lane >> 4;
    const int K = g.K, nt = K / BK;
    unsigned voffA[2], voffB[2];
#pragma unroll
    for (int i = 0; i < 2; ++i) { int R, C; stage_rc(tid * 16 + i * 8192, R, C); const int Rb = Epi::PERM ? ((R & ~31) + perm32(R & 31)) : R;
        voffA[i] = (unsigned)(R * K + C) * 2u; voffB[i] = (unsigned)(Rb * K + C) * 2u; }
    const size_t kstep = (size_t)(BK * 2);
    const size_t hstep = (size_t)HALF * K * 2;
    const size_t tstep = 2 * hstep;
    const unsigned ldsw = (unsigned)wid * 1024u;
    const int aoff = lds_byte(wr * 64 + fr, fq * 8), boff = lds_byte(wc * 32 + fr, fq * 8);
#define PG8_SA(b, h) (((b) * 2 + (h)) * HTB)
#define PG8_SB(b, h) ((4 + (b) * 2 + (h)) * HTB)
#define PG8_STAGE(bufoff, gbase, voff) do { _Pragma("unroll") for (int _i = 0; _i < 2; ++_i) \
        __builtin_amdgcn_global_load_lds((const unsigned*)((const char*)(gbase) + (voff)[_i]), (PG8_LAS unsigned*)(lds + (bufoff) + ldsw + _i * 8192), 16, 0, 0); } while (0)
#define PG8_LDA(dst, b, h) do { _Pragma("unroll") for (int m = 0; m < 4; ++m) _Pragma("unroll") for (int k = 0; k < 2; ++k) dst[m][k] = *(const PG8_LAS bf16x8*)(lds + PG8_SA(b, h) + aoff + m * 2048 + k * 1024); } while (0)
#define PG8_LDB(dst, b, h) do { _Pragma("unroll") for (int n = 0; n < 2; ++n) _Pragma("unroll") for (int k = 0; k < 2; ++k) dst[n][k] = *(const PG8_LAS bf16x8*)(lds + PG8_SB(b, h) + boff + n * 2048 + k * 1024); } while (0)
#define PG8_MMA(ai, bj, At, Bt) do { __builtin_amdgcn_s_setprio(1); _Pragma("unroll") for (int m = 0; m < 4; ++m) _Pragma("unroll") for (int n = 0; n < 2; ++n) _Pragma("unroll") for (int k = 0; k < 2; ++k) \
        acc[ai][bj][m][n] = __builtin_amdgcn_mfma_f32_16x16x32_bf16(Bt[n][k], At[m][k], acc[ai][bj][m][n], 0, 0, 0); __builtin_amdgcn_s_setprio(0); } while (0)
#define PG8_WAIT_V(n) asm volatile("s_waitcnt vmcnt(" #n ")" ::: "memory")
#define PG8_WAIT_L(n) asm volatile("s_waitcnt lgkmcnt(" #n ")" ::: "memory")
#define PG8_BAR __builtin_amdgcn_s_barrier()
#define PG8_SCHED __builtin_amdgcn_sched_barrier(0)
    Unit cur, nxt; int ui = 0;
    if (!S.next(0, cur)) return;
    f32x4 acc[2][2][4][2];
#pragma unroll
    for (int a = 0; a < 2; ++a)
#pragma unroll
        for (int b = 0; b < 2; ++b)
#pragma unroll
            for (int m = 0; m < 4; ++m)
#pragma unroll
                for (int n = 0; n < 2; ++n) acc[a][b][m][n] = (f32x4){0.f, 0.f, 0.f, 0.f};
    bf16x8 At[4][2], B0[2][2], B1[2][2];
    const char* cA = (const char*)g.A + (size_t)cur.pm * tstep; const char* cB = (const char*)g.Bt + (size_t)cur.pn * tstep;
    S.a_ready(cur);
    if constexpr (SP2) {
        PG8_STAGE(PG8_SB(0, 0), cB, voffB); PG8_STAGE(PG8_SB(0, 1), cB + hstep, voffB); PG8_STAGE(PG8_SA(0, 0), cA, voffA); PG8_STAGE(PG8_SA(0, 1), cA + hstep, voffA);
        if (wr == 1) PG8_BAR;
        PG8_WAIT_V(2); PG8_BAR;
        PG8_STAGE(PG8_SB(1, 0), cB + kstep, voffB); PG8_STAGE(PG8_SA(1, 0), cA + kstep, voffA); PG8_STAGE(PG8_SB(1, 1), cB + hstep + kstep, voffB);
        PG8_WAIT_V(6); PG8_BAR;
    } else {
        PG8_STAGE(PG8_SB(0, 0), cB, voffB); PG8_STAGE(PG8_SA(0, 0), cA, voffA); PG8_STAGE(PG8_SB(0, 1), cB + hstep, voffB); PG8_STAGE(PG8_SA(0, 1), cA + hstep, voffA);
        if (wr == 1) PG8_BAR;
        PG8_WAIT_V(4); PG8_BAR;
        PG8_STAGE(PG8_SB(1, 0), cB + kstep, voffB); PG8_STAGE(PG8_SA(1, 0), cA + kstep, voffA); PG8_STAGE(PG8_SB(1, 1), cB + hstep + kstep, voffB);
        PG8_WAIT_V(6); PG8_BAR;
    }
    for (;;) {
        const bool has_next = S.next(ui + 1, nxt);
        const char* nA = has_next ? (const char*)g.A + (size_t)nxt.pm * tstep : cA; const char* nB = has_next ? (const char*)g.Bt + (size_t)nxt.pn * tstep : cB;
        for (int t = 0; t < nt; t += 2) {
            const bool last = (t == nt - 2);
            const char* a1 = cA + (size_t)(t + 1) * kstep;
            const char* a2 = last ? nA : cA + (size_t)(t + 2) * kstep; const char* b2 = last ? nB : cB + (size_t)(t + 2) * kstep;
            const char* a3 = a2 + kstep; const char* b3 = b2 + kstep;
            if (last && has_next) S.a_ready(nxt);
            if constexpr (SP2) {
            PG8_LDB(B0, 0, 0); PG8_LDB(B1, 0, 1); PG8_SCHED; PG8_LDA(At, 0, 0); PG8_STAGE(PG8_SA(1, 1), a1 + hstep, voffA);
            PG8_WAIT_V(8); PG8_WAIT_L(0); PG8_BAR; PG8_MMA(0, 0, At, B0); PG8_MMA(0, 1, At, B1); PG8_BAR; PG8_SCHED;
            PG8_LDA(At, 0, 1); PG8_STAGE(PG8_SB(0, 0), b2, voffB); PG8_STAGE(PG8_SB(0, 1), b2 + hstep, voffB); PG8_STAGE(PG8_SA(0, 0), a2, voffA);
            PG8_WAIT_V(8); PG8_WAIT_L(0); PG8_BAR; PG8_MMA(1, 0, At, B0); PG8_MMA(1, 1, At, B1); PG8_BAR; PG8_SCHED;
            PG8_LDB(B0, 1, 0); PG8_LDB(B1, 1, 1); PG8_SCHED; PG8_LDA(At, 1, 0); PG8_STAGE(PG8_SA(0, 1), a2 + hstep, voffA);
            PG8_WAIT_V(8); PG8_WAIT_L(0); PG8_BAR; PG8_MMA(0, 0, At, B0); PG8_MMA(0, 1, At, B1); PG8_BAR; PG8_SCHED;
            PG8_LDA(At, 1, 1); PG8_STAGE(PG8_SB(1, 0), b3, voffB); PG8_STAGE(PG8_SB(1, 1), b3 + hstep, voffB); PG8_STAGE(PG8_SA(1, 0), a3, voffA);
            PG8_WAIT_V(8); PG8_WAIT_L(0); PG8_BAR; PG8_MMA(1, 0, At, B0); PG8_MMA(1, 1, At, B1); PG8_BAR; PG8_SCHED;
            } else {
            PG8_LDB(B0, 0, 0); PG8_SCHED; PG8_LDA(At, 0, 0); PG8_STAGE(PG8_SA(1, 1), a1 + hstep, voffA);
            PG8_WAIT_L(8); PG8_BAR; PG8_WAIT_L(0); PG8_MMA(0, 0, At, B0); PG8_BAR; PG8_SCHED;
            PG8_LDB(B1, 0, 1); PG8_STAGE(PG8_SB(0, 0), b2, voffB);
            PG8_BAR; PG8_WAIT_L(0); PG8_MMA(0, 1, At, B1); PG8_BAR;
            PG8_LDA(At, 0, 1); PG8_STAGE(PG8_SA(0, 0), a2, voffA);
            PG8_BAR; PG8_WAIT_L(0); PG8_MMA(1, 0, At, B0); PG8_BAR; PG8_SCHED;
            PG8_STAGE(PG8_SB(0, 1), b2 + hstep, voffB);
            PG8_WAIT_V(6); PG8_BAR; PG8_MMA(1, 1, At, B1); PG8_BAR;
            PG8_LDB(B0, 1, 0); PG8_SCHED; PG8_LDA(At, 1, 0); PG8_STAGE(PG8_SA(0, 1), a2 + hstep, voffA);
            PG8_WAIT_L(8); PG8_BAR; PG8_WAIT_L(0); PG8_MMA(0, 0, At, B0); PG8_BAR; PG8_SCHED;
            PG8_LDB(B1, 1, 1); PG8_STAGE(PG8_SB(1, 0), b3, voffB);
            PG8_BAR; PG8_WAIT_L(0); PG8_MMA(0, 1, At, B1); PG8_BAR;
            PG8_LDA(At, 1, 1); PG8_STAGE(PG8_SA(1, 0), a3, voffA);
            PG8_BAR; PG8_WAIT_L(0); PG8_MMA(1, 0, At, B0); PG8_BAR; PG8_SCHED;
            PG8_STAGE(PG8_SB(1, 1), b3 + hstep, voffB);
            PG8_WAIT_V(6); PG8_BAR; PG8_MMA(1, 1, At, B1); PG8_BAR;
            }
        }
        if constexpr (ALIGN_EPI) { if (wr == 0) PG8_BAR; }
        if constexpr (!Epi::AFTER_DRAIN) { E(acc, cur, wr, wc, fr, fq); S.done(cur); }
        if (!has_next) break;
#pragma unroll
        for (int a = 0; a < 2; ++a)
#pragma unroll
            for (int b = 0; b < 2; ++b)
#pragma unroll
                for (int m = 0; m < 4; ++m)
#pragma unroll
                    for (int n = 0; n < 2; ++n) acc[a][b][m][n] = (f32x4){0.f, 0.f, 0.f, 0.f};
        cur = nxt; cA = nA; cB = nB; ++ui;
        if constexpr (ALIGN_EPI) { if (wr == 1) PG8_BAR; }
    }
    PG8_WAIT_V(0);
    if constexpr (!ALIGN_EPI) { if (wr == 0) PG8_BAR; }
    PG8_BAR;
    if constexpr (Epi::AFTER_DRAIN) { E.fused(acc, cur, wr, wc, fr, fq, lds, wid, lane); S.done(cur); }
#undef PG8_SA
#undef PG8_SB
#undef PG8_STAGE
#undef PG8_LDA
#undef PG8_LDB
#undef PG8_MMA
#undef PG8_WAIT_V
#undef PG8_WAIT_L
#undef PG8_BAR
#undef PG8_SCHED
}
}
using pg8::f32x4; using pg8::u32x4;

__device__ __forceinline__ void transpose_item(const float* W, int K, int N, bf16_t* WT, int row_off, float* scr, int item, int lane) {
    const int nblk = N / 32, kb = item / nblk, nbk = item % nblk, k0 = 64 * kb, n0 = 32 * nbk;
#pragma unroll 8
    for (int i = 0; i < 32; ++i) { const int kk = 2 * i + (lane >> 5); scr[kk * 33 + (lane & 31)] = W[(size_t)(k0 + kk) * N + n0 + (lane & 31)]; }
    asm volatile("s_waitcnt lgkmcnt(0)" ::: "memory");
    const int c = lane & 7;
#pragma unroll
    for (int j = 0; j < 4; ++j) { const int n = (lane >> 3) + 8 * j; const float* s = scr + (8 * c) * 33 + n;
        uint4 o; o.x = pk2(s[0 * 33], s[1 * 33]); o.y = pk2(s[2 * 33], s[3 * 33]); o.z = pk2(s[4 * 33], s[5 * 33]); o.w = pk2(s[6 * 33], s[7 * 33]);
        *(uint4*)(WT + (size_t)(row_off + n0 + n) * K + k0 + 8 * c) = o; }
    asm volatile("s_waitcnt lgkmcnt(0)" ::: "memory");
}
__device__ __forceinline__ void ph_prep(const Params& p, int bid, int nb, float* lds) {
    const int tid = tid_(), wave = tid >> 6, lane = tid & 63;
    {
        float* sl = lds;
        float* red = lds + 4096;
        for (int i = tid; i < 4096; i += NTH) sl[i] = siluf_(p.c[i]);
        __syncthreads();
        for (int it = bid; it < 192; it += nb) {
            const int c4 = tid & 15, kg = tid >> 4;
            const float* wp = p.w_ada + (size_t)kg * NMOD + it * 64 + c4 * 4;
            float a0[4] = {0.f, 0.f, 0.f, 0.f}, a1[4] = {0.f, 0.f, 0.f, 0.f};
#pragma unroll 8
            for (int i = 0; i < 64; ++i) {
                const int k = kg + 32 * i;
                const float4 w = *(const float4*)(wp + (size_t)(32 * i) * NMOD);
                const float s0 = sl[k], s1 = sl[2048 + k];
                a0[0] += s0 * w.x; a0[1] += s0 * w.y; a0[2] += s0 * w.z; a0[3] += s0 * w.w;
                a1[0] += s1 * w.x; a1[1] += s1 * w.y; a1[2] += s1 * w.z; a1[3] += s1 * w.w;
            }
            __syncthreads();
#pragma unroll
            for (int e = 0; e < 4; ++e) { red[(kg * 16 + c4) * 8 + e] = a0[e]; red[(kg * 16 + c4) * 8 + 4 + e] = a1[e]; }
            __syncthreads();
            if (tid < 128) {
                const int b = tid >> 6, col = tid & 63;
                float s = 0.f;
                for (int g = 0; g < 32; ++g) s += red[(g * 16 + (col >> 2)) * 8 + b * 4 + (col & 3)];
                p.ada[b * NMOD + it * 64 + col] = s + p.b_ada[it * 64 + col];
            }
        }
        __syncthreads();
    }
    for (int e = bid * NTH + tid; e < NTOK * 64; e += nb * NTH) {
        const int tok = e >> 6, j = e & 63;
        const float ang = (float)p.pos[tok] * c_freq[j];
        float s, c; sincos_acc(ang, s, c);
        p.rope[(size_t)e * 2] = c; p.rope[(size_t)e * 2 + 1] = s;
    }
    {
        float* scr = lds + wave * (64 * 33);
        const int gw = bid * 8 + wave, ngw = nb * 8;
        constexpr int I1 = 32 * 256, I2 = 32 * 128, I3 = 16 * 64, I4 = 32 * 64;
        constexpr int NIT = I1 + I2 + I3 + 3 * I4;
        for (int it = gw; it < NIT; it += ngw) {
            int r = it;
            if (r < I1) { transpose_item(p.w_in, 2048, 8192, p.Wt1, 0, scr, r, lane); continue; } r -= I1;
            if (r < I2) { transpose_item(p.w_bg, 2048, 4096, p.Wt1, 8192, scr, r, lane); continue; } r -= I2;
            if (r < I3) { transpose_item(p.w_a_out, 1024, 2048, p.Wta, 0, scr, r, lane); continue; } r -= I3;
            if (r < I4) { transpose_item(p.w_b_out, 2048, 2048, p.Wtb, 0, scr, r, lane); continue; } r -= I4;
            if (r < I4) { transpose_item(p.w_o, 2048, 2048, p.Wto, 0, scr, r, lane); continue; } r -= I4;
            transpose_item(p.peer_wq, 2048, 2048, p.Wtq, 0, scr, r, lane);
        }
    }
    __syncthreads();
}
__device__ __forceinline__ void ph_tabconv(const Params& p, int bid, int nb) {
    const int tid = tid_(), wave = tid >> 6, lane = tid & 63;
    for (int r = bid * 8 + wave; r < 2 * 16384; r += nb * 8) {
        const bool second = r >= 16384; const int row = second ? r - 16384 : r;
        const float* src = (second ? p.peer_v : p.peer_u) + (size_t)row * DM;
        float4 v[2][4]; float am = 0.f;
#pragma unroll
        for (int j = 0; j < 2; ++j)
#pragma unroll
            for (int q = 0; q < 4; ++q) { v[j][q] = *(const float4*)(src + (lane + 64 * j) * 16 + 4 * q);
                am = fmaxf(am, fmaxf(fmaxf(fabsf(v[j][q].x), fabsf(v[j][q].y)), fmaxf(fabsf(v[j][q].z), fabsf(v[j][q].w)))); }
        am = wave_max(am);
        const float sc = (am > 0.f) ? am * (1.0f / 384.0f) : 1.0f, inv = (am > 0.f) ? 384.0f / am : 1.0f;
        unsigned char* dst = (second ? p.V8 : p.U8) + (size_t)row * DM;
#pragma unroll
        for (int j = 0; j < 2; ++j) {
            unsigned w[4];
#pragma unroll
            for (int q = 0; q < 4; ++q) { int t = 0; t = __builtin_amdgcn_cvt_pk_fp8_f32(v[j][q].x * inv, v[j][q].y * inv, t, false); t = __builtin_amdgcn_cvt_pk_fp8_f32(v[j][q].z * inv, v[j][q].w * inv, t, true); w[q] = (unsigned)t; }
            *(uint4*)(dst + (lane + 64 * j) * 16) = make_uint4(w[0], w[1], w[2], w[3]);
        }
        if (lane == 0) (second ? p.sv : p.su)[row] = sc;
    }
}

__device__ __forceinline__ void ph_modnorm(const Params& p, const float* xin, const float* g, int sh_off, int sc_off, bf16_t* hout, int bid, int nb, float* lds) {
    const int tid = tid_(), wave = tid >> 6, lane = tid & 63;
    for (int row = bid * 8 + wave; row < NTOK; row += nb * 8) {
        const int b = row / SQ;
        const float4* xr = (const float4*)(xin + (size_t)row * DM);
        float4 v[8]; float ss = 0.f;
#pragma unroll
        for (int j = 0; j < 8; ++j) { v[j] = xr[lane + 64 * j]; ss += dot4(v[j], v[j]); }
        ss = wave_sum(ss);
        const float rs = 1.0f / sqrtf(ss * (1.0f / DM) + 1e-6f);
#pragma unroll
        for (int j = 0; j < 8; ++j) {
            const int col = (lane + 64 * j) * 4;
            const float4 g4 = *(const float4*)(g + col);
            const float4 sc = *(const float4*)(p.ada + b * NMOD + sc_off + col);
            const float4 sh = *(const float4*)(p.ada + b * NMOD + sh_off + col);
            float4 o;
            o.x = v[j].x * rs * g4.x * (1.0f + sc.x) + sh.x; o.y = v[j].y * rs * g4.y * (1.0f + sc.y) + sh.y;
            o.z = v[j].z * rs * g4.z * (1.0f + sc.z) + sh.z; o.w = v[j].w * rs * g4.w * (1.0f + sc.w) + sh.w;
            *(uint2*)(hout + (size_t)row * DM + col) = make_uint2(pk2(o.x, o.y), pk2(o.z, o.w));
        }
    }
}

__device__ __forceinline__ void ph_gmlp(const Params& p, int bid, int nb, float* lds) {
    float* vt = lds;
    float* wm = lds + 16384;
    const bf16_t* z = p.ZG;
    const int tid = tid_(), wave = tid >> 6, lane = tid & 63;
    for (int it = bid; it < 512; it += nb) {
        const int g = it & 7, n = (it >> 3) & 31, b = it >> 8;
        const int tok0 = b * SQ + n * 128;
        __syncthreads();
        for (int i = tid; i < 16384; i += NTH) { const int ii = i >> 7, jj = i & 127; wm[i] = ((ii >> 6) >= (jj >> 6)) ? p.gm_ws[g * 16384 + i] : 0.f; }
        for (int j = wave; j < 128; j += 8) {
            const bf16_t* zr = z + (size_t)(tok0 + j) * ZW + 1024 + g * 128;
            const float a = bf2f(zr[lane]), c2 = bf2f(zr[lane + 64]);
            const float ss = wave_sum(a * a + c2 * c2);
            const float rs = 1.0f / sqrtf(ss * (1.0f / 128.0f) + 1e-6f);
            vt[j * 128 + lane] = a * rs * p.gm_v_g[g * 128 + lane];
            vt[j * 128 + lane + 64] = c2 * rs * p.gm_v_g[g * 128 + lane + 64];
        }
        __syncthreads();
        const int d = tid & 127, ig = tid >> 7;
        float acc[32];
#pragma unroll
        for (int ii = 0; ii < 32; ++ii) acc[ii] = 0.f;
        for (int j = 0; j < 128; ++j) {
            const float vv = vt[j * 128 + d];
#pragma unroll
            for (int ii = 0; ii < 32; ++ii) acc[ii] += wm[(ig * 32 + ii) * 128 + j] * vv;
        }
#pragma unroll
        for (int ii = 0; ii < 32; ++ii) {
            const int i = ig * 32 + ii;
            const float s = acc[ii] + p.gm_b[g * 128 + i];
            const size_t tok = (size_t)(tok0 + i);
            const float u = bf2f(z[tok * ZW + g * 128 + d]);
            p.yain[tok * 1024 + g * 128 + d] = (bf16_t)f2bf(u * s);
        }
    }
    __syncthreads();
}

__device__ __forceinline__ void ph_ret(const Params& p, int bid, int nb, float* lds) {
    float* Qs = lds;
    float* Ks = Qs + 64 * 129;
    float* Vs = Ks + 64 * 129;
    float* Ss = Vs + 64 * 16;
    float* At = Ss + 128 * 16;
    float* kd = At + 64 * 65;
    const int tid = tid_();
    const bf16_t* z = p.ZG;
    for (int it = bid; it < 256; it += nb) {
        const int vs = it & 15, h = (it >> 4) & 7, b = it >> 7;
        const float lg = log1pf(-exp2f(-5.0f - (float)h));
        const float cdec = expf(lg * 64.0f);
        __syncthreads();
        for (int i = tid; i < 2048; i += NTH) Ss[i] = 0.f;
        if (tid < 64) kd[tid] = expf(lg * (float)(63 - tid));
        for (int n = 0; n < 64; ++n) {
            const int tok0 = b * SQ + n * 64;
            __syncthreads();
            for (int e = tid; e < 4096; e += NTH) {
                const int i = e >> 6, dd = e & 63; const size_t tok = (size_t)(tok0 + i);
                const float cs = p.rope[(tok * 64 + dd) * 2], sn = p.rope[(tok * 64 + dd) * 2 + 1];
                const bf16_t* zr = z + tok * ZW;
                const float q1 = bf2f(zr[2048 + h * 128 + dd]), q2 = bf2f(zr[2048 + h * 128 + 64 + dd]);
                const float k1 = bf2f(zr[3072 + h * 128 + dd]), k2 = bf2f(zr[3072 + h * 128 + 64 + dd]);
                Qs[i * 129 + dd] = q1 * cs - q2 * sn; Qs[i * 129 + 64 + dd] = q1 * sn + q2 * cs;
                const float sc = 0.08838834764831845f;
                Ks[i * 129 + dd] = (k1 * cs - k2 * sn) * sc; Ks[i * 129 + 64 + dd] = (k1 * sn + k2 * cs) * sc;
            }
            for (int e = tid; e < 1024; e += NTH) { const int j = e >> 4, v = e & 15; Vs[e] = bf2f(z[(size_t)(tok0 + j) * ZW + 4096 + h * 256 + vs * 16 + v]); }
            __syncthreads();
            {
                const int j = tid & 63, i0 = (tid >> 6) * 8;
                float acc[8];
#pragma unroll
                for (int ii = 0; ii < 8; ++ii) acc[ii] = 0.f;
                for (int d = 0; d < 128; ++d) {
                    const float kv = Ks[j * 129 + d];
#pragma unroll
                    for (int ii = 0; ii < 8; ++ii) acc[ii] += Qs[(i0 + ii) * 129 + d] * kv;
                }
#pragma unroll
                for (int ii = 0; ii < 8; ++ii) { const int i = i0 + ii; At[i * 65 + j] = acc[ii] * expf(lg * fabsf((float)(i - j))); }
            }
            __syncthreads();
            {
                const int v = tid & 15, i0 = tid >> 4;
#pragma unroll
                for (int rep = 0; rep < 2; ++rep) {
                    const int i = i0 + 32 * rep;
                    float a = 0.f; for (int j = 0; j < 64; ++j) a += At[i * 65 + j] * Vs[j * 16 + v];
                    float c2 = 0.f; for (int d = 0; d < 128; ++d) c2 += Qs[i * 129 + d] * Ss[d * 16 + v];
                    p.obuf[(size_t)(tok0 + i) * DM + h * 256 + vs * 16 + v] = a + c2 * expf(lg * (float)(i + 1));
                }
            }
            __syncthreads();
            {
                const int v = tid & 15, d0 = tid >> 4;
#pragma unroll
                for (int rep = 0; rep < 4; ++rep) {
                    const int d = d0 + 32 * rep;
                    float a = 0.f; for (int j = 0; j < 64; ++j) a += Ks[j * 129 + d] * kd[j] * Vs[j * 16 + v];
                    Ss[d * 16 + v] = Ss[d * 16 + v] * cdec + a;
                }
            }
        }
    }
    __syncthreads();
}

typedef short bf16x8_t __attribute__((ext_vector_type(8)));
typedef float f32x4_t __attribute__((ext_vector_type(4)));

__device__ __forceinline__ void ph_retprep(const Params& p, int bid, int nb, float* lds) {
    bf16_t* Kl = (bf16_t*)lds;
    bf16_t* Vl = Kl + 64 * 130;
    const int tid = tid_();
    for (int it = bid; it < 1024; it += nb) {
        const int n = it & 63, h = (it >> 6) & 7, b = it >> 9;
        const int tok0 = b * SQ + n * 64;
        const size_t rowbase = (size_t)(b * 8 + h) * SQ + n * 64;
        const float lg = log1pf(-exp2f(-5.0f - (float)h));
        __syncthreads();
        for (int e = tid; e < 4096; e += NTH) {
            const int i = e >> 6, dd = e & 63; const size_t tok = (size_t)(tok0 + i);
            const float2 cssn = *(const float2*)(p.rope + (tok * 64 + dd) * 2);
            const float cs = cssn.x, sn = cssn.y;
            const bf16_t* zr = p.ZG + tok * ZW;
            const float q1 = bf2f(zr[2048 + h * 128 + dd]), q2 = bf2f(zr[2048 + h * 128 + 64 + dd]);
            const float k1 = bf2f(zr[3072 + h * 128 + dd]), k2 = bf2f(zr[3072 + h * 128 + 64 + dd]);
            const float sc = 0.08838834764831845f;
            const float qa = q1 * cs - q2 * sn, qb = q1 * sn + q2 * cs, ka = (k1 * cs - k2 * sn) * sc, kb = (k1 * sn + k2 * cs) * sc;
            p.Qr[(rowbase + i) * 128 + dd] = (bf16_t)f2bf(qa); p.Qr[(rowbase + i) * 128 + 64 + dd] = (bf16_t)f2bf(qb);
            p.Kr[(rowbase + i) * 128 + dd] = (bf16_t)f2bf(ka); p.Kr[(rowbase + i) * 128 + 64 + dd] = (bf16_t)f2bf(kb);
            const float kd = expf(lg * (float)(63 - i));
            Kl[i * 130 + dd] = (bf16_t)f2bf(ka * kd); Kl[i * 130 + 64 + dd] = (bf16_t)f2bf(kb * kd);
        }
        for (int e = tid; e < 64 * 128; e += NTH) {
            const int j = e >> 7, vp = e & 127;
            *(unsigned*)(Vl + j * 258 + vp * 2) = *(const unsigned*)(p.ZG + (size_t)(tok0 + j) * ZW + 4096 + h * 256 + vp * 2);
        }
        __syncthreads();
        bf16_t* kt = p.KTd + (size_t)it * 8192;
        for (int e = tid; e < 8192; e += NTH) { const int d = e >> 6, j = e & 63; kt[e] = Kl[j * 130 + d]; }
        bf16_t* vt = p.Vt + (size_t)it * 16384;
        for (int e = tid; e < 16384; e += NTH) { const int v = e >> 6, j = e & 63; vt[e] = Vl[j * 258 + v]; }
    }
    __syncthreads();
}

__device__ __forceinline__ bf16x8_t ldfrag(const char* base, int row, int chunk, int rb, int sm) { return *(const bf16x8_t*)(base + row * rb + ((chunk ^ (row & sm)) << 4)); }
__device__ __forceinline__ void ph_ret2(const Params& p, int bid, int nb, float* lds) {
    char* L = (char*)lds;
    constexpr int OQ = 0, OKK = 16384, OKT = 32768, OVT = 49152, TILE = 51200, OP = 2 * TILE, OST = OP + 8192;
    const int tid = tid_(), wave = tid >> 6, lane = tid & 63, fr = lane & 15, fq = lane >> 4;
    for (int it = bid; it < 256; it += nb) {
        const int vs = it & 15, h = (it >> 4) & 7, b = it >> 7;
        const float lg = log1pf(-exp2f(-5.0f - (float)h));
        const float cdec = expf(lg * 64.0f);
        const size_t bh = (size_t)(b * 8 + h);
        const char* gQ = (const char*)(p.Qr + bh * SQ * 128);
        const char* gK = (const char*)(p.Kr + bh * SQ * 128);
        const char* gKT = (const char*)(p.KTd + bh * 64 * 8192);
        const char* gVt = (const char*)(p.Vt + bh * 64 * 16384) + vs * 16 * 128;
        int lq[2], lkt[2];
#pragma unroll
        for (int u = 0; u < 2; ++u) { const int ci = tid + 512 * u; const int r = ci >> 4, c = ci & 15; lq[u] = r * 256 + ((c ^ (r & 15)) << 4); const int d = ci >> 3, c8 = ci & 7; lkt[u] = d * 128 + ((c8 ^ (d & 7)) << 4); }
        const int lv = (tid >> 3) * 128 + (((tid & 7) ^ ((tid >> 3) & 7)) << 4);
        uint4 sq0, sq1, sk0, sk1, skt0, skt1, sv = make_uint4(0u, 0u, 0u, 0u);
#define RET_LOAD(n_) do { const size_t o0 = (size_t)(n_) * 16384 + (size_t)tid * 16, o1 = o0 + 8192; \
        sq0 = *(const uint4*)(gQ + o0); sq1 = *(const uint4*)(gQ + o1); sk0 = *(const uint4*)(gK + o0); sk1 = *(const uint4*)(gK + o1); skt0 = *(const uint4*)(gKT + o0); skt1 = *(const uint4*)(gKT + o1); \
        if (tid < 128) sv = *(const uint4*)(gVt + (size_t)(n_) * 32768 + tid * 16); } while (0)
#define RET_WRITE(buf_) do { char* B_ = L + (buf_) * TILE; \
        *(uint4*)(B_ + OQ + lq[0]) = sq0; *(uint4*)(B_ + OQ + lq[1]) = sq1; *(uint4*)(B_ + OKK + lq[0]) = sk0; *(uint4*)(B_ + OKK + lq[1]) = sk1; *(uint4*)(B_ + OKT + lkt[0]) = skt0; *(uint4*)(B_ + OKT + lkt[1]) = skt1; \
        if (tid < 128) *(uint4*)(B_ + OVT + lv) = sv; } while (0)
        __syncthreads();
        for (int i = tid; i < 1024; i += NTH) ((unsigned*)(L + OST))[i] = 0u;
        RET_LOAD(0); RET_WRITE(0);
        f32x4_t sacc[2] = {{0.f, 0.f, 0.f, 0.f}, {0.f, 0.f, 0.f, 0.f}};
        for (int n = 0; n < 64; ++n) {
            const int cur = n & 1;
            __syncthreads();
            if (n + 1 < 64) RET_LOAD(n + 1);
            const char* T = L + cur * TILE;
            {
                const int jt = wave >> 1, it0 = 2 * (wave & 1);
                f32x4_t s0 = {0.f, 0.f, 0.f, 0.f}, s1 = {0.f, 0.f, 0.f, 0.f};
#pragma unroll
                for (int ks = 0; ks < 4; ++ks) {
                    const bf16x8_t a = ldfrag(T + OKK, jt * 16 + fr, ks * 4 + fq, 256, 15);
                    const bf16x8_t b0 = ldfrag(T + OQ, it0 * 16 + fr, ks * 4 + fq, 256, 15), b1 = ldfrag(T + OQ, (it0 + 1) * 16 + fr, ks * 4 + fq, 256, 15);
                    s0 = __builtin_amdgcn_mfma_f32_16x16x32_bf16(a, b0, s0, 0, 0, 0);
                    s1 = __builtin_amdgcn_mfma_f32_16x16x32_bf16(a, b1, s1, 0, 0, 0);
                }
                const int j0 = jt * 16 + fq * 4;
#pragma unroll
                for (int tt = 0; tt < 2; ++tt) {
                    const int i = (it0 + tt) * 16 + fr; const f32x4_t sv4 = tt ? s1 : s0; float pv[4];
#pragma unroll
                    for (int r = 0; r < 4; ++r) pv[r] = sv4[r] * __expf(lg * fabsf((float)(i - (j0 + r))));
                    *(uint2*)(L + OP + i * 128 + ((((j0 >> 3)) ^ (i & 7)) << 4) + (j0 & 7) * 2) = make_uint2(pk2(pv[0], pv[1]), pk2(pv[2], pv[3]));
                }
            }
            __syncthreads();
            if (wave < 4) {
                const int itl = wave;
                f32x4_t o1 = {0.f, 0.f, 0.f, 0.f}, o2 = {0.f, 0.f, 0.f, 0.f};
#pragma unroll
                for (int ks = 0; ks < 2; ++ks) o1 = __builtin_amdgcn_mfma_f32_16x16x32_bf16(ldfrag(L + OP, itl * 16 + fr, ks * 4 + fq, 128, 7), ldfrag(T + OVT, fr, ks * 4 + fq, 128, 7), o1, 0, 0, 0);
#pragma unroll
                for (int ks = 0; ks < 4; ++ks) o2 = __builtin_amdgcn_mfma_f32_16x16x32_bf16(ldfrag(T + OQ, itl * 16 + fr, ks * 4 + fq, 256, 15), ldfrag(L + OST + cur * 4096, fr, ks * 4 + fq, 256, 15), o2, 0, 0, 0);
#pragma unroll
                for (int r = 0; r < 4; ++r) { const int i = itl * 16 + fq * 4 + r;
                    p.ob16[(size_t)(b * SQ + n * 64 + i) * DM + h * 256 + vs * 16 + fr] = (bf16_t)f2bf(o1[r] + __expf(lg * (float)(i + 1)) * o2[r]); }
            } else {
#pragma unroll
                for (int u = 0; u < 2; ++u) {
                    const int dt = 2 * (wave - 4) + u;
                    sacc[u] = sacc[u] * cdec;
#pragma unroll
                    for (int ks = 0; ks < 2; ++ks) sacc[u] = __builtin_amdgcn_mfma_f32_16x16x32_bf16(ldfrag(T + OKT, dt * 16 + fr, ks * 4 + fq, 128, 7), ldfrag(T + OVT, fr, ks * 4 + fq, 128, 7), sacc[u], 0, 0, 0);
                    *(uint2*)(L + OST + (cur ^ 1) * 4096 + fr * 256 + (((dt * 2 + (fq >> 1)) ^ fr) << 4) + (fq & 1) * 8) = make_uint2(pk2(sacc[u][0], sacc[u][1]), pk2(sacc[u][2], sacc[u][3]));
                }
            }
            if (n + 1 < 64) RET_WRITE(cur ^ 1);
        }
#undef RET_LOAD
#undef RET_WRITE
    }
    __syncthreads();
}

__device__ __forceinline__ void ph_gn(const Params& p, int bid, int nb, float* lds) {
    const int tid = tid_(), wave = tid >> 6, lane = tid & 63;
    for (int tok = bid * 8 + wave; tok < NTOK; tok += nb * 8) {
#pragma unroll
        for (int h = 0; h < 8; ++h) {
            const uint2 ow = *(const uint2*)(p.ob16 + (size_t)tok * DM + h * 256 + lane * 4);
            const float4 o = make_float4(bflo(ow.x), bfhi(ow.x), bflo(ow.y), bfhi(ow.y));
            const float mu = wave_sum(o.x + o.y + o.z + o.w) * (1.0f / 256.0f);
            const float4 d = make_float4(o.x - mu, o.y - mu, o.z - mu, o.w - mu);
            const float var = wave_sum(dot4(d, d)) * (1.0f / 256.0f);
            const float rs = 1.0f / sqrtf(var + 1e-6f);
            const float4 gn = *(const float4*)(p.ret_gn_g + h * 256 + lane * 4);
            const uint2 gw = *(const uint2*)(p.ZG + (size_t)tok * ZW + 6144 + h * 256 + lane * 4);
            const float g0 = bflo(gw.x), g1 = bfhi(gw.x), g2 = bflo(gw.y), g3 = bfhi(gw.y);
            *(uint2*)(p.ybin + (size_t)tok * DM + h * 256 + lane * 4) =
                make_uint2(pk2(siluf_(g0) * d.x * rs * gn.x, siluf_(g1) * d.y * rs * gn.y), pk2(siluf_(g2) * d.z * rs * gn.z, siluf_(g3) * d.w * rs * gn.w));
        }
    }
}

template <int NL>
__device__ __forceinline__ void wave_top16(float (&v)[NL], const int (&idx)[NL], float& outv, int& outi, int lane) {
    outv = 0.f; outi = 0;
    for (int r = 0; r < 16; ++r) {
        float m = v[0];
#pragma unroll
        for (int u = 1; u < NL; ++u) m = fmaxf(m, v[u]);
        const float wm = wave_max(m);
        const unsigned long long bal = __ballot(m == wm);
        const int owner = __ffsll((long long)bal) - 1;
        int myi = -1;
        if (lane == owner) {
            bool done = false;
#pragma unroll
            for (int u = 0; u < NL; ++u) if (!done && v[u] == wm) { myi = idx[u]; v[u] = -INFINITY; done = true; }
        }
        const int wi = __shfl(myi, owner);
        if (lane == r) { outv = wm; outi = wi; }
    }
}
__device__ __forceinline__ void ph_topk(const Params& p, const float* qb, int bid, int nb, float* lds) {
    const int tid = tid_(), wave = tid >> 6, lane = tid & 63;
    for (int t = bid; t < NTOK; t += nb) {
        const int h = wave;
        const float* q = qb + (size_t)t * DM + h * 256;
        float s[2][2];
#pragma unroll
        for (int pp = 0; pp < 2; ++pp)
#pragma unroll
            for (int r = 0; r < 2; ++r) {
                const int n = lane + 64 * r;
                const float4* kr = (const float4*)(p.peer_sk + ((size_t)(h * 2 + pp) * 128 + n) * 128);
                const float4* qr = (const float4*)(q + pp * 128);
                float a = 0.f;
#pragma unroll 4
                for (int d4 = 0; d4 < 32; ++d4) a += dot4(kr[d4], qr[d4]);
                s[pp][r] = a;
            }
        float v1, v2; int i1, i2;
        { float vv[2] = {s[0][0], s[0][1]}; const int ii[2] = {lane, lane + 64}; wave_top16<2>(vv, ii, v1, i1, lane); }
        { float vv[2] = {s[1][0], s[1][1]}; const int ii[2] = {lane, lane + 64}; wave_top16<2>(vv, ii, v2, i2, lane); }
        float cv[4]; int ci[4];
        const int a = lane >> 2, b0 = (lane & 3) * 4;
        const float va = __shfl(v1, a); const int ia = __shfl(i1, a);
#pragma unroll
        for (int u = 0; u < 4; ++u) { const float vb = __shfl(v2, b0 + u); const int ib = __shfl(i2, b0 + u); cv[u] = va + vb; ci[u] = ia * 128 + ib; }
        float tv; int te;
        wave_top16<4>(cv, ci, tv, te, lane);
        const float mx = __shfl(tv, 0);
        const float ex = (lane < 16) ? expf(tv - mx) : 0.f;
        const float sum = wave_sum(ex);
        if (lane < 16) { p.eidx[(size_t)t * 128 + h * 16 + lane] = te; p.gatev[(size_t)t * 128 + h * 16 + lane] = ex / sum; }
    }
}

__device__ __forceinline__ void ph_peer(const Params& p, const float* x1, const bf16_t* h2, int bid, int nb, float* lds) {
    float* ys = lds;
    float* red = lds + 8 * 2048;
    const int tid = tid_(), wave = tid >> 6, lane = tid & 63;
    for (int t = bid; t < NTOK; t += nb) {
        const int b = t / SQ, h = wave;
        const uint2* hr = (const uint2*)(h2 + (size_t)t * DM);
        float4 hv[8], y[8];
#pragma unroll
        for (int j = 0; j < 8; ++j) { const uint2 w = hr[lane + 64 * j]; hv[j] = make_float4(bflo(w.x), bfhi(w.x), bflo(w.y), bfhi(w.y)); y[j] = make_float4(0.f, 0.f, 0.f, 0.f); }
        for (int k = 0; k < 16; ++k) {
            const int e = p.eidx[(size_t)t * 128 + h * 16 + k]; const float gt = p.gatev[(size_t)t * 128 + h * 16 + k];
            const float4* ur = (const float4*)(p.peer_u + (size_t)e * DM);
            float a = 0.f;
#pragma unroll
            for (int j = 0; j < 8; ++j) a += dot4(ur[lane + 64 * j], hv[j]);
            a = wave_sum(a);
            const float w = geluf_(a) * gt;
            const float4* vr = (const float4*)(p.peer_v + (size_t)e * DM);
#pragma unroll
            for (int j = 0; j < 8; ++j) { const float4 v4 = vr[lane + 64 * j]; y[j].x += w * v4.x; y[j].y += w * v4.y; y[j].z += w * v4.z; y[j].w += w * v4.w; }
        }
        __syncthreads();
#pragma unroll
        for (int j = 0; j < 8; ++j) *(float4*)(ys + h * 2048 + (lane + 64 * j) * 4) = y[j];
        __syncthreads();
        const int c = tid * 4;
        float4 s = make_float4(0.f, 0.f, 0.f, 0.f);
#pragma unroll
        for (int hh = 0; hh < 8; ++hh) { const float4 a = *(const float4*)(ys + hh * 2048 + c); s.x += a.x; s.y += a.y; s.z += a.z; s.w += a.w; }
        const float4 xv = *(const float4*)(x1 + (size_t)t * DM + c);
        const float4 ga = *(const float4*)(p.ada + b * NMOD + 5 * DM + c);
        const float4 x2 = make_float4(xv.x + ga.x * s.x, xv.y + ga.y * s.y, xv.z + ga.z * s.z, xv.w + ga.w * s.w);
        const float ss = wave_sum(dot4(x2, x2));
        if (lane == 0) red[wave] = ss;
        __syncthreads();
        float tot = 0.f;
#pragma unroll
        for (int w = 0; w < 8; ++w) tot += red[w];
        const float rs = 1.0f / sqrtf(tot * (1.0f / DM) + 1e-6f);
        const float4 gf = *(const float4*)(p.norm_f_g + c);
        *(float4*)(p.out + (size_t)t * DM + c) = make_float4(x2.x * rs * gf.x, x2.y * rs * gf.y, x2.z * rs * gf.z, x2.w * rs * gf.w);
    }
    __syncthreads();
}

__device__ __forceinline__ void split8(const float4 a, const float4 b, uint4& hi, uint4& lo) {
    const float x[8] = {a.x, a.y, a.z, a.w, b.x, b.y, b.z, b.w}; unsigned h[8], l[8];
#pragma unroll
    for (int i = 0; i < 8; ++i) { h[i] = f2bf(x[i]); l[i] = f2bf(x[i] - __uint_as_float(h[i] << 16)); }
    hi = make_uint4(h[0] | (h[1] << 16), h[2] | (h[3] << 16), h[4] | (h[5] << 16), h[6] | (h[7] << 16));
    lo = make_uint4(l[0] | (l[1] << 16), l[2] | (l[3] << 16), l[4] | (l[5] << 16), l[6] | (l[7] << 16));
}
__device__ __forceinline__ bf16x8_t as_bf16x8(const uint4 v) { return __builtin_bit_cast(bf16x8_t, v); }
struct PairTab { int a[52], b[52]; };
__host__ __device__ constexpr PairTab make_pairs() {
    PairTab t{}; int n = 0;
    for (int a = 0; a < 16; ++a) for (int b = 0; b < 16; ++b) if ((a + 1) * (b + 1) <= 16) { t.a[n] = a; t.b[n] = b; ++n; }
    for (; n < 52; ++n) { t.a[n] = -1; t.b[n] = -1; }
    return t;
}
constexpr PairTab PAIRS = make_pairs();
static_assert(PAIRS.a[49] >= 0 && PAIRS.a[50] < 0, "50 candidate pairs");

__device__ __forceinline__ void ph_topk2(const Params& p, const float* qb, int bid, int nb, float* lds) {
    const int tid = tid_(), wave = tid >> 6, lane = tid & 63;
    uint4* SK = (uint4*)lds;
    const float NEG = -INFINITY;
    for (int it = bid; it < 256; it += nb) {
        const int h = it & 7, tg = it >> 3;
        __syncthreads();
        for (int gi = tid; gi < 4096; gi += NTH) {
            const int dq = gi & 15, n = (gi >> 4) & 127, pp = gi >> 11;
            const float4* src = (const float4*)(p.peer_sk + ((size_t)(h * 2 + pp) * 128 + n) * 128 + dq * 8);
            uint4 hi, lo; split8(src[0], src[1], hi, lo);
            const int base = (((pp * 8 + (n >> 4)) * 4 + (dq >> 2)) * 2) * 64 + (dq & 3) * 16 + (n & 15);
            SK[base] = hi; SK[base + 64] = lo;
        }
        __syncthreads();
#pragma unroll 1
        for (int tile = 0; tile < 2; ++tile) {
            const int tok = tg * 256 + wave * 32 + tile * 16 + (lane & 15);
            const int qd = lane >> 4;
            float v12[2][16];
#pragma unroll
            for (int pp = 0; pp < 2; ++pp) {
                bf16x8_t Bh[4], Bl[4];
                const float* qp = qb + (size_t)tok * DM + h * 256 + pp * 128 + 8 * qd;
#pragma unroll
                for (int ks = 0; ks < 4; ++ks) { uint4 hi, lo; split8(*(const float4*)(qp + ks * 32), *(const float4*)(qp + ks * 32 + 4), hi, lo); Bh[ks] = as_bf16x8(hi); Bl[ks] = as_bf16x8(lo); }
                float v[32];
#pragma unroll
                for (int kt = 0; kt < 8; ++kt) {
                    f32x4_t acc = {0.f, 0.f, 0.f, 0.f};
#pragma unroll
                    for (int ks = 0; ks < 4; ++ks) {
                        const bf16x8_t Ah = as_bf16x8(SK[(((pp * 8 + kt) * 4 + ks) * 2) * 64 + lane]), Al = as_bf16x8(SK[(((pp * 8 + kt) * 4 + ks) * 2 + 1) * 64 + lane]);
                        acc = __builtin_amdgcn_mfma_f32_16x16x32_bf16(Ah, Bh[ks], acc, 0, 0, 0);
                        acc = __builtin_amdgcn_mfma_f32_16x16x32_bf16(Ah, Bl[ks], acc, 0, 0, 0);
                        acc = __builtin_amdgcn_mfma_f32_16x16x32_bf16(Al, Bh[ks], acc, 0, 0, 0);
                    }
#pragma unroll
                    for (int r = 0; r < 4; ++r) v[kt * 4 + r] = __uint_as_float((__float_as_uint(acc[r]) & ~127u) | (unsigned)(kt * 16 + qd * 4 + r));
                    __builtin_amdgcn_sched_barrier(0);
                }
#pragma unroll
                for (int r = 0; r < 16; ++r) {
                    float m = v[0];
#pragma unroll
                    for (int u = 1; u < 32; ++u) m = fmaxf(m, v[u]);
                    m = fmaxf(m, __shfl_xor(m, 16)); m = fmaxf(m, __shfl_xor(m, 32));
                    v12[pp][r] = m;
#pragma unroll
                    for (int u = 0; u < 32; ++u) v[u] = (v[u] == m) ? NEG : v[u];
                }
            }
            float c[13]; unsigned pay[13];
#pragma unroll
            for (int s = 0; s < 13; ++s) {
                float cq[4]; unsigned pq[4];
#pragma unroll
                for (int q = 0; q < 4; ++q) {
                    const int pi = 4 * s + q; const int a = PAIRS.a[pi], b = PAIRS.b[pi];
                    if (a >= 0) {
                        const float sum = v12[0][a] + v12[1][b];
                        cq[q] = __uint_as_float((__float_as_uint(sum) & ~63u) | (unsigned)pi);
                        pq[q] = (__float_as_uint(v12[0][a]) & 127u) * 128u + (__float_as_uint(v12[1][b]) & 127u);
                    } else { cq[q] = NEG; pq[q] = 0u; }
                }
                c[s] = qd == 0 ? cq[0] : qd == 1 ? cq[1] : qd == 2 ? cq[2] : cq[3];
                pay[s] = qd == 0 ? pq[0] : qd == 1 ? pq[1] : qd == 2 ? pq[2] : pq[3];
            }
            float top[16]; unsigned eid[16];
#pragma unroll
            for (int r = 0; r < 16; ++r) {
                float m = c[0];
#pragma unroll
                for (int s = 1; s < 13; ++s) m = fmaxf(m, c[s]);
                m = fmaxf(m, __shfl_xor(m, 16)); m = fmaxf(m, __shfl_xor(m, 32));
                unsigned pw = 0u;
#pragma unroll
                for (int s = 0; s < 13; ++s) { const bool eq = (c[s] == m); pw |= eq ? pay[s] : 0u; c[s] = eq ? NEG : c[s]; }
                pw |= (unsigned)__shfl_xor((int)pw, 16); pw |= (unsigned)__shfl_xor((int)pw, 32);
                top[r] = m; eid[r] = pw;
            }
            float sum = 0.f; const float mx = top[0];
#pragma unroll
            for (int r = 0; r < 16; ++r) { top[r] = expf(top[r] - mx); sum += top[r]; }
            const float inv = 1.0f / sum;
            if (lane < 16) {
                int4* ep = (int4*)(p.eidx + (size_t)tok * 128 + h * 16); float4* gp = (float4*)(p.gatev + (size_t)tok * 128 + h * 16);
#pragma unroll
                for (int q = 0; q < 4; ++q) {
                    ep[q] = make_int4((int)eid[4 * q], (int)eid[4 * q + 1], (int)eid[4 * q + 2], (int)eid[4 * q + 3]);
                    gp[q] = make_float4(top[4 * q] * inv, top[4 * q + 1] * inv, top[4 * q + 2] * inv, top[4 * q + 3] * inv);
                }
            }
        }
    }
    __syncthreads();
}

typedef float f32x2_t __attribute__((ext_vector_type(2)));
__device__ __forceinline__ void peer_load4(const unsigned char* tab, const int (&e)[4], int lane, uint4 (&R)[4][2]) {
#pragma unroll
    for (int i = 0; i < 4; ++i) { const uint4* r = (const uint4*)(tab + (size_t)e[i] * DM) + lane; R[i][0] = r[0]; R[i][1] = r[64]; }
}
__device__ __forceinline__ void ph_peer3(const Params& p, const float* x1, const bf16_t* h2, int bid, int nb) {
    const int tid = tid_(), wave = tid >> 6, lane = tid & 63;
    for (int t = bid * 8 + wave; t < NTOK; t += nb * 8) {
        const int b = t / SQ;
        float hv[32], y[32];
#pragma unroll
        for (int j = 0; j < 2; ++j)
#pragma unroll
            for (int q = 0; q < 2; ++q) { const uint4 w = *(const uint4*)(h2 + (size_t)t * DM + (lane + 64 * j) * 16 + 8 * q); float* d = hv + 16 * j + 8 * q;
                d[0] = bflo(w.x); d[1] = bfhi(w.x); d[2] = bflo(w.y); d[3] = bfhi(w.y); d[4] = bflo(w.z); d[5] = bfhi(w.z); d[6] = bflo(w.w); d[7] = bfhi(w.w); }
#pragma unroll
        for (int i = 0; i < 32; ++i) y[i] = 0.f;
        const int e0 = p.eidx[(size_t)t * 128 + lane], e1 = p.eidx[(size_t)t * 128 + 64 + lane];
        const float g0 = p.gatev[(size_t)t * 128 + lane], g1 = p.gatev[(size_t)t * 128 + 64 + lane];
        const float su0 = p.su[e0], su1 = p.su[e1];
        const float gv0 = g0 * p.sv[e0], gv1 = g1 * p.sv[e1];
        uint4 Uc[4][2], Un[4][2], Vc[4][2];
        { int e[4];
#pragma unroll
          for (int i = 0; i < 4; ++i) e[i] = __builtin_amdgcn_readlane(e0, i);
          peer_load4(p.U8, e, lane, Uc); }
        for (int g = 0; g < 32; ++g) {
            const bool lo = g < 16; const int k0 = (4 * g) & 63;
            const int ee = lo ? e0 : e1; const float suu = lo ? su0 : su1, gvv = lo ? gv0 : gv1;
            int e[4]; float sa[4], gw[4];
#pragma unroll
            for (int i = 0; i < 4; ++i) { e[i] = __builtin_amdgcn_readlane(ee, k0 + i);
                sa[i] = __uint_as_float(__builtin_amdgcn_readlane(__float_as_uint(suu), k0 + i)); gw[i] = __uint_as_float(__builtin_amdgcn_readlane(__float_as_uint(gvv), k0 + i)); }
            peer_load4(p.V8, e, lane, Vc);
            {
                const int gn = (g < 31) ? g + 1 : g; const int en = (gn < 16) ? e0 : e1; const int kn = (4 * gn) & 63; int e2[4];
#pragma unroll
                for (int i = 0; i < 4; ++i) e2[i] = __builtin_amdgcn_readlane(en, kn + i);
                peer_load4(p.U8, e2, lane, Un);
            }
            float a[4];
#pragma unroll
            for (int i = 0; i < 4; ++i) {
                float acc = 0.f;
#pragma unroll
                for (int j = 0; j < 2; ++j) {
                    const unsigned w[4] = {Uc[i][j].x, Uc[i][j].y, Uc[i][j].z, Uc[i][j].w};
#pragma unroll
                    for (int q = 0; q < 4; ++q) {
                        const f32x2_t c0 = __builtin_amdgcn_cvt_pk_f32_fp8((int)w[q], false), c1 = __builtin_amdgcn_cvt_pk_f32_fp8((int)w[q], true);
                        const float* hh = hv + 16 * j + 4 * q;
                        acc += c0.x * hh[0] + c0.y * hh[1] + c1.x * hh[2] + c1.y * hh[3];
                    }
                }
                a[i] = acc;
            }
#pragma unroll
            for (int o = 1; o < 64; o <<= 1) { a[0] += __shfl_xor(a[0], o); a[1] += __shfl_xor(a[1], o); a[2] += __shfl_xor(a[2], o); a[3] += __shfl_xor(a[3], o); }
            float wgt[4];
#pragma unroll
            for (int i = 0; i < 4; ++i) wgt[i] = geluf_(a[i] * sa[i]) * gw[i];
#pragma unroll
            for (int j = 0; j < 2; ++j)
#pragma unroll
                for (int q = 0; q < 4; ++q) {
                    float* yy = y + 16 * j + 4 * q;
#pragma unroll
                    for (int i = 0; i < 4; ++i) {
                        const unsigned w = (q == 0) ? Vc[i][j].x : (q == 1) ? Vc[i][j].y : (q == 2) ? Vc[i][j].z : Vc[i][j].w;
                        const f32x2_t c0 = __builtin_amdgcn_cvt_pk_f32_fp8((int)w, false), c1 = __builtin_amdgcn_cvt_pk_f32_fp8((int)w, true);
                        yy[0] += wgt[i] * c0.x; yy[1] += wgt[i] * c0.y; yy[2] += wgt[i] * c1.x; yy[3] += wgt[i] * c1.y;
                    }
                }
#pragma unroll
            for (int i = 0; i < 4; ++i) { Uc[i][0] = Un[i][0]; Uc[i][1] = Un[i][1]; }
        }
        float ss = 0.f;
#pragma unroll
        for (int j = 0; j < 2; ++j)
#pragma unroll
            for (int q = 0; q < 4; ++q) {
                const int c = (lane + 64 * j) * 16 + 4 * q;
                const float4 xv = *(const float4*)(x1 + (size_t)t * DM + c);
                const float4 ga = *(const float4*)(p.ada + b * NMOD + 5 * DM + c);
                float* yy = y + 16 * j + 4 * q;
                yy[0] = xv.x + ga.x * yy[0]; yy[1] = xv.y + ga.y * yy[1]; yy[2] = xv.z + ga.z * yy[2]; yy[3] = xv.w + ga.w * yy[3];
                ss += yy[0] * yy[0] + yy[1] * yy[1] + yy[2] * yy[2] + yy[3] * yy[3];
            }
        ss = wave_sum(ss);
        const float rs = 1.0f / sqrtf(ss * (1.0f / DM) + 1e-6f);
#pragma unroll
        for (int j = 0; j < 2; ++j)
#pragma unroll
            for (int q = 0; q < 4; ++q) {
                const int c = (lane + 64 * j) * 16 + 4 * q;
                const float4 gf = *(const float4*)(p.norm_f_g + c);
                const float* yy = y + 16 * j + 4 * q;
                *(float4*)(p.out + (size_t)t * DM + c) = make_float4(yy[0] * rs * gf.x, yy[1] * rs * gf.y, yy[2] * rs * gf.z, yy[3] * rs * gf.w);
            }
    }
}

#define LAS __attribute__((address_space(3)))
#define XB_TMO      128
#define XB_XCNT(j)  (256  + 64 * (j))
#define XB_XSUB(j)  (1280 + 64 * (j))
#define XB_XGEN(j)  (2304 + 64 * (j))
#define XB_TOP      3328
#define XB_TOPGEN   3392
#define XCD_BAR_WORDS 3456
#define XB_SPIN_CAP (1u << 18)

__device__ __forceinline__ unsigned xb_ld(unsigned* p)              { return __hip_atomic_load(p, __ATOMIC_RELAXED, __HIP_MEMORY_SCOPE_AGENT); }
__device__ __forceinline__ unsigned xb_add(unsigned* p, unsigned v) { return __hip_atomic_fetch_add(p, v, __ATOMIC_RELAXED, __HIP_MEMORY_SCOPE_AGENT); }
__device__ __forceinline__ unsigned xb_xcc_id() { return (unsigned)__builtin_amdgcn_s_getreg((3 << 11) | 20) & 0xFu; }
#define XB_SPIN(cond, bar) do { unsigned _sp = 0; while (cond) { __builtin_amdgcn_s_sleep(1); \
    if ((++_sp & 255u) == 0u) { if (xb_ld(&(bar)[XB_TMO])) break; if (_sp > XB_SPIN_CAP) { atomicAdd(&(bar)[XB_TMO], 1u); break; } } } } while (0)

struct XcdBarrier {
    unsigned* bar; unsigned x;
    volatile LAS unsigned* st;
};

__device__ __forceinline__ XcdBarrier xcd_barrier_post(unsigned* bar, volatile LAS unsigned* st) {
    XcdBarrier b; b.bar = bar; b.x = xb_xcc_id(); b.st = st;
    if (threadIdx.x == 0) (void)xb_add(&bar[XB_XCNT(b.x)], 1u);
    return b;
}
__device__ __forceinline__ void xcd_barrier_complete(unsigned* bar, unsigned x, unsigned& nloc, unsigned& nx) {
    const unsigned G = gridDim.x * gridDim.y * gridDim.z;
    unsigned sum, cnt, mine, sp = 0u;
    for (;;) {
        sum = 0u; cnt = 0u; mine = 0u;
#pragma unroll
        for (unsigned j = 0; j < 16; ++j) { const unsigned c = xb_ld(&bar[XB_XCNT(j)]); sum += c; cnt += (c > 0u) ? 1u : 0u; mine = (j == x) ? c : mine; }
        if (sum == G) break;
        __builtin_amdgcn_s_sleep(1);
        if ((++sp & 255u) == 0u) { if (xb_ld(&bar[XB_TMO])) break; if (sp > XB_SPIN_CAP) { atomicAdd(&bar[XB_TMO], 1u); break; } }
    }
    nloc = mine > 0u ? mine : 1u; nx = cnt > 0u ? cnt : 1u;
}

__device__ __forceinline__ void xcd_barrier(const XcdBarrier& b) {
    asm volatile("s_waitcnt vmcnt(0)" ::: "memory");
    __syncthreads();
    if (threadIdx.x == 0) {
        unsigned* bar = b.bar;
        __builtin_amdgcn_s_waitcnt(0);
        unsigned nloc = b.st[0], nx = b.st[1];
        if (nloc == 0u) { xcd_barrier_complete(bar, b.x, nloc, nx); b.st[0] = nloc; b.st[1] = nx; }
        const unsigned old = xb_add(&bar[XB_XSUB(b.x)], 1u);
        const unsigned gen = old / nloc;
        if (old + 1u == (gen + 1u) * nloc) {
            __builtin_amdgcn_fence(__ATOMIC_RELEASE, "agent");
            asm volatile("s_waitcnt vmcnt(0)" ::: "memory");
            const unsigned og = xb_add(&bar[XB_TOP], 1u);
            const unsigned tg = og / nx;
            if (og + 1u == (tg + 1u) * nx) xb_add(&bar[XB_TOPGEN], 1u);
            else XB_SPIN(xb_ld(&bar[XB_TOPGEN]) == tg, bar);
            __builtin_amdgcn_fence(__ATOMIC_ACQUIRE, "agent");
            xb_add(&bar[XB_XGEN(b.x)], 1u);
            asm volatile("s_waitcnt vmcnt(0)" ::: "memory");
        } else {
            XB_SPIN(xb_ld(&bar[XB_XGEN(b.x)]) == gen, bar);
            __builtin_amdgcn_fence(__ATOMIC_ACQUIRE, "agent");
            asm volatile("s_waitcnt vmcnt(0)" ::: "memory");
        }
    }
    __syncthreads();
}

template <class Epi>
__device__ __forceinline__ void gemm_run(float* lds, const bf16_t* A, const bf16_t* Bt, int M, int N, int K, const Epi& E) {
    __syncthreads();
    pg8::Gemm g{A, Bt, M, N, K}; pg8::StaticOrder S; S.init(M, N, (int)gridDim.x, (int)blockIdx.x);
    pg8::gemm_phase<Epi, pg8::StaticOrder, true, true>((PG8_LAS unsigned char*)lds, g, S, E);
    __syncthreads();
}
constexpr int NPHASE = 11;
template <int PH>
__device__ __forceinline__ void run_phase(const Params& p, int bid, int nb, float* lds) {
    asm volatile("" : "+s"(bid));
    if constexpr (PH == 0) ph_prep(p, bid, nb, lds);
    if constexpr (PH == 1) ph_modnorm(p, p.x, p.norm1_g, 0 * DM, 1 * DM, p.hb, bid, nb, lds);
    if constexpr (PH == 2) gemm_run(lds, p.hb, p.Wt1, NTOK, ZW, DM, pg8::EpiZG{p.ZG, p.b_bg});
    if constexpr (PH == 3) { ph_retprep(p, bid, nb, lds); ph_gmlp(p, bid, nb, lds); }
    if constexpr (PH == 11) ph_ret2(p, bid, nb, lds);
    if constexpr (PH == 4) ph_gn(p, bid, nb, lds);
    if constexpr (PH == 5) {
        gemm_run(lds, p.yain, p.Wta, NTOK, DM, 1024, pg8::EpiMixB<0>{p.hb, p.ZG, 0});
        gemm_run(lds, p.ybin, p.Wtb, NTOK, DM, DM, pg8::EpiMixB<1>{p.hb, p.ZG, 2048});
    }
    if constexpr (PH == 6) gemm_run(lds, p.hb, p.Wto, NTOK, DM, DM, pg8::EpiResF{p.obuf, p.x, p.ada + 2 * DM});
    if constexpr (PH == 7) { ph_modnorm(p, p.obuf, p.norm2_g, 3 * DM, 4 * DM, p.hb, bid, nb, lds); ph_tabconv(p, bid, nb); }
    if constexpr (PH == 8) gemm_run(lds, p.hb, p.Wtq, NTOK, DM, DM, pg8::EpiF32{p.qbuf, DM});
    if constexpr (PH == 9) ph_topk2(p, p.qbuf, bid, nb, lds);
    if constexpr (PH == 10) ph_peer3(p, p.obuf, p.hb, bid, nb);
}

constexpr int MISC_OFF = 132 * 1024;
__global__ void __launch_bounds__(NTH) k_mega(Params p) {
    extern __shared__ __attribute__((aligned(16))) float lds[];
    cg::grid_group grid = cg::this_grid();
    const int bid = blockIdx.x, nb = gridDim.x;
    volatile LAS unsigned* misc = (volatile LAS unsigned*)((LAS unsigned char*)lds + MISC_OFF);
    if (threadIdx.x < 4) misc[threadIdx.x] = 0u;
    __syncthreads();
    XcdBarrier bar = xcd_barrier_post(p.bar, misc);
    run_phase<0>(p, bid, nb, lds); grid.sync();
    run_phase<1>(p, bid, nb, lds); xcd_barrier(bar);
    run_phase<2>(p, bid, nb, lds); xcd_barrier(bar);
    run_phase<3>(p, bid, nb, lds); xcd_barrier(bar);
    run_phase<11>(p, bid, nb, lds); xcd_barrier(bar);
    run_phase<4>(p, bid, nb, lds); xcd_barrier(bar);
    run_phase<5>(p, bid, nb, lds); xcd_barrier(bar);
    run_phase<6>(p, bid, nb, lds); xcd_barrier(bar);
    run_phase<7>(p, bid, nb, lds); xcd_barrier(bar);
    run_phase<8>(p, bid, nb, lds); xcd_barrier(bar);
    run_phase<9>(p, bid, nb, lds); xcd_barrier(bar);
    run_phase<10>(p, bid, nb, lds);
}

extern "C" void kernel_launch(void* const* d_in, const int* in_sizes, int n_in, void* d_out, int out_size, void* d_ws, size_t ws_size, hipStream_t stream) {
    Params p{};
    p.x = (const float*)d_in[0]; p.c = (const float*)d_in[1]; p.pos = (const int*)d_in[2];
    p.w_ada = (const float*)d_in[3]; p.b_ada = (const float*)d_in[4]; p.norm1_g = (const float*)d_in[5]; p.w_in = (const float*)d_in[6];
    p.w_bg = (const float*)d_in[7]; p.b_bg = (const float*)d_in[8]; p.gm_v_g = (const float*)d_in[9]; p.gm_ws = (const float*)d_in[10];
    p.gm_b = (const float*)d_in[11]; p.ret_gn_g = (const float*)d_in[12]; p.w_a_out = (const float*)d_in[13]; p.w_b_out = (const float*)d_in[14];
    p.w_o = (const float*)d_in[15]; p.norm2_g = (const float*)d_in[16]; p.peer_wq = (const float*)d_in[17]; p.peer_sk = (const float*)d_in[18];
    p.peer_u = (const float*)d_in[19]; p.peer_v = (const float*)d_in[20]; p.norm_f_g = (const float*)d_in[21];
    p.out = (float*)d_out;
    char* w = (char*)d_ws; size_t off = 0;
    auto take = [&](size_t bytes) { char* r = w + off; off += (bytes + 255) & ~(size_t)255; return r; };
    p.bar = (unsigned*)take(XCD_BAR_WORDS * 4);
    p.ada = (float*)take(2 * NMOD * 4);
    p.rope = (float*)take((size_t)NTOK * 128 * 4);
    p.eidx = (int*)take((size_t)NTOK * 128 * 4);
    p.gatev = (float*)take((size_t)NTOK * 128 * 4);
    p.Wt1 = (bf16_t*)take((size_t)ZW * DM * 2);
    p.Wta = (bf16_t*)take((size_t)DM * 1024 * 2);
    p.Wtb = (bf16_t*)take((size_t)DM * DM * 2);
    p.Wto = (bf16_t*)take((size_t)DM * DM * 2);
    p.Wtq = (bf16_t*)take((size_t)DM * DM * 2);
    p.hb = (bf16_t*)take((size_t)NTOK * DM * 2);
    p.ZG = (bf16_t*)take((size_t)NTOK * ZW * 2);
    p.qbuf = (float*)p.ZG;
    p.obuf = (float*)take((size_t)NTOK * DM * 4);
    p.ybin = (bf16_t*)take((size_t)NTOK * DM * 2);
    p.yain = (bf16_t*)take((size_t)NTOK * 1024 * 2);
    p.U8 = (unsigned char*)p.ZG + (size_t)NTOK * DM * 4;
    p.V8 = p.U8 + (size_t)16384 * DM;
    p.su = (float*)take(16384 * 4); p.sv = (float*)take(16384 * 4);
    p.Qr = (bf16_t*)take((size_t)NTOK * 1024 * 2);
    p.Kr = (bf16_t*)take((size_t)NTOK * 1024 * 2);
    p.KTd = (bf16_t*)take((size_t)NTOK * 1024 * 2);
    p.Vt = (bf16_t*)take((size_t)NTOK * 2048 * 2);
    p.ob16 = (bf16_t*)take((size_t)NTOK * DM * 2);
    if (off > ws_size) { fprintf(stderr, "kernel_launch: workspace too small: need %zu have %zu\n", off, ws_size); return; }
    static int grid = 0;
    if (!grid) {
        int dev = 0, cus = 0, per_cu = 0;
        (void)hipGetDevice(&dev); (void)hipDeviceGetAttribute(&cus, hipDeviceAttributeMultiprocessorCount, dev);
        (void)hipFuncSetAttribute((const void*)k_mega, hipFuncAttributeMaxDynamicSharedMemorySize, LDS_BYTES);
        (void)hipOccupancyMaxActiveBlocksPerMultiprocessor(&per_cu, k_mega, NTH, LDS_BYTES);
        if (per_cu < 1) per_cu = 1;
        grid = cus * per_cu;
    }
    (void)hipMemsetAsync(p.bar, 0, XCD_BAR_WORDS * 4, stream);
    void* args[] = {&p};
    hipError_t e = hipLaunchCooperativeKernel((const void*)k_mega, dim3(grid), dim3(NTH), args, LDS_BYTES, stream);
    if (e != hipSuccess) fprintf(stderr, "cooperative launch failed: %s (grid %d)\n", hipGetErrorString(e), grid);
}
```

```cpp
#include <hip/hip_runtime.h>
#include <hip/hip_cooperative_groups.h>
#include <stdint.h>
#include <math.h>
#include <cstdio>

namespace cg = cooperative_groups;

constexpr int DM = 2048;
constexpr int SQ = 4096;
constexpr int NTOK = 8192;
constexpr int NTH = 512;
constexpr int ZW = 12288;
constexpr int NMOD = 12288;
constexpr int LDS_BYTES = 136 * 1024;

typedef unsigned short bf16_t;

struct Params {
    const float *x, *c; const int* pos;
    const float *w_ada, *b_ada, *norm1_g, *w_in, *w_bg, *b_bg, *gm_v_g, *gm_ws, *gm_b, *ret_gn_g, *w_a_out, *w_b_out, *w_o, *norm2_g,
                *peer_wq, *peer_sk, *peer_u, *peer_v, *norm_f_g;
    float* out;
    float *ada, *rope, *gatev; int* eidx;
    bf16_t *Wt1, *Wta, *Wtb, *Wto, *Wtq;
    bf16_t *hb;
    bf16_t *ZG;
    float *obuf;
    bf16_t *ybin, *yain;
    float *qbuf;
    unsigned char *U8, *V8;
    float *su, *sv;
    bf16_t *Qr, *Kr, *KTd, *Vt;
    bf16_t *ob16;
    unsigned *bar;
};

__constant__ float c_freq[64] = {
1.000000000e+00f, 8.659643531e-01f, 7.498942018e-01f, 6.493816376e-01f, 5.623413324e-01f, 4.869675338e-01f, 4.216965139e-01f, 3.651741147e-01f, 3.162277639e-01f, 2.738419771e-01f, 2.371373773e-01f, 2.053525001e-01f, 1.778279394e-01f, 1.539926529e-01f, 1.333521456e-01f, 1.154781953e-01f, 1.000000015e-01f, 8.659642935e-02f, 7.498942316e-02f, 6.493816525e-02f, 5.623413250e-02f, 4.869675264e-02f, 4.216964915e-02f, 3.651741147e-02f, 3.162277490e-02f, 2.738419548e-02f, 2.371373773e-02f, 2.053525113e-02f, 1.778279431e-02f, 1.539926510e-02f, 1.333521400e-02f, 1.154781971e-02f, 9.999999776e-03f, 8.659643121e-03f, 7.498942316e-03f, 6.493816152e-03f, 5.623413250e-03f, 4.869675264e-03f, 4.216964822e-03f, 3.651741194e-03f, 3.162277630e-03f, 2.738419687e-03f, 2.371373819e-03f, 2.053525066e-03f, 1.778279431e-03f, 1.539926510e-03f, 1.333521446e-03f, 1.154782018e-03f, 1.000000047e-03f, 8.659643354e-04f, 7.498941850e-04f, 6.493816036e-04f, 5.623413017e-04f, 4.869675322e-04f, 4.216965172e-04f, 3.651741135e-04f, 3.162277571e-04f, 2.738419571e-04f, 2.371373703e-04f, 2.053525095e-04f, 1.778279402e-04f, 1.539926598e-04f, 1.333521504e-04f, 1.154782003e-04f };

__device__ __forceinline__ int tid_() { int t = threadIdx.x; asm volatile("" : "+v"(t)); return t; }
__device__ __forceinline__ float wave_sum(float v) {
#pragma unroll
    for (int o = 1; o < 64; o <<= 1) v += __shfl_xor(v, o);
    return v;
}
__device__ __forceinline__ float wave_max(float v) {
#pragma unroll
    for (int o = 1; o < 64; o <<= 1) v = fmaxf(v, __shfl_xor(v, o));
    return v;
}
__device__ __forceinline__ float sigmoidf_(float x) { return 1.0f / (1.0f + expf(-x)); }
__device__ __forceinline__ float siluf_(float x) { return x * sigmoidf_(x); }
__device__ __forceinline__ float geluf_(float x) { return 0.5f * x * (1.0f + erff(x * 0.70710678118654752f)); }
__device__ __forceinline__ float dot4(float4 a, float4 b) { return a.x * b.x + a.y * b.y + a.z * b.z + a.w * b.w; }
__device__ __forceinline__ float bf2f(bf16_t v) { return __uint_as_float((unsigned)v << 16); }
__device__ __forceinline__ float bflo(unsigned w) { return __uint_as_float(w << 16); }
__device__ __forceinline__ float bfhi(unsigned w) { return __uint_as_float(w & 0xffff0000u); }
__device__ __forceinline__ unsigned f2bf(float f) { unsigned u = __float_as_uint(f); return (u + 0x7fffu + ((u >> 16) & 1u)) >> 16; }
__device__ __forceinline__ unsigned pk2(float lo, float hi) { return f2bf(lo) | (f2bf(hi) << 16); }

__device__ __forceinline__ void sincos_acc(float ang, float& s, float& c) {
    const double x = (double)ang;
    const double k = rint(x * 0.63661977236758134308);
    double r = fma(-k, 1.57079632679489655800, x); r = fma(-k, 6.12323399573676603587e-17, r);
    const double r2 = r * r;
    const double sp = r * (1.0 + r2 * (-1.0 / 6.0 + r2 * (1.0 / 120.0 + r2 * (-1.0 / 5040.0 + r2 * (1.0 / 362880.0 + r2 * (-1.0 / 39916800.0 + r2 * (1.0 / 6227020800.0)))))));
    const double cp = 1.0 + r2 * (-0.5 + r2 * (1.0 / 24.0 + r2 * (-1.0 / 720.0 + r2 * (1.0 / 40320.0 + r2 * (-1.0 / 3628800.0 + r2 * (1.0 / 479001600.0 + r2 * (-1.0 / 87178291200.0)))))));
    const int q = ((int)k) & 3;
    const float fs = (float)sp, fc = (float)cp;
    s = (q == 0) ? fs : (q == 1) ? fc : (q == 2) ? -fs : -fc;
    c = (q == 0) ? fc : (q == 1) ? -fs : (q == 2) ? -fc : fs;
}

namespace pg8 {
#define PG8_LAS __attribute__((address_space(3)))
typedef unsigned short bf16_t;
typedef short bf16x8 __attribute__((ext_vector_type(8)));
typedef float f32x4 __attribute__((ext_vector_type(4)));
typedef unsigned u32x4 __attribute__((ext_vector_type(4)));
constexpr int BM = 256, BK = 64, HALF = 128, HTB = HALF * BK * 2  , STAGE_BYTES = 8 * HTB, NXCD = 8, WGM = 8;

__host__ __device__ __forceinline__ int lds_byte(int r, int c) { const int st = (r >> 4) * 2 + (c >> 5), rr = r & 15, cc = c & 31, ob = rr * 64 + cc * 2; return st * 1024 + (ob ^ (((ob >> 9) & 1) << 5)); }
__host__ __device__ __forceinline__ void stage_rc(int b, int& R, int& C) { const int st = b / 1024, sb = b % 1024, swz = sb ^ (((sb >> 9) & 1) << 5); R = (st >> 1) * 16 + swz / 64; C = (st & 1) * 32 + (swz % 64) / 2; }
__host__ __device__ __forceinline__ int perm32(int rho) { const int n = rho >> 4, i = rho & 15; return 8 * (i >> 2) + 4 * n + (i & 3); }

struct Unit { int pm, pn; };
struct Gemm { const bf16_t* A; const bf16_t* Bt; int M, N, K; };

struct StaticOrder {
    int nM, nN, nwg, G, c;
    __host__ __device__ void init(int M, int N, int G_, int c_) { nM = M / BM; nN = N / BM; nwg = nM * nN; G = G_; c = c_; }
    __host__ __device__ bool next(int i, Unit& u) const {
        const long L = (long)i * G + c; if (L >= nwg) return false;
        int wgid = (int)L; { const int q = nwg / NXCD, r = nwg % NXCD, xcd = wgid % NXCD, off = wgid / NXCD; wgid = (xcd < r ? xcd * (q + 1) : r * (q + 1) + (xcd - r) * q) + off; }
        const int nig = WGM * nN, gid = wgid / nig, fm = gid * WGM, gsz = (nM - fm) < WGM ? (nM - fm) : WGM;
        u.pm = fm + ((wgid % nig) % gsz); u.pn = (wgid % nig) / gsz; return true;
    }
    __device__ __forceinline__ void a_ready(const Unit&) const {}
    __device__ __forceinline__ void done(const Unit&) const {}
};

__device__ __forceinline__ unsigned cvt_pk_bf16(float lo, float hi) { unsigned r; asm volatile("v_cvt_pk_bf16_f32 %0, %1, %2" : "=v"(r) : "v"(lo), "v"(hi)); return r; }
typedef float f32x2 __attribute__((ext_vector_type(2)));
__device__ __forceinline__ f32x2 gelu_pk(f32x2 v) {
    const f32x2 av = __builtin_elementwise_abs(v), d = av * 0.2316418882f + 1.0f;
    f32x2 t; t.x = __builtin_amdgcn_rcpf(d.x); t.y = __builtin_amdgcn_rcpf(d.y);
    f32x2 q = t * 0.5307027145f + (-0.7265760135f); q = q * t + 0.7107068705f; q = q * t + (-0.142248368f); q = q * t + 0.127414796f; q = q * t;
    const f32x2 s = (v * v) * (-0.72134752044f);
    f32x2 e; e.x = __builtin_amdgcn_exp2f(s.x); e.y = __builtin_amdgcn_exp2f(s.y);
    const f32x2 m = v * (q * e), r = v - m;
    f32x2 o; o.x = v.x < 0.f ? m.x : r.x; o.y = v.y < 0.f ? m.y : r.y; return o;
}

typedef unsigned u32x2v __attribute__((ext_vector_type(2)));
struct EpiZG {
    static constexpr bool PERM = true, AFTER_DRAIN = false;
    bf16_t* O; const float* bias;
    __device__ __forceinline__ void operator()(const f32x4 (&acc)[2][2][4][2], const Unit& u, int wr, int wc, int fr, int fq) const {
        const int row0 = u.pm * BM + wr * 64 + fr, col0 = u.pn * BM + wc * 32 + 8 * fq;
        const int mode = u.pn < 8 ? 1 : (u.pn < 32 ? 0 : 2);
        f32x4 bv[2][2];
#pragma unroll
        for (int bj = 0; bj < 2; ++bj)
#pragma unroll
            for (int n = 0; n < 2; ++n) bv[bj][n] = (mode == 2) ? *(const f32x4*)(bias + (col0 - 8192) + bj * HALF + 4 * n) : (f32x4){0.f, 0.f, 0.f, 0.f};
#pragma unroll
        for (int ai = 0; ai < 2; ++ai)
#pragma unroll
            for (int m = 0; m < 4; ++m) { bf16_t* rowp = O + (size_t)(row0 + ai * HALF + m * 16) * ZW + col0;
#pragma unroll
                for (int bj = 0; bj < 2; ++bj) { f32x4 v0 = acc[ai][bj][m][0], v1 = acc[ai][bj][m][1];
                    if (mode == 1) { f32x2 a = gelu_pk((f32x2){v0[0], v0[1]}), b = gelu_pk((f32x2){v0[2], v0[3]}), c = gelu_pk((f32x2){v1[0], v1[1]}), d = gelu_pk((f32x2){v1[2], v1[3]});
                        v0 = (f32x4){a.x, a.y, b.x, b.y}; v1 = (f32x4){c.x, c.y, d.x, d.y}; }
                    if (mode == 2) { v0 = v0 + bv[bj][0]; v1 = v1 + bv[bj][1];
#pragma unroll
                        for (int e = 0; e < 4; ++e) { v0[e] = __builtin_amdgcn_rcpf(1.0f + __expf(-v0[e])); v1[e] = __builtin_amdgcn_rcpf(1.0f + __expf(-v1[e])); } }
                    u32x4 w; w.x = cvt_pk_bf16(v0[0], v0[1]); w.y = cvt_pk_bf16(v0[2], v0[3]); w.z = cvt_pk_bf16(v1[0], v1[1]); w.w = cvt_pk_bf16(v1[2], v1[3]);
                    *(u32x4*)(rowp + bj * HALF) = w; } }
    }
};
template <int ACCUM> struct EpiMixB {
    static constexpr bool PERM = true, AFTER_DRAIN = false;
    bf16_t* Mo; const bf16_t* ZGp; int goff;
    __device__ __forceinline__ void operator()(const f32x4 (&acc)[2][2][4][2], const Unit& u, int wr, int wc, int fr, int fq) const {
        const int row0 = u.pm * BM + wr * 64 + fr, col0 = u.pn * BM + wc * 32 + 8 * fq;
#pragma unroll
        for (int ai = 0; ai < 2; ++ai)
#pragma unroll
            for (int m = 0; m < 4; ++m) { const size_t row = (size_t)(row0 + ai * HALF + m * 16);
#pragma unroll
                for (int bj = 0; bj < 2; ++bj) { const f32x4 v0 = acc[ai][bj][m][0], v1 = acc[ai][bj][m][1];
                    const u32x4 g = *(const u32x4*)(ZGp + row * ZW + 8192 + goff + col0 + bj * HALF);
                    float o[8];
                    o[0] = bflo(g.x) * v0[0]; o[1] = bfhi(g.x) * v0[1]; o[2] = bflo(g.y) * v0[2]; o[3] = bfhi(g.y) * v0[3];
                    o[4] = bflo(g.z) * v1[0]; o[5] = bfhi(g.z) * v1[1]; o[6] = bflo(g.w) * v1[2]; o[7] = bfhi(g.w) * v1[3];
                    bf16_t* mp = Mo + row * DM + col0 + bj * HALF;
                    if (ACCUM) { const u32x4 old = *(const u32x4*)mp;
                        o[0] += bflo(old.x); o[1] += bfhi(old.x); o[2] += bflo(old.y); o[3] += bfhi(old.y); o[4] += bflo(old.z); o[5] += bfhi(old.z); o[6] += bflo(old.w); o[7] += bfhi(old.w); }
                    u32x4 w; w.x = cvt_pk_bf16(o[0], o[1]); w.y = cvt_pk_bf16(o[2], o[3]); w.z = cvt_pk_bf16(o[4], o[5]); w.w = cvt_pk_bf16(o[6], o[7]);
                    *(u32x4*)mp = w; } }
    }
};
struct EpiResF {
    static constexpr bool PERM = false, AFTER_DRAIN = false;
    float* x1; const float* x; const float* ga;
    __device__ __forceinline__ void operator()(const f32x4 (&acc)[2][2][4][2], const Unit& u, int wr, int wc, int fr, int fq) const {
        const int row0 = u.pm * BM + wr * 64 + fr, col0 = u.pn * BM + wc * 32 + 4 * fq;
        const int b = (u.pm * BM) / SQ;
        f32x4 gv[2][2];
#pragma unroll
        for (int bj = 0; bj < 2; ++bj)
#pragma unroll
            for (int n = 0; n < 2; ++n) gv[bj][n] = *(const f32x4*)(ga + b * NMOD + col0 + bj * HALF + n * 16);
#pragma unroll
        for (int ai = 0; ai < 2; ++ai)
#pragma unroll
            for (int m = 0; m < 4; ++m) { const size_t off = (size_t)(row0 + ai * HALF + m * 16) * DM + col0;
#pragma unroll
                for (int bj = 0; bj < 2; ++bj)
#pragma unroll
                    for (int n = 0; n < 2; ++n) { const f32x4 xv = *(const f32x4*)(x + off + bj * HALF + n * 16);
                        *(f32x4*)(x1 + off + bj * HALF + n * 16) = xv + gv[bj][n] * acc[ai][bj][m][n]; } }
    }
};
struct EpiF32 {
    static constexpr bool PERM = false, AFTER_DRAIN = false;
    float* O; int ldc;
    __device__ __forceinline__ void operator()(const f32x4 (&acc)[2][2][4][2], const Unit& u, int wr, int wc, int fr, int fq) const {
        const int row0 = u.pm * BM + wr * 64 + fr, col0 = u.pn * BM + wc * 32 + 4 * fq;
#pragma unroll
        for (int ai = 0; ai < 2; ++ai)
#pragma unroll
            for (int m = 0; m < 4; ++m) { const size_t off = (size_t)(row0 + ai * HALF + m * 16) * ldc + col0;
#pragma unroll
                for (int bj = 0; bj < 2; ++bj)
#pragma unroll
                    for (int n = 0; n < 2; ++n) *(f32x4*)(O + off + bj * HALF + n * 16) = acc[ai][bj][m][n]; }
    }
};

template <class Epi, class Sched, bool ALIGN_EPI = false, bool SP2 = false>
__device__ __forceinline__ void gemm_phase(PG8_LAS unsigned char* lds, const Gemm g, const Sched& S, const Epi& E) {
    const int tid = threadIdx.x, wid = __builtin_amdgcn_readfirstlane(tid >> 6), lane = tid & 63, wr = wid >> 2, wc = wid & 3, fr = lane & 15, fq = lane >> 4;
    const int K = g.K, nt = K / BK;
    unsigned voffA[2], voffB[2];
#pragma unroll
    for (int i = 0; i < 2; ++i) { int R, C; stage_rc(tid * 16 + i * 8192, R, C); const int Rb = Epi::PERM ? ((R & ~31) + perm32(R & 31)) : R;
        voffA[i] = (unsigned)(R * K + C) * 2u; voffB[i] = (unsigned)(Rb * K + C) * 2u; }
    const size_t kstep = (size_t)(BK * 2);
    const size_t hstep = (size_t)HALF * K * 2;
    const size_t tstep = 2 * hstep;
    const unsigned ldsw = (unsigned)wid * 1024u;
    const int aoff = lds_byte(wr * 64 + fr, fq * 8), boff = lds_byte(wc * 32 + fr, fq * 8);
#define PG8_SA(b, h) (((b) * 2 + (h)) * HTB)
#define PG8_SB(b, h) ((4 + (b) * 2 + (h)) * HTB)
#define PG8_STAGE(bufoff, gbase, voff) do { _Pragma("unroll") for (int _i = 0; _i < 2; ++_i) \
        __builtin_amdgcn_global_load_lds((const unsigned*)((const char*)(gbase) + (voff)[_i]), (PG8_LAS unsigned*)(lds + (bufoff) + ldsw + _i * 8192), 16, 0, 0); } while (0)
#define PG8_LDA(dst, b, h) do { _Pragma("unroll") for (int m = 0; m < 4; ++m) _Pragma("unroll") for (int k = 0; k < 2; ++k) dst[m][k] = *(const PG8_LAS bf16x8*)(lds + PG8_SA(b, h) + aoff + m * 2048 + k * 1024); } while (0)
#define PG8_LDB(dst, b, h) do { _Pragma("unroll") for (int n = 0; n < 2; ++n) _Pragma("unroll") for (int k = 0; k < 2; ++k) dst[n][k] = *(const PG8_LAS bf16x8*)(lds + PG8_SB(b, h) + boff + n * 2048 + k * 1024); } while (0)
#define PG8_MMA(ai, bj, At, Bt) do { __builtin_amdgcn_s_setprio(1); _Pragma("unroll") for (int m = 0; m < 4; ++m) _Pragma("unroll") for (int n = 0; n < 2; ++n) _Pragma("unroll") for (int k = 0; k < 2; ++k) \
        acc[ai][bj][m][n] = __builtin_amdgcn_mfma_f32_16x16x32_bf16(Bt[n][k], At[m][k], acc[ai][bj][m][n], 0, 0, 0); __builtin_amdgcn_s_setprio(0); } while (0)
#define PG8_WAIT_V(n) asm volatile("s_waitcnt vmcnt(" #n ")" ::: "memory")
#define PG8_WAIT_L(n) asm volatile("s_waitcnt lgkmcnt(" #n ")" ::: "memory")
#define PG8_BAR __builtin_amdgcn_s_barrier()
#define PG8_SCHED __builtin_amdgcn_sched_barrier(0)
    Unit cur, nxt; int ui = 0;
    if (!S.next(0, cur)) return;
    f32x4 acc[2][2][4][2];
#pragma unroll
    for (int a = 0; a < 2; ++a)
#pragma unroll
        for (int b = 0; b < 2; ++b)
#pragma unroll
            for (int m = 0; m < 4; ++m)
#pragma unroll
                for (int n = 0; n < 2; ++n) acc[a][b][m][n] = (f32x4){0.f, 0.f, 0.f, 0.f};
    bf16x8 At[4][2], B0[2][2], B1[2][2];
    const char* cA = (const char*)g.A + (size_t)cur.pm * tstep; const char* cB = (const char*)g.Bt + (size_t)cur.pn * tstep;
    S.a_ready(cur);
    if constexpr (SP2) {
        PG8_STAGE(PG8_SB(0, 0), cB, voffB); PG8_STAGE(PG8_SB(0, 1), cB + hstep, voffB); PG8_STAGE(PG8_SA(0, 0), cA, voffA); PG8_STAGE(PG8_SA(0, 1), cA + hstep, voffA);
        if (wr == 1) PG8_BAR;
        PG8_WAIT_V(2); PG8_BAR;
        PG8_STAGE(PG8_SB(1, 0), cB + kstep, voffB); PG8_STAGE(PG8_SA(1, 0), cA + kstep, voffA); PG8_STAGE(PG8_SB(1, 1), cB + hstep + kstep, voffB);
        PG8_WAIT_V(6); PG8_BAR;
    } else {
        PG8_STAGE(PG8_SB(0, 0), cB, voffB); PG8_STAGE(PG8_SA(0, 0), cA, voffA); PG8_STAGE(PG8_SB(0, 1), cB + hstep, voffB); PG8_STAGE(PG8_SA(0, 1), cA + hstep, voffA);
        if (wr == 1) PG8_BAR;
        PG8_WAIT_V(4); PG8_BAR;
        PG8_STAGE(PG8_SB(1, 0), cB + kstep, voffB); PG8_STAGE(PG8_SA(1, 0), cA + kstep, voffA); PG8_STAGE(PG8_SB(1, 1), cB + hstep + kstep, voffB);
        PG8_WAIT_V(6); PG8_BAR;
    }
    for (;;) {
        const bool has_next = S.next(ui + 1, nxt);
        const char* nA = has_next ? (const char*)g.A + (size_t)nxt.pm * tstep : cA; const char* nB = has_next ? (const char*)g.Bt + (size_t)nxt.pn * tstep : cB;
        for (int t = 0; t < nt; t += 2) {
            const bool last = (t == nt - 2);
            const char* a1 = cA + (size_t)(t + 1) * kstep;
            const char* a2 = last ? nA : cA + (size_t)(t + 2) * kstep; const char* b2 = last ? nB : cB + (size_t)(t + 2) * kstep;
            const char* a3 = a2 + kstep; const char* b3 = b2 + kstep;
            if (last && has_next) S.a_ready(nxt);
            if constexpr (SP2) {
            PG8_LDB(B0, 0, 0); PG8_LDB(B1, 0, 1); PG8_SCHED; PG8_LDA(At, 0, 0); PG8_STAGE(PG8_SA(1, 1), a1 + hstep, voffA);
            PG8_WAIT_V(8); PG8_WAIT_L(0); PG8_BAR; PG8_MMA(0, 0, At, B0); PG8_MMA(0, 1, At, B1); PG8_BAR; PG8_SCHED;
            PG8_LDA(At, 0, 1); PG8_STAGE(PG8_SB(0, 0), b2, voffB); PG8_STAGE(PG8_SB(0, 1), b2 + hstep, voffB); PG8_STAGE(PG8_SA(0, 0), a2, voffA);
            PG8_WAIT_V(8); PG8_WAIT_L(0); PG8_BAR; PG8_MMA(1, 0, At, B0); PG8_MMA(1, 1, At, B1); PG8_BAR; PG8_SCHED;
            PG8_LDB(B0, 1, 0); PG8_LDB(B1, 1, 1); PG8_SCHED; PG8_LDA(At, 1, 0); PG8_STAGE(PG8_SA(0, 1), a2 + hstep, voffA);
            PG8_WAIT_V(8); PG8_WAIT_L(0); PG8_BAR; PG8_MMA(0, 0, At, B0); PG8_MMA(0, 1, At, B1); PG8_BAR; PG8_SCHED;
            PG8_LDA(At, 1, 1); PG8_STAGE(PG8_SB(1, 0), b3, voffB); PG8_STAGE(PG8_SB(1, 1), b3 + hstep, voffB); PG8_STAGE(PG8_SA(1, 0), a3, voffA);
            PG8_WAIT_V(8); PG8_WAIT_L(0); PG8_BAR; PG8_MMA(1, 0, At, B0); PG8_MMA(1, 1, At, B1); PG8_BAR; PG8_SCHED;
            } else {
            PG8_LDB(B0, 0, 0); PG8_SCHED; PG8_LDA(At, 0, 0); PG8_STAGE(PG8_SA(1, 1), a1 + hstep, voffA);
            PG8_WAIT_L(8); PG8_BAR; PG8_WAIT_L(0); PG8_MMA(0, 0, At, B0); PG8_BAR; PG8_SCHED;
            PG8_LDB(B1, 0, 1); PG8_STAGE(PG8_SB(0, 0), b2, voffB);
            PG8_BAR; PG8_WAIT_L(0); PG8_MMA(0, 1, At, B1); PG8_BAR;
            PG8_LDA(At, 0, 1); PG8_STAGE(PG8_SA(0, 0), a2, voffA);
            PG8_BAR; PG8_WAIT_L(0); PG8_MMA(1, 0, At, B0); PG8_BAR; PG8_SCHED;
            PG8_STAGE(PG8_SB(0, 1), b2 + hstep, voffB);
            PG8_WAIT_V(6); PG8_BAR; PG8_MMA(1, 1, At, B1); PG8_BAR;
            PG8_LDB(B0, 1, 0); PG8_SCHED; PG8_LDA(At, 1, 0); PG8_STAGE(PG8_SA(0, 1), a2 + hstep, voffA);
            PG8_WAIT_L(8); PG8_BAR; PG8_WAIT_L(0); PG8_MMA(0, 0, At, B0); PG8_BAR; PG8_SCHED;
            PG8_LDB(B1, 1, 1); PG8_STAGE(PG8_SB(1, 0), b3, voffB);
            PG8_BAR; PG8_WAIT_L(0); PG8_MMA(0, 1, At, B1); PG8_BAR;
            PG8_LDA(At, 1, 1); PG8_STAGE(PG8_SA(1, 0), a3, voffA);
            PG8_BAR; PG8_WAIT_L(0); PG8_MMA(1, 0, At, B0); PG8_BAR; PG8_SCHED;
            PG8_STAGE(PG8_SB(1, 1), b3 + hstep, voffB);
            PG8_WAIT_V(6); PG8_BAR; PG8_MMA(1, 1, At, B1); PG8_BAR;
            }
        }
        if constexpr (ALIGN_EPI) { if (wr == 0) PG8_BAR; }
        if constexpr (!Epi::AFTER_DRAIN) { E(acc, cur, wr, wc, fr, fq); S.done(cur); }
        if (!has_next) break;
#pragma unroll
        for (int a = 0; a < 2; ++a)
#pragma unroll
            for (int b = 0; b < 2; ++b)
#pragma unroll
                for (int m = 0; m < 4; ++m)
#pragma unroll
                    for (int n = 0; n < 2; ++n) acc[a][b][m][n] = (f32x4){0.f, 0.f, 0.f, 0.f};
        cur = nxt; cA = nA; cB = nB; ++ui;
        if constexpr (ALIGN_EPI) { if (wr == 1) PG8_BAR; }
    }
    PG8_WAIT_V(0);
    if constexpr (!ALIGN_EPI) { if (wr == 0) PG8_BAR; }
    PG8_BAR;
    if constexpr (Epi::AFTER_DRAIN) { E.fused(acc, cur, wr, wc, fr, fq, lds, wid, lane); S.done(cur); }
#undef PG8_SA
#undef PG8_SB
#undef PG8_STAGE
#undef PG8_LDA
#undef PG8_LDB
#undef PG8_MMA
#undef PG8_WAIT_V
#undef PG8_WAIT_L
#undef PG8_BAR
#undef PG8_SCHED
}
}
using pg8::f32x4; using pg8::u32x4;

__device__ __forceinline__ void transpose_item(const float* W, int K, int N, bf16_t* WT, int row_off, float* scr, int item, int lane) {
    const int nblk = N / 32, kb = item / nblk, nbk = item % nblk, k0 = 64 * kb, n0 = 32 * nbk;
#pragma unroll 8
    for (int i = 0; i < 32; ++i) { const int kk = 2 * i + (lane >> 5); scr[kk * 33 + (lane & 31)] = W[(size_t)(k0 + kk) * N + n0 + (lane & 31)]; }
    asm volatile("s_waitcnt lgkmcnt(0)" ::: "memory");
    const int c = lane & 7;
#pragma unroll
    for (int j = 0; j < 4; ++j) { const int n = (lane >> 3) + 8 * j; const float* s = scr + (8 * c) * 33 + n;
        uint4 o; o.x = pk2(s[0 * 33], s[1 * 33]); o.y = pk2(s[2 * 33], s[3 * 33]); o.z = pk2(s[4 * 33], s[5 * 33]); o.w = pk2(s[6 * 33], s[7 * 33]);
        *(uint4*)(WT + (size_t)(row_off + n0 + n) * K + k0 + 8 * c) = o; }
    asm volatile("s_waitcnt lgkmcnt(0)" ::: "memory");
}
__device__ __forceinline__ void ph_prep(const Params& p, int bid, int nb, float* lds) {
    const int tid = tid_(), wave = tid >> 6, lane = tid & 63;
    {
        float* sl = lds;
        float* red = lds + 4096;
        for (int i = tid; i < 4096; i += NTH) sl[i] = siluf_(p.c[i]);
        __syncthreads();
        for (int it = bid; it < 192; it += nb) {
            const int c4 = tid & 15, kg = tid >> 4;
            const float* wp = p.w_ada + (size_t)kg * NMOD + it * 64 + c4 * 4;
            float a0[4] = {0.f, 0.f, 0.f, 0.f}, a1[4] = {0.f, 0.f, 0.f, 0.f};
#pragma unroll 8
            for (int i = 0; i < 64; ++i) {
                const int k = kg + 32 * i;
                const float4 w = *(const float4*)(wp + (size_t)(32 * i) * NMOD);
                const float s0 = sl[k], s1 = sl[2048 + k];
                a0[0] += s0 * w.x; a0[1] += s0 * w.y; a0[2] += s0 * w.z; a0[3] += s0 * w.w;
                a1[0] += s1 * w.x; a1[1] += s1 * w.y; a1[2] += s1 * w.z; a1[3] += s1 * w.w;
            }
            __syncthreads();
#pragma unroll
            for (int e = 0; e < 4; ++e) { red[(kg * 16 + c4) * 8 + e] = a0[e]; red[(kg * 16 + c4) * 8 + 4 + e] = a1[e]; }
            __syncthreads();
            if (tid < 128) {
                const int b = tid >> 6, col = tid & 63;
                float s = 0.f;
                for (int g = 0; g < 32; ++g) s += red[(g * 16 + (col >> 2)) * 8 + b * 4 + (col & 3)];
                p.ada[b * NMOD + it * 64 + col] = s + p.b_ada[it * 64 + col];
            }
        }
        __syncthreads();
    }
    for (int e = bid * NTH + tid; e < NTOK * 64; e += nb * NTH) {
        const int tok = e >> 6, j = e & 63;
        const float ang = (float)p.pos[tok] * c_freq[j];
        float s, c; sincos_acc(ang, s, c);
        p.rope[(size_t)e * 2] = c; p.rope[(size_t)e * 2 + 1] = s;
    }
    {
        float* scr = lds + wave * (64 * 33);
        const int gw = bid * 8 + wave, ngw = nb * 8;
        constexpr int I1 = 32 * 256, I2 = 32 * 128, I3 = 16 * 64, I4 = 32 * 64;
        constexpr int NIT = I1 + I2 + I3 + 3 * I4;
        for (int it = gw; it < NIT; it += ngw) {
            int r = it;
            if (r < I1) { transpose_item(p.w_in, 2048, 8192, p.Wt1, 0, scr, r, lane); continue; } r -= I1;
            if (r < I2) { transpose_item(p.w_bg, 2048, 4096, p.Wt1, 8192, scr, r, lane); continue; } r -= I2;
            if (r < I3) { transpose_item(p.w_a_out, 1024, 2048, p.Wta, 0, scr, r, lane); continue; } r -= I3;
            if (r < I4) { transpose_item(p.w_b_out, 2048, 2048, p.Wtb, 0, scr, r, lane); continue; } r -= I4;
            if (r < I4) { transpose_item(p.w_o, 2048, 2048, p.Wto, 0, scr, r, lane); continue; } r -= I4;
            transpose_item(p.peer_wq, 2048, 2048, p.Wtq, 0, scr, r, lane);
        }
    }
    __syncthreads();
}
__device__ __forceinline__ void ph_tabconv(const Params& p, int bid, int nb) {
    const int tid = tid_(), wave = tid >> 6, lane = tid & 63;
    for (int r = bid * 8 + wave; r < 2 * 16384; r += nb * 8) {
        const bool second = r >= 16384; const int row = second ? r - 16384 : r;
        const float* src = (second ? p.peer_v : p.peer_u) + (size_t)row * DM;
        float4 v[2][4]; float am = 0.f;
#pragma unroll
        for (int j = 0; j < 2; ++j)
#pragma unroll
            for (int q = 0; q < 4; ++q) { v[j][q] = *(const float4*)(src + (lane + 64 * j) * 16 + 4 * q);
                am = fmaxf(am, fmaxf(fmaxf(fabsf(v[j][q].x), fabsf(v[j][q].y)), fmaxf(fabsf(v[j][q].z), fabsf(v[j][q].w)))); }
        am = wave_max(am);
        const float sc = (am > 0.f) ? am * (1.0f / 384.0f) : 1.0f, inv = (am > 0.f) ? 384.0f / am : 1.0f;
        unsigned char* dst = (second ? p.V8 : p.U8) + (size_t)row * DM;
#pragma unroll
        for (int j = 0; j < 2; ++j) {
            unsigned w[4];
#pragma unroll
            for (int q = 0; q < 4; ++q) { int t = 0; t = __builtin_amdgcn_cvt_pk_fp8_f32(v[j][q].x * inv, v[j][q].y * inv, t, false); t = __builtin_amdgcn_cvt_pk_fp8_f32(v[j][q].z * inv, v[j][q].w * inv, t, true); w[q] = (unsigned)t; }
            *(uint4*)(dst + (lane + 64 * j) * 16) = make_uint4(w[0], w[1], w[2], w[3]);
        }
        if (lane == 0) (second ? p.sv : p.su)[row] = sc;
    }
}

__device__ __forceinline__ void ph_modnorm(const Params& p, const float* xin, const float* g, int sh_off, int sc_off, bf16_t* hout, int bid, int nb, float* lds) {
    const int tid = tid_(), wave = tid >> 6, lane = tid & 63;
    for (int row = bid * 8 + wave; row < NTOK; row += nb * 8) {
        const int b = row / SQ;
        const float4* xr = (const float4*)(xin + (size_t)row * DM);
        float4 v[8]; float ss = 0.f;
#pragma unroll
        for (int j = 0; j < 8; ++j) { v[j] = xr[lane + 64 * j]; ss += dot4(v[j], v[j]); }
        ss = wave_sum(ss);
        const float rs = 1.0f / sqrtf(ss * (1.0f / DM) + 1e-6f);
#pragma unroll
        for (int j = 0; j < 8; ++j) {
            const int col = (lane + 64 * j) * 4;
            const float4 g4 = *(const float4*)(g + col);
            const float4 sc = *(const float4*)(p.ada + b * NMOD + sc_off + col);
            const float4 sh = *(const float4*)(p.ada + b * NMOD + sh_off + col);
            float4 o;
            o.x = v[j].x * rs * g4.x * (1.0f + sc.x) + sh.x; o.y = v[j].y * rs * g4.y * (1.0f + sc.y) + sh.y;
            o.z = v[j].z * rs * g4.z * (1.0f + sc.z) + sh.z; o.w = v[j].w * rs * g4.w * (1.0f + sc.w) + sh.w;
            *(uint2*)(hout + (size_t)row * DM + col) = make_uint2(pk2(o.x, o.y), pk2(o.z, o.w));
        }
    }
}

typedef short bf16x8_t __attribute__((ext_vector_type(8)));
typedef float f32x4_t __attribute__((ext_vector_type(4)));
__device__ __forceinline__ bf16x8_t ldfrag(const char* base, int row, int chunk, int rb, int sm) { return *(const bf16x8_t*)(base + row * rb + ((chunk ^ (row & sm)) << 4)); }
__device__ __forceinline__ void ph_gmlp2(const Params& p, int bid, int nb, float* lds) {
    char* WM = (char*)lds; char* VT = WM + 32768;
    const int tid = tid_(), wave = tid >> 6, lane = tid & 63, fr = lane & 15, fq = lane >> 4;
    int gl = -1;
    for (int it = bid; it < 512; it += nb) {
        const int g = it & 7, n = (it >> 3) & 31, b = it >> 8;
        const int tok0 = b * SQ + n * 128;
        __syncthreads();
        if (g != gl) {
            for (int u = tid; u < 2048; u += NTH) {
                const int i = u >> 4, c = u & 15;
                const float4* src = (const float4*)(p.gm_ws + (size_t)g * 16384 + i * 128 + c * 8);
                float4 a = src[0], b4 = src[1];
                if ((i >> 6) < (c >> 3)) { a = make_float4(0.f, 0.f, 0.f, 0.f); b4 = a; }
                *(uint4*)(WM + i * 256 + ((c ^ (i & 15)) << 4)) = make_uint4(pk2(a.x, a.y), pk2(a.z, a.w), pk2(b4.x, b4.y), pk2(b4.z, b4.w));
            }
            gl = g;
        }
        {
            const float2 gn = *(const float2*)(p.gm_v_g + g * 128 + lane * 2);
#pragma unroll 4
            for (int jj = 0; jj < 16; ++jj) {
                const int j = wave * 16 + jj;
                const unsigned w = *(const unsigned*)(p.ZG + (size_t)(tok0 + j) * ZW + 1024 + g * 128 + lane * 2);
                const float a = bflo(w), c2 = bfhi(w);
                const float ss = wave_sum(a * a + c2 * c2);
                const float rs = 1.0f / sqrtf(ss * (1.0f / 128.0f) + 1e-6f);
                const int d0 = lane * 2, d1 = d0 + 1;
                *(bf16_t*)(VT + d0 * 256 + (((j >> 3) ^ (d0 & 15)) << 4) + (j & 7) * 2) = (bf16_t)f2bf(a * rs * gn.x);
                *(bf16_t*)(VT + d1 * 256 + (((j >> 3) ^ (d1 & 15)) << 4) + (j & 7) * 2) = (bf16_t)f2bf(c2 * rs * gn.y);
            }
        }
        __syncthreads();
        {
            bf16x8_t A[4];
#pragma unroll
            for (int ks = 0; ks < 4; ++ks) A[ks] = ldfrag(VT, wave * 16 + fr, ks * 4 + fq, 256, 15);
            const int d0 = wave * 16 + fq * 4;
#pragma unroll
            for (int itl = 0; itl < 8; ++itl) {
                f32x4_t acc = {0.f, 0.f, 0.f, 0.f};
#pragma unroll
                for (int ks = 0; ks < 4; ++ks) if (itl >= 4 || ks < 2) acc = __builtin_amdgcn_mfma_f32_16x16x32_bf16(A[ks], ldfrag(WM, itl * 16 + fr, ks * 4 + fq, 256, 15), acc, 0, 0, 0);
                const int i = itl * 16 + fr;
                const float bias = p.gm_b[g * 128 + i];
                const size_t tok = (size_t)(tok0 + i);
                const uint2 uw = *(const uint2*)(p.ZG + tok * ZW + g * 128 + d0);
                *(uint2*)(p.yain + tok * 1024 + g * 128 + d0) = make_uint2(pk2(bflo(uw.x) * (acc[0] + bias), bfhi(uw.x) * (acc[1] + bias)), pk2(bflo(uw.y) * (acc[2] + bias), bfhi(uw.y) * (acc[3] + bias)));
            }
        }
    }
    __syncthreads();
}

__device__ __forceinline__ void ph_ret(const Params& p, int bid, int nb, float* lds) {
    float* Qs = lds;
    float* Ks = Qs + 64 * 129;
    float* Vs = Ks + 64 * 129;
    float* Ss = Vs + 64 * 16;
    float* At = Ss + 128 * 16;
    float* kd = At + 64 * 65;
    const int tid = tid_();
    const bf16_t* z = p.ZG;
    for (int it = bid; it < 256; it += nb) {
        const int vs = it & 15, h = (it >> 4) & 7, b = it >> 7;
        const float lg = log1pf(-exp2f(-5.0f - (float)h));
        const float cdec = expf(lg * 64.0f);
        __syncthreads();
        for (int i = tid; i < 2048; i += NTH) Ss[i] = 0.f;
        if (tid < 64) kd[tid] = expf(lg * (float)(63 - tid));
        for (int n = 0; n < 64; ++n) {
            const int tok0 = b * SQ + n * 64;
            __syncthreads();
            for (int e = tid; e < 4096; e += NTH) {
                const int i = e >> 6, dd = e & 63; const size_t tok = (size_t)(tok0 + i);
                const float cs = p.rope[(tok * 64 + dd) * 2], sn = p.rope[(tok * 64 + dd) * 2 + 1];
                const bf16_t* zr = z + tok * ZW;
                const float q1 = bf2f(zr[2048 + h * 128 + dd]), q2 = bf2f(zr[2048 + h * 128 + 64 + dd]);
                const float k1 = bf2f(zr[3072 + h * 128 + dd]), k2 = bf2f(zr[3072 + h * 128 + 64 + dd]);
                Qs[i * 129 + dd] = q1 * cs - q2 * sn; Qs[i * 129 + 64 + dd] = q1 * sn + q2 * cs;
                const float sc = 0.08838834764831845f;
                Ks[i * 129 + dd] = (k1 * cs - k2 * sn) * sc; Ks[i * 129 + 64 + dd] = (k1 * sn + k2 * cs) * sc;
            }
            for (int e = tid; e < 1024; e += NTH) { const int j = e >> 4, v = e & 15; Vs[e] = bf2f(z[(size_t)(tok0 + j) * ZW + 4096 + h * 256 + vs * 16 + v]); }
            __syncthreads();
            {
                const int j = tid & 63, i0 = (tid >> 6) * 8;
                float acc[8];
#pragma unroll
                for (int ii = 0; ii < 8; ++ii) acc[ii] = 0.f;
                for (int d = 0; d < 128; ++d) {
                    const float kv = Ks[j * 129 + d];
#pragma unroll
                    for (int ii = 0; ii < 8; ++ii) acc[ii] += Qs[(i0 + ii) * 129 + d] * kv;
                }
#pragma unroll
                for (int ii = 0; ii < 8; ++ii) { const int i = i0 + ii; At[i * 65 + j] = acc[ii] * expf(lg * fabsf((float)(i - j))); }
            }
            __syncthreads();
            {
                const int v = tid & 15, i0 = tid >> 4;
#pragma unroll
                for (int rep = 0; rep < 2; ++rep) {
                    const int i = i0 + 32 * rep;
                    float a = 0.f; for (int j = 0; j < 64; ++j) a += At[i * 65 + j] * Vs[j * 16 + v];
                    float c2 = 0.f; for (int d = 0; d < 128; ++d) c2 += Qs[i * 129 + d] * Ss[d * 16 + v];
                    p.obuf[(size_t)(tok0 + i) * DM + h * 256 + vs * 16 + v] = a + c2 * expf(lg * (float)(i + 1));
                }
            }
            __syncthreads();
            {
                const int v = tid & 15, d0 = tid >> 4;
#pragma unroll
                for (int rep = 0; rep < 4; ++rep) {
                    const int d = d0 + 32 * rep;
                    float a = 0.f; for (int j = 0; j < 64; ++j) a += Ks[j * 129 + d] * kd[j] * Vs[j * 16 + v];
                    Ss[d * 16 + v] = Ss[d * 16 + v] * cdec + a;
                }
            }
        }
    }
    __syncthreads();
}


__device__ __forceinline__ void ph_retprep(const Params& p, int bid, int nb, float* lds) {
    bf16_t* Kl = (bf16_t*)lds;
    bf16_t* Vl = Kl + 64 * 132;
    const int tid = tid_();
    for (int it = bid; it < 1024; it += nb) {
        const int n = it & 63, h = (it >> 6) & 7, b = it >> 9;
        const int tok0 = b * SQ + n * 64;
        const size_t rowbase = (size_t)(b * 8 + h) * SQ + n * 64;
        const float lg = log1pf(-exp2f(-5.0f - (float)h));
        __syncthreads();
#pragma unroll
        for (int k = 0; k < 2; ++k) {
            const int u = tid + 512 * k, i = u >> 4, dd = (u & 15) * 4; const size_t tok = (size_t)(tok0 + i);
            const float4 r0 = *(const float4*)(p.rope + (tok * 64 + dd) * 2), r1 = *(const float4*)(p.rope + (tok * 64 + dd) * 2 + 4);
            const float cs[4] = {r0.x, r0.z, r1.x, r1.z}, sn[4] = {r0.y, r0.w, r1.y, r1.w};
            const bf16_t* zr = p.ZG + tok * ZW;
            const uint2 q1w = *(const uint2*)(zr + 2048 + h * 128 + dd), q2w = *(const uint2*)(zr + 2048 + h * 128 + 64 + dd);
            const uint2 k1w = *(const uint2*)(zr + 3072 + h * 128 + dd), k2w = *(const uint2*)(zr + 3072 + h * 128 + 64 + dd);
            const float q1[4] = {bflo(q1w.x), bfhi(q1w.x), bflo(q1w.y), bfhi(q1w.y)}, q2[4] = {bflo(q2w.x), bfhi(q2w.x), bflo(q2w.y), bfhi(q2w.y)};
            const float k1[4] = {bflo(k1w.x), bfhi(k1w.x), bflo(k1w.y), bfhi(k1w.y)}, k2[4] = {bflo(k2w.x), bfhi(k2w.x), bflo(k2w.y), bfhi(k2w.y)};
            const float sc = 0.08838834764831845f, kd = expf(lg * (float)(63 - i));
            float qa[4], qb[4], ka[4], kb[4];
#pragma unroll
            for (int e = 0; e < 4; ++e) { qa[e] = q1[e] * cs[e] - q2[e] * sn[e]; qb[e] = q1[e] * sn[e] + q2[e] * cs[e]; ka[e] = (k1[e] * cs[e] - k2[e] * sn[e]) * sc; kb[e] = (k1[e] * sn[e] + k2[e] * cs[e]) * sc; }
            *(uint2*)(p.Qr + (rowbase + i) * 128 + dd) = make_uint2(pk2(qa[0], qa[1]), pk2(qa[2], qa[3]));
            *(uint2*)(p.Qr + (rowbase + i) * 128 + 64 + dd) = make_uint2(pk2(qb[0], qb[1]), pk2(qb[2], qb[3]));
            *(uint2*)(p.Kr + (rowbase + i) * 128 + dd) = make_uint2(pk2(ka[0], ka[1]), pk2(ka[2], ka[3]));
            *(uint2*)(p.Kr + (rowbase + i) * 128 + 64 + dd) = make_uint2(pk2(kb[0], kb[1]), pk2(kb[2], kb[3]));
            *(uint2*)(Kl + i * 132 + dd) = make_uint2(pk2(ka[0] * kd, ka[1] * kd), pk2(ka[2] * kd, ka[3] * kd));
            *(uint2*)(Kl + i * 132 + 64 + dd) = make_uint2(pk2(kb[0] * kd, kb[1] * kd), pk2(kb[2] * kd, kb[3] * kd));
        }
#pragma unroll
        for (int k = 0; k < 4; ++k) {
            const int u = tid + 512 * k, j = u >> 5, c = u & 31;
            *(uint4*)(Vl + j * 264 + c * 8) = *(const uint4*)(p.ZG + (size_t)(tok0 + j) * ZW + 4096 + h * 256 + c * 8);
        }
        __syncthreads();
        bf16_t* kt = p.KTd + (size_t)it * 8192;
#pragma unroll
        for (int k = 0; k < 2; ++k) {
            const int u = tid + 512 * k, d = u & 127, jg = u >> 7;
            unsigned w[4];
#pragma unroll
            for (int q = 0; q < 4; ++q) w[q] = (unsigned)Kl[(jg * 8 + 2 * q) * 132 + d] | ((unsigned)Kl[(jg * 8 + 2 * q + 1) * 132 + d] << 16);
            *(uint4*)(kt + d * 64 + jg * 8) = make_uint4(w[0], w[1], w[2], w[3]);
        }
        bf16_t* vt = p.Vt + (size_t)it * 16384;
#pragma unroll
        for (int k = 0; k < 4; ++k) {
            const int u = tid + 512 * k, v = u & 255, jg = u >> 8;
            unsigned w[4];
#pragma unroll
            for (int q = 0; q < 4; ++q) w[q] = (unsigned)Vl[(jg * 8 + 2 * q) * 264 + v] | ((unsigned)Vl[(jg * 8 + 2 * q + 1) * 264 + v] << 16);
            *(uint4*)(vt + v * 64 + jg * 8) = make_uint4(w[0], w[1], w[2], w[3]);
        }
    }
    __syncthreads();
}

__device__ __forceinline__ void ph_ret2(const Params& p, int bid, int nb, float* lds) {
    char* L = (char*)lds;
    constexpr int OQ = 0, OKK = 16384, OKT = 32768, OVT = 49152, TILE = 51200, OP = 2 * TILE, OST = OP + 8192;
    const int tid = tid_(), wave = tid >> 6, lane = tid & 63, fr = lane & 15, fq = lane >> 4;
    for (int it = bid; it < 256; it += nb) {
        const int vs = it & 15, h = (it >> 4) & 7, b = it >> 7;
        const float lg = log1pf(-exp2f(-5.0f - (float)h));
        const float cdec = expf(lg * 64.0f);
        const size_t bh = (size_t)(b * 8 + h);
        const char* gQ = (const char*)(p.Qr + bh * SQ * 128);
        const char* gK = (const char*)(p.Kr + bh * SQ * 128);
        const char* gKT = (const char*)(p.KTd + bh * 64 * 8192);
        const char* gVt = (const char*)(p.Vt + bh * 64 * 16384) + vs * 16 * 128;
        int lq[2], lkt[2];
#pragma unroll
        for (int u = 0; u < 2; ++u) { const int ci = tid + 512 * u; const int r = ci >> 4, c = ci & 15; lq[u] = r * 256 + ((c ^ (r & 15)) << 4); const int d = ci >> 3, c8 = ci & 7; lkt[u] = d * 128 + ((c8 ^ (d & 7)) << 4); }
        const int lv = (tid >> 3) * 128 + (((tid & 7) ^ ((tid >> 3) & 7)) << 4);
        uint4 qA0, qA1, kA0, kA1, tA0, tA1, vA = make_uint4(0u, 0u, 0u, 0u), qB0, qB1, kB0, kB1, tB0, tB1, vB = make_uint4(0u, 0u, 0u, 0u);
#define RET_LOAD(X_, n_) do { const size_t o0 = (size_t)(n_) * 16384 + (size_t)tid * 16, o1 = o0 + 8192; \
        q##X_##0 = *(const uint4*)(gQ + o0); q##X_##1 = *(const uint4*)(gQ + o1); k##X_##0 = *(const uint4*)(gK + o0); k##X_##1 = *(const uint4*)(gK + o1); t##X_##0 = *(const uint4*)(gKT + o0); t##X_##1 = *(const uint4*)(gKT + o1); \
        if (tid < 128) v##X_ = *(const uint4*)(gVt + (size_t)(n_) * 32768 + tid * 16); } while (0)
#define RET_WRITE(X_, buf_) do { char* B_ = L + (buf_) * TILE; \
        *(uint4*)(B_ + OQ + lq[0]) = q##X_##0; *(uint4*)(B_ + OQ + lq[1]) = q##X_##1; *(uint4*)(B_ + OKK + lq[0]) = k##X_##0; *(uint4*)(B_ + OKK + lq[1]) = k##X_##1; *(uint4*)(B_ + OKT + lkt[0]) = t##X_##0; *(uint4*)(B_ + OKT + lkt[1]) = t##X_##1; \
        if (tid < 128) *(uint4*)(B_ + OVT + lv) = v##X_; } while (0)
        __syncthreads();
        for (int i = tid; i < 1024; i += NTH) ((unsigned*)(L + OST))[i] = 0u;
        RET_LOAD(A, 0); RET_WRITE(A, 0); RET_LOAD(B, 1);
        f32x4_t sacc[2] = {{0.f, 0.f, 0.f, 0.f}, {0.f, 0.f, 0.f, 0.f}};
#define RET_STEP(n_, cur_, LS_, WS_) do { const int n = (n_); constexpr int cur = (cur_); \
            __syncthreads();                                     \
            if (n + 2 < 64) RET_LOAD(LS_, n + 2); \
            const char* T = L + cur * TILE; \
            {     \
                const int jt = wave >> 1, it0 = 2 * (wave & 1); \
                f32x4_t s0 = {0.f, 0.f, 0.f, 0.f}, s1 = {0.f, 0.f, 0.f, 0.f}; \
                _Pragma("unroll") for (int ks = 0; ks < 4; ++ks) { \
                    const bf16x8_t a = ldfrag(T + OKK, jt * 16 + fr, ks * 4 + fq, 256, 15); \
                    const bf16x8_t b0 = ldfrag(T + OQ, it0 * 16 + fr, ks * 4 + fq, 256, 15), b1 = ldfrag(T + OQ, (it0 + 1) * 16 + fr, ks * 4 + fq, 256, 15); \
                    s0 = __builtin_amdgcn_mfma_f32_16x16x32_bf16(a, b0, s0, 0, 0, 0); \
                    s1 = __builtin_amdgcn_mfma_f32_16x16x32_bf16(a, b1, s1, 0, 0, 0); } \
                const int j0 = jt * 16 + fq * 4; \
                _Pragma("unroll") for (int tt = 0; tt < 2; ++tt) { \
                    const int i = (it0 + tt) * 16 + fr; const f32x4_t sv4 = tt ? s1 : s0; float pv[4]; \
                    _Pragma("unroll") for (int r = 0; r < 4; ++r) pv[r] = sv4[r] * __expf(lg * fabsf((float)(i - (j0 + r)))); \
                    *(uint2*)(L + OP + i * 128 + ((((j0 >> 3)) ^ (i & 7)) << 4) + (j0 & 7) * 2) = make_uint2(pk2(pv[0], pv[1]), pk2(pv[2], pv[3])); } \
            } \
            __syncthreads();                                     \
            if (wave < 4) {     \
                const int itl = wave; \
                f32x4_t o1 = {0.f, 0.f, 0.f, 0.f}, o2 = {0.f, 0.f, 0.f, 0.f}; \
                _Pragma("unroll") for (int ks = 0; ks < 2; ++ks) o1 = __builtin_amdgcn_mfma_f32_16x16x32_bf16(ldfrag(L + OP, itl * 16 + fr, ks * 4 + fq, 128, 7), ldfrag(T + OVT, fr, ks * 4 + fq, 128, 7), o1, 0, 0, 0); \
                _Pragma("unroll") for (int ks = 0; ks < 4; ++ks) o2 = __builtin_amdgcn_mfma_f32_16x16x32_bf16(ldfrag(T + OQ, itl * 16 + fr, ks * 4 + fq, 256, 15), ldfrag(L + OST + cur * 4096, fr, ks * 4 + fq, 256, 15), o2, 0, 0, 0); \
                _Pragma("unroll") for (int r = 0; r < 4; ++r) { const int i = itl * 16 + fq * 4 + r; \
                    p.ob16[(size_t)(b * SQ + n * 64 + i) * DM + h * 256 + vs * 16 + fr] = (bf16_t)f2bf(o1[r] + __expf(lg * (float)(i + 1)) * o2[r]); } \
            } else {            \
                _Pragma("unroll") for (int u = 0; u < 2; ++u) { \
                    const int dt = 2 * (wave - 4) + u; \
                    sacc[u] = sacc[u] * cdec; \
                    _Pragma("unroll") for (int ks = 0; ks < 2; ++ks) sacc[u] = __builtin_amdgcn_mfma_f32_16x16x32_bf16(ldfrag(T + OKT, dt * 16 + fr, ks * 4 + fq, 128, 7), ldfrag(T + OVT, fr, ks * 4 + fq, 128, 7), sacc[u], 0, 0, 0); \
                    *(uint2*)(L + OST + (cur ^ 1) * 4096 + fr * 256 + (((dt * 2 + (fq >> 1)) ^ fr) << 4) + (fq & 1) * 8) = make_uint2(pk2(sacc[u][0], sacc[u][1]), pk2(sacc[u][2], sacc[u][3])); } \
            } \
            if (n + 1 < 64) RET_WRITE(WS_, cur ^ 1); } while (0)
        for (int n2 = 0; n2 < 64; n2 += 2) { RET_STEP(n2, 0, A, B); RET_STEP(n2 + 1, 1, B, A); }
#undef RET_STEP
#undef RET_LOAD
#undef RET_WRITE
    }
    __syncthreads();
}

__device__ __forceinline__ void ph_gn(const Params& p, int bid, int nb, float* lds) {
    const int tid = tid_(), wave = tid >> 6, lane = tid & 63;
    for (int tok = bid * 8 + wave; tok < NTOK; tok += nb * 8) {
#pragma unroll
        for (int h = 0; h < 8; ++h) {
            const uint2 ow = *(const uint2*)(p.ob16 + (size_t)tok * DM + h * 256 + lane * 4);
            const float4 o = make_float4(bflo(ow.x), bfhi(ow.x), bflo(ow.y), bfhi(ow.y));
            const float mu = wave_sum(o.x + o.y + o.z + o.w) * (1.0f / 256.0f);
            const float4 d = make_float4(o.x - mu, o.y - mu, o.z - mu, o.w - mu);
            const float var = wave_sum(dot4(d, d)) * (1.0f / 256.0f);
            const float rs = 1.0f / sqrtf(var + 1e-6f);
            const float4 gn = *(const float4*)(p.ret_gn_g + h * 256 + lane * 4);
            const uint2 gw = *(const uint2*)(p.ZG + (size_t)tok * ZW + 6144 + h * 256 + lane * 4);
            const float g0 = bflo(gw.x), g1 = bfhi(gw.x), g2 = bflo(gw.y), g3 = bfhi(gw.y);
            *(uint2*)(p.ybin + (size_t)tok * DM + h * 256 + lane * 4) =
                make_uint2(pk2(siluf_(g0) * d.x * rs * gn.x, siluf_(g1) * d.y * rs * gn.y), pk2(siluf_(g2) * d.z * rs * gn.z, siluf_(g3) * d.w * rs * gn.w));
        }
    }
}

template <int NL>
__device__ __forceinline__ void wave_top16(float (&v)[NL], const int (&idx)[NL], float& outv, int& outi, int lane) {
    outv = 0.f; outi = 0;
    for (int r = 0; r < 16; ++r) {
        float m = v[0];
#pragma unroll
        for (int u = 1; u < NL; ++u) m = fmaxf(m, v[u]);
        const float wm = wave_max(m);
        const unsigned long long bal = __ballot(m == wm);
        const int owner = __ffsll((long long)bal) - 1;
        int myi = -1;
        if (lane == owner) {
            bool done = false;
#pragma unroll
            for (int u = 0; u < NL; ++u) if (!done && v[u] == wm) { myi = idx[u]; v[u] = -INFINITY; done = true; }
        }
        const int wi = __shfl(myi, owner);
        if (lane == r) { outv = wm; outi = wi; }
    }
}
__device__ __forceinline__ void ph_topk(const Params& p, const float* qb, int bid, int nb, float* lds) {
    const int tid = tid_(), wave = tid >> 6, lane = tid & 63;
    for (int t = bid; t < NTOK; t += nb) {
        const int h = wave;
        const float* q = qb + (size_t)t * DM + h * 256;
        float s[2][2];
#pragma unroll
        for (int pp = 0; pp < 2; ++pp)
#pragma unroll
            for (int r = 0; r < 2; ++r) {
                const int n = lane + 64 * r;
                const float4* kr = (const float4*)(p.peer_sk + ((size_t)(h * 2 + pp) * 128 + n) * 128);
                const float4* qr = (const float4*)(q + pp * 128);
                float a = 0.f;
#pragma unroll 4
                for (int d4 = 0; d4 < 32; ++d4) a += dot4(kr[d4], qr[d4]);
                s[pp][r] = a;
            }
        float v1, v2; int i1, i2;
        { float vv[2] = {s[0][0], s[0][1]}; const int ii[2] = {lane, lane + 64}; wave_top16<2>(vv, ii, v1, i1, lane); }
        { float vv[2] = {s[1][0], s[1][1]}; const int ii[2] = {lane, lane + 64}; wave_top16<2>(vv, ii, v2, i2, lane); }
        float cv[4]; int ci[4];
        const int a = lane >> 2, b0 = (lane & 3) * 4;
        const float va = __shfl(v1, a); const int ia = __shfl(i1, a);
#pragma unroll
        for (int u = 0; u < 4; ++u) { const float vb = __shfl(v2, b0 + u); const int ib = __shfl(i2, b0 + u); cv[u] = va + vb; ci[u] = ia * 128 + ib; }
        float tv; int te;
        wave_top16<4>(cv, ci, tv, te, lane);
        const float mx = __shfl(tv, 0);
        const float ex = (lane < 16) ? expf(tv - mx) : 0.f;
        const float sum = wave_sum(ex);
        if (lane < 16) { p.eidx[(size_t)t * 128 + h * 16 + lane] = te; p.gatev[(size_t)t * 128 + h * 16 + lane] = ex / sum; }
    }
}

__device__ __forceinline__ void ph_peer(const Params& p, const float* x1, const bf16_t* h2, int bid, int nb, float* lds) {
    float* ys = lds;
    float* red = lds + 8 * 2048;
    const int tid = tid_(), wave = tid >> 6, lane = tid & 63;
    for (int t = bid; t < NTOK; t += nb) {
        const int b = t / SQ, h = wave;
        const uint2* hr = (const uint2*)(h2 + (size_t)t * DM);
        float4 hv[8], y[8];
#pragma unroll
        for (int j = 0; j < 8; ++j) { const uint2 w = hr[lane + 64 * j]; hv[j] = make_float4(bflo(w.x), bfhi(w.x), bflo(w.y), bfhi(w.y)); y[j] = make_float4(0.f, 0.f, 0.f, 0.f); }
        for (int k = 0; k < 16; ++k) {
            const int e = p.eidx[(size_t)t * 128 + h * 16 + k]; const float gt = p.gatev[(size_t)t * 128 + h * 16 + k];
            const float4* ur = (const float4*)(p.peer_u + (size_t)e * DM);
            float a = 0.f;
#pragma unroll
            for (int j = 0; j < 8; ++j) a += dot4(ur[lane + 64 * j], hv[j]);
            a = wave_sum(a);
            const float w = geluf_(a) * gt;
            const float4* vr = (const float4*)(p.peer_v + (size_t)e * DM);
#pragma unroll
            for (int j = 0; j < 8; ++j) { const float4 v4 = vr[lane + 64 * j]; y[j].x += w * v4.x; y[j].y += w * v4.y; y[j].z += w * v4.z; y[j].w += w * v4.w; }
        }
        __syncthreads();
#pragma unroll
        for (int j = 0; j < 8; ++j) *(float4*)(ys + h * 2048 + (lane + 64 * j) * 4) = y[j];
        __syncthreads();
        const int c = tid * 4;
        float4 s = make_float4(0.f, 0.f, 0.f, 0.f);
#pragma unroll
        for (int hh = 0; hh < 8; ++hh) { const float4 a = *(const float4*)(ys + hh * 2048 + c); s.x += a.x; s.y += a.y; s.z += a.z; s.w += a.w; }
        const float4 xv = *(const float4*)(x1 + (size_t)t * DM + c);
        const float4 ga = *(const float4*)(p.ada + b * NMOD + 5 * DM + c);
        const float4 x2 = make_float4(xv.x + ga.x * s.x, xv.y + ga.y * s.y, xv.z + ga.z * s.z, xv.w + ga.w * s.w);
        const float ss = wave_sum(dot4(x2, x2));
        if (lane == 0) red[wave] = ss;
        __syncthreads();
        float tot = 0.f;
#pragma unroll
        for (int w = 0; w < 8; ++w) tot += red[w];
        const float rs = 1.0f / sqrtf(tot * (1.0f / DM) + 1e-6f);
        const float4 gf = *(const float4*)(p.norm_f_g + c);
        *(float4*)(p.out + (size_t)t * DM + c) = make_float4(x2.x * rs * gf.x, x2.y * rs * gf.y, x2.z * rs * gf.z, x2.w * rs * gf.w);
    }
    __syncthreads();
}

__device__ __forceinline__ void split8(const float4 a, const float4 b, uint4& hi, uint4& lo) {
    const float x[8] = {a.x, a.y, a.z, a.w, b.x, b.y, b.z, b.w}; unsigned h[8], l[8];
#pragma unroll
    for (int i = 0; i < 8; ++i) { h[i] = f2bf(x[i]); l[i] = f2bf(x[i] - __uint_as_float(h[i] << 16)); }
    hi = make_uint4(h[0] | (h[1] << 16), h[2] | (h[3] << 16), h[4] | (h[5] << 16), h[6] | (h[7] << 16));
    lo = make_uint4(l[0] | (l[1] << 16), l[2] | (l[3] << 16), l[4] | (l[5] << 16), l[6] | (l[7] << 16));
}
__device__ __forceinline__ bf16x8_t as_bf16x8(const uint4 v) { return __builtin_bit_cast(bf16x8_t, v); }
struct PairTab { int a[52], b[52]; };
__host__ __device__ constexpr PairTab make_pairs() {
    PairTab t{}; int n = 0;
    for (int a = 0; a < 16; ++a) for (int b = 0; b < 16; ++b) if ((a + 1) * (b + 1) <= 16) { t.a[n] = a; t.b[n] = b; ++n; }
    for (; n < 52; ++n) { t.a[n] = -1; t.b[n] = -1; }
    return t;
}
constexpr PairTab PAIRS = make_pairs();
static_assert(PAIRS.a[49] >= 0 && PAIRS.a[50] < 0, "50 candidate pairs");

__device__ __forceinline__ void ph_topk2(const Params& p, const float* qb, int bid, int nb, float* lds) {
    const int tid = tid_(), wave = tid >> 6, lane = tid & 63;
    uint4* SK = (uint4*)lds;
    const float NEG = -INFINITY;
    for (int it = bid; it < 256; it += nb) {
        const int h = it & 7, tg = it >> 3;
        __syncthreads();
        for (int gi = tid; gi < 4096; gi += NTH) {
            const int dq = gi & 15, n = (gi >> 4) & 127, pp = gi >> 11;
            const float4* src = (const float4*)(p.peer_sk + ((size_t)(h * 2 + pp) * 128 + n) * 128 + dq * 8);
            uint4 hi, lo; split8(src[0], src[1], hi, lo);
            const int base = (((pp * 8 + (n >> 4)) * 4 + (dq >> 2)) * 2) * 64 + (dq & 3) * 16 + (n & 15);
            SK[base] = hi; SK[base + 64] = lo;
        }
        __syncthreads();
#pragma unroll 1
        for (int tile = 0; tile < 2; ++tile) {
            const int tok = tg * 256 + wave * 32 + tile * 16 + (lane & 15);
            const int qd = lane >> 4;
            float v12[2][16];
#pragma unroll
            for (int pp = 0; pp < 2; ++pp) {
                bf16x8_t Bh[4], Bl[4];
                const float* qp = qb + (size_t)tok * DM + h * 256 + pp * 128 + 8 * qd;
#pragma unroll
                for (int ks = 0; ks < 4; ++ks) { uint4 hi, lo; split8(*(const float4*)(qp + ks * 32), *(const float4*)(qp + ks * 32 + 4), hi, lo); Bh[ks] = as_bf16x8(hi); Bl[ks] = as_bf16x8(lo); }
                float v[32];
#pragma unroll
                for (int kt = 0; kt < 8; ++kt) {
                    f32x4_t acc = {0.f, 0.f, 0.f, 0.f};
#pragma unroll
                    for (int ks = 0; ks < 4; ++ks) {
                        const bf16x8_t Ah = as_bf16x8(SK[(((pp * 8 + kt) * 4 + ks) * 2) * 64 + lane]), Al = as_bf16x8(SK[(((pp * 8 + kt) * 4 + ks) * 2 + 1) * 64 + lane]);
                        acc = __builtin_amdgcn_mfma_f32_16x16x32_bf16(Ah, Bh[ks], acc, 0, 0, 0);
                        acc = __builtin_amdgcn_mfma_f32_16x16x32_bf16(Ah, Bl[ks], acc, 0, 0, 0);
                        acc = __builtin_amdgcn_mfma_f32_16x16x32_bf16(Al, Bh[ks], acc, 0, 0, 0);
                    }
#pragma unroll
                    for (int r = 0; r < 4; ++r) v[kt * 4 + r] = __uint_as_float((__float_as_uint(acc[r]) & ~127u) | (unsigned)(kt * 16 + qd * 4 + r));
                    __builtin_amdgcn_sched_barrier(0);
                }
#pragma unroll
                for (int r = 0; r < 16; ++r) {
                    float m = v[0];
#pragma unroll
                    for (int u = 1; u < 32; ++u) m = fmaxf(m, v[u]);
                    m = fmaxf(m, __shfl_xor(m, 16)); m = fmaxf(m, __shfl_xor(m, 32));
                    v12[pp][r] = m;
#pragma unroll
                    for (int u = 0; u < 32; ++u) v[u] = (v[u] == m) ? NEG : v[u];
                }
            }
            float c[13]; unsigned pay[13];
#pragma unroll
            for (int s = 0; s < 13; ++s) {
                float cq[4]; unsigned pq[4];
#pragma unroll
                for (int q = 0; q < 4; ++q) {
                    const int pi = 4 * s + q; const int a = PAIRS.a[pi], b = PAIRS.b[pi];
                    if (a >= 0) {
                        const float sum = v12[0][a] + v12[1][b];
                        cq[q] = __uint_as_float((__float_as_uint(sum) & ~63u) | (unsigned)pi);
                        pq[q] = (__float_as_uint(v12[0][a]) & 127u) * 128u + (__float_as_uint(v12[1][b]) & 127u);
                    } else { cq[q] = NEG; pq[q] = 0u; }
                }
                c[s] = qd == 0 ? cq[0] : qd == 1 ? cq[1] : qd == 2 ? cq[2] : cq[3];
                pay[s] = qd == 0 ? pq[0] : qd == 1 ? pq[1] : qd == 2 ? pq[2] : pq[3];
            }
            float top[16]; unsigned eid[16];
#pragma unroll
            for (int r = 0; r < 16; ++r) {
                float m = c[0];
#pragma unroll
                for (int s = 1; s < 13; ++s) m = fmaxf(m, c[s]);
                m = fmaxf(m, __shfl_xor(m, 16)); m = fmaxf(m, __shfl_xor(m, 32));
                unsigned pw = 0u;
#pragma unroll
                for (int s = 0; s < 13; ++s) { const bool eq = (c[s] == m); pw |= eq ? pay[s] : 0u; c[s] = eq ? NEG : c[s]; }
                pw |= (unsigned)__shfl_xor((int)pw, 16); pw |= (unsigned)__shfl_xor((int)pw, 32);
                top[r] = m; eid[r] = pw;
            }
            float sum = 0.f; const float mx = top[0];
#pragma unroll
            for (int r = 0; r < 16; ++r) { top[r] = expf(top[r] - mx); sum += top[r]; }
            const float inv = 1.0f / sum;
            if (lane < 16) {
                int4* ep = (int4*)(p.eidx + (size_t)tok * 128 + h * 16); float4* gp = (float4*)(p.gatev + (size_t)tok * 128 + h * 16);
#pragma unroll
                for (int q = 0; q < 4; ++q) {
                    ep[q] = make_int4((int)eid[4 * q], (int)eid[4 * q + 1], (int)eid[4 * q + 2], (int)eid[4 * q + 3]);
                    gp[q] = make_float4(top[4 * q] * inv, top[4 * q + 1] * inv, top[4 * q + 2] * inv, top[4 * q + 3] * inv);
                }
            }
        }
    }
    __syncthreads();
}

typedef float f32x2_t __attribute__((ext_vector_type(2)));
__device__ __forceinline__ void peer_load4(const unsigned char* tab, const int (&e)[4], int lane, uint4 (&R)[4][2]) {
#pragma unroll
    for (int i = 0; i < 4; ++i) { const uint4* r = (const uint4*)(tab + (size_t)e[i] * DM) + lane; R[i][0] = r[0]; R[i][1] = r[64]; }
}
__device__ __forceinline__ void ph_peer3(const Params& p, const float* x1, const bf16_t* h2, int bid, int nb) {
    const int tid = tid_(), wave = tid >> 6, lane = tid & 63;
    for (int t = bid * 8 + wave; t < NTOK; t += nb * 8) {
        const int b = t / SQ;
        float hv[32], y[32];
#pragma unroll
        for (int j = 0; j < 2; ++j)
#pragma unroll
            for (int q = 0; q < 2; ++q) { const uint4 w = *(const uint4*)(h2 + (size_t)t * DM + (lane + 64 * j) * 16 + 8 * q); float* d = hv + 16 * j + 8 * q;
                d[0] = bflo(w.x); d[1] = bfhi(w.x); d[2] = bflo(w.y); d[3] = bfhi(w.y); d[4] = bflo(w.z); d[5] = bfhi(w.z); d[6] = bflo(w.w); d[7] = bfhi(w.w); }
#pragma unroll
        for (int i = 0; i < 32; ++i) y[i] = 0.f;
        const int e0 = p.eidx[(size_t)t * 128 + lane], e1 = p.eidx[(size_t)t * 128 + 64 + lane];
        const float g0 = p.gatev[(size_t)t * 128 + lane], g1 = p.gatev[(size_t)t * 128 + 64 + lane];
        const float su0 = p.su[e0], su1 = p.su[e1];
        const float gv0 = g0 * p.sv[e0], gv1 = g1 * p.sv[e1];
        uint4 Uc[4][2], Un[4][2], Vc[4][2];
        { int e[4];
#pragma unroll
          for (int i = 0; i < 4; ++i) e[i] = __builtin_amdgcn_readlane(e0, i);
          peer_load4(p.U8, e, lane, Uc); }
        for (int g = 0; g < 32; ++g) {
            const bool lo = g < 16; const int k0 = (4 * g) & 63;
            const int ee = lo ? e0 : e1; const float suu = lo ? su0 : su1, gvv = lo ? gv0 : gv1;
            int e[4]; float sa[4], gw[4];
#pragma unroll
            for (int i = 0; i < 4; ++i) { e[i] = __builtin_amdgcn_readlane(ee, k0 + i);
                sa[i] = __uint_as_float(__builtin_amdgcn_readlane(__float_as_uint(suu), k0 + i)); gw[i] = __uint_as_float(__builtin_amdgcn_readlane(__float_as_uint(gvv), k0 + i)); }
            peer_load4(p.V8, e, lane, Vc);
            {
                const int gn = (g < 31) ? g + 1 : g; const int en = (gn < 16) ? e0 : e1; const int kn = (4 * gn) & 63; int e2[4];
#pragma unroll
                for (int i = 0; i < 4; ++i) e2[i] = __builtin_amdgcn_readlane(en, kn + i);
                peer_load4(p.U8, e2, lane, Un);
            }
            float a[4];
#pragma unroll
            for (int i = 0; i < 4; ++i) {
                float acc = 0.f;
#pragma unroll
                for (int j = 0; j < 2; ++j) {
                    const unsigned w[4] = {Uc[i][j].x, Uc[i][j].y, Uc[i][j].z, Uc[i][j].w};
#pragma unroll
                    for (int q = 0; q < 4; ++q) {
                        const f32x2_t c0 = __builtin_amdgcn_cvt_pk_f32_fp8((int)w[q], false), c1 = __builtin_amdgcn_cvt_pk_f32_fp8((int)w[q], true);
                        const float* hh = hv + 16 * j + 4 * q;
                        acc += c0.x * hh[0] + c0.y * hh[1] + c1.x * hh[2] + c1.y * hh[3];
                    }
                }
                a[i] = acc;
            }
#pragma unroll
            for (int o = 1; o < 64; o <<= 1) { a[0] += __shfl_xor(a[0], o); a[1] += __shfl_xor(a[1], o); a[2] += __shfl_xor(a[2], o); a[3] += __shfl_xor(a[3], o); }
            float wgt[4];
#pragma unroll
            for (int i = 0; i < 4; ++i) wgt[i] = geluf_(a[i] * sa[i]) * gw[i];
#pragma unroll
            for (int j = 0; j < 2; ++j)
#pragma unroll
                for (int q = 0; q < 4; ++q) {
                    float* yy = y + 16 * j + 4 * q;
#pragma unroll
                    for (int i = 0; i < 4; ++i) {
                        const unsigned w = (q == 0) ? Vc[i][j].x : (q == 1) ? Vc[i][j].y : (q == 2) ? Vc[i][j].z : Vc[i][j].w;
                        const f32x2_t c0 = __builtin_amdgcn_cvt_pk_f32_fp8((int)w, false), c1 = __builtin_amdgcn_cvt_pk_f32_fp8((int)w, true);
                        yy[0] += wgt[i] * c0.x; yy[1] += wgt[i] * c0.y; yy[2] += wgt[i] * c1.x; yy[3] += wgt[i] * c1.y;
                    }
                }
#pragma unroll
            for (int i = 0; i < 4; ++i) { Uc[i][0] = Un[i][0]; Uc[i][1] = Un[i][1]; }
        }
        float ss = 0.f;
#pragma unroll
        for (int j = 0; j < 2; ++j)
#pragma unroll
            for (int q = 0; q < 4; ++q) {
                const int c = (lane + 64 * j) * 16 + 4 * q;
                const float4 xv = *(const float4*)(x1 + (size_t)t * DM + c);
                const float4 ga = *(const float4*)(p.ada + b * NMOD + 5 * DM + c);
                float* yy = y + 16 * j + 4 * q;
                yy[0] = xv.x + ga.x * yy[0]; yy[1] = xv.y + ga.y * yy[1]; yy[2] = xv.z + ga.z * yy[2]; yy[3] = xv.w + ga.w * yy[3];
                ss += yy[0] * yy[0] + yy[1] * yy[1] + yy[2] * yy[2] + yy[3] * yy[3];
            }
        ss = wave_sum(ss);
        const float rs = 1.0f / sqrtf(ss * (1.0f / DM) + 1e-6f);
#pragma unroll
        for (int j = 0; j < 2; ++j)
#pragma unroll
            for (int q = 0; q < 4; ++q) {
                const int c = (lane + 64 * j) * 16 + 4 * q;
                const float4 gf = *(const float4*)(p.norm_f_g + c);
                const float* yy = y + 16 * j + 4 * q;
                *(float4*)(p.out + (size_t)t * DM + c) = make_float4(yy[0] * rs * gf.x, yy[1] * rs * gf.y, yy[2] * rs * gf.z, yy[3] * rs * gf.w);
            }
    }
}

#define LAS __attribute__((address_space(3)))
#define XB_TMO      128
#define XB_XCNT(j)  (256  + 64 * (j))
#define XB_XSUB(j)  (1280 + 64 * (j))
#define XB_XGEN(j)  (2304 + 64 * (j))
#define XB_TOP      3328
#define XB_TOPGEN   3392
#define XCD_BAR_WORDS 3456
#define XB_SPIN_CAP (1u << 18)

__device__ __forceinline__ unsigned xb_ld(unsigned* p)              { return __hip_atomic_load(p, __ATOMIC_RELAXED, __HIP_MEMORY_SCOPE_AGENT); }
__device__ __forceinline__ unsigned xb_add(unsigned* p, unsigned v) { return __hip_atomic_fetch_add(p, v, __ATOMIC_RELAXED, __HIP_MEMORY_SCOPE_AGENT); }
__device__ __forceinline__ unsigned xb_xcc_id() { return (unsigned)__builtin_amdgcn_s_getreg((3 << 11) | 20) & 0xFu; }
#define XB_SPIN(cond, bar) do { unsigned _sp = 0; while (cond) { __builtin_amdgcn_s_sleep(1); \
    if ((++_sp & 255u) == 0u) { if (xb_ld(&(bar)[XB_TMO])) break; if (_sp > XB_SPIN_CAP) { atomicAdd(&(bar)[XB_TMO], 1u); break; } } } } while (0)

struct XcdBarrier {
    unsigned* bar; unsigned x;
    volatile LAS unsigned* st;
};

__device__ __forceinline__ XcdBarrier xcd_barrier_post(unsigned* bar, volatile LAS unsigned* st) {
    XcdBarrier b; b.bar = bar; b.x = xb_xcc_id(); b.st = st;
    if (threadIdx.x == 0) (void)xb_add(&bar[XB_XCNT(b.x)], 1u);
    return b;
}
__device__ __forceinline__ void xcd_barrier_complete(unsigned* bar, unsigned x, unsigned& nloc, unsigned& nx) {
    const unsigned G = gridDim.x * gridDim.y * gridDim.z;
    unsigned sum, cnt, mine, sp = 0u;
    for (;;) {
        sum = 0u; cnt = 0u; mine = 0u;
#pragma unroll
        for (unsigned j = 0; j < 16; ++j) { const unsigned c = xb_ld(&bar[XB_XCNT(j)]); sum += c; cnt += (c > 0u) ? 1u : 0u; mine = (j == x) ? c : mine; }
        if (sum == G) break;
        __builtin_amdgcn_s_sleep(1);
        if ((++sp & 255u) == 0u) { if (xb_ld(&bar[XB_TMO])) break; if (sp > XB_SPIN_CAP) { atomicAdd(&bar[XB_TMO], 1u); break; } }
    }
    nloc = mine > 0u ? mine : 1u; nx = cnt > 0u ? cnt : 1u;
}

__device__ __forceinline__ void xcd_barrier(const XcdBarrier& b) {
    asm volatile("s_waitcnt vmcnt(0)" ::: "memory");
    __syncthreads();
    if (threadIdx.x == 0) {
        unsigned* bar = b.bar;
        __builtin_amdgcn_s_waitcnt(0);
        unsigned nloc = b.st[0], nx = b.st[1];
        if (nloc == 0u) { xcd_barrier_complete(bar, b.x, nloc, nx); b.st[0] = nloc; b.st[1] = nx; }
        const unsigned old = xb_add(&bar[XB_XSUB(b.x)], 1u);
        const unsigned gen = old / nloc;
        if (old + 1u == (gen + 1u) * nloc) {
            __builtin_amdgcn_fence(__ATOMIC_RELEASE, "agent");
            asm volatile("s_waitcnt vmcnt(0)" ::: "memory");
            const unsigned og = xb_add(&bar[XB_TOP], 1u);
            const unsigned tg = og / nx;
            if (og + 1u == (tg + 1u) * nx) xb_add(&bar[XB_TOPGEN], 1u);
            else XB_SPIN(xb_ld(&bar[XB_TOPGEN]) == tg, bar);
            __builtin_amdgcn_fence(__ATOMIC_ACQUIRE, "agent");
            xb_add(&bar[XB_XGEN(b.x)], 1u);
            asm volatile("s_waitcnt vmcnt(0)" ::: "memory");
        } else {
            XB_SPIN(xb_ld(&bar[XB_XGEN(b.x)]) == gen, bar);
            __builtin_amdgcn_fence(__ATOMIC_ACQUIRE, "agent");
            asm volatile("s_waitcnt vmcnt(0)" ::: "memory");
        }
    }
    __syncthreads();
}

template <class Epi>
__device__ __forceinline__ void gemm_run(float* lds, const bf16_t* A, const bf16_t* Bt, int M, int N, int K, const Epi& E) {
    __syncthreads();
    pg8::Gemm g{A, Bt, M, N, K}; pg8::StaticOrder S; S.init(M, N, (int)gridDim.x, (int)blockIdx.x);
    pg8::gemm_phase<Epi, pg8::StaticOrder, true, true>((PG8_LAS unsigned char*)lds, g, S, E);
    __syncthreads();
}
constexpr int NPHASE = 11;
template <int PH>
__device__ __forceinline__ void run_phase(const Params& p, int bid, int nb, float* lds) {
    asm volatile("" : "+s"(bid));
    if constexpr (PH == 0) ph_prep(p, bid, nb, lds);
    if constexpr (PH == 1) ph_modnorm(p, p.x, p.norm1_g, 0 * DM, 1 * DM, p.hb, bid, nb, lds);
    if constexpr (PH == 2) gemm_run(lds, p.hb, p.Wt1, NTOK, ZW, DM, pg8::EpiZG{p.ZG, p.b_bg});
    if constexpr (PH == 3) { ph_retprep(p, bid, nb, lds); ph_gmlp2(p, bid, nb, lds); }
    if constexpr (PH == 11) ph_ret2(p, bid, nb, lds);
    if constexpr (PH == 4) ph_gn(p, bid, nb, lds);
    if constexpr (PH == 5) {
        gemm_run(lds, p.yain, p.Wta, NTOK, DM, 1024, pg8::EpiMixB<0>{p.hb, p.ZG, 0});
        gemm_run(lds, p.ybin, p.Wtb, NTOK, DM, DM, pg8::EpiMixB<1>{p.hb, p.ZG, 2048});
    }
    if constexpr (PH == 6) gemm_run(lds, p.hb, p.Wto, NTOK, DM, DM, pg8::EpiResF{p.obuf, p.x, p.ada + 2 * DM});
    if constexpr (PH == 7) { ph_modnorm(p, p.obuf, p.norm2_g, 3 * DM, 4 * DM, p.hb, bid, nb, lds); ph_tabconv(p, bid, nb); }
    if constexpr (PH == 8) gemm_run(lds, p.hb, p.Wtq, NTOK, DM, DM, pg8::EpiF32{p.qbuf, DM});
    if constexpr (PH == 9) ph_topk2(p, p.qbuf, bid, nb, lds);
    if constexpr (PH == 10) ph_peer3(p, p.obuf, p.hb, bid, nb);
}

constexpr int MISC_OFF = 132 * 1024;
__global__ void __launch_bounds__(NTH) k_mega(Params p) {
    extern __shared__ __attribute__((aligned(16))) float lds[];
    cg::grid_group grid = cg::this_grid();
    const int bid = blockIdx.x, nb = gridDim.x;
    volatile LAS unsigned* misc = (volatile LAS unsigned*)((LAS unsigned char*)lds + MISC_OFF);
    if (threadIdx.x < 4) misc[threadIdx.x] = 0u;
    __syncthreads();
    XcdBarrier bar = xcd_barrier_post(p.bar, misc);
    run_phase<0>(p, bid, nb, lds); grid.sync();
    run_phase<1>(p, bid, nb, lds); xcd_barrier(bar);
    run_phase<2>(p, bid, nb, lds); xcd_barrier(bar);
    run_phase<3>(p, bid, nb, lds); xcd_barrier(bar);
    run_phase<11>(p, bid, nb, lds); xcd_barrier(bar);
    run_phase<4>(p, bid, nb, lds); xcd_barrier(bar);
    run_phase<5>(p, bid, nb, lds); xcd_barrier(bar);
    run_phase<6>(p, bid, nb, lds); xcd_barrier(bar);
    run_phase<7>(p, bid, nb, lds); xcd_barrier(bar);
    run_phase<8>(p, bid, nb, lds); xcd_barrier(bar);
    run_phase<9>(p, bid, nb, lds); xcd_barrier(bar);
    run_phase<10>(p, bid, nb, lds);
}

extern "C" void kernel_launch(void* const* d_in, const int* in_sizes, int n_in, void* d_out, int out_size, void* d_ws, size_t ws_size, hipStream_t stream) {
    Params p{};
    p.x = (const float*)d_in[0]; p.c = (const float*)d_in[1]; p.pos = (const int*)d_in[2];
    p.w_ada = (const float*)d_in[3]; p.b_ada = (const float*)d_in[4]; p.norm1_g = (const float*)d_in[5]; p.w_in = (const float*)d_in[6];
    p.w_bg = (const float*)d_in[7]; p.b_bg = (const float*)d_in[8]; p.gm_v_g = (const float*)d_in[9]; p.gm_ws = (const float*)d_in[10];
    p.gm_b = (const float*)d_in[11]; p.ret_gn_g = (const float*)d_in[12]; p.w_a_out = (const float*)d_in[13]; p.w_b_out = (const float*)d_in[14];
    p.w_o = (const float*)d_in[15]; p.norm2_g = (const float*)d_in[16]; p.peer_wq = (const float*)d_in[17]; p.peer_sk = (const float*)d_in[18];
    p.peer_u = (const float*)d_in[19]; p.peer_v = (const float*)d_in[20]; p.norm_f_g = (const float*)d_in[21];
    p.out = (float*)d_out;
    char* w = (char*)d_ws; size_t off = 0;
    auto take = [&](size_t bytes) { char* r = w + off; off += (bytes + 255) & ~(size_t)255; return r; };
    p.bar = (unsigned*)take(XCD_BAR_WORDS * 4);
    p.ada = (float*)take(2 * NMOD * 4);
    p.rope = (float*)take((size_t)NTOK * 128 * 4);
    p.eidx = (int*)take((size_t)NTOK * 128 * 4);
    p.gatev = (float*)take((size_t)NTOK * 128 * 4);
    p.Wt1 = (bf16_t*)take((size_t)ZW * DM * 2);
    p.Wta = (bf16_t*)take((size_t)DM * 1024 * 2);
    p.Wtb = (bf16_t*)take((size_t)DM * DM * 2);
    p.Wto = (bf16_t*)take((size_t)DM * DM * 2);
    p.Wtq = (bf16_t*)take((size_t)DM * DM * 2);
    p.hb = (bf16_t*)take((size_t)NTOK * DM * 2);
    p.ZG = (bf16_t*)take((size_t)NTOK * ZW * 2);
    p.qbuf = (float*)p.ZG;
    p.obuf = (float*)take((size_t)NTOK * DM * 4);
    p.ybin = (bf16_t*)take((size_t)NTOK * DM * 2);
    p.yain = (bf16_t*)take((size_t)NTOK * 1024 * 2);
    p.U8 = (unsigned char*)p.ZG + (size_t)NTOK * DM * 4;
    p.V8 = p.U8 + (size_t)16384 * DM;
    p.su = (float*)take(16384 * 4); p.sv = (float*)take(16384 * 4);
    p.Qr = (bf16_t*)take((size_t)NTOK * 1024 * 2);
    p.Kr = (bf16_t*)take((size_t)NTOK * 1024 * 2);
    p.KTd = (bf16_t*)take((size_t)NTOK * 1024 * 2);
    p.Vt = (bf16_t*)take((size_t)NTOK * 2048 * 2);
    p.ob16 = (bf16_t*)take((size_t)NTOK * DM * 2);
    if (off > ws_size) { fprintf(stderr, "kernel_launch: workspace too small: need %zu have %zu\n", off, ws_size); return; }
    static int grid = 0;
    if (!grid) {
        int dev = 0, cus = 0, per_cu = 0;
        (void)hipGetDevice(&dev); (void)hipDeviceGetAttribute(&cus, hipDeviceAttributeMultiprocessorCount, dev);
        (void)hipFuncSetAttribute((const void*)k_mega, hipFuncAttributeMaxDynamicSharedMemorySize, LDS_BYTES);
        (void)hipOccupancyMaxActiveBlocksPerMultiprocessor(&per_cu, k_mega, NTH, LDS_BYTES);
        if (per_cu < 1) per_cu = 1;
        grid = cus * per_cu;
    }
    (void)hipMemsetAsync(p.bar, 0, XCD_BAR_WORDS * 4, stream);
    void* args[] = {&p};
    hipError_t e = hipLaunchCooperativeKernel((const void*)k_mega, dim3(grid), dim3(NTH), args, LDS_BYTES, stream);
    if (e != hipSuccess) fprintf(stderr, "cooperative launch failed: %s (grid %d)\n", hipGetErrorString(e), grid);
}
```

```cpp
#include <hip/hip_runtime.h>
#include <hip/hip_cooperative_groups.h>
#include <stdint.h>
#include <math.h>
#include <cstdio>

namespace cg = cooperative_groups;

constexpr int DM = 2048;
constexpr int SQ = 4096;
constexpr int NTOK = 8192;
constexpr int NTH = 512;
constexpr int ZW = 12288;
constexpr int NMOD = 12288;
constexpr int LDS_BYTES = 136 * 1024;

typedef unsigned short bf16_t;

struct Params {
    const float *x, *c; const int* pos;
    const float *w_ada, *b_ada, *norm1_g, *w_in, *w_bg, *b_bg, *gm_v_g, *gm_ws, *gm_b, *ret_gn_g, *w_a_out, *w_b_out, *w_o, *norm2_g,
                *peer_wq, *peer_sk, *peer_u, *peer_v, *norm_f_g;
    float* out;
    float *ada, *rope, *gatev; int* eidx;
    bf16_t *Wt1, *Wta, *Wtb, *Wto, *Wtq;
    bf16_t *hb;
    bf16_t *ZG;
    float *obuf;
    bf16_t *ybin, *yain;
    float *qbuf;
    unsigned char *U8, *V8;
    float *su, *sv;
    bf16_t *Qr, *Kr, *KTd, *Vt;
    bf16_t *ob16;
    unsigned *bar;
};

__constant__ float c_freq[64] = {
1.000000000e+00f, 8.659643531e-01f, 7.498942018e-01f, 6.493816376e-01f, 5.623413324e-01f, 4.869675338e-01f, 4.216965139e-01f, 3.651741147e-01f, 3.162277639e-01f, 2.738419771e-01f, 2.371373773e-01f, 2.053525001e-01f, 1.778279394e-01f, 1.539926529e-01f, 1.333521456e-01f, 1.154781953e-01f, 1.000000015e-01f, 8.659642935e-02f, 7.498942316e-02f, 6.493816525e-02f, 5.623413250e-02f, 4.869675264e-02f, 4.216964915e-02f, 3.651741147e-02f, 3.162277490e-02f, 2.738419548e-02f, 2.371373773e-02f, 2.053525113e-02f, 1.778279431e-02f, 1.539926510e-02f, 1.333521400e-02f, 1.154781971e-02f, 9.999999776e-03f, 8.659643121e-03f, 7.498942316e-03f, 6.493816152e-03f, 5.623413250e-03f, 4.869675264e-03f, 4.216964822e-03f, 3.651741194e-03f, 3.162277630e-03f, 2.738419687e-03f, 2.371373819e-03f, 2.053525066e-03f, 1.778279431e-03f, 1.539926510e-03f, 1.333521446e-03f, 1.154782018e-03f, 1.000000047e-03f, 8.659643354e-04f, 7.498941850e-04f, 6.493816036e-04f, 5.623413017e-04f, 4.869675322e-04f, 4.216965172e-04f, 3.651741135e-04f, 3.162277571e-04f, 2.738419571e-04f, 2.371373703e-04f, 2.053525095e-04f, 1.778279402e-04f, 1.539926598e-04f, 1.333521504e-04f, 1.154782003e-04f };

__device__ __forceinline__ int tid_() { int t = threadIdx.x; asm volatile("" : "+v"(t)); return t; }
__device__ __forceinline__ float wave_sum(float v) {
#pragma unroll
    for (int o = 1; o < 64; o <<= 1) v += __shfl_xor(v, o);
    return v;
}
__device__ __forceinline__ float wave_max(float v) {
#pragma unroll
    for (int o = 1; o < 64; o <<= 1) v = fmaxf(v, __shfl_xor(v, o));
    return v;
}
__device__ __forceinline__ float sigmoidf_(float x) { return 1.0f / (1.0f + expf(-x)); }
__device__ __forceinline__ float siluf_(float x) { return x * sigmoidf_(x); }
__device__ __forceinline__ float geluf_(float x) { return 0.5f * x * (1.0f + erff(x * 0.70710678118654752f)); }
__device__ __forceinline__ float dot4(float4 a, float4 b) { return a.x * b.x + a.y * b.y + a.z * b.z + a.w * b.w; }
__device__ __forceinline__ float bf2f(bf16_t v) { return __uint_as_float((unsigned)v << 16); }
__device__ __forceinline__ float bflo(unsigned w) { return __uint_as_float(w << 16); }
__device__ __forceinline__ float bfhi(unsigned w) { return __uint_as_float(w & 0xffff0000u); }
__device__ __forceinline__ unsigned f2bf(float f) { unsigned u = __float_as_uint(f); return (u + 0x7fffu + ((u >> 16) & 1u)) >> 16; }
__device__ __forceinline__ unsigned pk2(float lo, float hi) { return f2bf(lo) | (f2bf(hi) << 16); }

__device__ __forceinline__ void sincos_acc(float ang, float& s, float& c) {
    const double x = (double)ang;
    const double k = rint(x * 0.63661977236758134308);
    double r = fma(-k, 1.57079632679489655800, x); r = fma(-k, 6.12323399573676603587e-17, r);
    const double r2 = r * r;
    const double sp = r * (1.0 + r2 * (-1.0 / 6.0 + r2 * (1.0 / 120.0 + r2 * (-1.0 / 5040.0 + r2 * (1.0 / 362880.0 + r2 * (-1.0 / 39916800.0 + r2 * (1.0 / 6227020800.0)))))));
    const double cp = 1.0 + r2 * (-0.5 + r2 * (1.0 / 24.0 + r2 * (-1.0 / 720.0 + r2 * (1.0 / 40320.0 + r2 * (-1.0 / 3628800.0 + r2 * (1.0 / 479001600.0 + r2 * (-1.0 / 87178291200.0)))))));
    const int q = ((int)k) & 3;
    const float fs = (float)sp, fc = (float)cp;
    s = (q == 0) ? fs : (q == 1) ? fc : (q == 2) ? -fs : -fc;
    c = (q == 0) ? fc : (q == 1) ? -fs : (q == 2) ? -fc : fs;
}

namespace pg8 {
#define PG8_LAS __attribute__((address_space(3)))
typedef unsigned short bf16_t;
typedef short bf16x8 __attribute__((ext_vector_type(8)));
typedef float f32x4 __attribute__((ext_vector_type(4)));
typedef unsigned u32x4 __attribute__((ext_vector_type(4)));
constexpr int BM = 256, BK = 64, HALF = 128, HTB = HALF * BK * 2  , STAGE_BYTES = 8 * HTB, NXCD = 8, WGM = 8;

__host__ __device__ __forceinline__ int lds_byte(int r, int c) { const int st = (r >> 4) * 2 + (c >> 5), rr = r & 15, cc = c & 31, ob = rr * 64 + cc * 2; return st * 1024 + (ob ^ (((ob >> 9) & 1) << 5)); }
__host__ __device__ __forceinline__ void stage_rc(int b, int& R, int& C) { const int st = b / 1024, sb = b % 1024, swz = sb ^ (((sb >> 9) & 1) << 5); R = (st >> 1) * 16 + swz / 64; C = (st & 1) * 32 + (swz % 64) / 2; }
__host__ __device__ __forceinline__ int perm32(int rho) { const int n = rho >> 4, i = rho & 15; return 8 * (i >> 2) + 4 * n + (i & 3); }

struct Unit { int pm, pn; };
struct Gemm { const bf16_t* A; const bf16_t* Bt; int M, N, K; };

struct StaticOrder {
    int nM, nN, nwg, G, c;
    __host__ __device__ void init(int M, int N, int G_, int c_) { nM = M / BM; nN = N / BM; nwg = nM * nN; G = G_; c = c_; }
    __host__ __device__ bool next(int i, Unit& u) const {
        const long L = (long)i * G + c; if (L >= nwg) return false;
        int wgid = (int)L; { const int q = nwg / NXCD, r = nwg % NXCD, xcd = wgid % NXCD, off = wgid / NXCD; wgid = (xcd < r ? xcd * (q + 1) : r * (q + 1) + (xcd - r) * q) + off; }
        const int nig = WGM * nN, gid = wgid / nig, fm = gid * WGM, gsz = (nM - fm) < WGM ? (nM - fm) : WGM;
        u.pm = fm + ((wgid % nig) % gsz); u.pn = (wgid % nig) / gsz; return true;
    }
    __device__ __forceinline__ void a_ready(const Unit&) const {}
    __device__ __forceinline__ void done(const Unit&) const {}
};

__device__ __forceinline__ unsigned cvt_pk_bf16(float lo, float hi) { unsigned r; asm volatile("v_cvt_pk_bf16_f32 %0, %1, %2" : "=v"(r) : "v"(lo), "v"(hi)); return r; }
typedef float f32x2 __attribute__((ext_vector_type(2)));
__device__ __forceinline__ f32x2 gelu_pk(f32x2 v) {
    const f32x2 av = __builtin_elementwise_abs(v), d = av * 0.2316418882f + 1.0f;
    f32x2 t; t.x = __builtin_amdgcn_rcpf(d.x); t.y = __builtin_amdgcn_rcpf(d.y);
    f32x2 q = t * 0.5307027145f + (-0.7265760135f); q = q * t + 0.7107068705f; q = q * t + (-0.142248368f); q = q * t + 0.127414796f; q = q * t;
    const f32x2 s = (v * v) * (-0.72134752044f);
    f32x2 e; e.x = __builtin_amdgcn_exp2f(s.x); e.y = __builtin_amdgcn_exp2f(s.y);
    const f32x2 m = v * (q * e), r = v - m;
    f32x2 o; o.x = v.x < 0.f ? m.x : r.x; o.y = v.y < 0.f ? m.y : r.y; return o;
}

typedef unsigned u32x2v __attribute__((ext_vector_type(2)));
struct EpiZG {
    static constexpr bool PERM = true, AFTER_DRAIN = false;
    bf16_t* O; const float* bias;
    __device__ __forceinline__ void operator()(const f32x4 (&acc)[2][2][4][2], const Unit& u, int wr, int wc, int fr, int fq) const {
        const int row0 = u.pm * BM + wr * 64 + fr, col0 = u.pn * BM + wc * 32 + 8 * fq;
        const int mode = u.pn < 8 ? 1 : (u.pn < 32 ? 0 : 2);
        f32x4 bv[2][2];
#pragma unroll
        for (int bj = 0; bj < 2; ++bj)
#pragma unroll
            for (int n = 0; n < 2; ++n) bv[bj][n] = (mode == 2) ? *(const f32x4*)(bias + (col0 - 8192) + bj * HALF + 4 * n) : (f32x4){0.f, 0.f, 0.f, 0.f};
#pragma unroll
        for (int ai = 0; ai < 2; ++ai)
#pragma unroll
            for (int m = 0; m < 4; ++m) { bf16_t* rowp = O + (size_t)(row0 + ai * HALF + m * 16) * ZW + col0;
#pragma unroll
                for (int bj = 0; bj < 2; ++bj) { f32x4 v0 = acc[ai][bj][m][0], v1 = acc[ai][bj][m][1];
                    if (mode == 1) { f32x2 a = gelu_pk((f32x2){v0[0], v0[1]}), b = gelu_pk((f32x2){v0[2], v0[3]}), c = gelu_pk((f32x2){v1[0], v1[1]}), d = gelu_pk((f32x2){v1[2], v1[3]});
                        v0 = (f32x4){a.x, a.y, b.x, b.y}; v1 = (f32x4){c.x, c.y, d.x, d.y}; }
                    if (mode == 2) { v0 = v0 + bv[bj][0]; v1 = v1 + bv[bj][1];
#pragma unroll
                        for (int e = 0; e < 4; ++e) { v0[e] = __builtin_amdgcn_rcpf(1.0f + __expf(-v0[e])); v1[e] = __builtin_amdgcn_rcpf(1.0f + __expf(-v1[e])); } }
                    u32x4 w; w.x = cvt_pk_bf16(v0[0], v0[1]); w.y = cvt_pk_bf16(v0[2], v0[3]); w.z = cvt_pk_bf16(v1[0], v1[1]); w.w = cvt_pk_bf16(v1[2], v1[3]);
                    *(u32x4*)(rowp + bj * HALF) = w; } }
    }
};
template <int ACCUM> struct EpiMixB {
    static constexpr bool PERM = true, AFTER_DRAIN = false;
    bf16_t* Mo; const bf16_t* ZGp; int goff;
    __device__ __forceinline__ void operator()(const f32x4 (&acc)[2][2][4][2], const Unit& u, int wr, int wc, int fr, int fq) const {
        const int row0 = u.pm * BM + wr * 64 + fr, col0 = u.pn * BM + wc * 32 + 8 * fq;
#pragma unroll
        for (int ai = 0; ai < 2; ++ai)
#pragma unroll
            for (int m = 0; m < 4; ++m) { const size_t row = (size_t)(row0 + ai * HALF + m * 16);
#pragma unroll
                for (int bj = 0; bj < 2; ++bj) { const f32x4 v0 = acc[ai][bj][m][0], v1 = acc[ai][bj][m][1];
                    const u32x4 g = *(const u32x4*)(ZGp + row * ZW + 8192 + goff + col0 + bj * HALF);
                    float o[8];
                    o[0] = bflo(g.x) * v0[0]; o[1] = bfhi(g.x) * v0[1]; o[2] = bflo(g.y) * v0[2]; o[3] = bfhi(g.y) * v0[3];
                    o[4] = bflo(g.z) * v1[0]; o[5] = bfhi(g.z) * v1[1]; o[6] = bflo(g.w) * v1[2]; o[7] = bfhi(g.w) * v1[3];
                    bf16_t* mp = Mo + row * DM + col0 + bj * HALF;
                    if (ACCUM) { const u32x4 old = *(const u32x4*)mp;
                        o[0] += bflo(old.x); o[1] += bfhi(old.x); o[2] += bflo(old.y); o[3] += bfhi(old.y); o[4] += bflo(old.z); o[5] += bfhi(old.z); o[6] += bflo(old.w); o[7] += bfhi(old.w); }
                    u32x4 w; w.x = cvt_pk_bf16(o[0], o[1]); w.y = cvt_pk_bf16(o[2], o[3]); w.z = cvt_pk_bf16(o[4], o[5]); w.w = cvt_pk_bf16(o[6], o[7]);
                    *(u32x4*)mp = w; } }
    }
};
struct EpiResF {
    static constexpr bool PERM = false, AFTER_DRAIN = false;
    float* x1; const float* x; const float* ga;
    __device__ __forceinline__ void operator()(const f32x4 (&acc)[2][2][4][2], const Unit& u, int wr, int wc, int fr, int fq) const {
        const int row0 = u.pm * BM + wr * 64 + fr, col0 = u.pn * BM + wc * 32 + 4 * fq;
        const int b = (u.pm * BM) / SQ;
        f32x4 gv[2][2];
#pragma unroll
        for (int bj = 0; bj < 2; ++bj)
#pragma unroll
            for (int n = 0; n < 2; ++n) gv[bj][n] = *(const f32x4*)(ga + b * NMOD + col0 + bj * HALF + n * 16);
#pragma unroll
        for (int ai = 0; ai < 2; ++ai)
#pragma unroll
            for (int m = 0; m < 4; ++m) { const size_t off = (size_t)(row0 + ai * HALF + m * 16) * DM + col0;
#pragma unroll
                for (int bj = 0; bj < 2; ++bj)
#pragma unroll
                    for (int n = 0; n < 2; ++n) { const f32x4 xv = *(const f32x4*)(x + off + bj * HALF + n * 16);
                        *(f32x4*)(x1 + off + bj * HALF + n * 16) = xv + gv[bj][n] * acc[ai][bj][m][n]; } }
    }
};
struct EpiF32 {
    static constexpr bool PERM = false, AFTER_DRAIN = false;
    float* O; int ldc;
    __device__ __forceinline__ void operator()(const f32x4 (&acc)[2][2][4][2], const Unit& u, int wr, int wc, int fr, int fq) const {
        const int row0 = u.pm * BM + wr * 64 + fr, col0 = u.pn * BM + wc * 32 + 4 * fq;
#pragma unroll
        for (int ai = 0; ai < 2; ++ai)
#pragma unroll
            for (int m = 0; m < 4; ++m) { const size_t off = (size_t)(row0 + ai * HALF + m * 16) * ldc + col0;
#pragma unroll
                for (int bj = 0; bj < 2; ++bj)
#pragma unroll
                    for (int n = 0; n < 2; ++n) *(f32x4*)(O + off + bj * HALF + n * 16) = acc[ai][bj][m][n]; }
    }
};

template <class Epi, class Sched, bool ALIGN_EPI = false, bool SP2 = false>
__device__ __forceinline__ void gemm_phase(PG8_LAS unsigned char* lds, const Gemm g, const Sched& S, const Epi& E) {
    const int tid = threadIdx.x, wid = __builtin_amdgcn_readfirstlane(tid >> 6), lane = tid & 63, wr = wid >> 2, wc = wid & 3, fr = lane & 15, fq = lane >> 4;
    const int K = g.K, nt = K / BK;
    unsigned voffA[2], voffB[2];
#pragma unroll
    for (int i = 0; i < 2; ++i) { int R, C; stage_rc(tid * 16 + i * 8192, R, C); const int Rb = Epi::PERM ? ((R & ~31) + perm32(R & 31)) : R;
        voffA[i] = (unsigned)(R * K + C) * 2u; voffB[i] = (unsigned)(Rb * K + C) * 2u; }
    const size_t kstep = (size_t)(BK * 2);
    const size_t hstep = (size_t)HALF * K * 2;
    const size_t tstep = 2 * hstep;
    const unsigned ldsw = (unsigned)wid * 1024u;
    const int aoff = lds_byte(wr * 64 + fr, fq * 8), boff = lds_byte(wc * 32 + fr, fq * 8);
#define PG8_SA(b, h) (((b) * 2 + (h)) * HTB)
#define PG8_SB(b, h) ((4 + (b) * 2 + (h)) * HTB)
#define PG8_STAGE(bufoff, gbase, voff) do { _Pragma("unroll") for (int _i = 0; _i < 2; ++_i) \
        __builtin_amdgcn_global_load_lds((const unsigned*)((const char*)(gbase) + (voff)[_i]), (PG8_LAS unsigned*)(lds + (bufoff) + ldsw + _i * 8192), 16, 0, 0); } while (0)
#define PG8_LDA(dst, b, h) do { _Pragma("unroll") for (int m = 0; m < 4; ++m) _Pragma("unroll") for (int k = 0; k < 2; ++k) dst[m][k] = *(const PG8_LAS bf16x8*)(lds + PG8_SA(b, h) + aoff + m * 2048 + k * 1024); } while (0)
#define PG8_LDB(dst, b, h) do { _Pragma("unroll") for (int n = 0; n < 2; ++n) _Pragma("unroll") for (int k = 0; k < 2; ++k) dst[n][k] = *(const PG8_LAS bf16x8*)(lds + PG8_SB(b, h) + boff + n * 2048 + k * 1024); } while (0)
#define PG8_MMA(ai, bj, At, Bt) do { __builtin_amdgcn_s_setprio(1); _Pragma("unroll") for (int m = 0; m < 4; ++m) _Pragma("unroll") for (int n = 0; n < 2; ++n) _Pragma("unroll") for (int k = 0; k < 2; ++k) \
        acc[ai][bj][m][n] = __builtin_amdgcn_mfma_f32_16x16x32_bf16(Bt[n][k], At[m][k], acc[ai][bj][m][n], 0, 0, 0); __builtin_amdgcn_s_setprio(0); } while (0)
#define PG8_WAIT_V(n) asm volatile("s_waitcnt vmcnt(" #n ")" ::: "memory")
#define PG8_WAIT_L(n) asm volatile("s_waitcnt lgkmcnt(" #n ")" ::: "memory")
#define PG8_BAR __builtin_amdgcn_s_barrier()
#define PG8_SCHED __builtin_amdgcn_sched_barrier(0)
    Unit cur, nxt; int ui = 0;
    if (!S.next(0, cur)) return;
    f32x4 acc[2][2][4][2];
#pragma unroll
    for (int a = 0; a < 2; ++a)
#pragma unroll
        for (int b = 0; b < 2; ++b)
#pragma unroll
            for (int m = 0; m < 4; ++m)
#pragma unroll
                for (int n = 0; n < 2; ++n) acc[a][b][m][n] = (f32x4){0.f, 0.f, 0.f, 0.f};
    bf16x8 At[4][2], B0[2][2], B1[2][2];
    const char* cA = (const char*)g.A + (size_t)cur.pm * tstep; const char* cB = (const char*)g.Bt + (size_t)cur.pn * tstep;
    S.a_ready(cur);
    if constexpr (SP2) {
        PG8_STAGE(PG8_SB(0, 0), cB, voffB); PG8_STAGE(PG8_SB(0, 1), cB + hstep, voffB); PG8_STAGE(PG8_SA(0, 0), cA, voffA); PG8_STAGE(PG8_SA(0, 1), cA + hstep, voffA);
        if (wr == 1) PG8_BAR;
        PG8_WAIT_V(2); PG8_BAR;
        PG8_STAGE(PG8_SB(1, 0), cB + kstep, voffB); PG8_STAGE(PG8_SA(1, 0), cA + kstep, voffA); PG8_STAGE(PG8_SB(1, 1), cB + hstep + kstep, voffB);
        PG8_WAIT_V(6); PG8_BAR;
    } else {
        PG8_STAGE(PG8_SB(0, 0), cB, voffB); PG8_STAGE(PG8_SA(0, 0), cA, voffA); PG8_STAGE(PG8_SB(0, 1), cB + hstep, voffB); PG8_STAGE(PG8_SA(0, 1), cA + hstep, voffA);
        if (wr == 1) PG8_BAR;
        PG8_WAIT_V(4); PG8_BAR;
        PG8_STAGE(PG8_SB(1, 0), cB + kstep, voffB); PG8_STAGE(PG8_SA(1, 0), cA + kstep, voffA); PG8_STAGE(PG8_SB(1, 1), cB + hstep + kstep, voffB);
        PG8_WAIT_V(6); PG8_BAR;
    }
    for (;;) {
        const bool has_next = S.next(ui + 1, nxt);
        const char* nA = has_next ? (const char*)g.A + (size_t)nxt.pm * tstep : cA; const char* nB = has_next ? (const char*)g.Bt + (size_t)nxt.pn * tstep : cB;
        for (int t = 0; t < nt; t += 2) {
            const bool last = (t == nt - 2);
            const char* a1 = cA + (size_t)(t + 1) * kstep;
            const char* a2 = last ? nA : cA + (size_t)(t + 2) * kstep; const char* b2 = last ? nB : cB + (size_t)(t + 2) * kstep;
            const char* a3 = a2 + kstep; const char* b3 = b2 + kstep;
            if (last && has_next) S.a_ready(nxt);
            if constexpr (SP2) {
            PG8_LDB(B0, 0, 0); PG8_LDB(B1, 0, 1); PG8_SCHED; PG8_LDA(At, 0, 0); PG8_STAGE(PG8_SA(1, 1), a1 + hstep, voffA);
            PG8_WAIT_V(8); PG8_WAIT_L(0); PG8_BAR; PG8_MMA(0, 0, At, B0); PG8_MMA(0, 1, At, B1); PG8_BAR; PG8_SCHED;
            PG8_LDA(At, 0, 1); PG8_STAGE(PG8_SB(0, 0), b2, voffB); PG8_STAGE(PG8_SB(0, 1), b2 + hstep, voffB); PG8_STAGE(PG8_SA(0, 0), a2, voffA);
            PG8_WAIT_V(8); PG8_WAIT_L(0); PG8_BAR; PG8_MMA(1, 0, At, B0); PG8_MMA(1, 1, At, B1); PG8_BAR; PG8_SCHED;
            PG8_LDB(B0, 1, 0); PG8_LDB(B1, 1, 1); PG8_SCHED; PG8_LDA(At, 1, 0); PG8_STAGE(PG8_SA(0, 1), a2 + hstep, voffA);
            PG8_WAIT_V(8); PG8_WAIT_L(0); PG8_BAR; PG8_MMA(0, 0, At, B0); PG8_MMA(0, 1, At, B1); PG8_BAR; PG8_SCHED;
            PG8_LDA(At, 1, 1); PG8_STAGE(PG8_SB(1, 0), b3, voffB); PG8_STAGE(PG8_SB(1, 1), b3 + hstep, voffB); PG8_STAGE(PG8_SA(1, 0), a3, voffA);
            PG8_WAIT_V(8); PG8_WAIT_L(0); PG8_BAR; PG8_MMA(1, 0, At, B0); PG8_MMA(1, 1, At, B1); PG8_BAR; PG8_SCHED;
            } else {
            PG8_LDB(B0, 0, 0); PG8_SCHED; PG8_LDA(At, 0, 0); PG8_STAGE(PG8_SA(1, 1), a1 + hstep, voffA);
            PG8_WAIT_L(8); PG8_BAR; PG8_WAIT_L(0); PG8_MMA(0, 0, At, B0); PG8_BAR; PG8_SCHED;
            PG8_LDB(B1, 0, 1); PG8_STAGE(PG8_SB(0, 0), b2, voffB);
            PG8_BAR; PG8_WAIT_L(0); PG8_MMA(0, 1, At, B1); PG8_BAR;
            PG8_LDA(At, 0, 1); PG8_STAGE(PG8_SA(0, 0), a2, voffA);
            PG8_BAR; PG8_WAIT_L(0); PG8_MMA(1, 0, At, B0); PG8_BAR; PG8_SCHED;
            PG8_STAGE(PG8_SB(0, 1), b2 + hstep, voffB);
            PG8_WAIT_V(6); PG8_BAR; PG8_MMA(1, 1, At, B1); PG8_BAR;
            PG8_LDB(B0, 1, 0); PG8_SCHED; PG8_LDA(At, 1, 0); PG8_STAGE(PG8_SA(0, 1), a2 + hstep, voffA);
            PG8_WAIT_L(8); PG8_BAR; PG8_WAIT_L(0); PG8_MMA(0, 0, At, B0); PG8_BAR; PG8_SCHED;
            PG8_LDB(B1, 1, 1); PG8_STAGE(PG8_SB(1, 0), b3, voffB);
            PG8_BAR; PG8_WAIT_L(0); PG8_MMA(0, 1, At, B1); PG8_BAR;
            PG8_LDA(At, 1, 1); PG8_STAGE(PG8_SA(1, 0), a3, voffA);
            PG8_BAR; PG8_WAIT_L(0); PG8_MMA(1, 0, At, B0); PG8_BAR; PG8_SCHED;
            PG8_STAGE(PG8_SB(1, 1), b3 + hstep, voffB);
            PG8_WAIT_V(6); PG8_BAR; PG8_MMA(1, 1, At, B1); PG8_BAR;
            }
        }
        if constexpr (ALIGN_EPI) { if (wr == 0) PG8_BAR; }
        if constexpr (!Epi::AFTER_DRAIN) { E(acc, cur, wr, wc, fr, fq); S.done(cur); }
        if (!has_next) break;
#pragma unroll
        for (int a = 0; a < 2; ++a)
#pragma unroll
            for (int b = 0; b < 2; ++b)
#pragma unroll
                for (int m = 0; m < 4; ++m)
#pragma unroll
                    for (int n = 0; n < 2; ++n) acc[a][b][m][n] = (f32x4){0.f, 0.f, 0.f, 0.f};
        cur = nxt; cA = nA; cB = nB; ++ui;
        if constexpr (ALIGN_EPI) { if (wr == 1) PG8_BAR; }
    }
    PG8_WAIT_V(0);
    if constexpr (!ALIGN_EPI) { if (wr == 0) PG8_BAR; }
    PG8_BAR;
    if constexpr (Epi::AFTER_DRAIN) { E.fused(acc, cur, wr, wc, fr, fq, lds, wid, lane); S.done(cur); }
#undef PG8_SA
#undef PG8_SB
#undef PG8_STAGE
#undef PG8_LDA
#undef PG8_LDB
#undef PG8_MMA
#undef PG8_WAIT_V
#undef PG8_WAIT_L
#undef PG8_BAR
#undef PG8_SCHED
}
}
using pg8::f32x4; using pg8::u32x4;

__device__ __forceinline__ void transpose_item(const float* W, int K, int N, bf16_t* WT, int row_off, float* scr, int item, int lane) {
    const int nblk = N / 32, kb = item / nblk, nbk = item % nblk, k0 = 64 * kb, n0 = 32 * nbk;
#pragma unroll 8
    for (int i = 0; i < 32; ++i) { const int kk = 2 * i + (lane >> 5); scr[kk * 33 + (lane & 31)] = W[(size_t)(k0 + kk) * N + n0 + (lane & 31)]; }
    asm volatile("s_waitcnt lgkmcnt(0)" ::: "memory");
    const int c = lane & 7;
#pragma unroll
    for (int j = 0; j < 4; ++j) { const int n = (lane >> 3) + 8 * j; const float* s = scr + (8 * c) * 33 + n;
        uint4 o; o.x = pk2(s[0 * 33], s[1 * 33]); o.y = pk2(s[2 * 33], s[3 * 33]); o.z = pk2(s[4 * 33], s[5 * 33]); o.w = pk2(s[6 * 33], s[7 * 33]);
        *(uint4*)(WT + (size_t)(row_off + n0 + n) * K + k0 + 8 * c) = o; }
    asm volatile("s_waitcnt lgkmcnt(0)" ::: "memory");
}
__device__ __forceinline__ void ph_prep(const Params& p, int bid, int nb, float* lds) {
    const int tid = tid_(), wave = tid >> 6, lane = tid & 63;
    {
        float* sl = lds;
        float* red = lds + 4096;
        for (int i = tid; i < 4096; i += NTH) sl[i] = siluf_(p.c[i]);
        __syncthreads();
        for (int it = bid; it < 192; it += nb) {
            const int c4 = tid & 15, kg = tid >> 4;
            const float* wp = p.w_ada + (size_t)kg * NMOD + it * 64 + c4 * 4;
            float a0[4] = {0.f, 0.f, 0.f, 0.f}, a1[4] = {0.f, 0.f, 0.f, 0.f};
#pragma unroll 8
            for (int i = 0; i < 64; ++i) {
                const int k = kg + 32 * i;
                const float4 w = *(const float4*)(wp + (size_t)(32 * i) * NMOD);
                const float s0 = sl[k], s1 = sl[2048 + k];
                a0[0] += s0 * w.x; a0[1] += s0 * w.y; a0[2] += s0 * w.z; a0[3] += s0 * w.w;
                a1[0] += s1 * w.x; a1[1] += s1 * w.y; a1[2] += s1 * w.z; a1[3] += s1 * w.w;
            }
            __syncthreads();
#pragma unroll
            for (int e = 0; e < 4; ++e) { red[(kg * 16 + c4) * 8 + e] = a0[e]; red[(kg * 16 + c4) * 8 + 4 + e] = a1[e]; }
            __syncthreads();
            if (tid < 128) {
                const int b = tid >> 6, col = tid & 63;
                float s = 0.f;
                for (int g = 0; g < 32; ++g) s += red[(g * 16 + (col >> 2)) * 8 + b * 4 + (col & 3)];
                p.ada[b * NMOD + it * 64 + col] = s + p.b_ada[it * 64 + col];
            }
        }
        __syncthreads();
    }
    for (int e = bid * NTH + tid; e < NTOK * 64; e += nb * NTH) {
        const int tok = e >> 6, j = e & 63;
        const float ang = (float)p.pos[tok] * c_freq[j];
        float s, c; sincos_acc(ang, s, c);
        p.rope[(size_t)e * 2] = c; p.rope[(size_t)e * 2 + 1] = s;
    }
    {
        float* scr = lds + wave * (64 * 33);
        const int gw = bid * 8 + wave, ngw = nb * 8;
        constexpr int I1 = 32 * 256, I2 = 32 * 128, I3 = 16 * 64, I4 = 32 * 64;
        constexpr int NIT = I1 + I2 + I3 + 3 * I4;
        for (int it = gw; it < NIT; it += ngw) {
            int r = it;
            if (r < I1) { transpose_item(p.w_in, 2048, 8192, p.Wt1, 0, scr, r, lane); continue; } r -= I1;
            if (r < I2) { transpose_item(p.w_bg, 2048, 4096, p.Wt1, 8192, scr, r, lane); continue; } r -= I2;
            if (r < I3) { transpose_item(p.w_a_out, 1024, 2048, p.Wta, 0, scr, r, lane); continue; } r -= I3;
            if (r < I4) { transpose_item(p.w_b_out, 2048, 2048, p.Wtb, 0, scr, r, lane); continue; } r -= I4;
            if (r < I4) { transpose_item(p.w_o, 2048, 2048, p.Wto, 0, scr, r, lane); continue; } r -= I4;
            transpose_item(p.peer_wq, 2048, 2048, p.Wtq, 0, scr, r, lane);
        }
    }
    __syncthreads();
}
constexpr int ROW6 = 1536;
__device__ __forceinline__ unsigned enc_e2m3(float x) {
    const unsigned sgn = (__float_as_uint(x) >> 26) & 32u; const float a = fabsf(x);
    const unsigned b = __float_as_uint(a);
    const unsigned nrm = ((b + 0x7FFFFu + ((b >> 20) & 1u)) >> 20) - 1008u;
    const unsigned sub = (unsigned)rintf(a * 8.0f);
    unsigned c = (a < 1.0f) ? sub : nrm; c = c > 31u ? 31u : c;
    return sgn | c;
}
__device__ __forceinline__ void ph_tabconv(const Params& p, int bid, int nb) {
    const int tid = tid_(), wave = tid >> 6, lane = tid & 63;
    for (int r = bid * 8 + wave; r < 2 * 16384; r += nb * 8) {
        const bool second = r >= 16384; const int row = second ? r - 16384 : r;
        const float* src = (second ? p.peer_v : p.peer_u) + (size_t)row * DM + lane * 32;
        float v[32]; float am = 0.f;
#pragma unroll
        for (int q = 0; q < 8; ++q) { const float4 t = *(const float4*)(src + 4 * q); v[4 * q] = t.x; v[4 * q + 1] = t.y; v[4 * q + 2] = t.z; v[4 * q + 3] = t.w;
            am = fmaxf(am, fmaxf(fmaxf(fabsf(t.x), fabsf(t.y)), fmaxf(fabsf(t.z), fabsf(t.w)))); }
        am = wave_max(am);
        const float sc = (am > 0.f) ? am * (1.0f / 7.5f) : 1.0f, inv = (am > 0.f) ? 7.5f / am : 1.0f;
        unsigned w[6] = {0u, 0u, 0u, 0u, 0u, 0u};
#pragma unroll
        for (int k = 0; k < 32; ++k) {
            const unsigned c = enc_e2m3(v[k] * inv);
            const int bp = 6 * k, wd = bp >> 5, sh = bp & 31;
            w[wd] |= c << sh;
            if (sh > 26) w[wd + 1] |= c >> (32 - sh);
        }
        unsigned char* dst = (second ? p.V8 : p.U8) + (size_t)row * ROW6 + lane * 24;
        *(uint2*)(dst) = make_uint2(w[0], w[1]); *(uint2*)(dst + 8) = make_uint2(w[2], w[3]); *(uint2*)(dst + 16) = make_uint2(w[4], w[5]);
        if (lane == 0) (second ? p.sv : p.su)[row] = sc;
    }
}

__device__ __forceinline__ void ph_modnorm(const Params& p, const float* xin, const float* g, int sh_off, int sc_off, bf16_t* hout, int bid, int nb, float* lds) {
    const int tid = tid_(), wave = tid >> 6, lane = tid & 63;
    for (int row = bid * 8 + wave; row < NTOK; row += nb * 8) {
        const int b = row / SQ;
        const float4* xr = (const float4*)(xin + (size_t)row * DM);
        float4 v[8]; float ss = 0.f;
#pragma unroll
        for (int j = 0; j < 8; ++j) { v[j] = xr[lane + 64 * j]; ss += dot4(v[j], v[j]); }
        ss = wave_sum(ss);
        const float rs = 1.0f / sqrtf(ss * (1.0f / DM) + 1e-6f);
#pragma unroll
        for (int j = 0; j < 8; ++j) {
            const int col = (lane + 64 * j) * 4;
            const float4 g4 = *(const float4*)(g + col);
            const float4 sc = *(const float4*)(p.ada + b * NMOD + sc_off + col);
            const float4 sh = *(const float4*)(p.ada + b * NMOD + sh_off + col);
            float4 o;
            o.x = v[j].x * rs * g4.x * (1.0f + sc.x) + sh.x; o.y = v[j].y * rs * g4.y * (1.0f + sc.y) + sh.y;
            o.z = v[j].z * rs * g4.z * (1.0f + sc.z) + sh.z; o.w = v[j].w * rs * g4.w * (1.0f + sc.w) + sh.w;
            *(uint2*)(hout + (size_t)row * DM + col) = make_uint2(pk2(o.x, o.y), pk2(o.z, o.w));
        }
    }
}

typedef short bf16x8_t __attribute__((ext_vector_type(8)));
typedef float f32x4_t __attribute__((ext_vector_type(4)));
__device__ __forceinline__ bf16x8_t ldfrag(const char* base, int row, int chunk, int rb, int sm) { return *(const bf16x8_t*)(base + row * rb + ((chunk ^ (row & sm)) << 4)); }
__device__ __forceinline__ void ph_gmlp2(const Params& p, int bid, int nb, float* lds) {
    char* WM = (char*)lds; char* VT = WM + 32768;
    const int tid = tid_(), wave = tid >> 6, lane = tid & 63, fr = lane & 15, fq = lane >> 4;
    int gl = -1;
    for (int it = bid; it < 512; it += nb) {
        const int g = it & 7, n = (it >> 3) & 31, b = it >> 8;
        const int tok0 = b * SQ + n * 128;
        __syncthreads();
        if (g != gl) {
            for (int u = tid; u < 2048; u += NTH) {
                const int i = u >> 4, c = u & 15;
                const float4* src = (const float4*)(p.gm_ws + (size_t)g * 16384 + i * 128 + c * 8);
                float4 a = src[0], b4 = src[1];
                if ((i >> 6) < (c >> 3)) { a = make_float4(0.f, 0.f, 0.f, 0.f); b4 = a; }
                *(uint4*)(WM + i * 256 + ((c ^ (i & 15)) << 4)) = make_uint4(pk2(a.x, a.y), pk2(a.z, a.w), pk2(b4.x, b4.y), pk2(b4.z, b4.w));
            }
            gl = g;
        }
        {
            const float2 gn = *(const float2*)(p.gm_v_g + g * 128 + lane * 2);
#pragma unroll 4
            for (int jj = 0; jj < 16; ++jj) {
                const int j = wave * 16 + jj;
                const unsigned w = *(const unsigned*)(p.ZG + (size_t)(tok0 + j) * ZW + 1024 + g * 128 + lane * 2);
                const float a = bflo(w), c2 = bfhi(w);
                const float ss = wave_sum(a * a + c2 * c2);
                const float rs = 1.0f / sqrtf(ss * (1.0f / 128.0f) + 1e-6f);
                const int d0 = lane * 2, d1 = d0 + 1;
                *(bf16_t*)(VT + d0 * 256 + (((j >> 3) ^ (d0 & 15)) << 4) + (j & 7) * 2) = (bf16_t)f2bf(a * rs * gn.x);
                *(bf16_t*)(VT + d1 * 256 + (((j >> 3) ^ (d1 & 15)) << 4) + (j & 7) * 2) = (bf16_t)f2bf(c2 * rs * gn.y);
            }
        }
        __syncthreads();
        {
            bf16x8_t A[4];
#pragma unroll
            for (int ks = 0; ks < 4; ++ks) A[ks] = ldfrag(VT, wave * 16 + fr, ks * 4 + fq, 256, 15);
            const int d0 = wave * 16 + fq * 4;
#pragma unroll
            for (int itl = 0; itl < 8; ++itl) {
                f32x4_t acc = {0.f, 0.f, 0.f, 0.f};
#pragma unroll
                for (int ks = 0; ks < 4; ++ks) if (itl >= 4 || ks < 2) acc = __builtin_amdgcn_mfma_f32_16x16x32_bf16(A[ks], ldfrag(WM, itl * 16 + fr, ks * 4 + fq, 256, 15), acc, 0, 0, 0);
                const int i = itl * 16 + fr;
                const float bias = p.gm_b[g * 128 + i];
                const size_t tok = (size_t)(tok0 + i);
                const uint2 uw = *(const uint2*)(p.ZG + tok * ZW + g * 128 + d0);
                *(uint2*)(p.yain + tok * 1024 + g * 128 + d0) = make_uint2(pk2(bflo(uw.x) * (acc[0] + bias), bfhi(uw.x) * (acc[1] + bias)), pk2(bflo(uw.y) * (acc[2] + bias), bfhi(uw.y) * (acc[3] + bias)));
            }
        }
    }
    __syncthreads();
}

__device__ __forceinline__ void ph_ret(const Params& p, int bid, int nb, float* lds) {
    float* Qs = lds;
    float* Ks = Qs + 64 * 129;
    float* Vs = Ks + 64 * 129;
    float* Ss = Vs + 64 * 16;
    float* At = Ss + 128 * 16;
    float* kd = At + 64 * 65;
    const int tid = tid_();
    const bf16_t* z = p.ZG;
    for (int it = bid; it < 256; it += nb) {
        const int vs = it & 15, h = (it >> 4) & 7, b = it >> 7;
        const float lg = log1pf(-exp2f(-5.0f - (float)h));
        const float cdec = expf(lg * 64.0f);
        __syncthreads();
        for (int i = tid; i < 2048; i += NTH) Ss[i] = 0.f;
        if (tid < 64) kd[tid] = expf(lg * (float)(63 - tid));
        for (int n = 0; n < 64; ++n) {
            const int tok0 = b * SQ + n * 64;
            __syncthreads();
            for (int e = tid; e < 4096; e += NTH) {
                const int i = e >> 6, dd = e & 63; const size_t tok = (size_t)(tok0 + i);
                const float cs = p.rope[(tok * 64 + dd) * 2], sn = p.rope[(tok * 64 + dd) * 2 + 1];
                const bf16_t* zr = z + tok * ZW;
                const float q1 = bf2f(zr[2048 + h * 128 + dd]), q2 = bf2f(zr[2048 + h * 128 + 64 + dd]);
                const float k1 = bf2f(zr[3072 + h * 128 + dd]), k2 = bf2f(zr[3072 + h * 128 + 64 + dd]);
                Qs[i * 129 + dd] = q1 * cs - q2 * sn; Qs[i * 129 + 64 + dd] = q1 * sn + q2 * cs;
                const float sc = 0.08838834764831845f;
                Ks[i * 129 + dd] = (k1 * cs - k2 * sn) * sc; Ks[i * 129 + 64 + dd] = (k1 * sn + k2 * cs) * sc;
            }
            for (int e = tid; e < 1024; e += NTH) { const int j = e >> 4, v = e & 15; Vs[e] = bf2f(z[(size_t)(tok0 + j) * ZW + 4096 + h * 256 + vs * 16 + v]); }
            __syncthreads();
            {
                const int j = tid & 63, i0 = (tid >> 6) * 8;
                float acc[8];
#pragma unroll
                for (int ii = 0; ii < 8; ++ii) acc[ii] = 0.f;
                for (int d = 0; d < 128; ++d) {
                    const float kv = Ks[j * 129 + d];
#pragma unroll
                    for (int ii = 0; ii < 8; ++ii) acc[ii] += Qs[(i0 + ii) * 129 + d] * kv;
                }
#pragma unroll
                for (int ii = 0; ii < 8; ++ii) { const int i = i0 + ii; At[i * 65 + j] = acc[ii] * expf(lg * fabsf((float)(i - j))); }
            }
            __syncthreads();
            {
                const int v = tid & 15, i0 = tid >> 4;
#pragma unroll
                for (int rep = 0; rep < 2; ++rep) {
                    const int i = i0 + 32 * rep;
                    float a = 0.f; for (int j = 0; j < 64; ++j) a += At[i * 65 + j] * Vs[j * 16 + v];
                    float c2 = 0.f; for (int d = 0; d < 128; ++d) c2 += Qs[i * 129 + d] * Ss[d * 16 + v];
                    p.obuf[(size_t)(tok0 + i) * DM + h * 256 + vs * 16 + v] = a + c2 * expf(lg * (float)(i + 1));
                }
            }
            __syncthreads();
            {
                const int v = tid & 15, d0 = tid >> 4;
#pragma unroll
                for (int rep = 0; rep < 4; ++rep) {
                    const int d = d0 + 32 * rep;
                    float a = 0.f; for (int j = 0; j < 64; ++j) a += Ks[j * 129 + d] * kd[j] * Vs[j * 16 + v];
                    Ss[d * 16 + v] = Ss[d * 16 + v] * cdec + a;
                }
            }
        }
    }
    __syncthreads();
}


__device__ __forceinline__ void ph_retprep(const Params& p, int bid, int nb, float* lds) {
    bf16_t* Kl = (bf16_t*)lds;
    bf16_t* Vl = Kl + 64 * 132;
    const int tid = tid_();
    for (int it = bid; it < 1024; it += nb) {
        const int n = it & 63, h = (it >> 6) & 7, b = it >> 9;
        const int tok0 = b * SQ + n * 64;
        const size_t rowbase = (size_t)(b * 8 + h) * SQ + n * 64;
        const float lg = log1pf(-exp2f(-5.0f - (float)h));
        __syncthreads();
#pragma unroll
        for (int k = 0; k < 2; ++k) {
            const int u = tid + 512 * k, i = u >> 4, dd = (u & 15) * 4; const size_t tok = (size_t)(tok0 + i);
            const float4 r0 = *(const float4*)(p.rope + (tok * 64 + dd) * 2), r1 = *(const float4*)(p.rope + (tok * 64 + dd) * 2 + 4);
            const float cs[4] = {r0.x, r0.z, r1.x, r1.z}, sn[4] = {r0.y, r0.w, r1.y, r1.w};
            const bf16_t* zr = p.ZG + tok * ZW;
            const uint2 q1w = *(const uint2*)(zr + 2048 + h * 128 + dd), q2w = *(const uint2*)(zr + 2048 + h * 128 + 64 + dd);
            const uint2 k1w = *(const uint2*)(zr + 3072 + h * 128 + dd), k2w = *(const uint2*)(zr + 3072 + h * 128 + 64 + dd);
            const float q1[4] = {bflo(q1w.x), bfhi(q1w.x), bflo(q1w.y), bfhi(q1w.y)}, q2[4] = {bflo(q2w.x), bfhi(q2w.x), bflo(q2w.y), bfhi(q2w.y)};
            const float k1[4] = {bflo(k1w.x), bfhi(k1w.x), bflo(k1w.y), bfhi(k1w.y)}, k2[4] = {bflo(k2w.x), bfhi(k2w.x), bflo(k2w.y), bfhi(k2w.y)};
            const float sc = 0.08838834764831845f, kd = expf(lg * (float)(63 - i));
            float qa[4], qb[4], ka[4], kb[4];
#pragma unroll
            for (int e = 0; e < 4; ++e) { qa[e] = q1[e] * cs[e] - q2[e] * sn[e]; qb[e] = q1[e] * sn[e] + q2[e] * cs[e]; ka[e] = (k1[e] * cs[e] - k2[e] * sn[e]) * sc; kb[e] = (k1[e] * sn[e] + k2[e] * cs[e]) * sc; }
            *(uint2*)(p.Qr + (rowbase + i) * 128 + dd) = make_uint2(pk2(qa[0], qa[1]), pk2(qa[2], qa[3]));
            *(uint2*)(p.Qr + (rowbase + i) * 128 + 64 + dd) = make_uint2(pk2(qb[0], qb[1]), pk2(qb[2], qb[3]));
            *(uint2*)(p.Kr + (rowbase + i) * 128 + dd) = make_uint2(pk2(ka[0], ka[1]), pk2(ka[2], ka[3]));
            *(uint2*)(p.Kr + (rowbase + i) * 128 + 64 + dd) = make_uint2(pk2(kb[0], kb[1]), pk2(kb[2], kb[3]));
            *(uint2*)(Kl + i * 132 + dd) = make_uint2(pk2(ka[0] * kd, ka[1] * kd), pk2(ka[2] * kd, ka[3] * kd));
            *(uint2*)(Kl + i * 132 + 64 + dd) = make_uint2(pk2(kb[0] * kd, kb[1] * kd), pk2(kb[2] * kd, kb[3] * kd));
        }
#pragma unroll
        for (int k = 0; k < 4; ++k) {
            const int u = tid + 512 * k, j = u >> 5, c = u & 31;
            *(uint4*)(Vl + j * 264 + c * 8) = *(const uint4*)(p.ZG + (size_t)(tok0 + j) * ZW + 4096 + h * 256 + c * 8);
        }
        __syncthreads();
        bf16_t* kt = p.KTd + (size_t)it * 8192;
#pragma unroll
        for (int k = 0; k < 2; ++k) {
            const int u = tid + 512 * k, d = u & 127, jg = u >> 7;
            unsigned w[4];
#pragma unroll
            for (int q = 0; q < 4; ++q) w[q] = (unsigned)Kl[(jg * 8 + 2 * q) * 132 + d] | ((unsigned)Kl[(jg * 8 + 2 * q + 1) * 132 + d] << 16);
            *(uint4*)(kt + d * 64 + jg * 8) = make_uint4(w[0], w[1], w[2], w[3]);
        }
        bf16_t* vt = p.Vt + (size_t)it * 16384;
#pragma unroll
        for (int k = 0; k < 4; ++k) {
            const int u = tid + 512 * k, v = u & 255, jg = u >> 8;
            unsigned w[4];
#pragma unroll
            for (int q = 0; q < 4; ++q) w[q] = (unsigned)Vl[(jg * 8 + 2 * q) * 264 + v] | ((unsigned)Vl[(jg * 8 + 2 * q + 1) * 264 + v] << 16);
            *(uint4*)(vt + v * 64 + jg * 8) = make_uint4(w[0], w[1], w[2], w[3]);
        }
    }
    __syncthreads();
}

__device__ __forceinline__ void ph_ret2(const Params& p, int bid, int nb, float* lds) {
    char* L = (char*)lds;
    constexpr int OQ = 0, OKK = 16384, OKT = 32768, OVT = 49152, TILE = 51200, OP = 2 * TILE, OST = OP + 8192;
    const int tid = tid_(), wave = tid >> 6, lane = tid & 63, fr = lane & 15, fq = lane >> 4;
    for (int it = bid; it < 256; it += nb) {
        const int vs = it & 15, h = (it >> 4) & 7, b = it >> 7;
        const float lg = log1pf(-exp2f(-5.0f - (float)h));
        const float cdec = expf(lg * 64.0f);
        const size_t bh = (size_t)(b * 8 + h);
        const char* gQ = (const char*)(p.Qr + bh * SQ * 128);
        const char* gK = (const char*)(p.Kr + bh * SQ * 128);
        const char* gKT = (const char*)(p.KTd + bh * 64 * 8192);
        const char* gVt = (const char*)(p.Vt + bh * 64 * 16384) + vs * 16 * 128;
        int lq[2], lkt[2];
#pragma unroll
        for (int u = 0; u < 2; ++u) { const int ci = tid + 512 * u; const int r = ci >> 4, c = ci & 15; lq[u] = r * 256 + ((c ^ (r & 15)) << 4); const int d = ci >> 3, c8 = ci & 7; lkt[u] = d * 128 + ((c8 ^ (d & 7)) << 4); }
        const int lv = (tid >> 3) * 128 + (((tid & 7) ^ ((tid >> 3) & 7)) << 4);
        uint4 qA0, qA1, kA0, kA1, tA0, tA1, vA = make_uint4(0u, 0u, 0u, 0u), qB0, qB1, kB0, kB1, tB0, tB1, vB = make_uint4(0u, 0u, 0u, 0u);
#define RET_LOAD(X_, n_) do { const size_t o0 = (size_t)(n_) * 16384 + (size_t)tid * 16, o1 = o0 + 8192; \
        q##X_##0 = *(const uint4*)(gQ + o0); q##X_##1 = *(const uint4*)(gQ + o1); k##X_##0 = *(const uint4*)(gK + o0); k##X_##1 = *(const uint4*)(gK + o1); t##X_##0 = *(const uint4*)(gKT + o0); t##X_##1 = *(const uint4*)(gKT + o1); \
        if (tid < 128) v##X_ = *(const uint4*)(gVt + (size_t)(n_) * 32768 + tid * 16); } while (0)
#define RET_WRITE(X_, buf_) do { char* B_ = L + (buf_) * TILE; \
        *(uint4*)(B_ + OQ + lq[0]) = q##X_##0; *(uint4*)(B_ + OQ + lq[1]) = q##X_##1; *(uint4*)(B_ + OKK + lq[0]) = k##X_##0; *(uint4*)(B_ + OKK + lq[1]) = k##X_##1; *(uint4*)(B_ + OKT + lkt[0]) = t##X_##0; *(uint4*)(B_ + OKT + lkt[1]) = t##X_##1; \
        if (tid < 128) *(uint4*)(B_ + OVT + lv) = v##X_; } while (0)
        __syncthreads();
        for (int i = tid; i < 1024; i += NTH) ((unsigned*)(L + OST))[i] = 0u;
        RET_LOAD(A, 0); RET_WRITE(A, 0); RET_LOAD(B, 1);
        f32x4_t sacc[2] = {{0.f, 0.f, 0.f, 0.f}, {0.f, 0.f, 0.f, 0.f}};
#define RET_STEP(n_, cur_, LS_, WS_) do { const int n = (n_); constexpr int cur = (cur_); \
            __syncthreads();                                     \
            if (n + 2 < 64) RET_LOAD(LS_, n + 2); \
            const char* T = L + cur * TILE; \
            {     \
                const int jt = wave >> 1, it0 = 2 * (wave & 1); \
                f32x4_t s0 = {0.f, 0.f, 0.f, 0.f}, s1 = {0.f, 0.f, 0.f, 0.f}; \
                _Pragma("unroll") for (int ks = 0; ks < 4; ++ks) { \
                    const bf16x8_t a = ldfrag(T + OKK, jt * 16 + fr, ks * 4 + fq, 256, 15); \
                    const bf16x8_t b0 = ldfrag(T + OQ, it0 * 16 + fr, ks * 4 + fq, 256, 15), b1 = ldfrag(T + OQ, (it0 + 1) * 16 + fr, ks * 4 + fq, 256, 15); \
                    s0 = __builtin_amdgcn_mfma_f32_16x16x32_bf16(a, b0, s0, 0, 0, 0); \
                    s1 = __builtin_amdgcn_mfma_f32_16x16x32_bf16(a, b1, s1, 0, 0, 0); } \
                const int j0 = jt * 16 + fq * 4; \
                _Pragma("unroll") for (int tt = 0; tt < 2; ++tt) { \
                    const int i = (it0 + tt) * 16 + fr; const f32x4_t sv4 = tt ? s1 : s0; float pv[4]; \
                    _Pragma("unroll") for (int r = 0; r < 4; ++r) pv[r] = sv4[r] * __expf(lg * fabsf((float)(i - (j0 + r)))); \
                    *(uint2*)(L + OP + i * 128 + ((((j0 >> 3)) ^ (i & 7)) << 4) + (j0 & 7) * 2) = make_uint2(pk2(pv[0], pv[1]), pk2(pv[2], pv[3])); } \
            } \
            __syncthreads();                                     \
            if (wave < 4) {     \
                const int itl = wave; \
                f32x4_t o1 = {0.f, 0.f, 0.f, 0.f}, o2 = {0.f, 0.f, 0.f, 0.f}; \
                _Pragma("unroll") for (int ks = 0; ks < 2; ++ks) o1 = __builtin_amdgcn_mfma_f32_16x16x32_bf16(ldfrag(L + OP, itl * 16 + fr, ks * 4 + fq, 128, 7), ldfrag(T + OVT, fr, ks * 4 + fq, 128, 7), o1, 0, 0, 0); \
                _Pragma("unroll") for (int ks = 0; ks < 4; ++ks) o2 = __builtin_amdgcn_mfma_f32_16x16x32_bf16(ldfrag(T + OQ, itl * 16 + fr, ks * 4 + fq, 256, 15), ldfrag(L + OST + cur * 4096, fr, ks * 4 + fq, 256, 15), o2, 0, 0, 0); \
                _Pragma("unroll") for (int r = 0; r < 4; ++r) { const int i = itl * 16 + fq * 4 + r; \
                    p.ob16[(size_t)(b * SQ + n * 64 + i) * DM + h * 256 + vs * 16 + fr] = (bf16_t)f2bf(o1[r] + __expf(lg * (float)(i + 1)) * o2[r]); } \
            } else {            \
                _Pragma("unroll") for (int u = 0; u < 2; ++u) { \
                    const int dt = 2 * (wave - 4) + u; \
                    sacc[u] = sacc[u] * cdec; \
                    _Pragma("unroll") for (int ks = 0; ks < 2; ++ks) sacc[u] = __builtin_amdgcn_mfma_f32_16x16x32_bf16(ldfrag(T + OKT, dt * 16 + fr, ks * 4 + fq, 128, 7), ldfrag(T + OVT, fr, ks * 4 + fq, 128, 7), sacc[u], 0, 0, 0); \
                    *(uint2*)(L + OST + (cur ^ 1) * 4096 + fr * 256 + (((dt * 2 + (fq >> 1)) ^ fr) << 4) + (fq & 1) * 8) = make_uint2(pk2(sacc[u][0], sacc[u][1]), pk2(sacc[u][2], sacc[u][3])); } \
            } \
            if (n + 1 < 64) RET_WRITE(WS_, cur ^ 1); } while (0)
        for (int n2 = 0; n2 < 64; n2 += 2) { RET_STEP(n2, 0, A, B); RET_STEP(n2 + 1, 1, B, A); }
#undef RET_STEP
#undef RET_LOAD
#undef RET_WRITE
    }
    __syncthreads();
}

__device__ __forceinline__ void ph_gn(const Params& p, int bid, int nb, float* lds) {
    const int tid = tid_(), wave = tid >> 6, lane = tid & 63;
    for (int tok = bid * 8 + wave; tok < NTOK; tok += nb * 8) {
#pragma unroll
        for (int h = 0; h < 8; ++h) {
            const uint2 ow = *(const uint2*)(p.ob16 + (size_t)tok * DM + h * 256 + lane * 4);
            const float4 o = make_float4(bflo(ow.x), bfhi(ow.x), bflo(ow.y), bfhi(ow.y));
            const float mu = wave_sum(o.x + o.y + o.z + o.w) * (1.0f / 256.0f);
            const float4 d = make_float4(o.x - mu, o.y - mu, o.z - mu, o.w - mu);
            const float var = wave_sum(dot4(d, d)) * (1.0f / 256.0f);
            const float rs = 1.0f / sqrtf(var + 1e-6f);
            const float4 gn = *(const float4*)(p.ret_gn_g + h * 256 + lane * 4);
            const uint2 gw = *(const uint2*)(p.ZG + (size_t)tok * ZW + 6144 + h * 256 + lane * 4);
            const float g0 = bflo(gw.x), g1 = bfhi(gw.x), g2 = bflo(gw.y), g3 = bfhi(gw.y);
            *(uint2*)(p.ybin + (size_t)tok * DM + h * 256 + lane * 4) =
                make_uint2(pk2(siluf_(g0) * d.x * rs * gn.x, siluf_(g1) * d.y * rs * gn.y), pk2(siluf_(g2) * d.z * rs * gn.z, siluf_(g3) * d.w * rs * gn.w));
        }
    }
}

template <int NL>
__device__ __forceinline__ void wave_top16(float (&v)[NL], const int (&idx)[NL], float& outv, int& outi, int lane) {
    outv = 0.f; outi = 0;
    for (int r = 0; r < 16; ++r) {
        float m = v[0];
#pragma unroll
        for (int u = 1; u < NL; ++u) m = fmaxf(m, v[u]);
        const float wm = wave_max(m);
        const unsigned long long bal = __ballot(m == wm);
        const int owner = __ffsll((long long)bal) - 1;
        int myi = -1;
        if (lane == owner) {
            bool done = false;
#pragma unroll
            for (int u = 0; u < NL; ++u) if (!done && v[u] == wm) { myi = idx[u]; v[u] = -INFINITY; done = true; }
        }
        const int wi = __shfl(myi, owner);
        if (lane == r) { outv = wm; outi = wi; }
    }
}
__device__ __forceinline__ void ph_topk(const Params& p, const float* qb, int bid, int nb, float* lds) {
    const int tid = tid_(), wave = tid >> 6, lane = tid & 63;
    for (int t = bid; t < NTOK; t += nb) {
        const int h = wave;
        const float* q = qb + (size_t)t * DM + h * 256;
        float s[2][2];
#pragma unroll
        for (int pp = 0; pp < 2; ++pp)
#pragma unroll
            for (int r = 0; r < 2; ++r) {
                const int n = lane + 64 * r;
                const float4* kr = (const float4*)(p.peer_sk + ((size_t)(h * 2 + pp) * 128 + n) * 128);
                const float4* qr = (const float4*)(q + pp * 128);
                float a = 0.f;
#pragma unroll 4
                for (int d4 = 0; d4 < 32; ++d4) a += dot4(kr[d4], qr[d4]);
                s[pp][r] = a;
            }
        float v1, v2; int i1, i2;
        { float vv[2] = {s[0][0], s[0][1]}; const int ii[2] = {lane, lane + 64}; wave_top16<2>(vv, ii, v1, i1, lane); }
        { float vv[2] = {s[1][0], s[1][1]}; const int ii[2] = {lane, lane + 64}; wave_top16<2>(vv, ii, v2, i2, lane); }
        float cv[4]; int ci[4];
        const int a = lane >> 2, b0 = (lane & 3) * 4;
        const float va = __shfl(v1, a); const int ia = __shfl(i1, a);
#pragma unroll
        for (int u = 0; u < 4; ++u) { const float vb = __shfl(v2, b0 + u); const int ib = __shfl(i2, b0 + u); cv[u] = va + vb; ci[u] = ia * 128 + ib; }
        float tv; int te;
        wave_top16<4>(cv, ci, tv, te, lane);
        const float mx = __shfl(tv, 0);
        const float ex = (lane < 16) ? expf(tv - mx) : 0.f;
        const float sum = wave_sum(ex);
        if (lane < 16) { p.eidx[(size_t)t * 128 + h * 16 + lane] = te; p.gatev[(size_t)t * 128 + h * 16 + lane] = ex / sum; }
    }
}

__device__ __forceinline__ void ph_peer(const Params& p, const float* x1, const bf16_t* h2, int bid, int nb, float* lds) {
    float* ys = lds;
    float* red = lds + 8 * 2048;
    const int tid = tid_(), wave = tid >> 6, lane = tid & 63;
    for (int t = bid; t < NTOK; t += nb) {
        const int b = t / SQ, h = wave;
        const uint2* hr = (const uint2*)(h2 + (size_t)t * DM);
        float4 hv[8], y[8];
#pragma unroll
        for (int j = 0; j < 8; ++j) { const uint2 w = hr[lane + 64 * j]; hv[j] = make_float4(bflo(w.x), bfhi(w.x), bflo(w.y), bfhi(w.y)); y[j] = make_float4(0.f, 0.f, 0.f, 0.f); }
        for (int k = 0; k < 16; ++k) {
            const int e = p.eidx[(size_t)t * 128 + h * 16 + k]; const float gt = p.gatev[(size_t)t * 128 + h * 16 + k];
            const float4* ur = (const float4*)(p.peer_u + (size_t)e * DM);
            float a = 0.f;
#pragma unroll
            for (int j = 0; j < 8; ++j) a += dot4(ur[lane + 64 * j], hv[j]);
            a = wave_sum(a);
            const float w = geluf_(a) * gt;
            const float4* vr = (const float4*)(p.peer_v + (size_t)e * DM);
#pragma unroll
            for (int j = 0; j < 8; ++j) { const float4 v4 = vr[lane + 64 * j]; y[j].x += w * v4.x; y[j].y += w * v4.y; y[j].z += w * v4.z; y[j].w += w * v4.w; }
        }
        __syncthreads();
#pragma unroll
        for (int j = 0; j < 8; ++j) *(float4*)(ys + h * 2048 + (lane + 64 * j) * 4) = y[j];
        __syncthreads();
        const int c = tid * 4;
        float4 s = make_float4(0.f, 0.f, 0.f, 0.f);
#pragma unroll
        for (int hh = 0; hh < 8; ++hh) { const float4 a = *(const float4*)(ys + hh * 2048 + c); s.x += a.x; s.y += a.y; s.z += a.z; s.w += a.w; }
        const float4 xv = *(const float4*)(x1 + (size_t)t * DM + c);
        const float4 ga = *(const float4*)(p.ada + b * NMOD + 5 * DM + c);
        const float4 x2 = make_float4(xv.x + ga.x * s.x, xv.y + ga.y * s.y, xv.z + ga.z * s.z, xv.w + ga.w * s.w);
        const float ss = wave_sum(dot4(x2, x2));
        if (lane == 0) red[wave] = ss;
        __syncthreads();
        float tot = 0.f;
#pragma unroll
        for (int w = 0; w < 8; ++w) tot += red[w];
        const float rs = 1.0f / sqrtf(tot * (1.0f / DM) + 1e-6f);
        const float4 gf = *(const float4*)(p.norm_f_g + c);
        *(float4*)(p.out + (size_t)t * DM + c) = make_float4(x2.x * rs * gf.x, x2.y * rs * gf.y, x2.z * rs * gf.z, x2.w * rs * gf.w);
    }
    __syncthreads();
}

__device__ __forceinline__ void split8(const float4 a, const float4 b, uint4& hi, uint4& lo) {
    const float x[8] = {a.x, a.y, a.z, a.w, b.x, b.y, b.z, b.w}; unsigned h[8], l[8];
#pragma unroll
    for (int i = 0; i < 8; ++i) { h[i] = f2bf(x[i]); l[i] = f2bf(x[i] - __uint_as_float(h[i] << 16)); }
    hi = make_uint4(h[0] | (h[1] << 16), h[2] | (h[3] << 16), h[4] | (h[5] << 16), h[6] | (h[7] << 16));
    lo = make_uint4(l[0] | (l[1] << 16), l[2] | (l[3] << 16), l[4] | (l[5] << 16), l[6] | (l[7] << 16));
}
__device__ __forceinline__ bf16x8_t as_bf16x8(const uint4 v) { return __builtin_bit_cast(bf16x8_t, v); }
struct PairTab { int a[52], b[52]; };
__host__ __device__ constexpr PairTab make_pairs() {
    PairTab t{}; int n = 0;
    for (int a = 0; a < 16; ++a) for (int b = 0; b < 16; ++b) if ((a + 1) * (b + 1) <= 16) { t.a[n] = a; t.b[n] = b; ++n; }
    for (; n < 52; ++n) { t.a[n] = -1; t.b[n] = -1; }
    return t;
}
constexpr PairTab PAIRS = make_pairs();
static_assert(PAIRS.a[49] >= 0 && PAIRS.a[50] < 0, "50 candidate pairs");

__device__ __forceinline__ void ph_topk2(const Params& p, const float* qb, int bid, int nb, float* lds) {
    const int tid = tid_(), wave = tid >> 6, lane = tid & 63;
    uint4* SK = (uint4*)lds;
    const float NEG = -INFINITY;
    for (int it = bid; it < 256; it += nb) {
        const int h = it & 7, tg = it >> 3;
        __syncthreads();
        for (int gi = tid; gi < 4096; gi += NTH) {
            const int dq = gi & 15, n = (gi >> 4) & 127, pp = gi >> 11;
            const float4* src = (const float4*)(p.peer_sk + ((size_t)(h * 2 + pp) * 128 + n) * 128 + dq * 8);
            uint4 hi, lo; split8(src[0], src[1], hi, lo);
            const int base = (((pp * 8 + (n >> 4)) * 4 + (dq >> 2)) * 2) * 64 + (dq & 3) * 16 + (n & 15);
            SK[base] = hi; SK[base + 64] = lo;
        }
        __syncthreads();
#pragma unroll 1
        for (int tile = 0; tile < 2; ++tile) {
            const int tok = tg * 256 + wave * 32 + tile * 16 + (lane & 15);
            const int qd = lane >> 4;
            float v12[2][16];
#pragma unroll
            for (int pp = 0; pp < 2; ++pp) {
                bf16x8_t Bh[4], Bl[4];
                const float* qp = qb + (size_t)tok * DM + h * 256 + pp * 128 + 8 * qd;
#pragma unroll
                for (int ks = 0; ks < 4; ++ks) { uint4 hi, lo; split8(*(const float4*)(qp + ks * 32), *(const float4*)(qp + ks * 32 + 4), hi, lo); Bh[ks] = as_bf16x8(hi); Bl[ks] = as_bf16x8(lo); }
                float v[32];
#pragma unroll
                for (int kt = 0; kt < 8; ++kt) {
                    f32x4_t acc = {0.f, 0.f, 0.f, 0.f};
#pragma unroll
                    for (int ks = 0; ks < 4; ++ks) {
                        const bf16x8_t Ah = as_bf16x8(SK[(((pp * 8 + kt) * 4 + ks) * 2) * 64 + lane]), Al = as_bf16x8(SK[(((pp * 8 + kt) * 4 + ks) * 2 + 1) * 64 + lane]);
                        acc = __builtin_amdgcn_mfma_f32_16x16x32_bf16(Ah, Bh[ks], acc, 0, 0, 0);
                        acc = __builtin_amdgcn_mfma_f32_16x16x32_bf16(Ah, Bl[ks], acc, 0, 0, 0);
                        acc = __builtin_amdgcn_mfma_f32_16x16x32_bf16(Al, Bh[ks], acc, 0, 0, 0);
                    }
#pragma unroll
                    for (int r = 0; r < 4; ++r) v[kt * 4 + r] = __uint_as_float((__float_as_uint(acc[r]) & ~127u) | (unsigned)(kt * 16 + qd * 4 + r));
                    __builtin_amdgcn_sched_barrier(0);
                }
#pragma unroll
                for (int r = 0; r < 16; ++r) {
                    float m = v[0];
#pragma unroll
                    for (int u = 1; u < 32; ++u) m = fmaxf(m, v[u]);
                    m = fmaxf(m, __shfl_xor(m, 16)); m = fmaxf(m, __shfl_xor(m, 32));
                    v12[pp][r] = m;
#pragma unroll
                    for (int u = 0; u < 32; ++u) v[u] = (v[u] == m) ? NEG : v[u];
                }
            }
            float c[13]; unsigned pay[13];
#pragma unroll
            for (int s = 0; s < 13; ++s) {
                float cq[4]; unsigned pq[4];
#pragma unroll
                for (int q = 0; q < 4; ++q) {
                    const int pi = 4 * s + q; const int a = PAIRS.a[pi], b = PAIRS.b[pi];
                    if (a >= 0) {
                        const float sum = v12[0][a] + v12[1][b];
                        cq[q] = __uint_as_float((__float_as_uint(sum) & ~63u) | (unsigned)pi);
                        pq[q] = (__float_as_uint(v12[0][a]) & 127u) * 128u + (__float_as_uint(v12[1][b]) & 127u);
                    } else { cq[q] = NEG; pq[q] = 0u; }
                }
                c[s] = qd == 0 ? cq[0] : qd == 1 ? cq[1] : qd == 2 ? cq[2] : cq[3];
                pay[s] = qd == 0 ? pq[0] : qd == 1 ? pq[1] : qd == 2 ? pq[2] : pq[3];
            }
            float top[16]; unsigned eid[16];
#pragma unroll
            for (int r = 0; r < 16; ++r) {
                float m = c[0];
#pragma unroll
                for (int s = 1; s < 13; ++s) m = fmaxf(m, c[s]);
                m = fmaxf(m, __shfl_xor(m, 16)); m = fmaxf(m, __shfl_xor(m, 32));
                unsigned pw = 0u;
#pragma unroll
                for (int s = 0; s < 13; ++s) { const bool eq = (c[s] == m); pw |= eq ? pay[s] : 0u; c[s] = eq ? NEG : c[s]; }
                pw |= (unsigned)__shfl_xor((int)pw, 16); pw |= (unsigned)__shfl_xor((int)pw, 32);
                top[r] = m; eid[r] = pw;
            }
            float sum = 0.f; const float mx = top[0];
#pragma unroll
            for (int r = 0; r < 16; ++r) { top[r] = expf(top[r] - mx); sum += top[r]; }
            const float inv = 1.0f / sum;
            if (lane < 16) {
                int4* ep = (int4*)(p.eidx + (size_t)tok * 128 + h * 16); float4* gp = (float4*)(p.gatev + (size_t)tok * 128 + h * 16);
#pragma unroll
                for (int q = 0; q < 4; ++q) {
                    ep[q] = make_int4((int)eid[4 * q], (int)eid[4 * q + 1], (int)eid[4 * q + 2], (int)eid[4 * q + 3]);
                    gp[q] = make_float4(top[4 * q] * inv, top[4 * q + 1] * inv, top[4 * q + 2] * inv, top[4 * q + 3] * inv);
                }
            }
        }
    }
    __syncthreads();
}

typedef float f32x32_t __attribute__((ext_vector_type(32)));
typedef unsigned u32x6_t __attribute__((ext_vector_type(6)));
__device__ __forceinline__ void peer_load4(const unsigned char* tab, const int (&e)[4], int lane, uint2 (&R)[4][3]) {
#pragma unroll
    for (int i = 0; i < 4; ++i) { const uint2* r = (const uint2*)(tab + (size_t)e[i] * ROW6 + lane * 24); R[i][0] = r[0]; R[i][1] = r[1]; R[i][2] = r[2]; }
}
__device__ __forceinline__ f32x32_t dec6(const uint2 (&R)[3]) { const u32x6_t w = {R[0].x, R[0].y, R[1].x, R[1].y, R[2].x, R[2].y}; return __builtin_amdgcn_cvt_scalef32_pk32_f32_fp6(w, 1.0f); }
__device__ __forceinline__ void ph_peer3(const Params& p, const float* x1, const bf16_t* h2, int bid, int nb) {
    const int tid = tid_(), wave = tid >> 6, lane = tid & 63;
    for (int t = bid * 8 + wave; t < NTOK; t += nb * 8) {
        const int b = t / SQ;
        float hv[32], y[32];
#pragma unroll
        for (int q = 0; q < 4; ++q) { const uint4 w = *(const uint4*)(h2 + (size_t)t * DM + lane * 32 + 8 * q); float* d = hv + 8 * q;
            d[0] = bflo(w.x); d[1] = bfhi(w.x); d[2] = bflo(w.y); d[3] = bfhi(w.y); d[4] = bflo(w.z); d[5] = bfhi(w.z); d[6] = bflo(w.w); d[7] = bfhi(w.w); }
#pragma unroll
        for (int i = 0; i < 32; ++i) y[i] = 0.f;
        const int e0 = p.eidx[(size_t)t * 128 + lane], e1 = p.eidx[(size_t)t * 128 + 64 + lane];
        const float g0 = p.gatev[(size_t)t * 128 + lane], g1 = p.gatev[(size_t)t * 128 + 64 + lane];
        const float su0 = p.su[e0], su1 = p.su[e1];
        const float gv0 = g0 * p.sv[e0], gv1 = g1 * p.sv[e1];
        uint2 Uc[4][3], Un[4][3], Vc[4][3];
        { int e[4];
#pragma unroll
          for (int i = 0; i < 4; ++i) e[i] = __builtin_amdgcn_readlane(e0, i);
          peer_load4(p.U8, e, lane, Uc); }
        for (int g = 0; g < 32; ++g) {
            const bool lo = g < 16; const int k0 = (4 * g) & 63;
            const int ee = lo ? e0 : e1; const float suu = lo ? su0 : su1, gvv = lo ? gv0 : gv1;
            int e[4]; float sa[4], gw[4];
#pragma unroll
            for (int i = 0; i < 4; ++i) { e[i] = __builtin_amdgcn_readlane(ee, k0 + i);
                sa[i] = __uint_as_float(__builtin_amdgcn_readlane(__float_as_uint(suu), k0 + i)); gw[i] = __uint_as_float(__builtin_amdgcn_readlane(__float_as_uint(gvv), k0 + i)); }
            peer_load4(p.V8, e, lane, Vc);
            {
                const int gn = (g < 31) ? g + 1 : g; const int en = (gn < 16) ? e0 : e1; const int kn = (4 * gn) & 63; int e2[4];
#pragma unroll
                for (int i = 0; i < 4; ++i) e2[i] = __builtin_amdgcn_readlane(en, kn + i);
                peer_load4(p.U8, e2, lane, Un);
            }
            float a[4];
#pragma unroll
            for (int i = 0; i < 4; ++i) {
                const f32x32_t d = dec6(Uc[i]);
                float acc0 = 0.f, acc1 = 0.f;
#pragma unroll
                for (int k = 0; k < 32; k += 2) { acc0 += d[k] * hv[k]; acc1 += d[k + 1] * hv[k + 1]; }
                a[i] = acc0 + acc1;
            }
#pragma unroll
            for (int o = 1; o < 64; o <<= 1) { a[0] += __shfl_xor(a[0], o); a[1] += __shfl_xor(a[1], o); a[2] += __shfl_xor(a[2], o); a[3] += __shfl_xor(a[3], o); }
#pragma unroll
            for (int i = 0; i < 4; ++i) {
                const float wgt = geluf_(a[i] * sa[i]) * gw[i];
                const f32x32_t d = dec6(Vc[i]);
#pragma unroll
                for (int k = 0; k < 32; ++k) y[k] += wgt * d[k];
            }
#pragma unroll
            for (int i = 0; i < 4; ++i) { Uc[i][0] = Un[i][0]; Uc[i][1] = Un[i][1]; Uc[i][2] = Un[i][2]; }
        }
        float ss = 0.f;
#pragma unroll
        for (int q = 0; q < 8; ++q) {
            const int c = lane * 32 + 4 * q;
            const float4 xv = *(const float4*)(x1 + (size_t)t * DM + c);
            const float4 ga = *(const float4*)(p.ada + b * NMOD + 5 * DM + c);
            float* yy = y + 4 * q;
            yy[0] = xv.x + ga.x * yy[0]; yy[1] = xv.y + ga.y * yy[1]; yy[2] = xv.z + ga.z * yy[2]; yy[3] = xv.w + ga.w * yy[3];
            ss += yy[0] * yy[0] + yy[1] * yy[1] + yy[2] * yy[2] + yy[3] * yy[3];
        }
        ss = wave_sum(ss);
        const float rs = 1.0f / sqrtf(ss * (1.0f / DM) + 1e-6f);
#pragma unroll
        for (int q = 0; q < 8; ++q) {
            const int c = lane * 32 + 4 * q;
            const float4 gf = *(const float4*)(p.norm_f_g + c);
            const float* yy = y + 4 * q;
            *(float4*)(p.out + (size_t)t * DM + c) = make_float4(yy[0] * rs * gf.x, yy[1] * rs * gf.y, yy[2] * rs * gf.z, yy[3] * rs * gf.w);
        }
    }
}

#define LAS __attribute__((address_space(3)))
#define XB_TMO      128
#define XB_XCNT(j)  (256  + 64 * (j))
#define XB_XSUB(j)  (1280 + 64 * (j))
#define XB_XGEN(j)  (2304 + 64 * (j))
#define XB_TOP      3328
#define XB_TOPGEN   3392
#define XCD_BAR_WORDS 3456
#define XB_SPIN_CAP (1u << 18)

__device__ __forceinline__ unsigned xb_ld(unsigned* p)              { return __hip_atomic_load(p, __ATOMIC_RELAXED, __HIP_MEMORY_SCOPE_AGENT); }
__device__ __forceinline__ unsigned xb_add(unsigned* p, unsigned v) { return __hip_atomic_fetch_add(p, v, __ATOMIC_RELAXED, __HIP_MEMORY_SCOPE_AGENT); }
__device__ __forceinline__ unsigned xb_xcc_id() { return (unsigned)__builtin_amdgcn_s_getreg((3 << 11) | 20) & 0xFu; }
#define XB_SPIN(cond, bar) do { unsigned _sp = 0; while (cond) { __builtin_amdgcn_s_sleep(1); \
    if ((++_sp & 255u) == 0u) { if (xb_ld(&(bar)[XB_TMO])) break; if (_sp > XB_SPIN_CAP) { atomicAdd(&(bar)[XB_TMO], 1u); break; } } } } while (0)

struct XcdBarrier {
    unsigned* bar; unsigned x;
    volatile LAS unsigned* st;
};

__device__ __forceinline__ XcdBarrier xcd_barrier_post(unsigned* bar, volatile LAS unsigned* st) {
    XcdBarrier b; b.bar = bar; b.x = xb_xcc_id(); b.st = st;
    if (threadIdx.x == 0) (void)xb_add(&bar[XB_XCNT(b.x)], 1u);
    return b;
}
__device__ __forceinline__ void xcd_barrier_complete(unsigned* bar, unsigned x, unsigned& nloc, unsigned& nx) {
    const unsigned G = gridDim.x * gridDim.y * gridDim.z;
    unsigned sum, cnt, mine, sp = 0u;
    for (;;) {
        sum = 0u; cnt = 0u; mine = 0u;
#pragma unroll
        for (unsigned j = 0; j < 16; ++j) { const unsigned c = xb_ld(&bar[XB_XCNT(j)]); sum += c; cnt += (c > 0u) ? 1u : 0u; mine = (j == x) ? c : mine; }
        if (sum == G) break;
        __builtin_amdgcn_s_sleep(1);
        if ((++sp & 255u) == 0u) { if (xb_ld(&bar[XB_TMO])) break; if (sp > XB_SPIN_CAP) { atomicAdd(&bar[XB_TMO], 1u); break; } }
    }
    nloc = mine > 0u ? mine : 1u; nx = cnt > 0u ? cnt : 1u;
}

__device__ __forceinline__ void xcd_barrier(const XcdBarrier& b) {
    asm volatile("s_waitcnt vmcnt(0)" ::: "memory");
    __syncthreads();
    if (threadIdx.x == 0) {
        unsigned* bar = b.bar;
        __builtin_amdgcn_s_waitcnt(0);
        unsigned nloc = b.st[0], nx = b.st[1];
        if (nloc == 0u) { xcd_barrier_complete(bar, b.x, nloc, nx); b.st[0] = nloc; b.st[1] = nx; }
        const unsigned old = xb_add(&bar[XB_XSUB(b.x)], 1u);
        const unsigned gen = old / nloc;
        if (old + 1u == (gen + 1u) * nloc) {
            __builtin_amdgcn_fence(__ATOMIC_RELEASE, "agent");
            asm volatile("s_waitcnt vmcnt(0)" ::: "memory");
            const unsigned og = xb_add(&bar[XB_TOP], 1u);
            const unsigned tg = og / nx;
            if (og + 1u == (tg + 1u) * nx) xb_add(&bar[XB_TOPGEN], 1u);
            else XB_SPIN(xb_ld(&bar[XB_TOPGEN]) == tg, bar);
            __builtin_amdgcn_fence(__ATOMIC_ACQUIRE, "agent");
            xb_add(&bar[XB_XGEN(b.x)], 1u);
            asm volatile("s_waitcnt vmcnt(0)" ::: "memory");
        } else {
            XB_SPIN(xb_ld(&bar[XB_XGEN(b.x)]) == gen, bar);
            __builtin_amdgcn_fence(__ATOMIC_ACQUIRE, "agent");
            asm volatile("s_waitcnt vmcnt(0)" ::: "memory");
        }
    }
    __syncthreads();
}

template <class Epi>
__device__ __forceinline__ void gemm_run(float* lds, const bf16_t* A, const bf16_t* Bt, int M, int N, int K, const Epi& E) {
    __syncthreads();
    pg8::Gemm g{A, Bt, M, N, K}; pg8::StaticOrder S; S.init(M, N, (int)gridDim.x, (int)blockIdx.x);
    pg8::gemm_phase<Epi, pg8::StaticOrder, true, true>((PG8_LAS unsigned char*)lds, g, S, E);
    __syncthreads();
}
constexpr int NPHASE = 11;
template <int PH>
__device__ __forceinline__ void run_phase(const Params& p, int bid, int nb, float* lds) {
    asm volatile("" : "+s"(bid));
    if constexpr (PH == 0) ph_prep(p, bid, nb, lds);
    if constexpr (PH == 1) ph_modnorm(p, p.x, p.norm1_g, 0 * DM, 1 * DM, p.hb, bid, nb, lds);
    if constexpr (PH == 2) gemm_run(lds, p.hb, p.Wt1, NTOK, ZW, DM, pg8::EpiZG{p.ZG, p.b_bg});
    if constexpr (PH == 3) { ph_retprep(p, bid, nb, lds); ph_gmlp2(p, bid, nb, lds); }
    if constexpr (PH == 11) ph_ret2(p, bid, nb, lds);
    if constexpr (PH == 4) ph_gn(p, bid, nb, lds);
    if constexpr (PH == 5) {
        gemm_run(lds, p.yain, p.Wta, NTOK, DM, 1024, pg8::EpiMixB<0>{p.hb, p.ZG, 0});
        gemm_run(lds, p.ybin, p.Wtb, NTOK, DM, DM, pg8::EpiMixB<1>{p.hb, p.ZG, 2048});
    }
    if constexpr (PH == 6) gemm_run(lds, p.hb, p.Wto, NTOK, DM, DM, pg8::EpiResF{p.obuf, p.x, p.ada + 2 * DM});
    if constexpr (PH == 7) { ph_modnorm(p, p.obuf, p.norm2_g, 3 * DM, 4 * DM, p.hb, bid, nb, lds); ph_tabconv(p, bid, nb); }
    if constexpr (PH == 8) gemm_run(lds, p.hb, p.Wtq, NTOK, DM, DM, pg8::EpiF32{p.qbuf, DM});
    if constexpr (PH == 9) ph_topk2(p, p.qbuf, bid, nb, lds);
    if constexpr (PH == 10) ph_peer3(p, p.obuf, p.hb, bid, nb);
}

constexpr int MISC_OFF = 132 * 1024;
__global__ void __launch_bounds__(NTH) k_mega(Params p) {
    extern __shared__ __attribute__((aligned(16))) float lds[];
    cg::grid_group grid = cg::this_grid();
    const int bid = blockIdx.x, nb = gridDim.x;
    volatile LAS unsigned* misc = (volatile LAS unsigned*)((LAS unsigned char*)lds + MISC_OFF);
    if (threadIdx.x < 4) misc[threadIdx.x] = 0u;
    __syncthreads();
    XcdBarrier bar = xcd_barrier_post(p.bar, misc);
    run_phase<0>(p, bid, nb, lds); grid.sync();
    run_phase<1>(p, bid, nb, lds); xcd_barrier(bar);
    run_phase<2>(p, bid, nb, lds); xcd_barrier(bar);
    run_phase<3>(p, bid, nb, lds); xcd_barrier(bar);
    run_phase<11>(p, bid, nb, lds); xcd_barrier(bar);
    run_phase<4>(p, bid, nb, lds); xcd_barrier(bar);
    run_phase<5>(p, bid, nb, lds); xcd_barrier(bar);
    run_phase<6>(p, bid, nb, lds); xcd_barrier(bar);
    run_phase<7>(p, bid, nb, lds); xcd_barrier(bar);
    run_phase<8>(p, bid, nb, lds); xcd_barrier(bar);
    run_phase<9>(p, bid, nb, lds); xcd_barrier(bar);
    run_phase<10>(p, bid, nb, lds);
}

extern "C" void kernel_launch(void* const* d_in, const int* in_sizes, int n_in, void* d_out, int out_size, void* d_ws, size_t ws_size, hipStream_t stream) {
    Params p{};
    p.x = (const float*)d_in[0]; p.c = (const float*)d_in[1]; p.pos = (const int*)d_in[2];
    p.w_ada = (const float*)d_in[3]; p.b_ada = (const float*)d_in[4]; p.norm1_g = (const float*)d_in[5]; p.w_in = (const float*)d_in[6];
    p.w_bg = (const float*)d_in[7]; p.b_bg = (const float*)d_in[8]; p.gm_v_g = (const float*)d_in[9]; p.gm_ws = (const float*)d_in[10];
    p.gm_b = (const float*)d_in[11]; p.ret_gn_g = (const float*)d_in[12]; p.w_a_out = (const float*)d_in[13]; p.w_b_out = (const float*)d_in[14];
    p.w_o = (const float*)d_in[15]; p.norm2_g = (const float*)d_in[16]; p.peer_wq = (const float*)d_in[17]; p.peer_sk = (const float*)d_in[18];
    p.peer_u = (const float*)d_in[19]; p.peer_v = (const float*)d_in[20]; p.norm_f_g = (const float*)d_in[21];
    p.out = (float*)d_out;
    char* w = (char*)d_ws; size_t off = 0;
    auto take = [&](size_t bytes) { char* r = w + off; off += (bytes + 255) & ~(size_t)255; return r; };
    p.bar = (unsigned*)take(XCD_BAR_WORDS * 4);
    p.ada = (float*)take(2 * NMOD * 4);
    p.rope = (float*)take((size_t)NTOK * 128 * 4);
    p.eidx = (int*)take((size_t)NTOK * 128 * 4);
    p.gatev = (float*)take((size_t)NTOK * 128 * 4);
    p.Wt1 = (bf16_t*)take((size_t)ZW * DM * 2);
    p.Wta = (bf16_t*)take((size_t)DM * 1024 * 2);
    p.Wtb = (bf16_t*)take((size_t)DM * DM * 2);
    p.Wto = (bf16_t*)take((size_t)DM * DM * 2);
    p.Wtq = (bf16_t*)take((size_t)DM * DM * 2);
    p.hb = (bf16_t*)take((size_t)NTOK * DM * 2);
    p.ZG = (bf16_t*)take((size_t)NTOK * ZW * 2);
    p.qbuf = (float*)p.ZG;
    p.obuf = (float*)take((size_t)NTOK * DM * 4);
    p.ybin = (bf16_t*)take((size_t)NTOK * DM * 2);
    p.yain = (bf16_t*)take((size_t)NTOK * 1024 * 2);
    p.U8 = (unsigned char*)p.ZG + (size_t)NTOK * DM * 4;
    p.V8 = p.U8 + (size_t)16384 * ROW6;
    p.su = (float*)take(16384 * 4); p.sv = (float*)take(16384 * 4);
    p.Qr = (bf16_t*)take((size_t)NTOK * 1024 * 2);
    p.Kr = (bf16_t*)take((size_t)NTOK * 1024 * 2);
    p.KTd = (bf16_t*)take((size_t)NTOK * 1024 * 2);
    p.Vt = (bf16_t*)take((size_t)NTOK * 2048 * 2);
    p.ob16 = (bf16_t*)take((size_t)NTOK * DM * 2);
    if (off > ws_size) { fprintf(stderr, "kernel_launch: workspace too small: need %zu have %zu\n", off, ws_size); return; }
    static int grid = 0;
    if (!grid) {
        int dev = 0, cus = 0, per_cu = 0;
        (void)hipGetDevice(&dev); (void)hipDeviceGetAttribute(&cus, hipDeviceAttributeMultiprocessorCount, dev);
        (void)hipFuncSetAttribute((const void*)k_mega, hipFuncAttributeMaxDynamicSharedMemorySize, LDS_BYTES);
        (void)hipOccupancyMaxActiveBlocksPerMultiprocessor(&per_cu, k_mega, NTH, LDS_BYTES);
        if (per_cu < 1) per_cu = 1;
        grid = cus * per_cu;
    }
    (void)hipMemsetAsync(p.bar, 0, XCD_BAR_WORDS * 4, stream);
    void* args[] = {&p};
    hipError_t e = hipLaunchCooperativeKernel((const void*)k_mega, dim3(grid), dim3(NTH), args, LDS_BYTES, stream);
    if (e != hipSuccess) fprintf(stderr, "cooperative launch failed: %s (grid %d)\n", hipGetErrorString(e), grid);
}
```

```cpp
#include <hip/hip_runtime.h>
#include <hip/hip_cooperative_groups.h>
#include <stdint.h>
#include <math.h>
#include <cstdio>

namespace cg = cooperative_groups;

constexpr int DM = 2048;
constexpr int SQ = 4096;
constexpr int NTOK = 8192;
constexpr int NTH = 512;
constexpr int ZW = 12288;
constexpr int NMOD = 12288;
constexpr int LDS_BYTES = 136 * 1024;

typedef unsigned short bf16_t;

struct Params {
    const float *x, *c; const int* pos;
    const float *w_ada, *b_ada, *norm1_g, *w_in, *w_bg, *b_bg, *gm_v_g, *gm_ws, *gm_b, *ret_gn_g, *w_a_out, *w_b_out, *w_o, *norm2_g,
                *peer_wq, *peer_sk, *peer_u, *peer_v, *norm_f_g;
    float* out;
    float *ada, *rope, *gatev; int* eidx;
    bf16_t *Wt1, *Wta, *Wtb, *Wto, *Wtq;
    bf16_t *hb;
    bf16_t *ZG;
    float *obuf;
    bf16_t *ybin, *yain;
    float *qbuf;
    unsigned char *U8, *V8;
    float *su, *sv;
    bf16_t *Qr, *Kr, *KTd, *Vt;
    bf16_t *ob16;
    unsigned *bar;
};

__constant__ float c_freq[64] = {
1.000000000e+00f, 8.659643531e-01f, 7.498942018e-01f, 6.493816376e-01f, 5.623413324e-01f, 4.869675338e-01f, 4.216965139e-01f, 3.651741147e-01f, 3.162277639e-01f, 2.738419771e-01f, 2.371373773e-01f, 2.053525001e-01f, 1.778279394e-01f, 1.539926529e-01f, 1.333521456e-01f, 1.154781953e-01f, 1.000000015e-01f, 8.659642935e-02f, 7.498942316e-02f, 6.493816525e-02f, 5.623413250e-02f, 4.869675264e-02f, 4.216964915e-02f, 3.651741147e-02f, 3.162277490e-02f, 2.738419548e-02f, 2.371373773e-02f, 2.053525113e-02f, 1.778279431e-02f, 1.539926510e-02f, 1.333521400e-02f, 1.154781971e-02f, 9.999999776e-03f, 8.659643121e-03f, 7.498942316e-03f, 6.493816152e-03f, 5.623413250e-03f, 4.869675264e-03f, 4.216964822e-03f, 3.651741194e-03f, 3.162277630e-03f, 2.738419687e-03f, 2.371373819e-03f, 2.053525066e-03f, 1.778279431e-03f, 1.539926510e-03f, 1.333521446e-03f, 1.154782018e-03f, 1.000000047e-03f, 8.659643354e-04f, 7.498941850e-04f, 6.493816036e-04f, 5.623413017e-04f, 4.869675322e-04f, 4.216965172e-04f, 3.651741135e-04f, 3.162277571e-04f, 2.738419571e-04f, 2.371373703e-04f, 2.053525095e-04f, 1.778279402e-04f, 1.539926598e-04f, 1.333521504e-04f, 1.154782003e-04f };

__device__ __forceinline__ int tid_() { int t = threadIdx.x; asm volatile("" : "+v"(t)); return t; }
__device__ __forceinline__ float wave_sum(float v) {
#pragma unroll
    for (int o = 1; o < 64; o <<= 1) v += __shfl_xor(v, o);
    return v;
}
__device__ __forceinline__ float wave_max(float v) {
#pragma unroll
    for (int o = 1; o < 64; o <<= 1) v = fmaxf(v, __shfl_xor(v, o));
    return v;
}
__device__ __forceinline__ float sigmoidf_(float x) { return 1.0f / (1.0f + expf(-x)); }
__device__ __forceinline__ float siluf_(float x) { return x * sigmoidf_(x); }
__device__ __forceinline__ float geluf_(float x) { return 0.5f * x * (1.0f + erff(x * 0.70710678118654752f)); }
__device__ __forceinline__ float dot4(float4 a, float4 b) { return a.x * b.x + a.y * b.y + a.z * b.z + a.w * b.w; }
__device__ __forceinline__ float bf2f(bf16_t v) { return __uint_as_float((unsigned)v << 16); }
__device__ __forceinline__ float bflo(unsigned w) { return __uint_as_float(w << 16); }
__device__ __forceinline__ float bfhi(unsigned w) { return __uint_as_float(w & 0xffff0000u); }
__device__ __forceinline__ unsigned f2bf(float f) { unsigned u = __float_as_uint(f); return (u + 0x7fffu + ((u >> 16) & 1u)) >> 16; }
__device__ __forceinline__ unsigned pk2(float lo, float hi) { return f2bf(lo) | (f2bf(hi) << 16); }

__device__ __forceinline__ void sincos_acc(float ang, float& s, float& c) {
    const double x = (double)ang;
    const double k = rint(x * 0.63661977236758134308);
    double r = fma(-k, 1.57079632679489655800, x); r = fma(-k, 6.12323399573676603587e-17, r);
    const double r2 = r * r;
    const double sp = r * (1.0 + r2 * (-1.0 / 6.0 + r2 * (1.0 / 120.0 + r2 * (-1.0 / 5040.0 + r2 * (1.0 / 362880.0 + r2 * (-1.0 / 39916800.0 + r2 * (1.0 / 6227020800.0)))))));
    const double cp = 1.0 + r2 * (-0.5 + r2 * (1.0 / 24.0 + r2 * (-1.0 / 720.0 + r2 * (1.0 / 40320.0 + r2 * (-1.0 / 3628800.0 + r2 * (1.0 / 479001600.0 + r2 * (-1.0 / 87178291200.0)))))));
    const int q = ((int)k) & 3;
    const float fs = (float)sp, fc = (float)cp;
    s = (q == 0) ? fs : (q == 1) ? fc : (q == 2) ? -fs : -fc;
    c = (q == 0) ? fc : (q == 1) ? -fs : (q == 2) ? -fc : fs;
}

namespace pg8 {
#define PG8_LAS __attribute__((address_space(3)))
typedef unsigned short bf16_t;
typedef short bf16x8 __attribute__((ext_vector_type(8)));
typedef float f32x4 __attribute__((ext_vector_type(4)));
typedef unsigned u32x4 __attribute__((ext_vector_type(4)));
constexpr int BM = 256, BK = 64, HALF = 128, HTB = HALF * BK * 2  , STAGE_BYTES = 8 * HTB, NXCD = 8, WGM = 8;

__host__ __device__ __forceinline__ int lds_byte(int r, int c) { const int st = (r >> 4) * 2 + (c >> 5), rr = r & 15, cc = c & 31, ob = rr * 64 + cc * 2; return st * 1024 + (ob ^ (((ob >> 9) & 1) << 5)); }
__host__ __device__ __forceinline__ void stage_rc(int b, int& R, int& C) { const int st = b / 1024, sb = b % 1024, swz = sb ^ (((sb >> 9) & 1) << 5); R = (st >> 1) * 16 + swz / 64; C = (st & 1) * 32 + (swz % 64) / 2; }
__host__ __device__ __forceinline__ int perm32(int rho) { const int n = rho >> 4, i = rho & 15; return 8 * (i >> 2) + 4 * n + (i & 3); }

struct Unit { int pm, pn; };
struct Gemm { const bf16_t* A; const bf16_t* Bt; int M, N, K; };

struct StaticOrder {
    int nM, nN, nwg, G, c;
    __host__ __device__ void init(int M, int N, int G_, int c_) { nM = M / BM; nN = N / BM; nwg = nM * nN; G = G_; c = c_; }
    __host__ __device__ bool next(int i, Unit& u) const {
        const long L = (long)i * G + c; if (L >= nwg) return false;
        int wgid = (int)L; { const int q = nwg / NXCD, r = nwg % NXCD, xcd = wgid % NXCD, off = wgid / NXCD; wgid = (xcd < r ? xcd * (q + 1) : r * (q + 1) + (xcd - r) * q) + off; }
        const int nig = WGM * nN, gid = wgid / nig, fm = gid * WGM, gsz = (nM - fm) < WGM ? (nM - fm) : WGM;
        u.pm = fm + ((wgid % nig) % gsz); u.pn = (wgid % nig) / gsz; return true;
    }
    __device__ __forceinline__ void a_ready(const Unit&) const {}
    __device__ __forceinline__ void done(const Unit&) const {}
};

__device__ __forceinline__ unsigned cvt_pk_bf16(float lo, float hi) { unsigned r; asm volatile("v_cvt_pk_bf16_f32 %0, %1, %2" : "=v"(r) : "v"(lo), "v"(hi)); return r; }
typedef float f32x2 __attribute__((ext_vector_type(2)));
__device__ __forceinline__ f32x2 gelu_pk(f32x2 v) {
    const f32x2 av = __builtin_elementwise_abs(v), d = av * 0.2316418882f + 1.0f;
    f32x2 t; t.x = __builtin_amdgcn_rcpf(d.x); t.y = __builtin_amdgcn_rcpf(d.y);
    f32x2 q = t * 0.5307027145f + (-0.7265760135f); q = q * t + 0.7107068705f; q = q * t + (-0.142248368f); q = q * t + 0.127414796f; q = q * t;
    const f32x2 s = (v * v) * (-0.72134752044f);
    f32x2 e; e.x = __builtin_amdgcn_exp2f(s.x); e.y = __builtin_amdgcn_exp2f(s.y);
    const f32x2 m = v * (q * e), r = v - m;
    f32x2 o; o.x = v.x < 0.f ? m.x : r.x; o.y = v.y < 0.f ? m.y : r.y; return o;
}

typedef unsigned u32x2v __attribute__((ext_vector_type(2)));
struct EpiZG {
    static constexpr bool PERM = true, AFTER_DRAIN = false;
    bf16_t* O; const float* bias;
    __device__ __forceinline__ void operator()(const f32x4 (&acc)[2][2][4][2], const Unit& u, int wr, int wc, int fr, int fq) const {
        const int row0 = u.pm * BM + wr * 64 + fr, col0 = u.pn * BM + wc * 32 + 8 * fq;
        const int mode = u.pn < 8 ? 1 : (u.pn < 32 ? 0 : 2);
        f32x4 bv[2][2];
#pragma unroll
        for (int bj = 0; bj < 2; ++bj)
#pragma unroll
            for (int n = 0; n < 2; ++n) bv[bj][n] = (mode == 2) ? *(const f32x4*)(bias + (col0 - 8192) + bj * HALF + 4 * n) : (f32x4){0.f, 0.f, 0.f, 0.f};
#pragma unroll
        for (int ai = 0; ai < 2; ++ai)
#pragma unroll
            for (int m = 0; m < 4; ++m) { bf16_t* rowp = O + (size_t)(row0 + ai * HALF + m * 16) * ZW + col0;
#pragma unroll
                for (int bj = 0; bj < 2; ++bj) { f32x4 v0 = acc[ai][bj][m][0], v1 = acc[ai][bj][m][1];
                    if (mode == 1) { f32x2 a = gelu_pk((f32x2){v0[0], v0[1]}), b = gelu_pk((f32x2){v0[2], v0[3]}), c = gelu_pk((f32x2){v1[0], v1[1]}), d = gelu_pk((f32x2){v1[2], v1[3]});
                        v0 = (f32x4){a.x, a.y, b.x, b.y}; v1 = (f32x4){c.x, c.y, d.x, d.y}; }
                    if (mode == 2) { v0 = v0 + bv[bj][0]; v1 = v1 + bv[bj][1];
#pragma unroll
                        for (int e = 0; e < 4; ++e) { v0[e] = __builtin_amdgcn_rcpf(1.0f + __expf(-v0[e])); v1[e] = __builtin_amdgcn_rcpf(1.0f + __expf(-v1[e])); } }
                    u32x4 w; w.x = cvt_pk_bf16(v0[0], v0[1]); w.y = cvt_pk_bf16(v0[2], v0[3]); w.z = cvt_pk_bf16(v1[0], v1[1]); w.w = cvt_pk_bf16(v1[2], v1[3]);
                    *(u32x4*)(rowp + bj * HALF) = w; } }
    }
};
template <int ACCUM> struct EpiMixB {
    static constexpr bool PERM = true, AFTER_DRAIN = false;
    bf16_t* Mo; const bf16_t* ZGp; int goff;
    __device__ __forceinline__ void operator()(const f32x4 (&acc)[2][2][4][2], const Unit& u, int wr, int wc, int fr, int fq) const {
        const int row0 = u.pm * BM + wr * 64 + fr, col0 = u.pn * BM + wc * 32 + 8 * fq;
#pragma unroll
        for (int ai = 0; ai < 2; ++ai)
#pragma unroll
            for (int m = 0; m < 4; ++m) { const size_t row = (size_t)(row0 + ai * HALF + m * 16);
#pragma unroll
                for (int bj = 0; bj < 2; ++bj) { const f32x4 v0 = acc[ai][bj][m][0], v1 = acc[ai][bj][m][1];
                    const u32x4 g = *(const u32x4*)(ZGp + row * ZW + 8192 + goff + col0 + bj * HALF);
                    float o[8];
                    o[0] = bflo(g.x) * v0[0]; o[1] = bfhi(g.x) * v0[1]; o[2] = bflo(g.y) * v0[2]; o[3] = bfhi(g.y) * v0[3];
                    o[4] = bflo(g.z) * v1[0]; o[5] = bfhi(g.z) * v1[1]; o[6] = bflo(g.w) * v1[2]; o[7] = bfhi(g.w) * v1[3];
                    bf16_t* mp = Mo + row * DM + col0 + bj * HALF;
                    if (ACCUM) { const u32x4 old = *(const u32x4*)mp;
                        o[0] += bflo(old.x); o[1] += bfhi(old.x); o[2] += bflo(old.y); o[3] += bfhi(old.y); o[4] += bflo(old.z); o[5] += bfhi(old.z); o[6] += bflo(old.w); o[7] += bfhi(old.w); }
                    u32x4 w; w.x = cvt_pk_bf16(o[0], o[1]); w.y = cvt_pk_bf16(o[2], o[3]); w.z = cvt_pk_bf16(o[4], o[5]); w.w = cvt_pk_bf16(o[6], o[7]);
                    *(u32x4*)mp = w; } }
    }
};
struct EpiResF {
    static constexpr bool PERM = false, AFTER_DRAIN = false;
    float* x1; const float* x; const float* ga;
    __device__ __forceinline__ void operator()(const f32x4 (&acc)[2][2][4][2], const Unit& u, int wr, int wc, int fr, int fq) const {
        const int row0 = u.pm * BM + wr * 64 + fr, col0 = u.pn * BM + wc * 32 + 4 * fq;
        const int b = (u.pm * BM) / SQ;
        f32x4 gv[2][2];
#pragma unroll
        for (int bj = 0; bj < 2; ++bj)
#pragma unroll
            for (int n = 0; n < 2; ++n) gv[bj][n] = *(const f32x4*)(ga + b * NMOD + col0 + bj * HALF + n * 16);
#pragma unroll
        for (int ai = 0; ai < 2; ++ai)
#pragma unroll
            for (int m = 0; m < 4; ++m) { const size_t off = (size_t)(row0 + ai * HALF + m * 16) * DM + col0;
#pragma unroll
                for (int bj = 0; bj < 2; ++bj)
#pragma unroll
                    for (int n = 0; n < 2; ++n) { const f32x4 xv = *(const f32x4*)(x + off + bj * HALF + n * 16);
                        *(f32x4*)(x1 + off + bj * HALF + n * 16) = xv + gv[bj][n] * acc[ai][bj][m][n]; } }
    }
};
struct EpiF32 {
    static constexpr bool PERM = false, AFTER_DRAIN = false;
    float* O; int ldc;
    __device__ __forceinline__ void operator()(const f32x4 (&acc)[2][2][4][2], const Unit& u, int wr, int wc, int fr, int fq) const {
        const int row0 = u.pm * BM + wr * 64 + fr, col0 = u.pn * BM + wc * 32 + 4 * fq;
#pragma unroll
        for (int ai = 0; ai < 2; ++ai)
#pragma unroll
            for (int m = 0; m < 4; ++m) { const size_t off = (size_t)(row0 + ai * HALF + m * 16) * ldc + col0;
#pragma unroll
                for (int bj = 0; bj < 2; ++bj)
#pragma unroll
                    for (int n = 0; n < 2; ++n) *(f32x4*)(O + off + bj * HALF + n * 16) = acc[ai][bj][m][n]; }
    }
};

template <class Epi, class Sched, bool ALIGN_EPI = false, bool SP2 = false>
__device__ __forceinline__ void gemm_phase(PG8_LAS unsigned char* lds, const Gemm g, const Sched& S, const Epi& E) {
    const int tid = threadIdx.x, wid = __builtin_amdgcn_readfirstlane(tid >> 6), lane = tid & 63, wr = wid >> 2, wc = wid & 3, fr = lane & 15, fq = lane >> 4;
    const int K = g.K, nt = K / BK;
    unsigned voffA[2], voffB[2];
#pragma unroll
    for (int i = 0; i < 2; ++i) { int R, C; stage_rc(tid * 16 + i * 8192, R, C); const int Rb = Epi::PERM ? ((R & ~31) + perm32(R & 31)) : R;
        voffA[i] = (unsigned)(R * K + C) * 2u; voffB[i] = (unsigned)(Rb * K + C) * 2u; }
    const size_t kstep = (size_t)(BK * 2);
    const size_t hstep = (size_t)HALF * K * 2;
    const size_t tstep = 2 * hstep;
    const unsigned ldsw = (unsigned)wid * 1024u;
    const int aoff = lds_byte(wr * 64 + fr, fq * 8), boff = lds_byte(wc * 32 + fr, fq * 8);
#define PG8_SA(b, h) (((b) * 2 + (h)) * HTB)
#define PG8_SB(b, h) ((4 + (b) * 2 + (h)) * HTB)
#define PG8_STAGE(bufoff, gbase, voff) do { _Pragma("unroll") for (int _i = 0; _i < 2; ++_i) \
        __builtin_amdgcn_global_load_lds((const unsigned*)((const char*)(gbase) + (voff)[_i]), (PG8_LAS unsigned*)(lds + (bufoff) + ldsw + _i * 8192), 16, 0, 0); } while (0)
#define PG8_LDA(dst, b, h) do { _Pragma("unroll") for (int m = 0; m < 4; ++m) _Pragma("unroll") for (int k = 0; k < 2; ++k) dst[m][k] = *(const PG8_LAS bf16x8*)(lds + PG8_SA(b, h) + aoff + m * 2048 + k * 1024); } while (0)
#define PG8_LDB(dst, b, h) do { _Pragma("unroll") for (int n = 0; n < 2; ++n) _Pragma("unroll") for (int k = 0; k < 2; ++k) dst[n][k] = *(const PG8_LAS bf16x8*)(lds + PG8_SB(b, h) + boff + n * 2048 + k * 1024); } while (0)
#define PG8_MMA(ai, bj, At, Bt) do { __builtin_amdgcn_s_setprio(1); _Pragma("unroll") for (int m = 0; m < 4; ++m) _Pragma("unroll") for (int n = 0; n < 2; ++n) _Pragma("unroll") for (int k = 0; k < 2; ++k) \
        acc[ai][bj][m][n] = __builtin_amdgcn_mfma_f32_16x16x32_bf16(Bt[n][k], At[m][k], acc[ai][bj][m][n], 0, 0, 0); __builtin_amdgcn_s_setprio(0); } while (0)
#define PG8_WAIT_V(n) asm volatile("s_waitcnt vmcnt(" #n ")" ::: "memory")
#define PG8_WAIT_L(n) asm volatile("s_waitcnt lgkmcnt(" #n ")" ::: "memory")
#define PG8_BAR __builtin_amdgcn_s_barrier()
#define PG8_SCHED __builtin_amdgcn_sched_barrier(0)
    Unit cur, nxt; int ui = 0;
    if (!S.next(0, cur)) return;
    f32x4 acc[2][2][4][2];
#pragma unroll
    for (int a = 0; a < 2; ++a)
#pragma unroll
        for (int b = 0; b < 2; ++b)
#pragma unroll
            for (int m = 0; m < 4; ++m)
#pragma unroll
                for (int n = 0; n < 2; ++n) acc[a][b][m][n] = (f32x4){0.f, 0.f, 0.f, 0.f};
    bf16x8 At[4][2], B0[2][2], B1[2][2];
    const char* cA = (const char*)g.A + (size_t)cur.pm * tstep; const char* cB = (const char*)g.Bt + (size_t)cur.pn * tstep;
    S.a_ready(cur);
    if constexpr (SP2) {
        PG8_STAGE(PG8_SB(0, 0), cB, voffB); PG8_STAGE(PG8_SB(0, 1), cB + hstep, voffB); PG8_STAGE(PG8_SA(0, 0), cA, voffA); PG8_STAGE(PG8_SA(0, 1), cA + hstep, voffA);
        if (wr == 1) PG8_BAR;
        PG8_WAIT_V(2); PG8_BAR;
        PG8_STAGE(PG8_SB(1, 0), cB + kstep, voffB); PG8_STAGE(PG8_SA(1, 0), cA + kstep, voffA); PG8_STAGE(PG8_SB(1, 1), cB + hstep + kstep, voffB);
        PG8_WAIT_V(6); PG8_BAR;
    } else {
        PG8_STAGE(PG8_SB(0, 0), cB, voffB); PG8_STAGE(PG8_SA(0, 0), cA, voffA); PG8_STAGE(PG8_SB(0, 1), cB + hstep, voffB); PG8_STAGE(PG8_SA(0, 1), cA + hstep, voffA);
        if (wr == 1) PG8_BAR;
        PG8_WAIT_V(4); PG8_BAR;
        PG8_STAGE(PG8_SB(1, 0), cB + kstep, voffB); PG8_STAGE(PG8_SA(1, 0), cA + kstep, voffA); PG8_STAGE(PG8_SB(1, 1), cB + hstep + kstep, voffB);
        PG8_WAIT_V(6); PG8_BAR;
    }
    for (;;) {
        const bool has_next = S.next(ui + 1, nxt);
        const char* nA = has_next ? (const char*)g.A + (size_t)nxt.pm * tstep : cA; const char* nB = has_next ? (const char*)g.Bt + (size_t)nxt.pn * tstep : cB;
        for (int t = 0; t < nt; t += 2) {
            const bool last = (t == nt - 2);
            const char* a1 = cA + (size_t)(t + 1) * kstep;
            const char* a2 = last ? nA : cA + (size_t)(t + 2) * kstep; const char* b2 = last ? nB : cB + (size_t)(t + 2) * kstep;
            const char* a3 = a2 + kstep; const char* b3 = b2 + kstep;
            if (last && has_next) S.a_ready(nxt);
            if constexpr (SP2) {
            PG8_LDB(B0, 0, 0); PG8_LDB(B1, 0, 1); PG8_SCHED; PG8_LDA(At, 0, 0); PG8_STAGE(PG8_SA(1, 1), a1 + hstep, voffA);
            PG8_WAIT_V(8); PG8_WAIT_L(0); PG8_BAR; PG8_MMA(0, 0, At, B0); PG8_MMA(0, 1, At, B1); PG8_BAR; PG8_SCHED;
            PG8_LDA(At, 0, 1); PG8_STAGE(PG8_SB(0, 0), b2, voffB); PG8_STAGE(PG8_SB(0, 1), b2 + hstep, voffB); PG8_STAGE(PG8_SA(0, 0), a2, voffA);
            PG8_WAIT_V(8); PG8_WAIT_L(0); PG8_BAR; PG8_MMA(1, 0, At, B0); PG8_MMA(1, 1, At, B1); PG8_BAR; PG8_SCHED;
            PG8_LDB(B0, 1, 0); PG8_LDB(B1, 1, 1); PG8_SCHED; PG8_LDA(At, 1, 0); PG8_STAGE(PG8_SA(0, 1), a2 + hstep, voffA);
            PG8_WAIT_V(8); PG8_WAIT_L(0); PG8_BAR; PG8_MMA(0, 0, At, B0); PG8_MMA(0, 1, At, B1); PG8_BAR; PG8_SCHED;
            PG8_LDA(At, 1, 1); PG8_STAGE(PG8_SB(1, 0), b3, voffB); PG8_STAGE(PG8_SB(1, 1), b3 + hstep, voffB); PG8_STAGE(PG8_SA(1, 0), a3, voffA);
            PG8_WAIT_V(8); PG8_WAIT_L(0); PG8_BAR; PG8_MMA(1, 0, At, B0); PG8_MMA(1, 1, At, B1); PG8_BAR; PG8_SCHED;
            } else {
            PG8_LDB(B0, 0, 0); PG8_SCHED; PG8_LDA(At, 0, 0); PG8_STAGE(PG8_SA(1, 1), a1 + hstep, voffA);
            PG8_WAIT_L(8); PG8_BAR; PG8_WAIT_L(0); PG8_MMA(0, 0, At, B0); PG8_BAR; PG8_SCHED;
            PG8_LDB(B1, 0, 1); PG8_STAGE(PG8_SB(0, 0), b2, voffB);
            PG8_BAR; PG8_WAIT_L(0); PG8_MMA(0, 1, At, B1); PG8_BAR;
            PG8_LDA(At, 0, 1); PG8_STAGE(PG8_SA(0, 0), a2, voffA);
            PG8_BAR; PG8_WAIT_L(0); PG8_MMA(1, 0, At, B0); PG8_BAR; PG8_SCHED;
            PG8_STAGE(PG8_SB(0, 1), b2 + hstep, voffB);
            PG8_WAIT_V(6); PG8_BAR; PG8_MMA(1, 1, At, B1); PG8_BAR;
            PG8_LDB(B0, 1, 0); PG8_SCHED; PG8_LDA(At, 1, 0); PG8_STAGE(PG8_SA(0, 1), a2 + hstep, voffA);
            PG8_WAIT_L(8); PG8_BAR; PG8_WAIT_L(0); PG8_MMA(0, 0, At, B0); PG8_BAR; PG8_SCHED;
            PG8_LDB(B1, 1, 1); PG8_STAGE(PG8_SB(1, 0), b3, voffB);
            PG8_BAR; PG8_WAIT_L(0); PG8_MMA(0, 1, At, B1); PG8_BAR;
            PG8_LDA(At, 1, 1); PG8_STAGE(PG8_SA(1, 0), a3, voffA);
            PG8_BAR; PG8_WAIT_L(0); PG8_MMA(1, 0, At, B0); PG8_BAR; PG8_SCHED;
            PG8_STAGE(PG8_SB(1, 1), b3 + hstep, voffB);
            PG8_WAIT_V(6); PG8_BAR; PG8_MMA(1, 1, At, B1); PG8_BAR;
            }
        }
        if constexpr (ALIGN_EPI) { if (wr == 0) PG8_BAR; }
        if constexpr (!Epi::AFTER_DRAIN) { E(acc, cur, wr, wc, fr, fq); S.done(cur); }
        if (!has_next) break;
#pragma unroll
        for (int a = 0; a < 2; ++a)
#pragma unroll
            for (int b = 0; b < 2; ++b)
#pragma unroll
                for (int m = 0; m < 4; ++m)
#pragma unroll
                    for (int n = 0; n < 2; ++n) acc[a][b][m][n] = (f32x4){0.f, 0.f, 0.f, 0.f};
        cur = nxt; cA = nA; cB = nB; ++ui;
        if constexpr (ALIGN_EPI) { if (wr == 1) PG8_BAR; }
    }
    PG8_WAIT_V(0);
    if constexpr (!ALIGN_EPI) { if (wr == 0) PG8_BAR; }
    PG8_BAR;
    if constexpr (Epi::AFTER_DRAIN) { E.fused(acc, cur, wr, wc, fr, fq, lds, wid, lane); S.done(cur); }
#undef PG8_SA
#undef PG8_SB
#undef PG8_STAGE
#undef PG8_LDA
#undef PG8_LDB
#undef PG8_MMA
#undef PG8_WAIT_V
#undef PG8_WAIT_L
#undef PG8_BAR
#undef PG8_SCHED
}
}
using pg8::f32x4; using pg8::u32x4;

__device__ __forceinline__ void transpose_item(const float* W, int K, int N, bf16_t* WT, int row_off, float* scr, int item, int lane) {
    const int nblk = N / 32, kb = item / nblk, nbk = item % nblk, k0 = 64 * kb, n0 = 32 * nbk;
#pragma unroll 8
    for (int i = 0; i < 32; ++i) { const int kk = 2 * i + (lane >> 5); scr[kk * 33 + (lane & 31)] = W[(size_t)(k0 + kk) * N + n0 + (lane & 31)]; }
    asm volatile("s_waitcnt lgkmcnt(0)" ::: "memory");
    const int c = lane & 7;
#pragma unroll
    for (int j = 0; j < 4; ++j) { const int n = (lane >> 3) + 8 * j; const float* s = scr + (8 * c) * 33 + n;
        uint4 o; o.x = pk2(s[0 * 33], s[1 * 33]); o.y = pk2(s[2 * 33], s[3 * 33]); o.z = pk2(s[4 * 33], s[5 * 33]); o.w = pk2(s[6 * 33], s[7 * 33]);
        *(uint4*)(WT + (size_t)(row_off + n0 + n) * K + k0 + 8 * c) = o; }
    asm volatile("s_waitcnt lgkmcnt(0)" ::: "memory");
}
__device__ __forceinline__ void ph_prep(const Params& p, int bid, int nb, float* lds) {
    const int tid = tid_(), wave = tid >> 6, lane = tid & 63;
    {
        float* sl = lds;
        float* red = lds + 4096;
        for (int i = tid; i < 4096; i += NTH) sl[i] = siluf_(p.c[i]);
        __syncthreads();
        for (int it = bid; it < 192; it += nb) {
            const int c4 = tid & 15, kg = tid >> 4;
            const float* wp = p.w_ada + (size_t)kg * NMOD + it * 64 + c4 * 4;
            float a0[4] = {0.f, 0.f, 0.f, 0.f}, a1[4] = {0.f, 0.f, 0.f, 0.f};
#pragma unroll 8
            for (int i = 0; i < 64; ++i) {
                const int k = kg + 32 * i;
                const float4 w = *(const float4*)(wp + (size_t)(32 * i) * NMOD);
                const float s0 = sl[k], s1 = sl[2048 + k];
                a0[0] += s0 * w.x; a0[1] += s0 * w.y; a0[2] += s0 * w.z; a0[3] += s0 * w.w;
                a1[0] += s1 * w.x; a1[1] += s1 * w.y; a1[2] += s1 * w.z; a1[3] += s1 * w.w;
            }
            __syncthreads();
#pragma unroll
            for (int e = 0; e < 4; ++e) { red[(kg * 16 + c4) * 8 + e] = a0[e]; red[(kg * 16 + c4) * 8 + 4 + e] = a1[e]; }
            __syncthreads();
            if (tid < 128) {
                const int b = tid >> 6, col = tid & 63;
                float s = 0.f;
                for (int g = 0; g < 32; ++g) s += red[(g * 16 + (col >> 2)) * 8 + b * 4 + (col & 3)];
                p.ada[b * NMOD + it * 64 + col] = s + p.b_ada[it * 64 + col];
            }
        }
        __syncthreads();
    }
    for (int e = bid * NTH + tid; e < NTOK * 64; e += nb * NTH) {
        const int tok = e >> 6, j = e & 63;
        const float ang = (float)p.pos[tok] * c_freq[j];
        float s, c; sincos_acc(ang, s, c);
        p.rope[(size_t)e * 2] = c; p.rope[(size_t)e * 2 + 1] = s;
    }
    {
        float* scr = lds + wave * (64 * 33);
        const int gw = bid * 8 + wave, ngw = nb * 8;
        constexpr int I1 = 32 * 256, I2 = 32 * 128, I3 = 16 * 64, I4 = 32 * 64;
        constexpr int NIT = I1 + I2 + I3 + 3 * I4;
        for (int it = gw; it < NIT; it += ngw) {
            int r = it;
            if (r < I1) { transpose_item(p.w_in, 2048, 8192, p.Wt1, 0, scr, r, lane); continue; } r -= I1;
            if (r < I2) { transpose_item(p.w_bg, 2048, 4096, p.Wt1, 8192, scr, r, lane); continue; } r -= I2;
            if (r < I3) { transpose_item(p.w_a_out, 1024, 2048, p.Wta, 0, scr, r, lane); continue; } r -= I3;
            if (r < I4) { transpose_item(p.w_b_out, 2048, 2048, p.Wtb, 0, scr, r, lane); continue; } r -= I4;
            if (r < I4) { transpose_item(p.w_o, 2048, 2048, p.Wto, 0, scr, r, lane); continue; } r -= I4;
            transpose_item(p.peer_wq, 2048, 2048, p.Wtq, 0, scr, r, lane);
        }
    }
    __syncthreads();
}
constexpr int ROW6 = 1536;
__device__ __forceinline__ unsigned enc_e2m3(float x) {
    const unsigned sgn = (__float_as_uint(x) >> 26) & 32u; const float a = fabsf(x);
    const unsigned b = __float_as_uint(a);
    const unsigned nrm = ((b + 0x7FFFFu + ((b >> 20) & 1u)) >> 20) - 1008u;
    const unsigned sub = (unsigned)rintf(a * 8.0f);
    unsigned c = (a < 1.0f) ? sub : nrm; c = c > 31u ? 31u : c;
    return sgn | c;
}
__device__ __forceinline__ void ph_tabconv(const Params& p, int bid, int nb) {
    const int tid = tid_(), wave = tid >> 6, lane = tid & 63;
    for (int r = bid * 8 + wave; r < 2 * 16384; r += nb * 8) {
        const bool second = r >= 16384; const int row = second ? r - 16384 : r;
        const float* src = (second ? p.peer_v : p.peer_u) + (size_t)row * DM + lane * 32;
        float v[32]; float am = 0.f;
#pragma unroll
        for (int q = 0; q < 8; ++q) { const float4 t = *(const float4*)(src + 4 * q); v[4 * q] = t.x; v[4 * q + 1] = t.y; v[4 * q + 2] = t.z; v[4 * q + 3] = t.w;
            am = fmaxf(am, fmaxf(fmaxf(fabsf(t.x), fabsf(t.y)), fmaxf(fabsf(t.z), fabsf(t.w)))); }
        am = wave_max(am);
        const float sc = (am > 0.f) ? am * (1.0f / 7.5f) : 1.0f, inv = (am > 0.f) ? 7.5f / am : 1.0f;
        unsigned w[6] = {0u, 0u, 0u, 0u, 0u, 0u};
#pragma unroll
        for (int k = 0; k < 32; ++k) {
            const unsigned c = enc_e2m3(v[k] * inv);
            const int bp = 6 * k, wd = bp >> 5, sh = bp & 31;
            w[wd] |= c << sh;
            if (sh > 26) w[wd + 1] |= c >> (32 - sh);
        }
        unsigned char* dst = (second ? p.V8 : p.U8) + (size_t)row * ROW6 + lane * 24;
        *(uint2*)(dst) = make_uint2(w[0], w[1]); *(uint2*)(dst + 8) = make_uint2(w[2], w[3]); *(uint2*)(dst + 16) = make_uint2(w[4], w[5]);
        if (lane == 0) (second ? p.sv : p.su)[row] = sc;
    }
}

__device__ __forceinline__ void ph_modnorm(const Params& p, const float* xin, const float* g, int sh_off, int sc_off, bf16_t* hout, int bid, int nb, float* lds) {
    const int tid = tid_(), wave = tid >> 6, lane = tid & 63;
    for (int row = bid * 8 + wave; row < NTOK; row += nb * 8) {
        const int b = row / SQ;
        const float4* xr = (const float4*)(xin + (size_t)row * DM);
        float4 v[8]; float ss = 0.f;
#pragma unroll
        for (int j = 0; j < 8; ++j) { v[j] = xr[lane + 64 * j]; ss += dot4(v[j], v[j]); }
        ss = wave_sum(ss);
        const float rs = 1.0f / sqrtf(ss * (1.0f / DM) + 1e-6f);
#pragma unroll
        for (int j = 0; j < 8; ++j) {
            const int col = (lane + 64 * j) * 4;
            const float4 g4 = *(const float4*)(g + col);
            const float4 sc = *(const float4*)(p.ada + b * NMOD + sc_off + col);
            const float4 sh = *(const float4*)(p.ada + b * NMOD + sh_off + col);
            float4 o;
            o.x = v[j].x * rs * g4.x * (1.0f + sc.x) + sh.x; o.y = v[j].y * rs * g4.y * (1.0f + sc.y) + sh.y;
            o.z = v[j].z * rs * g4.z * (1.0f + sc.z) + sh.z; o.w = v[j].w * rs * g4.w * (1.0f + sc.w) + sh.w;
            *(uint2*)(hout + (size_t)row * DM + col) = make_uint2(pk2(o.x, o.y), pk2(o.z, o.w));
        }
    }
}

typedef short bf16x8_t __attribute__((ext_vector_type(8)));
typedef float f32x4_t __attribute__((ext_vector_type(4)));
__device__ __forceinline__ bf16x8_t ldfrag(const char* base, int row, int chunk, int rb, int sm) { return *(const bf16x8_t*)(base + row * rb + ((chunk ^ (row & sm)) << 4)); }
__device__ __forceinline__ void ph_gmlp2(const Params& p, int bid, int nb, float* lds) {
    char* WM = (char*)lds; char* VT = WM + 32768;
    const int tid = tid_(), wave = tid >> 6, lane = tid & 63, fr = lane & 15, fq = lane >> 4;
    int gl = -1;
    for (int it = bid; it < 512; it += nb) {
        const int g = it & 7, n = (it >> 3) & 31, b = it >> 8;
        const int tok0 = b * SQ + n * 128;
        __syncthreads();
        if (g != gl) {
            for (int u = tid; u < 2048; u += NTH) {
                const int i = u >> 4, c = u & 15;
                const float4* src = (const float4*)(p.gm_ws + (size_t)g * 16384 + i * 128 + c * 8);
                float4 a = src[0], b4 = src[1];
                if ((i >> 6) < (c >> 3)) { a = make_float4(0.f, 0.f, 0.f, 0.f); b4 = a; }
                *(uint4*)(WM + i * 256 + ((c ^ (i & 15)) << 4)) = make_uint4(pk2(a.x, a.y), pk2(a.z, a.w), pk2(b4.x, b4.y), pk2(b4.z, b4.w));
            }
            gl = g;
        }
        {
            const float2 gn = *(const float2*)(p.gm_v_g + g * 128 + lane * 2);
#pragma unroll 4
            for (int jj = 0; jj < 16; ++jj) {
                const int j = wave * 16 + jj;
                const unsigned w = *(const unsigned*)(p.ZG + (size_t)(tok0 + j) * ZW + 1024 + g * 128 + lane * 2);
                const float a = bflo(w), c2 = bfhi(w);
                const float ss = wave_sum(a * a + c2 * c2);
                const float rs = 1.0f / sqrtf(ss * (1.0f / 128.0f) + 1e-6f);
                const int d0 = lane * 2, d1 = d0 + 1;
                *(bf16_t*)(VT + d0 * 256 + (((j >> 3) ^ (d0 & 15)) << 4) + (j & 7) * 2) = (bf16_t)f2bf(a * rs * gn.x);
                *(bf16_t*)(VT + d1 * 256 + (((j >> 3) ^ (d1 & 15)) << 4) + (j & 7) * 2) = (bf16_t)f2bf(c2 * rs * gn.y);
            }
        }
        __syncthreads();
        {
            bf16x8_t A[4];
#pragma unroll
            for (int ks = 0; ks < 4; ++ks) A[ks] = ldfrag(VT, wave * 16 + fr, ks * 4 + fq, 256, 15);
            const int d0 = wave * 16 + fq * 4;
#pragma unroll
            for (int itl = 0; itl < 8; ++itl) {
                f32x4_t acc = {0.f, 0.f, 0.f, 0.f};
#pragma unroll
                for (int ks = 0; ks < 4; ++ks) if (itl >= 4 || ks < 2) acc = __builtin_amdgcn_mfma_f32_16x16x32_bf16(A[ks], ldfrag(WM, itl * 16 + fr, ks * 4 + fq, 256, 15), acc, 0, 0, 0);
                const int i = itl * 16 + fr;
                const float bias = p.gm_b[g * 128 + i];
                const size_t tok = (size_t)(tok0 + i);
                const uint2 uw = *(const uint2*)(p.ZG + tok * ZW + g * 128 + d0);
                *(uint2*)(p.yain + tok * 1024 + g * 128 + d0) = make_uint2(pk2(bflo(uw.x) * (acc[0] + bias), bfhi(uw.x) * (acc[1] + bias)), pk2(bflo(uw.y) * (acc[2] + bias), bfhi(uw.y) * (acc[3] + bias)));
            }
        }
    }
    __syncthreads();
}

__device__ __forceinline__ void ph_ret(const Params& p, int bid, int nb, float* lds) {
    float* Qs = lds;
    float* Ks = Qs + 64 * 129;
    float* Vs = Ks + 64 * 129;
    float* Ss = Vs + 64 * 16;
    float* At = Ss + 128 * 16;
    float* kd = At + 64 * 65;
    const int tid = tid_();
    const bf16_t* z = p.ZG;
    for (int it = bid; it < 256; it += nb) {
        const int vs = it & 15, h = (it >> 4) & 7, b = it >> 7;
        const float lg = log1pf(-exp2f(-5.0f - (float)h));
        const float cdec = expf(lg * 64.0f);
        __syncthreads();
        for (int i = tid; i < 2048; i += NTH) Ss[i] = 0.f;
        if (tid < 64) kd[tid] = expf(lg * (float)(63 - tid));
        for (int n = 0; n < 64; ++n) {
            const int tok0 = b * SQ + n * 64;
            __syncthreads();
            for (int e = tid; e < 4096; e += NTH) {
                const int i = e >> 6, dd = e & 63; const size_t tok = (size_t)(tok0 + i);
                const float cs = p.rope[(tok * 64 + dd) * 2], sn = p.rope[(tok * 64 + dd) * 2 + 1];
                const bf16_t* zr = z + tok * ZW;
                const float q1 = bf2f(zr[2048 + h * 128 + dd]), q2 = bf2f(zr[2048 + h * 128 + 64 + dd]);
                const float k1 = bf2f(zr[3072 + h * 128 + dd]), k2 = bf2f(zr[3072 + h * 128 + 64 + dd]);
                Qs[i * 129 + dd] = q1 * cs - q2 * sn; Qs[i * 129 + 64 + dd] = q1 * sn + q2 * cs;
                const float sc = 0.08838834764831845f;
                Ks[i * 129 + dd] = (k1 * cs - k2 * sn) * sc; Ks[i * 129 + 64 + dd] = (k1 * sn + k2 * cs) * sc;
            }
            for (int e = tid; e < 1024; e += NTH) { const int j = e >> 4, v = e & 15; Vs[e] = bf2f(z[(size_t)(tok0 + j) * ZW + 4096 + h * 256 + vs * 16 + v]); }
            __syncthreads();
            {
                const int j = tid & 63, i0 = (tid >> 6) * 8;
                float acc[8];
#pragma unroll
                for (int ii = 0; ii < 8; ++ii) acc[ii] = 0.f;
                for (int d = 0; d < 128; ++d) {
                    const float kv = Ks[j * 129 + d];
#pragma unroll
                    for (int ii = 0; ii < 8; ++ii) acc[ii] += Qs[(i0 + ii) * 129 + d] * kv;
                }
#pragma unroll
                for (int ii = 0; ii < 8; ++ii) { const int i = i0 + ii; At[i * 65 + j] = acc[ii] * expf(lg * fabsf((float)(i - j))); }
            }
            __syncthreads();
            {
                const int v = tid & 15, i0 = tid >> 4;
#pragma unroll
                for (int rep = 0; rep < 2; ++rep) {
                    const int i = i0 + 32 * rep;
                    float a = 0.f; for (int j = 0; j < 64; ++j) a += At[i * 65 + j] * Vs[j * 16 + v];
                    float c2 = 0.f; for (int d = 0; d < 128; ++d) c2 += Qs[i * 129 + d] * Ss[d * 16 + v];
                    p.obuf[(size_t)(tok0 + i) * DM + h * 256 + vs * 16 + v] = a + c2 * expf(lg * (float)(i + 1));
                }
            }
            __syncthreads();
            {
                const int v = tid & 15, d0 = tid >> 4;
#pragma unroll
                for (int rep = 0; rep < 4; ++rep) {
                    const int d = d0 + 32 * rep;
                    float a = 0.f; for (int j = 0; j < 64; ++j) a += Ks[j * 129 + d] * kd[j] * Vs[j * 16 + v];
                    Ss[d * 16 + v] = Ss[d * 16 + v] * cdec + a;
                }
            }
        }
    }
    __syncthreads();
}


__device__ __forceinline__ void ph_retprep(const Params& p, int bid, int nb, float* lds) {
    bf16_t* Kl = (bf16_t*)lds;
    bf16_t* Vl = Kl + 64 * 132;
    const int tid = tid_();
    for (int it = bid; it < 1024; it += nb) {
        const int n = it & 63, h = (it >> 6) & 7, b = it >> 9;
        const int tok0 = b * SQ + n * 64;
        const size_t rowbase = (size_t)(b * 8 + h) * SQ + n * 64;
        const float lg = log1pf(-exp2f(-5.0f - (float)h));
        __syncthreads();
#pragma unroll
        for (int k = 0; k < 2; ++k) {
            const int u = tid + 512 * k, i = u >> 4, dd = (u & 15) * 4; const size_t tok = (size_t)(tok0 + i);
            const float4 r0 = *(const float4*)(p.rope + (tok * 64 + dd) * 2), r1 = *(const float4*)(p.rope + (tok * 64 + dd) * 2 + 4);
            const float cs[4] = {r0.x, r0.z, r1.x, r1.z}, sn[4] = {r0.y, r0.w, r1.y, r1.w};
            const bf16_t* zr = p.ZG + tok * ZW;
            const uint2 q1w = *(const uint2*)(zr + 2048 + h * 128 + dd), q2w = *(const uint2*)(zr + 2048 + h * 128 + 64 + dd);
            const uint2 k1w = *(const uint2*)(zr + 3072 + h * 128 + dd), k2w = *(const uint2*)(zr + 3072 + h * 128 + 64 + dd);
            const float q1[4] = {bflo(q1w.x), bfhi(q1w.x), bflo(q1w.y), bfhi(q1w.y)}, q2[4] = {bflo(q2w.x), bfhi(q2w.x), bflo(q2w.y), bfhi(q2w.y)};
            const float k1[4] = {bflo(k1w.x), bfhi(k1w.x), bflo(k1w.y), bfhi(k1w.y)}, k2[4] = {bflo(k2w.x), bfhi(k2w.x), bflo(k2w.y), bfhi(k2w.y)};
            const float sc = 0.08838834764831845f, kd = expf(lg * (float)(63 - i));
            float qa[4], qb[4], ka[4], kb[4];
#pragma unroll
            for (int e = 0; e < 4; ++e) { qa[e] = q1[e] * cs[e] - q2[e] * sn[e]; qb[e] = q1[e] * sn[e] + q2[e] * cs[e]; ka[e] = (k1[e] * cs[e] - k2[e] * sn[e]) * sc; kb[e] = (k1[e] * sn[e] + k2[e] * cs[e]) * sc; }
            *(uint2*)(p.Qr + (rowbase + i) * 128 + dd) = make_uint2(pk2(qa[0], qa[1]), pk2(qa[2], qa[3]));
            *(uint2*)(p.Qr + (rowbase + i) * 128 + 64 + dd) = make_uint2(pk2(qb[0], qb[1]), pk2(qb[2], qb[3]));
            *(uint2*)(p.Kr + (rowbase + i) * 128 + dd) = make_uint2(pk2(ka[0], ka[1]), pk2(ka[2], ka[3]));
            *(uint2*)(p.Kr + (rowbase + i) * 128 + 64 + dd) = make_uint2(pk2(kb[0], kb[1]), pk2(kb[2], kb[3]));
            *(uint2*)(Kl + i * 132 + dd) = make_uint2(pk2(ka[0] * kd, ka[1] * kd), pk2(ka[2] * kd, ka[3] * kd));
            *(uint2*)(Kl + i * 132 + 64 + dd) = make_uint2(pk2(kb[0] * kd, kb[1] * kd), pk2(kb[2] * kd, kb[3] * kd));
        }
#pragma unroll
        for (int k = 0; k < 4; ++k) {
            const int u = tid + 512 * k, j = u >> 5, c = u & 31;
            *(uint4*)(Vl + j * 264 + c * 8) = *(const uint4*)(p.ZG + (size_t)(tok0 + j) * ZW + 4096 + h * 256 + c * 8);
        }
        __syncthreads();
        bf16_t* kt = p.KTd + (size_t)it * 8192;
#pragma unroll
        for (int k = 0; k < 2; ++k) {
            const int u = tid + 512 * k, d = u & 127, jg = u >> 7;
            unsigned w[4];
#pragma unroll
            for (int q = 0; q < 4; ++q) w[q] = (unsigned)Kl[(jg * 8 + 2 * q) * 132 + d] | ((unsigned)Kl[(jg * 8 + 2 * q + 1) * 132 + d] << 16);
            *(uint4*)(kt + d * 64 + jg * 8) = make_uint4(w[0], w[1], w[2], w[3]);
        }
        bf16_t* vt = p.Vt + (size_t)it * 16384;
#pragma unroll
        for (int k = 0; k < 4; ++k) {
            const int u = tid + 512 * k, v = u & 255, jg = u >> 8;
            unsigned w[4];
#pragma unroll
            for (int q = 0; q < 4; ++q) w[q] = (unsigned)Vl[(jg * 8 + 2 * q) * 264 + v] | ((unsigned)Vl[(jg * 8 + 2 * q + 1) * 264 + v] << 16);
            *(uint4*)(vt + v * 64 + jg * 8) = make_uint4(w[0], w[1], w[2], w[3]);
        }
    }
    __syncthreads();
}

__device__ __forceinline__ void ph_ret2(const Params& p, int bid, int nb, float* lds) {
    char* L = (char*)lds;
    constexpr int OQ = 0, OKK = 16384, OKT = 32768, OVT = 49152, TILE = 51200, OP = 2 * TILE, OST = OP + 8192;
    const int tid = tid_(), wave = tid >> 6, lane = tid & 63, fr = lane & 15, fq = lane >> 4;
    for (int it = bid; it < 256; it += nb) {
        const int vs = it & 15, h = (it >> 4) & 7, b = it >> 7;
        const float lg = log1pf(-exp2f(-5.0f - (float)h));
        const float cdec = expf(lg * 64.0f);
        const size_t bh = (size_t)(b * 8 + h);
        const char* gQ = (const char*)(p.Qr + bh * SQ * 128);
        const char* gK = (const char*)(p.Kr + bh * SQ * 128);
        const char* gKT = (const char*)(p.KTd + bh * 64 * 8192);
        const char* gVt = (const char*)(p.Vt + bh * 64 * 16384) + vs * 16 * 128;
        int lq[2], lkt[2];
#pragma unroll
        for (int u = 0; u < 2; ++u) { const int ci = tid + 512 * u; const int r = ci >> 4, c = ci & 15; lq[u] = r * 256 + ((c ^ (r & 15)) << 4); const int d = ci >> 3, c8 = ci & 7; lkt[u] = d * 128 + ((c8 ^ (d & 7)) << 4); }
        const int lv = (tid >> 3) * 128 + (((tid & 7) ^ ((tid >> 3) & 7)) << 4);
        uint4 qA0, qA1, kA0, kA1, tA0, tA1, vA = make_uint4(0u, 0u, 0u, 0u), qB0, qB1, kB0, kB1, tB0, tB1, vB = make_uint4(0u, 0u, 0u, 0u);
#define RET_LOAD(X_, n_) do { const size_t o0 = (size_t)(n_) * 16384 + (size_t)tid * 16, o1 = o0 + 8192; \
        q##X_##0 = *(const uint4*)(gQ + o0); q##X_##1 = *(const uint4*)(gQ + o1); k##X_##0 = *(const uint4*)(gK + o0); k##X_##1 = *(const uint4*)(gK + o1); t##X_##0 = *(const uint4*)(gKT + o0); t##X_##1 = *(const uint4*)(gKT + o1); \
        if (tid < 128) v##X_ = *(const uint4*)(gVt + (size_t)(n_) * 32768 + tid * 16); } while (0)
#define RET_WRITE(X_, buf_) do { char* B_ = L + (buf_) * TILE; \
        *(uint4*)(B_ + OQ + lq[0]) = q##X_##0; *(uint4*)(B_ + OQ + lq[1]) = q##X_##1; *(uint4*)(B_ + OKK + lq[0]) = k##X_##0; *(uint4*)(B_ + OKK + lq[1]) = k##X_##1; *(uint4*)(B_ + OKT + lkt[0]) = t##X_##0; *(uint4*)(B_ + OKT + lkt[1]) = t##X_##1; \
        if (tid < 128) *(uint4*)(B_ + OVT + lv) = v##X_; } while (0)
        __syncthreads();
        for (int i = tid; i < 1024; i += NTH) ((unsigned*)(L + OST))[i] = 0u;
        RET_LOAD(A, 0); RET_WRITE(A, 0); RET_LOAD(B, 1);
        f32x4_t sacc[2] = {{0.f, 0.f, 0.f, 0.f}, {0.f, 0.f, 0.f, 0.f}};
#define RET_STEP(n_, cur_, LS_, WS_) do { const int n = (n_); constexpr int cur = (cur_); \
            __syncthreads();                                     \
            if (n + 2 < 64) RET_LOAD(LS_, n + 2); \
            const char* T = L + cur * TILE; \
            {     \
                const int jt = wave >> 1, it0 = 2 * (wave & 1); \
                f32x4_t s0 = {0.f, 0.f, 0.f, 0.f}, s1 = {0.f, 0.f, 0.f, 0.f}; \
                _Pragma("unroll") for (int ks = 0; ks < 4; ++ks) { \
                    const bf16x8_t a = ldfrag(T + OKK, jt * 16 + fr, ks * 4 + fq, 256, 15); \
                    const bf16x8_t b0 = ldfrag(T + OQ, it0 * 16 + fr, ks * 4 + fq, 256, 15), b1 = ldfrag(T + OQ, (it0 + 1) * 16 + fr, ks * 4 + fq, 256, 15); \
                    s0 = __builtin_amdgcn_mfma_f32_16x16x32_bf16(a, b0, s0, 0, 0, 0); \
                    s1 = __builtin_amdgcn_mfma_f32_16x16x32_bf16(a, b1, s1, 0, 0, 0); } \
                const int j0 = jt * 16 + fq * 4; \
                _Pragma("unroll") for (int tt = 0; tt < 2; ++tt) { \
                    const int i = (it0 + tt) * 16 + fr; const f32x4_t sv4 = tt ? s1 : s0; float pv[4]; \
                    _Pragma("unroll") for (int r = 0; r < 4; ++r) pv[r] = sv4[r] * __expf(lg * fabsf((float)(i - (j0 + r)))); \
                    *(uint2*)(L + OP + i * 128 + ((((j0 >> 3)) ^ (i & 7)) << 4) + (j0 & 7) * 2) = make_uint2(pk2(pv[0], pv[1]), pk2(pv[2], pv[3])); } \
            } \
            __syncthreads();                                     \
            if (wave < 4) {     \
                const int itl = wave; \
                f32x4_t o1 = {0.f, 0.f, 0.f, 0.f}, o2 = {0.f, 0.f, 0.f, 0.f}; \
                _Pragma("unroll") for (int ks = 0; ks < 2; ++ks) o1 = __builtin_amdgcn_mfma_f32_16x16x32_bf16(ldfrag(L + OP, itl * 16 + fr, ks * 4 + fq, 128, 7), ldfrag(T + OVT, fr, ks * 4 + fq, 128, 7), o1, 0, 0, 0); \
                _Pragma("unroll") for (int ks = 0; ks < 4; ++ks) o2 = __builtin_amdgcn_mfma_f32_16x16x32_bf16(ldfrag(T + OQ, itl * 16 + fr, ks * 4 + fq, 256, 15), ldfrag(L + OST + cur * 4096, fr, ks * 4 + fq, 256, 15), o2, 0, 0, 0); \
                _Pragma("unroll") for (int r = 0; r < 4; ++r) { const int i = itl * 16 + fq * 4 + r; \
                    p.ob16[(size_t)(b * SQ + n * 64 + i) * DM + h * 256 + vs * 16 + fr] = (bf16_t)f2bf(o1[r] + __expf(lg * (float)(i + 1)) * o2[r]); } \
            } else {            \
                _Pragma("unroll") for (int u = 0; u < 2; ++u) { \
                    const int dt = 2 * (wave - 4) + u; \
                    sacc[u] = sacc[u] * cdec; \
                    _Pragma("unroll") for (int ks = 0; ks < 2; ++ks) sacc[u] = __builtin_amdgcn_mfma_f32_16x16x32_bf16(ldfrag(T + OKT, dt * 16 + fr, ks * 4 + fq, 128, 7), ldfrag(T + OVT, fr, ks * 4 + fq, 128, 7), sacc[u], 0, 0, 0); \
                    *(uint2*)(L + OST + (cur ^ 1) * 4096 + fr * 256 + (((dt * 2 + (fq >> 1)) ^ fr) << 4) + (fq & 1) * 8) = make_uint2(pk2(sacc[u][0], sacc[u][1]), pk2(sacc[u][2], sacc[u][3])); } \
            } \
            if (n + 1 < 64) RET_WRITE(WS_, cur ^ 1); } while (0)
        for (int n2 = 0; n2 < 64; n2 += 2) { RET_STEP(n2, 0, A, B); RET_STEP(n2 + 1, 1, B, A); }
#undef RET_STEP
#undef RET_LOAD
#undef RET_WRITE
    }
    __syncthreads();
}

__device__ __forceinline__ void ph_gn(const Params& p, int bid, int nb, float* lds) {
    const int tid = tid_(), wave = tid >> 6, lane = tid & 63;
    for (int tok = bid * 8 + wave; tok < NTOK; tok += nb * 8) {
#pragma unroll
        for (int h = 0; h < 8; ++h) {
            const uint2 ow = *(const uint2*)(p.ob16 + (size_t)tok * DM + h * 256 + lane * 4);
            const float4 o = make_float4(bflo(ow.x), bfhi(ow.x), bflo(ow.y), bfhi(ow.y));
            const float mu = wave_sum(o.x + o.y + o.z + o.w) * (1.0f / 256.0f);
            const float4 d = make_float4(o.x - mu, o.y - mu, o.z - mu, o.w - mu);
            const float var = wave_sum(dot4(d, d)) * (1.0f / 256.0f);
            const float rs = 1.0f / sqrtf(var + 1e-6f);
            const float4 gn = *(const float4*)(p.ret_gn_g + h * 256 + lane * 4);
            const uint2 gw = *(const uint2*)(p.ZG + (size_t)tok * ZW + 6144 + h * 256 + lane * 4);
            const float g0 = bflo(gw.x), g1 = bfhi(gw.x), g2 = bflo(gw.y), g3 = bfhi(gw.y);
            *(uint2*)(p.ybin + (size_t)tok * DM + h * 256 + lane * 4) =
                make_uint2(pk2(siluf_(g0) * d.x * rs * gn.x, siluf_(g1) * d.y * rs * gn.y), pk2(siluf_(g2) * d.z * rs * gn.z, siluf_(g3) * d.w * rs * gn.w));
        }
    }
}

template <int NL>
__device__ __forceinline__ void wave_top16(float (&v)[NL], const int (&idx)[NL], float& outv, int& outi, int lane) {
    outv = 0.f; outi = 0;
    for (int r = 0; r < 16; ++r) {
        float m = v[0];
#pragma unroll
        for (int u = 1; u < NL; ++u) m = fmaxf(m, v[u]);
        const float wm = wave_max(m);
        const unsigned long long bal = __ballot(m == wm);
        const int owner = __ffsll((long long)bal) - 1;
        int myi = -1;
        if (lane == owner) {
            bool done = false;
#pragma unroll
            for (int u = 0; u < NL; ++u) if (!done && v[u] == wm) { myi = idx[u]; v[u] = -INFINITY; done = true; }
        }
        const int wi = __shfl(myi, owner);
        if (lane == r) { outv = wm; outi = wi; }
    }
}
__device__ __forceinline__ void ph_topk(const Params& p, const float* qb, int bid, int nb, float* lds) {
    const int tid = tid_(), wave = tid >> 6, lane = tid & 63;
    for (int t = bid; t < NTOK; t += nb) {
        const int h = wave;
        const float* q = qb + (size_t)t * DM + h * 256;
        float s[2][2];
#pragma unroll
        for (int pp = 0; pp < 2; ++pp)
#pragma unroll
            for (int r = 0; r < 2; ++r) {
                const int n = lane + 64 * r;
                const float4* kr = (const float4*)(p.peer_sk + ((size_t)(h * 2 + pp) * 128 + n) * 128);
                const float4* qr = (const float4*)(q + pp * 128);
                float a = 0.f;
#pragma unroll 4
                for (int d4 = 0; d4 < 32; ++d4) a += dot4(kr[d4], qr[d4]);
                s[pp][r] = a;
            }
        float v1, v2; int i1, i2;
        { float vv[2] = {s[0][0], s[0][1]}; const int ii[2] = {lane, lane + 64}; wave_top16<2>(vv, ii, v1, i1, lane); }
        { float vv[2] = {s[1][0], s[1][1]}; const int ii[2] = {lane, lane + 64}; wave_top16<2>(vv, ii, v2, i2, lane); }
        float cv[4]; int ci[4];
        const int a = lane >> 2, b0 = (lane & 3) * 4;
        const float va = __shfl(v1, a); const int ia = __shfl(i1, a);
#pragma unroll
        for (int u = 0; u < 4; ++u) { const float vb = __shfl(v2, b0 + u); const int ib = __shfl(i2, b0 + u); cv[u] = va + vb; ci[u] = ia * 128 + ib; }
        float tv; int te;
        wave_top16<4>(cv, ci, tv, te, lane);
        const float mx = __shfl(tv, 0);
        const float ex = (lane < 16) ? expf(tv - mx) : 0.f;
        const float sum = wave_sum(ex);
        if (lane < 16) { p.eidx[(size_t)t * 128 + h * 16 + lane] = te; p.gatev[(size_t)t * 128 + h * 16 + lane] = ex / sum; }
    }
}

__device__ __forceinline__ void ph_peer(const Params& p, const float* x1, const bf16_t* h2, int bid, int nb, float* lds) {
    float* ys = lds;
    float* red = lds + 8 * 2048;
    const int tid = tid_(), wave = tid >> 6, lane = tid & 63;
    for (int t = bid; t < NTOK; t += nb) {
        const int b = t / SQ, h = wave;
        const uint2* hr = (const uint2*)(h2 + (size_t)t * DM);
        float4 hv[8], y[8];
#pragma unroll
        for (int j = 0; j < 8; ++j) { const uint2 w = hr[lane + 64 * j]; hv[j] = make_float4(bflo(w.x), bfhi(w.x), bflo(w.y), bfhi(w.y)); y[j] = make_float4(0.f, 0.f, 0.f, 0.f); }
        for (int k = 0; k < 16; ++k) {
            const int e = p.eidx[(size_t)t * 128 + h * 16 + k]; const float gt = p.gatev[(size_t)t * 128 + h * 16 + k];
            const float4* ur = (const float4*)(p.peer_u + (size_t)e * DM);
            float a = 0.f;
#pragma unroll
            for (int j = 0; j < 8; ++j) a += dot4(ur[lane + 64 * j], hv[j]);
            a = wave_sum(a);
            const float w = geluf_(a) * gt;
            const float4* vr = (const float4*)(p.peer_v + (size_t)e * DM);
#pragma unroll
            for (int j = 0; j < 8; ++j) { const float4 v4 = vr[lane + 64 * j]; y[j].x += w * v4.x; y[j].y += w * v4.y; y[j].z += w * v4.z; y[j].w += w * v4.w; }
        }
        __syncthreads();
#pragma unroll
        for (int j = 0; j < 8; ++j) *(float4*)(ys + h * 2048 + (lane + 64 * j) * 4) = y[j];
        __syncthreads();
        const int c = tid * 4;
        float4 s = make_float4(0.f, 0.f, 0.f, 0.f);
#pragma unroll
        for (int hh = 0; hh < 8; ++hh) { const float4 a = *(const float4*)(ys + hh * 2048 + c); s.x += a.x; s.y += a.y; s.z += a.z; s.w += a.w; }
        const float4 xv = *(const float4*)(x1 + (size_t)t * DM + c);
        const float4 ga = *(const float4*)(p.ada + b * NMOD + 5 * DM + c);
        const float4 x2 = make_float4(xv.x + ga.x * s.x, xv.y + ga.y * s.y, xv.z + ga.z * s.z, xv.w + ga.w * s.w);
        const float ss = wave_sum(dot4(x2, x2));
        if (lane == 0) red[wave] = ss;
        __syncthreads();
        float tot = 0.f;
#pragma unroll
        for (int w = 0; w < 8; ++w) tot += red[w];
        const float rs = 1.0f / sqrtf(tot * (1.0f / DM) + 1e-6f);
        const float4 gf = *(const float4*)(p.norm_f_g + c);
        *(float4*)(p.out + (size_t)t * DM + c) = make_float4(x2.x * rs * gf.x, x2.y * rs * gf.y, x2.z * rs * gf.z, x2.w * rs * gf.w);
    }
    __syncthreads();
}

__device__ __forceinline__ void split8(const float4 a, const float4 b, uint4& hi, uint4& lo) {
    const float x[8] = {a.x, a.y, a.z, a.w, b.x, b.y, b.z, b.w}; unsigned h[8], l[8];
#pragma unroll
    for (int i = 0; i < 8; ++i) { h[i] = f2bf(x[i]); l[i] = f2bf(x[i] - __uint_as_float(h[i] << 16)); }
    hi = make_uint4(h[0] | (h[1] << 16), h[2] | (h[3] << 16), h[4] | (h[5] << 16), h[6] | (h[7] << 16));
    lo = make_uint4(l[0] | (l[1] << 16), l[2] | (l[3] << 16), l[4] | (l[5] << 16), l[6] | (l[7] << 16));
}
__device__ __forceinline__ bf16x8_t as_bf16x8(const uint4 v) { return __builtin_bit_cast(bf16x8_t, v); }
struct PairTab { int a[52], b[52]; };
__host__ __device__ constexpr PairTab make_pairs() {
    PairTab t{}; int n = 0;
    for (int a = 0; a < 16; ++a) for (int b = 0; b < 16; ++b) if ((a + 1) * (b + 1) <= 16) { t.a[n] = a; t.b[n] = b; ++n; }
    for (; n < 52; ++n) { t.a[n] = -1; t.b[n] = -1; }
    return t;
}
constexpr PairTab PAIRS = make_pairs();
static_assert(PAIRS.a[49] >= 0 && PAIRS.a[50] < 0, "50 candidate pairs");

__device__ __forceinline__ void ph_topk2(const Params& p, const float* qb, int bid, int nb, float* lds) {
    const int tid = tid_(), wave = tid >> 6, lane = tid & 63;
    uint4* SK = (uint4*)lds;
    const float NEG = -INFINITY;
    for (int it = bid; it < 256; it += nb) {
        const int h = it & 7, tg = it >> 3;
        __syncthreads();
        for (int gi = tid; gi < 4096; gi += NTH) {
            const int dq = gi & 15, n = (gi >> 4) & 127, pp = gi >> 11;
            const float4* src = (const float4*)(p.peer_sk + ((size_t)(h * 2 + pp) * 128 + n) * 128 + dq * 8);
            uint4 hi, lo; split8(src[0], src[1], hi, lo);
            const int base = (((pp * 8 + (n >> 4)) * 4 + (dq >> 2)) * 2) * 64 + (dq & 3) * 16 + (n & 15);
            SK[base] = hi; SK[base + 64] = lo;
        }
        __syncthreads();
#pragma unroll 1
        for (int tile = 0; tile < 2; ++tile) {
            const int tok = tg * 256 + wave * 32 + tile * 16 + (lane & 15);
            const int qd = lane >> 4;
            float v12[2][16];
#pragma unroll
            for (int pp = 0; pp < 2; ++pp) {
                bf16x8_t Bh[4], Bl[4];
                const float* qp = qb + (size_t)tok * DM + h * 256 + pp * 128 + 8 * qd;
#pragma unroll
                for (int ks = 0; ks < 4; ++ks) { uint4 hi, lo; split8(*(const float4*)(qp + ks * 32), *(const float4*)(qp + ks * 32 + 4), hi, lo); Bh[ks] = as_bf16x8(hi); Bl[ks] = as_bf16x8(lo); }
                float v[32];
#pragma unroll
                for (int kt = 0; kt < 8; ++kt) {
                    f32x4_t acc = {0.f, 0.f, 0.f, 0.f};
#pragma unroll
                    for (int ks = 0; ks < 4; ++ks) {
                        const bf16x8_t Ah = as_bf16x8(SK[(((pp * 8 + kt) * 4 + ks) * 2) * 64 + lane]), Al = as_bf16x8(SK[(((pp * 8 + kt) * 4 + ks) * 2 + 1) * 64 + lane]);
                        acc = __builtin_amdgcn_mfma_f32_16x16x32_bf16(Ah, Bh[ks], acc, 0, 0, 0);
                        acc = __builtin_amdgcn_mfma_f32_16x16x32_bf16(Ah, Bl[ks], acc, 0, 0, 0);
                        acc = __builtin_amdgcn_mfma_f32_16x16x32_bf16(Al, Bh[ks], acc, 0, 0, 0);
                    }
#pragma unroll
                    for (int r = 0; r < 4; ++r) v[kt * 4 + r] = __uint_as_float((__float_as_uint(acc[r]) & ~127u) | (unsigned)(kt * 16 + qd * 4 + r));
                    __builtin_amdgcn_sched_barrier(0);
                }
#pragma unroll
                for (int r = 0; r < 16; ++r) {
                    float m = v[0];
#pragma unroll
                    for (int u = 1; u < 32; ++u) m = fmaxf(m, v[u]);
                    m = fmaxf(m, __shfl_xor(m, 16)); m = fmaxf(m, __shfl_xor(m, 32));
                    v12[pp][r] = m;
#pragma unroll
                    for (int u = 0; u < 32; ++u) v[u] = (v[u] == m) ? NEG : v[u];
                }
            }
            float c[13]; unsigned pay[13];
#pragma unroll
            for (int s = 0; s < 13; ++s) {
                float cq[4]; unsigned pq[4];
#pragma unroll
                for (int q = 0; q < 4; ++q) {
                    const int pi = 4 * s + q; const int a = PAIRS.a[pi], b = PAIRS.b[pi];
                    if (a >= 0) {
                        const float sum = v12[0][a] + v12[1][b];
                        cq[q] = __uint_as_float((__float_as_uint(sum) & ~63u) | (unsigned)pi);
                        pq[q] = (__float_as_uint(v12[0][a]) & 127u) * 128u + (__float_as_uint(v12[1][b]) & 127u);
                    } else { cq[q] = NEG; pq[q] = 0u; }
                }
                c[s] = qd == 0 ? cq[0] : qd == 1 ? cq[1] : qd == 2 ? cq[2] : cq[3];
                pay[s] = qd == 0 ? pq[0] : qd == 1 ? pq[1] : qd == 2 ? pq[2] : pq[3];
            }
            float top[16]; unsigned eid[16];
#pragma unroll
            for (int r = 0; r < 16; ++r) {
                float m = c[0];
#pragma unroll
                for (int s = 1; s < 13; ++s) m = fmaxf(m, c[s]);
                m = fmaxf(m, __shfl_xor(m, 16)); m = fmaxf(m, __shfl_xor(m, 32));
                unsigned pw = 0u;
#pragma unroll
                for (int s = 0; s < 13; ++s) { const bool eq = (c[s] == m); pw |= eq ? pay[s] : 0u; c[s] = eq ? NEG : c[s]; }
                pw |= (unsigned)__shfl_xor((int)pw, 16); pw |= (unsigned)__shfl_xor((int)pw, 32);
                top[r] = m; eid[r] = pw;
            }
            float sum = 0.f; const float mx = top[0];
#pragma unroll
            for (int r = 0; r < 16; ++r) { top[r] = expf(top[r] - mx); sum += top[r]; }
            const float inv = 1.0f / sum;
            if (lane < 16) {
                int4* ep = (int4*)(p.eidx + (size_t)tok * 128 + h * 16); float4* gp = (float4*)(p.gatev + (size_t)tok * 128 + h * 16);
#pragma unroll
                for (int q = 0; q < 4; ++q) {
                    ep[q] = make_int4((int)eid[4 * q], (int)eid[4 * q + 1], (int)eid[4 * q + 2], (int)eid[4 * q + 3]);
                    gp[q] = make_float4(top[4 * q] * inv, top[4 * q + 1] * inv, top[4 * q + 2] * inv, top[4 * q + 3] * inv);
                }
            }
        }
    }
    __syncthreads();
}

typedef float f32x32_t __attribute__((ext_vector_type(32)));
typedef unsigned u32x6_t __attribute__((ext_vector_type(6)));
__device__ __forceinline__ void peer_load4(const unsigned char* tab, const int (&e)[4], int lane, uint2 (&R)[4][3]) {
#pragma unroll
    for (int i = 0; i < 4; ++i) { const uint2* r = (const uint2*)(tab + (size_t)e[i] * ROW6 + lane * 24); R[i][0] = r[0]; R[i][1] = r[1]; R[i][2] = r[2]; }
}
__device__ __forceinline__ f32x32_t dec6(const uint2 (&R)[3]) { const u32x6_t w = {R[0].x, R[0].y, R[1].x, R[1].y, R[2].x, R[2].y}; return __builtin_amdgcn_cvt_scalef32_pk32_f32_fp6(w, 1.0f); }
__device__ __forceinline__ void ph_peer3(const Params& p, const float* x1, const bf16_t* h2, int bid, int nb) {
    const int tid = tid_(), wave = tid >> 6, lane = tid & 63;
    for (int t = bid * 8 + wave; t < NTOK; t += nb * 8) {
        const int b = t / SQ;
        float hv[32], y[32];
#pragma unroll
        for (int q = 0; q < 4; ++q) { const uint4 w = *(const uint4*)(h2 + (size_t)t * DM + lane * 32 + 8 * q); float* d = hv + 8 * q;
            d[0] = bflo(w.x); d[1] = bfhi(w.x); d[2] = bflo(w.y); d[3] = bfhi(w.y); d[4] = bflo(w.z); d[5] = bfhi(w.z); d[6] = bflo(w.w); d[7] = bfhi(w.w); }
#pragma unroll
        for (int i = 0; i < 32; ++i) y[i] = 0.f;
        const int e0 = p.eidx[(size_t)t * 128 + lane], e1 = p.eidx[(size_t)t * 128 + 64 + lane];
        const float g0 = p.gatev[(size_t)t * 128 + lane], g1 = p.gatev[(size_t)t * 128 + 64 + lane];
        const float su0 = p.su[e0], su1 = p.su[e1];
        const float gv0 = g0 * p.sv[e0], gv1 = g1 * p.sv[e1];
        uint2 Uc[4][3], Un[4][3], Vc[4][3];
        { int e[4];
#pragma unroll
          for (int i = 0; i < 4; ++i) e[i] = __builtin_amdgcn_readlane(e0, i);
          peer_load4(p.U8, e, lane, Uc); }
        for (int g = 0; g < 32; ++g) {
            const bool lo = g < 16; const int k0 = (4 * g) & 63;
            const int ee = lo ? e0 : e1; const float suu = lo ? su0 : su1, gvv = lo ? gv0 : gv1;
            int e[4]; float sa[4], gw[4];
#pragma unroll
            for (int i = 0; i < 4; ++i) { e[i] = __builtin_amdgcn_readlane(ee, k0 + i);
                sa[i] = __uint_as_float(__builtin_amdgcn_readlane(__float_as_uint(suu), k0 + i)); gw[i] = __uint_as_float(__builtin_amdgcn_readlane(__float_as_uint(gvv), k0 + i)); }
            peer_load4(p.V8, e, lane, Vc);
            {
                const int gn = (g < 31) ? g + 1 : g; const int en = (gn < 16) ? e0 : e1; const int kn = (4 * gn) & 63; int e2[4];
#pragma unroll
                for (int i = 0; i < 4; ++i) e2[i] = __builtin_amdgcn_readlane(en, kn + i);
                peer_load4(p.U8, e2, lane, Un);
            }
            float a[4];
#pragma unroll
            for (int i = 0; i < 4; ++i) {
                const f32x32_t d = dec6(Uc[i]);
                float acc0 = 0.f, acc1 = 0.f;
#pragma unroll
                for (int k = 0; k < 32; k += 2) { acc0 += d[k] * hv[k]; acc1 += d[k + 1] * hv[k + 1]; }
                a[i] = acc0 + acc1;
            }
#pragma unroll
            for (int o = 1; o < 64; o <<= 1) { a[0] += __shfl_xor(a[0], o); a[1] += __shfl_xor(a[1], o); a[2] += __shfl_xor(a[2], o); a[3] += __shfl_xor(a[3], o); }
#pragma unroll
            for (int i = 0; i < 4; ++i) {
                const float wgt = geluf_(a[i] * sa[i]) * gw[i];
                const f32x32_t d = dec6(Vc[i]);
#pragma unroll
                for (int k = 0; k < 32; ++k) y[k] += wgt * d[k];
            }
#pragma unroll
            for (int i = 0; i < 4; ++i) { Uc[i][0] = Un[i][0]; Uc[i][1] = Un[i][1]; Uc[i][2] = Un[i][2]; }
        }
        float ss = 0.f;
#pragma unroll
        for (int q = 0; q < 8; ++q) {
            const int c = lane * 32 + 4 * q;
            const float4 xv = *(const float4*)(x1 + (size_t)t * DM + c);
            const float4 ga = *(const float4*)(p.ada + b * NMOD + 5 * DM + c);
            float* yy = y + 4 * q;
            yy[0] = xv.x + ga.x * yy[0]; yy[1] = xv.y + ga.y * yy[1]; yy[2] = xv.z + ga.z * yy[2]; yy[3] = xv.w + ga.w * yy[3];
            ss += yy[0] * yy[0] + yy[1] * yy[1] + yy[2] * yy[2] + yy[3] * yy[3];
        }
        ss = wave_sum(ss);
        const float rs = 1.0f / sqrtf(ss * (1.0f / DM) + 1e-6f);
#pragma unroll
        for (int q = 0; q < 8; ++q) {
            const int c = lane * 32 + 4 * q;
            const float4 gf = *(const float4*)(p.norm_f_g + c);
            const float* yy = y + 4 * q;
            *(float4*)(p.out + (size_t)t * DM + c) = make_float4(yy[0] * rs * gf.x, yy[1] * rs * gf.y, yy[2] * rs * gf.z, yy[3] * rs * gf.w);
        }
    }
}

#define LAS __attribute__((address_space(3)))
#define XB_TMO      128
#define XB_XCNT(j)  (256  + 64 * (j))
#define XB_XSUB(j)  (1280 + 64 * (j))
#define XB_XGEN(j)  (2304 + 64 * (j))
#define XB_TOP      3328
#define XB_TOPGEN   3392
#define XCD_BAR_WORDS 3456
#define XB_SPIN_CAP (1u << 18)

__device__ __forceinline__ unsigned xb_ld(unsigned* p)              { return __hip_atomic_load(p, __ATOMIC_RELAXED, __HIP_MEMORY_SCOPE_AGENT); }
__device__ __forceinline__ unsigned xb_add(unsigned* p, unsigned v) { return __hip_atomic_fetch_add(p, v, __ATOMIC_RELAXED, __HIP_MEMORY_SCOPE_AGENT); }
__device__ __forceinline__ unsigned xb_xcc_id() { return (unsigned)__builtin_amdgcn_s_getreg((3 << 11) | 20) & 0xFu; }
#define XB_SPIN(cond, bar) do { unsigned _sp = 0; while (cond) { __builtin_amdgcn_s_sleep(1); \
    if ((++_sp & 255u) == 0u) { if (xb_ld(&(bar)[XB_TMO])) break; if (_sp > XB_SPIN_CAP) { atomicAdd(&(bar)[XB_TMO], 1u); break; } } } } while (0)

struct XcdBarrier {
    unsigned* bar; unsigned x;
    volatile LAS unsigned* st;
};

__device__ __forceinline__ XcdBarrier xcd_barrier_post(unsigned* bar, volatile LAS unsigned* st) {
    XcdBarrier b; b.bar = bar; b.x = xb_xcc_id(); b.st = st;
    if (threadIdx.x == 0) (void)xb_add(&bar[XB_XCNT(b.x)], 1u);
    return b;
}
__device__ __forceinline__ void xcd_barrier_complete(unsigned* bar, unsigned x, unsigned& nloc, unsigned& nx) {
    const unsigned G = gridDim.x * gridDim.y * gridDim.z;
    unsigned sum, cnt, mine, sp = 0u;
    for (;;) {
        sum = 0u; cnt = 0u; mine = 0u;
#pragma unroll
        for (unsigned j = 0; j < 16; ++j) { const unsigned c = xb_ld(&bar[XB_XCNT(j)]); sum += c; cnt += (c > 0u) ? 1u : 0u; mine = (j == x) ? c : mine; }
        if (sum == G) break;
        __builtin_amdgcn_s_sleep(1);
        if ((++sp & 255u) == 0u) { if (xb_ld(&bar[XB_TMO])) break; if (sp > XB_SPIN_CAP) { atomicAdd(&bar[XB_TMO], 1u); break; } }
    }
    nloc = mine > 0u ? mine : 1u; nx = cnt > 0u ? cnt : 1u;
}

__device__ __forceinline__ void xcd_barrier(const XcdBarrier& b) {
    asm volatile("s_waitcnt vmcnt(0)" ::: "memory");
    __syncthreads();
    if (threadIdx.x == 0) {
        unsigned* bar = b.bar;
        __builtin_amdgcn_s_waitcnt(0);
        unsigned nloc = b.st[0], nx = b.st[1];
        if (nloc == 0u) { xcd_barrier_complete(bar, b.x, nloc, nx); b.st[0] = nloc; b.st[1] = nx; }
        const unsigned old = xb_add(&bar[XB_XSUB(b.x)], 1u);
        const unsigned gen = old / nloc;
        if (old + 1u == (gen + 1u) * nloc) {
            __builtin_amdgcn_fence(__ATOMIC_RELEASE, "agent");
            asm volatile("s_waitcnt vmcnt(0)" ::: "memory");
            const unsigned og = xb_add(&bar[XB_TOP], 1u);
            const unsigned tg = og / nx;
            if (og + 1u == (tg + 1u) * nx) xb_add(&bar[XB_TOPGEN], 1u);
            else XB_SPIN(xb_ld(&bar[XB_TOPGEN]) == tg, bar);
            __builtin_amdgcn_fence(__ATOMIC_ACQUIRE, "agent");
            xb_add(&bar[XB_XGEN(b.x)], 1u);
            asm volatile("s_waitcnt vmcnt(0)" ::: "memory");
        } else {
            XB_SPIN(xb_ld(&bar[XB_XGEN(b.x)]) == gen, bar);
            __builtin_amdgcn_fence(__ATOMIC_ACQUIRE, "agent");
            asm volatile("s_waitcnt vmcnt(0)" ::: "memory");
        }
    }
    __syncthreads();
}

template <class Epi>
__device__ __forceinline__ void gemm_run(float* lds, const bf16_t* A, const bf16_t* Bt, int M, int N, int K, const Epi& E) {
    __syncthreads();
    pg8::Gemm g{A, Bt, M, N, K}; pg8::StaticOrder S; S.init(M, N, (int)gridDim.x, (int)blockIdx.x);
    pg8::gemm_phase<Epi, pg8::StaticOrder, true, true>((PG8_LAS unsigned char*)lds, g, S, E);
    __syncthreads();
}
constexpr int NPHASE = 11;
template <int PH>
__device__ __forceinline__ void run_phase(const Params& p, int bid, int nb, float* lds) {
    asm volatile("" : "+s"(bid));
    if constexpr (PH == 0) ph_prep(p, bid, nb, lds);
    if constexpr (PH == 1) ph_modnorm(p, p.x, p.norm1_g, 0 * DM, 1 * DM, p.hb, bid, nb, lds);
    if constexpr (PH == 2) gemm_run(lds, p.hb, p.Wt1, NTOK, ZW, DM, pg8::EpiZG{p.ZG, p.b_bg});
    if constexpr (PH == 3) { ph_retprep(p, bid, nb, lds); ph_gmlp2(p, bid, nb, lds); }
    if constexpr (PH == 11) ph_ret2(p, bid, nb, lds);
    if constexpr (PH == 4) ph_gn(p, bid, nb, lds);
    if constexpr (PH == 5) {
        gemm_run(lds, p.yain, p.Wta, NTOK, DM, 1024, pg8::EpiMixB<0>{p.hb, p.ZG, 0});
        gemm_run(lds, p.ybin, p.Wtb, NTOK, DM, DM, pg8::EpiMixB<1>{p.hb, p.ZG, 2048});
    }
    if constexpr (PH == 6) gemm_run(lds, p.hb, p.Wto, NTOK, DM, DM, pg8::EpiResF{p.obuf, p.x, p.ada + 2 * DM});
    if constexpr (PH == 7) { ph_modnorm(p, p.obuf, p.norm2_g, 3 * DM, 4 * DM, p.hb, bid, nb, lds); ph_tabconv(p, bid, nb); }
    if constexpr (PH == 8) gemm_run(lds, p.hb, p.Wtq, NTOK, DM, DM, pg8::EpiF32{p.qbuf, DM});
    if constexpr (PH == 9) ph_topk2(p, p.qbuf, bid, nb, lds);
    if constexpr (PH == 10) ph_peer3(p, p.obuf, p.hb, bid, nb);
}

constexpr int MISC_OFF = 132 * 1024;
__global__ void __launch_bounds__(NTH) k_mega(Params p) {
    extern __shared__ __attribute__((aligned(16))) float lds[];
    const int bid = blockIdx.x, nb = gridDim.x;
    volatile LAS unsigned* misc = (volatile LAS unsigned*)((LAS unsigned char*)lds + MISC_OFF);
    if (threadIdx.x < 4) misc[threadIdx.x] = 0u;
    __syncthreads();
    XcdBarrier bar = xcd_barrier_post(p.bar, misc);
    run_phase<0>(p, bid, nb, lds); xcd_barrier(bar);
    run_phase<1>(p, bid, nb, lds); xcd_barrier(bar);
    run_phase<2>(p, bid, nb, lds); xcd_barrier(bar);
    run_phase<3>(p, bid, nb, lds); xcd_barrier(bar);
    run_phase<11>(p, bid, nb, lds); xcd_barrier(bar);
    run_phase<4>(p, bid, nb, lds); xcd_barrier(bar);
    run_phase<5>(p, bid, nb, lds); xcd_barrier(bar);
    run_phase<6>(p, bid, nb, lds); xcd_barrier(bar);
    run_phase<7>(p, bid, nb, lds); xcd_barrier(bar);
    run_phase<8>(p, bid, nb, lds); xcd_barrier(bar);
    run_phase<9>(p, bid, nb, lds); xcd_barrier(bar);
    run_phase<10>(p, bid, nb, lds);
}

extern "C" void kernel_launch(void* const* d_in, const int* in_sizes, int n_in, void* d_out, int out_size, void* d_ws, size_t ws_size, hipStream_t stream) {
    Params p{};
    p.x = (const float*)d_in[0]; p.c = (const float*)d_in[1]; p.pos = (const int*)d_in[2];
    p.w_ada = (const float*)d_in[3]; p.b_ada = (const float*)d_in[4]; p.norm1_g = (const float*)d_in[5]; p.w_in = (const float*)d_in[6];
    p.w_bg = (const float*)d_in[7]; p.b_bg = (const float*)d_in[8]; p.gm_v_g = (const float*)d_in[9]; p.gm_ws = (const float*)d_in[10];
    p.gm_b = (const float*)d_in[11]; p.ret_gn_g = (const float*)d_in[12]; p.w_a_out = (const float*)d_in[13]; p.w_b_out = (const float*)d_in[14];
    p.w_o = (const float*)d_in[15]; p.norm2_g = (const float*)d_in[16]; p.peer_wq = (const float*)d_in[17]; p.peer_sk = (const float*)d_in[18];
    p.peer_u = (const float*)d_in[19]; p.peer_v = (const float*)d_in[20]; p.norm_f_g = (const float*)d_in[21];
    p.out = (float*)d_out;
    char* w = (char*)d_ws; size_t off = 0;
    auto take = [&](size_t bytes) { char* r = w + off; off += (bytes + 255) & ~(size_t)255; return r; };
    p.bar = (unsigned*)take(XCD_BAR_WORDS * 4);
    p.ada = (float*)take(2 * NMOD * 4);
    p.rope = (float*)take((size_t)NTOK * 128 * 4);
    p.eidx = (int*)take((size_t)NTOK * 128 * 4);
    p.gatev = (float*)take((size_t)NTOK * 128 * 4);
    p.Wt1 = (bf16_t*)take((size_t)ZW * DM * 2);
    p.Wta = (bf16_t*)take((size_t)DM * 1024 * 2);
    p.Wtb = (bf16_t*)take((size_t)DM * DM * 2);
    p.Wto = (bf16_t*)take((size_t)DM * DM * 2);
    p.Wtq = (bf16_t*)take((size_t)DM * DM * 2);
    p.hb = (bf16_t*)take((size_t)NTOK * DM * 2);
    p.ZG = (bf16_t*)take((size_t)NTOK * ZW * 2);
    p.qbuf = (float*)p.ZG;
    p.obuf = (float*)take((size_t)NTOK * DM * 4);
    p.ybin = (bf16_t*)take((size_t)NTOK * DM * 2);
    p.yain = (bf16_t*)take((size_t)NTOK * 1024 * 2);
    p.U8 = (unsigned char*)p.ZG + (size_t)NTOK * DM * 4;
    p.V8 = p.U8 + (size_t)16384 * ROW6;
    p.su = (float*)take(16384 * 4); p.sv = (float*)take(16384 * 4);
    p.Qr = (bf16_t*)take((size_t)NTOK * 1024 * 2);
    p.Kr = (bf16_t*)take((size_t)NTOK * 1024 * 2);
    p.KTd = (bf16_t*)take((size_t)NTOK * 1024 * 2);
    p.Vt = (bf16_t*)take((size_t)NTOK * 2048 * 2);
    p.ob16 = (bf16_t*)take((size_t)NTOK * DM * 2);
    if (off > ws_size) { fprintf(stderr, "kernel_launch: workspace too small: need %zu have %zu\n", off, ws_size); return; }
    static int grid = 0;
    if (!grid) {
        int dev = 0, cus = 0, per_cu = 0;
        (void)hipGetDevice(&dev); (void)hipDeviceGetAttribute(&cus, hipDeviceAttributeMultiprocessorCount, dev);
        (void)hipFuncSetAttribute((const void*)k_mega, hipFuncAttributeMaxDynamicSharedMemorySize, LDS_BYTES);
        (void)hipOccupancyMaxActiveBlocksPerMultiprocessor(&per_cu, k_mega, NTH, LDS_BYTES);
        (void)per_cu;
        grid = cus;
    }
    (void)hipMemsetAsync(p.bar, 0, XCD_BAR_WORDS * 4, stream);
    hipLaunchKernelGGL(k_mega, dim3(grid), dim3(NTH), LDS_BYTES, stream, p);
    hipError_t e = hipPeekAtLastError();
    if (e != hipSuccess) fprintf(stderr, "launch failed: %s (grid %d)\n", hipGetErrorString(e), grid);
}
```

```cpp
#include <hip/hip_runtime.h>
#include <hip/hip_cooperative_groups.h>
#include <stdint.h>
#include <math.h>
#include <cstdio>

namespace cg = cooperative_groups;

constexpr int DM = 2048;
constexpr int SQ = 4096;
constexpr int NTOK = 8192;
constexpr int NTH = 512;
constexpr int ZW = 12288;
constexpr int NMOD = 12288;
constexpr int LDS_BYTES = 136 * 1024;

typedef unsigned short bf16_t;

struct Params {
    const float *x, *c; const int* pos;
    const float *w_ada, *b_ada, *norm1_g, *w_in, *w_bg, *b_bg, *gm_v_g, *gm_ws, *gm_b, *ret_gn_g, *w_a_out, *w_b_out, *w_o, *norm2_g,
                *peer_wq, *peer_sk, *peer_u, *peer_v, *norm_f_g;
    float* out;
    float *ada, *rope, *gatev; int* eidx;
    bf16_t *Wt1, *Wta, *Wtb, *Wto, *Wtq;
    bf16_t *hb;
    bf16_t *ZG;
    float *obuf;
    bf16_t *ybin, *yain;
    float *qbuf;
    unsigned char *U8, *V8;
    float *su, *sv;
    bf16_t *Qr, *Kr, *KTd, *Vt;
    bf16_t *ob16;
    unsigned *bar;
};

__constant__ float c_freq[64] = {
1.000000000e+00f, 8.659643531e-01f, 7.498942018e-01f, 6.493816376e-01f, 5.623413324e-01f, 4.869675338e-01f, 4.216965139e-01f, 3.651741147e-01f, 3.162277639e-01f, 2.738419771e-01f, 2.371373773e-01f, 2.053525001e-01f, 1.778279394e-01f, 1.539926529e-01f, 1.333521456e-01f, 1.154781953e-01f, 1.000000015e-01f, 8.659642935e-02f, 7.498942316e-02f, 6.493816525e-02f, 5.623413250e-02f, 4.869675264e-02f, 4.216964915e-02f, 3.651741147e-02f, 3.162277490e-02f, 2.738419548e-02f, 2.371373773e-02f, 2.053525113e-02f, 1.778279431e-02f, 1.539926510e-02f, 1.333521400e-02f, 1.154781971e-02f, 9.999999776e-03f, 8.659643121e-03f, 7.498942316e-03f, 6.493816152e-03f, 5.623413250e-03f, 4.869675264e-03f, 4.216964822e-03f, 3.651741194e-03f, 3.162277630e-03f, 2.738419687e-03f, 2.371373819e-03f, 2.053525066e-03f, 1.778279431e-03f, 1.539926510e-03f, 1.333521446e-03f, 1.154782018e-03f, 1.000000047e-03f, 8.659643354e-04f, 7.498941850e-04f, 6.493816036e-04f, 5.623413017e-04f, 4.869675322e-04f, 4.216965172e-04f, 3.651741135e-04f, 3.162277571e-04f, 2.738419571e-04f, 2.371373703e-04f, 2.053525095e-04f, 1.778279402e-04f, 1.539926598e-04f, 1.333521504e-04f, 1.154782003e-04f };

__device__ __forceinline__ int tid_() { int t = threadIdx.x; asm volatile("" : "+v"(t)); return t; }
__device__ __forceinline__ float wave_sum(float v) {
#pragma unroll
    for (int o = 1; o < 64; o <<= 1) v += __shfl_xor(v, o);
    return v;
}
__device__ __forceinline__ float wave_max(float v) {
#pragma unroll
    for (int o = 1; o < 64; o <<= 1) v = fmaxf(v, __shfl_xor(v, o));
    return v;
}
__device__ __forceinline__ float sigmoidf_(float x) { return 1.0f / (1.0f + expf(-x)); }
__device__ __forceinline__ float siluf_(float x) { return x * sigmoidf_(x); }
__device__ __forceinline__ float geluf_(float x) { return 0.5f * x * (1.0f + erff(x * 0.70710678118654752f)); }
__device__ __forceinline__ float dot4(float4 a, float4 b) { return a.x * b.x + a.y * b.y + a.z * b.z + a.w * b.w; }
__device__ __forceinline__ float bf2f(bf16_t v) { return __uint_as_float((unsigned)v << 16); }
__device__ __forceinline__ float bflo(unsigned w) { return __uint_as_float(w << 16); }
__device__ __forceinline__ float bfhi(unsigned w) { return __uint_as_float(w & 0xffff0000u); }
__device__ __forceinline__ unsigned f2bf(float f) { unsigned u = __float_as_uint(f); return (u + 0x7fffu + ((u >> 16) & 1u)) >> 16; }
__device__ __forceinline__ unsigned pk2(float lo, float hi) { return f2bf(lo) | (f2bf(hi) << 16); }

__device__ __forceinline__ void sincos_acc(float ang, float& s, float& c) {
    const double x = (double)ang;
    const double k = rint(x * 0.63661977236758134308);
    double r = fma(-k, 1.57079632679489655800, x); r = fma(-k, 6.12323399573676603587e-17, r);
    const double r2 = r * r;
    const double sp = r * (1.0 + r2 * (-1.0 / 6.0 + r2 * (1.0 / 120.0 + r2 * (-1.0 / 5040.0 + r2 * (1.0 / 362880.0 + r2 * (-1.0 / 39916800.0 + r2 * (1.0 / 6227020800.0)))))));
    const double cp = 1.0 + r2 * (-0.5 + r2 * (1.0 / 24.0 + r2 * (-1.0 / 720.0 + r2 * (1.0 / 40320.0 + r2 * (-1.0 / 3628800.0 + r2 * (1.0 / 479001600.0 + r2 * (-1.0 / 87178291200.0)))))));
    const int q = ((int)k) & 3;
    const float fs = (float)sp, fc = (float)cp;
    s = (q == 0) ? fs : (q == 1) ? fc : (q == 2) ? -fs : -fc;
    c = (q == 0) ? fc : (q == 1) ? -fs : (q == 2) ? -fc : fs;
}

namespace pg8 {
#define PG8_LAS __attribute__((address_space(3)))
typedef unsigned short bf16_t;
typedef short bf16x8 __attribute__((ext_vector_type(8)));
typedef float f32x4 __attribute__((ext_vector_type(4)));
typedef unsigned u32x4 __attribute__((ext_vector_type(4)));
constexpr int BM = 256, BK = 64, HALF = 128, HTB = HALF * BK * 2  , STAGE_BYTES = 8 * HTB, NXCD = 8, WGM = 8;

__host__ __device__ __forceinline__ int lds_byte(int r, int c) { const int st = (r >> 4) * 2 + (c >> 5), rr = r & 15, cc = c & 31, ob = rr * 64 + cc * 2; return st * 1024 + (ob ^ (((ob >> 9) & 1) << 5)); }
__host__ __device__ __forceinline__ void stage_rc(int b, int& R, int& C) { const int st = b / 1024, sb = b % 1024, swz = sb ^ (((sb >> 9) & 1) << 5); R = (st >> 1) * 16 + swz / 64; C = (st & 1) * 32 + (swz % 64) / 2; }
__host__ __device__ __forceinline__ int perm32(int rho) { const int n = rho >> 4, i = rho & 15; return 8 * (i >> 2) + 4 * n + (i & 3); }

struct Unit { int pm, pn; };
struct Gemm { const bf16_t* A; const bf16_t* Bt; int M, N, K; };

struct StaticOrder {
    int nM, nN, nwg, G, c;
    __host__ __device__ void init(int M, int N, int G_, int c_) { nM = M / BM; nN = N / BM; nwg = nM * nN; G = G_; c = c_; }
    __host__ __device__ bool next(int i, Unit& u) const {
        const long L = (long)i * G + c; if (L >= nwg) return false;
        int wgid = (int)L; { const int q = nwg / NXCD, r = nwg % NXCD, xcd = wgid % NXCD, off = wgid / NXCD; wgid = (xcd < r ? xcd * (q + 1) : r * (q + 1) + (xcd - r) * q) + off; }
        const int nig = WGM * nN, gid = wgid / nig, fm = gid * WGM, gsz = (nM - fm) < WGM ? (nM - fm) : WGM;
        u.pm = fm + ((wgid % nig) % gsz); u.pn = (wgid % nig) / gsz; return true;
    }
    __device__ __forceinline__ void a_ready(const Unit&) const {}
    __device__ __forceinline__ void done(const Unit&) const {}
};

__device__ __forceinline__ unsigned cvt_pk_bf16(float lo, float hi) { unsigned r; asm volatile("v_cvt_pk_bf16_f32 %0, %1, %2" : "=v"(r) : "v"(lo), "v"(hi)); return r; }
typedef float f32x2 __attribute__((ext_vector_type(2)));
__device__ __forceinline__ f32x2 gelu_pk(f32x2 v) {
    const f32x2 av = __builtin_elementwise_abs(v), d = av * 0.2316418882f + 1.0f;
    f32x2 t; t.x = __builtin_amdgcn_rcpf(d.x); t.y = __builtin_amdgcn_rcpf(d.y);
    f32x2 q = t * 0.5307027145f + (-0.7265760135f); q = q * t + 0.7107068705f; q = q * t + (-0.142248368f); q = q * t + 0.127414796f; q = q * t;
    const f32x2 s = (v * v) * (-0.72134752044f);
    f32x2 e; e.x = __builtin_amdgcn_exp2f(s.x); e.y = __builtin_amdgcn_exp2f(s.y);
    const f32x2 m = v * (q * e), r = v - m;
    f32x2 o; o.x = v.x < 0.f ? m.x : r.x; o.y = v.y < 0.f ? m.y : r.y; return o;
}

typedef unsigned u32x2v __attribute__((ext_vector_type(2)));
struct EpiZG {
    static constexpr bool PERM = true, AFTER_DRAIN = false;
    bf16_t* O; const float* bias;
    __device__ __forceinline__ void operator()(const f32x4 (&acc)[2][2][4][2], const Unit& u, int wr, int wc, int fr, int fq) const {
        const int row0 = u.pm * BM + wr * 64 + fr, col0 = u.pn * BM + wc * 32 + 8 * fq;
        const int mode = u.pn < 8 ? 1 : (u.pn < 32 ? 0 : 2);
        f32x4 bv[2][2];
#pragma unroll
        for (int bj = 0; bj < 2; ++bj)
#pragma unroll
            for (int n = 0; n < 2; ++n) bv[bj][n] = (mode == 2) ? *(const f32x4*)(bias + (col0 - 8192) + bj * HALF + 4 * n) : (f32x4){0.f, 0.f, 0.f, 0.f};
#pragma unroll
        for (int ai = 0; ai < 2; ++ai)
#pragma unroll
            for (int m = 0; m < 4; ++m) { bf16_t* rowp = O + (size_t)(row0 + ai * HALF + m * 16) * ZW + col0;
#pragma unroll
                for (int bj = 0; bj < 2; ++bj) { f32x4 v0 = acc[ai][bj][m][0], v1 = acc[ai][bj][m][1];
                    if (mode == 1) { f32x2 a = gelu_pk((f32x2){v0[0], v0[1]}), b = gelu_pk((f32x2){v0[2], v0[3]}), c = gelu_pk((f32x2){v1[0], v1[1]}), d = gelu_pk((f32x2){v1[2], v1[3]});
                        v0 = (f32x4){a.x, a.y, b.x, b.y}; v1 = (f32x4){c.x, c.y, d.x, d.y}; }
                    if (mode == 2) { v0 = v0 + bv[bj][0]; v1 = v1 + bv[bj][1];
#pragma unroll
                        for (int e = 0; e < 4; ++e) { v0[e] = __builtin_amdgcn_rcpf(1.0f + __expf(-v0[e])); v1[e] = __builtin_amdgcn_rcpf(1.0f + __expf(-v1[e])); } }
                    u32x4 w; w.x = cvt_pk_bf16(v0[0], v0[1]); w.y = cvt_pk_bf16(v0[2], v0[3]); w.z = cvt_pk_bf16(v1[0], v1[1]); w.w = cvt_pk_bf16(v1[2], v1[3]);
                    *(u32x4*)(rowp + bj * HALF) = w; } }
    }
};
template <int ACCUM> struct EpiMixB {
    static constexpr bool PERM = true, AFTER_DRAIN = false;
    bf16_t* Mo; const bf16_t* ZGp; int goff;
    __device__ __forceinline__ void operator()(const f32x4 (&acc)[2][2][4][2], const Unit& u, int wr, int wc, int fr, int fq) const {
        const int row0 = u.pm * BM + wr * 64 + fr, col0 = u.pn * BM + wc * 32 + 8 * fq;
#pragma unroll
        for (int ai = 0; ai < 2; ++ai)
#pragma unroll
            for (int m = 0; m < 4; ++m) { const size_t row = (size_t)(row0 + ai * HALF + m * 16);
#pragma unroll
                for (int bj = 0; bj < 2; ++bj) { const f32x4 v0 = acc[ai][bj][m][0], v1 = acc[ai][bj][m][1];
                    const u32x4 g = *(const u32x4*)(ZGp + row * ZW + 8192 + goff + col0 + bj * HALF);
                    float o[8];
                    o[0] = bflo(g.x) * v0[0]; o[1] = bfhi(g.x) * v0[1]; o[2] = bflo(g.y) * v0[2]; o[3] = bfhi(g.y) * v0[3];
                    o[4] = bflo(g.z) * v1[0]; o[5] = bfhi(g.z) * v1[1]; o[6] = bflo(g.w) * v1[2]; o[7] = bfhi(g.w) * v1[3];
                    bf16_t* mp = Mo + row * DM + col0 + bj * HALF;
                    if (ACCUM) { const u32x4 old = *(const u32x4*)mp;
                        o[0] += bflo(old.x); o[1] += bfhi(old.x); o[2] += bflo(old.y); o[3] += bfhi(old.y); o[4] += bflo(old.z); o[5] += bfhi(old.z); o[6] += bflo(old.w); o[7] += bfhi(old.w); }
                    u32x4 w; w.x = cvt_pk_bf16(o[0], o[1]); w.y = cvt_pk_bf16(o[2], o[3]); w.z = cvt_pk_bf16(o[4], o[5]); w.w = cvt_pk_bf16(o[6], o[7]);
                    *(u32x4*)mp = w; } }
    }
};
struct EpiResF {
    static constexpr bool PERM = false, AFTER_DRAIN = false;
    float* x1; const float* x; const float* ga;
    __device__ __forceinline__ void operator()(const f32x4 (&acc)[2][2][4][2], const Unit& u, int wr, int wc, int fr, int fq) const {
        const int row0 = u.pm * BM + wr * 64 + fr, col0 = u.pn * BM + wc * 32 + 4 * fq;
        const int b = (u.pm * BM) / SQ;
        f32x4 gv[2][2];
#pragma unroll
        for (int bj = 0; bj < 2; ++bj)
#pragma unroll
            for (int n = 0; n < 2; ++n) gv[bj][n] = *(const f32x4*)(ga + b * NMOD + col0 + bj * HALF + n * 16);
#pragma unroll
        for (int ai = 0; ai < 2; ++ai)
#pragma unroll
            for (int m = 0; m < 4; ++m) { const size_t off = (size_t)(row0 + ai * HALF + m * 16) * DM + col0;
#pragma unroll
                for (int bj = 0; bj < 2; ++bj)
#pragma unroll
                    for (int n = 0; n < 2; ++n) { const f32x4 xv = *(const f32x4*)(x + off + bj * HALF + n * 16);
                        *(f32x4*)(x1 + off + bj * HALF + n * 16) = xv + gv[bj][n] * acc[ai][bj][m][n]; } }
    }
};
struct EpiF32 {
    static constexpr bool PERM = false, AFTER_DRAIN = false;
    float* O; int ldc;
    __device__ __forceinline__ void operator()(const f32x4 (&acc)[2][2][4][2], const Unit& u, int wr, int wc, int fr, int fq) const {
        const int row0 = u.pm * BM + wr * 64 + fr, col0 = u.pn * BM + wc * 32 + 4 * fq;
#pragma unroll
        for (int ai = 0; ai < 2; ++ai)
#pragma unroll
            for (int m = 0; m < 4; ++m) { const size_t off = (size_t)(row0 + ai * HALF + m * 16) * ldc + col0;
#pragma unroll
                for (int bj = 0; bj < 2; ++bj)
#pragma unroll
                    for (int n = 0; n < 2; ++n) *(f32x4*)(O + off + bj * HALF + n * 16) = acc[ai][bj][m][n]; }
    }
};

template <class Epi, class Sched, bool ALIGN_EPI = false, bool SP2 = false>
__device__ __forceinline__ void gemm_phase(PG8_LAS unsigned char* lds, const Gemm g, const Sched& S, const Epi& E) {
    const int tid = threadIdx.x, wid = __builtin_amdgcn_readfirstlane(tid >> 6), lane = tid & 63, wr = wid >> 2, wc = wid & 3, fr = lane & 15, fq = lane >> 4;
    const int K = g.K, nt = K / BK;
    unsigned voffA[2], voffB[2];
#pragma unroll
    for (int i = 0; i < 2; ++i) { int R, C; stage_rc(tid * 16 + i * 8192, R, C); const int Rb = Epi::PERM ? ((R & ~31) + perm32(R & 31)) : R;
        voffA[i] = (unsigned)(R * K + C) * 2u; voffB[i] = (unsigned)(Rb * K + C) * 2u; }
    const size_t kstep = (size_t)(BK * 2);
    const size_t hstep = (size_t)HALF * K * 2;
    const size_t tstep = 2 * hstep;
    const unsigned ldsw = (unsigned)wid * 1024u;
    const int aoff = lds_byte(wr * 64 + fr, fq * 8), boff = lds_byte(wc * 32 + fr, fq * 8);
#define PG8_SA(b, h) (((b) * 2 + (h)) * HTB)
#define PG8_SB(b, h) ((4 + (b) * 2 + (h)) * HTB)
#define PG8_STAGE(bufoff, gbase, voff) do { _Pragma("unroll") for (int _i = 0; _i < 2; ++_i) \
        __builtin_amdgcn_global_load_lds((const unsigned*)((const char*)(gbase) + (voff)[_i]), (PG8_LAS unsigned*)(lds + (bufoff) + ldsw + _i * 8192), 16, 0, 0); } while (0)
#define PG8_LDA(dst, b, h) do { _Pragma("unroll") for (int m = 0; m < 4; ++m) _Pragma("unroll") for (int k = 0; k < 2; ++k) dst[m][k] = *(const PG8_LAS bf16x8*)(lds + PG8_SA(b, h) + aoff + m * 2048 + k * 1024); } while (0)
#define PG8_LDB(dst, b, h) do { _Pragma("unroll") for (int n = 0; n < 2; ++n) _Pragma("unroll") for (int k = 0; k < 2; ++k) dst[n][k] = *(const PG8_LAS bf16x8*)(lds + PG8_SB(b, h) + boff + n * 2048 + k * 1024); } while (0)
#define PG8_MMA(ai, bj, At, Bt) do { __builtin_amdgcn_s_setprio(1); _Pragma("unroll") for (int m = 0; m < 4; ++m) _Pragma("unroll") for (int n = 0; n < 2; ++n) _Pragma("unroll") for (int k = 0; k < 2; ++k) \
        acc[ai][bj][m][n] = __builtin_amdgcn_mfma_f32_16x16x32_bf16(Bt[n][k], At[m][k], acc[ai][bj][m][n], 0, 0, 0); __builtin_amdgcn_s_setprio(0); } while (0)
#define PG8_WAIT_V(n) asm volatile("s_waitcnt vmcnt(" #n ")" ::: "memory")
#define PG8_WAIT_L(n) asm volatile("s_waitcnt lgkmcnt(" #n ")" ::: "memory")
#define PG8_BAR __builtin_amdgcn_s_barrier()
#define PG8_SCHED __builtin_amdgcn_sched_barrier(0)
    Unit cur, nxt; int ui = 0;
    if (!S.next(0, cur)) return;
    f32x4 acc[2][2][4][2];
#pragma unroll
    for (int a = 0; a < 2; ++a)
#pragma unroll
        for (int b = 0; b < 2; ++b)
#pragma unroll
            for (int m = 0; m < 4; ++m)
#pragma unroll
                for (int n = 0; n < 2; ++n) acc[a][b][m][n] = (f32x4){0.f, 0.f, 0.f, 0.f};
    bf16x8 At[4][2], B0[2][2], B1[2][2];
    const char* cA = (const char*)g.A + (size_t)cur.pm * tstep; const char* cB = (const char*)g.Bt + (size_t)cur.pn * tstep;
    S.a_ready(cur);
    if constexpr (SP2) {
        PG8_STAGE(PG8_SB(0, 0), cB, voffB); PG8_STAGE(PG8_SB(0, 1), cB + hstep, voffB); PG8_STAGE(PG8_SA(0, 0), cA, voffA); PG8_STAGE(PG8_SA(0, 1), cA + hstep, voffA);
        if (wr == 1) PG8_BAR;
        PG8_WAIT_V(2); PG8_BAR;
        PG8_STAGE(PG8_SB(1, 0), cB + kstep, voffB); PG8_STAGE(PG8_SA(1, 0), cA + kstep, voffA); PG8_STAGE(PG8_SB(1, 1), cB + hstep + kstep, voffB);
        PG8_WAIT_V(6); PG8_BAR;
    } else {
        PG8_STAGE(PG8_SB(0, 0), cB, voffB); PG8_STAGE(PG8_SA(0, 0), cA, voffA); PG8_STAGE(PG8_SB(0, 1), cB + hstep, voffB); PG8_STAGE(PG8_SA(0, 1), cA + hstep, voffA);
        if (wr == 1) PG8_BAR;
        PG8_WAIT_V(4); PG8_BAR;
        PG8_STAGE(PG8_SB(1, 0), cB + kstep, voffB); PG8_STAGE(PG8_SA(1, 0), cA + kstep, voffA); PG8_STAGE(PG8_SB(1, 1), cB + hstep + kstep, voffB);
        PG8_WAIT_V(6); PG8_BAR;
    }
    for (;;) {
        const bool has_next = S.next(ui + 1, nxt);
        const char* nA = has_next ? (const char*)g.A + (size_t)nxt.pm * tstep : cA; const char* nB = has_next ? (const char*)g.Bt + (size_t)nxt.pn * tstep : cB;
        for (int t = 0; t < nt; t += 2) {
            const bool last = (t == nt - 2);
            const char* a1 = cA + (size_t)(t + 1) * kstep;
            const char* a2 = last ? nA : cA + (size_t)(t + 2) * kstep; const char* b2 = last ? nB : cB + (size_t)(t + 2) * kstep;
            const char* a3 = a2 + kstep; const char* b3 = b2 + kstep;
            if (last && has_next) S.a_ready(nxt);
            if constexpr (SP2) {
            PG8_LDB(B0, 0, 0); PG8_LDB(B1, 0, 1); PG8_SCHED; PG8_LDA(At, 0, 0); PG8_STAGE(PG8_SA(1, 1), a1 + hstep, voffA);
            PG8_WAIT_V(8); PG8_WAIT_L(0); PG8_BAR; PG8_MMA(0, 0, At, B0); PG8_MMA(0, 1, At, B1); PG8_BAR; PG8_SCHED;
            PG8_LDA(At, 0, 1); PG8_STAGE(PG8_SB(0, 0), b2, voffB); PG8_STAGE(PG8_SB(0, 1), b2 + hstep, voffB); PG8_STAGE(PG8_SA(0, 0), a2, voffA);
            PG8_WAIT_V(8); PG8_WAIT_L(0); PG8_BAR; PG8_MMA(1, 0, At, B0); PG8_MMA(1, 1, At, B1); PG8_BAR; PG8_SCHED;
            PG8_LDB(B0, 1, 0); PG8_LDB(B1, 1, 1); PG8_SCHED; PG8_LDA(At, 1, 0); PG8_STAGE(PG8_SA(0, 1), a2 + hstep, voffA);
            PG8_WAIT_V(8); PG8_WAIT_L(0); PG8_BAR; PG8_MMA(0, 0, At, B0); PG8_MMA(0, 1, At, B1); PG8_BAR; PG8_SCHED;
            PG8_LDA(At, 1, 1); PG8_STAGE(PG8_SB(1, 0), b3, voffB); PG8_STAGE(PG8_SB(1, 1), b3 + hstep, voffB); PG8_STAGE(PG8_SA(1, 0), a3, voffA);
            PG8_WAIT_V(8); PG8_WAIT_L(0); PG8_BAR; PG8_MMA(1, 0, At, B0); PG8_MMA(1, 1, At, B1); PG8_BAR; PG8_SCHED;
            } else {
            PG8_LDB(B0, 0, 0); PG8_SCHED; PG8_LDA(At, 0, 0); PG8_STAGE(PG8_SA(1, 1), a1 + hstep, voffA);
            PG8_WAIT_L(8); PG8_BAR; PG8_WAIT_L(0); PG8_MMA(0, 0, At, B0); PG8_BAR; PG8_SCHED;
            PG8_LDB(B1, 0, 1); PG8_STAGE(PG8_SB(0, 0), b2, voffB);
            PG8_BAR; PG8_WAIT_L(0); PG8_MMA(0, 1, At, B1); PG8_BAR;
            PG8_LDA(At, 0, 1); PG8_STAGE(PG8_SA(0, 0), a2, voffA);
            PG8_BAR; PG8_WAIT_L(0); PG8_MMA(1, 0, At, B0); PG8_BAR; PG8_SCHED;
            PG8_STAGE(PG8_SB(0, 1), b2 + hstep, voffB);
            PG8_WAIT_V(6); PG8_BAR; PG8_MMA(1, 1, At, B1); PG8_BAR;
            PG8_LDB(B0, 1, 0); PG8_SCHED; PG8_LDA(At, 1, 0); PG8_STAGE(PG8_SA(0, 1), a2 + hstep, voffA);
            PG8_WAIT_L(8); PG8_BAR; PG8_WAIT_L(0); PG8_MMA(0, 0, At, B0); PG8_BAR; PG8_SCHED;
            PG8_LDB(B1, 1, 1); PG8_STAGE(PG8_SB(1, 0), b3, voffB);
            PG8_BAR; PG8_WAIT_L(0); PG8_MMA(0, 1, At, B1); PG8_BAR;
            PG8_LDA(At, 1, 1); PG8_STAGE(PG8_SA(1, 0), a3, voffA);
            PG8_BAR; PG8_WAIT_L(0); PG8_MMA(1, 0, At, B0); PG8_BAR; PG8_SCHED;
            PG8_STAGE(PG8_SB(1, 1), b3 + hstep, voffB);
            PG8_WAIT_V(6); PG8_BAR; PG8_MMA(1, 1, At, B1); PG8_BAR;
            }
        }
        if constexpr (ALIGN_EPI) { if (wr == 0) PG8_BAR; }
        if constexpr (!Epi::AFTER_DRAIN) { E(acc, cur, wr, wc, fr, fq); S.done(cur); }
        if (!has_next) break;
#pragma unroll
        for (int a = 0; a < 2; ++a)
#pragma unroll
            for (int b = 0; b < 2; ++b)
#pragma unroll
                for (int m = 0; m < 4; ++m)
#pragma unroll
                    for (int n = 0; n < 2; ++n) acc[a][b][m][n] = (f32x4){0.f, 0.f, 0.f, 0.f};
        cur = nxt; cA = nA; cB = nB; ++ui;
        if constexpr (ALIGN_EPI) { if (wr == 1) PG8_BAR; }
    }
    PG8_WAIT_V(0);
    if constexpr (!ALIGN_EPI) { if (wr == 0) PG8_BAR; }
    PG8_BAR;
    if constexpr (Epi::AFTER_DRAIN) { E.fused(acc, cur, wr, wc, fr, fq, lds, wid, lane); S.done(cur); }
#undef PG8_SA
#undef PG8_SB
#undef PG8_STAGE
#undef PG8_LDA
#undef PG8_LDB
#undef PG8_MMA
#undef PG8_WAIT_V
#undef PG8_WAIT_L
#undef PG8_BAR
#undef PG8_SCHED
}
}
using pg8::f32x4; using pg8::u32x4;

__device__ __forceinline__ void transpose_item(const float* W, int K, int N, bf16_t* WT, int row_off, float* scr, int item, int lane) {
    const int nblk = N / 32, kb = item / nblk, nbk = item % nblk, k0 = 64 * kb, n0 = 32 * nbk;
#pragma unroll 8
    for (int i = 0; i < 32; ++i) { const int kk = 2 * i + (lane >> 5); scr[kk * 33 + (lane & 31)] = W[(size_t)(k0 + kk) * N + n0 + (lane & 31)]; }
    asm volatile("s_waitcnt lgkmcnt(0)" ::: "memory");
    const int c = lane & 7;
#pragma unroll
    for (int j = 0; j < 4; ++j) { const int n = (lane >> 3) + 8 * j; const float* s = scr + (8 * c) * 33 + n;
        uint4 o; o.x = pk2(s[0 * 33], s[1 * 33]); o.y = pk2(s[2 * 33], s[3 * 33]); o.z = pk2(s[4 * 33], s[5 * 33]); o.w = pk2(s[6 * 33], s[7 * 33]);
        *(uint4*)(WT + (size_t)(row_off + n0 + n) * K + k0 + 8 * c) = o; }
    asm volatile("s_waitcnt lgkmcnt(0)" ::: "memory");
}
__device__ __forceinline__ void ph_prep(const Params& p, int bid, int nb, float* lds) {
    const int tid = tid_(), wave = tid >> 6, lane = tid & 63;
    {
        float* sl = lds;
        float* red = lds + 4096;
        for (int i = tid; i < 4096; i += NTH) sl[i] = siluf_(p.c[i]);
        __syncthreads();
        for (int it = bid; it < 192; it += nb) {
            const int c4 = tid & 15, kg = tid >> 4;
            const float* wp = p.w_ada + (size_t)kg * NMOD + it * 64 + c4 * 4;
            float a0[4] = {0.f, 0.f, 0.f, 0.f}, a1[4] = {0.f, 0.f, 0.f, 0.f};
#pragma unroll 8
            for (int i = 0; i < 64; ++i) {
                const int k = kg + 32 * i;
                const float4 w = *(const float4*)(wp + (size_t)(32 * i) * NMOD);
                const float s0 = sl[k], s1 = sl[2048 + k];
                a0[0] += s0 * w.x; a0[1] += s0 * w.y; a0[2] += s0 * w.z; a0[3] += s0 * w.w;
                a1[0] += s1 * w.x; a1[1] += s1 * w.y; a1[2] += s1 * w.z; a1[3] += s1 * w.w;
            }
            __syncthreads();
#pragma unroll
            for (int e = 0; e < 4; ++e) { red[(kg * 16 + c4) * 8 + e] = a0[e]; red[(kg * 16 + c4) * 8 + 4 + e] = a1[e]; }
            __syncthreads();
            if (tid < 128) {
                const int b = tid >> 6, col = tid & 63;
                float s = 0.f;
                for (int g = 0; g < 32; ++g) s += red[(g * 16 + (col >> 2)) * 8 + b * 4 + (col & 3)];
                p.ada[b * NMOD + it * 64 + col] = s + p.b_ada[it * 64 + col];
            }
        }
        __syncthreads();
    }
    for (int e = bid * NTH + tid; e < NTOK * 64; e += nb * NTH) {
        const int tok = e >> 6, j = e & 63;
        const float ang = (float)p.pos[tok] * c_freq[j];
        float s, c; sincos_acc(ang, s, c);
        p.rope[(size_t)e * 2] = c; p.rope[(size_t)e * 2 + 1] = s;
    }
    {
        float* scr = lds + wave * (64 * 33);
        const int gw = bid * 8 + wave, ngw = nb * 8;
        constexpr int I1 = 32 * 256, I2 = 32 * 128, I3 = 16 * 64, I4 = 32 * 64;
        constexpr int NIT = I1 + I2 + I3 + 3 * I4;
        for (int it = gw; it < NIT; it += ngw) {
            int r = it;
            if (r < I1) { transpose_item(p.w_in, 2048, 8192, p.Wt1, 0, scr, r, lane); continue; } r -= I1;
            if (r < I2) { transpose_item(p.w_bg, 2048, 4096, p.Wt1, 8192, scr, r, lane); continue; } r -= I2;
            if (r < I3) { transpose_item(p.w_a_out, 1024, 2048, p.Wta, 0, scr, r, lane); continue; } r -= I3;
            if (r < I4) { transpose_item(p.w_b_out, 2048, 2048, p.Wtb, 0, scr, r, lane); continue; } r -= I4;
            if (r < I4) { transpose_item(p.w_o, 2048, 2048, p.Wto, 0, scr, r, lane); continue; } r -= I4;
            transpose_item(p.peer_wq, 2048, 2048, p.Wtq, 0, scr, r, lane);
        }
    }
    __syncthreads();
}
constexpr int ROW6 = 1536;
typedef float f32x32_t __attribute__((ext_vector_type(32)));
typedef unsigned u32x6_t __attribute__((ext_vector_type(6)));
__device__ __forceinline__ void tc_load(const Params& p, int r, int lane, float4 (&t)[8]) {
    const bool second = r >= 16384; const int row = second ? r - 16384 : r;
    const float* src = (second ? p.peer_v : p.peer_u) + (size_t)row * DM + lane * 32;
#pragma unroll
    for (int q = 0; q < 8; ++q) t[q] = *(const float4*)(src + 4 * q);
}
__device__ __forceinline__ void tc_finish(const Params& p, int r, int lane, const float4 (&t)[8]) {
    const bool second = r >= 16384; const int row = second ? r - 16384 : r;
    float am = 0.f;
#pragma unroll
    for (int q = 0; q < 8; ++q) am = fmaxf(am, fmaxf(fmaxf(fabsf(t[q].x), fabsf(t[q].y)), fmaxf(fabsf(t[q].z), fabsf(t[q].w))));
    am = wave_max(am);
    const float sc = (am > 0.f) ? am * (1.0f / 7.5f) : 1.0f, inv = (am > 0.f) ? 7.5f / am : 1.0f;
    typedef float f32x16_t __attribute__((ext_vector_type(16)));
    f32x16_t ev, od;
#pragma unroll
    for (int q = 0; q < 8; ++q) { ev[2 * q] = t[q].x * inv; od[2 * q] = t[q].y * inv; ev[2 * q + 1] = t[q].z * inv; od[2 * q + 1] = t[q].w * inv; }
    const u32x6_t w = __builtin_amdgcn_cvt_scalef32_2xpk16_fp6_f32(ev, od, 1.0f);
    unsigned char* dst = (second ? p.V8 : p.U8) + (size_t)row * ROW6 + lane * 24;
    *(uint2*)(dst) = make_uint2(w[0], w[1]); *(uint2*)(dst + 8) = make_uint2(w[2], w[3]); *(uint2*)(dst + 16) = make_uint2(w[4], w[5]);
    if (lane == 0) (second ? p.sv : p.su)[row] = sc;
}
__device__ __forceinline__ void ph_tabconv(const Params& p, int bid, int nb) {
    const int tid = tid_(), wave = tid >> 6, lane = tid & 63;
    for (int r = bid * 8 + wave; r < 2 * 16384; r += nb * 8) { float4 t[8]; tc_load(p, r, lane, t); tc_finish(p, r, lane, t); }
}

__device__ __forceinline__ void ph_modnorm(const Params& p, const float* xin, const float* g, int sh_off, int sc_off, bf16_t* hout, int bid, int nb, float* lds) {
    const int tid = tid_(), wave = tid >> 6, lane = tid & 63;
    for (int row = bid * 8 + wave; row < NTOK; row += nb * 8) {
        const int b = row / SQ;
        const float4* xr = (const float4*)(xin + (size_t)row * DM);
        float4 v[8]; float ss = 0.f;
#pragma unroll
        for (int j = 0; j < 8; ++j) { v[j] = xr[lane + 64 * j]; ss += dot4(v[j], v[j]); }
        ss = wave_sum(ss);
        const float rs = 1.0f / sqrtf(ss * (1.0f / DM) + 1e-6f);
#pragma unroll
        for (int j = 0; j < 8; ++j) {
            const int col = (lane + 64 * j) * 4;
            const float4 g4 = *(const float4*)(g + col);
            const float4 sc = *(const float4*)(p.ada + b * NMOD + sc_off + col);
            const float4 sh = *(const float4*)(p.ada + b * NMOD + sh_off + col);
            float4 o;
            o.x = v[j].x * rs * g4.x * (1.0f + sc.x) + sh.x; o.y = v[j].y * rs * g4.y * (1.0f + sc.y) + sh.y;
            o.z = v[j].z * rs * g4.z * (1.0f + sc.z) + sh.z; o.w = v[j].w * rs * g4.w * (1.0f + sc.w) + sh.w;
            *(uint2*)(hout + (size_t)row * DM + col) = make_uint2(pk2(o.x, o.y), pk2(o.z, o.w));
        }
    }
}

typedef short bf16x8_t __attribute__((ext_vector_type(8)));
typedef float f32x4_t __attribute__((ext_vector_type(4)));
__device__ __forceinline__ bf16x8_t ldfrag(const char* base, int row, int chunk, int rb, int sm) { return *(const bf16x8_t*)(base + row * rb + ((chunk ^ (row & sm)) << 4)); }
__device__ __forceinline__ void ph_gmlp2(const Params& p, int bid, int nb, float* lds) {
    char* WM = (char*)lds; char* VT = WM + 32768;
    const int tid = tid_(), wave = tid >> 6, lane = tid & 63, fr = lane & 15, fq = lane >> 4;
    int gl = -1;
    for (int it = bid; it < 512; it += nb) {
        const int g = it & 7, n = (it >> 3) & 31, b = it >> 8;
        const int tok0 = b * SQ + n * 128;
        __syncthreads();
        if (g != gl) {
            for (int u = tid; u < 2048; u += NTH) {
                const int i = u >> 4, c = u & 15;
                const float4* src = (const float4*)(p.gm_ws + (size_t)g * 16384 + i * 128 + c * 8);
                float4 a = src[0], b4 = src[1];
                if ((i >> 6) < (c >> 3)) { a = make_float4(0.f, 0.f, 0.f, 0.f); b4 = a; }
                *(uint4*)(WM + i * 256 + ((c ^ (i & 15)) << 4)) = make_uint4(pk2(a.x, a.y), pk2(a.z, a.w), pk2(b4.x, b4.y), pk2(b4.z, b4.w));
            }
            gl = g;
        }
        {
            const float2 gn = *(const float2*)(p.gm_v_g + g * 128 + lane * 2);
#pragma unroll 4
            for (int jj = 0; jj < 16; ++jj) {
                const int j = wave * 16 + jj;
                const unsigned w = *(const unsigned*)(p.ZG + (size_t)(tok0 + j) * ZW + 1024 + g * 128 + lane * 2);
                const float a = bflo(w), c2 = bfhi(w);
                const float ss = wave_sum(a * a + c2 * c2);
                const float rs = 1.0f / sqrtf(ss * (1.0f / 128.0f) + 1e-6f);
                const int d0 = lane * 2, d1 = d0 + 1;
                *(bf16_t*)(VT + d0 * 256 + (((j >> 3) ^ (d0 & 15)) << 4) + (j & 7) * 2) = (bf16_t)f2bf(a * rs * gn.x);
                *(bf16_t*)(VT + d1 * 256 + (((j >> 3) ^ (d1 & 15)) << 4) + (j & 7) * 2) = (bf16_t)f2bf(c2 * rs * gn.y);
            }
        }
        __syncthreads();
        {
            bf16x8_t A[4];
#pragma unroll
            for (int ks = 0; ks < 4; ++ks) A[ks] = ldfrag(VT, wave * 16 + fr, ks * 4 + fq, 256, 15);
            const int d0 = wave * 16 + fq * 4;
#pragma unroll
            for (int itl = 0; itl < 8; ++itl) {
                f32x4_t acc = {0.f, 0.f, 0.f, 0.f};
#pragma unroll
                for (int ks = 0; ks < 4; ++ks) if (itl >= 4 || ks < 2) acc = __builtin_amdgcn_mfma_f32_16x16x32_bf16(A[ks], ldfrag(WM, itl * 16 + fr, ks * 4 + fq, 256, 15), acc, 0, 0, 0);
                const int i = itl * 16 + fr;
                const float bias = p.gm_b[g * 128 + i];
                const size_t tok = (size_t)(tok0 + i);
                const uint2 uw = *(const uint2*)(p.ZG + tok * ZW + g * 128 + d0);
                *(uint2*)(p.yain + tok * 1024 + g * 128 + d0) = make_uint2(pk2(bflo(uw.x) * (acc[0] + bias), bfhi(uw.x) * (acc[1] + bias)), pk2(bflo(uw.y) * (acc[2] + bias), bfhi(uw.y) * (acc[3] + bias)));
            }
        }
    }
    __syncthreads();
}

__device__ __forceinline__ void ph_ret(const Params& p, int bid, int nb, float* lds) {
    float* Qs = lds;
    float* Ks = Qs + 64 * 129;
    float* Vs = Ks + 64 * 129;
    float* Ss = Vs + 64 * 16;
    float* At = Ss + 128 * 16;
    float* kd = At + 64 * 65;
    const int tid = tid_();
    const bf16_t* z = p.ZG;
    for (int it = bid; it < 256; it += nb) {
        const int vs = it & 15, h = (it >> 4) & 7, b = it >> 7;
        const float lg = log1pf(-exp2f(-5.0f - (float)h));
        const float cdec = expf(lg * 64.0f);
        __syncthreads();
        for (int i = tid; i < 2048; i += NTH) Ss[i] = 0.f;
        if (tid < 64) kd[tid] = expf(lg * (float)(63 - tid));
        for (int n = 0; n < 64; ++n) {
            const int tok0 = b * SQ + n * 64;
            __syncthreads();
            for (int e = tid; e < 4096; e += NTH) {
                const int i = e >> 6, dd = e & 63; const size_t tok = (size_t)(tok0 + i);
                const float cs = p.rope[(tok * 64 + dd) * 2], sn = p.rope[(tok * 64 + dd) * 2 + 1];
                const bf16_t* zr = z + tok * ZW;
                const float q1 = bf2f(zr[2048 + h * 128 + dd]), q2 = bf2f(zr[2048 + h * 128 + 64 + dd]);
                const float k1 = bf2f(zr[3072 + h * 128 + dd]), k2 = bf2f(zr[3072 + h * 128 + 64 + dd]);
                Qs[i * 129 + dd] = q1 * cs - q2 * sn; Qs[i * 129 + 64 + dd] = q1 * sn + q2 * cs;
                const float sc = 0.08838834764831845f;
                Ks[i * 129 + dd] = (k1 * cs - k2 * sn) * sc; Ks[i * 129 + 64 + dd] = (k1 * sn + k2 * cs) * sc;
            }
            for (int e = tid; e < 1024; e += NTH) { const int j = e >> 4, v = e & 15; Vs[e] = bf2f(z[(size_t)(tok0 + j) * ZW + 4096 + h * 256 + vs * 16 + v]); }
            __syncthreads();
            {
                const int j = tid & 63, i0 = (tid >> 6) * 8;
                float acc[8];
#pragma unroll
                for (int ii = 0; ii < 8; ++ii) acc[ii] = 0.f;
                for (int d = 0; d < 128; ++d) {
                    const float kv = Ks[j * 129 + d];
#pragma unroll
                    for (int ii = 0; ii < 8; ++ii) acc[ii] += Qs[(i0 + ii) * 129 + d] * kv;
                }
#pragma unroll
                for (int ii = 0; ii < 8; ++ii) { const int i = i0 + ii; At[i * 65 + j] = acc[ii] * expf(lg * fabsf((float)(i - j))); }
            }
            __syncthreads();
            {
                const int v = tid & 15, i0 = tid >> 4;
#pragma unroll
                for (int rep = 0; rep < 2; ++rep) {
                    const int i = i0 + 32 * rep;
                    float a = 0.f; for (int j = 0; j < 64; ++j) a += At[i * 65 + j] * Vs[j * 16 + v];
                    float c2 = 0.f; for (int d = 0; d < 128; ++d) c2 += Qs[i * 129 + d] * Ss[d * 16 + v];
                    p.obuf[(size_t)(tok0 + i) * DM + h * 256 + vs * 16 + v] = a + c2 * expf(lg * (float)(i + 1));
                }
            }
            __syncthreads();
            {
                const int v = tid & 15, d0 = tid >> 4;
#pragma unroll
                for (int rep = 0; rep < 4; ++rep) {
                    const int d = d0 + 32 * rep;
                    float a = 0.f; for (int j = 0; j < 64; ++j) a += Ks[j * 129 + d] * kd[j] * Vs[j * 16 + v];
                    Ss[d * 16 + v] = Ss[d * 16 + v] * cdec + a;
                }
            }
        }
    }
    __syncthreads();
}


__device__ __forceinline__ void ph_retprep(const Params& p, int bid, int nb, float* lds) {
    bf16_t* Kl = (bf16_t*)lds;
    bf16_t* Vl = Kl + 64 * 132;
    const int tid = tid_();
    for (int it = bid; it < 1024; it += nb) {
        const int n = it & 63, h = (it >> 6) & 7, b = it >> 9;
        const int tok0 = b * SQ + n * 64;
        const size_t rowbase = (size_t)(b * 8 + h) * SQ + n * 64;
        const float lg = log1pf(-exp2f(-5.0f - (float)h));
        __syncthreads();
#pragma unroll
        for (int k = 0; k < 2; ++k) {
            const int u = tid + 512 * k, i = u >> 4, dd = (u & 15) * 4; const size_t tok = (size_t)(tok0 + i);
            const float4 r0 = *(const float4*)(p.rope + (tok * 64 + dd) * 2), r1 = *(const float4*)(p.rope + (tok * 64 + dd) * 2 + 4);
            const float cs[4] = {r0.x, r0.z, r1.x, r1.z}, sn[4] = {r0.y, r0.w, r1.y, r1.w};
            const bf16_t* zr = p.ZG + tok * ZW;
            const uint2 q1w = *(const uint2*)(zr + 2048 + h * 128 + dd), q2w = *(const uint2*)(zr + 2048 + h * 128 + 64 + dd);
            const uint2 k1w = *(const uint2*)(zr + 3072 + h * 128 + dd), k2w = *(const uint2*)(zr + 3072 + h * 128 + 64 + dd);
            const float q1[4] = {bflo(q1w.x), bfhi(q1w.x), bflo(q1w.y), bfhi(q1w.y)}, q2[4] = {bflo(q2w.x), bfhi(q2w.x), bflo(q2w.y), bfhi(q2w.y)};
            const float k1[4] = {bflo(k1w.x), bfhi(k1w.x), bflo(k1w.y), bfhi(k1w.y)}, k2[4] = {bflo(k2w.x), bfhi(k2w.x), bflo(k2w.y), bfhi(k2w.y)};
            const float sc = 0.08838834764831845f, kd = expf(lg * (float)(63 - i));
            float qa[4], qb[4], ka[4], kb[4];
#pragma unroll
            for (int e = 0; e < 4; ++e) { qa[e] = q1[e] * cs[e] - q2[e] * sn[e]; qb[e] = q1[e] * sn[e] + q2[e] * cs[e]; ka[e] = (k1[e] * cs[e] - k2[e] * sn[e]) * sc; kb[e] = (k1[e] * sn[e] + k2[e] * cs[e]) * sc; }
            *(uint2*)(p.Qr + (rowbase + i) * 128 + dd) = make_uint2(pk2(qa[0], qa[1]), pk2(qa[2], qa[3]));
            *(uint2*)(p.Qr + (rowbase + i) * 128 + 64 + dd) = make_uint2(pk2(qb[0], qb[1]), pk2(qb[2], qb[3]));
            *(uint2*)(p.Kr + (rowbase + i) * 128 + dd) = make_uint2(pk2(ka[0], ka[1]), pk2(ka[2], ka[3]));
            *(uint2*)(p.Kr + (rowbase + i) * 128 + 64 + dd) = make_uint2(pk2(kb[0], kb[1]), pk2(kb[2], kb[3]));
            *(uint2*)(Kl + i * 132 + dd) = make_uint2(pk2(ka[0] * kd, ka[1] * kd), pk2(ka[2] * kd, ka[3] * kd));
            *(uint2*)(Kl + i * 132 + 64 + dd) = make_uint2(pk2(kb[0] * kd, kb[1] * kd), pk2(kb[2] * kd, kb[3] * kd));
        }
#pragma unroll
        for (int k = 0; k < 4; ++k) {
            const int u = tid + 512 * k, j = u >> 5, c = u & 31;
            *(uint4*)(Vl + j * 264 + c * 8) = *(const uint4*)(p.ZG + (size_t)(tok0 + j) * ZW + 4096 + h * 256 + c * 8);
        }
        __syncthreads();
        bf16_t* kt = p.KTd + (size_t)it * 8192;
#pragma unroll
        for (int k = 0; k < 2; ++k) {
            const int u = tid + 512 * k, d = u & 127, jg = u >> 7;
            unsigned w[4];
#pragma unroll
            for (int q = 0; q < 4; ++q) w[q] = (unsigned)Kl[(jg * 8 + 2 * q) * 132 + d] | ((unsigned)Kl[(jg * 8 + 2 * q + 1) * 132 + d] << 16);
            *(uint4*)(kt + d * 64 + jg * 8) = make_uint4(w[0], w[1], w[2], w[3]);
        }
        bf16_t* vt = p.Vt + (size_t)it * 16384;
#pragma unroll
        for (int k = 0; k < 4; ++k) {
            const int u = tid + 512 * k, v = u & 255, jg = u >> 8;
            unsigned w[4];
#pragma unroll
            for (int q = 0; q < 4; ++q) w[q] = (unsigned)Vl[(jg * 8 + 2 * q) * 264 + v] | ((unsigned)Vl[(jg * 8 + 2 * q + 1) * 264 + v] << 16);
            *(uint4*)(vt + v * 64 + jg * 8) = make_uint4(w[0], w[1], w[2], w[3]);
        }
    }
    __syncthreads();
}

__device__ __forceinline__ void ph_ret2(const Params& p, int bid, int nb, float* lds) {
    char* L = (char*)lds;
    constexpr int OQ = 0, OKK = 16384, OKT = 32768, OVT = 49152, TILE = 51200, OP = 2 * TILE, OST = OP + 8192;
    const int tid = tid_(), wave = tid >> 6, lane = tid & 63, fr = lane & 15, fq = lane >> 4;
    for (int it = bid; it < 256; it += nb) {
        const int vs = it & 15, h = (it >> 4) & 7, b = it >> 7;
        const float lg = log1pf(-exp2f(-5.0f - (float)h));
        const float cdec = expf(lg * 64.0f);
        const size_t bh = (size_t)(b * 8 + h);
        const char* gQ = (const char*)(p.Qr + bh * SQ * 128);
        const char* gK = (const char*)(p.Kr + bh * SQ * 128);
        const char* gKT = (const char*)(p.KTd + bh * 64 * 8192);
        const char* gVt = (const char*)(p.Vt + bh * 64 * 16384) + vs * 16 * 128;
        int lq[2], lkt[2];
#pragma unroll
        for (int u = 0; u < 2; ++u) { const int ci = tid + 512 * u; const int r = ci >> 4, c = ci & 15; lq[u] = r * 256 + ((c ^ (r & 15)) << 4); const int d = ci >> 3, c8 = ci & 7; lkt[u] = d * 128 + ((c8 ^ (d & 7)) << 4); }
        const int lv = (tid >> 3) * 128 + (((tid & 7) ^ ((tid >> 3) & 7)) << 4);
        uint4 qA0, qA1, kA0, kA1, tA0, tA1, vA = make_uint4(0u, 0u, 0u, 0u), qB0, qB1, kB0, kB1, tB0, tB1, vB = make_uint4(0u, 0u, 0u, 0u);
#define RET_LOAD(X_, n_) do { const size_t o0 = (size_t)(n_) * 16384 + (size_t)tid * 16, o1 = o0 + 8192; \
        q##X_##0 = *(const uint4*)(gQ + o0); q##X_##1 = *(const uint4*)(gQ + o1); k##X_##0 = *(const uint4*)(gK + o0); k##X_##1 = *(const uint4*)(gK + o1); t##X_##0 = *(const uint4*)(gKT + o0); t##X_##1 = *(const uint4*)(gKT + o1); \
        if (tid < 128) v##X_ = *(const uint4*)(gVt + (size_t)(n_) * 32768 + tid * 16); } while (0)
#define RET_WRITE(X_, buf_) do { char* B_ = L + (buf_) * TILE; \
        *(uint4*)(B_ + OQ + lq[0]) = q##X_##0; *(uint4*)(B_ + OQ + lq[1]) = q##X_##1; *(uint4*)(B_ + OKK + lq[0]) = k##X_##0; *(uint4*)(B_ + OKK + lq[1]) = k##X_##1; *(uint4*)(B_ + OKT + lkt[0]) = t##X_##0; *(uint4*)(B_ + OKT + lkt[1]) = t##X_##1; \
        if (tid < 128) *(uint4*)(B_ + OVT + lv) = v##X_; } while (0)
        __syncthreads();
        for (int i = tid; i < 1024; i += NTH) ((unsigned*)(L + OST))[i] = 0u;
        RET_LOAD(A, 0); RET_WRITE(A, 0); RET_LOAD(B, 1);
        f32x4_t sacc[2] = {{0.f, 0.f, 0.f, 0.f}, {0.f, 0.f, 0.f, 0.f}};
#define RET_STEP(n_, cur_, LS_, WS_) do { const int n = (n_); constexpr int cur = (cur_); \
            __syncthreads();                                     \
            if (n + 2 < 64) RET_LOAD(LS_, n + 2); \
            const char* T = L + cur * TILE; \
            {     \
                const int jt = wave >> 1, it0 = 2 * (wave & 1); \
                f32x4_t s0 = {0.f, 0.f, 0.f, 0.f}, s1 = {0.f, 0.f, 0.f, 0.f}; \
                _Pragma("unroll") for (int ks = 0; ks < 4; ++ks) { \
                    const bf16x8_t a = ldfrag(T + OKK, jt * 16 + fr, ks * 4 + fq, 256, 15); \
                    const bf16x8_t b0 = ldfrag(T + OQ, it0 * 16 + fr, ks * 4 + fq, 256, 15), b1 = ldfrag(T + OQ, (it0 + 1) * 16 + fr, ks * 4 + fq, 256, 15); \
                    s0 = __builtin_amdgcn_mfma_f32_16x16x32_bf16(a, b0, s0, 0, 0, 0); \
                    s1 = __builtin_amdgcn_mfma_f32_16x16x32_bf16(a, b1, s1, 0, 0, 0); } \
                const int j0 = jt * 16 + fq * 4; \
                _Pragma("unroll") for (int tt = 0; tt < 2; ++tt) { \
                    const int i = (it0 + tt) * 16 + fr; const f32x4_t sv4 = tt ? s1 : s0; float pv[4]; \
                    _Pragma("unroll") for (int r = 0; r < 4; ++r) pv[r] = sv4[r] * __expf(lg * fabsf((float)(i - (j0 + r)))); \
                    *(uint2*)(L + OP + i * 128 + ((((j0 >> 3)) ^ (i & 7)) << 4) + (j0 & 7) * 2) = make_uint2(pk2(pv[0], pv[1]), pk2(pv[2], pv[3])); } \
            } \
            __syncthreads();                                     \
            if (wave < 4) {     \
                const int itl = wave; \
                f32x4_t o1 = {0.f, 0.f, 0.f, 0.f}, o2 = {0.f, 0.f, 0.f, 0.f}; \
                _Pragma("unroll") for (int ks = 0; ks < 2; ++ks) o1 = __builtin_amdgcn_mfma_f32_16x16x32_bf16(ldfrag(L + OP, itl * 16 + fr, ks * 4 + fq, 128, 7), ldfrag(T + OVT, fr, ks * 4 + fq, 128, 7), o1, 0, 0, 0); \
                _Pragma("unroll") for (int ks = 0; ks < 4; ++ks) o2 = __builtin_amdgcn_mfma_f32_16x16x32_bf16(ldfrag(T + OQ, itl * 16 + fr, ks * 4 + fq, 256, 15), ldfrag(L + OST + cur * 4096, fr, ks * 4 + fq, 256, 15), o2, 0, 0, 0); \
                _Pragma("unroll") for (int r = 0; r < 4; ++r) { const int i = itl * 16 + fq * 4 + r; \
                    p.ob16[(size_t)(b * SQ + n * 64 + i) * DM + h * 256 + vs * 16 + fr] = (bf16_t)f2bf(o1[r] + __expf(lg * (float)(i + 1)) * o2[r]); } \
            } else {            \
                _Pragma("unroll") for (int u = 0; u < 2; ++u) { \
                    const int dt = 2 * (wave - 4) + u; \
                    sacc[u] = sacc[u] * cdec; \
                    _Pragma("unroll") for (int ks = 0; ks < 2; ++ks) sacc[u] = __builtin_amdgcn_mfma_f32_16x16x32_bf16(ldfrag(T + OKT, dt * 16 + fr, ks * 4 + fq, 128, 7), ldfrag(T + OVT, fr, ks * 4 + fq, 128, 7), sacc[u], 0, 0, 0); \
                    *(uint2*)(L + OST + (cur ^ 1) * 4096 + fr * 256 + (((dt * 2 + (fq >> 1)) ^ fr) << 4) + (fq & 1) * 8) = make_uint2(pk2(sacc[u][0], sacc[u][1]), pk2(sacc[u][2], sacc[u][3])); } \
            } \
            if (n + 1 < 64) RET_WRITE(WS_, cur ^ 1); } while (0)
        for (int n2 = 0; n2 < 64; n2 += 2) { RET_STEP(n2, 0, A, B); RET_STEP(n2 + 1, 1, B, A); }
#undef RET_STEP
#undef RET_LOAD
#undef RET_WRITE
    }
    __syncthreads();
}

__device__ __forceinline__ void ph_gn(const Params& p, int bid, int nb, float* lds) {
    const int tid = tid_(), wave = tid >> 6, lane = tid & 63;
    for (int tok = bid * 8 + wave; tok < NTOK; tok += nb * 8) {
#pragma unroll
        for (int h = 0; h < 8; ++h) {
            const uint2 ow = *(const uint2*)(p.ob16 + (size_t)tok * DM + h * 256 + lane * 4);
            const float4 o = make_float4(bflo(ow.x), bfhi(ow.x), bflo(ow.y), bfhi(ow.y));
            const float mu = wave_sum(o.x + o.y + o.z + o.w) * (1.0f / 256.0f);
            const float4 d = make_float4(o.x - mu, o.y - mu, o.z - mu, o.w - mu);
            const float var = wave_sum(dot4(d, d)) * (1.0f / 256.0f);
            const float rs = 1.0f / sqrtf(var + 1e-6f);
            const float4 gn = *(const float4*)(p.ret_gn_g + h * 256 + lane * 4);
            const uint2 gw = *(const uint2*)(p.ZG + (size_t)tok * ZW + 6144 + h * 256 + lane * 4);
            const float g0 = bflo(gw.x), g1 = bfhi(gw.x), g2 = bflo(gw.y), g3 = bfhi(gw.y);
            *(uint2*)(p.ybin + (size_t)tok * DM + h * 256 + lane * 4) =
                make_uint2(pk2(siluf_(g0) * d.x * rs * gn.x, siluf_(g1) * d.y * rs * gn.y), pk2(siluf_(g2) * d.z * rs * gn.z, siluf_(g3) * d.w * rs * gn.w));
        }
    }
}

template <int NL>
__device__ __forceinline__ void wave_top16(float (&v)[NL], const int (&idx)[NL], float& outv, int& outi, int lane) {
    outv = 0.f; outi = 0;
    for (int r = 0; r < 16; ++r) {
        float m = v[0];
#pragma unroll
        for (int u = 1; u < NL; ++u) m = fmaxf(m, v[u]);
        const float wm = wave_max(m);
        const unsigned long long bal = __ballot(m == wm);
        const int owner = __ffsll((long long)bal) - 1;
        int myi = -1;
        if (lane == owner) {
            bool done = false;
#pragma unroll
            for (int u = 0; u < NL; ++u) if (!done && v[u] == wm) { myi = idx[u]; v[u] = -INFINITY; done = true; }
        }
        const int wi = __shfl(myi, owner);
        if (lane == r) { outv = wm; outi = wi; }
    }
}
__device__ __forceinline__ void ph_topk(const Params& p, const float* qb, int bid, int nb, float* lds) {
    const int tid = tid_(), wave = tid >> 6, lane = tid & 63;
    for (int t = bid; t < NTOK; t += nb) {
        const int h = wave;
        const float* q = qb + (size_t)t * DM + h * 256;
        float s[2][2];
#pragma unroll
        for (int pp = 0; pp < 2; ++pp)
#pragma unroll
            for (int r = 0; r < 2; ++r) {
                const int n = lane + 64 * r;
                const float4* kr = (const float4*)(p.peer_sk + ((size_t)(h * 2 + pp) * 128 + n) * 128);
                const float4* qr = (const float4*)(q + pp * 128);
                float a = 0.f;
#pragma unroll 4
                for (int d4 = 0; d4 < 32; ++d4) a += dot4(kr[d4], qr[d4]);
                s[pp][r] = a;
            }
        float v1, v2; int i1, i2;
        { float vv[2] = {s[0][0], s[0][1]}; const int ii[2] = {lane, lane + 64}; wave_top16<2>(vv, ii, v1, i1, lane); }
        { float vv[2] = {s[1][0], s[1][1]}; const int ii[2] = {lane, lane + 64}; wave_top16<2>(vv, ii, v2, i2, lane); }
        float cv[4]; int ci[4];
        const int a = lane >> 2, b0 = (lane & 3) * 4;
        const float va = __shfl(v1, a); const int ia = __shfl(i1, a);
#pragma unroll
        for (int u = 0; u < 4; ++u) { const float vb = __shfl(v2, b0 + u); const int ib = __shfl(i2, b0 + u); cv[u] = va + vb; ci[u] = ia * 128 + ib; }
        float tv; int te;
        wave_top16<4>(cv, ci, tv, te, lane);
        const float mx = __shfl(tv, 0);
        const float ex = (lane < 16) ? expf(tv - mx) : 0.f;
        const float sum = wave_sum(ex);
        if (lane < 16) { p.eidx[(size_t)t * 128 + h * 16 + lane] = te; p.gatev[(size_t)t * 128 + h * 16 + lane] = ex / sum; }
    }
}

__device__ __forceinline__ void ph_peer(const Params& p, const float* x1, const bf16_t* h2, int bid, int nb, float* lds) {
    float* ys = lds;
    float* red = lds + 8 * 2048;
    const int tid = tid_(), wave = tid >> 6, lane = tid & 63;
    for (int t = bid; t < NTOK; t += nb) {
        const int b = t / SQ, h = wave;
        const uint2* hr = (const uint2*)(h2 + (size_t)t * DM);
        float4 hv[8], y[8];
#pragma unroll
        for (int j = 0; j < 8; ++j) { const uint2 w = hr[lane + 64 * j]; hv[j] = make_float4(bflo(w.x), bfhi(w.x), bflo(w.y), bfhi(w.y)); y[j] = make_float4(0.f, 0.f, 0.f, 0.f); }
        for (int k = 0; k < 16; ++k) {
            const int e = p.eidx[(size_t)t * 128 + h * 16 + k]; const float gt = p.gatev[(size_t)t * 128 + h * 16 + k];
            const float4* ur = (const float4*)(p.peer_u + (size_t)e * DM);
            float a = 0.f;
#pragma unroll
            for (int j = 0; j < 8; ++j) a += dot4(ur[lane + 64 * j], hv[j]);
            a = wave_sum(a);
            const float w = geluf_(a) * gt;
            const float4* vr = (const float4*)(p.peer_v + (size_t)e * DM);
#pragma unroll
            for (int j = 0; j < 8; ++j) { const float4 v4 = vr[lane + 64 * j]; y[j].x += w * v4.x; y[j].y += w * v4.y; y[j].z += w * v4.z; y[j].w += w * v4.w; }
        }
        __syncthreads();
#pragma unroll
        for (int j = 0; j < 8; ++j) *(float4*)(ys + h * 2048 + (lane + 64 * j) * 4) = y[j];
        __syncthreads();
        const int c = tid * 4;
        float4 s = make_float4(0.f, 0.f, 0.f, 0.f);
#pragma unroll
        for (int hh = 0; hh < 8; ++hh) { const float4 a = *(const float4*)(ys + hh * 2048 + c); s.x += a.x; s.y += a.y; s.z += a.z; s.w += a.w; }
        const float4 xv = *(const float4*)(x1 + (size_t)t * DM + c);
        const float4 ga = *(const float4*)(p.ada + b * NMOD + 5 * DM + c);
        const float4 x2 = make_float4(xv.x + ga.x * s.x, xv.y + ga.y * s.y, xv.z + ga.z * s.z, xv.w + ga.w * s.w);
        const float ss = wave_sum(dot4(x2, x2));
        if (lane == 0) red[wave] = ss;
        __syncthreads();
        float tot = 0.f;
#pragma unroll
        for (int w = 0; w < 8; ++w) tot += red[w];
        const float rs = 1.0f / sqrtf(tot * (1.0f / DM) + 1e-6f);
        const float4 gf = *(const float4*)(p.norm_f_g + c);
        *(float4*)(p.out + (size_t)t * DM + c) = make_float4(x2.x * rs * gf.x, x2.y * rs * gf.y, x2.z * rs * gf.z, x2.w * rs * gf.w);
    }
    __syncthreads();
}

__device__ __forceinline__ void split8(const float4 a, const float4 b, uint4& hi, uint4& lo) {
    const float x[8] = {a.x, a.y, a.z, a.w, b.x, b.y, b.z, b.w}; unsigned h[8], l[8];
#pragma unroll
    for (int i = 0; i < 8; ++i) { h[i] = f2bf(x[i]); l[i] = f2bf(x[i] - __uint_as_float(h[i] << 16)); }
    hi = make_uint4(h[0] | (h[1] << 16), h[2] | (h[3] << 16), h[4] | (h[5] << 16), h[6] | (h[7] << 16));
    lo = make_uint4(l[0] | (l[1] << 16), l[2] | (l[3] << 16), l[4] | (l[5] << 16), l[6] | (l[7] << 16));
}
__device__ __forceinline__ bf16x8_t as_bf16x8(const uint4 v) { return __builtin_bit_cast(bf16x8_t, v); }
struct PairTab { int a[52], b[52]; };
__host__ __device__ constexpr PairTab make_pairs() {
    PairTab t{}; int n = 0;
    for (int a = 0; a < 16; ++a) for (int b = 0; b < 16; ++b) if ((a + 1) * (b + 1) <= 16) { t.a[n] = a; t.b[n] = b; ++n; }
    for (; n < 52; ++n) { t.a[n] = -1; t.b[n] = -1; }
    return t;
}
constexpr PairTab PAIRS = make_pairs();
static_assert(PAIRS.a[49] >= 0 && PAIRS.a[50] < 0, "50 candidate pairs");

__device__ __forceinline__ void ph_topk2(const Params& p, const float* qb, int bid, int nb, float* lds) {
    const int tid = tid_(), wave = tid >> 6, lane = tid & 63;
    uint4* SK = (uint4*)lds;
    const float NEG = -INFINITY;
    const bool tc_on = (nb == 256); const int tcr0 = (bid * 8 + wave) * 16; float4 tct[8];
    if (tc_on) tc_load(p, tcr0, lane, tct);
    for (int it = bid; it < 256; it += nb) {
        const int h = it & 7, tg = it >> 3;
        __syncthreads();
        for (int gi = tid; gi < 4096; gi += NTH) {
            const int dq = gi & 15, n = (gi >> 4) & 127, pp = gi >> 11;
            const float4* src = (const float4*)(p.peer_sk + ((size_t)(h * 2 + pp) * 128 + n) * 128 + dq * 8);
            uint4 hi, lo; split8(src[0], src[1], hi, lo);
            const int base = (((pp * 8 + (n >> 4)) * 4 + (dq >> 2)) * 2) * 64 + (dq & 3) * 16 + (n & 15);
            SK[base] = hi; SK[base + 64] = lo;
        }
        __syncthreads();
#pragma unroll 1
        for (int tile = 0; tile < 2; ++tile) {
            const int tok = tg * 256 + wave * 32 + tile * 16 + (lane & 15);
            const int qd = lane >> 4;
            float v12[2][16];
#pragma unroll
            for (int pp = 0; pp < 2; ++pp) {
                bf16x8_t Bh[4], Bl[4];
                const float* qp = qb + (size_t)tok * DM + h * 256 + pp * 128 + 8 * qd;
#pragma unroll
                for (int ks = 0; ks < 4; ++ks) { uint4 hi, lo; split8(*(const float4*)(qp + ks * 32), *(const float4*)(qp + ks * 32 + 4), hi, lo); Bh[ks] = as_bf16x8(hi); Bl[ks] = as_bf16x8(lo); }
                float v[32];
#pragma unroll
                for (int kt = 0; kt < 8; ++kt) {
                    f32x4_t acc = {0.f, 0.f, 0.f, 0.f};
#pragma unroll
                    for (int ks = 0; ks < 4; ++ks) {
                        const bf16x8_t Ah = as_bf16x8(SK[(((pp * 8 + kt) * 4 + ks) * 2) * 64 + lane]), Al = as_bf16x8(SK[(((pp * 8 + kt) * 4 + ks) * 2 + 1) * 64 + lane]);
                        acc = __builtin_amdgcn_mfma_f32_16x16x32_bf16(Ah, Bh[ks], acc, 0, 0, 0);
                        acc = __builtin_amdgcn_mfma_f32_16x16x32_bf16(Ah, Bl[ks], acc, 0, 0, 0);
                        acc = __builtin_amdgcn_mfma_f32_16x16x32_bf16(Al, Bh[ks], acc, 0, 0, 0);
                    }
#pragma unroll
                    for (int r = 0; r < 4; ++r) v[kt * 4 + r] = __uint_as_float((__float_as_uint(acc[r]) & ~127u) | (unsigned)(kt * 16 + qd * 4 + r));
                    __builtin_amdgcn_sched_barrier(0);
                }
#pragma unroll
                for (int r = 0; r < 16; ++r) {
                    if ((r & 3) == 0 && tc_on) { const int ti = tile * 8 + pp * 4 + (r >> 2); tc_finish(p, tcr0 + ti, lane, tct); if (ti < 15) tc_load(p, tcr0 + ti + 1, lane, tct); }
                    float m = v[0];
#pragma unroll
                    for (int u = 1; u < 32; ++u) m = fmaxf(m, v[u]);
                    m = fmaxf(m, __shfl_xor(m, 16)); m = fmaxf(m, __shfl_xor(m, 32));
                    v12[pp][r] = m;
#pragma unroll
                    for (int u = 0; u < 32; ++u) v[u] = (v[u] == m) ? NEG : v[u];
                }
            }
            float c[13]; unsigned pay[13];
#pragma unroll
            for (int s = 0; s < 13; ++s) {
                float cq[4]; unsigned pq[4];
#pragma unroll
                for (int q = 0; q < 4; ++q) {
                    const int pi = 4 * s + q; const int a = PAIRS.a[pi], b = PAIRS.b[pi];
                    if (a >= 0) {
                        const float sum = v12[0][a] + v12[1][b];
                        cq[q] = __uint_as_float((__float_as_uint(sum) & ~63u) | (unsigned)pi);
                        pq[q] = (__float_as_uint(v12[0][a]) & 127u) * 128u + (__float_as_uint(v12[1][b]) & 127u);
                    } else { cq[q] = NEG; pq[q] = 0u; }
                }
                c[s] = qd == 0 ? cq[0] : qd == 1 ? cq[1] : qd == 2 ? cq[2] : cq[3];
                pay[s] = qd == 0 ? pq[0] : qd == 1 ? pq[1] : qd == 2 ? pq[2] : pq[3];
            }
            float top[16]; unsigned eid[16];
#pragma unroll
            for (int r = 0; r < 16; ++r) {
                float m = c[0];
#pragma unroll
                for (int s = 1; s < 13; ++s) m = fmaxf(m, c[s]);
                m = fmaxf(m, __shfl_xor(m, 16)); m = fmaxf(m, __shfl_xor(m, 32));
                unsigned pw = 0u;
#pragma unroll
                for (int s = 0; s < 13; ++s) { const bool eq = (c[s] == m); pw |= eq ? pay[s] : 0u; c[s] = eq ? NEG : c[s]; }
                pw |= (unsigned)__shfl_xor((int)pw, 16); pw |= (unsigned)__shfl_xor((int)pw, 32);
                top[r] = m; eid[r] = pw;
            }
            float sum = 0.f; const float mx = top[0];
#pragma unroll
            for (int r = 0; r < 16; ++r) { top[r] = expf(top[r] - mx); sum += top[r]; }
            const float inv = 1.0f / sum;
            if (lane < 16) {
                int4* ep = (int4*)(p.eidx + (size_t)tok * 128 + h * 16); float4* gp = (float4*)(p.gatev + (size_t)tok * 128 + h * 16);
#pragma unroll
                for (int q = 0; q < 4; ++q) {
                    ep[q] = make_int4((int)eid[4 * q], (int)eid[4 * q + 1], (int)eid[4 * q + 2], (int)eid[4 * q + 3]);
                    gp[q] = make_float4(top[4 * q] * inv, top[4 * q + 1] * inv, top[4 * q + 2] * inv, top[4 * q + 3] * inv);
                }
            }
        }
    }
    __syncthreads();
}

__device__ __forceinline__ void peer_load4(const unsigned char* tab, const int (&e)[4], int lane, uint2 (&R)[4][3]) {
#pragma unroll
    for (int i = 0; i < 4; ++i) { const uint2* r = (const uint2*)(tab + (size_t)e[i] * ROW6 + lane * 24); R[i][0] = r[0]; R[i][1] = r[1]; R[i][2] = r[2]; }
}
__device__ __forceinline__ f32x32_t dec6(const uint2 (&R)[3]) { const u32x6_t w = {R[0].x, R[0].y, R[1].x, R[1].y, R[2].x, R[2].y}; return __builtin_amdgcn_cvt_scalef32_pk32_f32_fp6(w, 1.0f); }
__device__ __forceinline__ void ph_peer3(const Params& p, const float* x1, const bf16_t* h2, int bid, int nb) {
    const int tid = tid_(), wave = tid >> 6, lane = tid & 63;
    for (int t = bid * 8 + wave; t < NTOK; t += nb * 8) {
        const int b = t / SQ;
        float hv[32], y[32];
#pragma unroll
        for (int q = 0; q < 4; ++q) { const uint4 w = *(const uint4*)(h2 + (size_t)t * DM + lane * 32 + 8 * q); float* d = hv + 8 * q;
            d[0] = bflo(w.x); d[1] = bfhi(w.x); d[2] = bflo(w.y); d[3] = bfhi(w.y); d[4] = bflo(w.z); d[5] = bfhi(w.z); d[6] = bflo(w.w); d[7] = bfhi(w.w); }
#pragma unroll
        for (int i = 0; i < 32; ++i) y[i] = 0.f;
        const int e0 = p.eidx[(size_t)t * 128 + lane], e1 = p.eidx[(size_t)t * 128 + 64 + lane];
        const float g0 = p.gatev[(size_t)t * 128 + lane], g1 = p.gatev[(size_t)t * 128 + 64 + lane];
        const float su0 = p.su[e0], su1 = p.su[e1];
        const float gv0 = g0 * p.sv[e0], gv1 = g1 * p.sv[e1];
        uint2 Uc[4][3], Un[4][3], Vc[4][3];
        { int e[4];
#pragma unroll
          for (int i = 0; i < 4; ++i) e[i] = __builtin_amdgcn_readlane(e0, i);
          peer_load4(p.U8, e, lane, Uc); }
        for (int g = 0; g < 32; ++g) {
            const bool lo = g < 16; const int k0 = (4 * g) & 63;
            const int ee = lo ? e0 : e1; const float suu = lo ? su0 : su1, gvv = lo ? gv0 : gv1;
            int e[4]; float sa[4], gw[4];
#pragma unroll
            for (int i = 0; i < 4; ++i) { e[i] = __builtin_amdgcn_readlane(ee, k0 + i);
                sa[i] = __uint_as_float(__builtin_amdgcn_readlane(__float_as_uint(suu), k0 + i)); gw[i] = __uint_as_float(__builtin_amdgcn_readlane(__float_as_uint(gvv), k0 + i)); }
            peer_load4(p.V8, e, lane, Vc);
            {
                const int gn = (g < 31) ? g + 1 : g; const int en = (gn < 16) ? e0 : e1; const int kn = (4 * gn) & 63; int e2[4];
#pragma unroll
                for (int i = 0; i < 4; ++i) e2[i] = __builtin_amdgcn_readlane(en, kn + i);
                peer_load4(p.U8, e2, lane, Un);
            }
            float a[4];
#pragma unroll
            for (int i = 0; i < 4; ++i) {
                const f32x32_t d = dec6(Uc[i]);
                float acc0 = 0.f, acc1 = 0.f;
#pragma unroll
                for (int k = 0; k < 32; k += 2) { acc0 += d[k] * hv[k]; acc1 += d[k + 1] * hv[k + 1]; }
                a[i] = acc0 + acc1;
            }
#pragma unroll
            for (int o = 1; o < 64; o <<= 1) { a[0] += __shfl_xor(a[0], o); a[1] += __shfl_xor(a[1], o); a[2] += __shfl_xor(a[2], o); a[3] += __shfl_xor(a[3], o); }
#pragma unroll
            for (int i = 0; i < 4; ++i) {
                const float wgt = geluf_(a[i] * sa[i]) * gw[i];
                const f32x32_t d = dec6(Vc[i]);
#pragma unroll
                for (int k = 0; k < 32; ++k) y[k] += wgt * d[k];
            }
#pragma unroll
            for (int i = 0; i < 4; ++i) { Uc[i][0] = Un[i][0]; Uc[i][1] = Un[i][1]; Uc[i][2] = Un[i][2]; }
        }
        float ss = 0.f;
#pragma unroll
        for (int q = 0; q < 8; ++q) {
            const int c = lane * 32 + 4 * q;
            const float4 xv = *(const float4*)(x1 + (size_t)t * DM + c);
            const float4 ga = *(const float4*)(p.ada + b * NMOD + 5 * DM + c);
            float* yy = y + 4 * q;
            yy[0] = xv.x + ga.x * yy[0]; yy[1] = xv.y + ga.y * yy[1]; yy[2] = xv.z + ga.z * yy[2]; yy[3] = xv.w + ga.w * yy[3];
            ss += yy[0] * yy[0] + yy[1] * yy[1] + yy[2] * yy[2] + yy[3] * yy[3];
        }
        ss = wave_sum(ss);
        const float rs = 1.0f / sqrtf(ss * (1.0f / DM) + 1e-6f);
#pragma unroll
        for (int q = 0; q < 8; ++q) {
            const int c = lane * 32 + 4 * q;
            const float4 gf = *(const float4*)(p.norm_f_g + c);
            const float* yy = y + 4 * q;
            *(float4*)(p.out + (size_t)t * DM + c) = make_float4(yy[0] * rs * gf.x, yy[1] * rs * gf.y, yy[2] * rs * gf.z, yy[3] * rs * gf.w);
        }
    }
}

#define LAS __attribute__((address_space(3)))
#define XB_TMO      128
#define XB_XCNT(j)  (256  + 64 * (j))
#define XB_XSUB(j)  (1280 + 64 * (j))
#define XB_XGEN(j)  (2304 + 64 * (j))
#define XB_TOP      3328
#define XB_TOPGEN   3392
#define XCD_BAR_WORDS 3456
#define XB_SPIN_CAP (1u << 18)

__device__ __forceinline__ unsigned xb_ld(unsigned* p)              { return __hip_atomic_load(p, __ATOMIC_RELAXED, __HIP_MEMORY_SCOPE_AGENT); }
__device__ __forceinline__ unsigned xb_add(unsigned* p, unsigned v) { return __hip_atomic_fetch_add(p, v, __ATOMIC_RELAXED, __HIP_MEMORY_SCOPE_AGENT); }
__device__ __forceinline__ unsigned xb_xcc_id() { return (unsigned)__builtin_amdgcn_s_getreg((3 << 11) | 20) & 0xFu; }
#define XB_SPIN(cond, bar) do { unsigned _sp = 0; while (cond) { __builtin_amdgcn_s_sleep(1); \
    if ((++_sp & 255u) == 0u) { if (xb_ld(&(bar)[XB_TMO])) break; if (_sp > XB_SPIN_CAP) { atomicAdd(&(bar)[XB_TMO], 1u); break; } } } } while (0)

struct XcdBarrier {
    unsigned* bar; unsigned x;
    volatile LAS unsigned* st;
};

__device__ __forceinline__ XcdBarrier xcd_barrier_post(unsigned* bar, volatile LAS unsigned* st) {
    XcdBarrier b; b.bar = bar; b.x = xb_xcc_id(); b.st = st;
    if (threadIdx.x == 0) (void)xb_add(&bar[XB_XCNT(b.x)], 1u);
    return b;
}
__device__ __forceinline__ void xcd_barrier_complete(unsigned* bar, unsigned x, unsigned& nloc, unsigned& nx) {
    const unsigned G = gridDim.x * gridDim.y * gridDim.z;
    unsigned sum, cnt, mine, sp = 0u;
    for (;;) {
        sum = 0u; cnt = 0u; mine = 0u;
#pragma unroll
        for (unsigned j = 0; j < 16; ++j) { const unsigned c = xb_ld(&bar[XB_XCNT(j)]); sum += c; cnt += (c > 0u) ? 1u : 0u; mine = (j == x) ? c : mine; }
        if (sum == G) break;
        __builtin_amdgcn_s_sleep(1);
        if ((++sp & 255u) == 0u) { if (xb_ld(&bar[XB_TMO])) break; if (sp > XB_SPIN_CAP) { atomicAdd(&bar[XB_TMO], 1u); break; } }
    }
    nloc = mine > 0u ? mine : 1u; nx = cnt > 0u ? cnt : 1u;
}

__device__ __forceinline__ void xcd_barrier(const XcdBarrier& b) {
    asm volatile("s_waitcnt vmcnt(0)" ::: "memory");
    __syncthreads();
    if (threadIdx.x == 0) {
        unsigned* bar = b.bar;
        __builtin_amdgcn_s_waitcnt(0);
        unsigned nloc = b.st[0], nx = b.st[1];
        if (nloc == 0u) { xcd_barrier_complete(bar, b.x, nloc, nx); b.st[0] = nloc; b.st[1] = nx; }
        const unsigned old = xb_add(&bar[XB_XSUB(b.x)], 1u);
        const unsigned gen = old / nloc;
        if (old + 1u == (gen + 1u) * nloc) {
            __builtin_amdgcn_fence(__ATOMIC_RELEASE, "agent");
            asm volatile("s_waitcnt vmcnt(0)" ::: "memory");
            const unsigned og = xb_add(&bar[XB_TOP], 1u);
            const unsigned tg = og / nx;
            if (og + 1u == (tg + 1u) * nx) xb_add(&bar[XB_TOPGEN], 1u);
            else XB_SPIN(xb_ld(&bar[XB_TOPGEN]) == tg, bar);
            __builtin_amdgcn_fence(__ATOMIC_ACQUIRE, "agent");
            xb_add(&bar[XB_XGEN(b.x)], 1u);
            asm volatile("s_waitcnt vmcnt(0)" ::: "memory");
        } else {
            XB_SPIN(xb_ld(&bar[XB_XGEN(b.x)]) == gen, bar);
            __builtin_amdgcn_fence(__ATOMIC_ACQUIRE, "agent");
            asm volatile("s_waitcnt vmcnt(0)" ::: "memory");
        }
    }
    __syncthreads();
}

template <class Epi>
__device__ __forceinline__ void gemm_run(float* lds, const bf16_t* A, const bf16_t* Bt, int M, int N, int K, const Epi& E) {
    __syncthreads();
    pg8::Gemm g{A, Bt, M, N, K}; pg8::StaticOrder S; S.init(M, N, (int)gridDim.x, (int)blockIdx.x);
    pg8::gemm_phase<Epi, pg8::StaticOrder, true, true>((PG8_LAS unsigned char*)lds, g, S, E);
    __syncthreads();
}
constexpr int NPHASE = 11;
template <int PH>
__device__ __forceinline__ void run_phase(const Params& p, int bid, int nb, float* lds) {
    asm volatile("" : "+s"(bid));
    if constexpr (PH == 0) ph_prep(p, bid, nb, lds);
    if constexpr (PH == 1) ph_modnorm(p, p.x, p.norm1_g, 0 * DM, 1 * DM, p.hb, bid, nb, lds);
    if constexpr (PH == 2) gemm_run(lds, p.hb, p.Wt1, NTOK, ZW, DM, pg8::EpiZG{p.ZG, p.b_bg});
    if constexpr (PH == 3) { ph_retprep(p, bid, nb, lds); ph_gmlp2(p, bid, nb, lds); }
    if constexpr (PH == 11) ph_ret2(p, bid, nb, lds);
    if constexpr (PH == 4) ph_gn(p, bid, nb, lds);
    if constexpr (PH == 5) {
        gemm_run(lds, p.yain, p.Wta, NTOK, DM, 1024, pg8::EpiMixB<0>{p.hb, p.ZG, 0});
        gemm_run(lds, p.ybin, p.Wtb, NTOK, DM, DM, pg8::EpiMixB<1>{p.hb, p.ZG, 2048});
    }
    if constexpr (PH == 6) gemm_run(lds, p.hb, p.Wto, NTOK, DM, DM, pg8::EpiResF{p.obuf, p.x, p.ada + 2 * DM});
    if constexpr (PH == 7) { ph_modnorm(p, p.obuf, p.norm2_g, 3 * DM, 4 * DM, p.hb, bid, nb, lds); if (nb != 256) ph_tabconv(p, bid, nb); }
    if constexpr (PH == 8) gemm_run(lds, p.hb, p.Wtq, NTOK, DM, DM, pg8::EpiF32{p.qbuf, DM});
    if constexpr (PH == 9) ph_topk2(p, p.qbuf, bid, nb, lds);
    if constexpr (PH == 10) ph_peer3(p, p.obuf, p.hb, bid, nb);
}

constexpr int MISC_OFF = 132 * 1024;
__global__ void __launch_bounds__(NTH) k_mega(Params p) {
    extern __shared__ __attribute__((aligned(16))) float lds[];
    const int bid = blockIdx.x, nb = gridDim.x;
    volatile LAS unsigned* misc = (volatile LAS unsigned*)((LAS unsigned char*)lds + MISC_OFF);
    if (threadIdx.x < 4) misc[threadIdx.x] = 0u;
    __syncthreads();
    XcdBarrier bar = xcd_barrier_post(p.bar, misc);
    run_phase<0>(p, bid, nb, lds); xcd_barrier(bar);
    run_phase<1>(p, bid, nb, lds); xcd_barrier(bar);
    run_phase<2>(p, bid, nb, lds); xcd_barrier(bar);
    run_phase<3>(p, bid, nb, lds); xcd_barrier(bar);
    run_phase<11>(p, bid, nb, lds); xcd_barrier(bar);
    run_phase<4>(p, bid, nb, lds); xcd_barrier(bar);
    run_phase<5>(p, bid, nb, lds); xcd_barrier(bar);
    run_phase<6>(p, bid, nb, lds); xcd_barrier(bar);
    run_phase<7>(p, bid, nb, lds); xcd_barrier(bar);
    run_phase<8>(p, bid, nb, lds); xcd_barrier(bar);
    run_phase<9>(p, bid, nb, lds); xcd_barrier(bar);
    run_phase<10>(p, bid, nb, lds);
}

extern "C" void kernel_launch(void* const* d_in, const int* in_sizes, int n_in, void* d_out, int out_size, void* d_ws, size_t ws_size, hipStream_t stream) {
    Params p{};
    p.x = (const float*)d_in[0]; p.c = (const float*)d_in[1]; p.pos = (const int*)d_in[2];
    p.w_ada = (const float*)d_in[3]; p.b_ada = (const float*)d_in[4]; p.norm1_g = (const float*)d_in[5]; p.w_in = (const float*)d_in[6];
    p.w_bg = (const float*)d_in[7]; p.b_bg = (const float*)d_in[8]; p.gm_v_g = (const float*)d_in[9]; p.gm_ws = (const float*)d_in[10];
    p.gm_b = (const float*)d_in[11]; p.ret_gn_g = (const float*)d_in[12]; p.w_a_out = (const float*)d_in[13]; p.w_b_out = (const float*)d_in[14];
    p.w_o = (const float*)d_in[15]; p.norm2_g = (const float*)d_in[16]; p.peer_wq = (const float*)d_in[17]; p.peer_sk = (const float*)d_in[18];
    p.peer_u = (const float*)d_in[19]; p.peer_v = (const float*)d_in[20]; p.norm_f_g = (const float*)d_in[21];
    p.out = (float*)d_out;
    char* w = (char*)d_ws; size_t off = 0;
    auto take = [&](size_t bytes) { char* r = w + off; off += (bytes + 255) & ~(size_t)255; return r; };
    p.bar = (unsigned*)take(XCD_BAR_WORDS * 4);
    p.ada = (float*)take(2 * NMOD * 4);
    p.rope = (float*)take((size_t)NTOK * 128 * 4);
    p.eidx = (int*)take((size_t)NTOK * 128 * 4);
    p.gatev = (float*)take((size_t)NTOK * 128 * 4);
    p.Wt1 = (bf16_t*)take((size_t)ZW * DM * 2);
    p.Wta = (bf16_t*)take((size_t)DM * 1024 * 2);
    p.Wtb = (bf16_t*)take((size_t)DM * DM * 2);
    p.Wto = (bf16_t*)take((size_t)DM * DM * 2);
    p.Wtq = (bf16_t*)take((size_t)DM * DM * 2);
    p.hb = (bf16_t*)take((size_t)NTOK * DM * 2);
    p.ZG = (bf16_t*)take((size_t)NTOK * ZW * 2);
    p.qbuf = (float*)p.ZG;
    p.obuf = (float*)take((size_t)NTOK * DM * 4);
    p.ybin = (bf16_t*)take((size_t)NTOK * DM * 2);
    p.yain = (bf16_t*)take((size_t)NTOK * 1024 * 2);
    p.U8 = (unsigned char*)p.ZG + (size_t)NTOK * DM * 4;
    p.V8 = p.U8 + (size_t)16384 * ROW6;
    p.su = (float*)take(16384 * 4); p.sv = (float*)take(16384 * 4);
    p.Qr = (bf16_t*)take((size_t)NTOK * 1024 * 2);
    p.Kr = (bf16_t*)take((size_t)NTOK * 1024 * 2);
    p.KTd = (bf16_t*)take((size_t)NTOK * 1024 * 2);
    p.Vt = (bf16_t*)take((size_t)NTOK * 2048 * 2);
    p.ob16 = (bf16_t*)take((size_t)NTOK * DM * 2);
    if (off > ws_size) { fprintf(stderr, "kernel_launch: workspace too small: need %zu have %zu\n", off, ws_size); return; }
    static int grid = 0;
    if (!grid) {
        int dev = 0, cus = 0, per_cu = 0;
        (void)hipGetDevice(&dev); (void)hipDeviceGetAttribute(&cus, hipDeviceAttributeMultiprocessorCount, dev);
        (void)hipFuncSetAttribute((const void*)k_mega, hipFuncAttributeMaxDynamicSharedMemorySize, LDS_BYTES);
        (void)hipOccupancyMaxActiveBlocksPerMultiprocessor(&per_cu, k_mega, NTH, LDS_BYTES);
        (void)per_cu;
        grid = cus;
    }
    (void)hipMemsetAsync(p.bar, 0, XCD_BAR_WORDS * 4, stream);
    hipLaunchKernelGGL(k_mega, dim3(grid), dim3(NTH), LDS_BYTES, stream, p);
    hipError_t e = hipPeekAtLastError();
    if (e != hipSuccess) fprintf(stderr, "launch failed: %s (grid %d)\n", hipGetErrorString(e), grid);
}
```

```cpp
#include <hip/hip_runtime.h>
#include <hip/hip_cooperative_groups.h>
#include <stdint.h>
#include <math.h>
#include <cstdio>

namespace cg = cooperative_groups;

constexpr int DM = 2048;
constexpr int SQ = 4096;
constexpr int NTOK = 8192;
constexpr int NTH = 512;
constexpr int ZW = 12288;
constexpr int NMOD = 12288;
constexpr int LDS_BYTES = 136 * 1024;

typedef unsigned short bf16_t;

struct Params {
    const float *x, *c; const int* pos;
    const float *w_ada, *b_ada, *norm1_g, *w_in, *w_bg, *b_bg, *gm_v_g, *gm_ws, *gm_b, *ret_gn_g, *w_a_out, *w_b_out, *w_o, *norm2_g,
                *peer_wq, *peer_sk, *peer_u, *peer_v, *norm_f_g;
    float* out;
    float *ada, *rope, *gatev; int* eidx;
    bf16_t *Wt1, *Wta, *Wtb, *Wto, *Wtq;
    bf16_t *hb;
    bf16_t *ZG;
    float *obuf;
    bf16_t *ybin, *yain;
    float *qbuf;
    unsigned char *U8, *V8;
    float *su, *sv;
    bf16_t *Qr, *Pm, *KTd, *Vt;
    bf16_t *ob16;
    unsigned *bar;
};

__constant__ float c_freq[64] = {
1.000000000e+00f, 8.659643531e-01f, 7.498942018e-01f, 6.493816376e-01f, 5.623413324e-01f, 4.869675338e-01f, 4.216965139e-01f, 3.651741147e-01f, 3.162277639e-01f, 2.738419771e-01f, 2.371373773e-01f, 2.053525001e-01f, 1.778279394e-01f, 1.539926529e-01f, 1.333521456e-01f, 1.154781953e-01f, 1.000000015e-01f, 8.659642935e-02f, 7.498942316e-02f, 6.493816525e-02f, 5.623413250e-02f, 4.869675264e-02f, 4.216964915e-02f, 3.651741147e-02f, 3.162277490e-02f, 2.738419548e-02f, 2.371373773e-02f, 2.053525113e-02f, 1.778279431e-02f, 1.539926510e-02f, 1.333521400e-02f, 1.154781971e-02f, 9.999999776e-03f, 8.659643121e-03f, 7.498942316e-03f, 6.493816152e-03f, 5.623413250e-03f, 4.869675264e-03f, 4.216964822e-03f, 3.651741194e-03f, 3.162277630e-03f, 2.738419687e-03f, 2.371373819e-03f, 2.053525066e-03f, 1.778279431e-03f, 1.539926510e-03f, 1.333521446e-03f, 1.154782018e-03f, 1.000000047e-03f, 8.659643354e-04f, 7.498941850e-04f, 6.493816036e-04f, 5.623413017e-04f, 4.869675322e-04f, 4.216965172e-04f, 3.651741135e-04f, 3.162277571e-04f, 2.738419571e-04f, 2.371373703e-04f, 2.053525095e-04f, 1.778279402e-04f, 1.539926598e-04f, 1.333521504e-04f, 1.154782003e-04f };

__device__ __forceinline__ int tid_() { int t = threadIdx.x; asm volatile("" : "+v"(t)); return t; }
__device__ __forceinline__ float wave_sum(float v) {
#pragma unroll
    for (int o = 1; o < 64; o <<= 1) v += __shfl_xor(v, o);
    return v;
}
__device__ __forceinline__ float wave_max(float v) {
#pragma unroll
    for (int o = 1; o < 64; o <<= 1) v = fmaxf(v, __shfl_xor(v, o));
    return v;
}
__device__ __forceinline__ float sigmoidf_(float x) { return 1.0f / (1.0f + expf(-x)); }
__device__ __forceinline__ float siluf_(float x) { return x * sigmoidf_(x); }
__device__ __forceinline__ float geluf_(float x) { return 0.5f * x * (1.0f + erff(x * 0.70710678118654752f)); }
__device__ __forceinline__ float dot4(float4 a, float4 b) { return a.x * b.x + a.y * b.y + a.z * b.z + a.w * b.w; }
__device__ __forceinline__ float bf2f(bf16_t v) { return __uint_as_float((unsigned)v << 16); }
__device__ __forceinline__ float bflo(unsigned w) { return __uint_as_float(w << 16); }
__device__ __forceinline__ float bfhi(unsigned w) { return __uint_as_float(w & 0xffff0000u); }
__device__ __forceinline__ unsigned f2bf(float f) { unsigned u = __float_as_uint(f); return (u + 0x7fffu + ((u >> 16) & 1u)) >> 16; }
__device__ __forceinline__ unsigned pk2(float lo, float hi) { return f2bf(lo) | (f2bf(hi) << 16); }

__device__ __forceinline__ void sincos_acc(float ang, float& s, float& c) {
    const double x = (double)ang;
    const double k = rint(x * 0.63661977236758134308);
    double r = fma(-k, 1.57079632679489655800, x); r = fma(-k, 6.12323399573676603587e-17, r);
    const double r2 = r * r;
    const double sp = r * (1.0 + r2 * (-1.0 / 6.0 + r2 * (1.0 / 120.0 + r2 * (-1.0 / 5040.0 + r2 * (1.0 / 362880.0 + r2 * (-1.0 / 39916800.0 + r2 * (1.0 / 6227020800.0)))))));
    const double cp = 1.0 + r2 * (-0.5 + r2 * (1.0 / 24.0 + r2 * (-1.0 / 720.0 + r2 * (1.0 / 40320.0 + r2 * (-1.0 / 3628800.0 + r2 * (1.0 / 479001600.0 + r2 * (-1.0 / 87178291200.0)))))));
    const int q = ((int)k) & 3;
    const float fs = (float)sp, fc = (float)cp;
    s = (q == 0) ? fs : (q == 1) ? fc : (q == 2) ? -fs : -fc;
    c = (q == 0) ? fc : (q == 1) ? -fs : (q == 2) ? -fc : fs;
}

namespace pg8 {
#define PG8_LAS __attribute__((address_space(3)))
typedef unsigned short bf16_t;
typedef short bf16x8 __attribute__((ext_vector_type(8)));
typedef float f32x4 __attribute__((ext_vector_type(4)));
typedef unsigned u32x4 __attribute__((ext_vector_type(4)));
constexpr int BM = 256, BK = 64, HALF = 128, HTB = HALF * BK * 2  , STAGE_BYTES = 8 * HTB, NXCD = 8, WGM = 8;

__host__ __device__ __forceinline__ int lds_byte(int r, int c) { const int st = (r >> 4) * 2 + (c >> 5), rr = r & 15, cc = c & 31, ob = rr * 64 + cc * 2; return st * 1024 + (ob ^ (((ob >> 9) & 1) << 5)); }
__host__ __device__ __forceinline__ void stage_rc(int b, int& R, int& C) { const int st = b / 1024, sb = b % 1024, swz = sb ^ (((sb >> 9) & 1) << 5); R = (st >> 1) * 16 + swz / 64; C = (st & 1) * 32 + (swz % 64) / 2; }
__host__ __device__ __forceinline__ int perm32(int rho) { const int n = rho >> 4, i = rho & 15; return 8 * (i >> 2) + 4 * n + (i & 3); }

struct Unit { int pm, pn; };
struct Gemm { const bf16_t* A; const bf16_t* Bt; int M, N, K; };

struct StaticOrder {
    int nM, nN, nwg, G, c;
    __host__ __device__ void init(int M, int N, int G_, int c_) { nM = M / BM; nN = N / BM; nwg = nM * nN; G = G_; c = c_; }
    __host__ __device__ bool next(int i, Unit& u) const {
        const long L = (long)i * G + c; if (L >= nwg) return false;
        int wgid = (int)L; { const int q = nwg / NXCD, r = nwg % NXCD, xcd = wgid % NXCD, off = wgid / NXCD; wgid = (xcd < r ? xcd * (q + 1) : r * (q + 1) + (xcd - r) * q) + off; }
        const int nig = WGM * nN, gid = wgid / nig, fm = gid * WGM, gsz = (nM - fm) < WGM ? (nM - fm) : WGM;
        u.pm = fm + ((wgid % nig) % gsz); u.pn = (wgid % nig) / gsz; return true;
    }
    __device__ __forceinline__ void a_ready(const Unit&) const {}
    __device__ __forceinline__ void done(const Unit&) const {}
};

__device__ __forceinline__ unsigned cvt_pk_bf16(float lo, float hi) { unsigned r; asm volatile("v_cvt_pk_bf16_f32 %0, %1, %2" : "=v"(r) : "v"(lo), "v"(hi)); return r; }
typedef float f32x2 __attribute__((ext_vector_type(2)));
__device__ __forceinline__ f32x2 gelu_pk(f32x2 v) {
    const f32x2 av = __builtin_elementwise_abs(v), d = av * 0.2316418882f + 1.0f;
    f32x2 t; t.x = __builtin_amdgcn_rcpf(d.x); t.y = __builtin_amdgcn_rcpf(d.y);
    f32x2 q = t * 0.5307027145f + (-0.7265760135f); q = q * t + 0.7107068705f; q = q * t + (-0.142248368f); q = q * t + 0.127414796f; q = q * t;
    const f32x2 s = (v * v) * (-0.72134752044f);
    f32x2 e; e.x = __builtin_amdgcn_exp2f(s.x); e.y = __builtin_amdgcn_exp2f(s.y);
    const f32x2 m = v * (q * e), r = v - m;
    f32x2 o; o.x = v.x < 0.f ? m.x : r.x; o.y = v.y < 0.f ? m.y : r.y; return o;
}

typedef unsigned u32x2v __attribute__((ext_vector_type(2)));
struct EpiZG {
    static constexpr bool PERM = true, AFTER_DRAIN = false;
    bf16_t* O; const float* bias;
    __device__ __forceinline__ void operator()(const f32x4 (&acc)[2][2][4][2], const Unit& u, int wr, int wc, int fr, int fq) const {
        const int row0 = u.pm * BM + wr * 64 + fr, col0 = u.pn * BM + wc * 32 + 8 * fq;
        const int mode = u.pn < 8 ? 1 : (u.pn < 32 ? 0 : 2);
        f32x4 bv[2][2];
#pragma unroll
        for (int bj = 0; bj < 2; ++bj)
#pragma unroll
            for (int n = 0; n < 2; ++n) bv[bj][n] = (mode == 2) ? *(const f32x4*)(bias + (col0 - 8192) + bj * HALF + 4 * n) : (f32x4){0.f, 0.f, 0.f, 0.f};
#pragma unroll
        for (int ai = 0; ai < 2; ++ai)
#pragma unroll
            for (int m = 0; m < 4; ++m) { bf16_t* rowp = O + (size_t)(row0 + ai * HALF + m * 16) * ZW + col0;
#pragma unroll
                for (int bj = 0; bj < 2; ++bj) { f32x4 v0 = acc[ai][bj][m][0], v1 = acc[ai][bj][m][1];
                    if (mode == 1) { f32x2 a = gelu_pk((f32x2){v0[0], v0[1]}), b = gelu_pk((f32x2){v0[2], v0[3]}), c = gelu_pk((f32x2){v1[0], v1[1]}), d = gelu_pk((f32x2){v1[2], v1[3]});
                        v0 = (f32x4){a.x, a.y, b.x, b.y}; v1 = (f32x4){c.x, c.y, d.x, d.y}; }
                    if (mode == 2) { v0 = v0 + bv[bj][0]; v1 = v1 + bv[bj][1];
#pragma unroll
                        for (int e = 0; e < 4; ++e) { v0[e] = __builtin_amdgcn_rcpf(1.0f + __expf(-v0[e])); v1[e] = __builtin_amdgcn_rcpf(1.0f + __expf(-v1[e])); } }
                    u32x4 w; w.x = cvt_pk_bf16(v0[0], v0[1]); w.y = cvt_pk_bf16(v0[2], v0[3]); w.z = cvt_pk_bf16(v1[0], v1[1]); w.w = cvt_pk_bf16(v1[2], v1[3]);
                    *(u32x4*)(rowp + bj * HALF) = w; } }
    }
};
template <int ACCUM> struct EpiMixB {
    static constexpr bool PERM = true, AFTER_DRAIN = false;
    bf16_t* Mo; const bf16_t* ZGp; int goff;
    __device__ __forceinline__ void operator()(const f32x4 (&acc)[2][2][4][2], const Unit& u, int wr, int wc, int fr, int fq) const {
        const int row0 = u.pm * BM + wr * 64 + fr, col0 = u.pn * BM + wc * 32 + 8 * fq;
#pragma unroll
        for (int ai = 0; ai < 2; ++ai)
#pragma unroll
            for (int m = 0; m < 4; ++m) { const size_t row = (size_t)(row0 + ai * HALF + m * 16);
#pragma unroll
                for (int bj = 0; bj < 2; ++bj) { const f32x4 v0 = acc[ai][bj][m][0], v1 = acc[ai][bj][m][1];
                    const u32x4 g = *(const u32x4*)(ZGp + row * ZW + 8192 + goff + col0 + bj * HALF);
                    float o[8];
                    o[0] = bflo(g.x) * v0[0]; o[1] = bfhi(g.x) * v0[1]; o[2] = bflo(g.y) * v0[2]; o[3] = bfhi(g.y) * v0[3];
                    o[4] = bflo(g.z) * v1[0]; o[5] = bfhi(g.z) * v1[1]; o[6] = bflo(g.w) * v1[2]; o[7] = bfhi(g.w) * v1[3];
                    bf16_t* mp = Mo + row * DM + col0 + bj * HALF;
                    if (ACCUM) { const u32x4 old = *(const u32x4*)mp;
                        o[0] += bflo(old.x); o[1] += bfhi(old.x); o[2] += bflo(old.y); o[3] += bfhi(old.y); o[4] += bflo(old.z); o[5] += bfhi(old.z); o[6] += bflo(old.w); o[7] += bfhi(old.w); }
                    u32x4 w; w.x = cvt_pk_bf16(o[0], o[1]); w.y = cvt_pk_bf16(o[2], o[3]); w.z = cvt_pk_bf16(o[4], o[5]); w.w = cvt_pk_bf16(o[6], o[7]);
                    *(u32x4*)mp = w; } }
    }
};
struct EpiResF {
    static constexpr bool PERM = false, AFTER_DRAIN = false;
    float* x1; const float* x; const float* ga;
    __device__ __forceinline__ void operator()(const f32x4 (&acc)[2][2][4][2], const Unit& u, int wr, int wc, int fr, int fq) const {
        const int row0 = u.pm * BM + wr * 64 + fr, col0 = u.pn * BM + wc * 32 + 4 * fq;
        const int b = (u.pm * BM) / SQ;
        f32x4 gv[2][2];
#pragma unroll
        for (int bj = 0; bj < 2; ++bj)
#pragma unroll
            for (int n = 0; n < 2; ++n) gv[bj][n] = *(const f32x4*)(ga + b * NMOD + col0 + bj * HALF + n * 16);
#pragma unroll
        for (int ai = 0; ai < 2; ++ai)
#pragma unroll
            for (int m = 0; m < 4; ++m) { const size_t off = (size_t)(row0 + ai * HALF + m * 16) * DM + col0;
#pragma unroll
                for (int bj = 0; bj < 2; ++bj)
#pragma unroll
                    for (int n = 0; n < 2; ++n) { const f32x4 xv = *(const f32x4*)(x + off + bj * HALF + n * 16);
                        *(f32x4*)(x1 + off + bj * HALF + n * 16) = xv + gv[bj][n] * acc[ai][bj][m][n]; } }
    }
};
struct EpiF32 {
    static constexpr bool PERM = false, AFTER_DRAIN = false;
    float* O; int ldc;
    __device__ __forceinline__ void operator()(const f32x4 (&acc)[2][2][4][2], const Unit& u, int wr, int wc, int fr, int fq) const {
        const int row0 = u.pm * BM + wr * 64 + fr, col0 = u.pn * BM + wc * 32 + 4 * fq;
#pragma unroll
        for (int ai = 0; ai < 2; ++ai)
#pragma unroll
            for (int m = 0; m < 4; ++m) { const size_t off = (size_t)(row0 + ai * HALF + m * 16) * ldc + col0;
#pragma unroll
                for (int bj = 0; bj < 2; ++bj)
#pragma unroll
                    for (int n = 0; n < 2; ++n) *(f32x4*)(O + off + bj * HALF + n * 16) = acc[ai][bj][m][n]; }
    }
};

template <class Epi, class Sched, bool ALIGN_EPI = false, bool SP2 = false>
__device__ __forceinline__ void gemm_phase(PG8_LAS unsigned char* lds, const Gemm g, const Sched& S, const Epi& E) {
    const int tid = threadIdx.x, wid = __builtin_amdgcn_readfirstlane(tid >> 6), lane = tid & 63, wr = wid >> 2, wc = wid & 3, fr = lane & 15, fq = lane >> 4;
    const int K = g.K, nt = K / BK;
    unsigned voffA[2], voffB[2];
#pragma unroll
    for (int i = 0; i < 2; ++i) { int R, C; stage_rc(tid * 16 + i * 8192, R, C); const int Rb = Epi::PERM ? ((R & ~31) + perm32(R & 31)) : R;
        voffA[i] = (unsigned)(R * K + C) * 2u; voffB[i] = (unsigned)(Rb * K + C) * 2u; }
    const size_t kstep = (size_t)(BK * 2);
    const size_t hstep = (size_t)HALF * K * 2;
    const size_t tstep = 2 * hstep;
    const unsigned ldsw = (unsigned)wid * 1024u;
    const int aoff = lds_byte(wr * 64 + fr, fq * 8), boff = lds_byte(wc * 32 + fr, fq * 8);
#define PG8_SA(b, h) (((b) * 2 + (h)) * HTB)
#define PG8_SB(b, h) ((4 + (b) * 2 + (h)) * HTB)
#define PG8_STAGE(bufoff, gbase, voff) do { _Pragma("unroll") for (int _i = 0; _i < 2; ++_i) \
        __builtin_amdgcn_global_load_lds((const unsigned*)((const char*)(gbase) + (voff)[_i]), (PG8_LAS unsigned*)(lds + (bufoff) + ldsw + _i * 8192), 16, 0, 0); } while (0)
#define PG8_LDA(dst, b, h) do { _Pragma("unroll") for (int m = 0; m < 4; ++m) _Pragma("unroll") for (int k = 0; k < 2; ++k) dst[m][k] = *(const PG8_LAS bf16x8*)(lds + PG8_SA(b, h) + aoff + m * 2048 + k * 1024); } while (0)
#define PG8_LDB(dst, b, h) do { _Pragma("unroll") for (int n = 0; n < 2; ++n) _Pragma("unroll") for (int k = 0; k < 2; ++k) dst[n][k] = *(const PG8_LAS bf16x8*)(lds + PG8_SB(b, h) + boff + n * 2048 + k * 1024); } while (0)
#define PG8_MMA(ai, bj, At, Bt) do { __builtin_amdgcn_s_setprio(1); _Pragma("unroll") for (int m = 0; m < 4; ++m) _Pragma("unroll") for (int n = 0; n < 2; ++n) _Pragma("unroll") for (int k = 0; k < 2; ++k) \
        acc[ai][bj][m][n] = __builtin_amdgcn_mfma_f32_16x16x32_bf16(Bt[n][k], At[m][k], acc[ai][bj][m][n], 0, 0, 0); __builtin_amdgcn_s_setprio(0); } while (0)
#define PG8_WAIT_V(n) asm volatile("s_waitcnt vmcnt(" #n ")" ::: "memory")
#define PG8_WAIT_L(n) asm volatile("s_waitcnt lgkmcnt(" #n ")" ::: "memory")
#define PG8_BAR __builtin_amdgcn_s_barrier()
#define PG8_SCHED __builtin_amdgcn_sched_barrier(0)
    Unit cur, nxt; int ui = 0;
    if (!S.next(0, cur)) return;
    f32x4 acc[2][2][4][2];
#pragma unroll
    for (int a = 0; a < 2; ++a)
#pragma unroll
        for (int b = 0; b < 2; ++b)
#pragma unroll
            for (int m = 0; m < 4; ++m)
#pragma unroll
                for (int n = 0; n < 2; ++n) acc[a][b][m][n] = (f32x4){0.f, 0.f, 0.f, 0.f};
    bf16x8 At[4][2], B0[2][2], B1[2][2];
    const char* cA = (const char*)g.A + (size_t)cur.pm * tstep; const char* cB = (const char*)g.Bt + (size_t)cur.pn * tstep;
    S.a_ready(cur);
    if constexpr (SP2) {
        PG8_STAGE(PG8_SB(0, 0), cB, voffB); PG8_STAGE(PG8_SB(0, 1), cB + hstep, voffB); PG8_STAGE(PG8_SA(0, 0), cA, voffA); PG8_STAGE(PG8_SA(0, 1), cA + hstep, voffA);
        if (wr == 1) PG8_BAR;
        PG8_WAIT_V(2); PG8_BAR;
        PG8_STAGE(PG8_SB(1, 0), cB + kstep, voffB); PG8_STAGE(PG8_SA(1, 0), cA + kstep, voffA); PG8_STAGE(PG8_SB(1, 1), cB + hstep + kstep, voffB);
        PG8_WAIT_V(6); PG8_BAR;
    } else {
        PG8_STAGE(PG8_SB(0, 0), cB, voffB); PG8_STAGE(PG8_SA(0, 0), cA, voffA); PG8_STAGE(PG8_SB(0, 1), cB + hstep, voffB); PG8_STAGE(PG8_SA(0, 1), cA + hstep, voffA);
        if (wr == 1) PG8_BAR;
        PG8_WAIT_V(4); PG8_BAR;
        PG8_STAGE(PG8_SB(1, 0), cB + kstep, voffB); PG8_STAGE(PG8_SA(1, 0), cA + kstep, voffA); PG8_STAGE(PG8_SB(1, 1), cB + hstep + kstep, voffB);
        PG8_WAIT_V(6); PG8_BAR;
    }
    for (;;) {
        const bool has_next = S.next(ui + 1, nxt);
        const char* nA = has_next ? (const char*)g.A + (size_t)nxt.pm * tstep : cA; const char* nB = has_next ? (const char*)g.Bt + (size_t)nxt.pn * tstep : cB;
        for (int t = 0; t < nt; t += 2) {
            const bool last = (t == nt - 2);
            const char* a1 = cA + (size_t)(t + 1) * kstep;
            const char* a2 = last ? nA : cA + (size_t)(t + 2) * kstep; const char* b2 = last ? nB : cB + (size_t)(t + 2) * kstep;
            const char* a3 = a2 + kstep; const char* b3 = b2 + kstep;
            if (last && has_next) S.a_ready(nxt);
            if constexpr (SP2) {
            PG8_LDB(B0, 0, 0); PG8_LDB(B1, 0, 1); PG8_SCHED; PG8_LDA(At, 0, 0); PG8_STAGE(PG8_SA(1, 1), a1 + hstep, voffA);
            PG8_WAIT_V(8); PG8_WAIT_L(0); PG8_BAR; PG8_MMA(0, 0, At, B0); PG8_MMA(0, 1, At, B1); PG8_BAR; PG8_SCHED;
            PG8_LDA(At, 0, 1); PG8_STAGE(PG8_SB(0, 0), b2, voffB); PG8_STAGE(PG8_SB(0, 1), b2 + hstep, voffB); PG8_STAGE(PG8_SA(0, 0), a2, voffA);
            PG8_WAIT_V(8); PG8_WAIT_L(0); PG8_BAR; PG8_MMA(1, 0, At, B0); PG8_MMA(1, 1, At, B1); PG8_BAR; PG8_SCHED;
            PG8_LDB(B0, 1, 0); PG8_LDB(B1, 1, 1); PG8_SCHED; PG8_LDA(At, 1, 0); PG8_STAGE(PG8_SA(0, 1), a2 + hstep, voffA);
            PG8_WAIT_V(8); PG8_WAIT_L(0); PG8_BAR; PG8_MMA(0, 0, At, B0); PG8_MMA(0, 1, At, B1); PG8_BAR; PG8_SCHED;
            PG8_LDA(At, 1, 1); PG8_STAGE(PG8_SB(1, 0), b3, voffB); PG8_STAGE(PG8_SB(1, 1), b3 + hstep, voffB); PG8_STAGE(PG8_SA(1, 0), a3, voffA);
            PG8_WAIT_V(8); PG8_WAIT_L(0); PG8_BAR; PG8_MMA(1, 0, At, B0); PG8_MMA(1, 1, At, B1); PG8_BAR; PG8_SCHED;
            } else {
            PG8_LDB(B0, 0, 0); PG8_SCHED; PG8_LDA(At, 0, 0); PG8_STAGE(PG8_SA(1, 1), a1 + hstep, voffA);
            PG8_WAIT_L(8); PG8_BAR; PG8_WAIT_L(0); PG8_MMA(0, 0, At, B0); PG8_BAR; PG8_SCHED;
            PG8_LDB(B1, 0, 1); PG8_STAGE(PG8_SB(0, 0), b2, voffB);
            PG8_BAR; PG8_WAIT_L(0); PG8_MMA(0, 1, At, B1); PG8_BAR;
            PG8_LDA(At, 0, 1); PG8_STAGE(PG8_SA(0, 0), a2, voffA);
            PG8_BAR; PG8_WAIT_L(0); PG8_MMA(1, 0, At, B0); PG8_BAR; PG8_SCHED;
            PG8_STAGE(PG8_SB(0, 1), b2 + hstep, voffB);
            PG8_WAIT_V(6); PG8_BAR; PG8_MMA(1, 1, At, B1); PG8_BAR;
            PG8_LDB(B0, 1, 0); PG8_SCHED; PG8_LDA(At, 1, 0); PG8_STAGE(PG8_SA(0, 1), a2 + hstep, voffA);
            PG8_WAIT_L(8); PG8_BAR; PG8_WAIT_L(0); PG8_MMA(0, 0, At, B0); PG8_BAR; PG8_SCHED;
            PG8_LDB(B1, 1, 1); PG8_STAGE(PG8_SB(1, 0), b3, voffB);
            PG8_BAR; PG8_WAIT_L(0); PG8_MMA(0, 1, At, B1); PG8_BAR;
            PG8_LDA(At, 1, 1); PG8_STAGE(PG8_SA(1, 0), a3, voffA);
            PG8_BAR; PG8_WAIT_L(0); PG8_MMA(1, 0, At, B0); PG8_BAR; PG8_SCHED;
            PG8_STAGE(PG8_SB(1, 1), b3 + hstep, voffB);
            PG8_WAIT_V(6); PG8_BAR; PG8_MMA(1, 1, At, B1); PG8_BAR;
            }
        }
        if constexpr (ALIGN_EPI) { if (wr == 0) PG8_BAR; }
        if constexpr (!Epi::AFTER_DRAIN) { E(acc, cur, wr, wc, fr, fq); S.done(cur); }
        if (!has_next) break;
#pragma unroll
        for (int a = 0; a < 2; ++a)
#pragma unroll
            for (int b = 0; b < 2; ++b)
#pragma unroll
                for (int m = 0; m < 4; ++m)
#pragma unroll
                    for (int n = 0; n < 2; ++n) acc[a][b][m][n] = (f32x4){0.f, 0.f, 0.f, 0.f};
        cur = nxt; cA = nA; cB = nB; ++ui;
        if constexpr (ALIGN_EPI) { if (wr == 1) PG8_BAR; }
    }
    PG8_WAIT_V(0);
    if constexpr (!ALIGN_EPI) { if (wr == 0) PG8_BAR; }
    PG8_BAR;
    if constexpr (Epi::AFTER_DRAIN) { E.fused(acc, cur, wr, wc, fr, fq, lds, wid, lane); S.done(cur); }
#undef PG8_SA
#undef PG8_SB
#undef PG8_STAGE
#undef PG8_LDA
#undef PG8_LDB
#undef PG8_MMA
#undef PG8_WAIT_V
#undef PG8_WAIT_L
#undef PG8_BAR
#undef PG8_SCHED
}
}
using pg8::f32x4; using pg8::u32x4;

__device__ __forceinline__ void transpose_item(const float* W, int K, int N, bf16_t* WT, int row_off, float* scr, int item, int lane) {
    const int nblk = N / 32, kb = item / nblk, nbk = item % nblk, k0 = 64 * kb, n0 = 32 * nbk;
#pragma unroll 8
    for (int i = 0; i < 32; ++i) { const int kk = 2 * i + (lane >> 5); scr[kk * 33 + (lane & 31)] = W[(size_t)(k0 + kk) * N + n0 + (lane & 31)]; }
    asm volatile("s_waitcnt lgkmcnt(0)" ::: "memory");
    const int c = lane & 7;
#pragma unroll
    for (int j = 0; j < 4; ++j) { const int n = (lane >> 3) + 8 * j; const float* s = scr + (8 * c) * 33 + n;
        uint4 o; o.x = pk2(s[0 * 33], s[1 * 33]); o.y = pk2(s[2 * 33], s[3 * 33]); o.z = pk2(s[4 * 33], s[5 * 33]); o.w = pk2(s[6 * 33], s[7 * 33]);
        *(uint4*)(WT + (size_t)(row_off + n0 + n) * K + k0 + 8 * c) = o; }
    asm volatile("s_waitcnt lgkmcnt(0)" ::: "memory");
}
__device__ __forceinline__ void ph_prep(const Params& p, int bid, int nb, float* lds) {
    const int tid = tid_(), wave = tid >> 6, lane = tid & 63;
    {
        float* sl = lds;
        float* red = lds + 4096;
        for (int i = tid; i < 4096; i += NTH) sl[i] = siluf_(p.c[i]);
        __syncthreads();
        for (int it = bid; it < 192; it += nb) {
            const int c4 = tid & 15, kg = tid >> 4;
            const float* wp = p.w_ada + (size_t)kg * NMOD + it * 64 + c4 * 4;
            float a0[4] = {0.f, 0.f, 0.f, 0.f}, a1[4] = {0.f, 0.f, 0.f, 0.f};
#pragma unroll 8
            for (int i = 0; i < 64; ++i) {
                const int k = kg + 32 * i;
                const float4 w = *(const float4*)(wp + (size_t)(32 * i) * NMOD);
                const float s0 = sl[k], s1 = sl[2048 + k];
                a0[0] += s0 * w.x; a0[1] += s0 * w.y; a0[2] += s0 * w.z; a0[3] += s0 * w.w;
                a1[0] += s1 * w.x; a1[1] += s1 * w.y; a1[2] += s1 * w.z; a1[3] += s1 * w.w;
            }
            __syncthreads();
#pragma unroll
            for (int e = 0; e < 4; ++e) { red[(kg * 16 + c4) * 8 + e] = a0[e]; red[(kg * 16 + c4) * 8 + 4 + e] = a1[e]; }
            __syncthreads();
            if (tid < 128) {
                const int b = tid >> 6, col = tid & 63;
                float s = 0.f;
                for (int g = 0; g < 32; ++g) s += red[(g * 16 + (col >> 2)) * 8 + b * 4 + (col & 3)];
                p.ada[b * NMOD + it * 64 + col] = s + p.b_ada[it * 64 + col];
            }
        }
        __syncthreads();
    }
    for (int e = bid * NTH + tid; e < NTOK * 64; e += nb * NTH) {
        const int tok = e >> 6, j = e & 63;
        const float ang = (float)p.pos[tok] * c_freq[j];
        float s, c; sincos_acc(ang, s, c);
        p.rope[(size_t)e * 2] = c; p.rope[(size_t)e * 2 + 1] = s;
    }
    {
        float* scr = lds + wave * (64 * 33);
        const int gw = bid * 8 + wave, ngw = nb * 8;
        constexpr int I1 = 32 * 256, I2 = 32 * 128, I3 = 16 * 64, I4 = 32 * 64;
        constexpr int NIT = I1 + I2 + I3 + 3 * I4;
        for (int it = gw; it < NIT; it += ngw) {
            int r = it;
            if (r < I1) { transpose_item(p.w_in, 2048, 8192, p.Wt1, 0, scr, r, lane); continue; } r -= I1;
            if (r < I2) { transpose_item(p.w_bg, 2048, 4096, p.Wt1, 8192, scr, r, lane); continue; } r -= I2;
            if (r < I3) { transpose_item(p.w_a_out, 1024, 2048, p.Wta, 0, scr, r, lane); continue; } r -= I3;
            if (r < I4) { transpose_item(p.w_b_out, 2048, 2048, p.Wtb, 0, scr, r, lane); continue; } r -= I4;
            if (r < I4) { transpose_item(p.w_o, 2048, 2048, p.Wto, 0, scr, r, lane); continue; } r -= I4;
            transpose_item(p.peer_wq, 2048, 2048, p.Wtq, 0, scr, r, lane);
        }
    }
    __syncthreads();
}
constexpr int ROW6 = 1536;
typedef float f32x32_t __attribute__((ext_vector_type(32)));
typedef unsigned u32x6_t __attribute__((ext_vector_type(6)));
__device__ __forceinline__ void tc_load(const Params& p, int r, int lane, float4 (&t)[8]) {
    const bool second = r >= 16384; const int row = second ? r - 16384 : r;
    const float* src = (second ? p.peer_v : p.peer_u) + (size_t)row * DM + lane * 32;
#pragma unroll
    for (int q = 0; q < 8; ++q) t[q] = *(const float4*)(src + 4 * q);
}
__device__ __forceinline__ void tc_finish(const Params& p, int r, int lane, const float4 (&t)[8]) {
    const bool second = r >= 16384; const int row = second ? r - 16384 : r;
    float am = 0.f;
#pragma unroll
    for (int q = 0; q < 8; ++q) am = fmaxf(am, fmaxf(fmaxf(fabsf(t[q].x), fabsf(t[q].y)), fmaxf(fabsf(t[q].z), fabsf(t[q].w))));
    am = wave_max(am);
    const float sc = (am > 0.f) ? am * (1.0f / 7.5f) : 1.0f, inv = (am > 0.f) ? 7.5f / am : 1.0f;
    typedef float f32x16_t __attribute__((ext_vector_type(16)));
    f32x16_t ev, od;
#pragma unroll
    for (int q = 0; q < 8; ++q) { ev[2 * q] = t[q].x * inv; od[2 * q] = t[q].y * inv; ev[2 * q + 1] = t[q].z * inv; od[2 * q + 1] = t[q].w * inv; }
    const u32x6_t w = __builtin_amdgcn_cvt_scalef32_2xpk16_fp6_f32(ev, od, 1.0f);
    unsigned char* dst = (second ? p.V8 : p.U8) + (size_t)row * ROW6 + lane * 24;
    *(uint2*)(dst) = make_uint2(w[0], w[1]); *(uint2*)(dst + 8) = make_uint2(w[2], w[3]); *(uint2*)(dst + 16) = make_uint2(w[4], w[5]);
    if (lane == 0) (second ? p.sv : p.su)[row] = sc;
}
__device__ __forceinline__ void ph_tabconv(const Params& p, int bid, int nb) {
    const int tid = tid_(), wave = tid >> 6, lane = tid & 63;
    for (int r = bid * 8 + wave; r < 2 * 16384; r += nb * 8) { float4 t[8]; tc_load(p, r, lane, t); tc_finish(p, r, lane, t); }
}

__device__ __forceinline__ void ph_modnorm(const Params& p, const float* xin, const float* g, int sh_off, int sc_off, bf16_t* hout, int bid, int nb, float* lds) {
    const int tid = tid_(), wave = tid >> 6, lane = tid & 63;
    const int stride = nb * 8;
    int row = bid * 8 + wave;
    float4 v[8], vn[8];
    if (row < NTOK) {
#pragma unroll
        for (int j = 0; j < 8; ++j) v[j] = ((const float4*)(xin + (size_t)row * DM))[lane + 64 * j];
    }
    for (; row < NTOK; row += stride) {
        const int nrow = row + stride;
        if (nrow < NTOK) {
#pragma unroll
            for (int j = 0; j < 8; ++j) vn[j] = ((const float4*)(xin + (size_t)nrow * DM))[lane + 64 * j];
        }
        const int b = row / SQ;
        float ss = 0.f;
#pragma unroll
        for (int j = 0; j < 8; ++j) ss += dot4(v[j], v[j]);
        ss = wave_sum(ss);
        const float rs = 1.0f / sqrtf(ss * (1.0f / DM) + 1e-6f);
#pragma unroll
        for (int j = 0; j < 8; ++j) {
            const int col = (lane + 64 * j) * 4;
            const float4 g4 = *(const float4*)(g + col);
            const float4 sc = *(const float4*)(p.ada + b * NMOD + sc_off + col);
            const float4 sh = *(const float4*)(p.ada + b * NMOD + sh_off + col);
            float4 o;
            o.x = v[j].x * rs * g4.x * (1.0f + sc.x) + sh.x; o.y = v[j].y * rs * g4.y * (1.0f + sc.y) + sh.y;
            o.z = v[j].z * rs * g4.z * (1.0f + sc.z) + sh.z; o.w = v[j].w * rs * g4.w * (1.0f + sc.w) + sh.w;
            *(uint2*)(hout + (size_t)row * DM + col) = make_uint2(pk2(o.x, o.y), pk2(o.z, o.w));
        }
#pragma unroll
        for (int j = 0; j < 8; ++j) v[j] = vn[j];
    }
}

typedef short bf16x8_t __attribute__((ext_vector_type(8)));
typedef float f32x4_t __attribute__((ext_vector_type(4)));
__device__ __forceinline__ bf16x8_t ldfrag(const char* base, int row, int chunk, int rb, int sm) { return *(const bf16x8_t*)(base + row * rb + ((chunk ^ (row & sm)) << 4)); }
__device__ __forceinline__ void ph_gmlp2(const Params& p, int bid, int nb, float* lds) {
    char* WM = (char*)lds; char* VT = WM + 32768;
    const int tid = tid_(), wave = tid >> 6, lane = tid & 63, fr = lane & 15, fq = lane >> 4;
    int gl = -1;
    for (int it = bid; it < 512; it += nb) {
        const int g = it & 7, n = (it >> 3) & 31, b = it >> 8;
        const int tok0 = b * SQ + n * 128;
        __syncthreads();
        if (g != gl) {
            for (int u = tid; u < 2048; u += NTH) {
                const int i = u >> 4, c = u & 15;
                const float4* src = (const float4*)(p.gm_ws + (size_t)g * 16384 + i * 128 + c * 8);
                float4 a = src[0], b4 = src[1];
                if ((i >> 6) < (c >> 3)) { a = make_float4(0.f, 0.f, 0.f, 0.f); b4 = a; }
                *(uint4*)(WM + i * 256 + ((c ^ (i & 15)) << 4)) = make_uint4(pk2(a.x, a.y), pk2(a.z, a.w), pk2(b4.x, b4.y), pk2(b4.z, b4.w));
            }
            gl = g;
        }
        {
            const float2 gn = *(const float2*)(p.gm_v_g + g * 128 + lane * 2);
#pragma unroll 4
            for (int jj = 0; jj < 16; ++jj) {
                const int j = wave * 16 + jj;
                const unsigned w = *(const unsigned*)(p.ZG + (size_t)(tok0 + j) * ZW + 1024 + g * 128 + lane * 2);
                const float a = bflo(w), c2 = bfhi(w);
                const float ss = wave_sum(a * a + c2 * c2);
                const float rs = 1.0f / sqrtf(ss * (1.0f / 128.0f) + 1e-6f);
                const int d0 = lane * 2, d1 = d0 + 1;
                *(bf16_t*)(VT + d0 * 256 + (((j >> 3) ^ (d0 & 15)) << 4) + (j & 7) * 2) = (bf16_t)f2bf(a * rs * gn.x);
                *(bf16_t*)(VT + d1 * 256 + (((j >> 3) ^ (d1 & 15)) << 4) + (j & 7) * 2) = (bf16_t)f2bf(c2 * rs * gn.y);
            }
        }
        __syncthreads();
        {
            bf16x8_t A[4];
#pragma unroll
            for (int ks = 0; ks < 4; ++ks) A[ks] = ldfrag(VT, wave * 16 + fr, ks * 4 + fq, 256, 15);
            const int d0 = wave * 16 + fq * 4;
#pragma unroll
            for (int itl = 0; itl < 8; ++itl) {
                f32x4_t acc = {0.f, 0.f, 0.f, 0.f};
#pragma unroll
                for (int ks = 0; ks < 4; ++ks) if (itl >= 4 || ks < 2) acc = __builtin_amdgcn_mfma_f32_16x16x32_bf16(A[ks], ldfrag(WM, itl * 16 + fr, ks * 4 + fq, 256, 15), acc, 0, 0, 0);
                const int i = itl * 16 + fr;
                const float bias = p.gm_b[g * 128 + i];
                const size_t tok = (size_t)(tok0 + i);
                const uint2 uw = *(const uint2*)(p.ZG + tok * ZW + g * 128 + d0);
                *(uint2*)(p.yain + tok * 1024 + g * 128 + d0) = make_uint2(pk2(bflo(uw.x) * (acc[0] + bias), bfhi(uw.x) * (acc[1] + bias)), pk2(bflo(uw.y) * (acc[2] + bias), bfhi(uw.y) * (acc[3] + bias)));
            }
        }
    }
    __syncthreads();
}

__device__ __forceinline__ void ph_ret(const Params& p, int bid, int nb, float* lds) {
    float* Qs = lds;
    float* Ks = Qs + 64 * 129;
    float* Vs = Ks + 64 * 129;
    float* Ss = Vs + 64 * 16;
    float* At = Ss + 128 * 16;
    float* kd = At + 64 * 65;
    const int tid = tid_();
    const bf16_t* z = p.ZG;
    for (int it = bid; it < 256; it += nb) {
        const int vs = it & 15, h = (it >> 4) & 7, b = it >> 7;
        const float lg = log1pf(-exp2f(-5.0f - (float)h));
        const float cdec = expf(lg * 64.0f);
        __syncthreads();
        for (int i = tid; i < 2048; i += NTH) Ss[i] = 0.f;
        if (tid < 64) kd[tid] = expf(lg * (float)(63 - tid));
        for (int n = 0; n < 64; ++n) {
            const int tok0 = b * SQ + n * 64;
            __syncthreads();
            for (int e = tid; e < 4096; e += NTH) {
                const int i = e >> 6, dd = e & 63; const size_t tok = (size_t)(tok0 + i);
                const float cs = p.rope[(tok * 64 + dd) * 2], sn = p.rope[(tok * 64 + dd) * 2 + 1];
                const bf16_t* zr = z + tok * ZW;
                const float q1 = bf2f(zr[2048 + h * 128 + dd]), q2 = bf2f(zr[2048 + h * 128 + 64 + dd]);
                const float k1 = bf2f(zr[3072 + h * 128 + dd]), k2 = bf2f(zr[3072 + h * 128 + 64 + dd]);
                Qs[i * 129 + dd] = q1 * cs - q2 * sn; Qs[i * 129 + 64 + dd] = q1 * sn + q2 * cs;
                const float sc = 0.08838834764831845f;
                Ks[i * 129 + dd] = (k1 * cs - k2 * sn) * sc; Ks[i * 129 + 64 + dd] = (k1 * sn + k2 * cs) * sc;
            }
            for (int e = tid; e < 1024; e += NTH) { const int j = e >> 4, v = e & 15; Vs[e] = bf2f(z[(size_t)(tok0 + j) * ZW + 4096 + h * 256 + vs * 16 + v]); }
            __syncthreads();
            {
                const int j = tid & 63, i0 = (tid >> 6) * 8;
                float acc[8];
#pragma unroll
                for (int ii = 0; ii < 8; ++ii) acc[ii] = 0.f;
                for (int d = 0; d < 128; ++d) {
                    const float kv = Ks[j * 129 + d];
#pragma unroll
                    for (int ii = 0; ii < 8; ++ii) acc[ii] += Qs[(i0 + ii) * 129 + d] * kv;
                }
#pragma unroll
                for (int ii = 0; ii < 8; ++ii) { const int i = i0 + ii; At[i * 65 + j] = acc[ii] * expf(lg * fabsf((float)(i - j))); }
            }
            __syncthreads();
            {
                const int v = tid & 15, i0 = tid >> 4;
#pragma unroll
                for (int rep = 0; rep < 2; ++rep) {
                    const int i = i0 + 32 * rep;
                    float a = 0.f; for (int j = 0; j < 64; ++j) a += At[i * 65 + j] * Vs[j * 16 + v];
                    float c2 = 0.f; for (int d = 0; d < 128; ++d) c2 += Qs[i * 129 + d] * Ss[d * 16 + v];
                    p.obuf[(size_t)(tok0 + i) * DM + h * 256 + vs * 16 + v] = a + c2 * expf(lg * (float)(i + 1));
                }
            }
            __syncthreads();
            {
                const int v = tid & 15, d0 = tid >> 4;
#pragma unroll
                for (int rep = 0; rep < 4; ++rep) {
                    const int d = d0 + 32 * rep;
                    float a = 0.f; for (int j = 0; j < 64; ++j) a += Ks[j * 129 + d] * kd[j] * Vs[j * 16 + v];
                    Ss[d * 16 + v] = Ss[d * 16 + v] * cdec + a;
                }
            }
        }
    }
    __syncthreads();
}


__device__ __forceinline__ void ph_retprep(const Params& p, int bid, int nb, float* lds) {
    bf16_t* Kl = (bf16_t*)lds;
    bf16_t* Vl = Kl + 64 * 132;
    char* Qm = (char*)(Vl + 64 * 264);
    char* Km = Qm + 16384;
    const int tid = tid_(), wave = tid >> 6, lane = tid & 63, fr = lane & 15, fq = lane >> 4;
    for (int it = bid; it < 1024; it += nb) {
        const int n = it & 63, h = (it >> 6) & 7, b = it >> 9;
        const int tok0 = b * SQ + n * 64;
        const size_t rowbase = (size_t)(b * 8 + h) * SQ + n * 64;
        const float lg = log1pf(-exp2f(-5.0f - (float)h));
        __syncthreads();
#pragma unroll
        for (int k = 0; k < 2; ++k) {
            const int u = tid + 512 * k, i = u >> 4, dd = (u & 15) * 4; const size_t tok = (size_t)(tok0 + i);
            const float4 r0 = *(const float4*)(p.rope + (tok * 64 + dd) * 2), r1 = *(const float4*)(p.rope + (tok * 64 + dd) * 2 + 4);
            const float cs[4] = {r0.x, r0.z, r1.x, r1.z}, sn[4] = {r0.y, r0.w, r1.y, r1.w};
            const bf16_t* zr = p.ZG + tok * ZW;
            const uint2 q1w = *(const uint2*)(zr + 2048 + h * 128 + dd), q2w = *(const uint2*)(zr + 2048 + h * 128 + 64 + dd);
            const uint2 k1w = *(const uint2*)(zr + 3072 + h * 128 + dd), k2w = *(const uint2*)(zr + 3072 + h * 128 + 64 + dd);
            const float q1[4] = {bflo(q1w.x), bfhi(q1w.x), bflo(q1w.y), bfhi(q1w.y)}, q2[4] = {bflo(q2w.x), bfhi(q2w.x), bflo(q2w.y), bfhi(q2w.y)};
            const float k1[4] = {bflo(k1w.x), bfhi(k1w.x), bflo(k1w.y), bfhi(k1w.y)}, k2[4] = {bflo(k2w.x), bfhi(k2w.x), bflo(k2w.y), bfhi(k2w.y)};
            const float sc = 0.08838834764831845f, kd = expf(lg * (float)(63 - i));
            float qa[4], qb[4], ka[4], kb[4];
#pragma unroll
            for (int e = 0; e < 4; ++e) { qa[e] = q1[e] * cs[e] - q2[e] * sn[e]; qb[e] = q1[e] * sn[e] + q2[e] * cs[e]; ka[e] = (k1[e] * cs[e] - k2[e] * sn[e]) * sc; kb[e] = (k1[e] * sn[e] + k2[e] * cs[e]) * sc; }
            const uint2 qaw = make_uint2(pk2(qa[0], qa[1]), pk2(qa[2], qa[3])), qbw = make_uint2(pk2(qb[0], qb[1]), pk2(qb[2], qb[3]));
            const uint2 kaw = make_uint2(pk2(ka[0], ka[1]), pk2(ka[2], ka[3])), kbw = make_uint2(pk2(kb[0], kb[1]), pk2(kb[2], kb[3]));
            *(uint2*)(p.Qr + (rowbase + i) * 128 + dd) = qaw; *(uint2*)(p.Qr + (rowbase + i) * 128 + 64 + dd) = qbw;
            const int c = dd >> 3, o8 = (dd & 7) * 2;
            *(uint2*)(Qm + i * 256 + ((c ^ (i & 15)) << 4) + o8) = qaw; *(uint2*)(Qm + i * 256 + (((c + 8) ^ (i & 15)) << 4) + o8) = qbw;
            *(uint2*)(Km + i * 256 + ((c ^ (i & 15)) << 4) + o8) = kaw; *(uint2*)(Km + i * 256 + (((c + 8) ^ (i & 15)) << 4) + o8) = kbw;
            *(uint2*)(Kl + i * 132 + dd) = make_uint2(pk2(ka[0] * kd, ka[1] * kd), pk2(ka[2] * kd, ka[3] * kd));
            *(uint2*)(Kl + i * 132 + 64 + dd) = make_uint2(pk2(kb[0] * kd, kb[1] * kd), pk2(kb[2] * kd, kb[3] * kd));
        }
#pragma unroll
        for (int k = 0; k < 4; ++k) {
            const int u = tid + 512 * k, j = u >> 5, c = u & 31;
            *(uint4*)(Vl + j * 264 + c * 8) = *(const uint4*)(p.ZG + (size_t)(tok0 + j) * ZW + 4096 + h * 256 + c * 8);
        }
        __syncthreads();
        {
            const int jt = wave >> 1, it0 = 2 * (wave & 1);
            f32x4_t s0 = {0.f, 0.f, 0.f, 0.f}, s1 = {0.f, 0.f, 0.f, 0.f};
#pragma unroll
            for (int ks = 0; ks < 4; ++ks) {
                const bf16x8_t a = ldfrag(Km, jt * 16 + fr, ks * 4 + fq, 256, 15);
                const bf16x8_t b0 = ldfrag(Qm, it0 * 16 + fr, ks * 4 + fq, 256, 15), b1 = ldfrag(Qm, (it0 + 1) * 16 + fr, ks * 4 + fq, 256, 15);
                s0 = __builtin_amdgcn_mfma_f32_16x16x32_bf16(a, b0, s0, 0, 0, 0);
                s1 = __builtin_amdgcn_mfma_f32_16x16x32_bf16(a, b1, s1, 0, 0, 0);
            }
            const int j0 = jt * 16 + fq * 4;
            bf16_t* pg = p.Pm + (size_t)it * 4096;
#pragma unroll
            for (int tt = 0; tt < 2; ++tt) {
                const int i = (it0 + tt) * 16 + fr; const f32x4_t sv4 = tt ? s1 : s0; float pv[4];
#pragma unroll
                for (int r = 0; r < 4; ++r) pv[r] = sv4[r] * __expf(lg * fabsf((float)(i - (j0 + r))));
                *(uint2*)(pg + i * 64 + j0) = make_uint2(pk2(pv[0], pv[1]), pk2(pv[2], pv[3]));
            }
        }
        bf16_t* kt = p.KTd + (size_t)it * 8192;
#pragma unroll
        for (int k = 0; k < 2; ++k) {
            const int u = tid + 512 * k, d = u & 127, jg = u >> 7;
            unsigned w[4];
#pragma unroll
            for (int q = 0; q < 4; ++q) w[q] = (unsigned)Kl[(jg * 8 + 2 * q) * 132 + d] | ((unsigned)Kl[(jg * 8 + 2 * q + 1) * 132 + d] << 16);
            *(uint4*)(kt + d * 64 + jg * 8) = make_uint4(w[0], w[1], w[2], w[3]);
        }
        bf16_t* vt = p.Vt + (size_t)it * 16384;
#pragma unroll
        for (int k = 0; k < 4; ++k) {
            const int u = tid + 512 * k, v = u & 255, jg = u >> 8;
            unsigned w[4];
#pragma unroll
            for (int q = 0; q < 4; ++q) w[q] = (unsigned)Vl[(jg * 8 + 2 * q) * 264 + v] | ((unsigned)Vl[(jg * 8 + 2 * q + 1) * 264 + v] << 16);
            *(uint4*)(vt + v * 64 + jg * 8) = make_uint4(w[0], w[1], w[2], w[3]);
        }
    }
    __syncthreads();
}

__device__ __forceinline__ void ph_ret2(const Params& p, int bid, int nb, float* lds) {
    char* L = (char*)lds;
    constexpr int OQ = 0, OKT = 16384, OPP = 32768, OVT = 40960, TILE = 43008, OST = 2 * TILE;
    const int tid = tid_(), wave = tid >> 6, lane = tid & 63, fr = lane & 15, fq = lane >> 4;
    for (int it = bid; it < 256; it += nb) {
        const int itm = ((it & 7) * 2 + (it >> 7)) * 16 + ((it >> 3) & 15);
        const int vs = itm & 15, h = (itm >> 4) & 7, b = itm >> 7;
        const float lg = log1pf(-exp2f(-5.0f - (float)h));
        const float cdec = expf(lg * 64.0f);
        const size_t bh = (size_t)(b * 8 + h);
        const char* gQ = (const char*)(p.Qr + bh * SQ * 128);
        const char* gKT = (const char*)(p.KTd + bh * 64 * 8192);
        const char* gP = (const char*)(p.Pm + bh * 64 * 4096);
        const char* gVt = (const char*)(p.Vt + bh * 64 * 16384) + vs * 16 * 128;
        int lq[2], lkt[2];
#pragma unroll
        for (int u = 0; u < 2; ++u) { const int ci = tid + 512 * u; const int r = ci >> 4, c = ci & 15; lq[u] = r * 256 + ((c ^ (r & 15)) << 4); const int d = ci >> 3, c8 = ci & 7; lkt[u] = d * 128 + ((c8 ^ (d & 7)) << 4); }
        const int lp = (tid >> 3) * 128 + (((tid & 7) ^ ((tid >> 3) & 7)) << 4);
        const int lv = lp;
        uint4 q0, q1, t0, t1, pp, vv = make_uint4(0u, 0u, 0u, 0u);
#define RET_LOAD(n_) do { const size_t o0 = (size_t)(n_) * 16384 + (size_t)tid * 16, o1 = o0 + 8192; \
        q0 = *(const uint4*)(gQ + o0); q1 = *(const uint4*)(gQ + o1); t0 = *(const uint4*)(gKT + o0); t1 = *(const uint4*)(gKT + o1); pp = *(const uint4*)(gP + (size_t)(n_) * 8192 + tid * 16); \
        if (tid < 128) vv = *(const uint4*)(gVt + (size_t)(n_) * 32768 + tid * 16); } while (0)
#define RET_WRITE(buf_) do { char* B_ = L + (buf_) * TILE; \
        *(uint4*)(B_ + OQ + lq[0]) = q0; *(uint4*)(B_ + OQ + lq[1]) = q1; *(uint4*)(B_ + OKT + lkt[0]) = t0; *(uint4*)(B_ + OKT + lkt[1]) = t1; *(uint4*)(B_ + OPP + lp) = pp; \
        if (tid < 128) *(uint4*)(B_ + OVT + lv) = vv; } while (0)
        __syncthreads();
        for (int i = tid; i < 1024; i += NTH) ((unsigned*)(L + OST))[i] = 0u;
        RET_LOAD(0); RET_WRITE(0);
        f32x4_t sacc[2] = {{0.f, 0.f, 0.f, 0.f}, {0.f, 0.f, 0.f, 0.f}};
#pragma unroll 1
        for (int n = 0; n < 64; ++n) {
            const int cur = n & 1;
            __syncthreads();
            if (n + 1 < 64) RET_LOAD(n + 1);
            const char* T = L + cur * TILE;
            if (wave < 4) {
                const int itl = wave;
                f32x4_t o1 = {0.f, 0.f, 0.f, 0.f}, o2 = {0.f, 0.f, 0.f, 0.f};
#pragma unroll
                for (int ks = 0; ks < 2; ++ks) o1 = __builtin_amdgcn_mfma_f32_16x16x32_bf16(ldfrag(T + OPP, itl * 16 + fr, ks * 4 + fq, 128, 7), ldfrag(T + OVT, fr, ks * 4 + fq, 128, 7), o1, 0, 0, 0);
#pragma unroll
                for (int ks = 0; ks < 4; ++ks) o2 = __builtin_amdgcn_mfma_f32_16x16x32_bf16(ldfrag(T + OQ, itl * 16 + fr, ks * 4 + fq, 256, 15), ldfrag(L + OST + cur * 4096, fr, ks * 4 + fq, 256, 15), o2, 0, 0, 0);
#pragma unroll
                for (int r = 0; r < 4; ++r) { const int i = itl * 16 + fq * 4 + r;
                    p.ob16[(size_t)(b * SQ + n * 64 + i) * DM + h * 256 + vs * 16 + fr] = (bf16_t)f2bf(o1[r] + __expf(lg * (float)(i + 1)) * o2[r]); }
            } else {
#pragma unroll
                for (int u = 0; u < 2; ++u) {
                    const int dt = 2 * (wave - 4) + u;
                    sacc[u] = sacc[u] * cdec;
#pragma unroll
                    for (int ks = 0; ks < 2; ++ks) sacc[u] = __builtin_amdgcn_mfma_f32_16x16x32_bf16(ldfrag(T + OKT, dt * 16 + fr, ks * 4 + fq, 128, 7), ldfrag(T + OVT, fr, ks * 4 + fq, 128, 7), sacc[u], 0, 0, 0);
                    *(uint2*)(L + OST + (cur ^ 1) * 4096 + fr * 256 + (((dt * 2 + (fq >> 1)) ^ fr) << 4) + (fq & 1) * 8) = make_uint2(pk2(sacc[u][0], sacc[u][1]), pk2(sacc[u][2], sacc[u][3]));
                }
            }
            if (n + 1 < 64) RET_WRITE(cur ^ 1);
        }
#undef RET_LOAD
#undef RET_WRITE
    }
    __syncthreads();
}

__device__ __forceinline__ void gn_load(const Params& p, int tok, int lane, uint2 (&ow)[8], uint2 (&gw)[8]) {
#pragma unroll
    for (int h = 0; h < 8; ++h) { ow[h] = *(const uint2*)(p.ob16 + (size_t)tok * DM + h * 256 + lane * 4); gw[h] = *(const uint2*)(p.ZG + (size_t)tok * ZW + 6144 + h * 256 + lane * 4); }
}
__device__ __forceinline__ void ph_gn(const Params& p, int bid, int nb, float* lds) {
    const int tid = tid_(), wave = tid >> 6, lane = tid & 63;
    const int stride = nb * 8;
    int tok = bid * 8 + wave;
    uint2 ow[8], gw[8], own[8], gwn[8];
    if (tok < NTOK) gn_load(p, tok, lane, ow, gw);
    for (; tok < NTOK; tok += stride) {
        if (tok + stride < NTOK) gn_load(p, tok + stride, lane, own, gwn);
        float4 o[8]; float s1[8], s2[8];
#pragma unroll
        for (int h = 0; h < 8; ++h) { o[h] = make_float4(bflo(ow[h].x), bfhi(ow[h].x), bflo(ow[h].y), bfhi(ow[h].y)); s1[h] = (o[h].x + o[h].y) + (o[h].z + o[h].w); }
#pragma unroll
        for (int off = 1; off < 64; off <<= 1)
#pragma unroll
            for (int h = 0; h < 8; ++h) s1[h] += __shfl_xor(s1[h], off);
#pragma unroll
        for (int h = 0; h < 8; ++h) { const float mu = s1[h] * (1.0f / 256.0f); o[h].x -= mu; o[h].y -= mu; o[h].z -= mu; o[h].w -= mu; s2[h] = dot4(o[h], o[h]); }
#pragma unroll
        for (int off = 1; off < 64; off <<= 1)
#pragma unroll
            for (int h = 0; h < 8; ++h) s2[h] += __shfl_xor(s2[h], off);
#pragma unroll
        for (int h = 0; h < 8; ++h) {
            const float rs = 1.0f / sqrtf(s2[h] * (1.0f / 256.0f) + 1e-6f);
            const float4 gn = *(const float4*)(p.ret_gn_g + h * 256 + lane * 4);
            const float g0 = bflo(gw[h].x), g1 = bfhi(gw[h].x), g2 = bflo(gw[h].y), g3 = bfhi(gw[h].y);
            *(uint2*)(p.ybin + (size_t)tok * DM + h * 256 + lane * 4) =
                make_uint2(pk2(siluf_(g0) * o[h].x * rs * gn.x, siluf_(g1) * o[h].y * rs * gn.y), pk2(siluf_(g2) * o[h].z * rs * gn.z, siluf_(g3) * o[h].w * rs * gn.w));
        }
#pragma unroll
        for (int h = 0; h < 8; ++h) { ow[h] = own[h]; gw[h] = gwn[h]; }
    }
}

__device__ __forceinline__ void split8(const float4 a, const float4 b, uint4& hi, uint4& lo) {
    const float x[8] = {a.x, a.y, a.z, a.w, b.x, b.y, b.z, b.w}; unsigned h[8], l[8];
#pragma unroll
    for (int i = 0; i < 8; ++i) { h[i] = f2bf(x[i]); l[i] = f2bf(x[i] - __uint_as_float(h[i] << 16)); }
    hi = make_uint4(h[0] | (h[1] << 16), h[2] | (h[3] << 16), h[4] | (h[5] << 16), h[6] | (h[7] << 16));
    lo = make_uint4(l[0] | (l[1] << 16), l[2] | (l[3] << 16), l[4] | (l[5] << 16), l[6] | (l[7] << 16));
}
__device__ __forceinline__ bf16x8_t as_bf16x8(const uint4 v) { return __builtin_bit_cast(bf16x8_t, v); }
struct PairTab { int a[52], b[52]; };
__host__ __device__ constexpr PairTab make_pairs() {
    PairTab t{}; int n = 0;
    for (int a = 0; a < 16; ++a) for (int b = 0; b < 16; ++b) if ((a + 1) * (b + 1) <= 16) { t.a[n] = a; t.b[n] = b; ++n; }
    for (; n < 52; ++n) { t.a[n] = -1; t.b[n] = -1; }
    return t;
}
constexpr PairTab PAIRS = make_pairs();
static_assert(PAIRS.a[49] >= 0 && PAIRS.a[50] < 0, "50 candidate pairs");

__device__ __forceinline__ void ph_topk2(const Params& p, const float* qb, int bid, int nb, float* lds) {
    const int tid = tid_(), wave = tid >> 6, lane = tid & 63;
    uint4* SK = (uint4*)lds;
    const float NEG = -INFINITY;
    const bool tc_on = (nb == 256); const int tcr0 = (bid * 8 + wave) * 16; float4 tct[8];
    if (tc_on) tc_load(p, tcr0, lane, tct);
    for (int it = bid; it < 256; it += nb) {
        const int h = it & 7, tg = it >> 3;
        __syncthreads();
        for (int gi = tid; gi < 4096; gi += NTH) {
            const int dq = gi & 15, n = (gi >> 4) & 127, pp = gi >> 11;
            const float4* src = (const float4*)(p.peer_sk + ((size_t)(h * 2 + pp) * 128 + n) * 128 + dq * 8);
            uint4 hi, lo; split8(src[0], src[1], hi, lo);
            const int base = (((pp * 8 + (n >> 4)) * 4 + (dq >> 2)) * 2) * 64 + (dq & 3) * 16 + (n & 15);
            SK[base] = hi; SK[base + 64] = lo;
        }
        __syncthreads();
#pragma unroll 1
        for (int tile = 0; tile < 2; ++tile) {
            const int tok = tg * 256 + wave * 32 + tile * 16 + (lane & 15);
            const int qd = lane >> 4;
            float v12[2][16];
#pragma unroll
            for (int pp = 0; pp < 2; ++pp) {
                bf16x8_t Bh[4], Bl[4];
                const float* qp = qb + (size_t)tok * DM + h * 256 + pp * 128 + 8 * qd;
#pragma unroll
                for (int ks = 0; ks < 4; ++ks) { uint4 hi, lo; split8(*(const float4*)(qp + ks * 32), *(const float4*)(qp + ks * 32 + 4), hi, lo); Bh[ks] = as_bf16x8(hi); Bl[ks] = as_bf16x8(lo); }
                float v[32];
#pragma unroll
                for (int kt = 0; kt < 8; ++kt) {
                    f32x4_t acc = {0.f, 0.f, 0.f, 0.f};
#pragma unroll
                    for (int ks = 0; ks < 4; ++ks) {
                        const bf16x8_t Ah = as_bf16x8(SK[(((pp * 8 + kt) * 4 + ks) * 2) * 64 + lane]), Al = as_bf16x8(SK[(((pp * 8 + kt) * 4 + ks) * 2 + 1) * 64 + lane]);
                        acc = __builtin_amdgcn_mfma_f32_16x16x32_bf16(Ah, Bh[ks], acc, 0, 0, 0);
                        acc = __builtin_amdgcn_mfma_f32_16x16x32_bf16(Ah, Bl[ks], acc, 0, 0, 0);
                        acc = __builtin_amdgcn_mfma_f32_16x16x32_bf16(Al, Bh[ks], acc, 0, 0, 0);
                    }
#pragma unroll
                    for (int r = 0; r < 4; ++r) v[kt * 4 + r] = __uint_as_float((__float_as_uint(acc[r]) & ~127u) | (unsigned)(kt * 16 + qd * 4 + r));
                    __builtin_amdgcn_sched_barrier(0);
                }
#pragma unroll
                for (int r = 0; r < 16; ++r) {
                    if ((r & 3) == 0 && tc_on) { const int ti = tile * 8 + pp * 4 + (r >> 2); tc_finish(p, tcr0 + ti, lane, tct); if (ti < 15) tc_load(p, tcr0 + ti + 1, lane, tct); }
                    float m = v[0];
#pragma unroll
                    for (int u = 1; u < 32; ++u) m = fmaxf(m, v[u]);
                    m = fmaxf(m, __shfl_xor(m, 16)); m = fmaxf(m, __shfl_xor(m, 32));
                    v12[pp][r] = m;
#pragma unroll
                    for (int u = 0; u < 32; ++u) v[u] = (v[u] == m) ? NEG : v[u];
                }
            }
            float c[13]; unsigned pay[13];
#pragma unroll
            for (int s = 0; s < 13; ++s) {
                float cq[4]; unsigned pq[4];
#pragma unroll
                for (int q = 0; q < 4; ++q) {
                    const int pi = 4 * s + q; const int a = PAIRS.a[pi], b = PAIRS.b[pi];
                    if (a >= 0) {
                        const float sum = v12[0][a] + v12[1][b];
                        cq[q] = __uint_as_float((__float_as_uint(sum) & ~63u) | (unsigned)pi);
                        pq[q] = (__float_as_uint(v12[0][a]) & 127u) * 128u + (__float_as_uint(v12[1][b]) & 127u);
                    } else { cq[q] = NEG; pq[q] = 0u; }
                }
                c[s] = qd == 0 ? cq[0] : qd == 1 ? cq[1] : qd == 2 ? cq[2] : cq[3];
                pay[s] = qd == 0 ? pq[0] : qd == 1 ? pq[1] : qd == 2 ? pq[2] : pq[3];
            }
            float top[16]; unsigned eid[16];
#pragma unroll
            for (int r = 0; r < 16; ++r) {
                float m = c[0];
#pragma unroll
                for (int s = 1; s < 13; ++s) m = fmaxf(m, c[s]);
                m = fmaxf(m, __shfl_xor(m, 16)); m = fmaxf(m, __shfl_xor(m, 32));
                unsigned pw = 0u;
#pragma unroll
                for (int s = 0; s < 13; ++s) { const bool eq = (c[s] == m); pw |= eq ? pay[s] : 0u; c[s] = eq ? NEG : c[s]; }
                pw |= (unsigned)__shfl_xor((int)pw, 16); pw |= (unsigned)__shfl_xor((int)pw, 32);
                top[r] = m; eid[r] = pw;
            }
            float sum = 0.f; const float mx = top[0];
#pragma unroll
            for (int r = 0; r < 16; ++r) { top[r] = expf(top[r] - mx); sum += top[r]; }
            const float inv = 1.0f / sum;
            if (lane < 16) {
                int4* ep = (int4*)(p.eidx + (size_t)tok * 128 + h * 16); float4* gp = (float4*)(p.gatev + (size_t)tok * 128 + h * 16);
#pragma unroll
                for (int q = 0; q < 4; ++q) {
                    ep[q] = make_int4((int)eid[4 * q], (int)eid[4 * q + 1], (int)eid[4 * q + 2], (int)eid[4 * q + 3]);
                    gp[q] = make_float4(top[4 * q] * inv, top[4 * q + 1] * inv, top[4 * q + 2] * inv, top[4 * q + 3] * inv);
                }
            }
        }
    }
    __syncthreads();
}

__device__ __forceinline__ void peer_load4(const unsigned char* tab, const int (&e)[4], int lane, uint2 (&R)[4][3]) {
#pragma unroll
    for (int i = 0; i < 4; ++i) { const uint2* r = (const uint2*)(tab + (size_t)e[i] * ROW6 + lane * 24); R[i][0] = r[0]; R[i][1] = r[1]; R[i][2] = r[2]; }
}
__device__ __forceinline__ f32x32_t dec6(const uint2 (&R)[3]) { const u32x6_t w = {R[0].x, R[0].y, R[1].x, R[1].y, R[2].x, R[2].y}; return __builtin_amdgcn_cvt_scalef32_pk32_f32_fp6(w, 1.0f); }
__device__ __forceinline__ void ph_peer3(const Params& p, const float* x1, const bf16_t* h2, int bid, int nb) {
    const int tid = tid_(), wave = tid >> 6, lane = tid & 63;
    for (int t = bid * 8 + wave; t < NTOK; t += nb * 8) {
        const int b = t / SQ;
        float hv[32], y[32];
#pragma unroll
        for (int q = 0; q < 4; ++q) { const uint4 w = *(const uint4*)(h2 + (size_t)t * DM + lane * 32 + 8 * q); float* d = hv + 8 * q;
            d[0] = bflo(w.x); d[1] = bfhi(w.x); d[2] = bflo(w.y); d[3] = bfhi(w.y); d[4] = bflo(w.z); d[5] = bfhi(w.z); d[6] = bflo(w.w); d[7] = bfhi(w.w); }
#pragma unroll
        for (int i = 0; i < 32; ++i) y[i] = 0.f;
        const int e0 = p.eidx[(size_t)t * 128 + lane], e1 = p.eidx[(size_t)t * 128 + 64 + lane];
        const float g0 = p.gatev[(size_t)t * 128 + lane], g1 = p.gatev[(size_t)t * 128 + 64 + lane];
        const float su0 = p.su[e0], su1 = p.su[e1];
        const float gv0 = g0 * p.sv[e0], gv1 = g1 * p.sv[e1];
        uint2 Uc[4][3], Un[4][3], Vc[4][3];
        { int e[4];
#pragma unroll
          for (int i = 0; i < 4; ++i) e[i] = __builtin_amdgcn_readlane(e0, i);
          peer_load4(p.U8, e, lane, Uc); }
        for (int g = 0; g < 32; ++g) {
            const bool lo = g < 16; const int k0 = (4 * g) & 63;
            const int ee = lo ? e0 : e1; const float suu = lo ? su0 : su1, gvv = lo ? gv0 : gv1;
            int e[4]; float sa[4], gw[4];
#pragma unroll
            for (int i = 0; i < 4; ++i) { e[i] = __builtin_amdgcn_readlane(ee, k0 + i);
                sa[i] = __uint_as_float(__builtin_amdgcn_readlane(__float_as_uint(suu), k0 + i)); gw[i] = __uint_as_float(__builtin_amdgcn_readlane(__float_as_uint(gvv), k0 + i)); }
            peer_load4(p.V8, e, lane, Vc);
            {
                const int gn = (g < 31) ? g + 1 : g; const int en = (gn < 16) ? e0 : e1; const int kn = (4 * gn) & 63; int e2[4];
#pragma unroll
                for (int i = 0; i < 4; ++i) e2[i] = __builtin_amdgcn_readlane(en, kn + i);
                peer_load4(p.U8, e2, lane, Un);
            }
            float a[4];
#pragma unroll
            for (int i = 0; i < 4; ++i) {
                const f32x32_t d = dec6(Uc[i]);
                float acc0 = 0.f, acc1 = 0.f;
#pragma unroll
                for (int k = 0; k < 32; k += 2) { acc0 += d[k] * hv[k]; acc1 += d[k + 1] * hv[k + 1]; }
                a[i] = acc0 + acc1;
            }
#pragma unroll
            for (int o = 1; o < 64; o <<= 1) { a[0] += __shfl_xor(a[0], o); a[1] += __shfl_xor(a[1], o); a[2] += __shfl_xor(a[2], o); a[3] += __shfl_xor(a[3], o); }
#pragma unroll
            for (int i = 0; i < 4; ++i) {
                const float wgt = geluf_(a[i] * sa[i]) * gw[i];
                const f32x32_t d = dec6(Vc[i]);
#pragma unroll
                for (int k = 0; k < 32; ++k) y[k] += wgt * d[k];
            }
#pragma unroll
            for (int i = 0; i < 4; ++i) { Uc[i][0] = Un[i][0]; Uc[i][1] = Un[i][1]; Uc[i][2] = Un[i][2]; }
        }
        float ss = 0.f;
#pragma unroll
        for (int q = 0; q < 8; ++q) {
            const int c = lane * 32 + 4 * q;
            const float4 xv = *(const float4*)(x1 + (size_t)t * DM + c);
            const float4 ga = *(const float4*)(p.ada + b * NMOD + 5 * DM + c);
            float* yy = y + 4 * q;
            yy[0] = xv.x + ga.x * yy[0]; yy[1] = xv.y + ga.y * yy[1]; yy[2] = xv.z + ga.z * yy[2]; yy[3] = xv.w + ga.w * yy[3];
            ss += yy[0] * yy[0] + yy[1] * yy[1] + yy[2] * yy[2] + yy[3] * yy[3];
        }
        ss = wave_sum(ss);
        const float rs = 1.0f / sqrtf(ss * (1.0f / DM) + 1e-6f);
#pragma unroll
        for (int q = 0; q < 8; ++q) {
            const int c = lane * 32 + 4 * q;
            const float4 gf = *(const float4*)(p.norm_f_g + c);
            const float* yy = y + 4 * q;
            *(float4*)(p.out + (size_t)t * DM + c) = make_float4(yy[0] * rs * gf.x, yy[1] * rs * gf.y, yy[2] * rs * gf.z, yy[3] * rs * gf.w);
        }
    }
}

#define LAS __attribute__((address_space(3)))
#define XB_TMO      128
#define XB_XCNT(j)  (256  + 64 * (j))
#define XB_XSUB(j)  (1280 + 64 * (j))
#define XB_XGEN(j)  (2304 + 64 * (j))
#define XB_TOP      3328
#define XB_TOPGEN   3392
#define XCD_BAR_WORDS 3456
#define XB_SPIN_CAP (1u << 18)

__device__ __forceinline__ unsigned xb_ld(unsigned* p)              { return __hip_atomic_load(p, __ATOMIC_RELAXED, __HIP_MEMORY_SCOPE_AGENT); }
__device__ __forceinline__ unsigned xb_add(unsigned* p, unsigned v) { return __hip_atomic_fetch_add(p, v, __ATOMIC_RELAXED, __HIP_MEMORY_SCOPE_AGENT); }
__device__ __forceinline__ unsigned xb_xcc_id() { return (unsigned)__builtin_amdgcn_s_getreg((3 << 11) | 20) & 0xFu; }
#define XB_SPIN(cond, bar) do { unsigned _sp = 0; while (cond) { __builtin_amdgcn_s_sleep(1); \
    if ((++_sp & 255u) == 0u) { if (xb_ld(&(bar)[XB_TMO])) break; if (_sp > XB_SPIN_CAP) { atomicAdd(&(bar)[XB_TMO], 1u); break; } } } } while (0)

struct XcdBarrier {
    unsigned* bar; unsigned x;
    volatile LAS unsigned* st;
};

__device__ __forceinline__ XcdBarrier xcd_barrier_post(unsigned* bar, volatile LAS unsigned* st) {
    XcdBarrier b; b.bar = bar; b.x = xb_xcc_id(); b.st = st;
    if (threadIdx.x == 0) (void)xb_add(&bar[XB_XCNT(b.x)], 1u);
    return b;
}
__device__ __forceinline__ void xcd_barrier_complete(unsigned* bar, unsigned x, unsigned& nloc, unsigned& nx) {
    const unsigned G = gridDim.x * gridDim.y * gridDim.z;
    unsigned sum, cnt, mine, sp = 0u;
    for (;;) {
        sum = 0u; cnt = 0u; mine = 0u;
#pragma unroll
        for (unsigned j = 0; j < 16; ++j) { const unsigned c = xb_ld(&bar[XB_XCNT(j)]); sum += c; cnt += (c > 0u) ? 1u : 0u; mine = (j == x) ? c : mine; }
        if (sum == G) break;
        __builtin_amdgcn_s_sleep(1);
        if ((++sp & 255u) == 0u) { if (xb_ld(&bar[XB_TMO])) break; if (sp > XB_SPIN_CAP) { atomicAdd(&bar[XB_TMO], 1u); break; } }
    }
    nloc = mine > 0u ? mine : 1u; nx = cnt > 0u ? cnt : 1u;
}

__device__ __forceinline__ void xcd_barrier(const XcdBarrier& b) {
    asm volatile("s_waitcnt vmcnt(0)" ::: "memory");
    __syncthreads();
    if (threadIdx.x == 0) {
        unsigned* bar = b.bar;
        __builtin_amdgcn_s_waitcnt(0);
        unsigned nloc = b.st[0], nx = b.st[1];
        if (nloc == 0u) { xcd_barrier_complete(bar, b.x, nloc, nx); b.st[0] = nloc; b.st[1] = nx; }
        const unsigned old = xb_add(&bar[XB_XSUB(b.x)], 1u);
        const unsigned gen = old / nloc;
        if (old + 1u == (gen + 1u) * nloc) {
            __builtin_amdgcn_fence(__ATOMIC_RELEASE, "agent");
            asm volatile("s_waitcnt vmcnt(0)" ::: "memory");
            const unsigned og = xb_add(&bar[XB_TOP], 1u);
            const unsigned tg = og / nx;
            if (og + 1u == (tg + 1u) * nx) xb_add(&bar[XB_TOPGEN], 1u);
            else XB_SPIN(xb_ld(&bar[XB_TOPGEN]) == tg, bar);
            __builtin_amdgcn_fence(__ATOMIC_ACQUIRE, "agent");
            xb_add(&bar[XB_XGEN(b.x)], 1u);
            asm volatile("s_waitcnt vmcnt(0)" ::: "memory");
        } else {
            XB_SPIN(xb_ld(&bar[XB_XGEN(b.x)]) == gen, bar);
            __builtin_amdgcn_fence(__ATOMIC_ACQUIRE, "agent");
            asm volatile("s_waitcnt vmcnt(0)" ::: "memory");
        }
    }
    __syncthreads();
}

template <class Epi>
__device__ __forceinline__ void gemm_run(float* lds, const bf16_t* A, const bf16_t* Bt, int M, int N, int K, const Epi& E) {
    __syncthreads();
    pg8::Gemm g{A, Bt, M, N, K}; pg8::StaticOrder S; S.init(M, N, (int)gridDim.x, (int)blockIdx.x);
    pg8::gemm_phase<Epi, pg8::StaticOrder, true, true>((PG8_LAS unsigned char*)lds, g, S, E);
    __syncthreads();
}
constexpr int NPHASE = 11;
template <int PH>
__device__ __forceinline__ void run_phase(const Params& p, int bid, int nb, float* lds) {
    asm volatile("" : "+s"(bid));
    if constexpr (PH == 0) ph_prep(p, bid, nb, lds);
    if constexpr (PH == 1) ph_modnorm(p, p.x, p.norm1_g, 0 * DM, 1 * DM, p.hb, bid, nb, lds);
    if constexpr (PH == 2) gemm_run(lds, p.hb, p.Wt1, NTOK, ZW, DM, pg8::EpiZG{p.ZG, p.b_bg});
    if constexpr (PH == 3) { ph_retprep(p, bid, nb, lds); ph_gmlp2(p, bid, nb, lds); }
    if constexpr (PH == 11) ph_ret2(p, bid, nb, lds);
    if constexpr (PH == 4) ph_gn(p, bid, nb, lds);
    if constexpr (PH == 5) {
        gemm_run(lds, p.yain, p.Wta, NTOK, DM, 1024, pg8::EpiMixB<0>{p.hb, p.ZG, 0});
        gemm_run(lds, p.ybin, p.Wtb, NTOK, DM, DM, pg8::EpiMixB<1>{p.hb, p.ZG, 2048});
    }
    if constexpr (PH == 6) gemm_run(lds, p.hb, p.Wto, NTOK, DM, DM, pg8::EpiResF{p.obuf, p.x, p.ada + 2 * DM});
    if constexpr (PH == 7) { ph_modnorm(p, p.obuf, p.norm2_g, 3 * DM, 4 * DM, p.hb, bid, nb, lds); if (nb != 256) ph_tabconv(p, bid, nb); }
    if constexpr (PH == 8) gemm_run(lds, p.hb, p.Wtq, NTOK, DM, DM, pg8::EpiF32{p.qbuf, DM});
    if constexpr (PH == 9) ph_topk2(p, p.qbuf, bid, nb, lds);
    if constexpr (PH == 10) ph_peer3(p, p.obuf, p.hb, bid, nb);
}

constexpr int MISC_OFF = 132 * 1024;
__global__ void __launch_bounds__(NTH) k_mega(Params p) {
    extern __shared__ __attribute__((aligned(16))) float lds[];
    const int bid = blockIdx.x, nb = gridDim.x;
    volatile LAS unsigned* misc = (volatile LAS unsigned*)((LAS unsigned char*)lds + MISC_OFF);
    if (threadIdx.x < 4) misc[threadIdx.x] = 0u;
    __syncthreads();
    XcdBarrier bar = xcd_barrier_post(p.bar, misc);
    run_phase<0>(p, bid, nb, lds); xcd_barrier(bar);
    run_phase<1>(p, bid, nb, lds); xcd_barrier(bar);
    run_phase<2>(p, bid, nb, lds); xcd_barrier(bar);
    run_phase<3>(p, bid, nb, lds); xcd_barrier(bar);
    run_phase<11>(p, bid, nb, lds); xcd_barrier(bar);
    run_phase<4>(p, bid, nb, lds); xcd_barrier(bar);
    run_phase<5>(p, bid, nb, lds); xcd_barrier(bar);
    run_phase<6>(p, bid, nb, lds); xcd_barrier(bar);
    run_phase<7>(p, bid, nb, lds); xcd_barrier(bar);
    run_phase<8>(p, bid, nb, lds); xcd_barrier(bar);
    run_phase<9>(p, bid, nb, lds); xcd_barrier(bar);
    run_phase<10>(p, bid, nb, lds);
}

extern "C" void kernel_launch(void* const* d_in, const int* in_sizes, int n_in, void* d_out, int out_size, void* d_ws, size_t ws_size, hipStream_t stream) {
    Params p{};
    p.x = (const float*)d_in[0]; p.c = (const float*)d_in[1]; p.pos = (const int*)d_in[2];
    p.w_ada = (const float*)d_in[3]; p.b_ada = (const float*)d_in[4]; p.norm1_g = (const float*)d_in[5]; p.w_in = (const float*)d_in[6];
    p.w_bg = (const float*)d_in[7]; p.b_bg = (const float*)d_in[8]; p.gm_v_g = (const float*)d_in[9]; p.gm_ws = (const float*)d_in[10];
    p.gm_b = (const float*)d_in[11]; p.ret_gn_g = (const float*)d_in[12]; p.w_a_out = (const float*)d_in[13]; p.w_b_out = (const float*)d_in[14];
    p.w_o = (const float*)d_in[15]; p.norm2_g = (const float*)d_in[16]; p.peer_wq = (const float*)d_in[17]; p.peer_sk = (const float*)d_in[18];
    p.peer_u = (const float*)d_in[19]; p.peer_v = (const float*)d_in[20]; p.norm_f_g = (const float*)d_in[21];
    p.out = (float*)d_out;
    char* w = (char*)d_ws; size_t off = 0;
    auto take = [&](size_t bytes) { char* r = w + off; off += (bytes + 255) & ~(size_t)255; return r; };
    p.bar = (unsigned*)take(XCD_BAR_WORDS * 4);
    p.ada = (float*)take(2 * NMOD * 4);
    p.rope = (float*)take((size_t)NTOK * 128 * 4);
    p.eidx = (int*)take((size_t)NTOK * 128 * 4);
    p.gatev = (float*)take((size_t)NTOK * 128 * 4);
    p.Wt1 = (bf16_t*)take((size_t)ZW * DM * 2);
    p.Wta = (bf16_t*)take((size_t)DM * 1024 * 2);
    p.Wtb = (bf16_t*)take((size_t)DM * DM * 2);
    p.Wto = (bf16_t*)take((size_t)DM * DM * 2);
    p.Wtq = (bf16_t*)take((size_t)DM * DM * 2);
    p.hb = (bf16_t*)take((size_t)NTOK * DM * 2);
    p.ZG = (bf16_t*)take((size_t)NTOK * ZW * 2);
    p.qbuf = (float*)p.ZG;
    p.obuf = (float*)take((size_t)NTOK * DM * 4);
    p.ybin = (bf16_t*)take((size_t)NTOK * DM * 2);
    p.yain = (bf16_t*)take((size_t)NTOK * 1024 * 2);
    p.U8 = (unsigned char*)p.ZG + (size_t)NTOK * DM * 4;
    p.V8 = p.U8 + (size_t)16384 * ROW6;
    p.su = (float*)take(16384 * 4); p.sv = (float*)take(16384 * 4);
    p.Qr = (bf16_t*)take((size_t)NTOK * 1024 * 2);
    p.Pm = (bf16_t*)take((size_t)16 * 64 * 4096 * 2);
    p.KTd = (bf16_t*)take((size_t)NTOK * 1024 * 2);
    p.Vt = (bf16_t*)take((size_t)NTOK * 2048 * 2);
    p.ob16 = (bf16_t*)take((size_t)NTOK * DM * 2);
    if (off > ws_size) { fprintf(stderr, "kernel_launch: workspace too small: need %zu have %zu\n", off, ws_size); return; }
    static int grid = 0;
    if (!grid) {
        int dev = 0, cus = 0, per_cu = 0;
        (void)hipGetDevice(&dev); (void)hipDeviceGetAttribute(&cus, hipDeviceAttributeMultiprocessorCount, dev);
        (void)hipFuncSetAttribute((const void*)k_mega, hipFuncAttributeMaxDynamicSharedMemorySize, LDS_BYTES);
        (void)hipOccupancyMaxActiveBlocksPerMultiprocessor(&per_cu, k_mega, NTH, LDS_BYTES);
        (void)per_cu;
        grid = cus;
    }
    (void)hipMemsetAsync(p.bar, 0, XCD_BAR_WORDS * 4, stream);
    hipLaunchKernelGGL(k_mega, dim3(grid), dim3(NTH), LDS_BYTES, stream, p);
    hipError_t e = hipPeekAtLastError();
    if (e != hipSuccess) fprintf(stderr, "launch failed: %s (grid %d)\n", hipGetErrorString(e), grid);
}
```

```cpp
#include <hip/hip_runtime.h>
#include <hip/hip_cooperative_groups.h>
#include <stdint.h>
#include <math.h>
#include <cstdio>

namespace cg = cooperative_groups;

constexpr int DM = 2048;
constexpr int SQ = 4096;
constexpr int NTOK = 8192;
constexpr int NTH = 512;
constexpr int ZW = 12288;
constexpr int NMOD = 12288;
constexpr int LDS_BYTES = 136 * 1024;

typedef unsigned short bf16_t;

struct Params {
    const float *x, *c; const int* pos;
    const float *w_ada, *b_ada, *norm1_g, *w_in, *w_bg, *b_bg, *gm_v_g, *gm_ws, *gm_b, *ret_gn_g, *w_a_out, *w_b_out, *w_o, *norm2_g,
                *peer_wq, *peer_sk, *peer_u, *peer_v, *norm_f_g;
    float* out;
    float *ada, *rope, *gatev; int* eidx;
    bf16_t *Wt1, *Wta, *Wtb, *Wto, *Wtq;
    bf16_t *hb;
    bf16_t *ZG;
    float *obuf;
    bf16_t *ybin, *yain;
    float *qbuf;
    unsigned char *U8, *V8;
    float *su, *sv;
    bf16_t *Qr, *Pm, *KTd, *Vt;
    bf16_t *ob16;
    unsigned *bar;
};

__constant__ float c_freq[64] = {
1.000000000e+00f, 8.659643531e-01f, 7.498942018e-01f, 6.493816376e-01f, 5.623413324e-01f, 4.869675338e-01f, 4.216965139e-01f, 3.651741147e-01f, 3.162277639e-01f, 2.738419771e-01f, 2.371373773e-01f, 2.053525001e-01f, 1.778279394e-01f, 1.539926529e-01f, 1.333521456e-01f, 1.154781953e-01f, 1.000000015e-01f, 8.659642935e-02f, 7.498942316e-02f, 6.493816525e-02f, 5.623413250e-02f, 4.869675264e-02f, 4.216964915e-02f, 3.651741147e-02f, 3.162277490e-02f, 2.738419548e-02f, 2.371373773e-02f, 2.053525113e-02f, 1.778279431e-02f, 1.539926510e-02f, 1.333521400e-02f, 1.154781971e-02f, 9.999999776e-03f, 8.659643121e-03f, 7.498942316e-03f, 6.493816152e-03f, 5.623413250e-03f, 4.869675264e-03f, 4.216964822e-03f, 3.651741194e-03f, 3.162277630e-03f, 2.738419687e-03f, 2.371373819e-03f, 2.053525066e-03f, 1.778279431e-03f, 1.539926510e-03f, 1.333521446e-03f, 1.154782018e-03f, 1.000000047e-03f, 8.659643354e-04f, 7.498941850e-04f, 6.493816036e-04f, 5.623413017e-04f, 4.869675322e-04f, 4.216965172e-04f, 3.651741135e-04f, 3.162277571e-04f, 2.738419571e-04f, 2.371373703e-04f, 2.053525095e-04f, 1.778279402e-04f, 1.539926598e-04f, 1.333521504e-04f, 1.154782003e-04f };

__device__ __forceinline__ int tid_() { int t = threadIdx.x; asm volatile("" : "+v"(t)); return t; }
__device__ __forceinline__ float wave_sum(float v) {
#pragma unroll
    for (int o = 1; o < 64; o <<= 1) v += __shfl_xor(v, o);
    return v;
}
__device__ __forceinline__ float wave_max(float v) {
#pragma unroll
    for (int o = 1; o < 64; o <<= 1) v = fmaxf(v, __shfl_xor(v, o));
    return v;
}
__device__ __forceinline__ float sigmoidf_(float x) { return 1.0f / (1.0f + expf(-x)); }
__device__ __forceinline__ float siluf_(float x) { return x * sigmoidf_(x); }
__device__ __forceinline__ float geluf_(float x) { return 0.5f * x * (1.0f + erff(x * 0.70710678118654752f)); }
__device__ __forceinline__ float dot4(float4 a, float4 b) { return a.x * b.x + a.y * b.y + a.z * b.z + a.w * b.w; }
__device__ __forceinline__ float bf2f(bf16_t v) { return __uint_as_float((unsigned)v << 16); }
__device__ __forceinline__ float bflo(unsigned w) { return __uint_as_float(w << 16); }
__device__ __forceinline__ float bfhi(unsigned w) { return __uint_as_float(w & 0xffff0000u); }
__device__ __forceinline__ unsigned f2bf(float f) { unsigned u = __float_as_uint(f); return (u + 0x7fffu + ((u >> 16) & 1u)) >> 16; }
__device__ __forceinline__ unsigned pk2(float lo, float hi) { return f2bf(lo) | (f2bf(hi) << 16); }

__device__ __forceinline__ void sincos_acc(float ang, float& s, float& c) {
    const double x = (double)ang;
    const double k = rint(x * 0.63661977236758134308);
    double r = fma(-k, 1.57079632679489655800, x); r = fma(-k, 6.12323399573676603587e-17, r);
    const double r2 = r * r;
    const double sp = r * (1.0 + r2 * (-1.0 / 6.0 + r2 * (1.0 / 120.0 + r2 * (-1.0 / 5040.0 + r2 * (1.0 / 362880.0 + r2 * (-1.0 / 39916800.0 + r2 * (1.0 / 6227020800.0)))))));
    const double cp = 1.0 + r2 * (-0.5 + r2 * (1.0 / 24.0 + r2 * (-1.0 / 720.0 + r2 * (1.0 / 40320.0 + r2 * (-1.0 / 3628800.0 + r2 * (1.0 / 479001600.0 + r2 * (-1.0 / 87178291200.0)))))));
    const int q = ((int)k) & 3;
    const float fs = (float)sp, fc = (float)cp;
    s = (q == 0) ? fs : (q == 1) ? fc : (q == 2) ? -fs : -fc;
    c = (q == 0) ? fc : (q == 1) ? -fs : (q == 2) ? -fc : fs;
}

namespace pg8 {
#define PG8_LAS __attribute__((address_space(3)))
typedef unsigned short bf16_t;
typedef short bf16x8 __attribute__((ext_vector_type(8)));
typedef float f32x4 __attribute__((ext_vector_type(4)));
typedef unsigned u32x4 __attribute__((ext_vector_type(4)));
constexpr int BM = 256, BK = 64, HALF = 128, HTB = HALF * BK * 2  , STAGE_BYTES = 8 * HTB, NXCD = 8, WGM = 8;

__host__ __device__ __forceinline__ int lds_byte(int r, int c) { const int st = (r >> 4) * 2 + (c >> 5), rr = r & 15, cc = c & 31, ob = rr * 64 + cc * 2; return st * 1024 + (ob ^ (((ob >> 9) & 1) << 5)); }
__host__ __device__ __forceinline__ void stage_rc(int b, int& R, int& C) { const int st = b / 1024, sb = b % 1024, swz = sb ^ (((sb >> 9) & 1) << 5); R = (st >> 1) * 16 + swz / 64; C = (st & 1) * 32 + (swz % 64) / 2; }
__host__ __device__ __forceinline__ int perm32(int rho) { const int n = rho >> 4, i = rho & 15; return 8 * (i >> 2) + 4 * n + (i & 3); }

struct Unit { int pm, pn; };
struct Gemm { const bf16_t* A; const bf16_t* Bt; int M, N, K; };

struct StaticOrder {
    int nM, nN, nwg, G, c;
    __host__ __device__ void init(int M, int N, int G_, int c_) { nM = M / BM; nN = N / BM; nwg = nM * nN; G = G_; c = c_; }
    __host__ __device__ bool next(int i, Unit& u) const {
        const long L = (long)i * G + c; if (L >= nwg) return false;
        int wgid = (int)L; { const int q = nwg / NXCD, r = nwg % NXCD, xcd = wgid % NXCD, off = wgid / NXCD; wgid = (xcd < r ? xcd * (q + 1) : r * (q + 1) + (xcd - r) * q) + off; }
        const int nig = WGM * nN, gid = wgid / nig, fm = gid * WGM, gsz = (nM - fm) < WGM ? (nM - fm) : WGM;
        u.pm = fm + ((wgid % nig) % gsz); u.pn = (wgid % nig) / gsz; return true;
    }
    __device__ __forceinline__ void a_ready(const Unit&) const {}
    __device__ __forceinline__ void done(const Unit&) const {}
};

__device__ __forceinline__ unsigned cvt_pk_bf16(float lo, float hi) { unsigned r; asm volatile("v_cvt_pk_bf16_f32 %0, %1, %2" : "=v"(r) : "v"(lo), "v"(hi)); return r; }
typedef float f32x2 __attribute__((ext_vector_type(2)));
__device__ __forceinline__ f32x2 gelu_pk(f32x2 v) {
    const f32x2 av = __builtin_elementwise_abs(v), d = av * 0.2316418882f + 1.0f;
    f32x2 t; t.x = __builtin_amdgcn_rcpf(d.x); t.y = __builtin_amdgcn_rcpf(d.y);
    f32x2 q = t * 0.5307027145f + (-0.7265760135f); q = q * t + 0.7107068705f; q = q * t + (-0.142248368f); q = q * t + 0.127414796f; q = q * t;
    const f32x2 s = (v * v) * (-0.72134752044f);
    f32x2 e; e.x = __builtin_amdgcn_exp2f(s.x); e.y = __builtin_amdgcn_exp2f(s.y);
    const f32x2 m = v * (q * e), r = v - m;
    f32x2 o; o.x = v.x < 0.f ? m.x : r.x; o.y = v.y < 0.f ? m.y : r.y; return o;
}

typedef unsigned u32x2v __attribute__((ext_vector_type(2)));
struct EpiZG {
    static constexpr bool PERM = true, AFTER_DRAIN = false;
    bf16_t* O; const float* bias;
    __device__ __forceinline__ void operator()(const f32x4 (&acc)[2][2][4][2], const Unit& u, int wr, int wc, int fr, int fq) const {
        const int row0 = u.pm * BM + wr * 64 + fr, col0 = u.pn * BM + wc * 32 + 8 * fq;
        const int mode = u.pn < 8 ? 1 : (u.pn < 32 ? 0 : 2);
        f32x4 bv[2][2];
#pragma unroll
        for (int bj = 0; bj < 2; ++bj)
#pragma unroll
            for (int n = 0; n < 2; ++n) bv[bj][n] = (mode == 2) ? *(const f32x4*)(bias + (col0 - 8192) + bj * HALF + 4 * n) : (f32x4){0.f, 0.f, 0.f, 0.f};
#pragma unroll
        for (int ai = 0; ai < 2; ++ai)
#pragma unroll
            for (int m = 0; m < 4; ++m) { bf16_t* rowp = O + (size_t)(row0 + ai * HALF + m * 16) * ZW + col0;
#pragma unroll
                for (int bj = 0; bj < 2; ++bj) { f32x4 v0 = acc[ai][bj][m][0], v1 = acc[ai][bj][m][1];
                    if (mode == 1) { f32x2 a = gelu_pk((f32x2){v0[0], v0[1]}), b = gelu_pk((f32x2){v0[2], v0[3]}), c = gelu_pk((f32x2){v1[0], v1[1]}), d = gelu_pk((f32x2){v1[2], v1[3]});
                        v0 = (f32x4){a.x, a.y, b.x, b.y}; v1 = (f32x4){c.x, c.y, d.x, d.y}; }
                    if (mode == 2) { v0 = v0 + bv[bj][0]; v1 = v1 + bv[bj][1];
#pragma unroll
                        for (int e = 0; e < 4; ++e) { v0[e] = __builtin_amdgcn_rcpf(1.0f + __expf(-v0[e])); v1[e] = __builtin_amdgcn_rcpf(1.0f + __expf(-v1[e])); } }
                    u32x4 w; w.x = cvt_pk_bf16(v0[0], v0[1]); w.y = cvt_pk_bf16(v0[2], v0[3]); w.z = cvt_pk_bf16(v1[0], v1[1]); w.w = cvt_pk_bf16(v1[2], v1[3]);
                    *(u32x4*)(rowp + bj * HALF) = w; } }
    }
};
template <int ACCUM> struct EpiMixB {
    static constexpr bool PERM = true, AFTER_DRAIN = false;
    bf16_t* Mo; const bf16_t* ZGp; int goff;
    __device__ __forceinline__ void operator()(const f32x4 (&acc)[2][2][4][2], const Unit& u, int wr, int wc, int fr, int fq) const {
        const int row0 = u.pm * BM + wr * 64 + fr, col0 = u.pn * BM + wc * 32 + 8 * fq;
#pragma unroll
        for (int ai = 0; ai < 2; ++ai)
#pragma unroll
            for (int m = 0; m < 4; ++m) { const size_t row = (size_t)(row0 + ai * HALF + m * 16);
#pragma unroll
                for (int bj = 0; bj < 2; ++bj) { const f32x4 v0 = acc[ai][bj][m][0], v1 = acc[ai][bj][m][1];
                    const u32x4 g = *(const u32x4*)(ZGp + row * ZW + 8192 + goff + col0 + bj * HALF);
                    float o[8];
                    o[0] = bflo(g.x) * v0[0]; o[1] = bfhi(g.x) * v0[1]; o[2] = bflo(g.y) * v0[2]; o[3] = bfhi(g.y) * v0[3];
                    o[4] = bflo(g.z) * v1[0]; o[5] = bfhi(g.z) * v1[1]; o[6] = bflo(g.w) * v1[2]; o[7] = bfhi(g.w) * v1[3];
                    bf16_t* mp = Mo + row * DM + col0 + bj * HALF;
                    if (ACCUM) { const u32x4 old = *(const u32x4*)mp;
                        o[0] += bflo(old.x); o[1] += bfhi(old.x); o[2] += bflo(old.y); o[3] += bfhi(old.y); o[4] += bflo(old.z); o[5] += bfhi(old.z); o[6] += bflo(old.w); o[7] += bfhi(old.w); }
                    u32x4 w; w.x = cvt_pk_bf16(o[0], o[1]); w.y = cvt_pk_bf16(o[2], o[3]); w.z = cvt_pk_bf16(o[4], o[5]); w.w = cvt_pk_bf16(o[6], o[7]);
                    *(u32x4*)mp = w; } }
    }
};
struct EpiResF {
    static constexpr bool PERM = false, AFTER_DRAIN = false;
    float* x1; const float* x; const float* ga;
    __device__ __forceinline__ void operator()(const f32x4 (&acc)[2][2][4][2], const Unit& u, int wr, int wc, int fr, int fq) const {
        const int row0 = u.pm * BM + wr * 64 + fr, col0 = u.pn * BM + wc * 32 + 4 * fq;
        const int b = (u.pm * BM) / SQ;
        f32x4 gv[2][2];
#pragma unroll
        for (int bj = 0; bj < 2; ++bj)
#pragma unroll
            for (int n = 0; n < 2; ++n) gv[bj][n] = *(const f32x4*)(ga + b * NMOD + col0 + bj * HALF + n * 16);
#pragma unroll
        for (int ai = 0; ai < 2; ++ai)
#pragma unroll
            for (int m = 0; m < 4; ++m) { const size_t off = (size_t)(row0 + ai * HALF + m * 16) * DM + col0;
#pragma unroll
                for (int bj = 0; bj < 2; ++bj)
#pragma unroll
                    for (int n = 0; n < 2; ++n) { const f32x4 xv = *(const f32x4*)(x + off + bj * HALF + n * 16);
                        *(f32x4*)(x1 + off + bj * HALF + n * 16) = xv + gv[bj][n] * acc[ai][bj][m][n]; } }
    }
};
struct EpiF32 {
    static constexpr bool PERM = false, AFTER_DRAIN = false;
    float* O; int ldc;
    __device__ __forceinline__ void operator()(const f32x4 (&acc)[2][2][4][2], const Unit& u, int wr, int wc, int fr, int fq) const {
        const int row0 = u.pm * BM + wr * 64 + fr, col0 = u.pn * BM + wc * 32 + 4 * fq;
#pragma unroll
        for (int ai = 0; ai < 2; ++ai)
#pragma unroll
            for (int m = 0; m < 4; ++m) { const size_t off = (size_t)(row0 + ai * HALF + m * 16) * ldc + col0;
#pragma unroll
                for (int bj = 0; bj < 2; ++bj)
#pragma unroll
                    for (int n = 0; n < 2; ++n) *(f32x4*)(O + off + bj * HALF + n * 16) = acc[ai][bj][m][n]; }
    }
};

template <class Epi, class Sched, bool ALIGN_EPI = false, bool SP2 = false>
__device__ __forceinline__ void gemm_phase(PG8_LAS unsigned char* lds, const Gemm g, const Sched& S, const Epi& E) {
    const int tid = threadIdx.x, wid = __builtin_amdgcn_readfirstlane(tid >> 6), lane = tid & 63, wr = wid >> 2, wc = wid & 3, fr = lane & 15, fq = lane >> 4;
    const int K = g.K, nt = K / BK;
    unsigned voffA[2], voffB[2];
#pragma unroll
    for (int i = 0; i < 2; ++i) { int R, C; stage_rc(tid * 16 + i * 8192, R, C); const int Rb = Epi::PERM ? ((R & ~31) + perm32(R & 31)) : R;
        voffA[i] = (unsigned)(R * K + C) * 2u; voffB[i] = (unsigned)(Rb * K + C) * 2u; }
    const size_t kstep = (size_t)(BK * 2);
    const size_t hstep = (size_t)HALF * K * 2;
    const size_t tstep = 2 * hstep;
    const unsigned ldsw = (unsigned)wid * 1024u;
    const int aoff = lds_byte(wr * 64 + fr, fq * 8), boff = lds_byte(wc * 32 + fr, fq * 8);
#define PG8_SA(b, h) (((b) * 2 + (h)) * HTB)
#define PG8_SB(b, h) ((4 + (b) * 2 + (h)) * HTB)
#define PG8_STAGE(bufoff, gbase, voff) do { _Pragma("unroll") for (int _i = 0; _i < 2; ++_i) \
        __builtin_amdgcn_global_load_lds((const unsigned*)((const char*)(gbase) + (voff)[_i]), (PG8_LAS unsigned*)(lds + (bufoff) + ldsw + _i * 8192), 16, 0, 0); } while (0)
#define PG8_LDA(dst, b, h) do { _Pragma("unroll") for (int m = 0; m < 4; ++m) _Pragma("unroll") for (int k = 0; k < 2; ++k) dst[m][k] = *(const PG8_LAS bf16x8*)(lds + PG8_SA(b, h) + aoff + m * 2048 + k * 1024); } while (0)
#define PG8_LDB(dst, b, h) do { _Pragma("unroll") for (int n = 0; n < 2; ++n) _Pragma("unroll") for (int k = 0; k < 2; ++k) dst[n][k] = *(const PG8_LAS bf16x8*)(lds + PG8_SB(b, h) + boff + n * 2048 + k * 1024); } while (0)
#define PG8_MMA(ai, bj, At, Bt) do { __builtin_amdgcn_s_setprio(1); _Pragma("unroll") for (int m = 0; m < 4; ++m) _Pragma("unroll") for (int n = 0; n < 2; ++n) _Pragma("unroll") for (int k = 0; k < 2; ++k) \
        acc[ai][bj][m][n] = __builtin_amdgcn_mfma_f32_16x16x32_bf16(Bt[n][k], At[m][k], acc[ai][bj][m][n], 0, 0, 0); __builtin_amdgcn_s_setprio(0); } while (0)
#define PG8_WAIT_V(n) asm volatile("s_waitcnt vmcnt(" #n ")" ::: "memory")
#define PG8_WAIT_L(n) asm volatile("s_waitcnt lgkmcnt(" #n ")" ::: "memory")
#define PG8_BAR __builtin_amdgcn_s_barrier()
#define PG8_SCHED __builtin_amdgcn_sched_barrier(0)
    Unit cur, nxt; int ui = 0;
    if (!S.next(0, cur)) return;
    f32x4 acc[2][2][4][2];
#pragma unroll
    for (int a = 0; a < 2; ++a)
#pragma unroll
        for (int b = 0; b < 2; ++b)
#pragma unroll
            for (int m = 0; m < 4; ++m)
#pragma unroll
                for (int n = 0; n < 2; ++n) acc[a][b][m][n] = (f32x4){0.f, 0.f, 0.f, 0.f};
    bf16x8 At[4][2], B0[2][2], B1[2][2];
    const char* cA = (const char*)g.A + (size_t)cur.pm * tstep; const char* cB = (const char*)g.Bt + (size_t)cur.pn * tstep;
    S.a_ready(cur);
    if constexpr (SP2) {
        PG8_STAGE(PG8_SB(0, 0), cB, voffB); PG8_STAGE(PG8_SB(0, 1), cB + hstep, voffB); PG8_STAGE(PG8_SA(0, 0), cA, voffA); PG8_STAGE(PG8_SA(0, 1), cA + hstep, voffA);
        if (wr == 1) PG8_BAR;
        PG8_WAIT_V(2); PG8_BAR;
        PG8_STAGE(PG8_SB(1, 0), cB + kstep, voffB); PG8_STAGE(PG8_SA(1, 0), cA + kstep, voffA); PG8_STAGE(PG8_SB(1, 1), cB + hstep + kstep, voffB);
        PG8_WAIT_V(6); PG8_BAR;
    } else {
        PG8_STAGE(PG8_SB(0, 0), cB, voffB); PG8_STAGE(PG8_SA(0, 0), cA, voffA); PG8_STAGE(PG8_SB(0, 1), cB + hstep, voffB); PG8_STAGE(PG8_SA(0, 1), cA + hstep, voffA);
        if (wr == 1) PG8_BAR;
        PG8_WAIT_V(4); PG8_BAR;
        PG8_STAGE(PG8_SB(1, 0), cB + kstep, voffB); PG8_STAGE(PG8_SA(1, 0), cA + kstep, voffA); PG8_STAGE(PG8_SB(1, 1), cB + hstep + kstep, voffB);
        PG8_WAIT_V(6); PG8_BAR;
    }
    for (;;) {
        const bool has_next = S.next(ui + 1, nxt);
        const char* nA = has_next ? (const char*)g.A + (size_t)nxt.pm * tstep : cA; const char* nB = has_next ? (const char*)g.Bt + (size_t)nxt.pn * tstep : cB;
        for (int t = 0; t < nt; t += 2) {
            const bool last = (t == nt - 2);
            const char* a1 = cA + (size_t)(t + 1) * kstep;
            const char* a2 = last ? nA : cA + (size_t)(t + 2) * kstep; const char* b2 = last ? nB : cB + (size_t)(t + 2) * kstep;
            const char* a3 = a2 + kstep; const char* b3 = b2 + kstep;
            if (last && has_next) S.a_ready(nxt);
            if constexpr (SP2) {
            PG8_LDB(B0, 0, 0); PG8_LDB(B1, 0, 1); PG8_SCHED; PG8_LDA(At, 0, 0); PG8_STAGE(PG8_SA(1, 1), a1 + hstep, voffA);
            PG8_WAIT_V(8); PG8_WAIT_L(0); PG8_BAR; PG8_MMA(0, 0, At, B0); PG8_MMA(0, 1, At, B1); PG8_BAR; PG8_SCHED;
            PG8_LDA(At, 0, 1); PG8_STAGE(PG8_SB(0, 0), b2, voffB); PG8_STAGE(PG8_SB(0, 1), b2 + hstep, voffB); PG8_STAGE(PG8_SA(0, 0), a2, voffA);
            PG8_WAIT_V(8); PG8_WAIT_L(0); PG8_BAR; PG8_MMA(1, 0, At, B0); PG8_MMA(1, 1, At, B1); PG8_BAR; PG8_SCHED;
            PG8_LDB(B0, 1, 0); PG8_LDB(B1, 1, 1); PG8_SCHED; PG8_LDA(At, 1, 0); PG8_STAGE(PG8_SA(0, 1), a2 + hstep, voffA);
            PG8_WAIT_V(8); PG8_WAIT_L(0); PG8_BAR; PG8_MMA(0, 0, At, B0); PG8_MMA(0, 1, At, B1); PG8_BAR; PG8_SCHED;
            PG8_LDA(At, 1, 1); PG8_STAGE(PG8_SB(1, 0), b3, voffB); PG8_STAGE(PG8_SB(1, 1), b3 + hstep, voffB); PG8_STAGE(PG8_SA(1, 0), a3, voffA);
            PG8_WAIT_V(8); PG8_WAIT_L(0); PG8_BAR; PG8_MMA(1, 0, At, B0); PG8_MMA(1, 1, At, B1); PG8_BAR; PG8_SCHED;
            } else {
            PG8_LDB(B0, 0, 0); PG8_SCHED; PG8_LDA(At, 0, 0); PG8_STAGE(PG8_SA(1, 1), a1 + hstep, voffA);
            PG8_WAIT_L(8); PG8_BAR; PG8_WAIT_L(0); PG8_MMA(0, 0, At, B0); PG8_BAR; PG8_SCHED;
            PG8_LDB(B1, 0, 1); PG8_STAGE(PG8_SB(0, 0), b2, voffB);
            PG8_BAR; PG8_WAIT_L(0); PG8_MMA(0, 1, At, B1); PG8_BAR;
            PG8_LDA(At, 0, 1); PG8_STAGE(PG8_SA(0, 0), a2, voffA);
            PG8_BAR; PG8_WAIT_L(0); PG8_MMA(1, 0, At, B0); PG8_BAR; PG8_SCHED;
            PG8_STAGE(PG8_SB(0, 1), b2 + hstep, voffB);
            PG8_WAIT_V(6); PG8_BAR; PG8_MMA(1, 1, At, B1); PG8_BAR;
            PG8_LDB(B0, 1, 0); PG8_SCHED; PG8_LDA(At, 1, 0); PG8_STAGE(PG8_SA(0, 1), a2 + hstep, voffA);
            PG8_WAIT_L(8); PG8_BAR; PG8_WAIT_L(0); PG8_MMA(0, 0, At, B0); PG8_BAR; PG8_SCHED;
            PG8_LDB(B1, 1, 1); PG8_STAGE(PG8_SB(1, 0), b3, voffB);
            PG8_BAR; PG8_WAIT_L(0); PG8_MMA(0, 1, At, B1); PG8_BAR;
            PG8_LDA(At, 1, 1); PG8_STAGE(PG8_SA(1, 0), a3, voffA);
            PG8_BAR; PG8_WAIT_L(0); PG8_MMA(1, 0, At, B0); PG8_BAR; PG8_SCHED;
            PG8_STAGE(PG8_SB(1, 1), b3 + hstep, voffB);
            PG8_WAIT_V(6); PG8_BAR; PG8_MMA(1, 1, At, B1); PG8_BAR;
            }
        }
        if constexpr (ALIGN_EPI) { if (wr == 0) PG8_BAR; }
        if constexpr (!Epi::AFTER_DRAIN) { E(acc, cur, wr, wc, fr, fq); S.done(cur); }
        if (!has_next) break;
#pragma unroll
        for (int a = 0; a < 2; ++a)
#pragma unroll
            for (int b = 0; b < 2; ++b)
#pragma unroll
                for (int m = 0; m < 4; ++m)
#pragma unroll
                    for (int n = 0; n < 2; ++n) acc[a][b][m][n] = (f32x4){0.f, 0.f, 0.f, 0.f};
        cur = nxt; cA = nA; cB = nB; ++ui;
        if constexpr (ALIGN_EPI) { if (wr == 1) PG8_BAR; }
    }
    PG8_WAIT_V(0);
    if constexpr (!ALIGN_EPI) { if (wr == 0) PG8_BAR; }
    PG8_BAR;
    if constexpr (Epi::AFTER_DRAIN) { E.fused(acc, cur, wr, wc, fr, fq, lds, wid, lane); S.done(cur); }
#undef PG8_SA
#undef PG8_SB
#undef PG8_STAGE
#undef PG8_LDA
#undef PG8_LDB
#undef PG8_MMA
#undef PG8_WAIT_V
#undef PG8_WAIT_L
#undef PG8_BAR
#undef PG8_SCHED
}
}
using pg8::f32x4; using pg8::u32x4;

__device__ __forceinline__ void transpose_item(const float* W, int K, int N, bf16_t* WT, int row_off, float* scr, int item, int lane) {
    const int nblk = N / 32, kb = item / nblk, nbk = item % nblk, k0 = 64 * kb, n0 = 32 * nbk;
#pragma unroll 8
    for (int i = 0; i < 32; ++i) { const int kk = 2 * i + (lane >> 5); scr[kk * 33 + (lane & 31)] = W[(size_t)(k0 + kk) * N + n0 + (lane & 31)]; }
    asm volatile("s_waitcnt lgkmcnt(0)" ::: "memory");
    const int c = lane & 7;
#pragma unroll
    for (int j = 0; j < 4; ++j) { const int n = (lane >> 3) + 8 * j; const float* s = scr + (8 * c) * 33 + n;
        uint4 o; o.x = pk2(s[0 * 33], s[1 * 33]); o.y = pk2(s[2 * 33], s[3 * 33]); o.z = pk2(s[4 * 33], s[5 * 33]); o.w = pk2(s[6 * 33], s[7 * 33]);
        *(uint4*)(WT + (size_t)(row_off + n0 + n) * K + k0 + 8 * c) = o; }
    asm volatile("s_waitcnt lgkmcnt(0)" ::: "memory");
}
__device__ __forceinline__ void ph_prep(const Params& p, int bid, int nb, float* lds) {
    const int tid = tid_(), wave = tid >> 6, lane = tid & 63;
    {
        float* sl = lds;
        float* red = lds + 4096;
        for (int i = tid; i < 4096; i += NTH) sl[i] = siluf_(p.c[i]);
        __syncthreads();
        for (int it = bid; it < 192; it += nb) {
            const int c4 = tid & 15, kg = tid >> 4;
            const float* wp = p.w_ada + (size_t)kg * NMOD + it * 64 + c4 * 4;
            float a0[4] = {0.f, 0.f, 0.f, 0.f}, a1[4] = {0.f, 0.f, 0.f, 0.f};
#pragma unroll 8
            for (int i = 0; i < 64; ++i) {
                const int k = kg + 32 * i;
                const float4 w = *(const float4*)(wp + (size_t)(32 * i) * NMOD);
                const float s0 = sl[k], s1 = sl[2048 + k];
                a0[0] += s0 * w.x; a0[1] += s0 * w.y; a0[2] += s0 * w.z; a0[3] += s0 * w.w;
                a1[0] += s1 * w.x; a1[1] += s1 * w.y; a1[2] += s1 * w.z; a1[3] += s1 * w.w;
            }
            __syncthreads();
#pragma unroll
            for (int e = 0; e < 4; ++e) { red[(kg * 16 + c4) * 8 + e] = a0[e]; red[(kg * 16 + c4) * 8 + 4 + e] = a1[e]; }
            __syncthreads();
            if (tid < 128) {
                const int b = tid >> 6, col = tid & 63;
                float s = 0.f;
                for (int g = 0; g < 32; ++g) s += red[(g * 16 + (col >> 2)) * 8 + b * 4 + (col & 3)];
                p.ada[b * NMOD + it * 64 + col] = s + p.b_ada[it * 64 + col];
            }
        }
        __syncthreads();
    }
    for (int e = bid * NTH + tid; e < NTOK * 64; e += nb * NTH) {
        const int tok = e >> 6, j = e & 63;
        const float ang = (float)p.pos[tok] * c_freq[j];
        float s, c; sincos_acc(ang, s, c);
        p.rope[(size_t)e * 2] = c; p.rope[(size_t)e * 2 + 1] = s;
    }
    {
        float* scr = lds + wave * (64 * 33);
        const int gw = bid * 8 + wave, ngw = nb * 8;
        constexpr int I1 = 32 * 256, I2 = 32 * 128, I3 = 16 * 64, I4 = 32 * 64;
        constexpr int NIT = I1 + I2 + I3 + 3 * I4;
        for (int it = gw; it < NIT; it += ngw) {
            int r = it;
            if (r < I1) { transpose_item(p.w_in, 2048, 8192, p.Wt1, 0, scr, r, lane); continue; } r -= I1;
            if (r < I2) { transpose_item(p.w_bg, 2048, 4096, p.Wt1, 8192, scr, r, lane); continue; } r -= I2;
            if (r < I3) { transpose_item(p.w_a_out, 1024, 2048, p.Wta, 0, scr, r, lane); continue; } r -= I3;
            if (r < I4) { transpose_item(p.w_b_out, 2048, 2048, p.Wtb, 0, scr, r, lane); continue; } r -= I4;
            if (r < I4) { transpose_item(p.w_o, 2048, 2048, p.Wto, 0, scr, r, lane); continue; } r -= I4;
            transpose_item(p.peer_wq, 2048, 2048, p.Wtq, 0, scr, r, lane);
        }
    }
    __syncthreads();
}
constexpr int ROW6 = 1536;
typedef float f32x32_t __attribute__((ext_vector_type(32)));
typedef unsigned u32x6_t __attribute__((ext_vector_type(6)));
__device__ __forceinline__ void tc_load(const Params& p, int r, int lane, float4 (&t)[8]) {
    const bool second = r >= 16384; const int row = second ? r - 16384 : r;
    const float* src = (second ? p.peer_v : p.peer_u) + (size_t)row * DM + lane * 4;
#pragma unroll
    for (int q = 0; q < 8; ++q) t[q] = *(const float4*)(src + 256 * q);
}
__device__ __forceinline__ void tc_finish(const Params& p, int r, int lane, const float4 (&t)[8]) {
    const bool second = r >= 16384; const int row = second ? r - 16384 : r;
    float am = 0.f;
#pragma unroll
    for (int q = 0; q < 8; ++q) am = fmaxf(am, fmaxf(fmaxf(fabsf(t[q].x), fabsf(t[q].y)), fmaxf(fabsf(t[q].z), fabsf(t[q].w))));
    am = wave_max(am);
    const float sc = (am > 0.f) ? am * (1.0f / 7.5f) : 1.0f, inv = (am > 0.f) ? 7.5f / am : 1.0f;
    typedef float f32x16_t __attribute__((ext_vector_type(16)));
    f32x16_t ev, od;
#pragma unroll
    for (int q = 0; q < 8; ++q) { ev[2 * q] = t[q].x * inv; od[2 * q] = t[q].y * inv; ev[2 * q + 1] = t[q].z * inv; od[2 * q + 1] = t[q].w * inv; }
    const u32x6_t w = __builtin_amdgcn_cvt_scalef32_2xpk16_fp6_f32(ev, od, 1.0f);
    unsigned char* dst = (second ? p.V8 : p.U8) + (size_t)row * ROW6 + lane * 24;
    *(uint2*)(dst) = make_uint2(w[0], w[1]); *(uint2*)(dst + 8) = make_uint2(w[2], w[3]); *(uint2*)(dst + 16) = make_uint2(w[4], w[5]);
    if (lane == 0) (second ? p.sv : p.su)[row] = sc;
}
__device__ __forceinline__ void ph_tabconv(const Params& p, int bid, int nb) {
    const int tid = tid_(), wave = tid >> 6, lane = tid & 63;
    for (int r = bid * 8 + wave; r < 2 * 16384; r += nb * 8) { float4 t[8]; tc_load(p, r, lane, t); tc_finish(p, r, lane, t); }
}

__device__ __forceinline__ void ph_modnorm(const Params& p, const float* xin, const float* g, int sh_off, int sc_off, bf16_t* hout, int bid, int nb, float* lds) {
    const int tid = tid_(), wave = tid >> 6, lane = tid & 63;
    const int stride = nb * 8;
    int row = bid * 8 + wave;
    float4 v[8], vn[8];
    if (row < NTOK) {
#pragma unroll
        for (int j = 0; j < 8; ++j) v[j] = ((const float4*)(xin + (size_t)row * DM))[lane + 64 * j];
    }
    for (; row < NTOK; row += stride) {
        const int nrow = row + stride;
        if (nrow < NTOK) {
#pragma unroll
            for (int j = 0; j < 8; ++j) vn[j] = ((const float4*)(xin + (size_t)nrow * DM))[lane + 64 * j];
        }
        const int b = row / SQ;
        float ss = 0.f;
#pragma unroll
        for (int j = 0; j < 8; ++j) ss += dot4(v[j], v[j]);
        ss = wave_sum(ss);
        const float rs = 1.0f / sqrtf(ss * (1.0f / DM) + 1e-6f);
#pragma unroll
        for (int j = 0; j < 8; ++j) {
            const int col = (lane + 64 * j) * 4;
            const float4 g4 = *(const float4*)(g + col);
            const float4 sc = *(const float4*)(p.ada + b * NMOD + sc_off + col);
            const float4 sh = *(const float4*)(p.ada + b * NMOD + sh_off + col);
            float4 o;
            o.x = v[j].x * rs * g4.x * (1.0f + sc.x) + sh.x; o.y = v[j].y * rs * g4.y * (1.0f + sc.y) + sh.y;
            o.z = v[j].z * rs * g4.z * (1.0f + sc.z) + sh.z; o.w = v[j].w * rs * g4.w * (1.0f + sc.w) + sh.w;
            *(uint2*)(hout + (size_t)row * DM + col) = make_uint2(pk2(o.x, o.y), pk2(o.z, o.w));
        }
#pragma unroll
        for (int j = 0; j < 8; ++j) v[j] = vn[j];
    }
}

typedef short bf16x8_t __attribute__((ext_vector_type(8)));
typedef float f32x4_t __attribute__((ext_vector_type(4)));
__device__ __forceinline__ bf16x8_t ldfrag(const char* base, int row, int chunk, int rb, int sm) { return *(const bf16x8_t*)(base + row * rb + ((chunk ^ (row & sm)) << 4)); }
__device__ __forceinline__ void ph_gmlp2(const Params& p, int bid, int nb, float* lds) {
    char* WM = (char*)lds; char* VT = WM + 32768;
    const int tid = tid_(), wave = tid >> 6, lane = tid & 63, fr = lane & 15, fq = lane >> 4;
    int gl = -1;
    for (int it = bid; it < 512; it += nb) {
        const int g = it & 7, n = (it >> 3) & 31, b = it >> 8;
        const int tok0 = b * SQ + n * 128;
        __syncthreads();
        if (g != gl) {
            for (int u = tid; u < 2048; u += NTH) {
                const int i = u >> 4, c = u & 15;
                const float4* src = (const float4*)(p.gm_ws + (size_t)g * 16384 + i * 128 + c * 8);
                float4 a = src[0], b4 = src[1];
                if ((i >> 6) < (c >> 3)) { a = make_float4(0.f, 0.f, 0.f, 0.f); b4 = a; }
                *(uint4*)(WM + i * 256 + ((c ^ (i & 15)) << 4)) = make_uint4(pk2(a.x, a.y), pk2(a.z, a.w), pk2(b4.x, b4.y), pk2(b4.z, b4.w));
            }
            gl = g;
        }
        {
            const float2 gn = *(const float2*)(p.gm_v_g + g * 128 + lane * 2);
#pragma unroll 4
            for (int jj = 0; jj < 16; ++jj) {
                const int j = wave * 16 + jj;
                const unsigned w = *(const unsigned*)(p.ZG + (size_t)(tok0 + j) * ZW + 1024 + g * 128 + lane * 2);
                const float a = bflo(w), c2 = bfhi(w);
                const float ss = wave_sum(a * a + c2 * c2);
                const float rs = 1.0f / sqrtf(ss * (1.0f / 128.0f) + 1e-6f);
                const int d0 = lane * 2, d1 = d0 + 1;
                *(bf16_t*)(VT + d0 * 256 + (((j >> 3) ^ (d0 & 15)) << 4) + (j & 7) * 2) = (bf16_t)f2bf(a * rs * gn.x);
                *(bf16_t*)(VT + d1 * 256 + (((j >> 3) ^ (d1 & 15)) << 4) + (j & 7) * 2) = (bf16_t)f2bf(c2 * rs * gn.y);
            }
        }
        __syncthreads();
        {
            bf16x8_t A[4];
#pragma unroll
            for (int ks = 0; ks < 4; ++ks) A[ks] = ldfrag(VT, wave * 16 + fr, ks * 4 + fq, 256, 15);
            const int d0 = wave * 16 + fq * 4;
#pragma unroll
            for (int itl = 0; itl < 8; ++itl) {
                f32x4_t acc = {0.f, 0.f, 0.f, 0.f};
#pragma unroll
                for (int ks = 0; ks < 4; ++ks) if (itl >= 4 || ks < 2) acc = __builtin_amdgcn_mfma_f32_16x16x32_bf16(A[ks], ldfrag(WM, itl * 16 + fr, ks * 4 + fq, 256, 15), acc, 0, 0, 0);
                const int i = itl * 16 + fr;
                const float bias = p.gm_b[g * 128 + i];
                const size_t tok = (size_t)(tok0 + i);
                const uint2 uw = *(const uint2*)(p.ZG + tok * ZW + g * 128 + d0);
                *(uint2*)(p.yain + tok * 1024 + g * 128 + d0) = make_uint2(pk2(bflo(uw.x) * (acc[0] + bias), bfhi(uw.x) * (acc[1] + bias)), pk2(bflo(uw.y) * (acc[2] + bias), bfhi(uw.y) * (acc[3] + bias)));
            }
        }
    }
    __syncthreads();
}

__device__ __forceinline__ void ph_ret(const Params& p, int bid, int nb, float* lds) {
    float* Qs = lds;
    float* Ks = Qs + 64 * 129;
    float* Vs = Ks + 64 * 129;
    float* Ss = Vs + 64 * 16;
    float* At = Ss + 128 * 16;
    float* kd = At + 64 * 65;
    const int tid = tid_();
    const bf16_t* z = p.ZG;
    for (int it = bid; it < 256; it += nb) {
        const int vs = it & 15, h = (it >> 4) & 7, b = it >> 7;
        const float lg = log1pf(-exp2f(-5.0f - (float)h));
        const float cdec = expf(lg * 64.0f);
        __syncthreads();
        for (int i = tid; i < 2048; i += NTH) Ss[i] = 0.f;
        if (tid < 64) kd[tid] = expf(lg * (float)(63 - tid));
        for (int n = 0; n < 64; ++n) {
            const int tok0 = b * SQ + n * 64;
            __syncthreads();
            for (int e = tid; e < 4096; e += NTH) {
                const int i = e >> 6, dd = e & 63; const size_t tok = (size_t)(tok0 + i);
                const float cs = p.rope[(tok * 64 + dd) * 2], sn = p.rope[(tok * 64 + dd) * 2 + 1];
                const bf16_t* zr = z + tok * ZW;
                const float q1 = bf2f(zr[2048 + h * 128 + dd]), q2 = bf2f(zr[2048 + h * 128 + 64 + dd]);
                const float k1 = bf2f(zr[3072 + h * 128 + dd]), k2 = bf2f(zr[3072 + h * 128 + 64 + dd]);
                Qs[i * 129 + dd] = q1 * cs - q2 * sn; Qs[i * 129 + 64 + dd] = q1 * sn + q2 * cs;
                const float sc = 0.08838834764831845f;
                Ks[i * 129 + dd] = (k1 * cs - k2 * sn) * sc; Ks[i * 129 + 64 + dd] = (k1 * sn + k2 * cs) * sc;
            }
            for (int e = tid; e < 1024; e += NTH) { const int j = e >> 4, v = e & 15; Vs[e] = bf2f(z[(size_t)(tok0 + j) * ZW + 4096 + h * 256 + vs * 16 + v]); }
            __syncthreads();
            {
                const int j = tid & 63, i0 = (tid >> 6) * 8;
                float acc[8];
#pragma unroll
                for (int ii = 0; ii < 8; ++ii) acc[ii] = 0.f;
                for (int d = 0; d < 128; ++d) {
                    const float kv = Ks[j * 129 + d];
#pragma unroll
                    for (int ii = 0; ii < 8; ++ii) acc[ii] += Qs[(i0 + ii) * 129 + d] * kv;
                }
#pragma unroll
                for (int ii = 0; ii < 8; ++ii) { const int i = i0 + ii; At[i * 65 + j] = acc[ii] * expf(lg * fabsf((float)(i - j))); }
            }
            __syncthreads();
            {
                const int v = tid & 15, i0 = tid >> 4;
#pragma unroll
                for (int rep = 0; rep < 2; ++rep) {
                    const int i = i0 + 32 * rep;
                    float a = 0.f; for (int j = 0; j < 64; ++j) a += At[i * 65 + j] * Vs[j * 16 + v];
                    float c2 = 0.f; for (int d = 0; d < 128; ++d) c2 += Qs[i * 129 + d] * Ss[d * 16 + v];
                    p.obuf[(size_t)(tok0 + i) * DM + h * 256 + vs * 16 + v] = a + c2 * expf(lg * (float)(i + 1));
                }
            }
            __syncthreads();
            {
                const int v = tid & 15, d0 = tid >> 4;
#pragma unroll
                for (int rep = 0; rep < 4; ++rep) {
                    const int d = d0 + 32 * rep;
                    float a = 0.f; for (int j = 0; j < 64; ++j) a += Ks[j * 129 + d] * kd[j] * Vs[j * 16 + v];
                    Ss[d * 16 + v] = Ss[d * 16 + v] * cdec + a;
                }
            }
        }
    }
    __syncthreads();
}


__device__ __forceinline__ void ph_retprep(const Params& p, int bid, int nb, float* lds) {
    bf16_t* Kl = (bf16_t*)lds;
    bf16_t* Vl = Kl + 64 * 132;
    char* Qm = (char*)(Vl + 64 * 264);
    char* Km = Qm + 16384;
    const int tid = tid_(), wave = tid >> 6, lane = tid & 63, fr = lane & 15, fq = lane >> 4;
    for (int it = bid; it < 1024; it += nb) {
        const int n = it & 63, h = (it >> 6) & 7, b = it >> 9;
        const int tok0 = b * SQ + n * 64;
        const size_t rowbase = (size_t)(b * 8 + h) * SQ + n * 64;
        const float lg = log1pf(-exp2f(-5.0f - (float)h));
        __syncthreads();
#pragma unroll
        for (int k = 0; k < 2; ++k) {
            const int u = tid + 512 * k, i = u >> 4, dd = (u & 15) * 4; const size_t tok = (size_t)(tok0 + i);
            const float4 r0 = *(const float4*)(p.rope + (tok * 64 + dd) * 2), r1 = *(const float4*)(p.rope + (tok * 64 + dd) * 2 + 4);
            const float cs[4] = {r0.x, r0.z, r1.x, r1.z}, sn[4] = {r0.y, r0.w, r1.y, r1.w};
            const bf16_t* zr = p.ZG + tok * ZW;
            const uint2 q1w = *(const uint2*)(zr + 2048 + h * 128 + dd), q2w = *(const uint2*)(zr + 2048 + h * 128 + 64 + dd);
            const uint2 k1w = *(const uint2*)(zr + 3072 + h * 128 + dd), k2w = *(const uint2*)(zr + 3072 + h * 128 + 64 + dd);
            const float q1[4] = {bflo(q1w.x), bfhi(q1w.x), bflo(q1w.y), bfhi(q1w.y)}, q2[4] = {bflo(q2w.x), bfhi(q2w.x), bflo(q2w.y), bfhi(q2w.y)};
            const float k1[4] = {bflo(k1w.x), bfhi(k1w.x), bflo(k1w.y), bfhi(k1w.y)}, k2[4] = {bflo(k2w.x), bfhi(k2w.x), bflo(k2w.y), bfhi(k2w.y)};
            const float sc = 0.08838834764831845f, kd = expf(lg * (float)(63 - i));
            float qa[4], qb[4], ka[4], kb[4];
#pragma unroll
            for (int e = 0; e < 4; ++e) { qa[e] = q1[e] * cs[e] - q2[e] * sn[e]; qb[e] = q1[e] * sn[e] + q2[e] * cs[e]; ka[e] = (k1[e] * cs[e] - k2[e] * sn[e]) * sc; kb[e] = (k1[e] * sn[e] + k2[e] * cs[e]) * sc; }
            const uint2 qaw = make_uint2(pk2(qa[0], qa[1]), pk2(qa[2], qa[3])), qbw = make_uint2(pk2(qb[0], qb[1]), pk2(qb[2], qb[3]));
            const uint2 kaw = make_uint2(pk2(ka[0], ka[1]), pk2(ka[2], ka[3])), kbw = make_uint2(pk2(kb[0], kb[1]), pk2(kb[2], kb[3]));
            *(uint2*)(p.Qr + (rowbase + i) * 128 + dd) = qaw; *(uint2*)(p.Qr + (rowbase + i) * 128 + 64 + dd) = qbw;
            const int c = dd >> 3, o8 = (dd & 7) * 2;
            *(uint2*)(Qm + i * 256 + ((c ^ (i & 15)) << 4) + o8) = qaw; *(uint2*)(Qm + i * 256 + (((c + 8) ^ (i & 15)) << 4) + o8) = qbw;
            *(uint2*)(Km + i * 256 + ((c ^ (i & 15)) << 4) + o8) = kaw; *(uint2*)(Km + i * 256 + (((c + 8) ^ (i & 15)) << 4) + o8) = kbw;
            *(uint2*)(Kl + i * 132 + dd) = make_uint2(pk2(ka[0] * kd, ka[1] * kd), pk2(ka[2] * kd, ka[3] * kd));
            *(uint2*)(Kl + i * 132 + 64 + dd) = make_uint2(pk2(kb[0] * kd, kb[1] * kd), pk2(kb[2] * kd, kb[3] * kd));
        }
#pragma unroll
        for (int k = 0; k < 4; ++k) {
            const int u = tid + 512 * k, j = u >> 5, c = u & 31;
            *(uint4*)(Vl + j * 264 + c * 8) = *(const uint4*)(p.ZG + (size_t)(tok0 + j) * ZW + 4096 + h * 256 + c * 8);
        }
        __syncthreads();
        {
            const int jt = wave >> 1, it0 = 2 * (wave & 1);
            f32x4_t s0 = {0.f, 0.f, 0.f, 0.f}, s1 = {0.f, 0.f, 0.f, 0.f};
#pragma unroll
            for (int ks = 0; ks < 4; ++ks) {
                const bf16x8_t a = ldfrag(Km, jt * 16 + fr, ks * 4 + fq, 256, 15);
                const bf16x8_t b0 = ldfrag(Qm, it0 * 16 + fr, ks * 4 + fq, 256, 15), b1 = ldfrag(Qm, (it0 + 1) * 16 + fr, ks * 4 + fq, 256, 15);
                s0 = __builtin_amdgcn_mfma_f32_16x16x32_bf16(a, b0, s0, 0, 0, 0);
                s1 = __builtin_amdgcn_mfma_f32_16x16x32_bf16(a, b1, s1, 0, 0, 0);
            }
            const int j0 = jt * 16 + fq * 4;
            bf16_t* pg = p.Pm + (size_t)it * 4096;
#pragma unroll
            for (int tt = 0; tt < 2; ++tt) {
                const int i = (it0 + tt) * 16 + fr; const f32x4_t sv4 = tt ? s1 : s0; float pv[4];
#pragma unroll
                for (int r = 0; r < 4; ++r) pv[r] = sv4[r] * __expf(lg * fabsf((float)(i - (j0 + r))));
                *(uint2*)(pg + i * 64 + j0) = make_uint2(pk2(pv[0], pv[1]), pk2(pv[2], pv[3]));
            }
        }
        bf16_t* kt = p.KTd + (size_t)it * 8192;
#pragma unroll
        for (int k = 0; k < 2; ++k) {
            const int u = tid + 512 * k, d = u & 127, jg = u >> 7;
            unsigned w[4];
#pragma unroll
            for (int q = 0; q < 4; ++q) w[q] = (unsigned)Kl[(jg * 8 + 2 * q) * 132 + d] | ((unsigned)Kl[(jg * 8 + 2 * q + 1) * 132 + d] << 16);
            *(uint4*)(kt + d * 64 + jg * 8) = make_uint4(w[0], w[1], w[2], w[3]);
        }
        bf16_t* vt = p.Vt + (size_t)it * 16384;
#pragma unroll
        for (int k = 0; k < 4; ++k) {
            const int u = tid + 512 * k, v = u & 255, jg = u >> 8;
            unsigned w[4];
#pragma unroll
            for (int q = 0; q < 4; ++q) w[q] = (unsigned)Vl[(jg * 8 + 2 * q) * 264 + v] | ((unsigned)Vl[(jg * 8 + 2 * q + 1) * 264 + v] << 16);
            *(uint4*)(vt + v * 64 + jg * 8) = make_uint4(w[0], w[1], w[2], w[3]);
        }
    }
    __syncthreads();
}

__device__ __forceinline__ void ph_ret2(const Params& p, int bid, int nb, float* lds) {
    char* L = (char*)lds;
    constexpr int OQ = 0, OKT = 16384, OPP = 32768, OVT = 40960, TILE = 43008, OST = 2 * TILE;
    const int tid = tid_(), wave = tid >> 6, lane = tid & 63, fr = lane & 15, fq = lane >> 4;
    for (int it = bid; it < 256; it += nb) {
        const int itm = ((it & 7) * 2 + (it >> 7)) * 16 + ((it >> 3) & 15);
        const int vs = itm & 15, h = (itm >> 4) & 7, b = itm >> 7;
        const float lg = log1pf(-exp2f(-5.0f - (float)h));
        const float cdec = expf(lg * 64.0f);
        const size_t bh = (size_t)(b * 8 + h);
        const char* gQ = (const char*)(p.Qr + bh * SQ * 128);
        const char* gKT = (const char*)(p.KTd + bh * 64 * 8192);
        const char* gP = (const char*)(p.Pm + bh * 64 * 4096);
        const char* gVt = (const char*)(p.Vt + bh * 64 * 16384) + vs * 16 * 128;
        int lq[2], lkt[2];
#pragma unroll
        for (int u = 0; u < 2; ++u) { const int ci = tid + 512 * u; const int r = ci >> 4, c = ci & 15; lq[u] = r * 256 + ((c ^ (r & 15)) << 4); const int d = ci >> 3, c8 = ci & 7; lkt[u] = d * 128 + ((c8 ^ (d & 7)) << 4); }
        const int lp = (tid >> 3) * 128 + (((tid & 7) ^ ((tid >> 3) & 7)) << 4);
        const int lv = lp;
        uint4 qA0, qA1, tA0, tA1, pA, vA = make_uint4(0u, 0u, 0u, 0u), qB0, qB1, tB0, tB1, pB, vB = make_uint4(0u, 0u, 0u, 0u);
#define RET_LOAD(X_, n_) do { const size_t o0 = (size_t)(n_) * 16384 + (size_t)tid * 16, o1 = o0 + 8192; \
        q##X_##0 = *(const uint4*)(gQ + o0); q##X_##1 = *(const uint4*)(gQ + o1); t##X_##0 = *(const uint4*)(gKT + o0); t##X_##1 = *(const uint4*)(gKT + o1); p##X_ = *(const uint4*)(gP + (size_t)(n_) * 8192 + tid * 16); \
        if (tid < 128) v##X_ = *(const uint4*)(gVt + (size_t)(n_) * 32768 + tid * 16); } while (0)
#define RET_WRITE(X_, buf_) do { char* B_ = L + (buf_) * TILE; \
        *(uint4*)(B_ + OQ + lq[0]) = q##X_##0; *(uint4*)(B_ + OQ + lq[1]) = q##X_##1; *(uint4*)(B_ + OKT + lkt[0]) = t##X_##0; *(uint4*)(B_ + OKT + lkt[1]) = t##X_##1; *(uint4*)(B_ + OPP + lp) = p##X_; \
        if (tid < 128) *(uint4*)(B_ + OVT + lv) = v##X_; } while (0)
        __syncthreads();
        for (int i = tid; i < 1024; i += NTH) ((unsigned*)(L + OST))[i] = 0u;
        RET_LOAD(A, 0); RET_WRITE(A, 0); RET_LOAD(B, 1);
        f32x4_t sacc[2] = {{0.f, 0.f, 0.f, 0.f}, {0.f, 0.f, 0.f, 0.f}};
#define RET_STEP(n_, cur_, LS_, WS_) do { const int n = (n_); constexpr int cur = (cur_); \
            __syncthreads();                                     \
            if (n + 2 < 64) RET_LOAD(LS_, n + 2); \
            const char* T = L + cur * TILE; \
            if (wave < 4) {     \
                const int itl = wave; \
                f32x4_t o1 = {0.f, 0.f, 0.f, 0.f}, o2 = {0.f, 0.f, 0.f, 0.f}; \
                _Pragma("unroll") for (int ks = 0; ks < 2; ++ks) o1 = __builtin_amdgcn_mfma_f32_16x16x32_bf16(ldfrag(T + OPP, itl * 16 + fr, ks * 4 + fq, 128, 7), ldfrag(T + OVT, fr, ks * 4 + fq, 128, 7), o1, 0, 0, 0); \
                _Pragma("unroll") for (int ks = 0; ks < 4; ++ks) o2 = __builtin_amdgcn_mfma_f32_16x16x32_bf16(ldfrag(T + OQ, itl * 16 + fr, ks * 4 + fq, 256, 15), ldfrag(L + OST + cur * 4096, fr, ks * 4 + fq, 256, 15), o2, 0, 0, 0); \
                _Pragma("unroll") for (int r = 0; r < 4; ++r) { const int i = itl * 16 + fq * 4 + r; \
                    p.ob16[(size_t)(b * SQ + n * 64 + i) * DM + h * 256 + vs * 16 + fr] = (bf16_t)f2bf(o1[r] + __expf(lg * (float)(i + 1)) * o2[r]); } \
            } else {            \
                _Pragma("unroll") for (int u = 0; u < 2; ++u) { \
                    const int dt = 2 * (wave - 4) + u; \
                    sacc[u] = sacc[u] * cdec; \
                    _Pragma("unroll") for (int ks = 0; ks < 2; ++ks) sacc[u] = __builtin_amdgcn_mfma_f32_16x16x32_bf16(ldfrag(T + OKT, dt * 16 + fr, ks * 4 + fq, 128, 7), ldfrag(T + OVT, fr, ks * 4 + fq, 128, 7), sacc[u], 0, 0, 0); \
                    *(uint2*)(L + OST + (cur ^ 1) * 4096 + fr * 256 + (((dt * 2 + (fq >> 1)) ^ fr) << 4) + (fq & 1) * 8) = make_uint2(pk2(sacc[u][0], sacc[u][1]), pk2(sacc[u][2], sacc[u][3])); } \
            } \
            if (n + 1 < 64) RET_WRITE(WS_, cur ^ 1); } while (0)
#pragma unroll 1
        for (int n2 = 0; n2 < 64; n2 += 2) { RET_STEP(n2, 0, A, B); RET_STEP(n2 + 1, 1, B, A); }
#undef RET_STEP
#undef RET_LOAD
#undef RET_WRITE
    }
    __syncthreads();
}

__device__ __forceinline__ void gn_load(const Params& p, int tok, int lane, uint2 (&ow)[8], uint2 (&gw)[8]) {
#pragma unroll
    for (int h = 0; h < 8; ++h) { ow[h] = *(const uint2*)(p.ob16 + (size_t)tok * DM + h * 256 + lane * 4); gw[h] = *(const uint2*)(p.ZG + (size_t)tok * ZW + 6144 + h * 256 + lane * 4); }
}
__device__ __forceinline__ void ph_gn(const Params& p, int bid, int nb, float* lds) {
    const int tid = tid_(), wave = tid >> 6, lane = tid & 63;
    const int stride = nb * 8;
    int tok = bid * 8 + wave;
    uint2 ow[8], gw[8], own[8], gwn[8];
    if (tok < NTOK) gn_load(p, tok, lane, ow, gw);
    for (; tok < NTOK; tok += stride) {
        if (tok + stride < NTOK) gn_load(p, tok + stride, lane, own, gwn);
        float4 o[8]; float s1[8], s2[8];
#pragma unroll
        for (int h = 0; h < 8; ++h) { o[h] = make_float4(bflo(ow[h].x), bfhi(ow[h].x), bflo(ow[h].y), bfhi(ow[h].y)); s1[h] = (o[h].x + o[h].y) + (o[h].z + o[h].w); }
#pragma unroll
        for (int off = 1; off < 64; off <<= 1)
#pragma unroll
            for (int h = 0; h < 8; ++h) s1[h] += __shfl_xor(s1[h], off);
#pragma unroll
        for (int h = 0; h < 8; ++h) { const float mu = s1[h] * (1.0f / 256.0f); o[h].x -= mu; o[h].y -= mu; o[h].z -= mu; o[h].w -= mu; s2[h] = dot4(o[h], o[h]); }
#pragma unroll
        for (int off = 1; off < 64; off <<= 1)
#pragma unroll
            for (int h = 0; h < 8; ++h) s2[h] += __shfl_xor(s2[h], off);
#pragma unroll
        for (int h = 0; h < 8; ++h) {
            const float rs = 1.0f / sqrtf(s2[h] * (1.0f / 256.0f) + 1e-6f);
            const float4 gn = *(const float4*)(p.ret_gn_g + h * 256 + lane * 4);
            const float g0 = bflo(gw[h].x), g1 = bfhi(gw[h].x), g2 = bflo(gw[h].y), g3 = bfhi(gw[h].y);
            *(uint2*)(p.ybin + (size_t)tok * DM + h * 256 + lane * 4) =
                make_uint2(pk2(siluf_(g0) * o[h].x * rs * gn.x, siluf_(g1) * o[h].y * rs * gn.y), pk2(siluf_(g2) * o[h].z * rs * gn.z, siluf_(g3) * o[h].w * rs * gn.w));
        }
#pragma unroll
        for (int h = 0; h < 8; ++h) { ow[h] = own[h]; gw[h] = gwn[h]; }
    }
}

__device__ __forceinline__ void split8(const float4 a, const float4 b, uint4& hi, uint4& lo) {
    const float x[8] = {a.x, a.y, a.z, a.w, b.x, b.y, b.z, b.w}; unsigned h[8], l[8];
#pragma unroll
    for (int i = 0; i < 8; ++i) { h[i] = f2bf(x[i]); l[i] = f2bf(x[i] - __uint_as_float(h[i] << 16)); }
    hi = make_uint4(h[0] | (h[1] << 16), h[2] | (h[3] << 16), h[4] | (h[5] << 16), h[6] | (h[7] << 16));
    lo = make_uint4(l[0] | (l[1] << 16), l[2] | (l[3] << 16), l[4] | (l[5] << 16), l[6] | (l[7] << 16));
}
__device__ __forceinline__ bf16x8_t as_bf16x8(const uint4 v) { return __builtin_bit_cast(bf16x8_t, v); }
struct PairTab { int a[52], b[52]; };
__host__ __device__ constexpr PairTab make_pairs() {
    PairTab t{}; int n = 0;
    for (int a = 0; a < 16; ++a) for (int b = 0; b < 16; ++b) if ((a + 1) * (b + 1) <= 16) { t.a[n] = a; t.b[n] = b; ++n; }
    for (; n < 52; ++n) { t.a[n] = -1; t.b[n] = -1; }
    return t;
}
constexpr PairTab PAIRS = make_pairs();
static_assert(PAIRS.a[49] >= 0 && PAIRS.a[50] < 0, "50 candidate pairs");

template <int N, int OFF> __device__ __forceinline__ void bitonic_sort_desc(float* v) {
#pragma unroll
    for (int k = 2; k <= N; k <<= 1)
#pragma unroll
        for (int j = k >> 1; j > 0; j >>= 1)
#pragma unroll
            for (int i = 0; i < N; ++i) { const int l = i ^ j; if (l > i) { const bool up = ((i & k) == 0);
                const float a = v[OFF + i], b = v[OFF + l]; const float mx = fmaxf(a, b), mn = fminf(a, b); v[OFF + i] = up ? mx : mn; v[OFF + l] = up ? mn : mx; } }
}
template <int N> __device__ __forceinline__ void bitonic_merge_desc(float* v) {
#pragma unroll
    for (int j = N >> 1; j > 0; j >>= 1)
#pragma unroll
        for (int i = 0; i < N; ++i) { const int l = i ^ j; if (l > i) { const float a = v[i], b = v[l]; v[i] = fmaxf(a, b); v[l] = fminf(a, b); } }
}
__device__ __forceinline__ void ph_topk2(const Params& p, const float* qb, int bid, int nb, float* lds) {
    const int tid = tid_(), wave = tid >> 6, lane = tid & 63;
    uint4* SK = (uint4*)lds;
    const float NEG = -INFINITY;
    const bool tc_on = (nb == 256); const int tcr0 = (bid * 8 + wave) * 16; float4 tct[8];
    if (tc_on) tc_load(p, tcr0, lane, tct);
    for (int it = bid; it < 256; it += nb) {
        const int h = it & 7, tg = it >> 3;
        __syncthreads();
        for (int gi = tid; gi < 4096; gi += NTH) {
            const int dq = gi & 15, n = (gi >> 4) & 127, pp = gi >> 11;
            const float4* src = (const float4*)(p.peer_sk + ((size_t)(h * 2 + pp) * 128 + n) * 128 + dq * 8);
            uint4 hi, lo; split8(src[0], src[1], hi, lo);
            const int base = (((pp * 8 + (n >> 4)) * 4 + (dq >> 2)) * 2) * 64 + (dq & 3) * 16 + (n & 15);
            SK[base] = hi; SK[base + 64] = lo;
        }
        __syncthreads();
#pragma unroll 1
        for (int tile = 0; tile < 2; ++tile) {
            const int tok = tg * 256 + wave * 32 + tile * 16 + (lane & 15);
            const int qd = lane >> 4;
            float v12[2][16];
#pragma unroll
            for (int pp = 0; pp < 2; ++pp) {
                if (tc_on) { const int ti = tile * 8 + pp * 4; tc_finish(p, tcr0 + ti, lane, tct); tc_load(p, tcr0 + ti + 1, lane, tct); }
                bf16x8_t Bh[4], Bl[4];
                const float* qp = qb + (size_t)tok * DM + h * 256 + pp * 128 + 8 * qd;
#pragma unroll
                for (int ks = 0; ks < 4; ++ks) { uint4 hi, lo; split8(*(const float4*)(qp + ks * 32), *(const float4*)(qp + ks * 32 + 4), hi, lo); Bh[ks] = as_bf16x8(hi); Bl[ks] = as_bf16x8(lo); }
                float v[32];
#pragma unroll
                for (int kt = 0; kt < 8; ++kt) {
                    f32x4_t acc = {0.f, 0.f, 0.f, 0.f};
#pragma unroll
                    for (int ks = 0; ks < 4; ++ks) {
                        const bf16x8_t Ah = as_bf16x8(SK[(((pp * 8 + kt) * 4 + ks) * 2) * 64 + lane]), Al = as_bf16x8(SK[(((pp * 8 + kt) * 4 + ks) * 2 + 1) * 64 + lane]);
                        acc = __builtin_amdgcn_mfma_f32_16x16x32_bf16(Ah, Bh[ks], acc, 0, 0, 0);
                        acc = __builtin_amdgcn_mfma_f32_16x16x32_bf16(Ah, Bl[ks], acc, 0, 0, 0);
                        acc = __builtin_amdgcn_mfma_f32_16x16x32_bf16(Al, Bh[ks], acc, 0, 0, 0);
                    }
#pragma unroll
                    for (int r = 0; r < 4; ++r) v[kt * 4 + r] = __uint_as_float((__float_as_uint(acc[r]) & ~127u) | (unsigned)(kt * 16 + qd * 4 + r));
                    __builtin_amdgcn_sched_barrier(0);
                }
                if (tc_on) { const int ti = tile * 8 + pp * 4 + 1; tc_finish(p, tcr0 + ti, lane, tct); tc_load(p, tcr0 + ti + 1, lane, tct); }
                bitonic_sort_desc<16, 0>(v); bitonic_sort_desc<16, 16>(v);
                float c16[16];
#pragma unroll
                for (int i = 0; i < 16; ++i) c16[i] = fmaxf(v[i], v[31 - i]);
                bitonic_merge_desc<16>(c16);
                if (tc_on) { const int ti = tile * 8 + pp * 4 + 2; tc_finish(p, tcr0 + ti, lane, tct); tc_load(p, tcr0 + ti + 1, lane, tct); }
#pragma unroll
                for (int st = 0; st < 2; ++st) {
                    float pr[16];
#pragma unroll
                    for (int i = 0; i < 16; ++i) pr[i] = __shfl_xor(c16[i], 16 << st);
#pragma unroll
                    for (int i = 0; i < 16; ++i) c16[i] = fmaxf(c16[i], pr[15 - i]);
                    bitonic_merge_desc<16>(c16);
                }
                if (tc_on) { const int ti = tile * 8 + pp * 4 + 3; tc_finish(p, tcr0 + ti, lane, tct); if (ti < 15) tc_load(p, tcr0 + ti + 1, lane, tct); }
#pragma unroll
                for (int i = 0; i < 16; ++i) v12[pp][i] = c16[i];
            }
            float c[13]; unsigned pay[13];
#pragma unroll
            for (int s = 0; s < 13; ++s) {
                float cq[4]; unsigned pq[4];
#pragma unroll
                for (int q = 0; q < 4; ++q) {
                    const int pi = 4 * s + q; const int a = PAIRS.a[pi], b = PAIRS.b[pi];
                    if (a >= 0) {
                        const float sum = v12[0][a] + v12[1][b];
                        cq[q] = __uint_as_float((__float_as_uint(sum) & ~63u) | (unsigned)pi);
                        pq[q] = (__float_as_uint(v12[0][a]) & 127u) * 128u + (__float_as_uint(v12[1][b]) & 127u);
                    } else { cq[q] = NEG; pq[q] = 0u; }
                }
                c[s] = qd == 0 ? cq[0] : qd == 1 ? cq[1] : qd == 2 ? cq[2] : cq[3];
                pay[s] = qd == 0 ? pq[0] : qd == 1 ? pq[1] : qd == 2 ? pq[2] : pq[3];
            }
            float top[16]; unsigned eid[16];
#pragma unroll
            for (int r = 0; r < 16; ++r) {
                float m = c[0];
#pragma unroll
                for (int s = 1; s < 13; ++s) m = fmaxf(m, c[s]);
                m = fmaxf(m, __shfl_xor(m, 16)); m = fmaxf(m, __shfl_xor(m, 32));
                unsigned pw = 0u;
#pragma unroll
                for (int s = 0; s < 13; ++s) { const bool eq = (c[s] == m); pw |= eq ? pay[s] : 0u; c[s] = eq ? NEG : c[s]; }
                pw |= (unsigned)__shfl_xor((int)pw, 16); pw |= (unsigned)__shfl_xor((int)pw, 32);
                top[r] = m; eid[r] = pw;
            }
            float sum = 0.f; const float mx = top[0];
#pragma unroll
            for (int r = 0; r < 16; ++r) { top[r] = expf(top[r] - mx); sum += top[r]; }
            const float inv = 1.0f / sum;
            if (lane < 16) {
                int4* ep = (int4*)(p.eidx + (size_t)tok * 128 + h * 16); float4* gp = (float4*)(p.gatev + (size_t)tok * 128 + h * 16);
#pragma unroll
                for (int q = 0; q < 4; ++q) {
                    ep[q] = make_int4((int)eid[4 * q], (int)eid[4 * q + 1], (int)eid[4 * q + 2], (int)eid[4 * q + 3]);
                    gp[q] = make_float4(top[4 * q] * inv, top[4 * q + 1] * inv, top[4 * q + 2] * inv, top[4 * q + 3] * inv);
                }
            }
        }
    }
    __syncthreads();
}

__device__ __forceinline__ void peer_load4(const unsigned char* tab, const int (&e)[4], int lane, uint2 (&R)[4][3]) {
#pragma unroll
    for (int i = 0; i < 4; ++i) { const uint2* r = (const uint2*)(tab + (size_t)e[i] * ROW6 + lane * 24); R[i][0] = r[0]; R[i][1] = r[1]; R[i][2] = r[2]; }
}
__device__ __forceinline__ f32x32_t dec6(const uint2 (&R)[3]) { const u32x6_t w = {R[0].x, R[0].y, R[1].x, R[1].y, R[2].x, R[2].y}; return __builtin_amdgcn_cvt_scalef32_pk32_f32_fp6(w, 1.0f); }
__device__ __forceinline__ void ph_peer3(const Params& p, const float* x1, const bf16_t* h2, int bid, int nb) {
    const int tid = tid_(), wave = tid >> 6, lane = tid & 63;
    for (int t = bid * 8 + wave; t < NTOK; t += nb * 8) {
        const int b = t / SQ;
        float hv[32], y[32];
#pragma unroll
        for (int q = 0; q < 8; ++q) { const uint2 w = *(const uint2*)(h2 + (size_t)t * DM + 256 * q + lane * 4); float* d = hv + 4 * q;
            d[0] = bflo(w.x); d[1] = bfhi(w.x); d[2] = bflo(w.y); d[3] = bfhi(w.y); }
#pragma unroll
        for (int i = 0; i < 32; ++i) y[i] = 0.f;
        const int e0 = p.eidx[(size_t)t * 128 + lane], e1 = p.eidx[(size_t)t * 128 + 64 + lane];
        const float g0 = p.gatev[(size_t)t * 128 + lane], g1 = p.gatev[(size_t)t * 128 + 64 + lane];
        const float su0 = p.su[e0], su1 = p.su[e1];
        const float gv0 = g0 * p.sv[e0], gv1 = g1 * p.sv[e1];
        uint2 Uc[4][3], Un[4][3], Vc[4][3];
        { int e[4];
#pragma unroll
          for (int i = 0; i < 4; ++i) e[i] = __builtin_amdgcn_readlane(e0, i);
          peer_load4(p.U8, e, lane, Uc); }
        for (int g = 0; g < 32; ++g) {
            const bool lo = g < 16; const int k0 = (4 * g) & 63;
            const int ee = lo ? e0 : e1; const float suu = lo ? su0 : su1, gvv = lo ? gv0 : gv1;
            int e[4]; float sa[4], gw[4];
#pragma unroll
            for (int i = 0; i < 4; ++i) { e[i] = __builtin_amdgcn_readlane(ee, k0 + i);
                sa[i] = __uint_as_float(__builtin_amdgcn_readlane(__float_as_uint(suu), k0 + i)); gw[i] = __uint_as_float(__builtin_amdgcn_readlane(__float_as_uint(gvv), k0 + i)); }
            peer_load4(p.V8, e, lane, Vc);
            {
                const int gn = (g < 31) ? g + 1 : g; const int en = (gn < 16) ? e0 : e1; const int kn = (4 * gn) & 63; int e2[4];
#pragma unroll
                for (int i = 0; i < 4; ++i) e2[i] = __builtin_amdgcn_readlane(en, kn + i);
                peer_load4(p.U8, e2, lane, Un);
            }
            float a[4];
#pragma unroll
            for (int i = 0; i < 4; ++i) {
                const f32x32_t d = dec6(Uc[i]);
                float acc0 = 0.f, acc1 = 0.f;
#pragma unroll
                for (int k = 0; k < 32; k += 2) { acc0 += d[k] * hv[k]; acc1 += d[k + 1] * hv[k + 1]; }
                a[i] = acc0 + acc1;
            }
#pragma unroll
            for (int o = 1; o < 64; o <<= 1) { a[0] += __shfl_xor(a[0], o); a[1] += __shfl_xor(a[1], o); a[2] += __shfl_xor(a[2], o); a[3] += __shfl_xor(a[3], o); }
#pragma unroll
            for (int i = 0; i < 4; ++i) {
                const float wgt = geluf_(a[i] * sa[i]) * gw[i];
                const f32x32_t d = dec6(Vc[i]);
#pragma unroll
                for (int k = 0; k < 32; ++k) y[k] += wgt * d[k];
            }
#pragma unroll
            for (int i = 0; i < 4; ++i) { Uc[i][0] = Un[i][0]; Uc[i][1] = Un[i][1]; Uc[i][2] = Un[i][2]; }
        }
        float ss = 0.f;
#pragma unroll
        for (int q = 0; q < 8; ++q) {
            const int c = 256 * q + lane * 4;
            const float4 xv = *(const float4*)(x1 + (size_t)t * DM + c);
            const float4 ga = *(const float4*)(p.ada + b * NMOD + 5 * DM + c);
            float* yy = y + 4 * q;
            yy[0] = xv.x + ga.x * yy[0]; yy[1] = xv.y + ga.y * yy[1]; yy[2] = xv.z + ga.z * yy[2]; yy[3] = xv.w + ga.w * yy[3];
            ss += yy[0] * yy[0] + yy[1] * yy[1] + yy[2] * yy[2] + yy[3] * yy[3];
        }
        ss = wave_sum(ss);
        const float rs = 1.0f / sqrtf(ss * (1.0f / DM) + 1e-6f);
#pragma unroll
        for (int q = 0; q < 8; ++q) {
            const int c = 256 * q + lane * 4;
            const float4 gf = *(const float4*)(p.norm_f_g + c);
            const float* yy = y + 4 * q;
            *(float4*)(p.out + (size_t)t * DM + c) = make_float4(yy[0] * rs * gf.x, yy[1] * rs * gf.y, yy[2] * rs * gf.z, yy[3] * rs * gf.w);
        }
    }
}

#define LAS __attribute__((address_space(3)))
#define XB_TMO      128
#define XB_XCNT(j)  (256  + 64 * (j))
#define XB_XSUB(j)  (1280 + 64 * (j))
#define XB_XGEN(j)  (2304 + 64 * (j))
#define XB_TOP      3328
#define XB_TOPGEN   3392
#define XCD_BAR_WORDS 3456
#define XB_SPIN_CAP (1u << 18)

__device__ __forceinline__ unsigned xb_ld(unsigned* p)              { return __hip_atomic_load(p, __ATOMIC_RELAXED, __HIP_MEMORY_SCOPE_AGENT); }
__device__ __forceinline__ unsigned xb_add(unsigned* p, unsigned v) { return __hip_atomic_fetch_add(p, v, __ATOMIC_RELAXED, __HIP_MEMORY_SCOPE_AGENT); }
__device__ __forceinline__ unsigned xb_xcc_id() { return (unsigned)__builtin_amdgcn_s_getreg((3 << 11) | 20) & 0xFu; }
#define XB_SPIN(cond, bar) do { unsigned _sp = 0; while (cond) { __builtin_amdgcn_s_sleep(1); \
    if ((++_sp & 255u) == 0u) { if (xb_ld(&(bar)[XB_TMO])) break; if (_sp > XB_SPIN_CAP) { atomicAdd(&(bar)[XB_TMO], 1u); break; } } } } while (0)

struct XcdBarrier {
    unsigned* bar; unsigned x;
    volatile LAS unsigned* st;
};

__device__ __forceinline__ XcdBarrier xcd_barrier_post(unsigned* bar, volatile LAS unsigned* st) {
    XcdBarrier b; b.bar = bar; b.x = xb_xcc_id(); b.st = st;
    if (threadIdx.x == 0) (void)xb_add(&bar[XB_XCNT(b.x)], 1u);
    return b;
}
__device__ __forceinline__ void xcd_barrier_complete(unsigned* bar, unsigned x, unsigned& nloc, unsigned& nx) {
    const unsigned G = gridDim.x * gridDim.y * gridDim.z;
    unsigned sum, cnt, mine, sp = 0u;
    for (;;) {
        sum = 0u; cnt = 0u; mine = 0u;
#pragma unroll
        for (unsigned j = 0; j < 16; ++j) { const unsigned c = xb_ld(&bar[XB_XCNT(j)]); sum += c; cnt += (c > 0u) ? 1u : 0u; mine = (j == x) ? c : mine; }
        if (sum == G) break;
        __builtin_amdgcn_s_sleep(1);
        if ((++sp & 255u) == 0u) { if (xb_ld(&bar[XB_TMO])) break; if (sp > XB_SPIN_CAP) { atomicAdd(&bar[XB_TMO], 1u); break; } }
    }
    nloc = mine > 0u ? mine : 1u; nx = cnt > 0u ? cnt : 1u;
}

__device__ __forceinline__ void xcd_barrier(const XcdBarrier& b) {
    asm volatile("s_waitcnt vmcnt(0)" ::: "memory");
    __syncthreads();
    if (threadIdx.x == 0) {
        unsigned* bar = b.bar;
        __builtin_amdgcn_s_waitcnt(0);
        unsigned nloc = b.st[0], nx = b.st[1];
        if (nloc == 0u) { xcd_barrier_complete(bar, b.x, nloc, nx); b.st[0] = nloc; b.st[1] = nx; }
        const unsigned old = xb_add(&bar[XB_XSUB(b.x)], 1u);
        const unsigned gen = old / nloc;
        if (old + 1u == (gen + 1u) * nloc) {
            __builtin_amdgcn_fence(__ATOMIC_RELEASE, "agent");
            asm volatile("s_waitcnt vmcnt(0)" ::: "memory");
            const unsigned og = xb_add(&bar[XB_TOP], 1u);
            const unsigned tg = og / nx;
            if (og + 1u == (tg + 1u) * nx) xb_add(&bar[XB_TOPGEN], 1u);
            else XB_SPIN(xb_ld(&bar[XB_TOPGEN]) == tg, bar);
            __builtin_amdgcn_fence(__ATOMIC_ACQUIRE, "agent");
            xb_add(&bar[XB_XGEN(b.x)], 1u);
            asm volatile("s_waitcnt vmcnt(0)" ::: "memory");
        } else {
            XB_SPIN(xb_ld(&bar[XB_XGEN(b.x)]) == gen, bar);
            __builtin_amdgcn_fence(__ATOMIC_ACQUIRE, "agent");
            asm volatile("s_waitcnt vmcnt(0)" ::: "memory");
        }
    }
    __syncthreads();
}

template <class Epi>
__device__ __forceinline__ void gemm_run(float* lds, const bf16_t* A, const bf16_t* Bt, int M, int N, int K, const Epi& E) {
    __syncthreads();
    pg8::Gemm g{A, Bt, M, N, K}; pg8::StaticOrder S; S.init(M, N, (int)gridDim.x, (int)blockIdx.x);
    pg8::gemm_phase<Epi, pg8::StaticOrder, true, true>((PG8_LAS unsigned char*)lds, g, S, E);
    __syncthreads();
}
constexpr int NPHASE = 11;
template <int PH>
__device__ __forceinline__ void run_phase(const Params& p, int bid, int nb, float* lds) {
    asm volatile("" : "+s"(bid));
    if constexpr (PH == 0) ph_prep(p, bid, nb, lds);
    if constexpr (PH == 1) ph_modnorm(p, p.x, p.norm1_g, 0 * DM, 1 * DM, p.hb, bid, nb, lds);
    if constexpr (PH == 2) gemm_run(lds, p.hb, p.Wt1, NTOK, ZW, DM, pg8::EpiZG{p.ZG, p.b_bg});
    if constexpr (PH == 3) { ph_retprep(p, bid, nb, lds); ph_gmlp2(p, bid, nb, lds); }
    if constexpr (PH == 11) ph_ret2(p, bid, nb, lds);
    if constexpr (PH == 4) ph_gn(p, bid, nb, lds);
    if constexpr (PH == 5) {
        gemm_run(lds, p.yain, p.Wta, NTOK, DM, 1024, pg8::EpiMixB<0>{p.hb, p.ZG, 0});
        gemm_run(lds, p.ybin, p.Wtb, NTOK, DM, DM, pg8::EpiMixB<1>{p.hb, p.ZG, 2048});
    }
    if constexpr (PH == 6) gemm_run(lds, p.hb, p.Wto, NTOK, DM, DM, pg8::EpiResF{p.obuf, p.x, p.ada + 2 * DM});
    if constexpr (PH == 7) { ph_modnorm(p, p.obuf, p.norm2_g, 3 * DM, 4 * DM, p.hb, bid, nb, lds); if (nb != 256) ph_tabconv(p, bid, nb); }
    if constexpr (PH == 8) gemm_run(lds, p.hb, p.Wtq, NTOK, DM, DM, pg8::EpiF32{p.qbuf, DM});
    if constexpr (PH == 9) ph_topk2(p, p.qbuf, bid, nb, lds);
    if constexpr (PH == 10) ph_peer3(p, p.obuf, p.hb, bid, nb);
}

constexpr int MISC_OFF = 132 * 1024;
__global__ void __launch_bounds__(NTH) k_mega(Params p) {
    extern __shared__ __attribute__((aligned(16))) float lds[];
    const int bid = blockIdx.x, nb = gridDim.x;
    volatile LAS unsigned* misc = (volatile LAS unsigned*)((LAS unsigned char*)lds + MISC_OFF);
    if (threadIdx.x < 4) misc[threadIdx.x] = 0u;
    __syncthreads();
    XcdBarrier bar = xcd_barrier_post(p.bar, misc);
    run_phase<0>(p, bid, nb, lds); xcd_barrier(bar);
    run_phase<1>(p, bid, nb, lds); xcd_barrier(bar);
    run_phase<2>(p, bid, nb, lds); xcd_barrier(bar);
    run_phase<3>(p, bid, nb, lds); xcd_barrier(bar);
    run_phase<11>(p, bid, nb, lds); xcd_barrier(bar);
    run_phase<4>(p, bid, nb, lds); xcd_barrier(bar);
    run_phase<5>(p, bid, nb, lds); xcd_barrier(bar);
    run_phase<6>(p, bid, nb, lds); xcd_barrier(bar);
    run_phase<7>(p, bid, nb, lds); xcd_barrier(bar);
    run_phase<8>(p, bid, nb, lds); xcd_barrier(bar);
    run_phase<9>(p, bid, nb, lds); xcd_barrier(bar);
    run_phase<10>(p, bid, nb, lds);
}

extern "C" void kernel_launch(void* const* d_in, const int* in_sizes, int n_in, void* d_out, int out_size, void* d_ws, size_t ws_size, hipStream_t stream) {
    Params p{};
    p.x = (const float*)d_in[0]; p.c = (const float*)d_in[1]; p.pos = (const int*)d_in[2];
    p.w_ada = (const float*)d_in[3]; p.b_ada = (const float*)d_in[4]; p.norm1_g = (const float*)d_in[5]; p.w_in = (const float*)d_in[6];
    p.w_bg = (const float*)d_in[7]; p.b_bg = (const float*)d_in[8]; p.gm_v_g = (const float*)d_in[9]; p.gm_ws = (const float*)d_in[10];
    p.gm_b = (const float*)d_in[11]; p.ret_gn_g = (const float*)d_in[12]; p.w_a_out = (const float*)d_in[13]; p.w_b_out = (const float*)d_in[14];
    p.w_o = (const float*)d_in[15]; p.norm2_g = (const float*)d_in[16]; p.peer_wq = (const float*)d_in[17]; p.peer_sk = (const float*)d_in[18];
    p.peer_u = (const float*)d_in[19]; p.peer_v = (const float*)d_in[20]; p.norm_f_g = (const float*)d_in[21];
    p.out = (float*)d_out;
    char* w = (char*)d_ws; size_t off = 0;
    auto take = [&](size_t bytes) { char* r = w + off; off += (bytes + 255) & ~(size_t)255; return r; };
    p.bar = (unsigned*)take(XCD_BAR_WORDS * 4);
    p.ada = (float*)take(2 * NMOD * 4);
    p.rope = (float*)take((size_t)NTOK * 128 * 4);
    p.eidx = (int*)take((size_t)NTOK * 128 * 4);
    p.gatev = (float*)take((size_t)NTOK * 128 * 4);
    p.Wt1 = (bf16_t*)take((size_t)ZW * DM * 2);
    p.Wta = (bf16_t*)take((size_t)DM * 1024 * 2);
    p.Wtb = (bf16_t*)take((size_t)DM * DM * 2);
    p.Wto = (bf16_t*)take((size_t)DM * DM * 2);
    p.Wtq = (bf16_t*)take((size_t)DM * DM * 2);
    p.hb = (bf16_t*)take((size_t)NTOK * DM * 2);
    p.ZG = (bf16_t*)take((size_t)NTOK * ZW * 2);
    p.qbuf = (float*)p.ZG;
    p.obuf = (float*)take((size_t)NTOK * DM * 4);
    p.ybin = (bf16_t*)take((size_t)NTOK * DM * 2);
    p.yain = (bf16_t*)take((size_t)NTOK * 1024 * 2);
    p.U8 = (unsigned char*)p.ZG + (size_t)NTOK * DM * 4;
    p.V8 = p.U8 + (size_t)16384 * ROW6;
    p.su = (float*)take(16384 * 4); p.sv = (float*)take(16384 * 4);
    p.Qr = (bf16_t*)take((size_t)NTOK * 1024 * 2);
    p.Pm = (bf16_t*)take((size_t)16 * 64 * 4096 * 2);
    p.KTd = (bf16_t*)take((size_t)NTOK * 1024 * 2);
    p.Vt = (bf16_t*)take((size_t)NTOK * 2048 * 2);
    p.ob16 = (bf16_t*)take((size_t)NTOK * DM * 2);
    if (off > ws_size) { fprintf(stderr, "kernel_launch: workspace too small: need %zu have %zu\n", off, ws_size); return; }
    static int grid = 0;
    if (!grid) {
        int dev = 0, cus = 0, per_cu = 0;
        (void)hipGetDevice(&dev); (void)hipDeviceGetAttribute(&cus, hipDeviceAttributeMultiprocessorCount, dev);
        (void)hipFuncSetAttribute((const void*)k_mega, hipFuncAttributeMaxDynamicSharedMemorySize, LDS_BYTES);
        (void)hipOccupancyMaxActiveBlocksPerMultiprocessor(&per_cu, k_mega, NTH, LDS_BYTES);
        (void)per_cu;
        grid = cus;
    }
    (void)hipMemsetAsync(p.bar, 0, XCD_BAR_WORDS * 4, stream);
    hipLaunchKernelGGL(k_mega, dim3(grid), dim3(NTH), LDS_BYTES, stream, p);
    hipError_t e = hipPeekAtLastError();
    if (e != hipSuccess) fprintf(stderr, "launch failed: %s (grid %d)\n", hipGetErrorString(e), grid);
}
```

```cpp
#include <hip/hip_runtime.h>
#include <hip/hip_cooperative_groups.h>
#include <stdint.h>
#include <math.h>
#include <cstdio>

namespace cg = cooperative_groups;

constexpr int DM = 2048;
constexpr int SQ = 4096;
constexpr int NTOK = 8192;
constexpr int NTH = 512;
constexpr int ZW = 12288;
constexpr int NMOD = 12288;
constexpr int LDS_BYTES = 136 * 1024;

typedef unsigned short bf16_t;

struct Params {
    const float *x, *c; const int* pos;
    const float *w_ada, *b_ada, *norm1_g, *w_in, *w_bg, *b_bg, *gm_v_g, *gm_ws, *gm_b, *ret_gn_g, *w_a_out, *w_b_out, *w_o, *norm2_g,
                *peer_wq, *peer_sk, *peer_u, *peer_v, *norm_f_g;
    float* out;
    float *ada, *rope, *gatev; int* eidx;
    bf16_t *Wt1, *Wta, *Wtb, *Wto, *Wtq;
    bf16_t *hb;
    bf16_t *ZG;
    float *obuf;
    bf16_t *ybin, *yain;
    float *qbuf;
    unsigned char *U8, *V8;
    float *su, *sv;
    bf16_t *Qr, *Pm, *KTd, *Vt;
    bf16_t *ob16;
    unsigned *bar;
};

__constant__ float c_freq[64] = {
1.000000000e+00f, 8.659643531e-01f, 7.498942018e-01f, 6.493816376e-01f, 5.623413324e-01f, 4.869675338e-01f, 4.216965139e-01f, 3.651741147e-01f, 3.162277639e-01f, 2.738419771e-01f, 2.371373773e-01f, 2.053525001e-01f, 1.778279394e-01f, 1.539926529e-01f, 1.333521456e-01f, 1.154781953e-01f, 1.000000015e-01f, 8.659642935e-02f, 7.498942316e-02f, 6.493816525e-02f, 5.623413250e-02f, 4.869675264e-02f, 4.216964915e-02f, 3.651741147e-02f, 3.162277490e-02f, 2.738419548e-02f, 2.371373773e-02f, 2.053525113e-02f, 1.778279431e-02f, 1.539926510e-02f, 1.333521400e-02f, 1.154781971e-02f, 9.999999776e-03f, 8.659643121e-03f, 7.498942316e-03f, 6.493816152e-03f, 5.623413250e-03f, 4.869675264e-03f, 4.216964822e-03f, 3.651741194e-03f, 3.162277630e-03f, 2.738419687e-03f, 2.371373819e-03f, 2.053525066e-03f, 1.778279431e-03f, 1.539926510e-03f, 1.333521446e-03f, 1.154782018e-03f, 1.000000047e-03f, 8.659643354e-04f, 7.498941850e-04f, 6.493816036e-04f, 5.623413017e-04f, 4.869675322e-04f, 4.216965172e-04f, 3.651741135e-04f, 3.162277571e-04f, 2.738419571e-04f, 2.371373703e-04f, 2.053525095e-04f, 1.778279402e-04f, 1.539926598e-04f, 1.333521504e-04f, 1.154782003e-04f };

__device__ __forceinline__ int tid_() { int t = threadIdx.x; asm volatile("" : "+v"(t)); return t; }
template <int CTRL> __device__ __forceinline__ float dppf(float x) { return __uint_as_float((unsigned)__builtin_amdgcn_update_dpp(0, (int)__float_as_uint(x), CTRL, 0xf, 0xf, true)); }
__device__ __forceinline__ float row_sum16(float v) { v += dppf<0xB1>(v); v += dppf<0x4E>(v); v += dppf<0x141>(v); v += dppf<0x140>(v); return v; }
__device__ __forceinline__ float wave_sum(float v) { v = row_sum16(v); v += __shfl_xor(v, 16); v += __shfl_xor(v, 32); return v; }
__device__ __forceinline__ float wave_max(float v) {
    v = fmaxf(v, dppf<0xB1>(v)); v = fmaxf(v, dppf<0x4E>(v)); v = fmaxf(v, dppf<0x141>(v)); v = fmaxf(v, dppf<0x140>(v));
    v = fmaxf(v, __shfl_xor(v, 16)); v = fmaxf(v, __shfl_xor(v, 32)); return v;
}
__device__ __forceinline__ float sigmoidf_(float x) { return 1.0f / (1.0f + expf(-x)); }
__device__ __forceinline__ float siluf_(float x) { return x * sigmoidf_(x); }
__device__ __forceinline__ float geluf_(float x) { return 0.5f * x * (1.0f + erff(x * 0.70710678118654752f)); }
__device__ __forceinline__ float dot4(float4 a, float4 b) { return a.x * b.x + a.y * b.y + a.z * b.z + a.w * b.w; }
__device__ __forceinline__ float bf2f(bf16_t v) { return __uint_as_float((unsigned)v << 16); }
__device__ __forceinline__ float bflo(unsigned w) { return __uint_as_float(w << 16); }
__device__ __forceinline__ float bfhi(unsigned w) { return __uint_as_float(w & 0xffff0000u); }
__device__ __forceinline__ unsigned f2bf(float f) { unsigned u = __float_as_uint(f); return (u + 0x7fffu + ((u >> 16) & 1u)) >> 16; }
__device__ __forceinline__ unsigned pk2(float lo, float hi) { return f2bf(lo) | (f2bf(hi) << 16); }

__device__ __forceinline__ void st_wt8(void* ptr, uint2 v) { __hip_atomic_store((unsigned long long*)ptr, ((unsigned long long)v.y << 32) | v.x, __ATOMIC_RELAXED, __HIP_MEMORY_SCOPE_AGENT); }
__device__ __forceinline__ void sincos_acc(float ang, float& s, float& c) {
    const double x = (double)ang;
    const double k = rint(x * 0.63661977236758134308);
    double r = fma(-k, 1.57079632679489655800, x); r = fma(-k, 6.12323399573676603587e-17, r);
    const double r2 = r * r;
    const double sp = r * (1.0 + r2 * (-1.0 / 6.0 + r2 * (1.0 / 120.0 + r2 * (-1.0 / 5040.0 + r2 * (1.0 / 362880.0 + r2 * (-1.0 / 39916800.0 + r2 * (1.0 / 6227020800.0)))))));
    const double cp = 1.0 + r2 * (-0.5 + r2 * (1.0 / 24.0 + r2 * (-1.0 / 720.0 + r2 * (1.0 / 40320.0 + r2 * (-1.0 / 3628800.0 + r2 * (1.0 / 479001600.0 + r2 * (-1.0 / 87178291200.0)))))));
    const int q = ((int)k) & 3;
    const float fs = (float)sp, fc = (float)cp;
    s = (q == 0) ? fs : (q == 1) ? fc : (q == 2) ? -fs : -fc;
    c = (q == 0) ? fc : (q == 1) ? -fs : (q == 2) ? -fc : fs;
}

namespace pg8 {
#define PG8_LAS __attribute__((address_space(3)))
typedef unsigned short bf16_t;
typedef short bf16x8 __attribute__((ext_vector_type(8)));
typedef float f32x4 __attribute__((ext_vector_type(4)));
typedef unsigned u32x4 __attribute__((ext_vector_type(4)));
constexpr int BM = 256, BK = 64, HALF = 128, HTB = HALF * BK * 2  , STAGE_BYTES = 8 * HTB, NXCD = 8, WGM = 8;

__host__ __device__ __forceinline__ int lds_byte(int r, int c) { const int st = (r >> 4) * 2 + (c >> 5), rr = r & 15, cc = c & 31, ob = rr * 64 + cc * 2; return st * 1024 + (ob ^ (((ob >> 9) & 1) << 5)); }
__host__ __device__ __forceinline__ void stage_rc(int b, int& R, int& C) { const int st = b / 1024, sb = b % 1024, swz = sb ^ (((sb >> 9) & 1) << 5); R = (st >> 1) * 16 + swz / 64; C = (st & 1) * 32 + (swz % 64) / 2; }
__host__ __device__ __forceinline__ int perm32(int rho) { const int n = rho >> 4, i = rho & 15; return 8 * (i >> 2) + 4 * n + (i & 3); }

struct Unit { int pm, pn; };
struct Gemm { const bf16_t* A; const bf16_t* Bt; int M, N, K; };

struct StaticOrder {
    int nM, nN, nwg, G, c;
    __host__ __device__ void init(int M, int N, int G_, int c_) { nM = M / BM; nN = N / BM; nwg = nM * nN; G = G_; c = c_; }
    __host__ __device__ bool next(int i, Unit& u) const {
        const long L = (long)i * G + c; if (L >= nwg) return false;
        int wgid = (int)L; { const int q = nwg / NXCD, r = nwg % NXCD, xcd = wgid % NXCD, off = wgid / NXCD; wgid = (xcd < r ? xcd * (q + 1) : r * (q + 1) + (xcd - r) * q) + off; }
        const int nig = WGM * nN, gid = wgid / nig, fm = gid * WGM, gsz = (nM - fm) < WGM ? (nM - fm) : WGM;
        u.pm = fm + ((wgid % nig) % gsz); u.pn = (wgid % nig) / gsz; return true;
    }
    __device__ __forceinline__ void a_ready(const Unit&) const {}
    __device__ __forceinline__ void done(const Unit&) const {}
};

__device__ __forceinline__ unsigned cvt_pk_bf16(float lo, float hi) { unsigned r; asm volatile("v_cvt_pk_bf16_f32 %0, %1, %2" : "=v"(r) : "v"(lo), "v"(hi)); return r; }
typedef float f32x2 __attribute__((ext_vector_type(2)));
__device__ __forceinline__ f32x2 gelu_pk(f32x2 v) {
    const f32x2 av = __builtin_elementwise_abs(v), d = av * 0.2316418882f + 1.0f;
    f32x2 t; t.x = __builtin_amdgcn_rcpf(d.x); t.y = __builtin_amdgcn_rcpf(d.y);
    f32x2 q = t * 0.5307027145f + (-0.7265760135f); q = q * t + 0.7107068705f; q = q * t + (-0.142248368f); q = q * t + 0.127414796f; q = q * t;
    const f32x2 s = (v * v) * (-0.72134752044f);
    f32x2 e; e.x = __builtin_amdgcn_exp2f(s.x); e.y = __builtin_amdgcn_exp2f(s.y);
    const f32x2 m = v * (q * e), r = v - m;
    f32x2 o; o.x = v.x < 0.f ? m.x : r.x; o.y = v.y < 0.f ? m.y : r.y; return o;
}

typedef unsigned u32x2v __attribute__((ext_vector_type(2)));
struct EpiZG {
    static constexpr bool PERM = true, AFTER_DRAIN = false;
    bf16_t* O; const float* bias;
    __device__ __forceinline__ void operator()(const f32x4 (&acc)[2][2][4][2], const Unit& u, int wr, int wc, int fr, int fq) const {
        const int row0 = u.pm * BM + wr * 64 + fr, col0 = u.pn * BM + wc * 32 + 8 * fq;
        const int mode = u.pn < 8 ? 1 : (u.pn < 32 ? 0 : 2);
        f32x4 bv[2][2];
#pragma unroll
        for (int bj = 0; bj < 2; ++bj)
#pragma unroll
            for (int n = 0; n < 2; ++n) bv[bj][n] = (mode == 2) ? *(const f32x4*)(bias + (col0 - 8192) + bj * HALF + 4 * n) : (f32x4){0.f, 0.f, 0.f, 0.f};
#pragma unroll
        for (int ai = 0; ai < 2; ++ai)
#pragma unroll
            for (int m = 0; m < 4; ++m) { bf16_t* rowp = O + (size_t)(row0 + ai * HALF + m * 16) * ZW + col0;
#pragma unroll
                for (int bj = 0; bj < 2; ++bj) { f32x4 v0 = acc[ai][bj][m][0], v1 = acc[ai][bj][m][1];
                    if (mode == 1) { f32x2 a = gelu_pk((f32x2){v0[0], v0[1]}), b = gelu_pk((f32x2){v0[2], v0[3]}), c = gelu_pk((f32x2){v1[0], v1[1]}), d = gelu_pk((f32x2){v1[2], v1[3]});
                        v0 = (f32x4){a.x, a.y, b.x, b.y}; v1 = (f32x4){c.x, c.y, d.x, d.y}; }
                    if (mode == 2) { v0 = v0 + bv[bj][0]; v1 = v1 + bv[bj][1];
#pragma unroll
                        for (int e = 0; e < 4; ++e) { v0[e] = __builtin_amdgcn_rcpf(1.0f + __expf(-v0[e])); v1[e] = __builtin_amdgcn_rcpf(1.0f + __expf(-v1[e])); } }
                    u32x4 w; w.x = cvt_pk_bf16(v0[0], v0[1]); w.y = cvt_pk_bf16(v0[2], v0[3]); w.z = cvt_pk_bf16(v1[0], v1[1]); w.w = cvt_pk_bf16(v1[2], v1[3]);
                    *(u32x4*)(rowp + bj * HALF) = w; } }
    }
};
template <int ACCUM> struct EpiMixB {
    static constexpr bool PERM = true, AFTER_DRAIN = false;
    bf16_t* Mo; const bf16_t* ZGp; int goff;
    __device__ __forceinline__ void operator()(const f32x4 (&acc)[2][2][4][2], const Unit& u, int wr, int wc, int fr, int fq) const {
        const int row0 = u.pm * BM + wr * 64 + fr, col0 = u.pn * BM + wc * 32 + 8 * fq;
#pragma unroll
        for (int ai = 0; ai < 2; ++ai)
#pragma unroll
            for (int m = 0; m < 4; ++m) { const size_t row = (size_t)(row0 + ai * HALF + m * 16);
#pragma unroll
                for (int bj = 0; bj < 2; ++bj) { const f32x4 v0 = acc[ai][bj][m][0], v1 = acc[ai][bj][m][1];
                    const u32x4 g = *(const u32x4*)(ZGp + row * ZW + 8192 + goff + col0 + bj * HALF);
                    float o[8];
                    o[0] = bflo(g.x) * v0[0]; o[1] = bfhi(g.x) * v0[1]; o[2] = bflo(g.y) * v0[2]; o[3] = bfhi(g.y) * v0[3];
                    o[4] = bflo(g.z) * v1[0]; o[5] = bfhi(g.z) * v1[1]; o[6] = bflo(g.w) * v1[2]; o[7] = bfhi(g.w) * v1[3];
                    bf16_t* mp = Mo + row * DM + col0 + bj * HALF;
                    if (ACCUM) { const u32x4 old = *(const u32x4*)mp;
                        o[0] += bflo(old.x); o[1] += bfhi(old.x); o[2] += bflo(old.y); o[3] += bfhi(old.y); o[4] += bflo(old.z); o[5] += bfhi(old.z); o[6] += bflo(old.w); o[7] += bfhi(old.w); }
                    u32x4 w; w.x = cvt_pk_bf16(o[0], o[1]); w.y = cvt_pk_bf16(o[2], o[3]); w.z = cvt_pk_bf16(o[4], o[5]); w.w = cvt_pk_bf16(o[6], o[7]);
                    *(u32x4*)mp = w; } }
    }
};
struct EpiResF {
    static constexpr bool PERM = false, AFTER_DRAIN = false;
    float* x1; const float* x; const float* ga;
    __device__ __forceinline__ void operator()(const f32x4 (&acc)[2][2][4][2], const Unit& u, int wr, int wc, int fr, int fq) const {
        const int row0 = u.pm * BM + wr * 64 + fr, col0 = u.pn * BM + wc * 32 + 4 * fq;
        const int b = (u.pm * BM) / SQ;
        f32x4 gv[2][2];
#pragma unroll
        for (int bj = 0; bj < 2; ++bj)
#pragma unroll
            for (int n = 0; n < 2; ++n) gv[bj][n] = *(const f32x4*)(ga + b * NMOD + col0 + bj * HALF + n * 16);
#pragma unroll
        for (int ai = 0; ai < 2; ++ai)
#pragma unroll
            for (int m = 0; m < 4; ++m) { const size_t off = (size_t)(row0 + ai * HALF + m * 16) * DM + col0;
#pragma unroll
                for (int bj = 0; bj < 2; ++bj)
#pragma unroll
                    for (int n = 0; n < 2; ++n) { const f32x4 xv = *(const f32x4*)(x + off + bj * HALF + n * 16);
                        *(f32x4*)(x1 + off + bj * HALF + n * 16) = xv + gv[bj][n] * acc[ai][bj][m][n]; } }
    }
};
struct EpiF32 {
    static constexpr bool PERM = false, AFTER_DRAIN = false;
    float* O; int ldc;
    __device__ __forceinline__ void operator()(const f32x4 (&acc)[2][2][4][2], const Unit& u, int wr, int wc, int fr, int fq) const {
        const int row0 = u.pm * BM + wr * 64 + fr, col0 = u.pn * BM + wc * 32 + 4 * fq;
#pragma unroll
        for (int ai = 0; ai < 2; ++ai)
#pragma unroll
            for (int m = 0; m < 4; ++m) { const size_t off = (size_t)(row0 + ai * HALF + m * 16) * ldc + col0;
#pragma unroll
                for (int bj = 0; bj < 2; ++bj)
#pragma unroll
                    for (int n = 0; n < 2; ++n) *(f32x4*)(O + off + bj * HALF + n * 16) = acc[ai][bj][m][n]; }
    }
};

template <class Epi, class Sched, bool ALIGN_EPI = false, bool SP2 = false>
__device__ __forceinline__ void gemm_phase(PG8_LAS unsigned char* lds, const Gemm g, const Sched& S, const Epi& E) {
    const int tid = threadIdx.x, wid = __builtin_amdgcn_readfirstlane(tid >> 6), lane = tid & 63, wr = wid >> 2, wc = wid & 3, fr = lane & 15, fq = lane >> 4;
    const int K = g.K, nt = K / BK;
    unsigned voffA[2], voffB[2];
#pragma unroll
    for (int i = 0; i < 2; ++i) { int R, C; stage_rc(tid * 16 + i * 8192, R, C); const int Rb = Epi::PERM ? ((R & ~31) + perm32(R & 31)) : R;
        voffA[i] = (unsigned)(R * K + C) * 2u; voffB[i] = (unsigned)(Rb * K + C) * 2u; }
    const size_t kstep = (size_t)(BK * 2);
    const size_t hstep = (size_t)HALF * K * 2;
    const size_t tstep = 2 * hstep;
    const unsigned ldsw = (unsigned)wid * 1024u;
    const int aoff = lds_byte(wr * 64 + fr, fq * 8), boff = lds_byte(wc * 32 + fr, fq * 8);
#define PG8_SA(b, h) (((b) * 2 + (h)) * HTB)
#define PG8_SB(b, h) ((4 + (b) * 2 + (h)) * HTB)
#define PG8_STAGE(bufoff, gbase, voff) do { _Pragma("unroll") for (int _i = 0; _i < 2; ++_i) \
        __builtin_amdgcn_global_load_lds((const unsigned*)((const char*)(gbase) + (voff)[_i]), (PG8_LAS unsigned*)(lds + (bufoff) + ldsw + _i * 8192), 16, 0, 0); } while (0)
#define PG8_LDA(dst, b, h) do { _Pragma("unroll") for (int m = 0; m < 4; ++m) _Pragma("unroll") for (int k = 0; k < 2; ++k) dst[m][k] = *(const PG8_LAS bf16x8*)(lds + PG8_SA(b, h) + aoff + m * 2048 + k * 1024); } while (0)
#define PG8_LDB(dst, b, h) do { _Pragma("unroll") for (int n = 0; n < 2; ++n) _Pragma("unroll") for (int k = 0; k < 2; ++k) dst[n][k] = *(const PG8_LAS bf16x8*)(lds + PG8_SB(b, h) + boff + n * 2048 + k * 1024); } while (0)
#define PG8_MMA(ai, bj, At, Bt) do { __builtin_amdgcn_s_setprio(1); _Pragma("unroll") for (int m = 0; m < 4; ++m) _Pragma("unroll") for (int n = 0; n < 2; ++n) _Pragma("unroll") for (int k = 0; k < 2; ++k) \
        acc[ai][bj][m][n] = __builtin_amdgcn_mfma_f32_16x16x32_bf16(Bt[n][k], At[m][k], acc[ai][bj][m][n], 0, 0, 0); __builtin_amdgcn_s_setprio(0); } while (0)
#define PG8_WAIT_V(n) asm volatile("s_waitcnt vmcnt(" #n ")" ::: "memory")
#define PG8_WAIT_L(n) asm volatile("s_waitcnt lgkmcnt(" #n ")" ::: "memory")
#define PG8_BAR __builtin_amdgcn_s_barrier()
#define PG8_SCHED __builtin_amdgcn_sched_barrier(0)
    Unit cur, nxt; int ui = 0;
    if (!S.next(0, cur)) return;
    f32x4 acc[2][2][4][2];
#pragma unroll
    for (int a = 0; a < 2; ++a)
#pragma unroll
        for (int b = 0; b < 2; ++b)
#pragma unroll
            for (int m = 0; m < 4; ++m)
#pragma unroll
                for (int n = 0; n < 2; ++n) acc[a][b][m][n] = (f32x4){0.f, 0.f, 0.f, 0.f};
    bf16x8 At[4][2], B0[2][2], B1[2][2];
    const char* cA = (const char*)g.A + (size_t)cur.pm * tstep; const char* cB = (const char*)g.Bt + (size_t)cur.pn * tstep;
    S.a_ready(cur);
    if constexpr (SP2) {
        PG8_STAGE(PG8_SB(0, 0), cB, voffB); PG8_STAGE(PG8_SB(0, 1), cB + hstep, voffB); PG8_STAGE(PG8_SA(0, 0), cA, voffA); PG8_STAGE(PG8_SA(0, 1), cA + hstep, voffA);
        if (wr == 1) PG8_BAR;
        PG8_WAIT_V(2); PG8_BAR;
        PG8_STAGE(PG8_SB(1, 0), cB + kstep, voffB); PG8_STAGE(PG8_SA(1, 0), cA + kstep, voffA); PG8_STAGE(PG8_SB(1, 1), cB + hstep + kstep, voffB);
        PG8_WAIT_V(6); PG8_BAR;
    } else {
        PG8_STAGE(PG8_SB(0, 0), cB, voffB); PG8_STAGE(PG8_SA(0, 0), cA, voffA); PG8_STAGE(PG8_SB(0, 1), cB + hstep, voffB); PG8_STAGE(PG8_SA(0, 1), cA + hstep, voffA);
        if (wr == 1) PG8_BAR;
        PG8_WAIT_V(4); PG8_BAR;
        PG8_STAGE(PG8_SB(1, 0), cB + kstep, voffB); PG8_STAGE(PG8_SA(1, 0), cA + kstep, voffA); PG8_STAGE(PG8_SB(1, 1), cB + hstep + kstep, voffB);
        PG8_WAIT_V(6); PG8_BAR;
    }
    for (;;) {
        const bool has_next = S.next(ui + 1, nxt);
        const char* nA = has_next ? (const char*)g.A + (size_t)nxt.pm * tstep : cA; const char* nB = has_next ? (const char*)g.Bt + (size_t)nxt.pn * tstep : cB;
        for (int t = 0; t < nt; t += 2) {
            const bool last = (t == nt - 2);
            const char* a1 = cA + (size_t)(t + 1) * kstep;
            const char* a2 = last ? nA : cA + (size_t)(t + 2) * kstep; const char* b2 = last ? nB : cB + (size_t)(t + 2) * kstep;
            const char* a3 = a2 + kstep; const char* b3 = b2 + kstep;
            if (last && has_next) S.a_ready(nxt);
            if constexpr (SP2) {
            PG8_LDB(B0, 0, 0); PG8_LDB(B1, 0, 1); PG8_SCHED; PG8_LDA(At, 0, 0); PG8_STAGE(PG8_SA(1, 1), a1 + hstep, voffA);
            PG8_WAIT_V(8); PG8_WAIT_L(0); PG8_BAR; PG8_MMA(0, 0, At, B0); PG8_MMA(0, 1, At, B1); PG8_BAR; PG8_SCHED;
            PG8_LDA(At, 0, 1); PG8_STAGE(PG8_SB(0, 0), b2, voffB); PG8_STAGE(PG8_SB(0, 1), b2 + hstep, voffB); PG8_STAGE(PG8_SA(0, 0), a2, voffA);
            PG8_WAIT_V(8); PG8_WAIT_L(0); PG8_BAR; PG8_MMA(1, 0, At, B0); PG8_MMA(1, 1, At, B1); PG8_BAR; PG8_SCHED;
            PG8_LDB(B0, 1, 0); PG8_LDB(B1, 1, 1); PG8_SCHED; PG8_LDA(At, 1, 0); PG8_STAGE(PG8_SA(0, 1), a2 + hstep, voffA);
            PG8_WAIT_V(8); PG8_WAIT_L(0); PG8_BAR; PG8_MMA(0, 0, At, B0); PG8_MMA(0, 1, At, B1); PG8_BAR; PG8_SCHED;
            PG8_LDA(At, 1, 1); PG8_STAGE(PG8_SB(1, 0), b3, voffB); PG8_STAGE(PG8_SB(1, 1), b3 + hstep, voffB); PG8_STAGE(PG8_SA(1, 0), a3, voffA);
            PG8_WAIT_V(8); PG8_WAIT_L(0); PG8_BAR; PG8_MMA(1, 0, At, B0); PG8_MMA(1, 1, At, B1); PG8_BAR; PG8_SCHED;
            } else {
            PG8_LDB(B0, 0, 0); PG8_SCHED; PG8_LDA(At, 0, 0); PG8_STAGE(PG8_SA(1, 1), a1 + hstep, voffA);
            PG8_WAIT_L(8); PG8_BAR; PG8_WAIT_L(0); PG8_MMA(0, 0, At, B0); PG8_BAR; PG8_SCHED;
            PG8_LDB(B1, 0, 1); PG8_STAGE(PG8_SB(0, 0), b2, voffB);
            PG8_BAR; PG8_WAIT_L(0); PG8_MMA(0, 1, At, B1); PG8_BAR;
            PG8_LDA(At, 0, 1); PG8_STAGE(PG8_SA(0, 0), a2, voffA);
            PG8_BAR; PG8_WAIT_L(0); PG8_MMA(1, 0, At, B0); PG8_BAR; PG8_SCHED;
            PG8_STAGE(PG8_SB(0, 1), b2 + hstep, voffB);
            PG8_WAIT_V(6); PG8_BAR; PG8_MMA(1, 1, At, B1); PG8_BAR;
            PG8_LDB(B0, 1, 0); PG8_SCHED; PG8_LDA(At, 1, 0); PG8_STAGE(PG8_SA(0, 1), a2 + hstep, voffA);
            PG8_WAIT_L(8); PG8_BAR; PG8_WAIT_L(0); PG8_MMA(0, 0, At, B0); PG8_BAR; PG8_SCHED;
            PG8_LDB(B1, 1, 1); PG8_STAGE(PG8_SB(1, 0), b3, voffB);
            PG8_BAR; PG8_WAIT_L(0); PG8_MMA(0, 1, At, B1); PG8_BAR;
            PG8_LDA(At, 1, 1); PG8_STAGE(PG8_SA(1, 0), a3, voffA);
            PG8_BAR; PG8_WAIT_L(0); PG8_MMA(1, 0, At, B0); PG8_BAR; PG8_SCHED;
            PG8_STAGE(PG8_SB(1, 1), b3 + hstep, voffB);
            PG8_WAIT_V(6); PG8_BAR; PG8_MMA(1, 1, At, B1); PG8_BAR;
            }
        }
        if constexpr (ALIGN_EPI) { if (wr == 0) PG8_BAR; }
        if constexpr (!Epi::AFTER_DRAIN) { E(acc, cur, wr, wc, fr, fq); S.done(cur); }
        if (!has_next) break;
#pragma unroll
        for (int a = 0; a < 2; ++a)
#pragma unroll
            for (int b = 0; b < 2; ++b)
#pragma unroll
                for (int m = 0; m < 4; ++m)
#pragma unroll
                    for (int n = 0; n < 2; ++n) acc[a][b][m][n] = (f32x4){0.f, 0.f, 0.f, 0.f};
        cur = nxt; cA = nA; cB = nB; ++ui;
        if constexpr (ALIGN_EPI) { if (wr == 1) PG8_BAR; }
    }
    PG8_WAIT_V(0);
    if constexpr (!ALIGN_EPI) { if (wr == 0) PG8_BAR; }
    PG8_BAR;
    if constexpr (Epi::AFTER_DRAIN) { E.fused(acc, cur, wr, wc, fr, fq, lds, wid, lane); S.done(cur); }
#undef PG8_SA
#undef PG8_SB
#undef PG8_STAGE
#undef PG8_LDA
#undef PG8_LDB
#undef PG8_MMA
#undef PG8_WAIT_V
#undef PG8_WAIT_L
#undef PG8_BAR
#undef PG8_SCHED
}
}
using pg8::f32x4; using pg8::u32x4;

__device__ __forceinline__ void transpose_item(const float* W, int K, int N, bf16_t* WT, int row_off, float* scr, int item, int lane) {
    const int nblk = N / 32, kb = item / nblk, nbk = item % nblk, k0 = 64 * kb, n0 = 32 * nbk;
#pragma unroll 8
    for (int i = 0; i < 32; ++i) { const int kk = 2 * i + (lane >> 5); scr[kk * 33 + (lane & 31)] = W[(size_t)(k0 + kk) * N + n0 + (lane & 31)]; }
    asm volatile("s_waitcnt lgkmcnt(0)" ::: "memory");
    const int c = lane & 7;
#pragma unroll
    for (int j = 0; j < 4; ++j) { const int n = (lane >> 3) + 8 * j; const float* s = scr + (8 * c) * 33 + n;
        uint4 o; o.x = pk2(s[0 * 33], s[1 * 33]); o.y = pk2(s[2 * 33], s[3 * 33]); o.z = pk2(s[4 * 33], s[5 * 33]); o.w = pk2(s[6 * 33], s[7 * 33]);
        *(uint4*)(WT + (size_t)(row_off + n0 + n) * K + k0 + 8 * c) = o; }
    asm volatile("s_waitcnt lgkmcnt(0)" ::: "memory");
}
__device__ __forceinline__ void ph_prep(const Params& p, int bid, int nb, float* lds) {
    const int tid = tid_(), wave = tid >> 6, lane = tid & 63;
    {
        float* sl = lds;
        float* red = lds + 4096;
        for (int i = tid; i < 4096; i += NTH) sl[i] = siluf_(p.c[i]);
        __syncthreads();
        for (int it = bid; it < 192; it += nb) {
            const int c4 = tid & 15, kg = tid >> 4;
            const float* wp = p.w_ada + (size_t)kg * NMOD + it * 64 + c4 * 4;
            float a0[4] = {0.f, 0.f, 0.f, 0.f}, a1[4] = {0.f, 0.f, 0.f, 0.f};
#pragma unroll 8
            for (int i = 0; i < 64; ++i) {
                const int k = kg + 32 * i;
                const float4 w = *(const float4*)(wp + (size_t)(32 * i) * NMOD);
                const float s0 = sl[k], s1 = sl[2048 + k];
                a0[0] += s0 * w.x; a0[1] += s0 * w.y; a0[2] += s0 * w.z; a0[3] += s0 * w.w;
                a1[0] += s1 * w.x; a1[1] += s1 * w.y; a1[2] += s1 * w.z; a1[3] += s1 * w.w;
            }
            __syncthreads();
#pragma unroll
            for (int e = 0; e < 4; ++e) { red[(kg * 16 + c4) * 8 + e] = a0[e]; red[(kg * 16 + c4) * 8 + 4 + e] = a1[e]; }
            __syncthreads();
            if (tid < 128) {
                const int b = tid >> 6, col = tid & 63;
                float s = 0.f;
                for (int g = 0; g < 32; ++g) s += red[(g * 16 + (col >> 2)) * 8 + b * 4 + (col & 3)];
                p.ada[b * NMOD + it * 64 + col] = s + p.b_ada[it * 64 + col];
            }
        }
        __syncthreads();
    }
    for (int e = bid * NTH + tid; e < NTOK * 64; e += nb * NTH) {
        const int tok = e >> 6, j = e & 63;
        const float ang = (float)p.pos[tok] * c_freq[j];
        float s, c; sincos_acc(ang, s, c);
        p.rope[(size_t)e * 2] = c; p.rope[(size_t)e * 2 + 1] = s;
    }
    {
        float* scr = lds + wave * (64 * 33);
        const int gw = bid * 8 + wave, ngw = nb * 8;
        constexpr int I1 = 32 * 256, I2 = 32 * 128, I3 = 16 * 64, I4 = 32 * 64;
        constexpr int NIT = I1 + I2 + I3 + 3 * I4;
        for (int it = gw; it < NIT; it += ngw) {
            int r = it;
            if (r < I1) { transpose_item(p.w_in, 2048, 8192, p.Wt1, 0, scr, r, lane); continue; } r -= I1;
            if (r < I2) { transpose_item(p.w_bg, 2048, 4096, p.Wt1, 8192, scr, r, lane); continue; } r -= I2;
            if (r < I3) { transpose_item(p.w_a_out, 1024, 2048, p.Wta, 0, scr, r, lane); continue; } r -= I3;
            if (r < I4) { transpose_item(p.w_b_out, 2048, 2048, p.Wtb, 0, scr, r, lane); continue; } r -= I4;
            if (r < I4) { transpose_item(p.w_o, 2048, 2048, p.Wto, 0, scr, r, lane); continue; } r -= I4;
            transpose_item(p.peer_wq, 2048, 2048, p.Wtq, 0, scr, r, lane);
        }
    }
    __syncthreads();
}
constexpr int ROW6 = 1536;
typedef float f32x32_t __attribute__((ext_vector_type(32)));
typedef unsigned u32x6_t __attribute__((ext_vector_type(6)));
__device__ __forceinline__ void tc_load(const Params& p, int r, int lane, float4 (&t)[8]) {
    const bool second = r >= 16384; const int row = second ? r - 16384 : r;
    const float* src = (second ? p.peer_v : p.peer_u) + (size_t)row * DM + lane * 4;
#pragma unroll
    for (int q = 0; q < 8; ++q) t[q] = *(const float4*)(src + 256 * q);
}
__device__ __forceinline__ void tc_finish(const Params& p, int r, int lane, const float4 (&t)[8]) {
    const bool second = r >= 16384; const int row = second ? r - 16384 : r;
    float am = 0.f;
#pragma unroll
    for (int q = 0; q < 8; ++q) am = fmaxf(am, fmaxf(fmaxf(fabsf(t[q].x), fabsf(t[q].y)), fmaxf(fabsf(t[q].z), fabsf(t[q].w))));
    am = wave_max(am);
    const float sc = (am > 0.f) ? am * (1.0f / 7.5f) : 1.0f, inv = (am > 0.f) ? 7.5f / am : 1.0f;
    typedef float f32x16_t __attribute__((ext_vector_type(16)));
    f32x16_t ev, od;
#pragma unroll
    for (int q = 0; q < 8; ++q) { ev[2 * q] = t[q].x * inv; od[2 * q] = t[q].y * inv; ev[2 * q + 1] = t[q].z * inv; od[2 * q + 1] = t[q].w * inv; }
    const u32x6_t w = __builtin_amdgcn_cvt_scalef32_2xpk16_fp6_f32(ev, od, 1.0f);
    unsigned char* dst = (second ? p.V8 : p.U8) + (size_t)row * ROW6 + lane * 8;
    *(uint2*)(dst) = make_uint2(w[0], w[1]); *(uint2*)(dst + 512) = make_uint2(w[2], w[3]); *(uint2*)(dst + 1024) = make_uint2(w[4], w[5]);
    if (lane == 0) (second ? p.sv : p.su)[row] = sc;
}
__device__ __forceinline__ void ph_tabconv(const Params& p, int bid, int nb) {
    const int tid = tid_(), wave = tid >> 6, lane = tid & 63;
    for (int r = bid * 8 + wave; r < 2 * 16384; r += nb * 8) { float4 t[8]; tc_load(p, r, lane, t); tc_finish(p, r, lane, t); }
}

__device__ __forceinline__ void ph_modnorm(const Params& p, const float* xin, const float* g, int sh_off, int sc_off, bf16_t* hout, int bid, int nb, float* lds) {
    const int tid = tid_(), wave = tid >> 6, lane = tid & 63;
    const int stride = nb * 8;
    int row = bid * 8 + wave;
    float4 v[8], vn[8];
    if (row < NTOK) {
#pragma unroll
        for (int j = 0; j < 8; ++j) v[j] = ((const float4*)(xin + (size_t)row * DM))[lane + 64 * j];
    }
    for (; row < NTOK; row += stride) {
        const int nrow = row + stride;
        if (nrow < NTOK) {
#pragma unroll
            for (int j = 0; j < 8; ++j) vn[j] = ((const float4*)(xin + (size_t)nrow * DM))[lane + 64 * j];
        }
        const int b = row / SQ;
        float ss = 0.f;
#pragma unroll
        for (int j = 0; j < 8; ++j) ss += dot4(v[j], v[j]);
        ss = wave_sum(ss);
        const float rs = 1.0f / sqrtf(ss * (1.0f / DM) + 1e-6f);
#pragma unroll
        for (int j = 0; j < 8; ++j) {
            const int col = (lane + 64 * j) * 4;
            const float4 g4 = *(const float4*)(g + col);
            const float4 sc = *(const float4*)(p.ada + b * NMOD + sc_off + col);
            const float4 sh = *(const float4*)(p.ada + b * NMOD + sh_off + col);
            float4 o;
            o.x = v[j].x * rs * g4.x * (1.0f + sc.x) + sh.x; o.y = v[j].y * rs * g4.y * (1.0f + sc.y) + sh.y;
            o.z = v[j].z * rs * g4.z * (1.0f + sc.z) + sh.z; o.w = v[j].w * rs * g4.w * (1.0f + sc.w) + sh.w;
            st_wt8(hout + (size_t)row * DM + col, make_uint2(pk2(o.x, o.y), pk2(o.z, o.w)));
        }
#pragma unroll
        for (int j = 0; j < 8; ++j) v[j] = vn[j];
    }
}

typedef short bf16x8_t __attribute__((ext_vector_type(8)));
typedef float f32x4_t __attribute__((ext_vector_type(4)));
__device__ __forceinline__ bf16x8_t ldfrag(const char* base, int row, int chunk, int rb, int sm) { return *(const bf16x8_t*)(base + row * rb + ((chunk ^ (row & sm)) << 4)); }
__device__ __forceinline__ void ph_gmlp2(const Params& p, int bid, int nb, float* lds) {
    char* WM = (char*)lds; char* VT = WM + 32768;
    const int tid = tid_(), wave = tid >> 6, lane = tid & 63, fr = lane & 15, fq = lane >> 4;
    int gl = -1;
    for (int it = bid; it < 512; it += nb) {
        const int g = it & 7, n = (it >> 3) & 31, b = it >> 8;
        const int tok0 = b * SQ + n * 128;
        __syncthreads();
        if (g != gl) {
            for (int u = tid; u < 2048; u += NTH) {
                const int i = u >> 4, c = u & 15;
                const float4* src = (const float4*)(p.gm_ws + (size_t)g * 16384 + i * 128 + c * 8);
                float4 a = src[0], b4 = src[1];
                if ((i >> 6) < (c >> 3)) { a = make_float4(0.f, 0.f, 0.f, 0.f); b4 = a; }
                *(uint4*)(WM + i * 256 + ((c ^ (i & 15)) << 4)) = make_uint4(pk2(a.x, a.y), pk2(a.z, a.w), pk2(b4.x, b4.y), pk2(b4.z, b4.w));
            }
            gl = g;
        }
        {
            const float2 gn = *(const float2*)(p.gm_v_g + g * 128 + lane * 2);
#pragma unroll 4
            for (int jj = 0; jj < 16; ++jj) {
                const int j = wave * 16 + jj;
                const unsigned w = *(const unsigned*)(p.ZG + (size_t)(tok0 + j) * ZW + 1024 + g * 128 + lane * 2);
                const float a = bflo(w), c2 = bfhi(w);
                const float ss = wave_sum(a * a + c2 * c2);
                const float rs = 1.0f / sqrtf(ss * (1.0f / 128.0f) + 1e-6f);
                const int d0 = lane * 2, d1 = d0 + 1;
                *(bf16_t*)(VT + d0 * 256 + (((j >> 3) ^ (d0 & 15)) << 4) + (j & 7) * 2) = (bf16_t)f2bf(a * rs * gn.x);
                *(bf16_t*)(VT + d1 * 256 + (((j >> 3) ^ (d1 & 15)) << 4) + (j & 7) * 2) = (bf16_t)f2bf(c2 * rs * gn.y);
            }
        }
        __syncthreads();
        {
            bf16x8_t A[4];
#pragma unroll
            for (int ks = 0; ks < 4; ++ks) A[ks] = ldfrag(VT, wave * 16 + fr, ks * 4 + fq, 256, 15);
            const int d0 = wave * 16 + fq * 4;
#pragma unroll
            for (int itl = 0; itl < 8; ++itl) {
                f32x4_t acc = {0.f, 0.f, 0.f, 0.f};
#pragma unroll
                for (int ks = 0; ks < 4; ++ks) if (itl >= 4 || ks < 2) acc = __builtin_amdgcn_mfma_f32_16x16x32_bf16(A[ks], ldfrag(WM, itl * 16 + fr, ks * 4 + fq, 256, 15), acc, 0, 0, 0);
                const int i = itl * 16 + fr;
                const float bias = p.gm_b[g * 128 + i];
                const size_t tok = (size_t)(tok0 + i);
                const uint2 uw = *(const uint2*)(p.ZG + tok * ZW + g * 128 + d0);
                *(uint2*)(p.yain + tok * 1024 + g * 128 + d0) = make_uint2(pk2(bflo(uw.x) * (acc[0] + bias), bfhi(uw.x) * (acc[1] + bias)), pk2(bflo(uw.y) * (acc[2] + bias), bfhi(uw.y) * (acc[3] + bias)));
            }
        }
    }
    __syncthreads();
}

__device__ __forceinline__ void ph_ret(const Params& p, int bid, int nb, float* lds) {
    float* Qs = lds;
    float* Ks = Qs + 64 * 129;
    float* Vs = Ks + 64 * 129;
    float* Ss = Vs + 64 * 16;
    float* At = Ss + 128 * 16;
    float* kd = At + 64 * 65;
    const int tid = tid_();
    const bf16_t* z = p.ZG;
    for (int it = bid; it < 256; it += nb) {
        const int vs = it & 15, h = (it >> 4) & 7, b = it >> 7;
        const float lg = log1pf(-exp2f(-5.0f - (float)h));
        const float cdec = expf(lg * 64.0f);
        __syncthreads();
        for (int i = tid; i < 2048; i += NTH) Ss[i] = 0.f;
        if (tid < 64) kd[tid] = expf(lg * (float)(63 - tid));
        for (int n = 0; n < 64; ++n) {
            const int tok0 = b * SQ + n * 64;
            __syncthreads();
            for (int e = tid; e < 4096; e += NTH) {
                const int i = e >> 6, dd = e & 63; const size_t tok = (size_t)(tok0 + i);
                const float cs = p.rope[(tok * 64 + dd) * 2], sn = p.rope[(tok * 64 + dd) * 2 + 1];
                const bf16_t* zr = z + tok * ZW;
                const float q1 = bf2f(zr[2048 + h * 128 + dd]), q2 = bf2f(zr[2048 + h * 128 + 64 + dd]);
                const float k1 = bf2f(zr[3072 + h * 128 + dd]), k2 = bf2f(zr[3072 + h * 128 + 64 + dd]);
                Qs[i * 129 + dd] = q1 * cs - q2 * sn; Qs[i * 129 + 64 + dd] = q1 * sn + q2 * cs;
                const float sc = 0.08838834764831845f;
                Ks[i * 129 + dd] = (k1 * cs - k2 * sn) * sc; Ks[i * 129 + 64 + dd] = (k1 * sn + k2 * cs) * sc;
            }
            for (int e = tid; e < 1024; e += NTH) { const int j = e >> 4, v = e & 15; Vs[e] = bf2f(z[(size_t)(tok0 + j) * ZW + 4096 + h * 256 + vs * 16 + v]); }
            __syncthreads();
            {
                const int j = tid & 63, i0 = (tid >> 6) * 8;
                float acc[8];
#pragma unroll
                for (int ii = 0; ii < 8; ++ii) acc[ii] = 0.f;
                for (int d = 0; d < 128; ++d) {
                    const float kv = Ks[j * 129 + d];
#pragma unroll
                    for (int ii = 0; ii < 8; ++ii) acc[ii] += Qs[(i0 + ii) * 129 + d] * kv;
                }
#pragma unroll
                for (int ii = 0; ii < 8; ++ii) { const int i = i0 + ii; At[i * 65 + j] = acc[ii] * expf(lg * fabsf((float)(i - j))); }
            }
            __syncthreads();
            {
                const int v = tid & 15, i0 = tid >> 4;
#pragma unroll
                for (int rep = 0; rep < 2; ++rep) {
                    const int i = i0 + 32 * rep;
                    float a = 0.f; for (int j = 0; j < 64; ++j) a += At[i * 65 + j] * Vs[j * 16 + v];
                    float c2 = 0.f; for (int d = 0; d < 128; ++d) c2 += Qs[i * 129 + d] * Ss[d * 16 + v];
                    p.obuf[(size_t)(tok0 + i) * DM + h * 256 + vs * 16 + v] = a + c2 * expf(lg * (float)(i + 1));
                }
            }
            __syncthreads();
            {
                const int v = tid & 15, d0 = tid >> 4;
#pragma unroll
                for (int rep = 0; rep < 4; ++rep) {
                    const int d = d0 + 32 * rep;
                    float a = 0.f; for (int j = 0; j < 64; ++j) a += Ks[j * 129 + d] * kd[j] * Vs[j * 16 + v];
                    Ss[d * 16 + v] = Ss[d * 16 + v] * cdec + a;
                }
            }
        }
    }
    __syncthreads();
}


__device__ __forceinline__ void ph_retprep(const Params& p, int bid, int nb, float* lds) {
    bf16_t* Kl = (bf16_t*)lds;
    bf16_t* Vl = Kl + 64 * 132;
    char* Qm = (char*)(Vl + 64 * 264);
    char* Km = Qm + 16384;
    const int tid = tid_(), wave = tid >> 6, lane = tid & 63, fr = lane & 15, fq = lane >> 4;
    for (int it = bid; it < 1024; it += nb) {
        const int n = it & 63, h = (it >> 6) & 7, b = it >> 9;
        const int tok0 = b * SQ + n * 64;
        const size_t rowbase = (size_t)(b * 8 + h) * SQ + n * 64;
        const float lg = log1pf(-exp2f(-5.0f - (float)h));
        __syncthreads();
#pragma unroll
        for (int k = 0; k < 2; ++k) {
            const int u = tid + 512 * k, i = u >> 4, dd = (u & 15) * 4; const size_t tok = (size_t)(tok0 + i);
            const float4 r0 = *(const float4*)(p.rope + (tok * 64 + dd) * 2), r1 = *(const float4*)(p.rope + (tok * 64 + dd) * 2 + 4);
            const float cs[4] = {r0.x, r0.z, r1.x, r1.z}, sn[4] = {r0.y, r0.w, r1.y, r1.w};
            const bf16_t* zr = p.ZG + tok * ZW;
            const uint2 q1w = *(const uint2*)(zr + 2048 + h * 128 + dd), q2w = *(const uint2*)(zr + 2048 + h * 128 + 64 + dd);
            const uint2 k1w = *(const uint2*)(zr + 3072 + h * 128 + dd), k2w = *(const uint2*)(zr + 3072 + h * 128 + 64 + dd);
            const float q1[4] = {bflo(q1w.x), bfhi(q1w.x), bflo(q1w.y), bfhi(q1w.y)}, q2[4] = {bflo(q2w.x), bfhi(q2w.x), bflo(q2w.y), bfhi(q2w.y)};
            const float k1[4] = {bflo(k1w.x), bfhi(k1w.x), bflo(k1w.y), bfhi(k1w.y)}, k2[4] = {bflo(k2w.x), bfhi(k2w.x), bflo(k2w.y), bfhi(k2w.y)};
            const float sc = 0.08838834764831845f, kd = expf(lg * (float)(63 - i));
            float qa[4], qb[4], ka[4], kb[4];
#pragma unroll
            for (int e = 0; e < 4; ++e) { qa[e] = q1[e] * cs[e] - q2[e] * sn[e]; qb[e] = q1[e] * sn[e] + q2[e] * cs[e]; ka[e] = (k1[e] * cs[e] - k2[e] * sn[e]) * sc; kb[e] = (k1[e] * sn[e] + k2[e] * cs[e]) * sc; }
            const uint2 qaw = make_uint2(pk2(qa[0], qa[1]), pk2(qa[2], qa[3])), qbw = make_uint2(pk2(qb[0], qb[1]), pk2(qb[2], qb[3]));
            const uint2 kaw = make_uint2(pk2(ka[0], ka[1]), pk2(ka[2], ka[3])), kbw = make_uint2(pk2(kb[0], kb[1]), pk2(kb[2], kb[3]));
            *(uint2*)(p.Qr + (rowbase + i) * 128 + dd) = qaw; *(uint2*)(p.Qr + (rowbase + i) * 128 + 64 + dd) = qbw;
            const int c = dd >> 3, o8 = (dd & 7) * 2;
            *(uint2*)(Qm + i * 256 + ((c ^ (i & 15)) << 4) + o8) = qaw; *(uint2*)(Qm + i * 256 + (((c + 8) ^ (i & 15)) << 4) + o8) = qbw;
            *(uint2*)(Km + i * 256 + ((c ^ (i & 15)) << 4) + o8) = kaw; *(uint2*)(Km + i * 256 + (((c + 8) ^ (i & 15)) << 4) + o8) = kbw;
            *(uint2*)(Kl + i * 132 + dd) = make_uint2(pk2(ka[0] * kd, ka[1] * kd), pk2(ka[2] * kd, ka[3] * kd));
            *(uint2*)(Kl + i * 132 + 64 + dd) = make_uint2(pk2(kb[0] * kd, kb[1] * kd), pk2(kb[2] * kd, kb[3] * kd));
        }
#pragma unroll
        for (int k = 0; k < 4; ++k) {
            const int u = tid + 512 * k, j = u >> 5, c = u & 31;
            *(uint4*)(Vl + j * 264 + c * 8) = *(const uint4*)(p.ZG + (size_t)(tok0 + j) * ZW + 4096 + h * 256 + c * 8);
        }
        __syncthreads();
        {
            const int jt = wave >> 1, it0 = 2 * (wave & 1);
            f32x4_t s0 = {0.f, 0.f, 0.f, 0.f}, s1 = {0.f, 0.f, 0.f, 0.f};
#pragma unroll
            for (int ks = 0; ks < 4; ++ks) {
                const bf16x8_t a = ldfrag(Km, jt * 16 + fr, ks * 4 + fq, 256, 15);
                const bf16x8_t b0 = ldfrag(Qm, it0 * 16 + fr, ks * 4 + fq, 256, 15), b1 = ldfrag(Qm, (it0 + 1) * 16 + fr, ks * 4 + fq, 256, 15);
                s0 = __builtin_amdgcn_mfma_f32_16x16x32_bf16(a, b0, s0, 0, 0, 0);
                s1 = __builtin_amdgcn_mfma_f32_16x16x32_bf16(a, b1, s1, 0, 0, 0);
            }
            const int j0 = jt * 16 + fq * 4;
            bf16_t* pg = p.Pm + (size_t)it * 4096;
#pragma unroll
            for (int tt = 0; tt < 2; ++tt) {
                const int i = (it0 + tt) * 16 + fr; const f32x4_t sv4 = tt ? s1 : s0; float pv[4];
#pragma unroll
                for (int r = 0; r < 4; ++r) pv[r] = sv4[r] * __expf(lg * fabsf((float)(i - (j0 + r))));
                *(uint2*)(pg + i * 64 + j0) = make_uint2(pk2(pv[0], pv[1]), pk2(pv[2], pv[3]));
            }
        }
        bf16_t* kt = p.KTd + (size_t)it * 8192;
#pragma unroll
        for (int k = 0; k < 2; ++k) {
            const int u = tid + 512 * k, d = u & 127, jg = u >> 7;
            unsigned w[4];
#pragma unroll
            for (int q = 0; q < 4; ++q) w[q] = (unsigned)Kl[(jg * 8 + 2 * q) * 132 + d] | ((unsigned)Kl[(jg * 8 + 2 * q + 1) * 132 + d] << 16);
            *(uint4*)(kt + d * 64 + jg * 8) = make_uint4(w[0], w[1], w[2], w[3]);
        }
        bf16_t* vt = p.Vt + (size_t)it * 16384;
#pragma unroll
        for (int k = 0; k < 4; ++k) {
            const int u = tid + 512 * k, v = u & 255, jg = u >> 8;
            unsigned w[4];
#pragma unroll
            for (int q = 0; q < 4; ++q) w[q] = (unsigned)Vl[(jg * 8 + 2 * q) * 264 + v] | ((unsigned)Vl[(jg * 8 + 2 * q + 1) * 264 + v] << 16);
            *(uint4*)(vt + v * 64 + jg * 8) = make_uint4(w[0], w[1], w[2], w[3]);
        }
    }
    __syncthreads();
}

__device__ __forceinline__ void ph_ret2(const Params& p, int bid, int nb, float* lds) {
    char* L = (char*)lds;
    constexpr int OQ = 0, OKT = 16384, OPP = 32768, OVT = 40960, TILE = 43008, OST = 2 * TILE;
    const int tid = tid_(), wave = tid >> 6, lane = tid & 63, fr = lane & 15, fq = lane >> 4;
    for (int it = bid; it < 256; it += nb) {
        const int itm = ((it & 7) * 2 + (it >> 7)) * 16 + ((it >> 3) & 15);
        const int vs = itm & 15, h = (itm >> 4) & 7, b = itm >> 7;
        const float lg = log1pf(-exp2f(-5.0f - (float)h));
        const float cdec = expf(lg * 64.0f);
        const size_t bh = (size_t)(b * 8 + h);
        const char* gQ = (const char*)(p.Qr + bh * SQ * 128);
        const char* gKT = (const char*)(p.KTd + bh * 64 * 8192);
        const char* gP = (const char*)(p.Pm + bh * 64 * 4096);
        const char* gVt = (const char*)(p.Vt + bh * 64 * 16384) + vs * 16 * 128;
        int lq[2], lkt[2];
#pragma unroll
        for (int u = 0; u < 2; ++u) { const int ci = tid + 512 * u; const int r = ci >> 4, c = ci & 15; lq[u] = r * 256 + ((c ^ (r & 15)) << 4); const int d = ci >> 3, c8 = ci & 7; lkt[u] = d * 128 + ((c8 ^ (d & 7)) << 4); }
        const int lp = (tid >> 3) * 128 + (((tid & 7) ^ ((tid >> 3) & 7)) << 4);
        const int lv = lp;
        uint4 qA0, qA1, tA0, tA1, pA, vA = make_uint4(0u, 0u, 0u, 0u), qB0, qB1, tB0, tB1, pB, vB = make_uint4(0u, 0u, 0u, 0u);
#define RET_LOAD(X_, n_) do { const size_t o0 = (size_t)(n_) * 16384 + (size_t)tid * 16, o1 = o0 + 8192; \
        q##X_##0 = *(const uint4*)(gQ + o0); q##X_##1 = *(const uint4*)(gQ + o1); t##X_##0 = *(const uint4*)(gKT + o0); t##X_##1 = *(const uint4*)(gKT + o1); p##X_ = *(const uint4*)(gP + (size_t)(n_) * 8192 + tid * 16); \
        if (tid < 128) v##X_ = *(const uint4*)(gVt + (size_t)(n_) * 32768 + tid * 16); } while (0)
#define RET_WRITE(X_, buf_) do { char* B_ = L + (buf_) * TILE; \
        *(uint4*)(B_ + OQ + lq[0]) = q##X_##0; *(uint4*)(B_ + OQ + lq[1]) = q##X_##1; *(uint4*)(B_ + OKT + lkt[0]) = t##X_##0; *(uint4*)(B_ + OKT + lkt[1]) = t##X_##1; *(uint4*)(B_ + OPP + lp) = p##X_; \
        if (tid < 128) *(uint4*)(B_ + OVT + lv) = v##X_; } while (0)
        __syncthreads();
        for (int i = tid; i < 1024; i += NTH) ((unsigned*)(L + OST))[i] = 0u;
        RET_LOAD(A, 0); RET_WRITE(A, 0); RET_LOAD(B, 1);
        f32x4_t sacc[2] = {{0.f, 0.f, 0.f, 0.f}, {0.f, 0.f, 0.f, 0.f}};
#define RET_STEP(n_, cur_, LS_, WS_) do { const int n = (n_); constexpr int cur = (cur_); \
            __syncthreads();                                     \
            if (n + 2 < 64) RET_LOAD(LS_, n + 2); \
            const char* T = L + cur * TILE; \
            if (wave < 4) {     \
                const int itl = wave; \
                f32x4_t o1 = {0.f, 0.f, 0.f, 0.f}, o2 = {0.f, 0.f, 0.f, 0.f}; \
                _Pragma("unroll") for (int ks = 0; ks < 2; ++ks) o1 = __builtin_amdgcn_mfma_f32_16x16x32_bf16(ldfrag(T + OPP, itl * 16 + fr, ks * 4 + fq, 128, 7), ldfrag(T + OVT, fr, ks * 4 + fq, 128, 7), o1, 0, 0, 0); \
                _Pragma("unroll") for (int ks = 0; ks < 4; ++ks) o2 = __builtin_amdgcn_mfma_f32_16x16x32_bf16(ldfrag(T + OQ, itl * 16 + fr, ks * 4 + fq, 256, 15), ldfrag(L + OST + cur * 4096, fr, ks * 4 + fq, 256, 15), o2, 0, 0, 0); \
                _Pragma("unroll") for (int r = 0; r < 4; ++r) { const int i = itl * 16 + fq * 4 + r; \
                    p.ob16[(size_t)(b * SQ + n * 64 + i) * DM + h * 256 + vs * 16 + fr] = (bf16_t)f2bf(o1[r] + __expf(lg * (float)(i + 1)) * o2[r]); } \
            } else {            \
                _Pragma("unroll") for (int u = 0; u < 2; ++u) { \
                    const int dt = 2 * (wave - 4) + u; \
                    sacc[u] = sacc[u] * cdec; \
                    _Pragma("unroll") for (int ks = 0; ks < 2; ++ks) sacc[u] = __builtin_amdgcn_mfma_f32_16x16x32_bf16(ldfrag(T + OKT, dt * 16 + fr, ks * 4 + fq, 128, 7), ldfrag(T + OVT, fr, ks * 4 + fq, 128, 7), sacc[u], 0, 0, 0); \
                    *(uint2*)(L + OST + (cur ^ 1) * 4096 + fr * 256 + (((dt * 2 + (fq >> 1)) ^ fr) << 4) + (fq & 1) * 8) = make_uint2(pk2(sacc[u][0], sacc[u][1]), pk2(sacc[u][2], sacc[u][3])); } \
            } \
            if (n + 1 < 64) RET_WRITE(WS_, cur ^ 1); } while (0)
#pragma unroll 1
        for (int n2 = 0; n2 < 64; n2 += 2) { RET_STEP(n2, 0, A, B); RET_STEP(n2 + 1, 1, B, A); }
#undef RET_STEP
#undef RET_LOAD
#undef RET_WRITE
    }
    __syncthreads();
}

__device__ __forceinline__ void gn_load(const Params& p, int tok, int lane, uint2 (&ow)[8], uint2 (&gw)[8]) {
#pragma unroll
    for (int h = 0; h < 8; ++h) { ow[h] = *(const uint2*)(p.ob16 + (size_t)tok * DM + h * 256 + lane * 4); gw[h] = *(const uint2*)(p.ZG + (size_t)tok * ZW + 6144 + h * 256 + lane * 4); }
}
__device__ __forceinline__ void ph_gn(const Params& p, int bid, int nb, float* lds) {
    const int tid = tid_(), wave = tid >> 6, lane = tid & 63;
    const int stride = nb * 8;
    int tok = bid * 8 + wave;
    uint2 ow[8], gw[8], own[8], gwn[8];
    if (tok < NTOK) gn_load(p, tok, lane, ow, gw);
    for (; tok < NTOK; tok += stride) {
        if (tok + stride < NTOK) gn_load(p, tok + stride, lane, own, gwn);
        float4 o[8]; float s1[8], s2[8];
#pragma unroll
        for (int h = 0; h < 8; ++h) { o[h] = make_float4(bflo(ow[h].x), bfhi(ow[h].x), bflo(ow[h].y), bfhi(ow[h].y)); s1[h] = (o[h].x + o[h].y) + (o[h].z + o[h].w); }
#pragma unroll
        for (int h = 0; h < 8; ++h) s1[h] = row_sum16(s1[h]);
#pragma unroll
        for (int off = 16; off < 64; off <<= 1)
#pragma unroll
            for (int h = 0; h < 8; ++h) s1[h] += __shfl_xor(s1[h], off);
#pragma unroll
        for (int h = 0; h < 8; ++h) { const float mu = s1[h] * (1.0f / 256.0f); o[h].x -= mu; o[h].y -= mu; o[h].z -= mu; o[h].w -= mu; s2[h] = dot4(o[h], o[h]); }
#pragma unroll
        for (int h = 0; h < 8; ++h) s2[h] = row_sum16(s2[h]);
#pragma unroll
        for (int off = 16; off < 64; off <<= 1)
#pragma unroll
            for (int h = 0; h < 8; ++h) s2[h] += __shfl_xor(s2[h], off);
#pragma unroll
        for (int h = 0; h < 8; ++h) {
            const float rs = 1.0f / sqrtf(s2[h] * (1.0f / 256.0f) + 1e-6f);
            const float4 gn = *(const float4*)(p.ret_gn_g + h * 256 + lane * 4);
            const float g0 = bflo(gw[h].x), g1 = bfhi(gw[h].x), g2 = bflo(gw[h].y), g3 = bfhi(gw[h].y);
            st_wt8(p.ybin + (size_t)tok * DM + h * 256 + lane * 4,
                make_uint2(pk2(siluf_(g0) * o[h].x * rs * gn.x, siluf_(g1) * o[h].y * rs * gn.y), pk2(siluf_(g2) * o[h].z * rs * gn.z, siluf_(g3) * o[h].w * rs * gn.w)));
        }
#pragma unroll
        for (int h = 0; h < 8; ++h) { ow[h] = own[h]; gw[h] = gwn[h]; }
    }
}

__device__ __forceinline__ void split8(const float4 a, const float4 b, uint4& hi, uint4& lo) {
    const float x[8] = {a.x, a.y, a.z, a.w, b.x, b.y, b.z, b.w}; unsigned h[8], l[8];
#pragma unroll
    for (int i = 0; i < 8; ++i) { h[i] = f2bf(x[i]); l[i] = f2bf(x[i] - __uint_as_float(h[i] << 16)); }
    hi = make_uint4(h[0] | (h[1] << 16), h[2] | (h[3] << 16), h[4] | (h[5] << 16), h[6] | (h[7] << 16));
    lo = make_uint4(l[0] | (l[1] << 16), l[2] | (l[3] << 16), l[4] | (l[5] << 16), l[6] | (l[7] << 16));
}
__device__ __forceinline__ bf16x8_t as_bf16x8(const uint4 v) { return __builtin_bit_cast(bf16x8_t, v); }
struct PairTab { int a[52], b[52]; };
__host__ __device__ constexpr PairTab make_pairs() {
    PairTab t{}; int n = 0;
    for (int a = 0; a < 16; ++a) for (int b = 0; b < 16; ++b) if ((a + 1) * (b + 1) <= 16) { t.a[n] = a; t.b[n] = b; ++n; }
    for (; n < 52; ++n) { t.a[n] = -1; t.b[n] = -1; }
    return t;
}
constexpr PairTab PAIRS = make_pairs();
static_assert(PAIRS.a[49] >= 0 && PAIRS.a[50] < 0, "50 candidate pairs");

template <int N, int OFF> __device__ __forceinline__ void bitonic_sort_desc(float* v) {
#pragma unroll
    for (int k = 2; k <= N; k <<= 1)
#pragma unroll
        for (int j = k >> 1; j > 0; j >>= 1)
#pragma unroll
            for (int i = 0; i < N; ++i) { const int l = i ^ j; if (l > i) { const bool up = ((i & k) == 0);
                const float a = v[OFF + i], b = v[OFF + l]; const float mx = fmaxf(a, b), mn = fminf(a, b); v[OFF + i] = up ? mx : mn; v[OFF + l] = up ? mn : mx; } }
}
template <int N> __device__ __forceinline__ void bitonic_merge_desc(float* v) {
#pragma unroll
    for (int j = N >> 1; j > 0; j >>= 1)
#pragma unroll
        for (int i = 0; i < N; ++i) { const int l = i ^ j; if (l > i) { const float a = v[i], b = v[l]; v[i] = fmaxf(a, b); v[l] = fminf(a, b); } }
}
__device__ __forceinline__ void ph_topk2(const Params& p, const float* qb, int bid, int nb, float* lds) {
    const int tid = tid_(), wave = tid >> 6, lane = tid & 63;
    uint4* SK = (uint4*)lds;
    const float NEG = -INFINITY;
    const bool tc_on = (nb == 256); const int tcr0 = (bid * 8 + wave) * 16; float4 tct[8];
    if (tc_on) tc_load(p, tcr0, lane, tct);
    for (int it = bid; it < 256; it += nb) {
        const int h = it & 7, tg = it >> 3;
        __syncthreads();
        for (int gi = tid; gi < 4096; gi += NTH) {
            const int dq = gi & 15, n = (gi >> 4) & 127, pp = gi >> 11;
            const float4* src = (const float4*)(p.peer_sk + ((size_t)(h * 2 + pp) * 128 + n) * 128 + dq * 8);
            uint4 hi, lo; split8(src[0], src[1], hi, lo);
            const int base = (((pp * 8 + (n >> 4)) * 4 + (dq >> 2)) * 2) * 64 + (dq & 3) * 16 + (n & 15);
            SK[base] = hi; SK[base + 64] = lo;
        }
        __syncthreads();
#pragma unroll 1
        for (int tile = 0; tile < 2; ++tile) {
            const int tok = tg * 256 + wave * 32 + tile * 16 + (lane & 15);
            const int qd = lane >> 4;
            float v12[2][16];
#pragma unroll
            for (int pp = 0; pp < 2; ++pp) {
                if (tc_on) { const int ti = tile * 8 + pp * 4; tc_finish(p, tcr0 + ti, lane, tct); tc_load(p, tcr0 + ti + 1, lane, tct); }
                bf16x8_t Bh[4], Bl[4];
                const float* qp = qb + (size_t)tok * DM + h * 256 + pp * 128 + 8 * qd;
#pragma unroll
                for (int ks = 0; ks < 4; ++ks) { uint4 hi, lo; split8(*(const float4*)(qp + ks * 32), *(const float4*)(qp + ks * 32 + 4), hi, lo); Bh[ks] = as_bf16x8(hi); Bl[ks] = as_bf16x8(lo); }
                float v[32];
#pragma unroll
                for (int kt = 0; kt < 8; ++kt) {
                    f32x4_t acc = {0.f, 0.f, 0.f, 0.f};
#pragma unroll
                    for (int ks = 0; ks < 4; ++ks) {
                        const bf16x8_t Ah = as_bf16x8(SK[(((pp * 8 + kt) * 4 + ks) * 2) * 64 + lane]), Al = as_bf16x8(SK[(((pp * 8 + kt) * 4 + ks) * 2 + 1) * 64 + lane]);
                        acc = __builtin_amdgcn_mfma_f32_16x16x32_bf16(Ah, Bh[ks], acc, 0, 0, 0);
                        acc = __builtin_amdgcn_mfma_f32_16x16x32_bf16(Ah, Bl[ks], acc, 0, 0, 0);
                        acc = __builtin_amdgcn_mfma_f32_16x16x32_bf16(Al, Bh[ks], acc, 0, 0, 0);
                    }
#pragma unroll
                    for (int r = 0; r < 4; ++r) v[kt * 4 + r] = __uint_as_float((__float_as_uint(acc[r]) & ~127u) | (unsigned)(kt * 16 + qd * 4 + r));
                    __builtin_amdgcn_sched_barrier(0);
                }
                if (tc_on) { const int ti = tile * 8 + pp * 4 + 1; tc_finish(p, tcr0 + ti, lane, tct); tc_load(p, tcr0 + ti + 1, lane, tct); }
                bitonic_sort_desc<16, 0>(v); bitonic_sort_desc<16, 16>(v);
                float c16[16];
#pragma unroll
                for (int i = 0; i < 16; ++i) c16[i] = fmaxf(v[i], v[31 - i]);
                bitonic_merge_desc<16>(c16);
                if (tc_on) { const int ti = tile * 8 + pp * 4 + 2; tc_finish(p, tcr0 + ti, lane, tct); tc_load(p, tcr0 + ti + 1, lane, tct); }
#pragma unroll
                for (int st = 0; st < 2; ++st) {
                    float pr[16];
#pragma unroll
                    for (int i = 0; i < 16; ++i) pr[i] = __shfl_xor(c16[i], 16 << st);
#pragma unroll
                    for (int i = 0; i < 16; ++i) c16[i] = fmaxf(c16[i], pr[15 - i]);
                    bitonic_merge_desc<16>(c16);
                }
                if (tc_on) { const int ti = tile * 8 + pp * 4 + 3; tc_finish(p, tcr0 + ti, lane, tct); if (ti < 15) tc_load(p, tcr0 + ti + 1, lane, tct); }
#pragma unroll
                for (int i = 0; i < 16; ++i) v12[pp][i] = c16[i];
            }
            float c[13]; unsigned pay[13];
#pragma unroll
            for (int s = 0; s < 13; ++s) {
                float cq[4]; unsigned pq[4];
#pragma unroll
                for (int q = 0; q < 4; ++q) {
                    const int pi = 4 * s + q; const int a = PAIRS.a[pi], b = PAIRS.b[pi];
                    if (a >= 0) {
                        const float sum = v12[0][a] + v12[1][b];
                        cq[q] = __uint_as_float((__float_as_uint(sum) & ~63u) | (unsigned)pi);
                        pq[q] = (__float_as_uint(v12[0][a]) & 127u) * 128u + (__float_as_uint(v12[1][b]) & 127u);
                    } else { cq[q] = NEG; pq[q] = 0u; }
                }
                c[s] = qd == 0 ? cq[0] : qd == 1 ? cq[1] : qd == 2 ? cq[2] : cq[3];
                pay[s] = qd == 0 ? pq[0] : qd == 1 ? pq[1] : qd == 2 ? pq[2] : pq[3];
            }
            float top[16]; unsigned eid[16];
#pragma unroll
            for (int r = 0; r < 16; ++r) {
                float m = c[0];
#pragma unroll
                for (int s = 1; s < 13; ++s) m = fmaxf(m, c[s]);
                m = fmaxf(m, __shfl_xor(m, 16)); m = fmaxf(m, __shfl_xor(m, 32));
                unsigned pw = 0u;
#pragma unroll
                for (int s = 0; s < 13; ++s) { const bool eq = (c[s] == m); pw |= eq ? pay[s] : 0u; c[s] = eq ? NEG : c[s]; }
                pw |= (unsigned)__shfl_xor((int)pw, 16); pw |= (unsigned)__shfl_xor((int)pw, 32);
                top[r] = m; eid[r] = pw;
            }
            float sum = 0.f; const float mx = top[0];
#pragma unroll
            for (int r = 0; r < 16; ++r) { top[r] = expf(top[r] - mx); sum += top[r]; }
            const float inv = 1.0f / sum;
            if (lane < 16) {
                int4* ep = (int4*)(p.eidx + (size_t)tok * 128 + h * 16); float4* gp = (float4*)(p.gatev + (size_t)tok * 128 + h * 16);
#pragma unroll
                for (int q = 0; q < 4; ++q) {
                    ep[q] = make_int4((int)eid[4 * q], (int)eid[4 * q + 1], (int)eid[4 * q + 2], (int)eid[4 * q + 3]);
                    gp[q] = make_float4(top[4 * q] * inv, top[4 * q + 1] * inv, top[4 * q + 2] * inv, top[4 * q + 3] * inv);
                }
            }
        }
    }
    __syncthreads();
}

__device__ __forceinline__ void peer_load4(const unsigned char* tab, const int (&e)[4], int lane, uint2 (&R)[4][3]) {
#pragma unroll
    for (int i = 0; i < 4; ++i) { const uint2* r = (const uint2*)(tab + (size_t)e[i] * ROW6 + lane * 8); R[i][0] = r[0]; R[i][1] = r[64]; R[i][2] = r[128]; }
}
__device__ __forceinline__ f32x32_t dec6(const uint2 (&R)[3]) { const u32x6_t w = {R[0].x, R[0].y, R[1].x, R[1].y, R[2].x, R[2].y}; return __builtin_amdgcn_cvt_scalef32_pk32_f32_fp6(w, 1.0f); }
__device__ __forceinline__ void ph_peer3(const Params& p, const float* x1, const bf16_t* h2, int bid, int nb) {
    const int tid = tid_(), wave = tid >> 6, lane = tid & 63;
    for (int t = bid * 8 + wave; t < NTOK; t += nb * 8) {
        const int b = t / SQ;
        float hv[32], y[32];
#pragma unroll
        for (int q = 0; q < 8; ++q) { const uint2 w = *(const uint2*)(h2 + (size_t)t * DM + 256 * q + lane * 4); float* d = hv + 4 * q;
            d[0] = bflo(w.x); d[1] = bfhi(w.x); d[2] = bflo(w.y); d[3] = bfhi(w.y); }
#pragma unroll
        for (int i = 0; i < 32; ++i) y[i] = 0.f;
        const int e0 = p.eidx[(size_t)t * 128 + lane], e1 = p.eidx[(size_t)t * 128 + 64 + lane];
        const float g0 = p.gatev[(size_t)t * 128 + lane], g1 = p.gatev[(size_t)t * 128 + 64 + lane];
        const float su0 = p.su[e0], su1 = p.su[e1];
        const float gv0 = g0 * p.sv[e0], gv1 = g1 * p.sv[e1];
        uint2 Uc[4][3], Un[4][3], Vc[4][3];
        { int e[4];
#pragma unroll
          for (int i = 0; i < 4; ++i) e[i] = __builtin_amdgcn_readlane(e0, i);
          peer_load4(p.U8, e, lane, Uc); }
        for (int g = 0; g < 32; ++g) {
            const bool lo = g < 16; const int k0 = (4 * g) & 63;
            const int ee = lo ? e0 : e1; const float suu = lo ? su0 : su1, gvv = lo ? gv0 : gv1;
            int e[4]; float sa[4], gw[4];
#pragma unroll
            for (int i = 0; i < 4; ++i) { e[i] = __builtin_amdgcn_readlane(ee, k0 + i);
                sa[i] = __uint_as_float(__builtin_amdgcn_readlane(__float_as_uint(suu), k0 + i)); gw[i] = __uint_as_float(__builtin_amdgcn_readlane(__float_as_uint(gvv), k0 + i)); }
            peer_load4(p.V8, e, lane, Vc);
            {
                const int gn = (g < 31) ? g + 1 : g; const int en = (gn < 16) ? e0 : e1; const int kn = (4 * gn) & 63; int e2[4];
#pragma unroll
                for (int i = 0; i < 4; ++i) e2[i] = __builtin_amdgcn_readlane(en, kn + i);
                peer_load4(p.U8, e2, lane, Un);
            }
            float a[4];
#pragma unroll
            for (int i = 0; i < 4; ++i) {
                const f32x32_t d = dec6(Uc[i]);
                float acc0 = 0.f, acc1 = 0.f;
#pragma unroll
                for (int k = 0; k < 32; k += 2) { acc0 += d[k] * hv[k]; acc1 += d[k + 1] * hv[k + 1]; }
                a[i] = acc0 + acc1;
            }
#pragma unroll
            for (int i = 0; i < 4; ++i) a[i] = row_sum16(a[i]);
#pragma unroll
            for (int o = 16; o < 64; o <<= 1) { a[0] += __shfl_xor(a[0], o); a[1] += __shfl_xor(a[1], o); a[2] += __shfl_xor(a[2], o); a[3] += __shfl_xor(a[3], o); }
#pragma unroll
            for (int i = 0; i < 4; ++i) {
                const float wgt = geluf_(a[i] * sa[i]) * gw[i];
                const f32x32_t d = dec6(Vc[i]);
#pragma unroll
                for (int k = 0; k < 32; ++k) y[k] += wgt * d[k];
            }
#pragma unroll
            for (int i = 0; i < 4; ++i) { Uc[i][0] = Un[i][0]; Uc[i][1] = Un[i][1]; Uc[i][2] = Un[i][2]; }
        }
        float ss = 0.f;
#pragma unroll
        for (int q = 0; q < 8; ++q) {
            const int c = 256 * q + lane * 4;
            const float4 xv = *(const float4*)(x1 + (size_t)t * DM + c);
            const float4 ga = *(const float4*)(p.ada + b * NMOD + 5 * DM + c);
            float* yy = y + 4 * q;
            yy[0] = xv.x + ga.x * yy[0]; yy[1] = xv.y + ga.y * yy[1]; yy[2] = xv.z + ga.z * yy[2]; yy[3] = xv.w + ga.w * yy[3];
            ss += yy[0] * yy[0] + yy[1] * yy[1] + yy[2] * yy[2] + yy[3] * yy[3];
        }
        ss = wave_sum(ss);
        const float rs = 1.0f / sqrtf(ss * (1.0f / DM) + 1e-6f);
#pragma unroll
        for (int q = 0; q < 8; ++q) {
            const int c = 256 * q + lane * 4;
            const float4 gf = *(const float4*)(p.norm_f_g + c);
            const float* yy = y + 4 * q;
            *(float4*)(p.out + (size_t)t * DM + c) = make_float4(yy[0] * rs * gf.x, yy[1] * rs * gf.y, yy[2] * rs * gf.z, yy[3] * rs * gf.w);
        }
    }
}

#define LAS __attribute__((address_space(3)))
#define XB_TMO      128
#define XB_XCNT(j)  (256  + 64 * (j))
#define XB_XSUB(j)  (1280 + 64 * (j))
#define XB_XGEN(j)  (2304 + 64 * (j))
#define XB_TOP      3328
#define XB_TOPGEN   3392
#define XCD_BAR_WORDS 3456
#define XB_SPIN_CAP (1u << 18)

__device__ __forceinline__ unsigned xb_ld(unsigned* p)              { return __hip_atomic_load(p, __ATOMIC_RELAXED, __HIP_MEMORY_SCOPE_AGENT); }
__device__ __forceinline__ unsigned xb_add(unsigned* p, unsigned v) { return __hip_atomic_fetch_add(p, v, __ATOMIC_RELAXED, __HIP_MEMORY_SCOPE_AGENT); }
__device__ __forceinline__ unsigned xb_xcc_id() { return (unsigned)__builtin_amdgcn_s_getreg((3 << 11) | 20) & 0xFu; }
#define XB_SPIN(cond, bar) do { unsigned _sp = 0; while (cond) { __builtin_amdgcn_s_sleep(1); \
    if ((++_sp & 255u) == 0u) { if (xb_ld(&(bar)[XB_TMO])) break; if (_sp > XB_SPIN_CAP) { atomicAdd(&(bar)[XB_TMO], 1u); break; } } } } while (0)

struct XcdBarrier {
    unsigned* bar; unsigned x;
    volatile LAS unsigned* st;
};

__device__ __forceinline__ XcdBarrier xcd_barrier_post(unsigned* bar, volatile LAS unsigned* st) {
    XcdBarrier b; b.bar = bar; b.x = xb_xcc_id(); b.st = st;
    if (threadIdx.x == 0) (void)xb_add(&bar[XB_XCNT(b.x)], 1u);
    return b;
}
__device__ __forceinline__ void xcd_barrier_complete(unsigned* bar, unsigned x, unsigned& nloc, unsigned& nx) {
    const unsigned G = gridDim.x * gridDim.y * gridDim.z;
    unsigned sum, cnt, mine, sp = 0u;
    for (;;) {
        sum = 0u; cnt = 0u; mine = 0u;
#pragma unroll
        for (unsigned j = 0; j < 16; ++j) { const unsigned c = xb_ld(&bar[XB_XCNT(j)]); sum += c; cnt += (c > 0u) ? 1u : 0u; mine = (j == x) ? c : mine; }
        if (sum == G) break;
        __builtin_amdgcn_s_sleep(1);
        if ((++sp & 255u) == 0u) { if (xb_ld(&bar[XB_TMO])) break; if (sp > XB_SPIN_CAP) { atomicAdd(&bar[XB_TMO], 1u); break; } }
    }
    nloc = mine > 0u ? mine : 1u; nx = cnt > 0u ? cnt : 1u;
}

__device__ __forceinline__ void xcd_barrier(const XcdBarrier& b) {
    asm volatile("s_waitcnt vmcnt(0)" ::: "memory");
    __syncthreads();
    if (threadIdx.x == 0) {
        unsigned* bar = b.bar;
        __builtin_amdgcn_s_waitcnt(0);
        unsigned nloc = b.st[0], nx = b.st[1];
        if (nloc == 0u) { xcd_barrier_complete(bar, b.x, nloc, nx); b.st[0] = nloc; b.st[1] = nx; }
        const unsigned old = xb_add(&bar[XB_XSUB(b.x)], 1u);
        const unsigned gen = old / nloc;
        if (old + 1u == (gen + 1u) * nloc) {
            __builtin_amdgcn_fence(__ATOMIC_RELEASE, "agent");
            asm volatile("s_waitcnt vmcnt(0)" ::: "memory");
            const unsigned og = xb_add(&bar[XB_TOP], 1u);
            const unsigned tg = og / nx;
            if (og + 1u == (tg + 1u) * nx) xb_add(&bar[XB_TOPGEN], 1u);
            else XB_SPIN(xb_ld(&bar[XB_TOPGEN]) == tg, bar);
            __builtin_amdgcn_fence(__ATOMIC_ACQUIRE, "agent");
            xb_add(&bar[XB_XGEN(b.x)], 1u);
            asm volatile("s_waitcnt vmcnt(0)" ::: "memory");
        } else {
            XB_SPIN(xb_ld(&bar[XB_XGEN(b.x)]) == gen, bar);
            __builtin_amdgcn_fence(__ATOMIC_ACQUIRE, "agent");
            asm volatile("s_waitcnt vmcnt(0)" ::: "memory");
        }
    }
    __syncthreads();
}

template <class Epi>
__device__ __forceinline__ void gemm_run(float* lds, const bf16_t* A, const bf16_t* Bt, int M, int N, int K, const Epi& E) {
    __syncthreads();
    pg8::Gemm g{A, Bt, M, N, K}; pg8::StaticOrder S; S.init(M, N, (int)gridDim.x, (int)blockIdx.x);
    pg8::gemm_phase<Epi, pg8::StaticOrder, true, true>((PG8_LAS unsigned char*)lds, g, S, E);
    __syncthreads();
}
constexpr int NPHASE = 11;
template <int PH>
__device__ __forceinline__ void run_phase(const Params& p, int bid, int nb, float* lds) {
    asm volatile("" : "+s"(bid));
    if constexpr (PH == 0) ph_prep(p, bid, nb, lds);
    if constexpr (PH == 1) ph_modnorm(p, p.x, p.norm1_g, 0 * DM, 1 * DM, p.hb, bid, nb, lds);
    if constexpr (PH == 2) gemm_run(lds, p.hb, p.Wt1, NTOK, ZW, DM, pg8::EpiZG{p.ZG, p.b_bg});
    if constexpr (PH == 3) { ph_retprep(p, bid, nb, lds); ph_gmlp2(p, bid, nb, lds); }
    if constexpr (PH == 11) ph_ret2(p, bid, nb, lds);
    if constexpr (PH == 4) ph_gn(p, bid, nb, lds);
    if constexpr (PH == 5) {
        gemm_run(lds, p.yain, p.Wta, NTOK, DM, 1024, pg8::EpiMixB<0>{p.hb, p.ZG, 0});
        gemm_run(lds, p.ybin, p.Wtb, NTOK, DM, DM, pg8::EpiMixB<1>{p.hb, p.ZG, 2048});
    }
    if constexpr (PH == 6) gemm_run(lds, p.hb, p.Wto, NTOK, DM, DM, pg8::EpiResF{p.obuf, p.x, p.ada + 2 * DM});
    if constexpr (PH == 7) { ph_modnorm(p, p.obuf, p.norm2_g, 3 * DM, 4 * DM, p.hb, bid, nb, lds); if (nb != 256) ph_tabconv(p, bid, nb); }
    if constexpr (PH == 8) gemm_run(lds, p.hb, p.Wtq, NTOK, DM, DM, pg8::EpiF32{p.qbuf, DM});
    if constexpr (PH == 9) ph_topk2(p, p.qbuf, bid, nb, lds);
    if constexpr (PH == 10) ph_peer3(p, p.obuf, p.hb, bid, nb);
}

constexpr int MISC_OFF = 132 * 1024;
__global__ void __launch_bounds__(NTH) k_mega(Params p) {
    extern __shared__ __attribute__((aligned(16))) float lds[];
    const int bid = blockIdx.x, nb = gridDim.x;
    volatile LAS unsigned* misc = (volatile LAS unsigned*)((LAS unsigned char*)lds + MISC_OFF);
    if (threadIdx.x < 4) misc[threadIdx.x] = 0u;
    __syncthreads();
    XcdBarrier bar = xcd_barrier_post(p.bar, misc);
    run_phase<0>(p, bid, nb, lds); xcd_barrier(bar);
    run_phase<1>(p, bid, nb, lds); xcd_barrier(bar);
    run_phase<2>(p, bid, nb, lds); xcd_barrier(bar);
    run_phase<3>(p, bid, nb, lds); xcd_barrier(bar);
    run_phase<11>(p, bid, nb, lds); xcd_barrier(bar);
    run_phase<4>(p, bid, nb, lds); xcd_barrier(bar);
    run_phase<5>(p, bid, nb, lds); xcd_barrier(bar);
    run_phase<6>(p, bid, nb, lds); xcd_barrier(bar);
    run_phase<7>(p, bid, nb, lds); xcd_barrier(bar);
    run_phase<8>(p, bid, nb, lds); xcd_barrier(bar);
    run_phase<9>(p, bid, nb, lds); xcd_barrier(bar);
    run_phase<10>(p, bid, nb, lds);
}

extern "C" void kernel_launch(void* const* d_in, const int* in_sizes, int n_in, void* d_out, int out_size, void* d_ws, size_t ws_size, hipStream_t stream) {
    Params p{};
    p.x = (const float*)d_in[0]; p.c = (const float*)d_in[1]; p.pos = (const int*)d_in[2];
    p.w_ada = (const float*)d_in[3]; p.b_ada = (const float*)d_in[4]; p.norm1_g = (const float*)d_in[5]; p.w_in = (const float*)d_in[6];
    p.w_bg = (const float*)d_in[7]; p.b_bg = (const float*)d_in[8]; p.gm_v_g = (const float*)d_in[9]; p.gm_ws = (const float*)d_in[10];
    p.gm_b = (const float*)d_in[11]; p.ret_gn_g = (const float*)d_in[12]; p.w_a_out = (const float*)d_in[13]; p.w_b_out = (const float*)d_in[14];
    p.w_o = (const float*)d_in[15]; p.norm2_g = (const float*)d_in[16]; p.peer_wq = (const float*)d_in[17]; p.peer_sk = (const float*)d_in[18];
    p.peer_u = (const float*)d_in[19]; p.peer_v = (const float*)d_in[20]; p.norm_f_g = (const float*)d_in[21];
    p.out = (float*)d_out;
    char* w = (char*)d_ws; size_t off = 0;
    auto take = [&](size_t bytes) { char* r = w + off; off += (bytes + 255) & ~(size_t)255; return r; };
    p.bar = (unsigned*)take(XCD_BAR_WORDS * 4);
    p.ada = (float*)take(2 * NMOD * 4);
    p.rope = (float*)take((size_t)NTOK * 128 * 4);
    p.eidx = (int*)take((size_t)NTOK * 128 * 4);
    p.gatev = (float*)take((size_t)NTOK * 128 * 4);
    p.Wt1 = (bf16_t*)take((size_t)ZW * DM * 2);
    p.Wta = (bf16_t*)take((size_t)DM * 1024 * 2);
    p.Wtb = (bf16_t*)take((size_t)DM * DM * 2);
    p.Wto = (bf16_t*)take((size_t)DM * DM * 2);
    p.Wtq = (bf16_t*)take((size_t)DM * DM * 2);
    p.hb = (bf16_t*)take((size_t)NTOK * DM * 2);
    p.ZG = (bf16_t*)take((size_t)NTOK * ZW * 2);
    p.qbuf = (float*)p.ZG;
    p.obuf = (float*)take((size_t)NTOK * DM * 4);
    p.ybin = (bf16_t*)take((size_t)NTOK * DM * 2);
    p.yain = (bf16_t*)take((size_t)NTOK * 1024 * 2);
    p.U8 = (unsigned char*)p.ZG + (size_t)NTOK * DM * 4;
    p.V8 = p.U8 + (size_t)16384 * ROW6;
    p.su = (float*)take(16384 * 4); p.sv = (float*)take(16384 * 4);
    p.Qr = (bf16_t*)take((size_t)NTOK * 1024 * 2);
    p.Pm = (bf16_t*)take((size_t)16 * 64 * 4096 * 2);
    p.KTd = (bf16_t*)take((size_t)NTOK * 1024 * 2);
    p.Vt = (bf16_t*)take((size_t)NTOK * 2048 * 2);
    p.ob16 = (bf16_t*)take((size_t)NTOK * DM * 2);
    if (off > ws_size) { fprintf(stderr, "kernel_launch: workspace too small: need %zu have %zu\n", off, ws_size); return; }
    static int grid = 0;
    if (!grid) {
        int dev = 0, cus = 0, per_cu = 0;
        (void)hipGetDevice(&dev); (void)hipDeviceGetAttribute(&cus, hipDeviceAttributeMultiprocessorCount, dev);
        (void)hipFuncSetAttribute((const void*)k_mega, hipFuncAttributeMaxDynamicSharedMemorySize, LDS_BYTES);
        (void)hipOccupancyMaxActiveBlocksPerMultiprocessor(&per_cu, k_mega, NTH, LDS_BYTES);
        (void)per_cu;
        grid = cus;
    }
    (void)hipMemsetAsync(p.bar, 0, XCD_BAR_WORDS * 4, stream);
    hipLaunchKernelGGL(k_mega, dim3(grid), dim3(NTH), LDS_BYTES, stream, p);
    hipError_t e = hipPeekAtLastError();
    if (e != hipSuccess) fprintf(stderr, "launch failed: %s (grid %d)\n", hipGetErrorString(e), grid);
}
```

```cpp
#include <hip/hip_runtime.h>
#include <hip/hip_cooperative_groups.h>
#include <stdint.h>
#include <math.h>
#include <cstdio>

namespace cg = cooperative_groups;

constexpr int DM = 2048;
constexpr int SQ = 4096;
constexpr int NTOK = 8192;
constexpr int NTH = 512;
constexpr int ZW = 12288;
constexpr int NMOD = 12288;
constexpr int LDS_BYTES = 136 * 1024;

typedef unsigned short bf16_t;

struct Params {
    const float *x, *c; const int* pos;
    const float *w_ada, *b_ada, *norm1_g, *w_in, *w_bg, *b_bg, *gm_v_g, *gm_ws, *gm_b, *ret_gn_g, *w_a_out, *w_b_out, *w_o, *norm2_g,
                *peer_wq, *peer_sk, *peer_u, *peer_v, *norm_f_g;
    float* out;
    float *ada, *rope, *gatev; int* eidx;
    bf16_t *Wt1, *Wta, *Wtb, *Wto, *Wtq;
    bf16_t *hb;
    bf16_t *ZG;
    float *obuf;
    bf16_t *ybin, *yain;
    float *qbuf;
    unsigned char *U8, *V8;
    float *su, *sv;
    bf16_t *Qr, *Pm, *KTd, *Vt;
    bf16_t *ob16;
    unsigned *bar;
};

__constant__ float c_freq[64] = {
1.000000000e+00f, 8.659643531e-01f, 7.498942018e-01f, 6.493816376e-01f, 5.623413324e-01f, 4.869675338e-01f, 4.216965139e-01f, 3.651741147e-01f, 3.162277639e-01f, 2.738419771e-01f, 2.371373773e-01f, 2.053525001e-01f, 1.778279394e-01f, 1.539926529e-01f, 1.333521456e-01f, 1.154781953e-01f, 1.000000015e-01f, 8.659642935e-02f, 7.498942316e-02f, 6.493816525e-02f, 5.623413250e-02f, 4.869675264e-02f, 4.216964915e-02f, 3.651741147e-02f, 3.162277490e-02f, 2.738419548e-02f, 2.371373773e-02f, 2.053525113e-02f, 1.778279431e-02f, 1.539926510e-02f, 1.333521400e-02f, 1.154781971e-02f, 9.999999776e-03f, 8.659643121e-03f, 7.498942316e-03f, 6.493816152e-03f, 5.623413250e-03f, 4.869675264e-03f, 4.216964822e-03f, 3.651741194e-03f, 3.162277630e-03f, 2.738419687e-03f, 2.371373819e-03f, 2.053525066e-03f, 1.778279431e-03f, 1.539926510e-03f, 1.333521446e-03f, 1.154782018e-03f, 1.000000047e-03f, 8.659643354e-04f, 7.498941850e-04f, 6.493816036e-04f, 5.623413017e-04f, 4.869675322e-04f, 4.216965172e-04f, 3.651741135e-04f, 3.162277571e-04f, 2.738419571e-04f, 2.371373703e-04f, 2.053525095e-04f, 1.778279402e-04f, 1.539926598e-04f, 1.333521504e-04f, 1.154782003e-04f };

__device__ __forceinline__ int tid_() { int t = threadIdx.x; asm volatile("" : "+v"(t)); return t; }
template <int CTRL> __device__ __forceinline__ float dppf(float x) { return __uint_as_float((unsigned)__builtin_amdgcn_update_dpp(0, (int)__float_as_uint(x), CTRL, 0xf, 0xf, true)); }
__device__ __forceinline__ float row_sum16(float v) { v += dppf<0xB1>(v); v += dppf<0x4E>(v); v += dppf<0x141>(v); v += dppf<0x140>(v); return v; }
__device__ __forceinline__ float xsum16(float v) { const auto r = __builtin_amdgcn_permlane16_swap(__float_as_uint(v), __float_as_uint(v), false, false); return __uint_as_float(r[0]) + __uint_as_float(r[1]); }
__device__ __forceinline__ float xsum32(float v) { const auto r = __builtin_amdgcn_permlane32_swap(__float_as_uint(v), __float_as_uint(v), false, false); return __uint_as_float(r[0]) + __uint_as_float(r[1]); }
__device__ __forceinline__ float xmax16(float v) { const auto r = __builtin_amdgcn_permlane16_swap(__float_as_uint(v), __float_as_uint(v), false, false); return fmaxf(__uint_as_float(r[0]), __uint_as_float(r[1])); }
__device__ __forceinline__ float xmax32(float v) { const auto r = __builtin_amdgcn_permlane32_swap(__float_as_uint(v), __float_as_uint(v), false, false); return fmaxf(__uint_as_float(r[0]), __uint_as_float(r[1])); }
__device__ __forceinline__ float wave_sum(float v) { v = row_sum16(v); v += __shfl_xor(v, 16); v += __shfl_xor(v, 32); return v; }
__device__ __forceinline__ float wave_max_b(float v) {
    v = fmaxf(v, dppf<0xB1>(v)); v = fmaxf(v, dppf<0x4E>(v)); v = fmaxf(v, dppf<0x141>(v)); v = fmaxf(v, dppf<0x140>(v));
    v = fmaxf(v, __shfl_xor(v, 16)); v = fmaxf(v, __shfl_xor(v, 32)); return v;
}
__device__ __forceinline__ float wave_max(float v) {
    v = fmaxf(v, dppf<0xB1>(v)); v = fmaxf(v, dppf<0x4E>(v)); v = fmaxf(v, dppf<0x141>(v)); v = fmaxf(v, dppf<0x140>(v));
    return xmax32(xmax16(v));
}
__device__ __forceinline__ float sigmoidf_(float x) { return 1.0f / (1.0f + expf(-x)); }
__device__ __forceinline__ float siluf_(float x) { return x * sigmoidf_(x); }
__device__ __forceinline__ float geluf_(float x) { return 0.5f * x * (1.0f + erff(x * 0.70710678118654752f)); }
__device__ __forceinline__ float dot4(float4 a, float4 b) { return a.x * b.x + a.y * b.y + a.z * b.z + a.w * b.w; }
__device__ __forceinline__ float bf2f(bf16_t v) { return __uint_as_float((unsigned)v << 16); }
__device__ __forceinline__ float bflo(unsigned w) { return __uint_as_float(w << 16); }
__device__ __forceinline__ float bfhi(unsigned w) { return __uint_as_float(w & 0xffff0000u); }
__device__ __forceinline__ unsigned f2bf(float f) { unsigned u = __float_as_uint(f); return (u + 0x7fffu + ((u >> 16) & 1u)) >> 16; }
__device__ __forceinline__ unsigned pk2(float lo, float hi) { return f2bf(lo) | (f2bf(hi) << 16); }

__device__ __forceinline__ void st_wt8(void* ptr, uint2 v) { __hip_atomic_store((unsigned long long*)ptr, ((unsigned long long)v.y << 32) | v.x, __ATOMIC_RELAXED, __HIP_MEMORY_SCOPE_AGENT); }
__device__ __forceinline__ void sincos_acc(float ang, float& s, float& c) {
    const double x = (double)ang;
    const double k = rint(x * 0.63661977236758134308);
    double r = fma(-k, 1.57079632679489655800, x); r = fma(-k, 6.12323399573676603587e-17, r);
    const double r2 = r * r;
    const double sp = r * (1.0 + r2 * (-1.0 / 6.0 + r2 * (1.0 / 120.0 + r2 * (-1.0 / 5040.0 + r2 * (1.0 / 362880.0 + r2 * (-1.0 / 39916800.0 + r2 * (1.0 / 6227020800.0)))))));
    const double cp = 1.0 + r2 * (-0.5 + r2 * (1.0 / 24.0 + r2 * (-1.0 / 720.0 + r2 * (1.0 / 40320.0 + r2 * (-1.0 / 3628800.0 + r2 * (1.0 / 479001600.0 + r2 * (-1.0 / 87178291200.0)))))));
    const int q = ((int)k) & 3;
    const float fs = (float)sp, fc = (float)cp;
    s = (q == 0) ? fs : (q == 1) ? fc : (q == 2) ? -fs : -fc;
    c = (q == 0) ? fc : (q == 1) ? -fs : (q == 2) ? -fc : fs;
}

namespace pg8 {
#define PG8_LAS __attribute__((address_space(3)))
typedef unsigned short bf16_t;
typedef short bf16x8 __attribute__((ext_vector_type(8)));
typedef float f32x4 __attribute__((ext_vector_type(4)));
typedef unsigned u32x4 __attribute__((ext_vector_type(4)));
constexpr int BM = 256, BK = 64, HALF = 128, HTB = HALF * BK * 2  , STAGE_BYTES = 8 * HTB, NXCD = 8, WGM = 8;

__host__ __device__ __forceinline__ int lds_byte(int r, int c) { const int st = (r >> 4) * 2 + (c >> 5), rr = r & 15, cc = c & 31, ob = rr * 64 + cc * 2; return st * 1024 + (ob ^ (((ob >> 9) & 1) << 5)); }
__host__ __device__ __forceinline__ void stage_rc(int b, int& R, int& C) { const int st = b / 1024, sb = b % 1024, swz = sb ^ (((sb >> 9) & 1) << 5); R = (st >> 1) * 16 + swz / 64; C = (st & 1) * 32 + (swz % 64) / 2; }
__host__ __device__ __forceinline__ int perm32(int rho) { const int n = rho >> 4, i = rho & 15; return 8 * (i >> 2) + 4 * n + (i & 3); }

struct Unit { int pm, pn; };
struct Gemm { const bf16_t* A; const bf16_t* Bt; int M, N, K; };

struct StaticOrder {
    int nM, nN, nwg, G, c;
    __host__ __device__ void init(int M, int N, int G_, int c_) { nM = M / BM; nN = N / BM; nwg = nM * nN; G = G_; c = c_; }
    __host__ __device__ bool next(int i, Unit& u) const {
        const long L = (long)i * G + c; if (L >= nwg) return false;
        int wgid = (int)L; { const int q = nwg / NXCD, r = nwg % NXCD, xcd = wgid % NXCD, off = wgid / NXCD; wgid = (xcd < r ? xcd * (q + 1) : r * (q + 1) + (xcd - r) * q) + off; }
        const int nig = WGM * nN, gid = wgid / nig, fm = gid * WGM, gsz = (nM - fm) < WGM ? (nM - fm) : WGM;
        u.pm = fm + ((wgid % nig) % gsz); u.pn = (wgid % nig) / gsz; return true;
    }
    __device__ __forceinline__ void a_ready(const Unit&) const {}
    __device__ __forceinline__ void done(const Unit&) const {}
};

__device__ __forceinline__ unsigned cvt_pk_bf16(float lo, float hi) { unsigned r; asm volatile("v_cvt_pk_bf16_f32 %0, %1, %2" : "=v"(r) : "v"(lo), "v"(hi)); return r; }
typedef float f32x2 __attribute__((ext_vector_type(2)));
__device__ __forceinline__ f32x2 gelu_pk(f32x2 v) {
    const f32x2 av = __builtin_elementwise_abs(v), d = av * 0.2316418882f + 1.0f;
    f32x2 t; t.x = __builtin_amdgcn_rcpf(d.x); t.y = __builtin_amdgcn_rcpf(d.y);
    f32x2 q = t * 0.5307027145f + (-0.7265760135f); q = q * t + 0.7107068705f; q = q * t + (-0.142248368f); q = q * t + 0.127414796f; q = q * t;
    const f32x2 s = (v * v) * (-0.72134752044f);
    f32x2 e; e.x = __builtin_amdgcn_exp2f(s.x); e.y = __builtin_amdgcn_exp2f(s.y);
    const f32x2 m = v * (q * e), r = v - m;
    f32x2 o; o.x = v.x < 0.f ? m.x : r.x; o.y = v.y < 0.f ? m.y : r.y; return o;
}

typedef unsigned u32x2v __attribute__((ext_vector_type(2)));
struct EpiZG {
    static constexpr bool PERM = true, AFTER_DRAIN = false;
    bf16_t* O; const float* bias;
    __device__ __forceinline__ void operator()(const f32x4 (&acc)[2][2][4][2], const Unit& u, int wr, int wc, int fr, int fq) const {
        const int row0 = u.pm * BM + wr * 64 + fr, col0 = u.pn * BM + wc * 32 + 8 * fq;
        const int mode = u.pn < 8 ? 1 : (u.pn < 32 ? 0 : 2);
        f32x4 bv[2][2];
#pragma unroll
        for (int bj = 0; bj < 2; ++bj)
#pragma unroll
            for (int n = 0; n < 2; ++n) bv[bj][n] = (mode == 2) ? *(const f32x4*)(bias + (col0 - 8192) + bj * HALF + 4 * n) : (f32x4){0.f, 0.f, 0.f, 0.f};
#pragma unroll
        for (int ai = 0; ai < 2; ++ai)
#pragma unroll
            for (int m = 0; m < 4; ++m) { bf16_t* rowp = O + (size_t)(row0 + ai * HALF + m * 16) * ZW + col0;
#pragma unroll
                for (int bj = 0; bj < 2; ++bj) { f32x4 v0 = acc[ai][bj][m][0], v1 = acc[ai][bj][m][1];
                    if (mode == 1) { f32x2 a = gelu_pk((f32x2){v0[0], v0[1]}), b = gelu_pk((f32x2){v0[2], v0[3]}), c = gelu_pk((f32x2){v1[0], v1[1]}), d = gelu_pk((f32x2){v1[2], v1[3]});
                        v0 = (f32x4){a.x, a.y, b.x, b.y}; v1 = (f32x4){c.x, c.y, d.x, d.y}; }
                    if (mode == 2) { v0 = v0 + bv[bj][0]; v1 = v1 + bv[bj][1];
#pragma unroll
                        for (int e = 0; e < 4; ++e) { v0[e] = __builtin_amdgcn_rcpf(1.0f + __expf(-v0[e])); v1[e] = __builtin_amdgcn_rcpf(1.0f + __expf(-v1[e])); } }
                    u32x4 w; w.x = cvt_pk_bf16(v0[0], v0[1]); w.y = cvt_pk_bf16(v0[2], v0[3]); w.z = cvt_pk_bf16(v1[0], v1[1]); w.w = cvt_pk_bf16(v1[2], v1[3]);
                    *(u32x4*)(rowp + bj * HALF) = w; } }
    }
};
template <int ACCUM> struct EpiMixB {
    static constexpr bool PERM = true, AFTER_DRAIN = false;
    bf16_t* Mo; const bf16_t* ZGp; int goff;
    __device__ __forceinline__ void operator()(const f32x4 (&acc)[2][2][4][2], const Unit& u, int wr, int wc, int fr, int fq) const {
        const int row0 = u.pm * BM + wr * 64 + fr, col0 = u.pn * BM + wc * 32 + 8 * fq;
#pragma unroll
        for (int ai = 0; ai < 2; ++ai)
#pragma unroll
            for (int m = 0; m < 4; ++m) { const size_t row = (size_t)(row0 + ai * HALF + m * 16);
#pragma unroll
                for (int bj = 0; bj < 2; ++bj) { const f32x4 v0 = acc[ai][bj][m][0], v1 = acc[ai][bj][m][1];
                    const u32x4 g = *(const u32x4*)(ZGp + row * ZW + 8192 + goff + col0 + bj * HALF);
                    float o[8];
                    o[0] = bflo(g.x) * v0[0]; o[1] = bfhi(g.x) * v0[1]; o[2] = bflo(g.y) * v0[2]; o[3] = bfhi(g.y) * v0[3];
                    o[4] = bflo(g.z) * v1[0]; o[5] = bfhi(g.z) * v1[1]; o[6] = bflo(g.w) * v1[2]; o[7] = bfhi(g.w) * v1[3];
                    bf16_t* mp = Mo + row * DM + col0 + bj * HALF;
                    if (ACCUM) { const u32x4 old = *(const u32x4*)mp;
                        o[0] += bflo(old.x); o[1] += bfhi(old.x); o[2] += bflo(old.y); o[3] += bfhi(old.y); o[4] += bflo(old.z); o[5] += bfhi(old.z); o[6] += bflo(old.w); o[7] += bfhi(old.w); }
                    u32x4 w; w.x = cvt_pk_bf16(o[0], o[1]); w.y = cvt_pk_bf16(o[2], o[3]); w.z = cvt_pk_bf16(o[4], o[5]); w.w = cvt_pk_bf16(o[6], o[7]);
                    *(u32x4*)mp = w; } }
    }
};
struct EpiResF {
    static constexpr bool PERM = false, AFTER_DRAIN = false;
    float* x1; const float* x; const float* ga;
    __device__ __forceinline__ void operator()(const f32x4 (&acc)[2][2][4][2], const Unit& u, int wr, int wc, int fr, int fq) const {
        const int row0 = u.pm * BM + wr * 64 + fr, col0 = u.pn * BM + wc * 32 + 4 * fq;
        const int b = (u.pm * BM) / SQ;
        f32x4 gv[2][2];
#pragma unroll
        for (int bj = 0; bj < 2; ++bj)
#pragma unroll
            for (int n = 0; n < 2; ++n) gv[bj][n] = *(const f32x4*)(ga + b * NMOD + col0 + bj * HALF + n * 16);
#pragma unroll
        for (int ai = 0; ai < 2; ++ai)
#pragma unroll
            for (int m = 0; m < 4; ++m) { const size_t off = (size_t)(row0 + ai * HALF + m * 16) * DM + col0;
#pragma unroll
                for (int bj = 0; bj < 2; ++bj)
#pragma unroll
                    for (int n = 0; n < 2; ++n) { const f32x4 xv = *(const f32x4*)(x + off + bj * HALF + n * 16);
                        *(f32x4*)(x1 + off + bj * HALF + n * 16) = xv + gv[bj][n] * acc[ai][bj][m][n]; } }
    }
};
struct EpiF32 {
    static constexpr bool PERM = false, AFTER_DRAIN = false;
    float* O; int ldc;
    __device__ __forceinline__ void operator()(const f32x4 (&acc)[2][2][4][2], const Unit& u, int wr, int wc, int fr, int fq) const {
        const int row0 = u.pm * BM + wr * 64 + fr, col0 = u.pn * BM + wc * 32 + 4 * fq;
#pragma unroll
        for (int ai = 0; ai < 2; ++ai)
#pragma unroll
            for (int m = 0; m < 4; ++m) { const size_t off = (size_t)(row0 + ai * HALF + m * 16) * ldc + col0;
#pragma unroll
                for (int bj = 0; bj < 2; ++bj)
#pragma unroll
                    for (int n = 0; n < 2; ++n) *(f32x4*)(O + off + bj * HALF + n * 16) = acc[ai][bj][m][n]; }
    }
};

template <class Epi, class Sched, bool ALIGN_EPI = false, bool SP2 = false>
__device__ __forceinline__ void gemm_phase(PG8_LAS unsigned char* lds, const Gemm g, const Sched& S, const Epi& E) {
    const int tid = threadIdx.x, wid = __builtin_amdgcn_readfirstlane(tid >> 6), lane = tid & 63, wr = wid >> 2, wc = wid & 3, fr = lane & 15, fq = lane >> 4;
    const int K = g.K, nt = K / BK;
    unsigned voffA[2], voffB[2];
#pragma unroll
    for (int i = 0; i < 2; ++i) { int R, C; stage_rc(tid * 16 + i * 8192, R, C); const int Rb = Epi::PERM ? ((R & ~31) + perm32(R & 31)) : R;
        voffA[i] = (unsigned)(R * K + C) * 2u; voffB[i] = (unsigned)(Rb * K + C) * 2u; }
    const size_t kstep = (size_t)(BK * 2);
    const size_t hstep = (size_t)HALF * K * 2;
    const size_t tstep = 2 * hstep;
    const unsigned ldsw = (unsigned)wid * 1024u;
    const int aoff = lds_byte(wr * 64 + fr, fq * 8), boff = lds_byte(wc * 32 + fr, fq * 8);
#define PG8_SA(b, h) (((b) * 2 + (h)) * HTB)
#define PG8_SB(b, h) ((4 + (b) * 2 + (h)) * HTB)
#define PG8_STAGE(bufoff, gbase, voff) do { _Pragma("unroll") for (int _i = 0; _i < 2; ++_i) \
        __builtin_amdgcn_global_load_lds((const unsigned*)((const char*)(gbase) + (voff)[_i]), (PG8_LAS unsigned*)(lds + (bufoff) + ldsw + _i * 8192), 16, 0, 0); } while (0)
#define PG8_LDA(dst, b, h) do { _Pragma("unroll") for (int m = 0; m < 4; ++m) _Pragma("unroll") for (int k = 0; k < 2; ++k) dst[m][k] = *(const PG8_LAS bf16x8*)(lds + PG8_SA(b, h) + aoff + m * 2048 + k * 1024); } while (0)
#define PG8_LDB(dst, b, h) do { _Pragma("unroll") for (int n = 0; n < 2; ++n) _Pragma("unroll") for (int k = 0; k < 2; ++k) dst[n][k] = *(const PG8_LAS bf16x8*)(lds + PG8_SB(b, h) + boff + n * 2048 + k * 1024); } while (0)
#define PG8_MMA(ai, bj, At, Bt) do { __builtin_amdgcn_s_setprio(1); _Pragma("unroll") for (int m = 0; m < 4; ++m) _Pragma("unroll") for (int n = 0; n < 2; ++n) _Pragma("unroll") for (int k = 0; k < 2; ++k) \
        acc[ai][bj][m][n] = __builtin_amdgcn_mfma_f32_16x16x32_bf16(Bt[n][k], At[m][k], acc[ai][bj][m][n], 0, 0, 0); __builtin_amdgcn_s_setprio(0); } while (0)
#define PG8_WAIT_V(n) asm volatile("s_waitcnt vmcnt(" #n ")" ::: "memory")
#define PG8_WAIT_L(n) asm volatile("s_waitcnt lgkmcnt(" #n ")" ::: "memory")
#define PG8_BAR __builtin_amdgcn_s_barrier()
#define PG8_SCHED __builtin_amdgcn_sched_barrier(0)
    Unit cur, nxt; int ui = 0;
    if (!S.next(0, cur)) return;
    f32x4 acc[2][2][4][2];
#pragma unroll
    for (int a = 0; a < 2; ++a)
#pragma unroll
        for (int b = 0; b < 2; ++b)
#pragma unroll
            for (int m = 0; m < 4; ++m)
#pragma unroll
                for (int n = 0; n < 2; ++n) acc[a][b][m][n] = (f32x4){0.f, 0.f, 0.f, 0.f};
    bf16x8 At[4][2], B0[2][2], B1[2][2];
    const char* cA = (const char*)g.A + (size_t)cur.pm * tstep; const char* cB = (const char*)g.Bt + (size_t)cur.pn * tstep;
    S.a_ready(cur);
    if constexpr (SP2) {
        PG8_STAGE(PG8_SB(0, 0), cB, voffB); PG8_STAGE(PG8_SB(0, 1), cB + hstep, voffB); PG8_STAGE(PG8_SA(0, 0), cA, voffA); PG8_STAGE(PG8_SA(0, 1), cA + hstep, voffA);
        if (wr == 1) PG8_BAR;
        PG8_WAIT_V(2); PG8_BAR;
        PG8_STAGE(PG8_SB(1, 0), cB + kstep, voffB); PG8_STAGE(PG8_SA(1, 0), cA + kstep, voffA); PG8_STAGE(PG8_SB(1, 1), cB + hstep + kstep, voffB);
        PG8_WAIT_V(6); PG8_BAR;
    } else {
        PG8_STAGE(PG8_SB(0, 0), cB, voffB); PG8_STAGE(PG8_SA(0, 0), cA, voffA); PG8_STAGE(PG8_SB(0, 1), cB + hstep, voffB); PG8_STAGE(PG8_SA(0, 1), cA + hstep, voffA);
        if (wr == 1) PG8_BAR;
        PG8_WAIT_V(4); PG8_BAR;
        PG8_STAGE(PG8_SB(1, 0), cB + kstep, voffB); PG8_STAGE(PG8_SA(1, 0), cA + kstep, voffA); PG8_STAGE(PG8_SB(1, 1), cB + hstep + kstep, voffB);
        PG8_WAIT_V(6); PG8_BAR;
    }
    for (;;) {
        const bool has_next = S.next(ui + 1, nxt);
        const char* nA = has_next ? (const char*)g.A + (size_t)nxt.pm * tstep : cA; const char* nB = has_next ? (const char*)g.Bt + (size_t)nxt.pn * tstep : cB;
        for (int t = 0; t < nt; t += 2) {
            const bool last = (t == nt - 2);
            const char* a1 = cA + (size_t)(t + 1) * kstep;
            const char* a2 = last ? nA : cA + (size_t)(t + 2) * kstep; const char* b2 = last ? nB : cB + (size_t)(t + 2) * kstep;
            const char* a3 = a2 + kstep; const char* b3 = b2 + kstep;
            if (last && has_next) S.a_ready(nxt);
            if constexpr (SP2) {
            PG8_LDB(B0, 0, 0); PG8_LDB(B1, 0, 1); PG8_SCHED; PG8_LDA(At, 0, 0); PG8_STAGE(PG8_SA(1, 1), a1 + hstep, voffA);
            PG8_WAIT_V(8); PG8_WAIT_L(0); PG8_BAR; PG8_MMA(0, 0, At, B0); PG8_MMA(0, 1, At, B1); PG8_BAR; PG8_SCHED;
            PG8_LDA(At, 0, 1); PG8_STAGE(PG8_SB(0, 0), b2, voffB); PG8_STAGE(PG8_SB(0, 1), b2 + hstep, voffB); PG8_STAGE(PG8_SA(0, 0), a2, voffA);
            PG8_WAIT_V(8); PG8_WAIT_L(0); PG8_BAR; PG8_MMA(1, 0, At, B0); PG8_MMA(1, 1, At, B1); PG8_BAR; PG8_SCHED;
            PG8_LDB(B0, 1, 0); PG8_LDB(B1, 1, 1); PG8_SCHED; PG8_LDA(At, 1, 0); PG8_STAGE(PG8_SA(0, 1), a2 + hstep, voffA);
            PG8_WAIT_V(8); PG8_WAIT_L(0); PG8_BAR; PG8_MMA(0, 0, At, B0); PG8_MMA(0, 1, At, B1); PG8_BAR; PG8_SCHED;
            PG8_LDA(At, 1, 1); PG8_STAGE(PG8_SB(1, 0), b3, voffB); PG8_STAGE(PG8_SB(1, 1), b3 + hstep, voffB); PG8_STAGE(PG8_SA(1, 0), a3, voffA);
            PG8_WAIT_V(8); PG8_WAIT_L(0); PG8_BAR; PG8_MMA(1, 0, At, B0); PG8_MMA(1, 1, At, B1); PG8_BAR; PG8_SCHED;
            } else {
            PG8_LDB(B0, 0, 0); PG8_SCHED; PG8_LDA(At, 0, 0); PG8_STAGE(PG8_SA(1, 1), a1 + hstep, voffA);
            PG8_WAIT_L(8); PG8_BAR; PG8_WAIT_L(0); PG8_MMA(0, 0, At, B0); PG8_BAR; PG8_SCHED;
            PG8_LDB(B1, 0, 1); PG8_STAGE(PG8_SB(0, 0), b2, voffB);
            PG8_BAR; PG8_WAIT_L(0); PG8_MMA(0, 1, At, B1); PG8_BAR;
            PG8_LDA(At, 0, 1); PG8_STAGE(PG8_SA(0, 0), a2, voffA);
            PG8_BAR; PG8_WAIT_L(0); PG8_MMA(1, 0, At, B0); PG8_BAR; PG8_SCHED;
            PG8_STAGE(PG8_SB(0, 1), b2 + hstep, voffB);
            PG8_WAIT_V(6); PG8_BAR; PG8_MMA(1, 1, At, B1); PG8_BAR;
            PG8_LDB(B0, 1, 0); PG8_SCHED; PG8_LDA(At, 1, 0); PG8_STAGE(PG8_SA(0, 1), a2 + hstep, voffA);
            PG8_WAIT_L(8); PG8_BAR; PG8_WAIT_L(0); PG8_MMA(0, 0, At, B0); PG8_BAR; PG8_SCHED;
            PG8_LDB(B1, 1, 1); PG8_STAGE(PG8_SB(1, 0), b3, voffB);
            PG8_BAR; PG8_WAIT_L(0); PG8_MMA(0, 1, At, B1); PG8_BAR;
            PG8_LDA(At, 1, 1); PG8_STAGE(PG8_SA(1, 0), a3, voffA);
            PG8_BAR; PG8_WAIT_L(0); PG8_MMA(1, 0, At, B0); PG8_BAR; PG8_SCHED;
            PG8_STAGE(PG8_SB(1, 1), b3 + hstep, voffB);
            PG8_WAIT_V(6); PG8_BAR; PG8_MMA(1, 1, At, B1); PG8_BAR;
            }
        }
        if constexpr (ALIGN_EPI) { if (wr == 0) PG8_BAR; }
        if constexpr (!Epi::AFTER_DRAIN) { E(acc, cur, wr, wc, fr, fq); S.done(cur); }
        if (!has_next) break;
#pragma unroll
        for (int a = 0; a < 2; ++a)
#pragma unroll
            for (int b = 0; b < 2; ++b)
#pragma unroll
                for (int m = 0; m < 4; ++m)
#pragma unroll
                    for (int n = 0; n < 2; ++n) acc[a][b][m][n] = (f32x4){0.f, 0.f, 0.f, 0.f};
        cur = nxt; cA = nA; cB = nB; ++ui;
        if constexpr (ALIGN_EPI) { if (wr == 1) PG8_BAR; }
    }
    PG8_WAIT_V(0);
    if constexpr (!ALIGN_EPI) { if (wr == 0) PG8_BAR; }
    PG8_BAR;
    if constexpr (Epi::AFTER_DRAIN) { E.fused(acc, cur, wr, wc, fr, fq, lds, wid, lane); S.done(cur); }
#undef PG8_SA
#undef PG8_SB
#undef PG8_STAGE
#undef PG8_LDA
#undef PG8_LDB
#undef PG8_MMA
#undef PG8_WAIT_V
#undef PG8_WAIT_L
#undef PG8_BAR
#undef PG8_SCHED
}
}
using pg8::f32x4; using pg8::u32x4;

__device__ __forceinline__ void transpose_item(const float* W, int K, int N, bf16_t* WT, int row_off, float* scr, int item, int lane) {
    const int nblk = N / 32, kb = item / nblk, nbk = item % nblk, k0 = 64 * kb, n0 = 32 * nbk;
    {
        const int r = lane >> 3, c4 = (lane & 7) * 4;
        float4 t[8];
#pragma unroll
        for (int i = 0; i < 8; ++i) t[i] = *(const float4*)(W + (size_t)(k0 + 8 * i + r) * N + n0 + c4);
#pragma unroll
        for (int i = 0; i < 8; ++i) { float* d = scr + (8 * i + r) * 33 + c4; d[0] = t[i].x; d[1] = t[i].y; d[2] = t[i].z; d[3] = t[i].w; }
    }
    asm volatile("s_waitcnt lgkmcnt(0)" ::: "memory");
    const int c = lane & 7;
#pragma unroll
    for (int j = 0; j < 4; ++j) { const int n = (lane >> 3) + 8 * j; const float* s = scr + (8 * c) * 33 + n;
        uint4 o; o.x = pk2(s[0 * 33], s[1 * 33]); o.y = pk2(s[2 * 33], s[3 * 33]); o.z = pk2(s[4 * 33], s[5 * 33]); o.w = pk2(s[6 * 33], s[7 * 33]);
        *(uint4*)(WT + (size_t)(row_off + n0 + n) * K + k0 + 8 * c) = o; }
    asm volatile("s_waitcnt lgkmcnt(0)" ::: "memory");
}
__device__ __forceinline__ void ph_prep(const Params& p, int bid, int nb, float* lds) {
    const int tid = tid_(), wave = tid >> 6, lane = tid & 63;
    {
        float* sl = lds;
        float* red = lds + 4096;
        for (int i = tid; i < 4096; i += NTH) sl[i] = siluf_(p.c[i]);
        __syncthreads();
        for (int it = bid; it < 192; it += nb) {
            const int c4 = tid & 15, kg = tid >> 4;
            const float* wp = p.w_ada + (size_t)kg * NMOD + it * 64 + c4 * 4;
            float a0[4] = {0.f, 0.f, 0.f, 0.f}, a1[4] = {0.f, 0.f, 0.f, 0.f};
#pragma unroll 8
            for (int i = 0; i < 64; ++i) {
                const int k = kg + 32 * i;
                const float4 w = *(const float4*)(wp + (size_t)(32 * i) * NMOD);
                const float s0 = sl[k], s1 = sl[2048 + k];
                a0[0] += s0 * w.x; a0[1] += s0 * w.y; a0[2] += s0 * w.z; a0[3] += s0 * w.w;
                a1[0] += s1 * w.x; a1[1] += s1 * w.y; a1[2] += s1 * w.z; a1[3] += s1 * w.w;
            }
            __syncthreads();
#pragma unroll
            for (int e = 0; e < 4; ++e) { red[(kg * 16 + c4) * 8 + e] = a0[e]; red[(kg * 16 + c4) * 8 + 4 + e] = a1[e]; }
            __syncthreads();
            if (tid < 128) {
                const int b = tid >> 6, col = tid & 63;
                float s = 0.f;
                for (int g = 0; g < 32; ++g) s += red[(g * 16 + (col >> 2)) * 8 + b * 4 + (col & 3)];
                p.ada[b * NMOD + it * 64 + col] = s + p.b_ada[it * 64 + col];
            }
        }
        __syncthreads();
    }
    for (int e = bid * NTH + tid; e < NTOK * 64; e += nb * NTH) {
        const int tok = e >> 6, j = e & 63;
        const float ang = (float)p.pos[tok] * c_freq[j];
        float s, c; sincos_acc(ang, s, c);
        p.rope[(size_t)e * 2] = c; p.rope[(size_t)e * 2 + 1] = s;
    }
    {
        float* scr = lds + wave * (64 * 33);
        const int gw = bid * 8 + wave, ngw = nb * 8;
        constexpr int I1 = 32 * 256, I2 = 32 * 128, I3 = 16 * 64, I4 = 32 * 64;
        constexpr int NIT = I1 + I2 + I3 + 3 * I4;
        for (int it = gw; it < NIT; it += ngw) {
            int r = it;
            if (r < I1) { transpose_item(p.w_in, 2048, 8192, p.Wt1, 0, scr, r, lane); continue; } r -= I1;
            if (r < I2) { transpose_item(p.w_bg, 2048, 4096, p.Wt1, 8192, scr, r, lane); continue; } r -= I2;
            if (r < I3) { transpose_item(p.w_a_out, 1024, 2048, p.Wta, 0, scr, r, lane); continue; } r -= I3;
            if (r < I4) { transpose_item(p.w_b_out, 2048, 2048, p.Wtb, 0, scr, r, lane); continue; } r -= I4;
            if (r < I4) { transpose_item(p.w_o, 2048, 2048, p.Wto, 0, scr, r, lane); continue; } r -= I4;
            transpose_item(p.peer_wq, 2048, 2048, p.Wtq, 0, scr, r, lane);
        }
    }
    __syncthreads();
}
constexpr int ROW6 = 1536;
typedef float f32x32_t __attribute__((ext_vector_type(32)));
typedef unsigned u32x6_t __attribute__((ext_vector_type(6)));
__device__ __forceinline__ void tc_load(const Params& p, int r, int lane, float4 (&t)[8]) {
    const bool second = r >= 16384; const int row = second ? r - 16384 : r;
    const float* src = (second ? p.peer_v : p.peer_u) + (size_t)row * DM + lane * 4;
#pragma unroll
    for (int q = 0; q < 8; ++q) t[q] = *(const float4*)(src + 256 * q);
}
__device__ __forceinline__ void tc_finish(const Params& p, int r, int lane, const float4 (&t)[8]) {
    const bool second = r >= 16384; const int row = second ? r - 16384 : r;
    float am = 0.f;
#pragma unroll
    for (int q = 0; q < 8; ++q) am = fmaxf(am, fmaxf(fmaxf(fabsf(t[q].x), fabsf(t[q].y)), fmaxf(fabsf(t[q].z), fabsf(t[q].w))));
    am = wave_max_b(am);
    const float sc = (am > 0.f) ? am * (1.0f / 7.5f) : 1.0f, inv = (am > 0.f) ? 7.5f / am : 1.0f;
    typedef float f32x16_t __attribute__((ext_vector_type(16)));
    f32x16_t ev, od;
#pragma unroll
    for (int q = 0; q < 8; ++q) { ev[2 * q] = t[q].x * inv; od[2 * q] = t[q].y * inv; ev[2 * q + 1] = t[q].z * inv; od[2 * q + 1] = t[q].w * inv; }
    const u32x6_t w = __builtin_amdgcn_cvt_scalef32_2xpk16_fp6_f32(ev, od, 1.0f);
    unsigned char* dst = (second ? p.V8 : p.U8) + (size_t)row * ROW6 + lane * 8;
    *(uint2*)(dst) = make_uint2(w[0], w[1]); *(uint2*)(dst + 512) = make_uint2(w[2], w[3]); *(uint2*)(dst + 1024) = make_uint2(w[4], w[5]);
    if (lane == 0) (second ? p.sv : p.su)[row] = sc;
}
__device__ __forceinline__ void ph_tabconv(const Params& p, int bid, int nb) {
    const int tid = tid_(), wave = tid >> 6, lane = tid & 63;
    for (int r = bid * 8 + wave; r < 2 * 16384; r += nb * 8) { float4 t[8]; tc_load(p, r, lane, t); tc_finish(p, r, lane, t); }
}

__device__ __forceinline__ void ph_modnorm(const Params& p, const float* xin, const float* g, int sh_off, int sc_off, bf16_t* hout, int bid, int nb, float* lds) {
    const int tid = tid_(), wave = tid >> 6, lane = tid & 63;
    const int stride = nb * 8;
    int row = bid * 8 + wave;
    float4 v[8], vn[8];
    if (row < NTOK) {
#pragma unroll
        for (int j = 0; j < 8; ++j) v[j] = ((const float4*)(xin + (size_t)row * DM))[lane + 64 * j];
    }
    for (; row < NTOK; row += stride) {
        const int nrow = row + stride;
        if (nrow < NTOK) {
#pragma unroll
            for (int j = 0; j < 8; ++j) vn[j] = ((const float4*)(xin + (size_t)nrow * DM))[lane + 64 * j];
        }
        const int b = row / SQ;
        float ss = 0.f;
#pragma unroll
        for (int j = 0; j < 8; ++j) ss += dot4(v[j], v[j]);
        ss = wave_sum(ss);
        const float rs = 1.0f / sqrtf(ss * (1.0f / DM) + 1e-6f);
#pragma unroll
        for (int j = 0; j < 8; ++j) {
            const int col = (lane + 64 * j) * 4;
            const float4 g4 = *(const float4*)(g + col);
            const float4 sc = *(const float4*)(p.ada + b * NMOD + sc_off + col);
            const float4 sh = *(const float4*)(p.ada + b * NMOD + sh_off + col);
            float4 o;
            o.x = v[j].x * rs * g4.x * (1.0f + sc.x) + sh.x; o.y = v[j].y * rs * g4.y * (1.0f + sc.y) + sh.y;
            o.z = v[j].z * rs * g4.z * (1.0f + sc.z) + sh.z; o.w = v[j].w * rs * g4.w * (1.0f + sc.w) + sh.w;
            st_wt8(hout + (size_t)row * DM + col, make_uint2(pk2(o.x, o.y), pk2(o.z, o.w)));
        }
#pragma unroll
        for (int j = 0; j < 8; ++j) v[j] = vn[j];
    }
}

typedef short bf16x8_t __attribute__((ext_vector_type(8)));
typedef float f32x4_t __attribute__((ext_vector_type(4)));
__device__ __forceinline__ bf16x8_t ldfrag(const char* base, int row, int chunk, int rb, int sm) { return *(const bf16x8_t*)(base + row * rb + ((chunk ^ (row & sm)) << 4)); }
__device__ __forceinline__ void ph_gmlp2(const Params& p, int bid, int nb, float* lds) {
    char* WM = (char*)lds; char* VT = WM + 32768;
    const int tid = tid_(), wave = tid >> 6, lane = tid & 63, fr = lane & 15, fq = lane >> 4;
    int gl = -1;
    for (int it = bid; it < 512; it += nb) {
        const int g = it & 7, n = (it >> 3) & 31, b = it >> 8;
        const int tok0 = b * SQ + n * 128;
        __syncthreads();
        if (g != gl) {
            for (int u = tid; u < 2048; u += NTH) {
                const int i = u >> 4, c = u & 15;
                const float4* src = (const float4*)(p.gm_ws + (size_t)g * 16384 + i * 128 + c * 8);
                float4 a = src[0], b4 = src[1];
                if ((i >> 6) < (c >> 3)) { a = make_float4(0.f, 0.f, 0.f, 0.f); b4 = a; }
                *(uint4*)(WM + i * 256 + ((c ^ (i & 15)) << 4)) = make_uint4(pk2(a.x, a.y), pk2(a.z, a.w), pk2(b4.x, b4.y), pk2(b4.z, b4.w));
            }
            gl = g;
        }
        {
            const float2 gn = *(const float2*)(p.gm_v_g + g * 128 + lane * 2);
#pragma unroll 4
            for (int jj = 0; jj < 16; ++jj) {
                const int j = wave * 16 + jj;
                const unsigned w = *(const unsigned*)(p.ZG + (size_t)(tok0 + j) * ZW + 1024 + g * 128 + lane * 2);
                const float a = bflo(w), c2 = bfhi(w);
                const float ss = wave_sum(a * a + c2 * c2);
                const float rs = 1.0f / sqrtf(ss * (1.0f / 128.0f) + 1e-6f);
                const int d0 = lane * 2, d1 = d0 + 1;
                *(bf16_t*)(VT + d0 * 256 + (((j >> 3) ^ (d0 & 15)) << 4) + (j & 7) * 2) = (bf16_t)f2bf(a * rs * gn.x);
                *(bf16_t*)(VT + d1 * 256 + (((j >> 3) ^ (d1 & 15)) << 4) + (j & 7) * 2) = (bf16_t)f2bf(c2 * rs * gn.y);
            }
        }
        __syncthreads();
        {
            bf16x8_t A[4];
#pragma unroll
            for (int ks = 0; ks < 4; ++ks) A[ks] = ldfrag(VT, wave * 16 + fr, ks * 4 + fq, 256, 15);
            const int d0 = wave * 16 + fq * 4;
#pragma unroll
            for (int itl = 0; itl < 8; ++itl) {
                f32x4_t acc = {0.f, 0.f, 0.f, 0.f};
#pragma unroll
                for (int ks = 0; ks < 4; ++ks) if (itl >= 4 || ks < 2) acc = __builtin_amdgcn_mfma_f32_16x16x32_bf16(A[ks], ldfrag(WM, itl * 16 + fr, ks * 4 + fq, 256, 15), acc, 0, 0, 0);
                const int i = itl * 16 + fr;
                const float bias = p.gm_b[g * 128 + i];
                const size_t tok = (size_t)(tok0 + i);
                const uint2 uw = *(const uint2*)(p.ZG + tok * ZW + g * 128 + d0);
                *(uint2*)(p.yain + tok * 1024 + g * 128 + d0) = make_uint2(pk2(bflo(uw.x) * (acc[0] + bias), bfhi(uw.x) * (acc[1] + bias)), pk2(bflo(uw.y) * (acc[2] + bias), bfhi(uw.y) * (acc[3] + bias)));
            }
        }
    }
    __syncthreads();
}

__device__ __forceinline__ void ph_ret(const Params& p, int bid, int nb, float* lds) {
    float* Qs = lds;
    float* Ks = Qs + 64 * 129;
    float* Vs = Ks + 64 * 129;
    float* Ss = Vs + 64 * 16;
    float* At = Ss + 128 * 16;
    float* kd = At + 64 * 65;
    const int tid = tid_();
    const bf16_t* z = p.ZG;
    for (int it = bid; it < 256; it += nb) {
        const int vs = it & 15, h = (it >> 4) & 7, b = it >> 7;
        const float lg = log1pf(-exp2f(-5.0f - (float)h));
        const float cdec = expf(lg * 64.0f);
        __syncthreads();
        for (int i = tid; i < 2048; i += NTH) Ss[i] = 0.f;
        if (tid < 64) kd[tid] = expf(lg * (float)(63 - tid));
        for (int n = 0; n < 64; ++n) {
            const int tok0 = b * SQ + n * 64;
            __syncthreads();
            for (int e = tid; e < 4096; e += NTH) {
                const int i = e >> 6, dd = e & 63; const size_t tok = (size_t)(tok0 + i);
                const float cs = p.rope[(tok * 64 + dd) * 2], sn = p.rope[(tok * 64 + dd) * 2 + 1];
                const bf16_t* zr = z + tok * ZW;
                const float q1 = bf2f(zr[2048 + h * 128 + dd]), q2 = bf2f(zr[2048 + h * 128 + 64 + dd]);
                const float k1 = bf2f(zr[3072 + h * 128 + dd]), k2 = bf2f(zr[3072 + h * 128 + 64 + dd]);
                Qs[i * 129 + dd] = q1 * cs - q2 * sn; Qs[i * 129 + 64 + dd] = q1 * sn + q2 * cs;
                const float sc = 0.08838834764831845f;
                Ks[i * 129 + dd] = (k1 * cs - k2 * sn) * sc; Ks[i * 129 + 64 + dd] = (k1 * sn + k2 * cs) * sc;
            }
            for (int e = tid; e < 1024; e += NTH) { const int j = e >> 4, v = e & 15; Vs[e] = bf2f(z[(size_t)(tok0 + j) * ZW + 4096 + h * 256 + vs * 16 + v]); }
            __syncthreads();
            {
                const int j = tid & 63, i0 = (tid >> 6) * 8;
                float acc[8];
#pragma unroll
                for (int ii = 0; ii < 8; ++ii) acc[ii] = 0.f;
                for (int d = 0; d < 128; ++d) {
                    const float kv = Ks[j * 129 + d];
#pragma unroll
                    for (int ii = 0; ii < 8; ++ii) acc[ii] += Qs[(i0 + ii) * 129 + d] * kv;
                }
#pragma unroll
                for (int ii = 0; ii < 8; ++ii) { const int i = i0 + ii; At[i * 65 + j] = acc[ii] * expf(lg * fabsf((float)(i - j))); }
            }
            __syncthreads();
            {
                const int v = tid & 15, i0 = tid >> 4;
#pragma unroll
                for (int rep = 0; rep < 2; ++rep) {
                    const int i = i0 + 32 * rep;
                    float a = 0.f; for (int j = 0; j < 64; ++j) a += At[i * 65 + j] * Vs[j * 16 + v];
                    float c2 = 0.f; for (int d = 0; d < 128; ++d) c2 += Qs[i * 129 + d] * Ss[d * 16 + v];
                    p.obuf[(size_t)(tok0 + i) * DM + h * 256 + vs * 16 + v] = a + c2 * expf(lg * (float)(i + 1));
                }
            }
            __syncthreads();
            {
                const int v = tid & 15, d0 = tid >> 4;
#pragma unroll
                for (int rep = 0; rep < 4; ++rep) {
                    const int d = d0 + 32 * rep;
                    float a = 0.f; for (int j = 0; j < 64; ++j) a += Ks[j * 129 + d] * kd[j] * Vs[j * 16 + v];
                    Ss[d * 16 + v] = Ss[d * 16 + v] * cdec + a;
                }
            }
        }
    }
    __syncthreads();
}


__device__ __forceinline__ void ph_retprep(const Params& p, int bid, int nb, float* lds) {
    bf16_t* Kl = (bf16_t*)lds;
    bf16_t* Vl = Kl + 64 * 132;
    char* Qm = (char*)(Vl + 64 * 264);
    char* Km = Qm + 16384;
    const int tid = tid_(), wave = tid >> 6, lane = tid & 63, fr = lane & 15, fq = lane >> 4;
    for (int it = bid; it < 1024; it += nb) {
        const int n = it & 63, h = (it >> 6) & 7, b = it >> 9;
        const int tok0 = b * SQ + n * 64;
        const size_t rowbase = (size_t)(b * 8 + h) * SQ + n * 64;
        const float lg = log1pf(-exp2f(-5.0f - (float)h));
        __syncthreads();
#pragma unroll
        for (int k = 0; k < 2; ++k) {
            const int u = tid + 512 * k, i = u >> 4, dd = (u & 15) * 4; const size_t tok = (size_t)(tok0 + i);
            const float4 r0 = *(const float4*)(p.rope + (tok * 64 + dd) * 2), r1 = *(const float4*)(p.rope + (tok * 64 + dd) * 2 + 4);
            const float cs[4] = {r0.x, r0.z, r1.x, r1.z}, sn[4] = {r0.y, r0.w, r1.y, r1.w};
            const bf16_t* zr = p.ZG + tok * ZW;
            const uint2 q1w = *(const uint2*)(zr + 2048 + h * 128 + dd), q2w = *(const uint2*)(zr + 2048 + h * 128 + 64 + dd);
            const uint2 k1w = *(const uint2*)(zr + 3072 + h * 128 + dd), k2w = *(const uint2*)(zr + 3072 + h * 128 + 64 + dd);
            const float q1[4] = {bflo(q1w.x), bfhi(q1w.x), bflo(q1w.y), bfhi(q1w.y)}, q2[4] = {bflo(q2w.x), bfhi(q2w.x), bflo(q2w.y), bfhi(q2w.y)};
            const float k1[4] = {bflo(k1w.x), bfhi(k1w.x), bflo(k1w.y), bfhi(k1w.y)}, k2[4] = {bflo(k2w.x), bfhi(k2w.x), bflo(k2w.y), bfhi(k2w.y)};
            const float sc = 0.08838834764831845f, kd = expf(lg * (float)(63 - i));
            float qa[4], qb[4], ka[4], kb[4];
#pragma unroll
            for (int e = 0; e < 4; ++e) { qa[e] = q1[e] * cs[e] - q2[e] * sn[e]; qb[e] = q1[e] * sn[e] + q2[e] * cs[e]; ka[e] = (k1[e] * cs[e] - k2[e] * sn[e]) * sc; kb[e] = (k1[e] * sn[e] + k2[e] * cs[e]) * sc; }
            const uint2 qaw = make_uint2(pk2(qa[0], qa[1]), pk2(qa[2], qa[3])), qbw = make_uint2(pk2(qb[0], qb[1]), pk2(qb[2], qb[3]));
            const uint2 kaw = make_uint2(pk2(ka[0], ka[1]), pk2(ka[2], ka[3])), kbw = make_uint2(pk2(kb[0], kb[1]), pk2(kb[2], kb[3]));
            *(uint2*)(p.Qr + (rowbase + i) * 128 + dd) = qaw; *(uint2*)(p.Qr + (rowbase + i) * 128 + 64 + dd) = qbw;
            const int c = dd >> 3, o8 = (dd & 7) * 2;
            *(uint2*)(Qm + i * 256 + ((c ^ (i & 15)) << 4) + o8) = qaw; *(uint2*)(Qm + i * 256 + (((c + 8) ^ (i & 15)) << 4) + o8) = qbw;
            *(uint2*)(Km + i * 256 + ((c ^ (i & 15)) << 4) + o8) = kaw; *(uint2*)(Km + i * 256 + (((c + 8) ^ (i & 15)) << 4) + o8) = kbw;
            *(uint2*)(Kl + i * 132 + dd) = make_uint2(pk2(ka[0] * kd, ka[1] * kd), pk2(ka[2] * kd, ka[3] * kd));
            *(uint2*)(Kl + i * 132 + 64 + dd) = make_uint2(pk2(kb[0] * kd, kb[1] * kd), pk2(kb[2] * kd, kb[3] * kd));
        }
#pragma unroll
        for (int k = 0; k < 4; ++k) {
            const int u = tid + 512 * k, j = u >> 5, c = u & 31;
            *(uint4*)(Vl + j * 264 + c * 8) = *(const uint4*)(p.ZG + (size_t)(tok0 + j) * ZW + 4096 + h * 256 + c * 8);
        }
        __syncthreads();
        {
            const int jt = wave >> 1, it0 = 2 * (wave & 1);
            f32x4_t s0 = {0.f, 0.f, 0.f, 0.f}, s1 = {0.f, 0.f, 0.f, 0.f};
#pragma unroll
            for (int ks = 0; ks < 4; ++ks) {
                const bf16x8_t a = ldfrag(Km, jt * 16 + fr, ks * 4 + fq, 256, 15);
                const bf16x8_t b0 = ldfrag(Qm, it0 * 16 + fr, ks * 4 + fq, 256, 15), b1 = ldfrag(Qm, (it0 + 1) * 16 + fr, ks * 4 + fq, 256, 15);
                s0 = __builtin_amdgcn_mfma_f32_16x16x32_bf16(a, b0, s0, 0, 0, 0);
                s1 = __builtin_amdgcn_mfma_f32_16x16x32_bf16(a, b1, s1, 0, 0, 0);
            }
            const int j0 = jt * 16 + fq * 4;
            bf16_t* pg = p.Pm + (size_t)it * 4096;
#pragma unroll
            for (int tt = 0; tt < 2; ++tt) {
                const int i = (it0 + tt) * 16 + fr; const f32x4_t sv4 = tt ? s1 : s0; float pv[4];
#pragma unroll
                for (int r = 0; r < 4; ++r) pv[r] = sv4[r] * __expf(lg * fabsf((float)(i - (j0 + r))));
                *(uint2*)(pg + i * 64 + j0) = make_uint2(pk2(pv[0], pv[1]), pk2(pv[2], pv[3]));
            }
        }
        bf16_t* kt = p.KTd + (size_t)it * 8192;
#pragma unroll
        for (int k = 0; k < 2; ++k) {
            const int u = tid + 512 * k, d = u & 127, jg = u >> 7;
            unsigned w[4];
#pragma unroll
            for (int q = 0; q < 4; ++q) w[q] = (unsigned)Kl[(jg * 8 + 2 * q) * 132 + d] | ((unsigned)Kl[(jg * 8 + 2 * q + 1) * 132 + d] << 16);
            *(uint4*)(kt + d * 64 + jg * 8) = make_uint4(w[0], w[1], w[2], w[3]);
        }
        bf16_t* vt = p.Vt + (size_t)it * 16384;
#pragma unroll
        for (int k = 0; k < 4; ++k) {
            const int u = tid + 512 * k, v = u & 255, jg = u >> 8;
            unsigned w[4];
#pragma unroll
            for (int q = 0; q < 4; ++q) w[q] = (unsigned)Vl[(jg * 8 + 2 * q) * 264 + v] | ((unsigned)Vl[(jg * 8 + 2 * q + 1) * 264 + v] << 16);
            *(uint4*)(vt + v * 64 + jg * 8) = make_uint4(w[0], w[1], w[2], w[3]);
        }
    }
    __syncthreads();
}

__device__ __forceinline__ void ph_ret2(const Params& p, int bid, int nb, float* lds) {
    char* L = (char*)lds;
    constexpr int OQ = 0, OKT = 16384, OPP = 32768, OVT = 40960, TILE = 43008, OST = 2 * TILE;
    const int tid = tid_(), wave = tid >> 6, lane = tid & 63, fr = lane & 15, fq = lane >> 4;
    for (int it = bid; it < 256; it += nb) {
        const int itm = ((it & 7) * 2 + (it >> 7)) * 16 + ((it >> 3) & 15);
        const int vs = itm & 15, h = (itm >> 4) & 7, b = itm >> 7;
        const float lg = log1pf(-exp2f(-5.0f - (float)h));
        const float cdec = expf(lg * 64.0f);
        const size_t bh = (size_t)(b * 8 + h);
        const char* gQ = (const char*)(p.Qr + bh * SQ * 128);
        const char* gKT = (const char*)(p.KTd + bh * 64 * 8192);
        const char* gP = (const char*)(p.Pm + bh * 64 * 4096);
        const char* gVt = (const char*)(p.Vt + bh * 64 * 16384) + vs * 16 * 128;
        int lq[2], lkt[2];
#pragma unroll
        for (int u = 0; u < 2; ++u) { const int ci = tid + 512 * u; const int r = ci >> 4, c = ci & 15; lq[u] = r * 256 + ((c ^ (r & 15)) << 4); const int d = ci >> 3, c8 = ci & 7; lkt[u] = d * 128 + ((c8 ^ (d & 7)) << 4); }
        const int lp = (tid >> 3) * 128 + (((tid & 7) ^ ((tid >> 3) & 7)) << 4);
        const int lv = lp;
        uint4 qA0, qA1, tA0, tA1, pA, vA = make_uint4(0u, 0u, 0u, 0u), qB0, qB1, tB0, tB1, pB, vB = make_uint4(0u, 0u, 0u, 0u);
#define RET_LOAD(X_, n_) do { const size_t o0 = (size_t)(n_) * 16384 + (size_t)tid * 16, o1 = o0 + 8192; \
        q##X_##0 = *(const uint4*)(gQ + o0); q##X_##1 = *(const uint4*)(gQ + o1); t##X_##0 = *(const uint4*)(gKT + o0); t##X_##1 = *(const uint4*)(gKT + o1); p##X_ = *(const uint4*)(gP + (size_t)(n_) * 8192 + tid * 16); \
        if (tid < 128) v##X_ = *(const uint4*)(gVt + (size_t)(n_) * 32768 + tid * 16); } while (0)
#define RET_WRITE(X_, buf_) do { char* B_ = L + (buf_) * TILE; \
        *(uint4*)(B_ + OQ + lq[0]) = q##X_##0; *(uint4*)(B_ + OQ + lq[1]) = q##X_##1; *(uint4*)(B_ + OKT + lkt[0]) = t##X_##0; *(uint4*)(B_ + OKT + lkt[1]) = t##X_##1; *(uint4*)(B_ + OPP + lp) = p##X_; \
        if (tid < 128) *(uint4*)(B_ + OVT + lv) = v##X_; } while (0)
        __syncthreads();
        for (int i = tid; i < 1024; i += NTH) ((unsigned*)(L + OST))[i] = 0u;
        RET_LOAD(A, 0); RET_WRITE(A, 0); RET_LOAD(B, 1);
        f32x4_t sacc[2] = {{0.f, 0.f, 0.f, 0.f}, {0.f, 0.f, 0.f, 0.f}};
#define RET_STEP(n_, cur_, LS_, WS_) do { const int n = (n_); constexpr int cur = (cur_); \
            __syncthreads();                                     \
            if (n + 2 < 64) RET_LOAD(LS_, n + 2); \
            const char* T = L + cur * TILE; \
            if (wave < 4) {     \
                const int itl = wave; \
                f32x4_t o1 = {0.f, 0.f, 0.f, 0.f}, o2 = {0.f, 0.f, 0.f, 0.f}; \
                _Pragma("unroll") for (int ks = 0; ks < 2; ++ks) o1 = __builtin_amdgcn_mfma_f32_16x16x32_bf16(ldfrag(T + OPP, itl * 16 + fr, ks * 4 + fq, 128, 7), ldfrag(T + OVT, fr, ks * 4 + fq, 128, 7), o1, 0, 0, 0); \
                _Pragma("unroll") for (int ks = 0; ks < 4; ++ks) o2 = __builtin_amdgcn_mfma_f32_16x16x32_bf16(ldfrag(T + OQ, itl * 16 + fr, ks * 4 + fq, 256, 15), ldfrag(L + OST + cur * 4096, fr, ks * 4 + fq, 256, 15), o2, 0, 0, 0); \
                _Pragma("unroll") for (int r = 0; r < 4; ++r) { const int i = itl * 16 + fq * 4 + r; \
                    p.ob16[(size_t)(b * SQ + n * 64 + i) * DM + h * 256 + vs * 16 + fr] = (bf16_t)f2bf(o1[r] + __expf(lg * (float)(i + 1)) * o2[r]); } \
            } else {            \
                _Pragma("unroll") for (int u = 0; u < 2; ++u) { \
                    const int dt = 2 * (wave - 4) + u; \
                    sacc[u] = sacc[u] * cdec; \
                    _Pragma("unroll") for (int ks = 0; ks < 2; ++ks) sacc[u] = __builtin_amdgcn_mfma_f32_16x16x32_bf16(ldfrag(T + OKT, dt * 16 + fr, ks * 4 + fq, 128, 7), ldfrag(T + OVT, fr, ks * 4 + fq, 128, 7), sacc[u], 0, 0, 0); \
                    *(uint2*)(L + OST + (cur ^ 1) * 4096 + fr * 256 + (((dt * 2 + (fq >> 1)) ^ fr) << 4) + (fq & 1) * 8) = make_uint2(pk2(sacc[u][0], sacc[u][1]), pk2(sacc[u][2], sacc[u][3])); } \
            } \
            if (n + 1 < 64) RET_WRITE(WS_, cur ^ 1); } while (0)
#pragma unroll 1
        for (int n2 = 0; n2 < 64; n2 += 2) { RET_STEP(n2, 0, A, B); RET_STEP(n2 + 1, 1, B, A); }
#undef RET_STEP
#undef RET_LOAD
#undef RET_WRITE
    }
    __syncthreads();
}

__device__ __forceinline__ void gn_load(const Params& p, int tok, int lane, uint2 (&ow)[8], uint2 (&gw)[8]) {
#pragma unroll
    for (int h = 0; h < 8; ++h) { ow[h] = *(const uint2*)(p.ob16 + (size_t)tok * DM + h * 256 + lane * 4); gw[h] = *(const uint2*)(p.ZG + (size_t)tok * ZW + 6144 + h * 256 + lane * 4); }
}
__device__ __forceinline__ void ph_gn(const Params& p, int bid, int nb, float* lds) {
    const int tid = tid_(), wave = tid >> 6, lane = tid & 63;
    const int stride = nb * 8;
    int tok = bid * 8 + wave;
    uint2 ow[8], gw[8], own[8], gwn[8];
    if (tok < NTOK) gn_load(p, tok, lane, ow, gw);
    for (; tok < NTOK; tok += stride) {
        if (tok + stride < NTOK) gn_load(p, tok + stride, lane, own, gwn);
        float4 o[8]; float s1[8], s2[8];
#pragma unroll
        for (int h = 0; h < 8; ++h) { o[h] = make_float4(bflo(ow[h].x), bfhi(ow[h].x), bflo(ow[h].y), bfhi(ow[h].y)); s1[h] = (o[h].x + o[h].y) + (o[h].z + o[h].w); }
#pragma unroll
        for (int h = 0; h < 8; ++h) s1[h] = row_sum16(s1[h]);
#pragma unroll
        for (int h = 0; h < 8; ++h) s1[h] = xsum32(xsum16(s1[h]));
#pragma unroll
        for (int h = 0; h < 8; ++h) { const float mu = s1[h] * (1.0f / 256.0f); o[h].x -= mu; o[h].y -= mu; o[h].z -= mu; o[h].w -= mu; s2[h] = dot4(o[h], o[h]); }
#pragma unroll
        for (int h = 0; h < 8; ++h) s2[h] = row_sum16(s2[h]);
#pragma unroll
        for (int h = 0; h < 8; ++h) s2[h] = xsum32(xsum16(s2[h]));
#pragma unroll
        for (int h = 0; h < 8; ++h) {
            const float rs = 1.0f / sqrtf(s2[h] * (1.0f / 256.0f) + 1e-6f);
            const float4 gn = *(const float4*)(p.ret_gn_g + h * 256 + lane * 4);
            const float g0 = bflo(gw[h].x), g1 = bfhi(gw[h].x), g2 = bflo(gw[h].y), g3 = bfhi(gw[h].y);
            st_wt8(p.ybin + (size_t)tok * DM + h * 256 + lane * 4,
                make_uint2(pk2(siluf_(g0) * o[h].x * rs * gn.x, siluf_(g1) * o[h].y * rs * gn.y), pk2(siluf_(g2) * o[h].z * rs * gn.z, siluf_(g3) * o[h].w * rs * gn.w)));
        }
#pragma unroll
        for (int h = 0; h < 8; ++h) { ow[h] = own[h]; gw[h] = gwn[h]; }
    }
}

__device__ __forceinline__ void split8(const float4 a, const float4 b, uint4& hi, uint4& lo) {
    const float x[8] = {a.x, a.y, a.z, a.w, b.x, b.y, b.z, b.w}; unsigned h[8], l[8];
#pragma unroll
    for (int i = 0; i < 8; ++i) { h[i] = f2bf(x[i]); l[i] = f2bf(x[i] - __uint_as_float(h[i] << 16)); }
    hi = make_uint4(h[0] | (h[1] << 16), h[2] | (h[3] << 16), h[4] | (h[5] << 16), h[6] | (h[7] << 16));
    lo = make_uint4(l[0] | (l[1] << 16), l[2] | (l[3] << 16), l[4] | (l[5] << 16), l[6] | (l[7] << 16));
}
__device__ __forceinline__ bf16x8_t as_bf16x8(const uint4 v) { return __builtin_bit_cast(bf16x8_t, v); }
struct PairTab { int a[52], b[52]; };
__host__ __device__ constexpr PairTab make_pairs() {
    PairTab t{}; int n = 0;
    for (int a = 0; a < 16; ++a) for (int b = 0; b < 16; ++b) if ((a + 1) * (b + 1) <= 16) { t.a[n] = a; t.b[n] = b; ++n; }
    for (; n < 52; ++n) { t.a[n] = -1; t.b[n] = -1; }
    return t;
}
constexpr PairTab PAIRS = make_pairs();
static_assert(PAIRS.a[49] >= 0 && PAIRS.a[50] < 0, "50 candidate pairs");

template <int N, int OFF> __device__ __forceinline__ void bitonic_sort_desc(float* v) {
#pragma unroll
    for (int k = 2; k <= N; k <<= 1)
#pragma unroll
        for (int j = k >> 1; j > 0; j >>= 1)
#pragma unroll
            for (int i = 0; i < N; ++i) { const int l = i ^ j; if (l > i) { const bool up = ((i & k) == 0);
                const float a = v[OFF + i], b = v[OFF + l]; const float mx = fmaxf(a, b), mn = fminf(a, b); v[OFF + i] = up ? mx : mn; v[OFF + l] = up ? mn : mx; } }
}
template <int N> __device__ __forceinline__ void bitonic_merge_desc(float* v) {
#pragma unroll
    for (int j = N >> 1; j > 0; j >>= 1)
#pragma unroll
        for (int i = 0; i < N; ++i) { const int l = i ^ j; if (l > i) { const float a = v[i], b = v[l]; v[i] = fmaxf(a, b); v[l] = fminf(a, b); } }
}
__device__ __forceinline__ void ph_topk2(const Params& p, const float* qb, int bid, int nb, float* lds, int it_fixed) {
    const int tid = tid_(), wave = tid >> 6, lane = tid & 63;
    uint4* SK = (uint4*)lds;
    const float NEG = -INFINITY;
    const bool tc_on = (nb == 256); const int tcr0 = (bid * 8 + wave) * 16; float4 tct[8];
    if (tc_on) tc_load(p, tcr0, lane, tct);
    for (int it = (it_fixed >= 0 ? it_fixed : bid); it < 256; it += (it_fixed >= 0 ? 256 : nb)) {
        const int h = it & 7, tg = it >> 3;
        __syncthreads();
        for (int gi = tid; gi < 4096; gi += NTH) {
            const int dq = gi & 15, n = (gi >> 4) & 127, pp = gi >> 11;
            const float4* src = (const float4*)(p.peer_sk + ((size_t)(h * 2 + pp) * 128 + n) * 128 + dq * 8);
            uint4 hi, lo; split8(src[0], src[1], hi, lo);
            const int base = (((pp * 8 + (n >> 4)) * 4 + (dq >> 2)) * 2) * 64 + (dq & 3) * 16 + (n & 15);
            SK[base] = hi; SK[base + 64] = lo;
        }
        __syncthreads();
#pragma unroll 1
        for (int tile = 0; tile < 2; ++tile) {
            const int tok = tg * 256 + wave * 32 + tile * 16 + (lane & 15);
            const int qd = lane >> 4;
            float v12[2][16];
#pragma unroll
            for (int pp = 0; pp < 2; ++pp) {
                if (tc_on) { const int ti = tile * 8 + pp * 4; tc_finish(p, tcr0 + ti, lane, tct); tc_load(p, tcr0 + ti + 1, lane, tct); }
                bf16x8_t Bh[4], Bl[4];
                const float* qp = qb + (size_t)tok * DM + h * 256 + pp * 128 + 8 * qd;
#pragma unroll
                for (int ks = 0; ks < 4; ++ks) { uint4 hi, lo; split8(*(const float4*)(qp + ks * 32), *(const float4*)(qp + ks * 32 + 4), hi, lo); Bh[ks] = as_bf16x8(hi); Bl[ks] = as_bf16x8(lo); }
                float v[32];
#pragma unroll
                for (int kt = 0; kt < 8; ++kt) {
                    f32x4_t acc = {0.f, 0.f, 0.f, 0.f};
#pragma unroll
                    for (int ks = 0; ks < 4; ++ks) {
                        const bf16x8_t Ah = as_bf16x8(SK[(((pp * 8 + kt) * 4 + ks) * 2) * 64 + lane]), Al = as_bf16x8(SK[(((pp * 8 + kt) * 4 + ks) * 2 + 1) * 64 + lane]);
                        acc = __builtin_amdgcn_mfma_f32_16x16x32_bf16(Ah, Bh[ks], acc, 0, 0, 0);
                        acc = __builtin_amdgcn_mfma_f32_16x16x32_bf16(Ah, Bl[ks], acc, 0, 0, 0);
                        acc = __builtin_amdgcn_mfma_f32_16x16x32_bf16(Al, Bh[ks], acc, 0, 0, 0);
                    }
#pragma unroll
                    for (int r = 0; r < 4; ++r) v[kt * 4 + r] = __uint_as_float((__float_as_uint(acc[r]) & ~127u) | (unsigned)(kt * 16 + qd * 4 + r));
                    __builtin_amdgcn_sched_barrier(0);
                }
                if (tc_on) { const int ti = tile * 8 + pp * 4 + 1; tc_finish(p, tcr0 + ti, lane, tct); tc_load(p, tcr0 + ti + 1, lane, tct); }
                bitonic_sort_desc<16, 0>(v); bitonic_sort_desc<16, 16>(v);
                float c16[16];
#pragma unroll
                for (int i = 0; i < 16; ++i) c16[i] = fmaxf(v[i], v[31 - i]);
                bitonic_merge_desc<16>(c16);
                if (tc_on) { const int ti = tile * 8 + pp * 4 + 2; tc_finish(p, tcr0 + ti, lane, tct); tc_load(p, tcr0 + ti + 1, lane, tct); }
#pragma unroll
                for (int st = 0; st < 2; ++st) {
                    float pr[16];
#pragma unroll
                    for (int i = 0; i < 16; ++i) pr[i] = __shfl_xor(c16[i], 16 << st);
#pragma unroll
                    for (int i = 0; i < 16; ++i) c16[i] = fmaxf(c16[i], pr[15 - i]);
                    bitonic_merge_desc<16>(c16);
                }
                if (tc_on) { const int ti = tile * 8 + pp * 4 + 3; tc_finish(p, tcr0 + ti, lane, tct); if (ti < 15) tc_load(p, tcr0 + ti + 1, lane, tct); }
#pragma unroll
                for (int i = 0; i < 16; ++i) v12[pp][i] = c16[i];
            }
            float c[13]; unsigned pay[13];
#pragma unroll
            for (int s = 0; s < 13; ++s) {
                float cq[4]; unsigned pq[4];
#pragma unroll
                for (int q = 0; q < 4; ++q) {
                    const int pi = 4 * s + q; const int a = PAIRS.a[pi], b = PAIRS.b[pi];
                    if (a >= 0) {
                        const float sum = v12[0][a] + v12[1][b];
                        cq[q] = __uint_as_float((__float_as_uint(sum) & ~63u) | (unsigned)pi);
                        pq[q] = (__float_as_uint(v12[0][a]) & 127u) * 128u + (__float_as_uint(v12[1][b]) & 127u);
                    } else { cq[q] = NEG; pq[q] = 0u; }
                }
                c[s] = qd == 0 ? cq[0] : qd == 1 ? cq[1] : qd == 2 ? cq[2] : cq[3];
                pay[s] = qd == 0 ? pq[0] : qd == 1 ? pq[1] : qd == 2 ? pq[2] : pq[3];
            }
            float top[16]; unsigned eid[16];
#pragma unroll
            for (int r = 0; r < 16; ++r) {
                float m = c[0];
#pragma unroll
                for (int s = 1; s < 13; ++s) m = fmaxf(m, c[s]);
                m = fmaxf(m, __shfl_xor(m, 16)); m = fmaxf(m, __shfl_xor(m, 32));
                unsigned pw = 0u;
#pragma unroll
                for (int s = 0; s < 13; ++s) { const bool eq = (c[s] == m); pw |= eq ? pay[s] : 0u; c[s] = eq ? NEG : c[s]; }
                pw |= (unsigned)__shfl_xor((int)pw, 16); pw |= (unsigned)__shfl_xor((int)pw, 32);
                top[r] = m; eid[r] = pw;
            }
            float sum = 0.f; const float mx = top[0];
#pragma unroll
            for (int r = 0; r < 16; ++r) { top[r] = expf(top[r] - mx); sum += top[r]; }
            const float inv = 1.0f / sum;
            if (lane < 16) {
                int4* ep = (int4*)(p.eidx + (size_t)tok * 128 + h * 16); float4* gp = (float4*)(p.gatev + (size_t)tok * 128 + h * 16);
#pragma unroll
                for (int q = 0; q < 4; ++q) {
                    ep[q] = make_int4((int)eid[4 * q], (int)eid[4 * q + 1], (int)eid[4 * q + 2], (int)eid[4 * q + 3]);
                    gp[q] = make_float4(top[4 * q] * inv, top[4 * q + 1] * inv, top[4 * q + 2] * inv, top[4 * q + 3] * inv);
                }
            }
        }
    }
    __syncthreads();
}

__device__ __forceinline__ void peer_load4(const unsigned char* tab, const int (&e)[4], int lane, uint2 (&R)[4][3]) {
#pragma unroll
    for (int i = 0; i < 4; ++i) { const uint2* r = (const uint2*)(tab + (size_t)e[i] * ROW6 + lane * 8); R[i][0] = r[0]; R[i][1] = r[64]; R[i][2] = r[128]; }
}
__device__ __forceinline__ f32x32_t dec6(const uint2 (&R)[3]) { const u32x6_t w = {R[0].x, R[0].y, R[1].x, R[1].y, R[2].x, R[2].y}; return __builtin_amdgcn_cvt_scalef32_pk32_f32_fp6(w, 1.0f); }
__device__ __forceinline__ void ph_peer3(const Params& p, const float* x1, const bf16_t* h2, int bid, int nb) {
    const int tid = tid_(), wave = tid >> 6, lane = tid & 63;
    for (int t = bid * 8 + wave; t < NTOK; t += nb * 8) {
        const int b = t / SQ;
        float hv[32], y[32];
#pragma unroll
        for (int q = 0; q < 8; ++q) { const uint2 w = *(const uint2*)(h2 + (size_t)t * DM + 256 * q + lane * 4); float* d = hv + 4 * q;
            d[0] = bflo(w.x); d[1] = bfhi(w.x); d[2] = bflo(w.y); d[3] = bfhi(w.y); }
#pragma unroll
        for (int i = 0; i < 32; ++i) y[i] = 0.f;
        const int e0 = p.eidx[(size_t)t * 128 + lane], e1 = p.eidx[(size_t)t * 128 + 64 + lane];
        const float g0 = p.gatev[(size_t)t * 128 + lane], g1 = p.gatev[(size_t)t * 128 + 64 + lane];
        const float su0 = p.su[e0], su1 = p.su[e1];
        const float gv0 = g0 * p.sv[e0], gv1 = g1 * p.sv[e1];
        uint2 Uc[4][3], Un[4][3], Vc[4][3];
        { int e[4];
#pragma unroll
          for (int i = 0; i < 4; ++i) e[i] = __builtin_amdgcn_readlane(e0, i);
          peer_load4(p.U8, e, lane, Uc); }
        for (int g = 0; g < 32; ++g) {
            const bool lo = g < 16; const int k0 = (4 * g) & 63;
            const int ee = lo ? e0 : e1; const float suu = lo ? su0 : su1, gvv = lo ? gv0 : gv1;
            int e[4]; float sa[4], gw[4];
#pragma unroll
            for (int i = 0; i < 4; ++i) { e[i] = __builtin_amdgcn_readlane(ee, k0 + i);
                sa[i] = __uint_as_float(__builtin_amdgcn_readlane(__float_as_uint(suu), k0 + i)); gw[i] = __uint_as_float(__builtin_amdgcn_readlane(__float_as_uint(gvv), k0 + i)); }
            peer_load4(p.V8, e, lane, Vc);
            {
                const int gn = (g < 31) ? g + 1 : g; const int en = (gn < 16) ? e0 : e1; const int kn = (4 * gn) & 63; int e2[4];
#pragma unroll
                for (int i = 0; i < 4; ++i) e2[i] = __builtin_amdgcn_readlane(en, kn + i);
                peer_load4(p.U8, e2, lane, Un);
            }
            float a[4];
#pragma unroll
            for (int i = 0; i < 4; ++i) {
                const f32x32_t d = dec6(Uc[i]);
                float acc0 = 0.f, acc1 = 0.f;
#pragma unroll
                for (int k = 0; k < 32; k += 2) { acc0 += d[k] * hv[k]; acc1 += d[k + 1] * hv[k + 1]; }
                a[i] = acc0 + acc1;
            }
#pragma unroll
            for (int i = 0; i < 4; ++i) a[i] = row_sum16(a[i]);
#pragma unroll
            for (int i = 0; i < 4; ++i) a[i] = xsum32(xsum16(a[i]));
#pragma unroll
            for (int i = 0; i < 4; ++i) {
                const float wgt = geluf_(a[i] * sa[i]) * gw[i];
                const f32x32_t d = dec6(Vc[i]);
#pragma unroll
                for (int k = 0; k < 32; ++k) y[k] += wgt * d[k];
            }
#pragma unroll
            for (int i = 0; i < 4; ++i) { Uc[i][0] = Un[i][0]; Uc[i][1] = Un[i][1]; Uc[i][2] = Un[i][2]; }
        }
        float ss = 0.f;
#pragma unroll
        for (int q = 0; q < 8; ++q) {
            const int c = 256 * q + lane * 4;
            const float4 xv = *(const float4*)(x1 + (size_t)t * DM + c);
            const float4 ga = *(const float4*)(p.ada + b * NMOD + 5 * DM + c);
            float* yy = y + 4 * q;
            yy[0] = xv.x + ga.x * yy[0]; yy[1] = xv.y + ga.y * yy[1]; yy[2] = xv.z + ga.z * yy[2]; yy[3] = xv.w + ga.w * yy[3];
            ss += yy[0] * yy[0] + yy[1] * yy[1] + yy[2] * yy[2] + yy[3] * yy[3];
        }
        ss = wave_sum(ss);
        const float rs = 1.0f / sqrtf(ss * (1.0f / DM) + 1e-6f);
#pragma unroll
        for (int q = 0; q < 8; ++q) {
            const int c = 256 * q + lane * 4;
            const float4 gf = *(const float4*)(p.norm_f_g + c);
            const float* yy = y + 4 * q;
            *(float4*)(p.out + (size_t)t * DM + c) = make_float4(yy[0] * rs * gf.x, yy[1] * rs * gf.y, yy[2] * rs * gf.z, yy[3] * rs * gf.w);
        }
    }
}

#define LAS __attribute__((address_space(3)))
#define XB_TMO      128
#define XB_XCNT(j)  (256  + 64 * (j))
#define XB_XSUB(j)  (1280 + 64 * (j))
#define XB_XGEN(j)  (2304 + 64 * (j))
#define XB_TOP      3328
#define XB_TOPGEN   3392
#define XCD_BAR_WORDS 3456
#define XB_SPIN_CAP (1u << 18)

__device__ __forceinline__ unsigned xb_ld(unsigned* p)              { return __hip_atomic_load(p, __ATOMIC_RELAXED, __HIP_MEMORY_SCOPE_AGENT); }
__device__ __forceinline__ unsigned xb_add(unsigned* p, unsigned v) { return __hip_atomic_fetch_add(p, v, __ATOMIC_RELAXED, __HIP_MEMORY_SCOPE_AGENT); }
__device__ __forceinline__ unsigned xb_xcc_id() { return (unsigned)__builtin_amdgcn_s_getreg((3 << 11) | 20) & 0xFu; }
#define XB_SPIN(cond, bar) do { unsigned _sp = 0; while (cond) { __builtin_amdgcn_s_sleep(1); \
    if ((++_sp & 255u) == 0u) { if (xb_ld(&(bar)[XB_TMO])) break; if (_sp > XB_SPIN_CAP) { atomicAdd(&(bar)[XB_TMO], 1u); break; } } } } while (0)

struct XcdBarrier {
    unsigned* bar; unsigned x;
    volatile LAS unsigned* st;
};

__device__ __forceinline__ XcdBarrier xcd_barrier_post(unsigned* bar, volatile LAS unsigned* st) {
    XcdBarrier b; b.bar = bar; b.x = xb_xcc_id(); b.st = st;
    if (threadIdx.x == 0) (void)xb_add(&bar[XB_XCNT(b.x)], 1u);
    return b;
}
__device__ __forceinline__ void xcd_barrier_complete(unsigned* bar, unsigned x, unsigned& nloc, unsigned& nx) {
    const unsigned G = gridDim.x * gridDim.y * gridDim.z;
    unsigned sum, cnt, mine, sp = 0u;
    for (;;) {
        sum = 0u; cnt = 0u; mine = 0u;
#pragma unroll
        for (unsigned j = 0; j < 16; ++j) { const unsigned c = xb_ld(&bar[XB_XCNT(j)]); sum += c; cnt += (c > 0u) ? 1u : 0u; mine = (j == x) ? c : mine; }
        if (sum == G) break;
        __builtin_amdgcn_s_sleep(1);
        if ((++sp & 255u) == 0u) { if (xb_ld(&bar[XB_TMO])) break; if (sp > XB_SPIN_CAP) { atomicAdd(&bar[XB_TMO], 1u); break; } }
    }
    nloc = mine > 0u ? mine : 1u; nx = cnt > 0u ? cnt : 1u;
}

__device__ __forceinline__ void xcd_barrier(const XcdBarrier& b) {
    asm volatile("s_waitcnt vmcnt(0)" ::: "memory");
    __syncthreads();
    if (threadIdx.x == 0) {
        unsigned* bar = b.bar;
        __builtin_amdgcn_s_waitcnt(0);
        unsigned nloc = b.st[0], nx = b.st[1];
        if (nloc == 0u) { xcd_barrier_complete(bar, b.x, nloc, nx); b.st[0] = nloc; b.st[1] = nx; }
        const unsigned old = xb_add(&bar[XB_XSUB(b.x)], 1u);
        const unsigned gen = old / nloc;
        if (old + 1u == (gen + 1u) * nloc) {
            __builtin_amdgcn_fence(__ATOMIC_RELEASE, "agent");
            asm volatile("s_waitcnt vmcnt(0)" ::: "memory");
            const unsigned og = xb_add(&bar[XB_TOP], 1u);
            const unsigned tg = og / nx;
            if (og + 1u == (tg + 1u) * nx) xb_add(&bar[XB_TOPGEN], 1u);
            else XB_SPIN(xb_ld(&bar[XB_TOPGEN]) == tg, bar);
            __builtin_amdgcn_fence(__ATOMIC_ACQUIRE, "agent");
            xb_add(&bar[XB_XGEN(b.x)], 1u);
            asm volatile("s_waitcnt vmcnt(0)" ::: "memory");
        } else {
            XB_SPIN(xb_ld(&bar[XB_XGEN(b.x)]) == gen, bar);
            __builtin_amdgcn_fence(__ATOMIC_ACQUIRE, "agent");
            asm volatile("s_waitcnt vmcnt(0)" ::: "memory");
        }
    }
    __syncthreads();
}

template <class Epi>
__device__ __forceinline__ void gemm_run(float* lds, const bf16_t* A, const bf16_t* Bt, int M, int N, int K, const Epi& E) {
    __syncthreads();
    pg8::Gemm g{A, Bt, M, N, K}; pg8::StaticOrder S; S.init(M, N, (int)gridDim.x, (int)blockIdx.x);
    pg8::gemm_phase<Epi, pg8::StaticOrder, true, true>((PG8_LAS unsigned char*)lds, g, S, E);
    __syncthreads();
}
constexpr int NPHASE = 11;
template <int PH>
__device__ __forceinline__ void run_phase(const Params& p, int bid, int nb, float* lds) {
    asm volatile("" : "+s"(bid));
    if constexpr (PH == 0) ph_prep(p, bid, nb, lds);
    if constexpr (PH == 1) ph_modnorm(p, p.x, p.norm1_g, 0 * DM, 1 * DM, p.hb, bid, nb, lds);
    if constexpr (PH == 2) gemm_run(lds, p.hb, p.Wt1, NTOK, ZW, DM, pg8::EpiZG{p.ZG, p.b_bg});
    if constexpr (PH == 3) { ph_retprep(p, bid, nb, lds); ph_gmlp2(p, bid, nb, lds); }
    if constexpr (PH == 11) ph_ret2(p, bid, nb, lds);
    if constexpr (PH == 4) ph_gn(p, bid, nb, lds);
    if constexpr (PH == 5) {
        gemm_run(lds, p.yain, p.Wta, NTOK, DM, 1024, pg8::EpiMixB<0>{p.hb, p.ZG, 0});
        gemm_run(lds, p.ybin, p.Wtb, NTOK, DM, DM, pg8::EpiMixB<1>{p.hb, p.ZG, 2048});
    }
    if constexpr (PH == 6) gemm_run(lds, p.hb, p.Wto, NTOK, DM, DM, pg8::EpiResF{p.obuf, p.x, p.ada + 2 * DM});
    if constexpr (PH == 7) { ph_modnorm(p, p.obuf, p.norm2_g, 3 * DM, 4 * DM, p.hb, bid, nb, lds); if (nb != 256) ph_tabconv(p, bid, nb); }
    if constexpr (PH == 8) {
        gemm_run(lds, p.hb, p.Wtq, NTOK, DM, DM, pg8::EpiF32{p.qbuf, DM});
        if (nb == 256) {
            pg8::StaticOrder S; S.init(NTOK, DM, (int)gridDim.x, (int)blockIdx.x); pg8::Unit u; S.next(0, u);
            asm volatile("s_waitcnt vmcnt(0)" ::: "memory"); __syncthreads();
            ph_topk2(p, p.qbuf, bid, nb, lds, u.pm * 8 + u.pn);
        }
    }
    if constexpr (PH == 9) { if (nb != 256) ph_topk2(p, p.qbuf, bid, nb, lds, -1); }
    if constexpr (PH == 10) ph_peer3(p, p.obuf, p.hb, bid, nb);
}

constexpr int MISC_OFF = 132 * 1024;
__global__ void __launch_bounds__(NTH) k_mega(Params p) {
    extern __shared__ __attribute__((aligned(16))) float lds[];
    const int bid = blockIdx.x, nb = gridDim.x;
    volatile LAS unsigned* misc = (volatile LAS unsigned*)((LAS unsigned char*)lds + MISC_OFF);
    if (threadIdx.x < 4) misc[threadIdx.x] = 0u;
    __syncthreads();
    XcdBarrier bar = xcd_barrier_post(p.bar, misc);
    run_phase<0>(p, bid, nb, lds); xcd_barrier(bar);
    run_phase<1>(p, bid, nb, lds); xcd_barrier(bar);
    run_phase<2>(p, bid, nb, lds); xcd_barrier(bar);
    run_phase<3>(p, bid, nb, lds); xcd_barrier(bar);
    run_phase<11>(p, bid, nb, lds); xcd_barrier(bar);
    run_phase<4>(p, bid, nb, lds); xcd_barrier(bar);
    run_phase<5>(p, bid, nb, lds); xcd_barrier(bar);
    run_phase<6>(p, bid, nb, lds); xcd_barrier(bar);
    run_phase<7>(p, bid, nb, lds); xcd_barrier(bar);
    run_phase<8>(p, bid, nb, lds); xcd_barrier(bar);
    if (nb != 256) { run_phase<9>(p, bid, nb, lds); xcd_barrier(bar); }
    run_phase<10>(p, bid, nb, lds);
}

extern "C" void kernel_launch(void* const* d_in, const int* in_sizes, int n_in, void* d_out, int out_size, void* d_ws, size_t ws_size, hipStream_t stream) {
    Params p{};
    p.x = (const float*)d_in[0]; p.c = (const float*)d_in[1]; p.pos = (const int*)d_in[2];
    p.w_ada = (const float*)d_in[3]; p.b_ada = (const float*)d_in[4]; p.norm1_g = (const float*)d_in[5]; p.w_in = (const float*)d_in[6];
    p.w_bg = (const float*)d_in[7]; p.b_bg = (const float*)d_in[8]; p.gm_v_g = (const float*)d_in[9]; p.gm_ws = (const float*)d_in[10];
    p.gm_b = (const float*)d_in[11]; p.ret_gn_g = (const float*)d_in[12]; p.w_a_out = (const float*)d_in[13]; p.w_b_out = (const float*)d_in[14];
    p.w_o = (const float*)d_in[15]; p.norm2_g = (const float*)d_in[16]; p.peer_wq = (const float*)d_in[17]; p.peer_sk = (const float*)d_in[18];
    p.peer_u = (const float*)d_in[19]; p.peer_v = (const float*)d_in[20]; p.norm_f_g = (const float*)d_in[21];
    p.out = (float*)d_out;
    char* w = (char*)d_ws; size_t off = 0;
    auto take = [&](size_t bytes) { char* r = w + off; off += (bytes + 255) & ~(size_t)255; return r; };
    p.bar = (unsigned*)take(XCD_BAR_WORDS * 4);
    p.ada = (float*)take(2 * NMOD * 4);
    p.rope = (float*)take((size_t)NTOK * 128 * 4);
    p.eidx = (int*)take((size_t)NTOK * 128 * 4);
    p.gatev = (float*)take((size_t)NTOK * 128 * 4);
    p.Wt1 = (bf16_t*)take((size_t)ZW * DM * 2);
    p.Wta = (bf16_t*)take((size_t)DM * 1024 * 2);
    p.Wtb = (bf16_t*)take((size_t)DM * DM * 2);
    p.Wto = (bf16_t*)take((size_t)DM * DM * 2);
    p.Wtq = (bf16_t*)take((size_t)DM * DM * 2);
    p.hb = (bf16_t*)take((size_t)NTOK * DM * 2);
    p.ZG = (bf16_t*)take((size_t)NTOK * ZW * 2);
    p.qbuf = (float*)p.ZG;
    p.obuf = (float*)take((size_t)NTOK * DM * 4);
    p.ybin = (bf16_t*)take((size_t)NTOK * DM * 2);
    p.yain = (bf16_t*)take((size_t)NTOK * 1024 * 2);
    p.U8 = (unsigned char*)p.ZG + (size_t)NTOK * DM * 4;
    p.V8 = p.U8 + (size_t)16384 * ROW6;
    p.su = (float*)take(16384 * 4); p.sv = (float*)take(16384 * 4);
    p.Qr = (bf16_t*)take((size_t)NTOK * 1024 * 2);
    p.Pm = (bf16_t*)take((size_t)16 * 64 * 4096 * 2);
    p.KTd = (bf16_t*)take((size_t)NTOK * 1024 * 2);
    p.Vt = (bf16_t*)take((size_t)NTOK * 2048 * 2);
    p.ob16 = (bf16_t*)take((size_t)NTOK * DM * 2);
    if (off > ws_size) { fprintf(stderr, "kernel_launch: workspace too small: need %zu have %zu\n", off, ws_size); return; }
    static int grid = 0;
    if (!grid) {
        int dev = 0, cus = 0, per_cu = 0;
        (void)hipGetDevice(&dev); (void)hipDeviceGetAttribute(&cus, hipDeviceAttributeMultiprocessorCount, dev);
        (void)hipFuncSetAttribute((const void*)k_mega, hipFuncAttributeMaxDynamicSharedMemorySize, LDS_BYTES);
        (void)hipOccupancyMaxActiveBlocksPerMultiprocessor(&per_cu, k_mega, NTH, LDS_BYTES);
        (void)per_cu;
        grid = cus;
    }
    (void)hipMemsetAsync(p.bar, 0, XCD_BAR_WORDS * 4, stream);
    hipLaunchKernelGGL(k_mega, dim3(grid), dim3(NTH), LDS_BYTES, stream, p);
    hipError_t e = hipPeekAtLastError();
    if (e != hipSuccess) fprintf(stderr, "launch failed: %s (grid %d)\n", hipGetErrorString(e), grid);
}
```

```cpp
#include <hip/hip_runtime.h>
#include <hip/hip_cooperative_groups.h>
#include <stdint.h>
#include <math.h>
#include <cstdio>

namespace cg = cooperative_groups;

constexpr int DM = 2048;
constexpr int SQ = 4096;
constexpr int NTOK = 8192;
constexpr int NTH = 512;
constexpr int ZW = 12288;
constexpr int NMOD = 12288;
constexpr int LDS_BYTES = 136 * 1024;

typedef unsigned short bf16_t;

struct Params {
    const float *x, *c; const int* pos;
    const float *w_ada, *b_ada, *norm1_g, *w_in, *w_bg, *b_bg, *gm_v_g, *gm_ws, *gm_b, *ret_gn_g, *w_a_out, *w_b_out, *w_o, *norm2_g,
                *peer_wq, *peer_sk, *peer_u, *peer_v, *norm_f_g;
    float* out;
    float *ada, *rope, *gatev; int* eidx;
    bf16_t *Wt1, *Wta, *Wtb, *Wto, *Wtq;
    bf16_t *hb;
    bf16_t *ZG;
    float *obuf;
    bf16_t *ybin, *yain;
    float *qbuf;
    unsigned char *U8, *V8;
    float *su, *sv;
    bf16_t *Qr, *Pm, *KTd, *Vt;
    bf16_t *ob16;
    unsigned *bar;
};

__constant__ float c_freq[64] = {
1.000000000e+00f, 8.659643531e-01f, 7.498942018e-01f, 6.493816376e-01f, 5.623413324e-01f, 4.869675338e-01f, 4.216965139e-01f, 3.651741147e-01f, 3.162277639e-01f, 2.738419771e-01f, 2.371373773e-01f, 2.053525001e-01f, 1.778279394e-01f, 1.539926529e-01f, 1.333521456e-01f, 1.154781953e-01f, 1.000000015e-01f, 8.659642935e-02f, 7.498942316e-02f, 6.493816525e-02f, 5.623413250e-02f, 4.869675264e-02f, 4.216964915e-02f, 3.651741147e-02f, 3.162277490e-02f, 2.738419548e-02f, 2.371373773e-02f, 2.053525113e-02f, 1.778279431e-02f, 1.539926510e-02f, 1.333521400e-02f, 1.154781971e-02f, 9.999999776e-03f, 8.659643121e-03f, 7.498942316e-03f, 6.493816152e-03f, 5.623413250e-03f, 4.869675264e-03f, 4.216964822e-03f, 3.651741194e-03f, 3.162277630e-03f, 2.738419687e-03f, 2.371373819e-03f, 2.053525066e-03f, 1.778279431e-03f, 1.539926510e-03f, 1.333521446e-03f, 1.154782018e-03f, 1.000000047e-03f, 8.659643354e-04f, 7.498941850e-04f, 6.493816036e-04f, 5.623413017e-04f, 4.869675322e-04f, 4.216965172e-04f, 3.651741135e-04f, 3.162277571e-04f, 2.738419571e-04f, 2.371373703e-04f, 2.053525095e-04f, 1.778279402e-04f, 1.539926598e-04f, 1.333521504e-04f, 1.154782003e-04f };

__device__ __forceinline__ int tid_() { int t = threadIdx.x; asm volatile("" : "+v"(t)); return t; }
template <int CTRL> __device__ __forceinline__ float dppf(float x) { return __uint_as_float((unsigned)__builtin_amdgcn_update_dpp(0, (int)__float_as_uint(x), CTRL, 0xf, 0xf, true)); }
__device__ __forceinline__ float row_sum16(float v) { v += dppf<0xB1>(v); v += dppf<0x4E>(v); v += dppf<0x141>(v); v += dppf<0x140>(v); return v; }
__device__ __forceinline__ float xsum16(float v) { const auto r = __builtin_amdgcn_permlane16_swap(__float_as_uint(v), __float_as_uint(v), false, false); return __uint_as_float(r[0]) + __uint_as_float(r[1]); }
__device__ __forceinline__ float xsum32(float v) { const auto r = __builtin_amdgcn_permlane32_swap(__float_as_uint(v), __float_as_uint(v), false, false); return __uint_as_float(r[0]) + __uint_as_float(r[1]); }
__device__ __forceinline__ float xmax16(float v) { const auto r = __builtin_amdgcn_permlane16_swap(__float_as_uint(v), __float_as_uint(v), false, false); return fmaxf(__uint_as_float(r[0]), __uint_as_float(r[1])); }
__device__ __forceinline__ float xmax32(float v) { const auto r = __builtin_amdgcn_permlane32_swap(__float_as_uint(v), __float_as_uint(v), false, false); return fmaxf(__uint_as_float(r[0]), __uint_as_float(r[1])); }
__device__ __forceinline__ float wave_sum(float v) { v = row_sum16(v); v += __shfl_xor(v, 16); v += __shfl_xor(v, 32); return v; }
__device__ __forceinline__ float wave_max_b(float v) {
    v = fmaxf(v, dppf<0xB1>(v)); v = fmaxf(v, dppf<0x4E>(v)); v = fmaxf(v, dppf<0x141>(v)); v = fmaxf(v, dppf<0x140>(v));
    v = fmaxf(v, __shfl_xor(v, 16)); v = fmaxf(v, __shfl_xor(v, 32)); return v;
}
__device__ __forceinline__ float wave_max(float v) {
    v = fmaxf(v, dppf<0xB1>(v)); v = fmaxf(v, dppf<0x4E>(v)); v = fmaxf(v, dppf<0x141>(v)); v = fmaxf(v, dppf<0x140>(v));
    return xmax32(xmax16(v));
}
__device__ __forceinline__ float sigmoidf_(float x) { return 1.0f / (1.0f + expf(-x)); }
__device__ __forceinline__ float siluf_(float x) { return x * sigmoidf_(x); }
__device__ __forceinline__ float geluf_(float x) { return 0.5f * x * (1.0f + erff(x * 0.70710678118654752f)); }
__device__ __forceinline__ float dot4(float4 a, float4 b) { return a.x * b.x + a.y * b.y + a.z * b.z + a.w * b.w; }
__device__ __forceinline__ float bf2f(bf16_t v) { return __uint_as_float((unsigned)v << 16); }
__device__ __forceinline__ float bflo(unsigned w) { return __uint_as_float(w << 16); }
__device__ __forceinline__ float bfhi(unsigned w) { return __uint_as_float(w & 0xffff0000u); }
__device__ __forceinline__ unsigned f2bf(float f) { unsigned u = __float_as_uint(f); return (u + 0x7fffu + ((u >> 16) & 1u)) >> 16; }
__device__ __forceinline__ unsigned pk2(float lo, float hi) { return f2bf(lo) | (f2bf(hi) << 16); }

__device__ __forceinline__ void st_wt8(void* ptr, uint2 v) { __hip_atomic_store((unsigned long long*)ptr, ((unsigned long long)v.y << 32) | v.x, __ATOMIC_RELAXED, __HIP_MEMORY_SCOPE_AGENT); }
__device__ __forceinline__ void sincos_acc(float ang, float& s, float& c) {
    const double x = (double)ang;
    const double k = rint(x * 0.63661977236758134308);
    double r = fma(-k, 1.57079632679489655800, x); r = fma(-k, 6.12323399573676603587e-17, r);
    const double r2 = r * r;
    const double sp = r * (1.0 + r2 * (-1.0 / 6.0 + r2 * (1.0 / 120.0 + r2 * (-1.0 / 5040.0 + r2 * (1.0 / 362880.0 + r2 * (-1.0 / 39916800.0 + r2 * (1.0 / 6227020800.0)))))));
    const double cp = 1.0 + r2 * (-0.5 + r2 * (1.0 / 24.0 + r2 * (-1.0 / 720.0 + r2 * (1.0 / 40320.0 + r2 * (-1.0 / 3628800.0 + r2 * (1.0 / 479001600.0 + r2 * (-1.0 / 87178291200.0)))))));
    const int q = ((int)k) & 3;
    const float fs = (float)sp, fc = (float)cp;
    s = (q == 0) ? fs : (q == 1) ? fc : (q == 2) ? -fs : -fc;
    c = (q == 0) ? fc : (q == 1) ? -fs : (q == 2) ? -fc : fs;
}

namespace pg8 {
#define PG8_LAS __attribute__((address_space(3)))
typedef unsigned short bf16_t;
typedef short bf16x8 __attribute__((ext_vector_type(8)));
typedef float f32x4 __attribute__((ext_vector_type(4)));
typedef unsigned u32x4 __attribute__((ext_vector_type(4)));
constexpr int BM = 256, BK = 64, HALF = 128, HTB = HALF * BK * 2  , STAGE_BYTES = 8 * HTB, NXCD = 8, WGM = 8;

__host__ __device__ __forceinline__ int lds_byte(int r, int c) { const int st = (r >> 4) * 2 + (c >> 5), rr = r & 15, cc = c & 31, ob = rr * 64 + cc * 2; return st * 1024 + (ob ^ (((ob >> 9) & 1) << 5)); }
__host__ __device__ __forceinline__ void stage_rc(int b, int& R, int& C) { const int st = b / 1024, sb = b % 1024, swz = sb ^ (((sb >> 9) & 1) << 5); R = (st >> 1) * 16 + swz / 64; C = (st & 1) * 32 + (swz % 64) / 2; }
__host__ __device__ __forceinline__ int perm32(int rho) { const int n = rho >> 4, i = rho & 15; return 8 * (i >> 2) + 4 * n + (i & 3); }

struct Unit { int pm, pn; };
struct Gemm { const bf16_t* A; const bf16_t* Bt; int M, N, K; };

struct StaticOrder {
    int nM, nN, nwg, G, c;
    __host__ __device__ void init(int M, int N, int G_, int c_) { nM = M / BM; nN = N / BM; nwg = nM * nN; G = G_; c = c_; }
    __host__ __device__ bool next(int i, Unit& u) const {
        const long L = (long)i * G + c; if (L >= nwg) return false;
        int wgid = (int)L; { const int q = nwg / NXCD, r = nwg % NXCD, xcd = wgid % NXCD, off = wgid / NXCD; wgid = (xcd < r ? xcd * (q + 1) : r * (q + 1) + (xcd - r) * q) + off; }
        const int nig = WGM * nN, gid = wgid / nig, fm = gid * WGM, gsz = (nM - fm) < WGM ? (nM - fm) : WGM;
        u.pm = fm + ((wgid % nig) % gsz); u.pn = (wgid % nig) / gsz; return true;
    }
    __device__ __forceinline__ void a_ready(const Unit&) const {}
    __device__ __forceinline__ void done(const Unit&) const {}
};

__device__ __forceinline__ unsigned cvt_pk_bf16(float lo, float hi) { unsigned r; asm volatile("v_cvt_pk_bf16_f32 %0, %1, %2" : "=v"(r) : "v"(lo), "v"(hi)); return r; }
typedef float f32x2 __attribute__((ext_vector_type(2)));
__device__ __forceinline__ f32x2 gelu_pk(f32x2 v) {
    const f32x2 av = __builtin_elementwise_abs(v), d = av * 0.2316418882f + 1.0f;
    f32x2 t; t.x = __builtin_amdgcn_rcpf(d.x); t.y = __builtin_amdgcn_rcpf(d.y);
    f32x2 q = t * 0.5307027145f + (-0.7265760135f); q = q * t + 0.7107068705f; q = q * t + (-0.142248368f); q = q * t + 0.127414796f; q = q * t;
    const f32x2 s = (v * v) * (-0.72134752044f);
    f32x2 e; e.x = __builtin_amdgcn_exp2f(s.x); e.y = __builtin_amdgcn_exp2f(s.y);
    const f32x2 m = v * (q * e), r = v - m;
    f32x2 o; o.x = v.x < 0.f ? m.x : r.x; o.y = v.y < 0.f ? m.y : r.y; return o;
}

typedef unsigned u32x2v __attribute__((ext_vector_type(2)));
struct EpiZG {
    static constexpr bool PERM = true, AFTER_DRAIN = false;
    bf16_t* O; const float* bias;
    __device__ __forceinline__ void operator()(const f32x4 (&acc)[2][2][4][2], const Unit& u, int wr, int wc, int fr, int fq) const {
        const int row0 = u.pm * BM + wr * 64 + fr, col0 = u.pn * BM + wc * 32 + 8 * fq;
        const int mode = u.pn < 8 ? 1 : (u.pn < 32 ? 0 : 2);
        f32x4 bv[2][2];
#pragma unroll
        for (int bj = 0; bj < 2; ++bj)
#pragma unroll
            for (int n = 0; n < 2; ++n) bv[bj][n] = (mode == 2) ? *(const f32x4*)(bias + (col0 - 8192) + bj * HALF + 4 * n) : (f32x4){0.f, 0.f, 0.f, 0.f};
#pragma unroll
        for (int ai = 0; ai < 2; ++ai)
#pragma unroll
            for (int m = 0; m < 4; ++m) { bf16_t* rowp = O + (size_t)(row0 + ai * HALF + m * 16) * ZW + col0;
#pragma unroll
                for (int bj = 0; bj < 2; ++bj) { f32x4 v0 = acc[ai][bj][m][0], v1 = acc[ai][bj][m][1];
                    if (mode == 1) { f32x2 a = gelu_pk((f32x2){v0[0], v0[1]}), b = gelu_pk((f32x2){v0[2], v0[3]}), c = gelu_pk((f32x2){v1[0], v1[1]}), d = gelu_pk((f32x2){v1[2], v1[3]});
                        v0 = (f32x4){a.x, a.y, b.x, b.y}; v1 = (f32x4){c.x, c.y, d.x, d.y}; }
                    if (mode == 2) { v0 = v0 + bv[bj][0]; v1 = v1 + bv[bj][1];
#pragma unroll
                        for (int e = 0; e < 4; ++e) { v0[e] = __builtin_amdgcn_rcpf(1.0f + __expf(-v0[e])); v1[e] = __builtin_amdgcn_rcpf(1.0f + __expf(-v1[e])); } }
                    u32x4 w; w.x = cvt_pk_bf16(v0[0], v0[1]); w.y = cvt_pk_bf16(v0[2], v0[3]); w.z = cvt_pk_bf16(v1[0], v1[1]); w.w = cvt_pk_bf16(v1[2], v1[3]);
                    *(u32x4*)(rowp + bj * HALF) = w; } }
    }
};
template <int ACCUM> struct EpiMixB {
    static constexpr bool PERM = true, AFTER_DRAIN = false;
    bf16_t* Mo; const bf16_t* ZGp; int goff;
    __device__ __forceinline__ void operator()(const f32x4 (&acc)[2][2][4][2], const Unit& u, int wr, int wc, int fr, int fq) const {
        const int row0 = u.pm * BM + wr * 64 + fr, col0 = u.pn * BM + wc * 32 + 8 * fq;
#pragma unroll
        for (int ai = 0; ai < 2; ++ai)
#pragma unroll
            for (int m = 0; m < 4; ++m) { const size_t row = (size_t)(row0 + ai * HALF + m * 16);
#pragma unroll
                for (int bj = 0; bj < 2; ++bj) { const f32x4 v0 = acc[ai][bj][m][0], v1 = acc[ai][bj][m][1];
                    const u32x4 g = *(const u32x4*)(ZGp + row * ZW + 8192 + goff + col0 + bj * HALF);
                    float o[8];
                    o[0] = bflo(g.x) * v0[0]; o[1] = bfhi(g.x) * v0[1]; o[2] = bflo(g.y) * v0[2]; o[3] = bfhi(g.y) * v0[3];
                    o[4] = bflo(g.z) * v1[0]; o[5] = bfhi(g.z) * v1[1]; o[6] = bflo(g.w) * v1[2]; o[7] = bfhi(g.w) * v1[3];
                    bf16_t* mp = Mo + row * DM + col0 + bj * HALF;
                    if (ACCUM) { const u32x4 old = *(const u32x4*)mp;
                        o[0] += bflo(old.x); o[1] += bfhi(old.x); o[2] += bflo(old.y); o[3] += bfhi(old.y); o[4] += bflo(old.z); o[5] += bfhi(old.z); o[6] += bflo(old.w); o[7] += bfhi(old.w); }
                    u32x4 w; w.x = cvt_pk_bf16(o[0], o[1]); w.y = cvt_pk_bf16(o[2], o[3]); w.z = cvt_pk_bf16(o[4], o[5]); w.w = cvt_pk_bf16(o[6], o[7]);
                    *(u32x4*)mp = w; } }
    }
};
struct EpiResF {
    static constexpr bool PERM = false, AFTER_DRAIN = false;
    float* x1; const float* x; const float* ga;
    __device__ __forceinline__ void operator()(const f32x4 (&acc)[2][2][4][2], const Unit& u, int wr, int wc, int fr, int fq) const {
        const int row0 = u.pm * BM + wr * 64 + fr, col0 = u.pn * BM + wc * 32 + 4 * fq;
        const int b = (u.pm * BM) / SQ;
        f32x4 gv[2][2];
#pragma unroll
        for (int bj = 0; bj < 2; ++bj)
#pragma unroll
            for (int n = 0; n < 2; ++n) gv[bj][n] = *(const f32x4*)(ga + b * NMOD + col0 + bj * HALF + n * 16);
#pragma unroll
        for (int ai = 0; ai < 2; ++ai)
#pragma unroll
            for (int m = 0; m < 4; ++m) { const size_t off = (size_t)(row0 + ai * HALF + m * 16) * DM + col0;
#pragma unroll
                for (int bj = 0; bj < 2; ++bj)
#pragma unroll
                    for (int n = 0; n < 2; ++n) { const f32x4 xv = *(const f32x4*)(x + off + bj * HALF + n * 16);
                        *(f32x4*)(x1 + off + bj * HALF + n * 16) = xv + gv[bj][n] * acc[ai][bj][m][n]; } }
    }
};
struct EpiF32 {
    static constexpr bool PERM = false, AFTER_DRAIN = false;
    float* O; int ldc;
    __device__ __forceinline__ void operator()(const f32x4 (&acc)[2][2][4][2], const Unit& u, int wr, int wc, int fr, int fq) const {
        const int row0 = u.pm * BM + wr * 64 + fr, col0 = u.pn * BM + wc * 32 + 4 * fq;
#pragma unroll
        for (int ai = 0; ai < 2; ++ai)
#pragma unroll
            for (int m = 0; m < 4; ++m) { const size_t off = (size_t)(row0 + ai * HALF + m * 16) * ldc + col0;
#pragma unroll
                for (int bj = 0; bj < 2; ++bj)
#pragma unroll
                    for (int n = 0; n < 2; ++n) *(f32x4*)(O + off + bj * HALF + n * 16) = acc[ai][bj][m][n]; }
    }
};

template <class Epi, class Sched, bool ALIGN_EPI = false, bool SP2 = false>
__device__ __forceinline__ void gemm_phase(PG8_LAS unsigned char* lds, const Gemm g, const Sched& S, const Epi& E) {
    const int tid = threadIdx.x, wid = __builtin_amdgcn_readfirstlane(tid >> 6), lane = tid & 63, wr = wid >> 2, wc = wid & 3, fr = lane & 15, fq = lane >> 4;
    const int K = g.K, nt = K / BK;
    unsigned voffA[2], voffB[2];
#pragma unroll
    for (int i = 0; i < 2; ++i) { int R, C; stage_rc(tid * 16 + i * 8192, R, C); const int Rb = Epi::PERM ? ((R & ~31) + perm32(R & 31)) : R;
        voffA[i] = (unsigned)(R * K + C) * 2u; voffB[i] = (unsigned)(Rb * K + C) * 2u; }
    const size_t kstep = (size_t)(BK * 2);
    const size_t hstep = (size_t)HALF * K * 2;
    const size_t tstep = 2 * hstep;
    const unsigned ldsw = (unsigned)wid * 1024u;
    const int aoff = lds_byte(wr * 64 + fr, fq * 8), boff = lds_byte(wc * 32 + fr, fq * 8);
#define PG8_SA(b, h) (((b) * 2 + (h)) * HTB)
#define PG8_SB(b, h) ((4 + (b) * 2 + (h)) * HTB)
#define PG8_STAGE(bufoff, gbase, voff) do { _Pragma("unroll") for (int _i = 0; _i < 2; ++_i) \
        __builtin_amdgcn_global_load_lds((const unsigned*)((const char*)(gbase) + (voff)[_i]), (PG8_LAS unsigned*)(lds + (bufoff) + ldsw + _i * 8192), 16, 0, 0); } while (0)
#define PG8_LDA(dst, b, h) do { _Pragma("unroll") for (int m = 0; m < 4; ++m) _Pragma("unroll") for (int k = 0; k < 2; ++k) dst[m][k] = *(const PG8_LAS bf16x8*)(lds + PG8_SA(b, h) + aoff + m * 2048 + k * 1024); } while (0)
#define PG8_LDB(dst, b, h) do { _Pragma("unroll") for (int n = 0; n < 2; ++n) _Pragma("unroll") for (int k = 0; k < 2; ++k) dst[n][k] = *(const PG8_LAS bf16x8*)(lds + PG8_SB(b, h) + boff + n * 2048 + k * 1024); } while (0)
#define PG8_MMA(ai, bj, At, Bt) do { __builtin_amdgcn_s_setprio(1); _Pragma("unroll") for (int m = 0; m < 4; ++m) _Pragma("unroll") for (int n = 0; n < 2; ++n) _Pragma("unroll") for (int k = 0; k < 2; ++k) \
        acc[ai][bj][m][n] = __builtin_amdgcn_mfma_f32_16x16x32_bf16(Bt[n][k], At[m][k], acc[ai][bj][m][n], 0, 0, 0); __builtin_amdgcn_s_setprio(0); } while (0)
#define PG8_WAIT_V(n) asm volatile("s_waitcnt vmcnt(" #n ")" ::: "memory")
#define PG8_WAIT_L(n) asm volatile("s_waitcnt lgkmcnt(" #n ")" ::: "memory")
#define PG8_BAR __builtin_amdgcn_s_barrier()
#define PG8_SCHED __builtin_amdgcn_sched_barrier(0)
    Unit cur, nxt; int ui = 0;
    if (!S.next(0, cur)) return;
    f32x4 acc[2][2][4][2];
#pragma unroll
    for (int a = 0; a < 2; ++a)
#pragma unroll
        for (int b = 0; b < 2; ++b)
#pragma unroll
            for (int m = 0; m < 4; ++m)
#pragma unroll
                for (int n = 0; n < 2; ++n) acc[a][b][m][n] = (f32x4){0.f, 0.f, 0.f, 0.f};
    bf16x8 At[4][2], B0[2][2], B1[2][2];
    const char* cA = (const char*)g.A + (size_t)cur.pm * tstep; const char* cB = (const char*)g.Bt + (size_t)cur.pn * tstep;
    S.a_ready(cur);
    if constexpr (SP2) {
        PG8_STAGE(PG8_SB(0, 0), cB, voffB); PG8_STAGE(PG8_SB(0, 1), cB + hstep, voffB); PG8_STAGE(PG8_SA(0, 0), cA, voffA); PG8_STAGE(PG8_SA(0, 1), cA + hstep, voffA);
        if (wr == 1) PG8_BAR;
        PG8_WAIT_V(2); PG8_BAR;
        PG8_STAGE(PG8_SB(1, 0), cB + kstep, voffB); PG8_STAGE(PG8_SA(1, 0), cA + kstep, voffA); PG8_STAGE(PG8_SB(1, 1), cB + hstep + kstep, voffB);
        PG8_WAIT_V(6); PG8_BAR;
    } else {
        PG8_STAGE(PG8_SB(0, 0), cB, voffB); PG8_STAGE(PG8_SA(0, 0), cA, voffA); PG8_STAGE(PG8_SB(0, 1), cB + hstep, voffB); PG8_STAGE(PG8_SA(0, 1), cA + hstep, voffA);
        if (wr == 1) PG8_BAR;
        PG8_WAIT_V(4); PG8_BAR;
        PG8_STAGE(PG8_SB(1, 0), cB + kstep, voffB); PG8_STAGE(PG8_SA(1, 0), cA + kstep, voffA); PG8_STAGE(PG8_SB(1, 1), cB + hstep + kstep, voffB);
        PG8_WAIT_V(6); PG8_BAR;
    }
    for (;;) {
        const bool has_next = S.next(ui + 1, nxt);
        const char* nA = has_next ? (const char*)g.A + (size_t)nxt.pm * tstep : cA; const char* nB = has_next ? (const char*)g.Bt + (size_t)nxt.pn * tstep : cB;
        for (int t = 0; t < nt; t += 2) {
            const bool last = (t == nt - 2);
            const char* a1 = cA + (size_t)(t + 1) * kstep;
            const char* a2 = last ? nA : cA + (size_t)(t + 2) * kstep; const char* b2 = last ? nB : cB + (size_t)(t + 2) * kstep;
            const char* a3 = a2 + kstep; const char* b3 = b2 + kstep;
            if (last && has_next) S.a_ready(nxt);
            if constexpr (SP2) {
            PG8_LDB(B0, 0, 0); PG8_LDB(B1, 0, 1); PG8_SCHED; PG8_LDA(At, 0, 0); PG8_STAGE(PG8_SA(1, 1), a1 + hstep, voffA);
            PG8_WAIT_V(8); PG8_WAIT_L(0); PG8_BAR; PG8_MMA(0, 0, At, B0); PG8_MMA(0, 1, At, B1); PG8_BAR; PG8_SCHED;
            PG8_LDA(At, 0, 1); PG8_STAGE(PG8_SB(0, 0), b2, voffB); PG8_STAGE(PG8_SB(0, 1), b2 + hstep, voffB); PG8_STAGE(PG8_SA(0, 0), a2, voffA);
            PG8_WAIT_V(8); PG8_WAIT_L(0); PG8_BAR; PG8_MMA(1, 0, At, B0); PG8_MMA(1, 1, At, B1); PG8_BAR; PG8_SCHED;
            PG8_LDB(B0, 1, 0); PG8_LDB(B1, 1, 1); PG8_SCHED; PG8_LDA(At, 1, 0); PG8_STAGE(PG8_SA(0, 1), a2 + hstep, voffA);
            PG8_WAIT_V(8); PG8_WAIT_L(0); PG8_BAR; PG8_MMA(0, 0, At, B0); PG8_MMA(0, 1, At, B1); PG8_BAR; PG8_SCHED;
            PG8_LDA(At, 1, 1); PG8_STAGE(PG8_SB(1, 0), b3, voffB); PG8_STAGE(PG8_SB(1, 1), b3 + hstep, voffB); PG8_STAGE(PG8_SA(1, 0), a3, voffA);
            PG8_WAIT_V(8); PG8_WAIT_L(0); PG8_BAR; PG8_MMA(1, 0, At, B0); PG8_MMA(1, 1, At, B1); PG8_BAR; PG8_SCHED;
            } else {
            PG8_LDB(B0, 0, 0); PG8_SCHED; PG8_LDA(At, 0, 0); PG8_STAGE(PG8_SA(1, 1), a1 + hstep, voffA);
            PG8_WAIT_L(8); PG8_BAR; PG8_WAIT_L(0); PG8_MMA(0, 0, At, B0); PG8_BAR; PG8_SCHED;
            PG8_LDB(B1, 0, 1); PG8_STAGE(PG8_SB(0, 0), b2, voffB);
            PG8_BAR; PG8_WAIT_L(0); PG8_MMA(0, 1, At, B1); PG8_BAR;
            PG8_LDA(At, 0, 1); PG8_STAGE(PG8_SA(0, 0), a2, voffA);
            PG8_BAR; PG8_WAIT_L(0); PG8_MMA(1, 0, At, B0); PG8_BAR; PG8_SCHED;
            PG8_STAGE(PG8_SB(0, 1), b2 + hstep, voffB);
            PG8_WAIT_V(6); PG8_BAR; PG8_MMA(1, 1, At, B1); PG8_BAR;
            PG8_LDB(B0, 1, 0); PG8_SCHED; PG8_LDA(At, 1, 0); PG8_STAGE(PG8_SA(0, 1), a2 + hstep, voffA);
            PG8_WAIT_L(8); PG8_BAR; PG8_WAIT_L(0); PG8_MMA(0, 0, At, B0); PG8_BAR; PG8_SCHED;
            PG8_LDB(B1, 1, 1); PG8_STAGE(PG8_SB(1, 0), b3, voffB);
            PG8_BAR; PG8_WAIT_L(0); PG8_MMA(0, 1, At, B1); PG8_BAR;
            PG8_LDA(At, 1, 1); PG8_STAGE(PG8_SA(1, 0), a3, voffA);
            PG8_BAR; PG8_WAIT_L(0); PG8_MMA(1, 0, At, B0); PG8_BAR; PG8_SCHED;
            PG8_STAGE(PG8_SB(1, 1), b3 + hstep, voffB);
            PG8_WAIT_V(6); PG8_BAR; PG8_MMA(1, 1, At, B1); PG8_BAR;
            }
        }
        if constexpr (ALIGN_EPI) { if (wr == 0) PG8_BAR; }
        if constexpr (!Epi::AFTER_DRAIN) { E(acc, cur, wr, wc, fr, fq); S.done(cur); }
        if (!has_next) break;
#pragma unroll
        for (int a = 0; a < 2; ++a)
#pragma unroll
            for (int b = 0; b < 2; ++b)
#pragma unroll
                for (int m = 0; m < 4; ++m)
#pragma unroll
                    for (int n = 0; n < 2; ++n) acc[a][b][m][n] = (f32x4){0.f, 0.f, 0.f, 0.f};
        cur = nxt; cA = nA; cB = nB; ++ui;
        if constexpr (ALIGN_EPI) { if (wr == 1) PG8_BAR; }
    }
    PG8_WAIT_V(0);
    if constexpr (!ALIGN_EPI) { if (wr == 0) PG8_BAR; }
    PG8_BAR;
    if constexpr (Epi::AFTER_DRAIN) { E.fused(acc, cur, wr, wc, fr, fq, lds, wid, lane); S.done(cur); }
#undef PG8_SA
#undef PG8_SB
#undef PG8_STAGE
#undef PG8_LDA
#undef PG8_LDB
#undef PG8_MMA
#undef PG8_WAIT_V
#undef PG8_WAIT_L
#undef PG8_BAR
#undef PG8_SCHED
}
}
using pg8::f32x4; using pg8::u32x4;

__device__ __forceinline__ void transpose_item(const float* W, int K, int N, bf16_t* WT, int row_off, float* scr, int item, int lane) {
    const int nblk = N / 32, kb = item / nblk, nbk = item % nblk, k0 = 64 * kb, n0 = 32 * nbk;
    {
        const int r = lane >> 3, c4 = (lane & 7) * 4;
        float4 t[8];
#pragma unroll
        for (int i = 0; i < 8; ++i) t[i] = *(const float4*)(W + (size_t)(k0 + 8 * i + r) * N + n0 + c4);
#pragma unroll
        for (int i = 0; i < 8; ++i) { float* d = scr + (8 * i + r) * 33 + c4; d[0] = t[i].x; d[1] = t[i].y; d[2] = t[i].z; d[3] = t[i].w; }
    }
    asm volatile("s_waitcnt lgkmcnt(0)" ::: "memory");
    const int c = lane & 7;
#pragma unroll
    for (int j = 0; j < 4; ++j) { const int n = (lane >> 3) + 8 * j; const float* s = scr + (8 * c) * 33 + n;
        uint4 o; o.x = pk2(s[0 * 33], s[1 * 33]); o.y = pk2(s[2 * 33], s[3 * 33]); o.z = pk2(s[4 * 33], s[5 * 33]); o.w = pk2(s[6 * 33], s[7 * 33]);
        *(uint4*)(WT + (size_t)(row_off + n0 + n) * K + k0 + 8 * c) = o; }
    asm volatile("s_waitcnt lgkmcnt(0)" ::: "memory");
}
__device__ __forceinline__ void ph_prep(const Params& p, int bid, int nb, float* lds) {
    const int tid = tid_(), wave = tid >> 6, lane = tid & 63;
    {
        float* sl = lds;
        float* red = lds + 4096;
        for (int i = tid; i < 4096; i += NTH) sl[i] = siluf_(p.c[i]);
        __syncthreads();
        for (int it = bid; it < 192; it += nb) {
            const int c4 = tid & 15, kg = tid >> 4;
            const float* wp = p.w_ada + (size_t)kg * NMOD + it * 64 + c4 * 4;
            float a0[4] = {0.f, 0.f, 0.f, 0.f}, a1[4] = {0.f, 0.f, 0.f, 0.f};
#pragma unroll 8
            for (int i = 0; i < 64; ++i) {
                const int k = kg + 32 * i;
                const float4 w = *(const float4*)(wp + (size_t)(32 * i) * NMOD);
                const float s0 = sl[k], s1 = sl[2048 + k];
                a0[0] += s0 * w.x; a0[1] += s0 * w.y; a0[2] += s0 * w.z; a0[3] += s0 * w.w;
                a1[0] += s1 * w.x; a1[1] += s1 * w.y; a1[2] += s1 * w.z; a1[3] += s1 * w.w;
            }
            __syncthreads();
#pragma unroll
            for (int e = 0; e < 4; ++e) { red[(kg * 16 + c4) * 8 + e] = a0[e]; red[(kg * 16 + c4) * 8 + 4 + e] = a1[e]; }
            __syncthreads();
            if (tid < 128) {
                const int b = tid >> 6, col = tid & 63;
                float s = 0.f;
                for (int g = 0; g < 32; ++g) s += red[(g * 16 + (col >> 2)) * 8 + b * 4 + (col & 3)];
                p.ada[b * NMOD + it * 64 + col] = s + p.b_ada[it * 64 + col];
            }
        }
        __syncthreads();
    }
    for (int e = bid * NTH + tid; e < NTOK * 64; e += nb * NTH) {
        const int tok = e >> 6, j = e & 63;
        const float ang = (float)p.pos[tok] * c_freq[j];
        float s, c; sincos_acc(ang, s, c);
        p.rope[(size_t)e * 2] = c; p.rope[(size_t)e * 2 + 1] = s;
    }
    {
        float* scr = lds + wave * (64 * 33);
        const int gw = bid * 8 + wave, ngw = nb * 8;
        constexpr int I1 = 32 * 256, I2 = 32 * 128, I3 = 16 * 64, I4 = 32 * 64;
        constexpr int NIT = I1 + I2 + I3 + 3 * I4;
        for (int it = gw; it < NIT; it += ngw) {
            int r = it;
            if (r < I1) { transpose_item(p.w_in, 2048, 8192, p.Wt1, 0, scr, r, lane); continue; } r -= I1;
            if (r < I2) { transpose_item(p.w_bg, 2048, 4096, p.Wt1, 8192, scr, r, lane); continue; } r -= I2;
            if (r < I3) { transpose_item(p.w_a_out, 1024, 2048, p.Wta, 0, scr, r, lane); continue; } r -= I3;
            if (r < I4) { transpose_item(p.w_b_out, 2048, 2048, p.Wtb, 0, scr, r, lane); continue; } r -= I4;
            if (r < I4) { transpose_item(p.w_o, 2048, 2048, p.Wto, 0, scr, r, lane); continue; } r -= I4;
            transpose_item(p.peer_wq, 2048, 2048, p.Wtq, 0, scr, r, lane);
        }
    }
    __syncthreads();
}
constexpr int ROW6 = 1536;
typedef float f32x32_t __attribute__((ext_vector_type(32)));
typedef unsigned u32x6_t __attribute__((ext_vector_type(6)));
__device__ __forceinline__ void tc_load(const Params& p, int r, int lane, float4 (&t)[8]) {
    const bool second = r >= 16384; const int row = second ? r - 16384 : r;
    const float* src = (second ? p.peer_v : p.peer_u) + (size_t)row * DM + lane * 4;
#pragma unroll
    for (int q = 0; q < 8; ++q) t[q] = *(const float4*)(src + 256 * q);
}
constexpr int ROW4 = 1024;
__device__ __forceinline__ void tc_finish(const Params& p, int r, int lane, const float4 (&t)[8]) {
    const bool second = r >= 16384; const int row = second ? r - 16384 : r;
    float am = 0.f;
#pragma unroll
    for (int q = 0; q < 8; ++q) am = fmaxf(am, fmaxf(fmaxf(fabsf(t[q].x), fabsf(t[q].y)), fmaxf(fabsf(t[q].z), fabsf(t[q].w))));
    am = wave_max_b(am);
    if (second) {
        const float sc = (am > 0.f) ? am * (1.0f / 6.0f) : 1.0f, inv = (am > 0.f) ? 6.0f / am : 1.0f;
        unsigned w0 = 0u, w1 = 0u, w2 = 0u, w3 = 0u;
#define TC_PK(W_, qa_, qb_) do { \
        W_ = __builtin_amdgcn_cvt_scalef32_pk_fp4_f32(W_, t[qa_].x * inv, t[qa_].y * inv, 1.0f, 0); W_ = __builtin_amdgcn_cvt_scalef32_pk_fp4_f32(W_, t[qa_].z * inv, t[qa_].w * inv, 1.0f, 1); \
        W_ = __builtin_amdgcn_cvt_scalef32_pk_fp4_f32(W_, t[qb_].x * inv, t[qb_].y * inv, 1.0f, 2); W_ = __builtin_amdgcn_cvt_scalef32_pk_fp4_f32(W_, t[qb_].z * inv, t[qb_].w * inv, 1.0f, 3); } while (0)
        TC_PK(w0, 0, 1); TC_PK(w1, 2, 3); TC_PK(w2, 4, 5); TC_PK(w3, 6, 7);
#undef TC_PK
        *(uint4*)(p.V8 + (size_t)row * ROW4 + lane * 16) = make_uint4(w0, w1, w2, w3);
        if (lane == 0) p.sv[row] = sc;
    } else {
        const float sc = (am > 0.f) ? am * (1.0f / 7.5f) : 1.0f, inv = (am > 0.f) ? 7.5f / am : 1.0f;
        typedef float f32x16_t __attribute__((ext_vector_type(16)));
        f32x16_t ev, od;
#pragma unroll
        for (int q = 0; q < 8; ++q) { ev[2 * q] = t[q].x * inv; od[2 * q] = t[q].y * inv; ev[2 * q + 1] = t[q].z * inv; od[2 * q + 1] = t[q].w * inv; }
        const u32x6_t w = __builtin_amdgcn_cvt_scalef32_2xpk16_fp6_f32(ev, od, 1.0f);
        unsigned char* dst = p.U8 + (size_t)row * ROW6 + lane * 8;
        *(uint2*)(dst) = make_uint2(w[0], w[1]); *(uint2*)(dst + 512) = make_uint2(w[2], w[3]); *(uint2*)(dst + 1024) = make_uint2(w[4], w[5]);
        if (lane == 0) p.su[row] = sc;
    }
}
__device__ __forceinline__ void ph_tabconv(const Params& p, int bid, int nb) {
    const int tid = tid_(), wave = tid >> 6, lane = tid & 63;
    for (int r = bid * 8 + wave; r < 2 * 16384; r += nb * 8) { float4 t[8]; tc_load(p, r, lane, t); tc_finish(p, r, lane, t); }
}

__device__ __forceinline__ void ph_modnorm(const Params& p, const float* xin, const float* g, int sh_off, int sc_off, bf16_t* hout, int bid, int nb, float* lds) {
    const int tid = tid_(), wave = tid >> 6, lane = tid & 63;
    const int stride = nb * 8;
    int row = bid * 8 + wave;
    float4 v[8], vn[8];
    if (row < NTOK) {
#pragma unroll
        for (int j = 0; j < 8; ++j) v[j] = ((const float4*)(xin + (size_t)row * DM))[lane + 64 * j];
    }
    for (; row < NTOK; row += stride) {
        const int nrow = row + stride;
        if (nrow < NTOK) {
#pragma unroll
            for (int j = 0; j < 8; ++j) vn[j] = ((const float4*)(xin + (size_t)nrow * DM))[lane + 64 * j];
        }
        const int b = row / SQ;
        float ss = 0.f;
#pragma unroll
        for (int j = 0; j < 8; ++j) ss += dot4(v[j], v[j]);
        ss = wave_sum(ss);
        const float rs = 1.0f / sqrtf(ss * (1.0f / DM) + 1e-6f);
#pragma unroll
        for (int j = 0; j < 8; ++j) {
            const int col = (lane + 64 * j) * 4;
            const float4 g4 = *(const float4*)(g + col);
            const float4 sc = *(const float4*)(p.ada + b * NMOD + sc_off + col);
            const float4 sh = *(const float4*)(p.ada + b * NMOD + sh_off + col);
            float4 o;
            o.x = v[j].x * rs * g4.x * (1.0f + sc.x) + sh.x; o.y = v[j].y * rs * g4.y * (1.0f + sc.y) + sh.y;
            o.z = v[j].z * rs * g4.z * (1.0f + sc.z) + sh.z; o.w = v[j].w * rs * g4.w * (1.0f + sc.w) + sh.w;
            st_wt8(hout + (size_t)row * DM + col, make_uint2(pk2(o.x, o.y), pk2(o.z, o.w)));
        }
#pragma unroll
        for (int j = 0; j < 8; ++j) v[j] = vn[j];
    }
}

typedef short bf16x8_t __attribute__((ext_vector_type(8)));
typedef float f32x4_t __attribute__((ext_vector_type(4)));
__device__ __forceinline__ bf16x8_t ldfrag(const char* base, int row, int chunk, int rb, int sm) { return *(const bf16x8_t*)(base + row * rb + ((chunk ^ (row & sm)) << 4)); }
__device__ __forceinline__ void ph_gmlp2(const Params& p, int bid, int nb, float* lds) {
    char* WM = (char*)lds; char* VT = WM + 32768;
    const int tid = tid_(), wave = tid >> 6, lane = tid & 63, fr = lane & 15, fq = lane >> 4;
    int gl = -1;
    for (int it = bid; it < 512; it += nb) {
        const int g = it & 7, n = (it >> 3) & 31, b = it >> 8;
        const int tok0 = b * SQ + n * 128;
        __syncthreads();
        if (g != gl) {
            for (int u = tid; u < 2048; u += NTH) {
                const int i = u >> 4, c = u & 15;
                const float4* src = (const float4*)(p.gm_ws + (size_t)g * 16384 + i * 128 + c * 8);
                float4 a = src[0], b4 = src[1];
                if ((i >> 6) < (c >> 3)) { a = make_float4(0.f, 0.f, 0.f, 0.f); b4 = a; }
                *(uint4*)(WM + i * 256 + ((c ^ (i & 15)) << 4)) = make_uint4(pk2(a.x, a.y), pk2(a.z, a.w), pk2(b4.x, b4.y), pk2(b4.z, b4.w));
            }
            gl = g;
        }
        {
            const float2 gn = *(const float2*)(p.gm_v_g + g * 128 + lane * 2);
#pragma unroll 4
            for (int jj = 0; jj < 16; ++jj) {
                const int j = wave * 16 + jj;
                const unsigned w = *(const unsigned*)(p.ZG + (size_t)(tok0 + j) * ZW + 1024 + g * 128 + lane * 2);
                const float a = bflo(w), c2 = bfhi(w);
                const float ss = wave_sum(a * a + c2 * c2);
                const float rs = 1.0f / sqrtf(ss * (1.0f / 128.0f) + 1e-6f);
                const int d0 = lane * 2, d1 = d0 + 1;
                *(bf16_t*)(VT + d0 * 256 + (((j >> 3) ^ (d0 & 15)) << 4) + (j & 7) * 2) = (bf16_t)f2bf(a * rs * gn.x);
                *(bf16_t*)(VT + d1 * 256 + (((j >> 3) ^ (d1 & 15)) << 4) + (j & 7) * 2) = (bf16_t)f2bf(c2 * rs * gn.y);
            }
        }
        __syncthreads();
        {
            bf16x8_t A[4];
#pragma unroll
            for (int ks = 0; ks < 4; ++ks) A[ks] = ldfrag(VT, wave * 16 + fr, ks * 4 + fq, 256, 15);
            const int d0 = wave * 16 + fq * 4;
#pragma unroll
            for (int itl = 0; itl < 8; ++itl) {
                f32x4_t acc = {0.f, 0.f, 0.f, 0.f};
#pragma unroll
                for (int ks = 0; ks < 4; ++ks) if (itl >= 4 || ks < 2) acc = __builtin_amdgcn_mfma_f32_16x16x32_bf16(A[ks], ldfrag(WM, itl * 16 + fr, ks * 4 + fq, 256, 15), acc, 0, 0, 0);
                const int i = itl * 16 + fr;
                const float bias = p.gm_b[g * 128 + i];
                const size_t tok = (size_t)(tok0 + i);
                const uint2 uw = *(const uint2*)(p.ZG + tok * ZW + g * 128 + d0);
                *(uint2*)(p.yain + tok * 1024 + g * 128 + d0) = make_uint2(pk2(bflo(uw.x) * (acc[0] + bias), bfhi(uw.x) * (acc[1] + bias)), pk2(bflo(uw.y) * (acc[2] + bias), bfhi(uw.y) * (acc[3] + bias)));
            }
        }
    }
    __syncthreads();
}

__device__ __forceinline__ void ph_ret(const Params& p, int bid, int nb, float* lds) {
    float* Qs = lds;
    float* Ks = Qs + 64 * 129;
    float* Vs = Ks + 64 * 129;
    float* Ss = Vs + 64 * 16;
    float* At = Ss + 128 * 16;
    float* kd = At + 64 * 65;
    const int tid = tid_();
    const bf16_t* z = p.ZG;
    for (int it = bid; it < 256; it += nb) {
        const int vs = it & 15, h = (it >> 4) & 7, b = it >> 7;
        const float lg = log1pf(-exp2f(-5.0f - (float)h));
        const float cdec = expf(lg * 64.0f);
        __syncthreads();
        for (int i = tid; i < 2048; i += NTH) Ss[i] = 0.f;
        if (tid < 64) kd[tid] = expf(lg * (float)(63 - tid));
        for (int n = 0; n < 64; ++n) {
            const int tok0 = b * SQ + n * 64;
            __syncthreads();
            for (int e = tid; e < 4096; e += NTH) {
                const int i = e >> 6, dd = e & 63; const size_t tok = (size_t)(tok0 + i);
                const float cs = p.rope[(tok * 64 + dd) * 2], sn = p.rope[(tok * 64 + dd) * 2 + 1];
                const bf16_t* zr = z + tok * ZW;
                const float q1 = bf2f(zr[2048 + h * 128 + dd]), q2 = bf2f(zr[2048 + h * 128 + 64 + dd]);
                const float k1 = bf2f(zr[3072 + h * 128 + dd]), k2 = bf2f(zr[3072 + h * 128 + 64 + dd]);
                Qs[i * 129 + dd] = q1 * cs - q2 * sn; Qs[i * 129 + 64 + dd] = q1 * sn + q2 * cs;
                const float sc = 0.08838834764831845f;
                Ks[i * 129 + dd] = (k1 * cs - k2 * sn) * sc; Ks[i * 129 + 64 + dd] = (k1 * sn + k2 * cs) * sc;
            }
            for (int e = tid; e < 1024; e += NTH) { const int j = e >> 4, v = e & 15; Vs[e] = bf2f(z[(size_t)(tok0 + j) * ZW + 4096 + h * 256 + vs * 16 + v]); }
            __syncthreads();
            {
                const int j = tid & 63, i0 = (tid >> 6) * 8;
                float acc[8];
#pragma unroll
                for (int ii = 0; ii < 8; ++ii) acc[ii] = 0.f;
                for (int d = 0; d < 128; ++d) {
                    const float kv = Ks[j * 129 + d];
#pragma unroll
                    for (int ii = 0; ii < 8; ++ii) acc[ii] += Qs[(i0 + ii) * 129 + d] * kv;
                }
#pragma unroll
                for (int ii = 0; ii < 8; ++ii) { const int i = i0 + ii; At[i * 65 + j] = acc[ii] * expf(lg * fabsf((float)(i - j))); }
            }
            __syncthreads();
            {
                const int v = tid & 15, i0 = tid >> 4;
#pragma unroll
                for (int rep = 0; rep < 2; ++rep) {
                    const int i = i0 + 32 * rep;
                    float a = 0.f; for (int j = 0; j < 64; ++j) a += At[i * 65 + j] * Vs[j * 16 + v];
                    float c2 = 0.f; for (int d = 0; d < 128; ++d) c2 += Qs[i * 129 + d] * Ss[d * 16 + v];
                    p.obuf[(size_t)(tok0 + i) * DM + h * 256 + vs * 16 + v] = a + c2 * expf(lg * (float)(i + 1));
                }
            }
            __syncthreads();
            {
                const int v = tid & 15, d0 = tid >> 4;
#pragma unroll
                for (int rep = 0; rep < 4; ++rep) {
                    const int d = d0 + 32 * rep;
                    float a = 0.f; for (int j = 0; j < 64; ++j) a += Ks[j * 129 + d] * kd[j] * Vs[j * 16 + v];
                    Ss[d * 16 + v] = Ss[d * 16 + v] * cdec + a;
                }
            }
        }
    }
    __syncthreads();
}


__device__ __forceinline__ void ph_retprep(const Params& p, int bid, int nb, float* lds) {
    bf16_t* Kl = (bf16_t*)lds;
    bf16_t* Vl = Kl + 64 * 132;
    char* Qm = (char*)(Vl + 64 * 264);
    char* Km = Qm + 16384;
    const int tid = tid_(), wave = tid >> 6, lane = tid & 63, fr = lane & 15, fq = lane >> 4;
    for (int it = bid; it < 1024; it += nb) {
        const int n = it & 63, h = (it >> 6) & 7, b = it >> 9;
        const int tok0 = b * SQ + n * 64;
        const size_t rowbase = (size_t)(b * 8 + h) * SQ + n * 64;
        const float lg = log1pf(-exp2f(-5.0f - (float)h));
        __syncthreads();
#pragma unroll
        for (int k = 0; k < 2; ++k) {
            const int u = tid + 512 * k, i = u >> 4, dd = (u & 15) * 4; const size_t tok = (size_t)(tok0 + i);
            const float4 r0 = *(const float4*)(p.rope + (tok * 64 + dd) * 2), r1 = *(const float4*)(p.rope + (tok * 64 + dd) * 2 + 4);
            const float cs[4] = {r0.x, r0.z, r1.x, r1.z}, sn[4] = {r0.y, r0.w, r1.y, r1.w};
            const bf16_t* zr = p.ZG + tok * ZW;
            const uint2 q1w = *(const uint2*)(zr + 2048 + h * 128 + dd), q2w = *(const uint2*)(zr + 2048 + h * 128 + 64 + dd);
            const uint2 k1w = *(const uint2*)(zr + 3072 + h * 128 + dd), k2w = *(const uint2*)(zr + 3072 + h * 128 + 64 + dd);
            const float q1[4] = {bflo(q1w.x), bfhi(q1w.x), bflo(q1w.y), bfhi(q1w.y)}, q2[4] = {bflo(q2w.x), bfhi(q2w.x), bflo(q2w.y), bfhi(q2w.y)};
            const float k1[4] = {bflo(k1w.x), bfhi(k1w.x), bflo(k1w.y), bfhi(k1w.y)}, k2[4] = {bflo(k2w.x), bfhi(k2w.x), bflo(k2w.y), bfhi(k2w.y)};
            const float sc = 0.08838834764831845f, kd = expf(lg * (float)(63 - i));
            float qa[4], qb[4], ka[4], kb[4];
#pragma unroll
            for (int e = 0; e < 4; ++e) { qa[e] = q1[e] * cs[e] - q2[e] * sn[e]; qb[e] = q1[e] * sn[e] + q2[e] * cs[e]; ka[e] = (k1[e] * cs[e] - k2[e] * sn[e]) * sc; kb[e] = (k1[e] * sn[e] + k2[e] * cs[e]) * sc; }
            const uint2 qaw = make_uint2(pk2(qa[0], qa[1]), pk2(qa[2], qa[3])), qbw = make_uint2(pk2(qb[0], qb[1]), pk2(qb[2], qb[3]));
            const uint2 kaw = make_uint2(pk2(ka[0], ka[1]), pk2(ka[2], ka[3])), kbw = make_uint2(pk2(kb[0], kb[1]), pk2(kb[2], kb[3]));
            *(uint2*)(p.Qr + (rowbase + i) * 128 + dd) = qaw; *(uint2*)(p.Qr + (rowbase + i) * 128 + 64 + dd) = qbw;
            const int c = dd >> 3, o8 = (dd & 7) * 2;
            *(uint2*)(Qm + i * 256 + ((c ^ (i & 15)) << 4) + o8) = qaw; *(uint2*)(Qm + i * 256 + (((c + 8) ^ (i & 15)) << 4) + o8) = qbw;
            *(uint2*)(Km + i * 256 + ((c ^ (i & 15)) << 4) + o8) = kaw; *(uint2*)(Km + i * 256 + (((c + 8) ^ (i & 15)) << 4) + o8) = kbw;
            *(uint2*)(Kl + i * 132 + dd) = make_uint2(pk2(ka[0] * kd, ka[1] * kd), pk2(ka[2] * kd, ka[3] * kd));
            *(uint2*)(Kl + i * 132 + 64 + dd) = make_uint2(pk2(kb[0] * kd, kb[1] * kd), pk2(kb[2] * kd, kb[3] * kd));
        }
#pragma unroll
        for (int k = 0; k < 4; ++k) {
            const int u = tid + 512 * k, j = u >> 5, c = u & 31;
            *(uint4*)(Vl + j * 264 + c * 8) = *(const uint4*)(p.ZG + (size_t)(tok0 + j) * ZW + 4096 + h * 256 + c * 8);
        }
        __syncthreads();
        {
            const int jt = wave >> 1, it0 = 2 * (wave & 1);
            f32x4_t s0 = {0.f, 0.f, 0.f, 0.f}, s1 = {0.f, 0.f, 0.f, 0.f};
#pragma unroll
            for (int ks = 0; ks < 4; ++ks) {
                const bf16x8_t a = ldfrag(Km, jt * 16 + fr, ks * 4 + fq, 256, 15);
                const bf16x8_t b0 = ldfrag(Qm, it0 * 16 + fr, ks * 4 + fq, 256, 15), b1 = ldfrag(Qm, (it0 + 1) * 16 + fr, ks * 4 + fq, 256, 15);
                s0 = __builtin_amdgcn_mfma_f32_16x16x32_bf16(a, b0, s0, 0, 0, 0);
                s1 = __builtin_amdgcn_mfma_f32_16x16x32_bf16(a, b1, s1, 0, 0, 0);
            }
            const int j0 = jt * 16 + fq * 4;
            bf16_t* pg = p.Pm + (size_t)it * 4096;
#pragma unroll
            for (int tt = 0; tt < 2; ++tt) {
                const int i = (it0 + tt) * 16 + fr; const f32x4_t sv4 = tt ? s1 : s0; float pv[4];
#pragma unroll
                for (int r = 0; r < 4; ++r) pv[r] = sv4[r] * __expf(lg * fabsf((float)(i - (j0 + r))));
                *(uint2*)(pg + i * 64 + j0) = make_uint2(pk2(pv[0], pv[1]), pk2(pv[2], pv[3]));
            }
        }
        bf16_t* kt = p.KTd + (size_t)it * 8192;
#pragma unroll
        for (int k = 0; k < 2; ++k) {
            const int u = tid + 512 * k, d = u & 127, jg = u >> 7;
            unsigned w[4];
#pragma unroll
            for (int q = 0; q < 4; ++q) w[q] = (unsigned)Kl[(jg * 8 + 2 * q) * 132 + d] | ((unsigned)Kl[(jg * 8 + 2 * q + 1) * 132 + d] << 16);
            *(uint4*)(kt + d * 64 + jg * 8) = make_uint4(w[0], w[1], w[2], w[3]);
        }
        bf16_t* vt = p.Vt + (size_t)it * 16384;
#pragma unroll
        for (int k = 0; k < 4; ++k) {
            const int u = tid + 512 * k, v = u & 255, jg = u >> 8;
            unsigned w[4];
#pragma unroll
            for (int q = 0; q < 4; ++q) w[q] = (unsigned)Vl[(jg * 8 + 2 * q) * 264 + v] | ((unsigned)Vl[(jg * 8 + 2 * q + 1) * 264 + v] << 16);
            *(uint4*)(vt + v * 64 + jg * 8) = make_uint4(w[0], w[1], w[2], w[3]);
        }
    }
    __syncthreads();
}

__device__ __forceinline__ void ph_ret2(const Params& p, int bid, int nb, float* lds) {
    char* L = (char*)lds;
    constexpr int OQ = 0, OKT = 16384, OPP = 32768, OVT = 40960, TILE = 43008, OST = 2 * TILE;
    const int tid = tid_(), wave = tid >> 6, lane = tid & 63, fr = lane & 15, fq = lane >> 4;
    for (int it = bid; it < 256; it += nb) {
        const int itm = ((it & 7) * 2 + (it >> 7)) * 16 + ((it >> 3) & 15);
        const int vs = itm & 15, h = (itm >> 4) & 7, b = itm >> 7;
        const float lg = log1pf(-exp2f(-5.0f - (float)h));
        const float cdec = expf(lg * 64.0f);
        const size_t bh = (size_t)(b * 8 + h);
        const char* gQ = (const char*)(p.Qr + bh * SQ * 128);
        const char* gKT = (const char*)(p.KTd + bh * 64 * 8192);
        const char* gP = (const char*)(p.Pm + bh * 64 * 4096);
        const char* gVt = (const char*)(p.Vt + bh * 64 * 16384) + vs * 16 * 128;
        int lq[2], lkt[2];
#pragma unroll
        for (int u = 0; u < 2; ++u) { const int ci = tid + 512 * u; const int r = ci >> 4, c = ci & 15; lq[u] = r * 256 + ((c ^ (r & 15)) << 4); const int d = ci >> 3, c8 = ci & 7; lkt[u] = d * 128 + ((c8 ^ (d & 7)) << 4); }
        const int lp = (tid >> 3) * 128 + (((tid & 7) ^ ((tid >> 3) & 7)) << 4);
        const int lv = lp;
        uint4 qA0, qA1, tA0, tA1, pA, vA = make_uint4(0u, 0u, 0u, 0u), qB0, qB1, tB0, tB1, pB, vB = make_uint4(0u, 0u, 0u, 0u);
#define RET_LOAD(X_, n_) do { const size_t o0 = (size_t)(n_) * 16384 + (size_t)tid * 16, o1 = o0 + 8192; \
        q##X_##0 = *(const uint4*)(gQ + o0); q##X_##1 = *(const uint4*)(gQ + o1); t##X_##0 = *(const uint4*)(gKT + o0); t##X_##1 = *(const uint4*)(gKT + o1); p##X_ = *(const uint4*)(gP + (size_t)(n_) * 8192 + tid * 16); \
        if (tid < 128) v##X_ = *(const uint4*)(gVt + (size_t)(n_) * 32768 + tid * 16); } while (0)
#define RET_WRITE(X_, buf_) do { char* B_ = L + (buf_) * TILE; \
        *(uint4*)(B_ + OQ + lq[0]) = q##X_##0; *(uint4*)(B_ + OQ + lq[1]) = q##X_##1; *(uint4*)(B_ + OKT + lkt[0]) = t##X_##0; *(uint4*)(B_ + OKT + lkt[1]) = t##X_##1; *(uint4*)(B_ + OPP + lp) = p##X_; \
        if (tid < 128) *(uint4*)(B_ + OVT + lv) = v##X_; } while (0)
        __syncthreads();
        for (int i = tid; i < 1024; i += NTH) ((unsigned*)(L + OST))[i] = 0u;
        RET_LOAD(A, 0); RET_WRITE(A, 0); RET_LOAD(B, 1);
        f32x4_t sacc[2] = {{0.f, 0.f, 0.f, 0.f}, {0.f, 0.f, 0.f, 0.f}};
#define RET_STEP(n_, cur_, LS_, WS_) do { const int n = (n_); constexpr int cur = (cur_); \
            __syncthreads();                                     \
            if (n + 2 < 64) RET_LOAD(LS_, n + 2); \
            const char* T = L + cur * TILE; \
            if (wave < 4) {     \
                const int itl = wave; \
                f32x4_t o1 = {0.f, 0.f, 0.f, 0.f}, o2 = {0.f, 0.f, 0.f, 0.f}; \
                _Pragma("unroll") for (int ks = 0; ks < 2; ++ks) o1 = __builtin_amdgcn_mfma_f32_16x16x32_bf16(ldfrag(T + OPP, itl * 16 + fr, ks * 4 + fq, 128, 7), ldfrag(T + OVT, fr, ks * 4 + fq, 128, 7), o1, 0, 0, 0); \
                _Pragma("unroll") for (int ks = 0; ks < 4; ++ks) o2 = __builtin_amdgcn_mfma_f32_16x16x32_bf16(ldfrag(T + OQ, itl * 16 + fr, ks * 4 + fq, 256, 15), ldfrag(L + OST + cur * 4096, fr, ks * 4 + fq, 256, 15), o2, 0, 0, 0); \
                _Pragma("unroll") for (int r = 0; r < 4; ++r) { const int i = itl * 16 + fq * 4 + r; \
                    p.ob16[(size_t)(b * SQ + n * 64 + i) * DM + h * 256 + vs * 16 + fr] = (bf16_t)f2bf(o1[r] + __expf(lg * (float)(i + 1)) * o2[r]); } \
            } else {            \
                _Pragma("unroll") for (int u = 0; u < 2; ++u) { \
                    const int dt = 2 * (wave - 4) + u; \
                    sacc[u] = sacc[u] * cdec; \
                    _Pragma("unroll") for (int ks = 0; ks < 2; ++ks) sacc[u] = __builtin_amdgcn_mfma_f32_16x16x32_bf16(ldfrag(T + OKT, dt * 16 + fr, ks * 4 + fq, 128, 7), ldfrag(T + OVT, fr, ks * 4 + fq, 128, 7), sacc[u], 0, 0, 0); \
                    *(uint2*)(L + OST + (cur ^ 1) * 4096 + fr * 256 + (((dt * 2 + (fq >> 1)) ^ fr) << 4) + (fq & 1) * 8) = make_uint2(pk2(sacc[u][0], sacc[u][1]), pk2(sacc[u][2], sacc[u][3])); } \
            } \
            if (n + 1 < 64) RET_WRITE(WS_, cur ^ 1); } while (0)
#pragma unroll 1
        for (int n2 = 0; n2 < 64; n2 += 2) { RET_STEP(n2, 0, A, B); RET_STEP(n2 + 1, 1, B, A); }
#undef RET_STEP
#undef RET_LOAD
#undef RET_WRITE
    }
    __syncthreads();
}

__device__ __forceinline__ void gn_load(const Params& p, int tok, int lane, uint2 (&ow)[8], uint2 (&gw)[8]) {
#pragma unroll
    for (int h = 0; h < 8; ++h) { ow[h] = *(const uint2*)(p.ob16 + (size_t)tok * DM + h * 256 + lane * 4); gw[h] = *(const uint2*)(p.ZG + (size_t)tok * ZW + 6144 + h * 256 + lane * 4); }
}
__device__ __forceinline__ void ph_gn(const Params& p, int bid, int nb, float* lds) {
    const int tid = tid_(), wave = tid >> 6, lane = tid & 63;
    const int stride = nb * 8;
    int tok = bid * 8 + wave;
    uint2 ow[8], gw[8], own[8], gwn[8];
    if (tok < NTOK) gn_load(p, tok, lane, ow, gw);
    for (; tok < NTOK; tok += stride) {
        if (tok + stride < NTOK) gn_load(p, tok + stride, lane, own, gwn);
        float4 o[8]; float s1[8], s2[8];
#pragma unroll
        for (int h = 0; h < 8; ++h) { o[h] = make_float4(bflo(ow[h].x), bfhi(ow[h].x), bflo(ow[h].y), bfhi(ow[h].y)); s1[h] = (o[h].x + o[h].y) + (o[h].z + o[h].w); }
#pragma unroll
        for (int h = 0; h < 8; ++h) s1[h] = row_sum16(s1[h]);
#pragma unroll
        for (int h = 0; h < 8; ++h) s1[h] = xsum32(xsum16(s1[h]));
#pragma unroll
        for (int h = 0; h < 8; ++h) { const float mu = s1[h] * (1.0f / 256.0f); o[h].x -= mu; o[h].y -= mu; o[h].z -= mu; o[h].w -= mu; s2[h] = dot4(o[h], o[h]); }
#pragma unroll
        for (int h = 0; h < 8; ++h) s2[h] = row_sum16(s2[h]);
#pragma unroll
        for (int h = 0; h < 8; ++h) s2[h] = xsum32(xsum16(s2[h]));
#pragma unroll
        for (int h = 0; h < 8; ++h) {
            const float rs = 1.0f / sqrtf(s2[h] * (1.0f / 256.0f) + 1e-6f);
            const float4 gn = *(const float4*)(p.ret_gn_g + h * 256 + lane * 4);
            const float g0 = bflo(gw[h].x), g1 = bfhi(gw[h].x), g2 = bflo(gw[h].y), g3 = bfhi(gw[h].y);
            st_wt8(p.ybin + (size_t)tok * DM + h * 256 + lane * 4,
                make_uint2(pk2(siluf_(g0) * o[h].x * rs * gn.x, siluf_(g1) * o[h].y * rs * gn.y), pk2(siluf_(g2) * o[h].z * rs * gn.z, siluf_(g3) * o[h].w * rs * gn.w)));
        }
#pragma unroll
        for (int h = 0; h < 8; ++h) { ow[h] = own[h]; gw[h] = gwn[h]; }
    }
}

__device__ __forceinline__ void split8(const float4 a, const float4 b, uint4& hi, uint4& lo) {
    const float x[8] = {a.x, a.y, a.z, a.w, b.x, b.y, b.z, b.w}; unsigned h[8], l[8];
#pragma unroll
    for (int i = 0; i < 8; ++i) { h[i] = f2bf(x[i]); l[i] = f2bf(x[i] - __uint_as_float(h[i] << 16)); }
    hi = make_uint4(h[0] | (h[1] << 16), h[2] | (h[3] << 16), h[4] | (h[5] << 16), h[6] | (h[7] << 16));
    lo = make_uint4(l[0] | (l[1] << 16), l[2] | (l[3] << 16), l[4] | (l[5] << 16), l[6] | (l[7] << 16));
}
__device__ __forceinline__ bf16x8_t as_bf16x8(const uint4 v) { return __builtin_bit_cast(bf16x8_t, v); }
struct PairTab { int a[52], b[52]; };
__host__ __device__ constexpr PairTab make_pairs() {
    PairTab t{}; int n = 0;
    for (int a = 0; a < 16; ++a) for (int b = 0; b < 16; ++b) if ((a + 1) * (b + 1) <= 16) { t.a[n] = a; t.b[n] = b; ++n; }
    for (; n < 52; ++n) { t.a[n] = -1; t.b[n] = -1; }
    return t;
}
constexpr PairTab PAIRS = make_pairs();
static_assert(PAIRS.a[49] >= 0 && PAIRS.a[50] < 0, "50 candidate pairs");

template <int N, int OFF> __device__ __forceinline__ void bitonic_sort_desc(float* v) {
#pragma unroll
    for (int k = 2; k <= N; k <<= 1)
#pragma unroll
        for (int j = k >> 1; j > 0; j >>= 1)
#pragma unroll
            for (int i = 0; i < N; ++i) { const int l = i ^ j; if (l > i) { const bool up = ((i & k) == 0);
                const float a = v[OFF + i], b = v[OFF + l]; const float mx = fmaxf(a, b), mn = fminf(a, b); v[OFF + i] = up ? mx : mn; v[OFF + l] = up ? mn : mx; } }
}
template <int N> __device__ __forceinline__ void bitonic_merge_desc(float* v) {
#pragma unroll
    for (int j = N >> 1; j > 0; j >>= 1)
#pragma unroll
        for (int i = 0; i < N; ++i) { const int l = i ^ j; if (l > i) { const float a = v[i], b = v[l]; v[i] = fmaxf(a, b); v[l] = fminf(a, b); } }
}
__device__ __forceinline__ void ph_topk2(const Params& p, const float* qb, int bid, int nb, float* lds, int it_fixed) {
    const int tid = tid_(), wave = tid >> 6, lane = tid & 63;
    uint4* SK = (uint4*)lds;
    const float NEG = -INFINITY;
    const bool tc_on = (nb == 256); const int tcr0 = (bid * 8 + wave) * 16; float4 tct[8];
    if (tc_on) tc_load(p, tcr0, lane, tct);
    for (int it = (it_fixed >= 0 ? it_fixed : bid); it < 256; it += (it_fixed >= 0 ? 256 : nb)) {
        const int h = it & 7, tg = it >> 3;
        __syncthreads();
        for (int gi = tid; gi < 4096; gi += NTH) {
            const int dq = gi & 15, n = (gi >> 4) & 127, pp = gi >> 11;
            const float4* src = (const float4*)(p.peer_sk + ((size_t)(h * 2 + pp) * 128 + n) * 128 + dq * 8);
            uint4 hi, lo; split8(src[0], src[1], hi, lo);
            const int base = (((pp * 8 + (n >> 4)) * 4 + (dq >> 2)) * 2) * 64 + (dq & 3) * 16 + (n & 15);
            SK[base] = hi; SK[base + 64] = lo;
        }
        __syncthreads();
#pragma unroll 1
        for (int tile = 0; tile < 2; ++tile) {
            const int tok = tg * 256 + wave * 32 + tile * 16 + (lane & 15);
            const int qd = lane >> 4;
            float v12[2][16];
#pragma unroll
            for (int pp = 0; pp < 2; ++pp) {
                if (tc_on) { const int ti = tile * 8 + pp * 4; tc_finish(p, tcr0 + ti, lane, tct); tc_load(p, tcr0 + ti + 1, lane, tct); }
                bf16x8_t Bh[4], Bl[4];
                const float* qp = qb + (size_t)tok * DM + h * 256 + pp * 128 + 8 * qd;
#pragma unroll
                for (int ks = 0; ks < 4; ++ks) { uint4 hi, lo; split8(*(const float4*)(qp + ks * 32), *(const float4*)(qp + ks * 32 + 4), hi, lo); Bh[ks] = as_bf16x8(hi); Bl[ks] = as_bf16x8(lo); }
                float v[32];
#pragma unroll
                for (int kt = 0; kt < 8; ++kt) {
                    f32x4_t acc = {0.f, 0.f, 0.f, 0.f};
#pragma unroll
                    for (int ks = 0; ks < 4; ++ks) {
                        const bf16x8_t Ah = as_bf16x8(SK[(((pp * 8 + kt) * 4 + ks) * 2) * 64 + lane]), Al = as_bf16x8(SK[(((pp * 8 + kt) * 4 + ks) * 2 + 1) * 64 + lane]);
                        acc = __builtin_amdgcn_mfma_f32_16x16x32_bf16(Ah, Bh[ks], acc, 0, 0, 0);
                        acc = __builtin_amdgcn_mfma_f32_16x16x32_bf16(Ah, Bl[ks], acc, 0, 0, 0);
                        acc = __builtin_amdgcn_mfma_f32_16x16x32_bf16(Al, Bh[ks], acc, 0, 0, 0);
                    }
#pragma unroll
                    for (int r = 0; r < 4; ++r) v[kt * 4 + r] = __uint_as_float((__float_as_uint(acc[r]) & ~127u) | (unsigned)(kt * 16 + qd * 4 + r));
                    __builtin_amdgcn_sched_barrier(0);
                }
                if (tc_on) { const int ti = tile * 8 + pp * 4 + 1; tc_finish(p, tcr0 + ti, lane, tct); tc_load(p, tcr0 + ti + 1, lane, tct); }
                bitonic_sort_desc<16, 0>(v); bitonic_sort_desc<16, 16>(v);
                float c16[16];
#pragma unroll
                for (int i = 0; i < 16; ++i) c16[i] = fmaxf(v[i], v[31 - i]);
                bitonic_merge_desc<16>(c16);
                if (tc_on) { const int ti = tile * 8 + pp * 4 + 2; tc_finish(p, tcr0 + ti, lane, tct); tc_load(p, tcr0 + ti + 1, lane, tct); }
#pragma unroll
                for (int st = 0; st < 2; ++st) {
                    float pr[16];
#pragma unroll
                    for (int i = 0; i < 16; ++i) pr[i] = __shfl_xor(c16[i], 16 << st);
#pragma unroll
                    for (int i = 0; i < 16; ++i) c16[i] = fmaxf(c16[i], pr[15 - i]);
                    bitonic_merge_desc<16>(c16);
                }
                if (tc_on) { const int ti = tile * 8 + pp * 4 + 3; tc_finish(p, tcr0 + ti, lane, tct); if (ti < 15) tc_load(p, tcr0 + ti + 1, lane, tct); }
#pragma unroll
                for (int i = 0; i < 16; ++i) v12[pp][i] = c16[i];
            }
            float c[13]; unsigned pay[13];
#pragma unroll
            for (int s = 0; s < 13; ++s) {
                float cq[4]; unsigned pq[4];
#pragma unroll
                for (int q = 0; q < 4; ++q) {
                    const int pi = 4 * s + q; const int a = PAIRS.a[pi], b = PAIRS.b[pi];
                    if (a >= 0) {
                        const float sum = v12[0][a] + v12[1][b];
                        cq[q] = __uint_as_float((__float_as_uint(sum) & ~63u) | (unsigned)pi);
                        pq[q] = (__float_as_uint(v12[0][a]) & 127u) * 128u + (__float_as_uint(v12[1][b]) & 127u);
                    } else { cq[q] = NEG; pq[q] = 0u; }
                }
                c[s] = qd == 0 ? cq[0] : qd == 1 ? cq[1] : qd == 2 ? cq[2] : cq[3];
                pay[s] = qd == 0 ? pq[0] : qd == 1 ? pq[1] : qd == 2 ? pq[2] : pq[3];
            }
            float top[16]; unsigned eid[16];
#pragma unroll
            for (int r = 0; r < 16; ++r) {
                float m = c[0];
#pragma unroll
                for (int s = 1; s < 13; ++s) m = fmaxf(m, c[s]);
                m = fmaxf(m, __shfl_xor(m, 16)); m = fmaxf(m, __shfl_xor(m, 32));
                unsigned pw = 0u;
#pragma unroll
                for (int s = 0; s < 13; ++s) { const bool eq = (c[s] == m); pw |= eq ? pay[s] : 0u; c[s] = eq ? NEG : c[s]; }
                pw |= (unsigned)__shfl_xor((int)pw, 16); pw |= (unsigned)__shfl_xor((int)pw, 32);
                top[r] = m; eid[r] = pw;
            }
            float sum = 0.f; const float mx = top[0];
#pragma unroll
            for (int r = 0; r < 16; ++r) { top[r] = expf(top[r] - mx); sum += top[r]; }
            const float inv = 1.0f / sum;
            if (lane < 16) {
                int4* ep = (int4*)(p.eidx + (size_t)tok * 128 + h * 16); float4* gp = (float4*)(p.gatev + (size_t)tok * 128 + h * 16);
#pragma unroll
                for (int q = 0; q < 4; ++q) {
                    ep[q] = make_int4((int)eid[4 * q], (int)eid[4 * q + 1], (int)eid[4 * q + 2], (int)eid[4 * q + 3]);
                    gp[q] = make_float4(top[4 * q] * inv, top[4 * q + 1] * inv, top[4 * q + 2] * inv, top[4 * q + 3] * inv);
                }
            }
        }
    }
    __syncthreads();
}

__device__ __forceinline__ void peer_load4(const unsigned char* tab, const int (&e)[4], int lane, uint2 (&R)[4][3]) {
#pragma unroll
    for (int i = 0; i < 4; ++i) { const uint2* r = (const uint2*)(tab + (size_t)e[i] * ROW6 + lane * 8); R[i][0] = r[0]; R[i][1] = r[64]; R[i][2] = r[128]; }
}
__device__ __forceinline__ f32x32_t dec6(const uint2 (&R)[3]) { const u32x6_t w = {R[0].x, R[0].y, R[1].x, R[1].y, R[2].x, R[2].y}; return __builtin_amdgcn_cvt_scalef32_pk32_f32_fp6(w, 1.0f); }
typedef float f32x2_t __attribute__((ext_vector_type(2)));
__device__ __forceinline__ void peer_group(const Params& p, int lane, int ee, float suu, float gvv, int k0, int en, int kn,
                                           const uint2 (&Uc)[4][3], uint2 (&Un)[4][3], const f32x2_t (&hv2)[16], f32x2_t (&y2)[16]) {
    int e[4], e2[4]; float sa[4], gw[4]; uint4 Vc[4];
#pragma unroll
    for (int i = 0; i < 4; ++i) { e[i] = __builtin_amdgcn_readlane(ee, k0 + i); e2[i] = __builtin_amdgcn_readlane(en, kn + i);
        sa[i] = __uint_as_float(__builtin_amdgcn_readlane(__float_as_uint(suu), k0 + i)); gw[i] = __uint_as_float(__builtin_amdgcn_readlane(__float_as_uint(gvv), k0 + i)); }
#pragma unroll
    for (int i = 0; i < 4; ++i) Vc[i] = *((const uint4*)(p.V8 + (size_t)e[i] * ROW4) + lane);
    peer_load4(p.U8, e2, lane, Un);
    float a[4];
#pragma unroll
    for (int i = 0; i < 4; ++i) {
        const f32x32_t d = dec6(Uc[i]);
        f32x2_t c0 = {0.f, 0.f}, c1 = {0.f, 0.f}, c2 = {0.f, 0.f}, c3 = {0.f, 0.f};
#define D2(k_) __builtin_shufflevector(d, d, 2 * (k_), 2 * (k_) + 1)
        c0 += D2(0) * hv2[0]; c1 += D2(1) * hv2[1]; c2 += D2(2) * hv2[2]; c3 += D2(3) * hv2[3];
        c0 += D2(4) * hv2[4]; c1 += D2(5) * hv2[5]; c2 += D2(6) * hv2[6]; c3 += D2(7) * hv2[7];
        c0 += D2(8) * hv2[8]; c1 += D2(9) * hv2[9]; c2 += D2(10) * hv2[10]; c3 += D2(11) * hv2[11];
        c0 += D2(12) * hv2[12]; c1 += D2(13) * hv2[13]; c2 += D2(14) * hv2[14]; c3 += D2(15) * hv2[15];
        const f32x2_t cs = (c0 + c1) + (c2 + c3);
        a[i] = cs.x + cs.y;
    }
#pragma unroll
    for (int i = 0; i < 4; ++i) a[i] = xsum32(xsum16(row_sum16(a[i])));
    const f32x2_t g01 = pg8::gelu_pk((f32x2_t){a[0] * sa[0], a[1] * sa[1]}), g23 = pg8::gelu_pk((f32x2_t){a[2] * sa[2], a[3] * sa[3]});
    const float wgt[4] = {g01.x * gw[0], g01.y * gw[1], g23.x * gw[2], g23.y * gw[3]};
#pragma unroll
    for (int i = 0; i < 4; ++i) {
        const f32x2_t w2 = {wgt[i], wgt[i]};
        const unsigned vw[4] = {Vc[i].x, Vc[i].y, Vc[i].z, Vc[i].w};
#pragma unroll
        for (int j = 0; j < 4; ++j) {
            y2[4 * j + 0] += w2 * __builtin_amdgcn_cvt_scalef32_pk_f32_fp4(vw[j], 1.0f, 0);
            y2[4 * j + 1] += w2 * __builtin_amdgcn_cvt_scalef32_pk_f32_fp4(vw[j], 1.0f, 1);
            y2[4 * j + 2] += w2 * __builtin_amdgcn_cvt_scalef32_pk_f32_fp4(vw[j], 1.0f, 2);
            y2[4 * j + 3] += w2 * __builtin_amdgcn_cvt_scalef32_pk_f32_fp4(vw[j], 1.0f, 3);
        }
    }
#undef D2
}
__device__ __forceinline__ void ph_peer3(const Params& p, const float* x1, const bf16_t* h2, int bid, int nb) {
    const int tid = tid_(), wave = tid >> 6, lane = tid & 63;
    for (int t = bid * 8 + wave; t < NTOK; t += nb * 8) {
        const int b = t / SQ;
        f32x2_t hv2[16], y2[16];
#pragma unroll
        for (int q = 0; q < 8; ++q) { const uint2 w = *(const uint2*)(h2 + (size_t)t * DM + 256 * q + lane * 4);
            hv2[2 * q] = (f32x2_t){bflo(w.x), bfhi(w.x)}; hv2[2 * q + 1] = (f32x2_t){bflo(w.y), bfhi(w.y)}; }
#pragma unroll
        for (int i = 0; i < 16; ++i) y2[i] = (f32x2_t){0.f, 0.f};
        const int e0 = p.eidx[(size_t)t * 128 + lane], e1 = p.eidx[(size_t)t * 128 + 64 + lane];
        const float g0 = p.gatev[(size_t)t * 128 + lane], g1 = p.gatev[(size_t)t * 128 + 64 + lane];
        const float su0 = p.su[e0], su1 = p.su[e1];
        const float gv0 = g0 * p.sv[e0], gv1 = g1 * p.sv[e1];
        uint2 UA[4][3], UB[4][3];
        { int e[4];
#pragma unroll
          for (int i = 0; i < 4; ++i) e[i] = __builtin_amdgcn_readlane(e0, i);
          peer_load4(p.U8, e, lane, UA); }
#pragma unroll 1
        for (int g = 0; g < 16; g += 2) {
            peer_group(p, lane, e0, su0, gv0, 4 * g, e0, 4 * g + 4, UA, UB, hv2, y2);
            peer_group(p, lane, e0, su0, gv0, 4 * g + 4, (g + 2 < 16) ? e0 : e1, (g + 2 < 16) ? 4 * g + 8 : 0, UB, UA, hv2, y2);
        }
#pragma unroll 1
        for (int g = 0; g < 16; g += 2) {
            peer_group(p, lane, e1, su1, gv1, 4 * g, e1, 4 * g + 4, UA, UB, hv2, y2);
            peer_group(p, lane, e1, su1, gv1, 4 * g + 4, e1, (g + 2 < 16) ? 4 * g + 8 : 4 * g + 4, UB, UA, hv2, y2);
        }
        float y[32];
#pragma unroll
        for (int k = 0; k < 16; ++k) { y[2 * k] = y2[k].x; y[2 * k + 1] = y2[k].y; }
        float ss = 0.f;
#pragma unroll
        for (int q = 0; q < 8; ++q) {
            const int c = 256 * q + lane * 4;
            const float4 xv = *(const float4*)(x1 + (size_t)t * DM + c);
            const float4 ga = *(const float4*)(p.ada + b * NMOD + 5 * DM + c);
            float* yy = y + 4 * q;
            yy[0] = xv.x + ga.x * yy[0]; yy[1] = xv.y + ga.y * yy[1]; yy[2] = xv.z + ga.z * yy[2]; yy[3] = xv.w + ga.w * yy[3];
            ss += yy[0] * yy[0] + yy[1] * yy[1] + yy[2] * yy[2] + yy[3] * yy[3];
        }
        ss = wave_sum(ss);
        const float rs = 1.0f / sqrtf(ss * (1.0f / DM) + 1e-6f);
#pragma unroll
        for (int q = 0; q < 8; ++q) {
            const int c = 256 * q + lane * 4;
            const float4 gf = *(const float4*)(p.norm_f_g + c);
            const float* yy = y + 4 * q;
            *(float4*)(p.out + (size_t)t * DM + c) = make_float4(yy[0] * rs * gf.x, yy[1] * rs * gf.y, yy[2] * rs * gf.z, yy[3] * rs * gf.w);
        }
    }
}

#define LAS __attribute__((address_space(3)))
#define XB_TMO      128
#define XB_XCNT(j)  (256  + 64 * (j))
#define XB_XSUB(j)  (1280 + 64 * (j))
#define XB_XGEN(j)  (2304 + 64 * (j))
#define XB_TOP      3328
#define XB_TOPGEN   3392
#define XCD_BAR_WORDS 3456
#define XB_SPIN_CAP (1u << 18)

__device__ __forceinline__ unsigned xb_ld(unsigned* p)              { return __hip_atomic_load(p, __ATOMIC_RELAXED, __HIP_MEMORY_SCOPE_AGENT); }
__device__ __forceinline__ unsigned xb_add(unsigned* p, unsigned v) { return __hip_atomic_fetch_add(p, v, __ATOMIC_RELAXED, __HIP_MEMORY_SCOPE_AGENT); }
__device__ __forceinline__ unsigned xb_xcc_id() { return (unsigned)__builtin_amdgcn_s_getreg((3 << 11) | 20) & 0xFu; }
#define XB_SPIN(cond, bar) do { unsigned _sp = 0; while (cond) { __builtin_amdgcn_s_sleep(1); \
    if ((++_sp & 255u) == 0u) { if (xb_ld(&(bar)[XB_TMO])) break; if (_sp > XB_SPIN_CAP) { atomicAdd(&(bar)[XB_TMO], 1u); break; } } } } while (0)

struct XcdBarrier {
    unsigned* bar; unsigned x;
    volatile LAS unsigned* st;
};

__device__ __forceinline__ XcdBarrier xcd_barrier_post(unsigned* bar, volatile LAS unsigned* st) {
    XcdBarrier b; b.bar = bar; b.x = xb_xcc_id(); b.st = st;
    if (threadIdx.x == 0) (void)xb_add(&bar[XB_XCNT(b.x)], 1u);
    return b;
}
__device__ __forceinline__ void xcd_barrier_complete(unsigned* bar, unsigned x, unsigned& nloc, unsigned& nx) {
    const unsigned G = gridDim.x * gridDim.y * gridDim.z;
    unsigned sum, cnt, mine, sp = 0u;
    for (;;) {
        sum = 0u; cnt = 0u; mine = 0u;
#pragma unroll
        for (unsigned j = 0; j < 16; ++j) { const unsigned c = xb_ld(&bar[XB_XCNT(j)]); sum += c; cnt += (c > 0u) ? 1u : 0u; mine = (j == x) ? c : mine; }
        if (sum == G) break;
        __builtin_amdgcn_s_sleep(1);
        if ((++sp & 255u) == 0u) { if (xb_ld(&bar[XB_TMO])) break; if (sp > XB_SPIN_CAP) { atomicAdd(&bar[XB_TMO], 1u); break; } }
    }
    nloc = mine > 0u ? mine : 1u; nx = cnt > 0u ? cnt : 1u;
}

__device__ __forceinline__ void xcd_barrier(const XcdBarrier& b) {
    asm volatile("s_waitcnt vmcnt(0)" ::: "memory");
    __syncthreads();
    if (threadIdx.x == 0) {
        unsigned* bar = b.bar;
        __builtin_amdgcn_s_waitcnt(0);
        unsigned nloc = b.st[0], nx = b.st[1];
        if (nloc == 0u) { xcd_barrier_complete(bar, b.x, nloc, nx); b.st[0] = nloc; b.st[1] = nx; }
        const unsigned old = xb_add(&bar[XB_XSUB(b.x)], 1u);
        const unsigned gen = old / nloc;
        if (old + 1u == (gen + 1u) * nloc) {
            __builtin_amdgcn_fence(__ATOMIC_RELEASE, "agent");
            asm volatile("s_waitcnt vmcnt(0)" ::: "memory");
            const unsigned og = xb_add(&bar[XB_TOP], 1u);
            const unsigned tg = og / nx;
            if (og + 1u == (tg + 1u) * nx) xb_add(&bar[XB_TOPGEN], 1u);
            else XB_SPIN(xb_ld(&bar[XB_TOPGEN]) == tg, bar);
            __builtin_amdgcn_fence(__ATOMIC_ACQUIRE, "agent");
            xb_add(&bar[XB_XGEN(b.x)], 1u);
            asm volatile("s_waitcnt vmcnt(0)" ::: "memory");
        } else {
            XB_SPIN(xb_ld(&bar[XB_XGEN(b.x)]) == gen, bar);
            __builtin_amdgcn_fence(__ATOMIC_ACQUIRE, "agent");
            asm volatile("s_waitcnt vmcnt(0)" ::: "memory");
        }
    }
    __syncthreads();
}

template <class Epi>
__device__ __forceinline__ void gemm_run(float* lds, const bf16_t* A, const bf16_t* Bt, int M, int N, int K, const Epi& E) {
    __syncthreads();
    pg8::Gemm g{A, Bt, M, N, K}; pg8::StaticOrder S; S.init(M, N, (int)gridDim.x, (int)blockIdx.x);
    pg8::gemm_phase<Epi, pg8::StaticOrder, true, true>((PG8_LAS unsigned char*)lds, g, S, E);
    __syncthreads();
}
constexpr int NPHASE = 11;
template <int PH>
__device__ __forceinline__ void run_phase(const Params& p, int bid, int nb, float* lds) {
    asm volatile("" : "+s"(bid));
    if constexpr (PH == 0) ph_prep(p, bid, nb, lds);
    if constexpr (PH == 1) ph_modnorm(p, p.x, p.norm1_g, 0 * DM, 1 * DM, p.hb, bid, nb, lds);
    if constexpr (PH == 2) gemm_run(lds, p.hb, p.Wt1, NTOK, ZW, DM, pg8::EpiZG{p.ZG, p.b_bg});
    if constexpr (PH == 3) { ph_retprep(p, bid, nb, lds); ph_gmlp2(p, bid, nb, lds); }
    if constexpr (PH == 11) ph_ret2(p, bid, nb, lds);
    if constexpr (PH == 4) ph_gn(p, bid, nb, lds);
    if constexpr (PH == 5) {
        gemm_run(lds, p.yain, p.Wta, NTOK, DM, 1024, pg8::EpiMixB<0>{p.hb, p.ZG, 0});
        gemm_run(lds, p.ybin, p.Wtb, NTOK, DM, DM, pg8::EpiMixB<1>{p.hb, p.ZG, 2048});
    }
    if constexpr (PH == 6) gemm_run(lds, p.hb, p.Wto, NTOK, DM, DM, pg8::EpiResF{p.obuf, p.x, p.ada + 2 * DM});
    if constexpr (PH == 7) { ph_modnorm(p, p.obuf, p.norm2_g, 3 * DM, 4 * DM, p.hb, bid, nb, lds); if (nb != 256) ph_tabconv(p, bid, nb); }
    if constexpr (PH == 8) {
        gemm_run(lds, p.hb, p.Wtq, NTOK, DM, DM, pg8::EpiF32{p.qbuf, DM});
        if (nb == 256) {
            pg8::StaticOrder S; S.init(NTOK, DM, (int)gridDim.x, (int)blockIdx.x); pg8::Unit u; S.next(0, u);
            asm volatile("s_waitcnt vmcnt(0)" ::: "memory"); __syncthreads();
            ph_topk2(p, p.qbuf, bid, nb, lds, u.pm * 8 + u.pn);
        }
    }
    if constexpr (PH == 9) { if (nb != 256) ph_topk2(p, p.qbuf, bid, nb, lds, -1); }
    if constexpr (PH == 10) ph_peer3(p, p.obuf, p.hb, bid, nb);
}

constexpr int MISC_OFF = 132 * 1024;
__global__ void __launch_bounds__(NTH) k_mega(Params p) {
    extern __shared__ __attribute__((aligned(16))) float lds[];
    const int bid = blockIdx.x, nb = gridDim.x;
    volatile LAS unsigned* misc = (volatile LAS unsigned*)((LAS unsigned char*)lds + MISC_OFF);
    if (threadIdx.x < 4) misc[threadIdx.x] = 0u;
    __syncthreads();
    XcdBarrier bar = xcd_barrier_post(p.bar, misc);
    run_phase<0>(p, bid, nb, lds); xcd_barrier(bar);
    run_phase<1>(p, bid, nb, lds); xcd_barrier(bar);
    run_phase<2>(p, bid, nb, lds); xcd_barrier(bar);
    run_phase<3>(p, bid, nb, lds); xcd_barrier(bar);
    run_phase<11>(p, bid, nb, lds); xcd_barrier(bar);
    run_phase<4>(p, bid, nb, lds); xcd_barrier(bar);
    run_phase<5>(p, bid, nb, lds); xcd_barrier(bar);
    run_phase<6>(p, bid, nb, lds); xcd_barrier(bar);
    run_phase<7>(p, bid, nb, lds); xcd_barrier(bar);
    run_phase<8>(p, bid, nb, lds); xcd_barrier(bar);
    if (nb != 256) { run_phase<9>(p, bid, nb, lds); xcd_barrier(bar); }
    run_phase<10>(p, bid, nb, lds);
}

extern "C" void kernel_launch(void* const* d_in, const int* in_sizes, int n_in, void* d_out, int out_size, void* d_ws, size_t ws_size, hipStream_t stream) {
    Params p{};
    p.x = (const float*)d_in[0]; p.c = (const float*)d_in[1]; p.pos = (const int*)d_in[2];
    p.w_ada = (const float*)d_in[3]; p.b_ada = (const float*)d_in[4]; p.norm1_g = (const float*)d_in[5]; p.w_in = (const float*)d_in[6];
    p.w_bg = (const float*)d_in[7]; p.b_bg = (const float*)d_in[8]; p.gm_v_g = (const float*)d_in[9]; p.gm_ws = (const float*)d_in[10];
    p.gm_b = (const float*)d_in[11]; p.ret_gn_g = (const float*)d_in[12]; p.w_a_out = (const float*)d_in[13]; p.w_b_out = (const float*)d_in[14];
    p.w_o = (const float*)d_in[15]; p.norm2_g = (const float*)d_in[16]; p.peer_wq = (const float*)d_in[17]; p.peer_sk = (const float*)d_in[18];
    p.peer_u = (const float*)d_in[19]; p.peer_v = (const float*)d_in[20]; p.norm_f_g = (const float*)d_in[21];
    p.out = (float*)d_out;
    char* w = (char*)d_ws; size_t off = 0;
    auto take = [&](size_t bytes) { char* r = w + off; off += (bytes + 255) & ~(size_t)255; return r; };
    p.bar = (unsigned*)take(XCD_BAR_WORDS * 4);
    p.ada = (float*)take(2 * NMOD * 4);
    p.rope = (float*)take((size_t)NTOK * 128 * 4);
    p.eidx = (int*)take((size_t)NTOK * 128 * 4);
    p.gatev = (float*)take((size_t)NTOK * 128 * 4);
    p.Wt1 = (bf16_t*)take((size_t)ZW * DM * 2);
    p.Wta = (bf16_t*)take((size_t)DM * 1024 * 2);
    p.Wtb = (bf16_t*)take((size_t)DM * DM * 2);
    p.Wto = (bf16_t*)take((size_t)DM * DM * 2);
    p.Wtq = (bf16_t*)take((size_t)DM * DM * 2);
    p.hb = (bf16_t*)take((size_t)NTOK * DM * 2);
    p.ZG = (bf16_t*)take((size_t)NTOK * ZW * 2);
    p.qbuf = (float*)p.ZG;
    p.obuf = (float*)take((size_t)NTOK * DM * 4);
    p.ybin = (bf16_t*)take((size_t)NTOK * DM * 2);
    p.yain = (bf16_t*)take((size_t)NTOK * 1024 * 2);
    p.U8 = (unsigned char*)p.ZG + (size_t)NTOK * DM * 4;
    p.V8 = p.U8 + (size_t)16384 * ROW6;
    p.su = (float*)take(16384 * 4); p.sv = (float*)take(16384 * 4);
    p.Qr = (bf16_t*)take((size_t)NTOK * 1024 * 2);
    p.Pm = (bf16_t*)take((size_t)16 * 64 * 4096 * 2);
    p.KTd = (bf16_t*)take((size_t)NTOK * 1024 * 2);
    p.Vt = (bf16_t*)take((size_t)NTOK * 2048 * 2);
    p.ob16 = (bf16_t*)take((size_t)NTOK * DM * 2);
    if (off > ws_size) { fprintf(stderr, "kernel_launch: workspace too small: need %zu have %zu\n", off, ws_size); return; }
    static int grid = 0;
    if (!grid) {
        int dev = 0, cus = 0, per_cu = 0;
        (void)hipGetDevice(&dev); (void)hipDeviceGetAttribute(&cus, hipDeviceAttributeMultiprocessorCount, dev);
        (void)hipFuncSetAttribute((const void*)k_mega, hipFuncAttributeMaxDynamicSharedMemorySize, LDS_BYTES);
        (void)hipOccupancyMaxActiveBlocksPerMultiprocessor(&per_cu, k_mega, NTH, LDS_BYTES);
        (void)per_cu;
        grid = cus;
    }
    (void)hipMemsetAsync(p.bar, 0, XCD_BAR_WORDS * 4, stream);
    hipLaunchKernelGGL(k_mega, dim3(grid), dim3(NTH), LDS_BYTES, stream, p);
    hipError_t e = hipPeekAtLastError();
    if (e != hipSuccess) fprintf(stderr, "launch failed: %s (grid %d)\n", hipGetErrorString(e), grid);
}
```

```cpp
#include <hip/hip_runtime.h>
#include <hip/hip_cooperative_groups.h>
#include <stdint.h>
#include <math.h>
#include <cstdio>

namespace cg = cooperative_groups;

constexpr int DM = 2048;
constexpr int SQ = 4096;
constexpr int NTOK = 8192;
constexpr int NTH = 512;
constexpr int ZW = 12288;
constexpr int NMOD = 12288;
constexpr int LDS_BYTES = 136 * 1024;

typedef unsigned short bf16_t;

struct Params {
    const float *x, *c; const int* pos;
    const float *w_ada, *b_ada, *norm1_g, *w_in, *w_bg, *b_bg, *gm_v_g, *gm_ws, *gm_b, *ret_gn_g, *w_a_out, *w_b_out, *w_o, *norm2_g,
                *peer_wq, *peer_sk, *peer_u, *peer_v, *norm_f_g;
    float* out;
    float *ada, *rope, *gatev; int* eidx;
    bf16_t *Wt1, *Wta, *Wtb, *Wto, *Wtq;
    bf16_t *hb;
    bf16_t *ZG;
    float *obuf;
    bf16_t *ybin, *yain;
    float *qbuf;
    unsigned char *U8, *V8;
    float *su, *sv;
    bf16_t *Qr, *Pm, *KTd, *Vt;
    bf16_t *ob16;
    unsigned *bar;
};

__constant__ float c_freq[64] = {
1.000000000e+00f, 8.659643531e-01f, 7.498942018e-01f, 6.493816376e-01f, 5.623413324e-01f, 4.869675338e-01f, 4.216965139e-01f, 3.651741147e-01f, 3.162277639e-01f, 2.738419771e-01f, 2.371373773e-01f, 2.053525001e-01f, 1.778279394e-01f, 1.539926529e-01f, 1.333521456e-01f, 1.154781953e-01f, 1.000000015e-01f, 8.659642935e-02f, 7.498942316e-02f, 6.493816525e-02f, 5.623413250e-02f, 4.869675264e-02f, 4.216964915e-02f, 3.651741147e-02f, 3.162277490e-02f, 2.738419548e-02f, 2.371373773e-02f, 2.053525113e-02f, 1.778279431e-02f, 1.539926510e-02f, 1.333521400e-02f, 1.154781971e-02f, 9.999999776e-03f, 8.659643121e-03f, 7.498942316e-03f, 6.493816152e-03f, 5.623413250e-03f, 4.869675264e-03f, 4.216964822e-03f, 3.651741194e-03f, 3.162277630e-03f, 2.738419687e-03f, 2.371373819e-03f, 2.053525066e-03f, 1.778279431e-03f, 1.539926510e-03f, 1.333521446e-03f, 1.154782018e-03f, 1.000000047e-03f, 8.659643354e-04f, 7.498941850e-04f, 6.493816036e-04f, 5.623413017e-04f, 4.869675322e-04f, 4.216965172e-04f, 3.651741135e-04f, 3.162277571e-04f, 2.738419571e-04f, 2.371373703e-04f, 2.053525095e-04f, 1.778279402e-04f, 1.539926598e-04f, 1.333521504e-04f, 1.154782003e-04f };

__device__ __forceinline__ int tid_() { int t = threadIdx.x; asm volatile("" : "+v"(t)); return t; }
template <int CTRL> __device__ __forceinline__ float dppf(float x) { return __uint_as_float((unsigned)__builtin_amdgcn_update_dpp(0, (int)__float_as_uint(x), CTRL, 0xf, 0xf, true)); }
__device__ __forceinline__ float row_sum16(float v) { v += dppf<0xB1>(v); v += dppf<0x4E>(v); v += dppf<0x141>(v); v += dppf<0x140>(v); return v; }
__device__ __forceinline__ float xsum16(float v) { const auto r = __builtin_amdgcn_permlane16_swap(__float_as_uint(v), __float_as_uint(v), false, false); return __uint_as_float(r[0]) + __uint_as_float(r[1]); }
__device__ __forceinline__ float xsum32(float v) { const auto r = __builtin_amdgcn_permlane32_swap(__float_as_uint(v), __float_as_uint(v), false, false); return __uint_as_float(r[0]) + __uint_as_float(r[1]); }
__device__ __forceinline__ float xmax16(float v) { const auto r = __builtin_amdgcn_permlane16_swap(__float_as_uint(v), __float_as_uint(v), false, false); return fmaxf(__uint_as_float(r[0]), __uint_as_float(r[1])); }
__device__ __forceinline__ float xmax32(float v) { const auto r = __builtin_amdgcn_permlane32_swap(__float_as_uint(v), __float_as_uint(v), false, false); return fmaxf(__uint_as_float(r[0]), __uint_as_float(r[1])); }
__device__ __forceinline__ float wave_sum(float v) { v = row_sum16(v); v += __shfl_xor(v, 16); v += __shfl_xor(v, 32); return v; }
__device__ __forceinline__ float wave_max_b(float v) {
    v = fmaxf(v, dppf<0xB1>(v)); v = fmaxf(v, dppf<0x4E>(v)); v = fmaxf(v, dppf<0x141>(v)); v = fmaxf(v, dppf<0x140>(v));
    v = fmaxf(v, __shfl_xor(v, 16)); v = fmaxf(v, __shfl_xor(v, 32)); return v;
}
__device__ __forceinline__ float wave_max(float v) {
    v = fmaxf(v, dppf<0xB1>(v)); v = fmaxf(v, dppf<0x4E>(v)); v = fmaxf(v, dppf<0x141>(v)); v = fmaxf(v, dppf<0x140>(v));
    return xmax32(xmax16(v));
}
__device__ __forceinline__ float sigmoidf_(float x) { return 1.0f / (1.0f + expf(-x)); }
__device__ __forceinline__ float siluf_(float x) { return x * sigmoidf_(x); }
__device__ __forceinline__ float geluf_(float x) { return 0.5f * x * (1.0f + erff(x * 0.70710678118654752f)); }
__device__ __forceinline__ float dot4(float4 a, float4 b) { return a.x * b.x + a.y * b.y + a.z * b.z + a.w * b.w; }
__device__ __forceinline__ float bf2f(bf16_t v) { return __uint_as_float((unsigned)v << 16); }
__device__ __forceinline__ float bflo(unsigned w) { return __uint_as_float(w << 16); }
__device__ __forceinline__ float bfhi(unsigned w) { return __uint_as_float(w & 0xffff0000u); }
__device__ __forceinline__ unsigned f2bf(float f) { unsigned u = __float_as_uint(f); return (u + 0x7fffu + ((u >> 16) & 1u)) >> 16; }
__device__ __forceinline__ unsigned pk2(float lo, float hi) { return f2bf(lo) | (f2bf(hi) << 16); }

__device__ __forceinline__ void st_wt8(void* ptr, uint2 v) { __hip_atomic_store((unsigned long long*)ptr, ((unsigned long long)v.y << 32) | v.x, __ATOMIC_RELAXED, __HIP_MEMORY_SCOPE_AGENT); }
__device__ __forceinline__ void sincos_acc(float ang, float& s, float& c) {
    const double x = (double)ang;
    const double k = rint(x * 0.63661977236758134308);
    double r = fma(-k, 1.57079632679489655800, x); r = fma(-k, 6.12323399573676603587e-17, r);
    const double r2 = r * r;
    const double sp = r * (1.0 + r2 * (-1.0 / 6.0 + r2 * (1.0 / 120.0 + r2 * (-1.0 / 5040.0 + r2 * (1.0 / 362880.0 + r2 * (-1.0 / 39916800.0 + r2 * (1.0 / 6227020800.0)))))));
    const double cp = 1.0 + r2 * (-0.5 + r2 * (1.0 / 24.0 + r2 * (-1.0 / 720.0 + r2 * (1.0 / 40320.0 + r2 * (-1.0 / 3628800.0 + r2 * (1.0 / 479001600.0 + r2 * (-1.0 / 87178291200.0)))))));
    const int q = ((int)k) & 3;
    const float fs = (float)sp, fc = (float)cp;
    s = (q == 0) ? fs : (q == 1) ? fc : (q == 2) ? -fs : -fc;
    c = (q == 0) ? fc : (q == 1) ? -fs : (q == 2) ? -fc : fs;
}

namespace pg8 {
#define PG8_LAS __attribute__((address_space(3)))
typedef unsigned short bf16_t;
typedef short bf16x8 __attribute__((ext_vector_type(8)));
typedef float f32x4 __attribute__((ext_vector_type(4)));
typedef unsigned u32x4 __attribute__((ext_vector_type(4)));
constexpr int BM = 256, BK = 64, HALF = 128, HTB = HALF * BK * 2  , STAGE_BYTES = 8 * HTB, NXCD = 8, WGM = 8;

__host__ __device__ __forceinline__ int lds_byte(int r, int c) { const int st = (r >> 4) * 2 + (c >> 5), rr = r & 15, cc = c & 31, ob = rr * 64 + cc * 2; return st * 1024 + (ob ^ (((ob >> 9) & 1) << 5)); }
__host__ __device__ __forceinline__ void stage_rc(int b, int& R, int& C) { const int st = b / 1024, sb = b % 1024, swz = sb ^ (((sb >> 9) & 1) << 5); R = (st >> 1) * 16 + swz / 64; C = (st & 1) * 32 + (swz % 64) / 2; }
__host__ __device__ __forceinline__ int perm32(int rho) { const int n = rho >> 4, i = rho & 15; return 8 * (i >> 2) + 4 * n + (i & 3); }

struct Unit { int pm, pn; };
struct Gemm { const bf16_t* A; const bf16_t* Bt; int M, N, K; };

struct StaticOrder {
    int nM, nN, nwg, G, c;
    __host__ __device__ void init(int M, int N, int G_, int c_) { nM = M / BM; nN = N / BM; nwg = nM * nN; G = G_; c = c_; }
    __host__ __device__ bool next(int i, Unit& u) const {
        const long L = (long)i * G + c; if (L >= nwg) return false;
        int wgid = (int)L; { const int q = nwg / NXCD, r = nwg % NXCD, xcd = wgid % NXCD, off = wgid / NXCD; wgid = (xcd < r ? xcd * (q + 1) : r * (q + 1) + (xcd - r) * q) + off; }
        const int nig = WGM * nN, gid = wgid / nig, fm = gid * WGM, gsz = (nM - fm) < WGM ? (nM - fm) : WGM;
        u.pm = fm + ((wgid % nig) % gsz); u.pn = (wgid % nig) / gsz; return true;
    }
    __device__ __forceinline__ void a_ready(const Unit&) const {}
    __device__ __forceinline__ void done(const Unit&) const {}
};

__device__ __forceinline__ unsigned cvt_pk_bf16(float lo, float hi) { unsigned r; asm volatile("v_cvt_pk_bf16_f32 %0, %1, %2" : "=v"(r) : "v"(lo), "v"(hi)); return r; }
typedef float f32x2 __attribute__((ext_vector_type(2)));
__device__ __forceinline__ f32x2 gelu_pk(f32x2 v) {
    const f32x2 av = __builtin_elementwise_abs(v), d = av * 0.2316418882f + 1.0f;
    f32x2 t; t.x = __builtin_amdgcn_rcpf(d.x); t.y = __builtin_amdgcn_rcpf(d.y);
    f32x2 q = t * 0.5307027145f + (-0.7265760135f); q = q * t + 0.7107068705f; q = q * t + (-0.142248368f); q = q * t + 0.127414796f; q = q * t;
    const f32x2 s = (v * v) * (-0.72134752044f);
    f32x2 e; e.x = __builtin_amdgcn_exp2f(s.x); e.y = __builtin_amdgcn_exp2f(s.y);
    const f32x2 m = v * (q * e), r = v - m;
    f32x2 o; o.x = v.x < 0.f ? m.x : r.x; o.y = v.y < 0.f ? m.y : r.y; return o;
}

typedef unsigned u32x2v __attribute__((ext_vector_type(2)));
struct EpiZG {
    static constexpr bool PERM = true, AFTER_DRAIN = false;
    bf16_t* O; const float* bias;
    __device__ __forceinline__ void operator()(const f32x4 (&acc)[2][2][4][2], const Unit& u, int wr, int wc, int fr, int fq) const {
        const int row0 = u.pm * BM + wr * 64 + fr, col0 = u.pn * BM + wc * 32 + 8 * fq;
        const int mode = u.pn < 8 ? 1 : (u.pn < 32 ? 0 : 2);
        f32x4 bv[2][2];
#pragma unroll
        for (int bj = 0; bj < 2; ++bj)
#pragma unroll
            for (int n = 0; n < 2; ++n) bv[bj][n] = (mode == 2) ? *(const f32x4*)(bias + (col0 - 8192) + bj * HALF + 4 * n) : (f32x4){0.f, 0.f, 0.f, 0.f};
#pragma unroll
        for (int ai = 0; ai < 2; ++ai)
#pragma unroll
            for (int m = 0; m < 4; ++m) { bf16_t* rowp = O + (size_t)(row0 + ai * HALF + m * 16) * ZW + col0;
#pragma unroll
                for (int bj = 0; bj < 2; ++bj) { f32x4 v0 = acc[ai][bj][m][0], v1 = acc[ai][bj][m][1];
                    if (mode == 1) { f32x2 a = gelu_pk((f32x2){v0[0], v0[1]}), b = gelu_pk((f32x2){v0[2], v0[3]}), c = gelu_pk((f32x2){v1[0], v1[1]}), d = gelu_pk((f32x2){v1[2], v1[3]});
                        v0 = (f32x4){a.x, a.y, b.x, b.y}; v1 = (f32x4){c.x, c.y, d.x, d.y}; }
                    if (mode == 2) { v0 = v0 + bv[bj][0]; v1 = v1 + bv[bj][1];
#pragma unroll
                        for (int e = 0; e < 4; ++e) { v0[e] = __builtin_amdgcn_rcpf(1.0f + __expf(-v0[e])); v1[e] = __builtin_amdgcn_rcpf(1.0f + __expf(-v1[e])); } }
                    u32x4 w; w.x = cvt_pk_bf16(v0[0], v0[1]); w.y = cvt_pk_bf16(v0[2], v0[3]); w.z = cvt_pk_bf16(v1[0], v1[1]); w.w = cvt_pk_bf16(v1[2], v1[3]);
                    *(u32x4*)(rowp + bj * HALF) = w; } }
    }
};
template <int ACCUM> struct EpiMixB {
    static constexpr bool PERM = true, AFTER_DRAIN = false;
    bf16_t* Mo; const bf16_t* ZGp; int goff;
    __device__ __forceinline__ void operator()(const f32x4 (&acc)[2][2][4][2], const Unit& u, int wr, int wc, int fr, int fq) const {
        const int row0 = u.pm * BM + wr * 64 + fr, col0 = u.pn * BM + wc * 32 + 8 * fq;
#pragma unroll
        for (int ai = 0; ai < 2; ++ai)
#pragma unroll
            for (int m = 0; m < 4; ++m) { const size_t row = (size_t)(row0 + ai * HALF + m * 16);
#pragma unroll
                for (int bj = 0; bj < 2; ++bj) { const f32x4 v0 = acc[ai][bj][m][0], v1 = acc[ai][bj][m][1];
                    const u32x4 g = *(const u32x4*)(ZGp + row * ZW + 8192 + goff + col0 + bj * HALF);
                    float o[8];
                    o[0] = bflo(g.x) * v0[0]; o[1] = bfhi(g.x) * v0[1]; o[2] = bflo(g.y) * v0[2]; o[3] = bfhi(g.y) * v0[3];
                    o[4] = bflo(g.z) * v1[0]; o[5] = bfhi(g.z) * v1[1]; o[6] = bflo(g.w) * v1[2]; o[7] = bfhi(g.w) * v1[3];
                    bf16_t* mp = Mo + row * DM + col0 + bj * HALF;
                    if (ACCUM) { const u32x4 old = *(const u32x4*)mp;
                        o[0] += bflo(old.x); o[1] += bfhi(old.x); o[2] += bflo(old.y); o[3] += bfhi(old.y); o[4] += bflo(old.z); o[5] += bfhi(old.z); o[6] += bflo(old.w); o[7] += bfhi(old.w); }
                    u32x4 w; w.x = cvt_pk_bf16(o[0], o[1]); w.y = cvt_pk_bf16(o[2], o[3]); w.z = cvt_pk_bf16(o[4], o[5]); w.w = cvt_pk_bf16(o[6], o[7]);
                    *(u32x4*)mp = w; } }
    }
};
struct EpiResF {
    static constexpr bool PERM = false, AFTER_DRAIN = false;
    float* x1; const float* x; const float* ga;
    __device__ __forceinline__ void operator()(const f32x4 (&acc)[2][2][4][2], const Unit& u, int wr, int wc, int fr, int fq) const {
        const int row0 = u.pm * BM + wr * 64 + fr, col0 = u.pn * BM + wc * 32 + 4 * fq;
        const int b = (u.pm * BM) / SQ;
        f32x4 gv[2][2];
#pragma unroll
        for (int bj = 0; bj < 2; ++bj)
#pragma unroll
            for (int n = 0; n < 2; ++n) gv[bj][n] = *(const f32x4*)(ga + b * NMOD + col0 + bj * HALF + n * 16);
#pragma unroll
        for (int ai = 0; ai < 2; ++ai)
#pragma unroll
            for (int m = 0; m < 4; ++m) { const size_t off = (size_t)(row0 + ai * HALF + m * 16) * DM + col0;
#pragma unroll
                for (int bj = 0; bj < 2; ++bj)
#pragma unroll
                    for (int n = 0; n < 2; ++n) { const f32x4 xv = *(const f32x4*)(x + off + bj * HALF + n * 16);
                        *(f32x4*)(x1 + off + bj * HALF + n * 16) = xv + gv[bj][n] * acc[ai][bj][m][n]; } }
    }
};
struct EpiF32 {
    static constexpr bool PERM = false, AFTER_DRAIN = false;
    float* O; int ldc;
    __device__ __forceinline__ void operator()(const f32x4 (&acc)[2][2][4][2], const Unit& u, int wr, int wc, int fr, int fq) const {
        const int row0 = u.pm * BM + wr * 64 + fr, col0 = u.pn * BM + wc * 32 + 4 * fq;
#pragma unroll
        for (int ai = 0; ai < 2; ++ai)
#pragma unroll
            for (int m = 0; m < 4; ++m) { const size_t off = (size_t)(row0 + ai * HALF + m * 16) * ldc + col0;
#pragma unroll
                for (int bj = 0; bj < 2; ++bj)
#pragma unroll
                    for (int n = 0; n < 2; ++n) *(f32x4*)(O + off + bj * HALF + n * 16) = acc[ai][bj][m][n]; }
    }
};

template <class Epi, class Sched, bool ALIGN_EPI = false, bool SP2 = false>
__device__ __forceinline__ void gemm_phase(PG8_LAS unsigned char* lds, const Gemm g, const Sched& S, const Epi& E) {
    const int tid = threadIdx.x, wid = __builtin_amdgcn_readfirstlane(tid >> 6), lane = tid & 63, wr = wid >> 2, wc = wid & 3, fr = lane & 15, fq = lane >> 4;
    const int K = g.K, nt = K / BK;
    unsigned voffA[2], voffB[2];
#pragma unroll
    for (int i = 0; i < 2; ++i) { int R, C; stage_rc(tid * 16 + i * 8192, R, C); const int Rb = Epi::PERM ? ((R & ~31) + perm32(R & 31)) : R;
        voffA[i] = (unsigned)(R * K + C) * 2u; voffB[i] = (unsigned)(Rb * K + C) * 2u; }
    const size_t kstep = (size_t)(BK * 2);
    const size_t hstep = (size_t)HALF * K * 2;
    const size_t tstep = 2 * hstep;
    const unsigned ldsw = (unsigned)wid * 1024u;
    const int aoff = lds_byte(wr * 64 + fr, fq * 8), boff = lds_byte(wc * 32 + fr, fq * 8);
#define PG8_SA(b, h) (((b) * 2 + (h)) * HTB)
#define PG8_SB(b, h) ((4 + (b) * 2 + (h)) * HTB)
#define PG8_STAGE(bufoff, gbase, voff) do { _Pragma("unroll") for (int _i = 0; _i < 2; ++_i) \
        __builtin_amdgcn_global_load_lds((const unsigned*)((const char*)(gbase) + (voff)[_i]), (PG8_LAS unsigned*)(lds + (bufoff) + ldsw + _i * 8192), 16, 0, 0); } while (0)
#define PG8_LDA(dst, b, h) do { _Pragma("unroll") for (int m = 0; m < 4; ++m) _Pragma("unroll") for (int k = 0; k < 2; ++k) dst[m][k] = *(const PG8_LAS bf16x8*)(lds + PG8_SA(b, h) + aoff + m * 2048 + k * 1024); } while (0)
#define PG8_LDB(dst, b, h) do { _Pragma("unroll") for (int n = 0; n < 2; ++n) _Pragma("unroll") for (int k = 0; k < 2; ++k) dst[n][k] = *(const PG8_LAS bf16x8*)(lds + PG8_SB(b, h) + boff + n * 2048 + k * 1024); } while (0)
#define PG8_MMA(ai, bj, At, Bt) do { __builtin_amdgcn_s_setprio(1); _Pragma("unroll") for (int m = 0; m < 4; ++m) _Pragma("unroll") for (int n = 0; n < 2; ++n) _Pragma("unroll") for (int k = 0; k < 2; ++k) \
        acc[ai][bj][m][n] = __builtin_amdgcn_mfma_f32_16x16x32_bf16(Bt[n][k], At[m][k], acc[ai][bj][m][n], 0, 0, 0); __builtin_amdgcn_s_setprio(0); } while (0)
#define PG8_WAIT_V(n) asm volatile("s_waitcnt vmcnt(" #n ")" ::: "memory")
#define PG8_WAIT_L(n) asm volatile("s_waitcnt lgkmcnt(" #n ")" ::: "memory")
#define PG8_BAR __builtin_amdgcn_s_barrier()
#define PG8_SCHED __builtin_amdgcn_sched_barrier(0)
    Unit cur, nxt; int ui = 0;
    if (!S.next(0, cur)) return;
    f32x4 acc[2][2][4][2];
#pragma unroll
    for (int a = 0; a < 2; ++a)
#pragma unroll
        for (int b = 0; b < 2; ++b)
#pragma unroll
            for (int m = 0; m < 4; ++m)
#pragma unroll
                for (int n = 0; n < 2; ++n) acc[a][b][m][n] = (f32x4){0.f, 0.f, 0.f, 0.f};
    bf16x8 At[4][2], B0[2][2], B1[2][2];
    const char* cA = (const char*)g.A + (size_t)cur.pm * tstep; const char* cB = (const char*)g.Bt + (size_t)cur.pn * tstep;
    S.a_ready(cur);
    if constexpr (SP2) {
        PG8_STAGE(PG8_SB(0, 0), cB, voffB); PG8_STAGE(PG8_SB(0, 1), cB + hstep, voffB); PG8_STAGE(PG8_SA(0, 0), cA, voffA); PG8_STAGE(PG8_SA(0, 1), cA + hstep, voffA);
        if (wr == 1) PG8_BAR;
        PG8_WAIT_V(2); PG8_BAR;
        PG8_STAGE(PG8_SB(1, 0), cB + kstep, voffB); PG8_STAGE(PG8_SA(1, 0), cA + kstep, voffA); PG8_STAGE(PG8_SB(1, 1), cB + hstep + kstep, voffB);
        PG8_WAIT_V(6); PG8_BAR;
    } else {
        PG8_STAGE(PG8_SB(0, 0), cB, voffB); PG8_STAGE(PG8_SA(0, 0), cA, voffA); PG8_STAGE(PG8_SB(0, 1), cB + hstep, voffB); PG8_STAGE(PG8_SA(0, 1), cA + hstep, voffA);
        if (wr == 1) PG8_BAR;
        PG8_WAIT_V(4); PG8_BAR;
        PG8_STAGE(PG8_SB(1, 0), cB + kstep, voffB); PG8_STAGE(PG8_SA(1, 0), cA + kstep, voffA); PG8_STAGE(PG8_SB(1, 1), cB + hstep + kstep, voffB);
        PG8_WAIT_V(6); PG8_BAR;
    }
    for (;;) {
        const bool has_next = S.next(ui + 1, nxt);
        const char* nA = has_next ? (const char*)g.A + (size_t)nxt.pm * tstep : cA; const char* nB = has_next ? (const char*)g.Bt + (size_t)nxt.pn * tstep : cB;
        for (int t = 0; t < nt; t += 2) {
            const bool last = (t == nt - 2);
            const char* a1 = cA + (size_t)(t + 1) * kstep;
            const char* a2 = last ? nA : cA + (size_t)(t + 2) * kstep; const char* b2 = last ? nB : cB + (size_t)(t + 2) * kstep;
            const char* a3 = a2 + kstep; const char* b3 = b2 + kstep;
            if (last && has_next) S.a_ready(nxt);
            if constexpr (SP2) {
            PG8_LDB(B0, 0, 0); PG8_LDB(B1, 0, 1); PG8_SCHED; PG8_LDA(At, 0, 0); PG8_STAGE(PG8_SA(1, 1), a1 + hstep, voffA);
            PG8_WAIT_V(8); PG8_WAIT_L(0); PG8_BAR; PG8_MMA(0, 0, At, B0); PG8_MMA(0, 1, At, B1); PG8_BAR; PG8_SCHED;
            PG8_LDA(At, 0, 1); PG8_STAGE(PG8_SB(0, 0), b2, voffB); PG8_STAGE(PG8_SB(0, 1), b2 + hstep, voffB); PG8_STAGE(PG8_SA(0, 0), a2, voffA);
            PG8_WAIT_V(8); PG8_WAIT_L(0); PG8_BAR; PG8_MMA(1, 0, At, B0); PG8_MMA(1, 1, At, B1); PG8_BAR; PG8_SCHED;
            PG8_LDB(B0, 1, 0); PG8_LDB(B1, 1, 1); PG8_SCHED; PG8_LDA(At, 1, 0); PG8_STAGE(PG8_SA(0, 1), a2 + hstep, voffA);
            PG8_WAIT_V(8); PG8_WAIT_L(0); PG8_BAR; PG8_MMA(0, 0, At, B0); PG8_MMA(0, 1, At, B1); PG8_BAR; PG8_SCHED;
            PG8_LDA(At, 1, 1); PG8_STAGE(PG8_SB(1, 0), b3, voffB); PG8_STAGE(PG8_SB(1, 1), b3 + hstep, voffB); PG8_STAGE(PG8_SA(1, 0), a3, voffA);
            PG8_WAIT_V(8); PG8_WAIT_L(0); PG8_BAR; PG8_MMA(1, 0, At, B0); PG8_MMA(1, 1, At, B1); PG8_BAR; PG8_SCHED;
            } else {
            PG8_LDB(B0, 0, 0); PG8_SCHED; PG8_LDA(At, 0, 0); PG8_STAGE(PG8_SA(1, 1), a1 + hstep, voffA);
            PG8_WAIT_L(8); PG8_BAR; PG8_WAIT_L(0); PG8_MMA(0, 0, At, B0); PG8_BAR; PG8_SCHED;
            PG8_LDB(B1, 0, 1); PG8_STAGE(PG8_SB(0, 0), b2, voffB);
            PG8_BAR; PG8_WAIT_L(0); PG8_MMA(0, 1, At, B1); PG8_BAR;
            PG8_LDA(At, 0, 1); PG8_STAGE(PG8_SA(0, 0), a2, voffA);
            PG8_BAR; PG8_WAIT_L(0); PG8_MMA(1, 0, At, B0); PG8_BAR; PG8_SCHED;
            PG8_STAGE(PG8_SB(0, 1), b2 + hstep, voffB);
            PG8_WAIT_V(6); PG8_BAR; PG8_MMA(1, 1, At, B1); PG8_BAR;
            PG8_LDB(B0, 1, 0); PG8_SCHED; PG8_LDA(At, 1, 0); PG8_STAGE(PG8_SA(0, 1), a2 + hstep, voffA);
            PG8_WAIT_L(8); PG8_BAR; PG8_WAIT_L(0); PG8_MMA(0, 0, At, B0); PG8_BAR; PG8_SCHED;
            PG8_LDB(B1, 1, 1); PG8_STAGE(PG8_SB(1, 0), b3, voffB);
            PG8_BAR; PG8_WAIT_L(0); PG8_MMA(0, 1, At, B1); PG8_BAR;
            PG8_LDA(At, 1, 1); PG8_STAGE(PG8_SA(1, 0), a3, voffA);
            PG8_BAR; PG8_WAIT_L(0); PG8_MMA(1, 0, At, B0); PG8_BAR; PG8_SCHED;
            PG8_STAGE(PG8_SB(1, 1), b3 + hstep, voffB);
            PG8_WAIT_V(6); PG8_BAR; PG8_MMA(1, 1, At, B1); PG8_BAR;
            }
        }
        if constexpr (ALIGN_EPI) { if (wr == 0) PG8_BAR; }
        if constexpr (!Epi::AFTER_DRAIN) { E(acc, cur, wr, wc, fr, fq); S.done(cur); }
        if (!has_next) break;
#pragma unroll
        for (int a = 0; a < 2; ++a)
#pragma unroll
            for (int b = 0; b < 2; ++b)
#pragma unroll
                for (int m = 0; m < 4; ++m)
#pragma unroll
                    for (int n = 0; n < 2; ++n) acc[a][b][m][n] = (f32x4){0.f, 0.f, 0.f, 0.f};
        cur = nxt; cA = nA; cB = nB; ++ui;
        if constexpr (ALIGN_EPI) { if (wr == 1) PG8_BAR; }
    }
    PG8_WAIT_V(0);
    if constexpr (!ALIGN_EPI) { if (wr == 0) PG8_BAR; }
    PG8_BAR;
    if constexpr (Epi::AFTER_DRAIN) { E.fused(acc, cur, wr, wc, fr, fq, lds, wid, lane); S.done(cur); }
#undef PG8_SA
#undef PG8_SB
#undef PG8_STAGE
#undef PG8_LDA
#undef PG8_LDB
#undef PG8_MMA
#undef PG8_WAIT_V
#undef PG8_WAIT_L
#undef PG8_BAR
#undef PG8_SCHED
}
}
using pg8::f32x4; using pg8::u32x4;

__device__ __forceinline__ void transpose_item(const float* W, int K, int N, bf16_t* WT, int row_off, float* scr, int item, int lane) {
    const int nblk = N / 32, kb = item / nblk, nbk = item % nblk, k0 = 64 * kb, n0 = 32 * nbk;
    {
        const int r = lane >> 3, c4 = (lane & 7) * 4;
        float4 t[8];
#pragma unroll
        for (int i = 0; i < 8; ++i) t[i] = *(const float4*)(W + (size_t)(k0 + 8 * i + r) * N + n0 + c4);
#pragma unroll
        for (int i = 0; i < 8; ++i) { float* d = scr + (8 * i + r) * 33 + c4; d[0] = t[i].x; d[1] = t[i].y; d[2] = t[i].z; d[3] = t[i].w; }
    }
    asm volatile("s_waitcnt lgkmcnt(0)" ::: "memory");
    const int c = lane & 7;
#pragma unroll
    for (int j = 0; j < 4; ++j) { const int n = (lane >> 3) + 8 * j; const float* s = scr + (8 * c) * 33 + n;
        uint4 o; o.x = pk2(s[0 * 33], s[1 * 33]); o.y = pk2(s[2 * 33], s[3 * 33]); o.z = pk2(s[4 * 33], s[5 * 33]); o.w = pk2(s[6 * 33], s[7 * 33]);
        *(uint4*)(WT + (size_t)(row_off + n0 + n) * K + k0 + 8 * c) = o; }
    asm volatile("s_waitcnt lgkmcnt(0)" ::: "memory");
}
__device__ __forceinline__ void ph_prep(const Params& p, int bid, int nb, float* lds) {
    const int tid = tid_(), wave = tid >> 6, lane = tid & 63;
    {
        float* sl = lds;
        float* red = lds + 4096;
        for (int i = tid; i < 4096; i += NTH) sl[i] = siluf_(p.c[i]);
        __syncthreads();
        for (int it = bid; it < 192; it += nb) {
            const int c4 = tid & 15, kg = tid >> 4;
            const float* wp = p.w_ada + (size_t)kg * NMOD + it * 64 + c4 * 4;
            float a0[4] = {0.f, 0.f, 0.f, 0.f}, a1[4] = {0.f, 0.f, 0.f, 0.f};
#pragma unroll 8
            for (int i = 0; i < 64; ++i) {
                const int k = kg + 32 * i;
                const float4 w = *(const float4*)(wp + (size_t)(32 * i) * NMOD);
                const float s0 = sl[k], s1 = sl[2048 + k];
                a0[0] += s0 * w.x; a0[1] += s0 * w.y; a0[2] += s0 * w.z; a0[3] += s0 * w.w;
                a1[0] += s1 * w.x; a1[1] += s1 * w.y; a1[2] += s1 * w.z; a1[3] += s1 * w.w;
            }
            __syncthreads();
#pragma unroll
            for (int e = 0; e < 4; ++e) { red[(kg * 16 + c4) * 8 + e] = a0[e]; red[(kg * 16 + c4) * 8 + 4 + e] = a1[e]; }
            __syncthreads();
            if (tid < 128) {
                const int b = tid >> 6, col = tid & 63;
                float s = 0.f;
                for (int g = 0; g < 32; ++g) s += red[(g * 16 + (col >> 2)) * 8 + b * 4 + (col & 3)];
                p.ada[b * NMOD + it * 64 + col] = s + p.b_ada[it * 64 + col];
            }
        }
        __syncthreads();
    }
    for (int e = bid * NTH + tid; e < NTOK * 64; e += nb * NTH) {
        const int tok = e >> 6, j = e & 63;
        const float ang = (float)p.pos[tok] * c_freq[j];
        float s, c; sincos_acc(ang, s, c);
        p.rope[(size_t)e * 2] = c; p.rope[(size_t)e * 2 + 1] = s;
    }
    {
        float* scr = lds + wave * (64 * 33);
        const int gw = bid * 8 + wave, ngw = nb * 8;
        constexpr int I1 = 32 * 256, I2 = 32 * 128, I3 = 16 * 64, I4 = 32 * 64;
        constexpr int NIT = I1 + I2 + I3 + 3 * I4;
        for (int it = gw; it < NIT; it += ngw) {
            int r = it;
            if (r < I1) { transpose_item(p.w_in, 2048, 8192, p.Wt1, 0, scr, r, lane); continue; } r -= I1;
            if (r < I2) { transpose_item(p.w_bg, 2048, 4096, p.Wt1, 8192, scr, r, lane); continue; } r -= I2;
            if (r < I3) { transpose_item(p.w_a_out, 1024, 2048, p.Wta, 0, scr, r, lane); continue; } r -= I3;
            if (r < I4) { transpose_item(p.w_b_out, 2048, 2048, p.Wtb, 0, scr, r, lane); continue; } r -= I4;
            if (r < I4) { transpose_item(p.w_o, 2048, 2048, p.Wto, 0, scr, r, lane); continue; } r -= I4;
            transpose_item(p.peer_wq, 2048, 2048, p.Wtq, 0, scr, r, lane);
        }
    }
    __syncthreads();
}
constexpr int ROW6 = 1536;
typedef float f32x32_t __attribute__((ext_vector_type(32)));
typedef unsigned u32x6_t __attribute__((ext_vector_type(6)));
__device__ __forceinline__ void tc_load(const Params& p, int r, int lane, float4 (&t)[8]) {
    const bool second = r >= 16384; const int row = second ? r - 16384 : r;
    const float* src = (second ? p.peer_v : p.peer_u) + (size_t)row * DM + lane * 4;
#pragma unroll
    for (int q = 0; q < 8; ++q) t[q] = *(const float4*)(src + 256 * q);
}
constexpr int ROW4 = 1024;
__device__ __forceinline__ void tc_finish(const Params& p, int r, int lane, const float4 (&t)[8]) {
    const bool second = r >= 16384; const int row = second ? r - 16384 : r;
    float am = 0.f;
#pragma unroll
    for (int q = 0; q < 8; ++q) am = fmaxf(am, fmaxf(fmaxf(fabsf(t[q].x), fabsf(t[q].y)), fmaxf(fabsf(t[q].z), fabsf(t[q].w))));
    am = wave_max_b(am);
    {
        const float sc = (am > 0.f) ? am * (1.0f / 6.0f) : 1.0f, inv = (am > 0.f) ? 6.0f / am : 1.0f;
        unsigned w0 = 0u, w1 = 0u, w2 = 0u, w3 = 0u;
#define TC_PK(W_, qa_, qb_) do { \
        W_ = __builtin_amdgcn_cvt_scalef32_pk_fp4_f32(W_, t[qa_].x * inv, t[qa_].y * inv, 1.0f, 0); W_ = __builtin_amdgcn_cvt_scalef32_pk_fp4_f32(W_, t[qa_].z * inv, t[qa_].w * inv, 1.0f, 1); \
        W_ = __builtin_amdgcn_cvt_scalef32_pk_fp4_f32(W_, t[qb_].x * inv, t[qb_].y * inv, 1.0f, 2); W_ = __builtin_amdgcn_cvt_scalef32_pk_fp4_f32(W_, t[qb_].z * inv, t[qb_].w * inv, 1.0f, 3); } while (0)
        TC_PK(w0, 0, 1); TC_PK(w1, 2, 3); TC_PK(w2, 4, 5); TC_PK(w3, 6, 7);
#undef TC_PK
        *(uint4*)((second ? p.V8 : p.U8) + (size_t)row * ROW4 + lane * 16) = make_uint4(w0, w1, w2, w3);
        if (lane == 0) (second ? p.sv : p.su)[row] = sc;
    }
}
__device__ __forceinline__ void ph_tabconv(const Params& p, int bid, int nb) {
    const int tid = tid_(), wave = tid >> 6, lane = tid & 63;
    for (int r = bid * 8 + wave; r < 2 * 16384; r += nb * 8) { float4 t[8]; tc_load(p, r, lane, t); tc_finish(p, r, lane, t); }
}

__device__ __forceinline__ void ph_modnorm(const Params& p, const float* xin, const float* g, int sh_off, int sc_off, bf16_t* hout, int bid, int nb, float* lds) {
    const int tid = tid_(), wave = tid >> 6, lane = tid & 63;
    const int stride = nb * 8;
    int row = bid * 8 + wave;
    float4 v[8], vn[8];
    if (row < NTOK) {
#pragma unroll
        for (int j = 0; j < 8; ++j) v[j] = ((const float4*)(xin + (size_t)row * DM))[lane + 64 * j];
    }
    for (; row < NTOK; row += stride) {
        const int nrow = row + stride;
        if (nrow < NTOK) {
#pragma unroll
            for (int j = 0; j < 8; ++j) vn[j] = ((const float4*)(xin + (size_t)nrow * DM))[lane + 64 * j];
        }
        const int b = row / SQ;
        float ss = 0.f;
#pragma unroll
        for (int j = 0; j < 8; ++j) ss += dot4(v[j], v[j]);
        ss = wave_sum(ss);
        const float rs = 1.0f / sqrtf(ss * (1.0f / DM) + 1e-6f);
#pragma unroll
        for (int j = 0; j < 8; ++j) {
            const int col = (lane + 64 * j) * 4;
            const float4 g4 = *(const float4*)(g + col);
            const float4 sc = *(const float4*)(p.ada + b * NMOD + sc_off + col);
            const float4 sh = *(const float4*)(p.ada + b * NMOD + sh_off + col);
            float4 o;
            o.x = v[j].x * rs * g4.x * (1.0f + sc.x) + sh.x; o.y = v[j].y * rs * g4.y * (1.0f + sc.y) + sh.y;
            o.z = v[j].z * rs * g4.z * (1.0f + sc.z) + sh.z; o.w = v[j].w * rs * g4.w * (1.0f + sc.w) + sh.w;
            st_wt8(hout + (size_t)row * DM + col, make_uint2(pk2(o.x, o.y), pk2(o.z, o.w)));
        }
#pragma unroll
        for (int j = 0; j < 8; ++j) v[j] = vn[j];
    }
}

typedef short bf16x8_t __attribute__((ext_vector_type(8)));
typedef float f32x4_t __attribute__((ext_vector_type(4)));
__device__ __forceinline__ bf16x8_t ldfrag(const char* base, int row, int chunk, int rb, int sm) { return *(const bf16x8_t*)(base + row * rb + ((chunk ^ (row & sm)) << 4)); }
__device__ __forceinline__ void ph_gmlp2(const Params& p, int bid, int nb, float* lds) {
    char* WM = (char*)lds; char* VT = WM + 32768;
    const int tid = tid_(), wave = tid >> 6, lane = tid & 63, fr = lane & 15, fq = lane >> 4;
    int gl = -1;
    for (int it = bid; it < 512; it += nb) {
        const int g = it & 7, n = (it >> 3) & 31, b = it >> 8;
        const int tok0 = b * SQ + n * 128;
        __syncthreads();
        if (g != gl) {
            for (int u = tid; u < 2048; u += NTH) {
                const int i = u >> 4, c = u & 15;
                const float4* src = (const float4*)(p.gm_ws + (size_t)g * 16384 + i * 128 + c * 8);
                float4 a = src[0], b4 = src[1];
                if ((i >> 6) < (c >> 3)) { a = make_float4(0.f, 0.f, 0.f, 0.f); b4 = a; }
                *(uint4*)(WM + i * 256 + ((c ^ (i & 15)) << 4)) = make_uint4(pk2(a.x, a.y), pk2(a.z, a.w), pk2(b4.x, b4.y), pk2(b4.z, b4.w));
            }
            gl = g;
        }
        {
            const float2 gn = *(const float2*)(p.gm_v_g + g * 128 + lane * 2);
#pragma unroll 4
            for (int jj = 0; jj < 16; ++jj) {
                const int j = wave * 16 + jj;
                const unsigned w = *(const unsigned*)(p.ZG + (size_t)(tok0 + j) * ZW + 1024 + g * 128 + lane * 2);
                const float a = bflo(w), c2 = bfhi(w);
                const float ss = wave_sum(a * a + c2 * c2);
                const float rs = 1.0f / sqrtf(ss * (1.0f / 128.0f) + 1e-6f);
                const int d0 = lane * 2, d1 = d0 + 1;
                *(bf16_t*)(VT + d0 * 256 + (((j >> 3) ^ (d0 & 15)) << 4) + (j & 7) * 2) = (bf16_t)f2bf(a * rs * gn.x);
                *(bf16_t*)(VT + d1 * 256 + (((j >> 3) ^ (d1 & 15)) << 4) + (j & 7) * 2) = (bf16_t)f2bf(c2 * rs * gn.y);
            }
        }
        __syncthreads();
        {
            bf16x8_t A[4];
#pragma unroll
            for (int ks = 0; ks < 4; ++ks) A[ks] = ldfrag(VT, wave * 16 + fr, ks * 4 + fq, 256, 15);
            const int d0 = wave * 16 + fq * 4;
#pragma unroll
            for (int itl = 0; itl < 8; ++itl) {
                f32x4_t acc = {0.f, 0.f, 0.f, 0.f};
#pragma unroll
                for (int ks = 0; ks < 4; ++ks) if (itl >= 4 || ks < 2) acc = __builtin_amdgcn_mfma_f32_16x16x32_bf16(A[ks], ldfrag(WM, itl * 16 + fr, ks * 4 + fq, 256, 15), acc, 0, 0, 0);
                const int i = itl * 16 + fr;
                const float bias = p.gm_b[g * 128 + i];
                const size_t tok = (size_t)(tok0 + i);
                const uint2 uw = *(const uint2*)(p.ZG + tok * ZW + g * 128 + d0);
                *(uint2*)(p.yain + tok * 1024 + g * 128 + d0) = make_uint2(pk2(bflo(uw.x) * (acc[0] + bias), bfhi(uw.x) * (acc[1] + bias)), pk2(bflo(uw.y) * (acc[2] + bias), bfhi(uw.y) * (acc[3] + bias)));
            }
        }
    }
    __syncthreads();
}

__device__ __forceinline__ void ph_ret(const Params& p, int bid, int nb, float* lds) {
    float* Qs = lds;
    float* Ks = Qs + 64 * 129;
    float* Vs = Ks + 64 * 129;
    float* Ss = Vs + 64 * 16;
    float* At = Ss + 128 * 16;
    float* kd = At + 64 * 65;
    const int tid = tid_();
    const bf16_t* z = p.ZG;
    for (int it = bid; it < 256; it += nb) {
        const int vs = it & 15, h = (it >> 4) & 7, b = it >> 7;
        const float lg = log1pf(-exp2f(-5.0f - (float)h));
        const float cdec = expf(lg * 64.0f);
        __syncthreads();
        for (int i = tid; i < 2048; i += NTH) Ss[i] = 0.f;
        if (tid < 64) kd[tid] = expf(lg * (float)(63 - tid));
        for (int n = 0; n < 64; ++n) {
            const int tok0 = b * SQ + n * 64;
            __syncthreads();
            for (int e = tid; e < 4096; e += NTH) {
                const int i = e >> 6, dd = e & 63; const size_t tok = (size_t)(tok0 + i);
                const float cs = p.rope[(tok * 64 + dd) * 2], sn = p.rope[(tok * 64 + dd) * 2 + 1];
                const bf16_t* zr = z + tok * ZW;
                const float q1 = bf2f(zr[2048 + h * 128 + dd]), q2 = bf2f(zr[2048 + h * 128 + 64 + dd]);
                const float k1 = bf2f(zr[3072 + h * 128 + dd]), k2 = bf2f(zr[3072 + h * 128 + 64 + dd]);
                Qs[i * 129 + dd] = q1 * cs - q2 * sn; Qs[i * 129 + 64 + dd] = q1 * sn + q2 * cs;
                const float sc = 0.08838834764831845f;
                Ks[i * 129 + dd] = (k1 * cs - k2 * sn) * sc; Ks[i * 129 + 64 + dd] = (k1 * sn + k2 * cs) * sc;
            }
            for (int e = tid; e < 1024; e += NTH) { const int j = e >> 4, v = e & 15; Vs[e] = bf2f(z[(size_t)(tok0 + j) * ZW + 4096 + h * 256 + vs * 16 + v]); }
            __syncthreads();
            {
                const int j = tid & 63, i0 = (tid >> 6) * 8;
                float acc[8];
#pragma unroll
                for (int ii = 0; ii < 8; ++ii) acc[ii] = 0.f;
                for (int d = 0; d < 128; ++d) {
                    const float kv = Ks[j * 129 + d];
#pragma unroll
                    for (int ii = 0; ii < 8; ++ii) acc[ii] += Qs[(i0 + ii) * 129 + d] * kv;
                }
#pragma unroll
                for (int ii = 0; ii < 8; ++ii) { const int i = i0 + ii; At[i * 65 + j] = acc[ii] * expf(lg * fabsf((float)(i - j))); }
            }
            __syncthreads();
            {
                const int v = tid & 15, i0 = tid >> 4;
#pragma unroll
                for (int rep = 0; rep < 2; ++rep) {
                    const int i = i0 + 32 * rep;
                    float a = 0.f; for (int j = 0; j < 64; ++j) a += At[i * 65 + j] * Vs[j * 16 + v];
                    float c2 = 0.f; for (int d = 0; d < 128; ++d) c2 += Qs[i * 129 + d] * Ss[d * 16 + v];
                    p.obuf[(size_t)(tok0 + i) * DM + h * 256 + vs * 16 + v] = a + c2 * expf(lg * (float)(i + 1));
                }
            }
            __syncthreads();
            {
                const int v = tid & 15, d0 = tid >> 4;
#pragma unroll
                for (int rep = 0; rep < 4; ++rep) {
                    const int d = d0 + 32 * rep;
                    float a = 0.f; for (int j = 0; j < 64; ++j) a += Ks[j * 129 + d] * kd[j] * Vs[j * 16 + v];
                    Ss[d * 16 + v] = Ss[d * 16 + v] * cdec + a;
                }
            }
        }
    }
    __syncthreads();
}


__device__ __forceinline__ void ph_retprep(const Params& p, int bid, int nb, float* lds) {
    bf16_t* Kl = (bf16_t*)lds;
    bf16_t* Vl = Kl + 64 * 132;
    char* Qm = (char*)(Vl + 64 * 264);
    char* Km = Qm + 16384;
    const int tid = tid_(), wave = tid >> 6, lane = tid & 63, fr = lane & 15, fq = lane >> 4;
    for (int it = bid; it < 1024; it += nb) {
        const int n = it & 63, h = (it >> 6) & 7, b = it >> 9;
        const int tok0 = b * SQ + n * 64;
        const size_t rowbase = (size_t)(b * 8 + h) * SQ + n * 64;
        const float lg = log1pf(-exp2f(-5.0f - (float)h));
        __syncthreads();
#pragma unroll
        for (int k = 0; k < 2; ++k) {
            const int u = tid + 512 * k, i = u >> 4, dd = (u & 15) * 4; const size_t tok = (size_t)(tok0 + i);
            const float4 r0 = *(const float4*)(p.rope + (tok * 64 + dd) * 2), r1 = *(const float4*)(p.rope + (tok * 64 + dd) * 2 + 4);
            const float cs[4] = {r0.x, r0.z, r1.x, r1.z}, sn[4] = {r0.y, r0.w, r1.y, r1.w};
            const bf16_t* zr = p.ZG + tok * ZW;
            const uint2 q1w = *(const uint2*)(zr + 2048 + h * 128 + dd), q2w = *(const uint2*)(zr + 2048 + h * 128 + 64 + dd);
            const uint2 k1w = *(const uint2*)(zr + 3072 + h * 128 + dd), k2w = *(const uint2*)(zr + 3072 + h * 128 + 64 + dd);
            const float q1[4] = {bflo(q1w.x), bfhi(q1w.x), bflo(q1w.y), bfhi(q1w.y)}, q2[4] = {bflo(q2w.x), bfhi(q2w.x), bflo(q2w.y), bfhi(q2w.y)};
            const float k1[4] = {bflo(k1w.x), bfhi(k1w.x), bflo(k1w.y), bfhi(k1w.y)}, k2[4] = {bflo(k2w.x), bfhi(k2w.x), bflo(k2w.y), bfhi(k2w.y)};
            const float sc = 0.08838834764831845f, kd = expf(lg * (float)(63 - i));
            float qa[4], qb[4], ka[4], kb[4];
#pragma unroll
            for (int e = 0; e < 4; ++e) { qa[e] = q1[e] * cs[e] - q2[e] * sn[e]; qb[e] = q1[e] * sn[e] + q2[e] * cs[e]; ka[e] = (k1[e] * cs[e] - k2[e] * sn[e]) * sc; kb[e] = (k1[e] * sn[e] + k2[e] * cs[e]) * sc; }
            const uint2 qaw = make_uint2(pk2(qa[0], qa[1]), pk2(qa[2], qa[3])), qbw = make_uint2(pk2(qb[0], qb[1]), pk2(qb[2], qb[3]));
            const uint2 kaw = make_uint2(pk2(ka[0], ka[1]), pk2(ka[2], ka[3])), kbw = make_uint2(pk2(kb[0], kb[1]), pk2(kb[2], kb[3]));
            *(uint2*)(p.Qr + (rowbase + i) * 128 + dd) = qaw; *(uint2*)(p.Qr + (rowbase + i) * 128 + 64 + dd) = qbw;
            const int c = dd >> 3, o8 = (dd & 7) * 2;
            *(uint2*)(Qm + i * 256 + ((c ^ (i & 15)) << 4) + o8) = qaw; *(uint2*)(Qm + i * 256 + (((c + 8) ^ (i & 15)) << 4) + o8) = qbw;
            *(uint2*)(Km + i * 256 + ((c ^ (i & 15)) << 4) + o8) = kaw; *(uint2*)(Km + i * 256 + (((c + 8) ^ (i & 15)) << 4) + o8) = kbw;
            *(uint2*)(Kl + i * 132 + dd) = make_uint2(pk2(ka[0] * kd, ka[1] * kd), pk2(ka[2] * kd, ka[3] * kd));
            *(uint2*)(Kl + i * 132 + 64 + dd) = make_uint2(pk2(kb[0] * kd, kb[1] * kd), pk2(kb[2] * kd, kb[3] * kd));
        }
#pragma unroll
        for (int k = 0; k < 4; ++k) {
            const int u = tid + 512 * k, j = u >> 5, c = u & 31;
            *(uint4*)(Vl + j * 264 + c * 8) = *(const uint4*)(p.ZG + (size_t)(tok0 + j) * ZW + 4096 + h * 256 + c * 8);
        }
        __syncthreads();
        {
            const int jt = wave >> 1, it0 = 2 * (wave & 1);
            f32x4_t s0 = {0.f, 0.f, 0.f, 0.f}, s1 = {0.f, 0.f, 0.f, 0.f};
#pragma unroll
            for (int ks = 0; ks < 4; ++ks) {
                const bf16x8_t a = ldfrag(Km, jt * 16 + fr, ks * 4 + fq, 256, 15);
                const bf16x8_t b0 = ldfrag(Qm, it0 * 16 + fr, ks * 4 + fq, 256, 15), b1 = ldfrag(Qm, (it0 + 1) * 16 + fr, ks * 4 + fq, 256, 15);
                s0 = __builtin_amdgcn_mfma_f32_16x16x32_bf16(a, b0, s0, 0, 0, 0);
                s1 = __builtin_amdgcn_mfma_f32_16x16x32_bf16(a, b1, s1, 0, 0, 0);
            }
            const int j0 = jt * 16 + fq * 4;
            bf16_t* pg = p.Pm + (size_t)it * 4096;
#pragma unroll
            for (int tt = 0; tt < 2; ++tt) {
                const int i = (it0 + tt) * 16 + fr; const f32x4_t sv4 = tt ? s1 : s0; float pv[4];
#pragma unroll
                for (int r = 0; r < 4; ++r) pv[r] = sv4[r] * __expf(lg * fabsf((float)(i - (j0 + r))));
                *(uint2*)(pg + i * 64 + j0) = make_uint2(pk2(pv[0], pv[1]), pk2(pv[2], pv[3]));
            }
        }
        bf16_t* kt = p.KTd + (size_t)it * 8192;
#pragma unroll
        for (int k = 0; k < 2; ++k) {
            const int u = tid + 512 * k, d = u & 127, jg = u >> 7;
            unsigned w[4];
#pragma unroll
            for (int q = 0; q < 4; ++q) w[q] = (unsigned)Kl[(jg * 8 + 2 * q) * 132 + d] | ((unsigned)Kl[(jg * 8 + 2 * q + 1) * 132 + d] << 16);
            *(uint4*)(kt + d * 64 + jg * 8) = make_uint4(w[0], w[1], w[2], w[3]);
        }
        bf16_t* vt = p.Vt + (size_t)it * 16384;
#pragma unroll
        for (int k = 0; k < 4; ++k) {
            const int u = tid + 512 * k, v = u & 255, jg = u >> 8;
            unsigned w[4];
#pragma unroll
            for (int q = 0; q < 4; ++q) w[q] = (unsigned)Vl[(jg * 8 + 2 * q) * 264 + v] | ((unsigned)Vl[(jg * 8 + 2 * q + 1) * 264 + v] << 16);
            *(uint4*)(vt + v * 64 + jg * 8) = make_uint4(w[0], w[1], w[2], w[3]);
        }
    }
    __syncthreads();
}

__device__ __forceinline__ void ph_ret2(const Params& p, int bid, int nb, float* lds) {
    char* L = (char*)lds;
    constexpr int OQ = 0, OKT = 16384, OPP = 32768, OVT = 40960, TILE = 43008, OST = 2 * TILE;
    const int tid = tid_(), wave = tid >> 6, lane = tid & 63, fr = lane & 15, fq = lane >> 4;
    for (int it = bid; it < 256; it += nb) {
        const int itm = ((it & 7) * 2 + (it >> 7)) * 16 + ((it >> 3) & 15);
        const int vs = itm & 15, h = (itm >> 4) & 7, b = itm >> 7;
        const float lg = log1pf(-exp2f(-5.0f - (float)h));
        const float cdec = expf(lg * 64.0f);
        const size_t bh = (size_t)(b * 8 + h);
        const char* gQ = (const char*)(p.Qr + bh * SQ * 128);
        const char* gKT = (const char*)(p.KTd + bh * 64 * 8192);
        const char* gP = (const char*)(p.Pm + bh * 64 * 4096);
        const char* gVt = (const char*)(p.Vt + bh * 64 * 16384) + vs * 16 * 128;
        int lq[2], lkt[2];
#pragma unroll
        for (int u = 0; u < 2; ++u) { const int ci = tid + 512 * u; const int r = ci >> 4, c = ci & 15; lq[u] = r * 256 + ((c ^ (r & 15)) << 4); const int d = ci >> 3, c8 = ci & 7; lkt[u] = d * 128 + ((c8 ^ (d & 7)) << 4); }
        const int lp = (tid >> 3) * 128 + (((tid & 7) ^ ((tid >> 3) & 7)) << 4);
        const int lv = lp;
        uint4 qA0, qA1, tA0, tA1, pA, vA = make_uint4(0u, 0u, 0u, 0u), qB0, qB1, tB0, tB1, pB, vB = make_uint4(0u, 0u, 0u, 0u);
#define RET_LOAD(X_, n_) do { const size_t o0 = (size_t)(n_) * 16384 + (size_t)tid * 16, o1 = o0 + 8192; \
        q##X_##0 = *(const uint4*)(gQ + o0); q##X_##1 = *(const uint4*)(gQ + o1); t##X_##0 = *(const uint4*)(gKT + o0); t##X_##1 = *(const uint4*)(gKT + o1); p##X_ = *(const uint4*)(gP + (size_t)(n_) * 8192 + tid * 16); \
        if (tid < 128) v##X_ = *(const uint4*)(gVt + (size_t)(n_) * 32768 + tid * 16); } while (0)
#define RET_WRITE(X_, buf_) do { char* B_ = L + (buf_) * TILE; \
        *(uint4*)(B_ + OQ + lq[0]) = q##X_##0; *(uint4*)(B_ + OQ + lq[1]) = q##X_##1; *(uint4*)(B_ + OKT + lkt[0]) = t##X_##0; *(uint4*)(B_ + OKT + lkt[1]) = t##X_##1; *(uint4*)(B_ + OPP + lp) = p##X_; \
        if (tid < 128) *(uint4*)(B_ + OVT + lv) = v##X_; } while (0)
        __syncthreads();
        for (int i = tid; i < 1024; i += NTH) ((unsigned*)(L + OST))[i] = 0u;
        RET_LOAD(A, 0); RET_WRITE(A, 0); RET_LOAD(B, 1);
        f32x4_t sacc[2] = {{0.f, 0.f, 0.f, 0.f}, {0.f, 0.f, 0.f, 0.f}};
#define RET_STEP(n_, cur_, LS_, WS_) do { const int n = (n_); constexpr int cur = (cur_); \
            __syncthreads();                                     \
            if (n + 2 < 64) RET_LOAD(LS_, n + 2); \
            const char* T = L + cur * TILE; \
            if (wave < 4) {     \
                const int itl = wave; \
                f32x4_t o1 = {0.f, 0.f, 0.f, 0.f}, o2 = {0.f, 0.f, 0.f, 0.f}; \
                _Pragma("unroll") for (int ks = 0; ks < 2; ++ks) o1 = __builtin_amdgcn_mfma_f32_16x16x32_bf16(ldfrag(T + OPP, itl * 16 + fr, ks * 4 + fq, 128, 7), ldfrag(T + OVT, fr, ks * 4 + fq, 128, 7), o1, 0, 0, 0); \
                _Pragma("unroll") for (int ks = 0; ks < 4; ++ks) o2 = __builtin_amdgcn_mfma_f32_16x16x32_bf16(ldfrag(T + OQ, itl * 16 + fr, ks * 4 + fq, 256, 15), ldfrag(L + OST + cur * 4096, fr, ks * 4 + fq, 256, 15), o2, 0, 0, 0); \
                _Pragma("unroll") for (int r = 0; r < 4; ++r) { const int i = itl * 16 + fq * 4 + r; \
                    p.ob16[(size_t)(b * SQ + n * 64 + i) * DM + h * 256 + vs * 16 + fr] = (bf16_t)f2bf(o1[r] + __expf(lg * (float)(i + 1)) * o2[r]); } \
            } else {            \
                _Pragma("unroll") for (int u = 0; u < 2; ++u) { \
                    const int dt = 2 * (wave - 4) + u; \
                    sacc[u] = sacc[u] * cdec; \
                    _Pragma("unroll") for (int ks = 0; ks < 2; ++ks) sacc[u] = __builtin_amdgcn_mfma_f32_16x16x32_bf16(ldfrag(T + OKT, dt * 16 + fr, ks * 4 + fq, 128, 7), ldfrag(T + OVT, fr, ks * 4 + fq, 128, 7), sacc[u], 0, 0, 0); \
                    *(uint2*)(L + OST + (cur ^ 1) * 4096 + fr * 256 + (((dt * 2 + (fq >> 1)) ^ fr) << 4) + (fq & 1) * 8) = make_uint2(pk2(sacc[u][0], sacc[u][1]), pk2(sacc[u][2], sacc[u][3])); } \
            } \
            if (n + 1 < 64) RET_WRITE(WS_, cur ^ 1); } while (0)
#pragma unroll 1
        for (int n2 = 0; n2 < 64; n2 += 2) { RET_STEP(n2, 0, A, B); RET_STEP(n2 + 1, 1, B, A); }
#undef RET_STEP
#undef RET_LOAD
#undef RET_WRITE
    }
    __syncthreads();
}

__device__ __forceinline__ void gn_load(const Params& p, int tok, int lane, uint2 (&ow)[8], uint2 (&gw)[8]) {
#pragma unroll
    for (int h = 0; h < 8; ++h) { ow[h] = *(const uint2*)(p.ob16 + (size_t)tok * DM + h * 256 + lane * 4); gw[h] = *(const uint2*)(p.ZG + (size_t)tok * ZW + 6144 + h * 256 + lane * 4); }
}
__device__ __forceinline__ void ph_gn(const Params& p, int bid, int nb, float* lds) {
    const int tid = tid_(), wave = tid >> 6, lane = tid & 63;
    const int stride = nb * 8;
    int tok = bid * 8 + wave;
    uint2 ow[8], gw[8], own[8], gwn[8];
    if (tok < NTOK) gn_load(p, tok, lane, ow, gw);
    for (; tok < NTOK; tok += stride) {
        if (tok + stride < NTOK) gn_load(p, tok + stride, lane, own, gwn);
        float4 o[8]; float s1[8], s2[8];
#pragma unroll
        for (int h = 0; h < 8; ++h) { o[h] = make_float4(bflo(ow[h].x), bfhi(ow[h].x), bflo(ow[h].y), bfhi(ow[h].y)); s1[h] = (o[h].x + o[h].y) + (o[h].z + o[h].w); }
#pragma unroll
        for (int h = 0; h < 8; ++h) s1[h] = row_sum16(s1[h]);
#pragma unroll
        for (int h = 0; h < 8; ++h) s1[h] = xsum32(xsum16(s1[h]));
#pragma unroll
        for (int h = 0; h < 8; ++h) { const float mu = s1[h] * (1.0f / 256.0f); o[h].x -= mu; o[h].y -= mu; o[h].z -= mu; o[h].w -= mu; s2[h] = dot4(o[h], o[h]); }
#pragma unroll
        for (int h = 0; h < 8; ++h) s2[h] = row_sum16(s2[h]);
#pragma unroll
        for (int h = 0; h < 8; ++h) s2[h] = xsum32(xsum16(s2[h]));
#pragma unroll
        for (int h = 0; h < 8; ++h) {
            const float rs = 1.0f / sqrtf(s2[h] * (1.0f / 256.0f) + 1e-6f);
            const float4 gn = *(const float4*)(p.ret_gn_g + h * 256 + lane * 4);
            const float g0 = bflo(gw[h].x), g1 = bfhi(gw[h].x), g2 = bflo(gw[h].y), g3 = bfhi(gw[h].y);
            st_wt8(p.ybin + (size_t)tok * DM + h * 256 + lane * 4,
                make_uint2(pk2(siluf_(g0) * o[h].x * rs * gn.x, siluf_(g1) * o[h].y * rs * gn.y), pk2(siluf_(g2) * o[h].z * rs * gn.z, siluf_(g3) * o[h].w * rs * gn.w)));
        }
#pragma unroll
        for (int h = 0; h < 8; ++h) { ow[h] = own[h]; gw[h] = gwn[h]; }
    }
}

__device__ __forceinline__ void split8(const float4 a, const float4 b, uint4& hi, uint4& lo) {
    const float x[8] = {a.x, a.y, a.z, a.w, b.x, b.y, b.z, b.w}; unsigned h[8], l[8];
#pragma unroll
    for (int i = 0; i < 8; ++i) { h[i] = f2bf(x[i]); l[i] = f2bf(x[i] - __uint_as_float(h[i] << 16)); }
    hi = make_uint4(h[0] | (h[1] << 16), h[2] | (h[3] << 16), h[4] | (h[5] << 16), h[6] | (h[7] << 16));
    lo = make_uint4(l[0] | (l[1] << 16), l[2] | (l[3] << 16), l[4] | (l[5] << 16), l[6] | (l[7] << 16));
}
__device__ __forceinline__ bf16x8_t as_bf16x8(const uint4 v) { return __builtin_bit_cast(bf16x8_t, v); }
struct PairTab { int a[52], b[52]; };
__host__ __device__ constexpr PairTab make_pairs() {
    PairTab t{}; int n = 0;
    for (int a = 0; a < 16; ++a) for (int b = 0; b < 16; ++b) if ((a + 1) * (b + 1) <= 16) { t.a[n] = a; t.b[n] = b; ++n; }
    for (; n < 52; ++n) { t.a[n] = -1; t.b[n] = -1; }
    return t;
}
constexpr PairTab PAIRS = make_pairs();
static_assert(PAIRS.a[49] >= 0 && PAIRS.a[50] < 0, "50 candidate pairs");

template <int N, int OFF> __device__ __forceinline__ void bitonic_sort_desc(float* v) {
#pragma unroll
    for (int k = 2; k <= N; k <<= 1)
#pragma unroll
        for (int j = k >> 1; j > 0; j >>= 1)
#pragma unroll
            for (int i = 0; i < N; ++i) { const int l = i ^ j; if (l > i) { const bool up = ((i & k) == 0);
                const float a = v[OFF + i], b = v[OFF + l]; const float mx = fmaxf(a, b), mn = fminf(a, b); v[OFF + i] = up ? mx : mn; v[OFF + l] = up ? mn : mx; } }
}
template <int N> __device__ __forceinline__ void bitonic_merge_desc(float* v) {
#pragma unroll
    for (int j = N >> 1; j > 0; j >>= 1)
#pragma unroll
        for (int i = 0; i < N; ++i) { const int l = i ^ j; if (l > i) { const float a = v[i], b = v[l]; v[i] = fmaxf(a, b); v[l] = fminf(a, b); } }
}
__device__ __forceinline__ void ph_topk2(const Params& p, const float* qb, int bid, int nb, float* lds, int it_fixed) {
    const int tid = tid_(), wave = tid >> 6, lane = tid & 63;
    uint4* SK = (uint4*)lds;
    const float NEG = -INFINITY;
    const bool tc_on = (nb == 256); const int tcr0 = (bid * 8 + wave) * 16; float4 tct[8];
    if (tc_on) tc_load(p, tcr0, lane, tct);
    for (int it = (it_fixed >= 0 ? it_fixed : bid); it < 256; it += (it_fixed >= 0 ? 256 : nb)) {
        const int h = it & 7, tg = it >> 3;
        __syncthreads();
        for (int gi = tid; gi < 4096; gi += NTH) {
            const int dq = gi & 15, n = (gi >> 4) & 127, pp = gi >> 11;
            const float4* src = (const float4*)(p.peer_sk + ((size_t)(h * 2 + pp) * 128 + n) * 128 + dq * 8);
            uint4 hi, lo; split8(src[0], src[1], hi, lo);
            const int base = (((pp * 8 + (n >> 4)) * 4 + (dq >> 2)) * 2) * 64 + (dq & 3) * 16 + (n & 15);
            SK[base] = hi; SK[base + 64] = lo;
        }
        __syncthreads();
#pragma unroll 1
        for (int tile = 0; tile < 2; ++tile) {
            const int tok = tg * 256 + wave * 32 + tile * 16 + (lane & 15);
            const int qd = lane >> 4;
            float v12[2][16];
#pragma unroll
            for (int pp = 0; pp < 2; ++pp) {
                if (tc_on) { const int ti = tile * 8 + pp * 4; tc_finish(p, tcr0 + ti, lane, tct); tc_load(p, tcr0 + ti + 1, lane, tct); }
                bf16x8_t Bh[4], Bl[4];
                const float* qp = qb + (size_t)tok * DM + h * 256 + pp * 128 + 8 * qd;
#pragma unroll
                for (int ks = 0; ks < 4; ++ks) { uint4 hi, lo; split8(*(const float4*)(qp + ks * 32), *(const float4*)(qp + ks * 32 + 4), hi, lo); Bh[ks] = as_bf16x8(hi); Bl[ks] = as_bf16x8(lo); }
                float v[32];
#pragma unroll
                for (int kt = 0; kt < 8; ++kt) {
                    f32x4_t acc = {0.f, 0.f, 0.f, 0.f};
#pragma unroll
                    for (int ks = 0; ks < 4; ++ks) {
                        const bf16x8_t Ah = as_bf16x8(SK[(((pp * 8 + kt) * 4 + ks) * 2) * 64 + lane]), Al = as_bf16x8(SK[(((pp * 8 + kt) * 4 + ks) * 2 + 1) * 64 + lane]);
                        acc = __builtin_amdgcn_mfma_f32_16x16x32_bf16(Ah, Bh[ks], acc, 0, 0, 0);
                        acc = __builtin_amdgcn_mfma_f32_16x16x32_bf16(Ah, Bl[ks], acc, 0, 0, 0);
                        acc = __builtin_amdgcn_mfma_f32_16x16x32_bf16(Al, Bh[ks], acc, 0, 0, 0);
                    }
#pragma unroll
                    for (int r = 0; r < 4; ++r) v[kt * 4 + r] = __uint_as_float((__float_as_uint(acc[r]) & ~127u) | (unsigned)(kt * 16 + qd * 4 + r));
                    __builtin_amdgcn_sched_barrier(0);
                }
                if (tc_on) { const int ti = tile * 8 + pp * 4 + 1; tc_finish(p, tcr0 + ti, lane, tct); tc_load(p, tcr0 + ti + 1, lane, tct); }
                bitonic_sort_desc<16, 0>(v); bitonic_sort_desc<16, 16>(v);
                float c16[16];
#pragma unroll
                for (int i = 0; i < 16; ++i) c16[i] = fmaxf(v[i], v[31 - i]);
                bitonic_merge_desc<16>(c16);
                if (tc_on) { const int ti = tile * 8 + pp * 4 + 2; tc_finish(p, tcr0 + ti, lane, tct); tc_load(p, tcr0 + ti + 1, lane, tct); }
#pragma unroll
                for (int st = 0; st < 2; ++st) {
                    float pr[16];
#pragma unroll
                    for (int i = 0; i < 16; ++i) pr[i] = __shfl_xor(c16[i], 16 << st);
#pragma unroll
                    for (int i = 0; i < 16; ++i) c16[i] = fmaxf(c16[i], pr[15 - i]);
                    bitonic_merge_desc<16>(c16);
                }
                if (tc_on) { const int ti = tile * 8 + pp * 4 + 3; tc_finish(p, tcr0 + ti, lane, tct); if (ti < 15) tc_load(p, tcr0 + ti + 1, lane, tct); }
#pragma unroll
                for (int i = 0; i < 16; ++i) v12[pp][i] = c16[i];
            }
            float c[13]; unsigned pay[13];
#pragma unroll
            for (int s = 0; s < 13; ++s) {
                float cq[4]; unsigned pq[4];
#pragma unroll
                for (int q = 0; q < 4; ++q) {
                    const int pi = 4 * s + q; const int a = PAIRS.a[pi], b = PAIRS.b[pi];
                    if (a >= 0) {
                        const float sum = v12[0][a] + v12[1][b];
                        cq[q] = __uint_as_float((__float_as_uint(sum) & ~63u) | (unsigned)pi);
                        pq[q] = (__float_as_uint(v12[0][a]) & 127u) * 128u + (__float_as_uint(v12[1][b]) & 127u);
                    } else { cq[q] = NEG; pq[q] = 0u; }
                }
                c[s] = qd == 0 ? cq[0] : qd == 1 ? cq[1] : qd == 2 ? cq[2] : cq[3];
                pay[s] = qd == 0 ? pq[0] : qd == 1 ? pq[1] : qd == 2 ? pq[2] : pq[3];
            }
            float top[16]; unsigned eid[16];
#pragma unroll
            for (int r = 0; r < 16; ++r) {
                float m = c[0];
#pragma unroll
                for (int s = 1; s < 13; ++s) m = fmaxf(m, c[s]);
                m = fmaxf(m, __shfl_xor(m, 16)); m = fmaxf(m, __shfl_xor(m, 32));
                unsigned pw = 0u;
#pragma unroll
                for (int s = 0; s < 13; ++s) { const bool eq = (c[s] == m); pw |= eq ? pay[s] : 0u; c[s] = eq ? NEG : c[s]; }
                pw |= (unsigned)__shfl_xor((int)pw, 16); pw |= (unsigned)__shfl_xor((int)pw, 32);
                top[r] = m; eid[r] = pw;
            }
            float sum = 0.f; const float mx = top[0];
#pragma unroll
            for (int r = 0; r < 16; ++r) { top[r] = expf(top[r] - mx); sum += top[r]; }
            const float inv = 1.0f / sum;
            if (lane < 16) {
                int4* ep = (int4*)(p.eidx + (size_t)tok * 128 + h * 16); float4* gp = (float4*)(p.gatev + (size_t)tok * 128 + h * 16);
#pragma unroll
                for (int q = 0; q < 4; ++q) {
                    ep[q] = make_int4((int)eid[4 * q], (int)eid[4 * q + 1], (int)eid[4 * q + 2], (int)eid[4 * q + 3]);
                    gp[q] = make_float4(top[4 * q] * inv, top[4 * q + 1] * inv, top[4 * q + 2] * inv, top[4 * q + 3] * inv);
                }
            }
        }
    }
    __syncthreads();
}

__device__ __forceinline__ void peer_load4(const unsigned char* tab, const int (&e)[4], int lane, uint2 (&R)[4][3]) {
#pragma unroll
    for (int i = 0; i < 4; ++i) { const uint2* r = (const uint2*)(tab + (size_t)e[i] * ROW6 + lane * 8); R[i][0] = r[0]; R[i][1] = r[64]; R[i][2] = r[128]; }
}
__device__ __forceinline__ f32x32_t dec6(const uint2 (&R)[3]) { const u32x6_t w = {R[0].x, R[0].y, R[1].x, R[1].y, R[2].x, R[2].y}; return __builtin_amdgcn_cvt_scalef32_pk32_f32_fp6(w, 1.0f); }
typedef float f32x2_t __attribute__((ext_vector_type(2)));
__device__ __forceinline__ void peer_group(const Params& p, int lane, int ee, float suu, float gvv, int k0, int en, int kn,
                                           const uint4 (&Uc)[4], uint4 (&Un)[4], const f32x2_t (&hv2)[16], f32x2_t (&y2)[16]) {
    int e[4], e2[4]; float sa[4], gw[4]; uint4 Vc[4];
#pragma unroll
    for (int i = 0; i < 4; ++i) { e[i] = __builtin_amdgcn_readlane(ee, k0 + i); e2[i] = __builtin_amdgcn_readlane(en, kn + i);
        sa[i] = __uint_as_float(__builtin_amdgcn_readlane(__float_as_uint(suu), k0 + i)); gw[i] = __uint_as_float(__builtin_amdgcn_readlane(__float_as_uint(gvv), k0 + i)); }
#pragma unroll
    for (int i = 0; i < 4; ++i) Vc[i] = *((const uint4*)(p.V8 + (size_t)e[i] * ROW4) + lane);
#pragma unroll
    for (int i = 0; i < 4; ++i) Un[i] = *((const uint4*)(p.U8 + (size_t)e2[i] * ROW4) + lane);
    float a[4];
#pragma unroll
    for (int i = 0; i < 4; ++i) {
        const unsigned uw[4] = {Uc[i].x, Uc[i].y, Uc[i].z, Uc[i].w};
        f32x2_t c0 = {0.f, 0.f}, c1 = {0.f, 0.f}, c2 = {0.f, 0.f}, c3 = {0.f, 0.f};
#pragma unroll
        for (int j = 0; j < 4; ++j) {
            c0 += __builtin_amdgcn_cvt_scalef32_pk_f32_fp4(uw[j], 1.0f, 0) * hv2[4 * j + 0];
            c1 += __builtin_amdgcn_cvt_scalef32_pk_f32_fp4(uw[j], 1.0f, 1) * hv2[4 * j + 1];
            c2 += __builtin_amdgcn_cvt_scalef32_pk_f32_fp4(uw[j], 1.0f, 2) * hv2[4 * j + 2];
            c3 += __builtin_amdgcn_cvt_scalef32_pk_f32_fp4(uw[j], 1.0f, 3) * hv2[4 * j + 3];
        }
        const f32x2_t cs = (c0 + c1) + (c2 + c3);
        a[i] = cs.x + cs.y;
    }
#pragma unroll
    for (int i = 0; i < 4; ++i) a[i] = xsum32(xsum16(row_sum16(a[i])));
    const f32x2_t g01 = pg8::gelu_pk((f32x2_t){a[0] * sa[0], a[1] * sa[1]}), g23 = pg8::gelu_pk((f32x2_t){a[2] * sa[2], a[3] * sa[3]});
    const float wgt[4] = {g01.x * gw[0], g01.y * gw[1], g23.x * gw[2], g23.y * gw[3]};
#pragma unroll
    for (int i = 0; i < 4; ++i) {
        const f32x2_t w2 = {wgt[i], wgt[i]};
        const unsigned vw[4] = {Vc[i].x, Vc[i].y, Vc[i].z, Vc[i].w};
#pragma unroll
        for (int j = 0; j < 4; ++j) {
            y2[4 * j + 0] += w2 * __builtin_amdgcn_cvt_scalef32_pk_f32_fp4(vw[j], 1.0f, 0);
            y2[4 * j + 1] += w2 * __builtin_amdgcn_cvt_scalef32_pk_f32_fp4(vw[j], 1.0f, 1);
            y2[4 * j + 2] += w2 * __builtin_amdgcn_cvt_scalef32_pk_f32_fp4(vw[j], 1.0f, 2);
            y2[4 * j + 3] += w2 * __builtin_amdgcn_cvt_scalef32_pk_f32_fp4(vw[j], 1.0f, 3);
        }
    }
}
__device__ __forceinline__ void ph_peer3(const Params& p, const float* x1, const bf16_t* h2, int bid, int nb) {
    const int tid = tid_(), wave = tid >> 6, lane = tid & 63;
    for (int t = bid * 8 + wave; t < NTOK; t += nb * 8) {
        const int b = t / SQ;
        f32x2_t hv2[16], y2[16];
#pragma unroll
        for (int q = 0; q < 8; ++q) { const uint2 w = *(const uint2*)(h2 + (size_t)t * DM + 256 * q + lane * 4);
            hv2[2 * q] = (f32x2_t){bflo(w.x), bfhi(w.x)}; hv2[2 * q + 1] = (f32x2_t){bflo(w.y), bfhi(w.y)}; }
#pragma unroll
        for (int i = 0; i < 16; ++i) y2[i] = (f32x2_t){0.f, 0.f};
        const int e0 = p.eidx[(size_t)t * 128 + lane], e1 = p.eidx[(size_t)t * 128 + 64 + lane];
        const float g0 = p.gatev[(size_t)t * 128 + lane], g1 = p.gatev[(size_t)t * 128 + 64 + lane];
        const float su0 = p.su[e0], su1 = p.su[e1];
        const float gv0 = g0 * p.sv[e0], gv1 = g1 * p.sv[e1];
        uint4 UA[4], UB[4];
#pragma unroll
        for (int i = 0; i < 4; ++i) UA[i] = *((const uint4*)(p.U8 + (size_t)__builtin_amdgcn_readlane(e0, i) * ROW4) + lane);
#pragma unroll 1
        for (int g = 0; g < 16; g += 2) {
            peer_group(p, lane, e0, su0, gv0, 4 * g, e0, 4 * g + 4, UA, UB, hv2, y2);
            peer_group(p, lane, e0, su0, gv0, 4 * g + 4, (g + 2 < 16) ? e0 : e1, (g + 2 < 16) ? 4 * g + 8 : 0, UB, UA, hv2, y2);
        }
#pragma unroll 1
        for (int g = 0; g < 16; g += 2) {
            peer_group(p, lane, e1, su1, gv1, 4 * g, e1, 4 * g + 4, UA, UB, hv2, y2);
            peer_group(p, lane, e1, su1, gv1, 4 * g + 4, e1, (g + 2 < 16) ? 4 * g + 8 : 4 * g + 4, UB, UA, hv2, y2);
        }
        float y[32];
#pragma unroll
        for (int k = 0; k < 16; ++k) { y[2 * k] = y2[k].x; y[2 * k + 1] = y2[k].y; }
        float ss = 0.f;
#pragma unroll
        for (int q = 0; q < 8; ++q) {
            const int c = 256 * q + lane * 4;
            const float4 xv = *(const float4*)(x1 + (size_t)t * DM + c);
            const float4 ga = *(const float4*)(p.ada + b * NMOD + 5 * DM + c);
            float* yy = y + 4 * q;
            yy[0] = xv.x + ga.x * yy[0]; yy[1] = xv.y + ga.y * yy[1]; yy[2] = xv.z + ga.z * yy[2]; yy[3] = xv.w + ga.w * yy[3];
            ss += yy[0] * yy[0] + yy[1] * yy[1] + yy[2] * yy[2] + yy[3] * yy[3];
        }
        ss = wave_sum(ss);
        const float rs = 1.0f / sqrtf(ss * (1.0f / DM) + 1e-6f);
#pragma unroll
        for (int q = 0; q < 8; ++q) {
            const int c = 256 * q + lane * 4;
            const float4 gf = *(const float4*)(p.norm_f_g + c);
            const float* yy = y + 4 * q;
            *(float4*)(p.out + (size_t)t * DM + c) = make_float4(yy[0] * rs * gf.x, yy[1] * rs * gf.y, yy[2] * rs * gf.z, yy[3] * rs * gf.w);
        }
    }
}

#define LAS __attribute__((address_space(3)))
#define XB_TMO      128
#define XB_XCNT(j)  (256  + 64 * (j))
#define XB_XSUB(j)  (1280 + 64 * (j))
#define XB_XGEN(j)  (2304 + 64 * (j))
#define XB_TOP      3328
#define XB_TOPGEN   3392
#define XCD_BAR_WORDS 3456
#define XB_SPIN_CAP (1u << 18)

__device__ __forceinline__ unsigned xb_ld(unsigned* p)              { return __hip_atomic_load(p, __ATOMIC_RELAXED, __HIP_MEMORY_SCOPE_AGENT); }
__device__ __forceinline__ unsigned xb_add(unsigned* p, unsigned v) { return __hip_atomic_fetch_add(p, v, __ATOMIC_RELAXED, __HIP_MEMORY_SCOPE_AGENT); }
__device__ __forceinline__ unsigned xb_xcc_id() { return (unsigned)__builtin_amdgcn_s_getreg((3 << 11) | 20) & 0xFu; }
#define XB_SPIN(cond, bar) do { unsigned _sp = 0; while (cond) { __builtin_amdgcn_s_sleep(1); \
    if ((++_sp & 255u) == 0u) { if (xb_ld(&(bar)[XB_TMO])) break; if (_sp > XB_SPIN_CAP) { atomicAdd(&(bar)[XB_TMO], 1u); break; } } } } while (0)

struct XcdBarrier {
    unsigned* bar; unsigned x;
    volatile LAS unsigned* st;
};

__device__ __forceinline__ XcdBarrier xcd_barrier_post(unsigned* bar, volatile LAS unsigned* st) {
    XcdBarrier b; b.bar = bar; b.x = xb_xcc_id(); b.st = st;
    if (threadIdx.x == 0) (void)xb_add(&bar[XB_XCNT(b.x)], 1u);
    return b;
}
__device__ __forceinline__ void xcd_barrier_complete(unsigned* bar, unsigned x, unsigned& nloc, unsigned& nx) {
    const unsigned G = gridDim.x * gridDim.y * gridDim.z;
    unsigned sum, cnt, mine, sp = 0u;
    for (;;) {
        sum = 0u; cnt = 0u; mine = 0u;
#pragma unroll
        for (unsigned j = 0; j < 16; ++j) { const unsigned c = xb_ld(&bar[XB_XCNT(j)]); sum += c; cnt += (c > 0u) ? 1u : 0u; mine = (j == x) ? c : mine; }
        if (sum == G) break;
        __builtin_amdgcn_s_sleep(1);
        if ((++sp & 255u) == 0u) { if (xb_ld(&bar[XB_TMO])) break; if (sp > XB_SPIN_CAP) { atomicAdd(&bar[XB_TMO], 1u); break; } }
    }
    nloc = mine > 0u ? mine : 1u; nx = cnt > 0u ? cnt : 1u;
}

__device__ __forceinline__ void xcd_barrier(const XcdBarrier& b) {
    asm volatile("s_waitcnt vmcnt(0)" ::: "memory");
    __syncthreads();
    if (threadIdx.x == 0) {
        unsigned* bar = b.bar;
        __builtin_amdgcn_s_waitcnt(0);
        unsigned nloc = b.st[0], nx = b.st[1];
        if (nloc == 0u) { xcd_barrier_complete(bar, b.x, nloc, nx); b.st[0] = nloc; b.st[1] = nx; }
        const unsigned old = xb_add(&bar[XB_XSUB(b.x)], 1u);
        const unsigned gen = old / nloc;
        if (old + 1u == (gen + 1u) * nloc) {
            __builtin_amdgcn_fence(__ATOMIC_RELEASE, "agent");
            asm volatile("s_waitcnt vmcnt(0)" ::: "memory");
            const unsigned og = xb_add(&bar[XB_TOP], 1u);
            const unsigned tg = og / nx;
            if (og + 1u == (tg + 1u) * nx) xb_add(&bar[XB_TOPGEN], 1u);
            else XB_SPIN(xb_ld(&bar[XB_TOPGEN]) == tg, bar);
            __builtin_amdgcn_fence(__ATOMIC_ACQUIRE, "agent");
            xb_add(&bar[XB_XGEN(b.x)], 1u);
            asm volatile("s_waitcnt vmcnt(0)" ::: "memory");
        } else {
            XB_SPIN(xb_ld(&bar[XB_XGEN(b.x)]) == gen, bar);
            __builtin_amdgcn_fence(__ATOMIC_ACQUIRE, "agent");
            asm volatile("s_waitcnt vmcnt(0)" ::: "memory");
        }
    }
    __syncthreads();
}

template <class Epi>
__device__ __forceinline__ void gemm_run(float* lds, const bf16_t* A, const bf16_t* Bt, int M, int N, int K, const Epi& E) {
    __syncthreads();
    pg8::Gemm g{A, Bt, M, N, K}; pg8::StaticOrder S; S.init(M, N, (int)gridDim.x, (int)blockIdx.x);
    pg8::gemm_phase<Epi, pg8::StaticOrder, true, true>((PG8_LAS unsigned char*)lds, g, S, E);
    __syncthreads();
}
constexpr int NPHASE = 11;
template <int PH>
__device__ __forceinline__ void run_phase(const Params& p, int bid, int nb, float* lds) {
    asm volatile("" : "+s"(bid));
    if constexpr (PH == 0) ph_prep(p, bid, nb, lds);
    if constexpr (PH == 1) ph_modnorm(p, p.x, p.norm1_g, 0 * DM, 1 * DM, p.hb, bid, nb, lds);
    if constexpr (PH == 2) gemm_run(lds, p.hb, p.Wt1, NTOK, ZW, DM, pg8::EpiZG{p.ZG, p.b_bg});
    if constexpr (PH == 3) { ph_retprep(p, bid, nb, lds); ph_gmlp2(p, bid, nb, lds); }
    if constexpr (PH == 11) ph_ret2(p, bid, nb, lds);
    if constexpr (PH == 4) ph_gn(p, bid, nb, lds);
    if constexpr (PH == 5) {
        gemm_run(lds, p.yain, p.Wta, NTOK, DM, 1024, pg8::EpiMixB<0>{p.hb, p.ZG, 0});
        gemm_run(lds, p.ybin, p.Wtb, NTOK, DM, DM, pg8::EpiMixB<1>{p.hb, p.ZG, 2048});
    }
    if constexpr (PH == 6) gemm_run(lds, p.hb, p.Wto, NTOK, DM, DM, pg8::EpiResF{p.obuf, p.x, p.ada + 2 * DM});
    if constexpr (PH == 7) { ph_modnorm(p, p.obuf, p.norm2_g, 3 * DM, 4 * DM, p.hb, bid, nb, lds); if (nb != 256) ph_tabconv(p, bid, nb); }
    if constexpr (PH == 8) {
        gemm_run(lds, p.hb, p.Wtq, NTOK, DM, DM, pg8::EpiF32{p.qbuf, DM});
        if (nb == 256) {
            pg8::StaticOrder S; S.init(NTOK, DM, (int)gridDim.x, (int)blockIdx.x); pg8::Unit u; S.next(0, u);
            asm volatile("s_waitcnt vmcnt(0)" ::: "memory"); __syncthreads();
            ph_topk2(p, p.qbuf, bid, nb, lds, u.pm * 8 + u.pn);
        }
    }
    if constexpr (PH == 9) { if (nb != 256) ph_topk2(p, p.qbuf, bid, nb, lds, -1); }
    if constexpr (PH == 10) ph_peer3(p, p.obuf, p.hb, bid, nb);
}

constexpr int MISC_OFF = 132 * 1024;
__global__ void __launch_bounds__(NTH) k_mega(Params p) {
    extern __shared__ __attribute__((aligned(16))) float lds[];
    const int bid = blockIdx.x, nb = gridDim.x;
    volatile LAS unsigned* misc = (volatile LAS unsigned*)((LAS unsigned char*)lds + MISC_OFF);
    if (threadIdx.x < 4) misc[threadIdx.x] = 0u;
    __syncthreads();
    XcdBarrier bar = xcd_barrier_post(p.bar, misc);
    run_phase<0>(p, bid, nb, lds); xcd_barrier(bar);
    run_phase<1>(p, bid, nb, lds); xcd_barrier(bar);
    run_phase<2>(p, bid, nb, lds); xcd_barrier(bar);
    run_phase<3>(p, bid, nb, lds); xcd_barrier(bar);
    run_phase<11>(p, bid, nb, lds); xcd_barrier(bar);
    run_phase<4>(p, bid, nb, lds); xcd_barrier(bar);
    run_phase<5>(p, bid, nb, lds); xcd_barrier(bar);
    run_phase<6>(p, bid, nb, lds); xcd_barrier(bar);
    run_phase<7>(p, bid, nb, lds); xcd_barrier(bar);
    run_phase<8>(p, bid, nb, lds); xcd_barrier(bar);
    if (nb != 256) { run_phase<9>(p, bid, nb, lds); xcd_barrier(bar); }
    run_phase<10>(p, bid, nb, lds);
}

extern "C" void kernel_launch(void* const* d_in, const int* in_sizes, int n_in, void* d_out, int out_size, void* d_ws, size_t ws_size, hipStream_t stream) {
    Params p{};
    p.x = (const float*)d_in[0]; p.c = (const float*)d_in[1]; p.pos = (const int*)d_in[2];
    p.w_ada = (const float*)d_in[3]; p.b_ada = (const float*)d_in[4]; p.norm1_g = (const float*)d_in[5]; p.w_in = (const float*)d_in[6];
    p.w_bg = (const float*)d_in[7]; p.b_bg = (const float*)d_in[8]; p.gm_v_g = (const float*)d_in[9]; p.gm_ws = (const float*)d_in[10];
    p.gm_b = (const float*)d_in[11]; p.ret_gn_g = (const float*)d_in[12]; p.w_a_out = (const float*)d_in[13]; p.w_b_out = (const float*)d_in[14];
    p.w_o = (const float*)d_in[15]; p.norm2_g = (const float*)d_in[16]; p.peer_wq = (const float*)d_in[17]; p.peer_sk = (const float*)d_in[18];
    p.peer_u = (const float*)d_in[19]; p.peer_v = (const float*)d_in[20]; p.norm_f_g = (const float*)d_in[21];
    p.out = (float*)d_out;
    char* w = (char*)d_ws; size_t off = 0;
    auto take = [&](size_t bytes) { char* r = w + off; off += (bytes + 255) & ~(size_t)255; return r; };
    p.bar = (unsigned*)take(XCD_BAR_WORDS * 4);
    p.ada = (float*)take(2 * NMOD * 4);
    p.rope = (float*)take((size_t)NTOK * 128 * 4);
    p.eidx = (int*)take((size_t)NTOK * 128 * 4);
    p.gatev = (float*)take((size_t)NTOK * 128 * 4);
    p.Wt1 = (bf16_t*)take((size_t)ZW * DM * 2);
    p.Wta = (bf16_t*)take((size_t)DM * 1024 * 2);
    p.Wtb = (bf16_t*)take((size_t)DM * DM * 2);
    p.Wto = (bf16_t*)take((size_t)DM * DM * 2);
    p.Wtq = (bf16_t*)take((size_t)DM * DM * 2);
    p.hb = (bf16_t*)take((size_t)NTOK * DM * 2);
    p.ZG = (bf16_t*)take((size_t)NTOK * ZW * 2);
    p.qbuf = (float*)p.ZG;
    p.obuf = (float*)take((size_t)NTOK * DM * 4);
    p.ybin = (bf16_t*)take((size_t)NTOK * DM * 2);
    p.yain = (bf16_t*)take((size_t)NTOK * 1024 * 2);
    p.U8 = (unsigned char*)p.ZG + (size_t)NTOK * DM * 4;
    p.V8 = p.U8 + (size_t)16384 * ROW4;
    p.su = (float*)take(16384 * 4); p.sv = (float*)take(16384 * 4);
    p.Qr = (bf16_t*)take((size_t)NTOK * 1024 * 2);
    p.Pm = (bf16_t*)take((size_t)16 * 64 * 4096 * 2);
    p.KTd = (bf16_t*)take((size_t)NTOK * 1024 * 2);
    p.Vt = (bf16_t*)take((size_t)NTOK * 2048 * 2);
    p.ob16 = (bf16_t*)take((size_t)NTOK * DM * 2);
    if (off > ws_size) { fprintf(stderr, "kernel_launch: workspace too small: need %zu have %zu\n", off, ws_size); return; }
    static int grid = 0;
    if (!grid) {
        int dev = 0, cus = 0, per_cu = 0;
        (void)hipGetDevice(&dev); (void)hipDeviceGetAttribute(&cus, hipDeviceAttributeMultiprocessorCount, dev);
        (void)hipFuncSetAttribute((const void*)k_mega, hipFuncAttributeMaxDynamicSharedMemorySize, LDS_BYTES);
        (void)hipOccupancyMaxActiveBlocksPerMultiprocessor(&per_cu, k_mega, NTH, LDS_BYTES);
        (void)per_cu;
        grid = cus;
    }
    (void)hipMemsetAsync(p.bar, 0, XCD_BAR_WORDS * 4, stream);
    hipLaunchKernelGGL(k_mega, dim3(grid), dim3(NTH), LDS_BYTES, stream, p);
    hipError_t e = hipPeekAtLastError();
    if (e != hipSuccess) fprintf(stderr, "launch failed: %s (grid %d)\n", hipGetErrorString(e), grid);
}
```

```cpp
#include <hip/hip_runtime.h>
#include <hip/hip_cooperative_groups.h>
#include <stdint.h>
#include <math.h>
#include <cstdio>

namespace cg = cooperative_groups;

constexpr int DM = 2048;
constexpr int SQ = 4096;
constexpr int NTOK = 8192;
constexpr int NTH = 512;
constexpr int ZW = 12288;
constexpr int NMOD = 12288;
constexpr int LDS_BYTES = 136 * 1024;

typedef unsigned short bf16_t;

struct Params {
    const float *x, *c; const int* pos;
    const float *w_ada, *b_ada, *norm1_g, *w_in, *w_bg, *b_bg, *gm_v_g, *gm_ws, *gm_b, *ret_gn_g, *w_a_out, *w_b_out, *w_o, *norm2_g,
                *peer_wq, *peer_sk, *peer_u, *peer_v, *norm_f_g;
    float* out;
    float *ada, *rope, *gatev; int* eidx;
    bf16_t *Wt1, *Wta, *Wtb, *Wto, *Wtq;
    bf16_t *hb;
    bf16_t *ZG;
    float *obuf;
    bf16_t *ybin, *yain;
    float *qbuf;
    unsigned char *U8, *V8;
    float *su, *sv;
    bf16_t *Qr, *Pm, *KTd, *Vt;
    bf16_t *ob16;
    unsigned *bar;
};

__constant__ float c_freq[64] = {
1.000000000e+00f, 8.659643531e-01f, 7.498942018e-01f, 6.493816376e-01f, 5.623413324e-01f, 4.869675338e-01f, 4.216965139e-01f, 3.651741147e-01f, 3.162277639e-01f, 2.738419771e-01f, 2.371373773e-01f, 2.053525001e-01f, 1.778279394e-01f, 1.539926529e-01f, 1.333521456e-01f, 1.154781953e-01f, 1.000000015e-01f, 8.659642935e-02f, 7.498942316e-02f, 6.493816525e-02f, 5.623413250e-02f, 4.869675264e-02f, 4.216964915e-02f, 3.651741147e-02f, 3.162277490e-02f, 2.738419548e-02f, 2.371373773e-02f, 2.053525113e-02f, 1.778279431e-02f, 1.539926510e-02f, 1.333521400e-02f, 1.154781971e-02f, 9.999999776e-03f, 8.659643121e-03f, 7.498942316e-03f, 6.493816152e-03f, 5.623413250e-03f, 4.869675264e-03f, 4.216964822e-03f, 3.651741194e-03f, 3.162277630e-03f, 2.738419687e-03f, 2.371373819e-03f, 2.053525066e-03f, 1.778279431e-03f, 1.539926510e-03f, 1.333521446e-03f, 1.154782018e-03f, 1.000000047e-03f, 8.659643354e-04f, 7.498941850e-04f, 6.493816036e-04f, 5.623413017e-04f, 4.869675322e-04f, 4.216965172e-04f, 3.651741135e-04f, 3.162277571e-04f, 2.738419571e-04f, 2.371373703e-04f, 2.053525095e-04f, 1.778279402e-04f, 1.539926598e-04f, 1.333521504e-04f, 1.154782003e-04f };

__device__ __forceinline__ int tid_() { int t = threadIdx.x; asm volatile("" : "+v"(t)); return t; }
template <int CTRL> __device__ __forceinline__ float dppf(float x) { return __uint_as_float((unsigned)__builtin_amdgcn_update_dpp(0, (int)__float_as_uint(x), CTRL, 0xf, 0xf, true)); }
__device__ __forceinline__ float row_sum16(float v) { v += dppf<0xB1>(v); v += dppf<0x4E>(v); v += dppf<0x141>(v); v += dppf<0x140>(v); return v; }
__device__ __forceinline__ float xsum16(float v) { const auto r = __builtin_amdgcn_permlane16_swap(__float_as_uint(v), __float_as_uint(v), false, false); return __uint_as_float(r[0]) + __uint_as_float(r[1]); }
__device__ __forceinline__ float xsum32(float v) { const auto r = __builtin_amdgcn_permlane32_swap(__float_as_uint(v), __float_as_uint(v), false, false); return __uint_as_float(r[0]) + __uint_as_float(r[1]); }
__device__ __forceinline__ float xmax16(float v) { const auto r = __builtin_amdgcn_permlane16_swap(__float_as_uint(v), __float_as_uint(v), false, false); return fmaxf(__uint_as_float(r[0]), __uint_as_float(r[1])); }
__device__ __forceinline__ float xmax32(float v) { const auto r = __builtin_amdgcn_permlane32_swap(__float_as_uint(v), __float_as_uint(v), false, false); return fmaxf(__uint_as_float(r[0]), __uint_as_float(r[1])); }
__device__ __forceinline__ float wave_sum(float v) { v = row_sum16(v); v += __shfl_xor(v, 16); v += __shfl_xor(v, 32); return v; }
__device__ __forceinline__ float wave_max_b(float v) {
    v = fmaxf(v, dppf<0xB1>(v)); v = fmaxf(v, dppf<0x4E>(v)); v = fmaxf(v, dppf<0x141>(v)); v = fmaxf(v, dppf<0x140>(v));
    v = fmaxf(v, __shfl_xor(v, 16)); v = fmaxf(v, __shfl_xor(v, 32)); return v;
}
__device__ __forceinline__ float wave_max(float v) {
    v = fmaxf(v, dppf<0xB1>(v)); v = fmaxf(v, dppf<0x4E>(v)); v = fmaxf(v, dppf<0x141>(v)); v = fmaxf(v, dppf<0x140>(v));
    return xmax32(xmax16(v));
}
__device__ __forceinline__ float sigmoidf_(float x) { return 1.0f / (1.0f + expf(-x)); }
__device__ __forceinline__ float siluf_(float x) { return x * sigmoidf_(x); }
__device__ __forceinline__ float geluf_(float x) { return 0.5f * x * (1.0f + erff(x * 0.70710678118654752f)); }
__device__ __forceinline__ float dot4(float4 a, float4 b) { return a.x * b.x + a.y * b.y + a.z * b.z + a.w * b.w; }
__device__ __forceinline__ float bf2f(bf16_t v) { return __uint_as_float((unsigned)v << 16); }
__device__ __forceinline__ float bflo(unsigned w) { return __uint_as_float(w << 16); }
__device__ __forceinline__ float bfhi(unsigned w) { return __uint_as_float(w & 0xffff0000u); }
__device__ __forceinline__ unsigned f2bf(float f) { unsigned u = __float_as_uint(f); return (u + 0x7fffu + ((u >> 16) & 1u)) >> 16; }
__device__ __forceinline__ unsigned pk2(float lo, float hi) { return f2bf(lo) | (f2bf(hi) << 16); }

__device__ __forceinline__ void st_wt8(void* ptr, uint2 v) { __hip_atomic_store((unsigned long long*)ptr, ((unsigned long long)v.y << 32) | v.x, __ATOMIC_RELAXED, __HIP_MEMORY_SCOPE_AGENT); }
__device__ __forceinline__ void sincos_acc(float ang, float& s, float& c) {
    const double x = (double)ang;
    const double k = rint(x * 0.63661977236758134308);
    double r = fma(-k, 1.57079632679489655800, x); r = fma(-k, 6.12323399573676603587e-17, r);
    const double r2 = r * r;
    const double sp = r * (1.0 + r2 * (-1.0 / 6.0 + r2 * (1.0 / 120.0 + r2 * (-1.0 / 5040.0 + r2 * (1.0 / 362880.0 + r2 * (-1.0 / 39916800.0 + r2 * (1.0 / 6227020800.0)))))));
    const double cp = 1.0 + r2 * (-0.5 + r2 * (1.0 / 24.0 + r2 * (-1.0 / 720.0 + r2 * (1.0 / 40320.0 + r2 * (-1.0 / 3628800.0 + r2 * (1.0 / 479001600.0 + r2 * (-1.0 / 87178291200.0)))))));
    const int q = ((int)k) & 3;
    const float fs = (float)sp, fc = (float)cp;
    s = (q == 0) ? fs : (q == 1) ? fc : (q == 2) ? -fs : -fc;
    c = (q == 0) ? fc : (q == 1) ? -fs : (q == 2) ? -fc : fs;
}

namespace pg8 {
#define PG8_LAS __attribute__((address_space(3)))
typedef unsigned short bf16_t;
typedef short bf16x8 __attribute__((ext_vector_type(8)));
typedef float f32x4 __attribute__((ext_vector_type(4)));
typedef unsigned u32x4 __attribute__((ext_vector_type(4)));
constexpr int BM = 256, BK = 64, HALF = 128, HTB = HALF * BK * 2  , STAGE_BYTES = 8 * HTB, NXCD = 8, WGM = 8;

__host__ __device__ __forceinline__ int lds_byte(int r, int c) { const int st = (r >> 4) * 2 + (c >> 5), rr = r & 15, cc = c & 31, ob = rr * 64 + cc * 2; return st * 1024 + (ob ^ (((ob >> 9) & 1) << 5)); }
__host__ __device__ __forceinline__ void stage_rc(int b, int& R, int& C) { const int st = b / 1024, sb = b % 1024, swz = sb ^ (((sb >> 9) & 1) << 5); R = (st >> 1) * 16 + swz / 64; C = (st & 1) * 32 + (swz % 64) / 2; }
__host__ __device__ __forceinline__ int perm32(int rho) { const int n = rho >> 4, i = rho & 15; return 8 * (i >> 2) + 4 * n + (i & 3); }

struct Unit { int pm, pn; };
struct Gemm { const bf16_t* A; const bf16_t* Bt; int M, N, K; };

struct StaticOrder {
    int nM, nN, nwg, G, c;
    __host__ __device__ void init(int M, int N, int G_, int c_) { nM = M / BM; nN = N / BM; nwg = nM * nN; G = G_; c = c_; }
    __host__ __device__ bool next(int i, Unit& u) const {
        const long L = (long)i * G + c; if (L >= nwg) return false;
        int wgid = (int)L; { const int q = nwg / NXCD, r = nwg % NXCD, xcd = wgid % NXCD, off = wgid / NXCD; wgid = (xcd < r ? xcd * (q + 1) : r * (q + 1) + (xcd - r) * q) + off; }
        const int nig = WGM * nN, gid = wgid / nig, fm = gid * WGM, gsz = (nM - fm) < WGM ? (nM - fm) : WGM;
        u.pm = fm + ((wgid % nig) % gsz); u.pn = (wgid % nig) / gsz; return true;
    }
    __device__ __forceinline__ void a_ready(const Unit&) const {}
    __device__ __forceinline__ void done(const Unit&) const {}
};

__device__ __forceinline__ unsigned cvt_pk_bf16(float lo, float hi) { unsigned r; asm volatile("v_cvt_pk_bf16_f32 %0, %1, %2" : "=v"(r) : "v"(lo), "v"(hi)); return r; }
typedef float f32x2 __attribute__((ext_vector_type(2)));
__device__ __forceinline__ f32x2 gelu_pk(f32x2 v) {
    const f32x2 av = __builtin_elementwise_abs(v), d = av * 0.2316418882f + 1.0f;
    f32x2 t; t.x = __builtin_amdgcn_rcpf(d.x); t.y = __builtin_amdgcn_rcpf(d.y);
    f32x2 q = t * 0.5307027145f + (-0.7265760135f); q = q * t + 0.7107068705f; q = q * t + (-0.142248368f); q = q * t + 0.127414796f; q = q * t;
    const f32x2 s = (v * v) * (-0.72134752044f);
    f32x2 e; e.x = __builtin_amdgcn_exp2f(s.x); e.y = __builtin_amdgcn_exp2f(s.y);
    const f32x2 m = v * (q * e), r = v - m;
    f32x2 o; o.x = v.x < 0.f ? m.x : r.x; o.y = v.y < 0.f ? m.y : r.y; return o;
}

typedef unsigned u32x2v __attribute__((ext_vector_type(2)));
struct EpiZG {
    static constexpr bool PERM = true, AFTER_DRAIN = false;
    bf16_t* O; const float* bias;
    __device__ __forceinline__ void operator()(const f32x4 (&acc)[2][2][4][2], const Unit& u, int wr, int wc, int fr, int fq) const {
        const int row0 = u.pm * BM + wr * 64 + fr, col0 = u.pn * BM + wc * 32 + 8 * fq;
        const int mode = u.pn < 8 ? 1 : (u.pn < 32 ? 0 : 2);
        f32x4 bv[2][2];
#pragma unroll
        for (int bj = 0; bj < 2; ++bj)
#pragma unroll
            for (int n = 0; n < 2; ++n) bv[bj][n] = (mode == 2) ? *(const f32x4*)(bias + (col0 - 8192) + bj * HALF + 4 * n) : (f32x4){0.f, 0.f, 0.f, 0.f};
#pragma unroll
        for (int ai = 0; ai < 2; ++ai)
#pragma unroll
            for (int m = 0; m < 4; ++m) { bf16_t* rowp = O + (size_t)(row0 + ai * HALF + m * 16) * ZW + col0;
#pragma unroll
                for (int bj = 0; bj < 2; ++bj) { f32x4 v0 = acc[ai][bj][m][0], v1 = acc[ai][bj][m][1];
                    if (mode == 1) { f32x2 a = gelu_pk((f32x2){v0[0], v0[1]}), b = gelu_pk((f32x2){v0[2], v0[3]}), c = gelu_pk((f32x2){v1[0], v1[1]}), d = gelu_pk((f32x2){v1[2], v1[3]});
                        v0 = (f32x4){a.x, a.y, b.x, b.y}; v1 = (f32x4){c.x, c.y, d.x, d.y}; }
                    if (mode == 2) { v0 = v0 + bv[bj][0]; v1 = v1 + bv[bj][1];
#pragma unroll
                        for (int e = 0; e < 4; ++e) { v0[e] = __builtin_amdgcn_rcpf(1.0f + __expf(-v0[e])); v1[e] = __builtin_amdgcn_rcpf(1.0f + __expf(-v1[e])); } }
                    u32x4 w; w.x = cvt_pk_bf16(v0[0], v0[1]); w.y = cvt_pk_bf16(v0[2], v0[3]); w.z = cvt_pk_bf16(v1[0], v1[1]); w.w = cvt_pk_bf16(v1[2], v1[3]);
                    *(u32x4*)(rowp + bj * HALF) = w; } }
    }
};
template <int ACCUM> struct EpiMixB {
    static constexpr bool PERM = true, AFTER_DRAIN = false;
    bf16_t* Mo; const bf16_t* ZGp; int goff;
    __device__ __forceinline__ void operator()(const f32x4 (&acc)[2][2][4][2], const Unit& u, int wr, int wc, int fr, int fq) const {
        const int row0 = u.pm * BM + wr * 64 + fr, col0 = u.pn * BM + wc * 32 + 8 * fq;
#pragma unroll
        for (int ai = 0; ai < 2; ++ai)
#pragma unroll
            for (int m = 0; m < 4; ++m) { const size_t row = (size_t)(row0 + ai * HALF + m * 16);
#pragma unroll
                for (int bj = 0; bj < 2; ++bj) { const f32x4 v0 = acc[ai][bj][m][0], v1 = acc[ai][bj][m][1];
                    const u32x4 g = *(const u32x4*)(ZGp + row * ZW + 8192 + goff + col0 + bj * HALF);
                    float o[8];
                    o[0] = bflo(g.x) * v0[0]; o[1] = bfhi(g.x) * v0[1]; o[2] = bflo(g.y) * v0[2]; o[3] = bfhi(g.y) * v0[3];
                    o[4] = bflo(g.z) * v1[0]; o[5] = bfhi(g.z) * v1[1]; o[6] = bflo(g.w) * v1[2]; o[7] = bfhi(g.w) * v1[3];
                    bf16_t* mp = Mo + row * DM + col0 + bj * HALF;
                    if (ACCUM) { const u32x4 old = *(const u32x4*)mp;
                        o[0] += bflo(old.x); o[1] += bfhi(old.x); o[2] += bflo(old.y); o[3] += bfhi(old.y); o[4] += bflo(old.z); o[5] += bfhi(old.z); o[6] += bflo(old.w); o[7] += bfhi(old.w); }
                    u32x4 w; w.x = cvt_pk_bf16(o[0], o[1]); w.y = cvt_pk_bf16(o[2], o[3]); w.z = cvt_pk_bf16(o[4], o[5]); w.w = cvt_pk_bf16(o[6], o[7]);
                    *(u32x4*)mp = w; } }
    }
};
struct EpiResF {
    static constexpr bool PERM = false, AFTER_DRAIN = false;
    float* x1; const float* x; const float* ga;
    __device__ __forceinline__ void operator()(const f32x4 (&acc)[2][2][4][2], const Unit& u, int wr, int wc, int fr, int fq) const {
        const int row0 = u.pm * BM + wr * 64 + fr, col0 = u.pn * BM + wc * 32 + 4 * fq;
        const int b = (u.pm * BM) / SQ;
        f32x4 gv[2][2];
#pragma unroll
        for (int bj = 0; bj < 2; ++bj)
#pragma unroll
            for (int n = 0; n < 2; ++n) gv[bj][n] = *(const f32x4*)(ga + b * NMOD + col0 + bj * HALF + n * 16);
#pragma unroll
        for (int ai = 0; ai < 2; ++ai)
#pragma unroll
            for (int m = 0; m < 4; ++m) { const size_t off = (size_t)(row0 + ai * HALF + m * 16) * DM + col0;
#pragma unroll
                for (int bj = 0; bj < 2; ++bj)
#pragma unroll
                    for (int n = 0; n < 2; ++n) { const f32x4 xv = *(const f32x4*)(x + off + bj * HALF + n * 16);
                        *(f32x4*)(x1 + off + bj * HALF + n * 16) = xv + gv[bj][n] * acc[ai][bj][m][n]; } }
    }
};
struct EpiF32 {
    static constexpr bool PERM = false, AFTER_DRAIN = false;
    float* O; int ldc;
    __device__ __forceinline__ void operator()(const f32x4 (&acc)[2][2][4][2], const Unit& u, int wr, int wc, int fr, int fq) const {
        const int row0 = u.pm * BM + wr * 64 + fr, col0 = u.pn * BM + wc * 32 + 4 * fq;
#pragma unroll
        for (int ai = 0; ai < 2; ++ai)
#pragma unroll
            for (int m = 0; m < 4; ++m) { const size_t off = (size_t)(row0 + ai * HALF + m * 16) * ldc + col0;
#pragma unroll
                for (int bj = 0; bj < 2; ++bj)
#pragma unroll
                    for (int n = 0; n < 2; ++n) *(f32x4*)(O + off + bj * HALF + n * 16) = acc[ai][bj][m][n]; }
    }
};

template <class Epi, class Sched, bool ALIGN_EPI = false, bool SP2 = false>
__device__ __forceinline__ void gemm_phase(PG8_LAS unsigned char* lds, const Gemm g, const Sched& S, const Epi& E) {
    const int tid = threadIdx.x, wid = __builtin_amdgcn_readfirstlane(tid >> 6), lane = tid & 63, wr = wid >> 2, wc = wid & 3, fr = lane & 15, fq = lane >> 4;
    const int K = g.K, nt = K / BK;
    unsigned voffA[2], voffB[2];
#pragma unroll
    for (int i = 0; i < 2; ++i) { int R, C; stage_rc(tid * 16 + i * 8192, R, C); const int Rb = Epi::PERM ? ((R & ~31) + perm32(R & 31)) : R;
        voffA[i] = (unsigned)(R * K + C) * 2u; voffB[i] = (unsigned)(Rb * K + C) * 2u; }
    const size_t kstep = (size_t)(BK * 2);
    const size_t hstep = (size_t)HALF * K * 2;
    const size_t tstep = 2 * hstep;
    const unsigned ldsw = (unsigned)wid * 1024u;
    const int aoff = lds_byte(wr * 64 + fr, fq * 8), boff = lds_byte(wc * 32 + fr, fq * 8);
#define PG8_SA(b, h) (((b) * 2 + (h)) * HTB)
#define PG8_SB(b, h) ((4 + (b) * 2 + (h)) * HTB)
#define PG8_STAGE(bufoff, gbase, voff) do { _Pragma("unroll") for (int _i = 0; _i < 2; ++_i) \
        __builtin_amdgcn_global_load_lds((const unsigned*)((const char*)(gbase) + (voff)[_i]), (PG8_LAS unsigned*)(lds + (bufoff) + ldsw + _i * 8192), 16, 0, 0); } while (0)
#define PG8_LDA(dst, b, h) do { _Pragma("unroll") for (int m = 0; m < 4; ++m) _Pragma("unroll") for (int k = 0; k < 2; ++k) dst[m][k] = *(const PG8_LAS bf16x8*)(lds + PG8_SA(b, h) + aoff + m * 2048 + k * 1024); } while (0)
#define PG8_LDB(dst, b, h) do { _Pragma("unroll") for (int n = 0; n < 2; ++n) _Pragma("unroll") for (int k = 0; k < 2; ++k) dst[n][k] = *(const PG8_LAS bf16x8*)(lds + PG8_SB(b, h) + boff + n * 2048 + k * 1024); } while (0)
#define PG8_MMA(ai, bj, At, Bt) do { __builtin_amdgcn_s_setprio(1); _Pragma("unroll") for (int m = 0; m < 4; ++m) _Pragma("unroll") for (int n = 0; n < 2; ++n) _Pragma("unroll") for (int k = 0; k < 2; ++k) \
        acc[ai][bj][m][n] = __builtin_amdgcn_mfma_f32_16x16x32_bf16(Bt[n][k], At[m][k], acc[ai][bj][m][n], 0, 0, 0); __builtin_amdgcn_s_setprio(0); } while (0)
#define PG8_WAIT_V(n) asm volatile("s_waitcnt vmcnt(" #n ")" ::: "memory")
#define PG8_WAIT_L(n) asm volatile("s_waitcnt lgkmcnt(" #n ")" ::: "memory")
#define PG8_BAR __builtin_amdgcn_s_barrier()
#define PG8_SCHED __builtin_amdgcn_sched_barrier(0)
    Unit cur, nxt; int ui = 0;
    if (!S.next(0, cur)) return;
    f32x4 acc[2][2][4][2];
#pragma unroll
    for (int a = 0; a < 2; ++a)
#pragma unroll
        for (int b = 0; b < 2; ++b)
#pragma unroll
            for (int m = 0; m < 4; ++m)
#pragma unroll
                for (int n = 0; n < 2; ++n) acc[a][b][m][n] = (f32x4){0.f, 0.f, 0.f, 0.f};
    bf16x8 At[4][2], B0[2][2], B1[2][2];
    const char* cA = (const char*)g.A + (size_t)cur.pm * tstep; const char* cB = (const char*)g.Bt + (size_t)cur.pn * tstep;
    S.a_ready(cur);
    if constexpr (SP2) {
        PG8_STAGE(PG8_SB(0, 0), cB, voffB); PG8_STAGE(PG8_SB(0, 1), cB + hstep, voffB); PG8_STAGE(PG8_SA(0, 0), cA, voffA); PG8_STAGE(PG8_SA(0, 1), cA + hstep, voffA);
        if (wr == 1) PG8_BAR;
        PG8_WAIT_V(2); PG8_BAR;
        PG8_STAGE(PG8_SB(1, 0), cB + kstep, voffB); PG8_STAGE(PG8_SA(1, 0), cA + kstep, voffA); PG8_STAGE(PG8_SB(1, 1), cB + hstep + kstep, voffB);
        PG8_WAIT_V(6); PG8_BAR;
    } else {
        PG8_STAGE(PG8_SB(0, 0), cB, voffB); PG8_STAGE(PG8_SA(0, 0), cA, voffA); PG8_STAGE(PG8_SB(0, 1), cB + hstep, voffB); PG8_STAGE(PG8_SA(0, 1), cA + hstep, voffA);
        if (wr == 1) PG8_BAR;
        PG8_WAIT_V(4); PG8_BAR;
        PG8_STAGE(PG8_SB(1, 0), cB + kstep, voffB); PG8_STAGE(PG8_SA(1, 0), cA + kstep, voffA); PG8_STAGE(PG8_SB(1, 1), cB + hstep + kstep, voffB);
        PG8_WAIT_V(6); PG8_BAR;
    }
    for (;;) {
        const bool has_next = S.next(ui + 1, nxt);
        const char* nA = has_next ? (const char*)g.A + (size_t)nxt.pm * tstep : cA; const char* nB = has_next ? (const char*)g.Bt + (size_t)nxt.pn * tstep : cB;
        for (int t = 0; t < nt; t += 2) {
            const bool last = (t == nt - 2);
            const char* a1 = cA + (size_t)(t + 1) * kstep;
            const char* a2 = last ? nA : cA + (size_t)(t + 2) * kstep; const char* b2 = last ? nB : cB + (size_t)(t + 2) * kstep;
            const char* a3 = a2 + kstep; const char* b3 = b2 + kstep;
            if (last && has_next) S.a_ready(nxt);
            if constexpr (SP2) {
            PG8_LDB(B0, 0, 0); PG8_LDB(B1, 0, 1); PG8_SCHED; PG8_LDA(At, 0, 0); PG8_STAGE(PG8_SA(1, 1), a1 + hstep, voffA);
            PG8_WAIT_V(8); PG8_WAIT_L(0); PG8_BAR; PG8_MMA(0, 0, At, B0); PG8_MMA(0, 1, At, B1); PG8_BAR; PG8_SCHED;
            PG8_LDA(At, 0, 1); PG8_STAGE(PG8_SB(0, 0), b2, voffB); PG8_STAGE(PG8_SB(0, 1), b2 + hstep, voffB); PG8_STAGE(PG8_SA(0, 0), a2, voffA);
            PG8_WAIT_V(8); PG8_WAIT_L(0); PG8_BAR; PG8_MMA(1, 0, At, B0); PG8_MMA(1, 1, At, B1); PG8_BAR; PG8_SCHED;
            PG8_LDB(B0, 1, 0); PG8_LDB(B1, 1, 1); PG8_SCHED; PG8_LDA(At, 1, 0); PG8_STAGE(PG8_SA(0, 1), a2 + hstep, voffA);
            PG8_WAIT_V(8); PG8_WAIT_L(0); PG8_BAR; PG8_MMA(0, 0, At, B0); PG8_MMA(0, 1, At, B1); PG8_BAR; PG8_SCHED;
            PG8_LDA(At, 1, 1); PG8_STAGE(PG8_SB(1, 0), b3, voffB); PG8_STAGE(PG8_SB(1, 1), b3 + hstep, voffB); PG8_STAGE(PG8_SA(1, 0), a3, voffA);
            PG8_WAIT_V(8); PG8_WAIT_L(0); PG8_BAR; PG8_MMA(1, 0, At, B0); PG8_MMA(1, 1, At, B1); PG8_BAR; PG8_SCHED;
            } else {
            PG8_LDB(B0, 0, 0); PG8_SCHED; PG8_LDA(At, 0, 0); PG8_STAGE(PG8_SA(1, 1), a1 + hstep, voffA);
            PG8_WAIT_L(8); PG8_BAR; PG8_WAIT_L(0); PG8_MMA(0, 0, At, B0); PG8_BAR; PG8_SCHED;
            PG8_LDB(B1, 0, 1); PG8_STAGE(PG8_SB(0, 0), b2, voffB);
            PG8_BAR; PG8_WAIT_L(0); PG8_MMA(0, 1, At, B1); PG8_BAR;
            PG8_LDA(At, 0, 1); PG8_STAGE(PG8_SA(0, 0), a2, voffA);
            PG8_BAR; PG8_WAIT_L(0); PG8_MMA(1, 0, At, B0); PG8_BAR; PG8_SCHED;
            PG8_STAGE(PG8_SB(0, 1), b2 + hstep, voffB);
            PG8_WAIT_V(6); PG8_BAR; PG8_MMA(1, 1, At, B1); PG8_BAR;
            PG8_LDB(B0, 1, 0); PG8_SCHED; PG8_LDA(At, 1, 0); PG8_STAGE(PG8_SA(0, 1), a2 + hstep, voffA);
            PG8_WAIT_L(8); PG8_BAR; PG8_WAIT_L(0); PG8_MMA(0, 0, At, B0); PG8_BAR; PG8_SCHED;
            PG8_LDB(B1, 1, 1); PG8_STAGE(PG8_SB(1, 0), b3, voffB);
            PG8_BAR; PG8_WAIT_L(0); PG8_MMA(0, 1, At, B1); PG8_BAR;
            PG8_LDA(At, 1, 1); PG8_STAGE(PG8_SA(1, 0), a3, voffA);
            PG8_BAR; PG8_WAIT_L(0); PG8_MMA(1, 0, At, B0); PG8_BAR; PG8_SCHED;
            PG8_STAGE(PG8_SB(1, 1), b3 + hstep, voffB);
            PG8_WAIT_V(6); PG8_BAR; PG8_MMA(1, 1, At, B1); PG8_BAR;
            }
        }
        if constexpr (ALIGN_EPI) { if (wr == 0) PG8_BAR; }
        if constexpr (!Epi::AFTER_DRAIN) { E(acc, cur, wr, wc, fr, fq); S.done(cur); }
        if (!has_next) break;
#pragma unroll
        for (int a = 0; a < 2; ++a)
#pragma unroll
            for (int b = 0; b < 2; ++b)
#pragma unroll
                for (int m = 0; m < 4; ++m)
#pragma unroll
                    for (int n = 0; n < 2; ++n) acc[a][b][m][n] = (f32x4){0.f, 0.f, 0.f, 0.f};
        cur = nxt; cA = nA; cB = nB; ++ui;
        if constexpr (ALIGN_EPI) { if (wr == 1) PG8_BAR; }
    }
    PG8_WAIT_V(0);
    if constexpr (!ALIGN_EPI) { if (wr == 0) PG8_BAR; }
    PG8_BAR;
    if constexpr (Epi::AFTER_DRAIN) { E.fused(acc, cur, wr, wc, fr, fq, lds, wid, lane); S.done(cur); }
#undef PG8_SA
#undef PG8_SB
#undef PG8_STAGE
#undef PG8_LDA
#undef PG8_LDB
#undef PG8_MMA
#undef PG8_WAIT_V
#undef PG8_WAIT_L
#undef PG8_BAR
#undef PG8_SCHED
}
}
using pg8::f32x4; using pg8::u32x4;

__device__ __forceinline__ void transpose_item(const float* W, int K, int N, bf16_t* WT, int row_off, float* scr, int item, int lane) {
    const int nblk = N / 32, kb = item / nblk, nbk = item % nblk, k0 = 64 * kb, n0 = 32 * nbk;
    {
        const int r = lane >> 3, c4 = (lane & 7) * 4;
        float4 t[8];
#pragma unroll
        for (int i = 0; i < 8; ++i) t[i] = *(const float4*)(W + (size_t)(k0 + 8 * i + r) * N + n0 + c4);
#pragma unroll
        for (int i = 0; i < 8; ++i) { float* d = scr + (8 * i + r) * 33 + c4; d[0] = t[i].x; d[1] = t[i].y; d[2] = t[i].z; d[3] = t[i].w; }
    }
    asm volatile("s_waitcnt lgkmcnt(0)" ::: "memory");
    const int c = lane & 7;
#pragma unroll
    for (int j = 0; j < 4; ++j) { const int n = (lane >> 3) + 8 * j; const float* s = scr + (8 * c) * 33 + n;
        uint4 o; o.x = pk2(s[0 * 33], s[1 * 33]); o.y = pk2(s[2 * 33], s[3 * 33]); o.z = pk2(s[4 * 33], s[5 * 33]); o.w = pk2(s[6 * 33], s[7 * 33]);
        *(uint4*)(WT + (size_t)(row_off + n0 + n) * K + k0 + 8 * c) = o; }
    asm volatile("s_waitcnt lgkmcnt(0)" ::: "memory");
}
__device__ __forceinline__ void ph_prep(const Params& p, int bid, int nb, float* lds) {
    const int tid = tid_(), wave = tid >> 6, lane = tid & 63;
    {
        float* sl = lds;
        float* red = lds + 4096;
        for (int i = tid; i < 4096; i += NTH) sl[i] = siluf_(p.c[i]);
        __syncthreads();
        for (int it = bid; it < 192; it += nb) {
            const int c4 = tid & 15, kg = tid >> 4;
            const float* wp = p.w_ada + (size_t)kg * NMOD + it * 64 + c4 * 4;
            float a0[4] = {0.f, 0.f, 0.f, 0.f}, a1[4] = {0.f, 0.f, 0.f, 0.f};
#pragma unroll 8
            for (int i = 0; i < 64; ++i) {
                const int k = kg + 32 * i;
                const float4 w = *(const float4*)(wp + (size_t)(32 * i) * NMOD);
                const float s0 = sl[k], s1 = sl[2048 + k];
                a0[0] += s0 * w.x; a0[1] += s0 * w.y; a0[2] += s0 * w.z; a0[3] += s0 * w.w;
                a1[0] += s1 * w.x; a1[1] += s1 * w.y; a1[2] += s1 * w.z; a1[3] += s1 * w.w;
            }
            __syncthreads();
#pragma unroll
            for (int e = 0; e < 4; ++e) { red[(kg * 16 + c4) * 8 + e] = a0[e]; red[(kg * 16 + c4) * 8 + 4 + e] = a1[e]; }
            __syncthreads();
            if (tid < 128) {
                const int b = tid >> 6, col = tid & 63;
                float s = 0.f;
                for (int g = 0; g < 32; ++g) s += red[(g * 16 + (col >> 2)) * 8 + b * 4 + (col & 3)];
                p.ada[b * NMOD + it * 64 + col] = s + p.b_ada[it * 64 + col];
            }
        }
        __syncthreads();
    }
    for (int e = bid * NTH + tid; e < NTOK * 64; e += nb * NTH) {
        const int tok = e >> 6, j = e & 63;
        const float ang = (float)p.pos[tok] * c_freq[j];
        float s, c; sincos_acc(ang, s, c);
        p.rope[(size_t)e * 2] = c; p.rope[(size_t)e * 2 + 1] = s;
    }
    {
        float* scr = lds + wave * (64 * 33);
        const int gw = bid * 8 + wave, ngw = nb * 8;
        constexpr int I1 = 32 * 256, I2 = 32 * 128, I3 = 16 * 64, I4 = 32 * 64;
        constexpr int NIT = I1 + I2 + I3 + 3 * I4;
        for (int it = gw; it < NIT; it += ngw) {
            int r = it;
            if (r < I1) { transpose_item(p.w_in, 2048, 8192, p.Wt1, 0, scr, r, lane); continue; } r -= I1;
            if (r < I2) { transpose_item(p.w_bg, 2048, 4096, p.Wt1, 8192, scr, r, lane); continue; } r -= I2;
            if (r < I3) { transpose_item(p.w_a_out, 1024, 2048, p.Wta, 0, scr, r, lane); continue; } r -= I3;
            if (r < I4) { transpose_item(p.w_b_out, 2048, 2048, p.Wtb, 0, scr, r, lane); continue; } r -= I4;
            if (r < I4) { transpose_item(p.w_o, 2048, 2048, p.Wto, 0, scr, r, lane); continue; } r -= I4;
            transpose_item(p.peer_wq, 2048, 2048, p.Wtq, 0, scr, r, lane);
        }
    }
    __syncthreads();
}
constexpr int ROW6 = 1536;
typedef float f32x32_t __attribute__((ext_vector_type(32)));
typedef unsigned u32x6_t __attribute__((ext_vector_type(6)));
__device__ __forceinline__ void tc_load(const Params& p, int r, int lane, float4 (&t)[8]) {
    const bool second = r >= 16384; const int row = second ? r - 16384 : r;
    const float* src = (const float*)((const char*)p.peer_u + (second ? ((const char*)p.peer_v - (const char*)p.peer_u) : (ptrdiff_t)0)) + (size_t)row * DM + (second ? lane * 4 : (lane >> 2) * 128 + (lane & 3) * 8);
#pragma unroll
    for (int q = 0; q < 8; ++q) t[q] = *(const float4*)(src + (second ? 256 * q : (q >> 1) * 32 + (q & 1) * 4));
}
constexpr int ROW4 = 1024;
__device__ __forceinline__ void tc_finish(const Params& p, int r, int lane, const float4 (&t)[8]) {
    const bool second = r >= 16384; const int row = second ? r - 16384 : r;
    float am = 0.f;
#pragma unroll
    for (int q = 0; q < 8; ++q) am = fmaxf(am, fmaxf(fmaxf(fabsf(t[q].x), fabsf(t[q].y)), fmaxf(fabsf(t[q].z), fabsf(t[q].w))));
    am = wave_max_b(am);
    {
        const float sc = (am > 0.f) ? am * (1.0f / 6.0f) : 1.0f, inv = (am > 0.f) ? 6.0f / am : 1.0f;
        unsigned w0 = 0u, w1 = 0u, w2 = 0u, w3 = 0u;
#define TC_PK(W_, qa_, qb_) do { \
        W_ = __builtin_amdgcn_cvt_scalef32_pk_fp4_f32(W_, t[qa_].x * inv, t[qa_].y * inv, 1.0f, 0); W_ = __builtin_amdgcn_cvt_scalef32_pk_fp4_f32(W_, t[qa_].z * inv, t[qa_].w * inv, 1.0f, 1); \
        W_ = __builtin_amdgcn_cvt_scalef32_pk_fp4_f32(W_, t[qb_].x * inv, t[qb_].y * inv, 1.0f, 2); W_ = __builtin_amdgcn_cvt_scalef32_pk_fp4_f32(W_, t[qb_].z * inv, t[qb_].w * inv, 1.0f, 3); } while (0)
        TC_PK(w0, 0, 1); TC_PK(w1, 2, 3); TC_PK(w2, 4, 5); TC_PK(w3, 6, 7);
#undef TC_PK
        *(uint4*)(p.U8 + (size_t)r * ROW4 + lane * 16) = make_uint4(w0, w1, w2, w3);
        if (lane == 0) p.su[r] = sc;
    }
}
__device__ __forceinline__ void ph_tabconv(const Params& p, int bid, int nb) {
    const int tid = tid_(), wave = tid >> 6, lane = tid & 63;
    for (int r = bid * 8 + wave; r < 2 * 16384; r += nb * 8) { float4 t[8]; tc_load(p, r, lane, t); tc_finish(p, r, lane, t); }
}

__device__ __forceinline__ void ph_modnorm(const Params& p, const float* xin, const float* g, int sh_off, int sc_off, bf16_t* hout, int bid, int nb, float* lds) {
    const int tid = tid_(), wave = tid >> 6, lane = tid & 63;
    const int stride = nb * 8;
    int row = bid * 8 + wave;
    float4 v[8], vn[8];
    if (row < NTOK) {
#pragma unroll
        for (int j = 0; j < 8; ++j) v[j] = ((const float4*)(xin + (size_t)row * DM))[lane + 64 * j];
    }
    for (; row < NTOK; row += stride) {
        const int nrow = row + stride;
        if (nrow < NTOK) {
#pragma unroll
            for (int j = 0; j < 8; ++j) vn[j] = ((const float4*)(xin + (size_t)nrow * DM))[lane + 64 * j];
        }
        const int b = row / SQ;
        float ss = 0.f;
#pragma unroll
        for (int j = 0; j < 8; ++j) ss += dot4(v[j], v[j]);
        ss = wave_sum(ss);
        const float rs = 1.0f / sqrtf(ss * (1.0f / DM) + 1e-6f);
#pragma unroll
        for (int j = 0; j < 8; ++j) {
            const int col = (lane + 64 * j) * 4;
            const float4 g4 = *(const float4*)(g + col);
            const float4 sc = *(const float4*)(p.ada + b * NMOD + sc_off + col);
            const float4 sh = *(const float4*)(p.ada + b * NMOD + sh_off + col);
            float4 o;
            o.x = v[j].x * rs * g4.x * (1.0f + sc.x) + sh.x; o.y = v[j].y * rs * g4.y * (1.0f + sc.y) + sh.y;
            o.z = v[j].z * rs * g4.z * (1.0f + sc.z) + sh.z; o.w = v[j].w * rs * g4.w * (1.0f + sc.w) + sh.w;
            st_wt8(hout + (size_t)row * DM + col, make_uint2(pk2(o.x, o.y), pk2(o.z, o.w)));
        }
#pragma unroll
        for (int j = 0; j < 8; ++j) v[j] = vn[j];
    }
}

typedef short bf16x8_t __attribute__((ext_vector_type(8)));
typedef float f32x4_t __attribute__((ext_vector_type(4)));
__device__ __forceinline__ bf16x8_t ldfrag(const char* base, int row, int chunk, int rb, int sm) { return *(const bf16x8_t*)(base + row * rb + ((chunk ^ (row & sm)) << 4)); }
__device__ __forceinline__ void ph_gmlp2(const Params& p, int bid, int nb, float* lds) {
    char* WM = (char*)lds; char* VT = WM + 32768;
    const int tid = tid_(), wave = tid >> 6, lane = tid & 63, fr = lane & 15, fq = lane >> 4;
    int gl = -1;
    for (int it = bid; it < 512; it += nb) {
        const int g = it & 7, n = (it >> 3) & 31, b = it >> 8;
        const int tok0 = b * SQ + n * 128;
        __syncthreads();
        if (g != gl) {
            for (int u = tid; u < 2048; u += NTH) {
                const int i = u >> 4, c = u & 15;
                const float4* src = (const float4*)(p.gm_ws + (size_t)g * 16384 + i * 128 + c * 8);
                float4 a = src[0], b4 = src[1];
                if ((i >> 6) < (c >> 3)) { a = make_float4(0.f, 0.f, 0.f, 0.f); b4 = a; }
                *(uint4*)(WM + i * 256 + ((c ^ (i & 15)) << 4)) = make_uint4(pk2(a.x, a.y), pk2(a.z, a.w), pk2(b4.x, b4.y), pk2(b4.z, b4.w));
            }
            gl = g;
        }
        {
            const float2 gn = *(const float2*)(p.gm_v_g + g * 128 + lane * 2);
#pragma unroll 4
            for (int jj = 0; jj < 16; ++jj) {
                const int j = wave * 16 + jj;
                const unsigned w = *(const unsigned*)(p.ZG + (size_t)(tok0 + j) * ZW + 1024 + g * 128 + lane * 2);
                const float a = bflo(w), c2 = bfhi(w);
                const float ss = wave_sum(a * a + c2 * c2);
                const float rs = 1.0f / sqrtf(ss * (1.0f / 128.0f) + 1e-6f);
                const int d0 = lane * 2, d1 = d0 + 1;
                *(bf16_t*)(VT + d0 * 256 + (((j >> 3) ^ (d0 & 15)) << 4) + (j & 7) * 2) = (bf16_t)f2bf(a * rs * gn.x);
                *(bf16_t*)(VT + d1 * 256 + (((j >> 3) ^ (d1 & 15)) << 4) + (j & 7) * 2) = (bf16_t)f2bf(c2 * rs * gn.y);
            }
        }
        __syncthreads();
        {
            bf16x8_t A[4];
#pragma unroll
            for (int ks = 0; ks < 4; ++ks) A[ks] = ldfrag(VT, wave * 16 + fr, ks * 4 + fq, 256, 15);
            const int d0 = wave * 16 + fq * 4;
#pragma unroll
            for (int itl = 0; itl < 8; ++itl) {
                f32x4_t acc = {0.f, 0.f, 0.f, 0.f};
#pragma unroll
                for (int ks = 0; ks < 4; ++ks) if (itl >= 4 || ks < 2) acc = __builtin_amdgcn_mfma_f32_16x16x32_bf16(A[ks], ldfrag(WM, itl * 16 + fr, ks * 4 + fq, 256, 15), acc, 0, 0, 0);
                const int i = itl * 16 + fr;
                const float bias = p.gm_b[g * 128 + i];
                const size_t tok = (size_t)(tok0 + i);
                const uint2 uw = *(const uint2*)(p.ZG + tok * ZW + g * 128 + d0);
                *(uint2*)(p.yain + tok * 1024 + g * 128 + d0) = make_uint2(pk2(bflo(uw.x) * (acc[0] + bias), bfhi(uw.x) * (acc[1] + bias)), pk2(bflo(uw.y) * (acc[2] + bias), bfhi(uw.y) * (acc[3] + bias)));
            }
        }
    }
    __syncthreads();
}

__device__ __forceinline__ void ph_ret(const Params& p, int bid, int nb, float* lds) {
    float* Qs = lds;
    float* Ks = Qs + 64 * 129;
    float* Vs = Ks + 64 * 129;
    float* Ss = Vs + 64 * 16;
    float* At = Ss + 128 * 16;
    float* kd = At + 64 * 65;
    const int tid = tid_();
    const bf16_t* z = p.ZG;
    for (int it = bid; it < 256; it += nb) {
        const int vs = it & 15, h = (it >> 4) & 7, b = it >> 7;
        const float lg = log1pf(-exp2f(-5.0f - (float)h));
        const float cdec = expf(lg * 64.0f);
        __syncthreads();
        for (int i = tid; i < 2048; i += NTH) Ss[i] = 0.f;
        if (tid < 64) kd[tid] = expf(lg * (float)(63 - tid));
        for (int n = 0; n < 64; ++n) {
            const int tok0 = b * SQ + n * 64;
            __syncthreads();
            for (int e = tid; e < 4096; e += NTH) {
                const int i = e >> 6, dd = e & 63; const size_t tok = (size_t)(tok0 + i);
                const float cs = p.rope[(tok * 64 + dd) * 2], sn = p.rope[(tok * 64 + dd) * 2 + 1];
                const bf16_t* zr = z + tok * ZW;
                const float q1 = bf2f(zr[2048 + h * 128 + dd]), q2 = bf2f(zr[2048 + h * 128 + 64 + dd]);
                const float k1 = bf2f(zr[3072 + h * 128 + dd]), k2 = bf2f(zr[3072 + h * 128 + 64 + dd]);
                Qs[i * 129 + dd] = q1 * cs - q2 * sn; Qs[i * 129 + 64 + dd] = q1 * sn + q2 * cs;
                const float sc = 0.08838834764831845f;
                Ks[i * 129 + dd] = (k1 * cs - k2 * sn) * sc; Ks[i * 129 + 64 + dd] = (k1 * sn + k2 * cs) * sc;
            }
            for (int e = tid; e < 1024; e += NTH) { const int j = e >> 4, v = e & 15; Vs[e] = bf2f(z[(size_t)(tok0 + j) * ZW + 4096 + h * 256 + vs * 16 + v]); }
            __syncthreads();
            {
                const int j = tid & 63, i0 = (tid >> 6) * 8;
                float acc[8];
#pragma unroll
                for (int ii = 0; ii < 8; ++ii) acc[ii] = 0.f;
                for (int d = 0; d < 128; ++d) {
                    const float kv = Ks[j * 129 + d];
#pragma unroll
                    for (int ii = 0; ii < 8; ++ii) acc[ii] += Qs[(i0 + ii) * 129 + d] * kv;
                }
#pragma unroll
                for (int ii = 0; ii < 8; ++ii) { const int i = i0 + ii; At[i * 65 + j] = acc[ii] * expf(lg * fabsf((float)(i - j))); }
            }
            __syncthreads();
            {
                const int v = tid & 15, i0 = tid >> 4;
#pragma unroll
                for (int rep = 0; rep < 2; ++rep) {
                    const int i = i0 + 32 * rep;
                    float a = 0.f; for (int j = 0; j < 64; ++j) a += At[i * 65 + j] * Vs[j * 16 + v];
                    float c2 = 0.f; for (int d = 0; d < 128; ++d) c2 += Qs[i * 129 + d] * Ss[d * 16 + v];
                    p.obuf[(size_t)(tok0 + i) * DM + h * 256 + vs * 16 + v] = a + c2 * expf(lg * (float)(i + 1));
                }
            }
            __syncthreads();
            {
                const int v = tid & 15, d0 = tid >> 4;
#pragma unroll
                for (int rep = 0; rep < 4; ++rep) {
                    const int d = d0 + 32 * rep;
                    float a = 0.f; for (int j = 0; j < 64; ++j) a += Ks[j * 129 + d] * kd[j] * Vs[j * 16 + v];
                    Ss[d * 16 + v] = Ss[d * 16 + v] * cdec + a;
                }
            }
        }
    }
    __syncthreads();
}


__device__ __forceinline__ void ph_retprep(const Params& p, int bid, int nb, float* lds) {
    bf16_t* Kl = (bf16_t*)lds;
    bf16_t* Vl = Kl + 64 * 130;
    char* Qm = (char*)lds + 49664;
    char* Km = Qm + 16384;
    const int tid = tid_(), wave = tid >> 6, lane = tid & 63, fr = lane & 15, fq = lane >> 4;
    for (int it = bid; it < 1024; it += nb) {
        const int n = it & 63, h = (it >> 6) & 7, b = it >> 9;
        const int tok0 = b * SQ + n * 64;
        const size_t rowbase = (size_t)(b * 8 + h) * SQ + n * 64;
        const float lg = log1pf(-exp2f(-5.0f - (float)h));
        __syncthreads();
#pragma unroll
        for (int k = 0; k < 2; ++k) {
            const int u = tid + 512 * k, i = u >> 4, dd = (u & 15) * 4; const size_t tok = (size_t)(tok0 + i);
            const float4 r0 = *(const float4*)(p.rope + (tok * 64 + dd) * 2), r1 = *(const float4*)(p.rope + (tok * 64 + dd) * 2 + 4);
            const float cs[4] = {r0.x, r0.z, r1.x, r1.z}, sn[4] = {r0.y, r0.w, r1.y, r1.w};
            const bf16_t* zr = p.ZG + tok * ZW;
            const uint2 q1w = *(const uint2*)(zr + 2048 + h * 128 + dd), q2w = *(const uint2*)(zr + 2048 + h * 128 + 64 + dd);
            const uint2 k1w = *(const uint2*)(zr + 3072 + h * 128 + dd), k2w = *(const uint2*)(zr + 3072 + h * 128 + 64 + dd);
            const float q1[4] = {bflo(q1w.x), bfhi(q1w.x), bflo(q1w.y), bfhi(q1w.y)}, q2[4] = {bflo(q2w.x), bfhi(q2w.x), bflo(q2w.y), bfhi(q2w.y)};
            const float k1[4] = {bflo(k1w.x), bfhi(k1w.x), bflo(k1w.y), bfhi(k1w.y)}, k2[4] = {bflo(k2w.x), bfhi(k2w.x), bflo(k2w.y), bfhi(k2w.y)};
            const float sc = 0.08838834764831845f, kd = expf(lg * (float)(63 - i));
            float qa[4], qb[4], ka[4], kb[4];
#pragma unroll
            for (int e = 0; e < 4; ++e) { qa[e] = q1[e] * cs[e] - q2[e] * sn[e]; qb[e] = q1[e] * sn[e] + q2[e] * cs[e]; ka[e] = (k1[e] * cs[e] - k2[e] * sn[e]) * sc; kb[e] = (k1[e] * sn[e] + k2[e] * cs[e]) * sc; }
            const uint2 qaw = make_uint2(pk2(qa[0], qa[1]), pk2(qa[2], qa[3])), qbw = make_uint2(pk2(qb[0], qb[1]), pk2(qb[2], qb[3]));
            const uint2 kaw = make_uint2(pk2(ka[0], ka[1]), pk2(ka[2], ka[3])), kbw = make_uint2(pk2(kb[0], kb[1]), pk2(kb[2], kb[3]));
            *(uint2*)(p.Qr + (rowbase + i) * 128 + dd) = qaw; *(uint2*)(p.Qr + (rowbase + i) * 128 + 64 + dd) = qbw;
            const int c = dd >> 3, o8 = (dd & 7) * 2;
            *(uint2*)(Qm + i * 256 + ((c ^ (i & 15)) << 4) + o8) = qaw; *(uint2*)(Qm + i * 256 + (((c + 8) ^ (i & 15)) << 4) + o8) = qbw;
            *(uint2*)(Km + i * 256 + ((c ^ (i & 15)) << 4) + o8) = kaw; *(uint2*)(Km + i * 256 + (((c + 8) ^ (i & 15)) << 4) + o8) = kbw;
            *(unsigned*)(Kl + i * 130 + dd) = pk2(ka[0] * kd, ka[1] * kd); *(unsigned*)(Kl + i * 130 + dd + 2) = pk2(ka[2] * kd, ka[3] * kd);
            *(unsigned*)(Kl + i * 130 + 64 + dd) = pk2(kb[0] * kd, kb[1] * kd); *(unsigned*)(Kl + i * 130 + 64 + dd + 2) = pk2(kb[2] * kd, kb[3] * kd);
        }
#pragma unroll
        for (int k = 0; k < 4; ++k) {
            const int u = tid + 512 * k, j = u >> 5, c = u & 31;
            const uint4 w = *(const uint4*)(p.ZG + (size_t)(tok0 + j) * ZW + 4096 + h * 256 + c * 8);
            unsigned* d = (unsigned*)(Vl + j * 258 + c * 8); d[0] = w.x; d[1] = w.y; d[2] = w.z; d[3] = w.w;
        }
        __syncthreads();
        {
            const int jt = wave >> 1, it0 = 2 * (wave & 1);
            f32x4_t s0 = {0.f, 0.f, 0.f, 0.f}, s1 = {0.f, 0.f, 0.f, 0.f};
#pragma unroll
            for (int ks = 0; ks < 4; ++ks) {
                const bf16x8_t a = ldfrag(Km, jt * 16 + fr, ks * 4 + fq, 256, 15);
                const bf16x8_t b0 = ldfrag(Qm, it0 * 16 + fr, ks * 4 + fq, 256, 15), b1 = ldfrag(Qm, (it0 + 1) * 16 + fr, ks * 4 + fq, 256, 15);
                s0 = __builtin_amdgcn_mfma_f32_16x16x32_bf16(a, b0, s0, 0, 0, 0);
                s1 = __builtin_amdgcn_mfma_f32_16x16x32_bf16(a, b1, s1, 0, 0, 0);
            }
            const int j0 = jt * 16 + fq * 4;
            bf16_t* pg = p.Pm + (size_t)it * 4096;
#pragma unroll
            for (int tt = 0; tt < 2; ++tt) {
                const int i = (it0 + tt) * 16 + fr; const f32x4_t sv4 = tt ? s1 : s0; float pv[4];
#pragma unroll
                for (int r = 0; r < 4; ++r) pv[r] = sv4[r] * __expf(lg * fabsf((float)(i - (j0 + r))));
                *(uint2*)(pg + i * 64 + j0) = make_uint2(pk2(pv[0], pv[1]), pk2(pv[2], pv[3]));
            }
        }
        bf16_t* kt = p.KTd + (size_t)it * 8192;
#pragma unroll
        for (int k = 0; k < 2; ++k) {
            const int u = tid + 512 * k, jg = u & 7, d = u >> 3;
            unsigned w[4];
#pragma unroll
            for (int q = 0; q < 4; ++q) w[q] = (unsigned)Kl[(jg * 8 + 2 * q) * 130 + d] | ((unsigned)Kl[(jg * 8 + 2 * q + 1) * 130 + d] << 16);
            *(uint4*)(kt + d * 64 + jg * 8) = make_uint4(w[0], w[1], w[2], w[3]);
        }
        bf16_t* vt = p.Vt + (size_t)it * 16384;
#pragma unroll
        for (int k = 0; k < 4; ++k) {
            const int u = tid + 512 * k, jg = u & 7, v = u >> 3;
            unsigned w[4];
#pragma unroll
            for (int q = 0; q < 4; ++q) w[q] = (unsigned)Vl[(jg * 8 + 2 * q) * 258 + v] | ((unsigned)Vl[(jg * 8 + 2 * q + 1) * 258 + v] << 16);
            *(uint4*)(vt + v * 64 + jg * 8) = make_uint4(w[0], w[1], w[2], w[3]);
        }
    }
    __syncthreads();
}

__device__ __forceinline__ void ph_ret2(const Params& p, int bid, int nb, float* lds) {
    char* L = (char*)lds;
    constexpr int OQ = 0, OKT = 16384, OPP = 32768, OVT = 40960, TILE = 43008, OST = 2 * TILE;
    const int tid = tid_(), wave = tid >> 6, lane = tid & 63, fr = lane & 15, fq = lane >> 4;
    for (int it = bid; it < 256; it += nb) {
        const int itm = ((it & 7) * 2 + (it >> 7)) * 16 + ((it >> 3) & 15);
        const int vs = itm & 15, h = (itm >> 4) & 7, b = itm >> 7;
        const float lg = log1pf(-exp2f(-5.0f - (float)h));
        const float cdec = expf(lg * 64.0f);
        const size_t bh = (size_t)(b * 8 + h);
        const char* gQ = (const char*)(p.Qr + bh * SQ * 128);
        const char* gKT = (const char*)(p.KTd + bh * 64 * 8192);
        const char* gP = (const char*)(p.Pm + bh * 64 * 4096);
        const char* gVt = (const char*)(p.Vt + bh * 64 * 16384) + vs * 16 * 128;
        int lq[2], lkt[2];
#pragma unroll
        for (int u = 0; u < 2; ++u) { const int ci = tid + 512 * u; const int r = ci >> 4, c = ci & 15; lq[u] = r * 256 + ((c ^ (r & 15)) << 4); const int d = ci >> 3, c8 = ci & 7; lkt[u] = d * 128 + ((c8 ^ (d & 7)) << 4); }
        const int lp = (tid >> 3) * 128 + (((tid & 7) ^ ((tid >> 3) & 7)) << 4);
        const int lv = lp;
        uint4 qA0, qA1, tA0, tA1, pA, vA = make_uint4(0u, 0u, 0u, 0u), qB0, qB1, tB0, tB1, pB, vB = make_uint4(0u, 0u, 0u, 0u);
#define RET_LOAD(X_, n_) do { const size_t o0 = (size_t)(n_) * 16384 + (size_t)tid * 16, o1 = o0 + 8192; \
        q##X_##0 = *(const uint4*)(gQ + o0); q##X_##1 = *(const uint4*)(gQ + o1); t##X_##0 = *(const uint4*)(gKT + o0); t##X_##1 = *(const uint4*)(gKT + o1); p##X_ = *(const uint4*)(gP + (size_t)(n_) * 8192 + tid * 16); \
        if (tid < 128) v##X_ = *(const uint4*)(gVt + (size_t)(n_) * 32768 + tid * 16); } while (0)
#define RET_WRITE(X_, buf_) do { char* B_ = L + (buf_) * TILE; \
        *(uint4*)(B_ + OQ + lq[0]) = q##X_##0; *(uint4*)(B_ + OQ + lq[1]) = q##X_##1; *(uint4*)(B_ + OKT + lkt[0]) = t##X_##0; *(uint4*)(B_ + OKT + lkt[1]) = t##X_##1; *(uint4*)(B_ + OPP + lp) = p##X_; \
        if (tid < 128) *(uint4*)(B_ + OVT + lv) = v##X_; } while (0)
        __syncthreads();
        for (int i = tid; i < 1024; i += NTH) ((unsigned*)(L + OST))[i] = 0u;
        RET_LOAD(A, 0); RET_WRITE(A, 0); RET_LOAD(B, 1);
        f32x4_t sacc[2] = {{0.f, 0.f, 0.f, 0.f}, {0.f, 0.f, 0.f, 0.f}};
#define RET_STEP(n_, cur_, LS_, WS_) do { const int n = (n_); constexpr int cur = (cur_); \
            __syncthreads();                                     \
            if (n + 2 < 64) RET_LOAD(LS_, n + 2); \
            const char* T = L + cur * TILE; \
            if (wave < 4) {     \
                const int itl = wave; \
                f32x4_t o1 = {0.f, 0.f, 0.f, 0.f}, o2 = {0.f, 0.f, 0.f, 0.f}; \
                _Pragma("unroll") for (int ks = 0; ks < 2; ++ks) o1 = __builtin_amdgcn_mfma_f32_16x16x32_bf16(ldfrag(T + OPP, itl * 16 + fr, ks * 4 + fq, 128, 7), ldfrag(T + OVT, fr, ks * 4 + fq, 128, 7), o1, 0, 0, 0); \
                _Pragma("unroll") for (int ks = 0; ks < 4; ++ks) o2 = __builtin_amdgcn_mfma_f32_16x16x32_bf16(ldfrag(T + OQ, itl * 16 + fr, ks * 4 + fq, 256, 15), ldfrag(L + OST + cur * 4096, fr, ks * 4 + fq, 256, 15), o2, 0, 0, 0); \
                _Pragma("unroll") for (int r = 0; r < 4; ++r) { const int i = itl * 16 + fq * 4 + r; \
                    p.ob16[(size_t)(b * SQ + n * 64 + i) * DM + h * 256 + vs * 16 + fr] = (bf16_t)f2bf(o1[r] + __expf(lg * (float)(i + 1)) * o2[r]); } \
            } else {            \
                _Pragma("unroll") for (int u = 0; u < 2; ++u) { \
                    const int dt = 2 * (wave - 4) + u; \
                    sacc[u] = sacc[u] * cdec; \
                    _Pragma("unroll") for (int ks = 0; ks < 2; ++ks) sacc[u] = __builtin_amdgcn_mfma_f32_16x16x32_bf16(ldfrag(T + OKT, dt * 16 + fr, ks * 4 + fq, 128, 7), ldfrag(T + OVT, fr, ks * 4 + fq, 128, 7), sacc[u], 0, 0, 0); \
                    *(uint2*)(L + OST + (cur ^ 1) * 4096 + fr * 256 + (((dt * 2 + (fq >> 1)) ^ fr) << 4) + (fq & 1) * 8) = make_uint2(pk2(sacc[u][0], sacc[u][1]), pk2(sacc[u][2], sacc[u][3])); } \
            } \
            if (n + 1 < 64) RET_WRITE(WS_, cur ^ 1); } while (0)
#pragma unroll 1
        for (int n2 = 0; n2 < 64; n2 += 2) { RET_STEP(n2, 0, A, B); RET_STEP(n2 + 1, 1, B, A); }
#undef RET_STEP
#undef RET_LOAD
#undef RET_WRITE
    }
    __syncthreads();
}

__device__ __forceinline__ void gn_load(const Params& p, int tok, int lane, uint2 (&ow)[8], uint2 (&gw)[8]) {
#pragma unroll
    for (int h = 0; h < 8; ++h) { ow[h] = *(const uint2*)(p.ob16 + (size_t)tok * DM + h * 256 + lane * 4); gw[h] = *(const uint2*)(p.ZG + (size_t)tok * ZW + 6144 + h * 256 + lane * 4); }
}
__device__ __forceinline__ void ph_gn(const Params& p, int bid, int nb, float* lds) {
    const int tid = tid_(), wave = tid >> 6, lane = tid & 63;
    const int stride = nb * 8;
    int tok = bid * 8 + wave;
    uint2 ow[8], gw[8], own[8], gwn[8];
    if (tok < NTOK) gn_load(p, tok, lane, ow, gw);
    for (; tok < NTOK; tok += stride) {
        if (tok + stride < NTOK) gn_load(p, tok + stride, lane, own, gwn);
        float4 o[8]; float s1[8], s2[8];
#pragma unroll
        for (int h = 0; h < 8; ++h) { o[h] = make_float4(bflo(ow[h].x), bfhi(ow[h].x), bflo(ow[h].y), bfhi(ow[h].y)); s1[h] = (o[h].x + o[h].y) + (o[h].z + o[h].w); }
#pragma unroll
        for (int h = 0; h < 8; ++h) s1[h] = row_sum16(s1[h]);
#pragma unroll
        for (int h = 0; h < 8; ++h) s1[h] = xsum32(xsum16(s1[h]));
#pragma unroll
        for (int h = 0; h < 8; ++h) { const float mu = s1[h] * (1.0f / 256.0f); o[h].x -= mu; o[h].y -= mu; o[h].z -= mu; o[h].w -= mu; s2[h] = dot4(o[h], o[h]); }
#pragma unroll
        for (int h = 0; h < 8; ++h) s2[h] = row_sum16(s2[h]);
#pragma unroll
        for (int h = 0; h < 8; ++h) s2[h] = xsum32(xsum16(s2[h]));
#pragma unroll
        for (int h = 0; h < 8; ++h) {
            const float rs = 1.0f / sqrtf(s2[h] * (1.0f / 256.0f) + 1e-6f);
            const float4 gn = *(const float4*)(p.ret_gn_g + h * 256 + lane * 4);
            const float g0 = bflo(gw[h].x), g1 = bfhi(gw[h].x), g2 = bflo(gw[h].y), g3 = bfhi(gw[h].y);
            st_wt8(p.ybin + (size_t)tok * DM + h * 256 + lane * 4,
                make_uint2(pk2(siluf_(g0) * o[h].x * rs * gn.x, siluf_(g1) * o[h].y * rs * gn.y), pk2(siluf_(g2) * o[h].z * rs * gn.z, siluf_(g3) * o[h].w * rs * gn.w)));
        }
#pragma unroll
        for (int h = 0; h < 8; ++h) { ow[h] = own[h]; gw[h] = gwn[h]; }
    }
}

__device__ __forceinline__ void split8(const float4 a, const float4 b, uint4& hi, uint4& lo) {
    const float x[8] = {a.x, a.y, a.z, a.w, b.x, b.y, b.z, b.w}; unsigned h[8], l[8];
#pragma unroll
    for (int i = 0; i < 8; ++i) { h[i] = f2bf(x[i]); l[i] = f2bf(x[i] - __uint_as_float(h[i] << 16)); }
    hi = make_uint4(h[0] | (h[1] << 16), h[2] | (h[3] << 16), h[4] | (h[5] << 16), h[6] | (h[7] << 16));
    lo = make_uint4(l[0] | (l[1] << 16), l[2] | (l[3] << 16), l[4] | (l[5] << 16), l[6] | (l[7] << 16));
}
__device__ __forceinline__ bf16x8_t as_bf16x8(const uint4 v) { return __builtin_bit_cast(bf16x8_t, v); }
struct PairTab { int a[52], b[52]; };
__host__ __device__ constexpr PairTab make_pairs() {
    PairTab t{}; int n = 0;
    for (int a = 0; a < 16; ++a) for (int b = 0; b < 16; ++b) if ((a + 1) * (b + 1) <= 16) { t.a[n] = a; t.b[n] = b; ++n; }
    for (; n < 52; ++n) { t.a[n] = -1; t.b[n] = -1; }
    return t;
}
constexpr PairTab PAIRS = make_pairs();
static_assert(PAIRS.a[49] >= 0 && PAIRS.a[50] < 0, "50 candidate pairs");

template <int N, int OFF> __device__ __forceinline__ void bitonic_sort_desc(float* v) {
#pragma unroll
    for (int k = 2; k <= N; k <<= 1)
#pragma unroll
        for (int j = k >> 1; j > 0; j >>= 1)
#pragma unroll
            for (int i = 0; i < N; ++i) { const int l = i ^ j; if (l > i) { const bool up = ((i & k) == 0);
                const float a = v[OFF + i], b = v[OFF + l]; const float mx = fmaxf(a, b), mn = fminf(a, b); v[OFF + i] = up ? mx : mn; v[OFF + l] = up ? mn : mx; } }
}
template <int N> __device__ __forceinline__ void bitonic_merge_desc(float* v) {
#pragma unroll
    for (int j = N >> 1; j > 0; j >>= 1)
#pragma unroll
        for (int i = 0; i < N; ++i) { const int l = i ^ j; if (l > i) { const float a = v[i], b = v[l]; v[i] = fmaxf(a, b); v[l] = fminf(a, b); } }
}
__device__ __forceinline__ void ph_topk2(const Params& p, const float* qb, int bid, int nb, float* lds, int it_fixed) {
    const int tid = tid_(), wave = tid >> 6, lane = tid & 63;
    uint4* SK = (uint4*)lds;
    const float NEG = -INFINITY;
    const bool tc_on = (nb == 256); const int tcr0 = (bid * 8 + wave) * 16; float4 tct[8];
    if (tc_on) tc_load(p, tcr0, lane, tct);
    for (int it = (it_fixed >= 0 ? it_fixed : bid); it < 256; it += (it_fixed >= 0 ? 256 : nb)) {
        const int h = it & 7, tg = it >> 3;
        __syncthreads();
        for (int gi = tid; gi < 4096; gi += NTH) {
            const int dq = gi & 15, n = (gi >> 4) & 127, pp = gi >> 11;
            const float4* src = (const float4*)(p.peer_sk + ((size_t)(h * 2 + pp) * 128 + n) * 128 + dq * 8);
            uint4 hi, lo; split8(src[0], src[1], hi, lo);
            const int base = (((pp * 8 + (n >> 4)) * 4 + (dq >> 2)) * 2) * 64 + (dq & 3) * 16 + (n & 15);
            SK[base] = hi; SK[base + 64] = lo;
        }
        __syncthreads();
#pragma unroll 1
        for (int tile = 0; tile < 2; ++tile) {
            const int tok = tg * 256 + wave * 32 + tile * 16 + (lane & 15);
            const int qd = lane >> 4;
            float v12[2][16];
#pragma unroll
            for (int pp = 0; pp < 2; ++pp) {
                if (tc_on) { const int ti = tile * 8 + pp * 4; tc_finish(p, tcr0 + ti, lane, tct); tc_load(p, tcr0 + ti + 1, lane, tct); }
                bf16x8_t Bh[4], Bl[4];
                const float* qp = qb + (size_t)tok * DM + h * 256 + pp * 128 + 8 * qd;
#pragma unroll
                for (int ks = 0; ks < 4; ++ks) { uint4 hi, lo; split8(*(const float4*)(qp + ks * 32), *(const float4*)(qp + ks * 32 + 4), hi, lo); Bh[ks] = as_bf16x8(hi); Bl[ks] = as_bf16x8(lo); }
                float v[32];
#pragma unroll
                for (int kt = 0; kt < 8; ++kt) {
                    f32x4_t acc = {0.f, 0.f, 0.f, 0.f};
#pragma unroll
                    for (int ks = 0; ks < 4; ++ks) {
                        const bf16x8_t Ah = as_bf16x8(SK[(((pp * 8 + kt) * 4 + ks) * 2) * 64 + lane]), Al = as_bf16x8(SK[(((pp * 8 + kt) * 4 + ks) * 2 + 1) * 64 + lane]);
                        acc = __builtin_amdgcn_mfma_f32_16x16x32_bf16(Ah, Bh[ks], acc, 0, 0, 0);
                        acc = __builtin_amdgcn_mfma_f32_16x16x32_bf16(Ah, Bl[ks], acc, 0, 0, 0);
                        acc = __builtin_amdgcn_mfma_f32_16x16x32_bf16(Al, Bh[ks], acc, 0, 0, 0);
                    }
#pragma unroll
                    for (int r = 0; r < 4; ++r) v[kt * 4 + r] = __uint_as_float((__float_as_uint(acc[r]) & ~127u) | (unsigned)(kt * 16 + qd * 4 + r));
                    __builtin_amdgcn_sched_barrier(0);
                }
                if (tc_on) { const int ti = tile * 8 + pp * 4 + 1; tc_finish(p, tcr0 + ti, lane, tct); tc_load(p, tcr0 + ti + 1, lane, tct); }
                bitonic_sort_desc<16, 0>(v); bitonic_sort_desc<16, 16>(v);
                float c16[16];
#pragma unroll
                for (int i = 0; i < 16; ++i) c16[i] = fmaxf(v[i], v[31 - i]);
                bitonic_merge_desc<16>(c16);
                if (tc_on) { const int ti = tile * 8 + pp * 4 + 2; tc_finish(p, tcr0 + ti, lane, tct); tc_load(p, tcr0 + ti + 1, lane, tct); }
#pragma unroll
                for (int st = 0; st < 2; ++st) {
                    float pr[16];
#pragma unroll
                    for (int i = 0; i < 16; ++i) pr[i] = __shfl_xor(c16[i], 16 << st);
#pragma unroll
                    for (int i = 0; i < 16; ++i) c16[i] = fmaxf(c16[i], pr[15 - i]);
                    bitonic_merge_desc<16>(c16);
                }
                if (tc_on) { const int ti = tile * 8 + pp * 4 + 3; tc_finish(p, tcr0 + ti, lane, tct); if (ti < 15) tc_load(p, tcr0 + ti + 1, lane, tct); }
#pragma unroll
                for (int i = 0; i < 16; ++i) v12[pp][i] = c16[i];
            }
            float c[13]; unsigned pay[13];
#pragma unroll
            for (int s = 0; s < 13; ++s) {
                float cq[4]; unsigned pq[4];
#pragma unroll
                for (int q = 0; q < 4; ++q) {
                    const int pi = 4 * s + q; const int a = PAIRS.a[pi], b = PAIRS.b[pi];
                    if (a >= 0) {
                        const float sum = v12[0][a] + v12[1][b];
                        cq[q] = __uint_as_float((__float_as_uint(sum) & ~63u) | (unsigned)pi);
                        pq[q] = (__float_as_uint(v12[0][a]) & 127u) * 128u + (__float_as_uint(v12[1][b]) & 127u);
                    } else { cq[q] = NEG; pq[q] = 0u; }
                }
                c[s] = qd == 0 ? cq[0] : qd == 1 ? cq[1] : qd == 2 ? cq[2] : cq[3];
                pay[s] = qd == 0 ? pq[0] : qd == 1 ? pq[1] : qd == 2 ? pq[2] : pq[3];
            }
            float top[16]; unsigned eid[16];
#pragma unroll
            for (int r = 0; r < 16; ++r) {
                float m = c[0];
#pragma unroll
                for (int s = 1; s < 13; ++s) m = fmaxf(m, c[s]);
                m = fmaxf(m, __shfl_xor(m, 16)); m = fmaxf(m, __shfl_xor(m, 32));
                unsigned pw = 0u;
#pragma unroll
                for (int s = 0; s < 13; ++s) { const bool eq = (c[s] == m); pw |= eq ? pay[s] : 0u; c[s] = eq ? NEG : c[s]; }
                pw |= (unsigned)__shfl_xor((int)pw, 16); pw |= (unsigned)__shfl_xor((int)pw, 32);
                top[r] = m; eid[r] = pw;
            }
            float sum = 0.f; const float mx = top[0];
#pragma unroll
            for (int r = 0; r < 16; ++r) { top[r] = expf(top[r] - mx); sum += top[r]; }
            const float inv = 1.0f / sum;
            if (lane < 16) {
                int4* ep = (int4*)(p.eidx + (size_t)tok * 128 + h * 16); float4* gp = (float4*)(p.gatev + (size_t)tok * 128 + h * 16);
#pragma unroll
                for (int q = 0; q < 4; ++q) {
                    ep[q] = make_int4((int)eid[4 * q], (int)eid[4 * q + 1], (int)eid[4 * q + 2], (int)eid[4 * q + 3]);
                    gp[q] = make_float4(top[4 * q] * inv, top[4 * q + 1] * inv, top[4 * q + 2] * inv, top[4 * q + 3] * inv);
                }
            }
        }
    }
    __syncthreads();
}

__device__ __forceinline__ void peer_load4(const unsigned char* tab, const int (&e)[4], int lane, uint2 (&R)[4][3]) {
#pragma unroll
    for (int i = 0; i < 4; ++i) { const uint2* r = (const uint2*)(tab + (size_t)e[i] * ROW6 + lane * 8); R[i][0] = r[0]; R[i][1] = r[64]; R[i][2] = r[128]; }
}
__device__ __forceinline__ f32x32_t dec6(const uint2 (&R)[3]) { const u32x6_t w = {R[0].x, R[0].y, R[1].x, R[1].y, R[2].x, R[2].y}; return __builtin_amdgcn_cvt_scalef32_pk32_f32_fp6(w, 1.0f); }
typedef float f32x2_t __attribute__((ext_vector_type(2)));
__device__ __forceinline__ bf16x8_t dec4_frag(unsigned w) {
    const unsigned a = __builtin_bit_cast(unsigned, __builtin_amdgcn_cvt_scalef32_pk_bf16_fp4(w, 1.0f, 0)), b = __builtin_bit_cast(unsigned, __builtin_amdgcn_cvt_scalef32_pk_bf16_fp4(w, 1.0f, 1));
    const unsigned c = __builtin_bit_cast(unsigned, __builtin_amdgcn_cvt_scalef32_pk_bf16_fp4(w, 1.0f, 2)), d = __builtin_bit_cast(unsigned, __builtin_amdgcn_cvt_scalef32_pk_bf16_fp4(w, 1.0f, 3));
    return as_bf16x8(make_uint4(a, b, c, d));
}
__device__ __forceinline__ void peer_vgroup(const Params& p, int lane, const uint4 (&Vc)[4], const float (&wgt)[4], f32x2_t (&y2)[16]) {
#pragma unroll
    for (int i = 0; i < 4; ++i) {
        const f32x2_t w2 = {wgt[i], wgt[i]};
        const unsigned vw[4] = {Vc[i].x, Vc[i].y, Vc[i].z, Vc[i].w};
#pragma unroll
        for (int j = 0; j < 4; ++j) {
            y2[4 * j + 0] += w2 * __builtin_amdgcn_cvt_scalef32_pk_f32_fp4(vw[j], 1.0f, 0);
            y2[4 * j + 1] += w2 * __builtin_amdgcn_cvt_scalef32_pk_f32_fp4(vw[j], 1.0f, 1);
            y2[4 * j + 2] += w2 * __builtin_amdgcn_cvt_scalef32_pk_f32_fp4(vw[j], 1.0f, 2);
            y2[4 * j + 3] += w2 * __builtin_amdgcn_cvt_scalef32_pk_f32_fp4(vw[j], 1.0f, 3);
        }
    }
}
__device__ __forceinline__ void ph_peer6(const Params& p, const float* x1, const bf16_t* h2, int bid, int nb, float* lds) {
    const int tid = tid_(), wave = tid >> 6, lane0 = tid & 63;
    for (int t = bid * 8 + wave; t < NTOK; t += nb * 8) {
        int lane = lane0; asm volatile("" : "+v"(lane));
        const int fr = lane & 15, kq = lane >> 4;
        char* HL = (char*)lds + wave * 4608;
        float* WL = (float*)(HL + 4096);
        const int b = t / SQ;
#pragma unroll
        for (int q = 0; q < 4; ++q) *(uint4*)(HL + (lane + 64 * q) * 16) = *(const uint4*)(h2 + (size_t)t * DM + (lane + 64 * q) * 8);
        const int e0 = p.eidx[(size_t)t * 128 + lane], e1 = p.eidx[(size_t)t * 128 + 64 + lane];
        const float su0 = p.su[e0], su1 = p.su[e1];
        const float gv0 = p.gatev[(size_t)t * 128 + lane] * p.sv[e0], gv1 = p.gatev[(size_t)t * 128 + 64 + lane] * p.sv[e1];
        unsigned ur[8];
#pragma unroll
        for (int G = 0; G < 8; ++G) ur[G] = (unsigned)__shfl(G < 4 ? e0 : e1, 16 * (G & 3) + fr) * (unsigned)ROW4 + (unsigned)kq * 16u;
        f32x4_t acc[8];
#pragma unroll
        for (int G = 0; G < 8; ++G) acc[G] = (f32x4_t){0.f, 0.f, 0.f, 0.f};
        uint4 Ac[8];
#pragma unroll
        for (int G = 0; G < 8; ++G) Ac[G] = *(const uint4*)(p.U8 + ur[G]);
#pragma unroll 1
        for (int blk = 0; blk < 16; ++blk) {
            const unsigned nof = (unsigned)((blk < 15) ? blk + 1 : blk) * 64u;
            bf16x8_t B[4];
#pragma unroll
            for (int sidx = 0; sidx < 4; ++sidx) B[sidx] = *(const bf16x8_t*)(HL + (blk * 128 + sidx * 32 + kq * 8) * 2);
#pragma unroll
            for (int G = 0; G < 8; ++G) {
                const bf16x8_t f0 = dec4_frag(Ac[G].x), f1 = dec4_frag(Ac[G].y), f2 = dec4_frag(Ac[G].z), f3 = dec4_frag(Ac[G].w);
                Ac[G] = *(const uint4*)(p.U8 + (ur[G] + nof));
                acc[G] = __builtin_amdgcn_mfma_f32_16x16x32_bf16(f0, B[0], acc[G], 0, 0, 0);
                acc[G] = __builtin_amdgcn_mfma_f32_16x16x32_bf16(f1, B[1], acc[G], 0, 0, 0);
                acc[G] = __builtin_amdgcn_mfma_f32_16x16x32_bf16(f2, B[2], acc[G], 0, 0, 0);
                acc[G] = __builtin_amdgcn_mfma_f32_16x16x32_bf16(f3, B[3], acc[G], 0, 0, 0);
                __builtin_amdgcn_sched_barrier(0);
            }
        }
        const int kq4 = 4 * kq;
#pragma unroll
        for (int G = 0; G < 8; ++G) {
            float av[4];
#pragma unroll
            for (int j = 0; j < 4; ++j) av[j] = acc[G][j] * __shfl(G < 4 ? su0 : su1, (16 * (G & 3) + j) + kq4);
            const f32x2_t g01 = pg8::gelu_pk((f32x2_t){av[0], av[1]}), g23 = pg8::gelu_pk((f32x2_t){av[2], av[3]});
            const float w0 = g01.x * __shfl(G < 4 ? gv0 : gv1, (16 * (G & 3) + 0) + kq4), w1 = g01.y * __shfl(G < 4 ? gv0 : gv1, (16 * (G & 3) + 1) + kq4);
            const float w2_ = g23.x * __shfl(G < 4 ? gv0 : gv1, (16 * (G & 3) + 2) + kq4), w3 = g23.y * __shfl(G < 4 ? gv0 : gv1, (16 * (G & 3) + 3) + kq4);
            if (fr == 0) *(float4*)(WL + 16 * G + kq4) = make_float4(w0, w1, w2_, w3);
            __builtin_amdgcn_sched_barrier(0);
        }
        f32x2_t y2[16];
#pragma unroll
        for (int i = 0; i < 16; ++i) y2[i] = (f32x2_t){0.f, 0.f};
        uint4 Vc[4], Vn[4];
#pragma unroll
        for (int i = 0; i < 4; ++i) Vc[i] = *(const uint4*)(p.V8 + ((unsigned)__builtin_amdgcn_readlane(e0, i) * (unsigned)ROW4 + (unsigned)lane * 16u));
#pragma unroll
        for (int G = 0; G < 8; ++G) {
#pragma unroll 1
            for (int q = 0; q < 4; ++q) {
                {
                    const int gn = 4 * G + q + ((G == 7 && q == 3) ? 0 : 1); const int sn = 4 * gn;
                    const int en = (sn < 64) ? e0 : e1;
#pragma unroll
                    for (int i = 0; i < 4; ++i) Vn[i] = *(const uint4*)(p.V8 + ((unsigned)__builtin_amdgcn_readlane(en, (sn + i) & 63) * (unsigned)ROW4 + (unsigned)lane * 16u));
                }
                const float4 w4 = *(const float4*)(WL + 16 * G + 4 * q);
                const float wgt[4] = {w4.x, w4.y, w4.z, w4.w};
                peer_vgroup(p, lane, Vc, wgt, y2);
#pragma unroll
                for (int i = 0; i < 4; ++i) Vc[i] = Vn[i];
            }
        }
        float y[32];
#pragma unroll
        for (int k = 0; k < 16; ++k) { y[2 * k] = y2[k].x; y[2 * k + 1] = y2[k].y; }
        float ss = 0.f;
#pragma unroll
        for (int q = 0; q < 8; ++q) {
            const int c = 256 * q + lane * 4;
            const float4 xv = *(const float4*)(x1 + (size_t)t * DM + c);
            const float4 ga = *(const float4*)(p.ada + b * NMOD + 5 * DM + c);
            float* yy = y + 4 * q;
            yy[0] = xv.x + ga.x * yy[0]; yy[1] = xv.y + ga.y * yy[1]; yy[2] = xv.z + ga.z * yy[2]; yy[3] = xv.w + ga.w * yy[3];
            ss += yy[0] * yy[0] + yy[1] * yy[1] + yy[2] * yy[2] + yy[3] * yy[3];
        }
        ss = xsum32(xsum16(row_sum16(ss)));
        const float rs = 1.0f / sqrtf(ss * (1.0f / DM) + 1e-6f);
#pragma unroll
        for (int q = 0; q < 8; ++q) {
            const int c = 256 * q + lane * 4;
            const float4 gf = *(const float4*)(p.norm_f_g + c);
            const float* yy = y + 4 * q;
            *(float4*)(p.out + (size_t)t * DM + c) = make_float4(yy[0] * rs * gf.x, yy[1] * rs * gf.y, yy[2] * rs * gf.z, yy[3] * rs * gf.w);
        }
    }
}

#define LAS __attribute__((address_space(3)))
#define XB_TMO      128
#define XB_XCNT(j)  (256  + 64 * (j))
#define XB_XSUB(j)  (1280 + 64 * (j))
#define XB_XGEN(j)  (2304 + 64 * (j))
#define XB_TOP      3328
#define XB_TOPGEN   3392
#define XCD_BAR_WORDS 3456
#define XB_SPIN_CAP (1u << 18)

__device__ __forceinline__ unsigned xb_ld(unsigned* p)              { return __hip_atomic_load(p, __ATOMIC_RELAXED, __HIP_MEMORY_SCOPE_AGENT); }
__device__ __forceinline__ unsigned xb_add(unsigned* p, unsigned v) { return __hip_atomic_fetch_add(p, v, __ATOMIC_RELAXED, __HIP_MEMORY_SCOPE_AGENT); }
__device__ __forceinline__ unsigned xb_xcc_id() { return (unsigned)__builtin_amdgcn_s_getreg((3 << 11) | 20) & 0xFu; }
#define XB_SPIN(cond, bar) do { unsigned _sp = 0; while (cond) { __builtin_amdgcn_s_sleep(1); \
    if ((++_sp & 255u) == 0u) { if (xb_ld(&(bar)[XB_TMO])) break; if (_sp > XB_SPIN_CAP) { atomicAdd(&(bar)[XB_TMO], 1u); break; } } } } while (0)

struct XcdBarrier {
    unsigned* bar; unsigned x;
    volatile LAS unsigned* st;
};

__device__ __forceinline__ XcdBarrier xcd_barrier_post(unsigned* bar, volatile LAS unsigned* st) {
    XcdBarrier b; b.bar = bar; b.x = xb_xcc_id(); b.st = st;
    if (threadIdx.x == 0) (void)xb_add(&bar[XB_XCNT(b.x)], 1u);
    return b;
}
__device__ __forceinline__ void xcd_barrier_complete(unsigned* bar, unsigned x, unsigned& nloc, unsigned& nx) {
    const unsigned G = gridDim.x * gridDim.y * gridDim.z;
    unsigned sum, cnt, mine, sp = 0u;
    for (;;) {
        sum = 0u; cnt = 0u; mine = 0u;
#pragma unroll
        for (unsigned j = 0; j < 16; ++j) { const unsigned c = xb_ld(&bar[XB_XCNT(j)]); sum += c; cnt += (c > 0u) ? 1u : 0u; mine = (j == x) ? c : mine; }
        if (sum == G) break;
        __builtin_amdgcn_s_sleep(1);
        if ((++sp & 255u) == 0u) { if (xb_ld(&bar[XB_TMO])) break; if (sp > XB_SPIN_CAP) { atomicAdd(&bar[XB_TMO], 1u); break; } }
    }
    nloc = mine > 0u ? mine : 1u; nx = cnt > 0u ? cnt : 1u;
}

__device__ __forceinline__ void xcd_barrier(const XcdBarrier& b) {
    asm volatile("s_waitcnt vmcnt(0)" ::: "memory");
    __syncthreads();
    if (threadIdx.x == 0) {
        unsigned* bar = b.bar;
        __builtin_amdgcn_s_waitcnt(0);
        unsigned nloc = b.st[0], nx = b.st[1];
        if (nloc == 0u) { xcd_barrier_complete(bar, b.x, nloc, nx); b.st[0] = nloc; b.st[1] = nx; }
        const unsigned old = xb_add(&bar[XB_XSUB(b.x)], 1u);
        const unsigned gen = old / nloc;
        if (old + 1u == (gen + 1u) * nloc) {
            __builtin_amdgcn_fence(__ATOMIC_RELEASE, "agent");
            asm volatile("s_waitcnt vmcnt(0)" ::: "memory");
            const unsigned og = xb_add(&bar[XB_TOP], 1u);
            const unsigned tg = og / nx;
            if (og + 1u == (tg + 1u) * nx) xb_add(&bar[XB_TOPGEN], 1u);
            else XB_SPIN(xb_ld(&bar[XB_TOPGEN]) == tg, bar);
            __builtin_amdgcn_fence(__ATOMIC_ACQUIRE, "agent");
            xb_add(&bar[XB_XGEN(b.x)], 1u);
            asm volatile("s_waitcnt vmcnt(0)" ::: "memory");
        } else {
            XB_SPIN(xb_ld(&bar[XB_XGEN(b.x)]) == gen, bar);
            __builtin_amdgcn_fence(__ATOMIC_ACQUIRE, "agent");
            asm volatile("s_waitcnt vmcnt(0)" ::: "memory");
        }
    }
    __syncthreads();
}

template <class Epi>
__device__ __forceinline__ void gemm_run(float* lds, const bf16_t* A, const bf16_t* Bt, int M, int N, int K, const Epi& E) {
    __syncthreads();
    pg8::Gemm g{A, Bt, M, N, K}; pg8::StaticOrder S; S.init(M, N, (int)gridDim.x, (int)blockIdx.x);
    pg8::gemm_phase<Epi, pg8::StaticOrder, true, true>((PG8_LAS unsigned char*)lds, g, S, E);
    __syncthreads();
}
constexpr int NPHASE = 11;
template <int PH>
__device__ __forceinline__ void run_phase(const Params& p, int bid, int nb, float* lds) {
    asm volatile("" : "+s"(bid));
    if constexpr (PH == 0) ph_prep(p, bid, nb, lds);
    if constexpr (PH == 1) ph_modnorm(p, p.x, p.norm1_g, 0 * DM, 1 * DM, p.hb, bid, nb, lds);
    if constexpr (PH == 2) gemm_run(lds, p.hb, p.Wt1, NTOK, ZW, DM, pg8::EpiZG{p.ZG, p.b_bg});
    if constexpr (PH == 3) { ph_retprep(p, bid, nb, lds); ph_gmlp2(p, bid, nb, lds); }
    if constexpr (PH == 11) ph_ret2(p, bid, nb, lds);
    if constexpr (PH == 4) ph_gn(p, bid, nb, lds);
    if constexpr (PH == 5) {
        gemm_run(lds, p.yain, p.Wta, NTOK, DM, 1024, pg8::EpiMixB<0>{p.hb, p.ZG, 0});
        gemm_run(lds, p.ybin, p.Wtb, NTOK, DM, DM, pg8::EpiMixB<1>{p.hb, p.ZG, 2048});
    }
    if constexpr (PH == 6) gemm_run(lds, p.hb, p.Wto, NTOK, DM, DM, pg8::EpiResF{p.obuf, p.x, p.ada + 2 * DM});
    if constexpr (PH == 7) { ph_modnorm(p, p.obuf, p.norm2_g, 3 * DM, 4 * DM, p.hb, bid, nb, lds); if (nb != 256) ph_tabconv(p, bid, nb); }
    if constexpr (PH == 8) {
        gemm_run(lds, p.hb, p.Wtq, NTOK, DM, DM, pg8::EpiF32{p.qbuf, DM});
        if (nb == 256) {
            pg8::StaticOrder S; S.init(NTOK, DM, (int)gridDim.x, (int)blockIdx.x); pg8::Unit u; S.next(0, u);
            asm volatile("s_waitcnt vmcnt(0)" ::: "memory"); __syncthreads();
            ph_topk2(p, p.qbuf, bid, nb, lds, u.pm * 8 + u.pn);
        }
    }
    if constexpr (PH == 9) { if (nb != 256) ph_topk2(p, p.qbuf, bid, nb, lds, -1); }
    if constexpr (PH == 10) ph_peer6(p, p.obuf, p.hb, bid, nb, lds);
}

constexpr int MISC_OFF = 132 * 1024;
__global__ void __launch_bounds__(NTH) k_mega(Params p) {
    extern __shared__ __attribute__((aligned(16))) float lds[];
    const int bid = blockIdx.x, nb = gridDim.x;
    volatile LAS unsigned* misc = (volatile LAS unsigned*)((LAS unsigned char*)lds + MISC_OFF);
    if (threadIdx.x < 4) misc[threadIdx.x] = 0u;
    __syncthreads();
    XcdBarrier bar = xcd_barrier_post(p.bar, misc);
    run_phase<0>(p, bid, nb, lds); xcd_barrier(bar);
    run_phase<1>(p, bid, nb, lds); xcd_barrier(bar);
    run_phase<2>(p, bid, nb, lds); xcd_barrier(bar);
    run_phase<3>(p, bid, nb, lds); xcd_barrier(bar);
    run_phase<11>(p, bid, nb, lds); xcd_barrier(bar);
    run_phase<4>(p, bid, nb, lds); xcd_barrier(bar);
    run_phase<5>(p, bid, nb, lds); xcd_barrier(bar);
    run_phase<6>(p, bid, nb, lds); xcd_barrier(bar);
    run_phase<7>(p, bid, nb, lds); xcd_barrier(bar);
    run_phase<8>(p, bid, nb, lds); xcd_barrier(bar);
    if (nb != 256) { run_phase<9>(p, bid, nb, lds); xcd_barrier(bar); }
    run_phase<10>(p, bid, nb, lds);
}

extern "C" void kernel_launch(void* const* d_in, const int* in_sizes, int n_in, void* d_out, int out_size, void* d_ws, size_t ws_size, hipStream_t stream) {
    Params p{};
    p.x = (const float*)d_in[0]; p.c = (const float*)d_in[1]; p.pos = (const int*)d_in[2];
    p.w_ada = (const float*)d_in[3]; p.b_ada = (const float*)d_in[4]; p.norm1_g = (const float*)d_in[5]; p.w_in = (const float*)d_in[6];
    p.w_bg = (const float*)d_in[7]; p.b_bg = (const float*)d_in[8]; p.gm_v_g = (const float*)d_in[9]; p.gm_ws = (const float*)d_in[10];
    p.gm_b = (const float*)d_in[11]; p.ret_gn_g = (const float*)d_in[12]; p.w_a_out = (const float*)d_in[13]; p.w_b_out = (const float*)d_in[14];
    p.w_o = (const float*)d_in[15]; p.norm2_g = (const float*)d_in[16]; p.peer_wq = (const float*)d_in[17]; p.peer_sk = (const float*)d_in[18];
    p.peer_u = (const float*)d_in[19]; p.peer_v = (const float*)d_in[20]; p.norm_f_g = (const float*)d_in[21];
    p.out = (float*)d_out;
    char* w = (char*)d_ws; size_t off = 0;
    auto take = [&](size_t bytes) { char* r = w + off; off += (bytes + 255) & ~(size_t)255; return r; };
    p.bar = (unsigned*)take(XCD_BAR_WORDS * 4);
    p.ada = (float*)take(2 * NMOD * 4);
    p.rope = (float*)take((size_t)NTOK * 128 * 4);
    p.eidx = (int*)take((size_t)NTOK * 128 * 4);
    p.gatev = (float*)take((size_t)NTOK * 128 * 4);
    p.Wt1 = (bf16_t*)take((size_t)ZW * DM * 2);
    p.Wta = (bf16_t*)take((size_t)DM * 1024 * 2);
    p.Wtb = (bf16_t*)take((size_t)DM * DM * 2);
    p.Wto = (bf16_t*)take((size_t)DM * DM * 2);
    p.Wtq = (bf16_t*)take((size_t)DM * DM * 2);
    p.hb = (bf16_t*)take((size_t)NTOK * DM * 2);
    p.ZG = (bf16_t*)take((size_t)NTOK * ZW * 2);
    p.qbuf = (float*)p.ZG;
    p.obuf = (float*)take((size_t)NTOK * DM * 4);
    p.ybin = (bf16_t*)take((size_t)NTOK * DM * 2);
    p.yain = (bf16_t*)take((size_t)NTOK * 1024 * 2);
    p.U8 = (unsigned char*)p.ZG + (size_t)NTOK * DM * 4;
    p.V8 = p.U8 + (size_t)16384 * ROW4;
    p.su = (float*)take(16384 * 4); p.sv = (float*)take(16384 * 4);
    p.Qr = (bf16_t*)take((size_t)NTOK * 1024 * 2);
    p.Pm = (bf16_t*)take((size_t)16 * 64 * 4096 * 2);
    p.KTd = (bf16_t*)take((size_t)NTOK * 1024 * 2);
    p.Vt = (bf16_t*)take((size_t)NTOK * 2048 * 2);
    p.ob16 = (bf16_t*)take((size_t)NTOK * DM * 2);
    if (off > ws_size) { fprintf(stderr, "kernel_launch: workspace too small: need %zu have %zu\n", off, ws_size); return; }
    static int grid = 0;
    if (!grid) {
        int dev = 0, cus = 0, per_cu = 0;
        (void)hipGetDevice(&dev); (void)hipDeviceGetAttribute(&cus, hipDeviceAttributeMultiprocessorCount, dev);
        (void)hipFuncSetAttribute((const void*)k_mega, hipFuncAttributeMaxDynamicSharedMemorySize, LDS_BYTES);
        (void)hipOccupancyMaxActiveBlocksPerMultiprocessor(&per_cu, k_mega, NTH, LDS_BYTES);
        (void)per_cu;
        grid = cus;
    }
    (void)hipMemsetAsync(p.bar, 0, XCD_BAR_WORDS * 4, stream);
    hipLaunchKernelGGL(k_mega, dim3(grid), dim3(NTH), LDS_BYTES, stream, p);
    hipError_t e = hipPeekAtLastError();
    if (e != hipSuccess) fprintf(stderr, "launch failed: %s (grid %d)\n", hipGetErrorString(e), grid);
}
```

```cpp
#include <hip/hip_runtime.h>
#include <hip/hip_cooperative_groups.h>
#include <stdint.h>
#include <math.h>
#include <cstdio>

namespace cg = cooperative_groups;

constexpr int DM = 2048;
constexpr int SQ = 4096;
constexpr int NTOK = 8192;
constexpr int NTH = 512;
constexpr int ZW = 12288;
constexpr int NMOD = 12288;
constexpr int LDS_BYTES = 136 * 1024;

typedef unsigned short bf16_t;

struct Params {
    const float *x, *c; const int* pos;
    const float *w_ada, *b_ada, *norm1_g, *w_in, *w_bg, *b_bg, *gm_v_g, *gm_ws, *gm_b, *ret_gn_g, *w_a_out, *w_b_out, *w_o, *norm2_g,
                *peer_wq, *peer_sk, *peer_u, *peer_v, *norm_f_g;
    float* out;
    float *ada, *rope, *gatev; int* eidx;
    bf16_t *Wt1, *Wta, *Wtb, *Wto, *Wtq;
    bf16_t *hb;
    bf16_t *ZG;
    float *obuf;
    bf16_t *ybin, *yain;
    float *qbuf;
    unsigned char *U8, *V8;
    float *su, *sv;
    bf16_t *Qr, *Pm, *KTd, *Vt;
    bf16_t *ob16;
    unsigned *bar;
};

__constant__ float c_freq[64] = {
1.000000000e+00f, 8.659643531e-01f, 7.498942018e-01f, 6.493816376e-01f, 5.623413324e-01f, 4.869675338e-01f, 4.216965139e-01f, 3.651741147e-01f, 3.162277639e-01f, 2.738419771e-01f, 2.371373773e-01f, 2.053525001e-01f, 1.778279394e-01f, 1.539926529e-01f, 1.333521456e-01f, 1.154781953e-01f, 1.000000015e-01f, 8.659642935e-02f, 7.498942316e-02f, 6.493816525e-02f, 5.623413250e-02f, 4.869675264e-02f, 4.216964915e-02f, 3.651741147e-02f, 3.162277490e-02f, 2.738419548e-02f, 2.371373773e-02f, 2.053525113e-02f, 1.778279431e-02f, 1.539926510e-02f, 1.333521400e-02f, 1.154781971e-02f, 9.999999776e-03f, 8.659643121e-03f, 7.498942316e-03f, 6.493816152e-03f, 5.623413250e-03f, 4.869675264e-03f, 4.216964822e-03f, 3.651741194e-03f, 3.162277630e-03f, 2.738419687e-03f, 2.371373819e-03f, 2.053525066e-03f, 1.778279431e-03f, 1.539926510e-03f, 1.333521446e-03f, 1.154782018e-03f, 1.000000047e-03f, 8.659643354e-04f, 7.498941850e-04f, 6.493816036e-04f, 5.623413017e-04f, 4.869675322e-04f, 4.216965172e-04f, 3.651741135e-04f, 3.162277571e-04f, 2.738419571e-04f, 2.371373703e-04f, 2.053525095e-04f, 1.778279402e-04f, 1.539926598e-04f, 1.333521504e-04f, 1.154782003e-04f };

__device__ __forceinline__ int tid_() { int t = threadIdx.x; asm volatile("" : "+v"(t)); return t; }
template <int CTRL> __device__ __forceinline__ float dppf(float x) { return __uint_as_float((unsigned)__builtin_amdgcn_update_dpp(0, (int)__float_as_uint(x), CTRL, 0xf, 0xf, true)); }
__device__ __forceinline__ float row_sum16(float v) { v += dppf<0xB1>(v); v += dppf<0x4E>(v); v += dppf<0x141>(v); v += dppf<0x140>(v); return v; }
__device__ __forceinline__ float xsum16(float v) { const auto r = __builtin_amdgcn_permlane16_swap(__float_as_uint(v), __float_as_uint(v), false, false); return __uint_as_float(r[0]) + __uint_as_float(r[1]); }
__device__ __forceinline__ float xsum32(float v) { const auto r = __builtin_amdgcn_permlane32_swap(__float_as_uint(v), __float_as_uint(v), false, false); return __uint_as_float(r[0]) + __uint_as_float(r[1]); }
__device__ __forceinline__ float xmax16(float v) { const auto r = __builtin_amdgcn_permlane16_swap(__float_as_uint(v), __float_as_uint(v), false, false); return fmaxf(__uint_as_float(r[0]), __uint_as_float(r[1])); }
__device__ __forceinline__ float xmax32(float v) { const auto r = __builtin_amdgcn_permlane32_swap(__float_as_uint(v), __float_as_uint(v), false, false); return fmaxf(__uint_as_float(r[0]), __uint_as_float(r[1])); }
__device__ __forceinline__ float wave_sum(float v) { v = row_sum16(v); v += __shfl_xor(v, 16); v += __shfl_xor(v, 32); return v; }
__device__ __forceinline__ float wave_max_b(float v) {
    v = fmaxf(v, dppf<0xB1>(v)); v = fmaxf(v, dppf<0x4E>(v)); v = fmaxf(v, dppf<0x141>(v)); v = fmaxf(v, dppf<0x140>(v));
    v = fmaxf(v, __shfl_xor(v, 16)); v = fmaxf(v, __shfl_xor(v, 32)); return v;
}
__device__ __forceinline__ float wave_max(float v) {
    v = fmaxf(v, dppf<0xB1>(v)); v = fmaxf(v, dppf<0x4E>(v)); v = fmaxf(v, dppf<0x141>(v)); v = fmaxf(v, dppf<0x140>(v));
    return xmax32(xmax16(v));
}
__device__ __forceinline__ float sigmoidf_(float x) { return 1.0f / (1.0f + expf(-x)); }
__device__ __forceinline__ float siluf_(float x) { return x * sigmoidf_(x); }
__device__ __forceinline__ float geluf_(float x) { return 0.5f * x * (1.0f + erff(x * 0.70710678118654752f)); }
__device__ __forceinline__ float dot4(float4 a, float4 b) { return a.x * b.x + a.y * b.y + a.z * b.z + a.w * b.w; }
__device__ __forceinline__ float bf2f(bf16_t v) { return __uint_as_float((unsigned)v << 16); }
__device__ __forceinline__ float bflo(unsigned w) { return __uint_as_float(w << 16); }
__device__ __forceinline__ float bfhi(unsigned w) { return __uint_as_float(w & 0xffff0000u); }
__device__ __forceinline__ unsigned f2bf(float f) { unsigned u = __float_as_uint(f); return (u + 0x7fffu + ((u >> 16) & 1u)) >> 16; }
__device__ __forceinline__ unsigned pk2(float lo, float hi) { return f2bf(lo) | (f2bf(hi) << 16); }

__device__ __forceinline__ void st_wt8(void* ptr, uint2 v) { __hip_atomic_store((unsigned long long*)ptr, ((unsigned long long)v.y << 32) | v.x, __ATOMIC_RELAXED, __HIP_MEMORY_SCOPE_AGENT); }
__device__ __forceinline__ void sincos_acc(float ang, float& s, float& c) {
    const double x = (double)ang;
    const double k = rint(x * 0.63661977236758134308);
    double r = fma(-k, 1.57079632679489655800, x); r = fma(-k, 6.12323399573676603587e-17, r);
    const double r2 = r * r;
    const double sp = r * (1.0 + r2 * (-1.0 / 6.0 + r2 * (1.0 / 120.0 + r2 * (-1.0 / 5040.0 + r2 * (1.0 / 362880.0 + r2 * (-1.0 / 39916800.0 + r2 * (1.0 / 6227020800.0)))))));
    const double cp = 1.0 + r2 * (-0.5 + r2 * (1.0 / 24.0 + r2 * (-1.0 / 720.0 + r2 * (1.0 / 40320.0 + r2 * (-1.0 / 3628800.0 + r2 * (1.0 / 479001600.0 + r2 * (-1.0 / 87178291200.0)))))));
    const int q = ((int)k) & 3;
    const float fs = (float)sp, fc = (float)cp;
    s = (q == 0) ? fs : (q == 1) ? fc : (q == 2) ? -fs : -fc;
    c = (q == 0) ? fc : (q == 1) ? -fs : (q == 2) ? -fc : fs;
}

namespace pg8 {
#define PG8_LAS __attribute__((address_space(3)))
typedef unsigned short bf16_t;
typedef short bf16x8 __attribute__((ext_vector_type(8)));
typedef float f32x4 __attribute__((ext_vector_type(4)));
typedef unsigned u32x4 __attribute__((ext_vector_type(4)));
constexpr int BM = 256, BK = 64, HALF = 128, HTB = HALF * BK * 2  , STAGE_BYTES = 8 * HTB, NXCD = 8, WGM = 8;

__host__ __device__ __forceinline__ int lds_byte(int r, int c) { const int st = (r >> 4) * 2 + (c >> 5), rr = r & 15, cc = c & 31, ob = rr * 64 + cc * 2; return st * 1024 + (ob ^ (((ob >> 9) & 1) << 5)); }
__host__ __device__ __forceinline__ void stage_rc(int b, int& R, int& C) { const int st = b / 1024, sb = b % 1024, swz = sb ^ (((sb >> 9) & 1) << 5); R = (st >> 1) * 16 + swz / 64; C = (st & 1) * 32 + (swz % 64) / 2; }
__host__ __device__ __forceinline__ int perm32(int rho) { const int n = rho >> 4, i = rho & 15; return 8 * (i >> 2) + 4 * n + (i & 3); }

struct Unit { int pm, pn; };
struct Gemm { const bf16_t* A; const bf16_t* Bt; int M, N, K; };

struct StaticOrder {
    int nM, nN, nwg, G, c;
    __host__ __device__ void init(int M, int N, int G_, int c_) { nM = M / BM; nN = N / BM; nwg = nM * nN; G = G_; c = c_; }
    __host__ __device__ bool next(int i, Unit& u) const {
        const long L = (long)i * G + c; if (L >= nwg) return false;
        int wgid = (int)L; { const int q = nwg / NXCD, r = nwg % NXCD, xcd = wgid % NXCD, off = wgid / NXCD; wgid = (xcd < r ? xcd * (q + 1) : r * (q + 1) + (xcd - r) * q) + off; }
        const int nig = WGM * nN, gid = wgid / nig, fm = gid * WGM, gsz = (nM - fm) < WGM ? (nM - fm) : WGM;
        u.pm = fm + ((wgid % nig) % gsz); u.pn = (wgid % nig) / gsz; return true;
    }
    __device__ __forceinline__ void a_ready(const Unit&) const {}
    __device__ __forceinline__ void done(const Unit&) const {}
};

__device__ __forceinline__ unsigned cvt_pk_bf16(float lo, float hi) { unsigned r; asm volatile("v_cvt_pk_bf16_f32 %0, %1, %2" : "=v"(r) : "v"(lo), "v"(hi)); return r; }
typedef float f32x2 __attribute__((ext_vector_type(2)));
__device__ __forceinline__ f32x2 gelu_pk(f32x2 v) {
    const f32x2 av = __builtin_elementwise_abs(v), d = av * 0.2316418882f + 1.0f;
    f32x2 t; t.x = __builtin_amdgcn_rcpf(d.x); t.y = __builtin_amdgcn_rcpf(d.y);
    f32x2 q = t * 0.5307027145f + (-0.7265760135f); q = q * t + 0.7107068705f; q = q * t + (-0.142248368f); q = q * t + 0.127414796f; q = q * t;
    const f32x2 s = (v * v) * (-0.72134752044f);
    f32x2 e; e.x = __builtin_amdgcn_exp2f(s.x); e.y = __builtin_amdgcn_exp2f(s.y);
    const f32x2 m = v * (q * e), r = v - m;
    f32x2 o; o.x = v.x < 0.f ? m.x : r.x; o.y = v.y < 0.f ? m.y : r.y; return o;
}

typedef unsigned u32x2v __attribute__((ext_vector_type(2)));
struct EpiZG {
    static constexpr bool PERM = true, AFTER_DRAIN = false;
    bf16_t* O; const float* bias;
    __device__ __forceinline__ void operator()(const f32x4 (&acc)[2][2][4][2], const Unit& u, int wr, int wc, int fr, int fq) const {
        const int row0 = u.pm * BM + wr * 64 + fr, col0 = u.pn * BM + wc * 32 + 8 * fq;
        const int mode = u.pn < 8 ? 1 : (u.pn < 32 ? 0 : 2);
        f32x4 bv[2][2];
#pragma unroll
        for (int bj = 0; bj < 2; ++bj)
#pragma unroll
            for (int n = 0; n < 2; ++n) bv[bj][n] = (mode == 2) ? *(const f32x4*)(bias + (col0 - 8192) + bj * HALF + 4 * n) : (f32x4){0.f, 0.f, 0.f, 0.f};
#pragma unroll
        for (int ai = 0; ai < 2; ++ai)
#pragma unroll
            for (int m = 0; m < 4; ++m) { bf16_t* rowp = O + (size_t)(row0 + ai * HALF + m * 16) * ZW + col0;
#pragma unroll
                for (int bj = 0; bj < 2; ++bj) { f32x4 v0 = acc[ai][bj][m][0], v1 = acc[ai][bj][m][1];
                    if (mode == 1) { f32x2 a = gelu_pk((f32x2){v0[0], v0[1]}), b = gelu_pk((f32x2){v0[2], v0[3]}), c = gelu_pk((f32x2){v1[0], v1[1]}), d = gelu_pk((f32x2){v1[2], v1[3]});
                        v0 = (f32x4){a.x, a.y, b.x, b.y}; v1 = (f32x4){c.x, c.y, d.x, d.y}; }
                    if (mode == 2) { v0 = v0 + bv[bj][0]; v1 = v1 + bv[bj][1];
#pragma unroll
                        for (int e = 0; e < 4; ++e) { v0[e] = __builtin_amdgcn_rcpf(1.0f + __expf(-v0[e])); v1[e] = __builtin_amdgcn_rcpf(1.0f + __expf(-v1[e])); } }
                    u32x4 w; w.x = cvt_pk_bf16(v0[0], v0[1]); w.y = cvt_pk_bf16(v0[2], v0[3]); w.z = cvt_pk_bf16(v1[0], v1[1]); w.w = cvt_pk_bf16(v1[2], v1[3]);
                    *(u32x4*)(rowp + bj * HALF) = w; } }
    }
};
template <int ACCUM> struct EpiMixB {
    static constexpr bool PERM = true, AFTER_DRAIN = false;
    bf16_t* Mo; const bf16_t* ZGp; int goff;
    __device__ __forceinline__ void operator()(const f32x4 (&acc)[2][2][4][2], const Unit& u, int wr, int wc, int fr, int fq) const {
        const int row0 = u.pm * BM + wr * 64 + fr, col0 = u.pn * BM + wc * 32 + 8 * fq;
#pragma unroll
        for (int ai = 0; ai < 2; ++ai)
#pragma unroll
            for (int m = 0; m < 4; ++m) { const size_t row = (size_t)(row0 + ai * HALF + m * 16);
#pragma unroll
                for (int bj = 0; bj < 2; ++bj) { const f32x4 v0 = acc[ai][bj][m][0], v1 = acc[ai][bj][m][1];
                    const u32x4 g = *(const u32x4*)(ZGp + row * ZW + 8192 + goff + col0 + bj * HALF);
                    float o[8];
                    o[0] = bflo(g.x) * v0[0]; o[1] = bfhi(g.x) * v0[1]; o[2] = bflo(g.y) * v0[2]; o[3] = bfhi(g.y) * v0[3];
                    o[4] = bflo(g.z) * v1[0]; o[5] = bfhi(g.z) * v1[1]; o[6] = bflo(g.w) * v1[2]; o[7] = bfhi(g.w) * v1[3];
                    bf16_t* mp = Mo + row * DM + col0 + bj * HALF;
                    if (ACCUM) { const u32x4 old = *(const u32x4*)mp;
                        o[0] += bflo(old.x); o[1] += bfhi(old.x); o[2] += bflo(old.y); o[3] += bfhi(old.y); o[4] += bflo(old.z); o[5] += bfhi(old.z); o[6] += bflo(old.w); o[7] += bfhi(old.w); }
                    u32x4 w; w.x = cvt_pk_bf16(o[0], o[1]); w.y = cvt_pk_bf16(o[2], o[3]); w.z = cvt_pk_bf16(o[4], o[5]); w.w = cvt_pk_bf16(o[6], o[7]);
                    *(u32x4*)mp = w; } }
    }
};
struct EpiResF {
    static constexpr bool PERM = false, AFTER_DRAIN = false;
    float* x1; const float* x; const float* ga;
    __device__ __forceinline__ void operator()(const f32x4 (&acc)[2][2][4][2], const Unit& u, int wr, int wc, int fr, int fq) const {
        const int row0 = u.pm * BM + wr * 64 + fr, col0 = u.pn * BM + wc * 32 + 4 * fq;
        const int b = (u.pm * BM) / SQ;
        f32x4 gv[2][2];
#pragma unroll
        for (int bj = 0; bj < 2; ++bj)
#pragma unroll
            for (int n = 0; n < 2; ++n) gv[bj][n] = *(const f32x4*)(ga + b * NMOD + col0 + bj * HALF + n * 16);
#pragma unroll
        for (int ai = 0; ai < 2; ++ai)
#pragma unroll
            for (int m = 0; m < 4; ++m) { const size_t off = (size_t)(row0 + ai * HALF + m * 16) * DM + col0;
#pragma unroll
                for (int bj = 0; bj < 2; ++bj)
#pragma unroll
                    for (int n = 0; n < 2; ++n) { const f32x4 xv = *(const f32x4*)(x + off + bj * HALF + n * 16);
                        *(f32x4*)(x1 + off + bj * HALF + n * 16) = xv + gv[bj][n] * acc[ai][bj][m][n]; } }
    }
};
struct EpiF32 {
    static constexpr bool PERM = false, AFTER_DRAIN = false;
    float* O; int ldc;
    __device__ __forceinline__ void operator()(const f32x4 (&acc)[2][2][4][2], const Unit& u, int wr, int wc, int fr, int fq) const {
        const int row0 = u.pm * BM + wr * 64 + fr, col0 = u.pn * BM + wc * 32 + 4 * fq;
#pragma unroll
        for (int ai = 0; ai < 2; ++ai)
#pragma unroll
            for (int m = 0; m < 4; ++m) { const size_t off = (size_t)(row0 + ai * HALF + m * 16) * ldc + col0;
#pragma unroll
                for (int bj = 0; bj < 2; ++bj)
#pragma unroll
                    for (int n = 0; n < 2; ++n) *(f32x4*)(O + off + bj * HALF + n * 16) = acc[ai][bj][m][n]; }
    }
};

template <class Epi, class Sched, bool ALIGN_EPI = false, bool SP2 = false>
__device__ __forceinline__ void gemm_phase(PG8_LAS unsigned char* lds, const Gemm g, const Sched& S, const Epi& E) {
    const int tid = threadIdx.x, wid = __builtin_amdgcn_readfirstlane(tid >> 6), lane = tid & 63, wr = wid >> 2, wc = wid & 3, fr = lane & 15, fq = lane >> 4;
    const int K = g.K, nt = K / BK;
    unsigned voffA[2], voffB[2];
#pragma unroll
    for (int i = 0; i < 2; ++i) { int R, C; stage_rc(tid * 16 + i * 8192, R, C); const int Rb = Epi::PERM ? ((R & ~31) + perm32(R & 31)) : R;
        voffA[i] = (unsigned)(R * K + C) * 2u; voffB[i] = (unsigned)(Rb * K + C) * 2u; }
    const size_t kstep = (size_t)(BK * 2);
    const size_t hstep = (size_t)HALF * K * 2;
    const size_t tstep = 2 * hstep;
    const unsigned ldsw = (unsigned)wid * 1024u;
    const int aoff = lds_byte(wr * 64 + fr, fq * 8), boff = lds_byte(wc * 32 + fr, fq * 8);
#define PG8_SA(b, h) (((b) * 2 + (h)) * HTB)
#define PG8_SB(b, h) ((4 + (b) * 2 + (h)) * HTB)
#define PG8_STAGE(bufoff, gbase, voff) do { _Pragma("unroll") for (int _i = 0; _i < 2; ++_i) \
        __builtin_amdgcn_global_load_lds((const unsigned*)((const char*)(gbase) + (voff)[_i]), (PG8_LAS unsigned*)(lds + (bufoff) + ldsw + _i * 8192), 16, 0, 0); } while (0)
#define PG8_LDA(dst, b, h) do { _Pragma("unroll") for (int m = 0; m < 4; ++m) _Pragma("unroll") for (int k = 0; k < 2; ++k) dst[m][k] = *(const PG8_LAS bf16x8*)(lds + PG8_SA(b, h) + aoff + m * 2048 + k * 1024); } while (0)
#define PG8_LDB(dst, b, h) do { _Pragma("unroll") for (int n = 0; n < 2; ++n) _Pragma("unroll") for (int k = 0; k < 2; ++k) dst[n][k] = *(const PG8_LAS bf16x8*)(lds + PG8_SB(b, h) + boff + n * 2048 + k * 1024); } while (0)
#define PG8_MMA(ai, bj, At, Bt) do { __builtin_amdgcn_s_setprio(1); _Pragma("unroll") for (int m = 0; m < 4; ++m) _Pragma("unroll") for (int n = 0; n < 2; ++n) _Pragma("unroll") for (int k = 0; k < 2; ++k) \
        acc[ai][bj][m][n] = __builtin_amdgcn_mfma_f32_16x16x32_bf16(Bt[n][k], At[m][k], acc[ai][bj][m][n], 0, 0, 0); __builtin_amdgcn_s_setprio(0); } while (0)
#define PG8_WAIT_V(n) asm volatile("s_waitcnt vmcnt(" #n ")" ::: "memory")
#define PG8_WAIT_L(n) asm volatile("s_waitcnt lgkmcnt(" #n ")" ::: "memory")
#define PG8_BAR __builtin_amdgcn_s_barrier()
#define PG8_SCHED __builtin_amdgcn_sched_barrier(0)
    Unit cur, nxt; int ui = 0;
    if (!S.next(0, cur)) return;
    f32x4 acc[2][2][4][2];
#pragma unroll
    for (int a = 0; a < 2; ++a)
#pragma unroll
        for (int b = 0; b < 2; ++b)
#pragma unroll
            for (int m = 0; m < 4; ++m)
#pragma unroll
                for (int n = 0; n < 2; ++n) acc[a][b][m][n] = (f32x4){0.f, 0.f, 0.f, 0.f};
    bf16x8 At[4][2], B0[2][2], B1[2][2];
    const char* cA = (const char*)g.A + (size_t)cur.pm * tstep; const char* cB = (const char*)g.Bt + (size_t)cur.pn * tstep;
    S.a_ready(cur);
    if constexpr (SP2) {
        PG8_STAGE(PG8_SB(0, 0), cB, voffB); PG8_STAGE(PG8_SB(0, 1), cB + hstep, voffB); PG8_STAGE(PG8_SA(0, 0), cA, voffA); PG8_STAGE(PG8_SA(0, 1), cA + hstep, voffA);
        if (wr == 1) PG8_BAR;
        PG8_WAIT_V(2); PG8_BAR;
        PG8_STAGE(PG8_SB(1, 0), cB + kstep, voffB); PG8_STAGE(PG8_SA(1, 0), cA + kstep, voffA); PG8_STAGE(PG8_SB(1, 1), cB + hstep + kstep, voffB);
        PG8_WAIT_V(6); PG8_BAR;
    } else {
        PG8_STAGE(PG8_SB(0, 0), cB, voffB); PG8_STAGE(PG8_SA(0, 0), cA, voffA); PG8_STAGE(PG8_SB(0, 1), cB + hstep, voffB); PG8_STAGE(PG8_SA(0, 1), cA + hstep, voffA);
        if (wr == 1) PG8_BAR;
        PG8_WAIT_V(4); PG8_BAR;
        PG8_STAGE(PG8_SB(1, 0), cB + kstep, voffB); PG8_STAGE(PG8_SA(1, 0), cA + kstep, voffA); PG8_STAGE(PG8_SB(1, 1), cB + hstep + kstep, voffB);
        PG8_WAIT_V(6); PG8_BAR;
    }
    for (;;) {
        const bool has_next = S.next(ui + 1, nxt);
        const char* nA = has_next ? (const char*)g.A + (size_t)nxt.pm * tstep : cA; const char* nB = has_next ? (const char*)g.Bt + (size_t)nxt.pn * tstep : cB;
        for (int t = 0; t < nt; t += 2) {
            const bool last = (t == nt - 2);
            const char* a1 = cA + (size_t)(t + 1) * kstep;
            const char* a2 = last ? nA : cA + (size_t)(t + 2) * kstep; const char* b2 = last ? nB : cB + (size_t)(t + 2) * kstep;
            const char* a3 = a2 + kstep; const char* b3 = b2 + kstep;
            if (last && has_next) S.a_ready(nxt);
            if constexpr (SP2) {
            PG8_LDB(B0, 0, 0); PG8_LDB(B1, 0, 1); PG8_SCHED; PG8_LDA(At, 0, 0); PG8_STAGE(PG8_SA(1, 1), a1 + hstep, voffA);
            PG8_WAIT_V(8); PG8_WAIT_L(0); PG8_BAR; PG8_MMA(0, 0, At, B0); PG8_MMA(0, 1, At, B1); PG8_BAR; PG8_SCHED;
            PG8_LDA(At, 0, 1); PG8_STAGE(PG8_SB(0, 0), b2, voffB); PG8_STAGE(PG8_SB(0, 1), b2 + hstep, voffB); PG8_STAGE(PG8_SA(0, 0), a2, voffA);
            PG8_WAIT_V(8); PG8_WAIT_L(0); PG8_BAR; PG8_MMA(1, 0, At, B0); PG8_MMA(1, 1, At, B1); PG8_BAR; PG8_SCHED;
            PG8_LDB(B0, 1, 0); PG8_LDB(B1, 1, 1); PG8_SCHED; PG8_LDA(At, 1, 0); PG8_STAGE(PG8_SA(0, 1), a2 + hstep, voffA);
            PG8_WAIT_V(8); PG8_WAIT_L(0); PG8_BAR; PG8_MMA(0, 0, At, B0); PG8_MMA(0, 1, At, B1); PG8_BAR; PG8_SCHED;
            PG8_LDA(At, 1, 1); PG8_STAGE(PG8_SB(1, 0), b3, voffB); PG8_STAGE(PG8_SB(1, 1), b3 + hstep, voffB); PG8_STAGE(PG8_SA(1, 0), a3, voffA);
            PG8_WAIT_V(8); PG8_WAIT_L(0); PG8_BAR; PG8_MMA(1, 0, At, B0); PG8_MMA(1, 1, At, B1); PG8_BAR; PG8_SCHED;
            } else {
            PG8_LDB(B0, 0, 0); PG8_SCHED; PG8_LDA(At, 0, 0); PG8_STAGE(PG8_SA(1, 1), a1 + hstep, voffA);
            PG8_WAIT_L(8); PG8_BAR; PG8_WAIT_L(0); PG8_MMA(0, 0, At, B0); PG8_BAR; PG8_SCHED;
            PG8_LDB(B1, 0, 1); PG8_STAGE(PG8_SB(0, 0), b2, voffB);
            PG8_BAR; PG8_WAIT_L(0); PG8_MMA(0, 1, At, B1); PG8_BAR;
            PG8_LDA(At, 0, 1); PG8_STAGE(PG8_SA(0, 0), a2, voffA);
            PG8_BAR; PG8_WAIT_L(0); PG8_MMA(1, 0, At, B0); PG8_BAR; PG8_SCHED;
            PG8_STAGE(PG8_SB(0, 1), b2 + hstep, voffB);
            PG8_WAIT_V(6); PG8_BAR; PG8_MMA(1, 1, At, B1); PG8_BAR;
            PG8_LDB(B0, 1, 0); PG8_SCHED; PG8_LDA(At, 1, 0); PG8_STAGE(PG8_SA(0, 1), a2 + hstep, voffA);
            PG8_WAIT_L(8); PG8_BAR; PG8_WAIT_L(0); PG8_MMA(0, 0, At, B0); PG8_BAR; PG8_SCHED;
            PG8_LDB(B1, 1, 1); PG8_STAGE(PG8_SB(1, 0), b3, voffB);
            PG8_BAR; PG8_WAIT_L(0); PG8_MMA(0, 1, At, B1); PG8_BAR;
            PG8_LDA(At, 1, 1); PG8_STAGE(PG8_SA(1, 0), a3, voffA);
            PG8_BAR; PG8_WAIT_L(0); PG8_MMA(1, 0, At, B0); PG8_BAR; PG8_SCHED;
            PG8_STAGE(PG8_SB(1, 1), b3 + hstep, voffB);
            PG8_WAIT_V(6); PG8_BAR; PG8_MMA(1, 1, At, B1); PG8_BAR;
            }
        }
        if constexpr (ALIGN_EPI) { if (wr == 0) PG8_BAR; }
        if constexpr (!Epi::AFTER_DRAIN) { E(acc, cur, wr, wc, fr, fq); S.done(cur); }
        if (!has_next) break;
#pragma unroll
        for (int a = 0; a < 2; ++a)
#pragma unroll
            for (int b = 0; b < 2; ++b)
#pragma unroll
                for (int m = 0; m < 4; ++m)
#pragma unroll
                    for (int n = 0; n < 2; ++n) acc[a][b][m][n] = (f32x4){0.f, 0.f, 0.f, 0.f};
        cur = nxt; cA = nA; cB = nB; ++ui;
        if constexpr (ALIGN_EPI) { if (wr == 1) PG8_BAR; }
    }
    PG8_WAIT_V(0);
    if constexpr (!ALIGN_EPI) { if (wr == 0) PG8_BAR; }
    PG8_BAR;
    if constexpr (Epi::AFTER_DRAIN) { E.fused(acc, cur, wr, wc, fr, fq, lds, wid, lane); S.done(cur); }
#undef PG8_SA
#undef PG8_SB
#undef PG8_STAGE
#undef PG8_LDA
#undef PG8_LDB
#undef PG8_MMA
#undef PG8_WAIT_V
#undef PG8_WAIT_L
#undef PG8_BAR
#undef PG8_SCHED
}
}
using pg8::f32x4; using pg8::u32x4;

__device__ __forceinline__ void transpose_item(const float* W, int K, int N, bf16_t* WT, int row_off, float* scr, int item, int lane) {
    const int nblk = N / 32, kb = item / nblk, nbk = item % nblk, k0 = 64 * kb, n0 = 32 * nbk;
    {
        const int r = lane >> 3, c4 = (lane & 7) * 4;
        float4 t[8];
#pragma unroll
        for (int i = 0; i < 8; ++i) t[i] = *(const float4*)(W + (size_t)(k0 + 8 * i + r) * N + n0 + c4);
#pragma unroll
        for (int i = 0; i < 8; ++i) { float* d = scr + (8 * i + r) * 33 + c4; d[0] = t[i].x; d[1] = t[i].y; d[2] = t[i].z; d[3] = t[i].w; }
    }
    asm volatile("s_waitcnt lgkmcnt(0)" ::: "memory");
    const int c = lane & 7;
#pragma unroll
    for (int j = 0; j < 4; ++j) { const int n = (lane >> 3) + 8 * j; const float* s = scr + (8 * c) * 33 + n;
        uint4 o; o.x = pk2(s[0 * 33], s[1 * 33]); o.y = pk2(s[2 * 33], s[3 * 33]); o.z = pk2(s[4 * 33], s[5 * 33]); o.w = pk2(s[6 * 33], s[7 * 33]);
        *(uint4*)(WT + (size_t)(row_off + n0 + n) * K + k0 + 8 * c) = o; }
    asm volatile("s_waitcnt lgkmcnt(0)" ::: "memory");
}
__device__ __forceinline__ void ph_prep(const Params& p, int bid, int nb, float* lds) {
    const int tid = tid_(), wave = tid >> 6, lane = tid & 63;
    {
        float* sl = lds;
        float* red = lds + 4096;
        for (int i = tid; i < 4096; i += NTH) sl[i] = siluf_(p.c[i]);
        __syncthreads();
        for (int it = bid; it < 192; it += nb) {
            const int c4 = tid & 15, kg = tid >> 4;
            const float* wp = p.w_ada + (size_t)kg * NMOD + it * 64 + c4 * 4;
            float a0[4] = {0.f, 0.f, 0.f, 0.f}, a1[4] = {0.f, 0.f, 0.f, 0.f};
#pragma unroll 8
            for (int i = 0; i < 64; ++i) {
                const int k = kg + 32 * i;
                const float4 w = *(const float4*)(wp + (size_t)(32 * i) * NMOD);
                const float s0 = sl[k], s1 = sl[2048 + k];
                a0[0] += s0 * w.x; a0[1] += s0 * w.y; a0[2] += s0 * w.z; a0[3] += s0 * w.w;
                a1[0] += s1 * w.x; a1[1] += s1 * w.y; a1[2] += s1 * w.z; a1[3] += s1 * w.w;
            }
            __syncthreads();
#pragma unroll
            for (int e = 0; e < 4; ++e) { red[(kg * 16 + c4) * 8 + e] = a0[e]; red[(kg * 16 + c4) * 8 + 4 + e] = a1[e]; }
            __syncthreads();
            if (tid < 128) {
                const int b = tid >> 6, col = tid & 63;
                float s = 0.f;
                for (int g = 0; g < 32; ++g) s += red[(g * 16 + (col >> 2)) * 8 + b * 4 + (col & 3)];
                p.ada[b * NMOD + it * 64 + col] = s + p.b_ada[it * 64 + col];
            }
        }
        __syncthreads();
    }
    for (int e = bid * NTH + tid; e < NTOK * 64; e += nb * NTH) {
        const int tok = e >> 6, j = e & 63;
        const float ang = (float)p.pos[tok] * c_freq[j];
        float s, c; sincos_acc(ang, s, c);
        p.rope[(size_t)e * 2] = c; p.rope[(size_t)e * 2 + 1] = s;
    }
    {
        float* scr = lds + wave * (64 * 33);
        const int gw = bid * 8 + wave, ngw = nb * 8;
        constexpr int I1 = 32 * 256, I2 = 32 * 128, I3 = 16 * 64, I4 = 32 * 64;
        constexpr int NIT = I1 + I2 + I3 + 3 * I4;
        for (int it = gw; it < NIT; it += ngw) {
            int r = it;
            if (r < I1) { transpose_item(p.w_in, 2048, 8192, p.Wt1, 0, scr, r, lane); continue; } r -= I1;
            if (r < I2) { transpose_item(p.w_bg, 2048, 4096, p.Wt1, 8192, scr, r, lane); continue; } r -= I2;
            if (r < I3) { transpose_item(p.w_a_out, 1024, 2048, p.Wta, 0, scr, r, lane); continue; } r -= I3;
            if (r < I4) { transpose_item(p.w_b_out, 2048, 2048, p.Wtb, 0, scr, r, lane); continue; } r -= I4;
            if (r < I4) { transpose_item(p.w_o, 2048, 2048, p.Wto, 0, scr, r, lane); continue; } r -= I4;
            transpose_item(p.peer_wq, 2048, 2048, p.Wtq, 0, scr, r, lane);
        }
    }
    __syncthreads();
}
constexpr int ROW6 = 1536;
typedef float f32x32_t __attribute__((ext_vector_type(32)));
typedef unsigned u32x6_t __attribute__((ext_vector_type(6)));
__device__ __forceinline__ void tc_load(const Params& p, int r, int lane, float4 (&t)[8]) {
    const bool second = r >= 16384; const int row = second ? r - 16384 : r;
    const float* src = (const float*)((const char*)p.peer_u + (second ? ((const char*)p.peer_v - (const char*)p.peer_u) : (ptrdiff_t)0)) + (size_t)row * DM + (second ? lane * 4 : (lane >> 2) * 128 + (lane & 3) * 8);
#pragma unroll
    for (int q = 0; q < 8; ++q) t[q] = *(const float4*)(src + (second ? 256 * q : (q >> 1) * 32 + (q & 1) * 4));
}
constexpr int ROW4 = 1024;
__device__ __forceinline__ void tc_finish(const Params& p, int r, int lane, const float4 (&t)[8]) {
    const bool second = r >= 16384; const int row = second ? r - 16384 : r;
    float am = 0.f;
#pragma unroll
    for (int q = 0; q < 8; ++q) am = fmaxf(am, fmaxf(fmaxf(fabsf(t[q].x), fabsf(t[q].y)), fmaxf(fabsf(t[q].z), fabsf(t[q].w))));
    am = wave_max_b(am);
    {
        const float sc = (am > 0.f) ? am * (1.0f / 6.0f) : 1.0f, inv = (am > 0.f) ? 6.0f / am : 1.0f;
        unsigned w0 = 0u, w1 = 0u, w2 = 0u, w3 = 0u;
#define TC_PK(W_, qa_, qb_) do { \
        W_ = __builtin_amdgcn_cvt_scalef32_pk_fp4_f32(W_, t[qa_].x * inv, t[qa_].y * inv, 1.0f, 0); W_ = __builtin_amdgcn_cvt_scalef32_pk_fp4_f32(W_, t[qa_].z * inv, t[qa_].w * inv, 1.0f, 1); \
        W_ = __builtin_amdgcn_cvt_scalef32_pk_fp4_f32(W_, t[qb_].x * inv, t[qb_].y * inv, 1.0f, 2); W_ = __builtin_amdgcn_cvt_scalef32_pk_fp4_f32(W_, t[qb_].z * inv, t[qb_].w * inv, 1.0f, 3); } while (0)
        TC_PK(w0, 0, 1); TC_PK(w1, 2, 3); TC_PK(w2, 4, 5); TC_PK(w3, 6, 7);
#undef TC_PK
        *(uint4*)(p.U8 + (size_t)r * ROW4 + lane * 16) = make_uint4(w0, w1, w2, w3);
        if (lane == 0) p.su[r] = sc;
    }
}
__device__ __forceinline__ void ph_tabconv(const Params& p, int bid, int nb) {
    const int tid = tid_(), wave = tid >> 6, lane = tid & 63;
    for (int r = bid * 8 + wave; r < 2 * 16384; r += nb * 8) { float4 t[8]; tc_load(p, r, lane, t); tc_finish(p, r, lane, t); }
}

__device__ __forceinline__ void ph_modnorm(const Params& p, const float* xin, const float* g, int sh_off, int sc_off, bf16_t* hout, int bid, int nb, float* lds) {
    const int tid = tid_(), wave = tid >> 6, lane = tid & 63;
    const int stride = nb * 8;
    int row = bid * 8 + wave;
    float4 v[8], vn[8];
    if (row < NTOK) {
#pragma unroll
        for (int j = 0; j < 8; ++j) v[j] = ((const float4*)(xin + (size_t)row * DM))[lane + 64 * j];
    }
    for (; row < NTOK; row += stride) {
        const int nrow = row + stride;
        if (nrow < NTOK) {
#pragma unroll
            for (int j = 0; j < 8; ++j) vn[j] = ((const float4*)(xin + (size_t)nrow * DM))[lane + 64 * j];
        }
        const int b = row / SQ;
        float ss = 0.f;
#pragma unroll
        for (int j = 0; j < 8; ++j) ss += dot4(v[j], v[j]);
        ss = wave_sum(ss);
        const float rs = 1.0f / sqrtf(ss * (1.0f / DM) + 1e-6f);
#pragma unroll
        for (int j = 0; j < 8; ++j) {
            const int col = (lane + 64 * j) * 4;
            const float4 g4 = *(const float4*)(g + col);
            const float4 sc = *(const float4*)(p.ada + b * NMOD + sc_off + col);
            const float4 sh = *(const float4*)(p.ada + b * NMOD + sh_off + col);
            float4 o;
            o.x = v[j].x * rs * g4.x * (1.0f + sc.x) + sh.x; o.y = v[j].y * rs * g4.y * (1.0f + sc.y) + sh.y;
            o.z = v[j].z * rs * g4.z * (1.0f + sc.z) + sh.z; o.w = v[j].w * rs * g4.w * (1.0f + sc.w) + sh.w;
            st_wt8(hout + (size_t)row * DM + col, make_uint2(pk2(o.x, o.y), pk2(o.z, o.w)));
        }
#pragma unroll
        for (int j = 0; j < 8; ++j) v[j] = vn[j];
    }
}

typedef short bf16x8_t __attribute__((ext_vector_type(8)));
typedef float f32x4_t __attribute__((ext_vector_type(4)));
__device__ __forceinline__ bf16x8_t ldfrag(const char* base, int row, int chunk, int rb, int sm) { return *(const bf16x8_t*)(base + row * rb + ((chunk ^ (row & sm)) << 4)); }
__device__ __forceinline__ void ph_gmlp2(const Params& p, int bid, int nb, float* lds) {
    char* WM = (char*)lds; char* VT = WM + 32768;
    const int tid = tid_(), wave = tid >> 6, lane = tid & 63, fr = lane & 15, fq = lane >> 4;
    int gl = -1;
    for (int it = bid; it < 512; it += nb) {
        const int g = it & 7, n = (it >> 3) & 31, b = it >> 8;
        const int tok0 = b * SQ + n * 128;
        __syncthreads();
        if (g != gl) {
            for (int u = tid; u < 2048; u += NTH) {
                const int i = u >> 4, c = u & 15;
                const float4* src = (const float4*)(p.gm_ws + (size_t)g * 16384 + i * 128 + c * 8);
                float4 a = src[0], b4 = src[1];
                if ((i >> 6) < (c >> 3)) { a = make_float4(0.f, 0.f, 0.f, 0.f); b4 = a; }
                *(uint4*)(WM + i * 256 + ((c ^ (i & 15)) << 4)) = make_uint4(pk2(a.x, a.y), pk2(a.z, a.w), pk2(b4.x, b4.y), pk2(b4.z, b4.w));
            }
            gl = g;
        }
        {
            const float2 gn = *(const float2*)(p.gm_v_g + g * 128 + lane * 2);
#pragma unroll 4
            for (int jj = 0; jj < 16; ++jj) {
                const int j = wave * 16 + jj;
                const unsigned w = *(const unsigned*)(p.ZG + (size_t)(tok0 + j) * ZW + 1024 + g * 128 + lane * 2);
                const float a = bflo(w), c2 = bfhi(w);
                const float ss = wave_sum(a * a + c2 * c2);
                const float rs = 1.0f / sqrtf(ss * (1.0f / 128.0f) + 1e-6f);
                const int d0 = lane * 2, d1 = d0 + 1;
                *(bf16_t*)(VT + d0 * 256 + (((j >> 3) ^ (d0 & 15)) << 4) + (j & 7) * 2) = (bf16_t)f2bf(a * rs * gn.x);
                *(bf16_t*)(VT + d1 * 256 + (((j >> 3) ^ (d1 & 15)) << 4) + (j & 7) * 2) = (bf16_t)f2bf(c2 * rs * gn.y);
            }
        }
        __syncthreads();
        {
            bf16x8_t A[4];
#pragma unroll
            for (int ks = 0; ks < 4; ++ks) A[ks] = ldfrag(VT, wave * 16 + fr, ks * 4 + fq, 256, 15);
            const int d0 = wave * 16 + fq * 4;
#pragma unroll
            for (int itl = 0; itl < 8; ++itl) {
                f32x4_t acc = {0.f, 0.f, 0.f, 0.f};
#pragma unroll
                for (int ks = 0; ks < 4; ++ks) if (itl >= 4 || ks < 2) acc = __builtin_amdgcn_mfma_f32_16x16x32_bf16(A[ks], ldfrag(WM, itl * 16 + fr, ks * 4 + fq, 256, 15), acc, 0, 0, 0);
                const int i = itl * 16 + fr;
                const float bias = p.gm_b[g * 128 + i];
                const size_t tok = (size_t)(tok0 + i);
                const uint2 uw = *(const uint2*)(p.ZG + tok * ZW + g * 128 + d0);
                *(uint2*)(p.yain + tok * 1024 + g * 128 + d0) = make_uint2(pk2(bflo(uw.x) * (acc[0] + bias), bfhi(uw.x) * (acc[1] + bias)), pk2(bflo(uw.y) * (acc[2] + bias), bfhi(uw.y) * (acc[3] + bias)));
            }
        }
    }
    __syncthreads();
}

__device__ __forceinline__ void ph_ret(const Params& p, int bid, int nb, float* lds) {
    float* Qs = lds;
    float* Ks = Qs + 64 * 129;
    float* Vs = Ks + 64 * 129;
    float* Ss = Vs + 64 * 16;
    float* At = Ss + 128 * 16;
    float* kd = At + 64 * 65;
    const int tid = tid_();
    const bf16_t* z = p.ZG;
    for (int it = bid; it < 256; it += nb) {
        const int vs = it & 15, h = (it >> 4) & 7, b = it >> 7;
        const float lg = log1pf(-exp2f(-5.0f - (float)h));
        const float cdec = expf(lg * 64.0f);
        __syncthreads();
        for (int i = tid; i < 2048; i += NTH) Ss[i] = 0.f;
        if (tid < 64) kd[tid] = expf(lg * (float)(63 - tid));
        for (int n = 0; n < 64; ++n) {
            const int tok0 = b * SQ + n * 64;
            __syncthreads();
            for (int e = tid; e < 4096; e += NTH) {
                const int i = e >> 6, dd = e & 63; const size_t tok = (size_t)(tok0 + i);
                const float cs = p.rope[(tok * 64 + dd) * 2], sn = p.rope[(tok * 64 + dd) * 2 + 1];
                const bf16_t* zr = z + tok * ZW;
                const float q1 = bf2f(zr[2048 + h * 128 + dd]), q2 = bf2f(zr[2048 + h * 128 + 64 + dd]);
                const float k1 = bf2f(zr[3072 + h * 128 + dd]), k2 = bf2f(zr[3072 + h * 128 + 64 + dd]);
                Qs[i * 129 + dd] = q1 * cs - q2 * sn; Qs[i * 129 + 64 + dd] = q1 * sn + q2 * cs;
                const float sc = 0.08838834764831845f;
                Ks[i * 129 + dd] = (k1 * cs - k2 * sn) * sc; Ks[i * 129 + 64 + dd] = (k1 * sn + k2 * cs) * sc;
            }
            for (int e = tid; e < 1024; e += NTH) { const int j = e >> 4, v = e & 15; Vs[e] = bf2f(z[(size_t)(tok0 + j) * ZW + 4096 + h * 256 + vs * 16 + v]); }
            __syncthreads();
            {
                const int j = tid & 63, i0 = (tid >> 6) * 8;
                float acc[8];
#pragma unroll
                for (int ii = 0; ii < 8; ++ii) acc[ii] = 0.f;
                for (int d = 0; d < 128; ++d) {
                    const float kv = Ks[j * 129 + d];
#pragma unroll
                    for (int ii = 0; ii < 8; ++ii) acc[ii] += Qs[(i0 + ii) * 129 + d] * kv;
                }
#pragma unroll
                for (int ii = 0; ii < 8; ++ii) { const int i = i0 + ii; At[i * 65 + j] = acc[ii] * expf(lg * fabsf((float)(i - j))); }
            }
            __syncthreads();
            {
                const int v = tid & 15, i0 = tid >> 4;
#pragma unroll
                for (int rep = 0; rep < 2; ++rep) {
                    const int i = i0 + 32 * rep;
                    float a = 0.f; for (int j = 0; j < 64; ++j) a += At[i * 65 + j] * Vs[j * 16 + v];
                    float c2 = 0.f; for (int d = 0; d < 128; ++d) c2 += Qs[i * 129 + d] * Ss[d * 16 + v];
                    p.obuf[(size_t)(tok0 + i) * DM + h * 256 + vs * 16 + v] = a + c2 * expf(lg * (float)(i + 1));
                }
            }
            __syncthreads();
            {
                const int v = tid & 15, d0 = tid >> 4;
#pragma unroll
                for (int rep = 0; rep < 4; ++rep) {
                    const int d = d0 + 32 * rep;
                    float a = 0.f; for (int j = 0; j < 64; ++j) a += Ks[j * 129 + d] * kd[j] * Vs[j * 16 + v];
                    Ss[d * 16 + v] = Ss[d * 16 + v] * cdec + a;
                }
            }
        }
    }
    __syncthreads();
}


__device__ __forceinline__ void ph_retprep(const Params& p, int bid, int nb, float* lds) {
    bf16_t* Kl = (bf16_t*)lds;
    bf16_t* Vl = Kl + 64 * 130;
    char* Qm = (char*)lds + 49664;
    char* Km = Qm + 16384;
    const int tid = tid_(), wave = tid >> 6, lane = tid & 63, fr = lane & 15, fq = lane >> 4;
    for (int it = bid; it < 1024; it += nb) {
        const int n = it & 63, h = (it >> 6) & 7, b = it >> 9;
        const int tok0 = b * SQ + n * 64;
        const size_t rowbase = (size_t)(b * 8 + h) * SQ + n * 64;
        const float lg = log1pf(-exp2f(-5.0f - (float)h));
        __syncthreads();
#pragma unroll
        for (int k = 0; k < 2; ++k) {
            const int u = tid + 512 * k, i = u >> 4, dd = (u & 15) * 4; const size_t tok = (size_t)(tok0 + i);
            const float4 r0 = *(const float4*)(p.rope + (tok * 64 + dd) * 2), r1 = *(const float4*)(p.rope + (tok * 64 + dd) * 2 + 4);
            const float cs[4] = {r0.x, r0.z, r1.x, r1.z}, sn[4] = {r0.y, r0.w, r1.y, r1.w};
            const bf16_t* zr = p.ZG + tok * ZW;
            const uint2 q1w = *(const uint2*)(zr + 2048 + h * 128 + dd), q2w = *(const uint2*)(zr + 2048 + h * 128 + 64 + dd);
            const uint2 k1w = *(const uint2*)(zr + 3072 + h * 128 + dd), k2w = *(const uint2*)(zr + 3072 + h * 128 + 64 + dd);
            const float q1[4] = {bflo(q1w.x), bfhi(q1w.x), bflo(q1w.y), bfhi(q1w.y)}, q2[4] = {bflo(q2w.x), bfhi(q2w.x), bflo(q2w.y), bfhi(q2w.y)};
            const float k1[4] = {bflo(k1w.x), bfhi(k1w.x), bflo(k1w.y), bfhi(k1w.y)}, k2[4] = {bflo(k2w.x), bfhi(k2w.x), bflo(k2w.y), bfhi(k2w.y)};
            const float sc = 0.08838834764831845f, kd = expf(lg * (float)(63 - i));
            float qa[4], qb[4], ka[4], kb[4];
#pragma unroll
            for (int e = 0; e < 4; ++e) { qa[e] = q1[e] * cs[e] - q2[e] * sn[e]; qb[e] = q1[e] * sn[e] + q2[e] * cs[e]; ka[e] = (k1[e] * cs[e] - k2[e] * sn[e]) * sc; kb[e] = (k1[e] * sn[e] + k2[e] * cs[e]) * sc; }
            const uint2 qaw = make_uint2(pk2(qa[0], qa[1]), pk2(qa[2], qa[3])), qbw = make_uint2(pk2(qb[0], qb[1]), pk2(qb[2], qb[3]));
            const uint2 kaw = make_uint2(pk2(ka[0], ka[1]), pk2(ka[2], ka[3])), kbw = make_uint2(pk2(kb[0], kb[1]), pk2(kb[2], kb[3]));
            *(uint2*)(p.Qr + (rowbase + i) * 128 + dd) = qaw; *(uint2*)(p.Qr + (rowbase + i) * 128 + 64 + dd) = qbw;
            const int c = dd >> 3, o8 = (dd & 7) * 2;
            *(uint2*)(Qm + i * 256 + ((c ^ (i & 15)) << 4) + o8) = qaw; *(uint2*)(Qm + i * 256 + (((c + 8) ^ (i & 15)) << 4) + o8) = qbw;
            *(uint2*)(Km + i * 256 + ((c ^ (i & 15)) << 4) + o8) = kaw; *(uint2*)(Km + i * 256 + (((c + 8) ^ (i & 15)) << 4) + o8) = kbw;
            *(unsigned*)(Kl + i * 130 + dd) = pk2(ka[0] * kd, ka[1] * kd); *(unsigned*)(Kl + i * 130 + dd + 2) = pk2(ka[2] * kd, ka[3] * kd);
            *(unsigned*)(Kl + i * 130 + 64 + dd) = pk2(kb[0] * kd, kb[1] * kd); *(unsigned*)(Kl + i * 130 + 64 + dd + 2) = pk2(kb[2] * kd, kb[3] * kd);
        }
#pragma unroll
        for (int k = 0; k < 4; ++k) {
            const int u = tid + 512 * k, j = u >> 5, c = u & 31;
            const uint4 w = *(const uint4*)(p.ZG + (size_t)(tok0 + j) * ZW + 4096 + h * 256 + c * 8);
            unsigned* d = (unsigned*)(Vl + j * 258 + c * 8); d[0] = w.x; d[1] = w.y; d[2] = w.z; d[3] = w.w;
        }
        __syncthreads();
        {
            const int jt = wave >> 1, it0 = 2 * (wave & 1);
            f32x4_t s0 = {0.f, 0.f, 0.f, 0.f}, s1 = {0.f, 0.f, 0.f, 0.f};
#pragma unroll
            for (int ks = 0; ks < 4; ++ks) {
                const bf16x8_t a = ldfrag(Km, jt * 16 + fr, ks * 4 + fq, 256, 15);
                const bf16x8_t b0 = ldfrag(Qm, it0 * 16 + fr, ks * 4 + fq, 256, 15), b1 = ldfrag(Qm, (it0 + 1) * 16 + fr, ks * 4 + fq, 256, 15);
                s0 = __builtin_amdgcn_mfma_f32_16x16x32_bf16(a, b0, s0, 0, 0, 0);
                s1 = __builtin_amdgcn_mfma_f32_16x16x32_bf16(a, b1, s1, 0, 0, 0);
            }
            const int j0 = jt * 16 + fq * 4;
            bf16_t* pg = p.Pm + (size_t)it * 4096;
#pragma unroll
            for (int tt = 0; tt < 2; ++tt) {
                const int i = (it0 + tt) * 16 + fr; const f32x4_t sv4 = tt ? s1 : s0; float pv[4];
#pragma unroll
                for (int r = 0; r < 4; ++r) pv[r] = sv4[r] * __expf(lg * fabsf((float)(i - (j0 + r))));
                *(uint2*)(pg + i * 64 + j0) = make_uint2(pk2(pv[0], pv[1]), pk2(pv[2], pv[3]));
            }
        }
        bf16_t* kt = p.KTd + (size_t)it * 8192;
#pragma unroll
        for (int k = 0; k < 2; ++k) {
            const int u = tid + 512 * k, jg = u & 7, d = u >> 3;
            unsigned w[4];
#pragma unroll
            for (int q = 0; q < 4; ++q) w[q] = (unsigned)Kl[(jg * 8 + 2 * q) * 130 + d] | ((unsigned)Kl[(jg * 8 + 2 * q + 1) * 130 + d] << 16);
            *(uint4*)(kt + d * 64 + jg * 8) = make_uint4(w[0], w[1], w[2], w[3]);
        }
        bf16_t* vt = p.Vt + (size_t)it * 16384;
#pragma unroll
        for (int k = 0; k < 4; ++k) {
            const int u = tid + 512 * k, jg = u & 7, v = u >> 3;
            unsigned w[4];
#pragma unroll
            for (int q = 0; q < 4; ++q) w[q] = (unsigned)Vl[(jg * 8 + 2 * q) * 258 + v] | ((unsigned)Vl[(jg * 8 + 2 * q + 1) * 258 + v] << 16);
            *(uint4*)(vt + v * 64 + jg * 8) = make_uint4(w[0], w[1], w[2], w[3]);
        }
    }
    __syncthreads();
}

__device__ __forceinline__ void ph_ret2(const Params& p, int bid, int nb, float* lds) {
    char* L = (char*)lds;
    constexpr int OQ = 0, OKT = 16384, OPP = 32768, OVT = 40960, TILE = 43008, OST = 2 * TILE;
    const int tid = tid_(), wave = tid >> 6, lane = tid & 63, fr = lane & 15, fq = lane >> 4;
    for (int it = bid; it < 256; it += nb) {
        const int itm = ((it & 7) * 2 + (it >> 7)) * 16 + ((it >> 3) & 15);
        const int vs = itm & 15, h = (itm >> 4) & 7, b = itm >> 7;
        const float lg = log1pf(-exp2f(-5.0f - (float)h));
        const float cdec = expf(lg * 64.0f);
        const size_t bh = (size_t)(b * 8 + h);
        const char* gQ = (const char*)(p.Qr + bh * SQ * 128);
        const char* gKT = (const char*)(p.KTd + bh * 64 * 8192);
        const char* gP = (const char*)(p.Pm + bh * 64 * 4096);
        const char* gVt = (const char*)(p.Vt + bh * 64 * 16384) + vs * 16 * 128;
        int lq[2], lkt[2];
#pragma unroll
        for (int u = 0; u < 2; ++u) { const int ci = tid + 512 * u; const int r = ci >> 4, c = ci & 15; lq[u] = r * 256 + ((c ^ (r & 15)) << 4); const int d = ci >> 3, c8 = ci & 7; lkt[u] = d * 128 + ((c8 ^ (d & 7)) << 4); }
        const int lp = (tid >> 3) * 128 + (((tid & 7) ^ ((tid >> 3) & 7)) << 4);
        const int lv = lp;
        uint4 qA0, qA1, tA0, tA1, pA, vA = make_uint4(0u, 0u, 0u, 0u), qB0, qB1, tB0, tB1, pB, vB = vA, qC0, qC1, tC0, tC1, pC, vC = vA, qD0, qD1, tD0, tD1, pD, vD = vA;
#define RET_LOAD(X_, n_) do { const size_t o0 = (size_t)(n_) * 16384 + (size_t)tid * 16, o1 = o0 + 8192; \
        q##X_##0 = *(const uint4*)(gQ + o0); q##X_##1 = *(const uint4*)(gQ + o1); t##X_##0 = *(const uint4*)(gKT + o0); t##X_##1 = *(const uint4*)(gKT + o1); p##X_ = *(const uint4*)(gP + (size_t)(n_) * 8192 + tid * 16); \
        if (tid < 128) v##X_ = *(const uint4*)(gVt + (size_t)(n_) * 32768 + tid * 16); } while (0)
#define RET_WRITE(X_, buf_) do { char* B_ = L + (buf_) * TILE; \
        *(uint4*)(B_ + OQ + lq[0]) = q##X_##0; *(uint4*)(B_ + OQ + lq[1]) = q##X_##1; *(uint4*)(B_ + OKT + lkt[0]) = t##X_##0; *(uint4*)(B_ + OKT + lkt[1]) = t##X_##1; *(uint4*)(B_ + OPP + lp) = p##X_; \
        if (tid < 128) *(uint4*)(B_ + OVT + lv) = v##X_; } while (0)
        __syncthreads();
        for (int i = tid; i < 1024; i += NTH) ((unsigned*)(L + OST))[i] = 0u;
        RET_LOAD(A, 0); RET_WRITE(A, 0); RET_LOAD(B, 1); RET_LOAD(C, 2); RET_LOAD(D, 3);
        f32x4_t sacc[2] = {{0.f, 0.f, 0.f, 0.f}, {0.f, 0.f, 0.f, 0.f}};
#define RET_STEP(n_, cur_, LS_, WS_) do { const int n = (n_); constexpr int cur = (cur_); \
            __syncthreads();                                     \
            if (n + 4 < 64) RET_LOAD(LS_, n + 4); \
            const char* T = L + cur * TILE; \
            if (wave < 4) {     \
                const int itl = wave; \
                f32x4_t o1 = {0.f, 0.f, 0.f, 0.f}, o2 = {0.f, 0.f, 0.f, 0.f}; \
                _Pragma("unroll") for (int ks = 0; ks < 2; ++ks) o1 = __builtin_amdgcn_mfma_f32_16x16x32_bf16(ldfrag(T + OPP, itl * 16 + fr, ks * 4 + fq, 128, 7), ldfrag(T + OVT, fr, ks * 4 + fq, 128, 7), o1, 0, 0, 0); \
                _Pragma("unroll") for (int ks = 0; ks < 4; ++ks) o2 = __builtin_amdgcn_mfma_f32_16x16x32_bf16(ldfrag(T + OQ, itl * 16 + fr, ks * 4 + fq, 256, 15), ldfrag(L + OST + cur * 4096, fr, ks * 4 + fq, 256, 15), o2, 0, 0, 0); \
                _Pragma("unroll") for (int r = 0; r < 4; ++r) { const int i = itl * 16 + fq * 4 + r; \
                    p.ob16[(size_t)(b * SQ + n * 64 + i) * DM + h * 256 + vs * 16 + fr] = (bf16_t)f2bf(o1[r] + __expf(lg * (float)(i + 1)) * o2[r]); } \
            } else {            \
                _Pragma("unroll") for (int u = 0; u < 2; ++u) { \
                    const int dt = 2 * (wave - 4) + u; \
                    sacc[u] = sacc[u] * cdec; \
                    _Pragma("unroll") for (int ks = 0; ks < 2; ++ks) sacc[u] = __builtin_amdgcn_mfma_f32_16x16x32_bf16(ldfrag(T + OKT, dt * 16 + fr, ks * 4 + fq, 128, 7), ldfrag(T + OVT, fr, ks * 4 + fq, 128, 7), sacc[u], 0, 0, 0); \
                    *(uint2*)(L + OST + (cur ^ 1) * 4096 + fr * 256 + (((dt * 2 + (fq >> 1)) ^ fr) << 4) + (fq & 1) * 8) = make_uint2(pk2(sacc[u][0], sacc[u][1]), pk2(sacc[u][2], sacc[u][3])); } \
            } \
            if (n + 1 < 64) RET_WRITE(WS_, cur ^ 1); } while (0)
#pragma unroll 1
        for (int n4 = 0; n4 < 64; n4 += 4) { RET_STEP(n4, 0, A, B); RET_STEP(n4 + 1, 1, B, C); RET_STEP(n4 + 2, 0, C, D); RET_STEP(n4 + 3, 1, D, A); }
#undef RET_STEP
#undef RET_LOAD
#undef RET_WRITE
    }
    __syncthreads();
}

__device__ __forceinline__ void gn_load(const Params& p, int tok, int lane, uint2 (&ow)[8], uint2 (&gw)[8]) {
#pragma unroll
    for (int h = 0; h < 8; ++h) { ow[h] = *(const uint2*)(p.ob16 + (size_t)tok * DM + h * 256 + lane * 4); gw[h] = *(const uint2*)(p.ZG + (size_t)tok * ZW + 6144 + h * 256 + lane * 4); }
}
__device__ __forceinline__ void ph_gn(const Params& p, int bid, int nb, float* lds) {
    const int tid = tid_(), wave = tid >> 6, lane = tid & 63;
    const int stride = nb * 8;
    int tok = bid * 8 + wave;
    uint2 ow[8], gw[8], own[8], gwn[8];
    if (tok < NTOK) gn_load(p, tok, lane, ow, gw);
    for (; tok < NTOK; tok += stride) {
        if (tok + stride < NTOK) gn_load(p, tok + stride, lane, own, gwn);
        float4 o[8]; float s1[8], s2[8];
#pragma unroll
        for (int h = 0; h < 8; ++h) { o[h] = make_float4(bflo(ow[h].x), bfhi(ow[h].x), bflo(ow[h].y), bfhi(ow[h].y)); s1[h] = (o[h].x + o[h].y) + (o[h].z + o[h].w); }
#pragma unroll
        for (int h = 0; h < 8; ++h) s1[h] = row_sum16(s1[h]);
#pragma unroll
        for (int h = 0; h < 8; ++h) s1[h] = xsum32(xsum16(s1[h]));
#pragma unroll
        for (int h = 0; h < 8; ++h) { const float mu = s1[h] * (1.0f / 256.0f); o[h].x -= mu; o[h].y -= mu; o[h].z -= mu; o[h].w -= mu; s2[h] = dot4(o[h], o[h]); }
#pragma unroll
        for (int h = 0; h < 8; ++h) s2[h] = row_sum16(s2[h]);
#pragma unroll
        for (int h = 0; h < 8; ++h) s2[h] = xsum32(xsum16(s2[h]));
#pragma unroll
        for (int h = 0; h < 8; ++h) {
            const float rs = 1.0f / sqrtf(s2[h] * (1.0f / 256.0f) + 1e-6f);
            const float4 gn = *(const float4*)(p.ret_gn_g + h * 256 + lane * 4);
            const float g0 = bflo(gw[h].x), g1 = bfhi(gw[h].x), g2 = bflo(gw[h].y), g3 = bfhi(gw[h].y);
            st_wt8(p.ybin + (size_t)tok * DM + h * 256 + lane * 4,
                make_uint2(pk2(siluf_(g0) * o[h].x * rs * gn.x, siluf_(g1) * o[h].y * rs * gn.y), pk2(siluf_(g2) * o[h].z * rs * gn.z, siluf_(g3) * o[h].w * rs * gn.w)));
        }
#pragma unroll
        for (int h = 0; h < 8; ++h) { ow[h] = own[h]; gw[h] = gwn[h]; }
    }
}

__device__ __forceinline__ void split8(const float4 a, const float4 b, uint4& hi, uint4& lo) {
    const float x[8] = {a.x, a.y, a.z, a.w, b.x, b.y, b.z, b.w}; unsigned h[8], l[8];
#pragma unroll
    for (int i = 0; i < 8; ++i) { h[i] = f2bf(x[i]); l[i] = f2bf(x[i] - __uint_as_float(h[i] << 16)); }
    hi = make_uint4(h[0] | (h[1] << 16), h[2] | (h[3] << 16), h[4] | (h[5] << 16), h[6] | (h[7] << 16));
    lo = make_uint4(l[0] | (l[1] << 16), l[2] | (l[3] << 16), l[4] | (l[5] << 16), l[6] | (l[7] << 16));
}
__device__ __forceinline__ bf16x8_t as_bf16x8(const uint4 v) { return __builtin_bit_cast(bf16x8_t, v); }
struct PairTab { int a[52], b[52]; };
__host__ __device__ constexpr PairTab make_pairs() {
    PairTab t{}; int n = 0;
    for (int a = 0; a < 16; ++a) for (int b = 0; b < 16; ++b) if ((a + 1) * (b + 1) <= 16) { t.a[n] = a; t.b[n] = b; ++n; }
    for (; n < 52; ++n) { t.a[n] = -1; t.b[n] = -1; }
    return t;
}
constexpr PairTab PAIRS = make_pairs();
static_assert(PAIRS.a[49] >= 0 && PAIRS.a[50] < 0, "50 candidate pairs");

template <int N, int OFF> __device__ __forceinline__ void bitonic_sort_desc(float* v) {
#pragma unroll
    for (int k = 2; k <= N; k <<= 1)
#pragma unroll
        for (int j = k >> 1; j > 0; j >>= 1)
#pragma unroll
            for (int i = 0; i < N; ++i) { const int l = i ^ j; if (l > i) { const bool up = ((i & k) == 0);
                const float a = v[OFF + i], b = v[OFF + l]; const float mx = fmaxf(a, b), mn = fminf(a, b); v[OFF + i] = up ? mx : mn; v[OFF + l] = up ? mn : mx; } }
}
template <int N> __device__ __forceinline__ void bitonic_merge_desc(float* v) {
#pragma unroll
    for (int j = N >> 1; j > 0; j >>= 1)
#pragma unroll
        for (int i = 0; i < N; ++i) { const int l = i ^ j; if (l > i) { const float a = v[i], b = v[l]; v[i] = fmaxf(a, b); v[l] = fminf(a, b); } }
}
__device__ __forceinline__ void ph_topk2(const Params& p, const float* qb, int bid, int nb, float* lds, int it_fixed) {
    const int tid = tid_(), wave = tid >> 6, lane = tid & 63;
    uint4* SK = (uint4*)lds;
    const float NEG = -INFINITY;
    const bool tc_on = (nb == 256); const int tcr0 = (bid * 8 + wave) * 16; float4 tct[8];
    if (tc_on) tc_load(p, tcr0, lane, tct);
    for (int it = (it_fixed >= 0 ? it_fixed : bid); it < 256; it += (it_fixed >= 0 ? 256 : nb)) {
        const int h = it & 7, tg = it >> 3;
        __syncthreads();
        for (int gi = tid; gi < 4096; gi += NTH) {
            const int dq = gi & 15, n = (gi >> 4) & 127, pp = gi >> 11;
            const float4* src = (const float4*)(p.peer_sk + ((size_t)(h * 2 + pp) * 128 + n) * 128 + dq * 8);
            uint4 hi, lo; split8(src[0], src[1], hi, lo);
            const int base = (((pp * 8 + (n >> 4)) * 4 + (dq >> 2)) * 2) * 64 + (dq & 3) * 16 + (n & 15);
            SK[base] = hi; SK[base + 64] = lo;
        }
        __syncthreads();
#pragma unroll 1
        for (int tile = 0; tile < 2; ++tile) {
            const int tok = tg * 256 + wave * 32 + tile * 16 + (lane & 15);
            const int qd = lane >> 4;
            float v12[2][16];
#pragma unroll
            for (int pp = 0; pp < 2; ++pp) {
                if (tc_on) { const int ti = tile * 8 + pp * 4; tc_finish(p, tcr0 + ti, lane, tct); tc_load(p, tcr0 + ti + 1, lane, tct); }
                bf16x8_t Bh[4], Bl[4];
                const float* qp = qb + (size_t)tok * DM + h * 256 + pp * 128 + 8 * qd;
#pragma unroll
                for (int ks = 0; ks < 4; ++ks) { uint4 hi, lo; split8(*(const float4*)(qp + ks * 32), *(const float4*)(qp + ks * 32 + 4), hi, lo); Bh[ks] = as_bf16x8(hi); Bl[ks] = as_bf16x8(lo); }
                float v[32];
#pragma unroll
                for (int kt = 0; kt < 8; ++kt) {
                    f32x4_t acc = {0.f, 0.f, 0.f, 0.f};
#pragma unroll
                    for (int ks = 0; ks < 4; ++ks) {
                        const bf16x8_t Ah = as_bf16x8(SK[(((pp * 8 + kt) * 4 + ks) * 2) * 64 + lane]), Al = as_bf16x8(SK[(((pp * 8 + kt) * 4 + ks) * 2 + 1) * 64 + lane]);
                        acc = __builtin_amdgcn_mfma_f32_16x16x32_bf16(Ah, Bh[ks], acc, 0, 0, 0);
                        acc = __builtin_amdgcn_mfma_f32_16x16x32_bf16(Ah, Bl[ks], acc, 0, 0, 0);
                        acc = __builtin_amdgcn_mfma_f32_16x16x32_bf16(Al, Bh[ks], acc, 0, 0, 0);
                    }
#pragma unroll
                    for (int r = 0; r < 4; ++r) v[kt * 4 + r] = __uint_as_float((__float_as_uint(acc[r]) & ~127u) | (unsigned)(kt * 16 + qd * 4 + r));
                    __builtin_amdgcn_sched_barrier(0);
                }
                if (tc_on) { const int ti = tile * 8 + pp * 4 + 1; tc_finish(p, tcr0 + ti, lane, tct); tc_load(p, tcr0 + ti + 1, lane, tct); }
                bitonic_sort_desc<16, 0>(v); bitonic_sort_desc<16, 16>(v);
                float c16[16];
#pragma unroll
                for (int i = 0; i < 16; ++i) c16[i] = fmaxf(v[i], v[31 - i]);
                bitonic_merge_desc<16>(c16);
                if (tc_on) { const int ti = tile * 8 + pp * 4 + 2; tc_finish(p, tcr0 + ti, lane, tct); tc_load(p, tcr0 + ti + 1, lane, tct); }
#pragma unroll
                for (int st = 0; st < 2; ++st) {
                    float pr[16];
#pragma unroll
                    for (int i = 0; i < 16; ++i) pr[i] = __shfl_xor(c16[i], 16 << st);
#pragma unroll
                    for (int i = 0; i < 16; ++i) c16[i] = fmaxf(c16[i], pr[15 - i]);
                    bitonic_merge_desc<16>(c16);
                }
                if (tc_on) { const int ti = tile * 8 + pp * 4 + 3; tc_finish(p, tcr0 + ti, lane, tct); if (ti < 15) tc_load(p, tcr0 + ti + 1, lane, tct); }
#pragma unroll
                for (int i = 0; i < 16; ++i) v12[pp][i] = c16[i];
            }
            float c[13]; unsigned pay[13];
#pragma unroll
            for (int s = 0; s < 13; ++s) {
                float cq[4]; unsigned pq[4];
#pragma unroll
                for (int q = 0; q < 4; ++q) {
                    const int pi = 4 * s + q; const int a = PAIRS.a[pi], b = PAIRS.b[pi];
                    if (a >= 0) {
                        const float sum = v12[0][a] + v12[1][b];
                        cq[q] = __uint_as_float((__float_as_uint(sum) & ~63u) | (unsigned)pi);
                        pq[q] = (__float_as_uint(v12[0][a]) & 127u) * 128u + (__float_as_uint(v12[1][b]) & 127u);
                    } else { cq[q] = NEG; pq[q] = 0u; }
                }
                c[s] = qd == 0 ? cq[0] : qd == 1 ? cq[1] : qd == 2 ? cq[2] : cq[3];
                pay[s] = qd == 0 ? pq[0] : qd == 1 ? pq[1] : qd == 2 ? pq[2] : pq[3];
            }
            float top[16]; unsigned eid[16];
#pragma unroll
            for (int r = 0; r < 16; ++r) {
                float m = c[0];
#pragma unroll
                for (int s = 1; s < 13; ++s) m = fmaxf(m, c[s]);
                m = fmaxf(m, __shfl_xor(m, 16)); m = fmaxf(m, __shfl_xor(m, 32));
                unsigned pw = 0u;
#pragma unroll
                for (int s = 0; s < 13; ++s) { const bool eq = (c[s] == m); pw |= eq ? pay[s] : 0u; c[s] = eq ? NEG : c[s]; }
                pw |= (unsigned)__shfl_xor((int)pw, 16); pw |= (unsigned)__shfl_xor((int)pw, 32);
                top[r] = m; eid[r] = pw;
            }
            float sum = 0.f; const float mx = top[0];
#pragma unroll
            for (int r = 0; r < 16; ++r) { top[r] = expf(top[r] - mx); sum += top[r]; }
            const float inv = 1.0f / sum;
            if (lane < 16) {
                int4* ep = (int4*)(p.eidx + (size_t)tok * 128 + h * 16); float4* gp = (float4*)(p.gatev + (size_t)tok * 128 + h * 16);
#pragma unroll
                for (int q = 0; q < 4; ++q) {
                    ep[q] = make_int4((int)eid[4 * q], (int)eid[4 * q + 1], (int)eid[4 * q + 2], (int)eid[4 * q + 3]);
                    gp[q] = make_float4(top[4 * q] * inv, top[4 * q + 1] * inv, top[4 * q + 2] * inv, top[4 * q + 3] * inv);
                }
            }
        }
    }
    __syncthreads();
}

__device__ __forceinline__ void peer_load4(const unsigned char* tab, const int (&e)[4], int lane, uint2 (&R)[4][3]) {
#pragma unroll
    for (int i = 0; i < 4; ++i) { const uint2* r = (const uint2*)(tab + (size_t)e[i] * ROW6 + lane * 8); R[i][0] = r[0]; R[i][1] = r[64]; R[i][2] = r[128]; }
}
__device__ __forceinline__ f32x32_t dec6(const uint2 (&R)[3]) { const u32x6_t w = {R[0].x, R[0].y, R[1].x, R[1].y, R[2].x, R[2].y}; return __builtin_amdgcn_cvt_scalef32_pk32_f32_fp6(w, 1.0f); }
typedef float f32x2_t __attribute__((ext_vector_type(2)));
__device__ __forceinline__ bf16x8_t dec4_frag(unsigned w) {
    const unsigned a = __builtin_bit_cast(unsigned, __builtin_amdgcn_cvt_scalef32_pk_bf16_fp4(w, 1.0f, 0)), b = __builtin_bit_cast(unsigned, __builtin_amdgcn_cvt_scalef32_pk_bf16_fp4(w, 1.0f, 1));
    const unsigned c = __builtin_bit_cast(unsigned, __builtin_amdgcn_cvt_scalef32_pk_bf16_fp4(w, 1.0f, 2)), d = __builtin_bit_cast(unsigned, __builtin_amdgcn_cvt_scalef32_pk_bf16_fp4(w, 1.0f, 3));
    return as_bf16x8(make_uint4(a, b, c, d));
}
__device__ __forceinline__ void peer_vgroup(const Params& p, int lane, const uint4 (&Vc)[4], const float (&wgt)[4], f32x2_t (&y2)[16]) {
#pragma unroll
    for (int i = 0; i < 4; ++i) {
        const f32x2_t w2 = {wgt[i], wgt[i]};
        const unsigned vw[4] = {Vc[i].x, Vc[i].y, Vc[i].z, Vc[i].w};
#pragma unroll
        for (int j = 0; j < 4; ++j) {
            y2[4 * j + 0] += w2 * __builtin_amdgcn_cvt_scalef32_pk_f32_fp4(vw[j], 1.0f, 0);
            y2[4 * j + 1] += w2 * __builtin_amdgcn_cvt_scalef32_pk_f32_fp4(vw[j], 1.0f, 1);
            y2[4 * j + 2] += w2 * __builtin_amdgcn_cvt_scalef32_pk_f32_fp4(vw[j], 1.0f, 2);
            y2[4 * j + 3] += w2 * __builtin_amdgcn_cvt_scalef32_pk_f32_fp4(vw[j], 1.0f, 3);
        }
    }
}
__device__ __forceinline__ void ph_peer6(const Params& p, const float* x1, const bf16_t* h2, int bid, int nb, float* lds) {
    const int tid = tid_(), wave = tid >> 6, lane0 = tid & 63;
    for (int t = bid * 8 + wave; t < NTOK; t += nb * 8) {
        int lane = lane0; asm volatile("" : "+v"(lane));
        const int fr = lane & 15, kq = lane >> 4;
        char* HL = (char*)lds + wave * 4608;
        float* WL = (float*)(HL + 4096);
        const int b = t / SQ;
#pragma unroll
        for (int q = 0; q < 4; ++q) *(uint4*)(HL + (lane + 64 * q) * 16) = *(const uint4*)(h2 + (size_t)t * DM + (lane + 64 * q) * 8);
        const int e0 = p.eidx[(size_t)t * 128 + lane], e1 = p.eidx[(size_t)t * 128 + 64 + lane];
        const float su0 = p.su[e0], su1 = p.su[e1];
        const float gv0 = p.gatev[(size_t)t * 128 + lane] * p.sv[e0], gv1 = p.gatev[(size_t)t * 128 + 64 + lane] * p.sv[e1];
        unsigned ur[8];
#pragma unroll
        for (int G = 0; G < 8; ++G) ur[G] = (unsigned)__shfl(G < 4 ? e0 : e1, 16 * (G & 3) + fr) * (unsigned)ROW4 + (unsigned)kq * 16u;
        f32x4_t acc[8];
#pragma unroll
        for (int G = 0; G < 8; ++G) acc[G] = (f32x4_t){0.f, 0.f, 0.f, 0.f};
        uint4 Ac[8];
#pragma unroll
        for (int G = 0; G < 8; ++G) Ac[G] = *(const uint4*)(p.U8 + ur[G]);
#pragma unroll 1
        for (int blk = 0; blk < 16; ++blk) {
            const unsigned nof = (unsigned)((blk < 15) ? blk + 1 : blk) * 64u;
            bf16x8_t B[4];
#pragma unroll
            for (int sidx = 0; sidx < 4; ++sidx) B[sidx] = *(const bf16x8_t*)(HL + (blk * 128 + sidx * 32 + kq * 8) * 2);
#pragma unroll
            for (int G = 0; G < 8; ++G) {
                const bf16x8_t f0 = dec4_frag(Ac[G].x), f1 = dec4_frag(Ac[G].y), f2 = dec4_frag(Ac[G].z), f3 = dec4_frag(Ac[G].w);
                Ac[G] = *(const uint4*)(p.U8 + (ur[G] + nof));
                acc[G] = __builtin_amdgcn_mfma_f32_16x16x32_bf16(f0, B[0], acc[G], 0, 0, 0);
                acc[G] = __builtin_amdgcn_mfma_f32_16x16x32_bf16(f1, B[1], acc[G], 0, 0, 0);
                acc[G] = __builtin_amdgcn_mfma_f32_16x16x32_bf16(f2, B[2], acc[G], 0, 0, 0);
                acc[G] = __builtin_amdgcn_mfma_f32_16x16x32_bf16(f3, B[3], acc[G], 0, 0, 0);
                __builtin_amdgcn_sched_barrier(0);
            }
        }
        const int kq4 = 4 * kq;
#pragma unroll
        for (int G = 0; G < 8; ++G) {
            float av[4];
#pragma unroll
            for (int j = 0; j < 4; ++j) av[j] = acc[G][j] * __shfl(G < 4 ? su0 : su1, (16 * (G & 3) + j) + kq4);
            const f32x2_t g01 = pg8::gelu_pk((f32x2_t){av[0], av[1]}), g23 = pg8::gelu_pk((f32x2_t){av[2], av[3]});
            const float w0 = g01.x * __shfl(G < 4 ? gv0 : gv1, (16 * (G & 3) + 0) + kq4), w1 = g01.y * __shfl(G < 4 ? gv0 : gv1, (16 * (G & 3) + 1) + kq4);
            const float w2_ = g23.x * __shfl(G < 4 ? gv0 : gv1, (16 * (G & 3) + 2) + kq4), w3 = g23.y * __shfl(G < 4 ? gv0 : gv1, (16 * (G & 3) + 3) + kq4);
            if (fr == 0) *(float4*)(WL + 16 * G + kq4) = make_float4(w0, w1, w2_, w3);
            __builtin_amdgcn_sched_barrier(0);
        }
        f32x2_t y2[16];
#pragma unroll
        for (int i = 0; i < 16; ++i) y2[i] = (f32x2_t){0.f, 0.f};
        uint4 Vc[4], Vn[4];
#pragma unroll
        for (int i = 0; i < 4; ++i) Vc[i] = *(const uint4*)(p.V8 + ((unsigned)__builtin_amdgcn_readlane(e0, i) * (unsigned)ROW4 + (unsigned)lane * 16u));
#pragma unroll
        for (int G = 0; G < 8; ++G) {
#pragma unroll 1
            for (int q = 0; q < 4; ++q) {
                {
                    const int gn = 4 * G + q + ((G == 7 && q == 3) ? 0 : 1); const int sn = 4 * gn;
                    const int en = (sn < 64) ? e0 : e1;
#pragma unroll
                    for (int i = 0; i < 4; ++i) Vn[i] = *(const uint4*)(p.V8 + ((unsigned)__builtin_amdgcn_readlane(en, (sn + i) & 63) * (unsigned)ROW4 + (unsigned)lane * 16u));
                }
                const float4 w4 = *(const float4*)(WL + 16 * G + 4 * q);
                const float wgt[4] = {w4.x, w4.y, w4.z, w4.w};
                peer_vgroup(p, lane, Vc, wgt, y2);
#pragma unroll
                for (int i = 0; i < 4; ++i) Vc[i] = Vn[i];
            }
        }
        float y[32];
#pragma unroll
        for (int k = 0; k < 16; ++k) { y[2 * k] = y2[k].x; y[2 * k + 1] = y2[k].y; }
        float ss = 0.f;
#pragma unroll
        for (int q = 0; q < 8; ++q) {
            const int c = 256 * q + lane * 4;
            const float4 xv = *(const float4*)(x1 + (size_t)t * DM + c);
            const float4 ga = *(const float4*)(p.ada + b * NMOD + 5 * DM + c);
            float* yy = y + 4 * q;
            yy[0] = xv.x + ga.x * yy[0]; yy[1] = xv.y + ga.y * yy[1]; yy[2] = xv.z + ga.z * yy[2]; yy[3] = xv.w + ga.w * yy[3];
            ss += yy[0] * yy[0] + yy[1] * yy[1] + yy[2] * yy[2] + yy[3] * yy[3];
        }
        ss = xsum32(xsum16(row_sum16(ss)));
        const float rs = 1.0f / sqrtf(ss * (1.0f / DM) + 1e-6f);
#pragma unroll
        for (int q = 0; q < 8; ++q) {
            const int c = 256 * q + lane * 4;
            const float4 gf = *(const float4*)(p.norm_f_g + c);
            const float* yy = y + 4 * q;
            *(float4*)(p.out + (size_t)t * DM + c) = make_float4(yy[0] * rs * gf.x, yy[1] * rs * gf.y, yy[2] * rs * gf.z, yy[3] * rs * gf.w);
        }
    }
}

#define LAS __attribute__((address_space(3)))
#define XB_TMO      128
#define XB_XCNT(j)  (256  + 64 * (j))
#define XB_XSUB(j)  (1280 + 64 * (j))
#define XB_XGEN(j)  (2304 + 64 * (j))
#define XB_TOP      3328
#define XB_TOPGEN   3392
#define XCD_BAR_WORDS 3456
#define XB_SPIN_CAP (1u << 18)

__device__ __forceinline__ unsigned xb_ld(unsigned* p)              { return __hip_atomic_load(p, __ATOMIC_RELAXED, __HIP_MEMORY_SCOPE_AGENT); }
__device__ __forceinline__ unsigned xb_add(unsigned* p, unsigned v) { return __hip_atomic_fetch_add(p, v, __ATOMIC_RELAXED, __HIP_MEMORY_SCOPE_AGENT); }
__device__ __forceinline__ unsigned xb_xcc_id() { return (unsigned)__builtin_amdgcn_s_getreg((3 << 11) | 20) & 0xFu; }
#define XB_SPIN(cond, bar) do { unsigned _sp = 0; while (cond) { __builtin_amdgcn_s_sleep(1); \
    if ((++_sp & 255u) == 0u) { if (xb_ld(&(bar)[XB_TMO])) break; if (_sp > XB_SPIN_CAP) { atomicAdd(&(bar)[XB_TMO], 1u); break; } } } } while (0)

struct XcdBarrier {
    unsigned* bar; unsigned x;
    volatile LAS unsigned* st;
};

__device__ __forceinline__ XcdBarrier xcd_barrier_post(unsigned* bar, volatile LAS unsigned* st) {
    XcdBarrier b; b.bar = bar; b.x = xb_xcc_id(); b.st = st;
    if (threadIdx.x == 0) (void)xb_add(&bar[XB_XCNT(b.x)], 1u);
    return b;
}
__device__ __forceinline__ void xcd_barrier_complete(unsigned* bar, unsigned x, unsigned& nloc, unsigned& nx) {
    const unsigned G = gridDim.x * gridDim.y * gridDim.z;
    unsigned sum, cnt, mine, sp = 0u;
    for (;;) {
        sum = 0u; cnt = 0u; mine = 0u;
#pragma unroll
        for (unsigned j = 0; j < 16; ++j) { const unsigned c = xb_ld(&bar[XB_XCNT(j)]); sum += c; cnt += (c > 0u) ? 1u : 0u; mine = (j == x) ? c : mine; }
        if (sum == G) break;
        __builtin_amdgcn_s_sleep(1);
        if ((++sp & 255u) == 0u) { if (xb_ld(&bar[XB_TMO])) break; if (sp > XB_SPIN_CAP) { atomicAdd(&bar[XB_TMO], 1u); break; } }
    }
    nloc = mine > 0u ? mine : 1u; nx = cnt > 0u ? cnt : 1u;
}

__device__ __forceinline__ void xcd_barrier(const XcdBarrier& b) {
    asm volatile("s_waitcnt vmcnt(0)" ::: "memory");
    __syncthreads();
    if (threadIdx.x == 0) {
        unsigned* bar = b.bar;
        __builtin_amdgcn_s_waitcnt(0);
        unsigned nloc = b.st[0], nx = b.st[1];
        if (nloc == 0u) { xcd_barrier_complete(bar, b.x, nloc, nx); b.st[0] = nloc; b.st[1] = nx; }
        const unsigned old = xb_add(&bar[XB_XSUB(b.x)], 1u);
        const unsigned gen = old / nloc;
        if (old + 1u == (gen + 1u) * nloc) {
            __builtin_amdgcn_fence(__ATOMIC_RELEASE, "agent");
            asm volatile("s_waitcnt vmcnt(0)" ::: "memory");
            const unsigned og = xb_add(&bar[XB_TOP], 1u);
            const unsigned tg = og / nx;
            if (og + 1u == (tg + 1u) * nx) xb_add(&bar[XB_TOPGEN], 1u);
            else XB_SPIN(xb_ld(&bar[XB_TOPGEN]) == tg, bar);
            __builtin_amdgcn_fence(__ATOMIC_ACQUIRE, "agent");
            xb_add(&bar[XB_XGEN(b.x)], 1u);
            asm volatile("s_waitcnt vmcnt(0)" ::: "memory");
        } else {
            XB_SPIN(xb_ld(&bar[XB_XGEN(b.x)]) == gen, bar);
            __builtin_amdgcn_fence(__ATOMIC_ACQUIRE, "agent");
            asm volatile("s_waitcnt vmcnt(0)" ::: "memory");
        }
    }
    __syncthreads();
}

template <class Epi>
__device__ __forceinline__ void gemm_run(float* lds, const bf16_t* A, const bf16_t* Bt, int M, int N, int K, const Epi& E) {
    __syncthreads();
    pg8::Gemm g{A, Bt, M, N, K}; pg8::StaticOrder S; S.init(M, N, (int)gridDim.x, (int)blockIdx.x);
    pg8::gemm_phase<Epi, pg8::StaticOrder, true, true>((PG8_LAS unsigned char*)lds, g, S, E);
    __syncthreads();
}
constexpr int NPHASE = 11;
template <int PH>
__device__ __forceinline__ void run_phase(const Params& p, int bid, int nb, float* lds) {
    asm volatile("" : "+s"(bid));
    if constexpr (PH == 0) ph_prep(p, bid, nb, lds);
    if constexpr (PH == 1) ph_modnorm(p, p.x, p.norm1_g, 0 * DM, 1 * DM, p.hb, bid, nb, lds);
    if constexpr (PH == 2) gemm_run(lds, p.hb, p.Wt1, NTOK, ZW, DM, pg8::EpiZG{p.ZG, p.b_bg});
    if constexpr (PH == 3) { ph_retprep(p, bid, nb, lds); ph_gmlp2(p, bid, nb, lds); }
    if constexpr (PH == 11) ph_ret2(p, bid, nb, lds);
    if constexpr (PH == 4) ph_gn(p, bid, nb, lds);
    if constexpr (PH == 5) {
        gemm_run(lds, p.yain, p.Wta, NTOK, DM, 1024, pg8::EpiMixB<0>{p.hb, p.ZG, 0});
        gemm_run(lds, p.ybin, p.Wtb, NTOK, DM, DM, pg8::EpiMixB<1>{p.hb, p.ZG, 2048});
    }
    if constexpr (PH == 6) gemm_run(lds, p.hb, p.Wto, NTOK, DM, DM, pg8::EpiResF{p.obuf, p.x, p.ada + 2 * DM});
    if constexpr (PH == 7) { ph_modnorm(p, p.obuf, p.norm2_g, 3 * DM, 4 * DM, p.hb, bid, nb, lds); if (nb != 256) ph_tabconv(p, bid, nb); }
    if constexpr (PH == 8) {
        gemm_run(lds, p.hb, p.Wtq, NTOK, DM, DM, pg8::EpiF32{p.qbuf, DM});
        if (nb == 256) {
            pg8::StaticOrder S; S.init(NTOK, DM, (int)gridDim.x, (int)blockIdx.x); pg8::Unit u; S.next(0, u);
            asm volatile("s_waitcnt vmcnt(0)" ::: "memory"); __syncthreads();
            ph_topk2(p, p.qbuf, bid, nb, lds, u.pm * 8 + u.pn);
        }
    }
    if constexpr (PH == 9) { if (nb != 256) ph_topk2(p, p.qbuf, bid, nb, lds, -1); }
    if constexpr (PH == 10) ph_peer6(p, p.obuf, p.hb, bid, nb, lds);
}

constexpr int MISC_OFF = 132 * 1024;
__global__ void __launch_bounds__(NTH) k_mega(Params p) {
    extern __shared__ __attribute__((aligned(16))) float lds[];
    const int bid = blockIdx.x, nb = gridDim.x;
    volatile LAS unsigned* misc = (volatile LAS unsigned*)((LAS unsigned char*)lds + MISC_OFF);
    if (threadIdx.x < 4) misc[threadIdx.x] = 0u;
    __syncthreads();
    XcdBarrier bar = xcd_barrier_post(p.bar, misc);
    run_phase<0>(p, bid, nb, lds); xcd_barrier(bar);
    run_phase<1>(p, bid, nb, lds); xcd_barrier(bar);
    run_phase<2>(p, bid, nb, lds); xcd_barrier(bar);
    run_phase<3>(p, bid, nb, lds); xcd_barrier(bar);
    run_phase<11>(p, bid, nb, lds); xcd_barrier(bar);
    run_phase<4>(p, bid, nb, lds); xcd_barrier(bar);
    run_phase<5>(p, bid, nb, lds); xcd_barrier(bar);
    run_phase<6>(p, bid, nb, lds); xcd_barrier(bar);
    run_phase<7>(p, bid, nb, lds); xcd_barrier(bar);
    run_phase<8>(p, bid, nb, lds); xcd_barrier(bar);
    if (nb != 256) { run_phase<9>(p, bid, nb, lds); xcd_barrier(bar); }
    run_phase<10>(p, bid, nb, lds);
}

extern "C" void kernel_launch(void* const* d_in, const int* in_sizes, int n_in, void* d_out, int out_size, void* d_ws, size_t ws_size, hipStream_t stream) {
    Params p{};
    p.x = (const float*)d_in[0]; p.c = (const float*)d_in[1]; p.pos = (const int*)d_in[2];
    p.w_ada = (const float*)d_in[3]; p.b_ada = (const float*)d_in[4]; p.norm1_g = (const float*)d_in[5]; p.w_in = (const float*)d_in[6];
    p.w_bg = (const float*)d_in[7]; p.b_bg = (const float*)d_in[8]; p.gm_v_g = (const float*)d_in[9]; p.gm_ws = (const float*)d_in[10];
    p.gm_b = (const float*)d_in[11]; p.ret_gn_g = (const float*)d_in[12]; p.w_a_out = (const float*)d_in[13]; p.w_b_out = (const float*)d_in[14];
    p.w_o = (const float*)d_in[15]; p.norm2_g = (const float*)d_in[16]; p.peer_wq = (const float*)d_in[17]; p.peer_sk = (const float*)d_in[18];
    p.peer_u = (const float*)d_in[19]; p.peer_v = (const float*)d_in[20]; p.norm_f_g = (const float*)d_in[21];
    p.out = (float*)d_out;
    char* w = (char*)d_ws; size_t off = 0;
    auto take = [&](size_t bytes) { char* r = w + off; off += (bytes + 255) & ~(size_t)255; return r; };
    p.bar = (unsigned*)take(XCD_BAR_WORDS * 4);
    p.ada = (float*)take(2 * NMOD * 4);
    p.rope = (float*)take((size_t)NTOK * 128 * 4);
    p.eidx = (int*)take((size_t)NTOK * 128 * 4);
    p.gatev = (float*)take((size_t)NTOK * 128 * 4);
    p.Wt1 = (bf16_t*)take((size_t)ZW * DM * 2);
    p.Wta = (bf16_t*)take((size_t)DM * 1024 * 2);
    p.Wtb = (bf16_t*)take((size_t)DM * DM * 2);
    p.Wto = (bf16_t*)take((size_t)DM * DM * 2);
    p.Wtq = (bf16_t*)take((size_t)DM * DM * 2);
    p.hb = (bf16_t*)take((size_t)NTOK * DM * 2);
    p.ZG = (bf16_t*)take((size_t)NTOK * ZW * 2);
    p.qbuf = (float*)p.ZG;
    p.obuf = (float*)take((size_t)NTOK * DM * 4);
    p.ybin = (bf16_t*)take((size_t)NTOK * DM * 2);
    p.yain = (bf16_t*)take((size_t)NTOK * 1024 * 2);
    p.U8 = (unsigned char*)p.ZG + (size_t)NTOK * DM * 4;
    p.V8 = p.U8 + (size_t)16384 * ROW4;
    p.su = (float*)take(16384 * 4); p.sv = (float*)take(16384 * 4);
    p.Qr = (bf16_t*)take((size_t)NTOK * 1024 * 2);
    p.Pm = (bf16_t*)take((size_t)16 * 64 * 4096 * 2);
    p.KTd = (bf16_t*)take((size_t)NTOK * 1024 * 2);
    p.Vt = (bf16_t*)take((size_t)NTOK * 2048 * 2);
    p.ob16 = (bf16_t*)take((size_t)NTOK * DM * 2);
    if (off > ws_size) { fprintf(stderr, "kernel_launch: workspace too small: need %zu have %zu\n", off, ws_size); return; }
    static int grid = 0;
    if (!grid) {
        int dev = 0, cus = 0, per_cu = 0;
        (void)hipGetDevice(&dev); (void)hipDeviceGetAttribute(&cus, hipDeviceAttributeMultiprocessorCount, dev);
        (void)hipFuncSetAttribute((const void*)k_mega, hipFuncAttributeMaxDynamicSharedMemorySize, LDS_BYTES);
        (void)hipOccupancyMaxActiveBlocksPerMultiprocessor(&per_cu, k_mega, NTH, LDS_BYTES);
        (void)per_cu;
        grid = cus;
    }
    (void)hipMemsetAsync(p.bar, 0, XCD_BAR_WORDS * 4, stream);
    hipLaunchKernelGGL(k_mega, dim3(grid), dim3(NTH), LDS_BYTES, stream, p);
    hipError_t e = hipPeekAtLastError();
    if (e != hipSuccess) fprintf(stderr, "launch failed: %s (grid %d)\n", hipGetErrorString(e), grid);
}
```

```cpp
#include <hip/hip_runtime.h>
#include <hip/hip_cooperative_groups.h>
#include <stdint.h>
#include <math.h>
#include <cstdio>

namespace cg = cooperative_groups;

constexpr int DM = 2048;
constexpr int SQ = 4096;
constexpr int NTOK = 8192;
constexpr int NTH = 512;
constexpr int ZW = 12288;
constexpr int NMOD = 12288;
constexpr int LDS_BYTES = 136 * 1024;

typedef unsigned short bf16_t;

struct Params {
    const float *x, *c; const int* pos;
    const float *w_ada, *b_ada, *norm1_g, *w_in, *w_bg, *b_bg, *gm_v_g, *gm_ws, *gm_b, *ret_gn_g, *w_a_out, *w_b_out, *w_o, *norm2_g,
                *peer_wq, *peer_sk, *peer_u, *peer_v, *norm_f_g;
    float* out;
    float *ada, *rope, *gatev; int* eidx;
    bf16_t *Wt1, *Wta, *Wtb, *Wto, *Wtq;
    bf16_t *hb;
    bf16_t *ZG;
    float *obuf;
    bf16_t *ybin, *yain;
    float *qbuf;
    unsigned char *U8, *V8;
    float *su, *sv;
    bf16_t *Qr, *Pm, *KTd, *Vt;
    bf16_t *ob16;
    unsigned *bar;
};

__constant__ float c_freq[64] = {
1.000000000e+00f, 8.659643531e-01f, 7.498942018e-01f, 6.493816376e-01f, 5.623413324e-01f, 4.869675338e-01f, 4.216965139e-01f, 3.651741147e-01f, 3.162277639e-01f, 2.738419771e-01f, 2.371373773e-01f, 2.053525001e-01f, 1.778279394e-01f, 1.539926529e-01f, 1.333521456e-01f, 1.154781953e-01f, 1.000000015e-01f, 8.659642935e-02f, 7.498942316e-02f, 6.493816525e-02f, 5.623413250e-02f, 4.869675264e-02f, 4.216964915e-02f, 3.651741147e-02f, 3.162277490e-02f, 2.738419548e-02f, 2.371373773e-02f, 2.053525113e-02f, 1.778279431e-02f, 1.539926510e-02f, 1.333521400e-02f, 1.154781971e-02f, 9.999999776e-03f, 8.659643121e-03f, 7.498942316e-03f, 6.493816152e-03f, 5.623413250e-03f, 4.869675264e-03f, 4.216964822e-03f, 3.651741194e-03f, 3.162277630e-03f, 2.738419687e-03f, 2.371373819e-03f, 2.053525066e-03f, 1.778279431e-03f, 1.539926510e-03f, 1.333521446e-03f, 1.154782018e-03f, 1.000000047e-03f, 8.659643354e-04f, 7.498941850e-04f, 6.493816036e-04f, 5.623413017e-04f, 4.869675322e-04f, 4.216965172e-04f, 3.651741135e-04f, 3.162277571e-04f, 2.738419571e-04f, 2.371373703e-04f, 2.053525095e-04f, 1.778279402e-04f, 1.539926598e-04f, 1.333521504e-04f, 1.154782003e-04f };

#define LASP __attribute__((address_space(3)))
constexpr int TIDW_OFF = 133 * 1024;
__device__ __forceinline__ int hw_slot_() { return (int)(__builtin_amdgcn_s_getreg((5 << 11) | 4) & 63u); }
__device__ __forceinline__ int lane_hw_() { int l; asm volatile("v_mbcnt_lo_u32_b32 %0, -1, 0\n\tv_mbcnt_hi_u32_b32 %0, -1, %0" : "=v"(l)); return l; }
__device__ __forceinline__ int tid_() {
    const int wv = (int)*(volatile LASP unsigned*)(unsigned)(TIDW_OFF + 4 * hw_slot_());
    int t = __builtin_amdgcn_readfirstlane(wv) * 64 + lane_hw_(); asm volatile("" : "+v"(t)); return t; }
template <int CTRL> __device__ __forceinline__ float dppf(float x) { return __uint_as_float((unsigned)__builtin_amdgcn_update_dpp(0, (int)__float_as_uint(x), CTRL, 0xf, 0xf, true)); }
__device__ __forceinline__ float row_sum16(float v) { v += dppf<0xB1>(v); v += dppf<0x4E>(v); v += dppf<0x141>(v); v += dppf<0x140>(v); return v; }
__device__ __forceinline__ float xsum16(float v) { const auto r = __builtin_amdgcn_permlane16_swap(__float_as_uint(v), __float_as_uint(v), false, false); return __uint_as_float(r[0]) + __uint_as_float(r[1]); }
__device__ __forceinline__ float xsum32(float v) { const auto r = __builtin_amdgcn_permlane32_swap(__float_as_uint(v), __float_as_uint(v), false, false); return __uint_as_float(r[0]) + __uint_as_float(r[1]); }
__device__ __forceinline__ float xmax16(float v) { const auto r = __builtin_amdgcn_permlane16_swap(__float_as_uint(v), __float_as_uint(v), false, false); return fmaxf(__uint_as_float(r[0]), __uint_as_float(r[1])); }
__device__ __forceinline__ float xmax32(float v) { const auto r = __builtin_amdgcn_permlane32_swap(__float_as_uint(v), __float_as_uint(v), false, false); return fmaxf(__uint_as_float(r[0]), __uint_as_float(r[1])); }
__device__ __forceinline__ float wave_sum(float v) { v = row_sum16(v); v += __shfl_xor(v, 16); v += __shfl_xor(v, 32); return v; }
__device__ __forceinline__ float wave_max_b(float v) {
    v = fmaxf(v, dppf<0xB1>(v)); v = fmaxf(v, dppf<0x4E>(v)); v = fmaxf(v, dppf<0x141>(v)); v = fmaxf(v, dppf<0x140>(v));
    v = fmaxf(v, __shfl_xor(v, 16)); v = fmaxf(v, __shfl_xor(v, 32)); return v;
}
__device__ __forceinline__ float wave_max(float v) {
    v = fmaxf(v, dppf<0xB1>(v)); v = fmaxf(v, dppf<0x4E>(v)); v = fmaxf(v, dppf<0x141>(v)); v = fmaxf(v, dppf<0x140>(v));
    return xmax32(xmax16(v));
}
__device__ __forceinline__ float sigmoidf_(float x) { return 1.0f / (1.0f + expf(-x)); }
__device__ __forceinline__ float siluf_(float x) { return x * sigmoidf_(x); }
__device__ __forceinline__ float geluf_(float x) { return 0.5f * x * (1.0f + erff(x * 0.70710678118654752f)); }
__device__ __forceinline__ float dot4(float4 a, float4 b) { return a.x * b.x + a.y * b.y + a.z * b.z + a.w * b.w; }
__device__ __forceinline__ float bf2f(bf16_t v) { return __uint_as_float((unsigned)v << 16); }
__device__ __forceinline__ float bflo(unsigned w) { return __uint_as_float(w << 16); }
__device__ __forceinline__ float bfhi(unsigned w) { return __uint_as_float(w & 0xffff0000u); }
__device__ __forceinline__ unsigned f2bf(float f) { unsigned u = __float_as_uint(f); return (u + 0x7fffu + ((u >> 16) & 1u)) >> 16; }
__device__ __forceinline__ unsigned pk2(float lo, float hi) { return f2bf(lo) | (f2bf(hi) << 16); }

__device__ __forceinline__ void st_wt8(void* ptr, uint2 v) { __hip_atomic_store((unsigned long long*)ptr, ((unsigned long long)v.y << 32) | v.x, __ATOMIC_RELAXED, __HIP_MEMORY_SCOPE_AGENT); }
__device__ __forceinline__ void sincos_acc(float ang, float& s, float& c) {
    const double x = (double)ang;
    const double k = rint(x * 0.63661977236758134308);
    double r = fma(-k, 1.57079632679489655800, x); r = fma(-k, 6.12323399573676603587e-17, r);
    const double r2 = r * r;
    const double sp = r * (1.0 + r2 * (-1.0 / 6.0 + r2 * (1.0 / 120.0 + r2 * (-1.0 / 5040.0 + r2 * (1.0 / 362880.0 + r2 * (-1.0 / 39916800.0 + r2 * (1.0 / 6227020800.0)))))));
    const double cp = 1.0 + r2 * (-0.5 + r2 * (1.0 / 24.0 + r2 * (-1.0 / 720.0 + r2 * (1.0 / 40320.0 + r2 * (-1.0 / 3628800.0 + r2 * (1.0 / 479001600.0 + r2 * (-1.0 / 87178291200.0)))))));
    const int q = ((int)k) & 3;
    const float fs = (float)sp, fc = (float)cp;
    s = (q == 0) ? fs : (q == 1) ? fc : (q == 2) ? -fs : -fc;
    c = (q == 0) ? fc : (q == 1) ? -fs : (q == 2) ? -fc : fs;
}

namespace pg8 {
#define PG8_LAS __attribute__((address_space(3)))
typedef unsigned short bf16_t;
typedef short bf16x8 __attribute__((ext_vector_type(8)));
typedef float f32x4 __attribute__((ext_vector_type(4)));
typedef unsigned u32x4 __attribute__((ext_vector_type(4)));
constexpr int BM = 256, BK = 64, HALF = 128, HTB = HALF * BK * 2  , STAGE_BYTES = 8 * HTB, NXCD = 8, WGM = 8;

__host__ __device__ __forceinline__ int lds_byte(int r, int c) { const int st = (r >> 4) * 2 + (c >> 5), rr = r & 15, cc = c & 31, ob = rr * 64 + cc * 2; return st * 1024 + (ob ^ (((ob >> 9) & 1) << 5)); }
__host__ __device__ __forceinline__ void stage_rc(int b, int& R, int& C) { const int st = b / 1024, sb = b % 1024, swz = sb ^ (((sb >> 9) & 1) << 5); R = (st >> 1) * 16 + swz / 64; C = (st & 1) * 32 + (swz % 64) / 2; }
__host__ __device__ __forceinline__ int perm32(int rho) { const int n = rho >> 4, i = rho & 15; return 8 * (i >> 2) + 4 * n + (i & 3); }

struct Unit { int pm, pn; };
struct Gemm { const bf16_t* A; const bf16_t* Bt; int M, N, K; };

struct StaticOrder {
    int nM, nN, nwg, G, c;
    __host__ __device__ void init(int M, int N, int G_, int c_) { nM = M / BM; nN = N / BM; nwg = nM * nN; G = G_; c = c_; }
    __host__ __device__ bool next(int i, Unit& u) const {
        const long L = (long)i * G + c; if (L >= nwg) return false;
        int wgid = (int)L; { const int q = nwg / NXCD, r = nwg % NXCD, xcd = wgid % NXCD, off = wgid / NXCD; wgid = (xcd < r ? xcd * (q + 1) : r * (q + 1) + (xcd - r) * q) + off; }
        const int nig = WGM * nN, gid = wgid / nig, fm = gid * WGM, gsz = (nM - fm) < WGM ? (nM - fm) : WGM;
        u.pm = fm + ((wgid % nig) % gsz); u.pn = (wgid % nig) / gsz; return true;
    }
    __device__ __forceinline__ void a_ready(const Unit&) const {}
    __device__ __forceinline__ void done(const Unit&) const {}
};

__device__ __forceinline__ unsigned cvt_pk_bf16(float lo, float hi) { unsigned r; asm volatile("v_cvt_pk_bf16_f32 %0, %1, %2" : "=v"(r) : "v"(lo), "v"(hi)); return r; }
typedef float f32x2 __attribute__((ext_vector_type(2)));
__device__ __forceinline__ f32x2 gelu_pk(f32x2 v) {
    const f32x2 av = __builtin_elementwise_abs(v), d = av * 0.2316418882f + 1.0f;
    f32x2 t; t.x = __builtin_amdgcn_rcpf(d.x); t.y = __builtin_amdgcn_rcpf(d.y);
    f32x2 q = t * 0.5307027145f + (-0.7265760135f); q = q * t + 0.7107068705f; q = q * t + (-0.142248368f); q = q * t + 0.127414796f; q = q * t;
    const f32x2 s = (v * v) * (-0.72134752044f);
    f32x2 e; e.x = __builtin_amdgcn_exp2f(s.x); e.y = __builtin_amdgcn_exp2f(s.y);
    const f32x2 m = v * (q * e), r = v - m;
    f32x2 o; o.x = v.x < 0.f ? m.x : r.x; o.y = v.y < 0.f ? m.y : r.y; return o;
}

typedef unsigned u32x2v __attribute__((ext_vector_type(2)));
struct EpiZG {
    static constexpr bool PERM = true, AFTER_DRAIN = false;
    bf16_t* O; const float* bias;
    __device__ __forceinline__ void operator()(const f32x4 (&acc)[2][2][4][2], const Unit& u, int wr, int wc, int fr, int fq) const {
        const int row0 = u.pm * BM + wr * 64 + fr, col0 = u.pn * BM + wc * 32 + 8 * fq;
        const int mode = u.pn < 8 ? 1 : (u.pn < 32 ? 0 : 2);
        f32x4 bv[2][2];
#pragma unroll
        for (int bj = 0; bj < 2; ++bj)
#pragma unroll
            for (int n = 0; n < 2; ++n) bv[bj][n] = (mode == 2) ? *(const f32x4*)(bias + (col0 - 8192) + bj * HALF + 4 * n) : (f32x4){0.f, 0.f, 0.f, 0.f};
#pragma unroll
        for (int ai = 0; ai < 2; ++ai)
#pragma unroll
            for (int m = 0; m < 4; ++m) { bf16_t* rowp = O + (size_t)(row0 + ai * HALF + m * 16) * ZW + col0;
#pragma unroll
                for (int bj = 0; bj < 2; ++bj) { f32x4 v0 = acc[ai][bj][m][0], v1 = acc[ai][bj][m][1];
                    if (mode == 1) { f32x2 a = gelu_pk((f32x2){v0[0], v0[1]}), b = gelu_pk((f32x2){v0[2], v0[3]}), c = gelu_pk((f32x2){v1[0], v1[1]}), d = gelu_pk((f32x2){v1[2], v1[3]});
                        v0 = (f32x4){a.x, a.y, b.x, b.y}; v1 = (f32x4){c.x, c.y, d.x, d.y}; }
                    if (mode == 2) { v0 = v0 + bv[bj][0]; v1 = v1 + bv[bj][1];
#pragma unroll
                        for (int e = 0; e < 4; ++e) { v0[e] = __builtin_amdgcn_rcpf(1.0f + __expf(-v0[e])); v1[e] = __builtin_amdgcn_rcpf(1.0f + __expf(-v1[e])); } }
                    u32x4 w; w.x = cvt_pk_bf16(v0[0], v0[1]); w.y = cvt_pk_bf16(v0[2], v0[3]); w.z = cvt_pk_bf16(v1[0], v1[1]); w.w = cvt_pk_bf16(v1[2], v1[3]);
                    *(u32x4*)(rowp + bj * HALF) = w; } }
    }
};
template <int ACCUM> struct EpiMixB {
    static constexpr bool PERM = true, AFTER_DRAIN = false;
    bf16_t* Mo; const bf16_t* ZGp; int goff;
    __device__ __forceinline__ void operator()(const f32x4 (&acc)[2][2][4][2], const Unit& u, int wr, int wc, int fr, int fq) const {
        const int row0 = u.pm * BM + wr * 64 + fr, col0 = u.pn * BM + wc * 32 + 8 * fq;
#pragma unroll
        for (int ai = 0; ai < 2; ++ai)
#pragma unroll
            for (int m = 0; m < 4; ++m) { const size_t row = (size_t)(row0 + ai * HALF + m * 16);
#pragma unroll
                for (int bj = 0; bj < 2; ++bj) { const f32x4 v0 = acc[ai][bj][m][0], v1 = acc[ai][bj][m][1];
                    const u32x4 g = *(const u32x4*)(ZGp + row * ZW + 8192 + goff + col0 + bj * HALF);
                    float o[8];
                    o[0] = bflo(g.x) * v0[0]; o[1] = bfhi(g.x) * v0[1]; o[2] = bflo(g.y) * v0[2]; o[3] = bfhi(g.y) * v0[3];
                    o[4] = bflo(g.z) * v1[0]; o[5] = bfhi(g.z) * v1[1]; o[6] = bflo(g.w) * v1[2]; o[7] = bfhi(g.w) * v1[3];
                    bf16_t* mp = Mo + row * DM + col0 + bj * HALF;
                    if (ACCUM) { const u32x4 old = *(const u32x4*)mp;
                        o[0] += bflo(old.x); o[1] += bfhi(old.x); o[2] += bflo(old.y); o[3] += bfhi(old.y); o[4] += bflo(old.z); o[5] += bfhi(old.z); o[6] += bflo(old.w); o[7] += bfhi(old.w); }
                    u32x4 w; w.x = cvt_pk_bf16(o[0], o[1]); w.y = cvt_pk_bf16(o[2], o[3]); w.z = cvt_pk_bf16(o[4], o[5]); w.w = cvt_pk_bf16(o[6], o[7]);
                    *(u32x4*)mp = w; } }
    }
};
struct EpiResF {
    static constexpr bool PERM = false, AFTER_DRAIN = false;
    float* x1; const float* x; const float* ga;
    __device__ __forceinline__ void operator()(const f32x4 (&acc)[2][2][4][2], const Unit& u, int wr, int wc, int fr, int fq) const {
        const int row0 = u.pm * BM + wr * 64 + fr, col0 = u.pn * BM + wc * 32 + 4 * fq;
        const int b = (u.pm * BM) / SQ;
        f32x4 gv[2][2];
#pragma unroll
        for (int bj = 0; bj < 2; ++bj)
#pragma unroll
            for (int n = 0; n < 2; ++n) gv[bj][n] = *(const f32x4*)(ga + b * NMOD + col0 + bj * HALF + n * 16);
#pragma unroll
        for (int ai = 0; ai < 2; ++ai)
#pragma unroll
            for (int m = 0; m < 4; ++m) { const size_t off = (size_t)(row0 + ai * HALF + m * 16) * DM + col0;
#pragma unroll
                for (int bj = 0; bj < 2; ++bj)
#pragma unroll
                    for (int n = 0; n < 2; ++n) { const f32x4 xv = *(const f32x4*)(x + off + bj * HALF + n * 16);
                        *(f32x4*)(x1 + off + bj * HALF + n * 16) = xv + gv[bj][n] * acc[ai][bj][m][n]; } }
    }
};
struct EpiF32 {
    static constexpr bool PERM = false, AFTER_DRAIN = false;
    float* O; int ldc;
    __device__ __forceinline__ void operator()(const f32x4 (&acc)[2][2][4][2], const Unit& u, int wr, int wc, int fr, int fq) const {
        const int row0 = u.pm * BM + wr * 64 + fr, col0 = u.pn * BM + wc * 32 + 4 * fq;
#pragma unroll
        for (int ai = 0; ai < 2; ++ai)
#pragma unroll
            for (int m = 0; m < 4; ++m) { const size_t off = (size_t)(row0 + ai * HALF + m * 16) * ldc + col0;
#pragma unroll
                for (int bj = 0; bj < 2; ++bj)
#pragma unroll
                    for (int n = 0; n < 2; ++n) *(f32x4*)(O + off + bj * HALF + n * 16) = acc[ai][bj][m][n]; }
    }
};

template <class Epi, class Sched, bool ALIGN_EPI = false, bool SP2 = false>
__device__ __forceinline__ void gemm_phase(PG8_LAS unsigned char* lds, const Gemm g, const Sched& S, const Epi& E) {
    const int tid = tid_(), wid = __builtin_amdgcn_readfirstlane(tid >> 6), lane = tid & 63, wr = wid >> 2, wc = wid & 3, fr = lane & 15, fq = lane >> 4;
    const int K = g.K, nt = K / BK;
    unsigned voffA[2], voffB[2];
#pragma unroll
    for (int i = 0; i < 2; ++i) { int R, C; stage_rc(tid * 16 + i * 8192, R, C); const int Rb = Epi::PERM ? ((R & ~31) + perm32(R & 31)) : R;
        voffA[i] = (unsigned)(R * K + C) * 2u; voffB[i] = (unsigned)(Rb * K + C) * 2u; }
    const size_t kstep = (size_t)(BK * 2);
    const size_t hstep = (size_t)HALF * K * 2;
    const size_t tstep = 2 * hstep;
    const unsigned ldsw = (unsigned)wid * 1024u;
    const int aoff = lds_byte(wr * 64 + fr, fq * 8), boff = lds_byte(wc * 32 + fr, fq * 8);
#define PG8_SA(b, h) (((b) * 2 + (h)) * HTB)
#define PG8_SB(b, h) ((4 + (b) * 2 + (h)) * HTB)
#define PG8_STAGE(bufoff, gbase, voff) do { _Pragma("unroll") for (int _i = 0; _i < 2; ++_i) \
        __builtin_amdgcn_global_load_lds((const unsigned*)((const char*)(gbase) + (voff)[_i]), (PG8_LAS unsigned*)(lds + (bufoff) + ldsw + _i * 8192), 16, 0, 0); } while (0)
#define PG8_LDA(dst, b, h) do { _Pragma("unroll") for (int m = 0; m < 4; ++m) _Pragma("unroll") for (int k = 0; k < 2; ++k) dst[m][k] = *(const PG8_LAS bf16x8*)(lds + PG8_SA(b, h) + aoff + m * 2048 + k * 1024); } while (0)
#define PG8_LDB(dst, b, h) do { _Pragma("unroll") for (int n = 0; n < 2; ++n) _Pragma("unroll") for (int k = 0; k < 2; ++k) dst[n][k] = *(const PG8_LAS bf16x8*)(lds + PG8_SB(b, h) + boff + n * 2048 + k * 1024); } while (0)
#define PG8_MMA(ai, bj, At, Bt) do { __builtin_amdgcn_s_setprio(1); _Pragma("unroll") for (int m = 0; m < 4; ++m) _Pragma("unroll") for (int n = 0; n < 2; ++n) _Pragma("unroll") for (int k = 0; k < 2; ++k) \
        acc[ai][bj][m][n] = __builtin_amdgcn_mfma_f32_16x16x32_bf16(Bt[n][k], At[m][k], acc[ai][bj][m][n], 0, 0, 0); __builtin_amdgcn_s_setprio(0); } while (0)
#define PG8_WAIT_V(n) asm volatile("s_waitcnt vmcnt(" #n ")" ::: "memory")
#define PG8_WAIT_L(n) asm volatile("s_waitcnt lgkmcnt(" #n ")" ::: "memory")
#define PG8_BAR __builtin_amdgcn_s_barrier()
#define PG8_SCHED __builtin_amdgcn_sched_barrier(0)
    Unit cur, nxt; int ui = 0;
    if (!S.next(0, cur)) return;
    f32x4 acc[2][2][4][2];
#pragma unroll
    for (int a = 0; a < 2; ++a)
#pragma unroll
        for (int b = 0; b < 2; ++b)
#pragma unroll
            for (int m = 0; m < 4; ++m)
#pragma unroll
                for (int n = 0; n < 2; ++n) acc[a][b][m][n] = (f32x4){0.f, 0.f, 0.f, 0.f};
    bf16x8 At[4][2], B0[2][2], B1[2][2];
    const char* cA = (const char*)g.A + (size_t)cur.pm * tstep; const char* cB = (const char*)g.Bt + (size_t)cur.pn * tstep;
    S.a_ready(cur);
    if constexpr (SP2) {
        PG8_STAGE(PG8_SB(0, 0), cB, voffB); PG8_STAGE(PG8_SB(0, 1), cB + hstep, voffB); PG8_STAGE(PG8_SA(0, 0), cA, voffA); PG8_STAGE(PG8_SA(0, 1), cA + hstep, voffA);
        if (wr == 1) PG8_BAR;
        PG8_WAIT_V(2); PG8_BAR;
        PG8_STAGE(PG8_SB(1, 0), cB + kstep, voffB); PG8_STAGE(PG8_SA(1, 0), cA + kstep, voffA); PG8_STAGE(PG8_SB(1, 1), cB + hstep + kstep, voffB);
        PG8_WAIT_V(6); PG8_BAR;
    } else {
        PG8_STAGE(PG8_SB(0, 0), cB, voffB); PG8_STAGE(PG8_SA(0, 0), cA, voffA); PG8_STAGE(PG8_SB(0, 1), cB + hstep, voffB); PG8_STAGE(PG8_SA(0, 1), cA + hstep, voffA);
        if (wr == 1) PG8_BAR;
        PG8_WAIT_V(4); PG8_BAR;
        PG8_STAGE(PG8_SB(1, 0), cB + kstep, voffB); PG8_STAGE(PG8_SA(1, 0), cA + kstep, voffA); PG8_STAGE(PG8_SB(1, 1), cB + hstep + kstep, voffB);
        PG8_WAIT_V(6); PG8_BAR;
    }
    for (;;) {
        const bool has_next = S.next(ui + 1, nxt);
        const char* nA = has_next ? (const char*)g.A + (size_t)nxt.pm * tstep : cA; const char* nB = has_next ? (const char*)g.Bt + (size_t)nxt.pn * tstep : cB;
        for (int t = 0; t < nt; t += 2) {
            const bool last = (t == nt - 2);
            const char* a1 = cA + (size_t)(t + 1) * kstep;
            const char* a2 = last ? nA : cA + (size_t)(t + 2) * kstep; const char* b2 = last ? nB : cB + (size_t)(t + 2) * kstep;
            const char* a3 = a2 + kstep; const char* b3 = b2 + kstep;
            if (last && has_next) S.a_ready(nxt);
            if constexpr (SP2) {
            PG8_LDB(B0, 0, 0); PG8_LDB(B1, 0, 1); PG8_SCHED; PG8_LDA(At, 0, 0); PG8_STAGE(PG8_SA(1, 1), a1 + hstep, voffA);
            PG8_WAIT_V(8); PG8_WAIT_L(0); PG8_BAR; PG8_MMA(0, 0, At, B0); PG8_MMA(0, 1, At, B1); PG8_BAR; PG8_SCHED;
            PG8_LDA(At, 0, 1); PG8_STAGE(PG8_SB(0, 0), b2, voffB); PG8_STAGE(PG8_SB(0, 1), b2 + hstep, voffB); PG8_STAGE(PG8_SA(0, 0), a2, voffA);
            PG8_WAIT_V(8); PG8_WAIT_L(0); PG8_BAR; PG8_MMA(1, 0, At, B0); PG8_MMA(1, 1, At, B1); PG8_BAR; PG8_SCHED;
            PG8_LDB(B0, 1, 0); PG8_LDB(B1, 1, 1); PG8_SCHED; PG8_LDA(At, 1, 0); PG8_STAGE(PG8_SA(0, 1), a2 + hstep, voffA);
            PG8_WAIT_V(8); PG8_WAIT_L(0); PG8_BAR; PG8_MMA(0, 0, At, B0); PG8_MMA(0, 1, At, B1); PG8_BAR; PG8_SCHED;
            PG8_LDA(At, 1, 1); PG8_STAGE(PG8_SB(1, 0), b3, voffB); PG8_STAGE(PG8_SB(1, 1), b3 + hstep, voffB); PG8_STAGE(PG8_SA(1, 0), a3, voffA);
            PG8_WAIT_V(8); PG8_WAIT_L(0); PG8_BAR; PG8_MMA(1, 0, At, B0); PG8_MMA(1, 1, At, B1); PG8_BAR; PG8_SCHED;
            } else {
            PG8_LDB(B0, 0, 0); PG8_SCHED; PG8_LDA(At, 0, 0); PG8_STAGE(PG8_SA(1, 1), a1 + hstep, voffA);
            PG8_WAIT_L(8); PG8_BAR; PG8_WAIT_L(0); PG8_MMA(0, 0, At, B0); PG8_BAR; PG8_SCHED;
            PG8_LDB(B1, 0, 1); PG8_STAGE(PG8_SB(0, 0), b2, voffB);
            PG8_BAR; PG8_WAIT_L(0); PG8_MMA(0, 1, At, B1); PG8_BAR;
            PG8_LDA(At, 0, 1); PG8_STAGE(PG8_SA(0, 0), a2, voffA);
            PG8_BAR; PG8_WAIT_L(0); PG8_MMA(1, 0, At, B0); PG8_BAR; PG8_SCHED;
            PG8_STAGE(PG8_SB(0, 1), b2 + hstep, voffB);
            PG8_WAIT_V(6); PG8_BAR; PG8_MMA(1, 1, At, B1); PG8_BAR;
            PG8_LDB(B0, 1, 0); PG8_SCHED; PG8_LDA(At, 1, 0); PG8_STAGE(PG8_SA(0, 1), a2 + hstep, voffA);
            PG8_WAIT_L(8); PG8_BAR; PG8_WAIT_L(0); PG8_MMA(0, 0, At, B0); PG8_BAR; PG8_SCHED;
            PG8_LDB(B1, 1, 1); PG8_STAGE(PG8_SB(1, 0), b3, voffB);
            PG8_BAR; PG8_WAIT_L(0); PG8_MMA(0, 1, At, B1); PG8_BAR;
            PG8_LDA(At, 1, 1); PG8_STAGE(PG8_SA(1, 0), a3, voffA);
            PG8_BAR; PG8_WAIT_L(0); PG8_MMA(1, 0, At, B0); PG8_BAR; PG8_SCHED;
            PG8_STAGE(PG8_SB(1, 1), b3 + hstep, voffB);
            PG8_WAIT_V(6); PG8_BAR; PG8_MMA(1, 1, At, B1); PG8_BAR;
            }
        }
        if constexpr (ALIGN_EPI) { if (wr == 0) PG8_BAR; }
        if constexpr (!Epi::AFTER_DRAIN) { E(acc, cur, wr, wc, fr, fq); S.done(cur); }
        if (!has_next) break;
#pragma unroll
        for (int a = 0; a < 2; ++a)
#pragma unroll
            for (int b = 0; b < 2; ++b)
#pragma unroll
                for (int m = 0; m < 4; ++m)
#pragma unroll
                    for (int n = 0; n < 2; ++n) acc[a][b][m][n] = (f32x4){0.f, 0.f, 0.f, 0.f};
        cur = nxt; cA = nA; cB = nB; ++ui;
        if constexpr (ALIGN_EPI) { if (wr == 1) PG8_BAR; }
    }
    PG8_WAIT_V(0);
    if constexpr (!ALIGN_EPI) { if (wr == 0) PG8_BAR; }
    PG8_BAR;
    if constexpr (Epi::AFTER_DRAIN) { E.fused(acc, cur, wr, wc, fr, fq, lds, wid, lane); S.done(cur); }
#undef PG8_SA
#undef PG8_SB
#undef PG8_STAGE
#undef PG8_LDA
#undef PG8_LDB
#undef PG8_MMA
#undef PG8_WAIT_V
#undef PG8_WAIT_L
#undef PG8_BAR
#undef PG8_SCHED
}
}
using pg8::f32x4; using pg8::u32x4;

__device__ __forceinline__ void transpose_item(const float* W, int K, int N, bf16_t* WT, int row_off, float* scr, int item, int lane) {
    const int nblk = N / 32, kb = item / nblk, nbk = item % nblk, k0 = 64 * kb, n0 = 32 * nbk;
    {
        const int r = lane >> 3, c4 = (lane & 7) * 4;
        float4 t[8];
#pragma unroll
        for (int i = 0; i < 8; ++i) t[i] = *(const float4*)(W + (size_t)(k0 + 8 * i + r) * N + n0 + c4);
#pragma unroll
        for (int i = 0; i < 8; ++i) { float* d = scr + (8 * i + r) * 33 + c4; d[0] = t[i].x; d[1] = t[i].y; d[2] = t[i].z; d[3] = t[i].w; }
    }
    asm volatile("s_waitcnt lgkmcnt(0)" ::: "memory");
    const int c = lane & 7;
#pragma unroll
    for (int j = 0; j < 4; ++j) { const int n = (lane >> 3) + 8 * j; const float* s = scr + (8 * c) * 33 + n;
        uint4 o; o.x = pk2(s[0 * 33], s[1 * 33]); o.y = pk2(s[2 * 33], s[3 * 33]); o.z = pk2(s[4 * 33], s[5 * 33]); o.w = pk2(s[6 * 33], s[7 * 33]);
        *(uint4*)(WT + (size_t)(row_off + n0 + n) * K + k0 + 8 * c) = o; }
    asm volatile("s_waitcnt lgkmcnt(0)" ::: "memory");
}
__device__ __forceinline__ void ph_prep(const Params& p, int bid, int nb, float* lds) {
    const int tid = tid_(), wave = tid >> 6, lane = tid & 63;
    {
        float* sl = lds;
        float* red = lds + 4096;
        for (int i = tid; i < 4096; i += NTH) sl[i] = siluf_(p.c[i]);
        __syncthreads();
        for (int it = bid; it < 192; it += nb) {
            const int c4 = tid & 15, kg = tid >> 4;
            const float* wp = p.w_ada + (size_t)kg * NMOD + it * 64 + c4 * 4;
            float a0[4] = {0.f, 0.f, 0.f, 0.f}, a1[4] = {0.f, 0.f, 0.f, 0.f};
#pragma unroll 8
            for (int i = 0; i < 64; ++i) {
                const int k = kg + 32 * i;
                const float4 w = *(const float4*)(wp + (size_t)(32 * i) * NMOD);
                const float s0 = sl[k], s1 = sl[2048 + k];
                a0[0] += s0 * w.x; a0[1] += s0 * w.y; a0[2] += s0 * w.z; a0[3] += s0 * w.w;
                a1[0] += s1 * w.x; a1[1] += s1 * w.y; a1[2] += s1 * w.z; a1[3] += s1 * w.w;
            }
            __syncthreads();
#pragma unroll
            for (int e = 0; e < 4; ++e) { red[(kg * 16 + c4) * 8 + e] = a0[e]; red[(kg * 16 + c4) * 8 + 4 + e] = a1[e]; }
            __syncthreads();
            if (tid < 128) {
                const int b = tid >> 6, col = tid & 63;
                float s = 0.f;
                for (int g = 0; g < 32; ++g) s += red[(g * 16 + (col >> 2)) * 8 + b * 4 + (col & 3)];
                p.ada[b * NMOD + it * 64 + col] = s + p.b_ada[it * 64 + col];
            }
        }
        __syncthreads();
    }
    for (int e = bid * NTH + tid; e < NTOK * 64; e += nb * NTH) {
        const int tok = e >> 6, j = e & 63;
        const float ang = (float)p.pos[tok] * c_freq[j];
        float s, c; sincos_acc(ang, s, c);
        p.rope[(size_t)e * 2] = c; p.rope[(size_t)e * 2 + 1] = s;
    }
    {
        float* scr = lds + wave * (64 * 33);
        const int gw = bid * 8 + wave, ngw = nb * 8;
        constexpr int I1 = 32 * 256, I2 = 32 * 128, I3 = 16 * 64, I4 = 32 * 64;
        constexpr int NIT = I1 + I2 + I3 + 3 * I4;
        for (int it = gw; it < NIT; it += ngw) {
            int r = it;
            if (r < I1) { transpose_item(p.w_in, 2048, 8192, p.Wt1, 0, scr, r, lane); continue; } r -= I1;
            if (r < I2) { transpose_item(p.w_bg, 2048, 4096, p.Wt1, 8192, scr, r, lane); continue; } r -= I2;
            if (r < I3) { transpose_item(p.w_a_out, 1024, 2048, p.Wta, 0, scr, r, lane); continue; } r -= I3;
            if (r < I4) { transpose_item(p.w_b_out, 2048, 2048, p.Wtb, 0, scr, r, lane); continue; } r -= I4;
            if (r < I4) { transpose_item(p.w_o, 2048, 2048, p.Wto, 0, scr, r, lane); continue; } r -= I4;
            transpose_item(p.peer_wq, 2048, 2048, p.Wtq, 0, scr, r, lane);
        }
    }
    __syncthreads();
}
constexpr int ROW6 = 1536;
typedef float f32x32_t __attribute__((ext_vector_type(32)));
typedef unsigned u32x6_t __attribute__((ext_vector_type(6)));
__device__ __forceinline__ void tc_load(const Params& p, int r, int lane, float4 (&t)[8]) {
    const bool second = r >= 16384; const int row = second ? r - 16384 : r;
    const float* src = (const float*)((const char*)p.peer_u + (second ? ((const char*)p.peer_v - (const char*)p.peer_u) : (ptrdiff_t)0)) + (size_t)row * DM + (second ? lane * 4 : (lane >> 2) * 128 + (lane & 3) * 8);
#pragma unroll
    for (int q = 0; q < 8; ++q) t[q] = *(const float4*)(src + (second ? 256 * q : (q >> 1) * 32 + (q & 1) * 4));
}
constexpr int ROW4 = 1024;
__device__ __forceinline__ void tc_finish(const Params& p, int r, int lane, const float4 (&t)[8]) {
    const bool second = r >= 16384; const int row = second ? r - 16384 : r;
    float am = 0.f;
#pragma unroll
    for (int q = 0; q < 8; ++q) am = fmaxf(am, fmaxf(fmaxf(fabsf(t[q].x), fabsf(t[q].y)), fmaxf(fabsf(t[q].z), fabsf(t[q].w))));
    am = wave_max_b(am);
    {
        const float sc = (am > 0.f) ? am * (1.0f / 6.0f) : 1.0f, inv = (am > 0.f) ? 6.0f / am : 1.0f;
        unsigned w0 = 0u, w1 = 0u, w2 = 0u, w3 = 0u;
#define TC_PK(W_, qa_, qb_) do { \
        W_ = __builtin_amdgcn_cvt_scalef32_pk_fp4_f32(W_, t[qa_].x * inv, t[qa_].y * inv, 1.0f, 0); W_ = __builtin_amdgcn_cvt_scalef32_pk_fp4_f32(W_, t[qa_].z * inv, t[qa_].w * inv, 1.0f, 1); \
        W_ = __builtin_amdgcn_cvt_scalef32_pk_fp4_f32(W_, t[qb_].x * inv, t[qb_].y * inv, 1.0f, 2); W_ = __builtin_amdgcn_cvt_scalef32_pk_fp4_f32(W_, t[qb_].z * inv, t[qb_].w * inv, 1.0f, 3); } while (0)
        TC_PK(w0, 0, 1); TC_PK(w1, 2, 3); TC_PK(w2, 4, 5); TC_PK(w3, 6, 7);
#undef TC_PK
        *(uint4*)(p.U8 + (size_t)r * ROW4 + lane * 16) = make_uint4(w0, w1, w2, w3);
        if (lane == 0) p.su[r] = sc;
    }
}
__device__ __forceinline__ void ph_tabconv(const Params& p, int bid, int nb) {
    const int tid = tid_(), wave = tid >> 6, lane = tid & 63;
    for (int r = bid * 8 + wave; r < 2 * 16384; r += nb * 8) { float4 t[8]; tc_load(p, r, lane, t); tc_finish(p, r, lane, t); }
}

__device__ __forceinline__ void mn_load(const float* xin, int row, int lane, float4 (&v)[8]) {
#pragma unroll
    for (int j = 0; j < 8; ++j) v[j] = ((const float4*)(xin + (size_t)row * DM))[lane + 64 * j];
}
__device__ __forceinline__ void mn_row(const Params& p, const float* g, int sh_off, int sc_off, bf16_t* hout, int row, int lane, const float4 (&v)[8]) {
    const int b = row / SQ;
    float ss = 0.f;
#pragma unroll
    for (int j = 0; j < 8; ++j) ss += dot4(v[j], v[j]);
    ss = wave_sum(ss);
    const float rs = 1.0f / sqrtf(ss * (1.0f / DM) + 1e-6f);
#pragma unroll
    for (int j = 0; j < 8; ++j) {
        const int col = (lane + 64 * j) * 4;
        const float4 g4 = *(const float4*)(g + col);
        const float4 sc = *(const float4*)(p.ada + b * NMOD + sc_off + col);
        const float4 sh = *(const float4*)(p.ada + b * NMOD + sh_off + col);
        float4 o;
        o.x = v[j].x * rs * g4.x * (1.0f + sc.x) + sh.x; o.y = v[j].y * rs * g4.y * (1.0f + sc.y) + sh.y;
        o.z = v[j].z * rs * g4.z * (1.0f + sc.z) + sh.z; o.w = v[j].w * rs * g4.w * (1.0f + sc.w) + sh.w;
        st_wt8(hout + (size_t)row * DM + col, make_uint2(pk2(o.x, o.y), pk2(o.z, o.w)));
    }
}
__device__ __forceinline__ void ph_modnorm(const Params& p, const float* xin, const float* g, int sh_off, int sc_off, bf16_t* hout, int bid, int nb, float* lds) {
    const int tid = tid_(), wave = tid >> 6, lane = tid & 63;
    const int stride = nb * 8;
    float4 va[8], vb[8], vc[8];
    int row = bid * 8 + wave;
    if (row < NTOK) mn_load(xin, row, lane, va);
    if (row + stride < NTOK) mn_load(xin, row + stride, lane, vb);
    for (; row < NTOK; row += 3 * stride) {
        if (row + 2 * stride < NTOK) mn_load(xin, row + 2 * stride, lane, vc);
        mn_row(p, g, sh_off, sc_off, hout, row, lane, va);
        if (row + stride >= NTOK) break;
        if (row + 3 * stride < NTOK) mn_load(xin, row + 3 * stride, lane, va);
        mn_row(p, g, sh_off, sc_off, hout, row + stride, lane, vb);
        if (row + 2 * stride >= NTOK) break;
        if (row + 4 * stride < NTOK) mn_load(xin, row + 4 * stride, lane, vb);
        mn_row(p, g, sh_off, sc_off, hout, row + 2 * stride, lane, vc);
    }
}

typedef short bf16x8_t __attribute__((ext_vector_type(8)));
typedef float f32x4_t __attribute__((ext_vector_type(4)));
__device__ __forceinline__ bf16x8_t ldfrag(const char* base, int row, int chunk, int rb, int sm) { return *(const bf16x8_t*)(base + row * rb + ((chunk ^ (row & sm)) << 4)); }
__device__ __forceinline__ void ph_gmlp2(const Params& p, int bid, int nb, float* lds) {
    char* WM = (char*)lds; char* VT = WM + 32768;
    const int tid = tid_(), wave = tid >> 6, lane = tid & 63, fr = lane & 15, fq = lane >> 4;
    int gl = -1;
    for (int it = bid; it < 512; it += nb) {
        const int g = it & 7, n = (it >> 3) & 31, b = it >> 8;
        const int tok0 = b * SQ + n * 128;
        __syncthreads();
        if (g != gl) {
            for (int u = tid; u < 2048; u += NTH) {
                const int i = u >> 4, c = u & 15;
                const float4* src = (const float4*)(p.gm_ws + (size_t)g * 16384 + i * 128 + c * 8);
                float4 a = src[0], b4 = src[1];
                if ((i >> 6) < (c >> 3)) { a = make_float4(0.f, 0.f, 0.f, 0.f); b4 = a; }
                *(uint4*)(WM + i * 256 + ((c ^ (i & 15)) << 4)) = make_uint4(pk2(a.x, a.y), pk2(a.z, a.w), pk2(b4.x, b4.y), pk2(b4.z, b4.w));
            }
            gl = g;
        }
        {
            const float2 gn = *(const float2*)(p.gm_v_g + g * 128 + lane * 2);
#pragma unroll 4
            for (int jj = 0; jj < 16; ++jj) {
                const int j = wave * 16 + jj;
                const unsigned w = *(const unsigned*)(p.ZG + (size_t)(tok0 + j) * ZW + 1024 + g * 128 + lane * 2);
                const float a = bflo(w), c2 = bfhi(w);
                const float ss = wave_sum(a * a + c2 * c2);
                const float rs = 1.0f / sqrtf(ss * (1.0f / 128.0f) + 1e-6f);
                const int d0 = lane * 2, d1 = d0 + 1;
                *(bf16_t*)(VT + d0 * 256 + (((j >> 3) ^ (d0 & 15)) << 4) + (j & 7) * 2) = (bf16_t)f2bf(a * rs * gn.x);
                *(bf16_t*)(VT + d1 * 256 + (((j >> 3) ^ (d1 & 15)) << 4) + (j & 7) * 2) = (bf16_t)f2bf(c2 * rs * gn.y);
            }
        }
        __syncthreads();
        {
            bf16x8_t A[4];
#pragma unroll
            for (int ks = 0; ks < 4; ++ks) A[ks] = ldfrag(VT, wave * 16 + fr, ks * 4 + fq, 256, 15);
            const int d0 = wave * 16 + fq * 4;
#pragma unroll
            for (int itl = 0; itl < 8; ++itl) {
                f32x4_t acc = {0.f, 0.f, 0.f, 0.f};
#pragma unroll
                for (int ks = 0; ks < 4; ++ks) if (itl >= 4 || ks < 2) acc = __builtin_amdgcn_mfma_f32_16x16x32_bf16(A[ks], ldfrag(WM, itl * 16 + fr, ks * 4 + fq, 256, 15), acc, 0, 0, 0);
                const int i = itl * 16 + fr;
                const float bias = p.gm_b[g * 128 + i];
                const size_t tok = (size_t)(tok0 + i);
                const uint2 uw = *(const uint2*)(p.ZG + tok * ZW + g * 128 + d0);
                *(uint2*)(p.yain + tok * 1024 + g * 128 + d0) = make_uint2(pk2(bflo(uw.x) * (acc[0] + bias), bfhi(uw.x) * (acc[1] + bias)), pk2(bflo(uw.y) * (acc[2] + bias), bfhi(uw.y) * (acc[3] + bias)));
            }
        }
    }
    __syncthreads();
}

__device__ __forceinline__ void ph_ret(const Params& p, int bid, int nb, float* lds) {
    float* Qs = lds;
    float* Ks = Qs + 64 * 129;
    float* Vs = Ks + 64 * 129;
    float* Ss = Vs + 64 * 16;
    float* At = Ss + 128 * 16;
    float* kd = At + 64 * 65;
    const int tid = tid_();
    const bf16_t* z = p.ZG;
    for (int it = bid; it < 256; it += nb) {
        const int vs = it & 15, h = (it >> 4) & 7, b = it >> 7;
        const float lg = log1pf(-exp2f(-5.0f - (float)h));
        const float cdec = expf(lg * 64.0f);
        __syncthreads();
        for (int i = tid; i < 2048; i += NTH) Ss[i] = 0.f;
        if (tid < 64) kd[tid] = expf(lg * (float)(63 - tid));
        for (int n = 0; n < 64; ++n) {
            const int tok0 = b * SQ + n * 64;
            __syncthreads();
            for (int e = tid; e < 4096; e += NTH) {
                const int i = e >> 6, dd = e & 63; const size_t tok = (size_t)(tok0 + i);
                const float cs = p.rope[(tok * 64 + dd) * 2], sn = p.rope[(tok * 64 + dd) * 2 + 1];
                const bf16_t* zr = z + tok * ZW;
                const float q1 = bf2f(zr[2048 + h * 128 + dd]), q2 = bf2f(zr[2048 + h * 128 + 64 + dd]);
                const float k1 = bf2f(zr[3072 + h * 128 + dd]), k2 = bf2f(zr[3072 + h * 128 + 64 + dd]);
                Qs[i * 129 + dd] = q1 * cs - q2 * sn; Qs[i * 129 + 64 + dd] = q1 * sn + q2 * cs;
                const float sc = 0.08838834764831845f;
                Ks[i * 129 + dd] = (k1 * cs - k2 * sn) * sc; Ks[i * 129 + 64 + dd] = (k1 * sn + k2 * cs) * sc;
            }
            for (int e = tid; e < 1024; e += NTH) { const int j = e >> 4, v = e & 15; Vs[e] = bf2f(z[(size_t)(tok0 + j) * ZW + 4096 + h * 256 + vs * 16 + v]); }
            __syncthreads();
            {
                const int j = tid & 63, i0 = (tid >> 6) * 8;
                float acc[8];
#pragma unroll
                for (int ii = 0; ii < 8; ++ii) acc[ii] = 0.f;
                for (int d = 0; d < 128; ++d) {
                    const float kv = Ks[j * 129 + d];
#pragma unroll
                    for (int ii = 0; ii < 8; ++ii) acc[ii] += Qs[(i0 + ii) * 129 + d] * kv;
                }
#pragma unroll
                for (int ii = 0; ii < 8; ++ii) { const int i = i0 + ii; At[i * 65 + j] = acc[ii] * expf(lg * fabsf((float)(i - j))); }
            }
            __syncthreads();
            {
                const int v = tid & 15, i0 = tid >> 4;
#pragma unroll
                for (int rep = 0; rep < 2; ++rep) {
                    const int i = i0 + 32 * rep;
                    float a = 0.f; for (int j = 0; j < 64; ++j) a += At[i * 65 + j] * Vs[j * 16 + v];
                    float c2 = 0.f; for (int d = 0; d < 128; ++d) c2 += Qs[i * 129 + d] * Ss[d * 16 + v];
                    p.obuf[(size_t)(tok0 + i) * DM + h * 256 + vs * 16 + v] = a + c2 * expf(lg * (float)(i + 1));
                }
            }
            __syncthreads();
            {
                const int v = tid & 15, d0 = tid >> 4;
#pragma unroll
                for (int rep = 0; rep < 4; ++rep) {
                    const int d = d0 + 32 * rep;
                    float a = 0.f; for (int j = 0; j < 64; ++j) a += Ks[j * 129 + d] * kd[j] * Vs[j * 16 + v];
                    Ss[d * 16 + v] = Ss[d * 16 + v] * cdec + a;
                }
            }
        }
    }
    __syncthreads();
}


__device__ __forceinline__ void ph_retprep(const Params& p, int bid, int nb, float* lds) {
    bf16_t* Kl = (bf16_t*)lds;
    bf16_t* Vl = Kl + 64 * 130;
    char* Qm = (char*)lds + 49664;
    char* Km = Qm + 16384;
    const int tid = tid_(), wave = tid >> 6, lane = tid & 63, fr = lane & 15, fq = lane >> 4;
    for (int it = bid; it < 1024; it += nb) {
        const int n = it & 63, h = (it >> 6) & 7, b = it >> 9;
        const int tok0 = b * SQ + n * 64;
        const size_t rowbase = (size_t)(b * 8 + h) * SQ + n * 64;
        const float lg = log1pf(-exp2f(-5.0f - (float)h));
        __syncthreads();
#pragma unroll
        for (int k = 0; k < 2; ++k) {
            const int u = tid + 512 * k, i = u >> 4, dd = (u & 15) * 4; const size_t tok = (size_t)(tok0 + i);
            const float4 r0 = *(const float4*)(p.rope + (tok * 64 + dd) * 2), r1 = *(const float4*)(p.rope + (tok * 64 + dd) * 2 + 4);
            const float cs[4] = {r0.x, r0.z, r1.x, r1.z}, sn[4] = {r0.y, r0.w, r1.y, r1.w};
            const bf16_t* zr = p.ZG + tok * ZW;
            const uint2 q1w = *(const uint2*)(zr + 2048 + h * 128 + dd), q2w = *(const uint2*)(zr + 2048 + h * 128 + 64 + dd);
            const uint2 k1w = *(const uint2*)(zr + 3072 + h * 128 + dd), k2w = *(const uint2*)(zr + 3072 + h * 128 + 64 + dd);
            const float q1[4] = {bflo(q1w.x), bfhi(q1w.x), bflo(q1w.y), bfhi(q1w.y)}, q2[4] = {bflo(q2w.x), bfhi(q2w.x), bflo(q2w.y), bfhi(q2w.y)};
            const float k1[4] = {bflo(k1w.x), bfhi(k1w.x), bflo(k1w.y), bfhi(k1w.y)}, k2[4] = {bflo(k2w.x), bfhi(k2w.x), bflo(k2w.y), bfhi(k2w.y)};
            const float sc = 0.08838834764831845f, kd = expf(lg * (float)(63 - i));
            float qa[4], qb[4], ka[4], kb[4];
#pragma unroll
            for (int e = 0; e < 4; ++e) { qa[e] = q1[e] * cs[e] - q2[e] * sn[e]; qb[e] = q1[e] * sn[e] + q2[e] * cs[e]; ka[e] = (k1[e] * cs[e] - k2[e] * sn[e]) * sc; kb[e] = (k1[e] * sn[e] + k2[e] * cs[e]) * sc; }
            const uint2 qaw = make_uint2(pk2(qa[0], qa[1]), pk2(qa[2], qa[3])), qbw = make_uint2(pk2(qb[0], qb[1]), pk2(qb[2], qb[3]));
            const uint2 kaw = make_uint2(pk2(ka[0], ka[1]), pk2(ka[2], ka[3])), kbw = make_uint2(pk2(kb[0], kb[1]), pk2(kb[2], kb[3]));
            *(uint2*)(p.Qr + (rowbase + i) * 128 + dd) = qaw; *(uint2*)(p.Qr + (rowbase + i) * 128 + 64 + dd) = qbw;
            const int c = dd >> 3, o8 = (dd & 7) * 2;
            *(uint2*)(Qm + i * 256 + ((c ^ (i & 15)) << 4) + o8) = qaw; *(uint2*)(Qm + i * 256 + (((c + 8) ^ (i & 15)) << 4) + o8) = qbw;
            *(uint2*)(Km + i * 256 + ((c ^ (i & 15)) << 4) + o8) = kaw; *(uint2*)(Km + i * 256 + (((c + 8) ^ (i & 15)) << 4) + o8) = kbw;
            *(unsigned*)(Kl + i * 130 + dd) = pk2(ka[0] * kd, ka[1] * kd); *(unsigned*)(Kl + i * 130 + dd + 2) = pk2(ka[2] * kd, ka[3] * kd);
            *(unsigned*)(Kl + i * 130 + 64 + dd) = pk2(kb[0] * kd, kb[1] * kd); *(unsigned*)(Kl + i * 130 + 64 + dd + 2) = pk2(kb[2] * kd, kb[3] * kd);
        }
#pragma unroll
        for (int k = 0; k < 4; ++k) {
            const int u = tid + 512 * k, j = u >> 5, c = u & 31;
            const uint4 w = *(const uint4*)(p.ZG + (size_t)(tok0 + j) * ZW + 4096 + h * 256 + c * 8);
            unsigned* d = (unsigned*)(Vl + j * 258 + c * 8); d[0] = w.x; d[1] = w.y; d[2] = w.z; d[3] = w.w;
        }
        __syncthreads();
        {
            const int jt = wave >> 1, it0 = 2 * (wave & 1);
            f32x4_t s0 = {0.f, 0.f, 0.f, 0.f}, s1 = {0.f, 0.f, 0.f, 0.f};
#pragma unroll
            for (int ks = 0; ks < 4; ++ks) {
                const bf16x8_t a = ldfrag(Km, jt * 16 + fr, ks * 4 + fq, 256, 15);
                const bf16x8_t b0 = ldfrag(Qm, it0 * 16 + fr, ks * 4 + fq, 256, 15), b1 = ldfrag(Qm, (it0 + 1) * 16 + fr, ks * 4 + fq, 256, 15);
                s0 = __builtin_amdgcn_mfma_f32_16x16x32_bf16(a, b0, s0, 0, 0, 0);
                s1 = __builtin_amdgcn_mfma_f32_16x16x32_bf16(a, b1, s1, 0, 0, 0);
            }
            const int j0 = jt * 16 + fq * 4;
            bf16_t* pg = p.Pm + (size_t)it * 4096;
#pragma unroll
            for (int tt = 0; tt < 2; ++tt) {
                const int i = (it0 + tt) * 16 + fr; const f32x4_t sv4 = tt ? s1 : s0; float pv[4];
#pragma unroll
                for (int r = 0; r < 4; ++r) pv[r] = sv4[r] * __expf(lg * fabsf((float)(i - (j0 + r))));
                *(uint2*)(pg + i * 64 + j0) = make_uint2(pk2(pv[0], pv[1]), pk2(pv[2], pv[3]));
            }
        }
        bf16_t* kt = p.KTd + (size_t)it * 8192;
#pragma unroll
        for (int k = 0; k < 2; ++k) {
            const int u = tid + 512 * k, jg = u & 7, d = u >> 3;
            unsigned w[4];
#pragma unroll
            for (int q = 0; q < 4; ++q) w[q] = (unsigned)Kl[(jg * 8 + 2 * q) * 130 + d] | ((unsigned)Kl[(jg * 8 + 2 * q + 1) * 130 + d] << 16);
            *(uint4*)(kt + d * 64 + jg * 8) = make_uint4(w[0], w[1], w[2], w[3]);
        }
        bf16_t* vt = p.Vt + (size_t)it * 16384;
#pragma unroll
        for (int k = 0; k < 4; ++k) {
            const int u = tid + 512 * k, jg = u & 7, v = u >> 3;
            unsigned w[4];
#pragma unroll
            for (int q = 0; q < 4; ++q) w[q] = (unsigned)Vl[(jg * 8 + 2 * q) * 258 + v] | ((unsigned)Vl[(jg * 8 + 2 * q + 1) * 258 + v] << 16);
            *(uint4*)(vt + v * 64 + jg * 8) = make_uint4(w[0], w[1], w[2], w[3]);
        }
    }
    __syncthreads();
}

__device__ __forceinline__ void ph_ret2(const Params& p, int bid, int nb, float* lds) {
    char* L = (char*)lds;
    constexpr int OQ = 0, OKT = 16384, OPP = 32768, OVT = 40960, TILE = 43008, OST = 2 * TILE;
    const int tid = tid_(), wave = tid >> 6, lane = tid & 63, fr = lane & 15, fq = lane >> 4;
    for (int it = bid; it < 256; it += nb) {
        const int itm = ((it & 7) * 2 + (it >> 7)) * 16 + ((it >> 3) & 15);
        const int vs = itm & 15, h = (itm >> 4) & 7, b = itm >> 7;
        const float lg = log1pf(-exp2f(-5.0f - (float)h));
        const float cdec = expf(lg * 64.0f);
        const size_t bh = (size_t)(b * 8 + h);
        const char* gQ = (const char*)(p.Qr + bh * SQ * 128);
        const char* gKT = (const char*)(p.KTd + bh * 64 * 8192);
        const char* gP = (const char*)(p.Pm + bh * 64 * 4096);
        const char* gVt = (const char*)(p.Vt + bh * 64 * 16384) + vs * 16 * 128;
        int lq[2], lkt[2];
#pragma unroll
        for (int u = 0; u < 2; ++u) { const int ci = tid + 512 * u; const int r = ci >> 4, c = ci & 15; lq[u] = r * 256 + ((c ^ (r & 15)) << 4); const int d = ci >> 3, c8 = ci & 7; lkt[u] = d * 128 + ((c8 ^ (d & 7)) << 4); }
        const int lp = (tid >> 3) * 128 + (((tid & 7) ^ ((tid >> 3) & 7)) << 4);
        const int lv = lp;
        uint4 qA0, qA1, tA0, tA1, pA, vA = make_uint4(0u, 0u, 0u, 0u), qB0, qB1, tB0, tB1, pB, vB = vA, qC0, qC1, tC0, tC1, pC, vC = vA, qD0, qD1, tD0, tD1, pD, vD = vA;
#define RET_LOAD(X_, n_) do { const size_t o0 = (size_t)(n_) * 16384 + (size_t)tid * 16, o1 = o0 + 8192; \
        q##X_##0 = *(const uint4*)(gQ + o0); q##X_##1 = *(const uint4*)(gQ + o1); t##X_##0 = *(const uint4*)(gKT + o0); t##X_##1 = *(const uint4*)(gKT + o1); p##X_ = *(const uint4*)(gP + (size_t)(n_) * 8192 + tid * 16); \
        if (tid < 128) v##X_ = *(const uint4*)(gVt + (size_t)(n_) * 32768 + tid * 16); } while (0)
#define RET_WRITE(X_, buf_) do { char* B_ = L + (buf_) * TILE; \
        *(uint4*)(B_ + OQ + lq[0]) = q##X_##0; *(uint4*)(B_ + OQ + lq[1]) = q##X_##1; *(uint4*)(B_ + OKT + lkt[0]) = t##X_##0; *(uint4*)(B_ + OKT + lkt[1]) = t##X_##1; *(uint4*)(B_ + OPP + lp) = p##X_; \
        if (tid < 128) *(uint4*)(B_ + OVT + lv) = v##X_; } while (0)
        __syncthreads();
        for (int i = tid; i < 1024; i += NTH) ((unsigned*)(L + OST))[i] = 0u;
        RET_LOAD(A, 0); RET_WRITE(A, 0); RET_LOAD(B, 1); RET_LOAD(C, 2); RET_LOAD(D, 3);
        f32x4_t sacc[2] = {{0.f, 0.f, 0.f, 0.f}, {0.f, 0.f, 0.f, 0.f}};
#define RET_STEP(n_, cur_, LS_, WS_) do { const int n = (n_); constexpr int cur = (cur_); \
            __syncthreads();                                     \
            if (n + 4 < 64) RET_LOAD(LS_, n + 4); \
            const char* T = L + cur * TILE; \
            if (wave < 4) {     \
                const int itl = wave; \
                f32x4_t o1 = {0.f, 0.f, 0.f, 0.f}, o2 = {0.f, 0.f, 0.f, 0.f}; \
                _Pragma("unroll") for (int ks = 0; ks < 2; ++ks) o1 = __builtin_amdgcn_mfma_f32_16x16x32_bf16(ldfrag(T + OPP, itl * 16 + fr, ks * 4 + fq, 128, 7), ldfrag(T + OVT, fr, ks * 4 + fq, 128, 7), o1, 0, 0, 0); \
                _Pragma("unroll") for (int ks = 0; ks < 4; ++ks) o2 = __builtin_amdgcn_mfma_f32_16x16x32_bf16(ldfrag(T + OQ, itl * 16 + fr, ks * 4 + fq, 256, 15), ldfrag(L + OST + cur * 4096, fr, ks * 4 + fq, 256, 15), o2, 0, 0, 0); \
                _Pragma("unroll") for (int r = 0; r < 4; ++r) { const int i = itl * 16 + fq * 4 + r; \
                    p.ob16[(size_t)(b * SQ + n * 64 + i) * DM + h * 256 + vs * 16 + fr] = (bf16_t)f2bf(o1[r] + __expf(lg * (float)(i + 1)) * o2[r]); } \
            } else {            \
                _Pragma("unroll") for (int u = 0; u < 2; ++u) { \
                    const int dt = 2 * (wave - 4) + u; \
                    sacc[u] = sacc[u] * cdec; \
                    _Pragma("unroll") for (int ks = 0; ks < 2; ++ks) sacc[u] = __builtin_amdgcn_mfma_f32_16x16x32_bf16(ldfrag(T + OKT, dt * 16 + fr, ks * 4 + fq, 128, 7), ldfrag(T + OVT, fr, ks * 4 + fq, 128, 7), sacc[u], 0, 0, 0); \
                    *(uint2*)(L + OST + (cur ^ 1) * 4096 + fr * 256 + (((dt * 2 + (fq >> 1)) ^ fr) << 4) + (fq & 1) * 8) = make_uint2(pk2(sacc[u][0], sacc[u][1]), pk2(sacc[u][2], sacc[u][3])); } \
            } \
            if (n + 1 < 64) RET_WRITE(WS_, cur ^ 1); } while (0)
#pragma unroll
        for (int n4 = 0; n4 < 64; n4 += 4) { RET_STEP(n4, 0, A, B); RET_STEP(n4 + 1, 1, B, C); RET_STEP(n4 + 2, 0, C, D); RET_STEP(n4 + 3, 1, D, A); }
#undef RET_STEP
#undef RET_LOAD
#undef RET_WRITE
    }
    __syncthreads();
}

__device__ __forceinline__ void gn_load(const Params& p, int tok, int lane, uint2 (&ow)[8], uint2 (&gw)[8]) {
#pragma unroll
    for (int h = 0; h < 8; ++h) { ow[h] = *(const uint2*)(p.ob16 + (size_t)tok * DM + h * 256 + lane * 4); gw[h] = *(const uint2*)(p.ZG + (size_t)tok * ZW + 6144 + h * 256 + lane * 4); }
}
__device__ __forceinline__ void ph_gn(const Params& p, int bid, int nb, float* lds) {
    const int tid = tid_(), wave = tid >> 6, lane = tid & 63;
    const int stride = nb * 8;
    int tok = bid * 8 + wave;
    uint2 ow[8], gw[8], own[8], gwn[8];
    if (tok < NTOK) gn_load(p, tok, lane, ow, gw);
    for (; tok < NTOK; tok += stride) {
        if (tok + stride < NTOK) gn_load(p, tok + stride, lane, own, gwn);
        float4 o[8]; float s1[8], s2[8];
#pragma unroll
        for (int h = 0; h < 8; ++h) { o[h] = make_float4(bflo(ow[h].x), bfhi(ow[h].x), bflo(ow[h].y), bfhi(ow[h].y)); s1[h] = (o[h].x + o[h].y) + (o[h].z + o[h].w); }
#pragma unroll
        for (int h = 0; h < 8; ++h) s1[h] = row_sum16(s1[h]);
#pragma unroll
        for (int h = 0; h < 8; ++h) s1[h] = xsum32(xsum16(s1[h]));
#pragma unroll
        for (int h = 0; h < 8; ++h) { const float mu = s1[h] * (1.0f / 256.0f); o[h].x -= mu; o[h].y -= mu; o[h].z -= mu; o[h].w -= mu; s2[h] = dot4(o[h], o[h]); }
#pragma unroll
        for (int h = 0; h < 8; ++h) s2[h] = row_sum16(s2[h]);
#pragma unroll
        for (int h = 0; h < 8; ++h) s2[h] = xsum32(xsum16(s2[h]));
#pragma unroll
        for (int h = 0; h < 8; ++h) {
            const float rs = 1.0f / sqrtf(s2[h] * (1.0f / 256.0f) + 1e-6f);
            const float4 gn = *(const float4*)(p.ret_gn_g + h * 256 + lane * 4);
            const float g0 = bflo(gw[h].x), g1 = bfhi(gw[h].x), g2 = bflo(gw[h].y), g3 = bfhi(gw[h].y);
            st_wt8(p.ybin + (size_t)tok * DM + h * 256 + lane * 4,
                make_uint2(pk2(siluf_(g0) * o[h].x * rs * gn.x, siluf_(g1) * o[h].y * rs * gn.y), pk2(siluf_(g2) * o[h].z * rs * gn.z, siluf_(g3) * o[h].w * rs * gn.w)));
        }
#pragma unroll
        for (int h = 0; h < 8; ++h) { ow[h] = own[h]; gw[h] = gwn[h]; }
    }
}

__device__ __forceinline__ void split8(const float4 a, const float4 b, uint4& hi, uint4& lo) {
    const float x[8] = {a.x, a.y, a.z, a.w, b.x, b.y, b.z, b.w}; unsigned h[8], l[8];
#pragma unroll
    for (int i = 0; i < 8; ++i) { h[i] = f2bf(x[i]); l[i] = f2bf(x[i] - __uint_as_float(h[i] << 16)); }
    hi = make_uint4(h[0] | (h[1] << 16), h[2] | (h[3] << 16), h[4] | (h[5] << 16), h[6] | (h[7] << 16));
    lo = make_uint4(l[0] | (l[1] << 16), l[2] | (l[3] << 16), l[4] | (l[5] << 16), l[6] | (l[7] << 16));
}
__device__ __forceinline__ bf16x8_t as_bf16x8(const uint4 v) { return __builtin_bit_cast(bf16x8_t, v); }
struct PairTab { int a[52], b[52]; };
__host__ __device__ constexpr PairTab make_pairs() {
    PairTab t{}; int n = 0;
    for (int a = 0; a < 16; ++a) for (int b = 0; b < 16; ++b) if ((a + 1) * (b + 1) <= 16) { t.a[n] = a; t.b[n] = b; ++n; }
    for (; n < 52; ++n) { t.a[n] = -1; t.b[n] = -1; }
    return t;
}
constexpr PairTab PAIRS = make_pairs();
static_assert(PAIRS.a[49] >= 0 && PAIRS.a[50] < 0, "50 candidate pairs");

template <int N, int OFF> __device__ __forceinline__ void bitonic_sort_desc(float* v) {
#pragma unroll
    for (int k = 2; k <= N; k <<= 1)
#pragma unroll
        for (int j = k >> 1; j > 0; j >>= 1)
#pragma unroll
            for (int i = 0; i < N; ++i) { const int l = i ^ j; if (l > i) { const bool up = ((i & k) == 0);
                const float a = v[OFF + i], b = v[OFF + l]; const float mx = fmaxf(a, b), mn = fminf(a, b); v[OFF + i] = up ? mx : mn; v[OFF + l] = up ? mn : mx; } }
}
template <int N> __device__ __forceinline__ void bitonic_merge_desc(float* v) {
#pragma unroll
    for (int j = N >> 1; j > 0; j >>= 1)
#pragma unroll
        for (int i = 0; i < N; ++i) { const int l = i ^ j; if (l > i) { const float a = v[i], b = v[l]; v[i] = fmaxf(a, b); v[l] = fminf(a, b); } }
}
__device__ __forceinline__ void ph_topk2(const Params& p, const float* qb, int bid, int nb, float* lds, int it_fixed) {
    const int tid = tid_(), wave = tid >> 6, lane = tid & 63;
    uint4* SK = (uint4*)lds;
    const float NEG = -INFINITY;
    const bool tc_on = (nb == 256); const int tcr0 = (bid * 8 + wave) * 16; float4 tct[8];
    if (tc_on) tc_load(p, tcr0, lane, tct);
    for (int it = (it_fixed >= 0 ? it_fixed : bid); it < 256; it += (it_fixed >= 0 ? 256 : nb)) {
        const int h = it & 7, tg = it >> 3;
        __syncthreads();
        for (int gi = tid; gi < 4096; gi += NTH) {
            const int dq = gi & 15, n = (gi >> 4) & 127, pp = gi >> 11;
            const float4* src = (const float4*)(p.peer_sk + ((size_t)(h * 2 + pp) * 128 + n) * 128 + dq * 8);
            uint4 hi, lo; split8(src[0], src[1], hi, lo);
            const int base = (((pp * 8 + (n >> 4)) * 4 + (dq >> 2)) * 2) * 64 + (dq & 3) * 16 + (n & 15);
            SK[base] = hi; SK[base + 64] = lo;
        }
        __syncthreads();
#pragma unroll 1
        for (int tile = 0; tile < 2; ++tile) {
            const int tok = tg * 256 + wave * 32 + tile * 16 + (lane & 15);
            const int qd = lane >> 4;
            float v12[2][16];
#pragma unroll
            for (int pp = 0; pp < 2; ++pp) {
                if (tc_on) { const int ti = tile * 8 + pp * 4; tc_finish(p, tcr0 + ti, lane, tct); tc_load(p, tcr0 + ti + 1, lane, tct); }
                bf16x8_t Bh[4], Bl[4];
                const float* qp = qb + (size_t)tok * DM + h * 256 + pp * 128 + 8 * qd;
#pragma unroll
                for (int ks = 0; ks < 4; ++ks) { uint4 hi, lo; split8(*(const float4*)(qp + ks * 32), *(const float4*)(qp + ks * 32 + 4), hi, lo); Bh[ks] = as_bf16x8(hi); Bl[ks] = as_bf16x8(lo); }
                float v[32];
#pragma unroll
                for (int kt = 0; kt < 8; ++kt) {
                    f32x4_t acc = {0.f, 0.f, 0.f, 0.f};
#pragma unroll
                    for (int ks = 0; ks < 4; ++ks) {
                        const bf16x8_t Ah = as_bf16x8(SK[(((pp * 8 + kt) * 4 + ks) * 2) * 64 + lane]), Al = as_bf16x8(SK[(((pp * 8 + kt) * 4 + ks) * 2 + 1) * 64 + lane]);
                        acc = __builtin_amdgcn_mfma_f32_16x16x32_bf16(Ah, Bh[ks], acc, 0, 0, 0);
                        acc = __builtin_amdgcn_mfma_f32_16x16x32_bf16(Ah, Bl[ks], acc, 0, 0, 0);
                        acc = __builtin_amdgcn_mfma_f32_16x16x32_bf16(Al, Bh[ks], acc, 0, 0, 0);
                    }
#pragma unroll
                    for (int r = 0; r < 4; ++r) v[kt * 4 + r] = __uint_as_float((__float_as_uint(acc[r]) & ~127u) | (unsigned)(kt * 16 + qd * 4 + r));
                    __builtin_amdgcn_sched_barrier(0);
                }
                if (tc_on) { const int ti = tile * 8 + pp * 4 + 1; tc_finish(p, tcr0 + ti, lane, tct); tc_load(p, tcr0 + ti + 1, lane, tct); }
                bitonic_sort_desc<16, 0>(v); bitonic_sort_desc<16, 16>(v);
                float c16[16];
#pragma unroll
                for (int i = 0; i < 16; ++i) c16[i] = fmaxf(v[i], v[31 - i]);
                bitonic_merge_desc<16>(c16);
                if (tc_on) { const int ti = tile * 8 + pp * 4 + 2; tc_finish(p, tcr0 + ti, lane, tct); tc_load(p, tcr0 + ti + 1, lane, tct); }
#pragma unroll
                for (int st = 0; st < 2; ++st) {
                    float pr[16];
#pragma unroll
                    for (int i = 0; i < 16; ++i) pr[i] = __shfl_xor(c16[i], 16 << st);
#pragma unroll
                    for (int i = 0; i < 16; ++i) c16[i] = fmaxf(c16[i], pr[15 - i]);
                    bitonic_merge_desc<16>(c16);
                }
                if (tc_on) { const int ti = tile * 8 + pp * 4 + 3; tc_finish(p, tcr0 + ti, lane, tct); if (ti < 15) tc_load(p, tcr0 + ti + 1, lane, tct); }
#pragma unroll
                for (int i = 0; i < 16; ++i) v12[pp][i] = c16[i];
            }
            float c[13]; unsigned pay[13];
#pragma unroll
            for (int s = 0; s < 13; ++s) {
                float cq[4]; unsigned pq[4];
#pragma unroll
                for (int q = 0; q < 4; ++q) {
                    const int pi = 4 * s + q; const int a = PAIRS.a[pi], b = PAIRS.b[pi];
                    if (a >= 0) {
                        const float sum = v12[0][a] + v12[1][b];
                        cq[q] = __uint_as_float((__float_as_uint(sum) & ~63u) | (unsigned)pi);
                        pq[q] = (__float_as_uint(v12[0][a]) & 127u) * 128u + (__float_as_uint(v12[1][b]) & 127u);
                    } else { cq[q] = NEG; pq[q] = 0u; }
                }
                c[s] = qd == 0 ? cq[0] : qd == 1 ? cq[1] : qd == 2 ? cq[2] : cq[3];
                pay[s] = qd == 0 ? pq[0] : qd == 1 ? pq[1] : qd == 2 ? pq[2] : pq[3];
            }
            float top[16]; unsigned eid[16];
#pragma unroll
            for (int r = 0; r < 16; ++r) {
                float m = c[0];
#pragma unroll
                for (int s = 1; s < 13; ++s) m = fmaxf(m, c[s]);
                m = fmaxf(m, __shfl_xor(m, 16)); m = fmaxf(m, __shfl_xor(m, 32));
                unsigned pw = 0u;
#pragma unroll
                for (int s = 0; s < 13; ++s) { const bool eq = (c[s] == m); pw |= eq ? pay[s] : 0u; c[s] = eq ? NEG : c[s]; }
                pw |= (unsigned)__shfl_xor((int)pw, 16); pw |= (unsigned)__shfl_xor((int)pw, 32);
                top[r] = m; eid[r] = pw;
            }
            float sum = 0.f; const float mx = top[0];
#pragma unroll
            for (int r = 0; r < 16; ++r) { top[r] = expf(top[r] - mx); sum += top[r]; }
            const float inv = 1.0f / sum;
            if (lane < 16) {
                int4* ep = (int4*)(p.eidx + (size_t)tok * 128 + h * 16); float4* gp = (float4*)(p.gatev + (size_t)tok * 128 + h * 16);
#pragma unroll
                for (int q = 0; q < 4; ++q) {
                    ep[q] = make_int4((int)eid[4 * q], (int)eid[4 * q + 1], (int)eid[4 * q + 2], (int)eid[4 * q + 3]);
                    gp[q] = make_float4(top[4 * q] * inv, top[4 * q + 1] * inv, top[4 * q + 2] * inv, top[4 * q + 3] * inv);
                }
            }
        }
    }
    __syncthreads();
}

__device__ __forceinline__ void peer_load4(const unsigned char* tab, const int (&e)[4], int lane, uint2 (&R)[4][3]) {
#pragma unroll
    for (int i = 0; i < 4; ++i) { const uint2* r = (const uint2*)(tab + (size_t)e[i] * ROW6 + lane * 8); R[i][0] = r[0]; R[i][1] = r[64]; R[i][2] = r[128]; }
}
__device__ __forceinline__ f32x32_t dec6(const uint2 (&R)[3]) { const u32x6_t w = {R[0].x, R[0].y, R[1].x, R[1].y, R[2].x, R[2].y}; return __builtin_amdgcn_cvt_scalef32_pk32_f32_fp6(w, 1.0f); }
typedef float f32x2_t __attribute__((ext_vector_type(2)));
__device__ __forceinline__ bf16x8_t dec4_frag(unsigned w) {
    const unsigned a = __builtin_bit_cast(unsigned, __builtin_amdgcn_cvt_scalef32_pk_bf16_fp4(w, 1.0f, 0)), b = __builtin_bit_cast(unsigned, __builtin_amdgcn_cvt_scalef32_pk_bf16_fp4(w, 1.0f, 1));
    const unsigned c = __builtin_bit_cast(unsigned, __builtin_amdgcn_cvt_scalef32_pk_bf16_fp4(w, 1.0f, 2)), d = __builtin_bit_cast(unsigned, __builtin_amdgcn_cvt_scalef32_pk_bf16_fp4(w, 1.0f, 3));
    return as_bf16x8(make_uint4(a, b, c, d));
}
__device__ __forceinline__ void peer_vgroup(const Params& p, int lane, const uint4 (&Vc)[4], const float (&wgt)[4], f32x2_t (&y2)[16]) {
#pragma unroll
    for (int i = 0; i < 4; ++i) {
        const f32x2_t w2 = {wgt[i], wgt[i]};
        const unsigned vw[4] = {Vc[i].x, Vc[i].y, Vc[i].z, Vc[i].w};
#pragma unroll
        for (int j = 0; j < 4; ++j) {
            y2[4 * j + 0] += w2 * __builtin_amdgcn_cvt_scalef32_pk_f32_fp4(vw[j], 1.0f, 0);
            y2[4 * j + 1] += w2 * __builtin_amdgcn_cvt_scalef32_pk_f32_fp4(vw[j], 1.0f, 1);
            y2[4 * j + 2] += w2 * __builtin_amdgcn_cvt_scalef32_pk_f32_fp4(vw[j], 1.0f, 2);
            y2[4 * j + 3] += w2 * __builtin_amdgcn_cvt_scalef32_pk_f32_fp4(vw[j], 1.0f, 3);
        }
    }
}
__device__ __forceinline__ void ph_peer6(const Params& p, const float* x1, const bf16_t* h2, int bid, int nb, float* lds) {
    const int tid = tid_(), wave = tid >> 6, lane0 = tid & 63;
    for (int t = bid * 8 + wave; t < NTOK; t += nb * 8) {
        int lane = lane0; asm volatile("" : "+v"(lane));
        const int fr = lane & 15, kq = lane >> 4;
        char* HL = (char*)lds + wave * 4608;
        float* WL = (float*)(HL + 4096);
        const int b = t / SQ;
#pragma unroll
        for (int q = 0; q < 4; ++q) *(uint4*)(HL + (lane + 64 * q) * 16) = *(const uint4*)(h2 + (size_t)t * DM + (lane + 64 * q) * 8);
        const int e0 = p.eidx[(size_t)t * 128 + lane], e1 = p.eidx[(size_t)t * 128 + 64 + lane];
        const float su0 = p.su[e0], su1 = p.su[e1];
        const float gv0 = p.gatev[(size_t)t * 128 + lane] * p.sv[e0], gv1 = p.gatev[(size_t)t * 128 + 64 + lane] * p.sv[e1];
        unsigned ur[8];
#pragma unroll
        for (int G = 0; G < 8; ++G) ur[G] = (unsigned)__shfl(G < 4 ? e0 : e1, 16 * (G & 3) + fr) * (unsigned)ROW4 + (unsigned)kq * 16u;
        f32x4_t acc[8];
#pragma unroll
        for (int G = 0; G < 8; ++G) acc[G] = (f32x4_t){0.f, 0.f, 0.f, 0.f};
        uint4 Ac[8];
#pragma unroll
        for (int G = 0; G < 8; ++G) Ac[G] = *(const uint4*)(p.U8 + ur[G]);
#pragma unroll 1
        for (int blk = 0; blk < 16; ++blk) {
            const unsigned nof = (unsigned)((blk < 15) ? blk + 1 : blk) * 64u;
            bf16x8_t B[4];
#pragma unroll
            for (int sidx = 0; sidx < 4; ++sidx) B[sidx] = *(const bf16x8_t*)(HL + (blk * 128 + sidx * 32 + kq * 8) * 2);
#pragma unroll
            for (int G = 0; G < 8; ++G) {
                const bf16x8_t f0 = dec4_frag(Ac[G].x), f1 = dec4_frag(Ac[G].y), f2 = dec4_frag(Ac[G].z), f3 = dec4_frag(Ac[G].w);
                Ac[G] = *(const uint4*)(p.U8 + (ur[G] + nof));
                acc[G] = __builtin_amdgcn_mfma_f32_16x16x32_bf16(f0, B[0], acc[G], 0, 0, 0);
                acc[G] = __builtin_amdgcn_mfma_f32_16x16x32_bf16(f1, B[1], acc[G], 0, 0, 0);
                acc[G] = __builtin_amdgcn_mfma_f32_16x16x32_bf16(f2, B[2], acc[G], 0, 0, 0);
                acc[G] = __builtin_amdgcn_mfma_f32_16x16x32_bf16(f3, B[3], acc[G], 0, 0, 0);
                __builtin_amdgcn_sched_barrier(0);
            }
        }
        const int kq4 = 4 * kq;
#pragma unroll
        for (int G = 0; G < 8; ++G) {
            float av[4];
#pragma unroll
            for (int j = 0; j < 4; ++j) av[j] = acc[G][j] * __shfl(G < 4 ? su0 : su1, (16 * (G & 3) + j) + kq4);
            const f32x2_t g01 = pg8::gelu_pk((f32x2_t){av[0], av[1]}), g23 = pg8::gelu_pk((f32x2_t){av[2], av[3]});
            const float w0 = g01.x * __shfl(G < 4 ? gv0 : gv1, (16 * (G & 3) + 0) + kq4), w1 = g01.y * __shfl(G < 4 ? gv0 : gv1, (16 * (G & 3) + 1) + kq4);
            const float w2_ = g23.x * __shfl(G < 4 ? gv0 : gv1, (16 * (G & 3) + 2) + kq4), w3 = g23.y * __shfl(G < 4 ? gv0 : gv1, (16 * (G & 3) + 3) + kq4);
            if (fr == 0) *(float4*)(WL + 16 * G + kq4) = make_float4(w0, w1, w2_, w3);
            __builtin_amdgcn_sched_barrier(0);
        }
        f32x2_t y2[16];
#pragma unroll
        for (int i = 0; i < 16; ++i) y2[i] = (f32x2_t){0.f, 0.f};
        uint4 Vc[4], Vn[4];
#pragma unroll
        for (int i = 0; i < 4; ++i) Vc[i] = *(const uint4*)(p.V8 + ((unsigned)__builtin_amdgcn_readlane(e0, i) * (unsigned)ROW4 + (unsigned)lane * 16u));
#pragma unroll
        for (int G = 0; G < 8; ++G) {
#pragma unroll 1
            for (int q = 0; q < 4; ++q) {
                {
                    const int gn = 4 * G + q + ((G == 7 && q == 3) ? 0 : 1); const int sn = 4 * gn;
                    const int en = (sn < 64) ? e0 : e1;
#pragma unroll
                    for (int i = 0; i < 4; ++i) Vn[i] = *(const uint4*)(p.V8 + ((unsigned)__builtin_amdgcn_readlane(en, (sn + i) & 63) * (unsigned)ROW4 + (unsigned)lane * 16u));
                }
                const float4 w4 = *(const float4*)(WL + 16 * G + 4 * q);
                const float wgt[4] = {w4.x, w4.y, w4.z, w4.w};
                peer_vgroup(p, lane, Vc, wgt, y2);
#pragma unroll
                for (int i = 0; i < 4; ++i) Vc[i] = Vn[i];
            }
        }
        float y[32];
#pragma unroll
        for (int k = 0; k < 16; ++k) { y[2 * k] = y2[k].x; y[2 * k + 1] = y2[k].y; }
        float ss = 0.f;
#pragma unroll
        for (int q = 0; q < 8; ++q) {
            const int c = 256 * q + lane * 4;
            const float4 xv = *(const float4*)(x1 + (size_t)t * DM + c);
            const float4 ga = *(const float4*)(p.ada + b * NMOD + 5 * DM + c);
            float* yy = y + 4 * q;
            yy[0] = xv.x + ga.x * yy[0]; yy[1] = xv.y + ga.y * yy[1]; yy[2] = xv.z + ga.z * yy[2]; yy[3] = xv.w + ga.w * yy[3];
            ss += yy[0] * yy[0] + yy[1] * yy[1] + yy[2] * yy[2] + yy[3] * yy[3];
        }
        ss = xsum32(xsum16(row_sum16(ss)));
        const float rs = 1.0f / sqrtf(ss * (1.0f / DM) + 1e-6f);
#pragma unroll
        for (int q = 0; q < 8; ++q) {
            const int c = 256 * q + lane * 4;
            const float4 gf = *(const float4*)(p.norm_f_g + c);
            const float* yy = y + 4 * q;
            *(float4*)(p.out + (size_t)t * DM + c) = make_float4(yy[0] * rs * gf.x, yy[1] * rs * gf.y, yy[2] * rs * gf.z, yy[3] * rs * gf.w);
        }
    }
}

#define LAS __attribute__((address_space(3)))
#define XB_TMO      128
#define XB_XCNT(j)  (256  + 64 * (j))
#define XB_XSUB(j)  (1280 + 64 * (j))
#define XB_XGEN(j)  (2304 + 64 * (j))
#define XB_TOP      3328
#define XB_TOPGEN   3392
#define XCD_BAR_WORDS 3456
#define XB_SPIN_CAP (1u << 18)

__device__ __forceinline__ unsigned xb_ld(unsigned* p)              { return __hip_atomic_load(p, __ATOMIC_RELAXED, __HIP_MEMORY_SCOPE_AGENT); }
__device__ __forceinline__ unsigned xb_add(unsigned* p, unsigned v) { return __hip_atomic_fetch_add(p, v, __ATOMIC_RELAXED, __HIP_MEMORY_SCOPE_AGENT); }
__device__ __forceinline__ unsigned xb_xcc_id() { return (unsigned)__builtin_amdgcn_s_getreg((3 << 11) | 20) & 0xFu; }
#define XB_SPIN(cond, bar) do { unsigned _sp = 0; while (cond) { __builtin_amdgcn_s_sleep(1); \
    if ((++_sp & 255u) == 0u) { if (xb_ld(&(bar)[XB_TMO])) break; if (_sp > XB_SPIN_CAP) { atomicAdd(&(bar)[XB_TMO], 1u); break; } } } } while (0)

struct XcdBarrier {
    unsigned* bar; unsigned x;
    volatile LAS unsigned* st;
};

__device__ __forceinline__ XcdBarrier xcd_barrier_post(unsigned* bar, volatile LAS unsigned* st) {
    XcdBarrier b; b.bar = bar; b.x = xb_xcc_id(); b.st = st;
    if (tid_() == 0) (void)xb_add(&bar[XB_XCNT(b.x)], 1u);
    return b;
}
__device__ __forceinline__ void xcd_barrier_complete(unsigned* bar, unsigned x, unsigned& nloc, unsigned& nx) {
    const unsigned G = gridDim.x * gridDim.y * gridDim.z;
    unsigned sum, cnt, mine, sp = 0u;
    for (;;) {
        sum = 0u; cnt = 0u; mine = 0u;
#pragma unroll
        for (unsigned j = 0; j < 16; ++j) { const unsigned c = xb_ld(&bar[XB_XCNT(j)]); sum += c; cnt += (c > 0u) ? 1u : 0u; mine = (j == x) ? c : mine; }
        if (sum == G) break;
        __builtin_amdgcn_s_sleep(1);
        if ((++sp & 255u) == 0u) { if (xb_ld(&bar[XB_TMO])) break; if (sp > XB_SPIN_CAP) { atomicAdd(&bar[XB_TMO], 1u); break; } }
    }
    nloc = mine > 0u ? mine : 1u; nx = cnt > 0u ? cnt : 1u;
}

__device__ __forceinline__ void xcd_barrier(const XcdBarrier& b) {
    asm volatile("s_waitcnt vmcnt(0)" ::: "memory");
    __syncthreads();
    if (tid_() == 0) {
        unsigned* bar = b.bar;
        __builtin_amdgcn_s_waitcnt(0);
        unsigned nloc = b.st[0], nx = b.st[1];
        if (nloc == 0u) { xcd_barrier_complete(bar, b.x, nloc, nx); b.st[0] = nloc; b.st[1] = nx; }
        const unsigned old = xb_add(&bar[XB_XSUB(b.x)], 1u);
        const unsigned gen = old / nloc;
        if (old + 1u == (gen + 1u) * nloc) {
            __builtin_amdgcn_fence(__ATOMIC_RELEASE, "agent");
            asm volatile("s_waitcnt vmcnt(0)" ::: "memory");
            const unsigned og = xb_add(&bar[XB_TOP], 1u);
            const unsigned tg = og / nx;
            if (og + 1u == (tg + 1u) * nx) xb_add(&bar[XB_TOPGEN], 1u);
            else XB_SPIN(xb_ld(&bar[XB_TOPGEN]) == tg, bar);
            __builtin_amdgcn_fence(__ATOMIC_ACQUIRE, "agent");
            xb_add(&bar[XB_XGEN(b.x)], 1u);
            asm volatile("s_waitcnt vmcnt(0)" ::: "memory");
        } else {
            XB_SPIN(xb_ld(&bar[XB_XGEN(b.x)]) == gen, bar);
            __builtin_amdgcn_fence(__ATOMIC_ACQUIRE, "agent");
            asm volatile("s_waitcnt vmcnt(0)" ::: "memory");
        }
    }
    __syncthreads();
}

template <class Epi>
__device__ __forceinline__ void gemm_run(float* lds, const bf16_t* A, const bf16_t* Bt, int M, int N, int K, const Epi& E) {
    __syncthreads();
    pg8::Gemm g{A, Bt, M, N, K}; pg8::StaticOrder S; S.init(M, N, (int)gridDim.x, (int)blockIdx.x);
    pg8::gemm_phase<Epi, pg8::StaticOrder, true, true>((PG8_LAS unsigned char*)lds, g, S, E);
    __syncthreads();
}
constexpr int NPHASE = 11;
template <int PH>
__device__ __forceinline__ void run_phase(const Params& p, int bid, int nb, float* lds) {
    asm volatile("" : "+s"(bid));
    if constexpr (PH == 0) ph_prep(p, bid, nb, lds);
    if constexpr (PH == 1) ph_modnorm(p, p.x, p.norm1_g, 0 * DM, 1 * DM, p.hb, bid, nb, lds);
    if constexpr (PH == 2) gemm_run(lds, p.hb, p.Wt1, NTOK, ZW, DM, pg8::EpiZG{p.ZG, p.b_bg});
    if constexpr (PH == 3) { ph_retprep(p, bid, nb, lds); ph_gmlp2(p, bid, nb, lds); }
    if constexpr (PH == 11) ph_ret2(p, bid, nb, lds);
    if constexpr (PH == 4) ph_gn(p, bid, nb, lds);
    if constexpr (PH == 5) {
        gemm_run(lds, p.yain, p.Wta, NTOK, DM, 1024, pg8::EpiMixB<0>{p.hb, p.ZG, 0});
        gemm_run(lds, p.ybin, p.Wtb, NTOK, DM, DM, pg8::EpiMixB<1>{p.hb, p.ZG, 2048});
    }
    if constexpr (PH == 6) gemm_run(lds, p.hb, p.Wto, NTOK, DM, DM, pg8::EpiResF{p.obuf, p.x, p.ada + 2 * DM});
    if constexpr (PH == 7) { ph_modnorm(p, p.obuf, p.norm2_g, 3 * DM, 4 * DM, p.hb, bid, nb, lds); if (nb != 256) ph_tabconv(p, bid, nb); }
    if constexpr (PH == 8) {
        gemm_run(lds, p.hb, p.Wtq, NTOK, DM, DM, pg8::EpiF32{p.qbuf, DM});
        if (nb == 256) {
            pg8::StaticOrder S; S.init(NTOK, DM, (int)gridDim.x, (int)blockIdx.x); pg8::Unit u; S.next(0, u);
            asm volatile("s_waitcnt vmcnt(0)" ::: "memory"); __syncthreads();
            ph_topk2(p, p.qbuf, bid, nb, lds, u.pm * 8 + u.pn);
        }
    }
    if constexpr (PH == 9) { if (nb != 256) ph_topk2(p, p.qbuf, bid, nb, lds, -1); }
    if constexpr (PH == 10) ph_peer6(p, p.obuf, p.hb, bid, nb, lds);
}

constexpr int MISC_OFF = 132 * 1024;
__global__ void __launch_bounds__(NTH) k_mega(Params p) {
    extern __shared__ __attribute__((aligned(16))) float lds[];
    const int bid = blockIdx.x, nb = gridDim.x;
    volatile LAS unsigned* misc = (volatile LAS unsigned*)((LAS unsigned char*)lds + MISC_OFF);
    if (threadIdx.x < 4) misc[threadIdx.x] = 0u;
    if ((threadIdx.x & 63) == 0) *(volatile LASP unsigned*)(unsigned)(TIDW_OFF + 4 * hw_slot_()) = threadIdx.x >> 6;
    __syncthreads();
    XcdBarrier bar = xcd_barrier_post(p.bar, misc);
    run_phase<0>(p, bid, nb, lds); xcd_barrier(bar);
    run_phase<1>(p, bid, nb, lds); xcd_barrier(bar);
    run_phase<2>(p, bid, nb, lds); xcd_barrier(bar);
    run_phase<3>(p, bid, nb, lds); xcd_barrier(bar);
    run_phase<11>(p, bid, nb, lds); xcd_barrier(bar);
    run_phase<4>(p, bid, nb, lds); xcd_barrier(bar);
    run_phase<5>(p, bid, nb, lds); xcd_barrier(bar);
    run_phase<6>(p, bid, nb, lds); xcd_barrier(bar);
    run_phase<7>(p, bid, nb, lds); xcd_barrier(bar);
    run_phase<8>(p, bid, nb, lds); xcd_barrier(bar);
    if (nb != 256) { run_phase<9>(p, bid, nb, lds); xcd_barrier(bar); }
    run_phase<10>(p, bid, nb, lds);
}

extern "C" void kernel_launch(void* const* d_in, const int* in_sizes, int n_in, void* d_out, int out_size, void* d_ws, size_t ws_size, hipStream_t stream) {
    Params p{};
    p.x = (const float*)d_in[0]; p.c = (const float*)d_in[1]; p.pos = (const int*)d_in[2];
    p.w_ada = (const float*)d_in[3]; p.b_ada = (const float*)d_in[4]; p.norm1_g = (const float*)d_in[5]; p.w_in = (const float*)d_in[6];
    p.w_bg = (const float*)d_in[7]; p.b_bg = (const float*)d_in[8]; p.gm_v_g = (const float*)d_in[9]; p.gm_ws = (const float*)d_in[10];
    p.gm_b = (const float*)d_in[11]; p.ret_gn_g = (const float*)d_in[12]; p.w_a_out = (const float*)d_in[13]; p.w_b_out = (const float*)d_in[14];
    p.w_o = (const float*)d_in[15]; p.norm2_g = (const float*)d_in[16]; p.peer_wq = (const float*)d_in[17]; p.peer_sk = (const float*)d_in[18];
    p.peer_u = (const float*)d_in[19]; p.peer_v = (const float*)d_in[20]; p.norm_f_g = (const float*)d_in[21];
    p.out = (float*)d_out;
    char* w = (char*)d_ws; size_t off = 0;
    auto take = [&](size_t bytes) { char* r = w + off; off += (bytes + 255) & ~(size_t)255; return r; };
    p.bar = (unsigned*)take(XCD_BAR_WORDS * 4);
    p.ada = (float*)take(2 * NMOD * 4);
    p.rope = (float*)take((size_t)NTOK * 128 * 4);
    p.eidx = (int*)take((size_t)NTOK * 128 * 4);
    p.gatev = (float*)take((size_t)NTOK * 128 * 4);
    p.Wt1 = (bf16_t*)take((size_t)ZW * DM * 2);
    p.Wta = (bf16_t*)take((size_t)DM * 1024 * 2);
    p.Wtb = (bf16_t*)take((size_t)DM * DM * 2);
    p.Wto = (bf16_t*)take((size_t)DM * DM * 2);
    p.Wtq = (bf16_t*)take((size_t)DM * DM * 2);
    p.hb = (bf16_t*)take((size_t)NTOK * DM * 2);
    p.ZG = (bf16_t*)take((size_t)NTOK * ZW * 2);
    p.qbuf = (float*)p.ZG;
    p.obuf = (float*)take((size_t)NTOK * DM * 4);
    p.ybin = (bf16_t*)take((size_t)NTOK * DM * 2);
    p.yain = (bf16_t*)take((size_t)NTOK * 1024 * 2);
    p.U8 = (unsigned char*)p.ZG + (size_t)NTOK * DM * 4;
    p.V8 = p.U8 + (size_t)16384 * ROW4;
    p.su = (float*)take(16384 * 4); p.sv = (float*)take(16384 * 4);
    p.Qr = (bf16_t*)take((size_t)NTOK * 1024 * 2);
    p.Pm = (bf16_t*)take((size_t)16 * 64 * 4096 * 2);
    p.KTd = (bf16_t*)take((size_t)NTOK * 1024 * 2);
    p.Vt = (bf16_t*)take((size_t)NTOK * 2048 * 2);
    p.ob16 = (bf16_t*)take((size_t)NTOK * DM * 2);
    if (off > ws_size) { fprintf(stderr, "kernel_launch: workspace too small: need %zu have %zu\n", off, ws_size); return; }
    static int grid = 0;
    if (!grid) {
        int dev = 0, cus = 0, per_cu = 0;
        (void)hipGetDevice(&dev); (void)hipDeviceGetAttribute(&cus, hipDeviceAttributeMultiprocessorCount, dev);
        (void)hipFuncSetAttribute((const void*)k_mega, hipFuncAttributeMaxDynamicSharedMemorySize, LDS_BYTES);
        (void)hipOccupancyMaxActiveBlocksPerMultiprocessor(&per_cu, k_mega, NTH, LDS_BYTES);
        (void)per_cu;
        grid = cus;
    }
    (void)hipMemsetAsync(p.bar, 0, XCD_BAR_WORDS * 4, stream);
    hipLaunchKernelGGL(k_mega, dim3(grid), dim3(NTH), LDS_BYTES, stream, p);
    hipError_t e = hipPeekAtLastError();
    if (e != hipSuccess) fprintf(stderr, "launch failed: %s (grid %d)\n", hipGetErrorString(e), grid);
}
```

```cpp
#include <hip/hip_runtime.h>
#include <hip/hip_cooperative_groups.h>
#include <stdint.h>
#include <math.h>
#include <cstdio>

namespace cg = cooperative_groups;

constexpr int DM = 2048;
constexpr int SQ = 4096;
constexpr int NTOK = 8192;
constexpr int NTH = 512;
constexpr int ZW = 12288;
constexpr int NMOD = 12288;
constexpr int LDS_BYTES = 136 * 1024;

typedef unsigned short bf16_t;

struct Params {
    const float *x, *c; const int* pos;
    const float *w_ada, *b_ada, *norm1_g, *w_in, *w_bg, *b_bg, *gm_v_g, *gm_ws, *gm_b, *ret_gn_g, *w_a_out, *w_b_out, *w_o, *norm2_g,
                *peer_wq, *peer_sk, *peer_u, *peer_v, *norm_f_g;
    float* out;
    float *ada, *rope, *gatev; int* eidx;
    bf16_t *Wt1, *Wta, *Wtb, *Wto, *Wtq;
    bf16_t *hb;
    bf16_t *ZG;
    float *obuf;
    bf16_t *ybin, *yain;
    float *qbuf;
    unsigned char *U8, *V8;
    float *su, *sv;
    bf16_t *Qr, *Pm, *KTd, *Vt;
    bf16_t *ob16;
    unsigned *bar;
};

__constant__ float c_freq[64] = {
1.000000000e+00f, 8.659643531e-01f, 7.498942018e-01f, 6.493816376e-01f, 5.623413324e-01f, 4.869675338e-01f, 4.216965139e-01f, 3.651741147e-01f, 3.162277639e-01f, 2.738419771e-01f, 2.371373773e-01f, 2.053525001e-01f, 1.778279394e-01f, 1.539926529e-01f, 1.333521456e-01f, 1.154781953e-01f, 1.000000015e-01f, 8.659642935e-02f, 7.498942316e-02f, 6.493816525e-02f, 5.623413250e-02f, 4.869675264e-02f, 4.216964915e-02f, 3.651741147e-02f, 3.162277490e-02f, 2.738419548e-02f, 2.371373773e-02f, 2.053525113e-02f, 1.778279431e-02f, 1.539926510e-02f, 1.333521400e-02f, 1.154781971e-02f, 9.999999776e-03f, 8.659643121e-03f, 7.498942316e-03f, 6.493816152e-03f, 5.623413250e-03f, 4.869675264e-03f, 4.216964822e-03f, 3.651741194e-03f, 3.162277630e-03f, 2.738419687e-03f, 2.371373819e-03f, 2.053525066e-03f, 1.778279431e-03f, 1.539926510e-03f, 1.333521446e-03f, 1.154782018e-03f, 1.000000047e-03f, 8.659643354e-04f, 7.498941850e-04f, 6.493816036e-04f, 5.623413017e-04f, 4.869675322e-04f, 4.216965172e-04f, 3.651741135e-04f, 3.162277571e-04f, 2.738419571e-04f, 2.371373703e-04f, 2.053525095e-04f, 1.778279402e-04f, 1.539926598e-04f, 1.333521504e-04f, 1.154782003e-04f };

#define LASP __attribute__((address_space(3)))
constexpr int TIDW_OFF = 133 * 1024;
__device__ __forceinline__ int hw_slot_() { return (int)(__builtin_amdgcn_s_getreg((5 << 11) | 4) & 63u); }
__device__ __forceinline__ int lane_hw_() { int l; asm volatile("v_mbcnt_lo_u32_b32 %0, -1, 0\n\tv_mbcnt_hi_u32_b32 %0, -1, %0" : "=v"(l)); return l; }
__device__ __forceinline__ int tid_() {
    const int wv = (int)*(volatile LASP unsigned*)(unsigned)(TIDW_OFF + 4 * hw_slot_());
    int t = __builtin_amdgcn_readfirstlane(wv) * 64 + lane_hw_(); asm volatile("" : "+v"(t)); return t; }
template <int CTRL> __device__ __forceinline__ float dppf(float x) { return __uint_as_float((unsigned)__builtin_amdgcn_update_dpp(0, (int)__float_as_uint(x), CTRL, 0xf, 0xf, true)); }
__device__ __forceinline__ float row_sum16(float v) { v += dppf<0xB1>(v); v += dppf<0x4E>(v); v += dppf<0x141>(v); v += dppf<0x140>(v); return v; }
__device__ __forceinline__ float xsum16(float v) { const auto r = __builtin_amdgcn_permlane16_swap(__float_as_uint(v), __float_as_uint(v), false, false); return __uint_as_float(r[0]) + __uint_as_float(r[1]); }
__device__ __forceinline__ float xsum32(float v) { const auto r = __builtin_amdgcn_permlane32_swap(__float_as_uint(v), __float_as_uint(v), false, false); return __uint_as_float(r[0]) + __uint_as_float(r[1]); }
__device__ __forceinline__ float xmax16(float v) { const auto r = __builtin_amdgcn_permlane16_swap(__float_as_uint(v), __float_as_uint(v), false, false); return fmaxf(__uint_as_float(r[0]), __uint_as_float(r[1])); }
__device__ __forceinline__ float xmax32(float v) { const auto r = __builtin_amdgcn_permlane32_swap(__float_as_uint(v), __float_as_uint(v), false, false); return fmaxf(__uint_as_float(r[0]), __uint_as_float(r[1])); }
__device__ __forceinline__ float wave_sum(float v) { v = row_sum16(v); v += __shfl_xor(v, 16); v += __shfl_xor(v, 32); return v; }
__device__ __forceinline__ float wave_max_b(float v) {
    v = fmaxf(v, dppf<0xB1>(v)); v = fmaxf(v, dppf<0x4E>(v)); v = fmaxf(v, dppf<0x141>(v)); v = fmaxf(v, dppf<0x140>(v));
    v = fmaxf(v, __shfl_xor(v, 16)); v = fmaxf(v, __shfl_xor(v, 32)); return v;
}
__device__ __forceinline__ float wave_max(float v) {
    v = fmaxf(v, dppf<0xB1>(v)); v = fmaxf(v, dppf<0x4E>(v)); v = fmaxf(v, dppf<0x141>(v)); v = fmaxf(v, dppf<0x140>(v));
    return xmax32(xmax16(v));
}
__device__ __forceinline__ float sigmoidf_(float x) { return 1.0f / (1.0f + expf(-x)); }
__device__ __forceinline__ float siluf_(float x) { return x * sigmoidf_(x); }
__device__ __forceinline__ float geluf_(float x) { return 0.5f * x * (1.0f + erff(x * 0.70710678118654752f)); }
__device__ __forceinline__ float dot4(float4 a, float4 b) { return a.x * b.x + a.y * b.y + a.z * b.z + a.w * b.w; }
__device__ __forceinline__ float bf2f(bf16_t v) { return __uint_as_float((unsigned)v << 16); }
__device__ __forceinline__ float bflo(unsigned w) { return __uint_as_float(w << 16); }
__device__ __forceinline__ float bfhi(unsigned w) { return __uint_as_float(w & 0xffff0000u); }
__device__ __forceinline__ unsigned f2bf(float f) { unsigned u = __float_as_uint(f); return (u + 0x7fffu + ((u >> 16) & 1u)) >> 16; }
__device__ __forceinline__ unsigned pk2(float lo, float hi) { return f2bf(lo) | (f2bf(hi) << 16); }

constexpr float W8S = 32.0f;
__device__ __forceinline__ unsigned pk4f8(float a, float b, float c, float d) { int w = __builtin_amdgcn_cvt_pk_fp8_f32(a, b, 0, false); w = __builtin_amdgcn_cvt_pk_fp8_f32(c, d, w, true); return (unsigned)w; }
__device__ __forceinline__ void st_wt4(void* ptr, unsigned v) { __hip_atomic_store((unsigned*)ptr, v, __ATOMIC_RELAXED, __HIP_MEMORY_SCOPE_AGENT); }
__device__ __forceinline__ void st_wt8(void* ptr, uint2 v) { __hip_atomic_store((unsigned long long*)ptr, ((unsigned long long)v.y << 32) | v.x, __ATOMIC_RELAXED, __HIP_MEMORY_SCOPE_AGENT); }
__device__ __forceinline__ void sincos_acc(float ang, float& s, float& c) {
    const double x = (double)ang;
    const double k = rint(x * 0.63661977236758134308);
    double r = fma(-k, 1.57079632679489655800, x); r = fma(-k, 6.12323399573676603587e-17, r);
    const double r2 = r * r;
    const double sp = r * (1.0 + r2 * (-1.0 / 6.0 + r2 * (1.0 / 120.0 + r2 * (-1.0 / 5040.0 + r2 * (1.0 / 362880.0 + r2 * (-1.0 / 39916800.0 + r2 * (1.0 / 6227020800.0)))))));
    const double cp = 1.0 + r2 * (-0.5 + r2 * (1.0 / 24.0 + r2 * (-1.0 / 720.0 + r2 * (1.0 / 40320.0 + r2 * (-1.0 / 3628800.0 + r2 * (1.0 / 479001600.0 + r2 * (-1.0 / 87178291200.0)))))));
    const int q = ((int)k) & 3;
    const float fs = (float)sp, fc = (float)cp;
    s = (q == 0) ? fs : (q == 1) ? fc : (q == 2) ? -fs : -fc;
    c = (q == 0) ? fc : (q == 1) ? -fs : (q == 2) ? -fc : fs;
}

namespace pg8 {
#define PG8_LAS __attribute__((address_space(3)))
typedef unsigned short bf16_t;
typedef short bf16x8 __attribute__((ext_vector_type(8)));
typedef float f32x4 __attribute__((ext_vector_type(4)));
typedef unsigned u32x4 __attribute__((ext_vector_type(4)));
constexpr int BM = 256, BK = 64, HALF = 128, HTB = HALF * BK * 2  , STAGE_BYTES = 8 * HTB, NXCD = 8, WGM = 8;

__host__ __device__ __forceinline__ int lds_byte(int r, int c) { const int st = (r >> 4) * 2 + (c >> 5), rr = r & 15, cc = c & 31, ob = rr * 64 + cc * 2; return st * 1024 + (ob ^ (((ob >> 9) & 1) << 5)); }
__host__ __device__ __forceinline__ void stage_rc(int b, int& R, int& C) { const int st = b / 1024, sb = b % 1024, swz = sb ^ (((sb >> 9) & 1) << 5); R = (st >> 1) * 16 + swz / 64; C = (st & 1) * 32 + (swz % 64) / 2; }
__host__ __device__ __forceinline__ int perm32(int rho) { const int n = rho >> 4, i = rho & 15; return 8 * (i >> 2) + 4 * n + (i & 3); }

struct Unit { int pm, pn; };
struct Gemm { const bf16_t* A; const bf16_t* Bt; int M, N, K; };

struct StaticOrder {
    int nM, nN, nwg, G, c;
    __host__ __device__ void init(int M, int N, int G_, int c_) { nM = M / BM; nN = N / BM; nwg = nM * nN; G = G_; c = c_; }
    __host__ __device__ bool next(int i, Unit& u) const {
        const long L = (long)i * G + c; if (L >= nwg) return false;
        int wgid = (int)L; { const int q = nwg / NXCD, r = nwg % NXCD, xcd = wgid % NXCD, off = wgid / NXCD; wgid = (xcd < r ? xcd * (q + 1) : r * (q + 1) + (xcd - r) * q) + off; }
        const int nig = WGM * nN, gid = wgid / nig, fm = gid * WGM, gsz = (nM - fm) < WGM ? (nM - fm) : WGM;
        u.pm = fm + ((wgid % nig) % gsz); u.pn = (wgid % nig) / gsz; return true;
    }
    __device__ __forceinline__ void a_ready(const Unit&) const {}
    __device__ __forceinline__ void done(const Unit&) const {}
};

__device__ __forceinline__ unsigned cvt_pk_bf16(float lo, float hi) { unsigned r; asm volatile("v_cvt_pk_bf16_f32 %0, %1, %2" : "=v"(r) : "v"(lo), "v"(hi)); return r; }
typedef float f32x2 __attribute__((ext_vector_type(2)));
__device__ __forceinline__ f32x2 gelu_pk(f32x2 v) {
    const f32x2 av = __builtin_elementwise_abs(v), d = av * 0.2316418882f + 1.0f;
    f32x2 t; t.x = __builtin_amdgcn_rcpf(d.x); t.y = __builtin_amdgcn_rcpf(d.y);
    f32x2 q = t * 0.5307027145f + (-0.7265760135f); q = q * t + 0.7107068705f; q = q * t + (-0.142248368f); q = q * t + 0.127414796f; q = q * t;
    const f32x2 s = (v * v) * (-0.72134752044f);
    f32x2 e; e.x = __builtin_amdgcn_exp2f(s.x); e.y = __builtin_amdgcn_exp2f(s.y);
    const f32x2 m = v * (q * e), r = v - m;
    f32x2 o; o.x = v.x < 0.f ? m.x : r.x; o.y = v.y < 0.f ? m.y : r.y; return o;
}

typedef unsigned u32x2v __attribute__((ext_vector_type(2)));
struct EpiZG {
    static constexpr bool PERM = true, AFTER_DRAIN = false;
    bf16_t* O; const float* bias; float osc;
    __device__ __forceinline__ void operator()(const f32x4 (&acc)[2][2][4][2], const Unit& u, int wr, int wc, int fr, int fq) const {
        const int row0 = u.pm * BM + wr * 64 + fr, col0 = u.pn * BM + wc * 32 + 8 * fq;
        const int mode = u.pn < 8 ? 1 : (u.pn < 32 ? 0 : 2);
        f32x4 bv[2][2];
#pragma unroll
        for (int bj = 0; bj < 2; ++bj)
#pragma unroll
            for (int n = 0; n < 2; ++n) bv[bj][n] = (mode == 2) ? *(const f32x4*)(bias + (col0 - 8192) + bj * HALF + 4 * n) : (f32x4){0.f, 0.f, 0.f, 0.f};
#pragma unroll
        for (int ai = 0; ai < 2; ++ai)
#pragma unroll
            for (int m = 0; m < 4; ++m) { bf16_t* rowp = O + (size_t)(row0 + ai * HALF + m * 16) * ZW + col0;
#pragma unroll
                for (int bj = 0; bj < 2; ++bj) { f32x4 v0 = acc[ai][bj][m][0] * osc, v1 = acc[ai][bj][m][1] * osc;
                    if (mode == 1) { f32x2 a = gelu_pk((f32x2){v0[0], v0[1]}), b = gelu_pk((f32x2){v0[2], v0[3]}), c = gelu_pk((f32x2){v1[0], v1[1]}), d = gelu_pk((f32x2){v1[2], v1[3]});
                        v0 = (f32x4){a.x, a.y, b.x, b.y}; v1 = (f32x4){c.x, c.y, d.x, d.y}; }
                    if (mode == 2) { v0 = v0 + bv[bj][0]; v1 = v1 + bv[bj][1];
#pragma unroll
                        for (int e = 0; e < 4; ++e) { v0[e] = __builtin_amdgcn_rcpf(1.0f + __expf(-v0[e])); v1[e] = __builtin_amdgcn_rcpf(1.0f + __expf(-v1[e])); } }
                    u32x4 w; w.x = cvt_pk_bf16(v0[0], v0[1]); w.y = cvt_pk_bf16(v0[2], v0[3]); w.z = cvt_pk_bf16(v1[0], v1[1]); w.w = cvt_pk_bf16(v1[2], v1[3]);
                    *(u32x4*)(rowp + bj * HALF) = w; } }
    }
};
template <int ACCUM> struct EpiMixB {
    static constexpr bool PERM = true, AFTER_DRAIN = false;
    bf16_t* Mo; const bf16_t* ZGp; int goff;
    __device__ __forceinline__ void operator()(const f32x4 (&acc)[2][2][4][2], const Unit& u, int wr, int wc, int fr, int fq) const {
        const int row0 = u.pm * BM + wr * 64 + fr, col0 = u.pn * BM + wc * 32 + 8 * fq;
#pragma unroll
        for (int ai = 0; ai < 2; ++ai)
#pragma unroll
            for (int m = 0; m < 4; ++m) { const size_t row = (size_t)(row0 + ai * HALF + m * 16);
#pragma unroll
                for (int bj = 0; bj < 2; ++bj) { const f32x4 v0 = acc[ai][bj][m][0], v1 = acc[ai][bj][m][1];
                    const u32x4 g = *(const u32x4*)(ZGp + row * ZW + 8192 + goff + col0 + bj * HALF);
                    float o[8];
                    o[0] = bflo(g.x) * v0[0]; o[1] = bfhi(g.x) * v0[1]; o[2] = bflo(g.y) * v0[2]; o[3] = bfhi(g.y) * v0[3];
                    o[4] = bflo(g.z) * v1[0]; o[5] = bfhi(g.z) * v1[1]; o[6] = bflo(g.w) * v1[2]; o[7] = bfhi(g.w) * v1[3];
                    bf16_t* mp = Mo + row * DM + col0 + bj * HALF;
                    if (ACCUM) { const u32x4 old = *(const u32x4*)mp;
                        o[0] += bflo(old.x); o[1] += bfhi(old.x); o[2] += bflo(old.y); o[3] += bfhi(old.y); o[4] += bflo(old.z); o[5] += bfhi(old.z); o[6] += bflo(old.w); o[7] += bfhi(old.w); }
                    u32x4 w; w.x = cvt_pk_bf16(o[0], o[1]); w.y = cvt_pk_bf16(o[2], o[3]); w.z = cvt_pk_bf16(o[4], o[5]); w.w = cvt_pk_bf16(o[6], o[7]);
                    *(u32x4*)mp = w; } }
    }
};
struct EpiResF {
    static constexpr bool PERM = false, AFTER_DRAIN = false;
    float* x1; const float* x; const float* ga;
    __device__ __forceinline__ void operator()(const f32x4 (&acc)[2][2][4][2], const Unit& u, int wr, int wc, int fr, int fq) const {
        const int row0 = u.pm * BM + wr * 64 + fr, col0 = u.pn * BM + wc * 32 + 4 * fq;
        const int b = (u.pm * BM) / SQ;
        f32x4 gv[2][2];
#pragma unroll
        for (int bj = 0; bj < 2; ++bj)
#pragma unroll
            for (int n = 0; n < 2; ++n) gv[bj][n] = *(const f32x4*)(ga + b * NMOD + col0 + bj * HALF + n * 16);
#pragma unroll
        for (int ai = 0; ai < 2; ++ai)
#pragma unroll
            for (int m = 0; m < 4; ++m) { const size_t off = (size_t)(row0 + ai * HALF + m * 16) * DM + col0;
#pragma unroll
                for (int bj = 0; bj < 2; ++bj)
#pragma unroll
                    for (int n = 0; n < 2; ++n) { const f32x4 xv = *(const f32x4*)(x + off + bj * HALF + n * 16);
                        *(f32x4*)(x1 + off + bj * HALF + n * 16) = xv + gv[bj][n] * acc[ai][bj][m][n]; } }
    }
};
struct EpiF32 {
    static constexpr bool PERM = false, AFTER_DRAIN = false;
    float* O; int ldc;
    __device__ __forceinline__ void operator()(const f32x4 (&acc)[2][2][4][2], const Unit& u, int wr, int wc, int fr, int fq) const {
        const int row0 = u.pm * BM + wr * 64 + fr, col0 = u.pn * BM + wc * 32 + 4 * fq;
#pragma unroll
        for (int ai = 0; ai < 2; ++ai)
#pragma unroll
            for (int m = 0; m < 4; ++m) { const size_t off = (size_t)(row0 + ai * HALF + m * 16) * ldc + col0;
#pragma unroll
                for (int bj = 0; bj < 2; ++bj)
#pragma unroll
                    for (int n = 0; n < 2; ++n) *(f32x4*)(O + off + bj * HALF + n * 16) = acc[ai][bj][m][n]; }
    }
};

typedef int i32x8 __attribute__((ext_vector_type(8)));
typedef int i32x4 __attribute__((ext_vector_type(4)));
__device__ __forceinline__ void mfma_f8(f32x4& acc, i32x8 a, i32x8 b) { asm volatile("v_mfma_f32_16x16x128_f8f6f4 %0, %1, %2, %0" : "+v"(acc) : "v"(a), "v"(b)); }
__device__ __forceinline__ i32x8 cat8(bf16x8 a, bf16x8 b) { return __builtin_shufflevector(__builtin_bit_cast(i32x4, a), __builtin_bit_cast(i32x4, b), 0, 1, 2, 3, 4, 5, 6, 7); }
template <class Epi, class Sched, bool ALIGN_EPI = false, bool SP2 = false, bool F8 = false>
__device__ __forceinline__ void gemm_phase(PG8_LAS unsigned char* lds, const Gemm g, const Sched& S, const Epi& E) {
    const int tid = tid_(), wid = __builtin_amdgcn_readfirstlane(tid >> 6), lane = tid & 63, wr = wid >> 2, wc = wid & 3, fr = lane & 15, fq = lane >> 4;
    const int K = g.K, nt = K / BK;
    unsigned voffA[2], voffB[2];
#pragma unroll
    for (int i = 0; i < 2; ++i) { int R, C; stage_rc(tid * 16 + i * 8192, R, C); const int Rb = Epi::PERM ? ((R & ~31) + perm32(R & 31)) : R;
        voffA[i] = (unsigned)(R * K + C) * 2u; voffB[i] = (unsigned)(Rb * K + C) * 2u; }
    const size_t kstep = (size_t)(BK * 2);
    const size_t hstep = (size_t)HALF * K * 2;
    const size_t tstep = 2 * hstep;
    const unsigned ldsw = (unsigned)wid * 1024u;
    const int aoff = lds_byte(wr * 64 + fr, fq * 8), boff = lds_byte(wc * 32 + fr, fq * 8);
#define PG8_SA(b, h) (((b) * 2 + (h)) * HTB)
#define PG8_SB(b, h) ((4 + (b) * 2 + (h)) * HTB)
#define PG8_STAGE(bufoff, gbase, voff) do { _Pragma("unroll") for (int _i = 0; _i < 2; ++_i) \
        __builtin_amdgcn_global_load_lds((const unsigned*)((const char*)(gbase) + (voff)[_i]), (PG8_LAS unsigned*)(lds + (bufoff) + ldsw + _i * 8192), 16, 0, 0); } while (0)
#define PG8_LDA(dst, b, h) do { _Pragma("unroll") for (int m = 0; m < 4; ++m) _Pragma("unroll") for (int k = 0; k < 2; ++k) dst[m][k] = *(const PG8_LAS bf16x8*)(lds + PG8_SA(b, h) + aoff + m * 2048 + k * 1024); } while (0)
#define PG8_LDB(dst, b, h) do { _Pragma("unroll") for (int n = 0; n < 2; ++n) _Pragma("unroll") for (int k = 0; k < 2; ++k) dst[n][k] = *(const PG8_LAS bf16x8*)(lds + PG8_SB(b, h) + boff + n * 2048 + k * 1024); } while (0)
#define PG8_MMA(ai, bj, At, Bt) do { __builtin_amdgcn_s_setprio(1); _Pragma("unroll") for (int m = 0; m < 4; ++m) _Pragma("unroll") for (int n = 0; n < 2; ++n) { \
        if constexpr (F8) mfma_f8(acc[ai][bj][m][n], cat8(Bt[n][0], Bt[n][1]), cat8(At[m][0], At[m][1])); \
        else { _Pragma("unroll") for (int k = 0; k < 2; ++k) acc[ai][bj][m][n] = __builtin_amdgcn_mfma_f32_16x16x32_bf16(Bt[n][k], At[m][k], acc[ai][bj][m][n], 0, 0, 0); } } __builtin_amdgcn_s_setprio(0); } while (0)
#define PG8_WAIT_V(n) asm volatile("s_waitcnt vmcnt(" #n ")" ::: "memory")
#define PG8_WAIT_L(n) asm volatile("s_waitcnt lgkmcnt(" #n ")" ::: "memory")
#define PG8_BAR __builtin_amdgcn_s_barrier()
#define PG8_SCHED __builtin_amdgcn_sched_barrier(0)
    Unit cur, nxt; int ui = 0;
    if (!S.next(0, cur)) return;
    f32x4 acc[2][2][4][2];
#pragma unroll
    for (int a = 0; a < 2; ++a)
#pragma unroll
        for (int b = 0; b < 2; ++b)
#pragma unroll
            for (int m = 0; m < 4; ++m)
#pragma unroll
                for (int n = 0; n < 2; ++n) acc[a][b][m][n] = (f32x4){0.f, 0.f, 0.f, 0.f};
    bf16x8 At[4][2], B0[2][2], B1[2][2];
    const char* cA = (const char*)g.A + (size_t)cur.pm * tstep; const char* cB = (const char*)g.Bt + (size_t)cur.pn * tstep;
    S.a_ready(cur);
    if constexpr (SP2) {
        PG8_STAGE(PG8_SB(0, 0), cB, voffB); PG8_STAGE(PG8_SB(0, 1), cB + hstep, voffB); PG8_STAGE(PG8_SA(0, 0), cA, voffA); PG8_STAGE(PG8_SA(0, 1), cA + hstep, voffA);
        if (wr == 1) PG8_BAR;
        PG8_WAIT_V(2); PG8_BAR;
        PG8_STAGE(PG8_SB(1, 0), cB + kstep, voffB); PG8_STAGE(PG8_SA(1, 0), cA + kstep, voffA); PG8_STAGE(PG8_SB(1, 1), cB + hstep + kstep, voffB);
        PG8_WAIT_V(6); PG8_BAR;
    } else {
        PG8_STAGE(PG8_SB(0, 0), cB, voffB); PG8_STAGE(PG8_SA(0, 0), cA, voffA); PG8_STAGE(PG8_SB(0, 1), cB + hstep, voffB); PG8_STAGE(PG8_SA(0, 1), cA + hstep, voffA);
        if (wr == 1) PG8_BAR;
        PG8_WAIT_V(4); PG8_BAR;
        PG8_STAGE(PG8_SB(1, 0), cB + kstep, voffB); PG8_STAGE(PG8_SA(1, 0), cA + kstep, voffA); PG8_STAGE(PG8_SB(1, 1), cB + hstep + kstep, voffB);
        PG8_WAIT_V(6); PG8_BAR;
    }
    for (;;) {
        const bool has_next = S.next(ui + 1, nxt);
        const char* nA = has_next ? (const char*)g.A + (size_t)nxt.pm * tstep : cA; const char* nB = has_next ? (const char*)g.Bt + (size_t)nxt.pn * tstep : cB;
        for (int t = 0; t < nt; t += 2) {
            const bool last = (t == nt - 2);
            const char* a1 = cA + (size_t)(t + 1) * kstep;
            const char* a2 = last ? nA : cA + (size_t)(t + 2) * kstep; const char* b2 = last ? nB : cB + (size_t)(t + 2) * kstep;
            const char* a3 = a2 + kstep; const char* b3 = b2 + kstep;
            if (last && has_next) S.a_ready(nxt);
            if constexpr (SP2) {
            PG8_LDB(B0, 0, 0); PG8_LDB(B1, 0, 1); PG8_SCHED; PG8_LDA(At, 0, 0); PG8_STAGE(PG8_SA(1, 1), a1 + hstep, voffA);
            PG8_WAIT_V(8); PG8_WAIT_L(0); PG8_BAR; PG8_MMA(0, 0, At, B0); PG8_MMA(0, 1, At, B1); PG8_BAR; PG8_SCHED;
            PG8_LDA(At, 0, 1); PG8_STAGE(PG8_SB(0, 0), b2, voffB); PG8_STAGE(PG8_SB(0, 1), b2 + hstep, voffB); PG8_STAGE(PG8_SA(0, 0), a2, voffA);
            PG8_WAIT_V(8); PG8_WAIT_L(0); PG8_BAR; PG8_MMA(1, 0, At, B0); PG8_MMA(1, 1, At, B1); PG8_BAR; PG8_SCHED;
            PG8_LDB(B0, 1, 0); PG8_LDB(B1, 1, 1); PG8_SCHED; PG8_LDA(At, 1, 0); PG8_STAGE(PG8_SA(0, 1), a2 + hstep, voffA);
            PG8_WAIT_V(8); PG8_WAIT_L(0); PG8_BAR; PG8_MMA(0, 0, At, B0); PG8_MMA(0, 1, At, B1); PG8_BAR; PG8_SCHED;
            PG8_LDA(At, 1, 1); PG8_STAGE(PG8_SB(1, 0), b3, voffB); PG8_STAGE(PG8_SB(1, 1), b3 + hstep, voffB); PG8_STAGE(PG8_SA(1, 0), a3, voffA);
            PG8_WAIT_V(8); PG8_WAIT_L(0); PG8_BAR; PG8_MMA(1, 0, At, B0); PG8_MMA(1, 1, At, B1); PG8_BAR; PG8_SCHED;
            } else {
            PG8_LDB(B0, 0, 0); PG8_SCHED; PG8_LDA(At, 0, 0); PG8_STAGE(PG8_SA(1, 1), a1 + hstep, voffA);
            PG8_WAIT_L(8); PG8_BAR; PG8_WAIT_L(0); PG8_MMA(0, 0, At, B0); PG8_BAR; PG8_SCHED;
            PG8_LDB(B1, 0, 1); PG8_STAGE(PG8_SB(0, 0), b2, voffB);
            PG8_BAR; PG8_WAIT_L(0); PG8_MMA(0, 1, At, B1); PG8_BAR;
            PG8_LDA(At, 0, 1); PG8_STAGE(PG8_SA(0, 0), a2, voffA);
            PG8_BAR; PG8_WAIT_L(0); PG8_MMA(1, 0, At, B0); PG8_BAR; PG8_SCHED;
            PG8_STAGE(PG8_SB(0, 1), b2 + hstep, voffB);
            PG8_WAIT_V(6); PG8_BAR; PG8_MMA(1, 1, At, B1); PG8_BAR;
            PG8_LDB(B0, 1, 0); PG8_SCHED; PG8_LDA(At, 1, 0); PG8_STAGE(PG8_SA(0, 1), a2 + hstep, voffA);
            PG8_WAIT_L(8); PG8_BAR; PG8_WAIT_L(0); PG8_MMA(0, 0, At, B0); PG8_BAR; PG8_SCHED;
            PG8_LDB(B1, 1, 1); PG8_STAGE(PG8_SB(1, 0), b3, voffB);
            PG8_BAR; PG8_WAIT_L(0); PG8_MMA(0, 1, At, B1); PG8_BAR;
            PG8_LDA(At, 1, 1); PG8_STAGE(PG8_SA(1, 0), a3, voffA);
            PG8_BAR; PG8_WAIT_L(0); PG8_MMA(1, 0, At, B0); PG8_BAR; PG8_SCHED;
            PG8_STAGE(PG8_SB(1, 1), b3 + hstep, voffB);
            PG8_WAIT_V(6); PG8_BAR; PG8_MMA(1, 1, At, B1); PG8_BAR;
            }
        }
        if constexpr (F8) asm volatile("s_nop 15\n\ts_nop 15\n\ts_nop 15\n\ts_nop 15" ::: "memory");
        if constexpr (ALIGN_EPI) { if (wr == 0) PG8_BAR; }
        if constexpr (!Epi::AFTER_DRAIN) { const int le = lane_hw_(); E(acc, cur, wr, wc, le & 15, le >> 4); S.done(cur); }
        if (!has_next) break;
#pragma unroll
        for (int a = 0; a < 2; ++a)
#pragma unroll
            for (int b = 0; b < 2; ++b)
#pragma unroll
                for (int m = 0; m < 4; ++m)
#pragma unroll
                    for (int n = 0; n < 2; ++n) acc[a][b][m][n] = (f32x4){0.f, 0.f, 0.f, 0.f};
        cur = nxt; cA = nA; cB = nB; ++ui;
        if constexpr (ALIGN_EPI) { if (wr == 1) PG8_BAR; }
    }
    PG8_WAIT_V(0);
    if constexpr (!ALIGN_EPI) { if (wr == 0) PG8_BAR; }
    PG8_BAR;
    if constexpr (Epi::AFTER_DRAIN) { E.fused(acc, cur, wr, wc, fr, fq, lds, wid, lane); S.done(cur); }
#undef PG8_SA
#undef PG8_SB
#undef PG8_STAGE
#undef PG8_LDA
#undef PG8_LDB
#undef PG8_MMA
#undef PG8_WAIT_V
#undef PG8_WAIT_L
#undef PG8_BAR
#undef PG8_SCHED
}
}
using pg8::f32x4; using pg8::u32x4;

template <bool F8 = false>
__device__ __forceinline__ void transpose_item(const float* W, int K, int N, bf16_t* WT, int row_off, float* scr, int item, int lane) {
    const int nblk = N / 32, kb = item / nblk, nbk = item % nblk, k0 = 64 * kb, n0 = 32 * nbk;
    {
        const int r = lane >> 3, c4 = (lane & 7) * 4;
        float4 t[8];
#pragma unroll
        for (int i = 0; i < 8; ++i) t[i] = *(const float4*)(W + (size_t)(k0 + 8 * i + r) * N + n0 + c4);
#pragma unroll
        for (int i = 0; i < 8; ++i) { float* d = scr + (8 * i + r) * 33 + c4; d[0] = t[i].x; d[1] = t[i].y; d[2] = t[i].z; d[3] = t[i].w; }
    }
    asm volatile("s_waitcnt lgkmcnt(0)" ::: "memory");
    const int c = lane & 7;
#pragma unroll
    for (int j = 0; j < 4; ++j) { const int n = (lane >> 3) + 8 * j; const float* s = scr + (8 * c) * 33 + n;
        if constexpr (F8) { *(uint2*)((unsigned char*)WT + (size_t)(row_off + n0 + n) * K + k0 + 8 * c) =
                make_uint2(pk4f8(s[0 * 33] * W8S, s[1 * 33] * W8S, s[2 * 33] * W8S, s[3 * 33] * W8S), pk4f8(s[4 * 33] * W8S, s[5 * 33] * W8S, s[6 * 33] * W8S, s[7 * 33] * W8S)); }
        else { uint4 o; o.x = pk2(s[0 * 33], s[1 * 33]); o.y = pk2(s[2 * 33], s[3 * 33]); o.z = pk2(s[4 * 33], s[5 * 33]); o.w = pk2(s[6 * 33], s[7 * 33]);
            *(uint4*)(WT + (size_t)(row_off + n0 + n) * K + k0 + 8 * c) = o; } }
    asm volatile("s_waitcnt lgkmcnt(0)" ::: "memory");
}
__device__ __forceinline__ void ph_prep(const Params& p, int bid, int nb, float* lds) {
    const int tid = tid_(), wave = tid >> 6, lane = tid & 63;
    {
        float* sl = lds;
        float* red = lds + 4096;
        for (int i = tid; i < 4096; i += NTH) sl[i] = siluf_(p.c[i]);
        __syncthreads();
        for (int it = bid; it < 192; it += nb) {
            const int c4 = tid & 15, kg = tid >> 4;
            const float* wp = p.w_ada + (size_t)kg * NMOD + it * 64 + c4 * 4;
            float a0[4] = {0.f, 0.f, 0.f, 0.f}, a1[4] = {0.f, 0.f, 0.f, 0.f};
#pragma unroll 8
            for (int i = 0; i < 64; ++i) {
                const int k = kg + 32 * i;
                const float4 w = *(const float4*)(wp + (size_t)(32 * i) * NMOD);
                const float s0 = sl[k], s1 = sl[2048 + k];
                a0[0] += s0 * w.x; a0[1] += s0 * w.y; a0[2] += s0 * w.z; a0[3] += s0 * w.w;
                a1[0] += s1 * w.x; a1[1] += s1 * w.y; a1[2] += s1 * w.z; a1[3] += s1 * w.w;
            }
            __syncthreads();
#pragma unroll
            for (int e = 0; e < 4; ++e) { red[(kg * 16 + c4) * 8 + e] = a0[e]; red[(kg * 16 + c4) * 8 + 4 + e] = a1[e]; }
            __syncthreads();
            if (tid < 128) {
                const int b = tid >> 6, col = tid & 63;
                float s = 0.f;
                for (int g = 0; g < 32; ++g) s += red[(g * 16 + (col >> 2)) * 8 + b * 4 + (col & 3)];
                p.ada[b * NMOD + it * 64 + col] = s + p.b_ada[it * 64 + col];
            }
        }
        __syncthreads();
    }
    for (int e = bid * NTH + tid; e < NTOK * 64; e += nb * NTH) {
        const int tok = e >> 6, j = e & 63;
        const float ang = (float)p.pos[tok] * c_freq[j];
        float s, c; sincos_acc(ang, s, c);
        p.rope[(size_t)e * 2] = c; p.rope[(size_t)e * 2 + 1] = s;
    }
    {
        float* scr = lds + wave * (64 * 33);
        const int gw = bid * 8 + wave, ngw = nb * 8;
        constexpr int I1 = 32 * 256, I2 = 32 * 128, I3 = 16 * 64, I4 = 32 * 64;
        constexpr int NIT = I1 + I2 + I3 + 3 * I4;
        for (int it = gw; it < NIT; it += ngw) {
            int r = it;
            if (r < I1) { transpose_item<true>(p.w_in, 2048, 8192, p.Wt1, 0, scr, r, lane); continue; } r -= I1;
            if (r < I2) { transpose_item<true>(p.w_bg, 2048, 4096, p.Wt1, 8192, scr, r, lane); continue; } r -= I2;
            if (r < I3) { transpose_item(p.w_a_out, 1024, 2048, p.Wta, 0, scr, r, lane); continue; } r -= I3;
            if (r < I4) { transpose_item(p.w_b_out, 2048, 2048, p.Wtb, 0, scr, r, lane); continue; } r -= I4;
            if (r < I4) { transpose_item(p.w_o, 2048, 2048, p.Wto, 0, scr, r, lane); continue; } r -= I4;
            transpose_item(p.peer_wq, 2048, 2048, p.Wtq, 0, scr, r, lane);
        }
    }
    __syncthreads();
}
constexpr int ROW6 = 1536;
typedef float f32x32_t __attribute__((ext_vector_type(32)));
typedef unsigned u32x6_t __attribute__((ext_vector_type(6)));
__device__ __forceinline__ void tc_load(const Params& p, int r, int lane, float4 (&t)[8]) {
    const bool second = r >= 16384; const int row = second ? r - 16384 : r;
    const float* src = (const float*)((const char*)p.peer_u + (second ? ((const char*)p.peer_v - (const char*)p.peer_u) : (ptrdiff_t)0)) + (size_t)row * DM + (second ? lane * 4 : (lane >> 2) * 128 + (lane & 3) * 8);
#pragma unroll
    for (int q = 0; q < 8; ++q) t[q] = *(const float4*)(src + (second ? 256 * q : (q >> 1) * 32 + (q & 1) * 4));
}
constexpr int ROW4 = 1024;
__device__ __forceinline__ void tc_finish(const Params& p, int r, int lane, const float4 (&t)[8]) {
    const bool second = r >= 16384; const int row = second ? r - 16384 : r;
    float am = 0.f;
#pragma unroll
    for (int q = 0; q < 8; ++q) am = fmaxf(am, fmaxf(fmaxf(fabsf(t[q].x), fabsf(t[q].y)), fmaxf(fabsf(t[q].z), fabsf(t[q].w))));
    am = wave_max_b(am);
    {
        const float sc = (am > 0.f) ? am * (1.0f / 6.0f) : 1.0f, inv = (am > 0.f) ? 6.0f / am : 1.0f;
        unsigned w0 = 0u, w1 = 0u, w2 = 0u, w3 = 0u;
#define TC_PK(W_, qa_, qb_) do { \
        W_ = __builtin_amdgcn_cvt_scalef32_pk_fp4_f32(W_, t[qa_].x * inv, t[qa_].y * inv, 1.0f, 0); W_ = __builtin_amdgcn_cvt_scalef32_pk_fp4_f32(W_, t[qa_].z * inv, t[qa_].w * inv, 1.0f, 1); \
        W_ = __builtin_amdgcn_cvt_scalef32_pk_fp4_f32(W_, t[qb_].x * inv, t[qb_].y * inv, 1.0f, 2); W_ = __builtin_amdgcn_cvt_scalef32_pk_fp4_f32(W_, t[qb_].z * inv, t[qb_].w * inv, 1.0f, 3); } while (0)
        TC_PK(w0, 0, 1); TC_PK(w1, 2, 3); TC_PK(w2, 4, 5); TC_PK(w3, 6, 7);
#undef TC_PK
        *(uint4*)(p.U8 + (size_t)r * ROW4 + lane * 16) = make_uint4(w0, w1, w2, w3);
        if (lane == 0) p.su[r] = sc;
    }
}
__device__ __forceinline__ void ph_tabconv(const Params& p, int bid, int nb) {
    const int tid = tid_(), wave = tid >> 6, lane = tid & 63;
    for (int r = bid * 8 + wave; r < 2 * 16384; r += nb * 8) { float4 t[8]; tc_load(p, r, lane, t); tc_finish(p, r, lane, t); }
}

__device__ __forceinline__ void mn_load(const float* xin, int row, int lane, float4 (&v)[8]) {
#pragma unroll
    for (int j = 0; j < 8; ++j) v[j] = ((const float4*)(xin + (size_t)row * DM))[lane + 64 * j];
}
template <bool F8>
__device__ __forceinline__ void mn_row(const Params& p, const float* g, int sh_off, int sc_off, bf16_t* hout, int row, int lane, const float4 (&v)[8]) {
    const int b = row / SQ;
    float ss = 0.f;
#pragma unroll
    for (int j = 0; j < 8; ++j) ss += dot4(v[j], v[j]);
    ss = wave_sum(ss);
    const float rs = 1.0f / sqrtf(ss * (1.0f / DM) + 1e-6f);
#pragma unroll
    for (int j = 0; j < 8; ++j) {
        const int col = (lane + 64 * j) * 4;
        const float4 g4 = *(const float4*)(g + col);
        const float4 sc = *(const float4*)(p.ada + b * NMOD + sc_off + col);
        const float4 sh = *(const float4*)(p.ada + b * NMOD + sh_off + col);
        float4 o;
        o.x = v[j].x * rs * g4.x * (1.0f + sc.x) + sh.x; o.y = v[j].y * rs * g4.y * (1.0f + sc.y) + sh.y;
        o.z = v[j].z * rs * g4.z * (1.0f + sc.z) + sh.z; o.w = v[j].w * rs * g4.w * (1.0f + sc.w) + sh.w;
        if constexpr (F8) st_wt4((unsigned char*)hout + (size_t)row * DM + col, pk4f8(o.x, o.y, o.z, o.w));
        else st_wt8(hout + (size_t)row * DM + col, make_uint2(pk2(o.x, o.y), pk2(o.z, o.w)));
    }
}
template <bool F8>
__device__ __forceinline__ void ph_modnorm(const Params& p, const float* xin, const float* g, int sh_off, int sc_off, bf16_t* hout, int bid, int nb, float* lds) {
    const int tid = tid_(), wave = tid >> 6, lane = tid & 63;
    const int stride = nb * 8;
    float4 va[8], vb[8], vc[8];
    int row = bid * 8 + wave;
    if (row < NTOK) mn_load(xin, row, lane, va);
    if (row + stride < NTOK) mn_load(xin, row + stride, lane, vb);
    for (; row < NTOK; row += 3 * stride) {
        if (row + 2 * stride < NTOK) mn_load(xin, row + 2 * stride, lane, vc);
        mn_row<F8>(p, g, sh_off, sc_off, hout, row, lane, va);
        if (row + stride >= NTOK) break;
        if (row + 3 * stride < NTOK) mn_load(xin, row + 3 * stride, lane, va);
        mn_row<F8>(p, g, sh_off, sc_off, hout, row + stride, lane, vb);
        if (row + 2 * stride >= NTOK) break;
        if (row + 4 * stride < NTOK) mn_load(xin, row + 4 * stride, lane, vb);
        mn_row<F8>(p, g, sh_off, sc_off, hout, row + 2 * stride, lane, vc);
    }
}

typedef short bf16x8_t __attribute__((ext_vector_type(8)));
typedef float f32x4_t __attribute__((ext_vector_type(4)));
__device__ __forceinline__ bf16x8_t ldfrag(const char* base, int row, int chunk, int rb, int sm) { return *(const bf16x8_t*)(base + row * rb + ((chunk ^ (row & sm)) << 4)); }
__device__ __forceinline__ void ph_gmlp2(const Params& p, int bid, int nb, float* lds) {
    char* WM = (char*)lds; char* VT = WM + 32768;
    const int tid = tid_(), wave = tid >> 6, lane = tid & 63, fr = lane & 15, fq = lane >> 4;
    int gl = -1;
    for (int it = bid; it < 512; it += nb) {
        const int g = it & 7, n = (it >> 3) & 31, b = it >> 8;
        const int tok0 = b * SQ + n * 128;
        __syncthreads();
        if (g != gl) {
            for (int u = tid; u < 2048; u += NTH) {
                const int i = u >> 4, c = u & 15;
                const float4* src = (const float4*)(p.gm_ws + (size_t)g * 16384 + i * 128 + c * 8);
                float4 a = src[0], b4 = src[1];
                if ((i >> 6) < (c >> 3)) { a = make_float4(0.f, 0.f, 0.f, 0.f); b4 = a; }
                *(uint4*)(WM + i * 256 + ((c ^ (i & 15)) << 4)) = make_uint4(pk2(a.x, a.y), pk2(a.z, a.w), pk2(b4.x, b4.y), pk2(b4.z, b4.w));
            }
            gl = g;
        }
        {
            const float2 gn = *(const float2*)(p.gm_v_g + g * 128 + lane * 2);
#pragma unroll 4
            for (int jj = 0; jj < 16; ++jj) {
                const int j = wave * 16 + jj;
                const unsigned w = *(const unsigned*)(p.ZG + (size_t)(tok0 + j) * ZW + 1024 + g * 128 + lane * 2);
                const float a = bflo(w), c2 = bfhi(w);
                const float ss = wave_sum(a * a + c2 * c2);
                const float rs = 1.0f / sqrtf(ss * (1.0f / 128.0f) + 1e-6f);
                const int d0 = lane * 2, d1 = d0 + 1;
                *(bf16_t*)(VT + d0 * 256 + (((j >> 3) ^ (d0 & 15)) << 4) + (j & 7) * 2) = (bf16_t)f2bf(a * rs * gn.x);
                *(bf16_t*)(VT + d1 * 256 + (((j >> 3) ^ (d1 & 15)) << 4) + (j & 7) * 2) = (bf16_t)f2bf(c2 * rs * gn.y);
            }
        }
        __syncthreads();
        {
            bf16x8_t A[4];
#pragma unroll
            for (int ks = 0; ks < 4; ++ks) A[ks] = ldfrag(VT, wave * 16 + fr, ks * 4 + fq, 256, 15);
            const int d0 = wave * 16 + fq * 4;
#pragma unroll
            for (int itl = 0; itl < 8; ++itl) {
                f32x4_t acc = {0.f, 0.f, 0.f, 0.f};
#pragma unroll
                for (int ks = 0; ks < 4; ++ks) if (itl >= 4 || ks < 2) acc = __builtin_amdgcn_mfma_f32_16x16x32_bf16(A[ks], ldfrag(WM, itl * 16 + fr, ks * 4 + fq, 256, 15), acc, 0, 0, 0);
                const int i = itl * 16 + fr;
                const float bias = p.gm_b[g * 128 + i];
                const size_t tok = (size_t)(tok0 + i);
                const uint2 uw = *(const uint2*)(p.ZG + tok * ZW + g * 128 + d0);
                *(uint2*)(p.yain + tok * 1024 + g * 128 + d0) = make_uint2(pk2(bflo(uw.x) * (acc[0] + bias), bfhi(uw.x) * (acc[1] + bias)), pk2(bflo(uw.y) * (acc[2] + bias), bfhi(uw.y) * (acc[3] + bias)));
            }
        }
    }
    __syncthreads();
}

__device__ __forceinline__ void ph_ret(const Params& p, int bid, int nb, float* lds) {
    float* Qs = lds;
    float* Ks = Qs + 64 * 129;
    float* Vs = Ks + 64 * 129;
    float* Ss = Vs + 64 * 16;
    float* At = Ss + 128 * 16;
    float* kd = At + 64 * 65;
    const int tid = tid_();
    const bf16_t* z = p.ZG;
    for (int it = bid; it < 256; it += nb) {
        const int vs = it & 15, h = (it >> 4) & 7, b = it >> 7;
        const float lg = log1pf(-exp2f(-5.0f - (float)h));
        const float cdec = expf(lg * 64.0f);
        __syncthreads();
        for (int i = tid; i < 2048; i += NTH) Ss[i] = 0.f;
        if (tid < 64) kd[tid] = expf(lg * (float)(63 - tid));
        for (int n = 0; n < 64; ++n) {
            const int tok0 = b * SQ + n * 64;
            __syncthreads();
            for (int e = tid; e < 4096; e += NTH) {
                const int i = e >> 6, dd = e & 63; const size_t tok = (size_t)(tok0 + i);
                const float cs = p.rope[(tok * 64 + dd) * 2], sn = p.rope[(tok * 64 + dd) * 2 + 1];
                const bf16_t* zr = z + tok * ZW;
                const float q1 = bf2f(zr[2048 + h * 128 + dd]), q2 = bf2f(zr[2048 + h * 128 + 64 + dd]);
                const float k1 = bf2f(zr[3072 + h * 128 + dd]), k2 = bf2f(zr[3072 + h * 128 + 64 + dd]);
                Qs[i * 129 + dd] = q1 * cs - q2 * sn; Qs[i * 129 + 64 + dd] = q1 * sn + q2 * cs;
                const float sc = 0.08838834764831845f;
                Ks[i * 129 + dd] = (k1 * cs - k2 * sn) * sc; Ks[i * 129 + 64 + dd] = (k1 * sn + k2 * cs) * sc;
            }
            for (int e = tid; e < 1024; e += NTH) { const int j = e >> 4, v = e & 15; Vs[e] = bf2f(z[(size_t)(tok0 + j) * ZW + 4096 + h * 256 + vs * 16 + v]); }
            __syncthreads();
            {
                const int j = tid & 63, i0 = (tid >> 6) * 8;
                float acc[8];
#pragma unroll
                for (int ii = 0; ii < 8; ++ii) acc[ii] = 0.f;
                for (int d = 0; d < 128; ++d) {
                    const float kv = Ks[j * 129 + d];
#pragma unroll
                    for (int ii = 0; ii < 8; ++ii) acc[ii] += Qs[(i0 + ii) * 129 + d] * kv;
                }
#pragma unroll
                for (int ii = 0; ii < 8; ++ii) { const int i = i0 + ii; At[i * 65 + j] = acc[ii] * expf(lg * fabsf((float)(i - j))); }
            }
            __syncthreads();
            {
                const int v = tid & 15, i0 = tid >> 4;
#pragma unroll
                for (int rep = 0; rep < 2; ++rep) {
                    const int i = i0 + 32 * rep;
                    float a = 0.f; for (int j = 0; j < 64; ++j) a += At[i * 65 + j] * Vs[j * 16 + v];
                    float c2 = 0.f; for (int d = 0; d < 128; ++d) c2 += Qs[i * 129 + d] * Ss[d * 16 + v];
                    p.obuf[(size_t)(tok0 + i) * DM + h * 256 + vs * 16 + v] = a + c2 * expf(lg * (float)(i + 1));
                }
            }
            __syncthreads();
            {
                const int v = tid & 15, d0 = tid >> 4;
#pragma unroll
                for (int rep = 0; rep < 4; ++rep) {
                    const int d = d0 + 32 * rep;
                    float a = 0.f; for (int j = 0; j < 64; ++j) a += Ks[j * 129 + d] * kd[j] * Vs[j * 16 + v];
                    Ss[d * 16 + v] = Ss[d * 16 + v] * cdec + a;
                }
            }
        }
    }
    __syncthreads();
}


__device__ __forceinline__ void ph_retprep(const Params& p, int bid, int nb, float* lds) {
    bf16_t* Kl = (bf16_t*)lds;
    bf16_t* Vl = Kl + 64 * 130;
    char* Qm = (char*)lds + 49664;
    char* Km = Qm + 16384;
    const int tid = tid_(), wave = tid >> 6, lane = tid & 63, fr = lane & 15, fq = lane >> 4;
    for (int it = bid; it < 1024; it += nb) {
        const int n = it & 63, h = (it >> 6) & 7, b = it >> 9;
        const int tok0 = b * SQ + n * 64;
        const size_t rowbase = (size_t)(b * 8 + h) * SQ + n * 64;
        const float lg = log1pf(-exp2f(-5.0f - (float)h));
        __syncthreads();
#pragma unroll
        for (int k = 0; k < 2; ++k) {
            const int u = tid + 512 * k, i = u >> 4, dd = (u & 15) * 4; const size_t tok = (size_t)(tok0 + i);
            const float4 r0 = *(const float4*)(p.rope + (tok * 64 + dd) * 2), r1 = *(const float4*)(p.rope + (tok * 64 + dd) * 2 + 4);
            const float cs[4] = {r0.x, r0.z, r1.x, r1.z}, sn[4] = {r0.y, r0.w, r1.y, r1.w};
            const bf16_t* zr = p.ZG + tok * ZW;
            const uint2 q1w = *(const uint2*)(zr + 2048 + h * 128 + dd), q2w = *(const uint2*)(zr + 2048 + h * 128 + 64 + dd);
            const uint2 k1w = *(const uint2*)(zr + 3072 + h * 128 + dd), k2w = *(const uint2*)(zr + 3072 + h * 128 + 64 + dd);
            const float q1[4] = {bflo(q1w.x), bfhi(q1w.x), bflo(q1w.y), bfhi(q1w.y)}, q2[4] = {bflo(q2w.x), bfhi(q2w.x), bflo(q2w.y), bfhi(q2w.y)};
            const float k1[4] = {bflo(k1w.x), bfhi(k1w.x), bflo(k1w.y), bfhi(k1w.y)}, k2[4] = {bflo(k2w.x), bfhi(k2w.x), bflo(k2w.y), bfhi(k2w.y)};
            const float sc = 0.08838834764831845f, kd = expf(lg * (float)(63 - i));
            float qa[4], qb[4], ka[4], kb[4];
#pragma unroll
            for (int e = 0; e < 4; ++e) { qa[e] = q1[e] * cs[e] - q2[e] * sn[e]; qb[e] = q1[e] * sn[e] + q2[e] * cs[e]; ka[e] = (k1[e] * cs[e] - k2[e] * sn[e]) * sc; kb[e] = (k1[e] * sn[e] + k2[e] * cs[e]) * sc; }
            const uint2 qaw = make_uint2(pk2(qa[0], qa[1]), pk2(qa[2], qa[3])), qbw = make_uint2(pk2(qb[0], qb[1]), pk2(qb[2], qb[3]));
            const uint2 kaw = make_uint2(pk2(ka[0], ka[1]), pk2(ka[2], ka[3])), kbw = make_uint2(pk2(kb[0], kb[1]), pk2(kb[2], kb[3]));
            *(uint2*)(p.Qr + (rowbase + i) * 128 + dd) = qaw; *(uint2*)(p.Qr + (rowbase + i) * 128 + 64 + dd) = qbw;
            const int c = dd >> 3, o8 = (dd & 7) * 2;
            *(uint2*)(Qm + i * 256 + ((c ^ (i & 15)) << 4) + o8) = qaw; *(uint2*)(Qm + i * 256 + (((c + 8) ^ (i & 15)) << 4) + o8) = qbw;
            *(uint2*)(Km + i * 256 + ((c ^ (i & 15)) << 4) + o8) = kaw; *(uint2*)(Km + i * 256 + (((c + 8) ^ (i & 15)) << 4) + o8) = kbw;
            *(unsigned*)(Kl + i * 130 + dd) = pk2(ka[0] * kd, ka[1] * kd); *(unsigned*)(Kl + i * 130 + dd + 2) = pk2(ka[2] * kd, ka[3] * kd);
            *(unsigned*)(Kl + i * 130 + 64 + dd) = pk2(kb[0] * kd, kb[1] * kd); *(unsigned*)(Kl + i * 130 + 64 + dd + 2) = pk2(kb[2] * kd, kb[3] * kd);
        }
#pragma unroll
        for (int k = 0; k < 4; ++k) {
            const int u = tid + 512 * k, j = u >> 5, c = u & 31;
            const uint4 w = *(const uint4*)(p.ZG + (size_t)(tok0 + j) * ZW + 4096 + h * 256 + c * 8);
            unsigned* d = (unsigned*)(Vl + j * 258 + c * 8); d[0] = w.x; d[1] = w.y; d[2] = w.z; d[3] = w.w;
        }
        __syncthreads();
        {
            const int jt = wave >> 1, it0 = 2 * (wave & 1);
            f32x4_t s0 = {0.f, 0.f, 0.f, 0.f}, s1 = {0.f, 0.f, 0.f, 0.f};
#pragma unroll
            for (int ks = 0; ks < 4; ++ks) {
                const bf16x8_t a = ldfrag(Km, jt * 16 + fr, ks * 4 + fq, 256, 15);
                const bf16x8_t b0 = ldfrag(Qm, it0 * 16 + fr, ks * 4 + fq, 256, 15), b1 = ldfrag(Qm, (it0 + 1) * 16 + fr, ks * 4 + fq, 256, 15);
                s0 = __builtin_amdgcn_mfma_f32_16x16x32_bf16(a, b0, s0, 0, 0, 0);
                s1 = __builtin_amdgcn_mfma_f32_16x16x32_bf16(a, b1, s1, 0, 0, 0);
            }
            const int j0 = jt * 16 + fq * 4;
            bf16_t* pg = p.Pm + (size_t)it * 4096;
#pragma unroll
            for (int tt = 0; tt < 2; ++tt) {
                const int i = (it0 + tt) * 16 + fr; const f32x4_t sv4 = tt ? s1 : s0; float pv[4];
#pragma unroll
                for (int r = 0; r < 4; ++r) pv[r] = sv4[r] * __expf(lg * fabsf((float)(i - (j0 + r))));
                *(uint2*)(pg + i * 64 + j0) = make_uint2(pk2(pv[0], pv[1]), pk2(pv[2], pv[3]));
            }
        }
        bf16_t* kt = p.KTd + (size_t)it * 8192;
#pragma unroll
        for (int k = 0; k < 2; ++k) {
            const int u = tid + 512 * k, jg = u & 7, d = u >> 3;
            unsigned w[4];
#pragma unroll
            for (int q = 0; q < 4; ++q) w[q] = (unsigned)Kl[(jg * 8 + 2 * q) * 130 + d] | ((unsigned)Kl[(jg * 8 + 2 * q + 1) * 130 + d] << 16);
            *(uint4*)(kt + d * 64 + jg * 8) = make_uint4(w[0], w[1], w[2], w[3]);
        }
        bf16_t* vt = p.Vt + (size_t)it * 16384;
#pragma unroll
        for (int k = 0; k < 4; ++k) {
            const int u = tid + 512 * k, jg = u & 7, v = u >> 3;
            unsigned w[4];
#pragma unroll
            for (int q = 0; q < 4; ++q) w[q] = (unsigned)Vl[(jg * 8 + 2 * q) * 258 + v] | ((unsigned)Vl[(jg * 8 + 2 * q + 1) * 258 + v] << 16);
            *(uint4*)(vt + v * 64 + jg * 8) = make_uint4(w[0], w[1], w[2], w[3]);
        }
    }
    __syncthreads();
}

__device__ __forceinline__ void ph_ret2(const Params& p, int bid, int nb, float* lds) {
    char* L = (char*)lds;
    constexpr int OQ = 0, OKT = 16384, OPP = 32768, OVT = 40960, TILE = 43008, OST = 2 * TILE;
    const int tid = tid_(), wave = tid >> 6, lane = tid & 63, fr = lane & 15, fq = lane >> 4;
    for (int it = bid; it < 256; it += nb) {
        const int itm = ((it & 7) * 2 + (it >> 7)) * 16 + ((it >> 3) & 15);
        const int vs = itm & 15, h = (itm >> 4) & 7, b = itm >> 7;
        const float lg = log1pf(-exp2f(-5.0f - (float)h));
        const float cdec = expf(lg * 64.0f);
        const size_t bh = (size_t)(b * 8 + h);
        const char* gQ = (const char*)(p.Qr + bh * SQ * 128);
        const char* gKT = (const char*)(p.KTd + bh * 64 * 8192);
        const char* gP = (const char*)(p.Pm + bh * 64 * 4096);
        const char* gVt = (const char*)(p.Vt + bh * 64 * 16384) + vs * 16 * 128;
        int lq[2], lkt[2];
#pragma unroll
        for (int u = 0; u < 2; ++u) { const int ci = tid + 512 * u; const int r = ci >> 4, c = ci & 15; lq[u] = r * 256 + ((c ^ (r & 15)) << 4); const int d = ci >> 3, c8 = ci & 7; lkt[u] = d * 128 + ((c8 ^ (d & 7)) << 4); }
        const int lp = (tid >> 3) * 128 + (((tid & 7) ^ ((tid >> 3) & 7)) << 4);
        const int lv = lp;
        uint4 qA0, qA1, tA0, tA1, pA, vA = make_uint4(0u, 0u, 0u, 0u), qB0, qB1, tB0, tB1, pB, vB = vA, qC0, qC1, tC0, tC1, pC, vC = vA, qD0, qD1, tD0, tD1, pD, vD = vA;
#define RET_LOAD(X_, n_) do { const size_t o0 = (size_t)(n_) * 16384 + (size_t)tid * 16, o1 = o0 + 8192; \
        q##X_##0 = *(const uint4*)(gQ + o0); q##X_##1 = *(const uint4*)(gQ + o1); t##X_##0 = *(const uint4*)(gKT + o0); t##X_##1 = *(const uint4*)(gKT + o1); p##X_ = *(const uint4*)(gP + (size_t)(n_) * 8192 + tid * 16); \
        if (tid < 128) v##X_ = *(const uint4*)(gVt + (size_t)(n_) * 32768 + tid * 16); } while (0)
#define RET_WRITE(X_, buf_) do { char* B_ = L + (buf_) * TILE; \
        *(uint4*)(B_ + OQ + lq[0]) = q##X_##0; *(uint4*)(B_ + OQ + lq[1]) = q##X_##1; *(uint4*)(B_ + OKT + lkt[0]) = t##X_##0; *(uint4*)(B_ + OKT + lkt[1]) = t##X_##1; *(uint4*)(B_ + OPP + lp) = p##X_; \
        if (tid < 128) *(uint4*)(B_ + OVT + lv) = v##X_; } while (0)
        __syncthreads();
        for (int i = tid; i < 1024; i += NTH) ((unsigned*)(L + OST))[i] = 0u;
        RET_LOAD(A, 0); RET_WRITE(A, 0); RET_LOAD(B, 1); RET_LOAD(C, 2); RET_LOAD(D, 3);
        f32x4_t sacc[2] = {{0.f, 0.f, 0.f, 0.f}, {0.f, 0.f, 0.f, 0.f}};
#define RET_STEP(n_, cur_, LS_, WS_) do { const int n = (n_); constexpr int cur = (cur_); \
            __syncthreads();                                     \
            if (n + 4 < 64) RET_LOAD(LS_, n + 4); \
            const char* T = L + cur * TILE; \
            if (wave < 4) {     \
                const int itl = wave; \
                f32x4_t o1 = {0.f, 0.f, 0.f, 0.f}, o2 = {0.f, 0.f, 0.f, 0.f}; \
                _Pragma("unroll") for (int ks = 0; ks < 2; ++ks) o1 = __builtin_amdgcn_mfma_f32_16x16x32_bf16(ldfrag(T + OPP, itl * 16 + fr, ks * 4 + fq, 128, 7), ldfrag(T + OVT, fr, ks * 4 + fq, 128, 7), o1, 0, 0, 0); \
                _Pragma("unroll") for (int ks = 0; ks < 4; ++ks) o2 = __builtin_amdgcn_mfma_f32_16x16x32_bf16(ldfrag(T + OQ, itl * 16 + fr, ks * 4 + fq, 256, 15), ldfrag(L + OST + cur * 4096, fr, ks * 4 + fq, 256, 15), o2, 0, 0, 0); \
                _Pragma("unroll") for (int r = 0; r < 4; ++r) { const int i = itl * 16 + fq * 4 + r; \
                    p.ob16[(size_t)(b * SQ + n * 64 + i) * DM + h * 256 + vs * 16 + fr] = (bf16_t)f2bf(o1[r] + __expf(lg * (float)(i + 1)) * o2[r]); } \
            } else {            \
                _Pragma("unroll") for (int u = 0; u < 2; ++u) { \
                    const int dt = 2 * (wave - 4) + u; \
                    sacc[u] = sacc[u] * cdec; \
                    _Pragma("unroll") for (int ks = 0; ks < 2; ++ks) sacc[u] = __builtin_amdgcn_mfma_f32_16x16x32_bf16(ldfrag(T + OKT, dt * 16 + fr, ks * 4 + fq, 128, 7), ldfrag(T + OVT, fr, ks * 4 + fq, 128, 7), sacc[u], 0, 0, 0); \
                    *(uint2*)(L + OST + (cur ^ 1) * 4096 + fr * 256 + (((dt * 2 + (fq >> 1)) ^ fr) << 4) + (fq & 1) * 8) = make_uint2(pk2(sacc[u][0], sacc[u][1]), pk2(sacc[u][2], sacc[u][3])); } \
            } \
            if (n + 1 < 64) RET_WRITE(WS_, cur ^ 1); } while (0)
#pragma unroll
        for (int n4 = 0; n4 < 64; n4 += 4) { RET_STEP(n4, 0, A, B); RET_STEP(n4 + 1, 1, B, C); RET_STEP(n4 + 2, 0, C, D); RET_STEP(n4 + 3, 1, D, A); }
#undef RET_STEP
#undef RET_LOAD
#undef RET_WRITE
    }
    __syncthreads();
}

__device__ __forceinline__ void gn_load(const Params& p, int tok, int lane, uint2 (&ow)[8], uint2 (&gw)[8]) {
#pragma unroll
    for (int h = 0; h < 8; ++h) { ow[h] = *(const uint2*)(p.ob16 + (size_t)tok * DM + h * 256 + lane * 4); gw[h] = *(const uint2*)(p.ZG + (size_t)tok * ZW + 6144 + h * 256 + lane * 4); }
}
__device__ __forceinline__ void ph_gn(const Params& p, int bid, int nb, float* lds) {
    const int tid = tid_(), wave = tid >> 6, lane = tid & 63;
    const int stride = nb * 8;
    int tok = bid * 8 + wave;
    uint2 ow[8], gw[8], own[8], gwn[8];
    if (tok < NTOK) gn_load(p, tok, lane, ow, gw);
    for (; tok < NTOK; tok += stride) {
        if (tok + stride < NTOK) gn_load(p, tok + stride, lane, own, gwn);
        float4 o[8]; float s1[8], s2[8];
#pragma unroll
        for (int h = 0; h < 8; ++h) { o[h] = make_float4(bflo(ow[h].x), bfhi(ow[h].x), bflo(ow[h].y), bfhi(ow[h].y)); s1[h] = (o[h].x + o[h].y) + (o[h].z + o[h].w); }
#pragma unroll
        for (int h = 0; h < 8; ++h) s1[h] = row_sum16(s1[h]);
#pragma unroll
        for (int h = 0; h < 8; ++h) s1[h] = xsum32(xsum16(s1[h]));
#pragma unroll
        for (int h = 0; h < 8; ++h) { const float mu = s1[h] * (1.0f / 256.0f); o[h].x -= mu; o[h].y -= mu; o[h].z -= mu; o[h].w -= mu; s2[h] = dot4(o[h], o[h]); }
#pragma unroll
        for (int h = 0; h < 8; ++h) s2[h] = row_sum16(s2[h]);
#pragma unroll
        for (int h = 0; h < 8; ++h) s2[h] = xsum32(xsum16(s2[h]));
#pragma unroll
        for (int h = 0; h < 8; ++h) {
            const float rs = 1.0f / sqrtf(s2[h] * (1.0f / 256.0f) + 1e-6f);
            const float4 gn = *(const float4*)(p.ret_gn_g + h * 256 + lane * 4);
            const float g0 = bflo(gw[h].x), g1 = bfhi(gw[h].x), g2 = bflo(gw[h].y), g3 = bfhi(gw[h].y);
            st_wt8(p.ybin + (size_t)tok * DM + h * 256 + lane * 4,
                make_uint2(pk2(siluf_(g0) * o[h].x * rs * gn.x, siluf_(g1) * o[h].y * rs * gn.y), pk2(siluf_(g2) * o[h].z * rs * gn.z, siluf_(g3) * o[h].w * rs * gn.w)));
        }
#pragma unroll
        for (int h = 0; h < 8; ++h) { ow[h] = own[h]; gw[h] = gwn[h]; }
    }
}

__device__ __forceinline__ void split8(const float4 a, const float4 b, uint4& hi, uint4& lo) {
    const float x[8] = {a.x, a.y, a.z, a.w, b.x, b.y, b.z, b.w}; unsigned h[8], l[8];
#pragma unroll
    for (int i = 0; i < 8; ++i) { h[i] = f2bf(x[i]); l[i] = f2bf(x[i] - __uint_as_float(h[i] << 16)); }
    hi = make_uint4(h[0] | (h[1] << 16), h[2] | (h[3] << 16), h[4] | (h[5] << 16), h[6] | (h[7] << 16));
    lo = make_uint4(l[0] | (l[1] << 16), l[2] | (l[3] << 16), l[4] | (l[5] << 16), l[6] | (l[7] << 16));
}
__device__ __forceinline__ bf16x8_t as_bf16x8(const uint4 v) { return __builtin_bit_cast(bf16x8_t, v); }
struct PairTab { int a[52], b[52]; };
__host__ __device__ constexpr PairTab make_pairs() {
    PairTab t{}; int n = 0;
    for (int a = 0; a < 16; ++a) for (int b = 0; b < 16; ++b) if ((a + 1) * (b + 1) <= 16) { t.a[n] = a; t.b[n] = b; ++n; }
    for (; n < 52; ++n) { t.a[n] = -1; t.b[n] = -1; }
    return t;
}
constexpr PairTab PAIRS = make_pairs();
static_assert(PAIRS.a[49] >= 0 && PAIRS.a[50] < 0, "50 candidate pairs");

template <int N, int OFF> __device__ __forceinline__ void bitonic_sort_desc(float* v) {
#pragma unroll
    for (int k = 2; k <= N; k <<= 1)
#pragma unroll
        for (int j = k >> 1; j > 0; j >>= 1)
#pragma unroll
            for (int i = 0; i < N; ++i) { const int l = i ^ j; if (l > i) { const bool up = ((i & k) == 0);
                const float a = v[OFF + i], b = v[OFF + l]; const float mx = fmaxf(a, b), mn = fminf(a, b); v[OFF + i] = up ? mx : mn; v[OFF + l] = up ? mn : mx; } }
}
template <int N> __device__ __forceinline__ void bitonic_merge_desc(float* v) {
#pragma unroll
    for (int j = N >> 1; j > 0; j >>= 1)
#pragma unroll
        for (int i = 0; i < N; ++i) { const int l = i ^ j; if (l > i) { const float a = v[i], b = v[l]; v[i] = fmaxf(a, b); v[l] = fminf(a, b); } }
}
__device__ __forceinline__ void ph_topk2(const Params& p, const float* qb, int bid, int nb, float* lds, int it_fixed) {
    const int tid = tid_(), wave = tid >> 6, lane = tid & 63;
    uint4* SK = (uint4*)lds;
    const float NEG = -INFINITY;
    const bool tc_on = (nb == 256); const int tcr0 = (bid * 8 + wave) * 16; float4 tct[8];
    if (tc_on) tc_load(p, tcr0, lane, tct);
    for (int it = (it_fixed >= 0 ? it_fixed : bid); it < 256; it += (it_fixed >= 0 ? 256 : nb)) {
        const int h = it & 7, tg = it >> 3;
        __syncthreads();
        for (int gi = tid; gi < 4096; gi += NTH) {
            const int dq = gi & 15, n = (gi >> 4) & 127, pp = gi >> 11;
            const float4* src = (const float4*)(p.peer_sk + ((size_t)(h * 2 + pp) * 128 + n) * 128 + dq * 8);
            uint4 hi, lo; split8(src[0], src[1], hi, lo);
            const int base = (((pp * 8 + (n >> 4)) * 4 + (dq >> 2)) * 2) * 64 + (dq & 3) * 16 + (n & 15);
            SK[base] = hi; SK[base + 64] = lo;
        }
        __syncthreads();
#pragma unroll 1
        for (int tile = 0; tile < 2; ++tile) {
            const int tok = tg * 256 + wave * 32 + tile * 16 + (lane & 15);
            const int qd = lane >> 4;
            float v12[2][16];
#pragma unroll
            for (int pp = 0; pp < 2; ++pp) {
                if (tc_on) { const int ti = tile * 8 + pp * 4; tc_finish(p, tcr0 + ti, lane, tct); tc_load(p, tcr0 + ti + 1, lane, tct); }
                bf16x8_t Bh[4], Bl[4];
                const float* qp = qb + (size_t)tok * DM + h * 256 + pp * 128 + 8 * qd;
#pragma unroll
                for (int ks = 0; ks < 4; ++ks) { uint4 hi, lo; split8(*(const float4*)(qp + ks * 32), *(const float4*)(qp + ks * 32 + 4), hi, lo); Bh[ks] = as_bf16x8(hi); Bl[ks] = as_bf16x8(lo); }
                float v[32];
#pragma unroll
                for (int kt = 0; kt < 8; ++kt) {
                    f32x4_t acc = {0.f, 0.f, 0.f, 0.f};
#pragma unroll
                    for (int ks = 0; ks < 4; ++ks) {
                        const bf16x8_t Ah = as_bf16x8(SK[(((pp * 8 + kt) * 4 + ks) * 2) * 64 + lane]), Al = as_bf16x8(SK[(((pp * 8 + kt) * 4 + ks) * 2 + 1) * 64 + lane]);
                        acc = __builtin_amdgcn_mfma_f32_16x16x32_bf16(Ah, Bh[ks], acc, 0, 0, 0);
                        acc = __builtin_amdgcn_mfma_f32_16x16x32_bf16(Ah, Bl[ks], acc, 0, 0, 0);
                        acc = __builtin_amdgcn_mfma_f32_16x16x32_bf16(Al, Bh[ks], acc, 0, 0, 0);
                    }
#pragma unroll
                    for (int r = 0; r < 4; ++r) v[kt * 4 + r] = __uint_as_float((__float_as_uint(acc[r]) & ~127u) | (unsigned)(kt * 16 + qd * 4 + r));
                    __builtin_amdgcn_sched_barrier(0);
                }
                if (tc_on) { const int ti = tile * 8 + pp * 4 + 1; tc_finish(p, tcr0 + ti, lane, tct); tc_load(p, tcr0 + ti + 1, lane, tct); }
                bitonic_sort_desc<16, 0>(v); bitonic_sort_desc<16, 16>(v);
                float c16[16];
#pragma unroll
                for (int i = 0; i < 16; ++i) c16[i] = fmaxf(v[i], v[31 - i]);
                bitonic_merge_desc<16>(c16);
                if (tc_on) { const int ti = tile * 8 + pp * 4 + 2; tc_finish(p, tcr0 + ti, lane, tct); tc_load(p, tcr0 + ti + 1, lane, tct); }
#pragma unroll
                for (int st = 0; st < 2; ++st) {
                    float pr[16];
#pragma unroll
                    for (int i = 0; i < 16; ++i) pr[i] = __shfl_xor(c16[i], 16 << st);
#pragma unroll
                    for (int i = 0; i < 16; ++i) c16[i] = fmaxf(c16[i], pr[15 - i]);
                    bitonic_merge_desc<16>(c16);
                }
                if (tc_on) { const int ti = tile * 8 + pp * 4 + 3; tc_finish(p, tcr0 + ti, lane, tct); if (ti < 15) tc_load(p, tcr0 + ti + 1, lane, tct); }
#pragma unroll
                for (int i = 0; i < 16; ++i) v12[pp][i] = c16[i];
            }
            float c[13]; unsigned pay[13];
#pragma unroll
            for (int s = 0; s < 13; ++s) {
                float cq[4]; unsigned pq[4];
#pragma unroll
                for (int q = 0; q < 4; ++q) {
                    const int pi = 4 * s + q; const int a = PAIRS.a[pi], b = PAIRS.b[pi];
                    if (a >= 0) {
                        const float sum = v12[0][a] + v12[1][b];
                        cq[q] = __uint_as_float((__float_as_uint(sum) & ~63u) | (unsigned)pi);
                        pq[q] = (__float_as_uint(v12[0][a]) & 127u) * 128u + (__float_as_uint(v12[1][b]) & 127u);
                    } else { cq[q] = NEG; pq[q] = 0u; }
                }
                c[s] = qd == 0 ? cq[0] : qd == 1 ? cq[1] : qd == 2 ? cq[2] : cq[3];
                pay[s] = qd == 0 ? pq[0] : qd == 1 ? pq[1] : qd == 2 ? pq[2] : pq[3];
            }
            float top[16]; unsigned eid[16];
#pragma unroll
            for (int r = 0; r < 16; ++r) {
                float m = c[0];
#pragma unroll
                for (int s = 1; s < 13; ++s) m = fmaxf(m, c[s]);
                m = fmaxf(m, __shfl_xor(m, 16)); m = fmaxf(m, __shfl_xor(m, 32));
                unsigned pw = 0u;
#pragma unroll
                for (int s = 0; s < 13; ++s) { const bool eq = (c[s] == m); pw |= eq ? pay[s] : 0u; c[s] = eq ? NEG : c[s]; }
                pw |= (unsigned)__shfl_xor((int)pw, 16); pw |= (unsigned)__shfl_xor((int)pw, 32);
                top[r] = m; eid[r] = pw;
            }
            float sum = 0.f; const float mx = top[0];
#pragma unroll
            for (int r = 0; r < 16; ++r) { top[r] = expf(top[r] - mx); sum += top[r]; }
            const float inv = 1.0f / sum;
            if (lane < 16) {
                int4* ep = (int4*)(p.eidx + (size_t)tok * 128 + h * 16); float4* gp = (float4*)(p.gatev + (size_t)tok * 128 + h * 16);
#pragma unroll
                for (int q = 0; q < 4; ++q) {
                    ep[q] = make_int4((int)eid[4 * q], (int)eid[4 * q + 1], (int)eid[4 * q + 2], (int)eid[4 * q + 3]);
                    gp[q] = make_float4(top[4 * q] * inv, top[4 * q + 1] * inv, top[4 * q + 2] * inv, top[4 * q + 3] * inv);
                }
            }
        }
    }
    __syncthreads();
}

__device__ __forceinline__ void peer_load4(const unsigned char* tab, const int (&e)[4], int lane, uint2 (&R)[4][3]) {
#pragma unroll
    for (int i = 0; i < 4; ++i) { const uint2* r = (const uint2*)(tab + (size_t)e[i] * ROW6 + lane * 8); R[i][0] = r[0]; R[i][1] = r[64]; R[i][2] = r[128]; }
}
__device__ __forceinline__ f32x32_t dec6(const uint2 (&R)[3]) { const u32x6_t w = {R[0].x, R[0].y, R[1].x, R[1].y, R[2].x, R[2].y}; return __builtin_amdgcn_cvt_scalef32_pk32_f32_fp6(w, 1.0f); }
typedef float f32x2_t __attribute__((ext_vector_type(2)));
__device__ __forceinline__ bf16x8_t dec4_frag(unsigned w) {
    const unsigned a = __builtin_bit_cast(unsigned, __builtin_amdgcn_cvt_scalef32_pk_bf16_fp4(w, 1.0f, 0)), b = __builtin_bit_cast(unsigned, __builtin_amdgcn_cvt_scalef32_pk_bf16_fp4(w, 1.0f, 1));
    const unsigned c = __builtin_bit_cast(unsigned, __builtin_amdgcn_cvt_scalef32_pk_bf16_fp4(w, 1.0f, 2)), d = __builtin_bit_cast(unsigned, __builtin_amdgcn_cvt_scalef32_pk_bf16_fp4(w, 1.0f, 3));
    return as_bf16x8(make_uint4(a, b, c, d));
}
__device__ __forceinline__ void peer_vgroup(const Params& p, int lane, const uint4 (&Vc)[4], const float (&wgt)[4], f32x2_t (&y2)[16]) {
#pragma unroll
    for (int i = 0; i < 4; ++i) {
        const f32x2_t w2 = {wgt[i], wgt[i]};
        unsigned vw[4] = {Vc[i].x, Vc[i].y, Vc[i].z, Vc[i].w};
        asm volatile("" : "+v"(vw[0]), "+v"(vw[1]), "+v"(vw[2]), "+v"(vw[3]));
#pragma unroll
        for (int j = 0; j < 4; ++j) {
            y2[4 * j + 0] += w2 * __builtin_amdgcn_cvt_scalef32_pk_f32_fp4(vw[j], 1.0f, 0);
            y2[4 * j + 1] += w2 * __builtin_amdgcn_cvt_scalef32_pk_f32_fp4(vw[j], 1.0f, 1);
            y2[4 * j + 2] += w2 * __builtin_amdgcn_cvt_scalef32_pk_f32_fp4(vw[j], 1.0f, 2);
            y2[4 * j + 3] += w2 * __builtin_amdgcn_cvt_scalef32_pk_f32_fp4(vw[j], 1.0f, 3);
        }
#pragma unroll
        for (int k = 0; k < 16; ++k) asm volatile("" : "+v"(y2[k]));
    }
}
template <bool LD>
__device__ __forceinline__ void peer_ublk(const Params& p, const char* HL, int kq, int blk, unsigned nof, const unsigned (&ur)[8], uint4 (&Ac)[8], f32x4_t (&acc)[8]) {
    bf16x8_t B[4];
#pragma unroll
    for (int sidx = 0; sidx < 4; ++sidx) B[sidx] = *(const bf16x8_t*)(HL + (blk * 128 + sidx * 32 + kq * 8) * 2);
#pragma unroll
    for (int G = 0; G < 8; ++G) {
        const bf16x8_t f0 = dec4_frag(Ac[G].x), f1 = dec4_frag(Ac[G].y), f2 = dec4_frag(Ac[G].z), f3 = dec4_frag(Ac[G].w);
        if constexpr (LD) Ac[G] = *(const uint4*)(p.U8 + (ur[G] + nof));
        acc[G] = __builtin_amdgcn_mfma_f32_16x16x32_bf16(f0, B[0], acc[G], 0, 0, 0);
        acc[G] = __builtin_amdgcn_mfma_f32_16x16x32_bf16(f1, B[1], acc[G], 0, 0, 0);
        acc[G] = __builtin_amdgcn_mfma_f32_16x16x32_bf16(f2, B[2], acc[G], 0, 0, 0);
        acc[G] = __builtin_amdgcn_mfma_f32_16x16x32_bf16(f3, B[3], acc[G], 0, 0, 0);
        __builtin_amdgcn_sched_barrier(0);
    }
}
__device__ __forceinline__ void ph_peer6(const Params& p, const float* x1, const bf16_t* h2, int bid, int nb, float* lds) {
    const int tid = tid_(), wave = tid >> 6, lane0 = tid & 63;
    for (int t = bid * 8 + wave; t < NTOK; t += nb * 8) {
        int lane = lane0; asm volatile("" : "+v"(lane));
        const int fr = lane & 15, kq = lane >> 4;
        char* HL = (char*)lds + wave * 4608;
        float* WL = (float*)(HL + 4096);
        const int b = t / SQ;
#pragma unroll
        for (int q = 0; q < 4; ++q) *(uint4*)(HL + (lane + 64 * q) * 16) = *(const uint4*)(h2 + (size_t)t * DM + (lane + 64 * q) * 8);
        const int e0 = p.eidx[(size_t)t * 128 + lane], e1 = p.eidx[(size_t)t * 128 + 64 + lane];
        const float su0 = p.su[e0], su1 = p.su[e1];
        const float gv0 = p.gatev[(size_t)t * 128 + lane] * p.sv[e0], gv1 = p.gatev[(size_t)t * 128 + 64 + lane] * p.sv[e1];
        unsigned ur[8];
#pragma unroll
        for (int G = 0; G < 8; ++G) ur[G] = (unsigned)__shfl(G < 4 ? e0 : e1, 16 * (G & 3) + fr) * (unsigned)ROW4 + (unsigned)kq * 16u;
        f32x4_t acc[8];
#pragma unroll
        for (int G = 0; G < 8; ++G) acc[G] = (f32x4_t){0.f, 0.f, 0.f, 0.f};
        uint4 Aa[8], Ab[8];
#pragma unroll
        for (int G = 0; G < 8; ++G) Aa[G] = *(const uint4*)(p.U8 + ur[G]);
#pragma unroll
        for (int G = 0; G < 8; ++G) Ab[G] = *(const uint4*)(p.U8 + (ur[G] + 64u));
#pragma unroll 1
        for (int blk = 0; blk < 14; blk += 2) {
            peer_ublk<true>(p, HL, kq, blk, (unsigned)(blk + 2) * 64u, ur, Aa, acc);
            peer_ublk<true>(p, HL, kq, blk + 1, (unsigned)(blk + 3) * 64u, ur, Ab, acc);
        }
        peer_ublk<false>(p, HL, kq, 14, 0u, ur, Aa, acc);
        peer_ublk<false>(p, HL, kq, 15, 0u, ur, Ab, acc);
        const int kq4 = 4 * kq;
#pragma unroll
        for (int G = 0; G < 8; ++G) {
            float av[4];
#pragma unroll
            for (int j = 0; j < 4; ++j) av[j] = acc[G][j] * __shfl(G < 4 ? su0 : su1, (16 * (G & 3) + j) + kq4);
            const f32x2_t g01 = pg8::gelu_pk((f32x2_t){av[0], av[1]}), g23 = pg8::gelu_pk((f32x2_t){av[2], av[3]});
            const float w0 = g01.x * __shfl(G < 4 ? gv0 : gv1, (16 * (G & 3) + 0) + kq4), w1 = g01.y * __shfl(G < 4 ? gv0 : gv1, (16 * (G & 3) + 1) + kq4);
            const float w2_ = g23.x * __shfl(G < 4 ? gv0 : gv1, (16 * (G & 3) + 2) + kq4), w3 = g23.y * __shfl(G < 4 ? gv0 : gv1, (16 * (G & 3) + 3) + kq4);
            if (fr == 0) *(float4*)(WL + 16 * G + kq4) = make_float4(w0, w1, w2_, w3);
            __builtin_amdgcn_sched_barrier(0);
        }
        f32x2_t y2[16];
#pragma unroll
        for (int i = 0; i < 16; ++i) y2[i] = (f32x2_t){0.f, 0.f};
        uint4 VA[4], VB[4], VC[4];
#define PV_LOAD(V, g) { const int sn_ = 4 * (g); const int en_ = (sn_ < 64) ? e0 : e1; _Pragma("unroll") for (int i = 0; i < 4; ++i) \
        V[i] = *(const uint4*)(p.V8 + ((unsigned)__builtin_amdgcn_readlane(en_, (sn_ + i) & 63) * (unsigned)ROW4 + (unsigned)lane * 16u)); }
#define PV_USE(V, g) { const float4 w4 = *(const float4*)(WL + 4 * (g)); const float wgt[4] = {w4.x, w4.y, w4.z, w4.w}; peer_vgroup(p, lane, V, wgt, y2); }
        PV_LOAD(VA, 0); PV_LOAD(VB, 1);
#pragma unroll
        for (int g = 0; g < 30; g += 3) {
            PV_LOAD(VC, g + 2); PV_USE(VA, g);
            PV_LOAD(VA, g + 3); PV_USE(VB, g + 1);
            PV_LOAD(VB, g + 4); PV_USE(VC, g + 2);
        }
        PV_USE(VA, 30); PV_USE(VB, 31);
#undef PV_LOAD
#undef PV_USE
        float y[32];
#pragma unroll
        for (int k = 0; k < 16; ++k) { y[2 * k] = y2[k].x; y[2 * k + 1] = y2[k].y; }
        float ss = 0.f;
#pragma unroll
        for (int q = 0; q < 8; ++q) {
            const int c = 256 * q + lane * 4;
            const float4 xv = *(const float4*)(x1 + (size_t)t * DM + c);
            const float4 ga = *(const float4*)(p.ada + b * NMOD + 5 * DM + c);
            float* yy = y + 4 * q;
            yy[0] = xv.x + ga.x * yy[0]; yy[1] = xv.y + ga.y * yy[1]; yy[2] = xv.z + ga.z * yy[2]; yy[3] = xv.w + ga.w * yy[3];
            ss += yy[0] * yy[0] + yy[1] * yy[1] + yy[2] * yy[2] + yy[3] * yy[3];
        }
        ss = xsum32(xsum16(row_sum16(ss)));
        const float rs = 1.0f / sqrtf(ss * (1.0f / DM) + 1e-6f);
#pragma unroll
        for (int q = 0; q < 8; ++q) {
            const int c = 256 * q + lane * 4;
            const float4 gf = *(const float4*)(p.norm_f_g + c);
            const float* yy = y + 4 * q;
            *(float4*)(p.out + (size_t)t * DM + c) = make_float4(yy[0] * rs * gf.x, yy[1] * rs * gf.y, yy[2] * rs * gf.z, yy[3] * rs * gf.w);
        }
    }
}

#define LAS __attribute__((address_space(3)))
#define XB_TMO      128
#define XB_XCNT(j)  (256  + 64 * (j))
#define XB_XSUB(j)  (1280 + 64 * (j))
#define XB_XGEN(j)  (2304 + 64 * (j))
#define XB_TOP      3328
#define XB_TOPGEN   3392
#define XCD_BAR_WORDS 3456
#define XB_SPIN_CAP (1u << 18)

__device__ __forceinline__ unsigned xb_ld(unsigned* p)              { return __hip_atomic_load(p, __ATOMIC_RELAXED, __HIP_MEMORY_SCOPE_AGENT); }
__device__ __forceinline__ unsigned xb_add(unsigned* p, unsigned v) { return __hip_atomic_fetch_add(p, v, __ATOMIC_RELAXED, __HIP_MEMORY_SCOPE_AGENT); }
__device__ __forceinline__ unsigned xb_xcc_id() { return (unsigned)__builtin_amdgcn_s_getreg((3 << 11) | 20) & 0xFu; }
#define XB_SPIN(cond, bar) do { unsigned _sp = 0; while (cond) { __builtin_amdgcn_s_sleep(1); \
    if ((++_sp & 255u) == 0u) { if (xb_ld(&(bar)[XB_TMO])) break; if (_sp > XB_SPIN_CAP) { atomicAdd(&(bar)[XB_TMO], 1u); break; } } } } while (0)

struct XcdBarrier {
    unsigned* bar; unsigned x;
    volatile LAS unsigned* st;
};

__device__ __forceinline__ XcdBarrier xcd_barrier_post(unsigned* bar, volatile LAS unsigned* st) {
    XcdBarrier b; b.bar = bar; b.x = xb_xcc_id(); b.st = st;
    if (tid_() == 0) (void)xb_add(&bar[XB_XCNT(b.x)], 1u);
    return b;
}
__device__ __forceinline__ void xcd_barrier_complete(unsigned* bar, unsigned x, unsigned& nloc, unsigned& nx) {
    const unsigned G = gridDim.x * gridDim.y * gridDim.z;
    unsigned sum, cnt, mine, sp = 0u;
    for (;;) {
        sum = 0u; cnt = 0u; mine = 0u;
#pragma unroll
        for (unsigned j = 0; j < 16; ++j) { const unsigned c = xb_ld(&bar[XB_XCNT(j)]); sum += c; cnt += (c > 0u) ? 1u : 0u; mine = (j == x) ? c : mine; }
        if (sum == G) break;
        __builtin_amdgcn_s_sleep(1);
        if ((++sp & 255u) == 0u) { if (xb_ld(&bar[XB_TMO])) break; if (sp > XB_SPIN_CAP) { atomicAdd(&bar[XB_TMO], 1u); break; } }
    }
    nloc = mine > 0u ? mine : 1u; nx = cnt > 0u ? cnt : 1u;
}

__device__ __forceinline__ void xcd_barrier(const XcdBarrier& b) {
    asm volatile("s_waitcnt vmcnt(0)" ::: "memory");
    __syncthreads();
    if (tid_() == 0) {
        unsigned* bar = b.bar;
        __builtin_amdgcn_s_waitcnt(0);
        unsigned nloc = b.st[0], nx = b.st[1];
        if (nloc == 0u) { xcd_barrier_complete(bar, b.x, nloc, nx); b.st[0] = nloc; b.st[1] = nx; }
        const unsigned old = xb_add(&bar[XB_XSUB(b.x)], 1u);
        const unsigned gen = old / nloc;
        if (old + 1u == (gen + 1u) * nloc) {
            __builtin_amdgcn_fence(__ATOMIC_RELEASE, "agent");
            asm volatile("s_waitcnt vmcnt(0)" ::: "memory");
            const unsigned og = xb_add(&bar[XB_TOP], 1u);
            const unsigned tg = og / nx;
            if (og + 1u == (tg + 1u) * nx) xb_add(&bar[XB_TOPGEN], 1u);
            else XB_SPIN(xb_ld(&bar[XB_TOPGEN]) == tg, bar);
            __builtin_amdgcn_fence(__ATOMIC_ACQUIRE, "agent");
            xb_add(&bar[XB_XGEN(b.x)], 1u);
            asm volatile("s_waitcnt vmcnt(0)" ::: "memory");
        } else {
            XB_SPIN(xb_ld(&bar[XB_XGEN(b.x)]) == gen, bar);
            __builtin_amdgcn_fence(__ATOMIC_ACQUIRE, "agent");
            asm volatile("s_waitcnt vmcnt(0)" ::: "memory");
        }
    }
    __syncthreads();
}

template <bool F8 = false, class Epi>
__device__ __forceinline__ void gemm_run(float* lds, const void* A, const void* Bt, int M, int N, int K, const Epi& E) {
    __syncthreads();
    pg8::Gemm g{(const bf16_t*)A, (const bf16_t*)Bt, M, N, F8 ? K / 2 : K}; pg8::StaticOrder S; S.init(M, N, (int)gridDim.x, (int)blockIdx.x);
    pg8::gemm_phase<Epi, pg8::StaticOrder, true, true, F8>((PG8_LAS unsigned char*)lds, g, S, E);
    __syncthreads();
}
constexpr int NPHASE = 11;
template <int PH>
__device__ __forceinline__ void run_phase(const Params& p, int bid, int nb, float* lds) {
    asm volatile("" : "+s"(bid));
    if constexpr (PH == 0) ph_prep(p, bid, nb, lds);
    if constexpr (PH == 1) ph_modnorm<true>(p, p.x, p.norm1_g, 0 * DM, 1 * DM, p.hb, bid, nb, lds);
    if constexpr (PH == 2) gemm_run<true>(lds, p.hb, p.Wt1, NTOK, ZW, DM, pg8::EpiZG{p.ZG, p.b_bg, 1.0f / W8S});
    if constexpr (PH == 3) { ph_retprep(p, bid, nb, lds); ph_gmlp2(p, bid, nb, lds); }
    if constexpr (PH == 11) ph_ret2(p, bid, nb, lds);
    if constexpr (PH == 4) ph_gn(p, bid, nb, lds);
    if constexpr (PH == 5) {
        gemm_run(lds, p.yain, p.Wta, NTOK, DM, 1024, pg8::EpiMixB<0>{p.hb, p.ZG, 0});
        gemm_run(lds, p.ybin, p.Wtb, NTOK, DM, DM, pg8::EpiMixB<1>{p.hb, p.ZG, 2048});
    }
    if constexpr (PH == 6) gemm_run(lds, p.hb, p.Wto, NTOK, DM, DM, pg8::EpiResF{p.obuf, p.x, p.ada + 2 * DM});
    if constexpr (PH == 7) { ph_modnorm<false>(p, p.obuf, p.norm2_g, 3 * DM, 4 * DM, p.hb, bid, nb, lds); if (nb != 256) ph_tabconv(p, bid, nb); }
    if constexpr (PH == 8) {
        gemm_run(lds, p.hb, p.Wtq, NTOK, DM, DM, pg8::EpiF32{p.qbuf, DM});
        if (nb == 256) {
            pg8::StaticOrder S; S.init(NTOK, DM, (int)gridDim.x, (int)blockIdx.x); pg8::Unit u; S.next(0, u);
            asm volatile("s_waitcnt vmcnt(0)" ::: "memory"); __syncthreads();
            ph_topk2(p, p.qbuf, bid, nb, lds, u.pm * 8 + u.pn);
        }
    }
    if constexpr (PH == 9) { if (nb != 256) ph_topk2(p, p.qbuf, bid, nb, lds, -1); }
    if constexpr (PH == 10) ph_peer6(p, p.obuf, p.hb, bid, nb, lds);
}

constexpr int MISC_OFF = 132 * 1024;
__global__ void __launch_bounds__(NTH) k_mega(Params p) {
    extern __shared__ __attribute__((aligned(16))) float lds[];
    const int bid = blockIdx.x, nb = gridDim.x;
    volatile LAS unsigned* misc = (volatile LAS unsigned*)((LAS unsigned char*)lds + MISC_OFF);
    if (threadIdx.x < 4) misc[threadIdx.x] = 0u;
    if ((threadIdx.x & 63) == 0) *(volatile LASP unsigned*)(unsigned)(TIDW_OFF + 4 * hw_slot_()) = threadIdx.x >> 6;
    __syncthreads();
    XcdBarrier bar = xcd_barrier_post(p.bar, misc);
    run_phase<0>(p, bid, nb, lds); xcd_barrier(bar);
    run_phase<1>(p, bid, nb, lds); xcd_barrier(bar);
    run_phase<2>(p, bid, nb, lds); xcd_barrier(bar);
    run_phase<3>(p, bid, nb, lds); xcd_barrier(bar);
    run_phase<11>(p, bid, nb, lds); xcd_barrier(bar);
    run_phase<4>(p, bid, nb, lds); xcd_barrier(bar);
    run_phase<5>(p, bid, nb, lds); xcd_barrier(bar);
    run_phase<6>(p, bid, nb, lds); xcd_barrier(bar);
    run_phase<7>(p, bid, nb, lds); xcd_barrier(bar);
    run_phase<8>(p, bid, nb, lds); xcd_barrier(bar);
    if (nb != 256) { run_phase<9>(p, bid, nb, lds); xcd_barrier(bar); }
    run_phase<10>(p, bid, nb, lds);
}

extern "C" void kernel_launch(void* const* d_in, const int* in_sizes, int n_in, void* d_out, int out_size, void* d_ws, size_t ws_size, hipStream_t stream) {
    Params p{};
    p.x = (const float*)d_in[0]; p.c = (const float*)d_in[1]; p.pos = (const int*)d_in[2];
    p.w_ada = (const float*)d_in[3]; p.b_ada = (const float*)d_in[4]; p.norm1_g = (const float*)d_in[5]; p.w_in = (const float*)d_in[6];
    p.w_bg = (const float*)d_in[7]; p.b_bg = (const float*)d_in[8]; p.gm_v_g = (const float*)d_in[9]; p.gm_ws = (const float*)d_in[10];
    p.gm_b = (const float*)d_in[11]; p.ret_gn_g = (const float*)d_in[12]; p.w_a_out = (const float*)d_in[13]; p.w_b_out = (const float*)d_in[14];
    p.w_o = (const float*)d_in[15]; p.norm2_g = (const float*)d_in[16]; p.peer_wq = (const float*)d_in[17]; p.peer_sk = (const float*)d_in[18];
    p.peer_u = (const float*)d_in[19]; p.peer_v = (const float*)d_in[20]; p.norm_f_g = (const float*)d_in[21];
    p.out = (float*)d_out;
    char* w = (char*)d_ws; size_t off = 0;
    auto take = [&](size_t bytes) { char* r = w + off; off += (bytes + 255) & ~(size_t)255; return r; };
    p.bar = (unsigned*)take(XCD_BAR_WORDS * 4);
    p.ada = (float*)take(2 * NMOD * 4);
    p.rope = (float*)take((size_t)NTOK * 128 * 4);
    p.eidx = (int*)take((size_t)NTOK * 128 * 4);
    p.gatev = (float*)take((size_t)NTOK * 128 * 4);
    p.Wt1 = (bf16_t*)take((size_t)ZW * DM * 2);
    p.Wta = (bf16_t*)take((size_t)DM * 1024 * 2);
    p.Wtb = (bf16_t*)take((size_t)DM * DM * 2);
    p.Wto = (bf16_t*)take((size_t)DM * DM * 2);
    p.Wtq = (bf16_t*)take((size_t)DM * DM * 2);
    p.hb = (bf16_t*)take((size_t)NTOK * DM * 2);
    p.ZG = (bf16_t*)take((size_t)NTOK * ZW * 2);
    p.qbuf = (float*)p.ZG;
    p.obuf = (float*)take((size_t)NTOK * DM * 4);
    p.ybin = (bf16_t*)take((size_t)NTOK * DM * 2);
    p.yain = (bf16_t*)take((size_t)NTOK * 1024 * 2);
    p.U8 = (unsigned char*)p.ZG + (size_t)NTOK * DM * 4;
    p.V8 = p.U8 + (size_t)16384 * ROW4;
    p.su = (float*)take(16384 * 4); p.sv = (float*)take(16384 * 4);
    p.Qr = (bf16_t*)take((size_t)NTOK * 1024 * 2);
    p.Pm = (bf16_t*)take((size_t)16 * 64 * 4096 * 2);
    p.KTd = (bf16_t*)take((size_t)NTOK * 1024 * 2);
    p.Vt = (bf16_t*)take((size_t)NTOK * 2048 * 2);
    p.ob16 = (bf16_t*)take((size_t)NTOK * DM * 2);
    if (off > ws_size) { fprintf(stderr, "kernel_launch: workspace too small: need %zu have %zu\n", off, ws_size); return; }
    static int grid = 0;
    if (!grid) {
        int dev = 0, cus = 0, per_cu = 0;
        (void)hipGetDevice(&dev); (void)hipDeviceGetAttribute(&cus, hipDeviceAttributeMultiprocessorCount, dev);
        (void)hipFuncSetAttribute((const void*)k_mega, hipFuncAttributeMaxDynamicSharedMemorySize, LDS_BYTES);
        (void)hipOccupancyMaxActiveBlocksPerMultiprocessor(&per_cu, k_mega, NTH, LDS_BYTES);
        (void)per_cu;
        grid = cus;
    }
    (void)hipMemsetAsync(p.bar, 0, XCD_BAR_WORDS * 4, stream);
    hipLaunchKernelGGL(k_mega, dim3(grid), dim3(NTH), LDS_BYTES, stream, p);
    hipError_t e = hipPeekAtLastError();
    if (e != hipSuccess) fprintf(stderr, "launch failed: %s (grid %d)\n", hipGetErrorString(e), grid);
}
```

```cpp
#include <hip/hip_runtime.h>
#include <hip/hip_cooperative_groups.h>
#include <stdint.h>
#include <math.h>
#include <cstdio>

namespace cg = cooperative_groups;

constexpr int DM = 2048;
constexpr int SQ = 4096;
constexpr int NTOK = 8192;
constexpr int NTH = 512;
constexpr int ZW = 12288;
constexpr int NMOD = 12288;
constexpr int LDS_BYTES = 136 * 1024;

typedef unsigned short bf16_t;

struct Params {
    const float *x, *c; const int* pos;
    const float *w_ada, *b_ada, *norm1_g, *w_in, *w_bg, *b_bg, *gm_v_g, *gm_ws, *gm_b, *ret_gn_g, *w_a_out, *w_b_out, *w_o, *norm2_g,
                *peer_wq, *peer_sk, *peer_u, *peer_v, *norm_f_g;
    float* out;
    float *ada, *rope, *gatev; int* eidx;
    bf16_t *Wt1, *Wta, *Wtb, *Wto, *Wtq;
    bf16_t *hb;
    bf16_t *ZG;
    float *obuf;
    bf16_t *ybin, *yain;
    float *qbuf;
    unsigned char *U8, *V8;
    float *su, *sv;
    bf16_t *Qr, *Pm, *KTd, *Vt;
    bf16_t *ob16;
    unsigned *bar;
};

__constant__ float c_freq[64] = {
1.000000000e+00f, 8.659643531e-01f, 7.498942018e-01f, 6.493816376e-01f, 5.623413324e-01f, 4.869675338e-01f, 4.216965139e-01f, 3.651741147e-01f, 3.162277639e-01f, 2.738419771e-01f, 2.371373773e-01f, 2.053525001e-01f, 1.778279394e-01f, 1.539926529e-01f, 1.333521456e-01f, 1.154781953e-01f, 1.000000015e-01f, 8.659642935e-02f, 7.498942316e-02f, 6.493816525e-02f, 5.623413250e-02f, 4.869675264e-02f, 4.216964915e-02f, 3.651741147e-02f, 3.162277490e-02f, 2.738419548e-02f, 2.371373773e-02f, 2.053525113e-02f, 1.778279431e-02f, 1.539926510e-02f, 1.333521400e-02f, 1.154781971e-02f, 9.999999776e-03f, 8.659643121e-03f, 7.498942316e-03f, 6.493816152e-03f, 5.623413250e-03f, 4.869675264e-03f, 4.216964822e-03f, 3.651741194e-03f, 3.162277630e-03f, 2.738419687e-03f, 2.371373819e-03f, 2.053525066e-03f, 1.778279431e-03f, 1.539926510e-03f, 1.333521446e-03f, 1.154782018e-03f, 1.000000047e-03f, 8.659643354e-04f, 7.498941850e-04f, 6.493816036e-04f, 5.623413017e-04f, 4.869675322e-04f, 4.216965172e-04f, 3.651741135e-04f, 3.162277571e-04f, 2.738419571e-04f, 2.371373703e-04f, 2.053525095e-04f, 1.778279402e-04f, 1.539926598e-04f, 1.333521504e-04f, 1.154782003e-04f };

#define LASP __attribute__((address_space(3)))
constexpr int TIDW_OFF = 133 * 1024;
__device__ __forceinline__ int hw_slot_() { return (int)(__builtin_amdgcn_s_getreg((5 << 11) | 4) & 63u); }
__device__ __forceinline__ int lane_hw_() { int l; asm volatile("v_mbcnt_lo_u32_b32 %0, -1, 0\n\tv_mbcnt_hi_u32_b32 %0, -1, %0" : "=v"(l)); return l; }
__device__ __forceinline__ int tid_() {
    const int wv = (int)*(volatile LASP unsigned*)(unsigned)(TIDW_OFF + 4 * hw_slot_());
    int t = __builtin_amdgcn_readfirstlane(wv) * 64 + lane_hw_(); asm volatile("" : "+v"(t)); return t; }
template <int CTRL> __device__ __forceinline__ float dppf(float x) { return __uint_as_float((unsigned)__builtin_amdgcn_update_dpp(0, (int)__float_as_uint(x), CTRL, 0xf, 0xf, true)); }
__device__ __forceinline__ float row_sum16(float v) { v += dppf<0xB1>(v); v += dppf<0x4E>(v); v += dppf<0x141>(v); v += dppf<0x140>(v); return v; }
__device__ __forceinline__ float xsum16(float v) { const auto r = __builtin_amdgcn_permlane16_swap(__float_as_uint(v), __float_as_uint(v), false, false); return __uint_as_float(r[0]) + __uint_as_float(r[1]); }
__device__ __forceinline__ float xsum32(float v) { const auto r = __builtin_amdgcn_permlane32_swap(__float_as_uint(v), __float_as_uint(v), false, false); return __uint_as_float(r[0]) + __uint_as_float(r[1]); }
__device__ __forceinline__ float xmax16(float v) { const auto r = __builtin_amdgcn_permlane16_swap(__float_as_uint(v), __float_as_uint(v), false, false); return fmaxf(__uint_as_float(r[0]), __uint_as_float(r[1])); }
__device__ __forceinline__ float xmax32(float v) { const auto r = __builtin_amdgcn_permlane32_swap(__float_as_uint(v), __float_as_uint(v), false, false); return fmaxf(__uint_as_float(r[0]), __uint_as_float(r[1])); }
__device__ __forceinline__ float wave_sum(float v) { v = row_sum16(v); v += __shfl_xor(v, 16); v += __shfl_xor(v, 32); return v; }
__device__ __forceinline__ float wave_max_b(float v) {
    v = fmaxf(v, dppf<0xB1>(v)); v = fmaxf(v, dppf<0x4E>(v)); v = fmaxf(v, dppf<0x141>(v)); v = fmaxf(v, dppf<0x140>(v));
    v = fmaxf(v, __shfl_xor(v, 16)); v = fmaxf(v, __shfl_xor(v, 32)); return v;
}
__device__ __forceinline__ float wave_max(float v) {
    v = fmaxf(v, dppf<0xB1>(v)); v = fmaxf(v, dppf<0x4E>(v)); v = fmaxf(v, dppf<0x141>(v)); v = fmaxf(v, dppf<0x140>(v));
    return xmax32(xmax16(v));
}
__device__ __forceinline__ float sigmoidf_(float x) { return 1.0f / (1.0f + expf(-x)); }
__device__ __forceinline__ float siluf_(float x) { return x * sigmoidf_(x); }
__device__ __forceinline__ float geluf_(float x) { return 0.5f * x * (1.0f + erff(x * 0.70710678118654752f)); }
__device__ __forceinline__ float dot4(float4 a, float4 b) { return a.x * b.x + a.y * b.y + a.z * b.z + a.w * b.w; }
__device__ __forceinline__ float bf2f(bf16_t v) { return __uint_as_float((unsigned)v << 16); }
__device__ __forceinline__ float bflo(unsigned w) { return __uint_as_float(w << 16); }
__device__ __forceinline__ float bfhi(unsigned w) { return __uint_as_float(w & 0xffff0000u); }
__device__ __forceinline__ unsigned f2bf(float f) { unsigned u = __float_as_uint(f); return (u + 0x7fffu + ((u >> 16) & 1u)) >> 16; }
__device__ __forceinline__ unsigned pk2(float lo, float hi) { return f2bf(lo) | (f2bf(hi) << 16); }

constexpr float W8S = 32.0f;
__device__ __forceinline__ unsigned pk4f8(float a, float b, float c, float d) { int w = __builtin_amdgcn_cvt_pk_fp8_f32(a, b, 0, false); w = __builtin_amdgcn_cvt_pk_fp8_f32(c, d, w, true); return (unsigned)w; }
__device__ __forceinline__ void st_wt4(void* ptr, unsigned v) { __hip_atomic_store((unsigned*)ptr, v, __ATOMIC_RELAXED, __HIP_MEMORY_SCOPE_AGENT); }
__device__ __forceinline__ void st_wt8(void* ptr, uint2 v) { __hip_atomic_store((unsigned long long*)ptr, ((unsigned long long)v.y << 32) | v.x, __ATOMIC_RELAXED, __HIP_MEMORY_SCOPE_AGENT); }
__device__ __forceinline__ void sincos_acc(float ang, float& s, float& c) {
    const double x = (double)ang;
    const double k = rint(x * 0.63661977236758134308);
    double r = fma(-k, 1.57079632679489655800, x); r = fma(-k, 6.12323399573676603587e-17, r);
    const double r2 = r * r;
    const double sp = r * (1.0 + r2 * (-1.0 / 6.0 + r2 * (1.0 / 120.0 + r2 * (-1.0 / 5040.0 + r2 * (1.0 / 362880.0 + r2 * (-1.0 / 39916800.0 + r2 * (1.0 / 6227020800.0)))))));
    const double cp = 1.0 + r2 * (-0.5 + r2 * (1.0 / 24.0 + r2 * (-1.0 / 720.0 + r2 * (1.0 / 40320.0 + r2 * (-1.0 / 3628800.0 + r2 * (1.0 / 479001600.0 + r2 * (-1.0 / 87178291200.0)))))));
    const int q = ((int)k) & 3;
    const float fs = (float)sp, fc = (float)cp;
    s = (q == 0) ? fs : (q == 1) ? fc : (q == 2) ? -fs : -fc;
    c = (q == 0) ? fc : (q == 1) ? -fs : (q == 2) ? -fc : fs;
}

namespace pg8 {
#define PG8_LAS __attribute__((address_space(3)))
typedef unsigned short bf16_t;
typedef short bf16x8 __attribute__((ext_vector_type(8)));
typedef float f32x4 __attribute__((ext_vector_type(4)));
typedef unsigned u32x4 __attribute__((ext_vector_type(4)));
constexpr int BM = 256, BK = 64, HALF = 128, HTB = HALF * BK * 2  , STAGE_BYTES = 8 * HTB, NXCD = 8, WGM = 8;

__host__ __device__ __forceinline__ int lds_byte(int r, int c) { const int st = (r >> 4) * 2 + (c >> 5), rr = r & 15, cc = c & 31, ob = rr * 64 + cc * 2; return st * 1024 + (ob ^ (((ob >> 9) & 1) << 5)); }
__host__ __device__ __forceinline__ void stage_rc(int b, int& R, int& C) { const int st = b / 1024, sb = b % 1024, swz = sb ^ (((sb >> 9) & 1) << 5); R = (st >> 1) * 16 + swz / 64; C = (st & 1) * 32 + (swz % 64) / 2; }
__host__ __device__ __forceinline__ int perm32(int rho) { const int n = rho >> 4, i = rho & 15; return 8 * (i >> 2) + 4 * n + (i & 3); }

struct Unit { int pm, pn; };
struct Gemm { const bf16_t* A; const bf16_t* Bt; int M, N, K; };

struct StaticOrder {
    int nM, nN, nwg, G, c;
    __host__ __device__ void init(int M, int N, int G_, int c_) { nM = M / BM; nN = N / BM; nwg = nM * nN; G = G_; c = c_; }
    __host__ __device__ bool next(int i, Unit& u) const {
        const long L = (long)i * G + c; if (L >= nwg) return false;
        int wgid = (int)L; { const int q = nwg / NXCD, r = nwg % NXCD, xcd = wgid % NXCD, off = wgid / NXCD; wgid = (xcd < r ? xcd * (q + 1) : r * (q + 1) + (xcd - r) * q) + off; }
        const int nig = WGM * nN, gid = wgid / nig, fm = gid * WGM, gsz = (nM - fm) < WGM ? (nM - fm) : WGM;
        u.pm = fm + ((wgid % nig) % gsz); u.pn = (wgid % nig) / gsz; return true;
    }
    __device__ __forceinline__ void a_ready(const Unit&) const {}
    __device__ __forceinline__ void done(const Unit&) const {}
};

__device__ __forceinline__ unsigned cvt_pk_bf16(float lo, float hi) { unsigned r; asm volatile("v_cvt_pk_bf16_f32 %0, %1, %2" : "=v"(r) : "v"(lo), "v"(hi)); return r; }
typedef float f32x2 __attribute__((ext_vector_type(2)));
__device__ __forceinline__ f32x2 gelu_pk(f32x2 v) {
    const f32x2 av = __builtin_elementwise_abs(v), d = av * 0.2316418882f + 1.0f;
    f32x2 t; t.x = __builtin_amdgcn_rcpf(d.x); t.y = __builtin_amdgcn_rcpf(d.y);
    f32x2 q = t * 0.5307027145f + (-0.7265760135f); q = q * t + 0.7107068705f; q = q * t + (-0.142248368f); q = q * t + 0.127414796f; q = q * t;
    const f32x2 s = (v * v) * (-0.72134752044f);
    f32x2 e; e.x = __builtin_amdgcn_exp2f(s.x); e.y = __builtin_amdgcn_exp2f(s.y);
    const f32x2 m = v * (q * e), r = v - m;
    f32x2 o; o.x = v.x < 0.f ? m.x : r.x; o.y = v.y < 0.f ? m.y : r.y; return o;
}

typedef unsigned u32x2v __attribute__((ext_vector_type(2)));
struct EpiZG {
    static constexpr bool PERM = true, AFTER_DRAIN = false;
    bf16_t* O; const float* bias; float osc;
    __device__ __forceinline__ void operator()(const f32x4 (&acc)[2][2][4][2], const Unit& u, int wr, int wc, int fr, int fq) const {
        const int row0 = u.pm * BM + wr * 64 + fr, col0 = u.pn * BM + wc * 32 + 8 * fq;
        const int mode = u.pn < 8 ? 1 : (u.pn < 32 ? 0 : 2);
        f32x4 bv[2][2];
#pragma unroll
        for (int bj = 0; bj < 2; ++bj)
#pragma unroll
            for (int n = 0; n < 2; ++n) bv[bj][n] = (mode == 2) ? *(const f32x4*)(bias + (col0 - 8192) + bj * HALF + 4 * n) : (f32x4){0.f, 0.f, 0.f, 0.f};
#pragma unroll
        for (int ai = 0; ai < 2; ++ai)
#pragma unroll
            for (int m = 0; m < 4; ++m) { bf16_t* rowp = O + (size_t)(row0 + ai * HALF + m * 16) * ZW + col0;
#pragma unroll
                for (int bj = 0; bj < 2; ++bj) { f32x4 v0 = acc[ai][bj][m][0] * osc, v1 = acc[ai][bj][m][1] * osc;
                    if (mode == 1) { f32x2 a = gelu_pk((f32x2){v0[0], v0[1]}), b = gelu_pk((f32x2){v0[2], v0[3]}), c = gelu_pk((f32x2){v1[0], v1[1]}), d = gelu_pk((f32x2){v1[2], v1[3]});
                        v0 = (f32x4){a.x, a.y, b.x, b.y}; v1 = (f32x4){c.x, c.y, d.x, d.y}; }
                    if (mode == 2) { v0 = v0 + bv[bj][0]; v1 = v1 + bv[bj][1];
#pragma unroll
                        for (int e = 0; e < 4; ++e) { v0[e] = __builtin_amdgcn_rcpf(1.0f + __expf(-v0[e])); v1[e] = __builtin_amdgcn_rcpf(1.0f + __expf(-v1[e])); } }
                    u32x4 w; w.x = cvt_pk_bf16(v0[0], v0[1]); w.y = cvt_pk_bf16(v0[2], v0[3]); w.z = cvt_pk_bf16(v1[0], v1[1]); w.w = cvt_pk_bf16(v1[2], v1[3]);
                    *(u32x4*)(rowp + bj * HALF) = w; } }
    }
};
template <int ACCUM> struct EpiMixB {
    static constexpr bool PERM = true, AFTER_DRAIN = false;
    bf16_t* T; unsigned char* Mo; const bf16_t* ZGp; int goff; float osc;
    __device__ __forceinline__ void operator()(const f32x4 (&acc)[2][2][4][2], const Unit& u, int wr, int wc, int fr, int fq) const {
        const int row0 = u.pm * BM + wr * 64 + fr, col0 = u.pn * BM + wc * 32 + 8 * fq;
#pragma unroll
        for (int ai = 0; ai < 2; ++ai)
#pragma unroll
            for (int m = 0; m < 4; ++m) { const size_t row = (size_t)(row0 + ai * HALF + m * 16);
#pragma unroll
                for (int bj = 0; bj < 2; ++bj) { const f32x4 v0 = acc[ai][bj][m][0] * osc, v1 = acc[ai][bj][m][1] * osc;
                    const u32x4 g = *(const u32x4*)(ZGp + row * ZW + 8192 + goff + col0 + bj * HALF);
                    float o[8];
                    o[0] = bflo(g.x) * v0[0]; o[1] = bfhi(g.x) * v0[1]; o[2] = bflo(g.y) * v0[2]; o[3] = bfhi(g.y) * v0[3];
                    o[4] = bflo(g.z) * v1[0]; o[5] = bfhi(g.z) * v1[1]; o[6] = bflo(g.w) * v1[2]; o[7] = bfhi(g.w) * v1[3];
                    bf16_t* tp = T + row * DM + col0 + bj * HALF;
                    if (ACCUM) { const u32x4 old = *(const u32x4*)tp;
                        o[0] += bflo(old.x); o[1] += bfhi(old.x); o[2] += bflo(old.y); o[3] += bfhi(old.y); o[4] += bflo(old.z); o[5] += bfhi(old.z); o[6] += bflo(old.w); o[7] += bfhi(old.w);
                        *(uint2*)(Mo + row * DM + col0 + bj * HALF) = make_uint2(pk4f8(o[0], o[1], o[2], o[3]), pk4f8(o[4], o[5], o[6], o[7]));
                    } else { u32x4 w; w.x = cvt_pk_bf16(o[0], o[1]); w.y = cvt_pk_bf16(o[2], o[3]); w.z = cvt_pk_bf16(o[4], o[5]); w.w = cvt_pk_bf16(o[6], o[7]);
                        *(u32x4*)tp = w; } } }
    }
};
struct EpiResF {
    static constexpr bool PERM = false, AFTER_DRAIN = false;
    float* x1; const float* x; const float* ga; float osc;
    __device__ __forceinline__ void operator()(const f32x4 (&acc)[2][2][4][2], const Unit& u, int wr, int wc, int fr, int fq) const {
        const int row0 = u.pm * BM + wr * 64 + fr, col0 = u.pn * BM + wc * 32 + 4 * fq;
        const int b = (u.pm * BM) / SQ;
        f32x4 gv[2][2];
#pragma unroll
        for (int bj = 0; bj < 2; ++bj)
#pragma unroll
            for (int n = 0; n < 2; ++n) gv[bj][n] = *(const f32x4*)(ga + b * NMOD + col0 + bj * HALF + n * 16) * osc;
#pragma unroll
        for (int ai = 0; ai < 2; ++ai)
#pragma unroll
            for (int m = 0; m < 4; ++m) { const size_t off = (size_t)(row0 + ai * HALF + m * 16) * DM + col0;
#pragma unroll
                for (int bj = 0; bj < 2; ++bj)
#pragma unroll
                    for (int n = 0; n < 2; ++n) { const f32x4 xv = *(const f32x4*)(x + off + bj * HALF + n * 16);
                        *(f32x4*)(x1 + off + bj * HALF + n * 16) = xv + gv[bj][n] * acc[ai][bj][m][n]; } }
    }
};
struct EpiF32 {
    static constexpr bool PERM = false, AFTER_DRAIN = false;
    float* O; int ldc;
    __device__ __forceinline__ void operator()(const f32x4 (&acc)[2][2][4][2], const Unit& u, int wr, int wc, int fr, int fq) const {
        const int row0 = u.pm * BM + wr * 64 + fr, col0 = u.pn * BM + wc * 32 + 4 * fq;
#pragma unroll
        for (int ai = 0; ai < 2; ++ai)
#pragma unroll
            for (int m = 0; m < 4; ++m) { const size_t off = (size_t)(row0 + ai * HALF + m * 16) * ldc + col0;
#pragma unroll
                for (int bj = 0; bj < 2; ++bj)
#pragma unroll
                    for (int n = 0; n < 2; ++n) *(f32x4*)(O + off + bj * HALF + n * 16) = acc[ai][bj][m][n]; }
    }
};

typedef int i32x8 __attribute__((ext_vector_type(8)));
typedef int i32x4 __attribute__((ext_vector_type(4)));
__device__ __forceinline__ void mfma_f8(f32x4& acc, i32x8 a, i32x8 b) { asm volatile("v_mfma_f32_16x16x128_f8f6f4 %0, %1, %2, %0" : "+v"(acc) : "v"(a), "v"(b)); }
__device__ __forceinline__ i32x8 cat8(bf16x8 a, bf16x8 b) { return __builtin_shufflevector(__builtin_bit_cast(i32x4, a), __builtin_bit_cast(i32x4, b), 0, 1, 2, 3, 4, 5, 6, 7); }
template <class Epi, class Sched, bool ALIGN_EPI = false, bool SP2 = false, bool F8 = false>
__device__ __forceinline__ void gemm_phase(PG8_LAS unsigned char* lds, const Gemm g, const Sched& S, const Epi& E) {
    const int tid = tid_(), wid = __builtin_amdgcn_readfirstlane(tid >> 6), lane = tid & 63, wr = wid >> 2, wc = wid & 3, fr = lane & 15, fq = lane >> 4;
    const int K = g.K, nt = K / BK;
    unsigned voffA[2], voffB[2];
#pragma unroll
    for (int i = 0; i < 2; ++i) { int R, C; stage_rc(tid * 16 + i * 8192, R, C); const int Rb = Epi::PERM ? ((R & ~31) + perm32(R & 31)) : R;
        voffA[i] = (unsigned)(R * K + C) * 2u; voffB[i] = (unsigned)(Rb * K + C) * 2u; }
    const size_t kstep = (size_t)(BK * 2);
    const size_t hstep = (size_t)HALF * K * 2;
    const size_t tstep = 2 * hstep;
    const unsigned ldsw = (unsigned)wid * 1024u;
    const int aoff = lds_byte(wr * 64 + fr, fq * 8), boff = lds_byte(wc * 32 + fr, fq * 8);
#define PG8_SA(b, h) (((b) * 2 + (h)) * HTB)
#define PG8_SB(b, h) ((4 + (b) * 2 + (h)) * HTB)
#define PG8_STAGE(bufoff, gbase, voff) do { _Pragma("unroll") for (int _i = 0; _i < 2; ++_i) \
        __builtin_amdgcn_global_load_lds((const unsigned*)((const char*)(gbase) + (voff)[_i]), (PG8_LAS unsigned*)(lds + (bufoff) + ldsw + _i * 8192), 16, 0, 0); } while (0)
#define PG8_LDA(dst, b, h) do { _Pragma("unroll") for (int m = 0; m < 4; ++m) _Pragma("unroll") for (int k = 0; k < 2; ++k) dst[m][k] = *(const PG8_LAS bf16x8*)(lds + PG8_SA(b, h) + aoff + m * 2048 + k * 1024); } while (0)
#define PG8_LDB(dst, b, h) do { _Pragma("unroll") for (int n = 0; n < 2; ++n) _Pragma("unroll") for (int k = 0; k < 2; ++k) dst[n][k] = *(const PG8_LAS bf16x8*)(lds + PG8_SB(b, h) + boff + n * 2048 + k * 1024); } while (0)
#define PG8_MMA(ai, bj, At, Bt) do { __builtin_amdgcn_s_setprio(1); _Pragma("unroll") for (int m = 0; m < 4; ++m) _Pragma("unroll") for (int n = 0; n < 2; ++n) { \
        if constexpr (F8) mfma_f8(acc[ai][bj][m][n], cat8(Bt[n][0], Bt[n][1]), cat8(At[m][0], At[m][1])); \
        else { _Pragma("unroll") for (int k = 0; k < 2; ++k) acc[ai][bj][m][n] = __builtin_amdgcn_mfma_f32_16x16x32_bf16(Bt[n][k], At[m][k], acc[ai][bj][m][n], 0, 0, 0); } } __builtin_amdgcn_s_setprio(0); } while (0)
#define PG8_WAIT_V(n) asm volatile("s_waitcnt vmcnt(" #n ")" ::: "memory")
#define PG8_WAIT_L(n) asm volatile("s_waitcnt lgkmcnt(" #n ")" ::: "memory")
#define PG8_BAR __builtin_amdgcn_s_barrier()
#define PG8_SCHED __builtin_amdgcn_sched_barrier(0)
    Unit cur, nxt; int ui = 0;
    if (!S.next(0, cur)) return;
    f32x4 acc[2][2][4][2];
#pragma unroll
    for (int a = 0; a < 2; ++a)
#pragma unroll
        for (int b = 0; b < 2; ++b)
#pragma unroll
            for (int m = 0; m < 4; ++m)
#pragma unroll
                for (int n = 0; n < 2; ++n) acc[a][b][m][n] = (f32x4){0.f, 0.f, 0.f, 0.f};
    bf16x8 At[4][2], B0[2][2], B1[2][2];
    const char* cA = (const char*)g.A + (size_t)cur.pm * tstep; const char* cB = (const char*)g.Bt + (size_t)cur.pn * tstep;
    S.a_ready(cur);
    if constexpr (SP2) {
        PG8_STAGE(PG8_SB(0, 0), cB, voffB); PG8_STAGE(PG8_SB(0, 1), cB + hstep, voffB); PG8_STAGE(PG8_SA(0, 0), cA, voffA); PG8_STAGE(PG8_SA(0, 1), cA + hstep, voffA);
        if (wr == 1) PG8_BAR;
        PG8_WAIT_V(2); PG8_BAR;
        PG8_STAGE(PG8_SB(1, 0), cB + kstep, voffB); PG8_STAGE(PG8_SA(1, 0), cA + kstep, voffA); PG8_STAGE(PG8_SB(1, 1), cB + hstep + kstep, voffB);
        PG8_WAIT_V(6); PG8_BAR;
    } else {
        PG8_STAGE(PG8_SB(0, 0), cB, voffB); PG8_STAGE(PG8_SA(0, 0), cA, voffA); PG8_STAGE(PG8_SB(0, 1), cB + hstep, voffB); PG8_STAGE(PG8_SA(0, 1), cA + hstep, voffA);
        if (wr == 1) PG8_BAR;
        PG8_WAIT_V(4); PG8_BAR;
        PG8_STAGE(PG8_SB(1, 0), cB + kstep, voffB); PG8_STAGE(PG8_SA(1, 0), cA + kstep, voffA); PG8_STAGE(PG8_SB(1, 1), cB + hstep + kstep, voffB);
        PG8_WAIT_V(6); PG8_BAR;
    }
    for (;;) {
        const bool has_next = S.next(ui + 1, nxt);
        const char* nA = has_next ? (const char*)g.A + (size_t)nxt.pm * tstep : cA; const char* nB = has_next ? (const char*)g.Bt + (size_t)nxt.pn * tstep : cB;
        for (int t = 0; t < nt; t += 2) {
            const bool last = (t == nt - 2);
            const char* a1 = cA + (size_t)(t + 1) * kstep;
            const char* a2 = last ? nA : cA + (size_t)(t + 2) * kstep; const char* b2 = last ? nB : cB + (size_t)(t + 2) * kstep;
            const char* a3 = a2 + kstep; const char* b3 = b2 + kstep;
            if (last && has_next) S.a_ready(nxt);
            if constexpr (SP2) {
            PG8_LDB(B0, 0, 0); PG8_LDB(B1, 0, 1); PG8_SCHED; PG8_LDA(At, 0, 0); PG8_STAGE(PG8_SA(1, 1), a1 + hstep, voffA);
            PG8_WAIT_V(8); PG8_WAIT_L(0); PG8_BAR; PG8_MMA(0, 0, At, B0); PG8_MMA(0, 1, At, B1); PG8_BAR; PG8_SCHED;
            PG8_LDA(At, 0, 1); PG8_STAGE(PG8_SB(0, 0), b2, voffB); PG8_STAGE(PG8_SB(0, 1), b2 + hstep, voffB); PG8_STAGE(PG8_SA(0, 0), a2, voffA);
            PG8_WAIT_V(8); PG8_WAIT_L(0); PG8_BAR; PG8_MMA(1, 0, At, B0); PG8_MMA(1, 1, At, B1); PG8_BAR; PG8_SCHED;
            PG8_LDB(B0, 1, 0); PG8_LDB(B1, 1, 1); PG8_SCHED; PG8_LDA(At, 1, 0); PG8_STAGE(PG8_SA(0, 1), a2 + hstep, voffA);
            PG8_WAIT_V(8); PG8_WAIT_L(0); PG8_BAR; PG8_MMA(0, 0, At, B0); PG8_MMA(0, 1, At, B1); PG8_BAR; PG8_SCHED;
            PG8_LDA(At, 1, 1); PG8_STAGE(PG8_SB(1, 0), b3, voffB); PG8_STAGE(PG8_SB(1, 1), b3 + hstep, voffB); PG8_STAGE(PG8_SA(1, 0), a3, voffA);
            PG8_WAIT_V(8); PG8_WAIT_L(0); PG8_BAR; PG8_MMA(1, 0, At, B0); PG8_MMA(1, 1, At, B1); PG8_BAR; PG8_SCHED;
            } else {
            PG8_LDB(B0, 0, 0); PG8_SCHED; PG8_LDA(At, 0, 0); PG8_STAGE(PG8_SA(1, 1), a1 + hstep, voffA);
            PG8_WAIT_L(8); PG8_BAR; PG8_WAIT_L(0); PG8_MMA(0, 0, At, B0); PG8_BAR; PG8_SCHED;
            PG8_LDB(B1, 0, 1); PG8_STAGE(PG8_SB(0, 0), b2, voffB);
            PG8_BAR; PG8_WAIT_L(0); PG8_MMA(0, 1, At, B1); PG8_BAR;
            PG8_LDA(At, 0, 1); PG8_STAGE(PG8_SA(0, 0), a2, voffA);
            PG8_BAR; PG8_WAIT_L(0); PG8_MMA(1, 0, At, B0); PG8_BAR; PG8_SCHED;
            PG8_STAGE(PG8_SB(0, 1), b2 + hstep, voffB);
            PG8_WAIT_V(6); PG8_BAR; PG8_MMA(1, 1, At, B1); PG8_BAR;
            PG8_LDB(B0, 1, 0); PG8_SCHED; PG8_LDA(At, 1, 0); PG8_STAGE(PG8_SA(0, 1), a2 + hstep, voffA);
            PG8_WAIT_L(8); PG8_BAR; PG8_WAIT_L(0); PG8_MMA(0, 0, At, B0); PG8_BAR; PG8_SCHED;
            PG8_LDB(B1, 1, 1); PG8_STAGE(PG8_SB(1, 0), b3, voffB);
            PG8_BAR; PG8_WAIT_L(0); PG8_MMA(0, 1, At, B1); PG8_BAR;
            PG8_LDA(At, 1, 1); PG8_STAGE(PG8_SA(1, 0), a3, voffA);
            PG8_BAR; PG8_WAIT_L(0); PG8_MMA(1, 0, At, B0); PG8_BAR; PG8_SCHED;
            PG8_STAGE(PG8_SB(1, 1), b3 + hstep, voffB);
            PG8_WAIT_V(6); PG8_BAR; PG8_MMA(1, 1, At, B1); PG8_BAR;
            }
        }
        if constexpr (F8) asm volatile("s_nop 15\n\ts_nop 15\n\ts_nop 15\n\ts_nop 15" ::: "memory");
        if constexpr (ALIGN_EPI) { if (wr == 0) PG8_BAR; }
        if constexpr (!Epi::AFTER_DRAIN) { const int le = lane_hw_(); E(acc, cur, wr, wc, le & 15, le >> 4); S.done(cur); }
        if (!has_next) break;
#pragma unroll
        for (int a = 0; a < 2; ++a)
#pragma unroll
            for (int b = 0; b < 2; ++b)
#pragma unroll
                for (int m = 0; m < 4; ++m)
#pragma unroll
                    for (int n = 0; n < 2; ++n) acc[a][b][m][n] = (f32x4){0.f, 0.f, 0.f, 0.f};
        cur = nxt; cA = nA; cB = nB; ++ui;
        if constexpr (ALIGN_EPI) { if (wr == 1) PG8_BAR; }
    }
    PG8_WAIT_V(0);
    if constexpr (!ALIGN_EPI) { if (wr == 0) PG8_BAR; }
    PG8_BAR;
    if constexpr (Epi::AFTER_DRAIN) { E.fused(acc, cur, wr, wc, fr, fq, lds, wid, lane); S.done(cur); }
#undef PG8_SA
#undef PG8_SB
#undef PG8_STAGE
#undef PG8_LDA
#undef PG8_LDB
#undef PG8_MMA
#undef PG8_WAIT_V
#undef PG8_WAIT_L
#undef PG8_BAR
#undef PG8_SCHED
}
}
using pg8::f32x4; using pg8::u32x4;

template <bool F8 = false>
__device__ __forceinline__ void transpose_item(const float* W, int K, int N, bf16_t* WT, int row_off, float* scr, int item, int lane) {
    const int nblk = N / 32, kb = item / nblk, nbk = item % nblk, k0 = 64 * kb, n0 = 32 * nbk;
    {
        const int r = lane >> 3, c4 = (lane & 7) * 4;
        float4 t[8];
#pragma unroll
        for (int i = 0; i < 8; ++i) t[i] = *(const float4*)(W + (size_t)(k0 + 8 * i + r) * N + n0 + c4);
#pragma unroll
        for (int i = 0; i < 8; ++i) { float* d = scr + (8 * i + r) * 33 + c4; d[0] = t[i].x; d[1] = t[i].y; d[2] = t[i].z; d[3] = t[i].w; }
    }
    asm volatile("s_waitcnt lgkmcnt(0)" ::: "memory");
    const int c = lane & 7;
#pragma unroll
    for (int j = 0; j < 4; ++j) { const int n = (lane >> 3) + 8 * j; const float* s = scr + (8 * c) * 33 + n;
        if constexpr (F8) { *(uint2*)((unsigned char*)WT + (size_t)(row_off + n0 + n) * K + k0 + 8 * c) =
                make_uint2(pk4f8(s[0 * 33] * W8S, s[1 * 33] * W8S, s[2 * 33] * W8S, s[3 * 33] * W8S), pk4f8(s[4 * 33] * W8S, s[5 * 33] * W8S, s[6 * 33] * W8S, s[7 * 33] * W8S)); }
        else { uint4 o; o.x = pk2(s[0 * 33], s[1 * 33]); o.y = pk2(s[2 * 33], s[3 * 33]); o.z = pk2(s[4 * 33], s[5 * 33]); o.w = pk2(s[6 * 33], s[7 * 33]);
            *(uint4*)(WT + (size_t)(row_off + n0 + n) * K + k0 + 8 * c) = o; } }
    asm volatile("s_waitcnt lgkmcnt(0)" ::: "memory");
}
__device__ __forceinline__ void ph_prep(const Params& p, int bid, int nb, float* lds) {
    const int tid = tid_(), wave = tid >> 6, lane = tid & 63;
    {
        float* sl = lds;
        float* red = lds + 4096;
        for (int i = tid; i < 4096; i += NTH) sl[i] = siluf_(p.c[i]);
        __syncthreads();
        for (int it = bid; it < 192; it += nb) {
            const int c4 = tid & 15, kg = tid >> 4;
            const float* wp = p.w_ada + (size_t)kg * NMOD + it * 64 + c4 * 4;
            float a0[4] = {0.f, 0.f, 0.f, 0.f}, a1[4] = {0.f, 0.f, 0.f, 0.f};
#pragma unroll 8
            for (int i = 0; i < 64; ++i) {
                const int k = kg + 32 * i;
                const float4 w = *(const float4*)(wp + (size_t)(32 * i) * NMOD);
                const float s0 = sl[k], s1 = sl[2048 + k];
                a0[0] += s0 * w.x; a0[1] += s0 * w.y; a0[2] += s0 * w.z; a0[3] += s0 * w.w;
                a1[0] += s1 * w.x; a1[1] += s1 * w.y; a1[2] += s1 * w.z; a1[3] += s1 * w.w;
            }
            __syncthreads();
#pragma unroll
            for (int e = 0; e < 4; ++e) { red[(kg * 16 + c4) * 8 + e] = a0[e]; red[(kg * 16 + c4) * 8 + 4 + e] = a1[e]; }
            __syncthreads();
            if (tid < 128) {
                const int b = tid >> 6, col = tid & 63;
                float s = 0.f;
                for (int g = 0; g < 32; ++g) s += red[(g * 16 + (col >> 2)) * 8 + b * 4 + (col & 3)];
                p.ada[b * NMOD + it * 64 + col] = s + p.b_ada[it * 64 + col];
            }
        }
        __syncthreads();
    }
    for (int e = bid * NTH + tid; e < NTOK * 64; e += nb * NTH) {
        const int tok = e >> 6, j = e & 63;
        const float ang = (float)p.pos[tok] * c_freq[j];
        float s, c; sincos_acc(ang, s, c);
        p.rope[(size_t)e * 2] = c; p.rope[(size_t)e * 2 + 1] = s;
    }
    {
        float* scr = lds + wave * (64 * 33);
        const int gw = bid * 8 + wave, ngw = nb * 8;
        constexpr int I1 = 32 * 256, I2 = 32 * 128, I3 = 16 * 64, I4 = 32 * 64;
        constexpr int NIT = I1 + I2 + I3 + 3 * I4;
        for (int it = gw; it < NIT; it += ngw) {
            int r = it;
            if (r < I1) { transpose_item<true>(p.w_in, 2048, 8192, p.Wt1, 0, scr, r, lane); continue; } r -= I1;
            if (r < I2) { transpose_item<true>(p.w_bg, 2048, 4096, p.Wt1, 8192, scr, r, lane); continue; } r -= I2;
            if (r < I3) { transpose_item<true>(p.w_a_out, 1024, 2048, p.Wta, 0, scr, r, lane); continue; } r -= I3;
            if (r < I4) { transpose_item<true>(p.w_b_out, 2048, 2048, p.Wtb, 0, scr, r, lane); continue; } r -= I4;
            if (r < I4) { transpose_item<true>(p.w_o, 2048, 2048, p.Wto, 0, scr, r, lane); continue; } r -= I4;
            transpose_item(p.peer_wq, 2048, 2048, p.Wtq, 0, scr, r, lane);
        }
    }
    __syncthreads();
}
constexpr int ROW6 = 1536;
typedef float f32x32_t __attribute__((ext_vector_type(32)));
typedef unsigned u32x6_t __attribute__((ext_vector_type(6)));
__device__ __forceinline__ void tc_load(const Params& p, int r, int lane, float4 (&t)[8]) {
    const bool second = r >= 16384; const int row = second ? r - 16384 : r;
    const float* src = (const float*)((const char*)p.peer_u + (second ? ((const char*)p.peer_v - (const char*)p.peer_u) : (ptrdiff_t)0)) + (size_t)row * DM + (second ? lane * 4 : (lane >> 2) * 128 + (lane & 3) * 8);
#pragma unroll
    for (int q = 0; q < 8; ++q) t[q] = *(const float4*)(src + (second ? 256 * q : (q >> 1) * 32 + (q & 1) * 4));
}
constexpr int ROW4 = 1024;
__device__ __forceinline__ void tc_finish(const Params& p, int r, int lane, const float4 (&t)[8]) {
    const bool second = r >= 16384; const int row = second ? r - 16384 : r;
    float am = 0.f;
#pragma unroll
    for (int q = 0; q < 8; ++q) am = fmaxf(am, fmaxf(fmaxf(fabsf(t[q].x), fabsf(t[q].y)), fmaxf(fabsf(t[q].z), fabsf(t[q].w))));
    am = wave_max_b(am);
    {
        const float sc = (am > 0.f) ? am * (1.0f / 6.0f) : 1.0f, inv = (am > 0.f) ? 6.0f / am : 1.0f;
        unsigned w0 = 0u, w1 = 0u, w2 = 0u, w3 = 0u;
#define TC_PK(W_, qa_, qb_) do { \
        W_ = __builtin_amdgcn_cvt_scalef32_pk_fp4_f32(W_, t[qa_].x * inv, t[qa_].y * inv, 1.0f, 0); W_ = __builtin_amdgcn_cvt_scalef32_pk_fp4_f32(W_, t[qa_].z * inv, t[qa_].w * inv, 1.0f, 1); \
        W_ = __builtin_amdgcn_cvt_scalef32_pk_fp4_f32(W_, t[qb_].x * inv, t[qb_].y * inv, 1.0f, 2); W_ = __builtin_amdgcn_cvt_scalef32_pk_fp4_f32(W_, t[qb_].z * inv, t[qb_].w * inv, 1.0f, 3); } while (0)
        TC_PK(w0, 0, 1); TC_PK(w1, 2, 3); TC_PK(w2, 4, 5); TC_PK(w3, 6, 7);
#undef TC_PK
        *(uint4*)(p.U8 + (size_t)r * ROW4 + lane * 16) = make_uint4(w0, w1, w2, w3);
        if (lane == 0) p.su[r] = sc;
    }
}
__device__ __forceinline__ void ph_tabconv(const Params& p, int bid, int nb) {
    const int tid = tid_(), wave = tid >> 6, lane = tid & 63;
    for (int r = bid * 8 + wave; r < 2 * 16384; r += nb * 8) { float4 t[8]; tc_load(p, r, lane, t); tc_finish(p, r, lane, t); }
}

__device__ __forceinline__ void mn_load(const float* xin, int row, int lane, float4 (&v)[8]) {
#pragma unroll
    for (int j = 0; j < 8; ++j) v[j] = ((const float4*)(xin + (size_t)row * DM))[lane + 64 * j];
}
template <bool F8>
__device__ __forceinline__ void mn_row(const Params& p, const float* g, int sh_off, int sc_off, bf16_t* hout, int row, int lane, const float4 (&v)[8]) {
    const int b = row / SQ;
    float ss = 0.f;
#pragma unroll
    for (int j = 0; j < 8; ++j) ss += dot4(v[j], v[j]);
    ss = wave_sum(ss);
    const float rs = 1.0f / sqrtf(ss * (1.0f / DM) + 1e-6f);
#pragma unroll
    for (int j = 0; j < 8; ++j) {
        const int col = (lane + 64 * j) * 4;
        const float4 g4 = *(const float4*)(g + col);
        const float4 sc = *(const float4*)(p.ada + b * NMOD + sc_off + col);
        const float4 sh = *(const float4*)(p.ada + b * NMOD + sh_off + col);
        float4 o;
        o.x = v[j].x * rs * g4.x * (1.0f + sc.x) + sh.x; o.y = v[j].y * rs * g4.y * (1.0f + sc.y) + sh.y;
        o.z = v[j].z * rs * g4.z * (1.0f + sc.z) + sh.z; o.w = v[j].w * rs * g4.w * (1.0f + sc.w) + sh.w;
        if constexpr (F8) st_wt4((unsigned char*)hout + (size_t)row * DM + col, pk4f8(o.x, o.y, o.z, o.w));
        else st_wt8(hout + (size_t)row * DM + col, make_uint2(pk2(o.x, o.y), pk2(o.z, o.w)));
    }
}
template <bool F8>
__device__ __forceinline__ void ph_modnorm(const Params& p, const float* xin, const float* g, int sh_off, int sc_off, bf16_t* hout, int bid, int nb, float* lds) {
    const int tid = tid_(), wave = tid >> 6, lane = tid & 63;
    const int stride = nb * 8;
    float4 va[8], vb[8], vc[8];
    int row = bid * 8 + wave;
    if (row < NTOK) mn_load(xin, row, lane, va);
    if (row + stride < NTOK) mn_load(xin, row + stride, lane, vb);
    for (; row < NTOK; row += 3 * stride) {
        if (row + 2 * stride < NTOK) mn_load(xin, row + 2 * stride, lane, vc);
        mn_row<F8>(p, g, sh_off, sc_off, hout, row, lane, va);
        if (row + stride >= NTOK) break;
        if (row + 3 * stride < NTOK) mn_load(xin, row + 3 * stride, lane, va);
        mn_row<F8>(p, g, sh_off, sc_off, hout, row + stride, lane, vb);
        if (row + 2 * stride >= NTOK) break;
        if (row + 4 * stride < NTOK) mn_load(xin, row + 4 * stride, lane, vb);
        mn_row<F8>(p, g, sh_off, sc_off, hout, row + 2 * stride, lane, vc);
    }
}

typedef short bf16x8_t __attribute__((ext_vector_type(8)));
typedef float f32x4_t __attribute__((ext_vector_type(4)));
__device__ __forceinline__ bf16x8_t ldfrag(const char* base, int row, int chunk, int rb, int sm) { return *(const bf16x8_t*)(base + row * rb + ((chunk ^ (row & sm)) << 4)); }
__device__ __forceinline__ void ph_gmlp2(const Params& p, int bid, int nb, float* lds) {
    char* WM = (char*)lds; char* VT = WM + 32768;
    const int tid = tid_(), wave = tid >> 6, lane = tid & 63, fr = lane & 15, fq = lane >> 4;
    int gl = -1;
    for (int it = bid; it < 512; it += nb) {
        const int g = it & 7, n = (it >> 3) & 31, b = it >> 8;
        const int tok0 = b * SQ + n * 128;
        __syncthreads();
        if (g != gl) {
            for (int u = tid; u < 2048; u += NTH) {
                const int i = u >> 4, c = u & 15;
                const float4* src = (const float4*)(p.gm_ws + (size_t)g * 16384 + i * 128 + c * 8);
                float4 a = src[0], b4 = src[1];
                if ((i >> 6) < (c >> 3)) { a = make_float4(0.f, 0.f, 0.f, 0.f); b4 = a; }
                *(uint4*)(WM + i * 256 + ((c ^ (i & 15)) << 4)) = make_uint4(pk2(a.x, a.y), pk2(a.z, a.w), pk2(b4.x, b4.y), pk2(b4.z, b4.w));
            }
            gl = g;
        }
        {
            const float2 gn = *(const float2*)(p.gm_v_g + g * 128 + lane * 2);
#pragma unroll 4
            for (int jj = 0; jj < 16; ++jj) {
                const int j = wave * 16 + jj;
                const unsigned w = *(const unsigned*)(p.ZG + (size_t)(tok0 + j) * ZW + 1024 + g * 128 + lane * 2);
                const float a = bflo(w), c2 = bfhi(w);
                const float ss = wave_sum(a * a + c2 * c2);
                const float rs = 1.0f / sqrtf(ss * (1.0f / 128.0f) + 1e-6f);
                const int d0 = lane * 2, d1 = d0 + 1;
                *(bf16_t*)(VT + d0 * 256 + (((j >> 3) ^ (d0 & 15)) << 4) + (j & 7) * 2) = (bf16_t)f2bf(a * rs * gn.x);
                *(bf16_t*)(VT + d1 * 256 + (((j >> 3) ^ (d1 & 15)) << 4) + (j & 7) * 2) = (bf16_t)f2bf(c2 * rs * gn.y);
            }
        }
        __syncthreads();
        {
            bf16x8_t A[4];
#pragma unroll
            for (int ks = 0; ks < 4; ++ks) A[ks] = ldfrag(VT, wave * 16 + fr, ks * 4 + fq, 256, 15);
            const int d0 = wave * 16 + fq * 4;
#pragma unroll
            for (int itl = 0; itl < 8; ++itl) {
                f32x4_t acc = {0.f, 0.f, 0.f, 0.f};
#pragma unroll
                for (int ks = 0; ks < 4; ++ks) if (itl >= 4 || ks < 2) acc = __builtin_amdgcn_mfma_f32_16x16x32_bf16(A[ks], ldfrag(WM, itl * 16 + fr, ks * 4 + fq, 256, 15), acc, 0, 0, 0);
                const int i = itl * 16 + fr;
                const float bias = p.gm_b[g * 128 + i];
                const size_t tok = (size_t)(tok0 + i);
                const uint2 uw = *(const uint2*)(p.ZG + tok * ZW + g * 128 + d0);
                *(unsigned*)((unsigned char*)p.yain + tok * 1024 + g * 128 + d0) = pk4f8(bflo(uw.x) * (acc[0] + bias), bfhi(uw.x) * (acc[1] + bias), bflo(uw.y) * (acc[2] + bias), bfhi(uw.y) * (acc[3] + bias));
            }
        }
    }
    __syncthreads();
}

__device__ __forceinline__ void ph_ret(const Params& p, int bid, int nb, float* lds) {
    float* Qs = lds;
    float* Ks = Qs + 64 * 129;
    float* Vs = Ks + 64 * 129;
    float* Ss = Vs + 64 * 16;
    float* At = Ss + 128 * 16;
    float* kd = At + 64 * 65;
    const int tid = tid_();
    const bf16_t* z = p.ZG;
    for (int it = bid; it < 256; it += nb) {
        const int vs = it & 15, h = (it >> 4) & 7, b = it >> 7;
        const float lg = log1pf(-exp2f(-5.0f - (float)h));
        const float cdec = expf(lg * 64.0f);
        __syncthreads();
        for (int i = tid; i < 2048; i += NTH) Ss[i] = 0.f;
        if (tid < 64) kd[tid] = expf(lg * (float)(63 - tid));
        for (int n = 0; n < 64; ++n) {
            const int tok0 = b * SQ + n * 64;
            __syncthreads();
            for (int e = tid; e < 4096; e += NTH) {
                const int i = e >> 6, dd = e & 63; const size_t tok = (size_t)(tok0 + i);
                const float cs = p.rope[(tok * 64 + dd) * 2], sn = p.rope[(tok * 64 + dd) * 2 + 1];
                const bf16_t* zr = z + tok * ZW;
                const float q1 = bf2f(zr[2048 + h * 128 + dd]), q2 = bf2f(zr[2048 + h * 128 + 64 + dd]);
                const float k1 = bf2f(zr[3072 + h * 128 + dd]), k2 = bf2f(zr[3072 + h * 128 + 64 + dd]);
                Qs[i * 129 + dd] = q1 * cs - q2 * sn; Qs[i * 129 + 64 + dd] = q1 * sn + q2 * cs;
                const float sc = 0.08838834764831845f;
                Ks[i * 129 + dd] = (k1 * cs - k2 * sn) * sc; Ks[i * 129 + 64 + dd] = (k1 * sn + k2 * cs) * sc;
            }
            for (int e = tid; e < 1024; e += NTH) { const int j = e >> 4, v = e & 15; Vs[e] = bf2f(z[(size_t)(tok0 + j) * ZW + 4096 + h * 256 + vs * 16 + v]); }
            __syncthreads();
            {
                const int j = tid & 63, i0 = (tid >> 6) * 8;
                float acc[8];
#pragma unroll
                for (int ii = 0; ii < 8; ++ii) acc[ii] = 0.f;
                for (int d = 0; d < 128; ++d) {
                    const float kv = Ks[j * 129 + d];
#pragma unroll
                    for (int ii = 0; ii < 8; ++ii) acc[ii] += Qs[(i0 + ii) * 129 + d] * kv;
                }
#pragma unroll
                for (int ii = 0; ii < 8; ++ii) { const int i = i0 + ii; At[i * 65 + j] = acc[ii] * expf(lg * fabsf((float)(i - j))); }
            }
            __syncthreads();
            {
                const int v = tid & 15, i0 = tid >> 4;
#pragma unroll
                for (int rep = 0; rep < 2; ++rep) {
                    const int i = i0 + 32 * rep;
                    float a = 0.f; for (int j = 0; j < 64; ++j) a += At[i * 65 + j] * Vs[j * 16 + v];
                    float c2 = 0.f; for (int d = 0; d < 128; ++d) c2 += Qs[i * 129 + d] * Ss[d * 16 + v];
                    p.obuf[(size_t)(tok0 + i) * DM + h * 256 + vs * 16 + v] = a + c2 * expf(lg * (float)(i + 1));
                }
            }
            __syncthreads();
            {
                const int v = tid & 15, d0 = tid >> 4;
#pragma unroll
                for (int rep = 0; rep < 4; ++rep) {
                    const int d = d0 + 32 * rep;
                    float a = 0.f; for (int j = 0; j < 64; ++j) a += Ks[j * 129 + d] * kd[j] * Vs[j * 16 + v];
                    Ss[d * 16 + v] = Ss[d * 16 + v] * cdec + a;
                }
            }
        }
    }
    __syncthreads();
}


__device__ __forceinline__ void ph_retprep(const Params& p, int bid, int nb, float* lds) {
    bf16_t* Kl = (bf16_t*)lds;
    bf16_t* Vl = Kl + 64 * 130;
    char* Qm = (char*)lds + 49664;
    char* Km = Qm + 16384;
    const int tid = tid_(), wave = tid >> 6, lane = tid & 63, fr = lane & 15, fq = lane >> 4;
    for (int it = bid; it < 1024; it += nb) {
        const int n = it & 63, h = (it >> 6) & 7, b = it >> 9;
        const int tok0 = b * SQ + n * 64;
        const size_t rowbase = (size_t)(b * 8 + h) * SQ + n * 64;
        const float lg = log1pf(-exp2f(-5.0f - (float)h));
        __syncthreads();
#pragma unroll
        for (int k = 0; k < 2; ++k) {
            const int u = tid + 512 * k, i = u >> 4, dd = (u & 15) * 4; const size_t tok = (size_t)(tok0 + i);
            const float4 r0 = *(const float4*)(p.rope + (tok * 64 + dd) * 2), r1 = *(const float4*)(p.rope + (tok * 64 + dd) * 2 + 4);
            const float cs[4] = {r0.x, r0.z, r1.x, r1.z}, sn[4] = {r0.y, r0.w, r1.y, r1.w};
            const bf16_t* zr = p.ZG + tok * ZW;
            const uint2 q1w = *(const uint2*)(zr + 2048 + h * 128 + dd), q2w = *(const uint2*)(zr + 2048 + h * 128 + 64 + dd);
            const uint2 k1w = *(const uint2*)(zr + 3072 + h * 128 + dd), k2w = *(const uint2*)(zr + 3072 + h * 128 + 64 + dd);
            const float q1[4] = {bflo(q1w.x), bfhi(q1w.x), bflo(q1w.y), bfhi(q1w.y)}, q2[4] = {bflo(q2w.x), bfhi(q2w.x), bflo(q2w.y), bfhi(q2w.y)};
            const float k1[4] = {bflo(k1w.x), bfhi(k1w.x), bflo(k1w.y), bfhi(k1w.y)}, k2[4] = {bflo(k2w.x), bfhi(k2w.x), bflo(k2w.y), bfhi(k2w.y)};
            const float sc = 0.08838834764831845f, kd = expf(lg * (float)(63 - i));
            float qa[4], qb[4], ka[4], kb[4];
#pragma unroll
            for (int e = 0; e < 4; ++e) { qa[e] = q1[e] * cs[e] - q2[e] * sn[e]; qb[e] = q1[e] * sn[e] + q2[e] * cs[e]; ka[e] = (k1[e] * cs[e] - k2[e] * sn[e]) * sc; kb[e] = (k1[e] * sn[e] + k2[e] * cs[e]) * sc; }
            const uint2 qaw = make_uint2(pk2(qa[0], qa[1]), pk2(qa[2], qa[3])), qbw = make_uint2(pk2(qb[0], qb[1]), pk2(qb[2], qb[3]));
            const uint2 kaw = make_uint2(pk2(ka[0], ka[1]), pk2(ka[2], ka[3])), kbw = make_uint2(pk2(kb[0], kb[1]), pk2(kb[2], kb[3]));
            *(uint2*)(p.Qr + (rowbase + i) * 128 + dd) = qaw; *(uint2*)(p.Qr + (rowbase + i) * 128 + 64 + dd) = qbw;
            const int c = dd >> 3, o8 = (dd & 7) * 2;
            *(uint2*)(Qm + i * 256 + ((c ^ (i & 15)) << 4) + o8) = qaw; *(uint2*)(Qm + i * 256 + (((c + 8) ^ (i & 15)) << 4) + o8) = qbw;
            *(uint2*)(Km + i * 256 + ((c ^ (i & 15)) << 4) + o8) = kaw; *(uint2*)(Km + i * 256 + (((c + 8) ^ (i & 15)) << 4) + o8) = kbw;
            *(unsigned*)(Kl + i * 130 + dd) = pk2(ka[0] * kd, ka[1] * kd); *(unsigned*)(Kl + i * 130 + dd + 2) = pk2(ka[2] * kd, ka[3] * kd);
            *(unsigned*)(Kl + i * 130 + 64 + dd) = pk2(kb[0] * kd, kb[1] * kd); *(unsigned*)(Kl + i * 130 + 64 + dd + 2) = pk2(kb[2] * kd, kb[3] * kd);
        }
#pragma unroll
        for (int k = 0; k < 4; ++k) {
            const int u = tid + 512 * k, j = u >> 5, c = u & 31;
            const uint4 w = *(const uint4*)(p.ZG + (size_t)(tok0 + j) * ZW + 4096 + h * 256 + c * 8);
            unsigned* d = (unsigned*)(Vl + j * 258 + c * 8); d[0] = w.x; d[1] = w.y; d[2] = w.z; d[3] = w.w;
        }
        __syncthreads();
        {
            const int jt = wave >> 1, it0 = 2 * (wave & 1);
            f32x4_t s0 = {0.f, 0.f, 0.f, 0.f}, s1 = {0.f, 0.f, 0.f, 0.f};
#pragma unroll
            for (int ks = 0; ks < 4; ++ks) {
                const bf16x8_t a = ldfrag(Km, jt * 16 + fr, ks * 4 + fq, 256, 15);
                const bf16x8_t b0 = ldfrag(Qm, it0 * 16 + fr, ks * 4 + fq, 256, 15), b1 = ldfrag(Qm, (it0 + 1) * 16 + fr, ks * 4 + fq, 256, 15);
                s0 = __builtin_amdgcn_mfma_f32_16x16x32_bf16(a, b0, s0, 0, 0, 0);
                s1 = __builtin_amdgcn_mfma_f32_16x16x32_bf16(a, b1, s1, 0, 0, 0);
            }
            const int j0 = jt * 16 + fq * 4;
            bf16_t* pg = p.Pm + (size_t)it * 4096;
#pragma unroll
            for (int tt = 0; tt < 2; ++tt) {
                const int i = (it0 + tt) * 16 + fr; const f32x4_t sv4 = tt ? s1 : s0; float pv[4];
#pragma unroll
                for (int r = 0; r < 4; ++r) pv[r] = sv4[r] * __expf(lg * fabsf((float)(i - (j0 + r))));
                *(uint2*)(pg + i * 64 + j0) = make_uint2(pk2(pv[0], pv[1]), pk2(pv[2], pv[3]));
            }
        }
        bf16_t* kt = p.KTd + (size_t)it * 8192;
#pragma unroll
        for (int k = 0; k < 2; ++k) {
            const int u = tid + 512 * k, jg = u & 7, d = u >> 3;
            unsigned w[4];
#pragma unroll
            for (int q = 0; q < 4; ++q) w[q] = (unsigned)Kl[(jg * 8 + 2 * q) * 130 + d] | ((unsigned)Kl[(jg * 8 + 2 * q + 1) * 130 + d] << 16);
            *(uint4*)(kt + d * 64 + jg * 8) = make_uint4(w[0], w[1], w[2], w[3]);
        }
        bf16_t* vt = p.Vt + (size_t)it * 16384;
#pragma unroll
        for (int k = 0; k < 4; ++k) {
            const int u = tid + 512 * k, jg = u & 7, v = u >> 3;
            unsigned w[4];
#pragma unroll
            for (int q = 0; q < 4; ++q) w[q] = (unsigned)Vl[(jg * 8 + 2 * q) * 258 + v] | ((unsigned)Vl[(jg * 8 + 2 * q + 1) * 258 + v] << 16);
            *(uint4*)(vt + v * 64 + jg * 8) = make_uint4(w[0], w[1], w[2], w[3]);
        }
    }
    __syncthreads();
}

__device__ __forceinline__ void ph_ret2(const Params& p, int bid, int nb, float* lds) {
    char* L = (char*)lds;
    constexpr int OQ = 0, OKT = 16384, OPP = 32768, OVT = 40960, TILE = 43008, OST = 2 * TILE;
    const int tid = tid_(), wave = tid >> 6, lane = tid & 63, fr = lane & 15, fq = lane >> 4;
    for (int it = bid; it < 256; it += nb) {
        const int itm = ((it & 7) * 2 + (it >> 7)) * 16 + ((it >> 3) & 15);
        const int vs = itm & 15, h = (itm >> 4) & 7, b = itm >> 7;
        const float lg = log1pf(-exp2f(-5.0f - (float)h));
        const float cdec = expf(lg * 64.0f);
        const size_t bh = (size_t)(b * 8 + h);
        const char* gQ = (const char*)(p.Qr + bh * SQ * 128);
        const char* gKT = (const char*)(p.KTd + bh * 64 * 8192);
        const char* gP = (const char*)(p.Pm + bh * 64 * 4096);
        const char* gVt = (const char*)(p.Vt + bh * 64 * 16384) + vs * 16 * 128;
        int lq[2], lkt[2];
#pragma unroll
        for (int u = 0; u < 2; ++u) { const int ci = tid + 512 * u; const int r = ci >> 4, c = ci & 15; lq[u] = r * 256 + ((c ^ (r & 15)) << 4); const int d = ci >> 3, c8 = ci & 7; lkt[u] = d * 128 + ((c8 ^ (d & 7)) << 4); }
        const int lp = (tid >> 3) * 128 + (((tid & 7) ^ ((tid >> 3) & 7)) << 4);
        const int lv = lp;
        uint4 qA0, qA1, tA0, tA1, pA, vA = make_uint4(0u, 0u, 0u, 0u), qB0, qB1, tB0, tB1, pB, vB = vA, qC0, qC1, tC0, tC1, pC, vC = vA, qD0, qD1, tD0, tD1, pD, vD = vA;
#define RET_LOAD(X_, n_) do { const size_t o0 = (size_t)(n_) * 16384 + (size_t)tid * 16, o1 = o0 + 8192; \
        q##X_##0 = *(const uint4*)(gQ + o0); q##X_##1 = *(const uint4*)(gQ + o1); t##X_##0 = *(const uint4*)(gKT + o0); t##X_##1 = *(const uint4*)(gKT + o1); p##X_ = *(const uint4*)(gP + (size_t)(n_) * 8192 + tid * 16); \
        if (tid < 128) v##X_ = *(const uint4*)(gVt + (size_t)(n_) * 32768 + tid * 16); } while (0)
#define RET_WRITE(X_, buf_) do { char* B_ = L + (buf_) * TILE; \
        *(uint4*)(B_ + OQ + lq[0]) = q##X_##0; *(uint4*)(B_ + OQ + lq[1]) = q##X_##1; *(uint4*)(B_ + OKT + lkt[0]) = t##X_##0; *(uint4*)(B_ + OKT + lkt[1]) = t##X_##1; *(uint4*)(B_ + OPP + lp) = p##X_; \
        if (tid < 128) *(uint4*)(B_ + OVT + lv) = v##X_; } while (0)
        __syncthreads();
        for (int i = tid; i < 1024; i += NTH) ((unsigned*)(L + OST))[i] = 0u;
        RET_LOAD(A, 0); RET_WRITE(A, 0); RET_LOAD(B, 1); RET_LOAD(C, 2); RET_LOAD(D, 3);
        f32x4_t sacc[2] = {{0.f, 0.f, 0.f, 0.f}, {0.f, 0.f, 0.f, 0.f}};
#define RET_STEP(n_, cur_, LS_, WS_) do { const int n = (n_); constexpr int cur = (cur_); \
            __syncthreads();                                     \
            if (n + 4 < 64) RET_LOAD(LS_, n + 4); \
            const char* T = L + cur * TILE; \
            if (wave < 4) {     \
                const int itl = wave; \
                f32x4_t o1 = {0.f, 0.f, 0.f, 0.f}, o2 = {0.f, 0.f, 0.f, 0.f}; \
                _Pragma("unroll") for (int ks = 0; ks < 2; ++ks) o1 = __builtin_amdgcn_mfma_f32_16x16x32_bf16(ldfrag(T + OPP, itl * 16 + fr, ks * 4 + fq, 128, 7), ldfrag(T + OVT, fr, ks * 4 + fq, 128, 7), o1, 0, 0, 0); \
                _Pragma("unroll") for (int ks = 0; ks < 4; ++ks) o2 = __builtin_amdgcn_mfma_f32_16x16x32_bf16(ldfrag(T + OQ, itl * 16 + fr, ks * 4 + fq, 256, 15), ldfrag(L + OST + cur * 4096, fr, ks * 4 + fq, 256, 15), o2, 0, 0, 0); \
                _Pragma("unroll") for (int r = 0; r < 4; ++r) { const int i = itl * 16 + fq * 4 + r; \
                    p.ob16[(size_t)(b * SQ + n * 64 + i) * DM + h * 256 + vs * 16 + fr] = (bf16_t)f2bf(o1[r] + __expf(lg * (float)(i + 1)) * o2[r]); } \
            } else {            \
                _Pragma("unroll") for (int u = 0; u < 2; ++u) { \
                    const int dt = 2 * (wave - 4) + u; \
                    sacc[u] = sacc[u] * cdec; \
                    _Pragma("unroll") for (int ks = 0; ks < 2; ++ks) sacc[u] = __builtin_amdgcn_mfma_f32_16x16x32_bf16(ldfrag(T + OKT, dt * 16 + fr, ks * 4 + fq, 128, 7), ldfrag(T + OVT, fr, ks * 4 + fq, 128, 7), sacc[u], 0, 0, 0); \
                    *(uint2*)(L + OST + (cur ^ 1) * 4096 + fr * 256 + (((dt * 2 + (fq >> 1)) ^ fr) << 4) + (fq & 1) * 8) = make_uint2(pk2(sacc[u][0], sacc[u][1]), pk2(sacc[u][2], sacc[u][3])); } \
            } \
            if (n + 1 < 64) RET_WRITE(WS_, cur ^ 1); } while (0)
#pragma unroll
        for (int n4 = 0; n4 < 64; n4 += 4) { RET_STEP(n4, 0, A, B); RET_STEP(n4 + 1, 1, B, C); RET_STEP(n4 + 2, 0, C, D); RET_STEP(n4 + 3, 1, D, A); }
#undef RET_STEP
#undef RET_LOAD
#undef RET_WRITE
    }
    __syncthreads();
}

__device__ __forceinline__ void gn_load(const Params& p, int tok, int lane, uint2 (&ow)[8], uint2 (&gw)[8]) {
#pragma unroll
    for (int h = 0; h < 8; ++h) { ow[h] = *(const uint2*)(p.ob16 + (size_t)tok * DM + h * 256 + lane * 4); gw[h] = *(const uint2*)(p.ZG + (size_t)tok * ZW + 6144 + h * 256 + lane * 4); }
}
__device__ __forceinline__ void ph_gn(const Params& p, int bid, int nb, float* lds) {
    const int tid = tid_(), wave = tid >> 6, lane = tid & 63;
    const int stride = nb * 8;
    int tok = bid * 8 + wave;
    uint2 ow[8], gw[8], own[8], gwn[8];
    if (tok < NTOK) gn_load(p, tok, lane, ow, gw);
    for (; tok < NTOK; tok += stride) {
        if (tok + stride < NTOK) gn_load(p, tok + stride, lane, own, gwn);
        float4 o[8]; float s1[8], s2[8];
#pragma unroll
        for (int h = 0; h < 8; ++h) { o[h] = make_float4(bflo(ow[h].x), bfhi(ow[h].x), bflo(ow[h].y), bfhi(ow[h].y)); s1[h] = (o[h].x + o[h].y) + (o[h].z + o[h].w); }
#pragma unroll
        for (int h = 0; h < 8; ++h) s1[h] = row_sum16(s1[h]);
#pragma unroll
        for (int h = 0; h < 8; ++h) s1[h] = xsum32(xsum16(s1[h]));
#pragma unroll
        for (int h = 0; h < 8; ++h) { const float mu = s1[h] * (1.0f / 256.0f); o[h].x -= mu; o[h].y -= mu; o[h].z -= mu; o[h].w -= mu; s2[h] = dot4(o[h], o[h]); }
#pragma unroll
        for (int h = 0; h < 8; ++h) s2[h] = row_sum16(s2[h]);
#pragma unroll
        for (int h = 0; h < 8; ++h) s2[h] = xsum32(xsum16(s2[h]));
#pragma unroll
        for (int h = 0; h < 8; ++h) {
            const float rs = 1.0f / sqrtf(s2[h] * (1.0f / 256.0f) + 1e-6f);
            const float4 gn = *(const float4*)(p.ret_gn_g + h * 256 + lane * 4);
            const float g0 = bflo(gw[h].x), g1 = bfhi(gw[h].x), g2 = bflo(gw[h].y), g3 = bfhi(gw[h].y);
            st_wt4((unsigned char*)p.ybin + (size_t)tok * DM + h * 256 + lane * 4,
                pk4f8(siluf_(g0) * o[h].x * rs * gn.x, siluf_(g1) * o[h].y * rs * gn.y, siluf_(g2) * o[h].z * rs * gn.z, siluf_(g3) * o[h].w * rs * gn.w));
        }
#pragma unroll
        for (int h = 0; h < 8; ++h) { ow[h] = own[h]; gw[h] = gwn[h]; }
    }
}

__device__ __forceinline__ void split8(const float4 a, const float4 b, uint4& hi, uint4& lo) {
    const float x[8] = {a.x, a.y, a.z, a.w, b.x, b.y, b.z, b.w}; unsigned h[8], l[8];
#pragma unroll
    for (int i = 0; i < 8; ++i) { h[i] = f2bf(x[i]); l[i] = f2bf(x[i] - __uint_as_float(h[i] << 16)); }
    hi = make_uint4(h[0] | (h[1] << 16), h[2] | (h[3] << 16), h[4] | (h[5] << 16), h[6] | (h[7] << 16));
    lo = make_uint4(l[0] | (l[1] << 16), l[2] | (l[3] << 16), l[4] | (l[5] << 16), l[6] | (l[7] << 16));
}
__device__ __forceinline__ bf16x8_t as_bf16x8(const uint4 v) { return __builtin_bit_cast(bf16x8_t, v); }
struct PairTab { int a[52], b[52]; };
__host__ __device__ constexpr PairTab make_pairs() {
    PairTab t{}; int n = 0;
    for (int a = 0; a < 16; ++a) for (int b = 0; b < 16; ++b) if ((a + 1) * (b + 1) <= 16) { t.a[n] = a; t.b[n] = b; ++n; }
    for (; n < 52; ++n) { t.a[n] = -1; t.b[n] = -1; }
    return t;
}
constexpr PairTab PAIRS = make_pairs();
static_assert(PAIRS.a[49] >= 0 && PAIRS.a[50] < 0, "50 candidate pairs");

template <int N, int OFF> __device__ __forceinline__ void bitonic_sort_desc(float* v) {
#pragma unroll
    for (int k = 2; k <= N; k <<= 1)
#pragma unroll
        for (int j = k >> 1; j > 0; j >>= 1)
#pragma unroll
            for (int i = 0; i < N; ++i) { const int l = i ^ j; if (l > i) { const bool up = ((i & k) == 0);
                const float a = v[OFF + i], b = v[OFF + l]; const float mx = fmaxf(a, b), mn = fminf(a, b); v[OFF + i] = up ? mx : mn; v[OFF + l] = up ? mn : mx; } }
}
template <int N> __device__ __forceinline__ void bitonic_merge_desc(float* v) {
#pragma unroll
    for (int j = N >> 1; j > 0; j >>= 1)
#pragma unroll
        for (int i = 0; i < N; ++i) { const int l = i ^ j; if (l > i) { const float a = v[i], b = v[l]; v[i] = fmaxf(a, b); v[l] = fminf(a, b); } }
}
__device__ __forceinline__ void ph_topk2(const Params& p, const float* qb, int bid, int nb, float* lds, int it_fixed) {
    const int tid = tid_(), wave = tid >> 6, lane = tid & 63;
    uint4* SK = (uint4*)lds;
    const float NEG = -INFINITY;
    const bool tc_on = (nb == 256); const int tcr0 = (bid * 8 + wave) * 16; float4 tct[8];
    if (tc_on) tc_load(p, tcr0, lane, tct);
    for (int it = (it_fixed >= 0 ? it_fixed : bid); it < 256; it += (it_fixed >= 0 ? 256 : nb)) {
        const int h = it & 7, tg = it >> 3;
        __syncthreads();
        for (int gi = tid; gi < 4096; gi += NTH) {
            const int dq = gi & 15, n = (gi >> 4) & 127, pp = gi >> 11;
            const float4* src = (const float4*)(p.peer_sk + ((size_t)(h * 2 + pp) * 128 + n) * 128 + dq * 8);
            uint4 hi, lo; split8(src[0], src[1], hi, lo);
            const int base = (((pp * 8 + (n >> 4)) * 4 + (dq >> 2)) * 2) * 64 + (dq & 3) * 16 + (n & 15);
            SK[base] = hi; SK[base + 64] = lo;
        }
        __syncthreads();
#pragma unroll 1
        for (int tile = 0; tile < 2; ++tile) {
            const int tok = tg * 256 + wave * 32 + tile * 16 + (lane & 15);
            const int qd = lane >> 4;
            float v12[2][16];
#pragma unroll
            for (int pp = 0; pp < 2; ++pp) {
                if (tc_on) { const int ti = tile * 8 + pp * 4; tc_finish(p, tcr0 + ti, lane, tct); tc_load(p, tcr0 + ti + 1, lane, tct); }
                bf16x8_t Bh[4], Bl[4];
                const float* qp = qb + (size_t)tok * DM + h * 256 + pp * 128 + 8 * qd;
#pragma unroll
                for (int ks = 0; ks < 4; ++ks) { uint4 hi, lo; split8(*(const float4*)(qp + ks * 32), *(const float4*)(qp + ks * 32 + 4), hi, lo); Bh[ks] = as_bf16x8(hi); Bl[ks] = as_bf16x8(lo); }
                float v[32];
#pragma unroll
                for (int kt = 0; kt < 8; ++kt) {
                    f32x4_t acc = {0.f, 0.f, 0.f, 0.f};
#pragma unroll
                    for (int ks = 0; ks < 4; ++ks) {
                        const bf16x8_t Ah = as_bf16x8(SK[(((pp * 8 + kt) * 4 + ks) * 2) * 64 + lane]), Al = as_bf16x8(SK[(((pp * 8 + kt) * 4 + ks) * 2 + 1) * 64 + lane]);
                        acc = __builtin_amdgcn_mfma_f32_16x16x32_bf16(Ah, Bh[ks], acc, 0, 0, 0);
                        acc = __builtin_amdgcn_mfma_f32_16x16x32_bf16(Ah, Bl[ks], acc, 0, 0, 0);
                        acc = __builtin_amdgcn_mfma_f32_16x16x32_bf16(Al, Bh[ks], acc, 0, 0, 0);
                    }
#pragma unroll
                    for (int r = 0; r < 4; ++r) v[kt * 4 + r] = __uint_as_float((__float_as_uint(acc[r]) & ~127u) | (unsigned)(kt * 16 + qd * 4 + r));
                    __builtin_amdgcn_sched_barrier(0);
                }
                if (tc_on) { const int ti = tile * 8 + pp * 4 + 1; tc_finish(p, tcr0 + ti, lane, tct); tc_load(p, tcr0 + ti + 1, lane, tct); }
                bitonic_sort_desc<16, 0>(v); bitonic_sort_desc<16, 16>(v);
                float c16[16];
#pragma unroll
                for (int i = 0; i < 16; ++i) c16[i] = fmaxf(v[i], v[31 - i]);
                bitonic_merge_desc<16>(c16);
                if (tc_on) { const int ti = tile * 8 + pp * 4 + 2; tc_finish(p, tcr0 + ti, lane, tct); tc_load(p, tcr0 + ti + 1, lane, tct); }
#pragma unroll
                for (int st = 0; st < 2; ++st) {
                    float pr[16];
#pragma unroll
                    for (int i = 0; i < 16; ++i) pr[i] = __shfl_xor(c16[i], 16 << st);
#pragma unroll
                    for (int i = 0; i < 16; ++i) c16[i] = fmaxf(c16[i], pr[15 - i]);
                    bitonic_merge_desc<16>(c16);
                }
                if (tc_on) { const int ti = tile * 8 + pp * 4 + 3; tc_finish(p, tcr0 + ti, lane, tct); if (ti < 15) tc_load(p, tcr0 + ti + 1, lane, tct); }
#pragma unroll
                for (int i = 0; i < 16; ++i) v12[pp][i] = c16[i];
            }
            float c[13]; unsigned pay[13];
#pragma unroll
            for (int s = 0; s < 13; ++s) {
                float cq[4]; unsigned pq[4];
#pragma unroll
                for (int q = 0; q < 4; ++q) {
                    const int pi = 4 * s + q; const int a = PAIRS.a[pi], b = PAIRS.b[pi];
                    if (a >= 0) {
                        const float sum = v12[0][a] + v12[1][b];
                        cq[q] = __uint_as_float((__float_as_uint(sum) & ~63u) | (unsigned)pi);
                        pq[q] = (__float_as_uint(v12[0][a]) & 127u) * 128u + (__float_as_uint(v12[1][b]) & 127u);
                    } else { cq[q] = NEG; pq[q] = 0u; }
                }
                c[s] = qd == 0 ? cq[0] : qd == 1 ? cq[1] : qd == 2 ? cq[2] : cq[3];
                pay[s] = qd == 0 ? pq[0] : qd == 1 ? pq[1] : qd == 2 ? pq[2] : pq[3];
            }
            float top[16]; unsigned eid[16];
#pragma unroll
            for (int r = 0; r < 16; ++r) {
                float m = c[0];
#pragma unroll
                for (int s = 1; s < 13; ++s) m = fmaxf(m, c[s]);
                m = fmaxf(m, __shfl_xor(m, 16)); m = fmaxf(m, __shfl_xor(m, 32));
                unsigned pw = 0u;
#pragma unroll
                for (int s = 0; s < 13; ++s) { const bool eq = (c[s] == m); pw |= eq ? pay[s] : 0u; c[s] = eq ? NEG : c[s]; }
                pw |= (unsigned)__shfl_xor((int)pw, 16); pw |= (unsigned)__shfl_xor((int)pw, 32);
                top[r] = m; eid[r] = pw;
            }
            float sum = 0.f; const float mx = top[0];
#pragma unroll
            for (int r = 0; r < 16; ++r) { top[r] = expf(top[r] - mx); sum += top[r]; }
            const float inv = 1.0f / sum;
            if (lane < 16) {
                int4* ep = (int4*)(p.eidx + (size_t)tok * 128 + h * 16); float4* gp = (float4*)(p.gatev + (size_t)tok * 128 + h * 16);
#pragma unroll
                for (int q = 0; q < 4; ++q) {
                    ep[q] = make_int4((int)eid[4 * q], (int)eid[4 * q + 1], (int)eid[4 * q + 2], (int)eid[4 * q + 3]);
                    gp[q] = make_float4(top[4 * q] * inv, top[4 * q + 1] * inv, top[4 * q + 2] * inv, top[4 * q + 3] * inv);
                }
            }
        }
    }
    __syncthreads();
}

__device__ __forceinline__ void peer_load4(const unsigned char* tab, const int (&e)[4], int lane, uint2 (&R)[4][3]) {
#pragma unroll
    for (int i = 0; i < 4; ++i) { const uint2* r = (const uint2*)(tab + (size_t)e[i] * ROW6 + lane * 8); R[i][0] = r[0]; R[i][1] = r[64]; R[i][2] = r[128]; }
}
__device__ __forceinline__ f32x32_t dec6(const uint2 (&R)[3]) { const u32x6_t w = {R[0].x, R[0].y, R[1].x, R[1].y, R[2].x, R[2].y}; return __builtin_amdgcn_cvt_scalef32_pk32_f32_fp6(w, 1.0f); }
typedef float f32x2_t __attribute__((ext_vector_type(2)));
__device__ __forceinline__ bf16x8_t dec4_frag(unsigned w) {
    const unsigned a = __builtin_bit_cast(unsigned, __builtin_amdgcn_cvt_scalef32_pk_bf16_fp4(w, 1.0f, 0)), b = __builtin_bit_cast(unsigned, __builtin_amdgcn_cvt_scalef32_pk_bf16_fp4(w, 1.0f, 1));
    const unsigned c = __builtin_bit_cast(unsigned, __builtin_amdgcn_cvt_scalef32_pk_bf16_fp4(w, 1.0f, 2)), d = __builtin_bit_cast(unsigned, __builtin_amdgcn_cvt_scalef32_pk_bf16_fp4(w, 1.0f, 3));
    return as_bf16x8(make_uint4(a, b, c, d));
}
__device__ __forceinline__ void peer_vgroup(const Params& p, int lane, const uint4 (&Vc)[4], const float (&wgt)[4], f32x2_t (&y2)[16]) {
#pragma unroll
    for (int i = 0; i < 4; ++i) {
        const f32x2_t w2 = {wgt[i], wgt[i]};
        unsigned vw[4] = {Vc[i].x, Vc[i].y, Vc[i].z, Vc[i].w};
        asm volatile("" : "+v"(vw[0]), "+v"(vw[1]), "+v"(vw[2]), "+v"(vw[3]));
#pragma unroll
        for (int j = 0; j < 4; ++j) {
            y2[4 * j + 0] += w2 * __builtin_amdgcn_cvt_scalef32_pk_f32_fp4(vw[j], 1.0f, 0);
            y2[4 * j + 1] += w2 * __builtin_amdgcn_cvt_scalef32_pk_f32_fp4(vw[j], 1.0f, 1);
            y2[4 * j + 2] += w2 * __builtin_amdgcn_cvt_scalef32_pk_f32_fp4(vw[j], 1.0f, 2);
            y2[4 * j + 3] += w2 * __builtin_amdgcn_cvt_scalef32_pk_f32_fp4(vw[j], 1.0f, 3);
        }
#pragma unroll
        for (int k = 0; k < 16; ++k) asm volatile("" : "+v"(y2[k]));
    }
}
template <bool LD>
__device__ __forceinline__ void peer_ublk(const Params& p, const char* HL, int kq, int blk, unsigned nof, const unsigned (&ur)[8], uint4 (&Ac)[8], f32x4_t (&acc)[8]) {
    bf16x8_t B[4];
#pragma unroll
    for (int sidx = 0; sidx < 4; ++sidx) B[sidx] = *(const bf16x8_t*)(HL + (blk * 128 + sidx * 32 + kq * 8) * 2);
#pragma unroll
    for (int G = 0; G < 8; ++G) {
        const bf16x8_t f0 = dec4_frag(Ac[G].x), f1 = dec4_frag(Ac[G].y), f2 = dec4_frag(Ac[G].z), f3 = dec4_frag(Ac[G].w);
        if constexpr (LD) Ac[G] = *(const uint4*)(p.U8 + (ur[G] + nof));
        acc[G] = __builtin_amdgcn_mfma_f32_16x16x32_bf16(f0, B[0], acc[G], 0, 0, 0);
        acc[G] = __builtin_amdgcn_mfma_f32_16x16x32_bf16(f1, B[1], acc[G], 0, 0, 0);
        acc[G] = __builtin_amdgcn_mfma_f32_16x16x32_bf16(f2, B[2], acc[G], 0, 0, 0);
        acc[G] = __builtin_amdgcn_mfma_f32_16x16x32_bf16(f3, B[3], acc[G], 0, 0, 0);
        __builtin_amdgcn_sched_barrier(0);
    }
}
__device__ __forceinline__ void ph_peer6(const Params& p, const float* x1, const bf16_t* h2, int bid, int nb, float* lds) {
    const int tid = tid_(), wave = tid >> 6, lane0 = tid & 63;
    for (int t = bid * 8 + wave; t < NTOK; t += nb * 8) {
        int lane = lane0; asm volatile("" : "+v"(lane));
        const int fr = lane & 15, kq = lane >> 4;
        char* HL = (char*)lds + wave * 4608;
        float* WL = (float*)(HL + 4096);
        const int b = t / SQ;
#pragma unroll
        for (int q = 0; q < 4; ++q) *(uint4*)(HL + (lane + 64 * q) * 16) = *(const uint4*)(h2 + (size_t)t * DM + (lane + 64 * q) * 8);
        const int e0 = p.eidx[(size_t)t * 128 + lane], e1 = p.eidx[(size_t)t * 128 + 64 + lane];
        const float su0 = p.su[e0], su1 = p.su[e1];
        const float gv0 = p.gatev[(size_t)t * 128 + lane] * p.sv[e0], gv1 = p.gatev[(size_t)t * 128 + 64 + lane] * p.sv[e1];
        unsigned ur[8];
#pragma unroll
        for (int G = 0; G < 8; ++G) ur[G] = (unsigned)__shfl(G < 4 ? e0 : e1, 16 * (G & 3) + fr) * (unsigned)ROW4 + (unsigned)kq * 16u;
        f32x4_t acc[8];
#pragma unroll
        for (int G = 0; G < 8; ++G) acc[G] = (f32x4_t){0.f, 0.f, 0.f, 0.f};
        uint4 Aa[8], Ab[8];
#pragma unroll
        for (int G = 0; G < 8; ++G) Aa[G] = *(const uint4*)(p.U8 + ur[G]);
#pragma unroll
        for (int G = 0; G < 8; ++G) Ab[G] = *(const uint4*)(p.U8 + (ur[G] + 64u));
#pragma unroll 1
        for (int blk = 0; blk < 14; blk += 2) {
            peer_ublk<true>(p, HL, kq, blk, (unsigned)(blk + 2) * 64u, ur, Aa, acc);
            peer_ublk<true>(p, HL, kq, blk + 1, (unsigned)(blk + 3) * 64u, ur, Ab, acc);
        }
        peer_ublk<false>(p, HL, kq, 14, 0u, ur, Aa, acc);
        peer_ublk<false>(p, HL, kq, 15, 0u, ur, Ab, acc);
        const int kq4 = 4 * kq;
#pragma unroll
        for (int G = 0; G < 8; ++G) {
            float av[4];
#pragma unroll
            for (int j = 0; j < 4; ++j) av[j] = acc[G][j] * __shfl(G < 4 ? su0 : su1, (16 * (G & 3) + j) + kq4);
            const f32x2_t g01 = pg8::gelu_pk((f32x2_t){av[0], av[1]}), g23 = pg8::gelu_pk((f32x2_t){av[2], av[3]});
            const float w0 = g01.x * __shfl(G < 4 ? gv0 : gv1, (16 * (G & 3) + 0) + kq4), w1 = g01.y * __shfl(G < 4 ? gv0 : gv1, (16 * (G & 3) + 1) + kq4);
            const float w2_ = g23.x * __shfl(G < 4 ? gv0 : gv1, (16 * (G & 3) + 2) + kq4), w3 = g23.y * __shfl(G < 4 ? gv0 : gv1, (16 * (G & 3) + 3) + kq4);
            if (fr == 0) *(float4*)(WL + 16 * G + kq4) = make_float4(w0, w1, w2_, w3);
            __builtin_amdgcn_sched_barrier(0);
        }
        f32x2_t y2[16];
#pragma unroll
        for (int i = 0; i < 16; ++i) y2[i] = (f32x2_t){0.f, 0.f};
        uint4 VA[4], VB[4], VC[4];
#define PV_LOAD(V, g) { const int sn_ = 4 * (g); const int en_ = (sn_ < 64) ? e0 : e1; _Pragma("unroll") for (int i = 0; i < 4; ++i) \
        V[i] = *(const uint4*)(p.V8 + ((unsigned)__builtin_amdgcn_readlane(en_, (sn_ + i) & 63) * (unsigned)ROW4 + (unsigned)lane * 16u)); }
#define PV_USE(V, g) { const float4 w4 = *(const float4*)(WL + 4 * (g)); const float wgt[4] = {w4.x, w4.y, w4.z, w4.w}; peer_vgroup(p, lane, V, wgt, y2); }
        PV_LOAD(VA, 0); PV_LOAD(VB, 1);
#pragma unroll
        for (int g = 0; g < 30; g += 3) {
            PV_LOAD(VC, g + 2); PV_USE(VA, g);
            PV_LOAD(VA, g + 3); PV_USE(VB, g + 1);
            PV_LOAD(VB, g + 4); PV_USE(VC, g + 2);
        }
        PV_USE(VA, 30); PV_USE(VB, 31);
#undef PV_LOAD
#undef PV_USE
        float y[32];
#pragma unroll
        for (int k = 0; k < 16; ++k) { y[2 * k] = y2[k].x; y[2 * k + 1] = y2[k].y; }
        float ss = 0.f;
#pragma unroll
        for (int q = 0; q < 8; ++q) {
            const int c = 256 * q + lane * 4;
            const float4 xv = *(const float4*)(x1 + (size_t)t * DM + c);
            const float4 ga = *(const float4*)(p.ada + b * NMOD + 5 * DM + c);
            float* yy = y + 4 * q;
            yy[0] = xv.x + ga.x * yy[0]; yy[1] = xv.y + ga.y * yy[1]; yy[2] = xv.z + ga.z * yy[2]; yy[3] = xv.w + ga.w * yy[3];
            ss += yy[0] * yy[0] + yy[1] * yy[1] + yy[2] * yy[2] + yy[3] * yy[3];
        }
        ss = xsum32(xsum16(row_sum16(ss)));
        const float rs = 1.0f / sqrtf(ss * (1.0f / DM) + 1e-6f);
#pragma unroll
        for (int q = 0; q < 8; ++q) {
            const int c = 256 * q + lane * 4;
            const float4 gf = *(const float4*)(p.norm_f_g + c);
            const float* yy = y + 4 * q;
            *(float4*)(p.out + (size_t)t * DM + c) = make_float4(yy[0] * rs * gf.x, yy[1] * rs * gf.y, yy[2] * rs * gf.z, yy[3] * rs * gf.w);
        }
    }
}

#define LAS __attribute__((address_space(3)))
#define XB_TMO      128
#define XB_XCNT(j)  (256  + 64 * (j))
#define XB_XSUB(j)  (1280 + 64 * (j))
#define XB_XGEN(j)  (2304 + 64 * (j))
#define XB_TOP      3328
#define XB_TOPGEN   3392
#define XCD_BAR_WORDS 3456
#define XB_SPIN_CAP (1u << 18)

__device__ __forceinline__ unsigned xb_ld(unsigned* p)              { return __hip_atomic_load(p, __ATOMIC_RELAXED, __HIP_MEMORY_SCOPE_AGENT); }
__device__ __forceinline__ unsigned xb_add(unsigned* p, unsigned v) { return __hip_atomic_fetch_add(p, v, __ATOMIC_RELAXED, __HIP_MEMORY_SCOPE_AGENT); }
__device__ __forceinline__ unsigned xb_xcc_id() { return (unsigned)__builtin_amdgcn_s_getreg((3 << 11) | 20) & 0xFu; }
#define XB_SPIN(cond, bar) do { unsigned _sp = 0; while (cond) { __builtin_amdgcn_s_sleep(1); \
    if ((++_sp & 255u) == 0u) { if (xb_ld(&(bar)[XB_TMO])) break; if (_sp > XB_SPIN_CAP) { atomicAdd(&(bar)[XB_TMO], 1u); break; } } } } while (0)

struct XcdBarrier {
    unsigned* bar; unsigned x;
    volatile LAS unsigned* st;
};

__device__ __forceinline__ XcdBarrier xcd_barrier_post(unsigned* bar, volatile LAS unsigned* st) {
    XcdBarrier b; b.bar = bar; b.x = xb_xcc_id(); b.st = st;
    if (tid_() == 0) (void)xb_add(&bar[XB_XCNT(b.x)], 1u);
    return b;
}
__device__ __forceinline__ void xcd_barrier_complete(unsigned* bar, unsigned x, unsigned& nloc, unsigned& nx) {
    const unsigned G = gridDim.x * gridDim.y * gridDim.z;
    unsigned sum, cnt, mine, sp = 0u;
    for (;;) {
        sum = 0u; cnt = 0u; mine = 0u;
#pragma unroll
        for (unsigned j = 0; j < 16; ++j) { const unsigned c = xb_ld(&bar[XB_XCNT(j)]); sum += c; cnt += (c > 0u) ? 1u : 0u; mine = (j == x) ? c : mine; }
        if (sum == G) break;
        __builtin_amdgcn_s_sleep(1);
        if ((++sp & 255u) == 0u) { if (xb_ld(&bar[XB_TMO])) break; if (sp > XB_SPIN_CAP) { atomicAdd(&bar[XB_TMO], 1u); break; } }
    }
    nloc = mine > 0u ? mine : 1u; nx = cnt > 0u ? cnt : 1u;
}

__device__ __forceinline__ void xcd_barrier(const XcdBarrier& b) {
    asm volatile("s_waitcnt vmcnt(0)" ::: "memory");
    __syncthreads();
    if (tid_() == 0) {
        unsigned* bar = b.bar;
        __builtin_amdgcn_s_waitcnt(0);
        unsigned nloc = b.st[0], nx = b.st[1];
        if (nloc == 0u) { xcd_barrier_complete(bar, b.x, nloc, nx); b.st[0] = nloc; b.st[1] = nx; }
        const unsigned old = xb_add(&bar[XB_XSUB(b.x)], 1u);
        const unsigned gen = old / nloc;
        if (old + 1u == (gen + 1u) * nloc) {
            __builtin_amdgcn_fence(__ATOMIC_RELEASE, "agent");
            asm volatile("s_waitcnt vmcnt(0)" ::: "memory");
            const unsigned og = xb_add(&bar[XB_TOP], 1u);
            const unsigned tg = og / nx;
            if (og + 1u == (tg + 1u) * nx) xb_add(&bar[XB_TOPGEN], 1u);
            else XB_SPIN(xb_ld(&bar[XB_TOPGEN]) == tg, bar);
            __builtin_amdgcn_fence(__ATOMIC_ACQUIRE, "agent");
            xb_add(&bar[XB_XGEN(b.x)], 1u);
            asm volatile("s_waitcnt vmcnt(0)" ::: "memory");
        } else {
            XB_SPIN(xb_ld(&bar[XB_XGEN(b.x)]) == gen, bar);
            __builtin_amdgcn_fence(__ATOMIC_ACQUIRE, "agent");
            asm volatile("s_waitcnt vmcnt(0)" ::: "memory");
        }
    }
    __syncthreads();
}

template <bool F8 = false, class Epi>
__device__ __forceinline__ void gemm_run(float* lds, const void* A, const void* Bt, int M, int N, int K, const Epi& E) {
    __syncthreads();
    pg8::Gemm g{(const bf16_t*)A, (const bf16_t*)Bt, M, N, F8 ? K / 2 : K}; pg8::StaticOrder S; S.init(M, N, (int)gridDim.x, (int)blockIdx.x);
    pg8::gemm_phase<Epi, pg8::StaticOrder, true, true, F8>((PG8_LAS unsigned char*)lds, g, S, E);
    __syncthreads();
}
constexpr int NPHASE = 11;
template <int PH>
__device__ __forceinline__ void run_phase(const Params& p, int bid, int nb, float* lds) {
    asm volatile("" : "+s"(bid));
    if constexpr (PH == 0) ph_prep(p, bid, nb, lds);
    if constexpr (PH == 1) ph_modnorm<true>(p, p.x, p.norm1_g, 0 * DM, 1 * DM, p.hb, bid, nb, lds);
    if constexpr (PH == 2) gemm_run<true>(lds, p.hb, p.Wt1, NTOK, ZW, DM, pg8::EpiZG{p.ZG, p.b_bg, 1.0f / W8S});
    if constexpr (PH == 3) { ph_retprep(p, bid, nb, lds); ph_gmlp2(p, bid, nb, lds); }
    if constexpr (PH == 11) ph_ret2(p, bid, nb, lds);
    if constexpr (PH == 4) ph_gn(p, bid, nb, lds);
    if constexpr (PH == 5) {
        gemm_run<true>(lds, p.yain, p.Wta, NTOK, DM, 1024, pg8::EpiMixB<0>{p.ob16, (unsigned char*)p.hb, p.ZG, 0, 1.0f / W8S});
        gemm_run<true>(lds, p.ybin, p.Wtb, NTOK, DM, DM, pg8::EpiMixB<1>{p.ob16, (unsigned char*)p.hb, p.ZG, 2048, 1.0f / W8S});
    }
    if constexpr (PH == 6) gemm_run<true>(lds, p.hb, p.Wto, NTOK, DM, DM, pg8::EpiResF{p.obuf, p.x, p.ada + 2 * DM, 1.0f / W8S});
    if constexpr (PH == 7) { ph_modnorm<false>(p, p.obuf, p.norm2_g, 3 * DM, 4 * DM, p.hb, bid, nb, lds); if (nb != 256) ph_tabconv(p, bid, nb); }
    if constexpr (PH == 8) {
        gemm_run(lds, p.hb, p.Wtq, NTOK, DM, DM, pg8::EpiF32{p.qbuf, DM});
        if (nb == 256) {
            pg8::StaticOrder S; S.init(NTOK, DM, (int)gridDim.x, (int)blockIdx.x); pg8::Unit u; S.next(0, u);
            asm volatile("s_waitcnt vmcnt(0)" ::: "memory"); __syncthreads();
            ph_topk2(p, p.qbuf, bid, nb, lds, u.pm * 8 + u.pn);
        }
    }
    if constexpr (PH == 9) { if (nb != 256) ph_topk2(p, p.qbuf, bid, nb, lds, -1); }
    if constexpr (PH == 10) ph_peer6(p, p.obuf, p.hb, bid, nb, lds);
}

constexpr int MISC_OFF = 132 * 1024;
__global__ void __launch_bounds__(NTH) k_mega(Params p) {
    extern __shared__ __attribute__((aligned(16))) float lds[];
    const int bid = blockIdx.x, nb = gridDim.x;
    volatile LAS unsigned* misc = (volatile LAS unsigned*)((LAS unsigned char*)lds + MISC_OFF);
    if (threadIdx.x < 4) misc[threadIdx.x] = 0u;
    if ((threadIdx.x & 63) == 0) *(volatile LASP unsigned*)(unsigned)(TIDW_OFF + 4 * hw_slot_()) = threadIdx.x >> 6;
    __syncthreads();
    XcdBarrier bar = xcd_barrier_post(p.bar, misc);
    run_phase<0>(p, bid, nb, lds); xcd_barrier(bar);
    run_phase<1>(p, bid, nb, lds); xcd_barrier(bar);
    run_phase<2>(p, bid, nb, lds); xcd_barrier(bar);
    run_phase<3>(p, bid, nb, lds); xcd_barrier(bar);
    run_phase<11>(p, bid, nb, lds); xcd_barrier(bar);
    run_phase<4>(p, bid, nb, lds); xcd_barrier(bar);
    run_phase<5>(p, bid, nb, lds); xcd_barrier(bar);
    run_phase<6>(p, bid, nb, lds); xcd_barrier(bar);
    run_phase<7>(p, bid, nb, lds); xcd_barrier(bar);
    run_phase<8>(p, bid, nb, lds); xcd_barrier(bar);
    if (nb != 256) { run_phase<9>(p, bid, nb, lds); xcd_barrier(bar); }
    run_phase<10>(p, bid, nb, lds);
}

extern "C" void kernel_launch(void* const* d_in, const int* in_sizes, int n_in, void* d_out, int out_size, void* d_ws, size_t ws_size, hipStream_t stream) {
    Params p{};
    p.x = (const float*)d_in[0]; p.c = (const float*)d_in[1]; p.pos = (const int*)d_in[2];
    p.w_ada = (const float*)d_in[3]; p.b_ada = (const float*)d_in[4]; p.norm1_g = (const float*)d_in[5]; p.w_in = (const float*)d_in[6];
    p.w_bg = (const float*)d_in[7]; p.b_bg = (const float*)d_in[8]; p.gm_v_g = (const float*)d_in[9]; p.gm_ws = (const float*)d_in[10];
    p.gm_b = (const float*)d_in[11]; p.ret_gn_g = (const float*)d_in[12]; p.w_a_out = (const float*)d_in[13]; p.w_b_out = (const float*)d_in[14];
    p.w_o = (const float*)d_in[15]; p.norm2_g = (const float*)d_in[16]; p.peer_wq = (const float*)d_in[17]; p.peer_sk = (const float*)d_in[18];
    p.peer_u = (const float*)d_in[19]; p.peer_v = (const float*)d_in[20]; p.norm_f_g = (const float*)d_in[21];
    p.out = (float*)d_out;
    char* w = (char*)d_ws; size_t off = 0;
    auto take = [&](size_t bytes) { char* r = w + off; off += (bytes + 255) & ~(size_t)255; return r; };
    p.bar = (unsigned*)take(XCD_BAR_WORDS * 4);
    p.ada = (float*)take(2 * NMOD * 4);
    p.rope = (float*)take((size_t)NTOK * 128 * 4);
    p.eidx = (int*)take((size_t)NTOK * 128 * 4);
    p.gatev = (float*)take((size_t)NTOK * 128 * 4);
    p.Wt1 = (bf16_t*)take((size_t)ZW * DM * 2);
    p.Wta = (bf16_t*)take((size_t)DM * 1024 * 2);
    p.Wtb = (bf16_t*)take((size_t)DM * DM * 2);
    p.Wto = (bf16_t*)take((size_t)DM * DM * 2);
    p.Wtq = (bf16_t*)take((size_t)DM * DM * 2);
    p.hb = (bf16_t*)take((size_t)NTOK * DM * 2);
    p.ZG = (bf16_t*)take((size_t)NTOK * ZW * 2);
    p.qbuf = (float*)p.ZG;
    p.obuf = (float*)take((size_t)NTOK * DM * 4);
    p.ybin = (bf16_t*)take((size_t)NTOK * DM * 2);
    p.yain = (bf16_t*)take((size_t)NTOK * 1024 * 2);
    p.U8 = (unsigned char*)p.ZG + (size_t)NTOK * DM * 4;
    p.V8 = p.U8 + (size_t)16384 * ROW4;
    p.su = (float*)take(16384 * 4); p.sv = (float*)take(16384 * 4);
    p.Qr = (bf16_t*)take((size_t)NTOK * 1024 * 2);
    p.Pm = (bf16_t*)take((size_t)16 * 64 * 4096 * 2);
    p.KTd = (bf16_t*)take((size_t)NTOK * 1024 * 2);
    p.Vt = (bf16_t*)take((size_t)NTOK * 2048 * 2);
    p.ob16 = (bf16_t*)take((size_t)NTOK * DM * 2);
    if (off > ws_size) { fprintf(stderr, "kernel_launch: workspace too small: need %zu have %zu\n", off, ws_size); return; }
    static int grid = 0;
    if (!grid) {
        int dev = 0, cus = 0, per_cu = 0;
        (void)hipGetDevice(&dev); (void)hipDeviceGetAttribute(&cus, hipDeviceAttributeMultiprocessorCount, dev);
        (void)hipFuncSetAttribute((const void*)k_mega, hipFuncAttributeMaxDynamicSharedMemorySize, LDS_BYTES);
        (void)hipOccupancyMaxActiveBlocksPerMultiprocessor(&per_cu, k_mega, NTH, LDS_BYTES);
        (void)per_cu;
        grid = cus;
    }
    (void)hipMemsetAsync(p.bar, 0, XCD_BAR_WORDS * 4, stream);
    hipLaunchKernelGGL(k_mega, dim3(grid), dim3(NTH), LDS_BYTES, stream, p);
    hipError_t e = hipPeekAtLastError();
    if (e != hipSuccess) fprintf(stderr, "launch failed: %s (grid %d)\n", hipGetErrorString(e), grid);
}
```
